# Optimizing an MI355X kernel written in HIP

```python
import math
import jax, jax.numpy as jnp
from jax import lax
import numpy as np

D_MODEL = 2048
BATCH = 2
SEQ = 16384
DEPTH = 2

RET_HEADS = 8
RET_DK = 128
RET_DV = 256
RET_CHUNK = 128
GDN_HEADS = 8
GDN_DK = 128
GDN_DV = 256
GDN_CHUNK = 64
CONV_WIDTH = 4
SWA_Q_HEADS = 32
SWA_KV_HEADS = 4
SWA_HEAD_DIM = 64
WINDOW = 128
ROPE_THETA = 10000.0
N_GROUPS = 4
EXPERTS_PER_GROUP = 8
N_EXPERTS = N_GROUPS * EXPERTS_PER_GROUP
TOP_K = 2
D_FF_EXPERT = 768
MOE_BLOCK = 128
EPS = 1e-6

GDN_CONV_CH = 2 * GDN_HEADS * GDN_DK + GDN_HEADS * GDN_DV
EVEN_SPLITS = (RET_HEADS * RET_DK, RET_HEADS * RET_DK, RET_HEADS * RET_DV, RET_HEADS * RET_DV,
               GDN_CONV_CH, GDN_HEADS * GDN_DV, GDN_HEADS, GDN_HEADS)
EVEN_IN_DIM = sum(EVEN_SPLITS)
EVEN_MIX_DIM = RET_HEADS * RET_DV + GDN_HEADS * GDN_DV
ODD_SPLITS = (SWA_Q_HEADS * SWA_HEAD_DIM, SWA_KV_HEADS * SWA_HEAD_DIM, SWA_KV_HEADS * SWA_HEAD_DIM)
ODD_IN_DIM = sum(ODD_SPLITS)
ODD_MIX_DIM = SWA_Q_HEADS * SWA_HEAD_DIM

kernel_name = "hybrid_retention_gdn_swa_hmoe"


def rmsnorm(x, g):
    xf = x.astype(jnp.float32)
    y = xf * lax.rsqrt(jnp.mean(xf * xf, axis=-1, keepdims=True) + EPS)
    return (y * g.astype(jnp.float32)).astype(x.dtype)


def l2norm(x):
    return x * lax.rsqrt(jnp.sum(x * x, axis=-1, keepdims=True) + EPS)


def split_cols(x, sizes):
    return jnp.split(x, np.cumsum(sizes)[:-1].tolist(), axis=-1)


def rope(x, pos):
    d = x.shape[-1]
    half = d // 2
    inv_freq = jnp.power(ROPE_THETA, -jnp.arange(half, dtype=jnp.float32) / half)
    ang = pos.astype(jnp.float32)[:, None] * inv_freq[None, :]
    cos = jnp.cos(ang)[None, :, None, :]
    sin = jnp.sin(ang)[None, :, None, :]
    xf = x.astype(jnp.float32)
    x1, x2 = xf[..., :half], xf[..., half:]
    return jnp.concatenate([x1 * cos - x2 * sin, x2 * cos + x1 * sin], axis=-1)


def to_chunks(x, c):
    b, s, h, d = x.shape
    return x.reshape(b, s // c, c, h, d).transpose(1, 0, 3, 2, 4)


def from_chunks(x):
    n, b, h, c, d = x.shape
    return x.transpose(1, 0, 3, 2, 4).reshape(b, n * c, h, d)


def causal_depthwise_conv(x, w):
    k_width = w.shape[0]
    s = x.shape[1]
    xp = jnp.pad(x, ((0, 0), (k_width - 1, 0), (0, 0)))
    return sum(xp[:, j:j + s] * w[j] for j in range(k_width))


def retention_chunkwise(q, k, v):
    b, _, h, dk = q.shape
    dv = v.shape[-1]
    c = RET_CHUNK
    log_gamma = jnp.log1p(-jnp.exp2(-5.0 - jnp.arange(h, dtype=jnp.float32)))
    pos = jnp.arange(c, dtype=jnp.float32)
    rel = pos[:, None] - pos[None, :]
    causal = rel >= 0
    d_in = jnp.where(causal, jnp.exp(log_gamma[:, None, None] * jnp.where(causal, rel, 0.0)), 0.0)
    q_dec = jnp.exp(log_gamma[:, None] * (pos + 1.0))[None, :, :, None]
    k_dec = jnp.exp(log_gamma[:, None] * (c - 1.0 - pos))[None, :, :, None]
    c_dec = jnp.exp(log_gamma * c)[None, :, None, None]
    qc, kc, vc = to_chunks(q, c), to_chunks(k, c), to_chunks(v, c)
    inner = jnp.einsum('nbhij,nbhje->nbhie', jnp.einsum('nbhid,nbhjd->nbhij', qc, kc) * d_in, vc)

    def step(state, inp):
        q_i, k_i, v_i = inp
        cross = jnp.einsum('bhid,bhde->bhie', q_i * q_dec, state)
        state = state * c_dec + jnp.einsum('bhjd,bhje->bhde', k_i * k_dec, v_i)
        return state, cross

    state0 = jnp.zeros((b, h, dk, dv), jnp.float32)
    _, cross = lax.scan(step, state0, (qc, kc, vc))
    return from_chunks(inner + cross)


def gated_delta_rule_chunked(q, k, v, g, beta):
    b, s, h, dk = q.shape
    dv = v.shape[-1]
    c = GDN_CHUNK
    n = s // c
    qc, kc, vc = to_chunks(q, c), to_chunks(k, c), to_chunks(v, c)
    gc = g.reshape(b, n, c, h).transpose(1, 0, 3, 2)
    bc = beta.reshape(b, n, c, h).transpose(1, 0, 3, 2)
    g_cum = jnp.cumsum(gc, axis=-1)
    rel = g_cum[..., :, None] - g_cum[..., None, :]
    causal = jnp.tril(jnp.ones((c, c), bool))
    strict = jnp.tril(jnp.ones((c, c), bool), -1)
    decay = jnp.where(causal, jnp.exp(jnp.where(causal, rel, 0.0)), 0.0)
    k_beta = kc * bc[..., None]
    lower = jnp.where(strict, jnp.einsum('nbhid,nbhjd->nbhij', k_beta, kc) * decay, 0.0)
    a_mat = lower + jnp.eye(c, dtype=jnp.float32)
    rhs = jnp.concatenate([vc * bc[..., None], k_beta * jnp.exp(g_cum)[..., None]], axis=-1)
    sol = lax.linalg.triangular_solve(a_mat.reshape(-1, c, c), rhs.reshape(-1, c, dv + dk),
                                      left_side=True, lower=True, unit_diagonal=True).reshape(rhs.shape)
    u, w = sol[..., :dv], sol[..., dv:]
    attn = jnp.where(causal, jnp.einsum('nbhid,nbhjd->nbhij', qc, kc) * decay, 0.0)
    q_g = qc * jnp.exp(g_cum)[..., None]
    k_tail = kc * jnp.exp(g_cum[..., -1:] - g_cum)[..., None]
    state_dec = jnp.exp(g_cum[..., -1])[..., None, None]

    def step(state, inp):
        u_i, w_i, q_i, k_i, a_i, d_i = inp
        v_new = u_i - jnp.einsum('bhid,bhde->bhie', w_i, state)
        o = jnp.einsum('bhid,bhde->bhie', q_i, state) + jnp.einsum('bhij,bhje->bhie', a_i, v_new)
        state = state * d_i + jnp.einsum('bhjd,bhje->bhde', k_i, v_new)
        return state, o

    state0 = jnp.zeros((b, h, dk, dv), jnp.float32)
    _, o = lax.scan(step, state0, (u, w, q_g, k_tail, attn, state_dec))
    return from_chunks(o)


def sliding_window_attention_sinks(q, k, v, sinks):
    b, s, qh, hd = q.shape
    kvh = k.shape[2]
    grp = qh // kvh
    w = WINDOW
    nb = s // w
    qb = q.reshape(b, nb, w, kvh, grp, hd).transpose(1, 0, 2, 3, 4, 5)

    def with_prev(t):
        tb = t.reshape(b, nb, w, kvh, hd)
        prev = jnp.concatenate([jnp.zeros_like(tb[:, :1]), tb[:, :-1]], axis=1)
        return jnp.concatenate([prev, tb], axis=2).transpose(1, 0, 2, 3, 4)

    kb, vb = with_prev(k), with_prev(v)
    qpos = jnp.arange(w)[:, None] + w
    kpos = jnp.arange(2 * w)[None, :]
    rel = qpos - kpos
    band = (rel >= 0) & (rel < w)
    first = (jnp.arange(nb) == 0)[:, None, None]
    valid = band[None] & ~(first & (kpos[None] < w))
    sink = sinks.astype(jnp.float32).reshape(kvh, grp)[None, :, :, None, None]
    scale = hd ** -0.5

    def block(args):
        q_i, k_i, v_i, m_i = args
        sc = jnp.einsum('bqkgd,bskd->bkgqs', q_i, k_i) * scale
        sc = jnp.where(m_i, sc, -jnp.inf)
        mx = jnp.maximum(jnp.max(sc, axis=-1, keepdims=True), sink)
        p = jnp.exp(sc - mx)
        denom = jnp.sum(p, axis=-1, keepdims=True) + jnp.exp(sink - mx)
        return jnp.einsum('bkgqs,bskd->bqkgd', p / denom, v_i)

    o = lax.map(block, (qb, kb, vb, valid))
    return o.transpose(1, 0, 2, 3, 4, 5).reshape(b, s, qh, hd)


def even_layer_mixer(h, w_in, ret_norm, gdn_conv, gdn_a_log, gdn_dt_bias, gdn_norm, w_out):
    b, s, _ = h.shape
    pos = jnp.arange(s)
    rq, rk, rv, rg, gqkv, gz, gb, ga = split_cols(h @ w_in, EVEN_SPLITS)
    rq = rope(rq.reshape(b, s, RET_HEADS, RET_DK), pos)
    rk = rope(rk.reshape(b, s, RET_HEADS, RET_DK), pos) * RET_DK ** -0.5
    rv = rv.reshape(b, s, RET_HEADS, RET_DV).astype(jnp.float32)
    o_ret = retention_chunkwise(rq, rk, rv)
    o_ret = rmsnorm(o_ret, ret_norm) * jax.nn.silu(rg.reshape(b, s, RET_HEADS, RET_DV).astype(jnp.float32))
    qkv = jax.nn.silu(causal_depthwise_conv(gqkv.astype(jnp.float32), gdn_conv.astype(jnp.float32)))
    gq, gk, gv = split_cols(qkv, (GDN_HEADS * GDN_DK, GDN_HEADS * GDN_DK, GDN_HEADS * GDN_DV))
    gq = l2norm(gq.reshape(b, s, GDN_HEADS, GDN_DK)) * GDN_DK ** -0.5
    gk = l2norm(gk.reshape(b, s, GDN_HEADS, GDN_DK))
    gv = gv.reshape(b, s, GDN_HEADS, GDN_DV)
    beta = jax.nn.sigmoid(gb.astype(jnp.float32))
    g = -jnp.exp(gdn_a_log.astype(jnp.float32)) * jax.nn.softplus(ga.astype(jnp.float32) + gdn_dt_bias.astype(jnp.float32))
    o_gdn = gated_delta_rule_chunked(gq, gk, gv, g, beta)
    o_gdn = rmsnorm(o_gdn, gdn_norm) * jax.nn.silu(gz.reshape(b, s, GDN_HEADS, GDN_DV).astype(jnp.float32))
    mixed = jnp.concatenate([o_ret.reshape(b, s, -1), o_gdn.reshape(b, s, -1)], axis=-1).astype(h.dtype)
    return mixed @ w_out


def odd_layer_mixer(h, w_in, q_norm, k_norm, sinks, w_out):
    b, s, _ = h.shape
    pos = jnp.arange(s)
    q, k, v = split_cols(h @ w_in, ODD_SPLITS)
    q = rope(rmsnorm(q.reshape(b, s, SWA_Q_HEADS, SWA_HEAD_DIM), q_norm), pos)
    k = rope(rmsnorm(k.reshape(b, s, SWA_KV_HEADS, SWA_HEAD_DIM), k_norm), pos)
    v = v.reshape(b, s, SWA_KV_HEADS, SWA_HEAD_DIM).astype(jnp.float32)
    o = sliding_window_attention_sinks(q, k, v, sinks)
    return o.reshape(b, s, -1).astype(h.dtype) @ w_out


def hierarchical_moe(h, w_router_group, w_router_expert, w_gate, w_up, w_down):
    b, s, d = h.shape
    n_tok = b * s
    xt = h.reshape(n_tok, d)
    rows = jnp.arange(n_tok)
    group_logits = (xt @ w_router_group).astype(jnp.float32)
    g_idx = jnp.argmax(group_logits, axis=-1)
    g_p = jax.nn.softmax(group_logits, axis=-1)[rows, g_idx]
    exp_logits = (xt @ w_router_expert).astype(jnp.float32).reshape(n_tok, N_GROUPS, EXPERTS_PER_GROUP)
    in_group = exp_logits[rows, g_idx]
    top_p, top_i = lax.top_k(jax.nn.softmax(in_group, axis=-1), TOP_K)
    gates = g_p[:, None] * top_p / jnp.sum(top_p, axis=-1, keepdims=True)
    n_assign = n_tok * TOP_K
    expert_id = (g_idx[:, None] * EXPERTS_PER_GROUP + top_i).reshape(-1).astype(jnp.int32)
    token_id = jnp.arange(n_assign, dtype=jnp.int32) // TOP_K
    gate_flat = gates.reshape(-1)
    order = jnp.argsort(expert_id)
    e_sorted, tok_sorted, gate_sorted = expert_id[order], token_id[order], gate_flat[order]
    counts = jax.ops.segment_sum(jnp.ones_like(expert_id), expert_id, num_segments=N_EXPERTS)
    start = jnp.cumsum(counts) - counts
    padded = (counts + MOE_BLOCK - 1) // MOE_BLOCK * MOE_BLOCK
    pstart = jnp.cumsum(padded) - padded
    dest = pstart[e_sorted] + (jnp.arange(n_assign, dtype=jnp.int32) - start[e_sorted])
    n_pad = (n_assign + N_EXPERTS * (MOE_BLOCK - 1) + MOE_BLOCK - 1) // MOE_BLOCK * MOE_BLOCK
    n_blk = n_pad // MOE_BLOCK
    tok_pad = jnp.zeros((n_pad,), jnp.int32).at[dest].set(tok_sorted)
    gate_pad = jnp.zeros((n_pad,), jnp.float32).at[dest].set(gate_sorted)
    block_start = jnp.arange(n_blk, dtype=jnp.int32) * MOE_BLOCK
    pend = pstart + padded
    block_expert = jnp.minimum(jnp.sum(pend[None, :] <= block_start[:, None], axis=1), N_EXPERTS - 1)

    def expert_block(args):
        tok_b, e, gate_b = args
        xb = xt[tok_b]
        hid = jax.nn.silu(xb @ w_gate[e]) * (xb @ w_up[e])
        return (hid @ w_down[e]) * gate_b[:, None].astype(xb.dtype)

    yb = lax.map(expert_block, (tok_pad.reshape(n_blk, MOE_BLOCK), block_expert,
                                gate_pad.reshape(n_blk, MOE_BLOCK)))
    y = jnp.zeros_like(xt).at[tok_pad].add(yb.reshape(n_pad, d).astype(xt.dtype))
    return y.reshape(b, s, d)


def setup_inputs(seed: int = 0) -> dict:
    key = jax.random.key(seed)
    ks = jax.random.split(key, 24)
    f32 = jnp.float32
    n_even = (DEPTH + 1) // 2
    n_odd = DEPTH // 2

    def normal(k, shape, scale):
        return jax.random.normal(k, shape, f32) * scale

    def gain(k, shape):
        return 1.0 + 0.02 * jax.random.normal(k, shape, f32)

    dt = jnp.exp(jax.random.uniform(ks[7], (n_even, GDN_HEADS), f32, math.log(1e-3), math.log(1e-1)))
    return {
        "x": normal(ks[0], (BATCH, SEQ, D_MODEL), 1.0),
        "norm_mix": gain(ks[1], (DEPTH, D_MODEL)),
        "norm_ffn": gain(ks[2], (DEPTH, D_MODEL)),
        "even_w_in": normal(ks[3], (n_even, D_MODEL, EVEN_IN_DIM), D_MODEL ** -0.5),
        "ret_norm": gain(ks[4], (n_even, RET_DV)),
        "gdn_conv": normal(ks[5], (n_even, CONV_WIDTH, GDN_CONV_CH), CONV_WIDTH ** -0.5),
        "gdn_a_log": jnp.log(jax.random.uniform(ks[6], (n_even, GDN_HEADS), f32, 1.0, 16.0)),
        "gdn_dt_bias": dt + jnp.log(-jnp.expm1(-dt)),
        "gdn_norm": gain(ks[8], (n_even, GDN_DV)),
        "even_w_out": normal(ks[9], (n_even, EVEN_MIX_DIM, D_MODEL), EVEN_MIX_DIM ** -0.5),
        "odd_w_in": normal(ks[10], (n_odd, D_MODEL, ODD_IN_DIM), D_MODEL ** -0.5),
        "q_norm": gain(ks[11], (n_odd, SWA_HEAD_DIM)),
        "k_norm": gain(ks[12], (n_odd, SWA_HEAD_DIM)),
        "attn_sinks": normal(ks[13], (n_odd, SWA_Q_HEADS), 1.0),
        "odd_w_out": normal(ks[14], (n_odd, ODD_MIX_DIM, D_MODEL), ODD_MIX_DIM ** -0.5),
        "router_group": normal(ks[15], (DEPTH, D_MODEL, N_GROUPS), D_MODEL ** -0.5),
        "router_expert": normal(ks[16], (DEPTH, D_MODEL, N_EXPERTS), D_MODEL ** -0.5),
        "expert_w_gate": normal(ks[17], (DEPTH, N_EXPERTS, D_MODEL, D_FF_EXPERT), D_MODEL ** -0.5),
        "expert_w_up": normal(ks[18], (DEPTH, N_EXPERTS, D_MODEL, D_FF_EXPERT), D_MODEL ** -0.5),
        "expert_w_down": normal(ks[19], (DEPTH, N_EXPERTS, D_FF_EXPERT, D_MODEL), D_FF_EXPERT ** -0.5),
    }


def reference(x, norm_mix, norm_ffn, even_w_in, ret_norm, gdn_conv, gdn_a_log, gdn_dt_bias,
              gdn_norm, even_w_out, odd_w_in, q_norm, k_norm, attn_sinks, odd_w_out,
              router_group, router_expert, expert_w_gate, expert_w_up, expert_w_down):
    for i in range(DEPTH):
        j = i // 2
        h = rmsnorm(x, norm_mix[i])
        if i % 2 == 0:
            x = x + even_layer_mixer(h, even_w_in[j], ret_norm[j], gdn_conv[j], gdn_a_log[j],
                                     gdn_dt_bias[j], gdn_norm[j], even_w_out[j])
        else:
            x = x + odd_layer_mixer(h, odd_w_in[j], q_norm[j], k_norm[j], attn_sinks[j], odd_w_out[j])
        h = rmsnorm(x, norm_ffn[i])
        x = x + hierarchical_moe(h, router_group[i], router_expert[i], expert_w_gate[i],
                                 expert_w_up[i], expert_w_down[i])
    return x
```

```cpp
#include <hip/hip_runtime.h>
#include <cstdio>
#include <cstdint>

#ifndef MK_MULTI
#define MK_MULTI 0
#endif

#define LAS __attribute__((address_space(3)))
typedef unsigned short bf16_t;
typedef short bf16x8 __attribute__((ext_vector_type(8)));
typedef float f32x4 __attribute__((ext_vector_type(4)));
typedef float f32x2 __attribute__((ext_vector_type(2)));
typedef unsigned u32x4 __attribute__((ext_vector_type(4)));
typedef unsigned u32x2 __attribute__((ext_vector_type(2)));
#define DI __device__ __forceinline__

constexpr int D = 2048, BATCH = 2, SEQ = 16384, NTOK = BATCH * SEQ;
constexpr int EVEN_IN = 12304, PJW = 12288;
constexpr int ODD_IN = 2560;
constexpr int NEXP = 32, FF = 768, TOPK = 2, MAXT = 288;
constexpr float EPS = 1e-6f;
constexpr double ROPE_R = 0.86596432336006535;
constexpr int C_RQ = 0, C_RK = 1024, C_RV = 2048, C_GQKV = 4096, C_RG = 8192, C_GZ = 10240;

constexpr size_t MiB = 1u << 20;
constexpr size_t WS_CTL = 0, CTL_ZERO_BYTES = 1 * MiB;
constexpr size_t WS_WIN0 = 2 * MiB;
constexpr size_t WS_WOUT0 = WS_WIN0 + 48 * MiB;
constexpr size_t WS_WIN1 = WS_WOUT0 + 16 * MiB;
constexpr size_t WS_WOUT1 = WS_WIN1 + 10 * MiB;
constexpr size_t WS_H = 84 * MiB;
constexpr size_t WS_BIG = 212 * MiB;
constexpr size_t WS_AUX = 980 * MiB;
constexpr size_t WS_END = 1492 * MiB;
constexpr size_t BIG_PJ = 0;
constexpr size_t BIG_EGU = 0;
constexpr size_t BIG_EDN = 192 * MiB;
constexpr size_t BIG_HID = 288 * MiB;
constexpr size_t BIG_Y = 400 * MiB;
constexpr size_t BIG_QKV1 = 0;
constexpr size_t AUX_QN = WS_AUX + 0;
constexpr size_t AUX_KN = WS_AUX + 64 * MiB;
constexpr size_t AUX_VC = WS_AUX + 128 * MiB;
constexpr size_t AUX_W = WS_AUX + 256 * MiB;
constexpr size_t AUX_ATT = WS_AUX + 320 * MiB;
constexpr size_t AUX_RST = WS_AUX + 352 * MiB;
constexpr size_t AUX_BG = WS_AUX + 480 * MiB;
constexpr size_t AUX_CS = WS_AUX + 482 * MiB;
constexpr size_t AUX_SW = WS_AUX + 490 * MiB;
constexpr size_t AUX_LIST = WS_AUX + 491 * MiB;
constexpr size_t AUX_GW = WS_AUX + 499 * MiB;
constexpr size_t AUX_ASG = WS_AUX + 507 * MiB;
static_assert(AUX_ASG + MiB <= WS_END, "aux map");
constexpr int CW_BAR = 4096;
constexpr int CW_CNT0 = 16384, CW_CNT1 = 16384 + 64;

constexpr int RING_BYTES = 131072;
constexpr int MISC_OFF = RING_BYTES;
constexpr int TBL_OFF = RING_BYTES + 256;
constexpr int TOK_OFF = RING_BYTES + 1024;
constexpr int LDS_BYTES = 147456;
static_assert(TOK_OFF + 12 * 1024 <= LDS_BYTES, "lds map");
DI float rdlane(float v, int l) { return __builtin_bit_cast(float, __builtin_amdgcn_readlane(__builtin_bit_cast(int, v), l)); }

DI unsigned f2bf(float f) { unsigned u = __builtin_bit_cast(unsigned, f); return (u + 0x7fffu + ((u >> 16) & 1u)) >> 16; }
DI unsigned pk2(float lo, float hi) { return f2bf(lo) | (f2bf(hi) << 16); }
DI float bflo(unsigned w) { return __builtin_bit_cast(float, w << 16); }
DI float bfhi(unsigned w) { return __builtin_bit_cast(float, w & 0xffff0000u); }
DI float bf2f(bf16_t b) { return __builtin_bit_cast(float, ((unsigned)b) << 16); }
DI unsigned cvt_pk_bf16(float lo, float hi) { unsigned r; asm volatile("v_cvt_pk_bf16_f32 %0, %1, %2" : "=v"(r) : "v"(lo), "v"(hi)); return r; }
DI float wave_sum(float v) {
#pragma unroll
    for (int o = 1; o < 64; o <<= 1) v += __shfl_xor(v, o);
    return v;
}
DI float siluf(float x) { return x / (1.0f + __expf(-x)); }
#define LDS_WAIT() asm volatile("s_waitcnt lgkmcnt(0)" ::: "memory")
#define VM_WAIT() asm volatile("s_waitcnt vmcnt(0)" ::: "memory")

#define XB_TMO      128
#define XB_XCNT(j)  (256  + 64 * (j))
#define XB_XSUB(j)  (1280 + 64 * (j))
#define XB_XGEN(j)  (2304 + 64 * (j))
#define XB_TOP      3328
#define XB_TOPGEN   3392
#define XCD_BAR_WORDS 3456
#define XB_SPIN_CAP (1u << 22)
DI unsigned xb_ld(unsigned* p)              { return __hip_atomic_load(p, __ATOMIC_RELAXED, __HIP_MEMORY_SCOPE_AGENT); }
DI unsigned xb_add(unsigned* p, unsigned v) { return __hip_atomic_fetch_add(p, v, __ATOMIC_RELAXED, __HIP_MEMORY_SCOPE_AGENT); }
DI unsigned xb_xcc_id() { return (unsigned)__builtin_amdgcn_s_getreg((3 << 11) | 20) & 0xFu; }
#define XB_SPIN(cond, bar) do { unsigned _sp = 0; while (cond) { __builtin_amdgcn_s_sleep(1); \
    if ((++_sp & 255u) == 0u) { if (xb_ld(&(bar)[XB_TMO])) break; if (_sp > XB_SPIN_CAP) { atomicAdd(&(bar)[XB_TMO], 1u); break; } } } } while (0)
struct XcdBarrier { unsigned* bar; unsigned x; volatile LAS unsigned* st; };
DI XcdBarrier xcd_barrier_post(unsigned* bar, volatile LAS unsigned* st) {
    XcdBarrier b; b.bar = bar; b.x = xb_xcc_id(); b.st = st;
    if (threadIdx.x == 0) (void)xb_add(&bar[XB_XCNT(b.x)], 1u);
    return b;
}
DI void xcd_barrier_complete(unsigned* bar, unsigned x, unsigned& nloc, unsigned& nx) {
    const unsigned G = gridDim.x * gridDim.y * gridDim.z;
    unsigned sum, cnt, mine, sp = 0u;
    for (;;) {
        sum = 0u; cnt = 0u; mine = 0u;
#pragma unroll
        for (unsigned j = 0; j < 16; ++j) { const unsigned c = xb_ld(&bar[XB_XCNT(j)]); sum += c; cnt += (c > 0u) ? 1u : 0u; mine = (j == x) ? c : mine; }
        if (sum == G) break;
        __builtin_amdgcn_s_sleep(1);
        if ((++sp & 255u) == 0u) { if (xb_ld(&bar[XB_TMO])) break; if (sp > XB_SPIN_CAP) { atomicAdd(&bar[XB_TMO], 1u); break; } }
    }
    nloc = mine > 0u ? mine : 1u; nx = cnt > 0u ? cnt : 1u;
}
DI void xcd_barrier(const XcdBarrier& b) {
    asm volatile("s_waitcnt vmcnt(0)" ::: "memory");
    __syncthreads();
    if (threadIdx.x == 0) {
        unsigned* bar = b.bar;
        __builtin_amdgcn_s_waitcnt(0);
        unsigned nloc = b.st[0], nx = b.st[1];
        if (nloc == 0u) { xcd_barrier_complete(bar, b.x, nloc, nx); b.st[0] = nloc; b.st[1] = nx; }
        const unsigned old = xb_add(&bar[XB_XSUB(b.x)], 1u);
        const unsigned gen = old / nloc;
        if (old + 1u == (gen + 1u) * nloc) {
            __builtin_amdgcn_fence(__ATOMIC_RELEASE, "agent");
            asm volatile("s_waitcnt vmcnt(0)" ::: "memory");
            const unsigned og = xb_add(&bar[XB_TOP], 1u);
            const unsigned tg = og / nx;
            if (og + 1u == (tg + 1u) * nx) xb_add(&bar[XB_TOPGEN], 1u);
            else XB_SPIN(xb_ld(&bar[XB_TOPGEN]) == tg, bar);
            __builtin_amdgcn_fence(__ATOMIC_ACQUIRE, "agent");
            xb_add(&bar[XB_XGEN(b.x)], 1u);
            asm volatile("s_waitcnt vmcnt(0)" ::: "memory");
        } else {
            XB_SPIN(xb_ld(&bar[XB_XGEN(b.x)]) == gen, bar);
            __builtin_amdgcn_fence(__ATOMIC_ACQUIRE, "agent");
            asm volatile("s_waitcnt vmcnt(0)" ::: "memory");
        }
    }
    __syncthreads();
}

namespace pg8 {
constexpr int BM = 256, BK = 64, HALF = 128, HTB = HALF * BK * 2, STAGE_BYTES = 8 * HTB, NXCD = 8, WGM = 8;
__host__ __device__ __forceinline__ int lds_byte(int r, int c) { const int st = (r >> 4) * 2 + (c >> 5), rr = r & 15, cc = c & 31, ob = rr * 64 + cc * 2; return st * 1024 + (ob ^ (((ob >> 9) & 1) << 5)); }
__host__ __device__ __forceinline__ void stage_rc(int b, int& R, int& C) { const int st = b / 1024, sb = b % 1024, swz = sb ^ (((sb >> 9) & 1) << 5); R = (st >> 1) * 16 + swz / 64; C = (st & 1) * 32 + (swz % 64) / 2; }
__host__ __device__ __forceinline__ int perm32(int rho) { const int n = rho >> 4, i = rho & 15; return 8 * (i >> 2) + 4 * n + (i & 3); }

struct Unit { int pm, pn, e, slot; };

DI int xcd_remap(int L, int nwg) { const int q = nwg / NXCD, r = nwg % NXCD, xcd = L % NXCD, off = L / NXCD; return (xcd < r ? xcd * (q + 1) : r * (q + 1) + (xcd - r) * q) + off; }

struct DenseOrder {
    int nM, nN, nwg, G, c; unsigned lda2; const char* Bt; size_t tstepB;
    DI void init(int M, int N, int K, int lda, const bf16_t* Bt_, int G_, int c_) { nM = M / BM; nN = N / BM; nwg = nM * nN; G = G_; c = c_; lda2 = (unsigned)lda * 2u; Bt = (const char*)Bt_; tstepB = (size_t)BM * K * 2; }
    DI bool next(int i, Unit& u) const {
        const long L = (long)i * G + c; if (L >= nwg) return false;
        const int wgid = xcd_remap((int)L, nwg);
        const int nig = WGM * nN, gid = wgid / nig, fm = gid * WGM, gsz = (nM - fm) < WGM ? (nM - fm) : WGM;
        u.pm = fm + ((wgid % nig) % gsz); u.pn = (wgid % nig) / gsz; u.e = 0; u.slot = i; return true;
    }
    DI unsigned a_off(const Unit& u, int h, int R) const { return (unsigned)(u.pm * BM + h * HALF + R) * lda2; }
    DI const char* b_base(const Unit& u) const { return Bt + (size_t)u.pn * tstepB; }
};
template <bool GATHER> struct MoeOrder {
    const LAS int* tb; const LAS unsigned* tokoff; int NT, nwg, G, c; unsigned lda2; const char* Bt; size_t estepB, tstepB;
    DI void init(const LAS int* tb_, const LAS unsigned* tokoff_, int NT_, int K, int lda, const bf16_t* Bt_, size_t estep_elems, int G_, int c_) {
        tb = tb_; tokoff = tokoff_; NT = NT_; nwg = tb_[32] * NT_; G = G_; c = c_; lda2 = (unsigned)lda * 2u; Bt = (const char*)Bt_; estepB = estep_elems * 2; tstepB = (size_t)BM * K * 2; }
    DI bool next(int i, Unit& u) const {
        const long L = (long)i * G + c; if (L >= nwg) return false;
        const int w = xcd_remap((int)L, nwg);
        int e = 0;
#pragma unroll 1
        for (int s = 16; s >= 1; s >>= 1) if (tb[e + s] * NT <= w) e += s;
        const int nt = tb[e + 1] - tb[e], local = w - tb[e] * NT;
        u.e = e; u.pn = local / nt; u.pm = tb[e] + local % nt; u.slot = i; return true;
    }
    DI unsigned a_off(const Unit& u, int h, int R) const { if (GATHER) return tokoff[u.slot * 256 + h * HALF + R]; return (unsigned)(u.pm * BM + h * HALF + R) * lda2; }
    DI const char* b_base(const Unit& u) const { return Bt + (size_t)u.e * estepB + (size_t)u.pn * tstepB; }
};

struct EpiBf16 {
    static constexpr bool PERM = true;
    bf16_t* O; int ldc;
    DI void operator()(const f32x4 (&acc)[2][2][4][2], const Unit& u, int wr, int wc, int fr, int fq) const {
        const int row0 = u.pm * BM + wr * 64 + fr, col0 = u.pn * BM + wc * 32 + 8 * fq;
#pragma unroll
        for (int ai = 0; ai < 2; ++ai)
#pragma unroll
            for (int m = 0; m < 4; ++m) { bf16_t* rowp = O + (size_t)(row0 + ai * HALF + m * 16) * ldc + col0;
#pragma unroll
                for (int bj = 0; bj < 2; ++bj) { const f32x4 v0 = acc[ai][bj][m][0], v1 = acc[ai][bj][m][1];
                    u32x4 w; w.x = cvt_pk_bf16(v0[0], v0[1]); w.y = cvt_pk_bf16(v0[2], v0[3]); w.z = cvt_pk_bf16(v1[0], v1[1]); w.w = cvt_pk_bf16(v1[2], v1[3]);
                    *(u32x4*)(rowp + bj * HALF) = w; } }
    }
};
struct EpiResF32 {
    static constexpr bool PERM = false;
    const float* base; float* out; int ldc;
    DI void operator()(const f32x4 (&acc)[2][2][4][2], const Unit& u, int wr, int wc, int fr, int fq) const {
        const int row0 = u.pm * BM + wr * 64 + fr, col0 = u.pn * BM + wc * 32 + 4 * fq;
#pragma unroll
        for (int ai = 0; ai < 2; ++ai)
#pragma unroll
            for (int m = 0; m < 4; ++m) { const size_t off = (size_t)(row0 + ai * HALF + m * 16) * ldc + col0;
#pragma unroll
                for (int bj = 0; bj < 2; ++bj)
#pragma unroll
                    for (int n = 0; n < 2; ++n) { const f32x4 bs = *(const f32x4*)(base + off + bj * HALF + n * 16); *(f32x4*)(out + off + bj * HALF + n * 16) = bs + acc[ai][bj][m][n]; }
                asm volatile("" ::: "memory"); }
    }
};
struct EpiSwiglu {
    static constexpr bool PERM = true;
    bf16_t* O;
    DI void operator()(const f32x4 (&acc)[2][2][4][2], const Unit& u, int wr, int wc, int fr, int fq) const {
        const int row0 = u.pm * BM + wr * 64 + fr, col0 = u.pn * HALF + wc * 32 + 8 * fq;
#pragma unroll
        for (int ai = 0; ai < 2; ++ai)
#pragma unroll
            for (int m = 0; m < 4; ++m) { bf16_t* rowp = O + (size_t)(row0 + ai * HALF + m * 16) * FF + col0;
                float h[8];
#pragma unroll
                for (int n = 0; n < 2; ++n)
#pragma unroll
                    for (int j = 0; j < 4; ++j) { const float g = acc[ai][0][m][n][j], up = acc[ai][1][m][n][j]; h[n * 4 + j] = g / (1.0f + __expf(-g)) * up; }
                u32x4 w; w.x = cvt_pk_bf16(h[0], h[1]); w.y = cvt_pk_bf16(h[2], h[3]); w.z = cvt_pk_bf16(h[4], h[5]); w.w = cvt_pk_bf16(h[6], h[7]);
                *(u32x4*)rowp = w; }
    }
};
struct EpiDown {
    static constexpr bool PERM = true;
    bf16_t* O; const float* gw; const LAS int* tb;
    DI void operator()(const f32x4 (&acc)[2][2][4][2], const Unit& u, int wr, int wc, int fr, int fq) const {
        const int row0 = u.pm * BM + wr * 64 + fr, col0 = u.pn * BM + wc * 32 + 8 * fq;
        const int lrow0 = (u.pm - tb[u.e]) * BM + wr * 64 + fr;
        const float* gwe = gw + (size_t)u.e * 65536;
#pragma unroll
        for (int ai = 0; ai < 2; ++ai)
#pragma unroll
            for (int m = 0; m < 4; ++m) { bf16_t* rowp = O + (size_t)(row0 + ai * HALF + m * 16) * D + col0; const float g = gwe[lrow0 + ai * HALF + m * 16];
#pragma unroll
                for (int bj = 0; bj < 2; ++bj) { const f32x4 v0 = acc[ai][bj][m][0] * g, v1 = acc[ai][bj][m][1] * g;
                    u32x4 w; w.x = cvt_pk_bf16(v0[0], v0[1]); w.y = cvt_pk_bf16(v0[2], v0[3]); w.z = cvt_pk_bf16(v1[0], v1[1]); w.w = cvt_pk_bf16(v1[2], v1[3]);
                    *(u32x4*)(rowp + bj * HALF) = w; } }
    }
};

template <class Epi, class Sched>
DI void gemm_phase(LAS unsigned char* lds, const bf16_t* Aptr, int K, const Sched& S, const Epi& E) {
    const int tid = threadIdx.x, wid = __builtin_amdgcn_readfirstlane(tid >> 6), lane = tid & 63, wr = wid >> 2, wc = wid & 3, fr = lane & 15, fq = lane >> 4;
    const int nt = K / BK;
    const char* Ab = (const char*)Aptr;
    int Rr[2], Cc[2]; unsigned voffB[2];
#pragma unroll
    for (int i = 0; i < 2; ++i) { int R, C; stage_rc(tid * 16 + i * 8192, R, C); const int Rb = Epi::PERM ? ((R & ~31) + perm32(R & 31)) : R; Rr[i] = R; Cc[i] = C * 2; voffB[i] = (unsigned)(Rb * K + C) * 2u; }
    const unsigned kstep = (unsigned)(BK * 2);
    const size_t hstepB = (size_t)HALF * K * 2;
    const unsigned ldsw = (unsigned)wid * 1024u;
    const int aoff = lds_byte(wr * 64 + fr, fq * 8), boff = lds_byte(wc * 32 + fr, fq * 8);
#define PG8_SA(b, h) (((b) * 2 + (h)) * HTB)
#define PG8_SB(b, h) ((4 + (b) * 2 + (h)) * HTB)
#define PG8_STAGEB(bufoff, gbase) do { _Pragma("unroll") for (int _i = 0; _i < 2; ++_i) \
        __builtin_amdgcn_global_load_lds((const unsigned*)((const char*)(gbase) + voffB[_i]), (LAS unsigned*)(lds + (bufoff) + ldsw + _i * 8192), 16, 0, 0); } while (0)
#define PG8_STAGEA(bufoff, offs, kb) do { _Pragma("unroll") for (int _i = 0; _i < 2; ++_i) \
        __builtin_amdgcn_global_load_lds((const unsigned*)(Ab + (size_t)((offs)[_i] + (kb))), (LAS unsigned*)(lds + (bufoff) + ldsw + _i * 8192), 16, 0, 0); } while (0)
#define PG8_LDA(dst, b, h) do { _Pragma("unroll") for (int m = 0; m < 4; ++m) _Pragma("unroll") for (int k = 0; k < 2; ++k) dst[m][k] = *(const LAS bf16x8*)(lds + PG8_SA(b, h) + aoff + m * 2048 + k * 1024); } while (0)
#define PG8_LDB(dst, b, h) do { _Pragma("unroll") for (int n = 0; n < 2; ++n) _Pragma("unroll") for (int k = 0; k < 2; ++k) dst[n][k] = *(const LAS bf16x8*)(lds + PG8_SB(b, h) + boff + n * 2048 + k * 1024); } while (0)
#define PG8_MMA(ai, bj, At, Bt) do { __builtin_amdgcn_s_setprio(1); _Pragma("unroll") for (int m = 0; m < 4; ++m) _Pragma("unroll") for (int n = 0; n < 2; ++n) _Pragma("unroll") for (int k = 0; k < 2; ++k) \
        acc[ai][bj][m][n] = __builtin_amdgcn_mfma_f32_16x16x32_bf16(Bt[n][k], At[m][k], acc[ai][bj][m][n], 0, 0, 0); __builtin_amdgcn_s_setprio(0); } while (0)
#define PG8_WAIT_V(n) asm volatile("s_waitcnt vmcnt(" #n ")" ::: "memory")
#define PG8_WAIT_L(n) asm volatile("s_waitcnt lgkmcnt(" #n ")" ::: "memory")
#define PG8_BAR __builtin_amdgcn_s_barrier()
#define PG8_SCHED __builtin_amdgcn_sched_barrier(0)
    Unit cur, nxt; int ui = 0;
    if (!S.next(0, cur)) return;
    f32x4 acc[2][2][4][2];
#pragma unroll
    for (int a = 0; a < 2; ++a)
#pragma unroll
        for (int b = 0; b < 2; ++b)
#pragma unroll
            for (int m = 0; m < 4; ++m)
#pragma unroll
                for (int n = 0; n < 2; ++n) acc[a][b][m][n] = (f32x4){0.f, 0.f, 0.f, 0.f};
    bf16x8 At[4][2], B0[2][2], B1[2][2];
    unsigned ao[2][2], an[2][2];
#pragma unroll
    for (int h = 0; h < 2; ++h)
#pragma unroll
        for (int i = 0; i < 2; ++i) ao[h][i] = S.a_off(cur, h, Rr[i]) + (unsigned)Cc[i];
    const char* cB = S.b_base(cur);
    PG8_STAGEB(PG8_SB(0, 0), cB); PG8_STAGEB(PG8_SB(0, 1), cB + hstepB); PG8_STAGEA(PG8_SA(0, 0), ao[0], 0u); PG8_STAGEA(PG8_SA(0, 1), ao[1], 0u);
    if (wr == 1) PG8_BAR;
    PG8_WAIT_V(2); PG8_BAR;
    PG8_STAGEB(PG8_SB(1, 0), cB + kstep); PG8_STAGEA(PG8_SA(1, 0), ao[0], kstep); PG8_STAGEB(PG8_SB(1, 1), cB + hstepB + kstep);
    PG8_WAIT_V(6); PG8_BAR;
    for (;;) {
        const bool has_next = S.next(ui + 1, nxt);
        const char* nB = has_next ? S.b_base(nxt) : cB;
#pragma unroll
        for (int h = 0; h < 2; ++h)
#pragma unroll
            for (int i = 0; i < 2; ++i) an[h][i] = has_next ? (S.a_off(nxt, h, Rr[i]) + (unsigned)Cc[i]) : ao[h][i];
        for (int t = 0; t < nt; t += 2) {
            const bool last = (t == nt - 2);
            const unsigned kb1 = (unsigned)(t + 1) * kstep, kb2 = (unsigned)(t + 2) * kstep;
            unsigned x2[2][2];
#pragma unroll
            for (int h = 0; h < 2; ++h)
#pragma unroll
                for (int i = 0; i < 2; ++i) x2[h][i] = last ? an[h][i] : ao[h][i] + kb2;
            const char* b2 = last ? nB : cB + kb2; const char* b3 = b2 + kstep;
            PG8_LDB(B0, 0, 0); PG8_LDB(B1, 0, 1); PG8_SCHED; PG8_LDA(At, 0, 0); PG8_STAGEA(PG8_SA(1, 1), ao[1], kb1);
            PG8_WAIT_V(8); PG8_WAIT_L(0); PG8_BAR; PG8_MMA(0, 0, At, B0); PG8_MMA(0, 1, At, B1); PG8_BAR; PG8_SCHED;
            PG8_LDA(At, 0, 1); PG8_STAGEB(PG8_SB(0, 0), b2); PG8_STAGEB(PG8_SB(0, 1), b2 + hstepB); PG8_STAGEA(PG8_SA(0, 0), x2[0], 0u);
            PG8_WAIT_V(8); PG8_WAIT_L(0); PG8_BAR; PG8_MMA(1, 0, At, B0); PG8_MMA(1, 1, At, B1); PG8_BAR; PG8_SCHED;
            PG8_LDB(B0, 1, 0); PG8_LDB(B1, 1, 1); PG8_SCHED; PG8_LDA(At, 1, 0); PG8_STAGEA(PG8_SA(0, 1), x2[1], 0u);
            PG8_WAIT_V(8); PG8_WAIT_L(0); PG8_BAR; PG8_MMA(0, 0, At, B0); PG8_MMA(0, 1, At, B1); PG8_BAR; PG8_SCHED;
            PG8_LDA(At, 1, 1); PG8_STAGEB(PG8_SB(1, 0), b3); PG8_STAGEB(PG8_SB(1, 1), b3 + hstepB); PG8_STAGEA(PG8_SA(1, 0), x2[0], kstep);
            PG8_WAIT_V(8); PG8_WAIT_L(0); PG8_BAR; PG8_MMA(1, 0, At, B0); PG8_MMA(1, 1, At, B1); PG8_BAR; PG8_SCHED;
        }
        if (wr == 0) PG8_BAR;
        E(acc, cur, wr, wc, fr, fq);
        if (!has_next) break;
#pragma unroll
        for (int a = 0; a < 2; ++a)
#pragma unroll
            for (int b = 0; b < 2; ++b)
#pragma unroll
                for (int m = 0; m < 4; ++m)
#pragma unroll
                    for (int n = 0; n < 2; ++n) acc[a][b][m][n] = (f32x4){0.f, 0.f, 0.f, 0.f};
        cur = nxt; cB = nB; ++ui;
#pragma unroll
        for (int h = 0; h < 2; ++h)
#pragma unroll
            for (int i = 0; i < 2; ++i) ao[h][i] = an[h][i];
        if (wr == 1) PG8_BAR;
    }
    PG8_WAIT_V(0);
    PG8_BAR;
#undef PG8_SA
#undef PG8_SB
#undef PG8_STAGEA
#undef PG8_STAGEB
#undef PG8_LDA
#undef PG8_LDB
#undef PG8_MMA
#undef PG8_WAIT_V
#undef PG8_WAIT_L
#undef PG8_BAR
#undef PG8_SCHED
}
}

constexpr int NWAVES = 8, NTHR = 512;
struct Frame {
    LAS unsigned char* lds;
    int tid, lane, wave, G, gw, NGW;
    unsigned* ctl;
    unsigned char* ws;
};

DI void transpose_item(const float* Wseg, int ldw, int ncols, int K, bf16_t* WT, int row_off, LAS float* scr, int item, int lane) {
    const int nblk = ncols / 32, kb = item / nblk, nb = item % nblk, k0 = 64 * kb, n0 = 32 * nb;
#pragma unroll 8
    for (int i = 0; i < 32; ++i) { const int kk = 2 * i + (lane >> 5); scr[kk * 33 + (lane & 31)] = Wseg[(size_t)(k0 + kk) * ldw + n0 + (lane & 31)]; }
    LDS_WAIT(); asm volatile("" ::: "memory");
    const int c = lane & 7;
#pragma unroll
    for (int j = 0; j < 4; ++j) { const int n = (lane >> 3) + 8 * j; const LAS float* s = scr + (8 * c) * 33 + n;
        u32x4 o; o.x = pk2(s[0 * 33], s[1 * 33]); o.y = pk2(s[2 * 33], s[3 * 33]); o.z = pk2(s[4 * 33], s[5 * 33]); o.w = pk2(s[6 * 33], s[7 * 33]);
        *(u32x4*)(WT + (size_t)(row_off + n0 + n) * K + k0 + 8 * c) = o; }
    LDS_WAIT(); asm volatile("" ::: "memory");
}

DI void p0_weights(Frame& F, const float* const* in) {
    LAS float* scr = (LAS float*)(F.lds + F.wave * 16384);
    bf16_t* win0 = (bf16_t*)(F.ws + WS_WIN0); bf16_t* wout0 = (bf16_t*)(F.ws + WS_WOUT0); bf16_t* win1 = (bf16_t*)(F.ws + WS_WIN1); bf16_t* wout1 = (bf16_t*)(F.ws + WS_WOUT1);
    const float* ewin = in[3]; const float* ewout = in[9]; const float* owin = in[10]; const float* owout = in[14];
    constexpr int KB = D / 64;
    constexpr int I_A = KB * (4096 / 32), I_B = KB * (4096 / 32), I_C = KB * (2048 / 32), I_D = KB * (2048 / 32);
    constexpr int I_O0 = (4096 / 64) * (D / 32), I_I1 = KB * (ODD_IN / 32), I_O1 = KB * (D / 32);
    constexpr int NIT = I_A + I_B + I_C + I_D + I_O0 + I_I1 + I_O1;
    for (int it = F.gw; it < NIT; it += F.NGW) {
        int r = it;
        if (r < I_A) { transpose_item(ewin + 0, EVEN_IN, 4096, D, win0, 0, scr, r, F.lane); continue; } r -= I_A;
        if (r < I_B) { transpose_item(ewin + 6144, EVEN_IN, 4096, D, win0, C_GQKV, scr, r, F.lane); continue; } r -= I_B;
        if (r < I_C) { transpose_item(ewin + 4096, EVEN_IN, 2048, D, win0, C_RG, scr, r, F.lane); continue; } r -= I_C;
        if (r < I_D) { transpose_item(ewin + 10240, EVEN_IN, 2048, D, win0, C_GZ, scr, r, F.lane); continue; } r -= I_D;
        if (r < I_O0) { transpose_item(ewout, D, D, 4096, wout0, 0, scr, r, F.lane); continue; } r -= I_O0;
        if (r < I_I1) { transpose_item(owin, ODD_IN, ODD_IN, D, win1, 0, scr, r, F.lane); continue; } r -= I_I1;
        transpose_item(owout, D, D, D, wout1, 0, scr, r, F.lane);
    }
    float* sw = (float*)(F.ws + AUX_SW);
    const int gt = (F.gw * 64 + F.lane), NGT = F.NGW * 64;
    for (int i = gt; i < 16 * D; i += NGT) { const int c = i / D, k = i % D; sw[i] = ewin[(size_t)k * EVEN_IN + 12288 + c]; }
    for (int l = 0; l < 2; ++l) { float* rt = sw + 16 * D + l * 36 * D; const float* rg = in[15] + (size_t)l * D * 4; const float* re = in[16] + (size_t)l * D * 32;
        for (int i = gt; i < 36 * D; i += NGT) { const int c = i / D, k = i % D; rt[i] = c < 4 ? rg[k * 4 + c] : re[k * 32 + (c - 4)]; } }
    f32x2* cs = (f32x2*)(F.ws + AUX_CS);
    for (int i = gt; i < SEQ * 64; i += NGT) { const int pos = i >> 6, fi = i & 63; double inv = 1.0;
        for (int q = 0; q < fi; ++q) inv *= ROPE_R;
        const double x = (double)pos * inv, k = __builtin_rint(x * 0.15915494309189535), r = (x - k * 6.283185307179586) - k * 2.4492935982947064e-16;
        const float rf = (float)r; cs[i] = (f32x2){cosf(rf), sinf(rf)}; }
}
DI void convert_experts(Frame& F, const float* const* in, int l) {
    LAS float* scr = (LAS float*)(F.lds + F.wave * 16384);
    const float* wg = in[17] + (size_t)l * NEXP * D * FF; const float* wu = in[18] + (size_t)l * NEXP * D * FF; const float* wd = in[19] + (size_t)l * NEXP * FF * D;
    bf16_t* gu = (bf16_t*)(F.ws + WS_BIG + BIG_EGU); bf16_t* dn = (bf16_t*)(F.ws + WS_BIG + BIG_EDN);
    constexpr int I_G = (D / 64) * (128 / 32);
    constexpr int I_GU = NEXP * 6 * 2 * I_G;
    constexpr int I_DE = (FF / 64) * (D / 32);
    constexpr int NIT = I_GU + NEXP * I_DE;
    for (int it = F.gw; it < NIT; it += F.NGW) {
        if (it < I_GU) { const int seg = it / I_G, r = it % I_G, e = seg / 12, s = seg % 12, pn = s >> 1, isup = s & 1;
            const float* src = (isup ? wu : wg) + (size_t)e * D * FF + pn * 128;
            transpose_item(src, FF, 128, D, gu + (size_t)e * 1536 * D, pn * 256 + isup * 128, scr, r, F.lane); }
        else { const int r2 = it - I_GU, e = r2 / I_DE, r = r2 % I_DE;
            transpose_item(wd + (size_t)e * FF * D, D, D, FF, dn + (size_t)e * D * FF, 0, scr, r, F.lane); }
    }
}

template <int NP, bool ADDY, bool WRITEX, bool WRITEH, class Handler>
DI void norm_pass(Frame& F, const float* src, float* dst, const bf16_t* y, const unsigned* asg, const LAS int* tb, const float* gain, const float* Wt, bf16_t* H, Handler hnd) {
    for (int m = F.gw; m < NTOK; m += F.NGW) {
        const f32x4* xr = (const f32x4*)(src + (size_t)m * D) + F.lane;
        f32x4 v[8];
#pragma unroll
        for (int j = 0; j < 8; ++j) v[j] = xr[64 * j];
        if (ADDY) {
            const unsigned a0 = asg[2 * m], a1 = asg[2 * m + 1];
            const size_t r0 = (size_t)tb[a0 >> 16] * 256 + (a0 & 0xffffu), r1 = (size_t)tb[a1 >> 16] * 256 + (a1 & 0xffffu);
            const u32x2* y0 = (const u32x2*)(y + r0 * D) + F.lane; const u32x2* y1 = (const u32x2*)(y + r1 * D) + F.lane;
#pragma unroll
            for (int j = 0; j < 8; ++j) { const u32x2 p = y0[64 * j], q = y1[64 * j];
                v[j].x += bflo(p.x) + bflo(q.x); v[j].y += bfhi(p.x) + bfhi(q.x); v[j].z += bflo(p.y) + bflo(q.y); v[j].w += bfhi(p.y) + bfhi(q.y); }
        }
        if (WRITEX) { f32x4* xo = (f32x4*)(dst + (size_t)m * D) + F.lane;
#pragma unroll
            for (int j = 0; j < 8; ++j) xo[64 * j] = v[j]; }
        if (WRITEH) {
            float s = 0.f;
#pragma unroll
            for (int j = 0; j < 8; ++j) s += (v[j].x * v[j].x + v[j].y * v[j].y) + (v[j].z * v[j].z + v[j].w * v[j].w);
            const float rstd = 1.0f / sqrtf(wave_sum(s) * (1.0f / D) + EPS);
            const f32x4* gr = (const f32x4*)gain + F.lane;
#pragma unroll
            for (int j = 0; j < 8; ++j) v[j] = v[j] * rstd * gr[64 * j];
            u32x2* ho = (u32x2*)(H + (size_t)m * D) + F.lane;
#pragma unroll
            for (int j = 0; j < 8; ++j) { u32x2 w; w.x = pk2(v[j].x, v[j].y); w.y = pk2(v[j].z, v[j].w); ho[64 * j] = w; }
            if constexpr (NP > 0) {
                float res = 0.f;
#pragma unroll 1
                for (int c0 = 0; c0 < NP; c0 += 4) {
                    float a[4];
#pragma unroll
                    for (int cc = 0; cc < 4; ++cc) { const f32x4* wr = (const f32x4*)(Wt + (size_t)(c0 + cc) * D) + F.lane; a[cc] = 0.f;
#pragma unroll
                        for (int j = 0; j < 8; ++j) { const f32x4 w = wr[64 * j]; a[cc] += (v[j].x * w.x + v[j].y * w.y) + (v[j].z * w.z + v[j].w * w.w); } }
#pragma unroll
                    for (int cc = 0; cc < 4; ++cc) { const float t = wave_sum(a[cc]); res = (F.lane == c0 + cc) ? t : res; }
                }
                hnd(m, res);
            }
        }
    }
}

DI void p2_prep(Frame& F, const float* conv_w) {
    bf16_t* pj = (bf16_t*)(F.ws + WS_BIG + BIG_PJ);
    const f32x2* cs = (const f32x2*)(F.ws + AUX_CS);
    bf16_t* qn = (bf16_t*)(F.ws + AUX_QN); bf16_t* kn = (bf16_t*)(F.ws + AUX_KN); bf16_t* vc = (bf16_t*)(F.ws + AUX_VC);
    const int lane = F.lane;
    for (int m = F.gw; m < NTOK; m += F.NGW) {
        const int pos = m & (SEQ - 1);
        bf16_t* row = pj + (size_t)m * PJW;
        const f32x2 c = cs[pos * 64 + lane];
#pragma unroll
        for (int hv = 0; hv < 16; ++hv) { bf16_t* p = row + hv * 128; const float x1 = bf2f(p[lane]), x2 = bf2f(p[lane + 64]); const float sc = hv >= 8 ? 0.08838834764831845f : 1.0f;
            p[lane] = (bf16_t)f2bf((x1 * c.x - x2 * c.y) * sc); p[lane + 64] = (bf16_t)f2bf((x2 * c.x + x1 * c.y) * sc); }
#pragma unroll
        for (int j = 0; j < 8; ++j) { const int ch = 512 * j + 8 * lane; float a[8];
#pragma unroll
            for (int e = 0; e < 8; ++e) a[e] = 0.f;
#pragma unroll
            for (int tp = 0; tp < 4; ++tp) { const int dp = pos - 3 + tp; if (dp >= 0) { const u32x4 r = *(const u32x4*)(pj + (size_t)(m - 3 + tp) * PJW + C_GQKV + ch);
                    const f32x4 w0 = *(const f32x4*)(conv_w + tp * 4096 + ch), w1 = *(const f32x4*)(conv_w + tp * 4096 + ch + 4);
                    a[0] += bflo(r.x) * w0.x; a[1] += bfhi(r.x) * w0.y; a[2] += bflo(r.y) * w0.z; a[3] += bfhi(r.y) * w0.w; a[4] += bflo(r.z) * w1.x; a[5] += bfhi(r.z) * w1.y; a[6] += bflo(r.w) * w1.z; a[7] += bfhi(r.w) * w1.w; } }
            float ss = 0.f;
#pragma unroll
            for (int e = 0; e < 8; ++e) { a[e] = siluf(a[e]); ss += a[e] * a[e]; }
            if (j < 4) { ss += __shfl_xor(ss, 1); ss += __shfl_xor(ss, 2); ss += __shfl_xor(ss, 4); ss += __shfl_xor(ss, 8);
                const float sc = (1.0f / sqrtf(ss + EPS)) * (j < 2 ? 0.08838834764831845f : 1.0f);
#pragma unroll
                for (int e = 0; e < 8; ++e) a[e] *= sc; }
            u32x4 o; o.x = pk2(a[0], a[1]); o.y = pk2(a[2], a[3]); o.z = pk2(a[4], a[5]); o.w = pk2(a[6], a[7]);
            bf16_t* dst = j < 2 ? qn + (size_t)m * 1024 + ch : (j < 4 ? kn + (size_t)m * 1024 + (ch - 1024) : vc + (size_t)m * 2048 + (ch - 2048));
            *(u32x4*)dst = o; }
    }
}

constexpr int TB = 16;
template <bool GDN>
DI void p3_recurrence(Frame& F, int u  ) {
    const int b = u >> 2, h = 2 * (u & 3) + (F.tid >> 8), e = F.tid & 255, hh = F.tid >> 8;
    bf16_t* pj = (bf16_t*)(F.ws + WS_BIG + BIG_PJ);
    const bf16_t* qsrc = GDN ? (const bf16_t*)(F.ws + AUX_QN) : pj + C_RQ; const bf16_t* ksrc = GDN ? (const bf16_t*)(F.ws + AUX_KN) : pj + C_RK;
    const int qld = GDN ? 1024 : PJW;
    bf16_t* vsrc = GDN ? (bf16_t*)(F.ws + AUX_VC) : pj + C_RV; const int vld = GDN ? 2048 : PJW;
    const float* bg = (const float*)(F.ws + AUX_BG);
    LAS float* qs = (LAS float*)F.lds;
    LAS float* ks = qs + 2 * TB * 128;
    LAS float* ab = ks + 2 * TB * 128;
    LAS float* vs = ab + 2 * TB * 2;
    float S[128];
#pragma unroll
    for (int d = 0; d < 128; ++d) S[d] = 0.f;
    const float gam = GDN ? 0.f : (1.0f - exp2f(-5.0f - (float)h));
    for (int t0 = 0; t0 < SEQ; t0 += TB) {
        const size_t r0 = (size_t)b * SEQ + t0;
        __syncthreads();
        for (int i = F.tid; i < 2 * TB * 128; i += NTHR) { const int h2 = i / (TB * 128), tt = (i / 128) % TB, d = i % 128; const int hd = 2 * (u & 3) + h2;
            qs[i] = bf2f(qsrc[(r0 + tt) * qld + hd * 128 + d]); ks[i] = bf2f(ksrc[(r0 + tt) * qld + hd * 128 + d]); }
        for (int i = F.tid; i < 2 * TB * 256; i += NTHR) { const int h2 = i / (TB * 256), tt = (i / 256) % TB, ee = i % 256; vs[i] = bf2f(vsrc[(r0 + tt) * vld + (2 * (u & 3) + h2) * 256 + ee]); }
        if (GDN && F.tid < 2 * TB) { const int h2 = F.tid / TB, tt = F.tid % TB, hd = 2 * (u & 3) + h2; ab[F.tid * 2] = __expf(bg[(r0 + tt) * 16 + 8 + hd]); ab[F.tid * 2 + 1] = bg[(r0 + tt) * 16 + hd]; }
        __syncthreads();
#pragma unroll 1
        for (int tt = 0; tt < TB; ++tt) {
            const LAS f32x4* q4 = (const LAS f32x4*)(qs + (hh * TB + tt) * 128); const LAS f32x4* k4 = (const LAS f32x4*)(ks + (hh * TB + tt) * 128);
            const float v = vs[(hh * TB + tt) * 256 + e];
            float o = 0.f;
            if (GDN) {
                const float a = ab[(hh * TB + tt) * 2], beta = ab[(hh * TB + tt) * 2 + 1];
                float ksum = 0.f;
#pragma unroll
                for (int d4 = 0; d4 < 32; ++d4) { if ((d4 & 7) == 0) asm volatile("" ::: "memory"); const f32x4 kk = k4[d4]; ksum += (kk.x * S[4 * d4] + kk.y * S[4 * d4 + 1]) + (kk.z * S[4 * d4 + 2] + kk.w * S[4 * d4 + 3]); }
                const float r = (v - a * ksum) * beta;
#pragma unroll
                for (int d4 = 0; d4 < 32; ++d4) { if ((d4 & 3) == 0) asm volatile("" ::: "memory"); const f32x4 kk = k4[d4], qq = q4[d4];
                    S[4 * d4] = a * S[4 * d4] + r * kk.x; S[4 * d4 + 1] = a * S[4 * d4 + 1] + r * kk.y; S[4 * d4 + 2] = a * S[4 * d4 + 2] + r * kk.z; S[4 * d4 + 3] = a * S[4 * d4 + 3] + r * kk.w;
                    o += (qq.x * S[4 * d4] + qq.y * S[4 * d4 + 1]) + (qq.z * S[4 * d4 + 2] + qq.w * S[4 * d4 + 3]); }
            } else {
#pragma unroll
                for (int d4 = 0; d4 < 32; ++d4) { if ((d4 & 3) == 0) asm volatile("" ::: "memory"); const f32x4 kk = k4[d4], qq = q4[d4];
                    S[4 * d4] = gam * S[4 * d4] + v * kk.x; S[4 * d4 + 1] = gam * S[4 * d4 + 1] + v * kk.y; S[4 * d4 + 2] = gam * S[4 * d4 + 2] + v * kk.z; S[4 * d4 + 3] = gam * S[4 * d4 + 3] + v * kk.w;
                    o += (qq.x * S[4 * d4] + qq.y * S[4 * d4 + 1]) + (qq.z * S[4 * d4 + 2] + qq.w * S[4 * d4 + 3]); }
            }
            vsrc[(r0 + tt) * vld + h * 256 + e] = (bf16_t)f2bf(o);
        }
    }
}

DI void p4_mixnorm(Frame& F, const float* ret_norm, const float* gdn_norm) {
    bf16_t* pj = (bf16_t*)(F.ws + WS_BIG + BIG_PJ); const bf16_t* vc = (const bf16_t*)(F.ws + AUX_VC);
    const int lane = F.lane;
    const f32x4 gr = *(const f32x4*)(ret_norm + 4 * lane), gg = *(const f32x4*)(gdn_norm + 4 * lane);
    for (int m = F.gw; m < NTOK; m += F.NGW) {
        bf16_t* row = pj + (size_t)m * PJW;
#pragma unroll
        for (int hv = 0; hv < 16; ++hv) { const int hd = hv & 7; const bool gdn = hv >= 8;
            const u32x2 ro = gdn ? *(const u32x2*)(vc + (size_t)m * 2048 + hd * 256 + 4 * lane) : *(const u32x2*)(row + C_RV + hd * 256 + 4 * lane);
            bf16_t* gp = row + (gdn ? C_GZ : C_RG) + hd * 256 + 4 * lane; const u32x2 gt = *(const u32x2*)gp;
            const float o0 = bflo(ro.x), o1 = bfhi(ro.x), o2 = bflo(ro.y), o3 = bfhi(ro.y);
            const float rstd = 1.0f / sqrtf(wave_sum((o0 * o0 + o1 * o1) + (o2 * o2 + o3 * o3)) * (1.0f / 256.0f) + EPS);
            const f32x4 g = gdn ? gg : gr;
            u32x2 w; w.x = pk2(o0 * rstd * g.x * siluf(bflo(gt.x)), o1 * rstd * g.y * siluf(bfhi(gt.x))); w.y = pk2(o2 * rstd * g.z * siluf(bflo(gt.y)), o3 * rstd * g.w * siluf(bfhi(gt.y)));
            *(u32x2*)gp = w; }
    }
}

DI void p11_swaprep(Frame& F, const float* qnorm, const float* knorm) {
    bf16_t* qkv = (bf16_t*)(F.ws + WS_BIG + BIG_QKV1); const f32x2* cs = (const f32x2*)(F.ws + AUX_CS);
    const int lane = F.lane; const float gq = qnorm[lane], gk = knorm[lane];
    for (int m = F.gw; m < NTOK; m += F.NGW) {
        const int pos = m & (SEQ - 1); const f32x2 c = cs[pos * 64 + 2 * (lane & 31)];
        bf16_t* row = qkv + (size_t)m * ODD_IN;
#pragma unroll 4
        for (int hv = 0; hv < 36; ++hv) { bf16_t* p = row + hv * 64; const float x = bf2f(p[lane]);
            const float rstd = 1.0f / sqrtf(wave_sum(x * x) * (1.0f / 64.0f) + EPS); const float xn = x * rstd * (hv < 32 ? gq : gk);
            const float xo = __shfl_xor(xn, 32);
            const float r = lane < 32 ? xn * c.x - xo * c.y : xn * c.x + xo * c.y;
            p[lane] = (bf16_t)f2bf(r); }
    }
}
DI void p12_swa_naive(Frame& F, const float* sinks) {
    bf16_t* qkv = (bf16_t*)(F.ws + WS_BIG + BIG_QKV1);
    const long total = (long)NTOK * 32;
    for (long idx = (long)blockIdx.x * NTHR + F.tid; idx < total; idx += (long)F.G * NTHR) {
        const int hq = (int)(idx / NTOK), m = (int)(idx % NTOK), pos = m & (SEQ - 1), kvh = hq >> 3;
        bf16_t* qp = qkv + (size_t)m * ODD_IN + hq * 64;
        float q[64], o[64];
#pragma unroll
        for (int d8 = 0; d8 < 8; ++d8) { const u32x4 r = *(const u32x4*)(qp + 8 * d8); q[8 * d8] = bflo(r.x); q[8 * d8 + 1] = bfhi(r.x); q[8 * d8 + 2] = bflo(r.y); q[8 * d8 + 3] = bfhi(r.y); q[8 * d8 + 4] = bflo(r.z); q[8 * d8 + 5] = bfhi(r.z); q[8 * d8 + 6] = bflo(r.w); q[8 * d8 + 7] = bfhi(r.w); }
#pragma unroll
        for (int d = 0; d < 64; ++d) o[d] = 0.f;
        float mx = sinks[hq], l = 1.0f;
        const int j0 = pos >= 127 ? 127 : pos;
#pragma unroll 1
        for (int j = j0; j >= 0; --j) {
            const bf16_t* kp = qkv + (size_t)(m - j) * ODD_IN + 2048 + kvh * 64; const bf16_t* vp = kp + 256;
            float s = 0.f;
#pragma unroll
            for (int d8 = 0; d8 < 8; ++d8) { const u32x4 r = *(const u32x4*)(kp + 8 * d8);
                s += q[8 * d8] * bflo(r.x) + q[8 * d8 + 1] * bfhi(r.x) + q[8 * d8 + 2] * bflo(r.y) + q[8 * d8 + 3] * bfhi(r.y) + q[8 * d8 + 4] * bflo(r.z) + q[8 * d8 + 5] * bfhi(r.z) + q[8 * d8 + 6] * bflo(r.w) + q[8 * d8 + 7] * bfhi(r.w); }
            s *= 0.125f;
            const float mn = fmaxf(mx, s), cf = __expf(mx - mn), p = __expf(s - mn);
            l = l * cf + p; mx = mn;
#pragma unroll
            for (int d8 = 0; d8 < 8; ++d8) { const u32x4 r = *(const u32x4*)(vp + 8 * d8);
                o[8 * d8] = o[8 * d8] * cf + p * bflo(r.x); o[8 * d8 + 1] = o[8 * d8 + 1] * cf + p * bfhi(r.x); o[8 * d8 + 2] = o[8 * d8 + 2] * cf + p * bflo(r.y); o[8 * d8 + 3] = o[8 * d8 + 3] * cf + p * bfhi(r.y);
                o[8 * d8 + 4] = o[8 * d8 + 4] * cf + p * bflo(r.z); o[8 * d8 + 5] = o[8 * d8 + 5] * cf + p * bfhi(r.z); o[8 * d8 + 6] = o[8 * d8 + 6] * cf + p * bflo(r.w); o[8 * d8 + 7] = o[8 * d8 + 7] * cf + p * bfhi(r.w); }
        }
        const float il = 1.0f / l;
#pragma unroll
        for (int d8 = 0; d8 < 8; ++d8) { u32x4 w; w.x = pk2(o[8 * d8] * il, o[8 * d8 + 1] * il); w.y = pk2(o[8 * d8 + 2] * il, o[8 * d8 + 3] * il); w.z = pk2(o[8 * d8 + 4] * il, o[8 * d8 + 5] * il); w.w = pk2(o[8 * d8 + 6] * il, o[8 * d8 + 7] * il);
            *(u32x4*)(qp + 8 * d8) = w; }
    }
}

struct RouteHandler {
    unsigned* cnt; int* list; float* gw; unsigned* asg; int lane;
    DI void operator()(int m, float res) const {
        float p[36];
#pragma unroll
        for (int j = 0; j < 36; ++j) p[j] = rdlane(res, j);
        int g = 0; float gm = p[0];
#pragma unroll
        for (int j = 1; j < 4; ++j) if (p[j] > gm) { gm = p[j]; g = j; }
        float gs = 0.f;
#pragma unroll
        for (int j = 0; j < 4; ++j) gs += __expf(p[j] - gm);
        const float g_p = 1.0f / gs;
        float q[8];
#pragma unroll
        for (int i = 0; i < 8; ++i) q[i] = g == 0 ? p[4 + i] : (g == 1 ? p[12 + i] : (g == 2 ? p[20 + i] : p[28 + i]));
        int i0 = 0; float m0 = q[0];
#pragma unroll
        for (int i = 1; i < 8; ++i) if (q[i] > m0) { m0 = q[i]; i0 = i; }
        int i1 = -1; float m1 = -3.0e38f;
#pragma unroll
        for (int i = 0; i < 8; ++i) if (i != i0 && q[i] > m1) { m1 = q[i]; i1 = i; }
        const float e1 = __expf(m1 - m0), w0 = g_p / (1.0f + e1), w1 = g_p * e1 / (1.0f + e1);
        if (lane == 0) {
            const int ea = g * 8 + i0, eb = g * 8 + i1;
            const unsigned pa = __hip_atomic_fetch_add(cnt + ea, 1u, __ATOMIC_RELAXED, __HIP_MEMORY_SCOPE_AGENT), pb = __hip_atomic_fetch_add(cnt + eb, 1u, __ATOMIC_RELAXED, __HIP_MEMORY_SCOPE_AGENT);
            list[ea * 65536 + pa] = m; list[eb * 65536 + pb] = m; gw[ea * 65536 + pa] = w0; gw[eb * 65536 + pb] = w1;
            asg[2 * m] = ((unsigned)ea << 16) | pa; asg[2 * m + 1] = ((unsigned)eb << 16) | pb;
        }
    }
};
struct BgHandler {
    float* bg; const float* a_log; const float* dt_bias; int lane;
    DI void operator()(int m, float v) const {
        if (lane < 16) {
            float r;
            if (lane < 8) r = 1.0f / (1.0f + __expf(-v));
            else { const float z = v + dt_bias[lane - 8]; const float sp = z > 20.f ? z : log1pf(__expf(z)); r = -__expf(a_log[lane - 8]) * sp; }
            bg[(size_t)m * 16 + lane] = r; }
    }
};
struct NoHandler { DI void operator()(int, float) const {} };
DI void moe_tables(Frame& F, const unsigned* cntg) {
    LAS int* cnt = (LAS int*)(F.lds + TBL_OFF); LAS int* tb = cnt + 32;
    __syncthreads();
    if (F.tid == 0) { int acc = 0; for (int e = 0; e < 32; ++e) { const int c = (int)__hip_atomic_load(cntg + e, __ATOMIC_RELAXED, __HIP_MEMORY_SCOPE_AGENT); cnt[e] = c; tb[e] = acc; acc += (c + 255) >> 8; } tb[32] = acc; }
    __syncthreads();
}

constexpr int NPH = 18;
struct Args { const float* in[20]; float* out; unsigned char* ws; int ph_lo, ph_hi; };
__global__ void __launch_bounds__(NTHR, 2) mk_fwd(Args args) {
    extern __shared__ __attribute__((aligned(16))) unsigned char lds[];
    Frame F;
    F.lds = (LAS unsigned char*)lds; F.tid = threadIdx.x; F.lane = F.tid & 63; F.wave = __builtin_amdgcn_readfirstlane(F.tid >> 6); F.G = gridDim.x;
    F.gw = blockIdx.x * NWAVES + F.wave; F.NGW = F.G * NWAVES; F.ws = args.ws; F.ctl = (unsigned*)(args.ws + WS_CTL);
    volatile LAS unsigned* MISC = (volatile LAS unsigned*)(F.lds + MISC_OFF);
    if (F.tid < 64) MISC[F.tid] = 0u;
    __syncthreads();
    XcdBarrier bar; bar.bar = F.ctl + CW_BAR; bar.x = 0; bar.st = nullptr;
    if (!MK_MULTI) bar = xcd_barrier_post(F.ctl + CW_BAR, MISC + 8);
    const int lo = args.ph_lo, hi = args.ph_hi;
#ifdef ONLY_PH
#define IN(k) ((k) == ONLY_PH && lo <= (k) && (k) < hi)
#else
#define IN(k) (lo <= (k) && (k) < hi)
#endif
#define SEAM(k) do { if (IN(k) && IN((k) + 1)) xcd_barrier(bar); } while (0)
    const float* const* in = args.in;
    float* XC = args.out;
    bf16_t* H = (bf16_t*)(F.ws + WS_H);
    bf16_t* PJ = (bf16_t*)(F.ws + WS_BIG + BIG_PJ);
    unsigned char* aux = F.ws;
    const LAS int* tbl_cnt = (const LAS int*)(F.lds + TBL_OFF); const LAS int* tbl_tb = tbl_cnt + 32;
    LAS unsigned* tokoff = (LAS unsigned*)(F.lds + TOK_OFF);

    if (IN(0)) {
        p0_weights(F, in);
        __syncthreads();
    }
    SEAM(0);
    if (IN(1)) {
        BgHandler hb{(float*)(aux + AUX_BG), in[6], in[7], F.lane};
        norm_pass<16, false, false, true>(F, in[0], nullptr, nullptr, nullptr, tbl_tb, in[1], (const float*)(aux + AUX_SW), H, hb);
    }
    SEAM(1);
    if (IN(2)) {
        pg8::DenseOrder S; S.init(NTOK, PJW, D, D, (const bf16_t*)(F.ws + WS_WIN0), F.G, blockIdx.x);
        pg8::EpiBf16 E{PJ, PJW};
        pg8::gemm_phase(F.lds, H, D, S, E);
    }
    SEAM(2);
    if (IN(3)) p2_prep(F, in[5]);
    SEAM(3);
    if (IN(4)) { if (blockIdx.x < 8) p3_recurrence<false>(F, blockIdx.x); else if (blockIdx.x < 16) p3_recurrence<true>(F, blockIdx.x - 8); __syncthreads(); }
    SEAM(4);
    if (IN(5)) p4_mixnorm(F, in[4], in[8]);
    SEAM(5);
    if (IN(6)) {
        pg8::DenseOrder S; S.init(NTOK, D, 4096, PJW, (const bf16_t*)(F.ws + WS_WOUT0), F.G, blockIdx.x);
        pg8::EpiResF32 E{in[0], XC, D};
        pg8::gemm_phase(F.lds, PJ + C_RG, 4096, S, E);
    }
    SEAM(6);
#define MOE_LAYER(P, L, CNTW)                                                                                                                  \
    if (IN(P)) {                                                            \
        convert_experts(F, in, L);                                                                                                             \
        RouteHandler hr{F.ctl + CNTW, (int*)(aux + AUX_LIST), (float*)(aux + AUX_GW), (unsigned*)(aux + AUX_ASG), F.lane};                      \
        norm_pass<36, false, false, true>(F, XC, nullptr, nullptr, nullptr, tbl_tb, in[2] + L * D, (const float*)(aux + AUX_SW) + 16 * D + L * 36 * D, H, hr); \
        __syncthreads();                                                                                                                       \
    }                                                                                                                                          \
    SEAM(P);                                                                                                                                   \
    if (IN(P + 1)) {                                                                                                \
        moe_tables(F, F.ctl + CNTW);                                                                                                           \
        pg8::MoeOrder<true> S; S.init(tbl_tb, tokoff, 6, D, D, (const bf16_t*)(F.ws + WS_BIG + BIG_EGU), (size_t)1536 * D, F.G, blockIdx.x);   \
        { pg8::Unit u; const int* list = (const int*)(aux + AUX_LIST);                                                                         \
          for (int ui = 0; ui < 12 && S.next(ui, u); ++ui) if (F.tid < 256) { const int idx = (u.pm - tbl_tb[u.e]) * 256 + F.tid;               \
              const int tok = idx < tbl_cnt[u.e] ? list[u.e * 65536 + idx] : 0; tokoff[ui * 256 + F.tid] = (unsigned)tok * (unsigned)(D * 2); } } \
        __syncthreads();                                                                                                                       \
        pg8::EpiSwiglu E{(bf16_t*)(F.ws + WS_BIG + BIG_HID)};                                                                                  \
        pg8::gemm_phase(F.lds, H, D, S, E);                                                                                                    \
    }                                                                                                                                          \
    SEAM(P + 1);                                                                                                                               \
    if (IN(P + 2)) {                                                                                  \
        moe_tables(F, F.ctl + CNTW);                                                                                                           \
        pg8::MoeOrder<false> S; S.init(tbl_tb, tokoff, 8, FF, FF, (const bf16_t*)(F.ws + WS_BIG + BIG_EDN), (size_t)D * FF, F.G, blockIdx.x);  \
        pg8::EpiDown E{(bf16_t*)(F.ws + WS_BIG + BIG_Y), (const float*)(aux + AUX_GW), tbl_tb};                                                \
        pg8::gemm_phase(F.lds, (const bf16_t*)(F.ws + WS_BIG + BIG_HID), FF, S, E);                                                            \
    }                                                                                                                                          \
    SEAM(P + 2);
    MOE_LAYER(7, 0, CW_CNT0)
    if (IN(10)) {
        moe_tables(F, F.ctl + CW_CNT0);
        norm_pass<0, true, true, true>(F, XC, XC, (const bf16_t*)(F.ws + WS_BIG + BIG_Y), (const unsigned*)(aux + AUX_ASG), tbl_tb, in[1] + D, nullptr, H, NoHandler{});
        __syncthreads();
    }
    SEAM(10);
    if (IN(11)) {
        pg8::DenseOrder S; S.init(NTOK, ODD_IN, D, D, (const bf16_t*)(F.ws + WS_WIN1), F.G, blockIdx.x);
        pg8::EpiBf16 E{(bf16_t*)(F.ws + WS_BIG + BIG_QKV1), ODD_IN};
        pg8::gemm_phase(F.lds, H, D, S, E);
    }
    SEAM(11);
    if (IN(12)) p11_swaprep(F, in[11], in[12]);
    SEAM(12);
    if (IN(13)) p12_swa_naive(F, in[13]);
    SEAM(13);
    if (IN(14)) {
        pg8::DenseOrder S; S.init(NTOK, D, D, ODD_IN, (const bf16_t*)(F.ws + WS_WOUT1), F.G, blockIdx.x);
        pg8::EpiResF32 E{XC, XC, D};
        pg8::gemm_phase(F.lds, (const bf16_t*)(F.ws + WS_BIG + BIG_QKV1), D, S, E);
    }
    SEAM(14);
    MOE_LAYER(15, 1, CW_CNT1)
    if (IN(18)) {
        moe_tables(F, F.ctl + CW_CNT1);
        norm_pass<0, true, true, false>(F, XC, XC, (const bf16_t*)(F.ws + WS_BIG + BIG_Y), (const unsigned*)(aux + AUX_ASG), tbl_tb, nullptr, nullptr, nullptr, NoHandler{});
    }
#undef IN
#undef SEAM
}

extern "C" void kernel_launch(void* const* d_in, const int* in_sizes, int n_in, void* d_out, int out_size, void* d_ws, size_t ws_size, hipStream_t stream) {
    static int grid = 0;
    if (grid == 0) {
        if (n_in != 20 || in_sizes[0] != NTOK * D || out_size != NTOK * D || ws_size < WS_END) { fprintf(stderr, "kernel_launch: unexpected shapes / workspace (n_in %d, in0 %d, out %d, ws %zu, need %zu)\n", n_in, n_in > 0 ? in_sizes[0] : -1, out_size, ws_size, (size_t)WS_END); grid = -1; return; }
        int dev = 0, cus = 0, per_cu = 0;
        if (hipGetDevice(&dev) != hipSuccess || hipDeviceGetAttribute(&cus, hipDeviceAttributeMultiprocessorCount, dev) != hipSuccess) { grid = -1; return; }
        if (hipFuncSetAttribute((const void*)mk_fwd, hipFuncAttributeMaxDynamicSharedMemorySize, LDS_BYTES) != hipSuccess) { fprintf(stderr, "kernel_launch: hipFuncSetAttribute failed\n"); grid = -1; return; }
        if (hipOccupancyMaxActiveBlocksPerMultiprocessor(&per_cu, (const void*)mk_fwd, NTHR, LDS_BYTES) != hipSuccess || per_cu < 1) fprintf(stderr, "kernel_launch: occupancy query reports %d\n", per_cu);
        (void)hipGetLastError();
        grid = cus;
    }
    if (grid < 0) return;
    (void)hipMemsetAsync((char*)d_ws + WS_CTL, 0, CTL_ZERO_BYTES, stream);
    Args a{};
    for (int i = 0; i < 20; ++i) a.in[i] = (const float*)d_in[i];
    a.out = (float*)d_out; a.ws = (unsigned char*)d_ws;
#if MK_MULTI
    for (int p = 0; p <= NPH; ++p) { a.ph_lo = p; a.ph_hi = p + 1; hipLaunchKernelGGL(mk_fwd, dim3(grid), dim3(NTHR), LDS_BYTES, stream, a); }
#else
    a.ph_lo = 0; a.ph_hi = NPH + 1;
    hipLaunchKernelGGL(mk_fwd, dim3(grid), dim3(NTHR), LDS_BYTES, stream, a);
#endif
}
```

```cpp
#include <hip/hip_runtime.h>
#include <cstdio>
#include <cstdint>

#ifndef MK_MULTI
#define MK_MULTI 0
#endif

#define LAS __attribute__((address_space(3)))
typedef unsigned short bf16_t;
typedef short bf16x8 __attribute__((ext_vector_type(8)));
typedef float f32x4 __attribute__((ext_vector_type(4)));
typedef float f32x2 __attribute__((ext_vector_type(2)));
typedef unsigned u32x4 __attribute__((ext_vector_type(4)));
typedef unsigned u32x2 __attribute__((ext_vector_type(2)));
#define DI __device__ __forceinline__

constexpr int D = 2048, BATCH = 2, SEQ = 16384, NTOK = BATCH * SEQ;
constexpr int EVEN_IN = 12304, PJW = 12288;
constexpr int ODD_IN = 2560;
constexpr int NEXP = 32, FF = 768, TOPK = 2, MAXT = 288;
constexpr float EPS = 1e-6f;
constexpr double ROPE_R = 0.86596432336006535;
constexpr int C_RQ = 0, C_RK = 1024, C_RV = 2048, C_GQKV = 4096, C_RG = 8192, C_GZ = 10240;

constexpr size_t MiB = 1u << 20;
constexpr size_t WS_CTL = 0, CTL_ZERO_BYTES = 1 * MiB;
constexpr size_t WS_WIN0 = 2 * MiB;
constexpr size_t WS_WOUT0 = WS_WIN0 + 48 * MiB;
constexpr size_t WS_WIN1 = WS_WOUT0 + 16 * MiB;
constexpr size_t WS_WOUT1 = WS_WIN1 + 10 * MiB;
constexpr size_t WS_H = 84 * MiB;
constexpr size_t WS_BIG = 212 * MiB;
constexpr size_t WS_AUX = 980 * MiB;
constexpr size_t WS_END = 1492 * MiB;
constexpr size_t BIG_PJ = 0;
constexpr size_t BIG_EGU = 0;
constexpr size_t BIG_EDN = 192 * MiB;
constexpr size_t BIG_HID = 288 * MiB;
constexpr size_t BIG_Y = 400 * MiB;
constexpr size_t BIG_QKV1 = 0;
constexpr size_t AUX_QN = WS_AUX + 0;
constexpr size_t AUX_KN = WS_AUX + 64 * MiB;
constexpr size_t AUX_VC = WS_AUX + 128 * MiB;
constexpr size_t AUX_W = WS_AUX + 256 * MiB;
constexpr size_t AUX_ATT = WS_AUX + 320 * MiB;
constexpr size_t AUX_RST = WS_AUX + 352 * MiB;
constexpr size_t AUX_BG = WS_AUX + 480 * MiB;
constexpr size_t AUX_CS = WS_AUX + 482 * MiB;
constexpr size_t AUX_DEC = WS_AUX + 490 * MiB + 768 * 1024;
constexpr size_t AUX_SW = WS_AUX + 490 * MiB;
constexpr size_t AUX_LIST = WS_AUX + 491 * MiB;
constexpr size_t AUX_GW = WS_AUX + 499 * MiB;
constexpr size_t AUX_ASG = WS_AUX + 507 * MiB;
static_assert(AUX_ASG + MiB <= WS_END, "aux map");
constexpr int CW_BAR = 4096;
constexpr int CW_CNT0 = 16384, CW_CNT1 = 16384 + 64;

constexpr int RING_BYTES = 131072;
constexpr int GA_LDS_WAVE = 17920;
constexpr int MISC_OFF = 8 * GA_LDS_WAVE;
constexpr int TBL_OFF = MISC_OFF + 256;
constexpr int TOK_OFF = MISC_OFF + 1024;
constexpr int LDS_BYTES = 163840;
static_assert(TOK_OFF + 12 * 1024 <= LDS_BYTES, "lds map");
DI float rdlane(float v, int l) { return __builtin_bit_cast(float, __builtin_amdgcn_readlane(__builtin_bit_cast(int, v), l)); }

DI unsigned f2bf(float f) { unsigned u = __builtin_bit_cast(unsigned, f); return (u + 0x7fffu + ((u >> 16) & 1u)) >> 16; }
DI unsigned pk2(float lo, float hi) { return f2bf(lo) | (f2bf(hi) << 16); }
DI float bflo(unsigned w) { return __builtin_bit_cast(float, w << 16); }
DI float bfhi(unsigned w) { return __builtin_bit_cast(float, w & 0xffff0000u); }
DI float bf2f(bf16_t b) { return __builtin_bit_cast(float, ((unsigned)b) << 16); }
DI unsigned cvt_pk_bf16(float lo, float hi) { unsigned r; asm volatile("v_cvt_pk_bf16_f32 %0, %1, %2" : "=v"(r) : "v"(lo), "v"(hi)); return r; }
DI float wave_sum(float v) {
#pragma unroll
    for (int o = 1; o < 64; o <<= 1) v += __shfl_xor(v, o);
    return v;
}
DI float siluf(float x) { return x / (1.0f + __expf(-x)); }
#define LDS_WAIT() asm volatile("s_waitcnt lgkmcnt(0)" ::: "memory")
#define VM_WAIT() asm volatile("s_waitcnt vmcnt(0)" ::: "memory")

#define XB_TMO      128
#define XB_XCNT(j)  (256  + 64 * (j))
#define XB_XSUB(j)  (1280 + 64 * (j))
#define XB_XGEN(j)  (2304 + 64 * (j))
#define XB_TOP      3328
#define XB_TOPGEN   3392
#define XCD_BAR_WORDS 3456
#define XB_SPIN_CAP (1u << 22)
DI unsigned xb_ld(unsigned* p)              { return __hip_atomic_load(p, __ATOMIC_RELAXED, __HIP_MEMORY_SCOPE_AGENT); }
DI unsigned xb_add(unsigned* p, unsigned v) { return __hip_atomic_fetch_add(p, v, __ATOMIC_RELAXED, __HIP_MEMORY_SCOPE_AGENT); }
DI unsigned xb_xcc_id() { return (unsigned)__builtin_amdgcn_s_getreg((3 << 11) | 20) & 0xFu; }
#define XB_SPIN(cond, bar) do { unsigned _sp = 0; while (cond) { __builtin_amdgcn_s_sleep(1); \
    if ((++_sp & 255u) == 0u) { if (xb_ld(&(bar)[XB_TMO])) break; if (_sp > XB_SPIN_CAP) { atomicAdd(&(bar)[XB_TMO], 1u); break; } } } } while (0)
struct XcdBarrier { unsigned* bar; unsigned x; volatile LAS unsigned* st; };
DI XcdBarrier xcd_barrier_post(unsigned* bar, volatile LAS unsigned* st) {
    XcdBarrier b; b.bar = bar; b.x = xb_xcc_id(); b.st = st;
    if (threadIdx.x == 0) (void)xb_add(&bar[XB_XCNT(b.x)], 1u);
    return b;
}
DI void xcd_barrier_complete(unsigned* bar, unsigned x, unsigned& nloc, unsigned& nx) {
    const unsigned G = gridDim.x * gridDim.y * gridDim.z;
    unsigned sum, cnt, mine, sp = 0u;
    for (;;) {
        sum = 0u; cnt = 0u; mine = 0u;
#pragma unroll
        for (unsigned j = 0; j < 16; ++j) { const unsigned c = xb_ld(&bar[XB_XCNT(j)]); sum += c; cnt += (c > 0u) ? 1u : 0u; mine = (j == x) ? c : mine; }
        if (sum == G) break;
        __builtin_amdgcn_s_sleep(1);
        if ((++sp & 255u) == 0u) { if (xb_ld(&bar[XB_TMO])) break; if (sp > XB_SPIN_CAP) { atomicAdd(&bar[XB_TMO], 1u); break; } }
    }
    nloc = mine > 0u ? mine : 1u; nx = cnt > 0u ? cnt : 1u;
}
DI void xcd_barrier(const XcdBarrier& b) {
    asm volatile("s_waitcnt vmcnt(0)" ::: "memory");
    __syncthreads();
    if (threadIdx.x == 0) {
        unsigned* bar = b.bar;
        __builtin_amdgcn_s_waitcnt(0);
        unsigned nloc = b.st[0], nx = b.st[1];
        if (nloc == 0u) { xcd_barrier_complete(bar, b.x, nloc, nx); b.st[0] = nloc; b.st[1] = nx; }
        const unsigned old = xb_add(&bar[XB_XSUB(b.x)], 1u);
        const unsigned gen = old / nloc;
        if (old + 1u == (gen + 1u) * nloc) {
            __builtin_amdgcn_fence(__ATOMIC_RELEASE, "agent");
            asm volatile("s_waitcnt vmcnt(0)" ::: "memory");
            const unsigned og = xb_add(&bar[XB_TOP], 1u);
            const unsigned tg = og / nx;
            if (og + 1u == (tg + 1u) * nx) xb_add(&bar[XB_TOPGEN], 1u);
            else XB_SPIN(xb_ld(&bar[XB_TOPGEN]) == tg, bar);
            __builtin_amdgcn_fence(__ATOMIC_ACQUIRE, "agent");
            xb_add(&bar[XB_XGEN(b.x)], 1u);
            asm volatile("s_waitcnt vmcnt(0)" ::: "memory");
        } else {
            XB_SPIN(xb_ld(&bar[XB_XGEN(b.x)]) == gen, bar);
            __builtin_amdgcn_fence(__ATOMIC_ACQUIRE, "agent");
            asm volatile("s_waitcnt vmcnt(0)" ::: "memory");
        }
    }
    __syncthreads();
}

namespace pg8 {
constexpr int BM = 256, BK = 64, HALF = 128, HTB = HALF * BK * 2, STAGE_BYTES = 8 * HTB, NXCD = 8, WGM = 8;
__host__ __device__ __forceinline__ int lds_byte(int r, int c) { const int st = (r >> 4) * 2 + (c >> 5), rr = r & 15, cc = c & 31, ob = rr * 64 + cc * 2; return st * 1024 + (ob ^ (((ob >> 9) & 1) << 5)); }
__host__ __device__ __forceinline__ void stage_rc(int b, int& R, int& C) { const int st = b / 1024, sb = b % 1024, swz = sb ^ (((sb >> 9) & 1) << 5); R = (st >> 1) * 16 + swz / 64; C = (st & 1) * 32 + (swz % 64) / 2; }
__host__ __device__ __forceinline__ int perm32(int rho) { const int n = rho >> 4, i = rho & 15; return 8 * (i >> 2) + 4 * n + (i & 3); }

struct Unit { int pm, pn, e, slot; };

DI int xcd_remap(int L, int nwg) { const int q = nwg / NXCD, r = nwg % NXCD, xcd = L % NXCD, off = L / NXCD; return (xcd < r ? xcd * (q + 1) : r * (q + 1) + (xcd - r) * q) + off; }

struct DenseOrder {
    int nM, nN, nwg, G, c; unsigned lda2; const char* Bt; size_t tstepB;
    DI void init(int M, int N, int K, int lda, const bf16_t* Bt_, int G_, int c_) { nM = M / BM; nN = N / BM; nwg = nM * nN; G = G_; c = c_; lda2 = (unsigned)lda * 2u; Bt = (const char*)Bt_; tstepB = (size_t)BM * K * 2; }
    DI bool next(int i, Unit& u) const {
        const long L = (long)i * G + c; if (L >= nwg) return false;
        const int wgid = xcd_remap((int)L, nwg);
        const int nig = WGM * nN, gid = wgid / nig, fm = gid * WGM, gsz = (nM - fm) < WGM ? (nM - fm) : WGM;
        u.pm = fm + ((wgid % nig) % gsz); u.pn = (wgid % nig) / gsz; u.e = 0; u.slot = i; return true;
    }
    DI unsigned a_off(const Unit& u, int h, int R) const { return (unsigned)(u.pm * BM + h * HALF + R) * lda2; }
    DI const char* b_base(const Unit& u) const { return Bt + (size_t)u.pn * tstepB; }
};
template <bool GATHER> struct MoeOrder {
    const LAS int* tb; const LAS unsigned* tokoff; int NT, nwg, G, c; unsigned lda2; const char* Bt; size_t estepB, tstepB;
    DI void init(const LAS int* tb_, const LAS unsigned* tokoff_, int NT_, int K, int lda, const bf16_t* Bt_, size_t estep_elems, int G_, int c_) {
        tb = tb_; tokoff = tokoff_; NT = NT_; nwg = tb_[32] * NT_; G = G_; c = c_; lda2 = (unsigned)lda * 2u; Bt = (const char*)Bt_; estepB = estep_elems * 2; tstepB = (size_t)BM * K * 2; }
    DI bool next(int i, Unit& u) const {
        const long L = (long)i * G + c; if (L >= nwg) return false;
        const int w = xcd_remap((int)L, nwg);
        int e = 0;
#pragma unroll 1
        for (int s = 16; s >= 1; s >>= 1) if (tb[e + s] * NT <= w) e += s;
        const int nt = tb[e + 1] - tb[e], local = w - tb[e] * NT;
        u.e = e; u.pn = local / nt; u.pm = tb[e] + local % nt; u.slot = i; return true;
    }
    DI unsigned a_off(const Unit& u, int h, int R) const { if (GATHER) return tokoff[u.slot * 256 + h * HALF + R]; return (unsigned)(u.pm * BM + h * HALF + R) * lda2; }
    DI const char* b_base(const Unit& u) const { return Bt + (size_t)u.e * estepB + (size_t)u.pn * tstepB; }
};

struct EpiBf16 {
    static constexpr bool PERM = true;
    bf16_t* O; int ldc;
    DI void operator()(const f32x4 (&acc)[2][2][4][2], const Unit& u, int wr, int wc, int fr, int fq) const {
        const int row0 = u.pm * BM + wr * 64 + fr, col0 = u.pn * BM + wc * 32 + 8 * fq;
#pragma unroll
        for (int ai = 0; ai < 2; ++ai)
#pragma unroll
            for (int m = 0; m < 4; ++m) { bf16_t* rowp = O + (size_t)(row0 + ai * HALF + m * 16) * ldc + col0;
#pragma unroll
                for (int bj = 0; bj < 2; ++bj) { const f32x4 v0 = acc[ai][bj][m][0], v1 = acc[ai][bj][m][1];
                    u32x4 w; w.x = cvt_pk_bf16(v0[0], v0[1]); w.y = cvt_pk_bf16(v0[2], v0[3]); w.z = cvt_pk_bf16(v1[0], v1[1]); w.w = cvt_pk_bf16(v1[2], v1[3]);
                    *(u32x4*)(rowp + bj * HALF) = w; } }
    }
};
struct EpiResF32 {
    static constexpr bool PERM = false;
    const float* base; float* out; int ldc;
    DI void operator()(const f32x4 (&acc)[2][2][4][2], const Unit& u, int wr, int wc, int fr, int fq) const {
        const int row0 = u.pm * BM + wr * 64 + fr, col0 = u.pn * BM + wc * 32 + 4 * fq;
#pragma unroll
        for (int ai = 0; ai < 2; ++ai)
#pragma unroll
            for (int m = 0; m < 4; ++m) { const size_t off = (size_t)(row0 + ai * HALF + m * 16) * ldc + col0;
#pragma unroll
                for (int bj = 0; bj < 2; ++bj)
#pragma unroll
                    for (int n = 0; n < 2; ++n) { const f32x4 bs = *(const f32x4*)(base + off + bj * HALF + n * 16); *(f32x4*)(out + off + bj * HALF + n * 16) = bs + acc[ai][bj][m][n]; }
                asm volatile("" ::: "memory"); }
    }
};
struct EpiSwiglu {
    static constexpr bool PERM = true;
    bf16_t* O;
    DI void operator()(const f32x4 (&acc)[2][2][4][2], const Unit& u, int wr, int wc, int fr, int fq) const {
        const int row0 = u.pm * BM + wr * 64 + fr, col0 = u.pn * HALF + wc * 32 + 8 * fq;
#pragma unroll
        for (int ai = 0; ai < 2; ++ai)
#pragma unroll
            for (int m = 0; m < 4; ++m) { bf16_t* rowp = O + (size_t)(row0 + ai * HALF + m * 16) * FF + col0;
                float h[8];
#pragma unroll
                for (int n = 0; n < 2; ++n)
#pragma unroll
                    for (int j = 0; j < 4; ++j) { const float g = acc[ai][0][m][n][j], up = acc[ai][1][m][n][j]; h[n * 4 + j] = g / (1.0f + __expf(-g)) * up; }
                u32x4 w; w.x = cvt_pk_bf16(h[0], h[1]); w.y = cvt_pk_bf16(h[2], h[3]); w.z = cvt_pk_bf16(h[4], h[5]); w.w = cvt_pk_bf16(h[6], h[7]);
                *(u32x4*)rowp = w; }
    }
};
struct EpiDown {
    static constexpr bool PERM = true;
    bf16_t* O; const float* gw; const LAS int* tb;
    DI void operator()(const f32x4 (&acc)[2][2][4][2], const Unit& u, int wr, int wc, int fr, int fq) const {
        const int row0 = u.pm * BM + wr * 64 + fr, col0 = u.pn * BM + wc * 32 + 8 * fq;
        const int lrow0 = (u.pm - tb[u.e]) * BM + wr * 64 + fr;
        const float* gwe = gw + (size_t)u.e * 65536;
#pragma unroll
        for (int ai = 0; ai < 2; ++ai)
#pragma unroll
            for (int m = 0; m < 4; ++m) { bf16_t* rowp = O + (size_t)(row0 + ai * HALF + m * 16) * D + col0; const float g = gwe[lrow0 + ai * HALF + m * 16];
#pragma unroll
                for (int bj = 0; bj < 2; ++bj) { const f32x4 v0 = acc[ai][bj][m][0] * g, v1 = acc[ai][bj][m][1] * g;
                    u32x4 w; w.x = cvt_pk_bf16(v0[0], v0[1]); w.y = cvt_pk_bf16(v0[2], v0[3]); w.z = cvt_pk_bf16(v1[0], v1[1]); w.w = cvt_pk_bf16(v1[2], v1[3]);
                    *(u32x4*)(rowp + bj * HALF) = w; } }
    }
};

template <class Epi, class Sched>
DI void gemm_phase(LAS unsigned char* lds, const bf16_t* Aptr, int K, const Sched& S, const Epi& E) {
    const int tid = threadIdx.x, wid = __builtin_amdgcn_readfirstlane(tid >> 6), lane = tid & 63, wr = wid >> 2, wc = wid & 3, fr = lane & 15, fq = lane >> 4;
    const int nt = K / BK;
    const char* Ab = (const char*)Aptr;
    int Rr[2], Cc[2]; unsigned voffB[2];
#pragma unroll
    for (int i = 0; i < 2; ++i) { int R, C; stage_rc(tid * 16 + i * 8192, R, C); const int Rb = Epi::PERM ? ((R & ~31) + perm32(R & 31)) : R; Rr[i] = R; Cc[i] = C * 2; voffB[i] = (unsigned)(Rb * K + C) * 2u; }
    const unsigned kstep = (unsigned)(BK * 2);
    const size_t hstepB = (size_t)HALF * K * 2;
    const unsigned ldsw = (unsigned)wid * 1024u;
    const int aoff = lds_byte(wr * 64 + fr, fq * 8), boff = lds_byte(wc * 32 + fr, fq * 8);
#define PG8_SA(b, h) (((b) * 2 + (h)) * HTB)
#define PG8_SB(b, h) ((4 + (b) * 2 + (h)) * HTB)
#define PG8_STAGEB(bufoff, gbase) do { _Pragma("unroll") for (int _i = 0; _i < 2; ++_i) \
        __builtin_amdgcn_global_load_lds((const unsigned*)((const char*)(gbase) + voffB[_i]), (LAS unsigned*)(lds + (bufoff) + ldsw + _i * 8192), 16, 0, 0); } while (0)
#define PG8_STAGEA(bufoff, offs, kb) do { _Pragma("unroll") for (int _i = 0; _i < 2; ++_i) \
        __builtin_amdgcn_global_load_lds((const unsigned*)(Ab + (size_t)((offs)[_i] + (kb))), (LAS unsigned*)(lds + (bufoff) + ldsw + _i * 8192), 16, 0, 0); } while (0)
#define PG8_LDA(dst, b, h) do { _Pragma("unroll") for (int m = 0; m < 4; ++m) _Pragma("unroll") for (int k = 0; k < 2; ++k) dst[m][k] = *(const LAS bf16x8*)(lds + PG8_SA(b, h) + aoff + m * 2048 + k * 1024); } while (0)
#define PG8_LDB(dst, b, h) do { _Pragma("unroll") for (int n = 0; n < 2; ++n) _Pragma("unroll") for (int k = 0; k < 2; ++k) dst[n][k] = *(const LAS bf16x8*)(lds + PG8_SB(b, h) + boff + n * 2048 + k * 1024); } while (0)
#define PG8_MMA(ai, bj, At, Bt) do { __builtin_amdgcn_s_setprio(1); _Pragma("unroll") for (int m = 0; m < 4; ++m) _Pragma("unroll") for (int n = 0; n < 2; ++n) _Pragma("unroll") for (int k = 0; k < 2; ++k) \
        acc[ai][bj][m][n] = __builtin_amdgcn_mfma_f32_16x16x32_bf16(Bt[n][k], At[m][k], acc[ai][bj][m][n], 0, 0, 0); __builtin_amdgcn_s_setprio(0); } while (0)
#define PG8_WAIT_V(n) asm volatile("s_waitcnt vmcnt(" #n ")" ::: "memory")
#define PG8_WAIT_L(n) asm volatile("s_waitcnt lgkmcnt(" #n ")" ::: "memory")
#define PG8_BAR __builtin_amdgcn_s_barrier()
#define PG8_SCHED __builtin_amdgcn_sched_barrier(0)
    Unit cur, nxt; int ui = 0;
    if (!S.next(0, cur)) return;
    f32x4 acc[2][2][4][2];
#pragma unroll
    for (int a = 0; a < 2; ++a)
#pragma unroll
        for (int b = 0; b < 2; ++b)
#pragma unroll
            for (int m = 0; m < 4; ++m)
#pragma unroll
                for (int n = 0; n < 2; ++n) acc[a][b][m][n] = (f32x4){0.f, 0.f, 0.f, 0.f};
    bf16x8 At[4][2], B0[2][2], B1[2][2];
    unsigned ao[2][2], an[2][2];
#pragma unroll
    for (int h = 0; h < 2; ++h)
#pragma unroll
        for (int i = 0; i < 2; ++i) ao[h][i] = S.a_off(cur, h, Rr[i]) + (unsigned)Cc[i];
    const char* cB = S.b_base(cur);
    PG8_STAGEB(PG8_SB(0, 0), cB); PG8_STAGEB(PG8_SB(0, 1), cB + hstepB); PG8_STAGEA(PG8_SA(0, 0), ao[0], 0u); PG8_STAGEA(PG8_SA(0, 1), ao[1], 0u);
    if (wr == 1) PG8_BAR;
    PG8_WAIT_V(2); PG8_BAR;
    PG8_STAGEB(PG8_SB(1, 0), cB + kstep); PG8_STAGEA(PG8_SA(1, 0), ao[0], kstep); PG8_STAGEB(PG8_SB(1, 1), cB + hstepB + kstep);
    PG8_WAIT_V(6); PG8_BAR;
    for (;;) {
        const bool has_next = S.next(ui + 1, nxt);
        const char* nB = has_next ? S.b_base(nxt) : cB;
#pragma unroll
        for (int h = 0; h < 2; ++h)
#pragma unroll
            for (int i = 0; i < 2; ++i) an[h][i] = has_next ? (S.a_off(nxt, h, Rr[i]) + (unsigned)Cc[i]) : ao[h][i];
        for (int t = 0; t < nt; t += 2) {
            const bool last = (t == nt - 2);
            const unsigned kb1 = (unsigned)(t + 1) * kstep, kb2 = (unsigned)(t + 2) * kstep;
            unsigned x2[2][2];
#pragma unroll
            for (int h = 0; h < 2; ++h)
#pragma unroll
                for (int i = 0; i < 2; ++i) x2[h][i] = last ? an[h][i] : ao[h][i] + kb2;
            const char* b2 = last ? nB : cB + kb2; const char* b3 = b2 + kstep;
            PG8_LDB(B0, 0, 0); PG8_LDB(B1, 0, 1); PG8_SCHED; PG8_LDA(At, 0, 0); PG8_STAGEA(PG8_SA(1, 1), ao[1], kb1);
            PG8_WAIT_V(8); PG8_WAIT_L(0); PG8_BAR; PG8_MMA(0, 0, At, B0); PG8_MMA(0, 1, At, B1); PG8_BAR; PG8_SCHED;
            PG8_LDA(At, 0, 1); PG8_STAGEB(PG8_SB(0, 0), b2); PG8_STAGEB(PG8_SB(0, 1), b2 + hstepB); PG8_STAGEA(PG8_SA(0, 0), x2[0], 0u);
            PG8_WAIT_V(8); PG8_WAIT_L(0); PG8_BAR; PG8_MMA(1, 0, At, B0); PG8_MMA(1, 1, At, B1); PG8_BAR; PG8_SCHED;
            PG8_LDB(B0, 1, 0); PG8_LDB(B1, 1, 1); PG8_SCHED; PG8_LDA(At, 1, 0); PG8_STAGEA(PG8_SA(0, 1), x2[1], 0u);
            PG8_WAIT_V(8); PG8_WAIT_L(0); PG8_BAR; PG8_MMA(0, 0, At, B0); PG8_MMA(0, 1, At, B1); PG8_BAR; PG8_SCHED;
            PG8_LDA(At, 1, 1); PG8_STAGEB(PG8_SB(1, 0), b3); PG8_STAGEB(PG8_SB(1, 1), b3 + hstepB); PG8_STAGEA(PG8_SA(1, 0), x2[0], kstep);
            PG8_WAIT_V(8); PG8_WAIT_L(0); PG8_BAR; PG8_MMA(1, 0, At, B0); PG8_MMA(1, 1, At, B1); PG8_BAR; PG8_SCHED;
        }
        if (wr == 0) PG8_BAR;
        E(acc, cur, wr, wc, fr, fq);
        if (!has_next) break;
#pragma unroll
        for (int a = 0; a < 2; ++a)
#pragma unroll
            for (int b = 0; b < 2; ++b)
#pragma unroll
                for (int m = 0; m < 4; ++m)
#pragma unroll
                    for (int n = 0; n < 2; ++n) acc[a][b][m][n] = (f32x4){0.f, 0.f, 0.f, 0.f};
        cur = nxt; cB = nB; ++ui;
#pragma unroll
        for (int h = 0; h < 2; ++h)
#pragma unroll
            for (int i = 0; i < 2; ++i) ao[h][i] = an[h][i];
        if (wr == 1) PG8_BAR;
    }
    PG8_WAIT_V(0);
    PG8_BAR;
#undef PG8_SA
#undef PG8_SB
#undef PG8_STAGEA
#undef PG8_STAGEB
#undef PG8_LDA
#undef PG8_LDB
#undef PG8_MMA
#undef PG8_WAIT_V
#undef PG8_WAIT_L
#undef PG8_BAR
#undef PG8_SCHED
}
}

constexpr int NWAVES = 8, NTHR = 512;
struct Frame {
    LAS unsigned char* lds;
    int tid, lane, wave, G, gw, NGW;
    unsigned* ctl;
    unsigned char* ws;
};

DI void transpose_item(const float* Wseg, int ldw, int ncols, int K, bf16_t* WT, int row_off, LAS float* scr, int item, int lane) {
    const int nblk = ncols / 32, kb = item / nblk, nb = item % nblk, k0 = 64 * kb, n0 = 32 * nb;
#pragma unroll 8
    for (int i = 0; i < 32; ++i) { const int kk = 2 * i + (lane >> 5); scr[kk * 33 + (lane & 31)] = Wseg[(size_t)(k0 + kk) * ldw + n0 + (lane & 31)]; }
    LDS_WAIT(); asm volatile("" ::: "memory");
    const int c = lane & 7;
#pragma unroll
    for (int j = 0; j < 4; ++j) { const int n = (lane >> 3) + 8 * j; const LAS float* s = scr + (8 * c) * 33 + n;
        u32x4 o; o.x = pk2(s[0 * 33], s[1 * 33]); o.y = pk2(s[2 * 33], s[3 * 33]); o.z = pk2(s[4 * 33], s[5 * 33]); o.w = pk2(s[6 * 33], s[7 * 33]);
        *(u32x4*)(WT + (size_t)(row_off + n0 + n) * K + k0 + 8 * c) = o; }
    LDS_WAIT(); asm volatile("" ::: "memory");
}

DI void p0_weights(Frame& F, const float* const* in) {
    LAS float* scr = (LAS float*)(F.lds + F.wave * 16384);
    bf16_t* win0 = (bf16_t*)(F.ws + WS_WIN0); bf16_t* wout0 = (bf16_t*)(F.ws + WS_WOUT0); bf16_t* win1 = (bf16_t*)(F.ws + WS_WIN1); bf16_t* wout1 = (bf16_t*)(F.ws + WS_WOUT1);
    const float* ewin = in[3]; const float* ewout = in[9]; const float* owin = in[10]; const float* owout = in[14];
    constexpr int KB = D / 64;
    constexpr int I_A = KB * (4096 / 32), I_B = KB * (4096 / 32), I_C = KB * (2048 / 32), I_D = KB * (2048 / 32);
    constexpr int I_O0 = (4096 / 64) * (D / 32), I_I1 = KB * (ODD_IN / 32), I_O1 = KB * (D / 32);
    constexpr int NIT = I_A + I_B + I_C + I_D + I_O0 + I_I1 + I_O1;
    for (int it = F.gw; it < NIT; it += F.NGW) {
        int r = it;
        if (r < I_A) { transpose_item(ewin + 0, EVEN_IN, 4096, D, win0, 0, scr, r, F.lane); continue; } r -= I_A;
        if (r < I_B) { transpose_item(ewin + 6144, EVEN_IN, 4096, D, win0, C_GQKV, scr, r, F.lane); continue; } r -= I_B;
        if (r < I_C) { transpose_item(ewin + 4096, EVEN_IN, 2048, D, win0, C_RG, scr, r, F.lane); continue; } r -= I_C;
        if (r < I_D) { transpose_item(ewin + 10240, EVEN_IN, 2048, D, win0, C_GZ, scr, r, F.lane); continue; } r -= I_D;
        if (r < I_O0) { transpose_item(ewout, D, D, 4096, wout0, 0, scr, r, F.lane); continue; } r -= I_O0;
        if (r < I_I1) { transpose_item(owin, ODD_IN, ODD_IN, D, win1, 0, scr, r, F.lane); continue; } r -= I_I1;
        transpose_item(owout, D, D, D, wout1, 0, scr, r, F.lane);
    }
    float* sw = (float*)(F.ws + AUX_SW);
    const int gt = (F.gw * 64 + F.lane), NGT = F.NGW * 64;
    for (int i = gt; i < 16 * D; i += NGT) { const int c = i / D, k = i % D; sw[i] = ewin[(size_t)k * EVEN_IN + 12288 + c]; }
    for (int l = 0; l < 2; ++l) { float* rt = sw + 16 * D + l * 36 * D; const float* rg = in[15] + (size_t)l * D * 4; const float* re = in[16] + (size_t)l * D * 32;
        for (int i = gt; i < 36 * D; i += NGT) { const int c = i / D, k = i % D; rt[i] = c < 4 ? rg[k * 4 + c] : re[k * 32 + (c - 4)]; } }
    f32x2* cs = (f32x2*)(F.ws + AUX_CS);
    for (int i = gt; i < SEQ * 64; i += NGT) { const int pos = i >> 6, fi = i & 63; double inv = 1.0;
        for (int q = 0; q < fi; ++q) inv *= ROPE_R;
        const double x = (double)pos * inv, k = __builtin_rint(x * 0.15915494309189535), r = (x - k * 6.283185307179586) - k * 2.4492935982947064e-16;
        const float rf = (float)r; cs[i] = (f32x2){cosf(rf), sinf(rf)}; }
}
DI void convert_experts(Frame& F, const float* const* in, int l) {
    LAS float* scr = (LAS float*)(F.lds + F.wave * 16384);
    const float* wg = in[17] + (size_t)l * NEXP * D * FF; const float* wu = in[18] + (size_t)l * NEXP * D * FF; const float* wd = in[19] + (size_t)l * NEXP * FF * D;
    bf16_t* gu = (bf16_t*)(F.ws + WS_BIG + BIG_EGU); bf16_t* dn = (bf16_t*)(F.ws + WS_BIG + BIG_EDN);
    constexpr int I_G = (D / 64) * (128 / 32);
    constexpr int I_GU = NEXP * 6 * 2 * I_G;
    constexpr int I_DE = (FF / 64) * (D / 32);
    constexpr int NIT = I_GU + NEXP * I_DE;
    for (int it = F.gw; it < NIT; it += F.NGW) {
        if (it < I_GU) { const int seg = it / I_G, r = it % I_G, e = seg / 12, s = seg % 12, pn = s >> 1, isup = s & 1;
            const float* src = (isup ? wu : wg) + (size_t)e * D * FF + pn * 128;
            transpose_item(src, FF, 128, D, gu + (size_t)e * 1536 * D, pn * 256 + isup * 128, scr, r, F.lane); }
        else { const int r2 = it - I_GU, e = r2 / I_DE, r = r2 % I_DE;
            transpose_item(wd + (size_t)e * FF * D, D, D, FF, dn + (size_t)e * D * FF, 0, scr, r, F.lane); }
    }
}

template <int NP, bool ADDY, bool WRITEX, bool WRITEH, class Handler>
DI void norm_pass(Frame& F, const float* src, float* dst, const bf16_t* y, const unsigned* asg, const LAS int* tb, const float* gain, const float* Wt, bf16_t* H, Handler hnd) {
    for (int m = F.gw; m < NTOK; m += F.NGW) {
        const f32x4* xr = (const f32x4*)(src + (size_t)m * D) + F.lane;
        f32x4 v[8];
#pragma unroll
        for (int j = 0; j < 8; ++j) v[j] = xr[64 * j];
        if (ADDY) {
            const unsigned a0 = asg[2 * m], a1 = asg[2 * m + 1];
            const size_t r0 = (size_t)tb[a0 >> 16] * 256 + (a0 & 0xffffu), r1 = (size_t)tb[a1 >> 16] * 256 + (a1 & 0xffffu);
            const u32x2* y0 = (const u32x2*)(y + r0 * D) + F.lane; const u32x2* y1 = (const u32x2*)(y + r1 * D) + F.lane;
#pragma unroll
            for (int j = 0; j < 8; ++j) { const u32x2 p = y0[64 * j], q = y1[64 * j];
                v[j].x += bflo(p.x) + bflo(q.x); v[j].y += bfhi(p.x) + bfhi(q.x); v[j].z += bflo(p.y) + bflo(q.y); v[j].w += bfhi(p.y) + bfhi(q.y); }
        }
        if (WRITEX) { f32x4* xo = (f32x4*)(dst + (size_t)m * D) + F.lane;
#pragma unroll
            for (int j = 0; j < 8; ++j) xo[64 * j] = v[j]; }
        if (WRITEH) {
            float s = 0.f;
#pragma unroll
            for (int j = 0; j < 8; ++j) s += (v[j].x * v[j].x + v[j].y * v[j].y) + (v[j].z * v[j].z + v[j].w * v[j].w);
            const float rstd = 1.0f / sqrtf(wave_sum(s) * (1.0f / D) + EPS);
            const f32x4* gr = (const f32x4*)gain + F.lane;
#pragma unroll
            for (int j = 0; j < 8; ++j) v[j] = v[j] * rstd * gr[64 * j];
            u32x2* ho = (u32x2*)(H + (size_t)m * D) + F.lane;
#pragma unroll
            for (int j = 0; j < 8; ++j) { u32x2 w; w.x = pk2(v[j].x, v[j].y); w.y = pk2(v[j].z, v[j].w); ho[64 * j] = w; }
            if constexpr (NP > 0) {
                float res = 0.f;
#pragma unroll 1
                for (int c0 = 0; c0 < NP; c0 += 4) {
                    float a[4];
#pragma unroll
                    for (int cc = 0; cc < 4; ++cc) { const f32x4* wr = (const f32x4*)(Wt + (size_t)(c0 + cc) * D) + F.lane; a[cc] = 0.f;
#pragma unroll
                        for (int j = 0; j < 8; ++j) { const f32x4 w = wr[64 * j]; a[cc] += (v[j].x * w.x + v[j].y * w.y) + (v[j].z * w.z + v[j].w * w.w); } }
#pragma unroll
                    for (int cc = 0; cc < 4; ++cc) { const float t = wave_sum(a[cc]); res = (F.lane == c0 + cc) ? t : res; }
                }
                hnd(m, res);
            }
        }
    }
}

DI void p2_prep(Frame& F, const float* conv_w) {
    bf16_t* pj = (bf16_t*)(F.ws + WS_BIG + BIG_PJ);
    const f32x2* cs = (const f32x2*)(F.ws + AUX_CS);
    bf16_t* qn = (bf16_t*)(F.ws + AUX_QN); bf16_t* kn = (bf16_t*)(F.ws + AUX_KN); bf16_t* vc = (bf16_t*)(F.ws + AUX_VC);
    const int lane = F.lane;
    for (int m = F.gw; m < NTOK; m += F.NGW) {
        const int pos = m & (SEQ - 1);
        bf16_t* row = pj + (size_t)m * PJW;
        const f32x2 c = cs[pos * 64 + lane];
#pragma unroll
        for (int hv = 0; hv < 16; ++hv) { bf16_t* p = row + hv * 128; const float x1 = bf2f(p[lane]), x2 = bf2f(p[lane + 64]); const float sc = hv >= 8 ? 0.08838834764831845f : 1.0f;
            p[lane] = (bf16_t)f2bf((x1 * c.x - x2 * c.y) * sc); p[lane + 64] = (bf16_t)f2bf((x2 * c.x + x1 * c.y) * sc); }
#pragma unroll
        for (int j = 0; j < 8; ++j) { const int ch = 512 * j + 8 * lane; float a[8];
#pragma unroll
            for (int e = 0; e < 8; ++e) a[e] = 0.f;
#pragma unroll
            for (int tp = 0; tp < 4; ++tp) { const int dp = pos - 3 + tp; if (dp >= 0) { const u32x4 r = *(const u32x4*)(pj + (size_t)(m - 3 + tp) * PJW + C_GQKV + ch);
                    const f32x4 w0 = *(const f32x4*)(conv_w + tp * 4096 + ch), w1 = *(const f32x4*)(conv_w + tp * 4096 + ch + 4);
                    a[0] += bflo(r.x) * w0.x; a[1] += bfhi(r.x) * w0.y; a[2] += bflo(r.y) * w0.z; a[3] += bfhi(r.y) * w0.w; a[4] += bflo(r.z) * w1.x; a[5] += bfhi(r.z) * w1.y; a[6] += bflo(r.w) * w1.z; a[7] += bfhi(r.w) * w1.w; } }
            float ss = 0.f;
#pragma unroll
            for (int e = 0; e < 8; ++e) { a[e] = siluf(a[e]); ss += a[e] * a[e]; }
            if (j < 4) { ss += __shfl_xor(ss, 1); ss += __shfl_xor(ss, 2); ss += __shfl_xor(ss, 4); ss += __shfl_xor(ss, 8);
                const float sc = (1.0f / sqrtf(ss + EPS)) * (j < 2 ? 0.08838834764831845f : 1.0f);
#pragma unroll
                for (int e = 0; e < 8; ++e) a[e] *= sc; }
            u32x4 o; o.x = pk2(a[0], a[1]); o.y = pk2(a[2], a[3]); o.z = pk2(a[4], a[5]); o.w = pk2(a[6], a[7]);
            bf16_t* dst = j < 2 ? qn + (size_t)m * 1024 + ch : (j < 4 ? kn + (size_t)m * 1024 + (ch - 1024) : vc + (size_t)m * 2048 + (ch - 2048));
            *(u32x4*)dst = o; }
    }
}

constexpr int TB = 16;
template <bool GDN>
DI void p3_recurrence(Frame& F, int u  ) {
    const int b = u >> 2, h = 2 * (u & 3) + (F.tid >> 8), e = F.tid & 255, hh = F.tid >> 8;
    bf16_t* pj = (bf16_t*)(F.ws + WS_BIG + BIG_PJ);
    const bf16_t* qsrc = GDN ? (const bf16_t*)(F.ws + AUX_QN) : pj + C_RQ; const bf16_t* ksrc = GDN ? (const bf16_t*)(F.ws + AUX_KN) : pj + C_RK;
    const int qld = GDN ? 1024 : PJW;
    bf16_t* vsrc = GDN ? (bf16_t*)(F.ws + AUX_VC) : pj + C_RV; const int vld = GDN ? 2048 : PJW;
    const float* bg = (const float*)(F.ws + AUX_BG);
    LAS float* qs = (LAS float*)F.lds;
    LAS float* ks = qs + 2 * TB * 128;
    LAS float* ab = ks + 2 * TB * 128;
    LAS float* vs = ab + 2 * TB * 2;
    float S[128];
#pragma unroll
    for (int d = 0; d < 128; ++d) S[d] = 0.f;
    const float gam = GDN ? 0.f : (1.0f - exp2f(-5.0f - (float)h));
    for (int t0 = 0; t0 < SEQ; t0 += TB) {
        const size_t r0 = (size_t)b * SEQ + t0;
        __syncthreads();
        for (int i = F.tid; i < 2 * TB * 128; i += NTHR) { const int h2 = i / (TB * 128), tt = (i / 128) % TB, d = i % 128; const int hd = 2 * (u & 3) + h2;
            qs[i] = bf2f(qsrc[(r0 + tt) * qld + hd * 128 + d]); ks[i] = bf2f(ksrc[(r0 + tt) * qld + hd * 128 + d]); }
        for (int i = F.tid; i < 2 * TB * 256; i += NTHR) { const int h2 = i / (TB * 256), tt = (i / 256) % TB, ee = i % 256; vs[i] = bf2f(vsrc[(r0 + tt) * vld + (2 * (u & 3) + h2) * 256 + ee]); }
        if (GDN && F.tid < 2 * TB) { const int h2 = F.tid / TB, tt = F.tid % TB, hd = 2 * (u & 3) + h2; ab[F.tid * 2] = __expf(bg[(r0 + tt) * 16 + 8 + hd]); ab[F.tid * 2 + 1] = bg[(r0 + tt) * 16 + hd]; }
        __syncthreads();
#pragma unroll 1
        for (int tt = 0; tt < TB; ++tt) {
            const LAS f32x4* q4 = (const LAS f32x4*)(qs + (hh * TB + tt) * 128); const LAS f32x4* k4 = (const LAS f32x4*)(ks + (hh * TB + tt) * 128);
            const float v = vs[(hh * TB + tt) * 256 + e];
            float o = 0.f;
            if (GDN) {
                const float a = ab[(hh * TB + tt) * 2], beta = ab[(hh * TB + tt) * 2 + 1];
                float ksum = 0.f;
#pragma unroll
                for (int d4 = 0; d4 < 32; ++d4) { if ((d4 & 7) == 0) asm volatile("" ::: "memory"); const f32x4 kk = k4[d4]; ksum += (kk.x * S[4 * d4] + kk.y * S[4 * d4 + 1]) + (kk.z * S[4 * d4 + 2] + kk.w * S[4 * d4 + 3]); }
                const float r = (v - a * ksum) * beta;
#pragma unroll
                for (int d4 = 0; d4 < 32; ++d4) { if ((d4 & 3) == 0) asm volatile("" ::: "memory"); const f32x4 kk = k4[d4], qq = q4[d4];
                    S[4 * d4] = a * S[4 * d4] + r * kk.x; S[4 * d4 + 1] = a * S[4 * d4 + 1] + r * kk.y; S[4 * d4 + 2] = a * S[4 * d4 + 2] + r * kk.z; S[4 * d4 + 3] = a * S[4 * d4 + 3] + r * kk.w;
                    o += (qq.x * S[4 * d4] + qq.y * S[4 * d4 + 1]) + (qq.z * S[4 * d4 + 2] + qq.w * S[4 * d4 + 3]); }
            } else {
#pragma unroll
                for (int d4 = 0; d4 < 32; ++d4) { if ((d4 & 3) == 0) asm volatile("" ::: "memory"); const f32x4 kk = k4[d4], qq = q4[d4];
                    S[4 * d4] = gam * S[4 * d4] + v * kk.x; S[4 * d4 + 1] = gam * S[4 * d4 + 1] + v * kk.y; S[4 * d4 + 2] = gam * S[4 * d4 + 2] + v * kk.z; S[4 * d4 + 3] = gam * S[4 * d4 + 3] + v * kk.w;
                    o += (qq.x * S[4 * d4] + qq.y * S[4 * d4 + 1]) + (qq.z * S[4 * d4 + 2] + qq.w * S[4 * d4 + 3]); }
            }
            vsrc[(r0 + tt) * vld + h * 256 + e] = (bf16_t)f2bf(o);
        }
    }
}


constexpr int NCH = SEQ / 64;
DI constexpr int rowoff4c(int i) { int a = 0; for (int k = 0; k < i; ++k) a += (k + 3) / 4; return a; }
typedef short s16x4 __attribute__((ext_vector_type(4)));
DI s16x4 tr_read(unsigned lds_addr) { s16x4 r; asm volatile("ds_read_b64_tr_b16 %0, %1\n\ts_waitcnt lgkmcnt(0)" : "=&v"(r) : "v"(lds_addr) : "memory"); return r; }
DI bf16x8 cat8(s16x4 a, s16x4 b) { return __builtin_shufflevector(a, b, 0, 1, 2, 3, 4, 5, 6, 7); }
DI f32x4 mfma16(bf16x8 a, bf16x8 b, f32x4 c) { return __builtin_amdgcn_mfma_f32_16x16x32_bf16(a, b, c, 0, 0, 0); }

template <bool GDN>
DI void ga_unit(Frame& F, int unit, unsigned char* stream, float* out_f32_unused) {
    (void)out_f32_unused;
    constexpr int NF = GDN ? 56 : 40, OFF_W = 0, OFF_QG = GDN ? 16 : 0, OFF_ATT = OFF_QG + 16, OFF_KT = OFF_ATT + 8;
    int lane_o = F.lane; asm volatile("" : "+v"(lane_o));
    const int lane = lane_o, fr = lane & 15, g = lane >> 4;
    const int bh = unit / NCH, n = unit % NCH, b = bh >> 3, h = bh & 7;
    const size_t row0 = (size_t)b * SEQ + (size_t)n * 64;
    LAS unsigned char* L = F.lds + F.wave * GA_LDS_WAVE;
    LAS float* LAf = (LAS float*)L; LAS unsigned char* LA = L; LAS unsigned char* LT = L + 9216; LAS float* LG = (LAS float*)(L + 17408); LAS float* LB = LG + 64;
    const bf16_t* pj = (const bf16_t*)(F.ws + WS_BIG + BIG_PJ);
    const bf16_t* qsrc = GDN ? (const bf16_t*)(F.ws + AUX_QN) + h * 128 : pj + C_RQ + h * 128;
    const bf16_t* ksrc = GDN ? (const bf16_t*)(F.ws + AUX_KN) + h * 128 : pj + C_RK + h * 128;
    const size_t qld = GDN ? 1024 : PJW;
    unsigned char* st = stream + (size_t)unit * NF * 1024 + lane * 16;
    float gv, bv = 1.f;
    if (GDN) { const float* bg = (const float*)(F.ws + AUX_BG); gv = bg[(row0 + lane) * 16 + 8 + h]; bv = bg[(row0 + lane) * 16 + h];
#pragma unroll
        for (int o = 1; o < 64; o <<= 1) { const float t = __shfl_up(gv, o); if (lane >= o) gv += t; } }
    else gv = (float)(lane + 1) * log1pf(-exp2f(-5.0f - (float)h));
    const float gl = rdlane(gv, 63);
    LG[lane] = gv; LB[lane] = bv;
    LDS_WAIT();
    float gr[16], gcl[4], br[16];
#pragma unroll
    for (int t = 0; t < 4; ++t) { gcl[t] = LG[16 * t + fr];
#pragma unroll
        for (int r = 0; r < 4; ++r) { gr[t * 4 + r] = LG[16 * t + 4 * g + r]; br[t * 4 + r] = LB[16 * t + 4 * g + r]; } }
    bf16x8 Kf[4][4], Qf[4][4];
#pragma unroll
    for (int t = 0; t < 4; ++t)
#pragma unroll
        for (int s2 = 0; s2 < 4; ++s2) Kf[t][s2] = *(const bf16x8*)(ksrc + (row0 + 16 * t + fr) * qld + 32 * s2 + 8 * g);
    if (GDN) {
#pragma unroll
        for (int it = 0; it < 4; ++it)
#pragma unroll
            for (int jt = 0; jt <= it; ++jt) { f32x4 acc = {0.f, 0.f, 0.f, 0.f};
#pragma unroll
                for (int s2 = 0; s2 < 4; ++s2) acc = mfma16(Kf[it][s2], Kf[jt][s2], acc);
#pragma unroll
                for (int r = 0; r < 4; ++r) { const int i = 16 * it + 4 * g + r, j = 16 * jt + fr; const int q = (i + 3) >> 2; const int ro = 2 * q * (q - 1) + q * (i - 4 * q + 3);
                    if (j < i) LAf[ro * 4 + j] = br[it * 4 + r] * acc[r] * __expf(gr[it * 4 + r] - gcl[jt]); } }
    }
    asm volatile("" ::: "memory");
#pragma unroll
    for (int it = 0; it < 4; ++it) {
        asm volatile("" ::: "memory");
#pragma unroll
        for (int s2 = 0; s2 < 4; ++s2) Qf[it][s2] = *(const bf16x8*)(qsrc + (row0 + 16 * it + fr) * qld + 32 * s2 + 8 * g);
#pragma unroll
        for (int sp = 0; sp < 2; ++sp) { u32x4 w;
#pragma unroll
            for (int hf = 0; hf < 2; ++hf) { const int jt = 2 * sp + hf; float v[4] = {0.f, 0.f, 0.f, 0.f};
                if (jt <= it) { f32x4 acc = {0.f, 0.f, 0.f, 0.f};
#pragma unroll
                    for (int s2 = 0; s2 < 4; ++s2) acc = mfma16(Kf[jt][s2], Qf[it][s2], acc);
#pragma unroll
                    for (int r = 0; r < 4; ++r) { const int j = 16 * jt + 4 * g + r, i = 16 * it + fr; v[r] = (j <= i) ? acc[r] * __expf(gcl[it] - gr[jt * 4 + r]) : 0.f; } }
                if (hf == 0) { w.x = pk2(v[0], v[1]); w.y = pk2(v[2], v[3]); } else { w.z = pk2(v[0], v[1]); w.w = pk2(v[2], v[3]); } }
            *(u32x4*)(st + (OFF_ATT + it * 2 + sp) * 1024) = w; }
    }
    asm volatile("" ::: "memory");
#pragma unroll
    for (int it = 0; it < 4; ++it) { const float sc = __expf(gcl[it]); asm volatile("" ::: "memory");
#pragma unroll
        for (int s2 = 0; s2 < 4; ++s2) { const bf16_t* qp = qsrc + (row0 + 16 * it + fr) * qld + 32 * s2 + 4 * g; const u32x2 lo = *(const u32x2*)qp, hi = *(const u32x2*)(qp + 16);
            u32x4 w; w.x = pk2(bflo(lo.x) * sc, bfhi(lo.x) * sc); w.y = pk2(bflo(lo.y) * sc, bfhi(lo.y) * sc); w.z = pk2(bflo(hi.x) * sc, bfhi(hi.x) * sc); w.w = pk2(bflo(hi.y) * sc, bfhi(hi.y) * sc);
            *(u32x4*)(st + (OFF_QG + it * 4 + s2) * 1024) = w; } }
    asm volatile("" ::: "memory");
    float t[64];
    float sw_ = 1.f, su_ = 1.f;
    if (GDN) {
        LDS_WAIT();
        const LAS f32x4* LA4 = (const LAS f32x4*)LA;
#pragma unroll
        for (int i = 0; i < 64; ++i) { float acc = (lane == i) ? 1.f : 0.f; if ((i & 1) == 0) asm volatile("" ::: "memory");
#pragma unroll
            for (int m4 = 0; m4 < (i + 3) / 4; ++m4) { const f32x4 l = LA4[rowoff4c(i) + m4];
                if (4 * m4 + 0 < i) acc -= l.x * t[4 * m4 + 0]; if (4 * m4 + 1 < i) acc -= l.y * t[4 * m4 + 1]; if (4 * m4 + 2 < i) acc -= l.z * t[4 * m4 + 2]; if (4 * m4 + 3 < i) acc -= l.w * t[4 * m4 + 3]; }
            t[i] = acc; }
        su_ = bv; sw_ = bv * __expf(gv);
        LDS_WAIT();
#pragma unroll
        for (int i = 0; i < 64; ++i) *(LAS bf16_t*)(LT + (i * 64 + lane) * 2) = (bf16_t)f2bf(t[i] * sw_);
    }
    asm volatile("" ::: "memory");
    float ksc[2][2][4];
#pragma unroll
    for (int sp = 0; sp < 2; ++sp)
#pragma unroll
        for (int tp = 0; tp < 2; ++tp)
#pragma unroll
            for (int e = 0; e < 4; ++e) ksc[sp][tp][e] = __expf(gl - LG[32 * sp + 16 * tp + 4 * g + e]);
    const unsigned la_addr = (unsigned)(size_t)LA, q4 = (unsigned)((lane & 15) >> 2), p4 = (unsigned)(lane & 3);
#pragma unroll 1
    for (int p = 0; p < 2; ++p) {
        LDS_WAIT();
#pragma unroll
        for (int k = 0; k < 8; ++k) { const int row = (lane >> 3) + 8 * k, pc = lane & 7; *(LAS u32x4*)(LA + row * 128 + pc * 16) = *(const u32x4*)(ksrc + (row0 + row) * qld + 64 * p + 8 * pc); }
        LDS_WAIT();
        if (GDN) {
#pragma unroll
            for (int it = 0; it < 4; ++it) { bf16x8 Tf[2];
#pragma unroll
                for (int ks = 0; ks < 2; ++ks) Tf[ks] = *(const LAS bf16x8*)(LT + ((16 * it + fr) * 64 + 32 * ks + 8 * g) * 2);
#pragma unroll
                for (int sl = 0; sl < 2; ++sl) { u32x4 w;
#pragma unroll
                    for (int hf = 0; hf < 2; ++hf) { const int dtl = 2 * sl + hf; f32x4 acc = {0.f, 0.f, 0.f, 0.f};
#pragma unroll
                        for (int ks = 0; ks < 2; ++ks) { const s16x4 a0 = tr_read(la_addr + (32 * ks + 8 * g + q4) * 128 + dtl * 32 + p4 * 8), a1 = tr_read(la_addr + (32 * ks + 8 * g + 4 + q4) * 128 + dtl * 32 + p4 * 8);
                            acc = mfma16(cat8(a0, a1), Tf[ks], acc); }
                        if (hf == 0) { w.x = pk2(-acc[0], -acc[1]); w.y = pk2(-acc[2], -acc[3]); } else { w.z = pk2(-acc[0], -acc[1]); w.w = pk2(-acc[2], -acc[3]); } }
                    *(u32x4*)(st + (OFF_W + it * 4 + 2 * p + sl) * 1024) = w; } }
        }
#pragma unroll
        for (int dtl = 0; dtl < 4; ++dtl)
#pragma unroll
            for (int sp = 0; sp < 2; ++sp) { const s16x4 a0 = tr_read(la_addr + (32 * sp + 4 * g + q4) * 128 + dtl * 32 + p4 * 8), a1 = tr_read(la_addr + (32 * sp + 16 + 4 * g + q4) * 128 + dtl * 32 + p4 * 8);
                u32x4 w; w.x = pk2(bf2f((bf16_t)a0[0]) * ksc[sp][0][0], bf2f((bf16_t)a0[1]) * ksc[sp][0][1]); w.y = pk2(bf2f((bf16_t)a0[2]) * ksc[sp][0][2], bf2f((bf16_t)a0[3]) * ksc[sp][0][3]);
                w.z = pk2(bf2f((bf16_t)a1[0]) * ksc[sp][1][0], bf2f((bf16_t)a1[1]) * ksc[sp][1][1]); w.w = pk2(bf2f((bf16_t)a1[2]) * ksc[sp][1][2], bf2f((bf16_t)a1[3]) * ksc[sp][1][3]);
                *(u32x4*)(st + (OFF_KT + (4 * p + dtl) * 2 + sp) * 1024) = w; }
    }
    if (GDN) {
        LDS_WAIT();
#pragma unroll
        for (int i = 0; i < 64; ++i) *(LAS bf16_t*)(LT + (i * 64 + lane) * 2) = (bf16_t)f2bf(t[i] * su_);
        const bf16_t* vsrc = (const bf16_t*)(F.ws + AUX_VC) + h * 256;
        unsigned char* ub = F.ws + WS_H + (size_t)unit * 32768 + lane * 32;
#pragma unroll 1
        for (int p = 0; p < 4; ++p) {
            LDS_WAIT();
#pragma unroll
            for (int k = 0; k < 8; ++k) { const int row = (lane >> 3) + 8 * k, pc = lane & 7; *(LAS u32x4*)(LA + row * 128 + pc * 16) = *(const u32x4*)(vsrc + (row0 + row) * 2048 + 64 * p + 8 * pc); }
            LDS_WAIT();
            bf16x8 Tf[4][2];
#pragma unroll
            for (int it = 0; it < 4; ++it)
#pragma unroll
                for (int ks = 0; ks < 2; ++ks) Tf[it][ks] = *(const LAS bf16x8*)(LT + ((16 * it + fr) * 64 + 32 * ks + 8 * g) * 2);
#pragma unroll
            for (int etl = 0; etl < 4; ++etl) { bf16x8 Vf[2];
#pragma unroll
                for (int ks = 0; ks < 2; ++ks) { const s16x4 a0 = tr_read(la_addr + (32 * ks + 8 * g + q4) * 128 + etl * 32 + p4 * 8), a1 = tr_read(la_addr + (32 * ks + 8 * g + 4 + q4) * 128 + etl * 32 + p4 * 8); Vf[ks] = cat8(a0, a1); }
                u32x4 w0, w1;
#pragma unroll
                for (int it = 0; it < 4; ++it) { f32x4 acc = {0.f, 0.f, 0.f, 0.f};
#pragma unroll
                    for (int ks = 0; ks < 2; ++ks) acc = mfma16(Tf[it][ks], Vf[ks], acc);
                    const unsigned a = pk2(acc[0], acc[1]), c = pk2(acc[2], acc[3]);
                    if (it == 0) { w0.x = a; w0.y = c; } else if (it == 1) { w0.z = a; w0.w = c; } else if (it == 2) { w1.x = a; w1.y = c; } else { w1.z = a; w1.w = c; } }
                *(u32x4*)(ub + (4 * p + etl) * 2048) = w0; *(u32x4*)(ub + (4 * p + etl) * 2048 + 16) = w1; }
        }
        if (lane == 0) ((float*)(F.ws + AUX_DEC))[unit] = __expf(gl);
    }
    LDS_WAIT();
}

template <bool GDN>
DI void scan_wave(Frame& F, int bh, int sl, const unsigned char* stream) {
    constexpr int NF = GDN ? 56 : 40;
    const int lane = F.lane, fr = lane & 15, g = lane >> 4, b = bh >> 3, h = bh & 7;
    const unsigned char* sp0 = stream + (size_t)bh * NCH * NF * 1024;
    const unsigned voff = (unsigned)lane * 16u;
    const size_t orow = (GDN ? (size_t)2048 : (size_t)PJW) * 2;
    const unsigned char* obu = (GDN ? F.ws + AUX_VC : F.ws + WS_BIG + BIG_PJ + (size_t)C_RV * 2) + (size_t)b * SEQ * orow + (size_t)(h * 256 + 16 * sl) * 2;
    const unsigned ooff = (unsigned)((size_t)(4 * g) * orow) + (unsigned)fr * 2u;
    const float* decp = (const float*)(F.ws + AUX_DEC) + bh * NCH;
    float decr = 1.f; { const float gm = 1.0f - exp2f(-5.0f - (float)h); float d2 = gm * gm; d2 *= d2; d2 *= d2; d2 *= d2; d2 *= d2; d2 *= d2; decr = d2; }
    const unsigned char* ubp = F.ws + WS_H + (size_t)bh * NCH * 32768 + sl * 2048; const unsigned uoff = (unsigned)lane * 32u;
    const unsigned zoff = 0u; (void)decp; (void)decr; (void)ubp; (void)uoff; (void)zoff;
    f32x4 S0 = {0.f, 0.f, 0.f, 0.f}, S1 = S0, S2 = S0, S3 = S0, S4 = S0, S5 = S0, S6 = S0, S7 = S0;
    bf16x8 Sp0 = (bf16x8){0, 0, 0, 0, 0, 0, 0, 0}, Sp1 = Sp0, Sp2 = Sp0, Sp3 = Sp0;
    if constexpr (GDN) {
    bf16x8 r0 = (bf16x8){0, 0, 0, 0, 0, 0, 0, 0};
    bf16x8 r1 = (bf16x8){0, 0, 0, 0, 0, 0, 0, 0};
    bf16x8 r2 = (bf16x8){0, 0, 0, 0, 0, 0, 0, 0};
    bf16x8 r3 = (bf16x8){0, 0, 0, 0, 0, 0, 0, 0};
    bf16x8 r4 = (bf16x8){0, 0, 0, 0, 0, 0, 0, 0};
    bf16x8 r5 = (bf16x8){0, 0, 0, 0, 0, 0, 0, 0};
    bf16x8 r6 = (bf16x8){0, 0, 0, 0, 0, 0, 0, 0};
    bf16x8 r7 = (bf16x8){0, 0, 0, 0, 0, 0, 0, 0};
    bf16x8 r8 = (bf16x8){0, 0, 0, 0, 0, 0, 0, 0};
    bf16x8 r9 = (bf16x8){0, 0, 0, 0, 0, 0, 0, 0};
    bf16x8 r10 = (bf16x8){0, 0, 0, 0, 0, 0, 0, 0};
    bf16x8 r11 = (bf16x8){0, 0, 0, 0, 0, 0, 0, 0};
    bf16x8 r12 = (bf16x8){0, 0, 0, 0, 0, 0, 0, 0};
    bf16x8 r13 = (bf16x8){0, 0, 0, 0, 0, 0, 0, 0};
    bf16x8 r14 = (bf16x8){0, 0, 0, 0, 0, 0, 0, 0};
    bf16x8 r15 = (bf16x8){0, 0, 0, 0, 0, 0, 0, 0};
    bf16x8 r16 = (bf16x8){0, 0, 0, 0, 0, 0, 0, 0};
    bf16x8 r17 = (bf16x8){0, 0, 0, 0, 0, 0, 0, 0};
    bf16x8 r18 = (bf16x8){0, 0, 0, 0, 0, 0, 0, 0};
    bf16x8 r19 = (bf16x8){0, 0, 0, 0, 0, 0, 0, 0};
    bf16x8 r20 = (bf16x8){0, 0, 0, 0, 0, 0, 0, 0};
    bf16x8 r21 = (bf16x8){0, 0, 0, 0, 0, 0, 0, 0};
    bf16x8 r22 = (bf16x8){0, 0, 0, 0, 0, 0, 0, 0};
    bf16x8 r23 = (bf16x8){0, 0, 0, 0, 0, 0, 0, 0};
    bf16x8 r24 = (bf16x8){0, 0, 0, 0, 0, 0, 0, 0};
    bf16x8 r25 = (bf16x8){0, 0, 0, 0, 0, 0, 0, 0};
    bf16x8 r26 = (bf16x8){0, 0, 0, 0, 0, 0, 0, 0};
    bf16x8 r27 = (bf16x8){0, 0, 0, 0, 0, 0, 0, 0};
    u32x4 un0 = {0u, 0u, 0u, 0u}, un1 = {0u, 0u, 0u, 0u};
    asm volatile("global_load_dwordx4 %0, %1, %2" : "+v"(un0) : "v"(uoff), "s"(ubp) : "memory");
    asm volatile("global_load_dwordx4 %0, %1, %2 offset:16" : "+v"(un1) : "v"(uoff), "s"(ubp) : "memory");
    float decv = 0.f; asm volatile("global_load_dword %0, %1, %2" : "+v"(decv) : "v"(zoff), "s"(decp) : "memory");
    const unsigned char* spc = sp0;
    asm volatile("global_load_dwordx4 %0, %1, %2" : "+v"(r0) : "v"(voff), "s"(spc) : "memory"); spc += 1024;
    asm volatile("global_load_dwordx4 %0, %1, %2" : "+v"(r1) : "v"(voff), "s"(spc) : "memory"); spc += 1024;
    asm volatile("global_load_dwordx4 %0, %1, %2" : "+v"(r2) : "v"(voff), "s"(spc) : "memory"); spc += 1024;
    asm volatile("global_load_dwordx4 %0, %1, %2" : "+v"(r3) : "v"(voff), "s"(spc) : "memory"); spc += 1024;
    asm volatile("global_load_dwordx4 %0, %1, %2" : "+v"(r4) : "v"(voff), "s"(spc) : "memory"); spc += 1024;
    asm volatile("global_load_dwordx4 %0, %1, %2" : "+v"(r5) : "v"(voff), "s"(spc) : "memory"); spc += 1024;
    asm volatile("global_load_dwordx4 %0, %1, %2" : "+v"(r6) : "v"(voff), "s"(spc) : "memory"); spc += 1024;
    asm volatile("global_load_dwordx4 %0, %1, %2" : "+v"(r7) : "v"(voff), "s"(spc) : "memory"); spc += 1024;
    asm volatile("global_load_dwordx4 %0, %1, %2" : "+v"(r8) : "v"(voff), "s"(spc) : "memory"); spc += 1024;
    asm volatile("global_load_dwordx4 %0, %1, %2" : "+v"(r9) : "v"(voff), "s"(spc) : "memory"); spc += 1024;
    asm volatile("global_load_dwordx4 %0, %1, %2" : "+v"(r10) : "v"(voff), "s"(spc) : "memory"); spc += 1024;
    asm volatile("global_load_dwordx4 %0, %1, %2" : "+v"(r11) : "v"(voff), "s"(spc) : "memory"); spc += 1024;
    asm volatile("global_load_dwordx4 %0, %1, %2" : "+v"(r12) : "v"(voff), "s"(spc) : "memory"); spc += 1024;
    asm volatile("global_load_dwordx4 %0, %1, %2" : "+v"(r13) : "v"(voff), "s"(spc) : "memory"); spc += 1024;
    asm volatile("global_load_dwordx4 %0, %1, %2" : "+v"(r14) : "v"(voff), "s"(spc) : "memory"); spc += 1024;
    asm volatile("global_load_dwordx4 %0, %1, %2" : "+v"(r15) : "v"(voff), "s"(spc) : "memory"); spc += 1024;
    asm volatile("global_load_dwordx4 %0, %1, %2" : "+v"(r16) : "v"(voff), "s"(spc) : "memory"); spc += 1024;
    asm volatile("global_load_dwordx4 %0, %1, %2" : "+v"(r17) : "v"(voff), "s"(spc) : "memory"); spc += 1024;
    asm volatile("global_load_dwordx4 %0, %1, %2" : "+v"(r18) : "v"(voff), "s"(spc) : "memory"); spc += 1024;
    asm volatile("global_load_dwordx4 %0, %1, %2" : "+v"(r19) : "v"(voff), "s"(spc) : "memory"); spc += 1024;
    asm volatile("global_load_dwordx4 %0, %1, %2" : "+v"(r20) : "v"(voff), "s"(spc) : "memory"); spc += 1024;
    asm volatile("global_load_dwordx4 %0, %1, %2" : "+v"(r21) : "v"(voff), "s"(spc) : "memory"); spc += 1024;
    asm volatile("global_load_dwordx4 %0, %1, %2" : "+v"(r22) : "v"(voff), "s"(spc) : "memory"); spc += 1024;
    asm volatile("global_load_dwordx4 %0, %1, %2" : "+v"(r23) : "v"(voff), "s"(spc) : "memory"); spc += 1024;
    asm volatile("global_load_dwordx4 %0, %1, %2" : "+v"(r24) : "v"(voff), "s"(spc) : "memory"); spc += 1024;
    asm volatile("global_load_dwordx4 %0, %1, %2" : "+v"(r25) : "v"(voff), "s"(spc) : "memory"); spc += 1024;
    asm volatile("global_load_dwordx4 %0, %1, %2" : "+v"(r26) : "v"(voff), "s"(spc) : "memory"); spc += 1024;
    asm volatile("global_load_dwordx4 %0, %1, %2" : "+v"(r27) : "v"(voff), "s"(spc) : "memory"); spc += 1024;
    { unsigned z = 0u;
      asm volatile("global_store_short %0, %1, %2" :: "v"(ooff), "v"(z), "s"(obu + (size_t)(0) * orow) : "memory");
      asm volatile("global_store_short %0, %1, %2" :: "v"(ooff), "v"(z), "s"(obu + (size_t)(1) * orow) : "memory");
      asm volatile("global_store_short %0, %1, %2" :: "v"(ooff), "v"(z), "s"(obu + (size_t)(2) * orow) : "memory");
      asm volatile("global_store_short %0, %1, %2" :: "v"(ooff), "v"(z), "s"(obu + (size_t)(3) * orow) : "memory");
      asm volatile("global_store_short %0, %1, %2" :: "v"(ooff), "v"(z), "s"(obu + (size_t)(16) * orow) : "memory");
      asm volatile("global_store_short %0, %1, %2" :: "v"(ooff), "v"(z), "s"(obu + (size_t)(17) * orow) : "memory");
      asm volatile("global_store_short %0, %1, %2" :: "v"(ooff), "v"(z), "s"(obu + (size_t)(18) * orow) : "memory");
      asm volatile("global_store_short %0, %1, %2" :: "v"(ooff), "v"(z), "s"(obu + (size_t)(19) * orow) : "memory");
      asm volatile("global_store_short %0, %1, %2" :: "v"(ooff), "v"(z), "s"(obu + (size_t)(32) * orow) : "memory");
      asm volatile("global_store_short %0, %1, %2" :: "v"(ooff), "v"(z), "s"(obu + (size_t)(33) * orow) : "memory");
      asm volatile("global_store_short %0, %1, %2" :: "v"(ooff), "v"(z), "s"(obu + (size_t)(34) * orow) : "memory");
      asm volatile("global_store_short %0, %1, %2" :: "v"(ooff), "v"(z), "s"(obu + (size_t)(35) * orow) : "memory");
      asm volatile("global_store_short %0, %1, %2" :: "v"(ooff), "v"(z), "s"(obu + (size_t)(48) * orow) : "memory");
      asm volatile("global_store_short %0, %1, %2" :: "v"(ooff), "v"(z), "s"(obu + (size_t)(49) * orow) : "memory");
      asm volatile("global_store_short %0, %1, %2" :: "v"(ooff), "v"(z), "s"(obu + (size_t)(50) * orow) : "memory");
      asm volatile("global_store_short %0, %1, %2" :: "v"(ooff), "v"(z), "s"(obu + (size_t)(51) * orow) : "memory");
    }
#pragma unroll 1
    for (int n = 0; n < NCH; ++n) {
        f32x4 a1_0, a1_1, a1_2, a1_3;
        asm volatile("s_waitcnt vmcnt(44)" : "+v"(un0), "+v"(un1), "+v"(decv));
        a1_0 = (f32x4){bflo(un0.x), bfhi(un0.x), bflo(un0.y), bfhi(un0.y)}; a1_1 = (f32x4){bflo(un0.z), bfhi(un0.z), bflo(un0.w), bfhi(un0.w)};
        a1_2 = (f32x4){bflo(un1.x), bfhi(un1.x), bflo(un1.y), bfhi(un1.y)}; a1_3 = (f32x4){bflo(un1.z), bfhi(un1.z), bflo(un1.w), bfhi(un1.w)};
        const float dec = decv;
        { const unsigned char* ubn = ubp + (size_t)(n + 1 < NCH ? n + 1 : n) * 32768;
          asm volatile("global_load_dwordx4 %0, %1, %2" : "+v"(un0) : "v"(uoff), "s"(ubn) : "memory");
          asm volatile("global_load_dwordx4 %0, %1, %2 offset:16" : "+v"(un1) : "v"(uoff), "s"(ubn) : "memory");
          asm volatile("global_load_dword %0, %1, %2" : "+v"(decv) : "v"(zoff), "s"(decp + (n + 1 < NCH ? n + 1 : n)) : "memory"); }
        __builtin_amdgcn_sched_barrier(0);
        asm volatile("s_waitcnt vmcnt(46)" : "+v"(r0));
        a1_0 = mfma16(r0, Sp0, a1_0);
        asm volatile("global_load_dwordx4 %0, %1, %2" : "+v"(r0) : "v"(voff), "s"(spc) : "memory"); spc += 1024;
        __builtin_amdgcn_sched_barrier(0);
        asm volatile("s_waitcnt vmcnt(46)" : "+v"(r1));
        a1_0 = mfma16(r1, Sp1, a1_0);
        asm volatile("global_load_dwordx4 %0, %1, %2" : "+v"(r1) : "v"(voff), "s"(spc) : "memory"); spc += 1024;
        __builtin_amdgcn_sched_barrier(0);
        asm volatile("s_waitcnt vmcnt(46)" : "+v"(r2));
        a1_0 = mfma16(r2, Sp2, a1_0);
        asm volatile("global_load_dwordx4 %0, %1, %2" : "+v"(r2) : "v"(voff), "s"(spc) : "memory"); spc += 1024;
        __builtin_amdgcn_sched_barrier(0);
        asm volatile("s_waitcnt vmcnt(46)" : "+v"(r3));
        a1_0 = mfma16(r3, Sp3, a1_0);
        asm volatile("global_load_dwordx4 %0, %1, %2" : "+v"(r3) : "v"(voff), "s"(spc) : "memory"); spc += 1024;
        __builtin_amdgcn_sched_barrier(0);
        asm volatile("s_waitcnt vmcnt(46)" : "+v"(r4));
        a1_1 = mfma16(r4, Sp0, a1_1);
        asm volatile("global_load_dwordx4 %0, %1, %2" : "+v"(r4) : "v"(voff), "s"(spc) : "memory"); spc += 1024;
        __builtin_amdgcn_sched_barrier(0);
        asm volatile("s_waitcnt vmcnt(46)" : "+v"(r5));
        a1_1 = mfma16(r5, Sp1, a1_1);
        asm volatile("global_load_dwordx4 %0, %1, %2" : "+v"(r5) : "v"(voff), "s"(spc) : "memory"); spc += 1024;
        __builtin_amdgcn_sched_barrier(0);
        asm volatile("s_waitcnt vmcnt(46)" : "+v"(r6));
        a1_1 = mfma16(r6, Sp2, a1_1);
        asm volatile("global_load_dwordx4 %0, %1, %2" : "+v"(r6) : "v"(voff), "s"(spc) : "memory"); spc += 1024;
        __builtin_amdgcn_sched_barrier(0);
        asm volatile("s_waitcnt vmcnt(46)" : "+v"(r7));
        a1_1 = mfma16(r7, Sp3, a1_1);
        asm volatile("global_load_dwordx4 %0, %1, %2" : "+v"(r7) : "v"(voff), "s"(spc) : "memory"); spc += 1024;
        __builtin_amdgcn_sched_barrier(0);
        asm volatile("s_waitcnt vmcnt(46)" : "+v"(r8));
        a1_2 = mfma16(r8, Sp0, a1_2);
        asm volatile("global_load_dwordx4 %0, %1, %2" : "+v"(r8) : "v"(voff), "s"(spc) : "memory"); spc += 1024;
        __builtin_amdgcn_sched_barrier(0);
        asm volatile("s_waitcnt vmcnt(46)" : "+v"(r9));
        a1_2 = mfma16(r9, Sp1, a1_2);
        asm volatile("global_load_dwordx4 %0, %1, %2" : "+v"(r9) : "v"(voff), "s"(spc) : "memory"); spc += 1024;
        __builtin_amdgcn_sched_barrier(0);
        asm volatile("s_waitcnt vmcnt(46)" : "+v"(r10));
        a1_2 = mfma16(r10, Sp2, a1_2);
        asm volatile("global_load_dwordx4 %0, %1, %2" : "+v"(r10) : "v"(voff), "s"(spc) : "memory"); spc += 1024;
        __builtin_amdgcn_sched_barrier(0);
        asm volatile("s_waitcnt vmcnt(46)" : "+v"(r11));
        a1_2 = mfma16(r11, Sp3, a1_2);
        asm volatile("global_load_dwordx4 %0, %1, %2" : "+v"(r11) : "v"(voff), "s"(spc) : "memory"); spc += 1024;
        __builtin_amdgcn_sched_barrier(0);
        asm volatile("s_waitcnt vmcnt(30)" : "+v"(r12));
        a1_3 = mfma16(r12, Sp0, a1_3);
        asm volatile("global_load_dwordx4 %0, %1, %2" : "+v"(r12) : "v"(voff), "s"(spc) : "memory"); spc += 1024;
        __builtin_amdgcn_sched_barrier(0);
        asm volatile("s_waitcnt vmcnt(30)" : "+v"(r13));
        a1_3 = mfma16(r13, Sp1, a1_3);
        asm volatile("global_load_dwordx4 %0, %1, %2" : "+v"(r13) : "v"(voff), "s"(spc) : "memory"); spc += 1024;
        __builtin_amdgcn_sched_barrier(0);
        asm volatile("s_waitcnt vmcnt(30)" : "+v"(r14));
        a1_3 = mfma16(r14, Sp2, a1_3);
        asm volatile("global_load_dwordx4 %0, %1, %2" : "+v"(r14) : "v"(voff), "s"(spc) : "memory"); spc += 1024;
        __builtin_amdgcn_sched_barrier(0);
        asm volatile("s_waitcnt vmcnt(30)" : "+v"(r15));
        a1_3 = mfma16(r15, Sp3, a1_3);
        asm volatile("global_load_dwordx4 %0, %1, %2" : "+v"(r15) : "v"(voff), "s"(spc) : "memory"); spc += 1024;
        __builtin_amdgcn_sched_barrier(0);
        bf16x8 vp0, vp1;
        { u32x4 w; w.x = cvt_pk_bf16(a1_0[0], a1_0[1]); w.y = cvt_pk_bf16(a1_0[2], a1_0[3]); w.z = cvt_pk_bf16(a1_1[0], a1_1[1]); w.w = cvt_pk_bf16(a1_1[2], a1_1[3]); vp0 = __builtin_bit_cast(bf16x8, w); }
        { u32x4 w; w.x = cvt_pk_bf16(a1_2[0], a1_2[1]); w.y = cvt_pk_bf16(a1_2[2], a1_2[3]); w.z = cvt_pk_bf16(a1_3[0], a1_3[1]); w.w = cvt_pk_bf16(a1_3[2], a1_3[3]); vp1 = __builtin_bit_cast(bf16x8, w); }
        f32x4 o0 = {0.f, 0.f, 0.f, 0.f}, o1 = o0, o2 = o0, o3 = o0;
        asm volatile("s_waitcnt vmcnt(30)" : "+v"(r16));
        o0 = mfma16(r16, Sp0, o0);
        asm volatile("global_load_dwordx4 %0, %1, %2" : "+v"(r16) : "v"(voff), "s"(spc) : "memory"); spc += 1024;
        __builtin_amdgcn_sched_barrier(0);
        asm volatile("s_waitcnt vmcnt(30)" : "+v"(r17));
        o0 = mfma16(r17, Sp1, o0);
        asm volatile("global_load_dwordx4 %0, %1, %2" : "+v"(r17) : "v"(voff), "s"(spc) : "memory"); spc += 1024;
        __builtin_amdgcn_sched_barrier(0);
        asm volatile("s_waitcnt vmcnt(30)" : "+v"(r18));
        o0 = mfma16(r18, Sp2, o0);
        asm volatile("global_load_dwordx4 %0, %1, %2" : "+v"(r18) : "v"(voff), "s"(spc) : "memory"); spc += 1024;
        __builtin_amdgcn_sched_barrier(0);
        asm volatile("s_waitcnt vmcnt(30)" : "+v"(r19));
        o0 = mfma16(r19, Sp3, o0);
        asm volatile("global_load_dwordx4 %0, %1, %2" : "+v"(r19) : "v"(voff), "s"(spc) : "memory"); spc += 1024;
        __builtin_amdgcn_sched_barrier(0);
        asm volatile("s_waitcnt vmcnt(30)" : "+v"(r20));
        o1 = mfma16(r20, Sp0, o1);
        asm volatile("global_load_dwordx4 %0, %1, %2" : "+v"(r20) : "v"(voff), "s"(spc) : "memory"); spc += 1024;
        __builtin_amdgcn_sched_barrier(0);
        asm volatile("s_waitcnt vmcnt(30)" : "+v"(r21));
        o1 = mfma16(r21, Sp1, o1);
        asm volatile("global_load_dwordx4 %0, %1, %2" : "+v"(r21) : "v"(voff), "s"(spc) : "memory"); spc += 1024;
        __builtin_amdgcn_sched_barrier(0);
        asm volatile("s_waitcnt vmcnt(30)" : "+v"(r22));
        o1 = mfma16(r22, Sp2, o1);
        asm volatile("global_load_dwordx4 %0, %1, %2" : "+v"(r22) : "v"(voff), "s"(spc) : "memory"); spc += 1024;
        __builtin_amdgcn_sched_barrier(0);
        asm volatile("s_waitcnt vmcnt(30)" : "+v"(r23));
        o1 = mfma16(r23, Sp3, o1);
        asm volatile("global_load_dwordx4 %0, %1, %2" : "+v"(r23) : "v"(voff), "s"(spc) : "memory"); spc += 1024;
        __builtin_amdgcn_sched_barrier(0);
        asm volatile("s_waitcnt vmcnt(30)" : "+v"(r24));
        o2 = mfma16(r24, Sp0, o2);
        asm volatile("global_load_dwordx4 %0, %1, %2" : "+v"(r24) : "v"(voff), "s"(spc) : "memory"); spc += 1024;
        __builtin_amdgcn_sched_barrier(0);
        asm volatile("s_waitcnt vmcnt(30)" : "+v"(r25));
        o2 = mfma16(r25, Sp1, o2);
        asm volatile("global_load_dwordx4 %0, %1, %2" : "+v"(r25) : "v"(voff), "s"(spc) : "memory"); spc += 1024;
        __builtin_amdgcn_sched_barrier(0);
        asm volatile("s_waitcnt vmcnt(30)" : "+v"(r26));
        o2 = mfma16(r26, Sp2, o2);
        asm volatile("global_load_dwordx4 %0, %1, %2" : "+v"(r26) : "v"(voff), "s"(spc) : "memory"); spc += 1024;
        __builtin_amdgcn_sched_barrier(0);
        asm volatile("s_waitcnt vmcnt(30)" : "+v"(r27));
        o2 = mfma16(r27, Sp3, o2);
        asm volatile("global_load_dwordx4 %0, %1, %2" : "+v"(r27) : "v"(voff), "s"(spc) : "memory"); spc += 1024;
        __builtin_amdgcn_sched_barrier(0);
        asm volatile("s_waitcnt vmcnt(27)" : "+v"(r0));
        o3 = mfma16(r0, Sp0, o3);
        asm volatile("global_load_dwordx4 %0, %1, %2" : "+v"(r0) : "v"(voff), "s"(spc) : "memory"); spc += 1024;
        __builtin_amdgcn_sched_barrier(0);
        asm volatile("s_waitcnt vmcnt(27)" : "+v"(r1));
        o3 = mfma16(r1, Sp1, o3);
        asm volatile("global_load_dwordx4 %0, %1, %2" : "+v"(r1) : "v"(voff), "s"(spc) : "memory"); spc += 1024;
        __builtin_amdgcn_sched_barrier(0);
        asm volatile("s_waitcnt vmcnt(27)" : "+v"(r2));
        o3 = mfma16(r2, Sp2, o3);
        asm volatile("global_load_dwordx4 %0, %1, %2" : "+v"(r2) : "v"(voff), "s"(spc) : "memory"); spc += 1024;
        __builtin_amdgcn_sched_barrier(0);
        asm volatile("s_waitcnt vmcnt(27)" : "+v"(r3));
        o3 = mfma16(r3, Sp3, o3);
        asm volatile("global_load_dwordx4 %0, %1, %2" : "+v"(r3) : "v"(voff), "s"(spc) : "memory"); spc += 1024;
        __builtin_amdgcn_sched_barrier(0);
        asm volatile("s_waitcnt vmcnt(27)" : "+v"(r4));
        o0 = mfma16(r4, vp0, o0);
        asm volatile("global_load_dwordx4 %0, %1, %2" : "+v"(r4) : "v"(voff), "s"(spc) : "memory"); spc += 1024;
        __builtin_amdgcn_sched_barrier(0);
        asm volatile("s_waitcnt vmcnt(27)" : "+v"(r5));
        o0 = mfma16(r5, vp1, o0);
        asm volatile("global_load_dwordx4 %0, %1, %2" : "+v"(r5) : "v"(voff), "s"(spc) : "memory"); spc += 1024;
        __builtin_amdgcn_sched_barrier(0);
        asm volatile("s_waitcnt vmcnt(27)" : "+v"(r6));
        o1 = mfma16(r6, vp0, o1);
        asm volatile("global_load_dwordx4 %0, %1, %2" : "+v"(r6) : "v"(voff), "s"(spc) : "memory"); spc += 1024;
        __builtin_amdgcn_sched_barrier(0);
        asm volatile("s_waitcnt vmcnt(27)" : "+v"(r7));
        o1 = mfma16(r7, vp1, o1);
        asm volatile("global_load_dwordx4 %0, %1, %2" : "+v"(r7) : "v"(voff), "s"(spc) : "memory"); spc += 1024;
        __builtin_amdgcn_sched_barrier(0);
        asm volatile("s_waitcnt vmcnt(27)" : "+v"(r8));
        o2 = mfma16(r8, vp0, o2);
        asm volatile("global_load_dwordx4 %0, %1, %2" : "+v"(r8) : "v"(voff), "s"(spc) : "memory"); spc += 1024;
        __builtin_amdgcn_sched_barrier(0);
        asm volatile("s_waitcnt vmcnt(27)" : "+v"(r9));
        o2 = mfma16(r9, vp1, o2);
        asm volatile("global_load_dwordx4 %0, %1, %2" : "+v"(r9) : "v"(voff), "s"(spc) : "memory"); spc += 1024;
        __builtin_amdgcn_sched_barrier(0);
        asm volatile("s_waitcnt vmcnt(27)" : "+v"(r10));
        o3 = mfma16(r10, vp0, o3);
        asm volatile("global_load_dwordx4 %0, %1, %2" : "+v"(r10) : "v"(voff), "s"(spc) : "memory"); spc += 1024;
        __builtin_amdgcn_sched_barrier(0);
        asm volatile("s_waitcnt vmcnt(27)" : "+v"(r11));
        o3 = mfma16(r11, vp1, o3);
        asm volatile("global_load_dwordx4 %0, %1, %2" : "+v"(r11) : "v"(voff), "s"(spc) : "memory"); spc += 1024;
        __builtin_amdgcn_sched_barrier(0);
        { const unsigned char* obn = obu + (size_t)n * 64 * orow;
          { const unsigned v = f2bf(o0[0]); asm volatile("global_store_short %0, %1, %2" :: "v"(ooff), "v"(v), "s"(obn + (size_t)(0) * orow) : "memory"); }
          { const unsigned v = f2bf(o0[1]); asm volatile("global_store_short %0, %1, %2" :: "v"(ooff), "v"(v), "s"(obn + (size_t)(1) * orow) : "memory"); }
          { const unsigned v = f2bf(o0[2]); asm volatile("global_store_short %0, %1, %2" :: "v"(ooff), "v"(v), "s"(obn + (size_t)(2) * orow) : "memory"); }
          { const unsigned v = f2bf(o0[3]); asm volatile("global_store_short %0, %1, %2" :: "v"(ooff), "v"(v), "s"(obn + (size_t)(3) * orow) : "memory"); }
          { const unsigned v = f2bf(o1[0]); asm volatile("global_store_short %0, %1, %2" :: "v"(ooff), "v"(v), "s"(obn + (size_t)(16) * orow) : "memory"); }
          { const unsigned v = f2bf(o1[1]); asm volatile("global_store_short %0, %1, %2" :: "v"(ooff), "v"(v), "s"(obn + (size_t)(17) * orow) : "memory"); }
          { const unsigned v = f2bf(o1[2]); asm volatile("global_store_short %0, %1, %2" :: "v"(ooff), "v"(v), "s"(obn + (size_t)(18) * orow) : "memory"); }
          { const unsigned v = f2bf(o1[3]); asm volatile("global_store_short %0, %1, %2" :: "v"(ooff), "v"(v), "s"(obn + (size_t)(19) * orow) : "memory"); }
          { const unsigned v = f2bf(o2[0]); asm volatile("global_store_short %0, %1, %2" :: "v"(ooff), "v"(v), "s"(obn + (size_t)(32) * orow) : "memory"); }
          { const unsigned v = f2bf(o2[1]); asm volatile("global_store_short %0, %1, %2" :: "v"(ooff), "v"(v), "s"(obn + (size_t)(33) * orow) : "memory"); }
          { const unsigned v = f2bf(o2[2]); asm volatile("global_store_short %0, %1, %2" :: "v"(ooff), "v"(v), "s"(obn + (size_t)(34) * orow) : "memory"); }
          { const unsigned v = f2bf(o2[3]); asm volatile("global_store_short %0, %1, %2" :: "v"(ooff), "v"(v), "s"(obn + (size_t)(35) * orow) : "memory"); }
          { const unsigned v = f2bf(o3[0]); asm volatile("global_store_short %0, %1, %2" :: "v"(ooff), "v"(v), "s"(obn + (size_t)(48) * orow) : "memory"); }
          { const unsigned v = f2bf(o3[1]); asm volatile("global_store_short %0, %1, %2" :: "v"(ooff), "v"(v), "s"(obn + (size_t)(49) * orow) : "memory"); }
          { const unsigned v = f2bf(o3[2]); asm volatile("global_store_short %0, %1, %2" :: "v"(ooff), "v"(v), "s"(obn + (size_t)(50) * orow) : "memory"); }
          { const unsigned v = f2bf(o3[3]); asm volatile("global_store_short %0, %1, %2" :: "v"(ooff), "v"(v), "s"(obn + (size_t)(51) * orow) : "memory"); }
        }
        __builtin_amdgcn_sched_barrier(0);
        S0 = S0 * dec;
        asm volatile("s_waitcnt vmcnt(43)" : "+v"(r12));
        S0 = mfma16(r12, vp0, S0);
        asm volatile("global_load_dwordx4 %0, %1, %2" : "+v"(r12) : "v"(voff), "s"(spc) : "memory"); spc += 1024;
        __builtin_amdgcn_sched_barrier(0);
        asm volatile("s_waitcnt vmcnt(43)" : "+v"(r13));
        S0 = mfma16(r13, vp1, S0);
        asm volatile("global_load_dwordx4 %0, %1, %2" : "+v"(r13) : "v"(voff), "s"(spc) : "memory"); spc += 1024;
        __builtin_amdgcn_sched_barrier(0);
        S1 = S1 * dec;
        asm volatile("s_waitcnt vmcnt(43)" : "+v"(r14));
        S1 = mfma16(r14, vp0, S1);
        asm volatile("global_load_dwordx4 %0, %1, %2" : "+v"(r14) : "v"(voff), "s"(spc) : "memory"); spc += 1024;
        __builtin_amdgcn_sched_barrier(0);
        asm volatile("s_waitcnt vmcnt(43)" : "+v"(r15));
        S1 = mfma16(r15, vp1, S1);
        asm volatile("global_load_dwordx4 %0, %1, %2" : "+v"(r15) : "v"(voff), "s"(spc) : "memory"); spc += 1024;
        __builtin_amdgcn_sched_barrier(0);
        S2 = S2 * dec;
        asm volatile("s_waitcnt vmcnt(43)" : "+v"(r16));
        S2 = mfma16(r16, vp0, S2);
        asm volatile("global_load_dwordx4 %0, %1, %2" : "+v"(r16) : "v"(voff), "s"(spc) : "memory"); spc += 1024;
        __builtin_amdgcn_sched_barrier(0);
        asm volatile("s_waitcnt vmcnt(43)" : "+v"(r17));
        S2 = mfma16(r17, vp1, S2);
        asm volatile("global_load_dwordx4 %0, %1, %2" : "+v"(r17) : "v"(voff), "s"(spc) : "memory"); spc += 1024;
        __builtin_amdgcn_sched_barrier(0);
        S3 = S3 * dec;
        asm volatile("s_waitcnt vmcnt(43)" : "+v"(r18));
        S3 = mfma16(r18, vp0, S3);
        asm volatile("global_load_dwordx4 %0, %1, %2" : "+v"(r18) : "v"(voff), "s"(spc) : "memory"); spc += 1024;
        __builtin_amdgcn_sched_barrier(0);
        asm volatile("s_waitcnt vmcnt(43)" : "+v"(r19));
        S3 = mfma16(r19, vp1, S3);
        asm volatile("global_load_dwordx4 %0, %1, %2" : "+v"(r19) : "v"(voff), "s"(spc) : "memory"); spc += 1024;
        __builtin_amdgcn_sched_barrier(0);
        S4 = S4 * dec;
        asm volatile("s_waitcnt vmcnt(43)" : "+v"(r20));
        S4 = mfma16(r20, vp0, S4);
        asm volatile("global_load_dwordx4 %0, %1, %2" : "+v"(r20) : "v"(voff), "s"(spc) : "memory"); spc += 1024;
        __builtin_amdgcn_sched_barrier(0);
        asm volatile("s_waitcnt vmcnt(43)" : "+v"(r21));
        S4 = mfma16(r21, vp1, S4);
        asm volatile("global_load_dwordx4 %0, %1, %2" : "+v"(r21) : "v"(voff), "s"(spc) : "memory"); spc += 1024;
        __builtin_amdgcn_sched_barrier(0);
        S5 = S5 * dec;
        asm volatile("s_waitcnt vmcnt(43)" : "+v"(r22));
        S5 = mfma16(r22, vp0, S5);
        asm volatile("global_load_dwordx4 %0, %1, %2" : "+v"(r22) : "v"(voff), "s"(spc) : "memory"); spc += 1024;
        __builtin_amdgcn_sched_barrier(0);
        asm volatile("s_waitcnt vmcnt(43)" : "+v"(r23));
        S5 = mfma16(r23, vp1, S5);
        asm volatile("global_load_dwordx4 %0, %1, %2" : "+v"(r23) : "v"(voff), "s"(spc) : "memory"); spc += 1024;
        __builtin_amdgcn_sched_barrier(0);
        S6 = S6 * dec;
        asm volatile("s_waitcnt vmcnt(43)" : "+v"(r24));
        S6 = mfma16(r24, vp0, S6);
        asm volatile("global_load_dwordx4 %0, %1, %2" : "+v"(r24) : "v"(voff), "s"(spc) : "memory"); spc += 1024;
        __builtin_amdgcn_sched_barrier(0);
        asm volatile("s_waitcnt vmcnt(43)" : "+v"(r25));
        S6 = mfma16(r25, vp1, S6);
        asm volatile("global_load_dwordx4 %0, %1, %2" : "+v"(r25) : "v"(voff), "s"(spc) : "memory"); spc += 1024;
        __builtin_amdgcn_sched_barrier(0);
        S7 = S7 * dec;
        asm volatile("s_waitcnt vmcnt(43)" : "+v"(r26));
        S7 = mfma16(r26, vp0, S7);
        asm volatile("global_load_dwordx4 %0, %1, %2" : "+v"(r26) : "v"(voff), "s"(spc) : "memory"); spc += 1024;
        __builtin_amdgcn_sched_barrier(0);
        asm volatile("s_waitcnt vmcnt(43)" : "+v"(r27));
        S7 = mfma16(r27, vp1, S7);
        asm volatile("global_load_dwordx4 %0, %1, %2" : "+v"(r27) : "v"(voff), "s"(spc) : "memory"); spc += 1024;
        __builtin_amdgcn_sched_barrier(0);
        { u32x4 w; w.x = cvt_pk_bf16(S0[0], S0[1]); w.y = cvt_pk_bf16(S0[2], S0[3]); w.z = cvt_pk_bf16(S1[0], S1[1]); w.w = cvt_pk_bf16(S1[2], S1[3]); Sp0 = __builtin_bit_cast(bf16x8, w); }
        { u32x4 w; w.x = cvt_pk_bf16(S2[0], S2[1]); w.y = cvt_pk_bf16(S2[2], S2[3]); w.z = cvt_pk_bf16(S3[0], S3[1]); w.w = cvt_pk_bf16(S3[2], S3[3]); Sp1 = __builtin_bit_cast(bf16x8, w); }
        { u32x4 w; w.x = cvt_pk_bf16(S4[0], S4[1]); w.y = cvt_pk_bf16(S4[2], S4[3]); w.z = cvt_pk_bf16(S5[0], S5[1]); w.w = cvt_pk_bf16(S5[2], S5[3]); Sp2 = __builtin_bit_cast(bf16x8, w); }
        { u32x4 w; w.x = cvt_pk_bf16(S6[0], S6[1]); w.y = cvt_pk_bf16(S6[2], S6[3]); w.z = cvt_pk_bf16(S7[0], S7[1]); w.w = cvt_pk_bf16(S7[2], S7[3]); Sp3 = __builtin_bit_cast(bf16x8, w); }
    }
    asm volatile("s_waitcnt vmcnt(0)" ::: "memory");
    } else {
    bf16x8 r0 = (bf16x8){0, 0, 0, 0, 0, 0, 0, 0};
    bf16x8 r1 = (bf16x8){0, 0, 0, 0, 0, 0, 0, 0};
    bf16x8 r2 = (bf16x8){0, 0, 0, 0, 0, 0, 0, 0};
    bf16x8 r3 = (bf16x8){0, 0, 0, 0, 0, 0, 0, 0};
    bf16x8 r4 = (bf16x8){0, 0, 0, 0, 0, 0, 0, 0};
    bf16x8 r5 = (bf16x8){0, 0, 0, 0, 0, 0, 0, 0};
    bf16x8 r6 = (bf16x8){0, 0, 0, 0, 0, 0, 0, 0};
    bf16x8 r7 = (bf16x8){0, 0, 0, 0, 0, 0, 0, 0};
    bf16x8 r8 = (bf16x8){0, 0, 0, 0, 0, 0, 0, 0};
    bf16x8 r9 = (bf16x8){0, 0, 0, 0, 0, 0, 0, 0};
    bf16x8 r10 = (bf16x8){0, 0, 0, 0, 0, 0, 0, 0};
    bf16x8 r11 = (bf16x8){0, 0, 0, 0, 0, 0, 0, 0};
    bf16x8 r12 = (bf16x8){0, 0, 0, 0, 0, 0, 0, 0};
    bf16x8 r13 = (bf16x8){0, 0, 0, 0, 0, 0, 0, 0};
    bf16x8 r14 = (bf16x8){0, 0, 0, 0, 0, 0, 0, 0};
    bf16x8 r15 = (bf16x8){0, 0, 0, 0, 0, 0, 0, 0};
    bf16x8 r16 = (bf16x8){0, 0, 0, 0, 0, 0, 0, 0};
    bf16x8 r17 = (bf16x8){0, 0, 0, 0, 0, 0, 0, 0};
    bf16x8 r18 = (bf16x8){0, 0, 0, 0, 0, 0, 0, 0};
    bf16x8 r19 = (bf16x8){0, 0, 0, 0, 0, 0, 0, 0};
    unsigned vn0 = 0u; asm volatile("global_load_ushort %0, %1, %2" : "+v"(vn0) : "v"(ooff), "s"(obu + (size_t)(0) * orow) : "memory");
    unsigned vn1 = 0u; asm volatile("global_load_ushort %0, %1, %2" : "+v"(vn1) : "v"(ooff), "s"(obu + (size_t)(1) * orow) : "memory");
    unsigned vn2 = 0u; asm volatile("global_load_ushort %0, %1, %2" : "+v"(vn2) : "v"(ooff), "s"(obu + (size_t)(2) * orow) : "memory");
    unsigned vn3 = 0u; asm volatile("global_load_ushort %0, %1, %2" : "+v"(vn3) : "v"(ooff), "s"(obu + (size_t)(3) * orow) : "memory");
    unsigned vn4 = 0u; asm volatile("global_load_ushort %0, %1, %2" : "+v"(vn4) : "v"(ooff), "s"(obu + (size_t)(16) * orow) : "memory");
    unsigned vn5 = 0u; asm volatile("global_load_ushort %0, %1, %2" : "+v"(vn5) : "v"(ooff), "s"(obu + (size_t)(17) * orow) : "memory");
    unsigned vn6 = 0u; asm volatile("global_load_ushort %0, %1, %2" : "+v"(vn6) : "v"(ooff), "s"(obu + (size_t)(18) * orow) : "memory");
    unsigned vn7 = 0u; asm volatile("global_load_ushort %0, %1, %2" : "+v"(vn7) : "v"(ooff), "s"(obu + (size_t)(19) * orow) : "memory");
    unsigned vn8 = 0u; asm volatile("global_load_ushort %0, %1, %2" : "+v"(vn8) : "v"(ooff), "s"(obu + (size_t)(32) * orow) : "memory");
    unsigned vn9 = 0u; asm volatile("global_load_ushort %0, %1, %2" : "+v"(vn9) : "v"(ooff), "s"(obu + (size_t)(33) * orow) : "memory");
    unsigned vn10 = 0u; asm volatile("global_load_ushort %0, %1, %2" : "+v"(vn10) : "v"(ooff), "s"(obu + (size_t)(34) * orow) : "memory");
    unsigned vn11 = 0u; asm volatile("global_load_ushort %0, %1, %2" : "+v"(vn11) : "v"(ooff), "s"(obu + (size_t)(35) * orow) : "memory");
    unsigned vn12 = 0u; asm volatile("global_load_ushort %0, %1, %2" : "+v"(vn12) : "v"(ooff), "s"(obu + (size_t)(48) * orow) : "memory");
    unsigned vn13 = 0u; asm volatile("global_load_ushort %0, %1, %2" : "+v"(vn13) : "v"(ooff), "s"(obu + (size_t)(49) * orow) : "memory");
    unsigned vn14 = 0u; asm volatile("global_load_ushort %0, %1, %2" : "+v"(vn14) : "v"(ooff), "s"(obu + (size_t)(50) * orow) : "memory");
    unsigned vn15 = 0u; asm volatile("global_load_ushort %0, %1, %2" : "+v"(vn15) : "v"(ooff), "s"(obu + (size_t)(51) * orow) : "memory");
    const unsigned char* spc = sp0;
    asm volatile("global_load_dwordx4 %0, %1, %2" : "+v"(r0) : "v"(voff), "s"(spc) : "memory"); spc += 1024;
    asm volatile("global_load_dwordx4 %0, %1, %2" : "+v"(r1) : "v"(voff), "s"(spc) : "memory"); spc += 1024;
    asm volatile("global_load_dwordx4 %0, %1, %2" : "+v"(r2) : "v"(voff), "s"(spc) : "memory"); spc += 1024;
    asm volatile("global_load_dwordx4 %0, %1, %2" : "+v"(r3) : "v"(voff), "s"(spc) : "memory"); spc += 1024;
    asm volatile("global_load_dwordx4 %0, %1, %2" : "+v"(r4) : "v"(voff), "s"(spc) : "memory"); spc += 1024;
    asm volatile("global_load_dwordx4 %0, %1, %2" : "+v"(r5) : "v"(voff), "s"(spc) : "memory"); spc += 1024;
    asm volatile("global_load_dwordx4 %0, %1, %2" : "+v"(r6) : "v"(voff), "s"(spc) : "memory"); spc += 1024;
    asm volatile("global_load_dwordx4 %0, %1, %2" : "+v"(r7) : "v"(voff), "s"(spc) : "memory"); spc += 1024;
    asm volatile("global_load_dwordx4 %0, %1, %2" : "+v"(r8) : "v"(voff), "s"(spc) : "memory"); spc += 1024;
    asm volatile("global_load_dwordx4 %0, %1, %2" : "+v"(r9) : "v"(voff), "s"(spc) : "memory"); spc += 1024;
    asm volatile("global_load_dwordx4 %0, %1, %2" : "+v"(r10) : "v"(voff), "s"(spc) : "memory"); spc += 1024;
    asm volatile("global_load_dwordx4 %0, %1, %2" : "+v"(r11) : "v"(voff), "s"(spc) : "memory"); spc += 1024;
    asm volatile("global_load_dwordx4 %0, %1, %2" : "+v"(r12) : "v"(voff), "s"(spc) : "memory"); spc += 1024;
    asm volatile("global_load_dwordx4 %0, %1, %2" : "+v"(r13) : "v"(voff), "s"(spc) : "memory"); spc += 1024;
    asm volatile("global_load_dwordx4 %0, %1, %2" : "+v"(r14) : "v"(voff), "s"(spc) : "memory"); spc += 1024;
    asm volatile("global_load_dwordx4 %0, %1, %2" : "+v"(r15) : "v"(voff), "s"(spc) : "memory"); spc += 1024;
    asm volatile("global_load_dwordx4 %0, %1, %2" : "+v"(r16) : "v"(voff), "s"(spc) : "memory"); spc += 1024;
    asm volatile("global_load_dwordx4 %0, %1, %2" : "+v"(r17) : "v"(voff), "s"(spc) : "memory"); spc += 1024;
    asm volatile("global_load_dwordx4 %0, %1, %2" : "+v"(r18) : "v"(voff), "s"(spc) : "memory"); spc += 1024;
    asm volatile("global_load_dwordx4 %0, %1, %2" : "+v"(r19) : "v"(voff), "s"(spc) : "memory"); spc += 1024;
    { unsigned z = 0u;
      asm volatile("global_store_short %0, %1, %2" :: "v"(ooff), "v"(z), "s"(obu + (size_t)(0) * orow) : "memory");
      asm volatile("global_store_short %0, %1, %2" :: "v"(ooff), "v"(z), "s"(obu + (size_t)(1) * orow) : "memory");
      asm volatile("global_store_short %0, %1, %2" :: "v"(ooff), "v"(z), "s"(obu + (size_t)(2) * orow) : "memory");
      asm volatile("global_store_short %0, %1, %2" :: "v"(ooff), "v"(z), "s"(obu + (size_t)(3) * orow) : "memory");
      asm volatile("global_store_short %0, %1, %2" :: "v"(ooff), "v"(z), "s"(obu + (size_t)(16) * orow) : "memory");
      asm volatile("global_store_short %0, %1, %2" :: "v"(ooff), "v"(z), "s"(obu + (size_t)(17) * orow) : "memory");
      asm volatile("global_store_short %0, %1, %2" :: "v"(ooff), "v"(z), "s"(obu + (size_t)(18) * orow) : "memory");
      asm volatile("global_store_short %0, %1, %2" :: "v"(ooff), "v"(z), "s"(obu + (size_t)(19) * orow) : "memory");
      asm volatile("global_store_short %0, %1, %2" :: "v"(ooff), "v"(z), "s"(obu + (size_t)(32) * orow) : "memory");
      asm volatile("global_store_short %0, %1, %2" :: "v"(ooff), "v"(z), "s"(obu + (size_t)(33) * orow) : "memory");
      asm volatile("global_store_short %0, %1, %2" :: "v"(ooff), "v"(z), "s"(obu + (size_t)(34) * orow) : "memory");
      asm volatile("global_store_short %0, %1, %2" :: "v"(ooff), "v"(z), "s"(obu + (size_t)(35) * orow) : "memory");
      asm volatile("global_store_short %0, %1, %2" :: "v"(ooff), "v"(z), "s"(obu + (size_t)(48) * orow) : "memory");
      asm volatile("global_store_short %0, %1, %2" :: "v"(ooff), "v"(z), "s"(obu + (size_t)(49) * orow) : "memory");
      asm volatile("global_store_short %0, %1, %2" :: "v"(ooff), "v"(z), "s"(obu + (size_t)(50) * orow) : "memory");
      asm volatile("global_store_short %0, %1, %2" :: "v"(ooff), "v"(z), "s"(obu + (size_t)(51) * orow) : "memory");
    }
#pragma unroll 1
    for (int n = 0; n < NCH; ++n) {
        f32x4 a1_0, a1_1, a1_2, a1_3;
        asm volatile("s_waitcnt vmcnt(36)" : "+v"(vn0), "+v"(vn1), "+v"(vn2), "+v"(vn3), "+v"(vn4), "+v"(vn5), "+v"(vn6), "+v"(vn7), "+v"(vn8), "+v"(vn9), "+v"(vn10), "+v"(vn11), "+v"(vn12), "+v"(vn13), "+v"(vn14), "+v"(vn15));
        a1_0 = (f32x4){__builtin_bit_cast(float, vn0 << 16), __builtin_bit_cast(float, vn1 << 16), __builtin_bit_cast(float, vn2 << 16), __builtin_bit_cast(float, vn3 << 16)};
        a1_1 = (f32x4){__builtin_bit_cast(float, vn4 << 16), __builtin_bit_cast(float, vn5 << 16), __builtin_bit_cast(float, vn6 << 16), __builtin_bit_cast(float, vn7 << 16)};
        a1_2 = (f32x4){__builtin_bit_cast(float, vn8 << 16), __builtin_bit_cast(float, vn9 << 16), __builtin_bit_cast(float, vn10 << 16), __builtin_bit_cast(float, vn11 << 16)};
        a1_3 = (f32x4){__builtin_bit_cast(float, vn12 << 16), __builtin_bit_cast(float, vn13 << 16), __builtin_bit_cast(float, vn14 << 16), __builtin_bit_cast(float, vn15 << 16)};
        const float dec = decr;
        { const unsigned char* obn = obu + (size_t)(n + 1 < NCH ? n + 1 : n) * 64 * orow;
          asm volatile("global_load_ushort %0, %1, %2" : "+v"(vn0) : "v"(ooff), "s"(obn + (size_t)(0) * orow) : "memory");
          asm volatile("global_load_ushort %0, %1, %2" : "+v"(vn1) : "v"(ooff), "s"(obn + (size_t)(1) * orow) : "memory");
          asm volatile("global_load_ushort %0, %1, %2" : "+v"(vn2) : "v"(ooff), "s"(obn + (size_t)(2) * orow) : "memory");
          asm volatile("global_load_ushort %0, %1, %2" : "+v"(vn3) : "v"(ooff), "s"(obn + (size_t)(3) * orow) : "memory");
          asm volatile("global_load_ushort %0, %1, %2" : "+v"(vn4) : "v"(ooff), "s"(obn + (size_t)(16) * orow) : "memory");
          asm volatile("global_load_ushort %0, %1, %2" : "+v"(vn5) : "v"(ooff), "s"(obn + (size_t)(17) * orow) : "memory");
          asm volatile("global_load_ushort %0, %1, %2" : "+v"(vn6) : "v"(ooff), "s"(obn + (size_t)(18) * orow) : "memory");
          asm volatile("global_load_ushort %0, %1, %2" : "+v"(vn7) : "v"(ooff), "s"(obn + (size_t)(19) * orow) : "memory");
          asm volatile("global_load_ushort %0, %1, %2" : "+v"(vn8) : "v"(ooff), "s"(obn + (size_t)(32) * orow) : "memory");
          asm volatile("global_load_ushort %0, %1, %2" : "+v"(vn9) : "v"(ooff), "s"(obn + (size_t)(33) * orow) : "memory");
          asm volatile("global_load_ushort %0, %1, %2" : "+v"(vn10) : "v"(ooff), "s"(obn + (size_t)(34) * orow) : "memory");
          asm volatile("global_load_ushort %0, %1, %2" : "+v"(vn11) : "v"(ooff), "s"(obn + (size_t)(35) * orow) : "memory");
          asm volatile("global_load_ushort %0, %1, %2" : "+v"(vn12) : "v"(ooff), "s"(obn + (size_t)(48) * orow) : "memory");
          asm volatile("global_load_ushort %0, %1, %2" : "+v"(vn13) : "v"(ooff), "s"(obn + (size_t)(49) * orow) : "memory");
          asm volatile("global_load_ushort %0, %1, %2" : "+v"(vn14) : "v"(ooff), "s"(obn + (size_t)(50) * orow) : "memory");
          asm volatile("global_load_ushort %0, %1, %2" : "+v"(vn15) : "v"(ooff), "s"(obn + (size_t)(51) * orow) : "memory");
        }
        __builtin_amdgcn_sched_barrier(0);
        bf16x8 vp0, vp1;
        { u32x4 w; w.x = cvt_pk_bf16(a1_0[0], a1_0[1]); w.y = cvt_pk_bf16(a1_0[2], a1_0[3]); w.z = cvt_pk_bf16(a1_1[0], a1_1[1]); w.w = cvt_pk_bf16(a1_1[2], a1_1[3]); vp0 = __builtin_bit_cast(bf16x8, w); }
        { u32x4 w; w.x = cvt_pk_bf16(a1_2[0], a1_2[1]); w.y = cvt_pk_bf16(a1_2[2], a1_2[3]); w.z = cvt_pk_bf16(a1_3[0], a1_3[1]); w.w = cvt_pk_bf16(a1_3[2], a1_3[3]); vp1 = __builtin_bit_cast(bf16x8, w); }
        f32x4 o0 = {0.f, 0.f, 0.f, 0.f}, o1 = o0, o2 = o0, o3 = o0;
        asm volatile("s_waitcnt vmcnt(51)" : "+v"(r0));
        o0 = mfma16(r0, Sp0, o0);
        asm volatile("global_load_dwordx4 %0, %1, %2" : "+v"(r0) : "v"(voff), "s"(spc) : "memory"); spc += 1024;
        __builtin_amdgcn_sched_barrier(0);
        asm volatile("s_waitcnt vmcnt(51)" : "+v"(r1));
        o0 = mfma16(r1, Sp1, o0);
        asm volatile("global_load_dwordx4 %0, %1, %2" : "+v"(r1) : "v"(voff), "s"(spc) : "memory"); spc += 1024;
        __builtin_amdgcn_sched_barrier(0);
        asm volatile("s_waitcnt vmcnt(51)" : "+v"(r2));
        o0 = mfma16(r2, Sp2, o0);
        asm volatile("global_load_dwordx4 %0, %1, %2" : "+v"(r2) : "v"(voff), "s"(spc) : "memory"); spc += 1024;
        __builtin_amdgcn_sched_barrier(0);
        asm volatile("s_waitcnt vmcnt(51)" : "+v"(r3));
        o0 = mfma16(r3, Sp3, o0);
        asm volatile("global_load_dwordx4 %0, %1, %2" : "+v"(r3) : "v"(voff), "s"(spc) : "memory"); spc += 1024;
        __builtin_amdgcn_sched_barrier(0);
        asm volatile("s_waitcnt vmcnt(35)" : "+v"(r4));
        o1 = mfma16(r4, Sp0, o1);
        asm volatile("global_load_dwordx4 %0, %1, %2" : "+v"(r4) : "v"(voff), "s"(spc) : "memory"); spc += 1024;
        __builtin_amdgcn_sched_barrier(0);
        asm volatile("s_waitcnt vmcnt(35)" : "+v"(r5));
        o1 = mfma16(r5, Sp1, o1);
        asm volatile("global_load_dwordx4 %0, %1, %2" : "+v"(r5) : "v"(voff), "s"(spc) : "memory"); spc += 1024;
        __builtin_amdgcn_sched_barrier(0);
        asm volatile("s_waitcnt vmcnt(35)" : "+v"(r6));
        o1 = mfma16(r6, Sp2, o1);
        asm volatile("global_load_dwordx4 %0, %1, %2" : "+v"(r6) : "v"(voff), "s"(spc) : "memory"); spc += 1024;
        __builtin_amdgcn_sched_barrier(0);
        asm volatile("s_waitcnt vmcnt(35)" : "+v"(r7));
        o1 = mfma16(r7, Sp3, o1);
        asm volatile("global_load_dwordx4 %0, %1, %2" : "+v"(r7) : "v"(voff), "s"(spc) : "memory"); spc += 1024;
        __builtin_amdgcn_sched_barrier(0);
        asm volatile("s_waitcnt vmcnt(35)" : "+v"(r8));
        o2 = mfma16(r8, Sp0, o2);
        asm volatile("global_load_dwordx4 %0, %1, %2" : "+v"(r8) : "v"(voff), "s"(spc) : "memory"); spc += 1024;
        __builtin_amdgcn_sched_barrier(0);
        asm volatile("s_waitcnt vmcnt(35)" : "+v"(r9));
        o2 = mfma16(r9, Sp1, o2);
        asm volatile("global_load_dwordx4 %0, %1, %2" : "+v"(r9) : "v"(voff), "s"(spc) : "memory"); spc += 1024;
        __builtin_amdgcn_sched_barrier(0);
        asm volatile("s_waitcnt vmcnt(35)" : "+v"(r10));
        o2 = mfma16(r10, Sp2, o2);
        asm volatile("global_load_dwordx4 %0, %1, %2" : "+v"(r10) : "v"(voff), "s"(spc) : "memory"); spc += 1024;
        __builtin_amdgcn_sched_barrier(0);
        asm volatile("s_waitcnt vmcnt(35)" : "+v"(r11));
        o2 = mfma16(r11, Sp3, o2);
        asm volatile("global_load_dwordx4 %0, %1, %2" : "+v"(r11) : "v"(voff), "s"(spc) : "memory"); spc += 1024;
        __builtin_amdgcn_sched_barrier(0);
        asm volatile("s_waitcnt vmcnt(35)" : "+v"(r12));
        o3 = mfma16(r12, Sp0, o3);
        asm volatile("global_load_dwordx4 %0, %1, %2" : "+v"(r12) : "v"(voff), "s"(spc) : "memory"); spc += 1024;
        __builtin_amdgcn_sched_barrier(0);
        asm volatile("s_waitcnt vmcnt(35)" : "+v"(r13));
        o3 = mfma16(r13, Sp1, o3);
        asm volatile("global_load_dwordx4 %0, %1, %2" : "+v"(r13) : "v"(voff), "s"(spc) : "memory"); spc += 1024;
        __builtin_amdgcn_sched_barrier(0);
        asm volatile("s_waitcnt vmcnt(35)" : "+v"(r14));
        o3 = mfma16(r14, Sp2, o3);
        asm volatile("global_load_dwordx4 %0, %1, %2" : "+v"(r14) : "v"(voff), "s"(spc) : "memory"); spc += 1024;
        __builtin_amdgcn_sched_barrier(0);
        asm volatile("s_waitcnt vmcnt(35)" : "+v"(r15));
        o3 = mfma16(r15, Sp3, o3);
        asm volatile("global_load_dwordx4 %0, %1, %2" : "+v"(r15) : "v"(voff), "s"(spc) : "memory"); spc += 1024;
        __builtin_amdgcn_sched_barrier(0);
        asm volatile("s_waitcnt vmcnt(35)" : "+v"(r16));
        o0 = mfma16(r16, vp0, o0);
        asm volatile("global_load_dwordx4 %0, %1, %2" : "+v"(r16) : "v"(voff), "s"(spc) : "memory"); spc += 1024;
        __builtin_amdgcn_sched_barrier(0);
        asm volatile("s_waitcnt vmcnt(35)" : "+v"(r17));
        o0 = mfma16(r17, vp1, o0);
        asm volatile("global_load_dwordx4 %0, %1, %2" : "+v"(r17) : "v"(voff), "s"(spc) : "memory"); spc += 1024;
        __builtin_amdgcn_sched_barrier(0);
        asm volatile("s_waitcnt vmcnt(35)" : "+v"(r18));
        o1 = mfma16(r18, vp0, o1);
        asm volatile("global_load_dwordx4 %0, %1, %2" : "+v"(r18) : "v"(voff), "s"(spc) : "memory"); spc += 1024;
        __builtin_amdgcn_sched_barrier(0);
        asm volatile("s_waitcnt vmcnt(35)" : "+v"(r19));
        o1 = mfma16(r19, vp1, o1);
        asm volatile("global_load_dwordx4 %0, %1, %2" : "+v"(r19) : "v"(voff), "s"(spc) : "memory"); spc += 1024;
        __builtin_amdgcn_sched_barrier(0);
        asm volatile("s_waitcnt vmcnt(19)" : "+v"(r0));
        o2 = mfma16(r0, vp0, o2);
        asm volatile("global_load_dwordx4 %0, %1, %2" : "+v"(r0) : "v"(voff), "s"(spc) : "memory"); spc += 1024;
        __builtin_amdgcn_sched_barrier(0);
        asm volatile("s_waitcnt vmcnt(19)" : "+v"(r1));
        o2 = mfma16(r1, vp1, o2);
        asm volatile("global_load_dwordx4 %0, %1, %2" : "+v"(r1) : "v"(voff), "s"(spc) : "memory"); spc += 1024;
        __builtin_amdgcn_sched_barrier(0);
        asm volatile("s_waitcnt vmcnt(19)" : "+v"(r2));
        o3 = mfma16(r2, vp0, o3);
        asm volatile("global_load_dwordx4 %0, %1, %2" : "+v"(r2) : "v"(voff), "s"(spc) : "memory"); spc += 1024;
        __builtin_amdgcn_sched_barrier(0);
        asm volatile("s_waitcnt vmcnt(19)" : "+v"(r3));
        o3 = mfma16(r3, vp1, o3);
        asm volatile("global_load_dwordx4 %0, %1, %2" : "+v"(r3) : "v"(voff), "s"(spc) : "memory"); spc += 1024;
        __builtin_amdgcn_sched_barrier(0);
        { const unsigned char* obn = obu + (size_t)n * 64 * orow;
          { const unsigned v = f2bf(o0[0]); asm volatile("global_store_short %0, %1, %2" :: "v"(ooff), "v"(v), "s"(obn + (size_t)(0) * orow) : "memory"); }
          { const unsigned v = f2bf(o0[1]); asm volatile("global_store_short %0, %1, %2" :: "v"(ooff), "v"(v), "s"(obn + (size_t)(1) * orow) : "memory"); }
          { const unsigned v = f2bf(o0[2]); asm volatile("global_store_short %0, %1, %2" :: "v"(ooff), "v"(v), "s"(obn + (size_t)(2) * orow) : "memory"); }
          { const unsigned v = f2bf(o0[3]); asm volatile("global_store_short %0, %1, %2" :: "v"(ooff), "v"(v), "s"(obn + (size_t)(3) * orow) : "memory"); }
          { const unsigned v = f2bf(o1[0]); asm volatile("global_store_short %0, %1, %2" :: "v"(ooff), "v"(v), "s"(obn + (size_t)(16) * orow) : "memory"); }
          { const unsigned v = f2bf(o1[1]); asm volatile("global_store_short %0, %1, %2" :: "v"(ooff), "v"(v), "s"(obn + (size_t)(17) * orow) : "memory"); }
          { const unsigned v = f2bf(o1[2]); asm volatile("global_store_short %0, %1, %2" :: "v"(ooff), "v"(v), "s"(obn + (size_t)(18) * orow) : "memory"); }
          { const unsigned v = f2bf(o1[3]); asm volatile("global_store_short %0, %1, %2" :: "v"(ooff), "v"(v), "s"(obn + (size_t)(19) * orow) : "memory"); }
          { const unsigned v = f2bf(o2[0]); asm volatile("global_store_short %0, %1, %2" :: "v"(ooff), "v"(v), "s"(obn + (size_t)(32) * orow) : "memory"); }
          { const unsigned v = f2bf(o2[1]); asm volatile("global_store_short %0, %1, %2" :: "v"(ooff), "v"(v), "s"(obn + (size_t)(33) * orow) : "memory"); }
          { const unsigned v = f2bf(o2[2]); asm volatile("global_store_short %0, %1, %2" :: "v"(ooff), "v"(v), "s"(obn + (size_t)(34) * orow) : "memory"); }
          { const unsigned v = f2bf(o2[3]); asm volatile("global_store_short %0, %1, %2" :: "v"(ooff), "v"(v), "s"(obn + (size_t)(35) * orow) : "memory"); }
          { const unsigned v = f2bf(o3[0]); asm volatile("global_store_short %0, %1, %2" :: "v"(ooff), "v"(v), "s"(obn + (size_t)(48) * orow) : "memory"); }
          { const unsigned v = f2bf(o3[1]); asm volatile("global_store_short %0, %1, %2" :: "v"(ooff), "v"(v), "s"(obn + (size_t)(49) * orow) : "memory"); }
          { const unsigned v = f2bf(o3[2]); asm volatile("global_store_short %0, %1, %2" :: "v"(ooff), "v"(v), "s"(obn + (size_t)(50) * orow) : "memory"); }
          { const unsigned v = f2bf(o3[3]); asm volatile("global_store_short %0, %1, %2" :: "v"(ooff), "v"(v), "s"(obn + (size_t)(51) * orow) : "memory"); }
        }
        __builtin_amdgcn_sched_barrier(0);
        S0 = S0 * dec;
        asm volatile("s_waitcnt vmcnt(35)" : "+v"(r4));
        S0 = mfma16(r4, vp0, S0);
        asm volatile("global_load_dwordx4 %0, %1, %2" : "+v"(r4) : "v"(voff), "s"(spc) : "memory"); spc += 1024;
        __builtin_amdgcn_sched_barrier(0);
        asm volatile("s_waitcnt vmcnt(35)" : "+v"(r5));
        S0 = mfma16(r5, vp1, S0);
        asm volatile("global_load_dwordx4 %0, %1, %2" : "+v"(r5) : "v"(voff), "s"(spc) : "memory"); spc += 1024;
        __builtin_amdgcn_sched_barrier(0);
        S1 = S1 * dec;
        asm volatile("s_waitcnt vmcnt(35)" : "+v"(r6));
        S1 = mfma16(r6, vp0, S1);
        asm volatile("global_load_dwordx4 %0, %1, %2" : "+v"(r6) : "v"(voff), "s"(spc) : "memory"); spc += 1024;
        __builtin_amdgcn_sched_barrier(0);
        asm volatile("s_waitcnt vmcnt(35)" : "+v"(r7));
        S1 = mfma16(r7, vp1, S1);
        asm volatile("global_load_dwordx4 %0, %1, %2" : "+v"(r7) : "v"(voff), "s"(spc) : "memory"); spc += 1024;
        __builtin_amdgcn_sched_barrier(0);
        S2 = S2 * dec;
        asm volatile("s_waitcnt vmcnt(35)" : "+v"(r8));
        S2 = mfma16(r8, vp0, S2);
        asm volatile("global_load_dwordx4 %0, %1, %2" : "+v"(r8) : "v"(voff), "s"(spc) : "memory"); spc += 1024;
        __builtin_amdgcn_sched_barrier(0);
        asm volatile("s_waitcnt vmcnt(35)" : "+v"(r9));
        S2 = mfma16(r9, vp1, S2);
        asm volatile("global_load_dwordx4 %0, %1, %2" : "+v"(r9) : "v"(voff), "s"(spc) : "memory"); spc += 1024;
        __builtin_amdgcn_sched_barrier(0);
        S3 = S3 * dec;
        asm volatile("s_waitcnt vmcnt(35)" : "+v"(r10));
        S3 = mfma16(r10, vp0, S3);
        asm volatile("global_load_dwordx4 %0, %1, %2" : "+v"(r10) : "v"(voff), "s"(spc) : "memory"); spc += 1024;
        __builtin_amdgcn_sched_barrier(0);
        asm volatile("s_waitcnt vmcnt(35)" : "+v"(r11));
        S3 = mfma16(r11, vp1, S3);
        asm volatile("global_load_dwordx4 %0, %1, %2" : "+v"(r11) : "v"(voff), "s"(spc) : "memory"); spc += 1024;
        __builtin_amdgcn_sched_barrier(0);
        S4 = S4 * dec;
        asm volatile("s_waitcnt vmcnt(35)" : "+v"(r12));
        S4 = mfma16(r12, vp0, S4);
        asm volatile("global_load_dwordx4 %0, %1, %2" : "+v"(r12) : "v"(voff), "s"(spc) : "memory"); spc += 1024;
        __builtin_amdgcn_sched_barrier(0);
        asm volatile("s_waitcnt vmcnt(35)" : "+v"(r13));
        S4 = mfma16(r13, vp1, S4);
        asm volatile("global_load_dwordx4 %0, %1, %2" : "+v"(r13) : "v"(voff), "s"(spc) : "memory"); spc += 1024;
        __builtin_amdgcn_sched_barrier(0);
        S5 = S5 * dec;
        asm volatile("s_waitcnt vmcnt(35)" : "+v"(r14));
        S5 = mfma16(r14, vp0, S5);
        asm volatile("global_load_dwordx4 %0, %1, %2" : "+v"(r14) : "v"(voff), "s"(spc) : "memory"); spc += 1024;
        __builtin_amdgcn_sched_barrier(0);
        asm volatile("s_waitcnt vmcnt(35)" : "+v"(r15));
        S5 = mfma16(r15, vp1, S5);
        asm volatile("global_load_dwordx4 %0, %1, %2" : "+v"(r15) : "v"(voff), "s"(spc) : "memory"); spc += 1024;
        __builtin_amdgcn_sched_barrier(0);
        S6 = S6 * dec;
        asm volatile("s_waitcnt vmcnt(35)" : "+v"(r16));
        S6 = mfma16(r16, vp0, S6);
        asm volatile("global_load_dwordx4 %0, %1, %2" : "+v"(r16) : "v"(voff), "s"(spc) : "memory"); spc += 1024;
        __builtin_amdgcn_sched_barrier(0);
        asm volatile("s_waitcnt vmcnt(35)" : "+v"(r17));
        S6 = mfma16(r17, vp1, S6);
        asm volatile("global_load_dwordx4 %0, %1, %2" : "+v"(r17) : "v"(voff), "s"(spc) : "memory"); spc += 1024;
        __builtin_amdgcn_sched_barrier(0);
        S7 = S7 * dec;
        asm volatile("s_waitcnt vmcnt(35)" : "+v"(r18));
        S7 = mfma16(r18, vp0, S7);
        asm volatile("global_load_dwordx4 %0, %1, %2" : "+v"(r18) : "v"(voff), "s"(spc) : "memory"); spc += 1024;
        __builtin_amdgcn_sched_barrier(0);
        asm volatile("s_waitcnt vmcnt(35)" : "+v"(r19));
        S7 = mfma16(r19, vp1, S7);
        asm volatile("global_load_dwordx4 %0, %1, %2" : "+v"(r19) : "v"(voff), "s"(spc) : "memory"); spc += 1024;
        __builtin_amdgcn_sched_barrier(0);
        { u32x4 w; w.x = cvt_pk_bf16(S0[0], S0[1]); w.y = cvt_pk_bf16(S0[2], S0[3]); w.z = cvt_pk_bf16(S1[0], S1[1]); w.w = cvt_pk_bf16(S1[2], S1[3]); Sp0 = __builtin_bit_cast(bf16x8, w); }
        { u32x4 w; w.x = cvt_pk_bf16(S2[0], S2[1]); w.y = cvt_pk_bf16(S2[2], S2[3]); w.z = cvt_pk_bf16(S3[0], S3[1]); w.w = cvt_pk_bf16(S3[2], S3[3]); Sp1 = __builtin_bit_cast(bf16x8, w); }
        { u32x4 w; w.x = cvt_pk_bf16(S4[0], S4[1]); w.y = cvt_pk_bf16(S4[2], S4[3]); w.z = cvt_pk_bf16(S5[0], S5[1]); w.w = cvt_pk_bf16(S5[2], S5[3]); Sp2 = __builtin_bit_cast(bf16x8, w); }
        { u32x4 w; w.x = cvt_pk_bf16(S6[0], S6[1]); w.y = cvt_pk_bf16(S6[2], S6[3]); w.z = cvt_pk_bf16(S7[0], S7[1]); w.w = cvt_pk_bf16(S7[2], S7[3]); Sp3 = __builtin_bit_cast(bf16x8, w); }
    }
    asm volatile("s_waitcnt vmcnt(0)" ::: "memory");
    }
}

DI void p4_mixnorm(Frame& F, const float* ret_norm, const float* gdn_norm) {
    bf16_t* pj = (bf16_t*)(F.ws + WS_BIG + BIG_PJ); const bf16_t* vc = (const bf16_t*)(F.ws + AUX_VC);
    const int lane = F.lane;
    const f32x4 gr = *(const f32x4*)(ret_norm + 4 * lane), gg = *(const f32x4*)(gdn_norm + 4 * lane);
    for (int m = F.gw; m < NTOK; m += F.NGW) {
        bf16_t* row = pj + (size_t)m * PJW;
#pragma unroll
        for (int hv = 0; hv < 16; ++hv) { const int hd = hv & 7; const bool gdn = hv >= 8;
            const u32x2 ro = gdn ? *(const u32x2*)(vc + (size_t)m * 2048 + hd * 256 + 4 * lane) : *(const u32x2*)(row + C_RV + hd * 256 + 4 * lane);
            bf16_t* gp = row + (gdn ? C_GZ : C_RG) + hd * 256 + 4 * lane; const u32x2 gt = *(const u32x2*)gp;
            const float o0 = bflo(ro.x), o1 = bfhi(ro.x), o2 = bflo(ro.y), o3 = bfhi(ro.y);
            const float rstd = 1.0f / sqrtf(wave_sum((o0 * o0 + o1 * o1) + (o2 * o2 + o3 * o3)) * (1.0f / 256.0f) + EPS);
            const f32x4 g = gdn ? gg : gr;
            u32x2 w; w.x = pk2(o0 * rstd * g.x * siluf(bflo(gt.x)), o1 * rstd * g.y * siluf(bfhi(gt.x))); w.y = pk2(o2 * rstd * g.z * siluf(bflo(gt.y)), o3 * rstd * g.w * siluf(bfhi(gt.y)));
            *(u32x2*)gp = w; }
    }
}

DI void p11_swaprep(Frame& F, const float* qnorm, const float* knorm) {
    bf16_t* qkv = (bf16_t*)(F.ws + WS_BIG + BIG_QKV1); const f32x2* cs = (const f32x2*)(F.ws + AUX_CS);
    const int lane = F.lane; const float gq = qnorm[lane], gk = knorm[lane];
    for (int m = F.gw; m < NTOK; m += F.NGW) {
        const int pos = m & (SEQ - 1); const f32x2 c = cs[pos * 64 + 2 * (lane & 31)];
        bf16_t* row = qkv + (size_t)m * ODD_IN;
#pragma unroll 4
        for (int hv = 0; hv < 36; ++hv) { bf16_t* p = row + hv * 64; const float x = bf2f(p[lane]);
            const float rstd = 1.0f / sqrtf(wave_sum(x * x) * (1.0f / 64.0f) + EPS); const float xn = x * rstd * (hv < 32 ? gq : gk);
            const float xo = __shfl_xor(xn, 32);
            const float r = lane < 32 ? xn * c.x - xo * c.y : xn * c.x + xo * c.y;
            p[lane] = (bf16_t)f2bf(r); }
    }
}
DI void p12_swa_naive(Frame& F, const float* sinks) {
    bf16_t* qkv = (bf16_t*)(F.ws + WS_BIG + BIG_QKV1);
    const long total = (long)NTOK * 32;
    for (long idx = (long)blockIdx.x * NTHR + F.tid; idx < total; idx += (long)F.G * NTHR) {
        const int hq = (int)(idx / NTOK), m = (int)(idx % NTOK), pos = m & (SEQ - 1), kvh = hq >> 3;
        bf16_t* qp = qkv + (size_t)m * ODD_IN + hq * 64;
        float q[64], o[64];
#pragma unroll
        for (int d8 = 0; d8 < 8; ++d8) { const u32x4 r = *(const u32x4*)(qp + 8 * d8); q[8 * d8] = bflo(r.x); q[8 * d8 + 1] = bfhi(r.x); q[8 * d8 + 2] = bflo(r.y); q[8 * d8 + 3] = bfhi(r.y); q[8 * d8 + 4] = bflo(r.z); q[8 * d8 + 5] = bfhi(r.z); q[8 * d8 + 6] = bflo(r.w); q[8 * d8 + 7] = bfhi(r.w); }
#pragma unroll
        for (int d = 0; d < 64; ++d) o[d] = 0.f;
        float mx = sinks[hq], l = 1.0f;
        const int j0 = pos >= 127 ? 127 : pos;
#pragma unroll 1
        for (int j = j0; j >= 0; --j) {
            const bf16_t* kp = qkv + (size_t)(m - j) * ODD_IN + 2048 + kvh * 64; const bf16_t* vp = kp + 256;
            float s = 0.f;
#pragma unroll
            for (int d8 = 0; d8 < 8; ++d8) { const u32x4 r = *(const u32x4*)(kp + 8 * d8);
                s += q[8 * d8] * bflo(r.x) + q[8 * d8 + 1] * bfhi(r.x) + q[8 * d8 + 2] * bflo(r.y) + q[8 * d8 + 3] * bfhi(r.y) + q[8 * d8 + 4] * bflo(r.z) + q[8 * d8 + 5] * bfhi(r.z) + q[8 * d8 + 6] * bflo(r.w) + q[8 * d8 + 7] * bfhi(r.w); }
            s *= 0.125f;
            const float mn = fmaxf(mx, s), cf = __expf(mx - mn), p = __expf(s - mn);
            l = l * cf + p; mx = mn;
#pragma unroll
            for (int d8 = 0; d8 < 8; ++d8) { const u32x4 r = *(const u32x4*)(vp + 8 * d8);
                o[8 * d8] = o[8 * d8] * cf + p * bflo(r.x); o[8 * d8 + 1] = o[8 * d8 + 1] * cf + p * bfhi(r.x); o[8 * d8 + 2] = o[8 * d8 + 2] * cf + p * bflo(r.y); o[8 * d8 + 3] = o[8 * d8 + 3] * cf + p * bfhi(r.y);
                o[8 * d8 + 4] = o[8 * d8 + 4] * cf + p * bflo(r.z); o[8 * d8 + 5] = o[8 * d8 + 5] * cf + p * bfhi(r.z); o[8 * d8 + 6] = o[8 * d8 + 6] * cf + p * bflo(r.w); o[8 * d8 + 7] = o[8 * d8 + 7] * cf + p * bfhi(r.w); }
        }
        const float il = 1.0f / l;
#pragma unroll
        for (int d8 = 0; d8 < 8; ++d8) { u32x4 w; w.x = pk2(o[8 * d8] * il, o[8 * d8 + 1] * il); w.y = pk2(o[8 * d8 + 2] * il, o[8 * d8 + 3] * il); w.z = pk2(o[8 * d8 + 4] * il, o[8 * d8 + 5] * il); w.w = pk2(o[8 * d8 + 6] * il, o[8 * d8 + 7] * il);
            *(u32x4*)(qp + 8 * d8) = w; }
    }
}

struct RouteHandler {
    unsigned* cnt; int* list; float* gw; unsigned* asg; int lane;
    DI void operator()(int m, float res) const {
        float p[36];
#pragma unroll
        for (int j = 0; j < 36; ++j) p[j] = rdlane(res, j);
        int g = 0; float gm = p[0];
#pragma unroll
        for (int j = 1; j < 4; ++j) if (p[j] > gm) { gm = p[j]; g = j; }
        float gs = 0.f;
#pragma unroll
        for (int j = 0; j < 4; ++j) gs += __expf(p[j] - gm);
        const float g_p = 1.0f / gs;
        float q[8];
#pragma unroll
        for (int i = 0; i < 8; ++i) q[i] = g == 0 ? p[4 + i] : (g == 1 ? p[12 + i] : (g == 2 ? p[20 + i] : p[28 + i]));
        int i0 = 0; float m0 = q[0];
#pragma unroll
        for (int i = 1; i < 8; ++i) if (q[i] > m0) { m0 = q[i]; i0 = i; }
        int i1 = -1; float m1 = -3.0e38f;
#pragma unroll
        for (int i = 0; i < 8; ++i) if (i != i0 && q[i] > m1) { m1 = q[i]; i1 = i; }
        const float e1 = __expf(m1 - m0), w0 = g_p / (1.0f + e1), w1 = g_p * e1 / (1.0f + e1);
        if (lane == 0) {
            const int ea = g * 8 + i0, eb = g * 8 + i1;
            const unsigned pa = __hip_atomic_fetch_add(cnt + ea, 1u, __ATOMIC_RELAXED, __HIP_MEMORY_SCOPE_AGENT), pb = __hip_atomic_fetch_add(cnt + eb, 1u, __ATOMIC_RELAXED, __HIP_MEMORY_SCOPE_AGENT);
            list[ea * 65536 + pa] = m; list[eb * 65536 + pb] = m; gw[ea * 65536 + pa] = w0; gw[eb * 65536 + pb] = w1;
            asg[2 * m] = ((unsigned)ea << 16) | pa; asg[2 * m + 1] = ((unsigned)eb << 16) | pb;
        }
    }
};
struct BgHandler {
    float* bg; const float* a_log; const float* dt_bias; int lane;
    DI void operator()(int m, float v) const {
        if (lane < 16) {
            float r;
            if (lane < 8) r = 1.0f / (1.0f + __expf(-v));
            else { const float z = v + dt_bias[lane - 8]; const float sp = z > 20.f ? z : log1pf(__expf(z)); r = -__expf(a_log[lane - 8]) * sp; }
            bg[(size_t)m * 16 + lane] = r; }
    }
};
struct NoHandler { DI void operator()(int, float) const {} };
DI void moe_tables(Frame& F, const unsigned* cntg) {
    LAS int* cnt = (LAS int*)(F.lds + TBL_OFF); LAS int* tb = cnt + 32;
    __syncthreads();
    if (F.tid == 0) { int acc = 0; for (int e = 0; e < 32; ++e) { const int c = (int)__hip_atomic_load(cntg + e, __ATOMIC_RELAXED, __HIP_MEMORY_SCOPE_AGENT); cnt[e] = c; tb[e] = acc; acc += (c + 255) >> 8; } tb[32] = acc; }
    __syncthreads();
}

constexpr int NPH = 19;
#ifndef FAST_GDN
#define FAST_GDN 1
#endif
#ifndef FAST_RET
#define FAST_RET 1
#endif
struct Args { const float* in[20]; float* out; unsigned char* ws; int ph_lo, ph_hi; };
__global__ void __launch_bounds__(NTHR, 2) mk_fwd(Args args) {
    extern __shared__ __attribute__((aligned(16))) unsigned char lds[];
    Frame F;
    F.lds = (LAS unsigned char*)lds; F.tid = threadIdx.x; F.lane = F.tid & 63; F.wave = __builtin_amdgcn_readfirstlane(F.tid >> 6); F.G = gridDim.x;
    F.gw = blockIdx.x * NWAVES + F.wave; F.NGW = F.G * NWAVES; F.ws = args.ws; F.ctl = (unsigned*)(args.ws + WS_CTL);
    volatile LAS unsigned* MISC = (volatile LAS unsigned*)(F.lds + MISC_OFF);
    if (F.tid < 64) MISC[F.tid] = 0u;
    __syncthreads();
    XcdBarrier bar; bar.bar = F.ctl + CW_BAR; bar.x = 0; bar.st = nullptr;
    if (!MK_MULTI) bar = xcd_barrier_post(F.ctl + CW_BAR, MISC + 8);
    const int lo = args.ph_lo, hi = args.ph_hi;
#ifdef ONLY_PH
#define IN(k) ((k) == ONLY_PH && lo <= (k) && (k) < hi)
#else
#define IN(k) (lo <= (k) && (k) < hi)
#endif
#define SEAM(k) do { if (IN(k) && IN((k) + 1)) xcd_barrier(bar); } while (0)
    const float* const* in = args.in;
    float* XC = args.out;
    bf16_t* H = (bf16_t*)(F.ws + WS_H);
    bf16_t* PJ = (bf16_t*)(F.ws + WS_BIG + BIG_PJ);
    unsigned char* aux = F.ws;
    const LAS int* tbl_cnt = (const LAS int*)(F.lds + TBL_OFF); const LAS int* tbl_tb = tbl_cnt + 32;
    LAS unsigned* tokoff = (LAS unsigned*)(F.lds + TOK_OFF);

    enum { P_W = 0, P_N0, P_G0, P_PREP, P_GA, P_SCAN, P_MIX, P_O0, P_M0A, P_M0B, P_M0C, P_N1, P_G1, P_SPREP, P_SWA, P_O1, P_M1A, P_M1B, P_M1C, P_FIN };
    static_assert(P_FIN == NPH, "phase count");
    if (IN(P_W)) { p0_weights(F, in); __syncthreads(); }
    SEAM(P_W);
    if (IN(P_N0)) {
        BgHandler hb{(float*)(aux + AUX_BG), in[6], in[7], F.lane};
        norm_pass<16, false, false, true>(F, in[0], nullptr, nullptr, nullptr, tbl_tb, in[1], (const float*)(aux + AUX_SW), H, hb);
    }
    SEAM(P_N0);
    if (IN(P_G0)) {
        pg8::DenseOrder S; S.init(NTOK, PJW, D, D, (const bf16_t*)(F.ws + WS_WIN0), F.G, blockIdx.x);
        pg8::EpiBf16 E{PJ, PJW};
        pg8::gemm_phase(F.lds, H, D, S, E);
    }
    SEAM(P_G0);
    if (IN(P_PREP)) p2_prep(F, in[5]);
    SEAM(P_PREP);
    if (IN(P_GA)) {
        for (int u = F.gw; u < 16 * NCH; u += F.NGW) {
            if (FAST_GDN) ga_unit<true>(F, u, (unsigned char*)args.out, nullptr);
            if (FAST_RET) ga_unit<false>(F, u, F.ws + AUX_W, nullptr);
        }
        __syncthreads();
    }
    SEAM(P_GA);
    if (IN(P_SCAN)) {
        if (FAST_GDN || FAST_RET) {
            for (int id = blockIdx.x; id < 256; id += F.G) { const int bh = (id % 8) * 2 + (id / 8) / 16, sl = (id / 8) % 16;
                if (FAST_GDN && F.wave == 0) scan_wave<true>(F, bh, sl, (const unsigned char*)args.out);
                if (FAST_RET && F.wave == 1) scan_wave<false>(F, bh, sl, F.ws + AUX_W); }
            __syncthreads();
        }
#ifndef NO_NAIVE
        if (!FAST_RET && blockIdx.x < 8) p3_recurrence<false>(F, blockIdx.x);
        if (!FAST_GDN && blockIdx.x >= 8 && blockIdx.x < 16) p3_recurrence<true>(F, blockIdx.x - 8);
#endif
        __syncthreads();
    }
    SEAM(P_SCAN);
    if (IN(P_MIX)) p4_mixnorm(F, in[4], in[8]);
    SEAM(P_MIX);
    if (IN(P_O0)) {
        pg8::DenseOrder S; S.init(NTOK, D, 4096, PJW, (const bf16_t*)(F.ws + WS_WOUT0), F.G, blockIdx.x);
        pg8::EpiResF32 E{in[0], XC, D};
        pg8::gemm_phase(F.lds, PJ + C_RG, 4096, S, E);
    }
    SEAM(P_O0);
#define MOE_LAYER(P, L, CNTW)                                                                                                                  \
    if (IN(P)) {                                                            \
        convert_experts(F, in, L);                                                                                                             \
        RouteHandler hr{F.ctl + CNTW, (int*)(aux + AUX_LIST), (float*)(aux + AUX_GW), (unsigned*)(aux + AUX_ASG), F.lane};                      \
        norm_pass<36, false, false, true>(F, XC, nullptr, nullptr, nullptr, tbl_tb, in[2] + L * D, (const float*)(aux + AUX_SW) + 16 * D + L * 36 * D, H, hr); \
        __syncthreads();                                                                                                                       \
    }                                                                                                                                          \
    SEAM(P);                                                                                                                                   \
    if (IN(P + 1)) {                                                                                                \
        moe_tables(F, F.ctl + CNTW);                                                                                                           \
        pg8::MoeOrder<true> S; S.init(tbl_tb, tokoff, 6, D, D, (const bf16_t*)(F.ws + WS_BIG + BIG_EGU), (size_t)1536 * D, F.G, blockIdx.x);   \
        { pg8::Unit u; const int* list = (const int*)(aux + AUX_LIST);                                                                         \
          for (int ui = 0; ui < 12 && S.next(ui, u); ++ui) if (F.tid < 256) { const int idx = (u.pm - tbl_tb[u.e]) * 256 + F.tid;               \
              const int tok = idx < tbl_cnt[u.e] ? list[u.e * 65536 + idx] : 0; tokoff[ui * 256 + F.tid] = (unsigned)tok * (unsigned)(D * 2); } } \
        __syncthreads();                                                                                                                       \
        pg8::EpiSwiglu E{(bf16_t*)(F.ws + WS_BIG + BIG_HID)};                                                                                  \
        pg8::gemm_phase(F.lds, H, D, S, E);                                                                                                    \
    }                                                                                                                                          \
    SEAM(P + 1);                                                                                                                               \
    if (IN(P + 2)) {                                                                                  \
        moe_tables(F, F.ctl + CNTW);                                                                                                           \
        pg8::MoeOrder<false> S; S.init(tbl_tb, tokoff, 8, FF, FF, (const bf16_t*)(F.ws + WS_BIG + BIG_EDN), (size_t)D * FF, F.G, blockIdx.x);  \
        pg8::EpiDown E{(bf16_t*)(F.ws + WS_BIG + BIG_Y), (const float*)(aux + AUX_GW), tbl_tb};                                                \
        pg8::gemm_phase(F.lds, (const bf16_t*)(F.ws + WS_BIG + BIG_HID), FF, S, E);                                                            \
    }                                                                                                                                          \
    SEAM(P + 2);
    MOE_LAYER(P_M0A, 0, CW_CNT0)
    if (IN(P_N1)) {
        moe_tables(F, F.ctl + CW_CNT0);
        norm_pass<0, true, true, true>(F, XC, XC, (const bf16_t*)(F.ws + WS_BIG + BIG_Y), (const unsigned*)(aux + AUX_ASG), tbl_tb, in[1] + D, nullptr, H, NoHandler{});
        __syncthreads();
    }
    SEAM(P_N1);
    if (IN(P_G1)) {
        pg8::DenseOrder S; S.init(NTOK, ODD_IN, D, D, (const bf16_t*)(F.ws + WS_WIN1), F.G, blockIdx.x);
        pg8::EpiBf16 E{(bf16_t*)(F.ws + WS_BIG + BIG_QKV1), ODD_IN};
        pg8::gemm_phase(F.lds, H, D, S, E);
    }
    SEAM(P_G1);
    if (IN(P_SPREP)) p11_swaprep(F, in[11], in[12]);
    SEAM(P_SPREP);
    if (IN(P_SWA)) p12_swa_naive(F, in[13]);
    SEAM(P_SWA);
    if (IN(P_O1)) {
        pg8::DenseOrder S; S.init(NTOK, D, D, ODD_IN, (const bf16_t*)(F.ws + WS_WOUT1), F.G, blockIdx.x);
        pg8::EpiResF32 E{XC, XC, D};
        pg8::gemm_phase(F.lds, (const bf16_t*)(F.ws + WS_BIG + BIG_QKV1), D, S, E);
    }
    SEAM(P_O1);
    MOE_LAYER(P_M1A, 1, CW_CNT1)
    if (IN(P_FIN)) {
        moe_tables(F, F.ctl + CW_CNT1);
        norm_pass<0, true, true, false>(F, XC, XC, (const bf16_t*)(F.ws + WS_BIG + BIG_Y), (const unsigned*)(aux + AUX_ASG), tbl_tb, nullptr, nullptr, nullptr, NoHandler{});
    }
#undef IN
#undef SEAM
}

extern "C" void kernel_launch(void* const* d_in, const int* in_sizes, int n_in, void* d_out, int out_size, void* d_ws, size_t ws_size, hipStream_t stream) {
    static int grid = 0;
    if (grid == 0) {
        if (n_in != 20 || in_sizes[0] != NTOK * D || out_size != NTOK * D || ws_size < WS_END) { fprintf(stderr, "kernel_launch: unexpected shapes / workspace (n_in %d, in0 %d, out %d, ws %zu, need %zu)\n", n_in, n_in > 0 ? in_sizes[0] : -1, out_size, ws_size, (size_t)WS_END); grid = -1; return; }
        int dev = 0, cus = 0, per_cu = 0;
        if (hipGetDevice(&dev) != hipSuccess || hipDeviceGetAttribute(&cus, hipDeviceAttributeMultiprocessorCount, dev) != hipSuccess) { grid = -1; return; }
        if (hipFuncSetAttribute((const void*)mk_fwd, hipFuncAttributeMaxDynamicSharedMemorySize, LDS_BYTES) != hipSuccess) { fprintf(stderr, "kernel_launch: hipFuncSetAttribute failed\n"); grid = -1; return; }
        if (hipOccupancyMaxActiveBlocksPerMultiprocessor(&per_cu, (const void*)mk_fwd, NTHR, LDS_BYTES) != hipSuccess || per_cu < 1) fprintf(stderr, "kernel_launch: occupancy query reports %d\n", per_cu);
        (void)hipGetLastError();
        grid = cus;
    }
    if (grid < 0) return;
    (void)hipMemsetAsync((char*)d_ws + WS_CTL, 0, CTL_ZERO_BYTES, stream);
    Args a{};
    for (int i = 0; i < 20; ++i) a.in[i] = (const float*)d_in[i];
    a.out = (float*)d_out; a.ws = (unsigned char*)d_ws;
#if MK_MULTI
    for (int p = 0; p <= NPH; ++p) { a.ph_lo = p; a.ph_hi = p + 1; hipLaunchKernelGGL(mk_fwd, dim3(grid), dim3(NTHR), LDS_BYTES, stream, a); }
#else
    a.ph_lo = 0; a.ph_hi = NPH + 1;
    hipLaunchKernelGGL(mk_fwd, dim3(grid), dim3(NTHR), LDS_BYTES, stream, a);
#endif
}
```

```cpp
#include <hip/hip_runtime.h>
#include <cstdio>
#include <cstdint>

#ifndef MK_MULTI
#define MK_MULTI 0
#endif

#define LAS __attribute__((address_space(3)))
typedef unsigned short bf16_t;
typedef short bf16x8 __attribute__((ext_vector_type(8)));
typedef float f32x4 __attribute__((ext_vector_type(4)));
typedef float f32x2 __attribute__((ext_vector_type(2)));
typedef unsigned u32x4 __attribute__((ext_vector_type(4)));
typedef unsigned u32x2 __attribute__((ext_vector_type(2)));
#define DI __device__ __forceinline__

constexpr int D = 2048, BATCH = 2, SEQ = 16384, NTOK = BATCH * SEQ;
constexpr int EVEN_IN = 12304, PJW = 12288;
constexpr int ODD_IN = 2560;
constexpr int NEXP = 32, FF = 768, TOPK = 2, MAXT = 288;
constexpr float EPS = 1e-6f;
constexpr double ROPE_R = 0.86596432336006535;
constexpr int C_RQ = 0, C_RK = 1024, C_RV = 2048, C_GQKV = 4096, C_RG = 8192, C_GZ = 10240;

constexpr size_t MiB = 1u << 20;
constexpr size_t WS_CTL = 0, CTL_ZERO_BYTES = 1 * MiB;
constexpr size_t WS_WIN0 = 2 * MiB;
constexpr size_t WS_WOUT0 = WS_WIN0 + 48 * MiB;
constexpr size_t WS_WIN1 = WS_WOUT0 + 16 * MiB;
constexpr size_t WS_WOUT1 = WS_WIN1 + 10 * MiB;
constexpr size_t WS_H = 84 * MiB;
constexpr size_t WS_BIG = 212 * MiB;
constexpr size_t WS_AUX = 980 * MiB;
constexpr size_t WS_END = 1492 * MiB;
constexpr size_t BIG_PJ = 0;
constexpr size_t BIG_EGU = 0;
constexpr size_t BIG_EDN = 192 * MiB;
constexpr size_t BIG_HID = 288 * MiB;
constexpr size_t BIG_Y = 400 * MiB;
constexpr size_t BIG_QKV1 = 0;
constexpr size_t AUX_QN = WS_AUX + 0;
constexpr size_t AUX_KN = WS_AUX + 64 * MiB;
constexpr size_t AUX_VC = WS_AUX + 128 * MiB;
constexpr size_t AUX_W = WS_AUX + 256 * MiB;
constexpr size_t AUX_ATT = WS_AUX + 320 * MiB;
constexpr size_t AUX_RST = WS_AUX + 352 * MiB;
constexpr size_t AUX_BG = WS_AUX + 480 * MiB;
constexpr size_t AUX_CS = WS_AUX + 482 * MiB;
constexpr size_t AUX_DEC = WS_AUX + 490 * MiB + 768 * 1024;
constexpr size_t AUX_SW = WS_AUX + 490 * MiB;
constexpr size_t AUX_LIST = WS_AUX + 491 * MiB;
constexpr size_t AUX_GW = WS_AUX + 499 * MiB;
constexpr size_t AUX_ASG = WS_AUX + 507 * MiB;
static_assert(AUX_ASG + MiB <= WS_END, "aux map");
constexpr int CW_BAR = 4096;
constexpr int CW_CNT0 = 16384, CW_CNT1 = 16384 + 64;

constexpr int RING_BYTES = 131072;
constexpr int GA_LDS_WAVE = 17920;
constexpr int MISC_OFF = 8 * GA_LDS_WAVE;
constexpr int TBL_OFF = MISC_OFF + 256;
constexpr int TOK_OFF = MISC_OFF + 1024;
constexpr int LDS_BYTES = 163840;
static_assert(TOK_OFF + 12 * 1024 <= LDS_BYTES, "lds map");
DI float rdlane(float v, int l) { return __builtin_bit_cast(float, __builtin_amdgcn_readlane(__builtin_bit_cast(int, v), l)); }

DI unsigned f2bf(float f) { unsigned u = __builtin_bit_cast(unsigned, f); return (u + 0x7fffu + ((u >> 16) & 1u)) >> 16; }
DI unsigned pk2(float lo, float hi) { return f2bf(lo) | (f2bf(hi) << 16); }
DI float bflo(unsigned w) { return __builtin_bit_cast(float, w << 16); }
DI float bfhi(unsigned w) { return __builtin_bit_cast(float, w & 0xffff0000u); }
DI float bf2f(bf16_t b) { return __builtin_bit_cast(float, ((unsigned)b) << 16); }
DI unsigned cvt_pk_bf16(float lo, float hi) { unsigned r; asm volatile("v_cvt_pk_bf16_f32 %0, %1, %2" : "=v"(r) : "v"(lo), "v"(hi)); return r; }
DI float wave_sum(float v) {
#pragma unroll
    for (int o = 1; o < 64; o <<= 1) v += __shfl_xor(v, o);
    return v;
}
DI float siluf(float x) { return x / (1.0f + __expf(-x)); }
#define LDS_WAIT() asm volatile("s_waitcnt lgkmcnt(0)" ::: "memory")
#define VM_WAIT() asm volatile("s_waitcnt vmcnt(0)" ::: "memory")

#define XB_TMO      128
#define XB_XCNT(j)  (256  + 64 * (j))
#define XB_XSUB(j)  (1280 + 64 * (j))
#define XB_XGEN(j)  (2304 + 64 * (j))
#define XB_TOP      3328
#define XB_TOPGEN   3392
#define XCD_BAR_WORDS 3456
#define XB_SPIN_CAP (1u << 22)
DI unsigned xb_ld(unsigned* p)              { return __hip_atomic_load(p, __ATOMIC_RELAXED, __HIP_MEMORY_SCOPE_AGENT); }
DI unsigned xb_add(unsigned* p, unsigned v) { return __hip_atomic_fetch_add(p, v, __ATOMIC_RELAXED, __HIP_MEMORY_SCOPE_AGENT); }
DI unsigned xb_xcc_id() { return (unsigned)__builtin_amdgcn_s_getreg((3 << 11) | 20) & 0xFu; }
#define XB_SPIN(cond, bar) do { unsigned _sp = 0; while (cond) { __builtin_amdgcn_s_sleep(1); \
    if ((++_sp & 255u) == 0u) { if (xb_ld(&(bar)[XB_TMO])) break; if (_sp > XB_SPIN_CAP) { atomicAdd(&(bar)[XB_TMO], 1u); break; } } } } while (0)
struct XcdBarrier { unsigned* bar; unsigned x; volatile LAS unsigned* st; };
DI XcdBarrier xcd_barrier_post(unsigned* bar, volatile LAS unsigned* st) {
    XcdBarrier b; b.bar = bar; b.x = xb_xcc_id(); b.st = st;
    if (threadIdx.x == 0) (void)xb_add(&bar[XB_XCNT(b.x)], 1u);
    return b;
}
DI void xcd_barrier_complete(unsigned* bar, unsigned x, unsigned& nloc, unsigned& nx) {
    const unsigned G = gridDim.x * gridDim.y * gridDim.z;
    unsigned sum, cnt, mine, sp = 0u;
    for (;;) {
        sum = 0u; cnt = 0u; mine = 0u;
#pragma unroll
        for (unsigned j = 0; j < 16; ++j) { const unsigned c = xb_ld(&bar[XB_XCNT(j)]); sum += c; cnt += (c > 0u) ? 1u : 0u; mine = (j == x) ? c : mine; }
        if (sum == G) break;
        __builtin_amdgcn_s_sleep(1);
        if ((++sp & 255u) == 0u) { if (xb_ld(&bar[XB_TMO])) break; if (sp > XB_SPIN_CAP) { atomicAdd(&bar[XB_TMO], 1u); break; } }
    }
    nloc = mine > 0u ? mine : 1u; nx = cnt > 0u ? cnt : 1u;
}
DI void xcd_barrier(const XcdBarrier& b) {
    asm volatile("s_waitcnt vmcnt(0)" ::: "memory");
    __syncthreads();
    if (threadIdx.x == 0) {
        unsigned* bar = b.bar;
        __builtin_amdgcn_s_waitcnt(0);
        unsigned nloc = b.st[0], nx = b.st[1];
        if (nloc == 0u) { xcd_barrier_complete(bar, b.x, nloc, nx); b.st[0] = nloc; b.st[1] = nx; }
        const unsigned old = xb_add(&bar[XB_XSUB(b.x)], 1u);
        const unsigned gen = old / nloc;
        if (old + 1u == (gen + 1u) * nloc) {
            __builtin_amdgcn_fence(__ATOMIC_RELEASE, "agent");
            asm volatile("s_waitcnt vmcnt(0)" ::: "memory");
            const unsigned og = xb_add(&bar[XB_TOP], 1u);
            const unsigned tg = og / nx;
            if (og + 1u == (tg + 1u) * nx) xb_add(&bar[XB_TOPGEN], 1u);
            else XB_SPIN(xb_ld(&bar[XB_TOPGEN]) == tg, bar);
            __builtin_amdgcn_fence(__ATOMIC_ACQUIRE, "agent");
            xb_add(&bar[XB_XGEN(b.x)], 1u);
            asm volatile("s_waitcnt vmcnt(0)" ::: "memory");
        } else {
            XB_SPIN(xb_ld(&bar[XB_XGEN(b.x)]) == gen, bar);
            __builtin_amdgcn_fence(__ATOMIC_ACQUIRE, "agent");
            asm volatile("s_waitcnt vmcnt(0)" ::: "memory");
        }
    }
    __syncthreads();
}

namespace pg8 {
constexpr int BM = 256, BK = 64, HALF = 128, HTB = HALF * BK * 2, STAGE_BYTES = 8 * HTB, NXCD = 8, WGM = 8;
__host__ __device__ __forceinline__ int lds_byte(int r, int c) { const int st = (r >> 4) * 2 + (c >> 5), rr = r & 15, cc = c & 31, ob = rr * 64 + cc * 2; return st * 1024 + (ob ^ (((ob >> 9) & 1) << 5)); }
__host__ __device__ __forceinline__ void stage_rc(int b, int& R, int& C) { const int st = b / 1024, sb = b % 1024, swz = sb ^ (((sb >> 9) & 1) << 5); R = (st >> 1) * 16 + swz / 64; C = (st & 1) * 32 + (swz % 64) / 2; }
__host__ __device__ __forceinline__ int perm32(int rho) { const int n = rho >> 4, i = rho & 15; return 8 * (i >> 2) + 4 * n + (i & 3); }

struct Unit { int pm, pn, e, slot; };

DI int xcd_remap(int L, int nwg) { const int q = nwg / NXCD, r = nwg % NXCD, xcd = L % NXCD, off = L / NXCD; return (xcd < r ? xcd * (q + 1) : r * (q + 1) + (xcd - r) * q) + off; }

struct DenseOrder {
    int nM, nN, nwg, G, c; unsigned lda2; const char* Bt; size_t tstepB;
    DI void init(int M, int N, int K, int lda, const bf16_t* Bt_, int G_, int c_) { nM = M / BM; nN = N / BM; nwg = nM * nN; G = G_; c = c_; lda2 = (unsigned)lda * 2u; Bt = (const char*)Bt_; tstepB = (size_t)BM * K * 2; }
    DI bool next(int i, Unit& u) const {
        const long L = (long)i * G + c; if (L >= nwg) return false;
        const int wgid = xcd_remap((int)L, nwg);
        const int nig = WGM * nN, gid = wgid / nig, fm = gid * WGM, gsz = (nM - fm) < WGM ? (nM - fm) : WGM;
        u.pm = fm + ((wgid % nig) % gsz); u.pn = (wgid % nig) / gsz; u.e = 0; u.slot = i; return true;
    }
    DI unsigned a_off(const Unit& u, int h, int R) const { return (unsigned)(u.pm * BM + h * HALF + R) * lda2; }
    DI const char* b_base(const Unit& u) const { return Bt + (size_t)u.pn * tstepB; }
};
template <bool GATHER> struct MoeOrder {
    const LAS int* tb; const LAS unsigned* tokoff; int NT, nwg, G, c; unsigned lda2; const char* Bt; size_t estepB, tstepB;
    DI void init(const LAS int* tb_, const LAS unsigned* tokoff_, int NT_, int K, int lda, const bf16_t* Bt_, size_t estep_elems, int G_, int c_) {
        tb = tb_; tokoff = tokoff_; NT = NT_; nwg = tb_[32] * NT_; G = G_; c = c_; lda2 = (unsigned)lda * 2u; Bt = (const char*)Bt_; estepB = estep_elems * 2; tstepB = (size_t)BM * K * 2; }
    DI bool next(int i, Unit& u) const {
        const long L = (long)i * G + c; if (L >= nwg) return false;
        const int w = xcd_remap((int)L, nwg);
        int e = 0;
#pragma unroll 1
        for (int s = 16; s >= 1; s >>= 1) if (tb[e + s] * NT <= w) e += s;
        const int nt = tb[e + 1] - tb[e], local = w - tb[e] * NT;
        u.e = e; u.pn = local / nt; u.pm = tb[e] + local % nt; u.slot = i; return true;
    }
    DI unsigned a_off(const Unit& u, int h, int R) const { if (GATHER) return tokoff[u.slot * 256 + h * HALF + R]; return (unsigned)(u.pm * BM + h * HALF + R) * lda2; }
    DI const char* b_base(const Unit& u) const { return Bt + (size_t)u.e * estepB + (size_t)u.pn * tstepB; }
};

struct EpiBf16 {
    static constexpr bool PERM = true;
    bf16_t* O; int ldc;
    DI void operator()(const f32x4 (&acc)[2][2][4][2], const Unit& u, int wr, int wc, int fr, int fq) const {
        const int row0 = u.pm * BM + wr * 64 + fr, col0 = u.pn * BM + wc * 32 + 8 * fq;
#pragma unroll
        for (int ai = 0; ai < 2; ++ai)
#pragma unroll
            for (int m = 0; m < 4; ++m) { bf16_t* rowp = O + (size_t)(row0 + ai * HALF + m * 16) * ldc + col0;
#pragma unroll
                for (int bj = 0; bj < 2; ++bj) { const f32x4 v0 = acc[ai][bj][m][0], v1 = acc[ai][bj][m][1];
                    u32x4 w; w.x = cvt_pk_bf16(v0[0], v0[1]); w.y = cvt_pk_bf16(v0[2], v0[3]); w.z = cvt_pk_bf16(v1[0], v1[1]); w.w = cvt_pk_bf16(v1[2], v1[3]);
                    *(u32x4*)(rowp + bj * HALF) = w; } }
    }
};
struct EpiResF32 {
    static constexpr bool PERM = false;
    const float* base; float* out; int ldc;
    DI void operator()(const f32x4 (&acc)[2][2][4][2], const Unit& u, int wr, int wc, int fr, int fq) const {
        const int row0 = u.pm * BM + wr * 64 + fr, col0 = u.pn * BM + wc * 32 + 4 * fq;
#pragma unroll
        for (int ai = 0; ai < 2; ++ai)
#pragma unroll
            for (int m = 0; m < 4; ++m) { const size_t off = (size_t)(row0 + ai * HALF + m * 16) * ldc + col0;
#pragma unroll
                for (int bj = 0; bj < 2; ++bj)
#pragma unroll
                    for (int n = 0; n < 2; ++n) { const f32x4 bs = *(const f32x4*)(base + off + bj * HALF + n * 16); *(f32x4*)(out + off + bj * HALF + n * 16) = bs + acc[ai][bj][m][n]; }
                asm volatile("" ::: "memory"); }
    }
};
struct EpiSwiglu {
    static constexpr bool PERM = true;
    bf16_t* O;
    DI void operator()(const f32x4 (&acc)[2][2][4][2], const Unit& u, int wr, int wc, int fr, int fq) const {
        const int row0 = u.pm * BM + wr * 64 + fr, col0 = u.pn * HALF + wc * 32 + 8 * fq;
#pragma unroll
        for (int ai = 0; ai < 2; ++ai)
#pragma unroll
            for (int m = 0; m < 4; ++m) { bf16_t* rowp = O + (size_t)(row0 + ai * HALF + m * 16) * FF + col0;
                float h[8];
#pragma unroll
                for (int n = 0; n < 2; ++n)
#pragma unroll
                    for (int j = 0; j < 4; ++j) { const float g = acc[ai][0][m][n][j], up = acc[ai][1][m][n][j]; h[n * 4 + j] = g / (1.0f + __expf(-g)) * up; }
                u32x4 w; w.x = cvt_pk_bf16(h[0], h[1]); w.y = cvt_pk_bf16(h[2], h[3]); w.z = cvt_pk_bf16(h[4], h[5]); w.w = cvt_pk_bf16(h[6], h[7]);
                *(u32x4*)rowp = w; }
    }
};
struct EpiDown {
    static constexpr bool PERM = true;
    bf16_t* O; const float* gw; const LAS int* tb;
    DI void operator()(const f32x4 (&acc)[2][2][4][2], const Unit& u, int wr, int wc, int fr, int fq) const {
        const int row0 = u.pm * BM + wr * 64 + fr, col0 = u.pn * BM + wc * 32 + 8 * fq;
        const int lrow0 = (u.pm - tb[u.e]) * BM + wr * 64 + fr;
        const float* gwe = gw + (size_t)u.e * 65536;
#pragma unroll
        for (int ai = 0; ai < 2; ++ai)
#pragma unroll
            for (int m = 0; m < 4; ++m) { bf16_t* rowp = O + (size_t)(row0 + ai * HALF + m * 16) * D + col0; const float g = gwe[lrow0 + ai * HALF + m * 16];
#pragma unroll
                for (int bj = 0; bj < 2; ++bj) { const f32x4 v0 = acc[ai][bj][m][0] * g, v1 = acc[ai][bj][m][1] * g;
                    u32x4 w; w.x = cvt_pk_bf16(v0[0], v0[1]); w.y = cvt_pk_bf16(v0[2], v0[3]); w.z = cvt_pk_bf16(v1[0], v1[1]); w.w = cvt_pk_bf16(v1[2], v1[3]);
                    *(u32x4*)(rowp + bj * HALF) = w; } }
    }
};

template <class Epi, class Sched>
DI void gemm_phase(LAS unsigned char* lds, const bf16_t* Aptr, int K, const Sched& S, const Epi& E) {
    const int tid = threadIdx.x, wid = __builtin_amdgcn_readfirstlane(tid >> 6), lane = tid & 63, wr = wid >> 2, wc = wid & 3, fr = lane & 15, fq = lane >> 4;
    const int nt = K / BK;
    const char* Ab = (const char*)Aptr;
    int Rr[2], Cc[2]; unsigned voffB[2];
#pragma unroll
    for (int i = 0; i < 2; ++i) { int R, C; stage_rc(tid * 16 + i * 8192, R, C); const int Rb = Epi::PERM ? ((R & ~31) + perm32(R & 31)) : R; Rr[i] = R; Cc[i] = C * 2; voffB[i] = (unsigned)(Rb * K + C) * 2u; }
    const unsigned kstep = (unsigned)(BK * 2);
    const size_t hstepB = (size_t)HALF * K * 2;
    const unsigned ldsw = (unsigned)wid * 1024u;
    const int aoff = lds_byte(wr * 64 + fr, fq * 8), boff = lds_byte(wc * 32 + fr, fq * 8);
#define PG8_SA(b, h) (((b) * 2 + (h)) * HTB)
#define PG8_SB(b, h) ((4 + (b) * 2 + (h)) * HTB)
#define PG8_STAGEB(bufoff, gbase) do { _Pragma("unroll") for (int _i = 0; _i < 2; ++_i) \
        __builtin_amdgcn_global_load_lds((const unsigned*)((const char*)(gbase) + voffB[_i]), (LAS unsigned*)(lds + (bufoff) + ldsw + _i * 8192), 16, 0, 0); } while (0)
#define PG8_STAGEA(bufoff, offs, kb) do { _Pragma("unroll") for (int _i = 0; _i < 2; ++_i) \
        __builtin_amdgcn_global_load_lds((const unsigned*)(Ab + (size_t)((offs)[_i] + (kb))), (LAS unsigned*)(lds + (bufoff) + ldsw + _i * 8192), 16, 0, 0); } while (0)
#define PG8_LDA(dst, b, h) do { _Pragma("unroll") for (int m = 0; m < 4; ++m) _Pragma("unroll") for (int k = 0; k < 2; ++k) dst[m][k] = *(const LAS bf16x8*)(lds + PG8_SA(b, h) + aoff + m * 2048 + k * 1024); } while (0)
#define PG8_LDB(dst, b, h) do { _Pragma("unroll") for (int n = 0; n < 2; ++n) _Pragma("unroll") for (int k = 0; k < 2; ++k) dst[n][k] = *(const LAS bf16x8*)(lds + PG8_SB(b, h) + boff + n * 2048 + k * 1024); } while (0)
#define PG8_MMA(ai, bj, At, Bt) do { __builtin_amdgcn_s_setprio(1); _Pragma("unroll") for (int m = 0; m < 4; ++m) _Pragma("unroll") for (int n = 0; n < 2; ++n) _Pragma("unroll") for (int k = 0; k < 2; ++k) \
        acc[ai][bj][m][n] = __builtin_amdgcn_mfma_f32_16x16x32_bf16(Bt[n][k], At[m][k], acc[ai][bj][m][n], 0, 0, 0); __builtin_amdgcn_s_setprio(0); } while (0)
#define PG8_WAIT_V(n) asm volatile("s_waitcnt vmcnt(" #n ")" ::: "memory")
#define PG8_WAIT_L(n) asm volatile("s_waitcnt lgkmcnt(" #n ")" ::: "memory")
#define PG8_BAR __builtin_amdgcn_s_barrier()
#define PG8_SCHED __builtin_amdgcn_sched_barrier(0)
    Unit cur, nxt; int ui = 0;
    if (!S.next(0, cur)) return;
    f32x4 acc[2][2][4][2];
#pragma unroll
    for (int a = 0; a < 2; ++a)
#pragma unroll
        for (int b = 0; b < 2; ++b)
#pragma unroll
            for (int m = 0; m < 4; ++m)
#pragma unroll
                for (int n = 0; n < 2; ++n) acc[a][b][m][n] = (f32x4){0.f, 0.f, 0.f, 0.f};
    bf16x8 At[4][2], B0[2][2], B1[2][2];
    unsigned ao[2][2], an[2][2];
#pragma unroll
    for (int h = 0; h < 2; ++h)
#pragma unroll
        for (int i = 0; i < 2; ++i) ao[h][i] = S.a_off(cur, h, Rr[i]) + (unsigned)Cc[i];
    const char* cB = S.b_base(cur);
    PG8_STAGEB(PG8_SB(0, 0), cB); PG8_STAGEB(PG8_SB(0, 1), cB + hstepB); PG8_STAGEA(PG8_SA(0, 0), ao[0], 0u); PG8_STAGEA(PG8_SA(0, 1), ao[1], 0u);
    if (wr == 1) PG8_BAR;
    PG8_WAIT_V(2); PG8_BAR;
    PG8_STAGEB(PG8_SB(1, 0), cB + kstep); PG8_STAGEA(PG8_SA(1, 0), ao[0], kstep); PG8_STAGEB(PG8_SB(1, 1), cB + hstepB + kstep);
    PG8_WAIT_V(6); PG8_BAR;
    for (;;) {
        const bool has_next = S.next(ui + 1, nxt);
        const char* nB = has_next ? S.b_base(nxt) : cB;
#pragma unroll
        for (int h = 0; h < 2; ++h)
#pragma unroll
            for (int i = 0; i < 2; ++i) an[h][i] = has_next ? (S.a_off(nxt, h, Rr[i]) + (unsigned)Cc[i]) : ao[h][i];
        for (int t = 0; t < nt; t += 2) {
            const bool last = (t == nt - 2);
            const unsigned kb1 = (unsigned)(t + 1) * kstep, kb2 = (unsigned)(t + 2) * kstep;
            unsigned x2[2][2];
#pragma unroll
            for (int h = 0; h < 2; ++h)
#pragma unroll
                for (int i = 0; i < 2; ++i) x2[h][i] = last ? an[h][i] : ao[h][i] + kb2;
            const char* b2 = last ? nB : cB + kb2; const char* b3 = b2 + kstep;
            PG8_LDB(B0, 0, 0); PG8_LDB(B1, 0, 1); PG8_SCHED; PG8_LDA(At, 0, 0); PG8_STAGEA(PG8_SA(1, 1), ao[1], kb1);
            PG8_WAIT_V(8); PG8_WAIT_L(0); PG8_BAR; PG8_MMA(0, 0, At, B0); PG8_MMA(0, 1, At, B1); PG8_BAR; PG8_SCHED;
            PG8_LDA(At, 0, 1); PG8_STAGEB(PG8_SB(0, 0), b2); PG8_STAGEB(PG8_SB(0, 1), b2 + hstepB); PG8_STAGEA(PG8_SA(0, 0), x2[0], 0u);
            PG8_WAIT_V(8); PG8_WAIT_L(0); PG8_BAR; PG8_MMA(1, 0, At, B0); PG8_MMA(1, 1, At, B1); PG8_BAR; PG8_SCHED;
            PG8_LDB(B0, 1, 0); PG8_LDB(B1, 1, 1); PG8_SCHED; PG8_LDA(At, 1, 0); PG8_STAGEA(PG8_SA(0, 1), x2[1], 0u);
            PG8_WAIT_V(8); PG8_WAIT_L(0); PG8_BAR; PG8_MMA(0, 0, At, B0); PG8_MMA(0, 1, At, B1); PG8_BAR; PG8_SCHED;
            PG8_LDA(At, 1, 1); PG8_STAGEB(PG8_SB(1, 0), b3); PG8_STAGEB(PG8_SB(1, 1), b3 + hstepB); PG8_STAGEA(PG8_SA(1, 0), x2[0], kstep);
            PG8_WAIT_V(8); PG8_WAIT_L(0); PG8_BAR; PG8_MMA(1, 0, At, B0); PG8_MMA(1, 1, At, B1); PG8_BAR; PG8_SCHED;
        }
        if (wr == 0) PG8_BAR;
        E(acc, cur, wr, wc, fr, fq);
        if (!has_next) break;
#pragma unroll
        for (int a = 0; a < 2; ++a)
#pragma unroll
            for (int b = 0; b < 2; ++b)
#pragma unroll
                for (int m = 0; m < 4; ++m)
#pragma unroll
                    for (int n = 0; n < 2; ++n) acc[a][b][m][n] = (f32x4){0.f, 0.f, 0.f, 0.f};
        cur = nxt; cB = nB; ++ui;
#pragma unroll
        for (int h = 0; h < 2; ++h)
#pragma unroll
            for (int i = 0; i < 2; ++i) ao[h][i] = an[h][i];
        if (wr == 1) PG8_BAR;
    }
    PG8_WAIT_V(0);
    PG8_BAR;
#undef PG8_SA
#undef PG8_SB
#undef PG8_STAGEA
#undef PG8_STAGEB
#undef PG8_LDA
#undef PG8_LDB
#undef PG8_MMA
#undef PG8_WAIT_V
#undef PG8_WAIT_L
#undef PG8_BAR
#undef PG8_SCHED
}
}

constexpr int NWAVES = 8, NTHR = 512;
struct Frame {
    LAS unsigned char* lds;
    int tid, lane, wave, G, gw, NGW;
    unsigned* ctl;
    unsigned char* ws;
};

DI void transpose_item(const float* Wseg, int ldw, int ncols, int K, bf16_t* WT, int row_off, LAS float* scr, int item, int lane) {
    const int nblk = ncols / 32, kb = item / nblk, nb = item % nblk, k0 = 64 * kb, n0 = 32 * nb;
#pragma unroll 8
    for (int i = 0; i < 32; ++i) { const int kk = 2 * i + (lane >> 5); scr[kk * 33 + (lane & 31)] = Wseg[(size_t)(k0 + kk) * ldw + n0 + (lane & 31)]; }
    LDS_WAIT(); asm volatile("" ::: "memory");
    const int c = lane & 7;
#pragma unroll
    for (int j = 0; j < 4; ++j) { const int n = (lane >> 3) + 8 * j; const LAS float* s = scr + (8 * c) * 33 + n;
        u32x4 o; o.x = pk2(s[0 * 33], s[1 * 33]); o.y = pk2(s[2 * 33], s[3 * 33]); o.z = pk2(s[4 * 33], s[5 * 33]); o.w = pk2(s[6 * 33], s[7 * 33]);
        *(u32x4*)(WT + (size_t)(row_off + n0 + n) * K + k0 + 8 * c) = o; }
    LDS_WAIT(); asm volatile("" ::: "memory");
}

DI void p0_weights(Frame& F, const float* const* in) {
    LAS float* scr = (LAS float*)(F.lds + F.wave * 16384);
    bf16_t* win0 = (bf16_t*)(F.ws + WS_WIN0); bf16_t* wout0 = (bf16_t*)(F.ws + WS_WOUT0); bf16_t* win1 = (bf16_t*)(F.ws + WS_WIN1); bf16_t* wout1 = (bf16_t*)(F.ws + WS_WOUT1);
    const float* ewin = in[3]; const float* ewout = in[9]; const float* owin = in[10]; const float* owout = in[14];
    constexpr int KB = D / 64;
    constexpr int I_A = KB * (4096 / 32), I_B = KB * (4096 / 32), I_C = KB * (2048 / 32), I_D = KB * (2048 / 32);
    constexpr int I_O0 = (4096 / 64) * (D / 32), I_I1 = KB * (ODD_IN / 32), I_O1 = KB * (D / 32);
    constexpr int NIT = I_A + I_B + I_C + I_D + I_O0 + I_I1 + I_O1;
    for (int it = F.gw; it < NIT; it += F.NGW) {
        int r = it;
        if (r < I_A) { transpose_item(ewin + 0, EVEN_IN, 4096, D, win0, 0, scr, r, F.lane); continue; } r -= I_A;
        if (r < I_B) { transpose_item(ewin + 6144, EVEN_IN, 4096, D, win0, C_GQKV, scr, r, F.lane); continue; } r -= I_B;
        if (r < I_C) { transpose_item(ewin + 4096, EVEN_IN, 2048, D, win0, C_RG, scr, r, F.lane); continue; } r -= I_C;
        if (r < I_D) { transpose_item(ewin + 10240, EVEN_IN, 2048, D, win0, C_GZ, scr, r, F.lane); continue; } r -= I_D;
        if (r < I_O0) { transpose_item(ewout, D, D, 4096, wout0, 0, scr, r, F.lane); continue; } r -= I_O0;
        if (r < I_I1) { transpose_item(owin, ODD_IN, ODD_IN, D, win1, 0, scr, r, F.lane); continue; } r -= I_I1;
        transpose_item(owout, D, D, D, wout1, 0, scr, r, F.lane);
    }
    float* sw = (float*)(F.ws + AUX_SW);
    const int gt = (F.gw * 64 + F.lane), NGT = F.NGW * 64;
    for (int i = gt; i < 16 * D; i += NGT) { const int c = i / D, k = i % D; sw[i] = ewin[(size_t)k * EVEN_IN + 12288 + c]; }
    for (int l = 0; l < 2; ++l) { float* rt = sw + 16 * D + l * 36 * D; const float* rg = in[15] + (size_t)l * D * 4; const float* re = in[16] + (size_t)l * D * 32;
        for (int i = gt; i < 36 * D; i += NGT) { const int c = i / D, k = i % D; rt[i] = c < 4 ? rg[k * 4 + c] : re[k * 32 + (c - 4)]; } }
    f32x2* cs = (f32x2*)(F.ws + AUX_CS);
    for (int i = gt; i < SEQ * 64; i += NGT) { const int pos = i >> 6, fi = i & 63; double inv = 1.0;
        for (int q = 0; q < fi; ++q) inv *= ROPE_R;
        const double x = (double)pos * inv, k = __builtin_rint(x * 0.15915494309189535), r = (x - k * 6.283185307179586) - k * 2.4492935982947064e-16;
        const float rf = (float)r; cs[i] = (f32x2){cosf(rf), sinf(rf)}; }
}
DI void convert_experts(Frame& F, const float* const* in, int l) {
    LAS float* scr = (LAS float*)(F.lds + F.wave * 16384);
    const float* wg = in[17] + (size_t)l * NEXP * D * FF; const float* wu = in[18] + (size_t)l * NEXP * D * FF; const float* wd = in[19] + (size_t)l * NEXP * FF * D;
    bf16_t* gu = (bf16_t*)(F.ws + WS_BIG + BIG_EGU); bf16_t* dn = (bf16_t*)(F.ws + WS_BIG + BIG_EDN);
    constexpr int I_G = (D / 64) * (128 / 32);
    constexpr int I_GU = NEXP * 6 * 2 * I_G;
    constexpr int I_DE = (FF / 64) * (D / 32);
    constexpr int NIT = I_GU + NEXP * I_DE;
    for (int it = F.gw; it < NIT; it += F.NGW) {
        if (it < I_GU) { const int seg = it / I_G, r = it % I_G, e = seg / 12, s = seg % 12, pn = s >> 1, isup = s & 1;
            const float* src = (isup ? wu : wg) + (size_t)e * D * FF + pn * 128;
            transpose_item(src, FF, 128, D, gu + (size_t)e * 1536 * D, pn * 256 + isup * 128, scr, r, F.lane); }
        else { const int r2 = it - I_GU, e = r2 / I_DE, r = r2 % I_DE;
            transpose_item(wd + (size_t)e * FF * D, D, D, FF, dn + (size_t)e * D * FF, 0, scr, r, F.lane); }
    }
}

template <int NP, bool ADDY, bool WRITEX, bool WRITEH, class Handler>
DI void norm_pass(Frame& F, const float* src, float* dst, const bf16_t* y, const unsigned* asg, const LAS int* tb, const float* gain, const float* Wt, bf16_t* H, Handler hnd) {
    for (int m = F.gw; m < NTOK; m += F.NGW) {
        const f32x4* xr = (const f32x4*)(src + (size_t)m * D) + F.lane;
        f32x4 v[8];
#pragma unroll
        for (int j = 0; j < 8; ++j) v[j] = xr[64 * j];
        if (ADDY) {
            const unsigned a0 = asg[2 * m], a1 = asg[2 * m + 1];
            const size_t r0 = (size_t)tb[a0 >> 16] * 256 + (a0 & 0xffffu), r1 = (size_t)tb[a1 >> 16] * 256 + (a1 & 0xffffu);
            const u32x2* y0 = (const u32x2*)(y + r0 * D) + F.lane; const u32x2* y1 = (const u32x2*)(y + r1 * D) + F.lane;
#pragma unroll
            for (int j = 0; j < 8; ++j) { const u32x2 p = y0[64 * j], q = y1[64 * j];
                v[j].x += bflo(p.x) + bflo(q.x); v[j].y += bfhi(p.x) + bfhi(q.x); v[j].z += bflo(p.y) + bflo(q.y); v[j].w += bfhi(p.y) + bfhi(q.y); }
        }
        if (WRITEX) { f32x4* xo = (f32x4*)(dst + (size_t)m * D) + F.lane;
#pragma unroll
            for (int j = 0; j < 8; ++j) xo[64 * j] = v[j]; }
        if (WRITEH) {
            float s = 0.f;
#pragma unroll
            for (int j = 0; j < 8; ++j) s += (v[j].x * v[j].x + v[j].y * v[j].y) + (v[j].z * v[j].z + v[j].w * v[j].w);
            const float rstd = 1.0f / sqrtf(wave_sum(s) * (1.0f / D) + EPS);
            const f32x4* gr = (const f32x4*)gain + F.lane;
#pragma unroll
            for (int j = 0; j < 8; ++j) v[j] = v[j] * rstd * gr[64 * j];
            u32x2* ho = (u32x2*)(H + (size_t)m * D) + F.lane;
#pragma unroll
            for (int j = 0; j < 8; ++j) { u32x2 w; w.x = pk2(v[j].x, v[j].y); w.y = pk2(v[j].z, v[j].w); ho[64 * j] = w; }
            if constexpr (NP > 0) {
                float res = 0.f;
#pragma unroll 1
                for (int c0 = 0; c0 < NP; c0 += 4) {
                    float a[4];
#pragma unroll
                    for (int cc = 0; cc < 4; ++cc) { const f32x4* wr = (const f32x4*)(Wt + (size_t)(c0 + cc) * D) + F.lane; a[cc] = 0.f;
#pragma unroll
                        for (int j = 0; j < 8; ++j) { const f32x4 w = wr[64 * j]; a[cc] += (v[j].x * w.x + v[j].y * w.y) + (v[j].z * w.z + v[j].w * w.w); } }
#pragma unroll
                    for (int cc = 0; cc < 4; ++cc) { const float t = wave_sum(a[cc]); res = (F.lane == c0 + cc) ? t : res; }
                }
                hnd(m, res);
            }
        }
    }
}

DI void p2_prep(Frame& F, const float* conv_w) {
    bf16_t* pj = (bf16_t*)(F.ws + WS_BIG + BIG_PJ);
    const f32x2* cs = (const f32x2*)(F.ws + AUX_CS);
    bf16_t* qn = (bf16_t*)(F.ws + AUX_QN); bf16_t* kn = (bf16_t*)(F.ws + AUX_KN); bf16_t* vc = (bf16_t*)(F.ws + AUX_VC);
    const int lane = F.lane;
    for (int m = F.gw; m < NTOK; m += F.NGW) {
        const int pos = m & (SEQ - 1);
        bf16_t* row = pj + (size_t)m * PJW;
        const f32x2 c = cs[pos * 64 + lane];
#pragma unroll
        for (int hv = 0; hv < 16; ++hv) { bf16_t* p = row + hv * 128; const float x1 = bf2f(p[lane]), x2 = bf2f(p[lane + 64]); const float sc = hv >= 8 ? 0.08838834764831845f : 1.0f;
            p[lane] = (bf16_t)f2bf((x1 * c.x - x2 * c.y) * sc); p[lane + 64] = (bf16_t)f2bf((x2 * c.x + x1 * c.y) * sc); }
#pragma unroll
        for (int j = 0; j < 8; ++j) { const int ch = 512 * j + 8 * lane; float a[8];
#pragma unroll
            for (int e = 0; e < 8; ++e) a[e] = 0.f;
#pragma unroll
            for (int tp = 0; tp < 4; ++tp) { const int dp = pos - 3 + tp; if (dp >= 0) { const u32x4 r = *(const u32x4*)(pj + (size_t)(m - 3 + tp) * PJW + C_GQKV + ch);
                    const f32x4 w0 = *(const f32x4*)(conv_w + tp * 4096 + ch), w1 = *(const f32x4*)(conv_w + tp * 4096 + ch + 4);
                    a[0] += bflo(r.x) * w0.x; a[1] += bfhi(r.x) * w0.y; a[2] += bflo(r.y) * w0.z; a[3] += bfhi(r.y) * w0.w; a[4] += bflo(r.z) * w1.x; a[5] += bfhi(r.z) * w1.y; a[6] += bflo(r.w) * w1.z; a[7] += bfhi(r.w) * w1.w; } }
            float ss = 0.f;
#pragma unroll
            for (int e = 0; e < 8; ++e) { a[e] = siluf(a[e]); ss += a[e] * a[e]; }
            if (j < 4) { ss += __shfl_xor(ss, 1); ss += __shfl_xor(ss, 2); ss += __shfl_xor(ss, 4); ss += __shfl_xor(ss, 8);
                const float sc = (1.0f / sqrtf(ss + EPS)) * (j < 2 ? 0.08838834764831845f : 1.0f);
#pragma unroll
                for (int e = 0; e < 8; ++e) a[e] *= sc; }
            u32x4 o; o.x = pk2(a[0], a[1]); o.y = pk2(a[2], a[3]); o.z = pk2(a[4], a[5]); o.w = pk2(a[6], a[7]);
            bf16_t* dst = j < 2 ? qn + (size_t)m * 1024 + ch : (j < 4 ? kn + (size_t)m * 1024 + (ch - 1024) : vc + (size_t)m * 2048 + (ch - 2048));
            *(u32x4*)dst = o; }
    }
}

constexpr int TB = 16;
template <bool GDN>
DI void p3_recurrence(Frame& F, int u  ) {
    const int b = u >> 2, h = 2 * (u & 3) + (F.tid >> 8), e = F.tid & 255, hh = F.tid >> 8;
    bf16_t* pj = (bf16_t*)(F.ws + WS_BIG + BIG_PJ);
    const bf16_t* qsrc = GDN ? (const bf16_t*)(F.ws + AUX_QN) : pj + C_RQ; const bf16_t* ksrc = GDN ? (const bf16_t*)(F.ws + AUX_KN) : pj + C_RK;
    const int qld = GDN ? 1024 : PJW;
    bf16_t* vsrc = GDN ? (bf16_t*)(F.ws + AUX_VC) : pj + C_RV; const int vld = GDN ? 2048 : PJW;
    const float* bg = (const float*)(F.ws + AUX_BG);
    LAS float* qs = (LAS float*)F.lds;
    LAS float* ks = qs + 2 * TB * 128;
    LAS float* ab = ks + 2 * TB * 128;
    LAS float* vs = ab + 2 * TB * 2;
    float S[128];
#pragma unroll
    for (int d = 0; d < 128; ++d) S[d] = 0.f;
    const float gam = GDN ? 0.f : (1.0f - exp2f(-5.0f - (float)h));
    for (int t0 = 0; t0 < SEQ; t0 += TB) {
        const size_t r0 = (size_t)b * SEQ + t0;
        __syncthreads();
        for (int i = F.tid; i < 2 * TB * 128; i += NTHR) { const int h2 = i / (TB * 128), tt = (i / 128) % TB, d = i % 128; const int hd = 2 * (u & 3) + h2;
            qs[i] = bf2f(qsrc[(r0 + tt) * qld + hd * 128 + d]); ks[i] = bf2f(ksrc[(r0 + tt) * qld + hd * 128 + d]); }
        for (int i = F.tid; i < 2 * TB * 256; i += NTHR) { const int h2 = i / (TB * 256), tt = (i / 256) % TB, ee = i % 256; vs[i] = bf2f(vsrc[(r0 + tt) * vld + (2 * (u & 3) + h2) * 256 + ee]); }
        if (GDN && F.tid < 2 * TB) { const int h2 = F.tid / TB, tt = F.tid % TB, hd = 2 * (u & 3) + h2; ab[F.tid * 2] = __expf(bg[(r0 + tt) * 16 + 8 + hd]); ab[F.tid * 2 + 1] = bg[(r0 + tt) * 16 + hd]; }
        __syncthreads();
#pragma unroll 1
        for (int tt = 0; tt < TB; ++tt) {
            const LAS f32x4* q4 = (const LAS f32x4*)(qs + (hh * TB + tt) * 128); const LAS f32x4* k4 = (const LAS f32x4*)(ks + (hh * TB + tt) * 128);
            const float v = vs[(hh * TB + tt) * 256 + e];
            float o = 0.f;
            if (GDN) {
                const float a = ab[(hh * TB + tt) * 2], beta = ab[(hh * TB + tt) * 2 + 1];
                float ksum = 0.f;
#pragma unroll
                for (int d4 = 0; d4 < 32; ++d4) { if ((d4 & 7) == 0) asm volatile("" ::: "memory"); const f32x4 kk = k4[d4]; ksum += (kk.x * S[4 * d4] + kk.y * S[4 * d4 + 1]) + (kk.z * S[4 * d4 + 2] + kk.w * S[4 * d4 + 3]); }
                const float r = (v - a * ksum) * beta;
#pragma unroll
                for (int d4 = 0; d4 < 32; ++d4) { if ((d4 & 3) == 0) asm volatile("" ::: "memory"); const f32x4 kk = k4[d4], qq = q4[d4];
                    S[4 * d4] = a * S[4 * d4] + r * kk.x; S[4 * d4 + 1] = a * S[4 * d4 + 1] + r * kk.y; S[4 * d4 + 2] = a * S[4 * d4 + 2] + r * kk.z; S[4 * d4 + 3] = a * S[4 * d4 + 3] + r * kk.w;
                    o += (qq.x * S[4 * d4] + qq.y * S[4 * d4 + 1]) + (qq.z * S[4 * d4 + 2] + qq.w * S[4 * d4 + 3]); }
            } else {
#pragma unroll
                for (int d4 = 0; d4 < 32; ++d4) { if ((d4 & 3) == 0) asm volatile("" ::: "memory"); const f32x4 kk = k4[d4], qq = q4[d4];
                    S[4 * d4] = gam * S[4 * d4] + v * kk.x; S[4 * d4 + 1] = gam * S[4 * d4 + 1] + v * kk.y; S[4 * d4 + 2] = gam * S[4 * d4 + 2] + v * kk.z; S[4 * d4 + 3] = gam * S[4 * d4 + 3] + v * kk.w;
                    o += (qq.x * S[4 * d4] + qq.y * S[4 * d4 + 1]) + (qq.z * S[4 * d4 + 2] + qq.w * S[4 * d4 + 3]); }
            }
            vsrc[(r0 + tt) * vld + h * 256 + e] = (bf16_t)f2bf(o);
        }
    }
}


constexpr int NCH = SEQ / 64;
DI constexpr int rowoff4c(int i) { int a = 0; for (int k = 0; k < i; ++k) a += (k + 3) / 4; return a; }
typedef short s16x4 __attribute__((ext_vector_type(4)));
DI s16x4 tr_read(unsigned lds_addr) { s16x4 r; asm volatile("ds_read_b64_tr_b16 %0, %1\n\ts_waitcnt lgkmcnt(0)" : "=&v"(r) : "v"(lds_addr) : "memory"); return r; }
DI bf16x8 cat8(s16x4 a, s16x4 b) { return __builtin_shufflevector(a, b, 0, 1, 2, 3, 4, 5, 6, 7); }
DI f32x4 mfma16(bf16x8 a, bf16x8 b, f32x4 c) { return __builtin_amdgcn_mfma_f32_16x16x32_bf16(a, b, c, 0, 0, 0); }

template <bool GDN>
DI void ga_unit(Frame& F, int unit, unsigned char* stream, float* out_f32_unused) {
    (void)out_f32_unused;
    constexpr int NF = GDN ? 56 : 40, OFF_W = 0, OFF_QG = GDN ? 16 : 0, OFF_ATT = OFF_QG + 16, OFF_KT = OFF_ATT + 8;
    int lane_o = F.lane; asm volatile("" : "+v"(lane_o));
    const int lane = lane_o, fr = lane & 15, g = lane >> 4;
    const int bh = unit / NCH, n = unit % NCH, b = bh >> 3, h = bh & 7;
    const size_t row0 = (size_t)b * SEQ + (size_t)n * 64;
    LAS unsigned char* L = F.lds + F.wave * GA_LDS_WAVE;
    LAS float* LAf = (LAS float*)L; LAS unsigned char* LA = L; LAS unsigned char* LT = L + 9216; LAS float* LG = (LAS float*)(L + 17408); LAS float* LB = LG + 64;
    const bf16_t* pj = (const bf16_t*)(F.ws + WS_BIG + BIG_PJ);
    const bf16_t* qsrc = GDN ? (const bf16_t*)(F.ws + AUX_QN) + h * 128 : pj + C_RQ + h * 128;
    const bf16_t* ksrc = GDN ? (const bf16_t*)(F.ws + AUX_KN) + h * 128 : pj + C_RK + h * 128;
    const size_t qld = GDN ? 1024 : PJW;
    unsigned char* st = stream + (size_t)unit * NF * 1024 + lane * 16;
    float gv, bv = 1.f;
    if (GDN) { const float* bg = (const float*)(F.ws + AUX_BG); gv = bg[(row0 + lane) * 16 + 8 + h]; bv = bg[(row0 + lane) * 16 + h];
#pragma unroll
        for (int o = 1; o < 64; o <<= 1) { const float t = __shfl_up(gv, o); if (lane >= o) gv += t; } }
    else gv = (float)(lane + 1) * log1pf(-exp2f(-5.0f - (float)h));
    const float gl = rdlane(gv, 63);
    LG[lane] = gv; LB[lane] = bv;
    LDS_WAIT();
    float gr[16], gcl[4], br[16];
#pragma unroll
    for (int t = 0; t < 4; ++t) { gcl[t] = LG[16 * t + fr];
#pragma unroll
        for (int r = 0; r < 4; ++r) { gr[t * 4 + r] = LG[16 * t + 4 * g + r]; br[t * 4 + r] = LB[16 * t + 4 * g + r]; } }
    bf16x8 Kf[4][4], Qf[4][4];
#pragma unroll
    for (int t = 0; t < 4; ++t)
#pragma unroll
        for (int s2 = 0; s2 < 4; ++s2) Kf[t][s2] = *(const bf16x8*)(ksrc + (row0 + 16 * t + fr) * qld + 32 * s2 + 8 * g);
    if (GDN) {
#pragma unroll
        for (int it = 0; it < 4; ++it)
#pragma unroll
            for (int jt = 0; jt <= it; ++jt) { f32x4 acc = {0.f, 0.f, 0.f, 0.f};
#pragma unroll
                for (int s2 = 0; s2 < 4; ++s2) acc = mfma16(Kf[it][s2], Kf[jt][s2], acc);
#pragma unroll
                for (int r = 0; r < 4; ++r) { const int i = 16 * it + 4 * g + r, j = 16 * jt + fr; const int q = (i + 3) >> 2; const int ro = 2 * q * (q - 1) + q * (i - 4 * q + 3);
                    if (j < i) LAf[ro * 4 + j] = br[it * 4 + r] * acc[r] * __expf(gr[it * 4 + r] - gcl[jt]); } }
    }
    asm volatile("" ::: "memory");
#pragma unroll
    for (int it = 0; it < 4; ++it) {
        asm volatile("" ::: "memory");
#pragma unroll
        for (int s2 = 0; s2 < 4; ++s2) Qf[it][s2] = *(const bf16x8*)(qsrc + (row0 + 16 * it + fr) * qld + 32 * s2 + 8 * g);
#pragma unroll
        for (int sp = 0; sp < 2; ++sp) { u32x4 w;
#pragma unroll
            for (int hf = 0; hf < 2; ++hf) { const int jt = 2 * sp + hf; float v[4] = {0.f, 0.f, 0.f, 0.f};
                if (jt <= it) { f32x4 acc = {0.f, 0.f, 0.f, 0.f};
#pragma unroll
                    for (int s2 = 0; s2 < 4; ++s2) acc = mfma16(Kf[jt][s2], Qf[it][s2], acc);
#pragma unroll
                    for (int r = 0; r < 4; ++r) { const int j = 16 * jt + 4 * g + r, i = 16 * it + fr; v[r] = (j <= i) ? acc[r] * __expf(gcl[it] - gr[jt * 4 + r]) : 0.f; } }
                if (hf == 0) { w.x = pk2(v[0], v[1]); w.y = pk2(v[2], v[3]); } else { w.z = pk2(v[0], v[1]); w.w = pk2(v[2], v[3]); } }
            *(u32x4*)(st + (OFF_ATT + it * 2 + sp) * 1024) = w; }
    }
    asm volatile("" ::: "memory");
#pragma unroll
    for (int it = 0; it < 4; ++it) { const float sc = __expf(gcl[it]); asm volatile("" ::: "memory");
#pragma unroll
        for (int s2 = 0; s2 < 4; ++s2) { const bf16_t* qp = qsrc + (row0 + 16 * it + fr) * qld + 32 * s2 + 4 * g; const u32x2 lo = *(const u32x2*)qp, hi = *(const u32x2*)(qp + 16);
            u32x4 w; w.x = pk2(bflo(lo.x) * sc, bfhi(lo.x) * sc); w.y = pk2(bflo(lo.y) * sc, bfhi(lo.y) * sc); w.z = pk2(bflo(hi.x) * sc, bfhi(hi.x) * sc); w.w = pk2(bflo(hi.y) * sc, bfhi(hi.y) * sc);
            *(u32x4*)(st + (OFF_QG + it * 4 + s2) * 1024) = w; } }
    asm volatile("" ::: "memory");
    float t[64];
    float sw_ = 1.f, su_ = 1.f;
    if (GDN) {
        LDS_WAIT();
        const LAS f32x4* LA4 = (const LAS f32x4*)LA;
#pragma unroll
        for (int i = 0; i < 64; ++i) { float acc = (lane == i) ? 1.f : 0.f; if ((i & 1) == 0) asm volatile("" ::: "memory");
#pragma unroll
            for (int m4 = 0; m4 < (i + 3) / 4; ++m4) { const f32x4 l = LA4[rowoff4c(i) + m4];
                if (4 * m4 + 0 < i) acc -= l.x * t[4 * m4 + 0]; if (4 * m4 + 1 < i) acc -= l.y * t[4 * m4 + 1]; if (4 * m4 + 2 < i) acc -= l.z * t[4 * m4 + 2]; if (4 * m4 + 3 < i) acc -= l.w * t[4 * m4 + 3]; }
            t[i] = acc; }
        su_ = bv; sw_ = bv * __expf(gv);
        LDS_WAIT();
#pragma unroll
        for (int i = 0; i < 64; ++i) *(LAS bf16_t*)(LT + (i * 64 + lane) * 2) = (bf16_t)f2bf(t[i] * sw_);
    }
    asm volatile("" ::: "memory");
    float ksc[2][2][4];
#pragma unroll
    for (int sp = 0; sp < 2; ++sp)
#pragma unroll
        for (int tp = 0; tp < 2; ++tp)
#pragma unroll
            for (int e = 0; e < 4; ++e) ksc[sp][tp][e] = __expf(gl - LG[32 * sp + 16 * tp + 4 * g + e]);
    const unsigned la_addr = (unsigned)(size_t)LA, q4 = (unsigned)((lane & 15) >> 2), p4 = (unsigned)(lane & 3);
#pragma unroll 1
    for (int p = 0; p < 2; ++p) {
        LDS_WAIT();
#pragma unroll
        for (int k = 0; k < 8; ++k) { const int row = (lane >> 3) + 8 * k, pc = lane & 7; *(LAS u32x4*)(LA + row * 128 + pc * 16) = *(const u32x4*)(ksrc + (row0 + row) * qld + 64 * p + 8 * pc); }
        LDS_WAIT();
        if (GDN) {
#pragma unroll
            for (int it = 0; it < 4; ++it) { bf16x8 Tf[2];
#pragma unroll
                for (int ks = 0; ks < 2; ++ks) Tf[ks] = *(const LAS bf16x8*)(LT + ((16 * it + fr) * 64 + 32 * ks + 8 * g) * 2);
#pragma unroll
                for (int sl = 0; sl < 2; ++sl) { u32x4 w;
#pragma unroll
                    for (int hf = 0; hf < 2; ++hf) { const int dtl = 2 * sl + hf; f32x4 acc = {0.f, 0.f, 0.f, 0.f};
#pragma unroll
                        for (int ks = 0; ks < 2; ++ks) { const s16x4 a0 = tr_read(la_addr + (32 * ks + 8 * g + q4) * 128 + dtl * 32 + p4 * 8), a1 = tr_read(la_addr + (32 * ks + 8 * g + 4 + q4) * 128 + dtl * 32 + p4 * 8);
                            acc = mfma16(cat8(a0, a1), Tf[ks], acc); }
                        if (hf == 0) { w.x = pk2(-acc[0], -acc[1]); w.y = pk2(-acc[2], -acc[3]); } else { w.z = pk2(-acc[0], -acc[1]); w.w = pk2(-acc[2], -acc[3]); } }
                    *(u32x4*)(st + (OFF_W + it * 4 + 2 * p + sl) * 1024) = w; } }
        }
#pragma unroll
        for (int dtl = 0; dtl < 4; ++dtl)
#pragma unroll
            for (int sp = 0; sp < 2; ++sp) { const s16x4 a0 = tr_read(la_addr + (32 * sp + 4 * g + q4) * 128 + dtl * 32 + p4 * 8), a1 = tr_read(la_addr + (32 * sp + 16 + 4 * g + q4) * 128 + dtl * 32 + p4 * 8);
                u32x4 w; w.x = pk2(bf2f((bf16_t)a0[0]) * ksc[sp][0][0], bf2f((bf16_t)a0[1]) * ksc[sp][0][1]); w.y = pk2(bf2f((bf16_t)a0[2]) * ksc[sp][0][2], bf2f((bf16_t)a0[3]) * ksc[sp][0][3]);
                w.z = pk2(bf2f((bf16_t)a1[0]) * ksc[sp][1][0], bf2f((bf16_t)a1[1]) * ksc[sp][1][1]); w.w = pk2(bf2f((bf16_t)a1[2]) * ksc[sp][1][2], bf2f((bf16_t)a1[3]) * ksc[sp][1][3]);
                *(u32x4*)(st + (OFF_KT + (4 * p + dtl) * 2 + sp) * 1024) = w; }
    }
    if (GDN) {
        LDS_WAIT();
#pragma unroll
        for (int i = 0; i < 64; ++i) *(LAS bf16_t*)(LT + (i * 64 + lane) * 2) = (bf16_t)f2bf(t[i] * su_);
        const bf16_t* vsrc = (const bf16_t*)(F.ws + AUX_VC) + h * 256;
        unsigned char* ub = F.ws + WS_H + (size_t)unit * 32768 + lane * 32;
#pragma unroll 1
        for (int p = 0; p < 4; ++p) {
            LDS_WAIT();
#pragma unroll
            for (int k = 0; k < 8; ++k) { const int row = (lane >> 3) + 8 * k, pc = lane & 7; *(LAS u32x4*)(LA + row * 128 + pc * 16) = *(const u32x4*)(vsrc + (row0 + row) * 2048 + 64 * p + 8 * pc); }
            LDS_WAIT();
            bf16x8 Tf[4][2];
#pragma unroll
            for (int it = 0; it < 4; ++it)
#pragma unroll
                for (int ks = 0; ks < 2; ++ks) Tf[it][ks] = *(const LAS bf16x8*)(LT + ((16 * it + fr) * 64 + 32 * ks + 8 * g) * 2);
#pragma unroll
            for (int etl = 0; etl < 4; ++etl) { bf16x8 Vf[2];
#pragma unroll
                for (int ks = 0; ks < 2; ++ks) { const s16x4 a0 = tr_read(la_addr + (32 * ks + 8 * g + q4) * 128 + etl * 32 + p4 * 8), a1 = tr_read(la_addr + (32 * ks + 8 * g + 4 + q4) * 128 + etl * 32 + p4 * 8); Vf[ks] = cat8(a0, a1); }
                u32x4 w0, w1;
#pragma unroll
                for (int it = 0; it < 4; ++it) { f32x4 acc = {0.f, 0.f, 0.f, 0.f};
#pragma unroll
                    for (int ks = 0; ks < 2; ++ks) acc = mfma16(Tf[it][ks], Vf[ks], acc);
                    const unsigned a = pk2(acc[0], acc[1]), c = pk2(acc[2], acc[3]);
                    if (it == 0) { w0.x = a; w0.y = c; } else if (it == 1) { w0.z = a; w0.w = c; } else if (it == 2) { w1.x = a; w1.y = c; } else { w1.z = a; w1.w = c; } }
                *(u32x4*)(ub + (4 * p + etl) * 2048) = w0; *(u32x4*)(ub + (4 * p + etl) * 2048 + 16) = w1; }
        }
        if (lane == 0) ((float*)(F.ws + AUX_DEC))[unit] = __expf(gl);
    }
    LDS_WAIT();
}

template <bool GDN>
DI void scan_wave(Frame& F, int bh, int sl, const unsigned char* stream) {
    constexpr int NF = GDN ? 56 : 40;
    const int lane = F.lane, fr = lane & 15, g = lane >> 4, b = bh >> 3, h = bh & 7;
    const unsigned char* sp0 = stream + (size_t)bh * NCH * NF * 1024;
    const unsigned voff = (unsigned)lane * 16u;
    const size_t orow = (GDN ? (size_t)2048 : (size_t)PJW) * 2;
    const unsigned char* obu = (GDN ? F.ws + AUX_VC : F.ws + WS_BIG + BIG_PJ + (size_t)C_RV * 2) + (size_t)b * SEQ * orow + (size_t)(h * 256 + 16 * sl) * 2;
    const unsigned ooff = (unsigned)((size_t)(4 * g) * orow) + (unsigned)fr * 2u;
    const float* decp = (const float*)(F.ws + AUX_DEC) + bh * NCH;
    float decr = 1.f; { const float gm = 1.0f - exp2f(-5.0f - (float)h); float d2 = gm * gm; d2 *= d2; d2 *= d2; d2 *= d2; d2 *= d2; d2 *= d2; decr = d2; }
    const unsigned char* ubp = F.ws + WS_H + (size_t)bh * NCH * 32768 + sl * 2048; const unsigned uoff = (unsigned)lane * 32u;
    const unsigned zoff = 0u; (void)decp; (void)decr; (void)ubp; (void)uoff; (void)zoff;
    f32x4 S0 = {0.f, 0.f, 0.f, 0.f}, S1 = S0, S2 = S0, S3 = S0, S4 = S0, S5 = S0, S6 = S0, S7 = S0;
    bf16x8 Sp0 = (bf16x8){0, 0, 0, 0, 0, 0, 0, 0}, Sp1 = Sp0, Sp2 = Sp0, Sp3 = Sp0;
    if constexpr (GDN) {
    bf16x8 r0 = (bf16x8){0, 0, 0, 0, 0, 0, 0, 0};
    bf16x8 r1 = (bf16x8){0, 0, 0, 0, 0, 0, 0, 0};
    bf16x8 r2 = (bf16x8){0, 0, 0, 0, 0, 0, 0, 0};
    bf16x8 r3 = (bf16x8){0, 0, 0, 0, 0, 0, 0, 0};
    bf16x8 r4 = (bf16x8){0, 0, 0, 0, 0, 0, 0, 0};
    bf16x8 r5 = (bf16x8){0, 0, 0, 0, 0, 0, 0, 0};
    bf16x8 r6 = (bf16x8){0, 0, 0, 0, 0, 0, 0, 0};
    bf16x8 r7 = (bf16x8){0, 0, 0, 0, 0, 0, 0, 0};
    bf16x8 r8 = (bf16x8){0, 0, 0, 0, 0, 0, 0, 0};
    bf16x8 r9 = (bf16x8){0, 0, 0, 0, 0, 0, 0, 0};
    bf16x8 r10 = (bf16x8){0, 0, 0, 0, 0, 0, 0, 0};
    bf16x8 r11 = (bf16x8){0, 0, 0, 0, 0, 0, 0, 0};
    bf16x8 r12 = (bf16x8){0, 0, 0, 0, 0, 0, 0, 0};
    bf16x8 r13 = (bf16x8){0, 0, 0, 0, 0, 0, 0, 0};
    bf16x8 r14 = (bf16x8){0, 0, 0, 0, 0, 0, 0, 0};
    bf16x8 r15 = (bf16x8){0, 0, 0, 0, 0, 0, 0, 0};
    bf16x8 r16 = (bf16x8){0, 0, 0, 0, 0, 0, 0, 0};
    bf16x8 r17 = (bf16x8){0, 0, 0, 0, 0, 0, 0, 0};
    bf16x8 r18 = (bf16x8){0, 0, 0, 0, 0, 0, 0, 0};
    bf16x8 r19 = (bf16x8){0, 0, 0, 0, 0, 0, 0, 0};
    bf16x8 r20 = (bf16x8){0, 0, 0, 0, 0, 0, 0, 0};
    bf16x8 r21 = (bf16x8){0, 0, 0, 0, 0, 0, 0, 0};
    bf16x8 r22 = (bf16x8){0, 0, 0, 0, 0, 0, 0, 0};
    bf16x8 r23 = (bf16x8){0, 0, 0, 0, 0, 0, 0, 0};
    bf16x8 r24 = (bf16x8){0, 0, 0, 0, 0, 0, 0, 0};
    bf16x8 r25 = (bf16x8){0, 0, 0, 0, 0, 0, 0, 0};
    bf16x8 r26 = (bf16x8){0, 0, 0, 0, 0, 0, 0, 0};
    bf16x8 r27 = (bf16x8){0, 0, 0, 0, 0, 0, 0, 0};
    u32x4 un0 = {0u, 0u, 0u, 0u}, un1 = {0u, 0u, 0u, 0u};
    asm volatile("global_load_dwordx4 %0, %1, %2" : "+v"(un0) : "v"(uoff), "s"(ubp) : "memory");
    asm volatile("global_load_dwordx4 %0, %1, %2 offset:16" : "+v"(un1) : "v"(uoff), "s"(ubp) : "memory");
    float decv = 0.f; asm volatile("global_load_dword %0, %1, %2" : "+v"(decv) : "v"(zoff), "s"(decp) : "memory");
    const unsigned char* spc = sp0;
    asm volatile("global_load_dwordx4 %0, %1, %2" : "+v"(r0) : "v"(voff), "s"(spc) : "memory"); spc += 1024;
    asm volatile("global_load_dwordx4 %0, %1, %2" : "+v"(r1) : "v"(voff), "s"(spc) : "memory"); spc += 1024;
    asm volatile("global_load_dwordx4 %0, %1, %2" : "+v"(r2) : "v"(voff), "s"(spc) : "memory"); spc += 1024;
    asm volatile("global_load_dwordx4 %0, %1, %2" : "+v"(r3) : "v"(voff), "s"(spc) : "memory"); spc += 1024;
    asm volatile("global_load_dwordx4 %0, %1, %2" : "+v"(r4) : "v"(voff), "s"(spc) : "memory"); spc += 1024;
    asm volatile("global_load_dwordx4 %0, %1, %2" : "+v"(r5) : "v"(voff), "s"(spc) : "memory"); spc += 1024;
    asm volatile("global_load_dwordx4 %0, %1, %2" : "+v"(r6) : "v"(voff), "s"(spc) : "memory"); spc += 1024;
    asm volatile("global_load_dwordx4 %0, %1, %2" : "+v"(r7) : "v"(voff), "s"(spc) : "memory"); spc += 1024;
    asm volatile("global_load_dwordx4 %0, %1, %2" : "+v"(r8) : "v"(voff), "s"(spc) : "memory"); spc += 1024;
    asm volatile("global_load_dwordx4 %0, %1, %2" : "+v"(r9) : "v"(voff), "s"(spc) : "memory"); spc += 1024;
    asm volatile("global_load_dwordx4 %0, %1, %2" : "+v"(r10) : "v"(voff), "s"(spc) : "memory"); spc += 1024;
    asm volatile("global_load_dwordx4 %0, %1, %2" : "+v"(r11) : "v"(voff), "s"(spc) : "memory"); spc += 1024;
    asm volatile("global_load_dwordx4 %0, %1, %2" : "+v"(r12) : "v"(voff), "s"(spc) : "memory"); spc += 1024;
    asm volatile("global_load_dwordx4 %0, %1, %2" : "+v"(r13) : "v"(voff), "s"(spc) : "memory"); spc += 1024;
    asm volatile("global_load_dwordx4 %0, %1, %2" : "+v"(r14) : "v"(voff), "s"(spc) : "memory"); spc += 1024;
    asm volatile("global_load_dwordx4 %0, %1, %2" : "+v"(r15) : "v"(voff), "s"(spc) : "memory"); spc += 1024;
    asm volatile("global_load_dwordx4 %0, %1, %2" : "+v"(r16) : "v"(voff), "s"(spc) : "memory"); spc += 1024;
    asm volatile("global_load_dwordx4 %0, %1, %2" : "+v"(r17) : "v"(voff), "s"(spc) : "memory"); spc += 1024;
    asm volatile("global_load_dwordx4 %0, %1, %2" : "+v"(r18) : "v"(voff), "s"(spc) : "memory"); spc += 1024;
    asm volatile("global_load_dwordx4 %0, %1, %2" : "+v"(r19) : "v"(voff), "s"(spc) : "memory"); spc += 1024;
    asm volatile("global_load_dwordx4 %0, %1, %2" : "+v"(r20) : "v"(voff), "s"(spc) : "memory"); spc += 1024;
    asm volatile("global_load_dwordx4 %0, %1, %2" : "+v"(r21) : "v"(voff), "s"(spc) : "memory"); spc += 1024;
    asm volatile("global_load_dwordx4 %0, %1, %2" : "+v"(r22) : "v"(voff), "s"(spc) : "memory"); spc += 1024;
    asm volatile("global_load_dwordx4 %0, %1, %2" : "+v"(r23) : "v"(voff), "s"(spc) : "memory"); spc += 1024;
    asm volatile("global_load_dwordx4 %0, %1, %2" : "+v"(r24) : "v"(voff), "s"(spc) : "memory"); spc += 1024;
    asm volatile("global_load_dwordx4 %0, %1, %2" : "+v"(r25) : "v"(voff), "s"(spc) : "memory"); spc += 1024;
    asm volatile("global_load_dwordx4 %0, %1, %2" : "+v"(r26) : "v"(voff), "s"(spc) : "memory"); spc += 1024;
    asm volatile("global_load_dwordx4 %0, %1, %2" : "+v"(r27) : "v"(voff), "s"(spc) : "memory"); spc += 1024;
    { unsigned z = 0u;
      asm volatile("global_store_short %0, %1, %2" :: "v"(ooff), "v"(z), "s"(obu + (size_t)(0) * orow) : "memory");
      asm volatile("global_store_short %0, %1, %2" :: "v"(ooff), "v"(z), "s"(obu + (size_t)(1) * orow) : "memory");
      asm volatile("global_store_short %0, %1, %2" :: "v"(ooff), "v"(z), "s"(obu + (size_t)(2) * orow) : "memory");
      asm volatile("global_store_short %0, %1, %2" :: "v"(ooff), "v"(z), "s"(obu + (size_t)(3) * orow) : "memory");
      asm volatile("global_store_short %0, %1, %2" :: "v"(ooff), "v"(z), "s"(obu + (size_t)(16) * orow) : "memory");
      asm volatile("global_store_short %0, %1, %2" :: "v"(ooff), "v"(z), "s"(obu + (size_t)(17) * orow) : "memory");
      asm volatile("global_store_short %0, %1, %2" :: "v"(ooff), "v"(z), "s"(obu + (size_t)(18) * orow) : "memory");
      asm volatile("global_store_short %0, %1, %2" :: "v"(ooff), "v"(z), "s"(obu + (size_t)(19) * orow) : "memory");
      asm volatile("global_store_short %0, %1, %2" :: "v"(ooff), "v"(z), "s"(obu + (size_t)(32) * orow) : "memory");
      asm volatile("global_store_short %0, %1, %2" :: "v"(ooff), "v"(z), "s"(obu + (size_t)(33) * orow) : "memory");
      asm volatile("global_store_short %0, %1, %2" :: "v"(ooff), "v"(z), "s"(obu + (size_t)(34) * orow) : "memory");
      asm volatile("global_store_short %0, %1, %2" :: "v"(ooff), "v"(z), "s"(obu + (size_t)(35) * orow) : "memory");
      asm volatile("global_store_short %0, %1, %2" :: "v"(ooff), "v"(z), "s"(obu + (size_t)(48) * orow) : "memory");
      asm volatile("global_store_short %0, %1, %2" :: "v"(ooff), "v"(z), "s"(obu + (size_t)(49) * orow) : "memory");
      asm volatile("global_store_short %0, %1, %2" :: "v"(ooff), "v"(z), "s"(obu + (size_t)(50) * orow) : "memory");
      asm volatile("global_store_short %0, %1, %2" :: "v"(ooff), "v"(z), "s"(obu + (size_t)(51) * orow) : "memory");
    }
#pragma unroll 1
    for (int n = 0; n < NCH; ++n) {
        f32x4 a1_0, a1_1, a1_2, a1_3;
        asm volatile("s_waitcnt vmcnt(44)" : "+v"(un0), "+v"(un1), "+v"(decv));
        a1_0 = (f32x4){bflo(un0.x), bfhi(un0.x), bflo(un0.y), bfhi(un0.y)}; a1_1 = (f32x4){bflo(un0.z), bfhi(un0.z), bflo(un0.w), bfhi(un0.w)};
        a1_2 = (f32x4){bflo(un1.x), bfhi(un1.x), bflo(un1.y), bfhi(un1.y)}; a1_3 = (f32x4){bflo(un1.z), bfhi(un1.z), bflo(un1.w), bfhi(un1.w)};
        const float dec = decv;
        { const unsigned char* ubn = ubp + (size_t)(n + 1 < NCH ? n + 1 : n) * 32768;
          asm volatile("global_load_dwordx4 %0, %1, %2" : "+v"(un0) : "v"(uoff), "s"(ubn) : "memory");
          asm volatile("global_load_dwordx4 %0, %1, %2 offset:16" : "+v"(un1) : "v"(uoff), "s"(ubn) : "memory");
          asm volatile("global_load_dword %0, %1, %2" : "+v"(decv) : "v"(zoff), "s"(decp + (n + 1 < NCH ? n + 1 : n)) : "memory"); }
        __builtin_amdgcn_sched_barrier(0);
        asm volatile("s_waitcnt vmcnt(46)" : "+v"(r0));
        a1_0 = mfma16(r0, Sp0, a1_0);
        asm volatile("global_load_dwordx4 %0, %1, %2" : "+v"(r0) : "v"(voff), "s"(spc) : "memory"); spc += 1024;
        __builtin_amdgcn_sched_barrier(0);
        asm volatile("s_waitcnt vmcnt(46)" : "+v"(r1));
        a1_0 = mfma16(r1, Sp1, a1_0);
        asm volatile("global_load_dwordx4 %0, %1, %2" : "+v"(r1) : "v"(voff), "s"(spc) : "memory"); spc += 1024;
        __builtin_amdgcn_sched_barrier(0);
        asm volatile("s_waitcnt vmcnt(46)" : "+v"(r2));
        a1_0 = mfma16(r2, Sp2, a1_0);
        asm volatile("global_load_dwordx4 %0, %1, %2" : "+v"(r2) : "v"(voff), "s"(spc) : "memory"); spc += 1024;
        __builtin_amdgcn_sched_barrier(0);
        asm volatile("s_waitcnt vmcnt(46)" : "+v"(r3));
        a1_0 = mfma16(r3, Sp3, a1_0);
        asm volatile("global_load_dwordx4 %0, %1, %2" : "+v"(r3) : "v"(voff), "s"(spc) : "memory"); spc += 1024;
        __builtin_amdgcn_sched_barrier(0);
        asm volatile("s_waitcnt vmcnt(46)" : "+v"(r4));
        a1_1 = mfma16(r4, Sp0, a1_1);
        asm volatile("global_load_dwordx4 %0, %1, %2" : "+v"(r4) : "v"(voff), "s"(spc) : "memory"); spc += 1024;
        __builtin_amdgcn_sched_barrier(0);
        asm volatile("s_waitcnt vmcnt(46)" : "+v"(r5));
        a1_1 = mfma16(r5, Sp1, a1_1);
        asm volatile("global_load_dwordx4 %0, %1, %2" : "+v"(r5) : "v"(voff), "s"(spc) : "memory"); spc += 1024;
        __builtin_amdgcn_sched_barrier(0);
        asm volatile("s_waitcnt vmcnt(46)" : "+v"(r6));
        a1_1 = mfma16(r6, Sp2, a1_1);
        asm volatile("global_load_dwordx4 %0, %1, %2" : "+v"(r6) : "v"(voff), "s"(spc) : "memory"); spc += 1024;
        __builtin_amdgcn_sched_barrier(0);
        asm volatile("s_waitcnt vmcnt(46)" : "+v"(r7));
        a1_1 = mfma16(r7, Sp3, a1_1);
        asm volatile("global_load_dwordx4 %0, %1, %2" : "+v"(r7) : "v"(voff), "s"(spc) : "memory"); spc += 1024;
        __builtin_amdgcn_sched_barrier(0);
        asm volatile("s_waitcnt vmcnt(46)" : "+v"(r8));
        a1_2 = mfma16(r8, Sp0, a1_2);
        asm volatile("global_load_dwordx4 %0, %1, %2" : "+v"(r8) : "v"(voff), "s"(spc) : "memory"); spc += 1024;
        __builtin_amdgcn_sched_barrier(0);
        asm volatile("s_waitcnt vmcnt(46)" : "+v"(r9));
        a1_2 = mfma16(r9, Sp1, a1_2);
        asm volatile("global_load_dwordx4 %0, %1, %2" : "+v"(r9) : "v"(voff), "s"(spc) : "memory"); spc += 1024;
        __builtin_amdgcn_sched_barrier(0);
        asm volatile("s_waitcnt vmcnt(46)" : "+v"(r10));
        a1_2 = mfma16(r10, Sp2, a1_2);
        asm volatile("global_load_dwordx4 %0, %1, %2" : "+v"(r10) : "v"(voff), "s"(spc) : "memory"); spc += 1024;
        __builtin_amdgcn_sched_barrier(0);
        asm volatile("s_waitcnt vmcnt(46)" : "+v"(r11));
        a1_2 = mfma16(r11, Sp3, a1_2);
        asm volatile("global_load_dwordx4 %0, %1, %2" : "+v"(r11) : "v"(voff), "s"(spc) : "memory"); spc += 1024;
        __builtin_amdgcn_sched_barrier(0);
        asm volatile("s_waitcnt vmcnt(30)" : "+v"(r12));
        a1_3 = mfma16(r12, Sp0, a1_3);
        asm volatile("global_load_dwordx4 %0, %1, %2" : "+v"(r12) : "v"(voff), "s"(spc) : "memory"); spc += 1024;
        __builtin_amdgcn_sched_barrier(0);
        asm volatile("s_waitcnt vmcnt(30)" : "+v"(r13));
        a1_3 = mfma16(r13, Sp1, a1_3);
        asm volatile("global_load_dwordx4 %0, %1, %2" : "+v"(r13) : "v"(voff), "s"(spc) : "memory"); spc += 1024;
        __builtin_amdgcn_sched_barrier(0);
        asm volatile("s_waitcnt vmcnt(30)" : "+v"(r14));
        a1_3 = mfma16(r14, Sp2, a1_3);
        asm volatile("global_load_dwordx4 %0, %1, %2" : "+v"(r14) : "v"(voff), "s"(spc) : "memory"); spc += 1024;
        __builtin_amdgcn_sched_barrier(0);
        asm volatile("s_waitcnt vmcnt(30)" : "+v"(r15));
        a1_3 = mfma16(r15, Sp3, a1_3);
        asm volatile("global_load_dwordx4 %0, %1, %2" : "+v"(r15) : "v"(voff), "s"(spc) : "memory"); spc += 1024;
        __builtin_amdgcn_sched_barrier(0);
        bf16x8 vp0, vp1;
        { u32x4 w; w.x = cvt_pk_bf16(a1_0[0], a1_0[1]); w.y = cvt_pk_bf16(a1_0[2], a1_0[3]); w.z = cvt_pk_bf16(a1_1[0], a1_1[1]); w.w = cvt_pk_bf16(a1_1[2], a1_1[3]); vp0 = __builtin_bit_cast(bf16x8, w); }
        { u32x4 w; w.x = cvt_pk_bf16(a1_2[0], a1_2[1]); w.y = cvt_pk_bf16(a1_2[2], a1_2[3]); w.z = cvt_pk_bf16(a1_3[0], a1_3[1]); w.w = cvt_pk_bf16(a1_3[2], a1_3[3]); vp1 = __builtin_bit_cast(bf16x8, w); }
        f32x4 o0 = {0.f, 0.f, 0.f, 0.f}, o1 = o0, o2 = o0, o3 = o0;
        asm volatile("s_waitcnt vmcnt(30)" : "+v"(r16));
        o0 = mfma16(r16, Sp0, o0);
        asm volatile("global_load_dwordx4 %0, %1, %2" : "+v"(r16) : "v"(voff), "s"(spc) : "memory"); spc += 1024;
        __builtin_amdgcn_sched_barrier(0);
        asm volatile("s_waitcnt vmcnt(30)" : "+v"(r17));
        o0 = mfma16(r17, Sp1, o0);
        asm volatile("global_load_dwordx4 %0, %1, %2" : "+v"(r17) : "v"(voff), "s"(spc) : "memory"); spc += 1024;
        __builtin_amdgcn_sched_barrier(0);
        asm volatile("s_waitcnt vmcnt(30)" : "+v"(r18));
        o0 = mfma16(r18, Sp2, o0);
        asm volatile("global_load_dwordx4 %0, %1, %2" : "+v"(r18) : "v"(voff), "s"(spc) : "memory"); spc += 1024;
        __builtin_amdgcn_sched_barrier(0);
        asm volatile("s_waitcnt vmcnt(30)" : "+v"(r19));
        o0 = mfma16(r19, Sp3, o0);
        asm volatile("global_load_dwordx4 %0, %1, %2" : "+v"(r19) : "v"(voff), "s"(spc) : "memory"); spc += 1024;
        __builtin_amdgcn_sched_barrier(0);
        asm volatile("s_waitcnt vmcnt(30)" : "+v"(r20));
        o1 = mfma16(r20, Sp0, o1);
        asm volatile("global_load_dwordx4 %0, %1, %2" : "+v"(r20) : "v"(voff), "s"(spc) : "memory"); spc += 1024;
        __builtin_amdgcn_sched_barrier(0);
        asm volatile("s_waitcnt vmcnt(30)" : "+v"(r21));
        o1 = mfma16(r21, Sp1, o1);
        asm volatile("global_load_dwordx4 %0, %1, %2" : "+v"(r21) : "v"(voff), "s"(spc) : "memory"); spc += 1024;
        __builtin_amdgcn_sched_barrier(0);
        asm volatile("s_waitcnt vmcnt(30)" : "+v"(r22));
        o1 = mfma16(r22, Sp2, o1);
        asm volatile("global_load_dwordx4 %0, %1, %2" : "+v"(r22) : "v"(voff), "s"(spc) : "memory"); spc += 1024;
        __builtin_amdgcn_sched_barrier(0);
        asm volatile("s_waitcnt vmcnt(30)" : "+v"(r23));
        o1 = mfma16(r23, Sp3, o1);
        asm volatile("global_load_dwordx4 %0, %1, %2" : "+v"(r23) : "v"(voff), "s"(spc) : "memory"); spc += 1024;
        __builtin_amdgcn_sched_barrier(0);
        asm volatile("s_waitcnt vmcnt(30)" : "+v"(r24));
        o2 = mfma16(r24, Sp0, o2);
        asm volatile("global_load_dwordx4 %0, %1, %2" : "+v"(r24) : "v"(voff), "s"(spc) : "memory"); spc += 1024;
        __builtin_amdgcn_sched_barrier(0);
        asm volatile("s_waitcnt vmcnt(30)" : "+v"(r25));
        o2 = mfma16(r25, Sp1, o2);
        asm volatile("global_load_dwordx4 %0, %1, %2" : "+v"(r25) : "v"(voff), "s"(spc) : "memory"); spc += 1024;
        __builtin_amdgcn_sched_barrier(0);
        asm volatile("s_waitcnt vmcnt(30)" : "+v"(r26));
        o2 = mfma16(r26, Sp2, o2);
        asm volatile("global_load_dwordx4 %0, %1, %2" : "+v"(r26) : "v"(voff), "s"(spc) : "memory"); spc += 1024;
        __builtin_amdgcn_sched_barrier(0);
        asm volatile("s_waitcnt vmcnt(30)" : "+v"(r27));
        o2 = mfma16(r27, Sp3, o2);
        asm volatile("global_load_dwordx4 %0, %1, %2" : "+v"(r27) : "v"(voff), "s"(spc) : "memory"); spc += 1024;
        __builtin_amdgcn_sched_barrier(0);
        asm volatile("s_waitcnt vmcnt(27)" : "+v"(r0));
        o3 = mfma16(r0, Sp0, o3);
        asm volatile("global_load_dwordx4 %0, %1, %2" : "+v"(r0) : "v"(voff), "s"(spc) : "memory"); spc += 1024;
        __builtin_amdgcn_sched_barrier(0);
        asm volatile("s_waitcnt vmcnt(27)" : "+v"(r1));
        o3 = mfma16(r1, Sp1, o3);
        asm volatile("global_load_dwordx4 %0, %1, %2" : "+v"(r1) : "v"(voff), "s"(spc) : "memory"); spc += 1024;
        __builtin_amdgcn_sched_barrier(0);
        asm volatile("s_waitcnt vmcnt(27)" : "+v"(r2));
        o3 = mfma16(r2, Sp2, o3);
        asm volatile("global_load_dwordx4 %0, %1, %2" : "+v"(r2) : "v"(voff), "s"(spc) : "memory"); spc += 1024;
        __builtin_amdgcn_sched_barrier(0);
        asm volatile("s_waitcnt vmcnt(27)" : "+v"(r3));
        o3 = mfma16(r3, Sp3, o3);
        asm volatile("global_load_dwordx4 %0, %1, %2" : "+v"(r3) : "v"(voff), "s"(spc) : "memory"); spc += 1024;
        __builtin_amdgcn_sched_barrier(0);
        asm volatile("s_waitcnt vmcnt(27)" : "+v"(r4));
        o0 = mfma16(r4, vp0, o0);
        asm volatile("global_load_dwordx4 %0, %1, %2" : "+v"(r4) : "v"(voff), "s"(spc) : "memory"); spc += 1024;
        __builtin_amdgcn_sched_barrier(0);
        asm volatile("s_waitcnt vmcnt(27)" : "+v"(r5));
        o0 = mfma16(r5, vp1, o0);
        asm volatile("global_load_dwordx4 %0, %1, %2" : "+v"(r5) : "v"(voff), "s"(spc) : "memory"); spc += 1024;
        __builtin_amdgcn_sched_barrier(0);
        asm volatile("s_waitcnt vmcnt(27)" : "+v"(r6));
        o1 = mfma16(r6, vp0, o1);
        asm volatile("global_load_dwordx4 %0, %1, %2" : "+v"(r6) : "v"(voff), "s"(spc) : "memory"); spc += 1024;
        __builtin_amdgcn_sched_barrier(0);
        asm volatile("s_waitcnt vmcnt(27)" : "+v"(r7));
        o1 = mfma16(r7, vp1, o1);
        asm volatile("global_load_dwordx4 %0, %1, %2" : "+v"(r7) : "v"(voff), "s"(spc) : "memory"); spc += 1024;
        __builtin_amdgcn_sched_barrier(0);
        asm volatile("s_waitcnt vmcnt(27)" : "+v"(r8));
        o2 = mfma16(r8, vp0, o2);
        asm volatile("global_load_dwordx4 %0, %1, %2" : "+v"(r8) : "v"(voff), "s"(spc) : "memory"); spc += 1024;
        __builtin_amdgcn_sched_barrier(0);
        asm volatile("s_waitcnt vmcnt(27)" : "+v"(r9));
        o2 = mfma16(r9, vp1, o2);
        asm volatile("global_load_dwordx4 %0, %1, %2" : "+v"(r9) : "v"(voff), "s"(spc) : "memory"); spc += 1024;
        __builtin_amdgcn_sched_barrier(0);
        asm volatile("s_waitcnt vmcnt(27)" : "+v"(r10));
        o3 = mfma16(r10, vp0, o3);
        asm volatile("global_load_dwordx4 %0, %1, %2" : "+v"(r10) : "v"(voff), "s"(spc) : "memory"); spc += 1024;
        __builtin_amdgcn_sched_barrier(0);
        asm volatile("s_waitcnt vmcnt(27)" : "+v"(r11));
        o3 = mfma16(r11, vp1, o3);
        asm volatile("global_load_dwordx4 %0, %1, %2" : "+v"(r11) : "v"(voff), "s"(spc) : "memory"); spc += 1024;
        __builtin_amdgcn_sched_barrier(0);
        { const unsigned char* obn = obu + (size_t)n * 64 * orow;
          { const unsigned v = f2bf(o0[0]); asm volatile("global_store_short %0, %1, %2" :: "v"(ooff), "v"(v), "s"(obn + (size_t)(0) * orow) : "memory"); }
          { const unsigned v = f2bf(o0[1]); asm volatile("global_store_short %0, %1, %2" :: "v"(ooff), "v"(v), "s"(obn + (size_t)(1) * orow) : "memory"); }
          { const unsigned v = f2bf(o0[2]); asm volatile("global_store_short %0, %1, %2" :: "v"(ooff), "v"(v), "s"(obn + (size_t)(2) * orow) : "memory"); }
          { const unsigned v = f2bf(o0[3]); asm volatile("global_store_short %0, %1, %2" :: "v"(ooff), "v"(v), "s"(obn + (size_t)(3) * orow) : "memory"); }
          { const unsigned v = f2bf(o1[0]); asm volatile("global_store_short %0, %1, %2" :: "v"(ooff), "v"(v), "s"(obn + (size_t)(16) * orow) : "memory"); }
          { const unsigned v = f2bf(o1[1]); asm volatile("global_store_short %0, %1, %2" :: "v"(ooff), "v"(v), "s"(obn + (size_t)(17) * orow) : "memory"); }
          { const unsigned v = f2bf(o1[2]); asm volatile("global_store_short %0, %1, %2" :: "v"(ooff), "v"(v), "s"(obn + (size_t)(18) * orow) : "memory"); }
          { const unsigned v = f2bf(o1[3]); asm volatile("global_store_short %0, %1, %2" :: "v"(ooff), "v"(v), "s"(obn + (size_t)(19) * orow) : "memory"); }
          { const unsigned v = f2bf(o2[0]); asm volatile("global_store_short %0, %1, %2" :: "v"(ooff), "v"(v), "s"(obn + (size_t)(32) * orow) : "memory"); }
          { const unsigned v = f2bf(o2[1]); asm volatile("global_store_short %0, %1, %2" :: "v"(ooff), "v"(v), "s"(obn + (size_t)(33) * orow) : "memory"); }
          { const unsigned v = f2bf(o2[2]); asm volatile("global_store_short %0, %1, %2" :: "v"(ooff), "v"(v), "s"(obn + (size_t)(34) * orow) : "memory"); }
          { const unsigned v = f2bf(o2[3]); asm volatile("global_store_short %0, %1, %2" :: "v"(ooff), "v"(v), "s"(obn + (size_t)(35) * orow) : "memory"); }
          { const unsigned v = f2bf(o3[0]); asm volatile("global_store_short %0, %1, %2" :: "v"(ooff), "v"(v), "s"(obn + (size_t)(48) * orow) : "memory"); }
          { const unsigned v = f2bf(o3[1]); asm volatile("global_store_short %0, %1, %2" :: "v"(ooff), "v"(v), "s"(obn + (size_t)(49) * orow) : "memory"); }
          { const unsigned v = f2bf(o3[2]); asm volatile("global_store_short %0, %1, %2" :: "v"(ooff), "v"(v), "s"(obn + (size_t)(50) * orow) : "memory"); }
          { const unsigned v = f2bf(o3[3]); asm volatile("global_store_short %0, %1, %2" :: "v"(ooff), "v"(v), "s"(obn + (size_t)(51) * orow) : "memory"); }
        }
        __builtin_amdgcn_sched_barrier(0);
        S0 = S0 * dec;
        asm volatile("s_waitcnt vmcnt(43)" : "+v"(r12));
        S0 = mfma16(r12, vp0, S0);
        asm volatile("global_load_dwordx4 %0, %1, %2" : "+v"(r12) : "v"(voff), "s"(spc) : "memory"); spc += 1024;
        __builtin_amdgcn_sched_barrier(0);
        asm volatile("s_waitcnt vmcnt(43)" : "+v"(r13));
        S0 = mfma16(r13, vp1, S0);
        asm volatile("global_load_dwordx4 %0, %1, %2" : "+v"(r13) : "v"(voff), "s"(spc) : "memory"); spc += 1024;
        __builtin_amdgcn_sched_barrier(0);
        S1 = S1 * dec;
        asm volatile("s_waitcnt vmcnt(43)" : "+v"(r14));
        S1 = mfma16(r14, vp0, S1);
        asm volatile("global_load_dwordx4 %0, %1, %2" : "+v"(r14) : "v"(voff), "s"(spc) : "memory"); spc += 1024;
        __builtin_amdgcn_sched_barrier(0);
        asm volatile("s_waitcnt vmcnt(43)" : "+v"(r15));
        S1 = mfma16(r15, vp1, S1);
        asm volatile("global_load_dwordx4 %0, %1, %2" : "+v"(r15) : "v"(voff), "s"(spc) : "memory"); spc += 1024;
        __builtin_amdgcn_sched_barrier(0);
        S2 = S2 * dec;
        asm volatile("s_waitcnt vmcnt(43)" : "+v"(r16));
        S2 = mfma16(r16, vp0, S2);
        asm volatile("global_load_dwordx4 %0, %1, %2" : "+v"(r16) : "v"(voff), "s"(spc) : "memory"); spc += 1024;
        __builtin_amdgcn_sched_barrier(0);
        asm volatile("s_waitcnt vmcnt(43)" : "+v"(r17));
        S2 = mfma16(r17, vp1, S2);
        asm volatile("global_load_dwordx4 %0, %1, %2" : "+v"(r17) : "v"(voff), "s"(spc) : "memory"); spc += 1024;
        __builtin_amdgcn_sched_barrier(0);
        S3 = S3 * dec;
        asm volatile("s_waitcnt vmcnt(43)" : "+v"(r18));
        S3 = mfma16(r18, vp0, S3);
        asm volatile("global_load_dwordx4 %0, %1, %2" : "+v"(r18) : "v"(voff), "s"(spc) : "memory"); spc += 1024;
        __builtin_amdgcn_sched_barrier(0);
        asm volatile("s_waitcnt vmcnt(43)" : "+v"(r19));
        S3 = mfma16(r19, vp1, S3);
        asm volatile("global_load_dwordx4 %0, %1, %2" : "+v"(r19) : "v"(voff), "s"(spc) : "memory"); spc += 1024;
        __builtin_amdgcn_sched_barrier(0);
        S4 = S4 * dec;
        asm volatile("s_waitcnt vmcnt(43)" : "+v"(r20));
        S4 = mfma16(r20, vp0, S4);
        asm volatile("global_load_dwordx4 %0, %1, %2" : "+v"(r20) : "v"(voff), "s"(spc) : "memory"); spc += 1024;
        __builtin_amdgcn_sched_barrier(0);
        asm volatile("s_waitcnt vmcnt(43)" : "+v"(r21));
        S4 = mfma16(r21, vp1, S4);
        asm volatile("global_load_dwordx4 %0, %1, %2" : "+v"(r21) : "v"(voff), "s"(spc) : "memory"); spc += 1024;
        __builtin_amdgcn_sched_barrier(0);
        S5 = S5 * dec;
        asm volatile("s_waitcnt vmcnt(43)" : "+v"(r22));
        S5 = mfma16(r22, vp0, S5);
        asm volatile("global_load_dwordx4 %0, %1, %2" : "+v"(r22) : "v"(voff), "s"(spc) : "memory"); spc += 1024;
        __builtin_amdgcn_sched_barrier(0);
        asm volatile("s_waitcnt vmcnt(43)" : "+v"(r23));
        S5 = mfma16(r23, vp1, S5);
        asm volatile("global_load_dwordx4 %0, %1, %2" : "+v"(r23) : "v"(voff), "s"(spc) : "memory"); spc += 1024;
        __builtin_amdgcn_sched_barrier(0);
        S6 = S6 * dec;
        asm volatile("s_waitcnt vmcnt(43)" : "+v"(r24));
        S6 = mfma16(r24, vp0, S6);
        asm volatile("global_load_dwordx4 %0, %1, %2" : "+v"(r24) : "v"(voff), "s"(spc) : "memory"); spc += 1024;
        __builtin_amdgcn_sched_barrier(0);
        asm volatile("s_waitcnt vmcnt(43)" : "+v"(r25));
        S6 = mfma16(r25, vp1, S6);
        asm volatile("global_load_dwordx4 %0, %1, %2" : "+v"(r25) : "v"(voff), "s"(spc) : "memory"); spc += 1024;
        __builtin_amdgcn_sched_barrier(0);
        S7 = S7 * dec;
        asm volatile("s_waitcnt vmcnt(43)" : "+v"(r26));
        S7 = mfma16(r26, vp0, S7);
        asm volatile("global_load_dwordx4 %0, %1, %2" : "+v"(r26) : "v"(voff), "s"(spc) : "memory"); spc += 1024;
        __builtin_amdgcn_sched_barrier(0);
        asm volatile("s_waitcnt vmcnt(43)" : "+v"(r27));
        S7 = mfma16(r27, vp1, S7);
        asm volatile("global_load_dwordx4 %0, %1, %2" : "+v"(r27) : "v"(voff), "s"(spc) : "memory"); spc += 1024;
        __builtin_amdgcn_sched_barrier(0);
        { u32x4 w; w.x = cvt_pk_bf16(S0[0], S0[1]); w.y = cvt_pk_bf16(S0[2], S0[3]); w.z = cvt_pk_bf16(S1[0], S1[1]); w.w = cvt_pk_bf16(S1[2], S1[3]); Sp0 = __builtin_bit_cast(bf16x8, w); }
        { u32x4 w; w.x = cvt_pk_bf16(S2[0], S2[1]); w.y = cvt_pk_bf16(S2[2], S2[3]); w.z = cvt_pk_bf16(S3[0], S3[1]); w.w = cvt_pk_bf16(S3[2], S3[3]); Sp1 = __builtin_bit_cast(bf16x8, w); }
        { u32x4 w; w.x = cvt_pk_bf16(S4[0], S4[1]); w.y = cvt_pk_bf16(S4[2], S4[3]); w.z = cvt_pk_bf16(S5[0], S5[1]); w.w = cvt_pk_bf16(S5[2], S5[3]); Sp2 = __builtin_bit_cast(bf16x8, w); }
        { u32x4 w; w.x = cvt_pk_bf16(S6[0], S6[1]); w.y = cvt_pk_bf16(S6[2], S6[3]); w.z = cvt_pk_bf16(S7[0], S7[1]); w.w = cvt_pk_bf16(S7[2], S7[3]); Sp3 = __builtin_bit_cast(bf16x8, w); }
    }
    asm volatile("s_waitcnt vmcnt(0)" ::: "memory");
    } else {
    bf16x8 r0 = (bf16x8){0, 0, 0, 0, 0, 0, 0, 0};
    bf16x8 r1 = (bf16x8){0, 0, 0, 0, 0, 0, 0, 0};
    bf16x8 r2 = (bf16x8){0, 0, 0, 0, 0, 0, 0, 0};
    bf16x8 r3 = (bf16x8){0, 0, 0, 0, 0, 0, 0, 0};
    bf16x8 r4 = (bf16x8){0, 0, 0, 0, 0, 0, 0, 0};
    bf16x8 r5 = (bf16x8){0, 0, 0, 0, 0, 0, 0, 0};
    bf16x8 r6 = (bf16x8){0, 0, 0, 0, 0, 0, 0, 0};
    bf16x8 r7 = (bf16x8){0, 0, 0, 0, 0, 0, 0, 0};
    bf16x8 r8 = (bf16x8){0, 0, 0, 0, 0, 0, 0, 0};
    bf16x8 r9 = (bf16x8){0, 0, 0, 0, 0, 0, 0, 0};
    bf16x8 r10 = (bf16x8){0, 0, 0, 0, 0, 0, 0, 0};
    bf16x8 r11 = (bf16x8){0, 0, 0, 0, 0, 0, 0, 0};
    bf16x8 r12 = (bf16x8){0, 0, 0, 0, 0, 0, 0, 0};
    bf16x8 r13 = (bf16x8){0, 0, 0, 0, 0, 0, 0, 0};
    bf16x8 r14 = (bf16x8){0, 0, 0, 0, 0, 0, 0, 0};
    bf16x8 r15 = (bf16x8){0, 0, 0, 0, 0, 0, 0, 0};
    bf16x8 r16 = (bf16x8){0, 0, 0, 0, 0, 0, 0, 0};
    bf16x8 r17 = (bf16x8){0, 0, 0, 0, 0, 0, 0, 0};
    bf16x8 r18 = (bf16x8){0, 0, 0, 0, 0, 0, 0, 0};
    bf16x8 r19 = (bf16x8){0, 0, 0, 0, 0, 0, 0, 0};
    unsigned vn0 = 0u; asm volatile("global_load_ushort %0, %1, %2" : "+v"(vn0) : "v"(ooff), "s"(obu + (size_t)(0) * orow) : "memory");
    unsigned vn1 = 0u; asm volatile("global_load_ushort %0, %1, %2" : "+v"(vn1) : "v"(ooff), "s"(obu + (size_t)(1) * orow) : "memory");
    unsigned vn2 = 0u; asm volatile("global_load_ushort %0, %1, %2" : "+v"(vn2) : "v"(ooff), "s"(obu + (size_t)(2) * orow) : "memory");
    unsigned vn3 = 0u; asm volatile("global_load_ushort %0, %1, %2" : "+v"(vn3) : "v"(ooff), "s"(obu + (size_t)(3) * orow) : "memory");
    unsigned vn4 = 0u; asm volatile("global_load_ushort %0, %1, %2" : "+v"(vn4) : "v"(ooff), "s"(obu + (size_t)(16) * orow) : "memory");
    unsigned vn5 = 0u; asm volatile("global_load_ushort %0, %1, %2" : "+v"(vn5) : "v"(ooff), "s"(obu + (size_t)(17) * orow) : "memory");
    unsigned vn6 = 0u; asm volatile("global_load_ushort %0, %1, %2" : "+v"(vn6) : "v"(ooff), "s"(obu + (size_t)(18) * orow) : "memory");
    unsigned vn7 = 0u; asm volatile("global_load_ushort %0, %1, %2" : "+v"(vn7) : "v"(ooff), "s"(obu + (size_t)(19) * orow) : "memory");
    unsigned vn8 = 0u; asm volatile("global_load_ushort %0, %1, %2" : "+v"(vn8) : "v"(ooff), "s"(obu + (size_t)(32) * orow) : "memory");
    unsigned vn9 = 0u; asm volatile("global_load_ushort %0, %1, %2" : "+v"(vn9) : "v"(ooff), "s"(obu + (size_t)(33) * orow) : "memory");
    unsigned vn10 = 0u; asm volatile("global_load_ushort %0, %1, %2" : "+v"(vn10) : "v"(ooff), "s"(obu + (size_t)(34) * orow) : "memory");
    unsigned vn11 = 0u; asm volatile("global_load_ushort %0, %1, %2" : "+v"(vn11) : "v"(ooff), "s"(obu + (size_t)(35) * orow) : "memory");
    unsigned vn12 = 0u; asm volatile("global_load_ushort %0, %1, %2" : "+v"(vn12) : "v"(ooff), "s"(obu + (size_t)(48) * orow) : "memory");
    unsigned vn13 = 0u; asm volatile("global_load_ushort %0, %1, %2" : "+v"(vn13) : "v"(ooff), "s"(obu + (size_t)(49) * orow) : "memory");
    unsigned vn14 = 0u; asm volatile("global_load_ushort %0, %1, %2" : "+v"(vn14) : "v"(ooff), "s"(obu + (size_t)(50) * orow) : "memory");
    unsigned vn15 = 0u; asm volatile("global_load_ushort %0, %1, %2" : "+v"(vn15) : "v"(ooff), "s"(obu + (size_t)(51) * orow) : "memory");
    const unsigned char* spc = sp0;
    asm volatile("global_load_dwordx4 %0, %1, %2" : "+v"(r0) : "v"(voff), "s"(spc) : "memory"); spc += 1024;
    asm volatile("global_load_dwordx4 %0, %1, %2" : "+v"(r1) : "v"(voff), "s"(spc) : "memory"); spc += 1024;
    asm volatile("global_load_dwordx4 %0, %1, %2" : "+v"(r2) : "v"(voff), "s"(spc) : "memory"); spc += 1024;
    asm volatile("global_load_dwordx4 %0, %1, %2" : "+v"(r3) : "v"(voff), "s"(spc) : "memory"); spc += 1024;
    asm volatile("global_load_dwordx4 %0, %1, %2" : "+v"(r4) : "v"(voff), "s"(spc) : "memory"); spc += 1024;
    asm volatile("global_load_dwordx4 %0, %1, %2" : "+v"(r5) : "v"(voff), "s"(spc) : "memory"); spc += 1024;
    asm volatile("global_load_dwordx4 %0, %1, %2" : "+v"(r6) : "v"(voff), "s"(spc) : "memory"); spc += 1024;
    asm volatile("global_load_dwordx4 %0, %1, %2" : "+v"(r7) : "v"(voff), "s"(spc) : "memory"); spc += 1024;
    asm volatile("global_load_dwordx4 %0, %1, %2" : "+v"(r8) : "v"(voff), "s"(spc) : "memory"); spc += 1024;
    asm volatile("global_load_dwordx4 %0, %1, %2" : "+v"(r9) : "v"(voff), "s"(spc) : "memory"); spc += 1024;
    asm volatile("global_load_dwordx4 %0, %1, %2" : "+v"(r10) : "v"(voff), "s"(spc) : "memory"); spc += 1024;
    asm volatile("global_load_dwordx4 %0, %1, %2" : "+v"(r11) : "v"(voff), "s"(spc) : "memory"); spc += 1024;
    asm volatile("global_load_dwordx4 %0, %1, %2" : "+v"(r12) : "v"(voff), "s"(spc) : "memory"); spc += 1024;
    asm volatile("global_load_dwordx4 %0, %1, %2" : "+v"(r13) : "v"(voff), "s"(spc) : "memory"); spc += 1024;
    asm volatile("global_load_dwordx4 %0, %1, %2" : "+v"(r14) : "v"(voff), "s"(spc) : "memory"); spc += 1024;
    asm volatile("global_load_dwordx4 %0, %1, %2" : "+v"(r15) : "v"(voff), "s"(spc) : "memory"); spc += 1024;
    asm volatile("global_load_dwordx4 %0, %1, %2" : "+v"(r16) : "v"(voff), "s"(spc) : "memory"); spc += 1024;
    asm volatile("global_load_dwordx4 %0, %1, %2" : "+v"(r17) : "v"(voff), "s"(spc) : "memory"); spc += 1024;
    asm volatile("global_load_dwordx4 %0, %1, %2" : "+v"(r18) : "v"(voff), "s"(spc) : "memory"); spc += 1024;
    asm volatile("global_load_dwordx4 %0, %1, %2" : "+v"(r19) : "v"(voff), "s"(spc) : "memory"); spc += 1024;
    { unsigned z = 0u;
      asm volatile("global_store_short %0, %1, %2" :: "v"(ooff), "v"(z), "s"(obu + (size_t)(0) * orow) : "memory");
      asm volatile("global_store_short %0, %1, %2" :: "v"(ooff), "v"(z), "s"(obu + (size_t)(1) * orow) : "memory");
      asm volatile("global_store_short %0, %1, %2" :: "v"(ooff), "v"(z), "s"(obu + (size_t)(2) * orow) : "memory");
      asm volatile("global_store_short %0, %1, %2" :: "v"(ooff), "v"(z), "s"(obu + (size_t)(3) * orow) : "memory");
      asm volatile("global_store_short %0, %1, %2" :: "v"(ooff), "v"(z), "s"(obu + (size_t)(16) * orow) : "memory");
      asm volatile("global_store_short %0, %1, %2" :: "v"(ooff), "v"(z), "s"(obu + (size_t)(17) * orow) : "memory");
      asm volatile("global_store_short %0, %1, %2" :: "v"(ooff), "v"(z), "s"(obu + (size_t)(18) * orow) : "memory");
      asm volatile("global_store_short %0, %1, %2" :: "v"(ooff), "v"(z), "s"(obu + (size_t)(19) * orow) : "memory");
      asm volatile("global_store_short %0, %1, %2" :: "v"(ooff), "v"(z), "s"(obu + (size_t)(32) * orow) : "memory");
      asm volatile("global_store_short %0, %1, %2" :: "v"(ooff), "v"(z), "s"(obu + (size_t)(33) * orow) : "memory");
      asm volatile("global_store_short %0, %1, %2" :: "v"(ooff), "v"(z), "s"(obu + (size_t)(34) * orow) : "memory");
      asm volatile("global_store_short %0, %1, %2" :: "v"(ooff), "v"(z), "s"(obu + (size_t)(35) * orow) : "memory");
      asm volatile("global_store_short %0, %1, %2" :: "v"(ooff), "v"(z), "s"(obu + (size_t)(48) * orow) : "memory");
      asm volatile("global_store_short %0, %1, %2" :: "v"(ooff), "v"(z), "s"(obu + (size_t)(49) * orow) : "memory");
      asm volatile("global_store_short %0, %1, %2" :: "v"(ooff), "v"(z), "s"(obu + (size_t)(50) * orow) : "memory");
      asm volatile("global_store_short %0, %1, %2" :: "v"(ooff), "v"(z), "s"(obu + (size_t)(51) * orow) : "memory");
    }
#pragma unroll 1
    for (int n = 0; n < NCH; ++n) {
        f32x4 a1_0, a1_1, a1_2, a1_3;
        asm volatile("s_waitcnt vmcnt(36)" : "+v"(vn0), "+v"(vn1), "+v"(vn2), "+v"(vn3), "+v"(vn4), "+v"(vn5), "+v"(vn6), "+v"(vn7), "+v"(vn8), "+v"(vn9), "+v"(vn10), "+v"(vn11), "+v"(vn12), "+v"(vn13), "+v"(vn14), "+v"(vn15));
        a1_0 = (f32x4){__builtin_bit_cast(float, vn0 << 16), __builtin_bit_cast(float, vn1 << 16), __builtin_bit_cast(float, vn2 << 16), __builtin_bit_cast(float, vn3 << 16)};
        a1_1 = (f32x4){__builtin_bit_cast(float, vn4 << 16), __builtin_bit_cast(float, vn5 << 16), __builtin_bit_cast(float, vn6 << 16), __builtin_bit_cast(float, vn7 << 16)};
        a1_2 = (f32x4){__builtin_bit_cast(float, vn8 << 16), __builtin_bit_cast(float, vn9 << 16), __builtin_bit_cast(float, vn10 << 16), __builtin_bit_cast(float, vn11 << 16)};
        a1_3 = (f32x4){__builtin_bit_cast(float, vn12 << 16), __builtin_bit_cast(float, vn13 << 16), __builtin_bit_cast(float, vn14 << 16), __builtin_bit_cast(float, vn15 << 16)};
        const float dec = decr;
        { const unsigned char* obn = obu + (size_t)(n + 1 < NCH ? n + 1 : n) * 64 * orow;
          asm volatile("global_load_ushort %0, %1, %2" : "+v"(vn0) : "v"(ooff), "s"(obn + (size_t)(0) * orow) : "memory");
          asm volatile("global_load_ushort %0, %1, %2" : "+v"(vn1) : "v"(ooff), "s"(obn + (size_t)(1) * orow) : "memory");
          asm volatile("global_load_ushort %0, %1, %2" : "+v"(vn2) : "v"(ooff), "s"(obn + (size_t)(2) * orow) : "memory");
          asm volatile("global_load_ushort %0, %1, %2" : "+v"(vn3) : "v"(ooff), "s"(obn + (size_t)(3) * orow) : "memory");
          asm volatile("global_load_ushort %0, %1, %2" : "+v"(vn4) : "v"(ooff), "s"(obn + (size_t)(16) * orow) : "memory");
          asm volatile("global_load_ushort %0, %1, %2" : "+v"(vn5) : "v"(ooff), "s"(obn + (size_t)(17) * orow) : "memory");
          asm volatile("global_load_ushort %0, %1, %2" : "+v"(vn6) : "v"(ooff), "s"(obn + (size_t)(18) * orow) : "memory");
          asm volatile("global_load_ushort %0, %1, %2" : "+v"(vn7) : "v"(ooff), "s"(obn + (size_t)(19) * orow) : "memory");
          asm volatile("global_load_ushort %0, %1, %2" : "+v"(vn8) : "v"(ooff), "s"(obn + (size_t)(32) * orow) : "memory");
          asm volatile("global_load_ushort %0, %1, %2" : "+v"(vn9) : "v"(ooff), "s"(obn + (size_t)(33) * orow) : "memory");
          asm volatile("global_load_ushort %0, %1, %2" : "+v"(vn10) : "v"(ooff), "s"(obn + (size_t)(34) * orow) : "memory");
          asm volatile("global_load_ushort %0, %1, %2" : "+v"(vn11) : "v"(ooff), "s"(obn + (size_t)(35) * orow) : "memory");
          asm volatile("global_load_ushort %0, %1, %2" : "+v"(vn12) : "v"(ooff), "s"(obn + (size_t)(48) * orow) : "memory");
          asm volatile("global_load_ushort %0, %1, %2" : "+v"(vn13) : "v"(ooff), "s"(obn + (size_t)(49) * orow) : "memory");
          asm volatile("global_load_ushort %0, %1, %2" : "+v"(vn14) : "v"(ooff), "s"(obn + (size_t)(50) * orow) : "memory");
          asm volatile("global_load_ushort %0, %1, %2" : "+v"(vn15) : "v"(ooff), "s"(obn + (size_t)(51) * orow) : "memory");
        }
        __builtin_amdgcn_sched_barrier(0);
        bf16x8 vp0, vp1;
        { u32x4 w; w.x = cvt_pk_bf16(a1_0[0], a1_0[1]); w.y = cvt_pk_bf16(a1_0[2], a1_0[3]); w.z = cvt_pk_bf16(a1_1[0], a1_1[1]); w.w = cvt_pk_bf16(a1_1[2], a1_1[3]); vp0 = __builtin_bit_cast(bf16x8, w); }
        { u32x4 w; w.x = cvt_pk_bf16(a1_2[0], a1_2[1]); w.y = cvt_pk_bf16(a1_2[2], a1_2[3]); w.z = cvt_pk_bf16(a1_3[0], a1_3[1]); w.w = cvt_pk_bf16(a1_3[2], a1_3[3]); vp1 = __builtin_bit_cast(bf16x8, w); }
        f32x4 o0 = {0.f, 0.f, 0.f, 0.f}, o1 = o0, o2 = o0, o3 = o0;
        asm volatile("s_waitcnt vmcnt(51)" : "+v"(r0));
        o0 = mfma16(r0, Sp0, o0);
        asm volatile("global_load_dwordx4 %0, %1, %2" : "+v"(r0) : "v"(voff), "s"(spc) : "memory"); spc += 1024;
        __builtin_amdgcn_sched_barrier(0);
        asm volatile("s_waitcnt vmcnt(51)" : "+v"(r1));
        o0 = mfma16(r1, Sp1, o0);
        asm volatile("global_load_dwordx4 %0, %1, %2" : "+v"(r1) : "v"(voff), "s"(spc) : "memory"); spc += 1024;
        __builtin_amdgcn_sched_barrier(0);
        asm volatile("s_waitcnt vmcnt(51)" : "+v"(r2));
        o0 = mfma16(r2, Sp2, o0);
        asm volatile("global_load_dwordx4 %0, %1, %2" : "+v"(r2) : "v"(voff), "s"(spc) : "memory"); spc += 1024;
        __builtin_amdgcn_sched_barrier(0);
        asm volatile("s_waitcnt vmcnt(51)" : "+v"(r3));
        o0 = mfma16(r3, Sp3, o0);
        asm volatile("global_load_dwordx4 %0, %1, %2" : "+v"(r3) : "v"(voff), "s"(spc) : "memory"); spc += 1024;
        __builtin_amdgcn_sched_barrier(0);
        asm volatile("s_waitcnt vmcnt(35)" : "+v"(r4));
        o1 = mfma16(r4, Sp0, o1);
        asm volatile("global_load_dwordx4 %0, %1, %2" : "+v"(r4) : "v"(voff), "s"(spc) : "memory"); spc += 1024;
        __builtin_amdgcn_sched_barrier(0);
        asm volatile("s_waitcnt vmcnt(35)" : "+v"(r5));
        o1 = mfma16(r5, Sp1, o1);
        asm volatile("global_load_dwordx4 %0, %1, %2" : "+v"(r5) : "v"(voff), "s"(spc) : "memory"); spc += 1024;
        __builtin_amdgcn_sched_barrier(0);
        asm volatile("s_waitcnt vmcnt(35)" : "+v"(r6));
        o1 = mfma16(r6, Sp2, o1);
        asm volatile("global_load_dwordx4 %0, %1, %2" : "+v"(r6) : "v"(voff), "s"(spc) : "memory"); spc += 1024;
        __builtin_amdgcn_sched_barrier(0);
        asm volatile("s_waitcnt vmcnt(35)" : "+v"(r7));
        o1 = mfma16(r7, Sp3, o1);
        asm volatile("global_load_dwordx4 %0, %1, %2" : "+v"(r7) : "v"(voff), "s"(spc) : "memory"); spc += 1024;
        __builtin_amdgcn_sched_barrier(0);
        asm volatile("s_waitcnt vmcnt(35)" : "+v"(r8));
        o2 = mfma16(r8, Sp0, o2);
        asm volatile("global_load_dwordx4 %0, %1, %2" : "+v"(r8) : "v"(voff), "s"(spc) : "memory"); spc += 1024;
        __builtin_amdgcn_sched_barrier(0);
        asm volatile("s_waitcnt vmcnt(35)" : "+v"(r9));
        o2 = mfma16(r9, Sp1, o2);
        asm volatile("global_load_dwordx4 %0, %1, %2" : "+v"(r9) : "v"(voff), "s"(spc) : "memory"); spc += 1024;
        __builtin_amdgcn_sched_barrier(0);
        asm volatile("s_waitcnt vmcnt(35)" : "+v"(r10));
        o2 = mfma16(r10, Sp2, o2);
        asm volatile("global_load_dwordx4 %0, %1, %2" : "+v"(r10) : "v"(voff), "s"(spc) : "memory"); spc += 1024;
        __builtin_amdgcn_sched_barrier(0);
        asm volatile("s_waitcnt vmcnt(35)" : "+v"(r11));
        o2 = mfma16(r11, Sp3, o2);
        asm volatile("global_load_dwordx4 %0, %1, %2" : "+v"(r11) : "v"(voff), "s"(spc) : "memory"); spc += 1024;
        __builtin_amdgcn_sched_barrier(0);
        asm volatile("s_waitcnt vmcnt(35)" : "+v"(r12));
        o3 = mfma16(r12, Sp0, o3);
        asm volatile("global_load_dwordx4 %0, %1, %2" : "+v"(r12) : "v"(voff), "s"(spc) : "memory"); spc += 1024;
        __builtin_amdgcn_sched_barrier(0);
        asm volatile("s_waitcnt vmcnt(35)" : "+v"(r13));
        o3 = mfma16(r13, Sp1, o3);
        asm volatile("global_load_dwordx4 %0, %1, %2" : "+v"(r13) : "v"(voff), "s"(spc) : "memory"); spc += 1024;
        __builtin_amdgcn_sched_barrier(0);
        asm volatile("s_waitcnt vmcnt(35)" : "+v"(r14));
        o3 = mfma16(r14, Sp2, o3);
        asm volatile("global_load_dwordx4 %0, %1, %2" : "+v"(r14) : "v"(voff), "s"(spc) : "memory"); spc += 1024;
        __builtin_amdgcn_sched_barrier(0);
        asm volatile("s_waitcnt vmcnt(35)" : "+v"(r15));
        o3 = mfma16(r15, Sp3, o3);
        asm volatile("global_load_dwordx4 %0, %1, %2" : "+v"(r15) : "v"(voff), "s"(spc) : "memory"); spc += 1024;
        __builtin_amdgcn_sched_barrier(0);
        asm volatile("s_waitcnt vmcnt(35)" : "+v"(r16));
        o0 = mfma16(r16, vp0, o0);
        asm volatile("global_load_dwordx4 %0, %1, %2" : "+v"(r16) : "v"(voff), "s"(spc) : "memory"); spc += 1024;
        __builtin_amdgcn_sched_barrier(0);
        asm volatile("s_waitcnt vmcnt(35)" : "+v"(r17));
        o0 = mfma16(r17, vp1, o0);
        asm volatile("global_load_dwordx4 %0, %1, %2" : "+v"(r17) : "v"(voff), "s"(spc) : "memory"); spc += 1024;
        __builtin_amdgcn_sched_barrier(0);
        asm volatile("s_waitcnt vmcnt(35)" : "+v"(r18));
        o1 = mfma16(r18, vp0, o1);
        asm volatile("global_load_dwordx4 %0, %1, %2" : "+v"(r18) : "v"(voff), "s"(spc) : "memory"); spc += 1024;
        __builtin_amdgcn_sched_barrier(0);
        asm volatile("s_waitcnt vmcnt(35)" : "+v"(r19));
        o1 = mfma16(r19, vp1, o1);
        asm volatile("global_load_dwordx4 %0, %1, %2" : "+v"(r19) : "v"(voff), "s"(spc) : "memory"); spc += 1024;
        __builtin_amdgcn_sched_barrier(0);
        asm volatile("s_waitcnt vmcnt(19)" : "+v"(r0));
        o2 = mfma16(r0, vp0, o2);
        asm volatile("global_load_dwordx4 %0, %1, %2" : "+v"(r0) : "v"(voff), "s"(spc) : "memory"); spc += 1024;
        __builtin_amdgcn_sched_barrier(0);
        asm volatile("s_waitcnt vmcnt(19)" : "+v"(r1));
        o2 = mfma16(r1, vp1, o2);
        asm volatile("global_load_dwordx4 %0, %1, %2" : "+v"(r1) : "v"(voff), "s"(spc) : "memory"); spc += 1024;
        __builtin_amdgcn_sched_barrier(0);
        asm volatile("s_waitcnt vmcnt(19)" : "+v"(r2));
        o3 = mfma16(r2, vp0, o3);
        asm volatile("global_load_dwordx4 %0, %1, %2" : "+v"(r2) : "v"(voff), "s"(spc) : "memory"); spc += 1024;
        __builtin_amdgcn_sched_barrier(0);
        asm volatile("s_waitcnt vmcnt(19)" : "+v"(r3));
        o3 = mfma16(r3, vp1, o3);
        asm volatile("global_load_dwordx4 %0, %1, %2" : "+v"(r3) : "v"(voff), "s"(spc) : "memory"); spc += 1024;
        __builtin_amdgcn_sched_barrier(0);
        { const unsigned char* obn = obu + (size_t)n * 64 * orow;
          { const unsigned v = f2bf(o0[0]); asm volatile("global_store_short %0, %1, %2" :: "v"(ooff), "v"(v), "s"(obn + (size_t)(0) * orow) : "memory"); }
          { const unsigned v = f2bf(o0[1]); asm volatile("global_store_short %0, %1, %2" :: "v"(ooff), "v"(v), "s"(obn + (size_t)(1) * orow) : "memory"); }
          { const unsigned v = f2bf(o0[2]); asm volatile("global_store_short %0, %1, %2" :: "v"(ooff), "v"(v), "s"(obn + (size_t)(2) * orow) : "memory"); }
          { const unsigned v = f2bf(o0[3]); asm volatile("global_store_short %0, %1, %2" :: "v"(ooff), "v"(v), "s"(obn + (size_t)(3) * orow) : "memory"); }
          { const unsigned v = f2bf(o1[0]); asm volatile("global_store_short %0, %1, %2" :: "v"(ooff), "v"(v), "s"(obn + (size_t)(16) * orow) : "memory"); }
          { const unsigned v = f2bf(o1[1]); asm volatile("global_store_short %0, %1, %2" :: "v"(ooff), "v"(v), "s"(obn + (size_t)(17) * orow) : "memory"); }
          { const unsigned v = f2bf(o1[2]); asm volatile("global_store_short %0, %1, %2" :: "v"(ooff), "v"(v), "s"(obn + (size_t)(18) * orow) : "memory"); }
          { const unsigned v = f2bf(o1[3]); asm volatile("global_store_short %0, %1, %2" :: "v"(ooff), "v"(v), "s"(obn + (size_t)(19) * orow) : "memory"); }
          { const unsigned v = f2bf(o2[0]); asm volatile("global_store_short %0, %1, %2" :: "v"(ooff), "v"(v), "s"(obn + (size_t)(32) * orow) : "memory"); }
          { const unsigned v = f2bf(o2[1]); asm volatile("global_store_short %0, %1, %2" :: "v"(ooff), "v"(v), "s"(obn + (size_t)(33) * orow) : "memory"); }
          { const unsigned v = f2bf(o2[2]); asm volatile("global_store_short %0, %1, %2" :: "v"(ooff), "v"(v), "s"(obn + (size_t)(34) * orow) : "memory"); }
          { const unsigned v = f2bf(o2[3]); asm volatile("global_store_short %0, %1, %2" :: "v"(ooff), "v"(v), "s"(obn + (size_t)(35) * orow) : "memory"); }
          { const unsigned v = f2bf(o3[0]); asm volatile("global_store_short %0, %1, %2" :: "v"(ooff), "v"(v), "s"(obn + (size_t)(48) * orow) : "memory"); }
          { const unsigned v = f2bf(o3[1]); asm volatile("global_store_short %0, %1, %2" :: "v"(ooff), "v"(v), "s"(obn + (size_t)(49) * orow) : "memory"); }
          { const unsigned v = f2bf(o3[2]); asm volatile("global_store_short %0, %1, %2" :: "v"(ooff), "v"(v), "s"(obn + (size_t)(50) * orow) : "memory"); }
          { const unsigned v = f2bf(o3[3]); asm volatile("global_store_short %0, %1, %2" :: "v"(ooff), "v"(v), "s"(obn + (size_t)(51) * orow) : "memory"); }
        }
        __builtin_amdgcn_sched_barrier(0);
        S0 = S0 * dec;
        asm volatile("s_waitcnt vmcnt(35)" : "+v"(r4));
        S0 = mfma16(r4, vp0, S0);
        asm volatile("global_load_dwordx4 %0, %1, %2" : "+v"(r4) : "v"(voff), "s"(spc) : "memory"); spc += 1024;
        __builtin_amdgcn_sched_barrier(0);
        asm volatile("s_waitcnt vmcnt(35)" : "+v"(r5));
        S0 = mfma16(r5, vp1, S0);
        asm volatile("global_load_dwordx4 %0, %1, %2" : "+v"(r5) : "v"(voff), "s"(spc) : "memory"); spc += 1024;
        __builtin_amdgcn_sched_barrier(0);
        S1 = S1 * dec;
        asm volatile("s_waitcnt vmcnt(35)" : "+v"(r6));
        S1 = mfma16(r6, vp0, S1);
        asm volatile("global_load_dwordx4 %0, %1, %2" : "+v"(r6) : "v"(voff), "s"(spc) : "memory"); spc += 1024;
        __builtin_amdgcn_sched_barrier(0);
        asm volatile("s_waitcnt vmcnt(35)" : "+v"(r7));
        S1 = mfma16(r7, vp1, S1);
        asm volatile("global_load_dwordx4 %0, %1, %2" : "+v"(r7) : "v"(voff), "s"(spc) : "memory"); spc += 1024;
        __builtin_amdgcn_sched_barrier(0);
        S2 = S2 * dec;
        asm volatile("s_waitcnt vmcnt(35)" : "+v"(r8));
        S2 = mfma16(r8, vp0, S2);
        asm volatile("global_load_dwordx4 %0, %1, %2" : "+v"(r8) : "v"(voff), "s"(spc) : "memory"); spc += 1024;
        __builtin_amdgcn_sched_barrier(0);
        asm volatile("s_waitcnt vmcnt(35)" : "+v"(r9));
        S2 = mfma16(r9, vp1, S2);
        asm volatile("global_load_dwordx4 %0, %1, %2" : "+v"(r9) : "v"(voff), "s"(spc) : "memory"); spc += 1024;
        __builtin_amdgcn_sched_barrier(0);
        S3 = S3 * dec;
        asm volatile("s_waitcnt vmcnt(35)" : "+v"(r10));
        S3 = mfma16(r10, vp0, S3);
        asm volatile("global_load_dwordx4 %0, %1, %2" : "+v"(r10) : "v"(voff), "s"(spc) : "memory"); spc += 1024;
        __builtin_amdgcn_sched_barrier(0);
        asm volatile("s_waitcnt vmcnt(35)" : "+v"(r11));
        S3 = mfma16(r11, vp1, S3);
        asm volatile("global_load_dwordx4 %0, %1, %2" : "+v"(r11) : "v"(voff), "s"(spc) : "memory"); spc += 1024;
        __builtin_amdgcn_sched_barrier(0);
        S4 = S4 * dec;
        asm volatile("s_waitcnt vmcnt(35)" : "+v"(r12));
        S4 = mfma16(r12, vp0, S4);
        asm volatile("global_load_dwordx4 %0, %1, %2" : "+v"(r12) : "v"(voff), "s"(spc) : "memory"); spc += 1024;
        __builtin_amdgcn_sched_barrier(0);
        asm volatile("s_waitcnt vmcnt(35)" : "+v"(r13));
        S4 = mfma16(r13, vp1, S4);
        asm volatile("global_load_dwordx4 %0, %1, %2" : "+v"(r13) : "v"(voff), "s"(spc) : "memory"); spc += 1024;
        __builtin_amdgcn_sched_barrier(0);
        S5 = S5 * dec;
        asm volatile("s_waitcnt vmcnt(35)" : "+v"(r14));
        S5 = mfma16(r14, vp0, S5);
        asm volatile("global_load_dwordx4 %0, %1, %2" : "+v"(r14) : "v"(voff), "s"(spc) : "memory"); spc += 1024;
        __builtin_amdgcn_sched_barrier(0);
        asm volatile("s_waitcnt vmcnt(35)" : "+v"(r15));
        S5 = mfma16(r15, vp1, S5);
        asm volatile("global_load_dwordx4 %0, %1, %2" : "+v"(r15) : "v"(voff), "s"(spc) : "memory"); spc += 1024;
        __builtin_amdgcn_sched_barrier(0);
        S6 = S6 * dec;
        asm volatile("s_waitcnt vmcnt(35)" : "+v"(r16));
        S6 = mfma16(r16, vp0, S6);
        asm volatile("global_load_dwordx4 %0, %1, %2" : "+v"(r16) : "v"(voff), "s"(spc) : "memory"); spc += 1024;
        __builtin_amdgcn_sched_barrier(0);
        asm volatile("s_waitcnt vmcnt(35)" : "+v"(r17));
        S6 = mfma16(r17, vp1, S6);
        asm volatile("global_load_dwordx4 %0, %1, %2" : "+v"(r17) : "v"(voff), "s"(spc) : "memory"); spc += 1024;
        __builtin_amdgcn_sched_barrier(0);
        S7 = S7 * dec;
        asm volatile("s_waitcnt vmcnt(35)" : "+v"(r18));
        S7 = mfma16(r18, vp0, S7);
        asm volatile("global_load_dwordx4 %0, %1, %2" : "+v"(r18) : "v"(voff), "s"(spc) : "memory"); spc += 1024;
        __builtin_amdgcn_sched_barrier(0);
        asm volatile("s_waitcnt vmcnt(35)" : "+v"(r19));
        S7 = mfma16(r19, vp1, S7);
        asm volatile("global_load_dwordx4 %0, %1, %2" : "+v"(r19) : "v"(voff), "s"(spc) : "memory"); spc += 1024;
        __builtin_amdgcn_sched_barrier(0);
        { u32x4 w; w.x = cvt_pk_bf16(S0[0], S0[1]); w.y = cvt_pk_bf16(S0[2], S0[3]); w.z = cvt_pk_bf16(S1[0], S1[1]); w.w = cvt_pk_bf16(S1[2], S1[3]); Sp0 = __builtin_bit_cast(bf16x8, w); }
        { u32x4 w; w.x = cvt_pk_bf16(S2[0], S2[1]); w.y = cvt_pk_bf16(S2[2], S2[3]); w.z = cvt_pk_bf16(S3[0], S3[1]); w.w = cvt_pk_bf16(S3[2], S3[3]); Sp1 = __builtin_bit_cast(bf16x8, w); }
        { u32x4 w; w.x = cvt_pk_bf16(S4[0], S4[1]); w.y = cvt_pk_bf16(S4[2], S4[3]); w.z = cvt_pk_bf16(S5[0], S5[1]); w.w = cvt_pk_bf16(S5[2], S5[3]); Sp2 = __builtin_bit_cast(bf16x8, w); }
        { u32x4 w; w.x = cvt_pk_bf16(S6[0], S6[1]); w.y = cvt_pk_bf16(S6[2], S6[3]); w.z = cvt_pk_bf16(S7[0], S7[1]); w.w = cvt_pk_bf16(S7[2], S7[3]); Sp3 = __builtin_bit_cast(bf16x8, w); }
    }
    asm volatile("s_waitcnt vmcnt(0)" ::: "memory");
    }
}

DI void p4_mixnorm(Frame& F, const float* ret_norm, const float* gdn_norm) {
    bf16_t* pj = (bf16_t*)(F.ws + WS_BIG + BIG_PJ); const bf16_t* vc = (const bf16_t*)(F.ws + AUX_VC);
    const int lane = F.lane;
    const f32x4 gr = *(const f32x4*)(ret_norm + 4 * lane), gg = *(const f32x4*)(gdn_norm + 4 * lane);
    for (int m = F.gw; m < NTOK; m += F.NGW) {
        bf16_t* row = pj + (size_t)m * PJW;
#pragma unroll
        for (int hv = 0; hv < 16; ++hv) { const int hd = hv & 7; const bool gdn = hv >= 8;
            const u32x2 ro = gdn ? *(const u32x2*)(vc + (size_t)m * 2048 + hd * 256 + 4 * lane) : *(const u32x2*)(row + C_RV + hd * 256 + 4 * lane);
            bf16_t* gp = row + (gdn ? C_GZ : C_RG) + hd * 256 + 4 * lane; const u32x2 gt = *(const u32x2*)gp;
            const float o0 = bflo(ro.x), o1 = bfhi(ro.x), o2 = bflo(ro.y), o3 = bfhi(ro.y);
            const float rstd = 1.0f / sqrtf(wave_sum((o0 * o0 + o1 * o1) + (o2 * o2 + o3 * o3)) * (1.0f / 256.0f) + EPS);
            const f32x4 g = gdn ? gg : gr;
            u32x2 w; w.x = pk2(o0 * rstd * g.x * siluf(bflo(gt.x)), o1 * rstd * g.y * siluf(bfhi(gt.x))); w.y = pk2(o2 * rstd * g.z * siluf(bflo(gt.y)), o3 * rstd * g.w * siluf(bfhi(gt.y)));
            *(u32x2*)gp = w; }
    }
}

DI void p11_swaprep(Frame& F, const float* qnorm, const float* knorm) {
    bf16_t* qkv = (bf16_t*)(F.ws + WS_BIG + BIG_QKV1); const f32x2* cs = (const f32x2*)(F.ws + AUX_CS);
    const int lane = F.lane; const float gq = qnorm[lane], gk = knorm[lane];
    for (int m = F.gw; m < NTOK; m += F.NGW) {
        const int pos = m & (SEQ - 1); const f32x2 c = cs[pos * 64 + 2 * (lane & 31)];
        bf16_t* row = qkv + (size_t)m * ODD_IN;
#pragma unroll 4
        for (int hv = 0; hv < 36; ++hv) { bf16_t* p = row + hv * 64; const float x = bf2f(p[lane]);
            const float rstd = 1.0f / sqrtf(wave_sum(x * x) * (1.0f / 64.0f) + EPS); const float xn = x * rstd * (hv < 32 ? gq : gk);
            const float xo = __shfl_xor(xn, 32);
            const float r = lane < 32 ? xn * c.x - xo * c.y : xn * c.x + xo * c.y;
            p[lane] = (bf16_t)f2bf(r); }
    }
}
DI void p12_swa_naive(Frame& F, const float* sinks) {
    bf16_t* qkv = (bf16_t*)(F.ws + WS_BIG + BIG_QKV1);
    const long total = (long)NTOK * 32;
    for (long idx = (long)blockIdx.x * NTHR + F.tid; idx < total; idx += (long)F.G * NTHR) {
        const int hq = (int)(idx / NTOK), m = (int)(idx % NTOK), pos = m & (SEQ - 1), kvh = hq >> 3;
        bf16_t* qp = qkv + (size_t)m * ODD_IN + hq * 64;
        float q[64], o[64];
#pragma unroll
        for (int d8 = 0; d8 < 8; ++d8) { const u32x4 r = *(const u32x4*)(qp + 8 * d8); q[8 * d8] = bflo(r.x); q[8 * d8 + 1] = bfhi(r.x); q[8 * d8 + 2] = bflo(r.y); q[8 * d8 + 3] = bfhi(r.y); q[8 * d8 + 4] = bflo(r.z); q[8 * d8 + 5] = bfhi(r.z); q[8 * d8 + 6] = bflo(r.w); q[8 * d8 + 7] = bfhi(r.w); }
#pragma unroll
        for (int d = 0; d < 64; ++d) o[d] = 0.f;
        float mx = sinks[hq], l = 1.0f;
        const int j0 = pos >= 127 ? 127 : pos;
#pragma unroll 1
        for (int j = j0; j >= 0; --j) {
            const bf16_t* kp = qkv + (size_t)(m - j) * ODD_IN + 2048 + kvh * 64; const bf16_t* vp = kp + 256;
            float s = 0.f;
#pragma unroll
            for (int d8 = 0; d8 < 8; ++d8) { const u32x4 r = *(const u32x4*)(kp + 8 * d8);
                s += q[8 * d8] * bflo(r.x) + q[8 * d8 + 1] * bfhi(r.x) + q[8 * d8 + 2] * bflo(r.y) + q[8 * d8 + 3] * bfhi(r.y) + q[8 * d8 + 4] * bflo(r.z) + q[8 * d8 + 5] * bfhi(r.z) + q[8 * d8 + 6] * bflo(r.w) + q[8 * d8 + 7] * bfhi(r.w); }
            s *= 0.125f;
            const float mn = fmaxf(mx, s), cf = __expf(mx - mn), p = __expf(s - mn);
            l = l * cf + p; mx = mn;
#pragma unroll
            for (int d8 = 0; d8 < 8; ++d8) { const u32x4 r = *(const u32x4*)(vp + 8 * d8);
                o[8 * d8] = o[8 * d8] * cf + p * bflo(r.x); o[8 * d8 + 1] = o[8 * d8 + 1] * cf + p * bfhi(r.x); o[8 * d8 + 2] = o[8 * d8 + 2] * cf + p * bflo(r.y); o[8 * d8 + 3] = o[8 * d8 + 3] * cf + p * bfhi(r.y);
                o[8 * d8 + 4] = o[8 * d8 + 4] * cf + p * bflo(r.z); o[8 * d8 + 5] = o[8 * d8 + 5] * cf + p * bfhi(r.z); o[8 * d8 + 6] = o[8 * d8 + 6] * cf + p * bflo(r.w); o[8 * d8 + 7] = o[8 * d8 + 7] * cf + p * bfhi(r.w); }
        }
        const float il = 1.0f / l;
#pragma unroll
        for (int d8 = 0; d8 < 8; ++d8) { u32x4 w; w.x = pk2(o[8 * d8] * il, o[8 * d8 + 1] * il); w.y = pk2(o[8 * d8 + 2] * il, o[8 * d8 + 3] * il); w.z = pk2(o[8 * d8 + 4] * il, o[8 * d8 + 5] * il); w.w = pk2(o[8 * d8 + 6] * il, o[8 * d8 + 7] * il);
            *(u32x4*)(qp + 8 * d8) = w; }
    }
}


typedef float f32x16 __attribute__((ext_vector_type(16)));
typedef __bf16 bf16v2 __attribute__((ext_vector_type(2)));
DI unsigned pkbf(float a, float b) { f32x2 v = {a, b}; return __builtin_bit_cast(unsigned, __builtin_convertvector(v, bf16v2)); }
DI f32x16 mfma32(bf16x8 a, bf16x8 b, f32x16 c) { return __builtin_amdgcn_mfma_f32_32x32x16_bf16(a, b, c, 0, 0, 0); }
DI void swa_phase(Frame& F, const float* sinks) {
    constexpr int KP = 144;
    bf16_t* qkv = (bf16_t*)(F.ws + WS_BIG + BIG_QKV1);
    LAS unsigned char* Ks = F.lds; LAS unsigned char* Vs = F.lds + 256 * KP;
    const unsigned vs_addr = (unsigned)(size_t)Vs;
    const int lane = F.lane, w = F.wave, h = lane >> 5, ql = lane & 31, q4 = (lane & 15) >> 2, p4 = lane & 3, blk = (lane >> 4) & 1;
    for (int unit = blockIdx.x; unit < 1024; unit += F.G) {
        const int b = unit >> 9, kvh = (unit >> 7) & 3, qb = unit & 127;
        const size_t tok0 = (size_t)b * SEQ + (size_t)qb * 128;
        __syncthreads();
#pragma unroll
        for (int i = 0; i < 4; ++i) { const int pc = F.tid + 512 * i, row = pc >> 3, c = pc & 7; const size_t tok = (qb == 0 && row < 128) ? tok0 : tok0 - 128 + row;
            const bf16_t* src = qkv + tok * ODD_IN + 2048 + kvh * 64 + c * 8;
            *(LAS u32x4*)(Ks + row * KP + c * 16) = *(const u32x4*)src; *(LAS u32x4*)(Vs + row * KP + c * 16) = *(const u32x4*)(src + 256); }
        __syncthreads();
        const int hq = kvh * 8 + w; const float sink = sinks[hq];
#pragma unroll 1
        for (int t = 0; t < 4; ++t) {
            bf16_t* qrow = qkv + (tok0 + 32 * t + ql) * ODD_IN + hq * 64;
            bf16x8 Qf[4];
#pragma unroll
            for (int s2 = 0; s2 < 4; ++s2) Qf[s2] = *(const bf16x8*)(qrow + 16 * s2 + 8 * h);
            f32x16 sc[5];
#pragma unroll
            for (int kt = 0; kt < 5; ++kt) {
#pragma unroll
                for (int r = 0; r < 16; ++r) sc[kt][r] = 0.f;
#pragma unroll
                for (int s2 = 0; s2 < 4; ++s2) { const bf16x8 a = *(const LAS bf16x8*)(Ks + (32 * (t + kt) + ql) * KP + (16 * s2 + 8 * h) * 2); sc[kt] = mfma32(a, Qf[s2], sc[kt]); } }
            float m = sink;
#pragma unroll
            for (int kt = 0; kt < 5; ++kt) { const bool tile_ok = !(qb == 0 && t + kt < 4);
#pragma unroll
                for (int r = 0; r < 16; ++r) { const int keyrow = (r & 3) + 8 * (r >> 2) + 4 * h; bool ok = tile_ok; if (kt == 0) ok = ok && (keyrow > ql); if (kt == 4) ok = ok && (keyrow <= ql);
                    const float v = ok ? sc[kt][r] * 0.125f : -1.0e30f; sc[kt][r] = v; m = fmaxf(m, v); } }
            m = fmaxf(m, __shfl_xor(m, 32));
            float l = 0.f;
#pragma unroll
            for (int kt = 0; kt < 5; ++kt)
#pragma unroll
                for (int r = 0; r < 16; ++r) { const float p = exp2f((sc[kt][r] - m) * 1.4426950408889634f); sc[kt][r] = p; l += p; }
            l += __shfl_xor(l, 32);
            l += exp2f((sink - m) * 1.4426950408889634f);
            f32x16 o0, o1;
#pragma unroll
            for (int r = 0; r < 16; ++r) { o0[r] = 0.f; o1[r] = 0.f; }
#pragma unroll
            for (int kt = 0; kt < 5; ++kt)
#pragma unroll
                for (int s2 = 0; s2 < 2; ++s2) { u32x4 pw; pw.x = pkbf(sc[kt][8 * s2], sc[kt][8 * s2 + 1]); pw.y = pkbf(sc[kt][8 * s2 + 2], sc[kt][8 * s2 + 3]); pw.z = pkbf(sc[kt][8 * s2 + 4], sc[kt][8 * s2 + 5]); pw.w = pkbf(sc[kt][8 * s2 + 6], sc[kt][8 * s2 + 7]);
                    const bf16x8 pb = __builtin_bit_cast(bf16x8, pw);
                    const unsigned ra = vs_addr + (unsigned)((32 * (t + kt) + 16 * s2 + 4 * h + q4) * KP + blk * 32 + p4 * 8);
                    const s16x4 a00 = tr_read(ra), a01 = tr_read(ra + 8 * KP), a10 = tr_read(ra + 64), a11 = tr_read(ra + 8 * KP + 64);
                    o0 = mfma32(cat8(a00, a01), pb, o0); o1 = mfma32(cat8(a10, a11), pb, o1); }
            const float il = 1.0f / l;
#pragma unroll
            for (int gq = 0; gq < 4; ++gq) { u32x2 w0, w1; w0.x = pkbf(o0[4 * gq] * il, o0[4 * gq + 1] * il); w0.y = pkbf(o0[4 * gq + 2] * il, o0[4 * gq + 3] * il); w1.x = pkbf(o1[4 * gq] * il, o1[4 * gq + 1] * il); w1.y = pkbf(o1[4 * gq + 2] * il, o1[4 * gq + 3] * il);
                *(u32x2*)(qrow + 8 * gq + 4 * h) = w0; *(u32x2*)(qrow + 32 + 8 * gq + 4 * h) = w1; }
        }
    }
}

struct RouteHandler {
    unsigned* cnt; int* list; float* gw; unsigned* asg; int lane;
    DI void operator()(int m, float res) const {
        float p[36];
#pragma unroll
        for (int j = 0; j < 36; ++j) p[j] = rdlane(res, j);
        int g = 0; float gm = p[0];
#pragma unroll
        for (int j = 1; j < 4; ++j) if (p[j] > gm) { gm = p[j]; g = j; }
        float gs = 0.f;
#pragma unroll
        for (int j = 0; j < 4; ++j) gs += __expf(p[j] - gm);
        const float g_p = 1.0f / gs;
        float q[8];
#pragma unroll
        for (int i = 0; i < 8; ++i) q[i] = g == 0 ? p[4 + i] : (g == 1 ? p[12 + i] : (g == 2 ? p[20 + i] : p[28 + i]));
        int i0 = 0; float m0 = q[0];
#pragma unroll
        for (int i = 1; i < 8; ++i) if (q[i] > m0) { m0 = q[i]; i0 = i; }
        int i1 = -1; float m1 = -3.0e38f;
#pragma unroll
        for (int i = 0; i < 8; ++i) if (i != i0 && q[i] > m1) { m1 = q[i]; i1 = i; }
        const float e1 = __expf(m1 - m0), w0 = g_p / (1.0f + e1), w1 = g_p * e1 / (1.0f + e1);
        if (lane == 0) {
            const int ea = g * 8 + i0, eb = g * 8 + i1;
            const unsigned pa = __hip_atomic_fetch_add(cnt + ea, 1u, __ATOMIC_RELAXED, __HIP_MEMORY_SCOPE_AGENT), pb = __hip_atomic_fetch_add(cnt + eb, 1u, __ATOMIC_RELAXED, __HIP_MEMORY_SCOPE_AGENT);
            list[ea * 65536 + pa] = m; list[eb * 65536 + pb] = m; gw[ea * 65536 + pa] = w0; gw[eb * 65536 + pb] = w1;
            asg[2 * m] = ((unsigned)ea << 16) | pa; asg[2 * m + 1] = ((unsigned)eb << 16) | pb;
        }
    }
};
struct BgHandler {
    float* bg; const float* a_log; const float* dt_bias; int lane;
    DI void operator()(int m, float v) const {
        if (lane < 16) {
            float r;
            if (lane < 8) r = 1.0f / (1.0f + __expf(-v));
            else { const float z = v + dt_bias[lane - 8]; const float sp = z > 20.f ? z : log1pf(__expf(z)); r = -__expf(a_log[lane - 8]) * sp; }
            bg[(size_t)m * 16 + lane] = r; }
    }
};
struct NoHandler { DI void operator()(int, float) const {} };
DI void moe_tables(Frame& F, const unsigned* cntg) {
    LAS int* cnt = (LAS int*)(F.lds + TBL_OFF); LAS int* tb = cnt + 32;
    __syncthreads();
    if (F.tid == 0) { int acc = 0; for (int e = 0; e < 32; ++e) { const int c = (int)__hip_atomic_load(cntg + e, __ATOMIC_RELAXED, __HIP_MEMORY_SCOPE_AGENT); cnt[e] = c; tb[e] = acc; acc += (c + 255) >> 8; } tb[32] = acc; }
    __syncthreads();
}

constexpr int NPH = 19;
#ifndef FAST_GDN
#define FAST_GDN 1
#endif
#ifndef FAST_RET
#define FAST_RET 1
#endif
struct Args { const float* in[20]; float* out; unsigned char* ws; int ph_lo, ph_hi; };
__global__ void __launch_bounds__(NTHR, 2) mk_fwd(Args args) {
    extern __shared__ __attribute__((aligned(16))) unsigned char lds[];
    Frame F;
    F.lds = (LAS unsigned char*)lds; F.tid = threadIdx.x; F.lane = F.tid & 63; F.wave = __builtin_amdgcn_readfirstlane(F.tid >> 6); F.G = gridDim.x;
    F.gw = blockIdx.x * NWAVES + F.wave; F.NGW = F.G * NWAVES; F.ws = args.ws; F.ctl = (unsigned*)(args.ws + WS_CTL);
    volatile LAS unsigned* MISC = (volatile LAS unsigned*)(F.lds + MISC_OFF);
    if (F.tid < 64) MISC[F.tid] = 0u;
    __syncthreads();
    XcdBarrier bar; bar.bar = F.ctl + CW_BAR; bar.x = 0; bar.st = nullptr;
    if (!MK_MULTI) bar = xcd_barrier_post(F.ctl + CW_BAR, MISC + 8);
    const int lo = args.ph_lo, hi = args.ph_hi;
#ifdef ONLY_PH
#define IN(k) ((k) == ONLY_PH && lo <= (k) && (k) < hi)
#else
#define IN(k) (lo <= (k) && (k) < hi)
#endif
#define SEAM(k) do { if (IN(k) && IN((k) + 1)) xcd_barrier(bar); } while (0)
    const float* const* in = args.in;
    float* XC = args.out;
    bf16_t* H = (bf16_t*)(F.ws + WS_H);
    bf16_t* PJ = (bf16_t*)(F.ws + WS_BIG + BIG_PJ);
    unsigned char* aux = F.ws;
    const LAS int* tbl_cnt = (const LAS int*)(F.lds + TBL_OFF); const LAS int* tbl_tb = tbl_cnt + 32;
    LAS unsigned* tokoff = (LAS unsigned*)(F.lds + TOK_OFF);

    enum { P_W = 0, P_N0, P_G0, P_PREP, P_GA, P_SCAN, P_MIX, P_O0, P_M0A, P_M0B, P_M0C, P_N1, P_G1, P_SPREP, P_SWA, P_O1, P_M1A, P_M1B, P_M1C, P_FIN };
    static_assert(P_FIN == NPH, "phase count");
    if (IN(P_W)) { p0_weights(F, in); __syncthreads(); }
    SEAM(P_W);
    if (IN(P_N0)) {
        BgHandler hb{(float*)(aux + AUX_BG), in[6], in[7], F.lane};
        norm_pass<16, false, false, true>(F, in[0], nullptr, nullptr, nullptr, tbl_tb, in[1], (const float*)(aux + AUX_SW), H, hb);
    }
    SEAM(P_N0);
    if (IN(P_G0)) {
        pg8::DenseOrder S; S.init(NTOK, PJW, D, D, (const bf16_t*)(F.ws + WS_WIN0), F.G, blockIdx.x);
        pg8::EpiBf16 E{PJ, PJW};
        pg8::gemm_phase(F.lds, H, D, S, E);
    }
    SEAM(P_G0);
    if (IN(P_PREP)) p2_prep(F, in[5]);
    SEAM(P_PREP);
    if (IN(P_GA)) {
        for (int u = F.gw; u < 16 * NCH; u += F.NGW) {
            if (FAST_GDN) ga_unit<true>(F, u, (unsigned char*)args.out, nullptr);
            if (FAST_RET) ga_unit<false>(F, u, F.ws + AUX_W, nullptr);
        }
        __syncthreads();
    }
    SEAM(P_GA);
    if (IN(P_SCAN)) {
        if (FAST_GDN || FAST_RET) {
            for (int id = blockIdx.x; id < 256; id += F.G) { const int bh = (id % 8) * 2 + (id / 8) / 16, sl = (id / 8) % 16;
                if (FAST_GDN && F.wave == 0) scan_wave<true>(F, bh, sl, (const unsigned char*)args.out);
                if (FAST_RET && F.wave == 1) scan_wave<false>(F, bh, sl, F.ws + AUX_W); }
            __syncthreads();
        }
#ifndef NO_NAIVE
        if (!FAST_RET && blockIdx.x < 8) p3_recurrence<false>(F, blockIdx.x);
        if (!FAST_GDN && blockIdx.x >= 8 && blockIdx.x < 16) p3_recurrence<true>(F, blockIdx.x - 8);
#endif
        __syncthreads();
    }
    SEAM(P_SCAN);
    if (IN(P_MIX)) p4_mixnorm(F, in[4], in[8]);
    SEAM(P_MIX);
    if (IN(P_O0)) {
        pg8::DenseOrder S; S.init(NTOK, D, 4096, PJW, (const bf16_t*)(F.ws + WS_WOUT0), F.G, blockIdx.x);
        pg8::EpiResF32 E{in[0], XC, D};
        pg8::gemm_phase(F.lds, PJ + C_RG, 4096, S, E);
    }
    SEAM(P_O0);
#define MOE_LAYER(P, L, CNTW)                                                                                                                  \
    if (IN(P)) {                                                            \
        convert_experts(F, in, L);                                                                                                             \
        RouteHandler hr{F.ctl + CNTW, (int*)(aux + AUX_LIST), (float*)(aux + AUX_GW), (unsigned*)(aux + AUX_ASG), F.lane};                      \
        norm_pass<36, false, false, true>(F, XC, nullptr, nullptr, nullptr, tbl_tb, in[2] + L * D, (const float*)(aux + AUX_SW) + 16 * D + L * 36 * D, H, hr); \
        __syncthreads();                                                                                                                       \
    }                                                                                                                                          \
    SEAM(P);                                                                                                                                   \
    if (IN(P + 1)) {                                                                                                \
        moe_tables(F, F.ctl + CNTW);                                                                                                           \
        pg8::MoeOrder<true> S; S.init(tbl_tb, tokoff, 6, D, D, (const bf16_t*)(F.ws + WS_BIG + BIG_EGU), (size_t)1536 * D, F.G, blockIdx.x);   \
        { pg8::Unit u; const int* list = (const int*)(aux + AUX_LIST);                                                                         \
          for (int ui = 0; ui < 12 && S.next(ui, u); ++ui) if (F.tid < 256) { const int idx = (u.pm - tbl_tb[u.e]) * 256 + F.tid;               \
              const int tok = idx < tbl_cnt[u.e] ? list[u.e * 65536 + idx] : 0; tokoff[ui * 256 + F.tid] = (unsigned)tok * (unsigned)(D * 2); } } \
        __syncthreads();                                                                                                                       \
        pg8::EpiSwiglu E{(bf16_t*)(F.ws + WS_BIG + BIG_HID)};                                                                                  \
        pg8::gemm_phase(F.lds, H, D, S, E);                                                                                                    \
    }                                                                                                                                          \
    SEAM(P + 1);                                                                                                                               \
    if (IN(P + 2)) {                                                                                  \
        moe_tables(F, F.ctl + CNTW);                                                                                                           \
        pg8::MoeOrder<false> S; S.init(tbl_tb, tokoff, 8, FF, FF, (const bf16_t*)(F.ws + WS_BIG + BIG_EDN), (size_t)D * FF, F.G, blockIdx.x);  \
        pg8::EpiDown E{(bf16_t*)(F.ws + WS_BIG + BIG_Y), (const float*)(aux + AUX_GW), tbl_tb};                                                \
        pg8::gemm_phase(F.lds, (const bf16_t*)(F.ws + WS_BIG + BIG_HID), FF, S, E);                                                            \
    }                                                                                                                                          \
    SEAM(P + 2);
    MOE_LAYER(P_M0A, 0, CW_CNT0)
    if (IN(P_N1)) {
        moe_tables(F, F.ctl + CW_CNT0);
        norm_pass<0, true, true, true>(F, XC, XC, (const bf16_t*)(F.ws + WS_BIG + BIG_Y), (const unsigned*)(aux + AUX_ASG), tbl_tb, in[1] + D, nullptr, H, NoHandler{});
        __syncthreads();
    }
    SEAM(P_N1);
    if (IN(P_G1)) {
        pg8::DenseOrder S; S.init(NTOK, ODD_IN, D, D, (const bf16_t*)(F.ws + WS_WIN1), F.G, blockIdx.x);
        pg8::EpiBf16 E{(bf16_t*)(F.ws + WS_BIG + BIG_QKV1), ODD_IN};
        pg8::gemm_phase(F.lds, H, D, S, E);
    }
    SEAM(P_G1);
    if (IN(P_SPREP)) p11_swaprep(F, in[11], in[12]);
    SEAM(P_SPREP);
#ifdef SWA_NAIVE
    if (IN(P_SWA)) p12_swa_naive(F, in[13]);
#else
    if (IN(P_SWA)) { swa_phase(F, in[13]); __syncthreads(); }
#endif
    SEAM(P_SWA);
    if (IN(P_O1)) {
        pg8::DenseOrder S; S.init(NTOK, D, D, ODD_IN, (const bf16_t*)(F.ws + WS_WOUT1), F.G, blockIdx.x);
        pg8::EpiResF32 E{XC, XC, D};
        pg8::gemm_phase(F.lds, (const bf16_t*)(F.ws + WS_BIG + BIG_QKV1), D, S, E);
    }
    SEAM(P_O1);
    MOE_LAYER(P_M1A, 1, CW_CNT1)
    if (IN(P_FIN)) {
        moe_tables(F, F.ctl + CW_CNT1);
        norm_pass<0, true, true, false>(F, XC, XC, (const bf16_t*)(F.ws + WS_BIG + BIG_Y), (const unsigned*)(aux + AUX_ASG), tbl_tb, nullptr, nullptr, nullptr, NoHandler{});
    }
#undef IN
#undef SEAM
}

extern "C" void kernel_launch(void* const* d_in, const int* in_sizes, int n_in, void* d_out, int out_size, void* d_ws, size_t ws_size, hipStream_t stream) {
    static int grid = 0;
    if (grid == 0) {
        if (n_in != 20 || in_sizes[0] != NTOK * D || out_size != NTOK * D || ws_size < WS_END) { fprintf(stderr, "kernel_launch: unexpected shapes / workspace (n_in %d, in0 %d, out %d, ws %zu, need %zu)\n", n_in, n_in > 0 ? in_sizes[0] : -1, out_size, ws_size, (size_t)WS_END); grid = -1; return; }
        int dev = 0, cus = 0, per_cu = 0;
        if (hipGetDevice(&dev) != hipSuccess || hipDeviceGetAttribute(&cus, hipDeviceAttributeMultiprocessorCount, dev) != hipSuccess) { grid = -1; return; }
        if (hipFuncSetAttribute((const void*)mk_fwd, hipFuncAttributeMaxDynamicSharedMemorySize, LDS_BYTES) != hipSuccess) { fprintf(stderr, "kernel_launch: hipFuncSetAttribute failed\n"); grid = -1; return; }
        if (hipOccupancyMaxActiveBlocksPerMultiprocessor(&per_cu, (const void*)mk_fwd, NTHR, LDS_BYTES) != hipSuccess || per_cu < 1) fprintf(stderr, "kernel_launch: occupancy query reports %d\n", per_cu);
        (void)hipGetLastError();
        grid = cus;
    }
    if (grid < 0) return;
    (void)hipMemsetAsync((char*)d_ws + WS_CTL, 0, CTL_ZERO_BYTES, stream);
    Args a{};
    for (int i = 0; i < 20; ++i) a.in[i] = (const float*)d_in[i];
    a.out = (float*)d_out; a.ws = (unsigned char*)d_ws;
#if MK_MULTI
    for (int p = 0; p <= NPH; ++p) { a.ph_lo = p; a.ph_hi = p + 1; hipLaunchKernelGGL(mk_fwd, dim3(grid), dim3(NTHR), LDS_BYTES, stream, a); }
#else
    a.ph_lo = 0; a.ph_hi = NPH + 1;
    hipLaunchKernelGGL(mk_fwd, dim3(grid), dim3(NTHR), LDS_BYTES, stream, a);
#endif
}
```

```cpp
#include <hip/hip_runtime.h>
#include <cstdio>
#include <cstdint>

#ifndef MK_MULTI
#define MK_MULTI 0
#endif

#define LAS __attribute__((address_space(3)))
typedef unsigned short bf16_t;
typedef short bf16x8 __attribute__((ext_vector_type(8)));
typedef float f32x4 __attribute__((ext_vector_type(4)));
typedef float f32x2 __attribute__((ext_vector_type(2)));
typedef unsigned u32x4 __attribute__((ext_vector_type(4)));
typedef unsigned u32x2 __attribute__((ext_vector_type(2)));
#define DI __device__ __forceinline__

constexpr int D = 2048, BATCH = 2, SEQ = 16384, NTOK = BATCH * SEQ;
constexpr int EVEN_IN = 12304, PJW = 12288;
constexpr int ODD_IN = 2560;
constexpr int NEXP = 32, FF = 768, TOPK = 2, MAXT = 288;
constexpr float EPS = 1e-6f;
constexpr double ROPE_R = 0.86596432336006535;
constexpr int C_RQ = 0, C_RK = 1024, C_RV = 2048, C_GQKV = 4096, C_RG = 8192, C_GZ = 10240;

constexpr size_t MiB = 1u << 20;
constexpr size_t WS_CTL = 0, CTL_ZERO_BYTES = 1 * MiB;
constexpr size_t WS_WIN0 = 2 * MiB;
constexpr size_t WS_WOUT0 = WS_WIN0 + 48 * MiB;
constexpr size_t WS_WIN1 = WS_WOUT0 + 16 * MiB;
constexpr size_t WS_WOUT1 = WS_WIN1 + 10 * MiB;
constexpr size_t WS_H = 84 * MiB;
constexpr size_t WS_BIG = 212 * MiB;
constexpr size_t WS_AUX = 980 * MiB;
constexpr size_t WS_END = 1492 * MiB;
constexpr size_t BIG_PJ = 0;
constexpr size_t BIG_EGU = 0;
constexpr size_t BIG_EDN = 192 * MiB;
constexpr size_t BIG_HID = 288 * MiB;
constexpr size_t BIG_Y = 400 * MiB;
constexpr size_t BIG_QKV1 = 0;
constexpr size_t AUX_QN = WS_AUX + 0;
constexpr size_t AUX_KN = WS_AUX + 64 * MiB;
constexpr size_t AUX_VC = WS_AUX + 128 * MiB;
constexpr size_t AUX_W = WS_AUX + 256 * MiB;
constexpr size_t AUX_ATT = WS_AUX + 320 * MiB;
constexpr size_t AUX_RST = WS_AUX + 352 * MiB;
constexpr size_t AUX_BG = WS_AUX + 480 * MiB;
constexpr size_t AUX_CS = WS_AUX + 482 * MiB;
constexpr size_t AUX_DEC = WS_AUX + 490 * MiB + 960 * 1024;
constexpr size_t AUX_SW = WS_AUX + 490 * MiB;
constexpr size_t AUX_LIST = WS_AUX + 491 * MiB;
constexpr size_t AUX_GW = WS_AUX + 499 * MiB;
constexpr size_t AUX_ASG = WS_AUX + 507 * MiB;
static_assert(AUX_ASG + MiB <= WS_END, "aux map");
constexpr int CW_BAR = 4096;
constexpr int CW_CNT0 = 16384, CW_CNT1 = 16384 + 64;

constexpr int RING_BYTES = 131072;
constexpr int GA_LDS_WAVE = 17920;
constexpr int MISC_OFF = 8 * GA_LDS_WAVE;
constexpr int TBL_OFF = MISC_OFF + 256;
constexpr int TOK_OFF = MISC_OFF + 1024;
constexpr int LDS_BYTES = 163840;
static_assert(TOK_OFF + 12 * 1024 <= LDS_BYTES, "lds map");
DI float rdlane(float v, int l) { return __builtin_bit_cast(float, __builtin_amdgcn_readlane(__builtin_bit_cast(int, v), l)); }

DI unsigned f2bf(float f) { unsigned u = __builtin_bit_cast(unsigned, f); return (u + 0x7fffu + ((u >> 16) & 1u)) >> 16; }
DI unsigned pk2(float lo, float hi) { return f2bf(lo) | (f2bf(hi) << 16); }
DI float bflo(unsigned w) { return __builtin_bit_cast(float, w << 16); }
DI float bfhi(unsigned w) { return __builtin_bit_cast(float, w & 0xffff0000u); }
DI float bf2f(bf16_t b) { return __builtin_bit_cast(float, ((unsigned)b) << 16); }
DI unsigned cvt_pk_bf16(float lo, float hi) { unsigned r; asm volatile("v_cvt_pk_bf16_f32 %0, %1, %2" : "=v"(r) : "v"(lo), "v"(hi)); return r; }
DI float wave_sum(float v) {
#pragma unroll
    for (int o = 1; o < 64; o <<= 1) v += __shfl_xor(v, o);
    return v;
}
DI float siluf(float x) { return x / (1.0f + __expf(-x)); }
#define LDS_WAIT() asm volatile("s_waitcnt lgkmcnt(0)" ::: "memory")
#define VM_WAIT() asm volatile("s_waitcnt vmcnt(0)" ::: "memory")

#define XB_TMO      128
#define XB_XCNT(j)  (256  + 64 * (j))
#define XB_XSUB(j)  (1280 + 64 * (j))
#define XB_XGEN(j)  (2304 + 64 * (j))
#define XB_TOP      3328
#define XB_TOPGEN   3392
#define XCD_BAR_WORDS 3456
#define XB_SPIN_CAP (1u << 22)
DI unsigned xb_ld(unsigned* p)              { return __hip_atomic_load(p, __ATOMIC_RELAXED, __HIP_MEMORY_SCOPE_AGENT); }
DI unsigned xb_add(unsigned* p, unsigned v) { return __hip_atomic_fetch_add(p, v, __ATOMIC_RELAXED, __HIP_MEMORY_SCOPE_AGENT); }
DI unsigned xb_xcc_id() { return (unsigned)__builtin_amdgcn_s_getreg((3 << 11) | 20) & 0xFu; }
#define XB_SPIN(cond, bar) do { unsigned _sp = 0; while (cond) { __builtin_amdgcn_s_sleep(1); \
    if ((++_sp & 255u) == 0u) { if (xb_ld(&(bar)[XB_TMO])) break; if (_sp > XB_SPIN_CAP) { atomicAdd(&(bar)[XB_TMO], 1u); break; } } } } while (0)
struct XcdBarrier { unsigned* bar; unsigned x; volatile LAS unsigned* st; };
DI XcdBarrier xcd_barrier_post(unsigned* bar, volatile LAS unsigned* st) {
    XcdBarrier b; b.bar = bar; b.x = xb_xcc_id(); b.st = st;
    if (threadIdx.x == 0) (void)xb_add(&bar[XB_XCNT(b.x)], 1u);
    return b;
}
DI void xcd_barrier_complete(unsigned* bar, unsigned x, unsigned& nloc, unsigned& nx) {
    const unsigned G = gridDim.x * gridDim.y * gridDim.z;
    unsigned sum, cnt, mine, sp = 0u;
    for (;;) {
        sum = 0u; cnt = 0u; mine = 0u;
#pragma unroll
        for (unsigned j = 0; j < 16; ++j) { const unsigned c = xb_ld(&bar[XB_XCNT(j)]); sum += c; cnt += (c > 0u) ? 1u : 0u; mine = (j == x) ? c : mine; }
        if (sum == G) break;
        __builtin_amdgcn_s_sleep(1);
        if ((++sp & 255u) == 0u) { if (xb_ld(&bar[XB_TMO])) break; if (sp > XB_SPIN_CAP) { atomicAdd(&bar[XB_TMO], 1u); break; } }
    }
    nloc = mine > 0u ? mine : 1u; nx = cnt > 0u ? cnt : 1u;
}
DI void xcd_barrier(const XcdBarrier& b) {
    asm volatile("s_waitcnt vmcnt(0)" ::: "memory");
    __syncthreads();
    if (threadIdx.x == 0) {
        unsigned* bar = b.bar;
        __builtin_amdgcn_s_waitcnt(0);
        unsigned nloc = b.st[0], nx = b.st[1];
        if (nloc == 0u) { xcd_barrier_complete(bar, b.x, nloc, nx); b.st[0] = nloc; b.st[1] = nx; }
        const unsigned old = xb_add(&bar[XB_XSUB(b.x)], 1u);
        const unsigned gen = old / nloc;
        if (old + 1u == (gen + 1u) * nloc) {
            __builtin_amdgcn_fence(__ATOMIC_RELEASE, "agent");
            asm volatile("s_waitcnt vmcnt(0)" ::: "memory");
            const unsigned og = xb_add(&bar[XB_TOP], 1u);
            const unsigned tg = og / nx;
            if (og + 1u == (tg + 1u) * nx) xb_add(&bar[XB_TOPGEN], 1u);
            else XB_SPIN(xb_ld(&bar[XB_TOPGEN]) == tg, bar);
            __builtin_amdgcn_fence(__ATOMIC_ACQUIRE, "agent");
            xb_add(&bar[XB_XGEN(b.x)], 1u);
            asm volatile("s_waitcnt vmcnt(0)" ::: "memory");
        } else {
            XB_SPIN(xb_ld(&bar[XB_XGEN(b.x)]) == gen, bar);
            __builtin_amdgcn_fence(__ATOMIC_ACQUIRE, "agent");
            asm volatile("s_waitcnt vmcnt(0)" ::: "memory");
        }
    }
    __syncthreads();
}

namespace pg8 {
constexpr int BM = 256, BK = 64, HALF = 128, HTB = HALF * BK * 2, STAGE_BYTES = 8 * HTB, NXCD = 8, WGM = 8;
__host__ __device__ __forceinline__ int lds_byte(int r, int c) { const int st = (r >> 4) * 2 + (c >> 5), rr = r & 15, cc = c & 31, ob = rr * 64 + cc * 2; return st * 1024 + (ob ^ (((ob >> 9) & 1) << 5)); }
__host__ __device__ __forceinline__ void stage_rc(int b, int& R, int& C) { const int st = b / 1024, sb = b % 1024, swz = sb ^ (((sb >> 9) & 1) << 5); R = (st >> 1) * 16 + swz / 64; C = (st & 1) * 32 + (swz % 64) / 2; }
__host__ __device__ __forceinline__ int perm32(int rho) { const int n = rho >> 4, i = rho & 15; return 8 * (i >> 2) + 4 * n + (i & 3); }

struct Unit { int pm, pn, e, slot; };

DI int xcd_remap(int L, int nwg) { const int q = nwg / NXCD, r = nwg % NXCD, xcd = L % NXCD, off = L / NXCD; return (xcd < r ? xcd * (q + 1) : r * (q + 1) + (xcd - r) * q) + off; }

struct DenseOrder {
    int nM, nN, nwg, G, c; unsigned lda2; const char* Bt; size_t tstepB;
    DI void init(int M, int N, int K, int lda, const bf16_t* Bt_, int G_, int c_) { nM = M / BM; nN = N / BM; nwg = nM * nN; G = G_; c = c_; lda2 = (unsigned)lda * 2u; Bt = (const char*)Bt_; tstepB = (size_t)BM * K * 2; }
    DI bool next(int i, Unit& u) const {
        const long L = (long)i * G + c; if (L >= nwg) return false;
        const int wgid = xcd_remap((int)L, nwg);
        const int nig = WGM * nN, gid = wgid / nig, fm = gid * WGM, gsz = (nM - fm) < WGM ? (nM - fm) : WGM;
        u.pm = fm + ((wgid % nig) % gsz); u.pn = (wgid % nig) / gsz; u.e = 0; u.slot = i; return true;
    }
    DI unsigned a_off(const Unit& u, int h, int R) const { return (unsigned)(u.pm * BM + h * HALF + R) * lda2; }
    DI const char* b_base(const Unit& u) const { return Bt + (size_t)u.pn * tstepB; }
};
template <bool GATHER> struct MoeOrder {
    const LAS int* tb; const LAS unsigned* tokoff; int NT, nwg, G, c; unsigned lda2; const char* Bt; size_t estepB, tstepB;
    DI void init(const LAS int* tb_, const LAS unsigned* tokoff_, int NT_, int K, int lda, const bf16_t* Bt_, size_t estep_elems, int G_, int c_) {
        tb = tb_; tokoff = tokoff_; NT = NT_; nwg = tb_[32] * NT_; G = G_; c = c_; lda2 = (unsigned)lda * 2u; Bt = (const char*)Bt_; estepB = estep_elems * 2; tstepB = (size_t)BM * K * 2; }
    DI bool next(int i, Unit& u) const {
        const long L = (long)i * G + c; if (L >= nwg) return false;
        const int w = xcd_remap((int)L, nwg);
        int e = 0;
#pragma unroll 1
        for (int s = 16; s >= 1; s >>= 1) if (tb[e + s] * NT <= w) e += s;
        const int nt = tb[e + 1] - tb[e], local = w - tb[e] * NT;
        u.e = e; u.pn = local / nt; u.pm = tb[e] + local % nt; u.slot = i; return true;
    }
    DI unsigned a_off(const Unit& u, int h, int R) const { if (GATHER) return tokoff[u.slot * 256 + h * HALF + R]; return (unsigned)(u.pm * BM + h * HALF + R) * lda2; }
    DI const char* b_base(const Unit& u) const { return Bt + (size_t)u.e * estepB + (size_t)u.pn * tstepB; }
};

struct EpiBf16 {
    static constexpr bool PERM = true;
    bf16_t* O; int ldc;
    DI void operator()(const f32x4 (&acc)[2][2][4][2], const Unit& u, int wr, int wc, int fr, int fq) const {
        const int row0 = u.pm * BM + wr * 64 + fr, col0 = u.pn * BM + wc * 32 + 8 * fq;
#pragma unroll
        for (int ai = 0; ai < 2; ++ai)
#pragma unroll
            for (int m = 0; m < 4; ++m) { bf16_t* rowp = O + (size_t)(row0 + ai * HALF + m * 16) * ldc + col0;
#pragma unroll
                for (int bj = 0; bj < 2; ++bj) { const f32x4 v0 = acc[ai][bj][m][0], v1 = acc[ai][bj][m][1];
                    u32x4 w; w.x = cvt_pk_bf16(v0[0], v0[1]); w.y = cvt_pk_bf16(v0[2], v0[3]); w.z = cvt_pk_bf16(v1[0], v1[1]); w.w = cvt_pk_bf16(v1[2], v1[3]);
                    *(u32x4*)(rowp + bj * HALF) = w; } }
    }
};
struct EpiResF32 {
    static constexpr bool PERM = false;
    const float* base; float* out; int ldc;
    DI void operator()(const f32x4 (&acc)[2][2][4][2], const Unit& u, int wr, int wc, int fr, int fq) const {
        const int row0 = u.pm * BM + wr * 64 + fr, col0 = u.pn * BM + wc * 32 + 4 * fq;
#pragma unroll
        for (int ai = 0; ai < 2; ++ai)
#pragma unroll
            for (int m = 0; m < 4; ++m) { const size_t off = (size_t)(row0 + ai * HALF + m * 16) * ldc + col0;
#pragma unroll
                for (int bj = 0; bj < 2; ++bj)
#pragma unroll
                    for (int n = 0; n < 2; ++n) { const f32x4 bs = *(const f32x4*)(base + off + bj * HALF + n * 16); *(f32x4*)(out + off + bj * HALF + n * 16) = bs + acc[ai][bj][m][n]; }
                asm volatile("" ::: "memory"); }
    }
};
struct EpiSwiglu {
    static constexpr bool PERM = true;
    bf16_t* O;
    DI void operator()(const f32x4 (&acc)[2][2][4][2], const Unit& u, int wr, int wc, int fr, int fq) const {
        const int row0 = u.pm * BM + wr * 64 + fr, col0 = u.pn * HALF + wc * 32 + 8 * fq;
#pragma unroll
        for (int ai = 0; ai < 2; ++ai)
#pragma unroll
            for (int m = 0; m < 4; ++m) { bf16_t* rowp = O + (size_t)(row0 + ai * HALF + m * 16) * FF + col0;
                float h[8];
#pragma unroll
                for (int n = 0; n < 2; ++n)
#pragma unroll
                    for (int j = 0; j < 4; ++j) { const float g = acc[ai][0][m][n][j], up = acc[ai][1][m][n][j]; h[n * 4 + j] = g / (1.0f + __expf(-g)) * up; }
                u32x4 w; w.x = cvt_pk_bf16(h[0], h[1]); w.y = cvt_pk_bf16(h[2], h[3]); w.z = cvt_pk_bf16(h[4], h[5]); w.w = cvt_pk_bf16(h[6], h[7]);
                *(u32x4*)rowp = w; }
    }
};
struct EpiDown {
    static constexpr bool PERM = true;
    bf16_t* O; const float* gw; const LAS int* tb;
    DI void operator()(const f32x4 (&acc)[2][2][4][2], const Unit& u, int wr, int wc, int fr, int fq) const {
        const int row0 = u.pm * BM + wr * 64 + fr, col0 = u.pn * BM + wc * 32 + 8 * fq;
        const int lrow0 = (u.pm - tb[u.e]) * BM + wr * 64 + fr;
        const float* gwe = gw + (size_t)u.e * 65536;
#pragma unroll
        for (int ai = 0; ai < 2; ++ai)
#pragma unroll
            for (int m = 0; m < 4; ++m) { bf16_t* rowp = O + (size_t)(row0 + ai * HALF + m * 16) * D + col0; const float g = gwe[lrow0 + ai * HALF + m * 16];
#pragma unroll
                for (int bj = 0; bj < 2; ++bj) { const f32x4 v0 = acc[ai][bj][m][0] * g, v1 = acc[ai][bj][m][1] * g;
                    u32x4 w; w.x = cvt_pk_bf16(v0[0], v0[1]); w.y = cvt_pk_bf16(v0[2], v0[3]); w.z = cvt_pk_bf16(v1[0], v1[1]); w.w = cvt_pk_bf16(v1[2], v1[3]);
                    *(u32x4*)(rowp + bj * HALF) = w; } }
    }
};

template <class Epi, class Sched>
DI void gemm_phase(LAS unsigned char* lds, const bf16_t* Aptr, int K, const Sched& S, const Epi& E) {
    const int tid = threadIdx.x, wid = __builtin_amdgcn_readfirstlane(tid >> 6), lane = tid & 63, wr = wid >> 2, wc = wid & 3, fr = lane & 15, fq = lane >> 4;
    const int nt = K / BK;
    const char* Ab = (const char*)Aptr;
    int Rr[2], Cc[2]; unsigned voffB[2];
#pragma unroll
    for (int i = 0; i < 2; ++i) { int R, C; stage_rc(tid * 16 + i * 8192, R, C); const int Rb = Epi::PERM ? ((R & ~31) + perm32(R & 31)) : R; Rr[i] = R; Cc[i] = C * 2; voffB[i] = (unsigned)(Rb * K + C) * 2u; }
    const unsigned kstep = (unsigned)(BK * 2);
    const size_t hstepB = (size_t)HALF * K * 2;
    const unsigned ldsw = (unsigned)wid * 1024u;
    const int aoff = lds_byte(wr * 64 + fr, fq * 8), boff = lds_byte(wc * 32 + fr, fq * 8);
#define PG8_SA(b, h) (((b) * 2 + (h)) * HTB)
#define PG8_SB(b, h) ((4 + (b) * 2 + (h)) * HTB)
#define PG8_STAGEB(bufoff, gbase) do { _Pragma("unroll") for (int _i = 0; _i < 2; ++_i) \
        __builtin_amdgcn_global_load_lds((const unsigned*)((const char*)(gbase) + voffB[_i]), (LAS unsigned*)(lds + (bufoff) + ldsw + _i * 8192), 16, 0, 0); } while (0)
#define PG8_STAGEA(bufoff, offs, kb) do { _Pragma("unroll") for (int _i = 0; _i < 2; ++_i) \
        __builtin_amdgcn_global_load_lds((const unsigned*)(Ab + (size_t)((offs)[_i] + (kb))), (LAS unsigned*)(lds + (bufoff) + ldsw + _i * 8192), 16, 0, 0); } while (0)
#define PG8_LDA(dst, b, h) do { _Pragma("unroll") for (int m = 0; m < 4; ++m) _Pragma("unroll") for (int k = 0; k < 2; ++k) dst[m][k] = *(const LAS bf16x8*)(lds + PG8_SA(b, h) + aoff + m * 2048 + k * 1024); } while (0)
#define PG8_LDB(dst, b, h) do { _Pragma("unroll") for (int n = 0; n < 2; ++n) _Pragma("unroll") for (int k = 0; k < 2; ++k) dst[n][k] = *(const LAS bf16x8*)(lds + PG8_SB(b, h) + boff + n * 2048 + k * 1024); } while (0)
#define PG8_MMA(ai, bj, At, Bt) do { __builtin_amdgcn_s_setprio(1); _Pragma("unroll") for (int m = 0; m < 4; ++m) _Pragma("unroll") for (int n = 0; n < 2; ++n) _Pragma("unroll") for (int k = 0; k < 2; ++k) \
        acc[ai][bj][m][n] = __builtin_amdgcn_mfma_f32_16x16x32_bf16(Bt[n][k], At[m][k], acc[ai][bj][m][n], 0, 0, 0); __builtin_amdgcn_s_setprio(0); } while (0)
#define PG8_WAIT_V(n) asm volatile("s_waitcnt vmcnt(" #n ")" ::: "memory")
#define PG8_WAIT_L(n) asm volatile("s_waitcnt lgkmcnt(" #n ")" ::: "memory")
#define PG8_BAR __builtin_amdgcn_s_barrier()
#define PG8_SCHED __builtin_amdgcn_sched_barrier(0)
    Unit cur, nxt; int ui = 0;
    if (!S.next(0, cur)) return;
    f32x4 acc[2][2][4][2];
#pragma unroll
    for (int a = 0; a < 2; ++a)
#pragma unroll
        for (int b = 0; b < 2; ++b)
#pragma unroll
            for (int m = 0; m < 4; ++m)
#pragma unroll
                for (int n = 0; n < 2; ++n) acc[a][b][m][n] = (f32x4){0.f, 0.f, 0.f, 0.f};
    bf16x8 At[4][2], B0[2][2], B1[2][2];
    unsigned ao[2][2], an[2][2];
#pragma unroll
    for (int h = 0; h < 2; ++h)
#pragma unroll
        for (int i = 0; i < 2; ++i) ao[h][i] = S.a_off(cur, h, Rr[i]) + (unsigned)Cc[i];
    const char* cB = S.b_base(cur);
    PG8_STAGEB(PG8_SB(0, 0), cB); PG8_STAGEB(PG8_SB(0, 1), cB + hstepB); PG8_STAGEA(PG8_SA(0, 0), ao[0], 0u); PG8_STAGEA(PG8_SA(0, 1), ao[1], 0u);
    if (wr == 1) PG8_BAR;
    PG8_WAIT_V(2); PG8_BAR;
    PG8_STAGEB(PG8_SB(1, 0), cB + kstep); PG8_STAGEA(PG8_SA(1, 0), ao[0], kstep); PG8_STAGEB(PG8_SB(1, 1), cB + hstepB + kstep);
    PG8_WAIT_V(6); PG8_BAR;
    for (;;) {
        const bool has_next = S.next(ui + 1, nxt);
        const char* nB = has_next ? S.b_base(nxt) : cB;
#pragma unroll
        for (int h = 0; h < 2; ++h)
#pragma unroll
            for (int i = 0; i < 2; ++i) an[h][i] = has_next ? (S.a_off(nxt, h, Rr[i]) + (unsigned)Cc[i]) : ao[h][i];
        for (int t = 0; t < nt; t += 2) {
            const bool last = (t == nt - 2);
            const unsigned kb1 = (unsigned)(t + 1) * kstep, kb2 = (unsigned)(t + 2) * kstep;
            unsigned x2[2][2];
#pragma unroll
            for (int h = 0; h < 2; ++h)
#pragma unroll
                for (int i = 0; i < 2; ++i) x2[h][i] = last ? an[h][i] : ao[h][i] + kb2;
            const char* b2 = last ? nB : cB + kb2; const char* b3 = b2 + kstep;
            PG8_LDB(B0, 0, 0); PG8_LDB(B1, 0, 1); PG8_SCHED; PG8_LDA(At, 0, 0); PG8_STAGEA(PG8_SA(1, 1), ao[1], kb1);
            PG8_WAIT_V(8); PG8_WAIT_L(0); PG8_BAR; PG8_MMA(0, 0, At, B0); PG8_MMA(0, 1, At, B1); PG8_BAR; PG8_SCHED;
            PG8_LDA(At, 0, 1); PG8_STAGEB(PG8_SB(0, 0), b2); PG8_STAGEB(PG8_SB(0, 1), b2 + hstepB); PG8_STAGEA(PG8_SA(0, 0), x2[0], 0u);
            PG8_WAIT_V(8); PG8_WAIT_L(0); PG8_BAR; PG8_MMA(1, 0, At, B0); PG8_MMA(1, 1, At, B1); PG8_BAR; PG8_SCHED;
            PG8_LDB(B0, 1, 0); PG8_LDB(B1, 1, 1); PG8_SCHED; PG8_LDA(At, 1, 0); PG8_STAGEA(PG8_SA(0, 1), x2[1], 0u);
            PG8_WAIT_V(8); PG8_WAIT_L(0); PG8_BAR; PG8_MMA(0, 0, At, B0); PG8_MMA(0, 1, At, B1); PG8_BAR; PG8_SCHED;
            PG8_LDA(At, 1, 1); PG8_STAGEB(PG8_SB(1, 0), b3); PG8_STAGEB(PG8_SB(1, 1), b3 + hstepB); PG8_STAGEA(PG8_SA(1, 0), x2[0], kstep);
            PG8_WAIT_V(8); PG8_WAIT_L(0); PG8_BAR; PG8_MMA(1, 0, At, B0); PG8_MMA(1, 1, At, B1); PG8_BAR; PG8_SCHED;
        }
        if (wr == 0) PG8_BAR;
        E(acc, cur, wr, wc, fr, fq);
        if (!has_next) break;
#pragma unroll
        for (int a = 0; a < 2; ++a)
#pragma unroll
            for (int b = 0; b < 2; ++b)
#pragma unroll
                for (int m = 0; m < 4; ++m)
#pragma unroll
                    for (int n = 0; n < 2; ++n) acc[a][b][m][n] = (f32x4){0.f, 0.f, 0.f, 0.f};
        cur = nxt; cB = nB; ++ui;
#pragma unroll
        for (int h = 0; h < 2; ++h)
#pragma unroll
            for (int i = 0; i < 2; ++i) ao[h][i] = an[h][i];
        if (wr == 1) PG8_BAR;
    }
    PG8_WAIT_V(0);
    PG8_BAR;
#undef PG8_SA
#undef PG8_SB
#undef PG8_STAGEA
#undef PG8_STAGEB
#undef PG8_LDA
#undef PG8_LDB
#undef PG8_MMA
#undef PG8_WAIT_V
#undef PG8_WAIT_L
#undef PG8_BAR
#undef PG8_SCHED
}
}

constexpr int NWAVES = 8, NTHR = 512;
struct Frame {
    LAS unsigned char* lds;
    int tid, lane, wave, G, gw, NGW;
    unsigned* ctl;
    unsigned char* ws;
};

DI void transpose_item(const float* Wseg, int ldw, int ncols, int K, bf16_t* WT, int row_off, LAS float* scr, int item, int lane) {
    const int nblk = ncols / 32, kb = item / nblk, nb = item % nblk, k0 = 64 * kb, n0 = 32 * nb;
#pragma unroll 8
    for (int i = 0; i < 32; ++i) { const int kk = 2 * i + (lane >> 5); scr[kk * 33 + (lane & 31)] = Wseg[(size_t)(k0 + kk) * ldw + n0 + (lane & 31)]; }
    LDS_WAIT(); asm volatile("" ::: "memory");
    const int c = lane & 7;
#pragma unroll
    for (int j = 0; j < 4; ++j) { const int n = (lane >> 3) + 8 * j; const LAS float* s = scr + (8 * c) * 33 + n;
        u32x4 o; o.x = pk2(s[0 * 33], s[1 * 33]); o.y = pk2(s[2 * 33], s[3 * 33]); o.z = pk2(s[4 * 33], s[5 * 33]); o.w = pk2(s[6 * 33], s[7 * 33]);
        *(u32x4*)(WT + (size_t)(row_off + n0 + n) * K + k0 + 8 * c) = o; }
    LDS_WAIT(); asm volatile("" ::: "memory");
}

DI void p0_weights(Frame& F, const float* const* in) {
    LAS float* scr = (LAS float*)(F.lds + F.wave * 16384);
    bf16_t* win0 = (bf16_t*)(F.ws + WS_WIN0); bf16_t* wout0 = (bf16_t*)(F.ws + WS_WOUT0); bf16_t* win1 = (bf16_t*)(F.ws + WS_WIN1); bf16_t* wout1 = (bf16_t*)(F.ws + WS_WOUT1);
    const float* ewin = in[3]; const float* ewout = in[9]; const float* owin = in[10]; const float* owout = in[14];
    constexpr int KB = D / 64;
    constexpr int I_A = KB * (4096 / 32), I_B = KB * (4096 / 32), I_C = KB * (2048 / 32), I_D = KB * (2048 / 32);
    constexpr int I_O0 = (4096 / 64) * (D / 32), I_I1 = KB * (ODD_IN / 32), I_O1 = KB * (D / 32);
    constexpr int NIT = I_A + I_B + I_C + I_D + I_O0 + I_I1 + I_O1;
    for (int it = F.gw; it < NIT; it += F.NGW) {
        int r = it;
        if (r < I_A) { transpose_item(ewin + 0, EVEN_IN, 4096, D, win0, 0, scr, r, F.lane); continue; } r -= I_A;
        if (r < I_B) { transpose_item(ewin + 6144, EVEN_IN, 4096, D, win0, C_GQKV, scr, r, F.lane); continue; } r -= I_B;
        if (r < I_C) { transpose_item(ewin + 4096, EVEN_IN, 2048, D, win0, C_RG, scr, r, F.lane); continue; } r -= I_C;
        if (r < I_D) { transpose_item(ewin + 10240, EVEN_IN, 2048, D, win0, C_GZ, scr, r, F.lane); continue; } r -= I_D;
        if (r < I_O0) { transpose_item(ewout, D, D, 4096, wout0, 0, scr, r, F.lane); continue; } r -= I_O0;
        if (r < I_I1) { transpose_item(owin, ODD_IN, ODD_IN, D, win1, 0, scr, r, F.lane); continue; } r -= I_I1;
        transpose_item(owout, D, D, D, wout1, 0, scr, r, F.lane);
    }
    float* sw = (float*)(F.ws + AUX_SW);
    const int gt = (F.gw * 64 + F.lane), NGT = F.NGW * 64;
    for (int i = gt; i < 16 * D; i += NGT) { const int c = i / D, k = i % D; sw[i] = ewin[(size_t)k * EVEN_IN + 12288 + c] * in[1][k]; }
    for (int l = 0; l < 2; ++l) { float* rt = sw + 16 * D + l * 48 * D; const float* rg = in[15] + (size_t)l * D * 4; const float* re = in[16] + (size_t)l * D * 32; const float* gn = in[2] + l * D;
        for (int i = gt; i < 48 * D; i += NGT) { const int c = i / D, k = i % D; rt[i] = c < 4 ? rg[k * 4 + c] * gn[k] : (c < 36 ? re[k * 32 + (c - 4)] * gn[k] : 0.f); } }
    f32x2* cs = (f32x2*)(F.ws + AUX_CS);
    for (int i = gt; i < SEQ * 64; i += NGT) { const int pos = i >> 6, fi = i & 63; double inv = 1.0;
        for (int q = 0; q < fi; ++q) inv *= ROPE_R;
        const double x = (double)pos * inv, k = __builtin_rint(x * 0.15915494309189535), r = (x - k * 6.283185307179586) - k * 2.4492935982947064e-16;
        const float rf = (float)r; cs[i] = (f32x2){cosf(rf), sinf(rf)}; }
}
DI void convert_experts(Frame& F, const float* const* in, int l) {
    LAS float* scr = (LAS float*)(F.lds + F.wave * 16384);
    const float* wg = in[17] + (size_t)l * NEXP * D * FF; const float* wu = in[18] + (size_t)l * NEXP * D * FF; const float* wd = in[19] + (size_t)l * NEXP * FF * D;
    bf16_t* gu = (bf16_t*)(F.ws + WS_BIG + BIG_EGU); bf16_t* dn = (bf16_t*)(F.ws + WS_BIG + BIG_EDN);
    constexpr int I_G = (D / 64) * (128 / 32);
    constexpr int I_GU = NEXP * 6 * 2 * I_G;
    constexpr int I_DE = (FF / 64) * (D / 32);
    constexpr int NIT = I_GU + NEXP * I_DE;
    for (int it = F.gw; it < NIT; it += F.NGW) {
        if (it < I_GU) { const int seg = it / I_G, r = it % I_G, e = seg / 12, s = seg % 12, pn = s >> 1, isup = s & 1;
            const float* src = (isup ? wu : wg) + (size_t)e * D * FF + pn * 128;
            transpose_item(src, FF, 128, D, gu + (size_t)e * 1536 * D, pn * 256 + isup * 128, scr, r, F.lane); }
        else { const int r2 = it - I_GU, e = r2 / I_DE, r = r2 % I_DE;
            transpose_item(wd + (size_t)e * FF * D, D, D, FF, dn + (size_t)e * D * FF, 0, scr, r, F.lane); }
    }
}

template <int NP, bool ADDY, bool WRITEX, bool WRITEH, class Handler>
DI void norm_pass(Frame& F, const float* src, float* dst, const bf16_t* y, const unsigned* asg, const LAS int* tb, const float* gain, const float* Wt, bf16_t* H, Handler hnd) {
    for (int m = F.gw; m < NTOK; m += F.NGW) {
        const f32x4* xr = (const f32x4*)(src + (size_t)m * D) + F.lane;
        f32x4 v[8];
#pragma unroll
        for (int j = 0; j < 8; ++j) v[j] = xr[64 * j];
        if (ADDY) {
            const unsigned a0 = asg[2 * m], a1 = asg[2 * m + 1];
            const size_t r0 = (size_t)tb[a0 >> 16] * 256 + (a0 & 0xffffu), r1 = (size_t)tb[a1 >> 16] * 256 + (a1 & 0xffffu);
            const u32x2* y0 = (const u32x2*)(y + r0 * D) + F.lane; const u32x2* y1 = (const u32x2*)(y + r1 * D) + F.lane;
#pragma unroll
            for (int j = 0; j < 8; ++j) { const u32x2 p = y0[64 * j], q = y1[64 * j];
                v[j].x += bflo(p.x) + bflo(q.x); v[j].y += bfhi(p.x) + bfhi(q.x); v[j].z += bflo(p.y) + bflo(q.y); v[j].w += bfhi(p.y) + bfhi(q.y); }
        }
        if (WRITEX) { f32x4* xo = (f32x4*)(dst + (size_t)m * D) + F.lane;
#pragma unroll
            for (int j = 0; j < 8; ++j) xo[64 * j] = v[j]; }
        if (WRITEH) {
            float s = 0.f;
#pragma unroll
            for (int j = 0; j < 8; ++j) s += (v[j].x * v[j].x + v[j].y * v[j].y) + (v[j].z * v[j].z + v[j].w * v[j].w);
            const float rstd = 1.0f / sqrtf(wave_sum(s) * (1.0f / D) + EPS);
            const f32x4* gr = (const f32x4*)gain + F.lane;
#pragma unroll
            for (int j = 0; j < 8; ++j) v[j] = v[j] * rstd * gr[64 * j];
            u32x2* ho = (u32x2*)(H + (size_t)m * D) + F.lane;
#pragma unroll
            for (int j = 0; j < 8; ++j) { u32x2 w; w.x = pk2(v[j].x, v[j].y); w.y = pk2(v[j].z, v[j].w); ho[64 * j] = w; }
            if constexpr (NP > 0) {
                float res = 0.f;
#pragma unroll 1
                for (int c0 = 0; c0 < NP; c0 += 4) {
                    float a[4];
#pragma unroll
                    for (int cc = 0; cc < 4; ++cc) { const f32x4* wr = (const f32x4*)(Wt + (size_t)(c0 + cc) * D) + F.lane; a[cc] = 0.f;
#pragma unroll
                        for (int j = 0; j < 8; ++j) { const f32x4 w = wr[64 * j]; a[cc] += (v[j].x * w.x + v[j].y * w.y) + (v[j].z * w.z + v[j].w * w.w); } }
#pragma unroll
                    for (int cc = 0; cc < 4; ++cc) { const float t = wave_sum(a[cc]); res = (F.lane == c0 + cc) ? t : res; }
                }
                hnd(m, res);
            }
        }
    }
}


template <int MODE>
DI void proj_pass(Frame& F, const float* x, const float* Wg, float* bg, const float* a_log, const float* dt_bias, unsigned* cnt, int* list, float* gw, unsigned* asg) {
    constexpr int NT = MODE == 0 ? 1 : 3;
    const int lane = F.lane, r = lane & 15, kq = lane >> 4;
    LAS float* lg = (LAS float*)(F.lds + F.wave * 4096);
    for (int tile = F.gw; tile < NTOK / 16; tile += F.NGW) {
        const size_t tok0 = (size_t)tile * 16;
        const f32x4* xp = (const f32x4*)(x + (tok0 + r) * D) + kq;
        f32x4 acc[NT];
#pragma unroll
        for (int nt = 0; nt < NT; ++nt) acc[nt] = (f32x4){0.f, 0.f, 0.f, 0.f};
        float ss = 0.f;
#pragma unroll 4
        for (int i = 0; i < D / 16; ++i) {
            const f32x4 xa = xp[4 * i];
            ss += (xa.x * xa.x + xa.y * xa.y) + (xa.z * xa.z + xa.w * xa.w);
#pragma unroll
            for (int nt = 0; nt < NT; ++nt) { const f32x4 wb = *((const f32x4*)(Wg + (size_t)(16 * nt + r) * D) + 4 * i + kq);
                acc[nt] = __builtin_amdgcn_mfma_f32_16x16x4f32(xa.x, wb.x, acc[nt], 0, 0, 0); acc[nt] = __builtin_amdgcn_mfma_f32_16x16x4f32(xa.y, wb.y, acc[nt], 0, 0, 0);
                acc[nt] = __builtin_amdgcn_mfma_f32_16x16x4f32(xa.z, wb.z, acc[nt], 0, 0, 0); acc[nt] = __builtin_amdgcn_mfma_f32_16x16x4f32(xa.w, wb.w, acc[nt], 0, 0, 0); }
        }
        ss += __shfl_xor(ss, 16); ss += __shfl_xor(ss, 32);
        const float rstd = 1.0f / sqrtf(ss * (1.0f / D) + EPS);
        float rs[4];
#pragma unroll
        for (int q = 0; q < 4; ++q) rs[q] = __shfl(rstd, 4 * kq + q);
        if (MODE == 0) {
#pragma unroll
            for (int q = 0; q < 4; ++q) { const float v = acc[0][q] * rs[q]; float o;
                if (r < 8) o = 1.0f / (1.0f + __expf(-v)); else { const float z = v + dt_bias[r - 8]; const float sp = z > 20.f ? z : log1pf(__expf(z)); o = -__expf(a_log[r - 8]) * sp; }
                bg[(tok0 + 4 * kq + q) * 16 + r] = o; }
        } else {
#pragma unroll
            for (int nt = 0; nt < NT; ++nt)
#pragma unroll
                for (int q = 0; q < 4; ++q) lg[(4 * kq + q) * 48 + 16 * nt + r] = acc[nt][q] * rs[q];
            LDS_WAIT();
            if (lane < 16) {
                const int m = (int)tok0 + lane; const LAS float* p = lg + lane * 48;
                int g = 0; float gm = p[0];
#pragma unroll
                for (int j = 1; j < 4; ++j) { const float v = p[j]; if (v > gm) { gm = v; g = j; } }
                float gs = 0.f;
#pragma unroll
                for (int j = 0; j < 4; ++j) gs += __expf(p[j] - gm);
                const float g_p = 1.0f / gs;
                float q8[8];
#pragma unroll
                for (int i = 0; i < 8; ++i) q8[i] = p[4 + 8 * g + i];
                int i0 = 0; float m0 = q8[0];
#pragma unroll
                for (int i = 1; i < 8; ++i) if (q8[i] > m0) { m0 = q8[i]; i0 = i; }
                int i1 = -1; float m1 = -3.0e38f;
#pragma unroll
                for (int i = 0; i < 8; ++i) if (i != i0 && q8[i] > m1) { m1 = q8[i]; i1 = i; }
                const float e1 = __expf(m1 - m0), w0 = g_p / (1.0f + e1), w1 = g_p * e1 / (1.0f + e1);
                const int ea = g * 8 + i0, eb = g * 8 + i1;
                const unsigned pa = __hip_atomic_fetch_add(cnt + ea, 1u, __ATOMIC_RELAXED, __HIP_MEMORY_SCOPE_AGENT), pb = __hip_atomic_fetch_add(cnt + eb, 1u, __ATOMIC_RELAXED, __HIP_MEMORY_SCOPE_AGENT);
                list[ea * 65536 + pa] = m; list[eb * 65536 + pb] = m; gw[ea * 65536 + pa] = w0; gw[eb * 65536 + pb] = w1;
                asg[2 * m] = ((unsigned)ea << 16) | pa; asg[2 * m + 1] = ((unsigned)eb << 16) | pb;
            }
            LDS_WAIT();
        }
    }
}

DI void p2_prep(Frame& F, const float* conv_w) {
    bf16_t* pj = (bf16_t*)(F.ws + WS_BIG + BIG_PJ);
    const f32x2* cs = (const f32x2*)(F.ws + AUX_CS);
    bf16_t* qn = (bf16_t*)(F.ws + AUX_QN); bf16_t* kn = (bf16_t*)(F.ws + AUX_KN); bf16_t* vc = (bf16_t*)(F.ws + AUX_VC);
    const int lane = F.lane;
    for (int m = F.gw; m < NTOK; m += F.NGW) {
        const int pos = m & (SEQ - 1);
        bf16_t* row = pj + (size_t)m * PJW;
        const f32x2 c = cs[pos * 64 + lane];
#pragma unroll
        for (int hv = 0; hv < 16; ++hv) { bf16_t* p = row + hv * 128; const float x1 = bf2f(p[lane]), x2 = bf2f(p[lane + 64]); const float sc = hv >= 8 ? 0.08838834764831845f : 1.0f;
            p[lane] = (bf16_t)f2bf((x1 * c.x - x2 * c.y) * sc); p[lane + 64] = (bf16_t)f2bf((x2 * c.x + x1 * c.y) * sc); }
#pragma unroll
        for (int j = 0; j < 8; ++j) { const int ch = 512 * j + 8 * lane; float a[8];
#pragma unroll
            for (int e = 0; e < 8; ++e) a[e] = 0.f;
#pragma unroll
            for (int tp = 0; tp < 4; ++tp) { const int dp = pos - 3 + tp; if (dp >= 0) { const u32x4 r = *(const u32x4*)(pj + (size_t)(m - 3 + tp) * PJW + C_GQKV + ch);
                    const f32x4 w0 = *(const f32x4*)(conv_w + tp * 4096 + ch), w1 = *(const f32x4*)(conv_w + tp * 4096 + ch + 4);
                    a[0] += bflo(r.x) * w0.x; a[1] += bfhi(r.x) * w0.y; a[2] += bflo(r.y) * w0.z; a[3] += bfhi(r.y) * w0.w; a[4] += bflo(r.z) * w1.x; a[5] += bfhi(r.z) * w1.y; a[6] += bflo(r.w) * w1.z; a[7] += bfhi(r.w) * w1.w; } }
            float ss = 0.f;
#pragma unroll
            for (int e = 0; e < 8; ++e) { a[e] = siluf(a[e]); ss += a[e] * a[e]; }
            if (j < 4) { ss += __shfl_xor(ss, 1); ss += __shfl_xor(ss, 2); ss += __shfl_xor(ss, 4); ss += __shfl_xor(ss, 8);
                const float sc = (1.0f / sqrtf(ss + EPS)) * (j < 2 ? 0.08838834764831845f : 1.0f);
#pragma unroll
                for (int e = 0; e < 8; ++e) a[e] *= sc; }
            u32x4 o; o.x = pk2(a[0], a[1]); o.y = pk2(a[2], a[3]); o.z = pk2(a[4], a[5]); o.w = pk2(a[6], a[7]);
            bf16_t* dst = j < 2 ? qn + (size_t)m * 1024 + ch : (j < 4 ? kn + (size_t)m * 1024 + (ch - 1024) : vc + (size_t)m * 2048 + (ch - 2048));
            *(u32x4*)dst = o; }
    }
}

constexpr int TB = 16;
template <bool GDN>
DI void p3_recurrence(Frame& F, int u  ) {
    const int b = u >> 2, h = 2 * (u & 3) + (F.tid >> 8), e = F.tid & 255, hh = F.tid >> 8;
    bf16_t* pj = (bf16_t*)(F.ws + WS_BIG + BIG_PJ);
    const bf16_t* qsrc = GDN ? (const bf16_t*)(F.ws + AUX_QN) : pj + C_RQ; const bf16_t* ksrc = GDN ? (const bf16_t*)(F.ws + AUX_KN) : pj + C_RK;
    const int qld = GDN ? 1024 : PJW;
    bf16_t* vsrc = GDN ? (bf16_t*)(F.ws + AUX_VC) : pj + C_RV; const int vld = GDN ? 2048 : PJW;
    const float* bg = (const float*)(F.ws + AUX_BG);
    LAS float* qs = (LAS float*)F.lds;
    LAS float* ks = qs + 2 * TB * 128;
    LAS float* ab = ks + 2 * TB * 128;
    LAS float* vs = ab + 2 * TB * 2;
    float S[128];
#pragma unroll
    for (int d = 0; d < 128; ++d) S[d] = 0.f;
    const float gam = GDN ? 0.f : (1.0f - exp2f(-5.0f - (float)h));
    for (int t0 = 0; t0 < SEQ; t0 += TB) {
        const size_t r0 = (size_t)b * SEQ + t0;
        __syncthreads();
        for (int i = F.tid; i < 2 * TB * 128; i += NTHR) { const int h2 = i / (TB * 128), tt = (i / 128) % TB, d = i % 128; const int hd = 2 * (u & 3) + h2;
            qs[i] = bf2f(qsrc[(r0 + tt) * qld + hd * 128 + d]); ks[i] = bf2f(ksrc[(r0 + tt) * qld + hd * 128 + d]); }
        for (int i = F.tid; i < 2 * TB * 256; i += NTHR) { const int h2 = i / (TB * 256), tt = (i / 256) % TB, ee = i % 256; vs[i] = bf2f(vsrc[(r0 + tt) * vld + (2 * (u & 3) + h2) * 256 + ee]); }
        if (GDN && F.tid < 2 * TB) { const int h2 = F.tid / TB, tt = F.tid % TB, hd = 2 * (u & 3) + h2; ab[F.tid * 2] = __expf(bg[(r0 + tt) * 16 + 8 + hd]); ab[F.tid * 2 + 1] = bg[(r0 + tt) * 16 + hd]; }
        __syncthreads();
#pragma unroll 1
        for (int tt = 0; tt < TB; ++tt) {
            const LAS f32x4* q4 = (const LAS f32x4*)(qs + (hh * TB + tt) * 128); const LAS f32x4* k4 = (const LAS f32x4*)(ks + (hh * TB + tt) * 128);
            const float v = vs[(hh * TB + tt) * 256 + e];
            float o = 0.f;
            if (GDN) {
                const float a = ab[(hh * TB + tt) * 2], beta = ab[(hh * TB + tt) * 2 + 1];
                float ksum = 0.f;
#pragma unroll
                for (int d4 = 0; d4 < 32; ++d4) { if ((d4 & 7) == 0) asm volatile("" ::: "memory"); const f32x4 kk = k4[d4]; ksum += (kk.x * S[4 * d4] + kk.y * S[4 * d4 + 1]) + (kk.z * S[4 * d4 + 2] + kk.w * S[4 * d4 + 3]); }
                const float r = (v - a * ksum) * beta;
#pragma unroll
                for (int d4 = 0; d4 < 32; ++d4) { if ((d4 & 3) == 0) asm volatile("" ::: "memory"); const f32x4 kk = k4[d4], qq = q4[d4];
                    S[4 * d4] = a * S[4 * d4] + r * kk.x; S[4 * d4 + 1] = a * S[4 * d4 + 1] + r * kk.y; S[4 * d4 + 2] = a * S[4 * d4 + 2] + r * kk.z; S[4 * d4 + 3] = a * S[4 * d4 + 3] + r * kk.w;
                    o += (qq.x * S[4 * d4] + qq.y * S[4 * d4 + 1]) + (qq.z * S[4 * d4 + 2] + qq.w * S[4 * d4 + 3]); }
            } else {
#pragma unroll
                for (int d4 = 0; d4 < 32; ++d4) { if ((d4 & 3) == 0) asm volatile("" ::: "memory"); const f32x4 kk = k4[d4], qq = q4[d4];
                    S[4 * d4] = gam * S[4 * d4] + v * kk.x; S[4 * d4 + 1] = gam * S[4 * d4 + 1] + v * kk.y; S[4 * d4 + 2] = gam * S[4 * d4 + 2] + v * kk.z; S[4 * d4 + 3] = gam * S[4 * d4 + 3] + v * kk.w;
                    o += (qq.x * S[4 * d4] + qq.y * S[4 * d4 + 1]) + (qq.z * S[4 * d4 + 2] + qq.w * S[4 * d4 + 3]); }
            }
            vsrc[(r0 + tt) * vld + h * 256 + e] = (bf16_t)f2bf(o);
        }
    }
}


constexpr int NCH = SEQ / 64;
DI constexpr int rowoff4c(int i) { int a = 0; for (int k = 0; k < i; ++k) a += (k + 3) / 4; return a; }
typedef short s16x4 __attribute__((ext_vector_type(4)));
DI s16x4 tr_read(unsigned lds_addr) { s16x4 r; asm volatile("ds_read_b64_tr_b16 %0, %1\n\ts_waitcnt lgkmcnt(0)" : "=&v"(r) : "v"(lds_addr) : "memory"); return r; }
DI bf16x8 cat8(s16x4 a, s16x4 b) { return __builtin_shufflevector(a, b, 0, 1, 2, 3, 4, 5, 6, 7); }
DI f32x4 mfma16(bf16x8 a, bf16x8 b, f32x4 c) { return __builtin_amdgcn_mfma_f32_16x16x32_bf16(a, b, c, 0, 0, 0); }

template <bool GDN>
DI void ga_unit(Frame& F, int unit, unsigned char* stream, float* out_f32_unused) {
    (void)out_f32_unused;
    constexpr int NF = GDN ? 56 : 40, OFF_W = 0, OFF_QG = GDN ? 16 : 0, OFF_ATT = OFF_QG + 16, OFF_KT = OFF_ATT + 8;
    int lane_o = F.lane; asm volatile("" : "+v"(lane_o));
    const int lane = lane_o, fr = lane & 15, g = lane >> 4;
    const int bh = unit / NCH, n = unit % NCH, b = bh >> 3, h = bh & 7;
    const size_t row0 = (size_t)b * SEQ + (size_t)n * 64;
    LAS unsigned char* L = F.lds + F.wave * GA_LDS_WAVE;
    LAS float* LAf = (LAS float*)L; LAS unsigned char* LA = L; LAS unsigned char* LT = L + 9216; LAS float* LG = (LAS float*)(L + 17408); LAS float* LB = LG + 64;
    const bf16_t* pj = (const bf16_t*)(F.ws + WS_BIG + BIG_PJ);
    const bf16_t* qsrc = GDN ? (const bf16_t*)(F.ws + AUX_QN) + h * 128 : pj + C_RQ + h * 128;
    const bf16_t* ksrc = GDN ? (const bf16_t*)(F.ws + AUX_KN) + h * 128 : pj + C_RK + h * 128;
    const size_t qld = GDN ? 1024 : PJW;
    unsigned char* st = stream + (size_t)unit * NF * 1024 + lane * 16;
    float gv, bv = 1.f;
    if (GDN) { const float* bg = (const float*)(F.ws + AUX_BG); gv = bg[(row0 + lane) * 16 + 8 + h]; bv = bg[(row0 + lane) * 16 + h];
#pragma unroll
        for (int o = 1; o < 64; o <<= 1) { const float t = __shfl_up(gv, o); if (lane >= o) gv += t; } }
    else gv = (float)(lane + 1) * log1pf(-exp2f(-5.0f - (float)h));
    const float gl = rdlane(gv, 63);
    LG[lane] = gv; LB[lane] = bv;
    LDS_WAIT();
    float gr[16], gcl[4], br[16];
#pragma unroll
    for (int t = 0; t < 4; ++t) { gcl[t] = LG[16 * t + fr];
#pragma unroll
        for (int r = 0; r < 4; ++r) { gr[t * 4 + r] = LG[16 * t + 4 * g + r]; br[t * 4 + r] = LB[16 * t + 4 * g + r]; } }
    bf16x8 Kf[4][4], Qf[4][4];
#pragma unroll
    for (int t = 0; t < 4; ++t)
#pragma unroll
        for (int s2 = 0; s2 < 4; ++s2) Kf[t][s2] = *(const bf16x8*)(ksrc + (row0 + 16 * t + fr) * qld + 32 * s2 + 8 * g);
    if (GDN) {
#pragma unroll
        for (int it = 0; it < 4; ++it)
#pragma unroll
            for (int jt = 0; jt <= it; ++jt) { f32x4 acc = {0.f, 0.f, 0.f, 0.f};
#pragma unroll
                for (int s2 = 0; s2 < 4; ++s2) acc = mfma16(Kf[it][s2], Kf[jt][s2], acc);
#pragma unroll
                for (int r = 0; r < 4; ++r) { const int i = 16 * it + 4 * g + r, j = 16 * jt + fr; const int q = (i + 3) >> 2; const int ro = 2 * q * (q - 1) + q * (i - 4 * q + 3);
                    if (j < i) LAf[ro * 4 + j] = br[it * 4 + r] * acc[r] * __expf(gr[it * 4 + r] - gcl[jt]); } }
    }
    asm volatile("" ::: "memory");
#pragma unroll
    for (int it = 0; it < 4; ++it) {
        asm volatile("" ::: "memory");
#pragma unroll
        for (int s2 = 0; s2 < 4; ++s2) Qf[it][s2] = *(const bf16x8*)(qsrc + (row0 + 16 * it + fr) * qld + 32 * s2 + 8 * g);
#pragma unroll
        for (int sp = 0; sp < 2; ++sp) { u32x4 w;
#pragma unroll
            for (int hf = 0; hf < 2; ++hf) { const int jt = 2 * sp + hf; float v[4] = {0.f, 0.f, 0.f, 0.f};
                if (jt <= it) { f32x4 acc = {0.f, 0.f, 0.f, 0.f};
#pragma unroll
                    for (int s2 = 0; s2 < 4; ++s2) acc = mfma16(Kf[jt][s2], Qf[it][s2], acc);
#pragma unroll
                    for (int r = 0; r < 4; ++r) { const int j = 16 * jt + 4 * g + r, i = 16 * it + fr; v[r] = (j <= i) ? acc[r] * __expf(gcl[it] - gr[jt * 4 + r]) : 0.f; } }
                if (hf == 0) { w.x = pk2(v[0], v[1]); w.y = pk2(v[2], v[3]); } else { w.z = pk2(v[0], v[1]); w.w = pk2(v[2], v[3]); } }
            *(u32x4*)(st + (OFF_ATT + it * 2 + sp) * 1024) = w; }
    }
    asm volatile("" ::: "memory");
#pragma unroll
    for (int it = 0; it < 4; ++it) { const float sc = __expf(gcl[it]); asm volatile("" ::: "memory");
#pragma unroll
        for (int s2 = 0; s2 < 4; ++s2) { const bf16_t* qp = qsrc + (row0 + 16 * it + fr) * qld + 32 * s2 + 4 * g; const u32x2 lo = *(const u32x2*)qp, hi = *(const u32x2*)(qp + 16);
            u32x4 w; w.x = pk2(bflo(lo.x) * sc, bfhi(lo.x) * sc); w.y = pk2(bflo(lo.y) * sc, bfhi(lo.y) * sc); w.z = pk2(bflo(hi.x) * sc, bfhi(hi.x) * sc); w.w = pk2(bflo(hi.y) * sc, bfhi(hi.y) * sc);
            *(u32x4*)(st + (OFF_QG + it * 4 + s2) * 1024) = w; } }
    asm volatile("" ::: "memory");
    float t[64];
    float sw_ = 1.f, su_ = 1.f;
    if (GDN) {
        LDS_WAIT();
        const LAS f32x4* LA4 = (const LAS f32x4*)LA;
#pragma unroll
        for (int i = 0; i < 64; ++i) { float acc = (lane == i) ? 1.f : 0.f; if ((i & 1) == 0) asm volatile("" ::: "memory");
#pragma unroll
            for (int m4 = 0; m4 < (i + 3) / 4; ++m4) { const f32x4 l = LA4[rowoff4c(i) + m4];
                if (4 * m4 + 0 < i) acc -= l.x * t[4 * m4 + 0]; if (4 * m4 + 1 < i) acc -= l.y * t[4 * m4 + 1]; if (4 * m4 + 2 < i) acc -= l.z * t[4 * m4 + 2]; if (4 * m4 + 3 < i) acc -= l.w * t[4 * m4 + 3]; }
            t[i] = acc; }
        su_ = bv; sw_ = bv * __expf(gv);
        LDS_WAIT();
#pragma unroll
        for (int i = 0; i < 64; ++i) *(LAS bf16_t*)(LT + (i * 64 + lane) * 2) = (bf16_t)f2bf(t[i] * sw_);
    }
    asm volatile("" ::: "memory");
    float ksc[2][2][4];
#pragma unroll
    for (int sp = 0; sp < 2; ++sp)
#pragma unroll
        for (int tp = 0; tp < 2; ++tp)
#pragma unroll
            for (int e = 0; e < 4; ++e) ksc[sp][tp][e] = __expf(gl - LG[32 * sp + 16 * tp + 4 * g + e]);
    const unsigned la_addr = (unsigned)(size_t)LA, q4 = (unsigned)((lane & 15) >> 2), p4 = (unsigned)(lane & 3);
#pragma unroll 1
    for (int p = 0; p < 2; ++p) {
        LDS_WAIT();
#pragma unroll
        for (int k = 0; k < 8; ++k) { const int row = (lane >> 3) + 8 * k, pc = lane & 7; *(LAS u32x4*)(LA + row * 128 + pc * 16) = *(const u32x4*)(ksrc + (row0 + row) * qld + 64 * p + 8 * pc); }
        LDS_WAIT();
        if (GDN) {
#pragma unroll
            for (int it = 0; it < 4; ++it) { bf16x8 Tf[2];
#pragma unroll
                for (int ks = 0; ks < 2; ++ks) Tf[ks] = *(const LAS bf16x8*)(LT + ((16 * it + fr) * 64 + 32 * ks + 8 * g) * 2);
#pragma unroll
                for (int sl = 0; sl < 2; ++sl) { u32x4 w;
#pragma unroll
                    for (int hf = 0; hf < 2; ++hf) { const int dtl = 2 * sl + hf; f32x4 acc = {0.f, 0.f, 0.f, 0.f};
#pragma unroll
                        for (int ks = 0; ks < 2; ++ks) { const s16x4 a0 = tr_read(la_addr + (32 * ks + 8 * g + q4) * 128 + dtl * 32 + p4 * 8), a1 = tr_read(la_addr + (32 * ks + 8 * g + 4 + q4) * 128 + dtl * 32 + p4 * 8);
                            acc = mfma16(cat8(a0, a1), Tf[ks], acc); }
                        if (hf == 0) { w.x = pk2(-acc[0], -acc[1]); w.y = pk2(-acc[2], -acc[3]); } else { w.z = pk2(-acc[0], -acc[1]); w.w = pk2(-acc[2], -acc[3]); } }
                    *(u32x4*)(st + (OFF_W + it * 4 + 2 * p + sl) * 1024) = w; } }
        }
#pragma unroll
        for (int dtl = 0; dtl < 4; ++dtl)
#pragma unroll
            for (int sp = 0; sp < 2; ++sp) { const s16x4 a0 = tr_read(la_addr + (32 * sp + 4 * g + q4) * 128 + dtl * 32 + p4 * 8), a1 = tr_read(la_addr + (32 * sp + 16 + 4 * g + q4) * 128 + dtl * 32 + p4 * 8);
                u32x4 w; w.x = pk2(bf2f((bf16_t)a0[0]) * ksc[sp][0][0], bf2f((bf16_t)a0[1]) * ksc[sp][0][1]); w.y = pk2(bf2f((bf16_t)a0[2]) * ksc[sp][0][2], bf2f((bf16_t)a0[3]) * ksc[sp][0][3]);
                w.z = pk2(bf2f((bf16_t)a1[0]) * ksc[sp][1][0], bf2f((bf16_t)a1[1]) * ksc[sp][1][1]); w.w = pk2(bf2f((bf16_t)a1[2]) * ksc[sp][1][2], bf2f((bf16_t)a1[3]) * ksc[sp][1][3]);
                *(u32x4*)(st + (OFF_KT + (4 * p + dtl) * 2 + sp) * 1024) = w; }
    }
    if (GDN) {
        LDS_WAIT();
#pragma unroll
        for (int i = 0; i < 64; ++i) *(LAS bf16_t*)(LT + (i * 64 + lane) * 2) = (bf16_t)f2bf(t[i] * su_);
        const bf16_t* vsrc = (const bf16_t*)(F.ws + AUX_VC) + h * 256;
        unsigned char* ub = F.ws + WS_H + (size_t)unit * 32768 + lane * 32;
#pragma unroll 1
        for (int p = 0; p < 4; ++p) {
            LDS_WAIT();
#pragma unroll
            for (int k = 0; k < 8; ++k) { const int row = (lane >> 3) + 8 * k, pc = lane & 7; *(LAS u32x4*)(LA + row * 128 + pc * 16) = *(const u32x4*)(vsrc + (row0 + row) * 2048 + 64 * p + 8 * pc); }
            LDS_WAIT();
            bf16x8 Tf[4][2];
#pragma unroll
            for (int it = 0; it < 4; ++it)
#pragma unroll
                for (int ks = 0; ks < 2; ++ks) Tf[it][ks] = *(const LAS bf16x8*)(LT + ((16 * it + fr) * 64 + 32 * ks + 8 * g) * 2);
#pragma unroll
            for (int etl = 0; etl < 4; ++etl) { bf16x8 Vf[2];
#pragma unroll
                for (int ks = 0; ks < 2; ++ks) { const s16x4 a0 = tr_read(la_addr + (32 * ks + 8 * g + q4) * 128 + etl * 32 + p4 * 8), a1 = tr_read(la_addr + (32 * ks + 8 * g + 4 + q4) * 128 + etl * 32 + p4 * 8); Vf[ks] = cat8(a0, a1); }
                u32x4 w0, w1;
#pragma unroll
                for (int it = 0; it < 4; ++it) { f32x4 acc = {0.f, 0.f, 0.f, 0.f};
#pragma unroll
                    for (int ks = 0; ks < 2; ++ks) acc = mfma16(Tf[it][ks], Vf[ks], acc);
                    const unsigned a = pk2(acc[0], acc[1]), c = pk2(acc[2], acc[3]);
                    if (it == 0) { w0.x = a; w0.y = c; } else if (it == 1) { w0.z = a; w0.w = c; } else if (it == 2) { w1.x = a; w1.y = c; } else { w1.z = a; w1.w = c; } }
                *(u32x4*)(ub + (4 * p + etl) * 2048) = w0; *(u32x4*)(ub + (4 * p + etl) * 2048 + 16) = w1; }
        }
        if (lane == 0) ((float*)(F.ws + AUX_DEC))[unit] = __expf(gl);
    }
    LDS_WAIT();
}

template <bool GDN>
DI void scan_wave(Frame& F, int bh, int sl, const unsigned char* stream) {
    constexpr int NF = GDN ? 56 : 40;
    const int lane = F.lane, fr = lane & 15, g = lane >> 4, b = bh >> 3, h = bh & 7;
    const unsigned char* sp0 = stream + (size_t)bh * NCH * NF * 1024;
    const unsigned voff = (unsigned)lane * 16u;
    const size_t orow = (GDN ? (size_t)2048 : (size_t)PJW) * 2;
    const unsigned char* obu = (GDN ? F.ws + AUX_VC : F.ws + WS_BIG + BIG_PJ + (size_t)C_RV * 2) + (size_t)b * SEQ * orow + (size_t)(h * 256 + 16 * sl) * 2;
    const unsigned ooff = (unsigned)((size_t)(4 * g) * orow) + (unsigned)fr * 2u;
    const float* decp = (const float*)(F.ws + AUX_DEC) + bh * NCH;
    float decr = 1.f; { const float gm = 1.0f - exp2f(-5.0f - (float)h); float d2 = gm * gm; d2 *= d2; d2 *= d2; d2 *= d2; d2 *= d2; d2 *= d2; decr = d2; }
    const unsigned char* ubp = F.ws + WS_H + (size_t)bh * NCH * 32768 + sl * 2048; const unsigned uoff = (unsigned)lane * 32u;
    const unsigned zoff = 0u; (void)decp; (void)decr; (void)ubp; (void)uoff; (void)zoff;
    f32x4 S0 = {0.f, 0.f, 0.f, 0.f}, S1 = S0, S2 = S0, S3 = S0, S4 = S0, S5 = S0, S6 = S0, S7 = S0;
    bf16x8 Sp0 = (bf16x8){0, 0, 0, 0, 0, 0, 0, 0}, Sp1 = Sp0, Sp2 = Sp0, Sp3 = Sp0;
    if constexpr (GDN) {
    bf16x8 r0 = (bf16x8){0, 0, 0, 0, 0, 0, 0, 0};
    bf16x8 r1 = (bf16x8){0, 0, 0, 0, 0, 0, 0, 0};
    bf16x8 r2 = (bf16x8){0, 0, 0, 0, 0, 0, 0, 0};
    bf16x8 r3 = (bf16x8){0, 0, 0, 0, 0, 0, 0, 0};
    bf16x8 r4 = (bf16x8){0, 0, 0, 0, 0, 0, 0, 0};
    bf16x8 r5 = (bf16x8){0, 0, 0, 0, 0, 0, 0, 0};
    bf16x8 r6 = (bf16x8){0, 0, 0, 0, 0, 0, 0, 0};
    bf16x8 r7 = (bf16x8){0, 0, 0, 0, 0, 0, 0, 0};
    bf16x8 r8 = (bf16x8){0, 0, 0, 0, 0, 0, 0, 0};
    bf16x8 r9 = (bf16x8){0, 0, 0, 0, 0, 0, 0, 0};
    bf16x8 r10 = (bf16x8){0, 0, 0, 0, 0, 0, 0, 0};
    bf16x8 r11 = (bf16x8){0, 0, 0, 0, 0, 0, 0, 0};
    bf16x8 r12 = (bf16x8){0, 0, 0, 0, 0, 0, 0, 0};
    bf16x8 r13 = (bf16x8){0, 0, 0, 0, 0, 0, 0, 0};
    bf16x8 r14 = (bf16x8){0, 0, 0, 0, 0, 0, 0, 0};
    bf16x8 r15 = (bf16x8){0, 0, 0, 0, 0, 0, 0, 0};
    bf16x8 r16 = (bf16x8){0, 0, 0, 0, 0, 0, 0, 0};
    bf16x8 r17 = (bf16x8){0, 0, 0, 0, 0, 0, 0, 0};
    bf16x8 r18 = (bf16x8){0, 0, 0, 0, 0, 0, 0, 0};
    bf16x8 r19 = (bf16x8){0, 0, 0, 0, 0, 0, 0, 0};
    bf16x8 r20 = (bf16x8){0, 0, 0, 0, 0, 0, 0, 0};
    bf16x8 r21 = (bf16x8){0, 0, 0, 0, 0, 0, 0, 0};
    bf16x8 r22 = (bf16x8){0, 0, 0, 0, 0, 0, 0, 0};
    bf16x8 r23 = (bf16x8){0, 0, 0, 0, 0, 0, 0, 0};
    bf16x8 r24 = (bf16x8){0, 0, 0, 0, 0, 0, 0, 0};
    bf16x8 r25 = (bf16x8){0, 0, 0, 0, 0, 0, 0, 0};
    bf16x8 r26 = (bf16x8){0, 0, 0, 0, 0, 0, 0, 0};
    bf16x8 r27 = (bf16x8){0, 0, 0, 0, 0, 0, 0, 0};
    u32x4 un0 = {0u, 0u, 0u, 0u}, un1 = {0u, 0u, 0u, 0u};
    asm volatile("global_load_dwordx4 %0, %1, %2" : "+v"(un0) : "v"(uoff), "s"(ubp) : "memory");
    asm volatile("global_load_dwordx4 %0, %1, %2 offset:16" : "+v"(un1) : "v"(uoff), "s"(ubp) : "memory");
    float decv = 0.f; asm volatile("global_load_dword %0, %1, %2" : "+v"(decv) : "v"(zoff), "s"(decp) : "memory");
    const unsigned char* spc = sp0;
    asm volatile("global_load_dwordx4 %0, %1, %2" : "+v"(r0) : "v"(voff), "s"(spc) : "memory"); spc += 1024;
    asm volatile("global_load_dwordx4 %0, %1, %2" : "+v"(r1) : "v"(voff), "s"(spc) : "memory"); spc += 1024;
    asm volatile("global_load_dwordx4 %0, %1, %2" : "+v"(r2) : "v"(voff), "s"(spc) : "memory"); spc += 1024;
    asm volatile("global_load_dwordx4 %0, %1, %2" : "+v"(r3) : "v"(voff), "s"(spc) : "memory"); spc += 1024;
    asm volatile("global_load_dwordx4 %0, %1, %2" : "+v"(r4) : "v"(voff), "s"(spc) : "memory"); spc += 1024;
    asm volatile("global_load_dwordx4 %0, %1, %2" : "+v"(r5) : "v"(voff), "s"(spc) : "memory"); spc += 1024;
    asm volatile("global_load_dwordx4 %0, %1, %2" : "+v"(r6) : "v"(voff), "s"(spc) : "memory"); spc += 1024;
    asm volatile("global_load_dwordx4 %0, %1, %2" : "+v"(r7) : "v"(voff), "s"(spc) : "memory"); spc += 1024;
    asm volatile("global_load_dwordx4 %0, %1, %2" : "+v"(r8) : "v"(voff), "s"(spc) : "memory"); spc += 1024;
    asm volatile("global_load_dwordx4 %0, %1, %2" : "+v"(r9) : "v"(voff), "s"(spc) : "memory"); spc += 1024;
    asm volatile("global_load_dwordx4 %0, %1, %2" : "+v"(r10) : "v"(voff), "s"(spc) : "memory"); spc += 1024;
    asm volatile("global_load_dwordx4 %0, %1, %2" : "+v"(r11) : "v"(voff), "s"(spc) : "memory"); spc += 1024;
    asm volatile("global_load_dwordx4 %0, %1, %2" : "+v"(r12) : "v"(voff), "s"(spc) : "memory"); spc += 1024;
    asm volatile("global_load_dwordx4 %0, %1, %2" : "+v"(r13) : "v"(voff), "s"(spc) : "memory"); spc += 1024;
    asm volatile("global_load_dwordx4 %0, %1, %2" : "+v"(r14) : "v"(voff), "s"(spc) : "memory"); spc += 1024;
    asm volatile("global_load_dwordx4 %0, %1, %2" : "+v"(r15) : "v"(voff), "s"(spc) : "memory"); spc += 1024;
    asm volatile("global_load_dwordx4 %0, %1, %2" : "+v"(r16) : "v"(voff), "s"(spc) : "memory"); spc += 1024;
    asm volatile("global_load_dwordx4 %0, %1, %2" : "+v"(r17) : "v"(voff), "s"(spc) : "memory"); spc += 1024;
    asm volatile("global_load_dwordx4 %0, %1, %2" : "+v"(r18) : "v"(voff), "s"(spc) : "memory"); spc += 1024;
    asm volatile("global_load_dwordx4 %0, %1, %2" : "+v"(r19) : "v"(voff), "s"(spc) : "memory"); spc += 1024;
    asm volatile("global_load_dwordx4 %0, %1, %2" : "+v"(r20) : "v"(voff), "s"(spc) : "memory"); spc += 1024;
    asm volatile("global_load_dwordx4 %0, %1, %2" : "+v"(r21) : "v"(voff), "s"(spc) : "memory"); spc += 1024;
    asm volatile("global_load_dwordx4 %0, %1, %2" : "+v"(r22) : "v"(voff), "s"(spc) : "memory"); spc += 1024;
    asm volatile("global_load_dwordx4 %0, %1, %2" : "+v"(r23) : "v"(voff), "s"(spc) : "memory"); spc += 1024;
    asm volatile("global_load_dwordx4 %0, %1, %2" : "+v"(r24) : "v"(voff), "s"(spc) : "memory"); spc += 1024;
    asm volatile("global_load_dwordx4 %0, %1, %2" : "+v"(r25) : "v"(voff), "s"(spc) : "memory"); spc += 1024;
    asm volatile("global_load_dwordx4 %0, %1, %2" : "+v"(r26) : "v"(voff), "s"(spc) : "memory"); spc += 1024;
    asm volatile("global_load_dwordx4 %0, %1, %2" : "+v"(r27) : "v"(voff), "s"(spc) : "memory"); spc += 1024;
    { unsigned z = 0u;
      asm volatile("global_store_short %0, %1, %2" :: "v"(ooff), "v"(z), "s"(obu + (size_t)(0) * orow) : "memory");
      asm volatile("global_store_short %0, %1, %2" :: "v"(ooff), "v"(z), "s"(obu + (size_t)(1) * orow) : "memory");
      asm volatile("global_store_short %0, %1, %2" :: "v"(ooff), "v"(z), "s"(obu + (size_t)(2) * orow) : "memory");
      asm volatile("global_store_short %0, %1, %2" :: "v"(ooff), "v"(z), "s"(obu + (size_t)(3) * orow) : "memory");
      asm volatile("global_store_short %0, %1, %2" :: "v"(ooff), "v"(z), "s"(obu + (size_t)(16) * orow) : "memory");
      asm volatile("global_store_short %0, %1, %2" :: "v"(ooff), "v"(z), "s"(obu + (size_t)(17) * orow) : "memory");
      asm volatile("global_store_short %0, %1, %2" :: "v"(ooff), "v"(z), "s"(obu + (size_t)(18) * orow) : "memory");
      asm volatile("global_store_short %0, %1, %2" :: "v"(ooff), "v"(z), "s"(obu + (size_t)(19) * orow) : "memory");
      asm volatile("global_store_short %0, %1, %2" :: "v"(ooff), "v"(z), "s"(obu + (size_t)(32) * orow) : "memory");
      asm volatile("global_store_short %0, %1, %2" :: "v"(ooff), "v"(z), "s"(obu + (size_t)(33) * orow) : "memory");
      asm volatile("global_store_short %0, %1, %2" :: "v"(ooff), "v"(z), "s"(obu + (size_t)(34) * orow) : "memory");
      asm volatile("global_store_short %0, %1, %2" :: "v"(ooff), "v"(z), "s"(obu + (size_t)(35) * orow) : "memory");
      asm volatile("global_store_short %0, %1, %2" :: "v"(ooff), "v"(z), "s"(obu + (size_t)(48) * orow) : "memory");
      asm volatile("global_store_short %0, %1, %2" :: "v"(ooff), "v"(z), "s"(obu + (size_t)(49) * orow) : "memory");
      asm volatile("global_store_short %0, %1, %2" :: "v"(ooff), "v"(z), "s"(obu + (size_t)(50) * orow) : "memory");
      asm volatile("global_store_short %0, %1, %2" :: "v"(ooff), "v"(z), "s"(obu + (size_t)(51) * orow) : "memory");
    }
#pragma unroll 1
    for (int n = 0; n < NCH; ++n) {
        f32x4 a1_0, a1_1, a1_2, a1_3;
        asm volatile("s_waitcnt vmcnt(44)" : "+v"(un0), "+v"(un1), "+v"(decv));
        a1_0 = (f32x4){bflo(un0.x), bfhi(un0.x), bflo(un0.y), bfhi(un0.y)}; a1_1 = (f32x4){bflo(un0.z), bfhi(un0.z), bflo(un0.w), bfhi(un0.w)};
        a1_2 = (f32x4){bflo(un1.x), bfhi(un1.x), bflo(un1.y), bfhi(un1.y)}; a1_3 = (f32x4){bflo(un1.z), bfhi(un1.z), bflo(un1.w), bfhi(un1.w)};
        const float dec = decv;
        { const unsigned char* ubn = ubp + (size_t)(n + 1 < NCH ? n + 1 : n) * 32768;
          asm volatile("global_load_dwordx4 %0, %1, %2" : "+v"(un0) : "v"(uoff), "s"(ubn) : "memory");
          asm volatile("global_load_dwordx4 %0, %1, %2 offset:16" : "+v"(un1) : "v"(uoff), "s"(ubn) : "memory");
          asm volatile("global_load_dword %0, %1, %2" : "+v"(decv) : "v"(zoff), "s"(decp + (n + 1 < NCH ? n + 1 : n)) : "memory"); }
        __builtin_amdgcn_sched_barrier(0);
        asm volatile("s_waitcnt vmcnt(46)" : "+v"(r0));
        a1_0 = mfma16(r0, Sp0, a1_0);
        asm volatile("global_load_dwordx4 %0, %1, %2" : "+v"(r0) : "v"(voff), "s"(spc) : "memory"); spc += 1024;
        __builtin_amdgcn_sched_barrier(0);
        asm volatile("s_waitcnt vmcnt(46)" : "+v"(r1));
        a1_0 = mfma16(r1, Sp1, a1_0);
        asm volatile("global_load_dwordx4 %0, %1, %2" : "+v"(r1) : "v"(voff), "s"(spc) : "memory"); spc += 1024;
        __builtin_amdgcn_sched_barrier(0);
        asm volatile("s_waitcnt vmcnt(46)" : "+v"(r2));
        a1_0 = mfma16(r2, Sp2, a1_0);
        asm volatile("global_load_dwordx4 %0, %1, %2" : "+v"(r2) : "v"(voff), "s"(spc) : "memory"); spc += 1024;
        __builtin_amdgcn_sched_barrier(0);
        asm volatile("s_waitcnt vmcnt(46)" : "+v"(r3));
        a1_0 = mfma16(r3, Sp3, a1_0);
        asm volatile("global_load_dwordx4 %0, %1, %2" : "+v"(r3) : "v"(voff), "s"(spc) : "memory"); spc += 1024;
        __builtin_amdgcn_sched_barrier(0);
        asm volatile("s_waitcnt vmcnt(46)" : "+v"(r4));
        a1_1 = mfma16(r4, Sp0, a1_1);
        asm volatile("global_load_dwordx4 %0, %1, %2" : "+v"(r4) : "v"(voff), "s"(spc) : "memory"); spc += 1024;
        __builtin_amdgcn_sched_barrier(0);
        asm volatile("s_waitcnt vmcnt(46)" : "+v"(r5));
        a1_1 = mfma16(r5, Sp1, a1_1);
        asm volatile("global_load_dwordx4 %0, %1, %2" : "+v"(r5) : "v"(voff), "s"(spc) : "memory"); spc += 1024;
        __builtin_amdgcn_sched_barrier(0);
        asm volatile("s_waitcnt vmcnt(46)" : "+v"(r6));
        a1_1 = mfma16(r6, Sp2, a1_1);
        asm volatile("global_load_dwordx4 %0, %1, %2" : "+v"(r6) : "v"(voff), "s"(spc) : "memory"); spc += 1024;
        __builtin_amdgcn_sched_barrier(0);
        asm volatile("s_waitcnt vmcnt(46)" : "+v"(r7));
        a1_1 = mfma16(r7, Sp3, a1_1);
        asm volatile("global_load_dwordx4 %0, %1, %2" : "+v"(r7) : "v"(voff), "s"(spc) : "memory"); spc += 1024;
        __builtin_amdgcn_sched_barrier(0);
        asm volatile("s_waitcnt vmcnt(46)" : "+v"(r8));
        a1_2 = mfma16(r8, Sp0, a1_2);
        asm volatile("global_load_dwordx4 %0, %1, %2" : "+v"(r8) : "v"(voff), "s"(spc) : "memory"); spc += 1024;
        __builtin_amdgcn_sched_barrier(0);
        asm volatile("s_waitcnt vmcnt(46)" : "+v"(r9));
        a1_2 = mfma16(r9, Sp1, a1_2);
        asm volatile("global_load_dwordx4 %0, %1, %2" : "+v"(r9) : "v"(voff), "s"(spc) : "memory"); spc += 1024;
        __builtin_amdgcn_sched_barrier(0);
        asm volatile("s_waitcnt vmcnt(46)" : "+v"(r10));
        a1_2 = mfma16(r10, Sp2, a1_2);
        asm volatile("global_load_dwordx4 %0, %1, %2" : "+v"(r10) : "v"(voff), "s"(spc) : "memory"); spc += 1024;
        __builtin_amdgcn_sched_barrier(0);
        asm volatile("s_waitcnt vmcnt(46)" : "+v"(r11));
        a1_2 = mfma16(r11, Sp3, a1_2);
        asm volatile("global_load_dwordx4 %0, %1, %2" : "+v"(r11) : "v"(voff), "s"(spc) : "memory"); spc += 1024;
        __builtin_amdgcn_sched_barrier(0);
        asm volatile("s_waitcnt vmcnt(30)" : "+v"(r12));
        a1_3 = mfma16(r12, Sp0, a1_3);
        asm volatile("global_load_dwordx4 %0, %1, %2" : "+v"(r12) : "v"(voff), "s"(spc) : "memory"); spc += 1024;
        __builtin_amdgcn_sched_barrier(0);
        asm volatile("s_waitcnt vmcnt(30)" : "+v"(r13));
        a1_3 = mfma16(r13, Sp1, a1_3);
        asm volatile("global_load_dwordx4 %0, %1, %2" : "+v"(r13) : "v"(voff), "s"(spc) : "memory"); spc += 1024;
        __builtin_amdgcn_sched_barrier(0);
        asm volatile("s_waitcnt vmcnt(30)" : "+v"(r14));
        a1_3 = mfma16(r14, Sp2, a1_3);
        asm volatile("global_load_dwordx4 %0, %1, %2" : "+v"(r14) : "v"(voff), "s"(spc) : "memory"); spc += 1024;
        __builtin_amdgcn_sched_barrier(0);
        asm volatile("s_waitcnt vmcnt(30)" : "+v"(r15));
        a1_3 = mfma16(r15, Sp3, a1_3);
        asm volatile("global_load_dwordx4 %0, %1, %2" : "+v"(r15) : "v"(voff), "s"(spc) : "memory"); spc += 1024;
        __builtin_amdgcn_sched_barrier(0);
        bf16x8 vp0, vp1;
        { u32x4 w; w.x = cvt_pk_bf16(a1_0[0], a1_0[1]); w.y = cvt_pk_bf16(a1_0[2], a1_0[3]); w.z = cvt_pk_bf16(a1_1[0], a1_1[1]); w.w = cvt_pk_bf16(a1_1[2], a1_1[3]); vp0 = __builtin_bit_cast(bf16x8, w); }
        { u32x4 w; w.x = cvt_pk_bf16(a1_2[0], a1_2[1]); w.y = cvt_pk_bf16(a1_2[2], a1_2[3]); w.z = cvt_pk_bf16(a1_3[0], a1_3[1]); w.w = cvt_pk_bf16(a1_3[2], a1_3[3]); vp1 = __builtin_bit_cast(bf16x8, w); }
        f32x4 o0 = {0.f, 0.f, 0.f, 0.f}, o1 = o0, o2 = o0, o3 = o0;
        asm volatile("s_waitcnt vmcnt(30)" : "+v"(r16));
        o0 = mfma16(r16, Sp0, o0);
        asm volatile("global_load_dwordx4 %0, %1, %2" : "+v"(r16) : "v"(voff), "s"(spc) : "memory"); spc += 1024;
        __builtin_amdgcn_sched_barrier(0);
        asm volatile("s_waitcnt vmcnt(30)" : "+v"(r17));
        o0 = mfma16(r17, Sp1, o0);
        asm volatile("global_load_dwordx4 %0, %1, %2" : "+v"(r17) : "v"(voff), "s"(spc) : "memory"); spc += 1024;
        __builtin_amdgcn_sched_barrier(0);
        asm volatile("s_waitcnt vmcnt(30)" : "+v"(r18));
        o0 = mfma16(r18, Sp2, o0);
        asm volatile("global_load_dwordx4 %0, %1, %2" : "+v"(r18) : "v"(voff), "s"(spc) : "memory"); spc += 1024;
        __builtin_amdgcn_sched_barrier(0);
        asm volatile("s_waitcnt vmcnt(30)" : "+v"(r19));
        o0 = mfma16(r19, Sp3, o0);
        asm volatile("global_load_dwordx4 %0, %1, %2" : "+v"(r19) : "v"(voff), "s"(spc) : "memory"); spc += 1024;
        __builtin_amdgcn_sched_barrier(0);
        asm volatile("s_waitcnt vmcnt(30)" : "+v"(r20));
        o1 = mfma16(r20, Sp0, o1);
        asm volatile("global_load_dwordx4 %0, %1, %2" : "+v"(r20) : "v"(voff), "s"(spc) : "memory"); spc += 1024;
        __builtin_amdgcn_sched_barrier(0);
        asm volatile("s_waitcnt vmcnt(30)" : "+v"(r21));
        o1 = mfma16(r21, Sp1, o1);
        asm volatile("global_load_dwordx4 %0, %1, %2" : "+v"(r21) : "v"(voff), "s"(spc) : "memory"); spc += 1024;
        __builtin_amdgcn_sched_barrier(0);
        asm volatile("s_waitcnt vmcnt(30)" : "+v"(r22));
        o1 = mfma16(r22, Sp2, o1);
        asm volatile("global_load_dwordx4 %0, %1, %2" : "+v"(r22) : "v"(voff), "s"(spc) : "memory"); spc += 1024;
        __builtin_amdgcn_sched_barrier(0);
        asm volatile("s_waitcnt vmcnt(30)" : "+v"(r23));
        o1 = mfma16(r23, Sp3, o1);
        asm volatile("global_load_dwordx4 %0, %1, %2" : "+v"(r23) : "v"(voff), "s"(spc) : "memory"); spc += 1024;
        __builtin_amdgcn_sched_barrier(0);
        asm volatile("s_waitcnt vmcnt(30)" : "+v"(r24));
        o2 = mfma16(r24, Sp0, o2);
        asm volatile("global_load_dwordx4 %0, %1, %2" : "+v"(r24) : "v"(voff), "s"(spc) : "memory"); spc += 1024;
        __builtin_amdgcn_sched_barrier(0);
        asm volatile("s_waitcnt vmcnt(30)" : "+v"(r25));
        o2 = mfma16(r25, Sp1, o2);
        asm volatile("global_load_dwordx4 %0, %1, %2" : "+v"(r25) : "v"(voff), "s"(spc) : "memory"); spc += 1024;
        __builtin_amdgcn_sched_barrier(0);
        asm volatile("s_waitcnt vmcnt(30)" : "+v"(r26));
        o2 = mfma16(r26, Sp2, o2);
        asm volatile("global_load_dwordx4 %0, %1, %2" : "+v"(r26) : "v"(voff), "s"(spc) : "memory"); spc += 1024;
        __builtin_amdgcn_sched_barrier(0);
        asm volatile("s_waitcnt vmcnt(30)" : "+v"(r27));
        o2 = mfma16(r27, Sp3, o2);
        asm volatile("global_load_dwordx4 %0, %1, %2" : "+v"(r27) : "v"(voff), "s"(spc) : "memory"); spc += 1024;
        __builtin_amdgcn_sched_barrier(0);
        asm volatile("s_waitcnt vmcnt(27)" : "+v"(r0));
        o3 = mfma16(r0, Sp0, o3);
        asm volatile("global_load_dwordx4 %0, %1, %2" : "+v"(r0) : "v"(voff), "s"(spc) : "memory"); spc += 1024;
        __builtin_amdgcn_sched_barrier(0);
        asm volatile("s_waitcnt vmcnt(27)" : "+v"(r1));
        o3 = mfma16(r1, Sp1, o3);
        asm volatile("global_load_dwordx4 %0, %1, %2" : "+v"(r1) : "v"(voff), "s"(spc) : "memory"); spc += 1024;
        __builtin_amdgcn_sched_barrier(0);
        asm volatile("s_waitcnt vmcnt(27)" : "+v"(r2));
        o3 = mfma16(r2, Sp2, o3);
        asm volatile("global_load_dwordx4 %0, %1, %2" : "+v"(r2) : "v"(voff), "s"(spc) : "memory"); spc += 1024;
        __builtin_amdgcn_sched_barrier(0);
        asm volatile("s_waitcnt vmcnt(27)" : "+v"(r3));
        o3 = mfma16(r3, Sp3, o3);
        asm volatile("global_load_dwordx4 %0, %1, %2" : "+v"(r3) : "v"(voff), "s"(spc) : "memory"); spc += 1024;
        __builtin_amdgcn_sched_barrier(0);
        asm volatile("s_waitcnt vmcnt(27)" : "+v"(r4));
        o0 = mfma16(r4, vp0, o0);
        asm volatile("global_load_dwordx4 %0, %1, %2" : "+v"(r4) : "v"(voff), "s"(spc) : "memory"); spc += 1024;
        __builtin_amdgcn_sched_barrier(0);
        asm volatile("s_waitcnt vmcnt(27)" : "+v"(r5));
        o0 = mfma16(r5, vp1, o0);
        asm volatile("global_load_dwordx4 %0, %1, %2" : "+v"(r5) : "v"(voff), "s"(spc) : "memory"); spc += 1024;
        __builtin_amdgcn_sched_barrier(0);
        asm volatile("s_waitcnt vmcnt(27)" : "+v"(r6));
        o1 = mfma16(r6, vp0, o1);
        asm volatile("global_load_dwordx4 %0, %1, %2" : "+v"(r6) : "v"(voff), "s"(spc) : "memory"); spc += 1024;
        __builtin_amdgcn_sched_barrier(0);
        asm volatile("s_waitcnt vmcnt(27)" : "+v"(r7));
        o1 = mfma16(r7, vp1, o1);
        asm volatile("global_load_dwordx4 %0, %1, %2" : "+v"(r7) : "v"(voff), "s"(spc) : "memory"); spc += 1024;
        __builtin_amdgcn_sched_barrier(0);
        asm volatile("s_waitcnt vmcnt(27)" : "+v"(r8));
        o2 = mfma16(r8, vp0, o2);
        asm volatile("global_load_dwordx4 %0, %1, %2" : "+v"(r8) : "v"(voff), "s"(spc) : "memory"); spc += 1024;
        __builtin_amdgcn_sched_barrier(0);
        asm volatile("s_waitcnt vmcnt(27)" : "+v"(r9));
        o2 = mfma16(r9, vp1, o2);
        asm volatile("global_load_dwordx4 %0, %1, %2" : "+v"(r9) : "v"(voff), "s"(spc) : "memory"); spc += 1024;
        __builtin_amdgcn_sched_barrier(0);
        asm volatile("s_waitcnt vmcnt(27)" : "+v"(r10));
        o3 = mfma16(r10, vp0, o3);
        asm volatile("global_load_dwordx4 %0, %1, %2" : "+v"(r10) : "v"(voff), "s"(spc) : "memory"); spc += 1024;
        __builtin_amdgcn_sched_barrier(0);
        asm volatile("s_waitcnt vmcnt(27)" : "+v"(r11));
        o3 = mfma16(r11, vp1, o3);
        asm volatile("global_load_dwordx4 %0, %1, %2" : "+v"(r11) : "v"(voff), "s"(spc) : "memory"); spc += 1024;
        __builtin_amdgcn_sched_barrier(0);
        { const unsigned char* obn = obu + (size_t)n * 64 * orow;
          { const unsigned v = f2bf(o0[0]); asm volatile("global_store_short %0, %1, %2" :: "v"(ooff), "v"(v), "s"(obn + (size_t)(0) * orow) : "memory"); }
          { const unsigned v = f2bf(o0[1]); asm volatile("global_store_short %0, %1, %2" :: "v"(ooff), "v"(v), "s"(obn + (size_t)(1) * orow) : "memory"); }
          { const unsigned v = f2bf(o0[2]); asm volatile("global_store_short %0, %1, %2" :: "v"(ooff), "v"(v), "s"(obn + (size_t)(2) * orow) : "memory"); }
          { const unsigned v = f2bf(o0[3]); asm volatile("global_store_short %0, %1, %2" :: "v"(ooff), "v"(v), "s"(obn + (size_t)(3) * orow) : "memory"); }
          { const unsigned v = f2bf(o1[0]); asm volatile("global_store_short %0, %1, %2" :: "v"(ooff), "v"(v), "s"(obn + (size_t)(16) * orow) : "memory"); }
          { const unsigned v = f2bf(o1[1]); asm volatile("global_store_short %0, %1, %2" :: "v"(ooff), "v"(v), "s"(obn + (size_t)(17) * orow) : "memory"); }
          { const unsigned v = f2bf(o1[2]); asm volatile("global_store_short %0, %1, %2" :: "v"(ooff), "v"(v), "s"(obn + (size_t)(18) * orow) : "memory"); }
          { const unsigned v = f2bf(o1[3]); asm volatile("global_store_short %0, %1, %2" :: "v"(ooff), "v"(v), "s"(obn + (size_t)(19) * orow) : "memory"); }
          { const unsigned v = f2bf(o2[0]); asm volatile("global_store_short %0, %1, %2" :: "v"(ooff), "v"(v), "s"(obn + (size_t)(32) * orow) : "memory"); }
          { const unsigned v = f2bf(o2[1]); asm volatile("global_store_short %0, %1, %2" :: "v"(ooff), "v"(v), "s"(obn + (size_t)(33) * orow) : "memory"); }
          { const unsigned v = f2bf(o2[2]); asm volatile("global_store_short %0, %1, %2" :: "v"(ooff), "v"(v), "s"(obn + (size_t)(34) * orow) : "memory"); }
          { const unsigned v = f2bf(o2[3]); asm volatile("global_store_short %0, %1, %2" :: "v"(ooff), "v"(v), "s"(obn + (size_t)(35) * orow) : "memory"); }
          { const unsigned v = f2bf(o3[0]); asm volatile("global_store_short %0, %1, %2" :: "v"(ooff), "v"(v), "s"(obn + (size_t)(48) * orow) : "memory"); }
          { const unsigned v = f2bf(o3[1]); asm volatile("global_store_short %0, %1, %2" :: "v"(ooff), "v"(v), "s"(obn + (size_t)(49) * orow) : "memory"); }
          { const unsigned v = f2bf(o3[2]); asm volatile("global_store_short %0, %1, %2" :: "v"(ooff), "v"(v), "s"(obn + (size_t)(50) * orow) : "memory"); }
          { const unsigned v = f2bf(o3[3]); asm volatile("global_store_short %0, %1, %2" :: "v"(ooff), "v"(v), "s"(obn + (size_t)(51) * orow) : "memory"); }
        }
        __builtin_amdgcn_sched_barrier(0);
        S0 = S0 * dec;
        asm volatile("s_waitcnt vmcnt(43)" : "+v"(r12));
        S0 = mfma16(r12, vp0, S0);
        asm volatile("global_load_dwordx4 %0, %1, %2" : "+v"(r12) : "v"(voff), "s"(spc) : "memory"); spc += 1024;
        __builtin_amdgcn_sched_barrier(0);
        asm volatile("s_waitcnt vmcnt(43)" : "+v"(r13));
        S0 = mfma16(r13, vp1, S0);
        asm volatile("global_load_dwordx4 %0, %1, %2" : "+v"(r13) : "v"(voff), "s"(spc) : "memory"); spc += 1024;
        __builtin_amdgcn_sched_barrier(0);
        S1 = S1 * dec;
        asm volatile("s_waitcnt vmcnt(43)" : "+v"(r14));
        S1 = mfma16(r14, vp0, S1);
        asm volatile("global_load_dwordx4 %0, %1, %2" : "+v"(r14) : "v"(voff), "s"(spc) : "memory"); spc += 1024;
        __builtin_amdgcn_sched_barrier(0);
        asm volatile("s_waitcnt vmcnt(43)" : "+v"(r15));
        S1 = mfma16(r15, vp1, S1);
        asm volatile("global_load_dwordx4 %0, %1, %2" : "+v"(r15) : "v"(voff), "s"(spc) : "memory"); spc += 1024;
        __builtin_amdgcn_sched_barrier(0);
        S2 = S2 * dec;
        asm volatile("s_waitcnt vmcnt(43)" : "+v"(r16));
        S2 = mfma16(r16, vp0, S2);
        asm volatile("global_load_dwordx4 %0, %1, %2" : "+v"(r16) : "v"(voff), "s"(spc) : "memory"); spc += 1024;
        __builtin_amdgcn_sched_barrier(0);
        asm volatile("s_waitcnt vmcnt(43)" : "+v"(r17));
        S2 = mfma16(r17, vp1, S2);
        asm volatile("global_load_dwordx4 %0, %1, %2" : "+v"(r17) : "v"(voff), "s"(spc) : "memory"); spc += 1024;
        __builtin_amdgcn_sched_barrier(0);
        S3 = S3 * dec;
        asm volatile("s_waitcnt vmcnt(43)" : "+v"(r18));
        S3 = mfma16(r18, vp0, S3);
        asm volatile("global_load_dwordx4 %0, %1, %2" : "+v"(r18) : "v"(voff), "s"(spc) : "memory"); spc += 1024;
        __builtin_amdgcn_sched_barrier(0);
        asm volatile("s_waitcnt vmcnt(43)" : "+v"(r19));
        S3 = mfma16(r19, vp1, S3);
        asm volatile("global_load_dwordx4 %0, %1, %2" : "+v"(r19) : "v"(voff), "s"(spc) : "memory"); spc += 1024;
        __builtin_amdgcn_sched_barrier(0);
        S4 = S4 * dec;
        asm volatile("s_waitcnt vmcnt(43)" : "+v"(r20));
        S4 = mfma16(r20, vp0, S4);
        asm volatile("global_load_dwordx4 %0, %1, %2" : "+v"(r20) : "v"(voff), "s"(spc) : "memory"); spc += 1024;
        __builtin_amdgcn_sched_barrier(0);
        asm volatile("s_waitcnt vmcnt(43)" : "+v"(r21));
        S4 = mfma16(r21, vp1, S4);
        asm volatile("global_load_dwordx4 %0, %1, %2" : "+v"(r21) : "v"(voff), "s"(spc) : "memory"); spc += 1024;
        __builtin_amdgcn_sched_barrier(0);
        S5 = S5 * dec;
        asm volatile("s_waitcnt vmcnt(43)" : "+v"(r22));
        S5 = mfma16(r22, vp0, S5);
        asm volatile("global_load_dwordx4 %0, %1, %2" : "+v"(r22) : "v"(voff), "s"(spc) : "memory"); spc += 1024;
        __builtin_amdgcn_sched_barrier(0);
        asm volatile("s_waitcnt vmcnt(43)" : "+v"(r23));
        S5 = mfma16(r23, vp1, S5);
        asm volatile("global_load_dwordx4 %0, %1, %2" : "+v"(r23) : "v"(voff), "s"(spc) : "memory"); spc += 1024;
        __builtin_amdgcn_sched_barrier(0);
        S6 = S6 * dec;
        asm volatile("s_waitcnt vmcnt(43)" : "+v"(r24));
        S6 = mfma16(r24, vp0, S6);
        asm volatile("global_load_dwordx4 %0, %1, %2" : "+v"(r24) : "v"(voff), "s"(spc) : "memory"); spc += 1024;
        __builtin_amdgcn_sched_barrier(0);
        asm volatile("s_waitcnt vmcnt(43)" : "+v"(r25));
        S6 = mfma16(r25, vp1, S6);
        asm volatile("global_load_dwordx4 %0, %1, %2" : "+v"(r25) : "v"(voff), "s"(spc) : "memory"); spc += 1024;
        __builtin_amdgcn_sched_barrier(0);
        S7 = S7 * dec;
        asm volatile("s_waitcnt vmcnt(43)" : "+v"(r26));
        S7 = mfma16(r26, vp0, S7);
        asm volatile("global_load_dwordx4 %0, %1, %2" : "+v"(r26) : "v"(voff), "s"(spc) : "memory"); spc += 1024;
        __builtin_amdgcn_sched_barrier(0);
        asm volatile("s_waitcnt vmcnt(43)" : "+v"(r27));
        S7 = mfma16(r27, vp1, S7);
        asm volatile("global_load_dwordx4 %0, %1, %2" : "+v"(r27) : "v"(voff), "s"(spc) : "memory"); spc += 1024;
        __builtin_amdgcn_sched_barrier(0);
        { u32x4 w; w.x = cvt_pk_bf16(S0[0], S0[1]); w.y = cvt_pk_bf16(S0[2], S0[3]); w.z = cvt_pk_bf16(S1[0], S1[1]); w.w = cvt_pk_bf16(S1[2], S1[3]); Sp0 = __builtin_bit_cast(bf16x8, w); }
        { u32x4 w; w.x = cvt_pk_bf16(S2[0], S2[1]); w.y = cvt_pk_bf16(S2[2], S2[3]); w.z = cvt_pk_bf16(S3[0], S3[1]); w.w = cvt_pk_bf16(S3[2], S3[3]); Sp1 = __builtin_bit_cast(bf16x8, w); }
        { u32x4 w; w.x = cvt_pk_bf16(S4[0], S4[1]); w.y = cvt_pk_bf16(S4[2], S4[3]); w.z = cvt_pk_bf16(S5[0], S5[1]); w.w = cvt_pk_bf16(S5[2], S5[3]); Sp2 = __builtin_bit_cast(bf16x8, w); }
        { u32x4 w; w.x = cvt_pk_bf16(S6[0], S6[1]); w.y = cvt_pk_bf16(S6[2], S6[3]); w.z = cvt_pk_bf16(S7[0], S7[1]); w.w = cvt_pk_bf16(S7[2], S7[3]); Sp3 = __builtin_bit_cast(bf16x8, w); }
    }
    asm volatile("s_waitcnt vmcnt(0)" ::: "memory");
    } else {
    bf16x8 r0 = (bf16x8){0, 0, 0, 0, 0, 0, 0, 0};
    bf16x8 r1 = (bf16x8){0, 0, 0, 0, 0, 0, 0, 0};
    bf16x8 r2 = (bf16x8){0, 0, 0, 0, 0, 0, 0, 0};
    bf16x8 r3 = (bf16x8){0, 0, 0, 0, 0, 0, 0, 0};
    bf16x8 r4 = (bf16x8){0, 0, 0, 0, 0, 0, 0, 0};
    bf16x8 r5 = (bf16x8){0, 0, 0, 0, 0, 0, 0, 0};
    bf16x8 r6 = (bf16x8){0, 0, 0, 0, 0, 0, 0, 0};
    bf16x8 r7 = (bf16x8){0, 0, 0, 0, 0, 0, 0, 0};
    bf16x8 r8 = (bf16x8){0, 0, 0, 0, 0, 0, 0, 0};
    bf16x8 r9 = (bf16x8){0, 0, 0, 0, 0, 0, 0, 0};
    bf16x8 r10 = (bf16x8){0, 0, 0, 0, 0, 0, 0, 0};
    bf16x8 r11 = (bf16x8){0, 0, 0, 0, 0, 0, 0, 0};
    bf16x8 r12 = (bf16x8){0, 0, 0, 0, 0, 0, 0, 0};
    bf16x8 r13 = (bf16x8){0, 0, 0, 0, 0, 0, 0, 0};
    bf16x8 r14 = (bf16x8){0, 0, 0, 0, 0, 0, 0, 0};
    bf16x8 r15 = (bf16x8){0, 0, 0, 0, 0, 0, 0, 0};
    bf16x8 r16 = (bf16x8){0, 0, 0, 0, 0, 0, 0, 0};
    bf16x8 r17 = (bf16x8){0, 0, 0, 0, 0, 0, 0, 0};
    bf16x8 r18 = (bf16x8){0, 0, 0, 0, 0, 0, 0, 0};
    bf16x8 r19 = (bf16x8){0, 0, 0, 0, 0, 0, 0, 0};
    unsigned vn0 = 0u; asm volatile("global_load_ushort %0, %1, %2" : "+v"(vn0) : "v"(ooff), "s"(obu + (size_t)(0) * orow) : "memory");
    unsigned vn1 = 0u; asm volatile("global_load_ushort %0, %1, %2" : "+v"(vn1) : "v"(ooff), "s"(obu + (size_t)(1) * orow) : "memory");
    unsigned vn2 = 0u; asm volatile("global_load_ushort %0, %1, %2" : "+v"(vn2) : "v"(ooff), "s"(obu + (size_t)(2) * orow) : "memory");
    unsigned vn3 = 0u; asm volatile("global_load_ushort %0, %1, %2" : "+v"(vn3) : "v"(ooff), "s"(obu + (size_t)(3) * orow) : "memory");
    unsigned vn4 = 0u; asm volatile("global_load_ushort %0, %1, %2" : "+v"(vn4) : "v"(ooff), "s"(obu + (size_t)(16) * orow) : "memory");
    unsigned vn5 = 0u; asm volatile("global_load_ushort %0, %1, %2" : "+v"(vn5) : "v"(ooff), "s"(obu + (size_t)(17) * orow) : "memory");
    unsigned vn6 = 0u; asm volatile("global_load_ushort %0, %1, %2" : "+v"(vn6) : "v"(ooff), "s"(obu + (size_t)(18) * orow) : "memory");
    unsigned vn7 = 0u; asm volatile("global_load_ushort %0, %1, %2" : "+v"(vn7) : "v"(ooff), "s"(obu + (size_t)(19) * orow) : "memory");
    unsigned vn8 = 0u; asm volatile("global_load_ushort %0, %1, %2" : "+v"(vn8) : "v"(ooff), "s"(obu + (size_t)(32) * orow) : "memory");
    unsigned vn9 = 0u; asm volatile("global_load_ushort %0, %1, %2" : "+v"(vn9) : "v"(ooff), "s"(obu + (size_t)(33) * orow) : "memory");
    unsigned vn10 = 0u; asm volatile("global_load_ushort %0, %1, %2" : "+v"(vn10) : "v"(ooff), "s"(obu + (size_t)(34) * orow) : "memory");
    unsigned vn11 = 0u; asm volatile("global_load_ushort %0, %1, %2" : "+v"(vn11) : "v"(ooff), "s"(obu + (size_t)(35) * orow) : "memory");
    unsigned vn12 = 0u; asm volatile("global_load_ushort %0, %1, %2" : "+v"(vn12) : "v"(ooff), "s"(obu + (size_t)(48) * orow) : "memory");
    unsigned vn13 = 0u; asm volatile("global_load_ushort %0, %1, %2" : "+v"(vn13) : "v"(ooff), "s"(obu + (size_t)(49) * orow) : "memory");
    unsigned vn14 = 0u; asm volatile("global_load_ushort %0, %1, %2" : "+v"(vn14) : "v"(ooff), "s"(obu + (size_t)(50) * orow) : "memory");
    unsigned vn15 = 0u; asm volatile("global_load_ushort %0, %1, %2" : "+v"(vn15) : "v"(ooff), "s"(obu + (size_t)(51) * orow) : "memory");
    const unsigned char* spc = sp0;
    asm volatile("global_load_dwordx4 %0, %1, %2" : "+v"(r0) : "v"(voff), "s"(spc) : "memory"); spc += 1024;
    asm volatile("global_load_dwordx4 %0, %1, %2" : "+v"(r1) : "v"(voff), "s"(spc) : "memory"); spc += 1024;
    asm volatile("global_load_dwordx4 %0, %1, %2" : "+v"(r2) : "v"(voff), "s"(spc) : "memory"); spc += 1024;
    asm volatile("global_load_dwordx4 %0, %1, %2" : "+v"(r3) : "v"(voff), "s"(spc) : "memory"); spc += 1024;
    asm volatile("global_load_dwordx4 %0, %1, %2" : "+v"(r4) : "v"(voff), "s"(spc) : "memory"); spc += 1024;
    asm volatile("global_load_dwordx4 %0, %1, %2" : "+v"(r5) : "v"(voff), "s"(spc) : "memory"); spc += 1024;
    asm volatile("global_load_dwordx4 %0, %1, %2" : "+v"(r6) : "v"(voff), "s"(spc) : "memory"); spc += 1024;
    asm volatile("global_load_dwordx4 %0, %1, %2" : "+v"(r7) : "v"(voff), "s"(spc) : "memory"); spc += 1024;
    asm volatile("global_load_dwordx4 %0, %1, %2" : "+v"(r8) : "v"(voff), "s"(spc) : "memory"); spc += 1024;
    asm volatile("global_load_dwordx4 %0, %1, %2" : "+v"(r9) : "v"(voff), "s"(spc) : "memory"); spc += 1024;
    asm volatile("global_load_dwordx4 %0, %1, %2" : "+v"(r10) : "v"(voff), "s"(spc) : "memory"); spc += 1024;
    asm volatile("global_load_dwordx4 %0, %1, %2" : "+v"(r11) : "v"(voff), "s"(spc) : "memory"); spc += 1024;
    asm volatile("global_load_dwordx4 %0, %1, %2" : "+v"(r12) : "v"(voff), "s"(spc) : "memory"); spc += 1024;
    asm volatile("global_load_dwordx4 %0, %1, %2" : "+v"(r13) : "v"(voff), "s"(spc) : "memory"); spc += 1024;
    asm volatile("global_load_dwordx4 %0, %1, %2" : "+v"(r14) : "v"(voff), "s"(spc) : "memory"); spc += 1024;
    asm volatile("global_load_dwordx4 %0, %1, %2" : "+v"(r15) : "v"(voff), "s"(spc) : "memory"); spc += 1024;
    asm volatile("global_load_dwordx4 %0, %1, %2" : "+v"(r16) : "v"(voff), "s"(spc) : "memory"); spc += 1024;
    asm volatile("global_load_dwordx4 %0, %1, %2" : "+v"(r17) : "v"(voff), "s"(spc) : "memory"); spc += 1024;
    asm volatile("global_load_dwordx4 %0, %1, %2" : "+v"(r18) : "v"(voff), "s"(spc) : "memory"); spc += 1024;
    asm volatile("global_load_dwordx4 %0, %1, %2" : "+v"(r19) : "v"(voff), "s"(spc) : "memory"); spc += 1024;
    { unsigned z = 0u;
      asm volatile("global_store_short %0, %1, %2" :: "v"(ooff), "v"(z), "s"(obu + (size_t)(0) * orow) : "memory");
      asm volatile("global_store_short %0, %1, %2" :: "v"(ooff), "v"(z), "s"(obu + (size_t)(1) * orow) : "memory");
      asm volatile("global_store_short %0, %1, %2" :: "v"(ooff), "v"(z), "s"(obu + (size_t)(2) * orow) : "memory");
      asm volatile("global_store_short %0, %1, %2" :: "v"(ooff), "v"(z), "s"(obu + (size_t)(3) * orow) : "memory");
      asm volatile("global_store_short %0, %1, %2" :: "v"(ooff), "v"(z), "s"(obu + (size_t)(16) * orow) : "memory");
      asm volatile("global_store_short %0, %1, %2" :: "v"(ooff), "v"(z), "s"(obu + (size_t)(17) * orow) : "memory");
      asm volatile("global_store_short %0, %1, %2" :: "v"(ooff), "v"(z), "s"(obu + (size_t)(18) * orow) : "memory");
      asm volatile("global_store_short %0, %1, %2" :: "v"(ooff), "v"(z), "s"(obu + (size_t)(19) * orow) : "memory");
      asm volatile("global_store_short %0, %1, %2" :: "v"(ooff), "v"(z), "s"(obu + (size_t)(32) * orow) : "memory");
      asm volatile("global_store_short %0, %1, %2" :: "v"(ooff), "v"(z), "s"(obu + (size_t)(33) * orow) : "memory");
      asm volatile("global_store_short %0, %1, %2" :: "v"(ooff), "v"(z), "s"(obu + (size_t)(34) * orow) : "memory");
      asm volatile("global_store_short %0, %1, %2" :: "v"(ooff), "v"(z), "s"(obu + (size_t)(35) * orow) : "memory");
      asm volatile("global_store_short %0, %1, %2" :: "v"(ooff), "v"(z), "s"(obu + (size_t)(48) * orow) : "memory");
      asm volatile("global_store_short %0, %1, %2" :: "v"(ooff), "v"(z), "s"(obu + (size_t)(49) * orow) : "memory");
      asm volatile("global_store_short %0, %1, %2" :: "v"(ooff), "v"(z), "s"(obu + (size_t)(50) * orow) : "memory");
      asm volatile("global_store_short %0, %1, %2" :: "v"(ooff), "v"(z), "s"(obu + (size_t)(51) * orow) : "memory");
    }
#pragma unroll 1
    for (int n = 0; n < NCH; ++n) {
        f32x4 a1_0, a1_1, a1_2, a1_3;
        asm volatile("s_waitcnt vmcnt(36)" : "+v"(vn0), "+v"(vn1), "+v"(vn2), "+v"(vn3), "+v"(vn4), "+v"(vn5), "+v"(vn6), "+v"(vn7), "+v"(vn8), "+v"(vn9), "+v"(vn10), "+v"(vn11), "+v"(vn12), "+v"(vn13), "+v"(vn14), "+v"(vn15));
        a1_0 = (f32x4){__builtin_bit_cast(float, vn0 << 16), __builtin_bit_cast(float, vn1 << 16), __builtin_bit_cast(float, vn2 << 16), __builtin_bit_cast(float, vn3 << 16)};
        a1_1 = (f32x4){__builtin_bit_cast(float, vn4 << 16), __builtin_bit_cast(float, vn5 << 16), __builtin_bit_cast(float, vn6 << 16), __builtin_bit_cast(float, vn7 << 16)};
        a1_2 = (f32x4){__builtin_bit_cast(float, vn8 << 16), __builtin_bit_cast(float, vn9 << 16), __builtin_bit_cast(float, vn10 << 16), __builtin_bit_cast(float, vn11 << 16)};
        a1_3 = (f32x4){__builtin_bit_cast(float, vn12 << 16), __builtin_bit_cast(float, vn13 << 16), __builtin_bit_cast(float, vn14 << 16), __builtin_bit_cast(float, vn15 << 16)};
        const float dec = decr;
        { const unsigned char* obn = obu + (size_t)(n + 1 < NCH ? n + 1 : n) * 64 * orow;
          asm volatile("global_load_ushort %0, %1, %2" : "+v"(vn0) : "v"(ooff), "s"(obn + (size_t)(0) * orow) : "memory");
          asm volatile("global_load_ushort %0, %1, %2" : "+v"(vn1) : "v"(ooff), "s"(obn + (size_t)(1) * orow) : "memory");
          asm volatile("global_load_ushort %0, %1, %2" : "+v"(vn2) : "v"(ooff), "s"(obn + (size_t)(2) * orow) : "memory");
          asm volatile("global_load_ushort %0, %1, %2" : "+v"(vn3) : "v"(ooff), "s"(obn + (size_t)(3) * orow) : "memory");
          asm volatile("global_load_ushort %0, %1, %2" : "+v"(vn4) : "v"(ooff), "s"(obn + (size_t)(16) * orow) : "memory");
          asm volatile("global_load_ushort %0, %1, %2" : "+v"(vn5) : "v"(ooff), "s"(obn + (size_t)(17) * orow) : "memory");
          asm volatile("global_load_ushort %0, %1, %2" : "+v"(vn6) : "v"(ooff), "s"(obn + (size_t)(18) * orow) : "memory");
          asm volatile("global_load_ushort %0, %1, %2" : "+v"(vn7) : "v"(ooff), "s"(obn + (size_t)(19) * orow) : "memory");
          asm volatile("global_load_ushort %0, %1, %2" : "+v"(vn8) : "v"(ooff), "s"(obn + (size_t)(32) * orow) : "memory");
          asm volatile("global_load_ushort %0, %1, %2" : "+v"(vn9) : "v"(ooff), "s"(obn + (size_t)(33) * orow) : "memory");
          asm volatile("global_load_ushort %0, %1, %2" : "+v"(vn10) : "v"(ooff), "s"(obn + (size_t)(34) * orow) : "memory");
          asm volatile("global_load_ushort %0, %1, %2" : "+v"(vn11) : "v"(ooff), "s"(obn + (size_t)(35) * orow) : "memory");
          asm volatile("global_load_ushort %0, %1, %2" : "+v"(vn12) : "v"(ooff), "s"(obn + (size_t)(48) * orow) : "memory");
          asm volatile("global_load_ushort %0, %1, %2" : "+v"(vn13) : "v"(ooff), "s"(obn + (size_t)(49) * orow) : "memory");
          asm volatile("global_load_ushort %0, %1, %2" : "+v"(vn14) : "v"(ooff), "s"(obn + (size_t)(50) * orow) : "memory");
          asm volatile("global_load_ushort %0, %1, %2" : "+v"(vn15) : "v"(ooff), "s"(obn + (size_t)(51) * orow) : "memory");
        }
        __builtin_amdgcn_sched_barrier(0);
        bf16x8 vp0, vp1;
        { u32x4 w; w.x = cvt_pk_bf16(a1_0[0], a1_0[1]); w.y = cvt_pk_bf16(a1_0[2], a1_0[3]); w.z = cvt_pk_bf16(a1_1[0], a1_1[1]); w.w = cvt_pk_bf16(a1_1[2], a1_1[3]); vp0 = __builtin_bit_cast(bf16x8, w); }
        { u32x4 w; w.x = cvt_pk_bf16(a1_2[0], a1_2[1]); w.y = cvt_pk_bf16(a1_2[2], a1_2[3]); w.z = cvt_pk_bf16(a1_3[0], a1_3[1]); w.w = cvt_pk_bf16(a1_3[2], a1_3[3]); vp1 = __builtin_bit_cast(bf16x8, w); }
        f32x4 o0 = {0.f, 0.f, 0.f, 0.f}, o1 = o0, o2 = o0, o3 = o0;
        asm volatile("s_waitcnt vmcnt(51)" : "+v"(r0));
        o0 = mfma16(r0, Sp0, o0);
        asm volatile("global_load_dwordx4 %0, %1, %2" : "+v"(r0) : "v"(voff), "s"(spc) : "memory"); spc += 1024;
        __builtin_amdgcn_sched_barrier(0);
        asm volatile("s_waitcnt vmcnt(51)" : "+v"(r1));
        o0 = mfma16(r1, Sp1, o0);
        asm volatile("global_load_dwordx4 %0, %1, %2" : "+v"(r1) : "v"(voff), "s"(spc) : "memory"); spc += 1024;
        __builtin_amdgcn_sched_barrier(0);
        asm volatile("s_waitcnt vmcnt(51)" : "+v"(r2));
        o0 = mfma16(r2, Sp2, o0);
        asm volatile("global_load_dwordx4 %0, %1, %2" : "+v"(r2) : "v"(voff), "s"(spc) : "memory"); spc += 1024;
        __builtin_amdgcn_sched_barrier(0);
        asm volatile("s_waitcnt vmcnt(51)" : "+v"(r3));
        o0 = mfma16(r3, Sp3, o0);
        asm volatile("global_load_dwordx4 %0, %1, %2" : "+v"(r3) : "v"(voff), "s"(spc) : "memory"); spc += 1024;
        __builtin_amdgcn_sched_barrier(0);
        asm volatile("s_waitcnt vmcnt(35)" : "+v"(r4));
        o1 = mfma16(r4, Sp0, o1);
        asm volatile("global_load_dwordx4 %0, %1, %2" : "+v"(r4) : "v"(voff), "s"(spc) : "memory"); spc += 1024;
        __builtin_amdgcn_sched_barrier(0);
        asm volatile("s_waitcnt vmcnt(35)" : "+v"(r5));
        o1 = mfma16(r5, Sp1, o1);
        asm volatile("global_load_dwordx4 %0, %1, %2" : "+v"(r5) : "v"(voff), "s"(spc) : "memory"); spc += 1024;
        __builtin_amdgcn_sched_barrier(0);
        asm volatile("s_waitcnt vmcnt(35)" : "+v"(r6));
        o1 = mfma16(r6, Sp2, o1);
        asm volatile("global_load_dwordx4 %0, %1, %2" : "+v"(r6) : "v"(voff), "s"(spc) : "memory"); spc += 1024;
        __builtin_amdgcn_sched_barrier(0);
        asm volatile("s_waitcnt vmcnt(35)" : "+v"(r7));
        o1 = mfma16(r7, Sp3, o1);
        asm volatile("global_load_dwordx4 %0, %1, %2" : "+v"(r7) : "v"(voff), "s"(spc) : "memory"); spc += 1024;
        __builtin_amdgcn_sched_barrier(0);
        asm volatile("s_waitcnt vmcnt(35)" : "+v"(r8));
        o2 = mfma16(r8, Sp0, o2);
        asm volatile("global_load_dwordx4 %0, %1, %2" : "+v"(r8) : "v"(voff), "s"(spc) : "memory"); spc += 1024;
        __builtin_amdgcn_sched_barrier(0);
        asm volatile("s_waitcnt vmcnt(35)" : "+v"(r9));
        o2 = mfma16(r9, Sp1, o2);
        asm volatile("global_load_dwordx4 %0, %1, %2" : "+v"(r9) : "v"(voff), "s"(spc) : "memory"); spc += 1024;
        __builtin_amdgcn_sched_barrier(0);
        asm volatile("s_waitcnt vmcnt(35)" : "+v"(r10));
        o2 = mfma16(r10, Sp2, o2);
        asm volatile("global_load_dwordx4 %0, %1, %2" : "+v"(r10) : "v"(voff), "s"(spc) : "memory"); spc += 1024;
        __builtin_amdgcn_sched_barrier(0);
        asm volatile("s_waitcnt vmcnt(35)" : "+v"(r11));
        o2 = mfma16(r11, Sp3, o2);
        asm volatile("global_load_dwordx4 %0, %1, %2" : "+v"(r11) : "v"(voff), "s"(spc) : "memory"); spc += 1024;
        __builtin_amdgcn_sched_barrier(0);
        asm volatile("s_waitcnt vmcnt(35)" : "+v"(r12));
        o3 = mfma16(r12, Sp0, o3);
        asm volatile("global_load_dwordx4 %0, %1, %2" : "+v"(r12) : "v"(voff), "s"(spc) : "memory"); spc += 1024;
        __builtin_amdgcn_sched_barrier(0);
        asm volatile("s_waitcnt vmcnt(35)" : "+v"(r13));
        o3 = mfma16(r13, Sp1, o3);
        asm volatile("global_load_dwordx4 %0, %1, %2" : "+v"(r13) : "v"(voff), "s"(spc) : "memory"); spc += 1024;
        __builtin_amdgcn_sched_barrier(0);
        asm volatile("s_waitcnt vmcnt(35)" : "+v"(r14));
        o3 = mfma16(r14, Sp2, o3);
        asm volatile("global_load_dwordx4 %0, %1, %2" : "+v"(r14) : "v"(voff), "s"(spc) : "memory"); spc += 1024;
        __builtin_amdgcn_sched_barrier(0);
        asm volatile("s_waitcnt vmcnt(35)" : "+v"(r15));
        o3 = mfma16(r15, Sp3, o3);
        asm volatile("global_load_dwordx4 %0, %1, %2" : "+v"(r15) : "v"(voff), "s"(spc) : "memory"); spc += 1024;
        __builtin_amdgcn_sched_barrier(0);
        asm volatile("s_waitcnt vmcnt(35)" : "+v"(r16));
        o0 = mfma16(r16, vp0, o0);
        asm volatile("global_load_dwordx4 %0, %1, %2" : "+v"(r16) : "v"(voff), "s"(spc) : "memory"); spc += 1024;
        __builtin_amdgcn_sched_barrier(0);
        asm volatile("s_waitcnt vmcnt(35)" : "+v"(r17));
        o0 = mfma16(r17, vp1, o0);
        asm volatile("global_load_dwordx4 %0, %1, %2" : "+v"(r17) : "v"(voff), "s"(spc) : "memory"); spc += 1024;
        __builtin_amdgcn_sched_barrier(0);
        asm volatile("s_waitcnt vmcnt(35)" : "+v"(r18));
        o1 = mfma16(r18, vp0, o1);
        asm volatile("global_load_dwordx4 %0, %1, %2" : "+v"(r18) : "v"(voff), "s"(spc) : "memory"); spc += 1024;
        __builtin_amdgcn_sched_barrier(0);
        asm volatile("s_waitcnt vmcnt(35)" : "+v"(r19));
        o1 = mfma16(r19, vp1, o1);
        asm volatile("global_load_dwordx4 %0, %1, %2" : "+v"(r19) : "v"(voff), "s"(spc) : "memory"); spc += 1024;
        __builtin_amdgcn_sched_barrier(0);
        asm volatile("s_waitcnt vmcnt(19)" : "+v"(r0));
        o2 = mfma16(r0, vp0, o2);
        asm volatile("global_load_dwordx4 %0, %1, %2" : "+v"(r0) : "v"(voff), "s"(spc) : "memory"); spc += 1024;
        __builtin_amdgcn_sched_barrier(0);
        asm volatile("s_waitcnt vmcnt(19)" : "+v"(r1));
        o2 = mfma16(r1, vp1, o2);
        asm volatile("global_load_dwordx4 %0, %1, %2" : "+v"(r1) : "v"(voff), "s"(spc) : "memory"); spc += 1024;
        __builtin_amdgcn_sched_barrier(0);
        asm volatile("s_waitcnt vmcnt(19)" : "+v"(r2));
        o3 = mfma16(r2, vp0, o3);
        asm volatile("global_load_dwordx4 %0, %1, %2" : "+v"(r2) : "v"(voff), "s"(spc) : "memory"); spc += 1024;
        __builtin_amdgcn_sched_barrier(0);
        asm volatile("s_waitcnt vmcnt(19)" : "+v"(r3));
        o3 = mfma16(r3, vp1, o3);
        asm volatile("global_load_dwordx4 %0, %1, %2" : "+v"(r3) : "v"(voff), "s"(spc) : "memory"); spc += 1024;
        __builtin_amdgcn_sched_barrier(0);
        { const unsigned char* obn = obu + (size_t)n * 64 * orow;
          { const unsigned v = f2bf(o0[0]); asm volatile("global_store_short %0, %1, %2" :: "v"(ooff), "v"(v), "s"(obn + (size_t)(0) * orow) : "memory"); }
          { const unsigned v = f2bf(o0[1]); asm volatile("global_store_short %0, %1, %2" :: "v"(ooff), "v"(v), "s"(obn + (size_t)(1) * orow) : "memory"); }
          { const unsigned v = f2bf(o0[2]); asm volatile("global_store_short %0, %1, %2" :: "v"(ooff), "v"(v), "s"(obn + (size_t)(2) * orow) : "memory"); }
          { const unsigned v = f2bf(o0[3]); asm volatile("global_store_short %0, %1, %2" :: "v"(ooff), "v"(v), "s"(obn + (size_t)(3) * orow) : "memory"); }
          { const unsigned v = f2bf(o1[0]); asm volatile("global_store_short %0, %1, %2" :: "v"(ooff), "v"(v), "s"(obn + (size_t)(16) * orow) : "memory"); }
          { const unsigned v = f2bf(o1[1]); asm volatile("global_store_short %0, %1, %2" :: "v"(ooff), "v"(v), "s"(obn + (size_t)(17) * orow) : "memory"); }
          { const unsigned v = f2bf(o1[2]); asm volatile("global_store_short %0, %1, %2" :: "v"(ooff), "v"(v), "s"(obn + (size_t)(18) * orow) : "memory"); }
          { const unsigned v = f2bf(o1[3]); asm volatile("global_store_short %0, %1, %2" :: "v"(ooff), "v"(v), "s"(obn + (size_t)(19) * orow) : "memory"); }
          { const unsigned v = f2bf(o2[0]); asm volatile("global_store_short %0, %1, %2" :: "v"(ooff), "v"(v), "s"(obn + (size_t)(32) * orow) : "memory"); }
          { const unsigned v = f2bf(o2[1]); asm volatile("global_store_short %0, %1, %2" :: "v"(ooff), "v"(v), "s"(obn + (size_t)(33) * orow) : "memory"); }
          { const unsigned v = f2bf(o2[2]); asm volatile("global_store_short %0, %1, %2" :: "v"(ooff), "v"(v), "s"(obn + (size_t)(34) * orow) : "memory"); }
          { const unsigned v = f2bf(o2[3]); asm volatile("global_store_short %0, %1, %2" :: "v"(ooff), "v"(v), "s"(obn + (size_t)(35) * orow) : "memory"); }
          { const unsigned v = f2bf(o3[0]); asm volatile("global_store_short %0, %1, %2" :: "v"(ooff), "v"(v), "s"(obn + (size_t)(48) * orow) : "memory"); }
          { const unsigned v = f2bf(o3[1]); asm volatile("global_store_short %0, %1, %2" :: "v"(ooff), "v"(v), "s"(obn + (size_t)(49) * orow) : "memory"); }
          { const unsigned v = f2bf(o3[2]); asm volatile("global_store_short %0, %1, %2" :: "v"(ooff), "v"(v), "s"(obn + (size_t)(50) * orow) : "memory"); }
          { const unsigned v = f2bf(o3[3]); asm volatile("global_store_short %0, %1, %2" :: "v"(ooff), "v"(v), "s"(obn + (size_t)(51) * orow) : "memory"); }
        }
        __builtin_amdgcn_sched_barrier(0);
        S0 = S0 * dec;
        asm volatile("s_waitcnt vmcnt(35)" : "+v"(r4));
        S0 = mfma16(r4, vp0, S0);
        asm volatile("global_load_dwordx4 %0, %1, %2" : "+v"(r4) : "v"(voff), "s"(spc) : "memory"); spc += 1024;
        __builtin_amdgcn_sched_barrier(0);
        asm volatile("s_waitcnt vmcnt(35)" : "+v"(r5));
        S0 = mfma16(r5, vp1, S0);
        asm volatile("global_load_dwordx4 %0, %1, %2" : "+v"(r5) : "v"(voff), "s"(spc) : "memory"); spc += 1024;
        __builtin_amdgcn_sched_barrier(0);
        S1 = S1 * dec;
        asm volatile("s_waitcnt vmcnt(35)" : "+v"(r6));
        S1 = mfma16(r6, vp0, S1);
        asm volatile("global_load_dwordx4 %0, %1, %2" : "+v"(r6) : "v"(voff), "s"(spc) : "memory"); spc += 1024;
        __builtin_amdgcn_sched_barrier(0);
        asm volatile("s_waitcnt vmcnt(35)" : "+v"(r7));
        S1 = mfma16(r7, vp1, S1);
        asm volatile("global_load_dwordx4 %0, %1, %2" : "+v"(r7) : "v"(voff), "s"(spc) : "memory"); spc += 1024;
        __builtin_amdgcn_sched_barrier(0);
        S2 = S2 * dec;
        asm volatile("s_waitcnt vmcnt(35)" : "+v"(r8));
        S2 = mfma16(r8, vp0, S2);
        asm volatile("global_load_dwordx4 %0, %1, %2" : "+v"(r8) : "v"(voff), "s"(spc) : "memory"); spc += 1024;
        __builtin_amdgcn_sched_barrier(0);
        asm volatile("s_waitcnt vmcnt(35)" : "+v"(r9));
        S2 = mfma16(r9, vp1, S2);
        asm volatile("global_load_dwordx4 %0, %1, %2" : "+v"(r9) : "v"(voff), "s"(spc) : "memory"); spc += 1024;
        __builtin_amdgcn_sched_barrier(0);
        S3 = S3 * dec;
        asm volatile("s_waitcnt vmcnt(35)" : "+v"(r10));
        S3 = mfma16(r10, vp0, S3);
        asm volatile("global_load_dwordx4 %0, %1, %2" : "+v"(r10) : "v"(voff), "s"(spc) : "memory"); spc += 1024;
        __builtin_amdgcn_sched_barrier(0);
        asm volatile("s_waitcnt vmcnt(35)" : "+v"(r11));
        S3 = mfma16(r11, vp1, S3);
        asm volatile("global_load_dwordx4 %0, %1, %2" : "+v"(r11) : "v"(voff), "s"(spc) : "memory"); spc += 1024;
        __builtin_amdgcn_sched_barrier(0);
        S4 = S4 * dec;
        asm volatile("s_waitcnt vmcnt(35)" : "+v"(r12));
        S4 = mfma16(r12, vp0, S4);
        asm volatile("global_load_dwordx4 %0, %1, %2" : "+v"(r12) : "v"(voff), "s"(spc) : "memory"); spc += 1024;
        __builtin_amdgcn_sched_barrier(0);
        asm volatile("s_waitcnt vmcnt(35)" : "+v"(r13));
        S4 = mfma16(r13, vp1, S4);
        asm volatile("global_load_dwordx4 %0, %1, %2" : "+v"(r13) : "v"(voff), "s"(spc) : "memory"); spc += 1024;
        __builtin_amdgcn_sched_barrier(0);
        S5 = S5 * dec;
        asm volatile("s_waitcnt vmcnt(35)" : "+v"(r14));
        S5 = mfma16(r14, vp0, S5);
        asm volatile("global_load_dwordx4 %0, %1, %2" : "+v"(r14) : "v"(voff), "s"(spc) : "memory"); spc += 1024;
        __builtin_amdgcn_sched_barrier(0);
        asm volatile("s_waitcnt vmcnt(35)" : "+v"(r15));
        S5 = mfma16(r15, vp1, S5);
        asm volatile("global_load_dwordx4 %0, %1, %2" : "+v"(r15) : "v"(voff), "s"(spc) : "memory"); spc += 1024;
        __builtin_amdgcn_sched_barrier(0);
        S6 = S6 * dec;
        asm volatile("s_waitcnt vmcnt(35)" : "+v"(r16));
        S6 = mfma16(r16, vp0, S6);
        asm volatile("global_load_dwordx4 %0, %1, %2" : "+v"(r16) : "v"(voff), "s"(spc) : "memory"); spc += 1024;
        __builtin_amdgcn_sched_barrier(0);
        asm volatile("s_waitcnt vmcnt(35)" : "+v"(r17));
        S6 = mfma16(r17, vp1, S6);
        asm volatile("global_load_dwordx4 %0, %1, %2" : "+v"(r17) : "v"(voff), "s"(spc) : "memory"); spc += 1024;
        __builtin_amdgcn_sched_barrier(0);
        S7 = S7 * dec;
        asm volatile("s_waitcnt vmcnt(35)" : "+v"(r18));
        S7 = mfma16(r18, vp0, S7);
        asm volatile("global_load_dwordx4 %0, %1, %2" : "+v"(r18) : "v"(voff), "s"(spc) : "memory"); spc += 1024;
        __builtin_amdgcn_sched_barrier(0);
        asm volatile("s_waitcnt vmcnt(35)" : "+v"(r19));
        S7 = mfma16(r19, vp1, S7);
        asm volatile("global_load_dwordx4 %0, %1, %2" : "+v"(r19) : "v"(voff), "s"(spc) : "memory"); spc += 1024;
        __builtin_amdgcn_sched_barrier(0);
        { u32x4 w; w.x = cvt_pk_bf16(S0[0], S0[1]); w.y = cvt_pk_bf16(S0[2], S0[3]); w.z = cvt_pk_bf16(S1[0], S1[1]); w.w = cvt_pk_bf16(S1[2], S1[3]); Sp0 = __builtin_bit_cast(bf16x8, w); }
        { u32x4 w; w.x = cvt_pk_bf16(S2[0], S2[1]); w.y = cvt_pk_bf16(S2[2], S2[3]); w.z = cvt_pk_bf16(S3[0], S3[1]); w.w = cvt_pk_bf16(S3[2], S3[3]); Sp1 = __builtin_bit_cast(bf16x8, w); }
        { u32x4 w; w.x = cvt_pk_bf16(S4[0], S4[1]); w.y = cvt_pk_bf16(S4[2], S4[3]); w.z = cvt_pk_bf16(S5[0], S5[1]); w.w = cvt_pk_bf16(S5[2], S5[3]); Sp2 = __builtin_bit_cast(bf16x8, w); }
        { u32x4 w; w.x = cvt_pk_bf16(S6[0], S6[1]); w.y = cvt_pk_bf16(S6[2], S6[3]); w.z = cvt_pk_bf16(S7[0], S7[1]); w.w = cvt_pk_bf16(S7[2], S7[3]); Sp3 = __builtin_bit_cast(bf16x8, w); }
    }
    asm volatile("s_waitcnt vmcnt(0)" ::: "memory");
    }
}

DI void p4_mixnorm(Frame& F, const float* ret_norm, const float* gdn_norm) {
    bf16_t* pj = (bf16_t*)(F.ws + WS_BIG + BIG_PJ); const bf16_t* vc = (const bf16_t*)(F.ws + AUX_VC);
    const int lane = F.lane;
    const f32x4 gr = *(const f32x4*)(ret_norm + 4 * lane), gg = *(const f32x4*)(gdn_norm + 4 * lane);
    for (int m = F.gw; m < NTOK; m += F.NGW) {
        bf16_t* row = pj + (size_t)m * PJW;
#pragma unroll
        for (int hv = 0; hv < 16; ++hv) { const int hd = hv & 7; const bool gdn = hv >= 8;
            const u32x2 ro = gdn ? *(const u32x2*)(vc + (size_t)m * 2048 + hd * 256 + 4 * lane) : *(const u32x2*)(row + C_RV + hd * 256 + 4 * lane);
            bf16_t* gp = row + (gdn ? C_GZ : C_RG) + hd * 256 + 4 * lane; const u32x2 gt = *(const u32x2*)gp;
            const float o0 = bflo(ro.x), o1 = bfhi(ro.x), o2 = bflo(ro.y), o3 = bfhi(ro.y);
            const float rstd = 1.0f / sqrtf(wave_sum((o0 * o0 + o1 * o1) + (o2 * o2 + o3 * o3)) * (1.0f / 256.0f) + EPS);
            const f32x4 g = gdn ? gg : gr;
            u32x2 w; w.x = pk2(o0 * rstd * g.x * siluf(bflo(gt.x)), o1 * rstd * g.y * siluf(bfhi(gt.x))); w.y = pk2(o2 * rstd * g.z * siluf(bflo(gt.y)), o3 * rstd * g.w * siluf(bfhi(gt.y)));
            *(u32x2*)gp = w; }
    }
}

DI void p11_swaprep(Frame& F, const float* qnorm, const float* knorm) {
    bf16_t* qkv = (bf16_t*)(F.ws + WS_BIG + BIG_QKV1); const f32x2* cs = (const f32x2*)(F.ws + AUX_CS);
    const int lane = F.lane; const float gq = qnorm[lane], gk = knorm[lane];
    for (int m = F.gw; m < NTOK; m += F.NGW) {
        const int pos = m & (SEQ - 1); const f32x2 c = cs[pos * 64 + 2 * (lane & 31)];
        bf16_t* row = qkv + (size_t)m * ODD_IN;
#pragma unroll 4
        for (int hv = 0; hv < 36; ++hv) { bf16_t* p = row + hv * 64; const float x = bf2f(p[lane]);
            const float rstd = 1.0f / sqrtf(wave_sum(x * x) * (1.0f / 64.0f) + EPS); const float xn = x * rstd * (hv < 32 ? gq : gk);
            const float xo = __shfl_xor(xn, 32);
            const float r = lane < 32 ? xn * c.x - xo * c.y : xn * c.x + xo * c.y;
            p[lane] = (bf16_t)f2bf(r); }
    }
}
DI void p12_swa_naive(Frame& F, const float* sinks) {
    bf16_t* qkv = (bf16_t*)(F.ws + WS_BIG + BIG_QKV1);
    const long total = (long)NTOK * 32;
    for (long idx = (long)blockIdx.x * NTHR + F.tid; idx < total; idx += (long)F.G * NTHR) {
        const int hq = (int)(idx / NTOK), m = (int)(idx % NTOK), pos = m & (SEQ - 1), kvh = hq >> 3;
        bf16_t* qp = qkv + (size_t)m * ODD_IN + hq * 64;
        float q[64], o[64];
#pragma unroll
        for (int d8 = 0; d8 < 8; ++d8) { const u32x4 r = *(const u32x4*)(qp + 8 * d8); q[8 * d8] = bflo(r.x); q[8 * d8 + 1] = bfhi(r.x); q[8 * d8 + 2] = bflo(r.y); q[8 * d8 + 3] = bfhi(r.y); q[8 * d8 + 4] = bflo(r.z); q[8 * d8 + 5] = bfhi(r.z); q[8 * d8 + 6] = bflo(r.w); q[8 * d8 + 7] = bfhi(r.w); }
#pragma unroll
        for (int d = 0; d < 64; ++d) o[d] = 0.f;
        float mx = sinks[hq], l = 1.0f;
        const int j0 = pos >= 127 ? 127 : pos;
#pragma unroll 1
        for (int j = j0; j >= 0; --j) {
            const bf16_t* kp = qkv + (size_t)(m - j) * ODD_IN + 2048 + kvh * 64; const bf16_t* vp = kp + 256;
            float s = 0.f;
#pragma unroll
            for (int d8 = 0; d8 < 8; ++d8) { const u32x4 r = *(const u32x4*)(kp + 8 * d8);
                s += q[8 * d8] * bflo(r.x) + q[8 * d8 + 1] * bfhi(r.x) + q[8 * d8 + 2] * bflo(r.y) + q[8 * d8 + 3] * bfhi(r.y) + q[8 * d8 + 4] * bflo(r.z) + q[8 * d8 + 5] * bfhi(r.z) + q[8 * d8 + 6] * bflo(r.w) + q[8 * d8 + 7] * bfhi(r.w); }
            s *= 0.125f;
            const float mn = fmaxf(mx, s), cf = __expf(mx - mn), p = __expf(s - mn);
            l = l * cf + p; mx = mn;
#pragma unroll
            for (int d8 = 0; d8 < 8; ++d8) { const u32x4 r = *(const u32x4*)(vp + 8 * d8);
                o[8 * d8] = o[8 * d8] * cf + p * bflo(r.x); o[8 * d8 + 1] = o[8 * d8 + 1] * cf + p * bfhi(r.x); o[8 * d8 + 2] = o[8 * d8 + 2] * cf + p * bflo(r.y); o[8 * d8 + 3] = o[8 * d8 + 3] * cf + p * bfhi(r.y);
                o[8 * d8 + 4] = o[8 * d8 + 4] * cf + p * bflo(r.z); o[8 * d8 + 5] = o[8 * d8 + 5] * cf + p * bfhi(r.z); o[8 * d8 + 6] = o[8 * d8 + 6] * cf + p * bflo(r.w); o[8 * d8 + 7] = o[8 * d8 + 7] * cf + p * bfhi(r.w); }
        }
        const float il = 1.0f / l;
#pragma unroll
        for (int d8 = 0; d8 < 8; ++d8) { u32x4 w; w.x = pk2(o[8 * d8] * il, o[8 * d8 + 1] * il); w.y = pk2(o[8 * d8 + 2] * il, o[8 * d8 + 3] * il); w.z = pk2(o[8 * d8 + 4] * il, o[8 * d8 + 5] * il); w.w = pk2(o[8 * d8 + 6] * il, o[8 * d8 + 7] * il);
            *(u32x4*)(qp + 8 * d8) = w; }
    }
}


typedef float f32x16 __attribute__((ext_vector_type(16)));
typedef __bf16 bf16v2 __attribute__((ext_vector_type(2)));
DI unsigned pkbf(float a, float b) { f32x2 v = {a, b}; return __builtin_bit_cast(unsigned, __builtin_convertvector(v, bf16v2)); }
DI f32x16 mfma32(bf16x8 a, bf16x8 b, f32x16 c) { return __builtin_amdgcn_mfma_f32_32x32x16_bf16(a, b, c, 0, 0, 0); }
DI void swa_phase(Frame& F, const float* sinks) {
    constexpr int KP = 144;
    bf16_t* qkv = (bf16_t*)(F.ws + WS_BIG + BIG_QKV1);
    LAS unsigned char* Ks = F.lds; LAS unsigned char* Vs = F.lds + 256 * KP;
    const unsigned vs_addr = (unsigned)(size_t)Vs;
    const int lane = F.lane, w = F.wave, h = lane >> 5, ql = lane & 31, q4 = (lane & 15) >> 2, p4 = lane & 3, blk = (lane >> 4) & 1;
    for (int unit = blockIdx.x; unit < 1024; unit += F.G) {
        const int b = unit >> 9, kvh = (unit >> 7) & 3, qb = unit & 127;
        const size_t tok0 = (size_t)b * SEQ + (size_t)qb * 128;
        __syncthreads();
#pragma unroll
        for (int i = 0; i < 4; ++i) { const int pc = F.tid + 512 * i, row = pc >> 3, c = pc & 7; const size_t tok = (qb == 0 && row < 128) ? tok0 : tok0 - 128 + row;
            const bf16_t* src = qkv + tok * ODD_IN + 2048 + kvh * 64 + c * 8;
            *(LAS u32x4*)(Ks + row * KP + c * 16) = *(const u32x4*)src; *(LAS u32x4*)(Vs + row * KP + c * 16) = *(const u32x4*)(src + 256); }
        __syncthreads();
        const int hq = kvh * 8 + w; const float sink = sinks[hq];
#pragma unroll 1
        for (int t = 0; t < 4; ++t) {
            bf16_t* qrow = qkv + (tok0 + 32 * t + ql) * ODD_IN + hq * 64;
            bf16x8 Qf[4];
#pragma unroll
            for (int s2 = 0; s2 < 4; ++s2) Qf[s2] = *(const bf16x8*)(qrow + 16 * s2 + 8 * h);
            f32x16 sc[5];
#pragma unroll
            for (int kt = 0; kt < 5; ++kt) {
#pragma unroll
                for (int r = 0; r < 16; ++r) sc[kt][r] = 0.f;
#pragma unroll
                for (int s2 = 0; s2 < 4; ++s2) { const bf16x8 a = *(const LAS bf16x8*)(Ks + (32 * (t + kt) + ql) * KP + (16 * s2 + 8 * h) * 2); sc[kt] = mfma32(a, Qf[s2], sc[kt]); } }
            float m = sink;
#pragma unroll
            for (int kt = 0; kt < 5; ++kt) { const bool tile_ok = !(qb == 0 && t + kt < 4);
#pragma unroll
                for (int r = 0; r < 16; ++r) { const int keyrow = (r & 3) + 8 * (r >> 2) + 4 * h; bool ok = tile_ok; if (kt == 0) ok = ok && (keyrow > ql); if (kt == 4) ok = ok && (keyrow <= ql);
                    const float v = ok ? sc[kt][r] * 0.125f : -1.0e30f; sc[kt][r] = v; m = fmaxf(m, v); } }
            m = fmaxf(m, __shfl_xor(m, 32));
            float l = 0.f;
#pragma unroll
            for (int kt = 0; kt < 5; ++kt)
#pragma unroll
                for (int r = 0; r < 16; ++r) { const float p = exp2f((sc[kt][r] - m) * 1.4426950408889634f); sc[kt][r] = p; l += p; }
            l += __shfl_xor(l, 32);
            l += exp2f((sink - m) * 1.4426950408889634f);
            f32x16 o0, o1;
#pragma unroll
            for (int r = 0; r < 16; ++r) { o0[r] = 0.f; o1[r] = 0.f; }
#pragma unroll
            for (int kt = 0; kt < 5; ++kt)
#pragma unroll
                for (int s2 = 0; s2 < 2; ++s2) { u32x4 pw; pw.x = pkbf(sc[kt][8 * s2], sc[kt][8 * s2 + 1]); pw.y = pkbf(sc[kt][8 * s2 + 2], sc[kt][8 * s2 + 3]); pw.z = pkbf(sc[kt][8 * s2 + 4], sc[kt][8 * s2 + 5]); pw.w = pkbf(sc[kt][8 * s2 + 6], sc[kt][8 * s2 + 7]);
                    const bf16x8 pb = __builtin_bit_cast(bf16x8, pw);
                    const unsigned ra = vs_addr + (unsigned)((32 * (t + kt) + 16 * s2 + 4 * h + q4) * KP + blk * 32 + p4 * 8);
                    const s16x4 a00 = tr_read(ra), a01 = tr_read(ra + 8 * KP), a10 = tr_read(ra + 64), a11 = tr_read(ra + 8 * KP + 64);
                    o0 = mfma32(cat8(a00, a01), pb, o0); o1 = mfma32(cat8(a10, a11), pb, o1); }
            const float il = 1.0f / l;
#pragma unroll
            for (int gq = 0; gq < 4; ++gq) { u32x2 w0, w1; w0.x = pkbf(o0[4 * gq] * il, o0[4 * gq + 1] * il); w0.y = pkbf(o0[4 * gq + 2] * il, o0[4 * gq + 3] * il); w1.x = pkbf(o1[4 * gq] * il, o1[4 * gq + 1] * il); w1.y = pkbf(o1[4 * gq + 2] * il, o1[4 * gq + 3] * il);
                *(u32x2*)(qrow + 8 * gq + 4 * h) = w0; *(u32x2*)(qrow + 32 + 8 * gq + 4 * h) = w1; }
        }
    }
}

struct RouteHandler {
    unsigned* cnt; int* list; float* gw; unsigned* asg; int lane;
    DI void operator()(int m, float res) const {
        float p[36];
#pragma unroll
        for (int j = 0; j < 36; ++j) p[j] = rdlane(res, j);
        int g = 0; float gm = p[0];
#pragma unroll
        for (int j = 1; j < 4; ++j) if (p[j] > gm) { gm = p[j]; g = j; }
        float gs = 0.f;
#pragma unroll
        for (int j = 0; j < 4; ++j) gs += __expf(p[j] - gm);
        const float g_p = 1.0f / gs;
        float q[8];
#pragma unroll
        for (int i = 0; i < 8; ++i) q[i] = g == 0 ? p[4 + i] : (g == 1 ? p[12 + i] : (g == 2 ? p[20 + i] : p[28 + i]));
        int i0 = 0; float m0 = q[0];
#pragma unroll
        for (int i = 1; i < 8; ++i) if (q[i] > m0) { m0 = q[i]; i0 = i; }
        int i1 = -1; float m1 = -3.0e38f;
#pragma unroll
        for (int i = 0; i < 8; ++i) if (i != i0 && q[i] > m1) { m1 = q[i]; i1 = i; }
        const float e1 = __expf(m1 - m0), w0 = g_p / (1.0f + e1), w1 = g_p * e1 / (1.0f + e1);
        if (lane == 0) {
            const int ea = g * 8 + i0, eb = g * 8 + i1;
            const unsigned pa = __hip_atomic_fetch_add(cnt + ea, 1u, __ATOMIC_RELAXED, __HIP_MEMORY_SCOPE_AGENT), pb = __hip_atomic_fetch_add(cnt + eb, 1u, __ATOMIC_RELAXED, __HIP_MEMORY_SCOPE_AGENT);
            list[ea * 65536 + pa] = m; list[eb * 65536 + pb] = m; gw[ea * 65536 + pa] = w0; gw[eb * 65536 + pb] = w1;
            asg[2 * m] = ((unsigned)ea << 16) | pa; asg[2 * m + 1] = ((unsigned)eb << 16) | pb;
        }
    }
};
struct BgHandler {
    float* bg; const float* a_log; const float* dt_bias; int lane;
    DI void operator()(int m, float v) const {
        if (lane < 16) {
            float r;
            if (lane < 8) r = 1.0f / (1.0f + __expf(-v));
            else { const float z = v + dt_bias[lane - 8]; const float sp = z > 20.f ? z : log1pf(__expf(z)); r = -__expf(a_log[lane - 8]) * sp; }
            bg[(size_t)m * 16 + lane] = r; }
    }
};
struct NoHandler { DI void operator()(int, float) const {} };
DI void moe_tables(Frame& F, const unsigned* cntg) {
    LAS int* cnt = (LAS int*)(F.lds + TBL_OFF); LAS int* tb = cnt + 32;
    __syncthreads();
    if (F.tid == 0) { int acc = 0; for (int e = 0; e < 32; ++e) { const int c = (int)__hip_atomic_load(cntg + e, __ATOMIC_RELAXED, __HIP_MEMORY_SCOPE_AGENT); cnt[e] = c; tb[e] = acc; acc += (c + 255) >> 8; } tb[32] = acc; }
    __syncthreads();
}

constexpr int NPH = 19;
#ifndef FAST_GDN
#define FAST_GDN 1
#endif
#ifndef FAST_RET
#define FAST_RET 1
#endif
struct Args { const float* in[20]; float* out; unsigned char* ws; int ph_lo, ph_hi; };
__global__ void __launch_bounds__(NTHR, 2) mk_fwd(Args args) {
    extern __shared__ __attribute__((aligned(16))) unsigned char lds[];
    Frame F;
    F.lds = (LAS unsigned char*)lds; F.tid = threadIdx.x; F.lane = F.tid & 63; F.wave = __builtin_amdgcn_readfirstlane(F.tid >> 6); F.G = gridDim.x;
    F.gw = blockIdx.x * NWAVES + F.wave; F.NGW = F.G * NWAVES; F.ws = args.ws; F.ctl = (unsigned*)(args.ws + WS_CTL);
    volatile LAS unsigned* MISC = (volatile LAS unsigned*)(F.lds + MISC_OFF);
    if (F.tid < 64) MISC[F.tid] = 0u;
    __syncthreads();
    XcdBarrier bar; bar.bar = F.ctl + CW_BAR; bar.x = 0; bar.st = nullptr;
    if (!MK_MULTI) bar = xcd_barrier_post(F.ctl + CW_BAR, MISC + 8);
    const int lo = args.ph_lo, hi = args.ph_hi;
#ifdef ONLY_PH
#define IN(k) ((k) == ONLY_PH && lo <= (k) && (k) < hi)
#else
#define IN(k) (lo <= (k) && (k) < hi)
#endif
#define SEAM(k) do { if (IN(k) && IN((k) + 1)) xcd_barrier(bar); } while (0)
    const float* const* in = args.in;
    float* XC = args.out;
    bf16_t* H = (bf16_t*)(F.ws + WS_H);
    bf16_t* PJ = (bf16_t*)(F.ws + WS_BIG + BIG_PJ);
    unsigned char* aux = F.ws;
    const LAS int* tbl_cnt = (const LAS int*)(F.lds + TBL_OFF); const LAS int* tbl_tb = tbl_cnt + 32;
    LAS unsigned* tokoff = (LAS unsigned*)(F.lds + TOK_OFF);

    enum { P_W = 0, P_N0, P_G0, P_PREP, P_GA, P_SCAN, P_MIX, P_O0, P_M0A, P_M0B, P_M0C, P_N1, P_G1, P_SPREP, P_SWA, P_O1, P_M1A, P_M1B, P_M1C, P_FIN };
    static_assert(P_FIN == NPH, "phase count");
    if (IN(P_W)) { p0_weights(F, in); __syncthreads(); }
    SEAM(P_W);
    if (IN(P_N0)) {
        norm_pass<0, false, false, true>(F, in[0], nullptr, nullptr, nullptr, tbl_tb, in[1], nullptr, H, NoHandler{});
        proj_pass<0>(F, in[0], (const float*)(aux + AUX_SW), (float*)(aux + AUX_BG), in[6], in[7], nullptr, nullptr, nullptr, nullptr);
    }
    SEAM(P_N0);
    if (IN(P_G0)) {
        pg8::DenseOrder S; S.init(NTOK, PJW, D, D, (const bf16_t*)(F.ws + WS_WIN0), F.G, blockIdx.x);
        pg8::EpiBf16 E{PJ, PJW};
        pg8::gemm_phase(F.lds, H, D, S, E);
    }
    SEAM(P_G0);
    if (IN(P_PREP)) p2_prep(F, in[5]);
    SEAM(P_PREP);
    if (IN(P_GA)) {
        for (int u = F.gw; u < 16 * NCH; u += F.NGW) {
            if (FAST_GDN) ga_unit<true>(F, u, (unsigned char*)args.out, nullptr);
            if (FAST_RET) ga_unit<false>(F, u, F.ws + AUX_W, nullptr);
        }
        __syncthreads();
    }
    SEAM(P_GA);
    if (IN(P_SCAN)) {
        if (FAST_GDN || FAST_RET) {
            for (int id = blockIdx.x; id < 256; id += F.G) { const int bh = (id % 8) * 2 + (id / 8) / 16, sl = (id / 8) % 16;
                if (FAST_GDN && F.wave == 0) scan_wave<true>(F, bh, sl, (const unsigned char*)args.out);
                if (FAST_RET && F.wave == 1) scan_wave<false>(F, bh, sl, F.ws + AUX_W); }
            __syncthreads();
        }
#ifndef NO_NAIVE
        if (!FAST_RET && blockIdx.x < 8) p3_recurrence<false>(F, blockIdx.x);
        if (!FAST_GDN && blockIdx.x >= 8 && blockIdx.x < 16) p3_recurrence<true>(F, blockIdx.x - 8);
#endif
        __syncthreads();
    }
    SEAM(P_SCAN);
    if (IN(P_MIX)) p4_mixnorm(F, in[4], in[8]);
    SEAM(P_MIX);
    if (IN(P_O0)) {
        pg8::DenseOrder S; S.init(NTOK, D, 4096, PJW, (const bf16_t*)(F.ws + WS_WOUT0), F.G, blockIdx.x);
        pg8::EpiResF32 E{in[0], XC, D};
        pg8::gemm_phase(F.lds, PJ + C_RG, 4096, S, E);
    }
    SEAM(P_O0);
#define MOE_LAYER(P, L, CNTW)                                                                                                                  \
    if (IN(P)) {                                                            \
        convert_experts(F, in, L);                                                                                                             \
        __syncthreads();                                                                \
        norm_pass<0, false, false, true>(F, XC, nullptr, nullptr, nullptr, tbl_tb, in[2] + L * D, nullptr, H, NoHandler{});                    \
        proj_pass<1>(F, XC, (const float*)(aux + AUX_SW) + 16 * D + L * 48 * D, nullptr, nullptr, nullptr, F.ctl + CNTW, (int*)(aux + AUX_LIST), (float*)(aux + AUX_GW), (unsigned*)(aux + AUX_ASG)); \
        __syncthreads();                                                                                                                       \
    }                                                                                                                                          \
    SEAM(P);                                                                                                                                   \
    if (IN(P + 1)) {                                                                                                \
        moe_tables(F, F.ctl + CNTW);                                                                                                           \
        pg8::MoeOrder<true> S; S.init(tbl_tb, tokoff, 6, D, D, (const bf16_t*)(F.ws + WS_BIG + BIG_EGU), (size_t)1536 * D, F.G, blockIdx.x);   \
        { pg8::Unit u; const int* list = (const int*)(aux + AUX_LIST);                                                                         \
          for (int ui = 0; ui < 12 && S.next(ui, u); ++ui) if (F.tid < 256) { const int idx = (u.pm - tbl_tb[u.e]) * 256 + F.tid;               \
              const int tok = idx < tbl_cnt[u.e] ? list[u.e * 65536 + idx] : 0; tokoff[ui * 256 + F.tid] = (unsigned)tok * (unsigned)(D * 2); } } \
        __syncthreads();                                                                                                                       \
        pg8::EpiSwiglu E{(bf16_t*)(F.ws + WS_BIG + BIG_HID)};                                                                                  \
        pg8::gemm_phase(F.lds, H, D, S, E);                                                                                                    \
    }                                                                                                                                          \
    SEAM(P + 1);                                                                                                                               \
    if (IN(P + 2)) {                                                                                  \
        moe_tables(F, F.ctl + CNTW);                                                                                                           \
        pg8::MoeOrder<false> S; S.init(tbl_tb, tokoff, 8, FF, FF, (const bf16_t*)(F.ws + WS_BIG + BIG_EDN), (size_t)D * FF, F.G, blockIdx.x);  \
        pg8::EpiDown E{(bf16_t*)(F.ws + WS_BIG + BIG_Y), (const float*)(aux + AUX_GW), tbl_tb};                                                \
        pg8::gemm_phase(F.lds, (const bf16_t*)(F.ws + WS_BIG + BIG_HID), FF, S, E);                                                            \
    }                                                                                                                                          \
    SEAM(P + 2);
    MOE_LAYER(P_M0A, 0, CW_CNT0)
    if (IN(P_N1)) {
        moe_tables(F, F.ctl + CW_CNT0);
        norm_pass<0, true, true, true>(F, XC, XC, (const bf16_t*)(F.ws + WS_BIG + BIG_Y), (const unsigned*)(aux + AUX_ASG), tbl_tb, in[1] + D, nullptr, H, NoHandler{});
        __syncthreads();
    }
    SEAM(P_N1);
    if (IN(P_G1)) {
        pg8::DenseOrder S; S.init(NTOK, ODD_IN, D, D, (const bf16_t*)(F.ws + WS_WIN1), F.G, blockIdx.x);
        pg8::EpiBf16 E{(bf16_t*)(F.ws + WS_BIG + BIG_QKV1), ODD_IN};
        pg8::gemm_phase(F.lds, H, D, S, E);
    }
    SEAM(P_G1);
    if (IN(P_SPREP)) p11_swaprep(F, in[11], in[12]);
    SEAM(P_SPREP);
#ifdef SWA_NAIVE
    if (IN(P_SWA)) p12_swa_naive(F, in[13]);
#else
    if (IN(P_SWA)) { swa_phase(F, in[13]); __syncthreads(); }
#endif
    SEAM(P_SWA);
    if (IN(P_O1)) {
        pg8::DenseOrder S; S.init(NTOK, D, D, ODD_IN, (const bf16_t*)(F.ws + WS_WOUT1), F.G, blockIdx.x);
        pg8::EpiResF32 E{XC, XC, D};
        pg8::gemm_phase(F.lds, (const bf16_t*)(F.ws + WS_BIG + BIG_QKV1), D, S, E);
    }
    SEAM(P_O1);
    MOE_LAYER(P_M1A, 1, CW_CNT1)
    if (IN(P_FIN)) {
        moe_tables(F, F.ctl + CW_CNT1);
        norm_pass<0, true, true, false>(F, XC, XC, (const bf16_t*)(F.ws + WS_BIG + BIG_Y), (const unsigned*)(aux + AUX_ASG), tbl_tb, nullptr, nullptr, nullptr, NoHandler{});
    }
#undef IN
#undef SEAM
}

extern "C" void kernel_launch(void* const* d_in, const int* in_sizes, int n_in, void* d_out, int out_size, void* d_ws, size_t ws_size, hipStream_t stream) {
    static int grid = 0;
    if (grid == 0) {
        if (n_in != 20 || in_sizes[0] != NTOK * D || out_size != NTOK * D || ws_size < WS_END) { fprintf(stderr, "kernel_launch: unexpected shapes / workspace (n_in %d, in0 %d, out %d, ws %zu, need %zu)\n", n_in, n_in > 0 ? in_sizes[0] : -1, out_size, ws_size, (size_t)WS_END); grid = -1; return; }
        int dev = 0, cus = 0, per_cu = 0;
        if (hipGetDevice(&dev) != hipSuccess || hipDeviceGetAttribute(&cus, hipDeviceAttributeMultiprocessorCount, dev) != hipSuccess) { grid = -1; return; }
        if (hipFuncSetAttribute((const void*)mk_fwd, hipFuncAttributeMaxDynamicSharedMemorySize, LDS_BYTES) != hipSuccess) { fprintf(stderr, "kernel_launch: hipFuncSetAttribute failed\n"); grid = -1; return; }
        if (hipOccupancyMaxActiveBlocksPerMultiprocessor(&per_cu, (const void*)mk_fwd, NTHR, LDS_BYTES) != hipSuccess || per_cu < 1) fprintf(stderr, "kernel_launch: occupancy query reports %d\n", per_cu);
        (void)hipGetLastError();
        grid = cus;
    }
    if (grid < 0) return;
    (void)hipMemsetAsync((char*)d_ws + WS_CTL, 0, CTL_ZERO_BYTES, stream);
    Args a{};
    for (int i = 0; i < 20; ++i) a.in[i] = (const float*)d_in[i];
    a.out = (float*)d_out; a.ws = (unsigned char*)d_ws;
#if MK_MULTI
    for (int p = 0; p <= NPH; ++p) { a.ph_lo = p; a.ph_hi = p + 1; hipLaunchKernelGGL(mk_fwd, dim3(grid), dim3(NTHR), LDS_BYTES, stream, a); }
#else
    a.ph_lo = 0; a.ph_hi = NPH + 1;
    hipLaunchKernelGGL(mk_fwd, dim3(grid), dim3(NTHR), LDS_BYTES, stream, a);
#endif
}
```

```cpp
#include <hip/hip_runtime.h>
#include <cstdio>
#include <cstdint>

#ifndef MK_MULTI
#define MK_MULTI 0
#endif

#define LAS __attribute__((address_space(3)))
typedef unsigned short bf16_t;
typedef short bf16x8 __attribute__((ext_vector_type(8)));
typedef float f32x4 __attribute__((ext_vector_type(4)));
typedef float f32x2 __attribute__((ext_vector_type(2)));
typedef unsigned u32x4 __attribute__((ext_vector_type(4)));
typedef unsigned u32x2 __attribute__((ext_vector_type(2)));
#define DI __device__ __forceinline__

constexpr int D = 2048, BATCH = 2, SEQ = 16384, NTOK = BATCH * SEQ;
constexpr int EVEN_IN = 12304, PJW = 12288;
constexpr int ODD_IN = 2560;
constexpr int NEXP = 32, FF = 768, TOPK = 2, MAXT = 288;
constexpr float EPS = 1e-6f;
constexpr double ROPE_R = 0.86596432336006535;
constexpr int C_RQ = 0, C_RK = 1024, C_RV = 2048, C_GQKV = 4096, C_RG = 8192, C_GZ = 10240;

constexpr size_t MiB = 1u << 20;
constexpr size_t WS_CTL = 0, CTL_ZERO_BYTES = 1 * MiB;
constexpr size_t WS_WIN0 = 2 * MiB;
constexpr size_t WS_WOUT0 = WS_WIN0 + 48 * MiB;
constexpr size_t WS_WIN1 = WS_WOUT0 + 16 * MiB;
constexpr size_t WS_WOUT1 = WS_WIN1 + 10 * MiB;
constexpr size_t WS_H = 84 * MiB;
constexpr size_t WS_BIG = 212 * MiB;
constexpr size_t WS_AUX = 980 * MiB;
constexpr size_t WS_END = 1492 * MiB;
constexpr size_t BIG_PJ = 0;
constexpr size_t BIG_EGU = 0;
constexpr size_t BIG_EDN = 192 * MiB;
constexpr size_t BIG_HID = 288 * MiB;
constexpr size_t BIG_Y = 400 * MiB;
constexpr size_t BIG_QKV1 = 0;
constexpr size_t AUX_QN = WS_AUX + 0;
constexpr size_t AUX_KN = WS_AUX + 64 * MiB;
constexpr size_t AUX_VC = WS_AUX + 128 * MiB;
constexpr size_t AUX_W = WS_AUX + 256 * MiB;
constexpr size_t AUX_ATT = WS_AUX + 320 * MiB;
constexpr size_t AUX_RST = WS_AUX + 352 * MiB;
constexpr size_t AUX_BG = WS_AUX + 480 * MiB;
constexpr size_t AUX_CS = WS_AUX + 482 * MiB;
constexpr size_t AUX_DEC = WS_AUX + 490 * MiB + 960 * 1024;
constexpr size_t AUX_SW = WS_AUX + 490 * MiB;
constexpr size_t AUX_LIST = WS_AUX + 491 * MiB;
constexpr size_t AUX_GW = WS_AUX + 499 * MiB;
constexpr size_t AUX_ASG = WS_AUX + 507 * MiB;
constexpr size_t AUX_CS32 = WS_AUX + 508 * MiB;
static_assert(AUX_CS32 + 4 * MiB <= WS_END, "aux map");
constexpr int CW_BAR = 4096;
constexpr int CW_CNT0 = 16384, CW_CNT1 = 16384 + 64;

constexpr int RING_BYTES = 131072;
constexpr int GA_LDS_WAVE = 17920;
constexpr int MISC_OFF = 8 * GA_LDS_WAVE;
constexpr int TBL_OFF = MISC_OFF + 256;
constexpr int TOK_OFF = MISC_OFF + 1024;
constexpr int LDS_BYTES = 163840;
static_assert(TOK_OFF + 12 * 1024 <= LDS_BYTES, "lds map");
DI float rdlane(float v, int l) { return __builtin_bit_cast(float, __builtin_amdgcn_readlane(__builtin_bit_cast(int, v), l)); }

DI unsigned f2bf(float f) { unsigned u = __builtin_bit_cast(unsigned, f); return (u + 0x7fffu + ((u >> 16) & 1u)) >> 16; }
DI unsigned pk2(float lo, float hi) { return f2bf(lo) | (f2bf(hi) << 16); }
DI float bflo(unsigned w) { return __builtin_bit_cast(float, w << 16); }
DI float bfhi(unsigned w) { return __builtin_bit_cast(float, w & 0xffff0000u); }
DI float bf2f(bf16_t b) { return __builtin_bit_cast(float, ((unsigned)b) << 16); }
DI unsigned cvt_pk_bf16(float lo, float hi) { unsigned r; asm volatile("v_cvt_pk_bf16_f32 %0, %1, %2" : "=v"(r) : "v"(lo), "v"(hi)); return r; }
DI float wave_sum(float v) {
#pragma unroll
    for (int o = 1; o < 64; o <<= 1) v += __shfl_xor(v, o);
    return v;
}
DI float siluf(float x) { return x / (1.0f + __expf(-x)); }
DI unsigned pk4fp8(float a, float b, float c, float d) { int w = __builtin_amdgcn_cvt_pk_fp8_f32(a, b, 0, false); w = __builtin_amdgcn_cvt_pk_fp8_f32(c, d, w, true); return (unsigned)w; }
typedef __bf16 bf16v2 __attribute__((ext_vector_type(2)));
DI unsigned pkbf(float a, float b) { f32x2 v = {a, b}; return __builtin_bit_cast(unsigned, __builtin_convertvector(v, bf16v2)); }
DI f32x4 mfma16(bf16x8 a, bf16x8 b, f32x4 c) { return __builtin_amdgcn_mfma_f32_16x16x32_bf16(a, b, c, 0, 0, 0); }
#define LDS_WAIT() asm volatile("s_waitcnt lgkmcnt(0)" ::: "memory")
#define VM_WAIT() asm volatile("s_waitcnt vmcnt(0)" ::: "memory")

#define XB_TMO      128
#define XB_XCNT(j)  (256  + 64 * (j))
#define XB_XSUB(j)  (1280 + 64 * (j))
#define XB_XGEN(j)  (2304 + 64 * (j))
#define XB_TOP      3328
#define XB_TOPGEN   3392
#define XCD_BAR_WORDS 3456
#define XB_SPIN_CAP (1u << 22)
DI unsigned xb_ld(unsigned* p)              { return __hip_atomic_load(p, __ATOMIC_RELAXED, __HIP_MEMORY_SCOPE_AGENT); }
DI unsigned xb_add(unsigned* p, unsigned v) { return __hip_atomic_fetch_add(p, v, __ATOMIC_RELAXED, __HIP_MEMORY_SCOPE_AGENT); }
DI unsigned xb_xcc_id() { return (unsigned)__builtin_amdgcn_s_getreg((3 << 11) | 20) & 0xFu; }
#define XB_SPIN(cond, bar) do { unsigned _sp = 0; while (cond) { __builtin_amdgcn_s_sleep(1); \
    if ((++_sp & 255u) == 0u) { if (xb_ld(&(bar)[XB_TMO])) break; if (_sp > XB_SPIN_CAP) { atomicAdd(&(bar)[XB_TMO], 1u); break; } } } } while (0)
struct XcdBarrier { unsigned* bar; unsigned x; volatile LAS unsigned* st; };
DI XcdBarrier xcd_barrier_post(unsigned* bar, volatile LAS unsigned* st) {
    XcdBarrier b; b.bar = bar; b.x = xb_xcc_id(); b.st = st;
    if (threadIdx.x == 0) (void)xb_add(&bar[XB_XCNT(b.x)], 1u);
    return b;
}
DI void xcd_barrier_complete(unsigned* bar, unsigned x, unsigned& nloc, unsigned& nx) {
    const unsigned G = gridDim.x * gridDim.y * gridDim.z;
    unsigned sum, cnt, mine, sp = 0u;
    for (;;) {
        sum = 0u; cnt = 0u; mine = 0u;
#pragma unroll
        for (unsigned j = 0; j < 16; ++j) { const unsigned c = xb_ld(&bar[XB_XCNT(j)]); sum += c; cnt += (c > 0u) ? 1u : 0u; mine = (j == x) ? c : mine; }
        if (sum == G) break;
        __builtin_amdgcn_s_sleep(1);
        if ((++sp & 255u) == 0u) { if (xb_ld(&bar[XB_TMO])) break; if (sp > XB_SPIN_CAP) { atomicAdd(&bar[XB_TMO], 1u); break; } }
    }
    nloc = mine > 0u ? mine : 1u; nx = cnt > 0u ? cnt : 1u;
}
DI void xcd_barrier(const XcdBarrier& b) {
    asm volatile("s_waitcnt vmcnt(0)" ::: "memory");
    __syncthreads();
    if (threadIdx.x == 0) {
        unsigned* bar = b.bar;
        __builtin_amdgcn_s_waitcnt(0);
        unsigned nloc = b.st[0], nx = b.st[1];
        if (nloc == 0u) { xcd_barrier_complete(bar, b.x, nloc, nx); b.st[0] = nloc; b.st[1] = nx; }
        const unsigned old = xb_add(&bar[XB_XSUB(b.x)], 1u);
        const unsigned gen = old / nloc;
        if (old + 1u == (gen + 1u) * nloc) {
            __builtin_amdgcn_fence(__ATOMIC_RELEASE, "agent");
            asm volatile("s_waitcnt vmcnt(0)" ::: "memory");
            const unsigned og = xb_add(&bar[XB_TOP], 1u);
            const unsigned tg = og / nx;
            if (og + 1u == (tg + 1u) * nx) xb_add(&bar[XB_TOPGEN], 1u);
            else XB_SPIN(xb_ld(&bar[XB_TOPGEN]) == tg, bar);
            __builtin_amdgcn_fence(__ATOMIC_ACQUIRE, "agent");
            xb_add(&bar[XB_XGEN(b.x)], 1u);
            asm volatile("s_waitcnt vmcnt(0)" ::: "memory");
        } else {
            XB_SPIN(xb_ld(&bar[XB_XGEN(b.x)]) == gen, bar);
            __builtin_amdgcn_fence(__ATOMIC_ACQUIRE, "agent");
            asm volatile("s_waitcnt vmcnt(0)" ::: "memory");
        }
    }
    __syncthreads();
}

namespace pg8 {
constexpr int BM = 256, BK = 64, HALF = 128, HTB = HALF * BK * 2, STAGE_BYTES = 8 * HTB, NXCD = 8, WGM = 8;
__host__ __device__ __forceinline__ int lds_byte(int r, int c) { const int st = (r >> 4) * 2 + (c >> 5), rr = r & 15, cc = c & 31, ob = rr * 64 + cc * 2; return st * 1024 + (ob ^ (((ob >> 9) & 1) << 5)); }
__host__ __device__ __forceinline__ void stage_rc(int b, int& R, int& C) { const int st = b / 1024, sb = b % 1024, swz = sb ^ (((sb >> 9) & 1) << 5); R = (st >> 1) * 16 + swz / 64; C = (st & 1) * 32 + (swz % 64) / 2; }
__host__ __device__ __forceinline__ int perm32(int rho) { const int n = rho >> 4, i = rho & 15; return 8 * (i >> 2) + 4 * n + (i & 3); }

struct Unit { int pm, pn, e, slot; };

DI int xcd_remap(int L, int nwg) { const int q = nwg / NXCD, r = nwg % NXCD, xcd = L % NXCD, off = L / NXCD; return (xcd < r ? xcd * (q + 1) : r * (q + 1) + (xcd - r) * q) + off; }

struct DenseOrder {
    int nM, nN, nwg, G, c; unsigned lda2; const char* Bt; size_t tstepB;
    DI void init(int M, int N, int K, int lda, const void* Bt_, int G_, int c_, int EB = 2) { nM = M / BM; nN = N / BM; nwg = nM * nN; G = G_; c = c_; lda2 = (unsigned)(lda * EB); Bt = (const char*)Bt_; tstepB = (size_t)BM * K * EB; }
    DI bool next(int i, Unit& u) const {
        const long L = (long)i * G + c; if (L >= nwg) return false;
        const int wgid = xcd_remap((int)L, nwg);
        const int nig = WGM * nN, gid = wgid / nig, fm = gid * WGM, gsz = (nM - fm) < WGM ? (nM - fm) : WGM;
        u.pm = fm + ((wgid % nig) % gsz); u.pn = (wgid % nig) / gsz; u.e = 0; u.slot = i; return true;
    }
    DI unsigned a_off(const Unit& u, int h, int R) const { return (unsigned)(u.pm * BM + h * HALF + R) * lda2; }
    DI const char* b_base(const Unit& u) const { return Bt + (size_t)u.pn * tstepB; }
};
template <bool GATHER> struct MoeOrder {
    const LAS int* tb; const LAS unsigned* tokoff; int NT, nwg, G, c; unsigned lda2; const char* Bt; size_t estepB, tstepB;
    DI void init(const LAS int* tb_, const LAS unsigned* tokoff_, int NT_, int K, int lda, const void* Bt_, size_t estep_elems, int G_, int c_, int EB = 2) {
        tb = tb_; tokoff = tokoff_; NT = NT_; nwg = tb_[32] * NT_; G = G_; c = c_; lda2 = (unsigned)(lda * EB); Bt = (const char*)Bt_; estepB = estep_elems * EB; tstepB = (size_t)BM * K * EB; }
    DI bool next(int i, Unit& u) const {
        const long L = (long)i * G + c; if (L >= nwg) return false;
        const int w = xcd_remap((int)L, nwg);
        int e = 0;
#pragma unroll 1
        for (int s = 16; s >= 1; s >>= 1) if (tb[e + s] * NT <= w) e += s;
        const int nt = tb[e + 1] - tb[e], local = w - tb[e] * NT;
        u.e = e; u.pn = local / nt; u.pm = tb[e] + local % nt; u.slot = i; return true;
    }
    DI unsigned a_off(const Unit& u, int h, int R) const { if (GATHER) return tokoff[u.slot * 256 + h * HALF + R]; return (unsigned)(u.pm * BM + h * HALF + R) * lda2; }
    DI const char* b_base(const Unit& u) const { return Bt + (size_t)u.e * estepB + (size_t)u.pn * tstepB; }
};

struct EpiBf16 {
    static constexpr bool PERM = true;
    bf16_t* O; int ldc;
    DI void operator()(const f32x4 (&acc)[2][2][4][2], const Unit& u, int wr, int wc, int fr, int fq) const {
        const int row0 = u.pm * BM + wr * 64 + fr, col0 = u.pn * BM + wc * 32 + 8 * fq;
#pragma unroll
        for (int ai = 0; ai < 2; ++ai)
#pragma unroll
            for (int m = 0; m < 4; ++m) { bf16_t* rowp = O + (size_t)(row0 + ai * HALF + m * 16) * ldc + col0;
#pragma unroll
                for (int bj = 0; bj < 2; ++bj) { const f32x4 v0 = acc[ai][bj][m][0], v1 = acc[ai][bj][m][1];
                    u32x4 w; w.x = cvt_pk_bf16(v0[0], v0[1]); w.y = cvt_pk_bf16(v0[2], v0[3]); w.z = cvt_pk_bf16(v1[0], v1[1]); w.w = cvt_pk_bf16(v1[2], v1[3]);
                    *(u32x4*)(rowp + bj * HALF) = w; } }
    }
};
struct EpiResF32 {
    static constexpr bool PERM = false;
    const float* base; float* out; int ldc;
    DI void operator()(const f32x4 (&acc)[2][2][4][2], const Unit& u, int wr, int wc, int fr, int fq) const {
        const int row0 = u.pm * BM + wr * 64 + fr, col0 = u.pn * BM + wc * 32 + 4 * fq;
#pragma unroll
        for (int ai = 0; ai < 2; ++ai)
#pragma unroll
            for (int m = 0; m < 4; ++m) { const size_t off = (size_t)(row0 + ai * HALF + m * 16) * ldc + col0;
#pragma unroll
                for (int bj = 0; bj < 2; ++bj)
#pragma unroll
                    for (int n = 0; n < 2; ++n) { const f32x4 bs = *(const f32x4*)(base + off + bj * HALF + n * 16); *(f32x4*)(out + off + bj * HALF + n * 16) = bs + acc[ai][bj][m][n]; }
                asm volatile("" ::: "memory"); }
    }
};
struct EpiSwiglu {
    static constexpr bool PERM = true;
    bf16_t* O;
    DI void operator()(const f32x4 (&acc)[2][2][4][2], const Unit& u, int wr, int wc, int fr, int fq) const {
        const int row0 = u.pm * BM + wr * 64 + fr, col0 = u.pn * HALF + wc * 32 + 8 * fq;
#pragma unroll
        for (int ai = 0; ai < 2; ++ai)
#pragma unroll
            for (int m = 0; m < 4; ++m) { bf16_t* rowp = O + (size_t)(row0 + ai * HALF + m * 16) * FF + col0;
                float h[8];
#pragma unroll
                for (int n = 0; n < 2; ++n)
#pragma unroll
                    for (int j = 0; j < 4; ++j) { const float g = acc[ai][0][m][n][j], up = acc[ai][1][m][n][j]; h[n * 4 + j] = g / (1.0f + __expf(-g)) * up; }
                u32x4 w; w.x = cvt_pk_bf16(h[0], h[1]); w.y = cvt_pk_bf16(h[2], h[3]); w.z = cvt_pk_bf16(h[4], h[5]); w.w = cvt_pk_bf16(h[6], h[7]);
                *(u32x4*)rowp = w; }
    }
};
struct EpiSwiglu8 {
    static constexpr bool PERM = true;
    unsigned char* O;
    DI void operator()(const f32x4 (&acc)[2][2][4][2], const Unit& u, int wr, int wc, int fr, int fq) const {
        const int row0 = u.pm * BM + wr * 64 + fr, col0 = u.pn * HALF + wc * 32 + 8 * fq;
#pragma unroll
        for (int ai = 0; ai < 2; ++ai)
#pragma unroll
            for (int m = 0; m < 4; ++m) { unsigned char* rowp = O + (size_t)(row0 + ai * HALF + m * 16) * FF + col0;
                float h[8];
#pragma unroll
                for (int n = 0; n < 2; ++n)
#pragma unroll
                    for (int j = 0; j < 4; ++j) { const float g = acc[ai][0][m][n][j], up = acc[ai][1][m][n][j]; h[n * 4 + j] = g / (1.0f + __expf(-g)) * up * 8.0f; }
                u32x2 w; w.x = pk4fp8(h[0], h[1], h[2], h[3]); w.y = pk4fp8(h[4], h[5], h[6], h[7]);
                *(u32x2*)rowp = w; }
    }
};
struct EpiDown {
    static constexpr bool PERM = true;
    bf16_t* O; const float* gw; const LAS int* tb;
    DI void operator()(const f32x4 (&acc)[2][2][4][2], const Unit& u, int wr, int wc, int fr, int fq) const {
        const int row0 = u.pm * BM + wr * 64 + fr, col0 = u.pn * BM + wc * 32 + 8 * fq;
        const int lrow0 = (u.pm - tb[u.e]) * BM + wr * 64 + fr;
        const float* gwe = gw + (size_t)u.e * 65536;
#pragma unroll
        for (int ai = 0; ai < 2; ++ai)
#pragma unroll
            for (int m = 0; m < 4; ++m) { unsigned char* rowp = (unsigned char*)O + (size_t)(row0 + ai * HALF + m * 16) * D + col0; const float g = gwe[lrow0 + ai * HALF + m * 16] * 16.0f;
#pragma unroll
                for (int bj = 0; bj < 2; ++bj) { const f32x4 v0 = acc[ai][bj][m][0] * g, v1 = acc[ai][bj][m][1] * g;
                    u32x2 w; w.x = pk4fp8(v0[0], v0[1], v0[2], v0[3]); w.y = pk4fp8(v1[0], v1[1], v1[2], v1[3]);
                    *(u32x2*)(rowp + bj * HALF) = w; } }
    }
};

typedef int v8i __attribute__((ext_vector_type(8)));
typedef int v4i __attribute__((ext_vector_type(4)));
template <class Epi, class Sched, bool FP8 = false, int SCW = 0x7f7f7f7f, int SCA = 0x7f7f7f7f>
DI void gemm_phase(LAS unsigned char* lds, const void* Aptr, int K, const Sched& S, const Epi& E) {
    constexpr int EB = FP8 ? 1 : 2;
    const int tid = threadIdx.x, wid = __builtin_amdgcn_readfirstlane(tid >> 6), lane = tid & 63, wr = wid >> 2, wc = wid & 3, fr = lane & 15, fq = lane >> 4;
    const int nt = K * EB / (BK * 2);
    const char* Ab = (const char*)Aptr;
    int Rr[2], Cc[2]; unsigned voffB[2];
#pragma unroll
    for (int i = 0; i < 2; ++i) { int R, C; stage_rc(tid * 16 + i * 8192, R, C); const int Rb = Epi::PERM ? ((R & ~31) + perm32(R & 31)) : R; Rr[i] = R; Cc[i] = C * 2; voffB[i] = (unsigned)(Rb * K * EB + C * 2); }
    const unsigned kstep = (unsigned)(BK * 2);
    const size_t hstepB = (size_t)HALF * K * EB;
    const unsigned ldsw = (unsigned)wid * 1024u;
    const int aoff = lds_byte(wr * 64 + fr, fq * (FP8 ? 16 : 8)), boff = lds_byte(wc * 32 + fr, fq * (FP8 ? 16 : 8));
#define PG8_SA(b, h) (((b) * 2 + (h)) * HTB)
#define PG8_SB(b, h) ((4 + (b) * 2 + (h)) * HTB)
#define PG8_STAGEB(bufoff, gbase) do { _Pragma("unroll") for (int _i = 0; _i < 2; ++_i) \
        __builtin_amdgcn_global_load_lds((const unsigned*)((const char*)(gbase) + voffB[_i]), (LAS unsigned*)(lds + (bufoff) + ldsw + _i * 8192), 16, 0, 0); } while (0)
#define PG8_STAGEA(bufoff, offs, kb) do { _Pragma("unroll") for (int _i = 0; _i < 2; ++_i) \
        __builtin_amdgcn_global_load_lds((const unsigned*)(Ab + (size_t)((offs)[_i] + (kb))), (LAS unsigned*)(lds + (bufoff) + ldsw + _i * 8192), 16, 0, 0); } while (0)
#define PG8_LDA(dst, b, h) do { _Pragma("unroll") for (int m = 0; m < 4; ++m) { if constexpr (FP8) { dst##8[m] = *(const LAS v8i*)(lds + PG8_SA(b, h) + aoff + m * 2048); } \
        else { _Pragma("unroll") for (int k = 0; k < 2; ++k) dst[m][k] = *(const LAS bf16x8*)(lds + PG8_SA(b, h) + aoff + m * 2048 + k * 1024); } } } while (0)
#define PG8_LDB(dst, b, h) do { _Pragma("unroll") for (int n = 0; n < 2; ++n) { if constexpr (FP8) { dst##8[n] = *(const LAS v8i*)(lds + PG8_SB(b, h) + boff + n * 2048); } \
        else { _Pragma("unroll") for (int k = 0; k < 2; ++k) dst[n][k] = *(const LAS bf16x8*)(lds + PG8_SB(b, h) + boff + n * 2048 + k * 1024); } } } while (0)
#define PG8_MMA(ai, bj, At, Bt) do { __builtin_amdgcn_s_setprio(1); _Pragma("unroll") for (int m = 0; m < 4; ++m) _Pragma("unroll") for (int n = 0; n < 2; ++n) { \
        if constexpr (FP8) asm volatile("v_mfma_scale_f32_16x16x128_f8f6f4 %0, %1, %2, %0, %3, %4 op_sel_hi:[0,0,0]" : "+v"(acc[ai][bj][m][n]) : "v"(Bt##8[n]), "v"(At##8[m]), "v"(scw_), "v"(sca_)); \
        else { _Pragma("unroll") for (int k = 0; k < 2; ++k) acc[ai][bj][m][n] = __builtin_amdgcn_mfma_f32_16x16x32_bf16(Bt[n][k], At[m][k], acc[ai][bj][m][n], 0, 0, 0); } } __builtin_amdgcn_s_setprio(0); } while (0)
#define PG8_WAIT_V(n) asm volatile("s_waitcnt vmcnt(" #n ")" ::: "memory")
#define PG8_WAIT_L(n) asm volatile("s_waitcnt lgkmcnt(" #n ")" ::: "memory")
#define PG8_BAR __builtin_amdgcn_s_barrier()
#define PG8_SCHED __builtin_amdgcn_sched_barrier(0)
    Unit cur, nxt; int ui = 0;
    if (!S.next(0, cur)) return;
    f32x4 acc[2][2][4][2];
#pragma unroll
    for (int a = 0; a < 2; ++a)
#pragma unroll
        for (int b = 0; b < 2; ++b)
#pragma unroll
            for (int m = 0; m < 4; ++m)
#pragma unroll
                for (int n = 0; n < 2; ++n) acc[a][b][m][n] = (f32x4){0.f, 0.f, 0.f, 0.f};
    const int scw_ = SCW, sca_ = SCA; (void)scw_; (void)sca_;
    bf16x8 At[4][2], B0[2][2], B1[2][2]; v8i At8[4], B08[2], B18[2]; (void)At; (void)B0; (void)B1; (void)At8; (void)B08; (void)B18;
    unsigned ao[2][2];
#pragma unroll
    for (int h = 0; h < 2; ++h)
#pragma unroll
        for (int i = 0; i < 2; ++i) ao[h][i] = S.a_off(cur, h, Rr[i]) + (unsigned)Cc[i];
    const char* cB = S.b_base(cur);
    PG8_STAGEB(PG8_SB(0, 0), cB); PG8_STAGEB(PG8_SB(0, 1), cB + hstepB); PG8_STAGEA(PG8_SA(0, 0), ao[0], 0u); PG8_STAGEA(PG8_SA(0, 1), ao[1], 0u);
    if (wr == 1) PG8_BAR;
    PG8_WAIT_V(2); PG8_BAR;
    PG8_STAGEB(PG8_SB(1, 0), cB + kstep); PG8_STAGEA(PG8_SA(1, 0), ao[0], kstep); PG8_STAGEB(PG8_SB(1, 1), cB + hstepB + kstep);
    PG8_WAIT_V(6); PG8_BAR;
    for (;;) {
        const bool has_next = S.next(ui + 1, nxt);
        const char* nB = has_next ? S.b_base(nxt) : cB;
#pragma unroll 1
        for (int t = 0; t < nt; t += 2) {
            const bool last = (t == nt - 2);
            const unsigned kb1 = (unsigned)(t + 1) * kstep, kb2 = (unsigned)(t + 2) * kstep;
            unsigned x2[2][2];
#pragma unroll
            for (int h = 0; h < 2; ++h)
#pragma unroll
                for (int i = 0; i < 2; ++i) x2[h][i] = last ? (has_next ? (S.a_off(nxt, h, Rr[i]) + (unsigned)Cc[i]) : ao[h][i]) : ao[h][i] + kb2;
            const char* b2 = last ? nB : cB + kb2; const char* b3 = b2 + kstep;
            PG8_LDB(B0, 0, 0); PG8_LDB(B1, 0, 1); PG8_SCHED; PG8_LDA(At, 0, 0); PG8_STAGEA(PG8_SA(1, 1), ao[1], kb1);
            PG8_WAIT_V(8); PG8_WAIT_L(0); PG8_BAR; PG8_MMA(0, 0, At, B0); PG8_MMA(0, 1, At, B1); PG8_BAR; PG8_SCHED;
            PG8_LDA(At, 0, 1); PG8_STAGEB(PG8_SB(0, 0), b2); PG8_STAGEB(PG8_SB(0, 1), b2 + hstepB); PG8_STAGEA(PG8_SA(0, 0), x2[0], 0u);
            PG8_WAIT_V(8); PG8_WAIT_L(0); PG8_BAR; PG8_MMA(1, 0, At, B0); PG8_MMA(1, 1, At, B1); PG8_BAR; PG8_SCHED;
            PG8_LDB(B0, 1, 0); PG8_LDB(B1, 1, 1); PG8_SCHED; PG8_LDA(At, 1, 0); PG8_STAGEA(PG8_SA(0, 1), x2[1], 0u);
            PG8_WAIT_V(8); PG8_WAIT_L(0); PG8_BAR; PG8_MMA(0, 0, At, B0); PG8_MMA(0, 1, At, B1); PG8_BAR; PG8_SCHED;
            PG8_LDA(At, 1, 1); PG8_STAGEB(PG8_SB(1, 0), b3); PG8_STAGEB(PG8_SB(1, 1), b3 + hstepB); PG8_STAGEA(PG8_SA(1, 0), x2[0], kstep);
            PG8_WAIT_V(8); PG8_WAIT_L(0); PG8_BAR; PG8_MMA(1, 0, At, B0); PG8_MMA(1, 1, At, B1); PG8_BAR; PG8_SCHED;
        }
        if (wr == 0) PG8_BAR;
        if constexpr (FP8) asm volatile("s_nop 15" ::: "memory");
        E(acc, cur, wr, wc, fr, fq);
        if (!has_next) break;
#pragma unroll
        for (int a = 0; a < 2; ++a)
#pragma unroll
            for (int b = 0; b < 2; ++b)
#pragma unroll
                for (int m = 0; m < 4; ++m)
#pragma unroll
                    for (int n = 0; n < 2; ++n) acc[a][b][m][n] = (f32x4){0.f, 0.f, 0.f, 0.f};
        cur = nxt; cB = nB; ++ui;
#pragma unroll
        for (int h = 0; h < 2; ++h)
#pragma unroll
            for (int i = 0; i < 2; ++i) ao[h][i] = S.a_off(cur, h, Rr[i]) + (unsigned)Cc[i];
        if (wr == 1) PG8_BAR;
    }
    PG8_WAIT_V(0);
    PG8_BAR;
#undef PG8_SA
#undef PG8_SB
#undef PG8_STAGEA
#undef PG8_STAGEB
#undef PG8_LDA
#undef PG8_LDB
#undef PG8_MMA
#undef PG8_WAIT_V
#undef PG8_WAIT_L
#undef PG8_BAR
#undef PG8_SCHED
}
}

constexpr int NWAVES = 8, NTHR = 512;
struct Frame {
    LAS unsigned char* lds;
    int tid, lane, wave, G, gw, NGW;
    unsigned* ctl;
    unsigned char* ws;
};

DI void transpose_item(const float* Wseg, int ldw, int ncols, int K, bf16_t* WT, int row_off, LAS float* scr, int item, int lane) {
    const int nblk = ncols / 32, kb = item / nblk, nb = item % nblk, k0 = 64 * kb, n0 = 32 * nb;
#pragma unroll 8
    for (int i = 0; i < 32; ++i) { const int kk = 2 * i + (lane >> 5); scr[kk * 33 + (lane & 31)] = Wseg[(size_t)(k0 + kk) * ldw + n0 + (lane & 31)]; }
    LDS_WAIT(); asm volatile("" ::: "memory");
    const int c = lane & 7;
#pragma unroll
    for (int j = 0; j < 4; ++j) { const int n = (lane >> 3) + 8 * j; const LAS float* s = scr + (8 * c) * 33 + n;
        u32x4 o; o.x = pk2(s[0 * 33], s[1 * 33]); o.y = pk2(s[2 * 33], s[3 * 33]); o.z = pk2(s[4 * 33], s[5 * 33]); o.w = pk2(s[6 * 33], s[7 * 33]);
        *(u32x4*)(WT + (size_t)(row_off + n0 + n) * K + k0 + 8 * c) = o; }
    LDS_WAIT(); asm volatile("" ::: "memory");
}

DI void transpose_item8(const float* Wseg, int ldw, int ncols, int K, unsigned char* WT, int row_off, LAS float* scr, int item, int lane, float qs) {
    const int nblk = ncols / 32, kb = item / nblk, nb = item % nblk, k0 = 64 * kb, n0 = 32 * nb;
#pragma unroll 8
    for (int i = 0; i < 32; ++i) { const int kk = 2 * i + (lane >> 5); scr[kk * 33 + (lane & 31)] = Wseg[(size_t)(k0 + kk) * ldw + n0 + (lane & 31)] * qs; }
    LDS_WAIT(); asm volatile("" ::: "memory");
    const int n = lane >> 1, hf = lane & 1; const LAS float* sp = scr + (32 * hf) * 33 + n;
    u32x4 o0, o1;
    o0.x = pk4fp8(sp[0 * 33], sp[1 * 33], sp[2 * 33], sp[3 * 33]); o0.y = pk4fp8(sp[4 * 33], sp[5 * 33], sp[6 * 33], sp[7 * 33]); o0.z = pk4fp8(sp[8 * 33], sp[9 * 33], sp[10 * 33], sp[11 * 33]); o0.w = pk4fp8(sp[12 * 33], sp[13 * 33], sp[14 * 33], sp[15 * 33]);
    o1.x = pk4fp8(sp[16 * 33], sp[17 * 33], sp[18 * 33], sp[19 * 33]); o1.y = pk4fp8(sp[20 * 33], sp[21 * 33], sp[22 * 33], sp[23 * 33]); o1.z = pk4fp8(sp[24 * 33], sp[25 * 33], sp[26 * 33], sp[27 * 33]); o1.w = pk4fp8(sp[28 * 33], sp[29 * 33], sp[30 * 33], sp[31 * 33]);
    unsigned char* dst = WT + (size_t)(row_off + n0 + n) * K + k0 + 32 * hf;
    *(u32x4*)dst = o0; *(u32x4*)(dst + 16) = o1;
    LDS_WAIT(); asm volatile("" ::: "memory");
}
DI void p0_weights(Frame& F, const float* const* in) {
    LAS float* scr = (LAS float*)(F.lds + F.wave * 16384);
    bf16_t* win0 = (bf16_t*)(F.ws + WS_WIN0); bf16_t* wout0 = (bf16_t*)(F.ws + WS_WOUT0); bf16_t* win1 = (bf16_t*)(F.ws + WS_WIN1); bf16_t* wout1 = (bf16_t*)(F.ws + WS_WOUT1);
    const float* ewin = in[3]; const float* ewout = in[9]; const float* owin = in[10]; const float* owout = in[14];
    constexpr int KB = D / 64;
    constexpr int I_A = KB * (4096 / 32), I_B = KB * (4096 / 32), I_C = KB * (2048 / 32), I_D = KB * (2048 / 32);
    constexpr int I_O0 = (4096 / 64) * (D / 32), I_I1 = KB * (ODD_IN / 32), I_O1 = KB * (D / 32);
    constexpr int NIT = I_A + I_B + I_C + I_D + I_O0 + I_I1 + I_O1;
    for (int it = F.gw; it < NIT; it += F.NGW) {
        int r = it;
        if (r < I_A) { transpose_item(ewin + 0, EVEN_IN, 4096, D, win0, 0, scr, r, F.lane); continue; } r -= I_A;
        if (r < I_B) { transpose_item(ewin + 6144, EVEN_IN, 4096, D, win0, C_GQKV, scr, r, F.lane); continue; } r -= I_B;
        if (r < I_C) { transpose_item(ewin + 4096, EVEN_IN, 2048, D, win0, C_RG, scr, r, F.lane); continue; } r -= I_C;
        if (r < I_D) { transpose_item(ewin + 10240, EVEN_IN, 2048, D, win0, C_GZ, scr, r, F.lane); continue; } r -= I_D;
        if (r < I_O0) { transpose_item(ewout, D, D, 4096, wout0, 0, scr, r, F.lane); continue; } r -= I_O0;
        if (r < I_I1) { transpose_item8(owin, ODD_IN, ODD_IN, D, (unsigned char*)win1, 0, scr, r, F.lane, 32.f); continue; } r -= I_I1;
        transpose_item8(owout, D, D, D, (unsigned char*)wout1, 0, scr, r, F.lane, 32.f);
    }
    bf16_t* swh = (bf16_t*)(F.ws + AUX_SW); bf16_t* swl = swh + 112 * D;
    const int gt = (F.gw * 64 + F.lane), NGT = F.NGW * 64;
    for (int i = gt; i < 112 * D; i += NGT) { const int c = i / D, k = i % D; float v;
        if (c < 16) v = ewin[(size_t)k * EVEN_IN + 12288 + c] * in[1][k];
        else { const int l = (c - 16) / 48, cc = (c - 16) % 48; const float gn = in[2][l * D + k]; v = cc < 4 ? in[15][(size_t)l * D * 4 + k * 4 + cc] * gn : (cc < 36 ? in[16][(size_t)l * D * 32 + k * 32 + (cc - 4)] * gn : 0.f); }
        const unsigned hb = f2bf(v); const float lo = v - __builtin_bit_cast(float, hb << 16); swh[i] = (bf16_t)hb; swl[i] = (bf16_t)f2bf(lo); }
    f32x2* cs = (f32x2*)(F.ws + AUX_CS);
    for (int i = gt; i < SEQ * 64; i += NGT) { const int pos = i >> 6, fi = i & 63; double inv = 1.0;
        for (int q = 0; q < fi; ++q) inv *= ROPE_R;
        const double x = (double)pos * inv, k = __builtin_rint(x * 0.15915494309189535), r = (x - k * 6.283185307179586) - k * 2.4492935982947064e-16;
        const float rf = (float)r; const f32x2 v = {cosf(rf), sinf(rf)}; cs[i] = v; if ((fi & 1) == 0) ((f32x2*)(F.ws + AUX_CS32))[pos * 32 + (fi >> 1)] = v; }
}
DI void convert_experts(Frame& F, const float* const* in, int l) {
    LAS float* scr = (LAS float*)(F.lds + F.wave * 16384);
    const float* wg = in[17] + (size_t)l * NEXP * D * FF; const float* wu = in[18] + (size_t)l * NEXP * D * FF; const float* wd = in[19] + (size_t)l * NEXP * FF * D;
    unsigned char* gu = F.ws + WS_BIG + BIG_EGU; unsigned char* dn = F.ws + WS_BIG + BIG_EDN;
    constexpr int I_G = (D / 64) * (128 / 32);
    constexpr int I_GU = NEXP * 6 * 2 * I_G;
    constexpr int I_DE = (FF / 64) * (D / 32);
    constexpr int NIT = I_GU + NEXP * I_DE;
    for (int it = F.gw; it < NIT; it += F.NGW) {
        if (it < I_GU) { const int seg = it / I_G, r = it % I_G, e = seg / 12, s = seg % 12, pn = s >> 1, isup = s & 1;
            const float* src = (isup ? wu : wg) + (size_t)e * D * FF + pn * 128;
            transpose_item8(src, FF, 128, D, gu + (size_t)e * 1536 * D, pn * 256 + isup * 128, scr, r, F.lane, 64.f); }
        else { const int r2 = it - I_GU, e = r2 / I_DE, r = r2 % I_DE;
            transpose_item8(wd + (size_t)e * FF * D, D, D, FF, dn + (size_t)e * D * FF, 0, scr, r, F.lane, 32.f); }
    }
}

template <int NP, bool ADDY, bool WRITEX, bool WRITEH, class Handler, bool H8 = false>
DI void norm_pass(Frame& F, const float* src, float* dst, const bf16_t* y, const unsigned* asg, const LAS int* tb, const float* gain, const float* Wt, bf16_t* H, Handler hnd) {
    for (int m = F.gw; m < NTOK; m += F.NGW) {
        const f32x4* xr = (const f32x4*)(src + (size_t)m * D) + F.lane;
        f32x4 v[8];
#pragma unroll
        for (int j = 0; j < 8; ++j) v[j] = xr[64 * j];
        if (ADDY) {
            const unsigned a0 = asg[2 * m], a1 = asg[2 * m + 1];
            const size_t r0 = (size_t)tb[a0 >> 16] * 256 + (a0 & 0xffffu), r1 = (size_t)tb[a1 >> 16] * 256 + (a1 & 0xffffu);
            const unsigned* y0 = (const unsigned*)((const unsigned char*)y + r0 * D) + F.lane; const unsigned* y1 = (const unsigned*)((const unsigned char*)y + r1 * D) + F.lane;
#pragma unroll
            for (int j = 0; j < 8; ++j) { const int p = (int)y0[64 * j], q = (int)y1[64 * j];
                v[j].x += (__builtin_amdgcn_cvt_f32_fp8(p, 0) + __builtin_amdgcn_cvt_f32_fp8(q, 0)) * 0.0625f; v[j].y += (__builtin_amdgcn_cvt_f32_fp8(p, 1) + __builtin_amdgcn_cvt_f32_fp8(q, 1)) * 0.0625f;
                v[j].z += (__builtin_amdgcn_cvt_f32_fp8(p, 2) + __builtin_amdgcn_cvt_f32_fp8(q, 2)) * 0.0625f; v[j].w += (__builtin_amdgcn_cvt_f32_fp8(p, 3) + __builtin_amdgcn_cvt_f32_fp8(q, 3)) * 0.0625f; }
        }
        if (WRITEX) { f32x4* xo = (f32x4*)(dst + (size_t)m * D) + F.lane;
#pragma unroll
            for (int j = 0; j < 8; ++j) xo[64 * j] = v[j]; }
        if (WRITEH) {
            float s = 0.f;
#pragma unroll
            for (int j = 0; j < 8; ++j) s += (v[j].x * v[j].x + v[j].y * v[j].y) + (v[j].z * v[j].z + v[j].w * v[j].w);
            const float rstd = 1.0f / sqrtf(wave_sum(s) * (1.0f / D) + EPS);
            const f32x4* gr = (const f32x4*)gain + F.lane;
#pragma unroll
            for (int j = 0; j < 8; ++j) v[j] = v[j] * rstd * gr[64 * j];
            if (H8) { unsigned* ho8 = (unsigned*)((unsigned char*)H + (size_t)m * D) + F.lane;
#pragma unroll
                for (int j = 0; j < 8; ++j) ho8[64 * j] = pk4fp8(v[j].x * 4.f, v[j].y * 4.f, v[j].z * 4.f, v[j].w * 4.f); }
            else {
            u32x2* ho = (u32x2*)(H + (size_t)m * D) + F.lane;
#pragma unroll
            for (int j = 0; j < 8; ++j) { u32x2 w; w.x = pk2(v[j].x, v[j].y); w.y = pk2(v[j].z, v[j].w); ho[64 * j] = w; } }
            if constexpr (NP > 0) {
                float res = 0.f;
#pragma unroll 1
                for (int c0 = 0; c0 < NP; c0 += 4) {
                    float a[4];
#pragma unroll
                    for (int cc = 0; cc < 4; ++cc) { const f32x4* wr = (const f32x4*)(Wt + (size_t)(c0 + cc) * D) + F.lane; a[cc] = 0.f;
#pragma unroll
                        for (int j = 0; j < 8; ++j) { const f32x4 w = wr[64 * j]; a[cc] += (v[j].x * w.x + v[j].y * w.y) + (v[j].z * w.z + v[j].w * w.w); } }
#pragma unroll
                    for (int cc = 0; cc < 4; ++cc) { const float t = wave_sum(a[cc]); res = (F.lane == c0 + cc) ? t : res; }
                }
                hnd(m, res);
            }
        }
    }
}


typedef f32x4 XTile[8][2];
template <int MODE>
DI void normproj_tile(Frame& F, const XTile& xr, int tile, int tl, int par, const float* gain, const bf16_t* Wh, const bf16_t* Wl, bf16_t* H, float* bg, const float* a_log, const float* dt_bias) {
    constexpr int NT = MODE == 0 ? 1 : 3;
    int lane_o = F.lane; asm volatile("" : "+v"(lane_o));
    const int lane = lane_o, r = lane & 15, kq = lane >> 4, w = F.wave;
    LAS float* ssp = (LAS float*)(F.lds + par * 32768);
    LAS f32x4* lp = (LAS f32x4*)(F.lds + par * 32768 + 1024);
    LAS float* lg = (LAS float*)(F.lds + par * 32768 + 1024 + 24576);
    LAS f32x4* sel = (LAS f32x4*)(F.lds + 65536);
    const size_t tok0 = (size_t)tile * 16;
    f32x4 acc[NT];
#pragma unroll
    for (int nt = 0; nt < NT; ++nt) acc[nt] = (f32x4){0.f, 0.f, 0.f, 0.f};
    float ss = 0.f;
#pragma unroll
    for (int i = 0; i < 8; ++i) { const f32x4 xa = xr[i][0], xb = xr[i][1]; asm volatile("" ::: "memory");
        ss += ((xa.x * xa.x + xa.y * xa.y) + (xa.z * xa.z + xa.w * xa.w)) + ((xb.x * xb.x + xb.y * xb.y) + (xb.z * xb.z + xb.w * xb.w));
        u32x4 hw; hw.x = pkbf(xa.x, xa.y); hw.y = pkbf(xa.z, xa.w); hw.z = pkbf(xb.x, xb.y); hw.w = pkbf(xb.z, xb.w);
        u32x4 lw; lw.x = pkbf(xa.x - bflo(hw.x), xa.y - bfhi(hw.x)); lw.y = pkbf(xa.z - bflo(hw.y), xa.w - bfhi(hw.y)); lw.z = pkbf(xb.x - bflo(hw.z), xb.y - bfhi(hw.z)); lw.w = pkbf(xb.z - bflo(hw.w), xb.w - bfhi(hw.w));
        const bf16x8 xh = __builtin_bit_cast(bf16x8, hw), xl = __builtin_bit_cast(bf16x8, lw);
#pragma unroll
        for (int nt = 0; nt < NT; ++nt) { const size_t wo = (size_t)(16 * nt + r) * D + 256 * w + 32 * i + 8 * kq; const bf16x8 wh = *(const bf16x8*)(Wh + wo), wl = *(const bf16x8*)(Wl + wo);
            acc[nt] = mfma16(xh, wh, acc[nt]); acc[nt] = mfma16(xh, wl, acc[nt]); acc[nt] = mfma16(xl, wh, acc[nt]); } }
    ss += __shfl_xor(ss, 16); ss += __shfl_xor(ss, 32);
    if (lane < 16) ssp[w * 16 + lane] = ss;
#pragma unroll
    for (int nt = 0; nt < NT; ++nt) lp[(w * NT + nt) * 64 + lane] = acc[nt];
    __syncthreads();
    float tot = 0.f;
#pragma unroll
    for (int q = 0; q < 8; ++q) tot += ssp[q * 16 + r];
    const float rstd = 1.0f / sqrtf(tot * (1.0f / D) + EPS);
    { const f32x4* gp = (const f32x4*)(gain + 256 * w + 8 * kq); bf16_t* hp = H + (tok0 + r) * D + 256 * w + 8 * kq;
#pragma unroll
      for (int i = 0; i < 8; ++i) { const f32x4 ga = gp[8 * i], gb = gp[8 * i + 1], xa = xr[i][0] * rstd, xb = xr[i][1] * rstd;
        if (MODE == 1) { u32x2 o; o.x = pk4fp8(xa.x * ga.x * 4.f, xa.y * ga.y * 4.f, xa.z * ga.z * 4.f, xa.w * ga.w * 4.f); o.y = pk4fp8(xb.x * gb.x * 4.f, xb.y * gb.y * 4.f, xb.z * gb.z * 4.f, xb.w * gb.w * 4.f);
            *(u32x2*)((unsigned char*)H + (tok0 + r) * D + 256 * w + 8 * kq + 32 * i) = o; }
        else { u32x4 o; o.x = pkbf(xa.x * ga.x, xa.y * ga.y); o.y = pkbf(xa.z * ga.z, xa.w * ga.w); o.z = pkbf(xb.x * gb.x, xb.y * gb.y); o.w = pkbf(xb.z * gb.z, xb.w * gb.w);
            *(u32x4*)(hp + 32 * i) = o; } } }
    if (w == 0) {
        float rs[4];
#pragma unroll
        for (int q = 0; q < 4; ++q) rs[q] = __shfl(rstd, 4 * kq + q);
        f32x4 tl4[NT];
#pragma unroll
        for (int nt = 0; nt < NT; ++nt) { tl4[nt] = lp[nt * 64 + lane];
#pragma unroll
            for (int q = 1; q < 8; ++q) tl4[nt] += lp[(q * NT + nt) * 64 + lane]; }
        if (MODE == 0) {
#pragma unroll
            for (int q = 0; q < 4; ++q) { const float v = tl4[0][q] * rs[q]; float o;
                if (r < 8) o = 1.0f / (1.0f + __expf(-v)); else { const float z = v + dt_bias[r - 8]; const float sp = z > 20.f ? z : log1pf(__expf(z)); o = -__expf(a_log[r - 8]) * sp; }
                bg[(tok0 + 4 * kq + q) * 16 + r] = o; }
        } else {
#pragma unroll
            for (int nt = 0; nt < NT; ++nt)
#pragma unroll
                for (int q = 0; q < 4; ++q) lg[(4 * kq + q) * 48 + 16 * nt + r] = tl4[nt][q] * rs[q];
            LDS_WAIT();
            if (lane < 16) {
                const LAS float* p = lg + lane * 48;
                int g = 0; float gm = p[0];
#pragma unroll
                for (int j = 1; j < 4; ++j) { const float v = p[j]; if (v > gm) { gm = v; g = j; } }
                float gs = 0.f;
#pragma unroll
                for (int j = 0; j < 4; ++j) gs += __expf(p[j] - gm);
                const float g_p = 1.0f / gs;
                float q8[8];
#pragma unroll
                for (int i = 0; i < 8; ++i) q8[i] = p[4 + 8 * g + i];
                int i0 = 0; float m0 = q8[0];
#pragma unroll
                for (int i = 1; i < 8; ++i) if (q8[i] > m0) { m0 = q8[i]; i0 = i; }
                int i1 = -1; float m1 = -3.0e38f;
#pragma unroll
                for (int i = 0; i < 8; ++i) if (i != i0 && q8[i] > m1) { m1 = q8[i]; i1 = i; }
                if (i1 < 0) i1 = (i0 + 1) & 7;
                const float e1 = __expf(m1 - m0), w0 = g_p / (1.0f + e1), w1 = g_p * e1 / (1.0f + e1);
                sel[tl * 16 + lane] = (f32x4){__builtin_bit_cast(float, g * 8 + i0), __builtin_bit_cast(float, g * 8 + i1), w0, w1};
            }
        }
    }
}
DI void xtile_load(Frame& F, XTile& xr, const float* x, int tile) {
    const f32x4* xp = (const f32x4*)(x + ((size_t)tile * 16 + (F.lane & 15)) * D + 256 * F.wave + 8 * (F.lane >> 4));
#pragma unroll
    for (int i = 0; i < 8; ++i) { xr[i][0] = xp[8 * i]; xr[i][1] = xp[8 * i + 1]; }
}
template <int MODE>
DI void normproj_pass(Frame& F, const float* x, const float* gain, const bf16_t* Wh, const bf16_t* Wl, bf16_t* H, float* bg, const float* a_log, const float* dt_bias, unsigned* cnt, int* list, float* gw, unsigned* asg) {
    constexpr int NTILE = NTOK / 16;
    XTile xa, xb;
    int tile = blockIdx.x, tl = 0;
    if (tile < NTILE) xtile_load(F, xa, x, tile);
    while (tile < NTILE) {
        if (tile + F.G < NTILE) xtile_load(F, xb, x, tile + F.G);
        normproj_tile<MODE>(F, xa, tile, tl, tl & 1, gain, Wh, Wl, H, bg, a_log, dt_bias);
        tile += F.G; ++tl;
        if (tile >= NTILE) break;
        if (tile + F.G < NTILE) xtile_load(F, xa, x, tile + F.G);
        normproj_tile<MODE>(F, xb, tile, tl, tl & 1, gain, Wh, Wl, H, bg, a_log, dt_bias);
        tile += F.G; ++tl;
    }
    __syncthreads();
    if (MODE == 1 && F.wave == 0) {
        LAS f32x4* sel = (LAS f32x4*)(F.lds + 65536); LAS unsigned* hist = (LAS unsigned*)(F.lds + 65536 + 4096); LAS unsigned* base = hist + 32;
        const int lane = F.lane;
        if (lane < 32) hist[lane] = 0u;
        LDS_WAIT();
        const int ntok = tl * 16;
        unsigned rk[8]; int ee[8]; float ww[8]; int mm[8];
#pragma unroll
        for (int q = 0; q < 8; ++q) { const int a = lane + 64 * q;
            ee[q] = -1; if ((a >> 1) < ntok) { const f32x4 sv = sel[a >> 1]; ee[q] = __builtin_bit_cast(int, (a & 1) ? sv.y : sv.x); ww[q] = (a & 1) ? sv.w : sv.z;
                mm[q] = (blockIdx.x + ((a >> 1) >> 4) * F.G) * 16 + ((a >> 1) & 15); rk[q] = __hip_atomic_fetch_add(hist + ee[q], 1u, __ATOMIC_RELAXED, __HIP_MEMORY_SCOPE_WORKGROUP); } }
        LDS_WAIT();
        if (lane < 32) { const unsigned c = hist[lane]; base[lane] = c ? __hip_atomic_fetch_add(cnt + lane, c, __ATOMIC_RELAXED, __HIP_MEMORY_SCOPE_AGENT) : 0u; }
        LDS_WAIT();
#pragma unroll
        for (int q = 0; q < 8; ++q) if (ee[q] >= 0) { const unsigned pos = base[ee[q]] + rk[q]; const int a = lane + 64 * q;
            list[ee[q] * 65536 + pos] = mm[q]; gw[ee[q] * 65536 + pos] = ww[q]; asg[2 * mm[q] + (a & 1)] = ((unsigned)ee[q] << 16) | pos; }
    }
    __syncthreads();
}

DI unsigned dpp_ror8(unsigned v) { return (unsigned)__builtin_amdgcn_mov_dpp((int)v, 0x128, 0xf, 0xf, true); }
DI void p2_prep(Frame& F, const float* conv_w) {
    bf16_t* pj = (bf16_t*)(F.ws + WS_BIG + BIG_PJ);
    const f32x2* cs = (const f32x2*)(F.ws + AUX_CS);
    bf16_t* qn = (bf16_t*)(F.ws + AUX_QN); bf16_t* kn = (bf16_t*)(F.ws + AUX_KN); bf16_t* vc = (bf16_t*)(F.ws + AUX_VC);
    const int lane = F.lane, l16 = lane & 15;
    for (int grp = F.gw; grp < NTOK / 16; grp += F.NGW) {
        const int m0 = grp * 16, pos0 = m0 & (SEQ - 1);
#pragma unroll 2
        for (int tt = 0; tt < 16; ++tt) {
            bf16_t* row = pj + (size_t)(m0 + tt) * PJW;
            const f32x4* cp = (const f32x4*)(cs + (size_t)(pos0 + tt) * 64 + 8 * (l16 & 7));
            const f32x4 c0 = cp[0], c1 = cp[1], c2 = cp[2], c3 = cp[3];
            u32x4 x[4];
#pragma unroll
            for (int i = 0; i < 4; ++i) x[i] = *(const u32x4*)(row + i * 512 + 8 * lane);
            asm volatile("" ::: "memory");
            const float sg = (l16 < 8) ? -1.f : 1.f;
#pragma unroll
            for (int i = 0; i < 4; ++i) { const float sc = i >= 2 ? 0.08838834764831845f : 1.0f; u32x4 p; p.x = dpp_ror8(x[i].x); p.y = dpp_ror8(x[i].y); p.z = dpp_ror8(x[i].z); p.w = dpp_ror8(x[i].w);
                u32x4 o;
                o.x = pk2((bflo(x[i].x) * c0.x + sg * bflo(p.x) * c0.y) * sc, (bfhi(x[i].x) * c0.z + sg * bfhi(p.x) * c0.w) * sc);
                o.y = pk2((bflo(x[i].y) * c1.x + sg * bflo(p.y) * c1.y) * sc, (bfhi(x[i].y) * c1.z + sg * bfhi(p.y) * c1.w) * sc);
                o.z = pk2((bflo(x[i].z) * c2.x + sg * bflo(p.z) * c2.y) * sc, (bfhi(x[i].z) * c2.z + sg * bfhi(p.z) * c2.w) * sc);
                o.w = pk2((bflo(x[i].w) * c3.x + sg * bflo(p.w) * c3.y) * sc, (bfhi(x[i].w) * c3.z + sg * bfhi(p.w) * c3.w) * sc);
                *(u32x4*)(row + i * 512 + 8 * lane) = o; }
        }
#pragma unroll 1
        for (int j = 0; j < 8; ++j) { const int ch = 512 * j + 8 * lane;
            f32x4 w[4][2];
#pragma unroll
            for (int tp = 0; tp < 4; ++tp) { w[tp][0] = *(const f32x4*)(conv_w + tp * 4096 + ch); w[tp][1] = *(const f32x4*)(conv_w + tp * 4096 + ch + 4); }
            u32x4 rr[19];
#pragma unroll
            for (int q = 0; q < 19; ++q) { const int dp = pos0 - 3 + q; rr[q] = (u32x4){0u, 0u, 0u, 0u}; if (dp >= 0) rr[q] = *(const u32x4*)(pj + (size_t)(m0 - 3 + q) * PJW + C_GQKV + ch); }
#pragma unroll
            for (int tt = 0; tt < 16; ++tt) { float a[8];
#pragma unroll
                for (int e = 0; e < 8; ++e) a[e] = 0.f;
#pragma unroll
                for (int tp = 0; tp < 4; ++tp) { const u32x4 r = rr[tt + tp];
                    a[0] += bflo(r.x) * w[tp][0].x; a[1] += bfhi(r.x) * w[tp][0].y; a[2] += bflo(r.y) * w[tp][0].z; a[3] += bfhi(r.y) * w[tp][0].w; a[4] += bflo(r.z) * w[tp][1].x; a[5] += bfhi(r.z) * w[tp][1].y; a[6] += bflo(r.w) * w[tp][1].z; a[7] += bfhi(r.w) * w[tp][1].w; }
                float ss = 0.f;
#pragma unroll
                for (int e = 0; e < 8; ++e) { a[e] = siluf(a[e]); ss += a[e] * a[e]; }
                if (j < 4) { ss += __shfl_xor(ss, 1); ss += __shfl_xor(ss, 2); ss += __shfl_xor(ss, 4); ss += __shfl_xor(ss, 8);
                    const float sc = (1.0f / sqrtf(ss + EPS)) * (j < 2 ? 0.08838834764831845f : 1.0f);
#pragma unroll
                    for (int e = 0; e < 8; ++e) a[e] *= sc; }
                u32x4 o; o.x = pk2(a[0], a[1]); o.y = pk2(a[2], a[3]); o.z = pk2(a[4], a[5]); o.w = pk2(a[6], a[7]);
                const size_t m = (size_t)(m0 + tt);
                bf16_t* dst = j < 2 ? qn + m * 1024 + ch : (j < 4 ? kn + m * 1024 + (ch - 1024) : vc + m * 2048 + (ch - 2048));
                *(u32x4*)dst = o; }
        }
    }
}

constexpr int TB = 16;
template <bool GDN>
DI void p3_recurrence(Frame& F, int u  ) {
    const int b = u >> 2, h = 2 * (u & 3) + (F.tid >> 8), e = F.tid & 255, hh = F.tid >> 8;
    bf16_t* pj = (bf16_t*)(F.ws + WS_BIG + BIG_PJ);
    const bf16_t* qsrc = GDN ? (const bf16_t*)(F.ws + AUX_QN) : pj + C_RQ; const bf16_t* ksrc = GDN ? (const bf16_t*)(F.ws + AUX_KN) : pj + C_RK;
    const int qld = GDN ? 1024 : PJW;
    bf16_t* vsrc = GDN ? (bf16_t*)(F.ws + AUX_VC) : pj + C_RV; const int vld = GDN ? 2048 : PJW;
    const float* bg = (const float*)(F.ws + AUX_BG);
    LAS float* qs = (LAS float*)F.lds;
    LAS float* ks = qs + 2 * TB * 128;
    LAS float* ab = ks + 2 * TB * 128;
    LAS float* vs = ab + 2 * TB * 2;
    float S[128];
#pragma unroll
    for (int d = 0; d < 128; ++d) S[d] = 0.f;
    const float gam = GDN ? 0.f : (1.0f - exp2f(-5.0f - (float)h));
    for (int t0 = 0; t0 < SEQ; t0 += TB) {
        const size_t r0 = (size_t)b * SEQ + t0;
        __syncthreads();
        for (int i = F.tid; i < 2 * TB * 128; i += NTHR) { const int h2 = i / (TB * 128), tt = (i / 128) % TB, d = i % 128; const int hd = 2 * (u & 3) + h2;
            qs[i] = bf2f(qsrc[(r0 + tt) * qld + hd * 128 + d]); ks[i] = bf2f(ksrc[(r0 + tt) * qld + hd * 128 + d]); }
        for (int i = F.tid; i < 2 * TB * 256; i += NTHR) { const int h2 = i / (TB * 256), tt = (i / 256) % TB, ee = i % 256; vs[i] = bf2f(vsrc[(r0 + tt) * vld + (2 * (u & 3) + h2) * 256 + ee]); }
        if (GDN && F.tid < 2 * TB) { const int h2 = F.tid / TB, tt = F.tid % TB, hd = 2 * (u & 3) + h2; ab[F.tid * 2] = __expf(bg[(r0 + tt) * 16 + 8 + hd]); ab[F.tid * 2 + 1] = bg[(r0 + tt) * 16 + hd]; }
        __syncthreads();
#pragma unroll 1
        for (int tt = 0; tt < TB; ++tt) {
            const LAS f32x4* q4 = (const LAS f32x4*)(qs + (hh * TB + tt) * 128); const LAS f32x4* k4 = (const LAS f32x4*)(ks + (hh * TB + tt) * 128);
            const float v = vs[(hh * TB + tt) * 256 + e];
            float o = 0.f;
            if (GDN) {
                const float a = ab[(hh * TB + tt) * 2], beta = ab[(hh * TB + tt) * 2 + 1];
                float ksum = 0.f;
#pragma unroll
                for (int d4 = 0; d4 < 32; ++d4) { if ((d4 & 7) == 0) asm volatile("" ::: "memory"); const f32x4 kk = k4[d4]; ksum += (kk.x * S[4 * d4] + kk.y * S[4 * d4 + 1]) + (kk.z * S[4 * d4 + 2] + kk.w * S[4 * d4 + 3]); }
                const float r = (v - a * ksum) * beta;
#pragma unroll
                for (int d4 = 0; d4 < 32; ++d4) { if ((d4 & 3) == 0) asm volatile("" ::: "memory"); const f32x4 kk = k4[d4], qq = q4[d4];
                    S[4 * d4] = a * S[4 * d4] + r * kk.x; S[4 * d4 + 1] = a * S[4 * d4 + 1] + r * kk.y; S[4 * d4 + 2] = a * S[4 * d4 + 2] + r * kk.z; S[4 * d4 + 3] = a * S[4 * d4 + 3] + r * kk.w;
                    o += (qq.x * S[4 * d4] + qq.y * S[4 * d4 + 1]) + (qq.z * S[4 * d4 + 2] + qq.w * S[4 * d4 + 3]); }
            } else {
#pragma unroll
                for (int d4 = 0; d4 < 32; ++d4) { if ((d4 & 3) == 0) asm volatile("" ::: "memory"); const f32x4 kk = k4[d4], qq = q4[d4];
                    S[4 * d4] = gam * S[4 * d4] + v * kk.x; S[4 * d4 + 1] = gam * S[4 * d4 + 1] + v * kk.y; S[4 * d4 + 2] = gam * S[4 * d4 + 2] + v * kk.z; S[4 * d4 + 3] = gam * S[4 * d4 + 3] + v * kk.w;
                    o += (qq.x * S[4 * d4] + qq.y * S[4 * d4 + 1]) + (qq.z * S[4 * d4 + 2] + qq.w * S[4 * d4 + 3]); }
            }
            vsrc[(r0 + tt) * vld + h * 256 + e] = (bf16_t)f2bf(o);
        }
    }
}


constexpr int NCH = SEQ / 64;
DI constexpr int rowoff4c(int i) { int a = 0; for (int k = 0; k < i; ++k) a += (k + 3) / 4; return a; }
typedef short s16x4 __attribute__((ext_vector_type(4)));
DI s16x4 tr_read(unsigned lds_addr) { s16x4 r; asm volatile("ds_read_b64_tr_b16 %0, %1\n\ts_waitcnt lgkmcnt(0)" : "=&v"(r) : "v"(lds_addr) : "memory"); return r; }
DI void tr_read4(unsigned a0, unsigned a1, unsigned a2, unsigned a3, s16x4& r0, s16x4& r1, s16x4& r2, s16x4& r3) {
    asm volatile("ds_read_b64_tr_b16 %0, %4\n\tds_read_b64_tr_b16 %1, %5\n\tds_read_b64_tr_b16 %2, %6\n\tds_read_b64_tr_b16 %3, %7\n\ts_waitcnt lgkmcnt(0)"
                 : "=&v"(r0), "=&v"(r1), "=&v"(r2), "=&v"(r3) : "v"(a0), "v"(a1), "v"(a2), "v"(a3) : "memory"); }
DI bf16x8 cat8(s16x4 a, s16x4 b) { return __builtin_shufflevector(a, b, 0, 1, 2, 3, 4, 5, 6, 7); }

template <bool GDN>
DI void ga_unit(Frame& F, int unit, unsigned char* stream, float* out_f32_unused) {
    (void)out_f32_unused;
    constexpr int NF = GDN ? 56 : 40, OFF_W = 0, OFF_QG = GDN ? 16 : 0, OFF_ATT = OFF_QG + 16, OFF_KT = OFF_ATT + 8;
    int lane_o = F.lane; asm volatile("" : "+v"(lane_o));
    const int lane = lane_o, fr = lane & 15, g = lane >> 4;
    const int bh = unit / NCH, n = unit % NCH, b = bh >> 3, h = bh & 7;
    const size_t row0 = (size_t)b * SEQ + (size_t)n * 64;
    LAS unsigned char* L = F.lds + F.wave * GA_LDS_WAVE;
    LAS float* LAf = (LAS float*)L; LAS unsigned char* LA = L; LAS unsigned char* LT = L + 9216; LAS float* LG = (LAS float*)(L + 17408); LAS float* LB = LG + 64;
    const bf16_t* pj = (const bf16_t*)(F.ws + WS_BIG + BIG_PJ);
    const bf16_t* qsrc = GDN ? (const bf16_t*)(F.ws + AUX_QN) + h * 128 : pj + C_RQ + h * 128;
    const bf16_t* ksrc = GDN ? (const bf16_t*)(F.ws + AUX_KN) + h * 128 : pj + C_RK + h * 128;
    const size_t qld = GDN ? 1024 : PJW;
    unsigned char* st = stream + (size_t)unit * NF * 1024 + lane * 16;
    float gv, bv = 1.f;
    if (GDN) { const float* bg = (const float*)(F.ws + AUX_BG); gv = bg[(row0 + lane) * 16 + 8 + h]; bv = bg[(row0 + lane) * 16 + h];
#pragma unroll
        for (int o = 1; o < 64; o <<= 1) { const float t = __shfl_up(gv, o); if (lane >= o) gv += t; } }
    else gv = (float)(lane + 1) * log1pf(-exp2f(-5.0f - (float)h));
    const float gl = rdlane(gv, 63);
    LG[lane] = gv; LB[lane] = bv;
    LDS_WAIT();
    float gr[16], gcl[4], br[16];
#pragma unroll
    for (int t = 0; t < 4; ++t) { gcl[t] = LG[16 * t + fr];
#pragma unroll
        for (int r = 0; r < 4; ++r) { gr[t * 4 + r] = LG[16 * t + 4 * g + r]; br[t * 4 + r] = LB[16 * t + 4 * g + r]; } }
    bf16x8 Kf[4][4], Qf[4][4];
#pragma unroll
    for (int t = 0; t < 4; ++t)
#pragma unroll
        for (int s2 = 0; s2 < 4; ++s2) Kf[t][s2] = *(const bf16x8*)(ksrc + (row0 + 16 * t + fr) * qld + 32 * s2 + 8 * g);
    if (GDN) {
#pragma unroll
        for (int it = 0; it < 4; ++it)
#pragma unroll
            for (int jt = 0; jt <= it; ++jt) { f32x4 acc = {0.f, 0.f, 0.f, 0.f};
#pragma unroll
                for (int s2 = 0; s2 < 4; ++s2) acc = mfma16(Kf[it][s2], Kf[jt][s2], acc);
#pragma unroll
                for (int r = 0; r < 4; ++r) { const int i = 16 * it + 4 * g + r, j = 16 * jt + fr; const int q = (i + 3) >> 2; const int ro = 2 * q * (q - 1) + q * (i - 4 * q + 3);
                    if (j < i) LAf[ro * 4 + j] = br[it * 4 + r] * acc[r] * __expf(gr[it * 4 + r] - gcl[jt]); } }
    }
    asm volatile("" ::: "memory");
#pragma unroll
    for (int it = 0; it < 4; ++it) {
        asm volatile("" ::: "memory");
#pragma unroll
        for (int s2 = 0; s2 < 4; ++s2) Qf[it][s2] = *(const bf16x8*)(qsrc + (row0 + 16 * it + fr) * qld + 32 * s2 + 8 * g);
#pragma unroll
        for (int sp = 0; sp < 2; ++sp) { u32x4 w;
#pragma unroll
            for (int hf = 0; hf < 2; ++hf) { const int jt = 2 * sp + hf; float v[4] = {0.f, 0.f, 0.f, 0.f};
                if (jt <= it) { f32x4 acc = {0.f, 0.f, 0.f, 0.f};
#pragma unroll
                    for (int s2 = 0; s2 < 4; ++s2) acc = mfma16(Kf[jt][s2], Qf[it][s2], acc);
#pragma unroll
                    for (int r = 0; r < 4; ++r) { const int j = 16 * jt + 4 * g + r, i = 16 * it + fr; v[r] = (j <= i) ? acc[r] * __expf(gcl[it] - gr[jt * 4 + r]) : 0.f; } }
                if (hf == 0) { w.x = pk2(v[0], v[1]); w.y = pk2(v[2], v[3]); } else { w.z = pk2(v[0], v[1]); w.w = pk2(v[2], v[3]); } }
            *(u32x4*)(st + (OFF_ATT + it * 2 + sp) * 1024) = w; }
    }
    asm volatile("" ::: "memory");
#pragma unroll
    for (int it = 0; it < 4; ++it) { const float sc = __expf(gcl[it]); asm volatile("" ::: "memory");
#pragma unroll
        for (int s2 = 0; s2 < 4; ++s2) { const bf16_t* qp = qsrc + (row0 + 16 * it + fr) * qld + 32 * s2 + 4 * g; const u32x2 lo = *(const u32x2*)qp, hi = *(const u32x2*)(qp + 16);
            u32x4 w; w.x = pk2(bflo(lo.x) * sc, bfhi(lo.x) * sc); w.y = pk2(bflo(lo.y) * sc, bfhi(lo.y) * sc); w.z = pk2(bflo(hi.x) * sc, bfhi(hi.x) * sc); w.w = pk2(bflo(hi.y) * sc, bfhi(hi.y) * sc);
            *(u32x4*)(st + (OFF_QG + it * 4 + s2) * 1024) = w; } }
    asm volatile("" ::: "memory");
    float t[64];
    float sw_ = 1.f, su_ = 1.f;
    if (GDN) {
        LDS_WAIT();
        const LAS f32x4* LA4 = (const LAS f32x4*)LA;
#pragma unroll
        for (int i = 0; i < 64; ++i) { float acc = (lane == i) ? 1.f : 0.f; if ((i & 1) == 0) asm volatile("" ::: "memory");
#pragma unroll
            for (int m4 = 0; m4 < (i + 3) / 4; ++m4) { const f32x4 l = LA4[rowoff4c(i) + m4];
                if (4 * m4 + 0 < i) acc -= l.x * t[4 * m4 + 0]; if (4 * m4 + 1 < i) acc -= l.y * t[4 * m4 + 1]; if (4 * m4 + 2 < i) acc -= l.z * t[4 * m4 + 2]; if (4 * m4 + 3 < i) acc -= l.w * t[4 * m4 + 3]; }
            t[i] = acc; }
        su_ = bv; sw_ = bv * __expf(gv);
        LDS_WAIT();
#pragma unroll
        for (int i = 0; i < 64; ++i) *(LAS bf16_t*)(LT + (i * 64 + lane) * 2) = (bf16_t)f2bf(t[i] * sw_);
    }
    asm volatile("" ::: "memory");
    float ksc[2][2][4];
#pragma unroll
    for (int sp = 0; sp < 2; ++sp)
#pragma unroll
        for (int tp = 0; tp < 2; ++tp)
#pragma unroll
            for (int e = 0; e < 4; ++e) ksc[sp][tp][e] = __expf(gl - LG[32 * sp + 16 * tp + 4 * g + e]);
    const unsigned la_addr = (unsigned)(size_t)LA, q4 = (unsigned)((lane & 15) >> 2), p4 = (unsigned)(lane & 3);
#pragma unroll 1
    for (int p = 0; p < 2; ++p) {
        LDS_WAIT();
#pragma unroll
        for (int k = 0; k < 8; ++k) { const int row = (lane >> 3) + 8 * k, pc = lane & 7; *(LAS u32x4*)(LA + row * 128 + pc * 16) = *(const u32x4*)(ksrc + (row0 + row) * qld + 64 * p + 8 * pc); }
        LDS_WAIT();
        if (GDN) {
#pragma unroll
            for (int it = 0; it < 4; ++it) { bf16x8 Tf[2];
#pragma unroll
                for (int ks = 0; ks < 2; ++ks) Tf[ks] = *(const LAS bf16x8*)(LT + ((16 * it + fr) * 64 + 32 * ks + 8 * g) * 2);
#pragma unroll
                for (int sl = 0; sl < 2; ++sl) { u32x4 w;
#pragma unroll
                    for (int hf = 0; hf < 2; ++hf) { const int dtl = 2 * sl + hf; f32x4 acc = {0.f, 0.f, 0.f, 0.f};
                        { s16x4 a0, a1, a2, a3; const unsigned ad = la_addr + (8 * g + q4) * 128 + dtl * 32 + p4 * 8; tr_read4(ad, ad + 4 * 128, ad + 32 * 128, ad + 36 * 128, a0, a1, a2, a3);
                          acc = mfma16(cat8(a0, a1), Tf[0], acc); acc = mfma16(cat8(a2, a3), Tf[1], acc); }
                        if (hf == 0) { w.x = pk2(-acc[0], -acc[1]); w.y = pk2(-acc[2], -acc[3]); } else { w.z = pk2(-acc[0], -acc[1]); w.w = pk2(-acc[2], -acc[3]); } }
                    *(u32x4*)(st + (OFF_W + it * 4 + 2 * p + sl) * 1024) = w; } }
        }
#pragma unroll
        for (int dtl = 0; dtl < 4; ++dtl) { s16x4 t0, t1, t2, t3; const unsigned ad = la_addr + (4 * g + q4) * 128 + dtl * 32 + p4 * 8; tr_read4(ad, ad + 16 * 128, ad + 32 * 128, ad + 48 * 128, t0, t1, t2, t3);
#pragma unroll
            for (int sp = 0; sp < 2; ++sp) { const s16x4 a0 = sp ? t2 : t0, a1 = sp ? t3 : t1;
                u32x4 w; w.x = pk2(bf2f((bf16_t)a0[0]) * ksc[sp][0][0], bf2f((bf16_t)a0[1]) * ksc[sp][0][1]); w.y = pk2(bf2f((bf16_t)a0[2]) * ksc[sp][0][2], bf2f((bf16_t)a0[3]) * ksc[sp][0][3]);
                w.z = pk2(bf2f((bf16_t)a1[0]) * ksc[sp][1][0], bf2f((bf16_t)a1[1]) * ksc[sp][1][1]); w.w = pk2(bf2f((bf16_t)a1[2]) * ksc[sp][1][2], bf2f((bf16_t)a1[3]) * ksc[sp][1][3]);
                *(u32x4*)(st + (OFF_KT + (4 * p + dtl) * 2 + sp) * 1024) = w; } }
    }
    if (GDN) {
        LDS_WAIT();
#pragma unroll
        for (int i = 0; i < 64; ++i) *(LAS bf16_t*)(LT + (i * 64 + lane) * 2) = (bf16_t)f2bf(t[i] * su_);
        const bf16_t* vsrc = (const bf16_t*)(F.ws + AUX_VC) + h * 256;
        unsigned char* ub = F.ws + WS_H + (size_t)unit * 32768 + lane * 32;
#pragma unroll 1
        for (int p = 0; p < 4; ++p) {
            LDS_WAIT();
#pragma unroll
            for (int k = 0; k < 8; ++k) { const int row = (lane >> 3) + 8 * k, pc = lane & 7; *(LAS u32x4*)(LA + row * 128 + pc * 16) = *(const u32x4*)(vsrc + (row0 + row) * 2048 + 64 * p + 8 * pc); }
            LDS_WAIT();
            bf16x8 Tf[4][2];
#pragma unroll
            for (int it = 0; it < 4; ++it)
#pragma unroll
                for (int ks = 0; ks < 2; ++ks) Tf[it][ks] = *(const LAS bf16x8*)(LT + ((16 * it + fr) * 64 + 32 * ks + 8 * g) * 2);
#pragma unroll
            for (int etl = 0; etl < 4; ++etl) { bf16x8 Vf[2];
                { s16x4 a0, a1, a2, a3; const unsigned ad = la_addr + (8 * g + q4) * 128 + etl * 32 + p4 * 8; tr_read4(ad, ad + 4 * 128, ad + 32 * 128, ad + 36 * 128, a0, a1, a2, a3); Vf[0] = cat8(a0, a1); Vf[1] = cat8(a2, a3); }
                u32x4 w0, w1;
#pragma unroll
                for (int it = 0; it < 4; ++it) { f32x4 acc = {0.f, 0.f, 0.f, 0.f};
#pragma unroll
                    for (int ks = 0; ks < 2; ++ks) acc = mfma16(Tf[it][ks], Vf[ks], acc);
                    const unsigned a = pk2(acc[0], acc[1]), c = pk2(acc[2], acc[3]);
                    if (it == 0) { w0.x = a; w0.y = c; } else if (it == 1) { w0.z = a; w0.w = c; } else if (it == 2) { w1.x = a; w1.y = c; } else { w1.z = a; w1.w = c; } }
                *(u32x4*)(ub + (4 * p + etl) * 2048) = w0; *(u32x4*)(ub + (4 * p + etl) * 2048 + 16) = w1; }
        }
        if (lane == 0) ((float*)(F.ws + AUX_DEC))[unit] = __expf(gl);
    }
    LDS_WAIT();
}

constexpr int XL_SLOT = 12288, XL_CNT = 4 * XL_SLOT;
template <bool GDN, int ROLE>
DI void scan_wave(Frame& F, int bh, int sl, const unsigned char* stream, LAS unsigned char* xl) {
    constexpr int NF = GDN ? 56 : 40;
    const int lane = F.lane, fr = lane & 15, g = lane >> 4, b = bh >> 3, h = bh & 7;
    const unsigned char* sp0 = stream + (size_t)bh * NCH * NF * 1024;
    const unsigned voff = (unsigned)lane * 16u;
    const size_t orow = (size_t)2048 * 2;
    const unsigned char* obu = (GDN ? F.ws + AUX_VC : F.ws + AUX_QN) + (size_t)b * SEQ * orow + (size_t)(h * 256 + 16 * sl) * 2;
    const unsigned ooff = (unsigned)((size_t)(4 * g) * orow) + (unsigned)fr * 2u;
    const size_t vrow = (size_t)PJW * 2;
    const unsigned char* vbu = F.ws + WS_BIG + BIG_PJ + (size_t)C_RV * 2 + (size_t)b * SEQ * vrow + (size_t)(h * 256 + 16 * sl) * 2;
    const unsigned voff2 = (unsigned)((size_t)(4 * g) * vrow) + (unsigned)fr * 2u;
    const float* decp = (const float*)(F.ws + AUX_DEC) + bh * NCH;
    float decr = 1.f; { const float gm = 1.0f - exp2f(-5.0f - (float)h); float d2 = gm * gm; d2 *= d2; d2 *= d2; d2 *= d2; d2 *= d2; d2 *= d2; decr = d2; }
    const unsigned char* ubp = F.ws + WS_H + (size_t)bh * NCH * 32768 + sl * 2048; const unsigned uoff = (unsigned)lane * 32u;
    const unsigned zoff = 0u; (void)decp; (void)decr; (void)ubp; (void)uoff; (void)zoff; (void)obu; (void)ooff; (void)vbu; (void)voff2; (void)vrow; (void)orow;
    if constexpr (GDN && ROLE == 0) {
    bf16x8 r0 = (bf16x8){0, 0, 0, 0, 0, 0, 0, 0};
    bf16x8 r1 = (bf16x8){0, 0, 0, 0, 0, 0, 0, 0};
    bf16x8 r2 = (bf16x8){0, 0, 0, 0, 0, 0, 0, 0};
    bf16x8 r3 = (bf16x8){0, 0, 0, 0, 0, 0, 0, 0};
    bf16x8 r4 = (bf16x8){0, 0, 0, 0, 0, 0, 0, 0};
    bf16x8 r5 = (bf16x8){0, 0, 0, 0, 0, 0, 0, 0};
    bf16x8 r6 = (bf16x8){0, 0, 0, 0, 0, 0, 0, 0};
    bf16x8 r7 = (bf16x8){0, 0, 0, 0, 0, 0, 0, 0};
    bf16x8 r8 = (bf16x8){0, 0, 0, 0, 0, 0, 0, 0};
    bf16x8 r9 = (bf16x8){0, 0, 0, 0, 0, 0, 0, 0};
    bf16x8 r10 = (bf16x8){0, 0, 0, 0, 0, 0, 0, 0};
    bf16x8 r11 = (bf16x8){0, 0, 0, 0, 0, 0, 0, 0};
    bf16x8 r12 = (bf16x8){0, 0, 0, 0, 0, 0, 0, 0};
    bf16x8 r13 = (bf16x8){0, 0, 0, 0, 0, 0, 0, 0};
    bf16x8 r14 = (bf16x8){0, 0, 0, 0, 0, 0, 0, 0};
    bf16x8 r15 = (bf16x8){0, 0, 0, 0, 0, 0, 0, 0};
    f32x4 S0_0 = {0.f, 0.f, 0.f, 0.f};
    f32x4 S0_1 = {0.f, 0.f, 0.f, 0.f};
    f32x4 S0_2 = {0.f, 0.f, 0.f, 0.f};
    f32x4 S0_3 = {0.f, 0.f, 0.f, 0.f};
    f32x4 S0_4 = {0.f, 0.f, 0.f, 0.f};
    f32x4 S0_5 = {0.f, 0.f, 0.f, 0.f};
    f32x4 S0_6 = {0.f, 0.f, 0.f, 0.f};
    f32x4 S0_7 = {0.f, 0.f, 0.f, 0.f};
    bf16x8 Sp0_0 = (bf16x8){0, 0, 0, 0, 0, 0, 0, 0};
    bf16x8 Sp0_1 = (bf16x8){0, 0, 0, 0, 0, 0, 0, 0};
    bf16x8 Sp0_2 = (bf16x8){0, 0, 0, 0, 0, 0, 0, 0};
    bf16x8 Sp0_3 = (bf16x8){0, 0, 0, 0, 0, 0, 0, 0};
    f32x4 S1_0 = {0.f, 0.f, 0.f, 0.f};
    f32x4 S1_1 = {0.f, 0.f, 0.f, 0.f};
    f32x4 S1_2 = {0.f, 0.f, 0.f, 0.f};
    f32x4 S1_3 = {0.f, 0.f, 0.f, 0.f};
    f32x4 S1_4 = {0.f, 0.f, 0.f, 0.f};
    f32x4 S1_5 = {0.f, 0.f, 0.f, 0.f};
    f32x4 S1_6 = {0.f, 0.f, 0.f, 0.f};
    f32x4 S1_7 = {0.f, 0.f, 0.f, 0.f};
    bf16x8 Sp1_0 = (bf16x8){0, 0, 0, 0, 0, 0, 0, 0};
    bf16x8 Sp1_1 = (bf16x8){0, 0, 0, 0, 0, 0, 0, 0};
    bf16x8 Sp1_2 = (bf16x8){0, 0, 0, 0, 0, 0, 0, 0};
    bf16x8 Sp1_3 = (bf16x8){0, 0, 0, 0, 0, 0, 0, 0};
    float decv = 0.f;
    u32x4 un0_0 = {0u, 0u, 0u, 0u}, un0_1 = {0u, 0u, 0u, 0u};
    u32x4 un1_0 = {0u, 0u, 0u, 0u}, un1_1 = {0u, 0u, 0u, 0u};
    { const int n = 0; (void)n;
    asm volatile("global_load_dwordx4 %0, %1, off" : "+v"(un0_0) : "v"((const unsigned char*)(ubp + 0 * 2048) + uoff) : "memory");
    asm volatile("global_load_dwordx4 %0, %1, off offset:16" : "+v"(un0_1) : "v"((const unsigned char*)(ubp + 0 * 2048) + uoff) : "memory");
    asm volatile("global_load_dwordx4 %0, %1, off" : "+v"(un1_0) : "v"((const unsigned char*)(ubp + 1 * 2048) + uoff) : "memory");
    asm volatile("global_load_dwordx4 %0, %1, off offset:16" : "+v"(un1_1) : "v"((const unsigned char*)(ubp + 1 * 2048) + uoff) : "memory");
    asm volatile("global_load_dword %0, %1, off" : "+v"(decv) : "v"((const unsigned char*)(decp) + zoff) : "memory");
    asm volatile("global_load_dwordx4 %0, %1, off" : "+v"(r0) : "v"((const unsigned char*)(sp0 + ((size_t)(n + 0) * 56 + 0) * 1024) + voff) : "memory");
    asm volatile("global_load_dwordx4 %0, %1, off" : "+v"(r1) : "v"((const unsigned char*)(sp0 + ((size_t)(n + 0) * 56 + 1) * 1024) + voff) : "memory");
    asm volatile("global_load_dwordx4 %0, %1, off" : "+v"(r2) : "v"((const unsigned char*)(sp0 + ((size_t)(n + 0) * 56 + 2) * 1024) + voff) : "memory");
    asm volatile("global_load_dwordx4 %0, %1, off" : "+v"(r3) : "v"((const unsigned char*)(sp0 + ((size_t)(n + 0) * 56 + 3) * 1024) + voff) : "memory");
    asm volatile("global_load_dwordx4 %0, %1, off" : "+v"(r4) : "v"((const unsigned char*)(sp0 + ((size_t)(n + 0) * 56 + 4) * 1024) + voff) : "memory");
    asm volatile("global_load_dwordx4 %0, %1, off" : "+v"(r5) : "v"((const unsigned char*)(sp0 + ((size_t)(n + 0) * 56 + 5) * 1024) + voff) : "memory");
    asm volatile("global_load_dwordx4 %0, %1, off" : "+v"(r6) : "v"((const unsigned char*)(sp0 + ((size_t)(n + 0) * 56 + 6) * 1024) + voff) : "memory");
    asm volatile("global_load_dwordx4 %0, %1, off" : "+v"(r7) : "v"((const unsigned char*)(sp0 + ((size_t)(n + 0) * 56 + 7) * 1024) + voff) : "memory");
    asm volatile("global_load_dwordx4 %0, %1, off" : "+v"(r8) : "v"((const unsigned char*)(sp0 + ((size_t)(n + 0) * 56 + 8) * 1024) + voff) : "memory");
    asm volatile("global_load_dwordx4 %0, %1, off" : "+v"(r9) : "v"((const unsigned char*)(sp0 + ((size_t)(n + 0) * 56 + 9) * 1024) + voff) : "memory");
    asm volatile("global_load_dwordx4 %0, %1, off" : "+v"(r10) : "v"((const unsigned char*)(sp0 + ((size_t)(n + 0) * 56 + 10) * 1024) + voff) : "memory");
    asm volatile("global_load_dwordx4 %0, %1, off" : "+v"(r11) : "v"((const unsigned char*)(sp0 + ((size_t)(n + 0) * 56 + 11) * 1024) + voff) : "memory");
    asm volatile("global_load_dwordx4 %0, %1, off" : "+v"(r12) : "v"((const unsigned char*)(sp0 + ((size_t)(n + 0) * 56 + 12) * 1024) + voff) : "memory");
    asm volatile("global_load_dwordx4 %0, %1, off" : "+v"(r13) : "v"((const unsigned char*)(sp0 + ((size_t)(n + 0) * 56 + 13) * 1024) + voff) : "memory");
    asm volatile("global_load_dwordx4 %0, %1, off" : "+v"(r14) : "v"((const unsigned char*)(sp0 + ((size_t)(n + 0) * 56 + 14) * 1024) + voff) : "memory");
    asm volatile("global_load_dwordx4 %0, %1, off" : "+v"(r15) : "v"((const unsigned char*)(sp0 + ((size_t)(n + 0) * 56 + 15) * 1024) + voff) : "memory");
    }
#pragma unroll 1
    for (int n = 0; n < NCH; ++n) {
        const int nn = n + 1 < NCH ? n + 1 : n;
        f32x4 a0_0, a0_1, a0_2, a0_3;
        f32x4 a1_0, a1_1, a1_2, a1_3;
        asm volatile("s_waitcnt vmcnt(16)" : "+v"(un0_0), "+v"(un0_1), "+v"(un1_0), "+v"(un1_1), "+v"(decv));
        a0_0 = (f32x4){bflo(un0_0.x), bfhi(un0_0.x), bflo(un0_0.y), bfhi(un0_0.y)}; a0_1 = (f32x4){bflo(un0_0.z), bfhi(un0_0.z), bflo(un0_0.w), bfhi(un0_0.w)};
        a0_2 = (f32x4){bflo(un0_1.x), bfhi(un0_1.x), bflo(un0_1.y), bfhi(un0_1.y)}; a0_3 = (f32x4){bflo(un0_1.z), bfhi(un0_1.z), bflo(un0_1.w), bfhi(un0_1.w)};
        a1_0 = (f32x4){bflo(un1_0.x), bfhi(un1_0.x), bflo(un1_0.y), bfhi(un1_0.y)}; a1_1 = (f32x4){bflo(un1_0.z), bfhi(un1_0.z), bflo(un1_0.w), bfhi(un1_0.w)};
        a1_2 = (f32x4){bflo(un1_1.x), bfhi(un1_1.x), bflo(un1_1.y), bfhi(un1_1.y)}; a1_3 = (f32x4){bflo(un1_1.z), bfhi(un1_1.z), bflo(un1_1.w), bfhi(un1_1.w)};
        const float dec = decv;
        { const unsigned char* ubn = ubp + (size_t)nn * 32768;
          asm volatile("global_load_dwordx4 %0, %1, off" : "+v"(un0_0) : "v"((const unsigned char*)(ubn + 0 * 2048) + uoff) : "memory");
          asm volatile("global_load_dwordx4 %0, %1, off offset:16" : "+v"(un0_1) : "v"((const unsigned char*)(ubn + 0 * 2048) + uoff) : "memory");
          asm volatile("global_load_dwordx4 %0, %1, off" : "+v"(un1_0) : "v"((const unsigned char*)(ubn + 1 * 2048) + uoff) : "memory");
          asm volatile("global_load_dwordx4 %0, %1, off offset:16" : "+v"(un1_1) : "v"((const unsigned char*)(ubn + 1 * 2048) + uoff) : "memory");
          asm volatile("global_load_dword %0, %1, off" : "+v"(decv) : "v"((const unsigned char*)(decp + nn) + zoff) : "memory"); }
        __builtin_amdgcn_sched_barrier(0);
        asm volatile("s_waitcnt vmcnt(20)" : "+v"(r0));
        a0_0 = mfma16(r0, Sp0_0, a0_0);
        a1_0 = mfma16(r0, Sp1_0, a1_0);
        asm volatile("global_load_dwordx4 %0, %1, off" : "+v"(r0) : "v"((const unsigned char*)(sp0 + ((size_t)(n + 0) * 56 + 40) * 1024) + voff) : "memory");
        __builtin_amdgcn_sched_barrier(0);
        asm volatile("s_waitcnt vmcnt(20)" : "+v"(r1));
        a0_0 = mfma16(r1, Sp0_1, a0_0);
        a1_0 = mfma16(r1, Sp1_1, a1_0);
        asm volatile("global_load_dwordx4 %0, %1, off" : "+v"(r1) : "v"((const unsigned char*)(sp0 + ((size_t)(n + 0) * 56 + 41) * 1024) + voff) : "memory");
        __builtin_amdgcn_sched_barrier(0);
        asm volatile("s_waitcnt vmcnt(20)" : "+v"(r2));
        a0_0 = mfma16(r2, Sp0_2, a0_0);
        a1_0 = mfma16(r2, Sp1_2, a1_0);
        asm volatile("global_load_dwordx4 %0, %1, off" : "+v"(r2) : "v"((const unsigned char*)(sp0 + ((size_t)(n + 0) * 56 + 42) * 1024) + voff) : "memory");
        __builtin_amdgcn_sched_barrier(0);
        asm volatile("s_waitcnt vmcnt(20)" : "+v"(r3));
        a0_0 = mfma16(r3, Sp0_3, a0_0);
        a1_0 = mfma16(r3, Sp1_3, a1_0);
        asm volatile("global_load_dwordx4 %0, %1, off" : "+v"(r3) : "v"((const unsigned char*)(sp0 + ((size_t)(n + 0) * 56 + 43) * 1024) + voff) : "memory");
        __builtin_amdgcn_sched_barrier(0);
        asm volatile("s_waitcnt vmcnt(20)" : "+v"(r4));
        a0_1 = mfma16(r4, Sp0_0, a0_1);
        a1_1 = mfma16(r4, Sp1_0, a1_1);
        asm volatile("global_load_dwordx4 %0, %1, off" : "+v"(r4) : "v"((const unsigned char*)(sp0 + ((size_t)(n + 0) * 56 + 44) * 1024) + voff) : "memory");
        __builtin_amdgcn_sched_barrier(0);
        asm volatile("s_waitcnt vmcnt(20)" : "+v"(r5));
        a0_1 = mfma16(r5, Sp0_1, a0_1);
        a1_1 = mfma16(r5, Sp1_1, a1_1);
        asm volatile("global_load_dwordx4 %0, %1, off" : "+v"(r5) : "v"((const unsigned char*)(sp0 + ((size_t)(n + 0) * 56 + 45) * 1024) + voff) : "memory");
        __builtin_amdgcn_sched_barrier(0);
        asm volatile("s_waitcnt vmcnt(20)" : "+v"(r6));
        a0_1 = mfma16(r6, Sp0_2, a0_1);
        a1_1 = mfma16(r6, Sp1_2, a1_1);
        asm volatile("global_load_dwordx4 %0, %1, off" : "+v"(r6) : "v"((const unsigned char*)(sp0 + ((size_t)(n + 0) * 56 + 46) * 1024) + voff) : "memory");
        __builtin_amdgcn_sched_barrier(0);
        asm volatile("s_waitcnt vmcnt(20)" : "+v"(r7));
        a0_1 = mfma16(r7, Sp0_3, a0_1);
        a1_1 = mfma16(r7, Sp1_3, a1_1);
        asm volatile("global_load_dwordx4 %0, %1, off" : "+v"(r7) : "v"((const unsigned char*)(sp0 + ((size_t)(n + 0) * 56 + 47) * 1024) + voff) : "memory");
        __builtin_amdgcn_sched_barrier(0);
        asm volatile("s_waitcnt vmcnt(20)" : "+v"(r8));
        a0_2 = mfma16(r8, Sp0_0, a0_2);
        a1_2 = mfma16(r8, Sp1_0, a1_2);
        asm volatile("global_load_dwordx4 %0, %1, off" : "+v"(r8) : "v"((const unsigned char*)(sp0 + ((size_t)(n + 0) * 56 + 48) * 1024) + voff) : "memory");
        __builtin_amdgcn_sched_barrier(0);
        asm volatile("s_waitcnt vmcnt(20)" : "+v"(r9));
        a0_2 = mfma16(r9, Sp0_1, a0_2);
        a1_2 = mfma16(r9, Sp1_1, a1_2);
        asm volatile("global_load_dwordx4 %0, %1, off" : "+v"(r9) : "v"((const unsigned char*)(sp0 + ((size_t)(n + 0) * 56 + 49) * 1024) + voff) : "memory");
        __builtin_amdgcn_sched_barrier(0);
        asm volatile("s_waitcnt vmcnt(20)" : "+v"(r10));
        a0_2 = mfma16(r10, Sp0_2, a0_2);
        a1_2 = mfma16(r10, Sp1_2, a1_2);
        asm volatile("global_load_dwordx4 %0, %1, off" : "+v"(r10) : "v"((const unsigned char*)(sp0 + ((size_t)(n + 0) * 56 + 50) * 1024) + voff) : "memory");
        __builtin_amdgcn_sched_barrier(0);
        asm volatile("s_waitcnt vmcnt(20)" : "+v"(r11));
        a0_2 = mfma16(r11, Sp0_3, a0_2);
        a1_2 = mfma16(r11, Sp1_3, a1_2);
        asm volatile("global_load_dwordx4 %0, %1, off" : "+v"(r11) : "v"((const unsigned char*)(sp0 + ((size_t)(n + 0) * 56 + 51) * 1024) + voff) : "memory");
        __builtin_amdgcn_sched_barrier(0);
        asm volatile("s_waitcnt vmcnt(20)" : "+v"(r12));
        a0_3 = mfma16(r12, Sp0_0, a0_3);
        a1_3 = mfma16(r12, Sp1_0, a1_3);
        asm volatile("global_load_dwordx4 %0, %1, off" : "+v"(r12) : "v"((const unsigned char*)(sp0 + ((size_t)(n + 0) * 56 + 52) * 1024) + voff) : "memory");
        __builtin_amdgcn_sched_barrier(0);
        asm volatile("s_waitcnt vmcnt(20)" : "+v"(r13));
        a0_3 = mfma16(r13, Sp0_1, a0_3);
        a1_3 = mfma16(r13, Sp1_1, a1_3);
        asm volatile("global_load_dwordx4 %0, %1, off" : "+v"(r13) : "v"((const unsigned char*)(sp0 + ((size_t)(n + 0) * 56 + 53) * 1024) + voff) : "memory");
        __builtin_amdgcn_sched_barrier(0);
        asm volatile("s_waitcnt vmcnt(20)" : "+v"(r14));
        a0_3 = mfma16(r14, Sp0_2, a0_3);
        a1_3 = mfma16(r14, Sp1_2, a1_3);
        asm volatile("global_load_dwordx4 %0, %1, off" : "+v"(r14) : "v"((const unsigned char*)(sp0 + ((size_t)(n + 0) * 56 + 54) * 1024) + voff) : "memory");
        __builtin_amdgcn_sched_barrier(0);
        asm volatile("s_waitcnt vmcnt(20)" : "+v"(r15));
        a0_3 = mfma16(r15, Sp0_3, a0_3);
        a1_3 = mfma16(r15, Sp1_3, a1_3);
        asm volatile("global_load_dwordx4 %0, %1, off" : "+v"(r15) : "v"((const unsigned char*)(sp0 + ((size_t)(n + 0) * 56 + 55) * 1024) + voff) : "memory");
        __builtin_amdgcn_sched_barrier(0);
        bf16x8 vp0_0, vp0_1;
        { u32x4 w; w.x = cvt_pk_bf16(a0_0[0], a0_0[1]); w.y = cvt_pk_bf16(a0_0[2], a0_0[3]); w.z = cvt_pk_bf16(a0_1[0], a0_1[1]); w.w = cvt_pk_bf16(a0_1[2], a0_1[3]); vp0_0 = __builtin_bit_cast(bf16x8, w); }
        { u32x4 w; w.x = cvt_pk_bf16(a0_2[0], a0_2[1]); w.y = cvt_pk_bf16(a0_2[2], a0_2[3]); w.z = cvt_pk_bf16(a0_3[0], a0_3[1]); w.w = cvt_pk_bf16(a0_3[2], a0_3[3]); vp0_1 = __builtin_bit_cast(bf16x8, w); }
        bf16x8 vp1_0, vp1_1;
        { u32x4 w; w.x = cvt_pk_bf16(a1_0[0], a1_0[1]); w.y = cvt_pk_bf16(a1_0[2], a1_0[3]); w.z = cvt_pk_bf16(a1_1[0], a1_1[1]); w.w = cvt_pk_bf16(a1_1[2], a1_1[3]); vp1_0 = __builtin_bit_cast(bf16x8, w); }
        { u32x4 w; w.x = cvt_pk_bf16(a1_2[0], a1_2[1]); w.y = cvt_pk_bf16(a1_2[2], a1_2[3]); w.z = cvt_pk_bf16(a1_3[0], a1_3[1]); w.w = cvt_pk_bf16(a1_3[2], a1_3[3]); vp1_1 = __builtin_bit_cast(bf16x8, w); }
        { unsigned sp_ = 0; while (*(volatile LAS unsigned*)(xl + XL_CNT + 64) + 4u <= (unsigned)n) { __builtin_amdgcn_s_sleep(1); if (++sp_ > (1u << 22)) break; } }
        { LAS bf16x8* sl_ = (LAS bf16x8*)(xl + (n & 3) * XL_SLOT) + lane; sl_[0] = Sp0_0; sl_[64] = Sp0_1; sl_[128] = Sp0_2; sl_[192] = Sp0_3; sl_[256] = vp0_0; sl_[320] = vp0_1; sl_[384] = Sp1_0; sl_[448] = Sp1_1; sl_[512] = Sp1_2; sl_[576] = Sp1_3; sl_[640] = vp1_0; sl_[704] = vp1_1; }
        asm volatile("s_waitcnt lgkmcnt(0)" ::: "memory");
        if (lane == 0) *(volatile LAS unsigned*)(xl + XL_CNT) = (unsigned)(n + 1);
        S0_0 = S0_0 * dec;
        S1_0 = S1_0 * dec;
        asm volatile("s_waitcnt vmcnt(15)" : "+v"(r0));
        S0_0 = mfma16(r0, vp0_0, S0_0);
        S1_0 = mfma16(r0, vp1_0, S1_0);
        asm volatile("global_load_dwordx4 %0, %1, off" : "+v"(r0) : "v"((const unsigned char*)(sp0 + ((size_t)(n + 1) * 56 + 0) * 1024) + voff) : "memory");
        __builtin_amdgcn_sched_barrier(0);
        asm volatile("s_waitcnt vmcnt(15)" : "+v"(r1));
        S0_0 = mfma16(r1, vp0_1, S0_0);
        S1_0 = mfma16(r1, vp1_1, S1_0);
        asm volatile("global_load_dwordx4 %0, %1, off" : "+v"(r1) : "v"((const unsigned char*)(sp0 + ((size_t)(n + 1) * 56 + 1) * 1024) + voff) : "memory");
        __builtin_amdgcn_sched_barrier(0);
        S0_1 = S0_1 * dec;
        S1_1 = S1_1 * dec;
        asm volatile("s_waitcnt vmcnt(15)" : "+v"(r2));
        S0_1 = mfma16(r2, vp0_0, S0_1);
        S1_1 = mfma16(r2, vp1_0, S1_1);
        asm volatile("global_load_dwordx4 %0, %1, off" : "+v"(r2) : "v"((const unsigned char*)(sp0 + ((size_t)(n + 1) * 56 + 2) * 1024) + voff) : "memory");
        __builtin_amdgcn_sched_barrier(0);
        asm volatile("s_waitcnt vmcnt(15)" : "+v"(r3));
        S0_1 = mfma16(r3, vp0_1, S0_1);
        S1_1 = mfma16(r3, vp1_1, S1_1);
        asm volatile("global_load_dwordx4 %0, %1, off" : "+v"(r3) : "v"((const unsigned char*)(sp0 + ((size_t)(n + 1) * 56 + 3) * 1024) + voff) : "memory");
        __builtin_amdgcn_sched_barrier(0);
        S0_2 = S0_2 * dec;
        S1_2 = S1_2 * dec;
        asm volatile("s_waitcnt vmcnt(15)" : "+v"(r4));
        S0_2 = mfma16(r4, vp0_0, S0_2);
        S1_2 = mfma16(r4, vp1_0, S1_2);
        asm volatile("global_load_dwordx4 %0, %1, off" : "+v"(r4) : "v"((const unsigned char*)(sp0 + ((size_t)(n + 1) * 56 + 4) * 1024) + voff) : "memory");
        __builtin_amdgcn_sched_barrier(0);
        asm volatile("s_waitcnt vmcnt(15)" : "+v"(r5));
        S0_2 = mfma16(r5, vp0_1, S0_2);
        S1_2 = mfma16(r5, vp1_1, S1_2);
        asm volatile("global_load_dwordx4 %0, %1, off" : "+v"(r5) : "v"((const unsigned char*)(sp0 + ((size_t)(n + 1) * 56 + 5) * 1024) + voff) : "memory");
        __builtin_amdgcn_sched_barrier(0);
        S0_3 = S0_3 * dec;
        S1_3 = S1_3 * dec;
        asm volatile("s_waitcnt vmcnt(15)" : "+v"(r6));
        S0_3 = mfma16(r6, vp0_0, S0_3);
        S1_3 = mfma16(r6, vp1_0, S1_3);
        asm volatile("global_load_dwordx4 %0, %1, off" : "+v"(r6) : "v"((const unsigned char*)(sp0 + ((size_t)(n + 1) * 56 + 6) * 1024) + voff) : "memory");
        __builtin_amdgcn_sched_barrier(0);
        asm volatile("s_waitcnt vmcnt(15)" : "+v"(r7));
        S0_3 = mfma16(r7, vp0_1, S0_3);
        S1_3 = mfma16(r7, vp1_1, S1_3);
        asm volatile("global_load_dwordx4 %0, %1, off" : "+v"(r7) : "v"((const unsigned char*)(sp0 + ((size_t)(n + 1) * 56 + 7) * 1024) + voff) : "memory");
        __builtin_amdgcn_sched_barrier(0);
        S0_4 = S0_4 * dec;
        S1_4 = S1_4 * dec;
        asm volatile("s_waitcnt vmcnt(15)" : "+v"(r8));
        S0_4 = mfma16(r8, vp0_0, S0_4);
        S1_4 = mfma16(r8, vp1_0, S1_4);
        asm volatile("global_load_dwordx4 %0, %1, off" : "+v"(r8) : "v"((const unsigned char*)(sp0 + ((size_t)(n + 1) * 56 + 8) * 1024) + voff) : "memory");
        __builtin_amdgcn_sched_barrier(0);
        asm volatile("s_waitcnt vmcnt(15)" : "+v"(r9));
        S0_4 = mfma16(r9, vp0_1, S0_4);
        S1_4 = mfma16(r9, vp1_1, S1_4);
        asm volatile("global_load_dwordx4 %0, %1, off" : "+v"(r9) : "v"((const unsigned char*)(sp0 + ((size_t)(n + 1) * 56 + 9) * 1024) + voff) : "memory");
        __builtin_amdgcn_sched_barrier(0);
        S0_5 = S0_5 * dec;
        S1_5 = S1_5 * dec;
        asm volatile("s_waitcnt vmcnt(15)" : "+v"(r10));
        S0_5 = mfma16(r10, vp0_0, S0_5);
        S1_5 = mfma16(r10, vp1_0, S1_5);
        asm volatile("global_load_dwordx4 %0, %1, off" : "+v"(r10) : "v"((const unsigned char*)(sp0 + ((size_t)(n + 1) * 56 + 10) * 1024) + voff) : "memory");
        __builtin_amdgcn_sched_barrier(0);
        asm volatile("s_waitcnt vmcnt(15)" : "+v"(r11));
        S0_5 = mfma16(r11, vp0_1, S0_5);
        S1_5 = mfma16(r11, vp1_1, S1_5);
        asm volatile("global_load_dwordx4 %0, %1, off" : "+v"(r11) : "v"((const unsigned char*)(sp0 + ((size_t)(n + 1) * 56 + 11) * 1024) + voff) : "memory");
        __builtin_amdgcn_sched_barrier(0);
        S0_6 = S0_6 * dec;
        S1_6 = S1_6 * dec;
        asm volatile("s_waitcnt vmcnt(15)" : "+v"(r12));
        S0_6 = mfma16(r12, vp0_0, S0_6);
        S1_6 = mfma16(r12, vp1_0, S1_6);
        asm volatile("global_load_dwordx4 %0, %1, off" : "+v"(r12) : "v"((const unsigned char*)(sp0 + ((size_t)(n + 1) * 56 + 12) * 1024) + voff) : "memory");
        __builtin_amdgcn_sched_barrier(0);
        asm volatile("s_waitcnt vmcnt(15)" : "+v"(r13));
        S0_6 = mfma16(r13, vp0_1, S0_6);
        S1_6 = mfma16(r13, vp1_1, S1_6);
        asm volatile("global_load_dwordx4 %0, %1, off" : "+v"(r13) : "v"((const unsigned char*)(sp0 + ((size_t)(n + 1) * 56 + 13) * 1024) + voff) : "memory");
        __builtin_amdgcn_sched_barrier(0);
        S0_7 = S0_7 * dec;
        S1_7 = S1_7 * dec;
        asm volatile("s_waitcnt vmcnt(15)" : "+v"(r14));
        S0_7 = mfma16(r14, vp0_0, S0_7);
        S1_7 = mfma16(r14, vp1_0, S1_7);
        asm volatile("global_load_dwordx4 %0, %1, off" : "+v"(r14) : "v"((const unsigned char*)(sp0 + ((size_t)(n + 1) * 56 + 14) * 1024) + voff) : "memory");
        __builtin_amdgcn_sched_barrier(0);
        asm volatile("s_waitcnt vmcnt(15)" : "+v"(r15));
        S0_7 = mfma16(r15, vp0_1, S0_7);
        S1_7 = mfma16(r15, vp1_1, S1_7);
        asm volatile("global_load_dwordx4 %0, %1, off" : "+v"(r15) : "v"((const unsigned char*)(sp0 + ((size_t)(n + 1) * 56 + 15) * 1024) + voff) : "memory");
        __builtin_amdgcn_sched_barrier(0);
        { u32x4 w; w.x = cvt_pk_bf16(S0_0[0], S0_0[1]); w.y = cvt_pk_bf16(S0_0[2], S0_0[3]); w.z = cvt_pk_bf16(S0_1[0], S0_1[1]); w.w = cvt_pk_bf16(S0_1[2], S0_1[3]); Sp0_0 = __builtin_bit_cast(bf16x8, w); }
        { u32x4 w; w.x = cvt_pk_bf16(S0_2[0], S0_2[1]); w.y = cvt_pk_bf16(S0_2[2], S0_2[3]); w.z = cvt_pk_bf16(S0_3[0], S0_3[1]); w.w = cvt_pk_bf16(S0_3[2], S0_3[3]); Sp0_1 = __builtin_bit_cast(bf16x8, w); }
        { u32x4 w; w.x = cvt_pk_bf16(S0_4[0], S0_4[1]); w.y = cvt_pk_bf16(S0_4[2], S0_4[3]); w.z = cvt_pk_bf16(S0_5[0], S0_5[1]); w.w = cvt_pk_bf16(S0_5[2], S0_5[3]); Sp0_2 = __builtin_bit_cast(bf16x8, w); }
        { u32x4 w; w.x = cvt_pk_bf16(S0_6[0], S0_6[1]); w.y = cvt_pk_bf16(S0_6[2], S0_6[3]); w.z = cvt_pk_bf16(S0_7[0], S0_7[1]); w.w = cvt_pk_bf16(S0_7[2], S0_7[3]); Sp0_3 = __builtin_bit_cast(bf16x8, w); }
        { u32x4 w; w.x = cvt_pk_bf16(S1_0[0], S1_0[1]); w.y = cvt_pk_bf16(S1_0[2], S1_0[3]); w.z = cvt_pk_bf16(S1_1[0], S1_1[1]); w.w = cvt_pk_bf16(S1_1[2], S1_1[3]); Sp1_0 = __builtin_bit_cast(bf16x8, w); }
        { u32x4 w; w.x = cvt_pk_bf16(S1_2[0], S1_2[1]); w.y = cvt_pk_bf16(S1_2[2], S1_2[3]); w.z = cvt_pk_bf16(S1_3[0], S1_3[1]); w.w = cvt_pk_bf16(S1_3[2], S1_3[3]); Sp1_1 = __builtin_bit_cast(bf16x8, w); }
        { u32x4 w; w.x = cvt_pk_bf16(S1_4[0], S1_4[1]); w.y = cvt_pk_bf16(S1_4[2], S1_4[3]); w.z = cvt_pk_bf16(S1_5[0], S1_5[1]); w.w = cvt_pk_bf16(S1_5[2], S1_5[3]); Sp1_2 = __builtin_bit_cast(bf16x8, w); }
        { u32x4 w; w.x = cvt_pk_bf16(S1_6[0], S1_6[1]); w.y = cvt_pk_bf16(S1_6[2], S1_6[3]); w.z = cvt_pk_bf16(S1_7[0], S1_7[1]); w.w = cvt_pk_bf16(S1_7[2], S1_7[3]); Sp1_3 = __builtin_bit_cast(bf16x8, w); }
    }
    asm volatile("s_waitcnt vmcnt(0)" ::: "memory");
    } else if constexpr (GDN && ROLE == 1) {
    bf16x8 r0 = (bf16x8){0, 0, 0, 0, 0, 0, 0, 0};
    bf16x8 r1 = (bf16x8){0, 0, 0, 0, 0, 0, 0, 0};
    bf16x8 r2 = (bf16x8){0, 0, 0, 0, 0, 0, 0, 0};
    bf16x8 r3 = (bf16x8){0, 0, 0, 0, 0, 0, 0, 0};
    bf16x8 r4 = (bf16x8){0, 0, 0, 0, 0, 0, 0, 0};
    bf16x8 r5 = (bf16x8){0, 0, 0, 0, 0, 0, 0, 0};
    bf16x8 r6 = (bf16x8){0, 0, 0, 0, 0, 0, 0, 0};
    bf16x8 r7 = (bf16x8){0, 0, 0, 0, 0, 0, 0, 0};
    bf16x8 r8 = (bf16x8){0, 0, 0, 0, 0, 0, 0, 0};
    bf16x8 r9 = (bf16x8){0, 0, 0, 0, 0, 0, 0, 0};
    bf16x8 r10 = (bf16x8){0, 0, 0, 0, 0, 0, 0, 0};
    bf16x8 r11 = (bf16x8){0, 0, 0, 0, 0, 0, 0, 0};
    bf16x8 r12 = (bf16x8){0, 0, 0, 0, 0, 0, 0, 0};
    bf16x8 r13 = (bf16x8){0, 0, 0, 0, 0, 0, 0, 0};
    bf16x8 r14 = (bf16x8){0, 0, 0, 0, 0, 0, 0, 0};
    bf16x8 r15 = (bf16x8){0, 0, 0, 0, 0, 0, 0, 0};
    bf16x8 r16 = (bf16x8){0, 0, 0, 0, 0, 0, 0, 0};
    bf16x8 r17 = (bf16x8){0, 0, 0, 0, 0, 0, 0, 0};
    bf16x8 r18 = (bf16x8){0, 0, 0, 0, 0, 0, 0, 0};
    bf16x8 r19 = (bf16x8){0, 0, 0, 0, 0, 0, 0, 0};
    bf16x8 r20 = (bf16x8){0, 0, 0, 0, 0, 0, 0, 0};
    bf16x8 r21 = (bf16x8){0, 0, 0, 0, 0, 0, 0, 0};
    bf16x8 r22 = (bf16x8){0, 0, 0, 0, 0, 0, 0, 0};
    bf16x8 r23 = (bf16x8){0, 0, 0, 0, 0, 0, 0, 0};
    asm volatile("global_load_dwordx4 %0, %1, off" : "+v"(r0) : "v"((const unsigned char*)(sp0 + ((size_t)(0 + 0) * 56 + 16) * 1024) + voff) : "memory");
    asm volatile("global_load_dwordx4 %0, %1, off" : "+v"(r1) : "v"((const unsigned char*)(sp0 + ((size_t)(0 + 0) * 56 + 17) * 1024) + voff) : "memory");
    asm volatile("global_load_dwordx4 %0, %1, off" : "+v"(r2) : "v"((const unsigned char*)(sp0 + ((size_t)(0 + 0) * 56 + 18) * 1024) + voff) : "memory");
    asm volatile("global_load_dwordx4 %0, %1, off" : "+v"(r3) : "v"((const unsigned char*)(sp0 + ((size_t)(0 + 0) * 56 + 19) * 1024) + voff) : "memory");
    asm volatile("global_load_dwordx4 %0, %1, off" : "+v"(r4) : "v"((const unsigned char*)(sp0 + ((size_t)(0 + 0) * 56 + 20) * 1024) + voff) : "memory");
    asm volatile("global_load_dwordx4 %0, %1, off" : "+v"(r5) : "v"((const unsigned char*)(sp0 + ((size_t)(0 + 0) * 56 + 21) * 1024) + voff) : "memory");
    asm volatile("global_load_dwordx4 %0, %1, off" : "+v"(r6) : "v"((const unsigned char*)(sp0 + ((size_t)(0 + 0) * 56 + 22) * 1024) + voff) : "memory");
    asm volatile("global_load_dwordx4 %0, %1, off" : "+v"(r7) : "v"((const unsigned char*)(sp0 + ((size_t)(0 + 0) * 56 + 23) * 1024) + voff) : "memory");
    asm volatile("global_load_dwordx4 %0, %1, off" : "+v"(r8) : "v"((const unsigned char*)(sp0 + ((size_t)(0 + 0) * 56 + 24) * 1024) + voff) : "memory");
    asm volatile("global_load_dwordx4 %0, %1, off" : "+v"(r9) : "v"((const unsigned char*)(sp0 + ((size_t)(0 + 0) * 56 + 25) * 1024) + voff) : "memory");
    asm volatile("global_load_dwordx4 %0, %1, off" : "+v"(r10) : "v"((const unsigned char*)(sp0 + ((size_t)(0 + 0) * 56 + 26) * 1024) + voff) : "memory");
    asm volatile("global_load_dwordx4 %0, %1, off" : "+v"(r11) : "v"((const unsigned char*)(sp0 + ((size_t)(0 + 0) * 56 + 27) * 1024) + voff) : "memory");
    asm volatile("global_load_dwordx4 %0, %1, off" : "+v"(r12) : "v"((const unsigned char*)(sp0 + ((size_t)(0 + 0) * 56 + 28) * 1024) + voff) : "memory");
    asm volatile("global_load_dwordx4 %0, %1, off" : "+v"(r13) : "v"((const unsigned char*)(sp0 + ((size_t)(0 + 0) * 56 + 29) * 1024) + voff) : "memory");
    asm volatile("global_load_dwordx4 %0, %1, off" : "+v"(r14) : "v"((const unsigned char*)(sp0 + ((size_t)(0 + 0) * 56 + 30) * 1024) + voff) : "memory");
    asm volatile("global_load_dwordx4 %0, %1, off" : "+v"(r15) : "v"((const unsigned char*)(sp0 + ((size_t)(0 + 0) * 56 + 31) * 1024) + voff) : "memory");
    asm volatile("global_load_dwordx4 %0, %1, off" : "+v"(r16) : "v"((const unsigned char*)(sp0 + ((size_t)(0 + 0) * 56 + 32) * 1024) + voff) : "memory");
    asm volatile("global_load_dwordx4 %0, %1, off" : "+v"(r17) : "v"((const unsigned char*)(sp0 + ((size_t)(0 + 0) * 56 + 33) * 1024) + voff) : "memory");
    asm volatile("global_load_dwordx4 %0, %1, off" : "+v"(r18) : "v"((const unsigned char*)(sp0 + ((size_t)(0 + 0) * 56 + 34) * 1024) + voff) : "memory");
    asm volatile("global_load_dwordx4 %0, %1, off" : "+v"(r19) : "v"((const unsigned char*)(sp0 + ((size_t)(0 + 0) * 56 + 35) * 1024) + voff) : "memory");
    asm volatile("global_load_dwordx4 %0, %1, off" : "+v"(r20) : "v"((const unsigned char*)(sp0 + ((size_t)(0 + 0) * 56 + 36) * 1024) + voff) : "memory");
    asm volatile("global_load_dwordx4 %0, %1, off" : "+v"(r21) : "v"((const unsigned char*)(sp0 + ((size_t)(0 + 0) * 56 + 37) * 1024) + voff) : "memory");
    asm volatile("global_load_dwordx4 %0, %1, off" : "+v"(r22) : "v"((const unsigned char*)(sp0 + ((size_t)(0 + 0) * 56 + 38) * 1024) + voff) : "memory");
    asm volatile("global_load_dwordx4 %0, %1, off" : "+v"(r23) : "v"((const unsigned char*)(sp0 + ((size_t)(0 + 0) * 56 + 39) * 1024) + voff) : "memory");
    { unsigned z = 0u;
      asm volatile("global_store_short %0, %1, off" :: "v"((const unsigned char*)(obu + (size_t)(0) * orow + 0) + ooff), "v"(z) : "memory");
      asm volatile("global_store_short %0, %1, off" :: "v"((const unsigned char*)(obu + (size_t)(1) * orow + 0) + ooff), "v"(z) : "memory");
      asm volatile("global_store_short %0, %1, off" :: "v"((const unsigned char*)(obu + (size_t)(2) * orow + 0) + ooff), "v"(z) : "memory");
      asm volatile("global_store_short %0, %1, off" :: "v"((const unsigned char*)(obu + (size_t)(3) * orow + 0) + ooff), "v"(z) : "memory");
      asm volatile("global_store_short %0, %1, off" :: "v"((const unsigned char*)(obu + (size_t)(16) * orow + 0) + ooff), "v"(z) : "memory");
      asm volatile("global_store_short %0, %1, off" :: "v"((const unsigned char*)(obu + (size_t)(17) * orow + 0) + ooff), "v"(z) : "memory");
      asm volatile("global_store_short %0, %1, off" :: "v"((const unsigned char*)(obu + (size_t)(18) * orow + 0) + ooff), "v"(z) : "memory");
      asm volatile("global_store_short %0, %1, off" :: "v"((const unsigned char*)(obu + (size_t)(19) * orow + 0) + ooff), "v"(z) : "memory");
      asm volatile("global_store_short %0, %1, off" :: "v"((const unsigned char*)(obu + (size_t)(32) * orow + 0) + ooff), "v"(z) : "memory");
      asm volatile("global_store_short %0, %1, off" :: "v"((const unsigned char*)(obu + (size_t)(33) * orow + 0) + ooff), "v"(z) : "memory");
      asm volatile("global_store_short %0, %1, off" :: "v"((const unsigned char*)(obu + (size_t)(34) * orow + 0) + ooff), "v"(z) : "memory");
      asm volatile("global_store_short %0, %1, off" :: "v"((const unsigned char*)(obu + (size_t)(35) * orow + 0) + ooff), "v"(z) : "memory");
      asm volatile("global_store_short %0, %1, off" :: "v"((const unsigned char*)(obu + (size_t)(48) * orow + 0) + ooff), "v"(z) : "memory");
      asm volatile("global_store_short %0, %1, off" :: "v"((const unsigned char*)(obu + (size_t)(49) * orow + 0) + ooff), "v"(z) : "memory");
      asm volatile("global_store_short %0, %1, off" :: "v"((const unsigned char*)(obu + (size_t)(50) * orow + 0) + ooff), "v"(z) : "memory");
      asm volatile("global_store_short %0, %1, off" :: "v"((const unsigned char*)(obu + (size_t)(51) * orow + 0) + ooff), "v"(z) : "memory");
      asm volatile("global_store_short %0, %1, off" :: "v"((const unsigned char*)(obu + (size_t)(0) * orow + 32) + ooff), "v"(z) : "memory");
      asm volatile("global_store_short %0, %1, off" :: "v"((const unsigned char*)(obu + (size_t)(1) * orow + 32) + ooff), "v"(z) : "memory");
      asm volatile("global_store_short %0, %1, off" :: "v"((const unsigned char*)(obu + (size_t)(2) * orow + 32) + ooff), "v"(z) : "memory");
      asm volatile("global_store_short %0, %1, off" :: "v"((const unsigned char*)(obu + (size_t)(3) * orow + 32) + ooff), "v"(z) : "memory");
      asm volatile("global_store_short %0, %1, off" :: "v"((const unsigned char*)(obu + (size_t)(16) * orow + 32) + ooff), "v"(z) : "memory");
      asm volatile("global_store_short %0, %1, off" :: "v"((const unsigned char*)(obu + (size_t)(17) * orow + 32) + ooff), "v"(z) : "memory");
      asm volatile("global_store_short %0, %1, off" :: "v"((const unsigned char*)(obu + (size_t)(18) * orow + 32) + ooff), "v"(z) : "memory");
      asm volatile("global_store_short %0, %1, off" :: "v"((const unsigned char*)(obu + (size_t)(19) * orow + 32) + ooff), "v"(z) : "memory");
      asm volatile("global_store_short %0, %1, off" :: "v"((const unsigned char*)(obu + (size_t)(32) * orow + 32) + ooff), "v"(z) : "memory");
      asm volatile("global_store_short %0, %1, off" :: "v"((const unsigned char*)(obu + (size_t)(33) * orow + 32) + ooff), "v"(z) : "memory");
      asm volatile("global_store_short %0, %1, off" :: "v"((const unsigned char*)(obu + (size_t)(34) * orow + 32) + ooff), "v"(z) : "memory");
      asm volatile("global_store_short %0, %1, off" :: "v"((const unsigned char*)(obu + (size_t)(35) * orow + 32) + ooff), "v"(z) : "memory");
      asm volatile("global_store_short %0, %1, off" :: "v"((const unsigned char*)(obu + (size_t)(48) * orow + 32) + ooff), "v"(z) : "memory");
      asm volatile("global_store_short %0, %1, off" :: "v"((const unsigned char*)(obu + (size_t)(49) * orow + 32) + ooff), "v"(z) : "memory");
      asm volatile("global_store_short %0, %1, off" :: "v"((const unsigned char*)(obu + (size_t)(50) * orow + 32) + ooff), "v"(z) : "memory");
      asm volatile("global_store_short %0, %1, off" :: "v"((const unsigned char*)(obu + (size_t)(51) * orow + 32) + ooff), "v"(z) : "memory");
    }
#pragma unroll 1
    for (int n = 0; n < NCH; ++n) {
        { unsigned sp_ = 0; while (*(volatile LAS unsigned*)(xl + XL_CNT) <= (unsigned)n) { __builtin_amdgcn_s_sleep(1); if (++sp_ > (1u << 22)) break; } }
        bf16x8 Sp0_0, Sp0_1, Sp0_2, Sp0_3, vp0_0, vp0_1;
        bf16x8 Sp1_0, Sp1_1, Sp1_2, Sp1_3, vp1_0, vp1_1;
        { const LAS bf16x8* sl_ = (const LAS bf16x8*)(xl + (n & 3) * XL_SLOT) + lane; Sp0_0 = sl_[0]; Sp0_1 = sl_[64]; Sp0_2 = sl_[128]; Sp0_3 = sl_[192]; vp0_0 = sl_[256]; vp0_1 = sl_[320]; Sp1_0 = sl_[384]; Sp1_1 = sl_[448]; Sp1_2 = sl_[512]; Sp1_3 = sl_[576]; vp1_0 = sl_[640]; vp1_1 = sl_[704]; }
        asm volatile("s_waitcnt lgkmcnt(0)" ::: "memory");
        if (lane == 0) *(volatile LAS unsigned*)(xl + XL_CNT + 64) = (unsigned)(n + 1);
        f32x4 o0_0 = {0.f, 0.f, 0.f, 0.f}, o0_1 = o0_0, o0_2 = o0_0, o0_3 = o0_0;
        f32x4 o1_0 = {0.f, 0.f, 0.f, 0.f}, o1_1 = o1_0, o1_2 = o1_0, o1_3 = o1_0;
        asm volatile("s_waitcnt vmcnt(55)" : "+v"(r0));
        o0_0 = mfma16(r0, Sp0_0, o0_0);
        o1_0 = mfma16(r0, Sp1_0, o1_0);
        asm volatile("global_load_dwordx4 %0, %1, off" : "+v"(r0) : "v"((const unsigned char*)(sp0 + ((size_t)(n + 1) * 56 + 16) * 1024) + voff) : "memory");
        __builtin_amdgcn_sched_barrier(0);
        asm volatile("s_waitcnt vmcnt(55)" : "+v"(r1));
        o0_0 = mfma16(r1, Sp0_1, o0_0);
        o1_0 = mfma16(r1, Sp1_1, o1_0);
        asm volatile("global_load_dwordx4 %0, %1, off" : "+v"(r1) : "v"((const unsigned char*)(sp0 + ((size_t)(n + 1) * 56 + 17) * 1024) + voff) : "memory");
        __builtin_amdgcn_sched_barrier(0);
        asm volatile("s_waitcnt vmcnt(55)" : "+v"(r2));
        o0_0 = mfma16(r2, Sp0_2, o0_0);
        o1_0 = mfma16(r2, Sp1_2, o1_0);
        asm volatile("global_load_dwordx4 %0, %1, off" : "+v"(r2) : "v"((const unsigned char*)(sp0 + ((size_t)(n + 1) * 56 + 18) * 1024) + voff) : "memory");
        __builtin_amdgcn_sched_barrier(0);
        asm volatile("s_waitcnt vmcnt(55)" : "+v"(r3));
        o0_0 = mfma16(r3, Sp0_3, o0_0);
        o1_0 = mfma16(r3, Sp1_3, o1_0);
        asm volatile("global_load_dwordx4 %0, %1, off" : "+v"(r3) : "v"((const unsigned char*)(sp0 + ((size_t)(n + 1) * 56 + 19) * 1024) + voff) : "memory");
        __builtin_amdgcn_sched_barrier(0);
        asm volatile("s_waitcnt vmcnt(55)" : "+v"(r4));
        o0_1 = mfma16(r4, Sp0_0, o0_1);
        o1_1 = mfma16(r4, Sp1_0, o1_1);
        asm volatile("global_load_dwordx4 %0, %1, off" : "+v"(r4) : "v"((const unsigned char*)(sp0 + ((size_t)(n + 1) * 56 + 20) * 1024) + voff) : "memory");
        __builtin_amdgcn_sched_barrier(0);
        asm volatile("s_waitcnt vmcnt(55)" : "+v"(r5));
        o0_1 = mfma16(r5, Sp0_1, o0_1);
        o1_1 = mfma16(r5, Sp1_1, o1_1);
        asm volatile("global_load_dwordx4 %0, %1, off" : "+v"(r5) : "v"((const unsigned char*)(sp0 + ((size_t)(n + 1) * 56 + 21) * 1024) + voff) : "memory");
        __builtin_amdgcn_sched_barrier(0);
        asm volatile("s_waitcnt vmcnt(55)" : "+v"(r6));
        o0_1 = mfma16(r6, Sp0_2, o0_1);
        o1_1 = mfma16(r6, Sp1_2, o1_1);
        asm volatile("global_load_dwordx4 %0, %1, off" : "+v"(r6) : "v"((const unsigned char*)(sp0 + ((size_t)(n + 1) * 56 + 22) * 1024) + voff) : "memory");
        __builtin_amdgcn_sched_barrier(0);
        asm volatile("s_waitcnt vmcnt(55)" : "+v"(r7));
        o0_1 = mfma16(r7, Sp0_3, o0_1);
        o1_1 = mfma16(r7, Sp1_3, o1_1);
        asm volatile("global_load_dwordx4 %0, %1, off" : "+v"(r7) : "v"((const unsigned char*)(sp0 + ((size_t)(n + 1) * 56 + 23) * 1024) + voff) : "memory");
        __builtin_amdgcn_sched_barrier(0);
        asm volatile("s_waitcnt vmcnt(55)" : "+v"(r8));
        o0_2 = mfma16(r8, Sp0_0, o0_2);
        o1_2 = mfma16(r8, Sp1_0, o1_2);
        asm volatile("global_load_dwordx4 %0, %1, off" : "+v"(r8) : "v"((const unsigned char*)(sp0 + ((size_t)(n + 1) * 56 + 24) * 1024) + voff) : "memory");
        __builtin_amdgcn_sched_barrier(0);
        asm volatile("s_waitcnt vmcnt(55)" : "+v"(r9));
        o0_2 = mfma16(r9, Sp0_1, o0_2);
        o1_2 = mfma16(r9, Sp1_1, o1_2);
        asm volatile("global_load_dwordx4 %0, %1, off" : "+v"(r9) : "v"((const unsigned char*)(sp0 + ((size_t)(n + 1) * 56 + 25) * 1024) + voff) : "memory");
        __builtin_amdgcn_sched_barrier(0);
        asm volatile("s_waitcnt vmcnt(55)" : "+v"(r10));
        o0_2 = mfma16(r10, Sp0_2, o0_2);
        o1_2 = mfma16(r10, Sp1_2, o1_2);
        asm volatile("global_load_dwordx4 %0, %1, off" : "+v"(r10) : "v"((const unsigned char*)(sp0 + ((size_t)(n + 1) * 56 + 26) * 1024) + voff) : "memory");
        __builtin_amdgcn_sched_barrier(0);
        asm volatile("s_waitcnt vmcnt(55)" : "+v"(r11));
        o0_2 = mfma16(r11, Sp0_3, o0_2);
        o1_2 = mfma16(r11, Sp1_3, o1_2);
        asm volatile("global_load_dwordx4 %0, %1, off" : "+v"(r11) : "v"((const unsigned char*)(sp0 + ((size_t)(n + 1) * 56 + 27) * 1024) + voff) : "memory");
        __builtin_amdgcn_sched_barrier(0);
        asm volatile("s_waitcnt vmcnt(55)" : "+v"(r12));
        o0_3 = mfma16(r12, Sp0_0, o0_3);
        o1_3 = mfma16(r12, Sp1_0, o1_3);
        asm volatile("global_load_dwordx4 %0, %1, off" : "+v"(r12) : "v"((const unsigned char*)(sp0 + ((size_t)(n + 1) * 56 + 28) * 1024) + voff) : "memory");
        __builtin_amdgcn_sched_barrier(0);
        asm volatile("s_waitcnt vmcnt(55)" : "+v"(r13));
        o0_3 = mfma16(r13, Sp0_1, o0_3);
        o1_3 = mfma16(r13, Sp1_1, o1_3);
        asm volatile("global_load_dwordx4 %0, %1, off" : "+v"(r13) : "v"((const unsigned char*)(sp0 + ((size_t)(n + 1) * 56 + 29) * 1024) + voff) : "memory");
        __builtin_amdgcn_sched_barrier(0);
        asm volatile("s_waitcnt vmcnt(55)" : "+v"(r14));
        o0_3 = mfma16(r14, Sp0_2, o0_3);
        o1_3 = mfma16(r14, Sp1_2, o1_3);
        asm volatile("global_load_dwordx4 %0, %1, off" : "+v"(r14) : "v"((const unsigned char*)(sp0 + ((size_t)(n + 1) * 56 + 30) * 1024) + voff) : "memory");
        __builtin_amdgcn_sched_barrier(0);
        asm volatile("s_waitcnt vmcnt(55)" : "+v"(r15));
        o0_3 = mfma16(r15, Sp0_3, o0_3);
        o1_3 = mfma16(r15, Sp1_3, o1_3);
        asm volatile("global_load_dwordx4 %0, %1, off" : "+v"(r15) : "v"((const unsigned char*)(sp0 + ((size_t)(n + 1) * 56 + 31) * 1024) + voff) : "memory");
        __builtin_amdgcn_sched_barrier(0);
        asm volatile("s_waitcnt vmcnt(55)" : "+v"(r16));
        o0_0 = mfma16(r16, vp0_0, o0_0);
        o1_0 = mfma16(r16, vp1_0, o1_0);
        asm volatile("global_load_dwordx4 %0, %1, off" : "+v"(r16) : "v"((const unsigned char*)(sp0 + ((size_t)(n + 1) * 56 + 32) * 1024) + voff) : "memory");
        __builtin_amdgcn_sched_barrier(0);
        asm volatile("s_waitcnt vmcnt(55)" : "+v"(r17));
        o0_0 = mfma16(r17, vp0_1, o0_0);
        o1_0 = mfma16(r17, vp1_1, o1_0);
        asm volatile("global_load_dwordx4 %0, %1, off" : "+v"(r17) : "v"((const unsigned char*)(sp0 + ((size_t)(n + 1) * 56 + 33) * 1024) + voff) : "memory");
        __builtin_amdgcn_sched_barrier(0);
        asm volatile("s_waitcnt vmcnt(55)" : "+v"(r18));
        o0_1 = mfma16(r18, vp0_0, o0_1);
        o1_1 = mfma16(r18, vp1_0, o1_1);
        asm volatile("global_load_dwordx4 %0, %1, off" : "+v"(r18) : "v"((const unsigned char*)(sp0 + ((size_t)(n + 1) * 56 + 34) * 1024) + voff) : "memory");
        __builtin_amdgcn_sched_barrier(0);
        asm volatile("s_waitcnt vmcnt(55)" : "+v"(r19));
        o0_1 = mfma16(r19, vp0_1, o0_1);
        o1_1 = mfma16(r19, vp1_1, o1_1);
        asm volatile("global_load_dwordx4 %0, %1, off" : "+v"(r19) : "v"((const unsigned char*)(sp0 + ((size_t)(n + 1) * 56 + 35) * 1024) + voff) : "memory");
        __builtin_amdgcn_sched_barrier(0);
        asm volatile("s_waitcnt vmcnt(55)" : "+v"(r20));
        o0_2 = mfma16(r20, vp0_0, o0_2);
        o1_2 = mfma16(r20, vp1_0, o1_2);
        asm volatile("global_load_dwordx4 %0, %1, off" : "+v"(r20) : "v"((const unsigned char*)(sp0 + ((size_t)(n + 1) * 56 + 36) * 1024) + voff) : "memory");
        __builtin_amdgcn_sched_barrier(0);
        asm volatile("s_waitcnt vmcnt(55)" : "+v"(r21));
        o0_2 = mfma16(r21, vp0_1, o0_2);
        o1_2 = mfma16(r21, vp1_1, o1_2);
        asm volatile("global_load_dwordx4 %0, %1, off" : "+v"(r21) : "v"((const unsigned char*)(sp0 + ((size_t)(n + 1) * 56 + 37) * 1024) + voff) : "memory");
        __builtin_amdgcn_sched_barrier(0);
        asm volatile("s_waitcnt vmcnt(55)" : "+v"(r22));
        o0_3 = mfma16(r22, vp0_0, o0_3);
        o1_3 = mfma16(r22, vp1_0, o1_3);
        asm volatile("global_load_dwordx4 %0, %1, off" : "+v"(r22) : "v"((const unsigned char*)(sp0 + ((size_t)(n + 1) * 56 + 38) * 1024) + voff) : "memory");
        __builtin_amdgcn_sched_barrier(0);
        asm volatile("s_waitcnt vmcnt(55)" : "+v"(r23));
        o0_3 = mfma16(r23, vp0_1, o0_3);
        o1_3 = mfma16(r23, vp1_1, o1_3);
        asm volatile("global_load_dwordx4 %0, %1, off" : "+v"(r23) : "v"((const unsigned char*)(sp0 + ((size_t)(n + 1) * 56 + 39) * 1024) + voff) : "memory");
        __builtin_amdgcn_sched_barrier(0);
        { const unsigned char* obn = obu + (size_t)n * 64 * orow;
          { const unsigned v = f2bf(o0_0[0]); asm volatile("global_store_short %0, %1, off" :: "v"((const unsigned char*)(obn + (size_t)(0) * orow + 0) + ooff), "v"(v) : "memory"); }
          { const unsigned v = f2bf(o0_0[1]); asm volatile("global_store_short %0, %1, off" :: "v"((const unsigned char*)(obn + (size_t)(1) * orow + 0) + ooff), "v"(v) : "memory"); }
          { const unsigned v = f2bf(o0_0[2]); asm volatile("global_store_short %0, %1, off" :: "v"((const unsigned char*)(obn + (size_t)(2) * orow + 0) + ooff), "v"(v) : "memory"); }
          { const unsigned v = f2bf(o0_0[3]); asm volatile("global_store_short %0, %1, off" :: "v"((const unsigned char*)(obn + (size_t)(3) * orow + 0) + ooff), "v"(v) : "memory"); }
          { const unsigned v = f2bf(o0_1[0]); asm volatile("global_store_short %0, %1, off" :: "v"((const unsigned char*)(obn + (size_t)(16) * orow + 0) + ooff), "v"(v) : "memory"); }
          { const unsigned v = f2bf(o0_1[1]); asm volatile("global_store_short %0, %1, off" :: "v"((const unsigned char*)(obn + (size_t)(17) * orow + 0) + ooff), "v"(v) : "memory"); }
          { const unsigned v = f2bf(o0_1[2]); asm volatile("global_store_short %0, %1, off" :: "v"((const unsigned char*)(obn + (size_t)(18) * orow + 0) + ooff), "v"(v) : "memory"); }
          { const unsigned v = f2bf(o0_1[3]); asm volatile("global_store_short %0, %1, off" :: "v"((const unsigned char*)(obn + (size_t)(19) * orow + 0) + ooff), "v"(v) : "memory"); }
          { const unsigned v = f2bf(o0_2[0]); asm volatile("global_store_short %0, %1, off" :: "v"((const unsigned char*)(obn + (size_t)(32) * orow + 0) + ooff), "v"(v) : "memory"); }
          { const unsigned v = f2bf(o0_2[1]); asm volatile("global_store_short %0, %1, off" :: "v"((const unsigned char*)(obn + (size_t)(33) * orow + 0) + ooff), "v"(v) : "memory"); }
          { const unsigned v = f2bf(o0_2[2]); asm volatile("global_store_short %0, %1, off" :: "v"((const unsigned char*)(obn + (size_t)(34) * orow + 0) + ooff), "v"(v) : "memory"); }
          { const unsigned v = f2bf(o0_2[3]); asm volatile("global_store_short %0, %1, off" :: "v"((const unsigned char*)(obn + (size_t)(35) * orow + 0) + ooff), "v"(v) : "memory"); }
          { const unsigned v = f2bf(o0_3[0]); asm volatile("global_store_short %0, %1, off" :: "v"((const unsigned char*)(obn + (size_t)(48) * orow + 0) + ooff), "v"(v) : "memory"); }
          { const unsigned v = f2bf(o0_3[1]); asm volatile("global_store_short %0, %1, off" :: "v"((const unsigned char*)(obn + (size_t)(49) * orow + 0) + ooff), "v"(v) : "memory"); }
          { const unsigned v = f2bf(o0_3[2]); asm volatile("global_store_short %0, %1, off" :: "v"((const unsigned char*)(obn + (size_t)(50) * orow + 0) + ooff), "v"(v) : "memory"); }
          { const unsigned v = f2bf(o0_3[3]); asm volatile("global_store_short %0, %1, off" :: "v"((const unsigned char*)(obn + (size_t)(51) * orow + 0) + ooff), "v"(v) : "memory"); }
          { const unsigned v = f2bf(o1_0[0]); asm volatile("global_store_short %0, %1, off" :: "v"((const unsigned char*)(obn + (size_t)(0) * orow + 32) + ooff), "v"(v) : "memory"); }
          { const unsigned v = f2bf(o1_0[1]); asm volatile("global_store_short %0, %1, off" :: "v"((const unsigned char*)(obn + (size_t)(1) * orow + 32) + ooff), "v"(v) : "memory"); }
          { const unsigned v = f2bf(o1_0[2]); asm volatile("global_store_short %0, %1, off" :: "v"((const unsigned char*)(obn + (size_t)(2) * orow + 32) + ooff), "v"(v) : "memory"); }
          { const unsigned v = f2bf(o1_0[3]); asm volatile("global_store_short %0, %1, off" :: "v"((const unsigned char*)(obn + (size_t)(3) * orow + 32) + ooff), "v"(v) : "memory"); }
          { const unsigned v = f2bf(o1_1[0]); asm volatile("global_store_short %0, %1, off" :: "v"((const unsigned char*)(obn + (size_t)(16) * orow + 32) + ooff), "v"(v) : "memory"); }
          { const unsigned v = f2bf(o1_1[1]); asm volatile("global_store_short %0, %1, off" :: "v"((const unsigned char*)(obn + (size_t)(17) * orow + 32) + ooff), "v"(v) : "memory"); }
          { const unsigned v = f2bf(o1_1[2]); asm volatile("global_store_short %0, %1, off" :: "v"((const unsigned char*)(obn + (size_t)(18) * orow + 32) + ooff), "v"(v) : "memory"); }
          { const unsigned v = f2bf(o1_1[3]); asm volatile("global_store_short %0, %1, off" :: "v"((const unsigned char*)(obn + (size_t)(19) * orow + 32) + ooff), "v"(v) : "memory"); }
          { const unsigned v = f2bf(o1_2[0]); asm volatile("global_store_short %0, %1, off" :: "v"((const unsigned char*)(obn + (size_t)(32) * orow + 32) + ooff), "v"(v) : "memory"); }
          { const unsigned v = f2bf(o1_2[1]); asm volatile("global_store_short %0, %1, off" :: "v"((const unsigned char*)(obn + (size_t)(33) * orow + 32) + ooff), "v"(v) : "memory"); }
          { const unsigned v = f2bf(o1_2[2]); asm volatile("global_store_short %0, %1, off" :: "v"((const unsigned char*)(obn + (size_t)(34) * orow + 32) + ooff), "v"(v) : "memory"); }
          { const unsigned v = f2bf(o1_2[3]); asm volatile("global_store_short %0, %1, off" :: "v"((const unsigned char*)(obn + (size_t)(35) * orow + 32) + ooff), "v"(v) : "memory"); }
          { const unsigned v = f2bf(o1_3[0]); asm volatile("global_store_short %0, %1, off" :: "v"((const unsigned char*)(obn + (size_t)(48) * orow + 32) + ooff), "v"(v) : "memory"); }
          { const unsigned v = f2bf(o1_3[1]); asm volatile("global_store_short %0, %1, off" :: "v"((const unsigned char*)(obn + (size_t)(49) * orow + 32) + ooff), "v"(v) : "memory"); }
          { const unsigned v = f2bf(o1_3[2]); asm volatile("global_store_short %0, %1, off" :: "v"((const unsigned char*)(obn + (size_t)(50) * orow + 32) + ooff), "v"(v) : "memory"); }
          { const unsigned v = f2bf(o1_3[3]); asm volatile("global_store_short %0, %1, off" :: "v"((const unsigned char*)(obn + (size_t)(51) * orow + 32) + ooff), "v"(v) : "memory"); }
        }
        __builtin_amdgcn_sched_barrier(0);
    }
    asm volatile("s_waitcnt vmcnt(0)" ::: "memory");
    } else if constexpr (!GDN && ROLE == 0) {
    bf16x8 r0 = (bf16x8){0, 0, 0, 0, 0, 0, 0, 0};
    bf16x8 r1 = (bf16x8){0, 0, 0, 0, 0, 0, 0, 0};
    bf16x8 r2 = (bf16x8){0, 0, 0, 0, 0, 0, 0, 0};
    bf16x8 r3 = (bf16x8){0, 0, 0, 0, 0, 0, 0, 0};
    bf16x8 r4 = (bf16x8){0, 0, 0, 0, 0, 0, 0, 0};
    bf16x8 r5 = (bf16x8){0, 0, 0, 0, 0, 0, 0, 0};
    bf16x8 r6 = (bf16x8){0, 0, 0, 0, 0, 0, 0, 0};
    bf16x8 r7 = (bf16x8){0, 0, 0, 0, 0, 0, 0, 0};
    bf16x8 r8 = (bf16x8){0, 0, 0, 0, 0, 0, 0, 0};
    bf16x8 r9 = (bf16x8){0, 0, 0, 0, 0, 0, 0, 0};
    bf16x8 r10 = (bf16x8){0, 0, 0, 0, 0, 0, 0, 0};
    bf16x8 r11 = (bf16x8){0, 0, 0, 0, 0, 0, 0, 0};
    bf16x8 r12 = (bf16x8){0, 0, 0, 0, 0, 0, 0, 0};
    bf16x8 r13 = (bf16x8){0, 0, 0, 0, 0, 0, 0, 0};
    bf16x8 r14 = (bf16x8){0, 0, 0, 0, 0, 0, 0, 0};
    bf16x8 r15 = (bf16x8){0, 0, 0, 0, 0, 0, 0, 0};
    f32x4 S0_0 = {0.f, 0.f, 0.f, 0.f};
    f32x4 S0_1 = {0.f, 0.f, 0.f, 0.f};
    f32x4 S0_2 = {0.f, 0.f, 0.f, 0.f};
    f32x4 S0_3 = {0.f, 0.f, 0.f, 0.f};
    f32x4 S0_4 = {0.f, 0.f, 0.f, 0.f};
    f32x4 S0_5 = {0.f, 0.f, 0.f, 0.f};
    f32x4 S0_6 = {0.f, 0.f, 0.f, 0.f};
    f32x4 S0_7 = {0.f, 0.f, 0.f, 0.f};
    bf16x8 Sp0_0 = (bf16x8){0, 0, 0, 0, 0, 0, 0, 0};
    bf16x8 Sp0_1 = (bf16x8){0, 0, 0, 0, 0, 0, 0, 0};
    bf16x8 Sp0_2 = (bf16x8){0, 0, 0, 0, 0, 0, 0, 0};
    bf16x8 Sp0_3 = (bf16x8){0, 0, 0, 0, 0, 0, 0, 0};
    f32x4 S1_0 = {0.f, 0.f, 0.f, 0.f};
    f32x4 S1_1 = {0.f, 0.f, 0.f, 0.f};
    f32x4 S1_2 = {0.f, 0.f, 0.f, 0.f};
    f32x4 S1_3 = {0.f, 0.f, 0.f, 0.f};
    f32x4 S1_4 = {0.f, 0.f, 0.f, 0.f};
    f32x4 S1_5 = {0.f, 0.f, 0.f, 0.f};
    f32x4 S1_6 = {0.f, 0.f, 0.f, 0.f};
    f32x4 S1_7 = {0.f, 0.f, 0.f, 0.f};
    bf16x8 Sp1_0 = (bf16x8){0, 0, 0, 0, 0, 0, 0, 0};
    bf16x8 Sp1_1 = (bf16x8){0, 0, 0, 0, 0, 0, 0, 0};
    bf16x8 Sp1_2 = (bf16x8){0, 0, 0, 0, 0, 0, 0, 0};
    bf16x8 Sp1_3 = (bf16x8){0, 0, 0, 0, 0, 0, 0, 0};
    unsigned vn0_0 = 0u, vn0_1 = 0u, vn0_2 = 0u, vn0_3 = 0u, vn0_4 = 0u, vn0_5 = 0u, vn0_6 = 0u, vn0_7 = 0u, vn0_8 = 0u, vn0_9 = 0u, vn0_10 = 0u, vn0_11 = 0u, vn0_12 = 0u, vn0_13 = 0u, vn0_14 = 0u, vn0_15 = 0u;
    unsigned vn1_0 = 0u, vn1_1 = 0u, vn1_2 = 0u, vn1_3 = 0u, vn1_4 = 0u, vn1_5 = 0u, vn1_6 = 0u, vn1_7 = 0u, vn1_8 = 0u, vn1_9 = 0u, vn1_10 = 0u, vn1_11 = 0u, vn1_12 = 0u, vn1_13 = 0u, vn1_14 = 0u, vn1_15 = 0u;
    { const int n = 0; (void)n;
    asm volatile("global_load_ushort %0, %1, off" : "+v"(vn0_0) : "v"((const unsigned char*)(vbu + (size_t)(0) * vrow + 0) + voff2) : "memory");
    asm volatile("global_load_ushort %0, %1, off" : "+v"(vn0_1) : "v"((const unsigned char*)(vbu + (size_t)(1) * vrow + 0) + voff2) : "memory");
    asm volatile("global_load_ushort %0, %1, off" : "+v"(vn0_2) : "v"((const unsigned char*)(vbu + (size_t)(2) * vrow + 0) + voff2) : "memory");
    asm volatile("global_load_ushort %0, %1, off" : "+v"(vn0_3) : "v"((const unsigned char*)(vbu + (size_t)(3) * vrow + 0) + voff2) : "memory");
    asm volatile("global_load_ushort %0, %1, off" : "+v"(vn0_4) : "v"((const unsigned char*)(vbu + (size_t)(16) * vrow + 0) + voff2) : "memory");
    asm volatile("global_load_ushort %0, %1, off" : "+v"(vn0_5) : "v"((const unsigned char*)(vbu + (size_t)(17) * vrow + 0) + voff2) : "memory");
    asm volatile("global_load_ushort %0, %1, off" : "+v"(vn0_6) : "v"((const unsigned char*)(vbu + (size_t)(18) * vrow + 0) + voff2) : "memory");
    asm volatile("global_load_ushort %0, %1, off" : "+v"(vn0_7) : "v"((const unsigned char*)(vbu + (size_t)(19) * vrow + 0) + voff2) : "memory");
    asm volatile("global_load_ushort %0, %1, off" : "+v"(vn0_8) : "v"((const unsigned char*)(vbu + (size_t)(32) * vrow + 0) + voff2) : "memory");
    asm volatile("global_load_ushort %0, %1, off" : "+v"(vn0_9) : "v"((const unsigned char*)(vbu + (size_t)(33) * vrow + 0) + voff2) : "memory");
    asm volatile("global_load_ushort %0, %1, off" : "+v"(vn0_10) : "v"((const unsigned char*)(vbu + (size_t)(34) * vrow + 0) + voff2) : "memory");
    asm volatile("global_load_ushort %0, %1, off" : "+v"(vn0_11) : "v"((const unsigned char*)(vbu + (size_t)(35) * vrow + 0) + voff2) : "memory");
    asm volatile("global_load_ushort %0, %1, off" : "+v"(vn0_12) : "v"((const unsigned char*)(vbu + (size_t)(48) * vrow + 0) + voff2) : "memory");
    asm volatile("global_load_ushort %0, %1, off" : "+v"(vn0_13) : "v"((const unsigned char*)(vbu + (size_t)(49) * vrow + 0) + voff2) : "memory");
    asm volatile("global_load_ushort %0, %1, off" : "+v"(vn0_14) : "v"((const unsigned char*)(vbu + (size_t)(50) * vrow + 0) + voff2) : "memory");
    asm volatile("global_load_ushort %0, %1, off" : "+v"(vn0_15) : "v"((const unsigned char*)(vbu + (size_t)(51) * vrow + 0) + voff2) : "memory");
    asm volatile("global_load_ushort %0, %1, off" : "+v"(vn1_0) : "v"((const unsigned char*)(vbu + (size_t)(0) * vrow + 32) + voff2) : "memory");
    asm volatile("global_load_ushort %0, %1, off" : "+v"(vn1_1) : "v"((const unsigned char*)(vbu + (size_t)(1) * vrow + 32) + voff2) : "memory");
    asm volatile("global_load_ushort %0, %1, off" : "+v"(vn1_2) : "v"((const unsigned char*)(vbu + (size_t)(2) * vrow + 32) + voff2) : "memory");
    asm volatile("global_load_ushort %0, %1, off" : "+v"(vn1_3) : "v"((const unsigned char*)(vbu + (size_t)(3) * vrow + 32) + voff2) : "memory");
    asm volatile("global_load_ushort %0, %1, off" : "+v"(vn1_4) : "v"((const unsigned char*)(vbu + (size_t)(16) * vrow + 32) + voff2) : "memory");
    asm volatile("global_load_ushort %0, %1, off" : "+v"(vn1_5) : "v"((const unsigned char*)(vbu + (size_t)(17) * vrow + 32) + voff2) : "memory");
    asm volatile("global_load_ushort %0, %1, off" : "+v"(vn1_6) : "v"((const unsigned char*)(vbu + (size_t)(18) * vrow + 32) + voff2) : "memory");
    asm volatile("global_load_ushort %0, %1, off" : "+v"(vn1_7) : "v"((const unsigned char*)(vbu + (size_t)(19) * vrow + 32) + voff2) : "memory");
    asm volatile("global_load_ushort %0, %1, off" : "+v"(vn1_8) : "v"((const unsigned char*)(vbu + (size_t)(32) * vrow + 32) + voff2) : "memory");
    asm volatile("global_load_ushort %0, %1, off" : "+v"(vn1_9) : "v"((const unsigned char*)(vbu + (size_t)(33) * vrow + 32) + voff2) : "memory");
    asm volatile("global_load_ushort %0, %1, off" : "+v"(vn1_10) : "v"((const unsigned char*)(vbu + (size_t)(34) * vrow + 32) + voff2) : "memory");
    asm volatile("global_load_ushort %0, %1, off" : "+v"(vn1_11) : "v"((const unsigned char*)(vbu + (size_t)(35) * vrow + 32) + voff2) : "memory");
    asm volatile("global_load_ushort %0, %1, off" : "+v"(vn1_12) : "v"((const unsigned char*)(vbu + (size_t)(48) * vrow + 32) + voff2) : "memory");
    asm volatile("global_load_ushort %0, %1, off" : "+v"(vn1_13) : "v"((const unsigned char*)(vbu + (size_t)(49) * vrow + 32) + voff2) : "memory");
    asm volatile("global_load_ushort %0, %1, off" : "+v"(vn1_14) : "v"((const unsigned char*)(vbu + (size_t)(50) * vrow + 32) + voff2) : "memory");
    asm volatile("global_load_ushort %0, %1, off" : "+v"(vn1_15) : "v"((const unsigned char*)(vbu + (size_t)(51) * vrow + 32) + voff2) : "memory");
    asm volatile("global_load_dwordx4 %0, %1, off" : "+v"(r0) : "v"((const unsigned char*)(sp0 + ((size_t)(n + 0) * 40 + 24) * 1024) + voff) : "memory");
    asm volatile("global_load_dwordx4 %0, %1, off" : "+v"(r1) : "v"((const unsigned char*)(sp0 + ((size_t)(n + 0) * 40 + 25) * 1024) + voff) : "memory");
    asm volatile("global_load_dwordx4 %0, %1, off" : "+v"(r2) : "v"((const unsigned char*)(sp0 + ((size_t)(n + 0) * 40 + 26) * 1024) + voff) : "memory");
    asm volatile("global_load_dwordx4 %0, %1, off" : "+v"(r3) : "v"((const unsigned char*)(sp0 + ((size_t)(n + 0) * 40 + 27) * 1024) + voff) : "memory");
    asm volatile("global_load_dwordx4 %0, %1, off" : "+v"(r4) : "v"((const unsigned char*)(sp0 + ((size_t)(n + 0) * 40 + 28) * 1024) + voff) : "memory");
    asm volatile("global_load_dwordx4 %0, %1, off" : "+v"(r5) : "v"((const unsigned char*)(sp0 + ((size_t)(n + 0) * 40 + 29) * 1024) + voff) : "memory");
    asm volatile("global_load_dwordx4 %0, %1, off" : "+v"(r6) : "v"((const unsigned char*)(sp0 + ((size_t)(n + 0) * 40 + 30) * 1024) + voff) : "memory");
    asm volatile("global_load_dwordx4 %0, %1, off" : "+v"(r7) : "v"((const unsigned char*)(sp0 + ((size_t)(n + 0) * 40 + 31) * 1024) + voff) : "memory");
    asm volatile("global_load_dwordx4 %0, %1, off" : "+v"(r8) : "v"((const unsigned char*)(sp0 + ((size_t)(n + 0) * 40 + 32) * 1024) + voff) : "memory");
    asm volatile("global_load_dwordx4 %0, %1, off" : "+v"(r9) : "v"((const unsigned char*)(sp0 + ((size_t)(n + 0) * 40 + 33) * 1024) + voff) : "memory");
    asm volatile("global_load_dwordx4 %0, %1, off" : "+v"(r10) : "v"((const unsigned char*)(sp0 + ((size_t)(n + 0) * 40 + 34) * 1024) + voff) : "memory");
    asm volatile("global_load_dwordx4 %0, %1, off" : "+v"(r11) : "v"((const unsigned char*)(sp0 + ((size_t)(n + 0) * 40 + 35) * 1024) + voff) : "memory");
    asm volatile("global_load_dwordx4 %0, %1, off" : "+v"(r12) : "v"((const unsigned char*)(sp0 + ((size_t)(n + 0) * 40 + 36) * 1024) + voff) : "memory");
    asm volatile("global_load_dwordx4 %0, %1, off" : "+v"(r13) : "v"((const unsigned char*)(sp0 + ((size_t)(n + 0) * 40 + 37) * 1024) + voff) : "memory");
    asm volatile("global_load_dwordx4 %0, %1, off" : "+v"(r14) : "v"((const unsigned char*)(sp0 + ((size_t)(n + 0) * 40 + 38) * 1024) + voff) : "memory");
    asm volatile("global_load_dwordx4 %0, %1, off" : "+v"(r15) : "v"((const unsigned char*)(sp0 + ((size_t)(n + 0) * 40 + 39) * 1024) + voff) : "memory");
    }
#pragma unroll 1
    for (int n = 0; n < NCH; ++n) {
        const int nn = n + 1 < NCH ? n + 1 : n;
        f32x4 a0_0, a0_1, a0_2, a0_3;
        f32x4 a1_0, a1_1, a1_2, a1_3;
        asm volatile("s_waitcnt vmcnt(16)" : "+v"(vn0_0), "+v"(vn0_1), "+v"(vn0_2), "+v"(vn0_3), "+v"(vn0_4), "+v"(vn0_5), "+v"(vn0_6), "+v"(vn0_7), "+v"(vn0_8), "+v"(vn0_9), "+v"(vn0_10), "+v"(vn0_11), "+v"(vn0_12), "+v"(vn0_13), "+v"(vn0_14), "+v"(vn0_15));
        asm volatile("s_waitcnt vmcnt(16)" : "+v"(vn1_0), "+v"(vn1_1), "+v"(vn1_2), "+v"(vn1_3), "+v"(vn1_4), "+v"(vn1_5), "+v"(vn1_6), "+v"(vn1_7), "+v"(vn1_8), "+v"(vn1_9), "+v"(vn1_10), "+v"(vn1_11), "+v"(vn1_12), "+v"(vn1_13), "+v"(vn1_14), "+v"(vn1_15));
        a0_0 = (f32x4){__builtin_bit_cast(float, vn0_0 << 16), __builtin_bit_cast(float, vn0_1 << 16), __builtin_bit_cast(float, vn0_2 << 16), __builtin_bit_cast(float, vn0_3 << 16)};
        a0_1 = (f32x4){__builtin_bit_cast(float, vn0_4 << 16), __builtin_bit_cast(float, vn0_5 << 16), __builtin_bit_cast(float, vn0_6 << 16), __builtin_bit_cast(float, vn0_7 << 16)};
        a0_2 = (f32x4){__builtin_bit_cast(float, vn0_8 << 16), __builtin_bit_cast(float, vn0_9 << 16), __builtin_bit_cast(float, vn0_10 << 16), __builtin_bit_cast(float, vn0_11 << 16)};
        a0_3 = (f32x4){__builtin_bit_cast(float, vn0_12 << 16), __builtin_bit_cast(float, vn0_13 << 16), __builtin_bit_cast(float, vn0_14 << 16), __builtin_bit_cast(float, vn0_15 << 16)};
        a1_0 = (f32x4){__builtin_bit_cast(float, vn1_0 << 16), __builtin_bit_cast(float, vn1_1 << 16), __builtin_bit_cast(float, vn1_2 << 16), __builtin_bit_cast(float, vn1_3 << 16)};
        a1_1 = (f32x4){__builtin_bit_cast(float, vn1_4 << 16), __builtin_bit_cast(float, vn1_5 << 16), __builtin_bit_cast(float, vn1_6 << 16), __builtin_bit_cast(float, vn1_7 << 16)};
        a1_2 = (f32x4){__builtin_bit_cast(float, vn1_8 << 16), __builtin_bit_cast(float, vn1_9 << 16), __builtin_bit_cast(float, vn1_10 << 16), __builtin_bit_cast(float, vn1_11 << 16)};
        a1_3 = (f32x4){__builtin_bit_cast(float, vn1_12 << 16), __builtin_bit_cast(float, vn1_13 << 16), __builtin_bit_cast(float, vn1_14 << 16), __builtin_bit_cast(float, vn1_15 << 16)};
        const float dec = decr;
        { const unsigned char* vbn = vbu + (size_t)nn * 64 * vrow;
          asm volatile("global_load_ushort %0, %1, off" : "+v"(vn0_0) : "v"((const unsigned char*)(vbn + (size_t)(0) * vrow + 0) + voff2) : "memory");
          asm volatile("global_load_ushort %0, %1, off" : "+v"(vn0_1) : "v"((const unsigned char*)(vbn + (size_t)(1) * vrow + 0) + voff2) : "memory");
          asm volatile("global_load_ushort %0, %1, off" : "+v"(vn0_2) : "v"((const unsigned char*)(vbn + (size_t)(2) * vrow + 0) + voff2) : "memory");
          asm volatile("global_load_ushort %0, %1, off" : "+v"(vn0_3) : "v"((const unsigned char*)(vbn + (size_t)(3) * vrow + 0) + voff2) : "memory");
          asm volatile("global_load_ushort %0, %1, off" : "+v"(vn0_4) : "v"((const unsigned char*)(vbn + (size_t)(16) * vrow + 0) + voff2) : "memory");
          asm volatile("global_load_ushort %0, %1, off" : "+v"(vn0_5) : "v"((const unsigned char*)(vbn + (size_t)(17) * vrow + 0) + voff2) : "memory");
          asm volatile("global_load_ushort %0, %1, off" : "+v"(vn0_6) : "v"((const unsigned char*)(vbn + (size_t)(18) * vrow + 0) + voff2) : "memory");
          asm volatile("global_load_ushort %0, %1, off" : "+v"(vn0_7) : "v"((const unsigned char*)(vbn + (size_t)(19) * vrow + 0) + voff2) : "memory");
          asm volatile("global_load_ushort %0, %1, off" : "+v"(vn0_8) : "v"((const unsigned char*)(vbn + (size_t)(32) * vrow + 0) + voff2) : "memory");
          asm volatile("global_load_ushort %0, %1, off" : "+v"(vn0_9) : "v"((const unsigned char*)(vbn + (size_t)(33) * vrow + 0) + voff2) : "memory");
          asm volatile("global_load_ushort %0, %1, off" : "+v"(vn0_10) : "v"((const unsigned char*)(vbn + (size_t)(34) * vrow + 0) + voff2) : "memory");
          asm volatile("global_load_ushort %0, %1, off" : "+v"(vn0_11) : "v"((const unsigned char*)(vbn + (size_t)(35) * vrow + 0) + voff2) : "memory");
          asm volatile("global_load_ushort %0, %1, off" : "+v"(vn0_12) : "v"((const unsigned char*)(vbn + (size_t)(48) * vrow + 0) + voff2) : "memory");
          asm volatile("global_load_ushort %0, %1, off" : "+v"(vn0_13) : "v"((const unsigned char*)(vbn + (size_t)(49) * vrow + 0) + voff2) : "memory");
          asm volatile("global_load_ushort %0, %1, off" : "+v"(vn0_14) : "v"((const unsigned char*)(vbn + (size_t)(50) * vrow + 0) + voff2) : "memory");
          asm volatile("global_load_ushort %0, %1, off" : "+v"(vn0_15) : "v"((const unsigned char*)(vbn + (size_t)(51) * vrow + 0) + voff2) : "memory");
          asm volatile("global_load_ushort %0, %1, off" : "+v"(vn1_0) : "v"((const unsigned char*)(vbn + (size_t)(0) * vrow + 32) + voff2) : "memory");
          asm volatile("global_load_ushort %0, %1, off" : "+v"(vn1_1) : "v"((const unsigned char*)(vbn + (size_t)(1) * vrow + 32) + voff2) : "memory");
          asm volatile("global_load_ushort %0, %1, off" : "+v"(vn1_2) : "v"((const unsigned char*)(vbn + (size_t)(2) * vrow + 32) + voff2) : "memory");
          asm volatile("global_load_ushort %0, %1, off" : "+v"(vn1_3) : "v"((const unsigned char*)(vbn + (size_t)(3) * vrow + 32) + voff2) : "memory");
          asm volatile("global_load_ushort %0, %1, off" : "+v"(vn1_4) : "v"((const unsigned char*)(vbn + (size_t)(16) * vrow + 32) + voff2) : "memory");
          asm volatile("global_load_ushort %0, %1, off" : "+v"(vn1_5) : "v"((const unsigned char*)(vbn + (size_t)(17) * vrow + 32) + voff2) : "memory");
          asm volatile("global_load_ushort %0, %1, off" : "+v"(vn1_6) : "v"((const unsigned char*)(vbn + (size_t)(18) * vrow + 32) + voff2) : "memory");
          asm volatile("global_load_ushort %0, %1, off" : "+v"(vn1_7) : "v"((const unsigned char*)(vbn + (size_t)(19) * vrow + 32) + voff2) : "memory");
          asm volatile("global_load_ushort %0, %1, off" : "+v"(vn1_8) : "v"((const unsigned char*)(vbn + (size_t)(32) * vrow + 32) + voff2) : "memory");
          asm volatile("global_load_ushort %0, %1, off" : "+v"(vn1_9) : "v"((const unsigned char*)(vbn + (size_t)(33) * vrow + 32) + voff2) : "memory");
          asm volatile("global_load_ushort %0, %1, off" : "+v"(vn1_10) : "v"((const unsigned char*)(vbn + (size_t)(34) * vrow + 32) + voff2) : "memory");
          asm volatile("global_load_ushort %0, %1, off" : "+v"(vn1_11) : "v"((const unsigned char*)(vbn + (size_t)(35) * vrow + 32) + voff2) : "memory");
          asm volatile("global_load_ushort %0, %1, off" : "+v"(vn1_12) : "v"((const unsigned char*)(vbn + (size_t)(48) * vrow + 32) + voff2) : "memory");
          asm volatile("global_load_ushort %0, %1, off" : "+v"(vn1_13) : "v"((const unsigned char*)(vbn + (size_t)(49) * vrow + 32) + voff2) : "memory");
          asm volatile("global_load_ushort %0, %1, off" : "+v"(vn1_14) : "v"((const unsigned char*)(vbn + (size_t)(50) * vrow + 32) + voff2) : "memory");
          asm volatile("global_load_ushort %0, %1, off" : "+v"(vn1_15) : "v"((const unsigned char*)(vbn + (size_t)(51) * vrow + 32) + voff2) : "memory");
        }
        __builtin_amdgcn_sched_barrier(0);
        bf16x8 vp0_0, vp0_1;
        { u32x4 w; w.x = cvt_pk_bf16(a0_0[0], a0_0[1]); w.y = cvt_pk_bf16(a0_0[2], a0_0[3]); w.z = cvt_pk_bf16(a0_1[0], a0_1[1]); w.w = cvt_pk_bf16(a0_1[2], a0_1[3]); vp0_0 = __builtin_bit_cast(bf16x8, w); }
        { u32x4 w; w.x = cvt_pk_bf16(a0_2[0], a0_2[1]); w.y = cvt_pk_bf16(a0_2[2], a0_2[3]); w.z = cvt_pk_bf16(a0_3[0], a0_3[1]); w.w = cvt_pk_bf16(a0_3[2], a0_3[3]); vp0_1 = __builtin_bit_cast(bf16x8, w); }
        bf16x8 vp1_0, vp1_1;
        { u32x4 w; w.x = cvt_pk_bf16(a1_0[0], a1_0[1]); w.y = cvt_pk_bf16(a1_0[2], a1_0[3]); w.z = cvt_pk_bf16(a1_1[0], a1_1[1]); w.w = cvt_pk_bf16(a1_1[2], a1_1[3]); vp1_0 = __builtin_bit_cast(bf16x8, w); }
        { u32x4 w; w.x = cvt_pk_bf16(a1_2[0], a1_2[1]); w.y = cvt_pk_bf16(a1_2[2], a1_2[3]); w.z = cvt_pk_bf16(a1_3[0], a1_3[1]); w.w = cvt_pk_bf16(a1_3[2], a1_3[3]); vp1_1 = __builtin_bit_cast(bf16x8, w); }
        { unsigned sp_ = 0; while (*(volatile LAS unsigned*)(xl + XL_CNT + 64) + 4u <= (unsigned)n) { __builtin_amdgcn_s_sleep(1); if (++sp_ > (1u << 22)) break; } }
        { LAS bf16x8* sl_ = (LAS bf16x8*)(xl + (n & 3) * XL_SLOT) + lane; sl_[0] = Sp0_0; sl_[64] = Sp0_1; sl_[128] = Sp0_2; sl_[192] = Sp0_3; sl_[256] = vp0_0; sl_[320] = vp0_1; sl_[384] = Sp1_0; sl_[448] = Sp1_1; sl_[512] = Sp1_2; sl_[576] = Sp1_3; sl_[640] = vp1_0; sl_[704] = vp1_1; }
        asm volatile("s_waitcnt lgkmcnt(0)" ::: "memory");
        if (lane == 0) *(volatile LAS unsigned*)(xl + XL_CNT) = (unsigned)(n + 1);
        S0_0 = S0_0 * dec;
        S1_0 = S1_0 * dec;
        asm volatile("s_waitcnt vmcnt(47)" : "+v"(r0));
        S0_0 = mfma16(r0, vp0_0, S0_0);
        S1_0 = mfma16(r0, vp1_0, S1_0);
        asm volatile("global_load_dwordx4 %0, %1, off" : "+v"(r0) : "v"((const unsigned char*)(sp0 + ((size_t)(n + 1) * 40 + 24) * 1024) + voff) : "memory");
        __builtin_amdgcn_sched_barrier(0);
        asm volatile("s_waitcnt vmcnt(47)" : "+v"(r1));
        S0_0 = mfma16(r1, vp0_1, S0_0);
        S1_0 = mfma16(r1, vp1_1, S1_0);
        asm volatile("global_load_dwordx4 %0, %1, off" : "+v"(r1) : "v"((const unsigned char*)(sp0 + ((size_t)(n + 1) * 40 + 25) * 1024) + voff) : "memory");
        __builtin_amdgcn_sched_barrier(0);
        S0_1 = S0_1 * dec;
        S1_1 = S1_1 * dec;
        asm volatile("s_waitcnt vmcnt(47)" : "+v"(r2));
        S0_1 = mfma16(r2, vp0_0, S0_1);
        S1_1 = mfma16(r2, vp1_0, S1_1);
        asm volatile("global_load_dwordx4 %0, %1, off" : "+v"(r2) : "v"((const unsigned char*)(sp0 + ((size_t)(n + 1) * 40 + 26) * 1024) + voff) : "memory");
        __builtin_amdgcn_sched_barrier(0);
        asm volatile("s_waitcnt vmcnt(47)" : "+v"(r3));
        S0_1 = mfma16(r3, vp0_1, S0_1);
        S1_1 = mfma16(r3, vp1_1, S1_1);
        asm volatile("global_load_dwordx4 %0, %1, off" : "+v"(r3) : "v"((const unsigned char*)(sp0 + ((size_t)(n + 1) * 40 + 27) * 1024) + voff) : "memory");
        __builtin_amdgcn_sched_barrier(0);
        S0_2 = S0_2 * dec;
        S1_2 = S1_2 * dec;
        asm volatile("s_waitcnt vmcnt(47)" : "+v"(r4));
        S0_2 = mfma16(r4, vp0_0, S0_2);
        S1_2 = mfma16(r4, vp1_0, S1_2);
        asm volatile("global_load_dwordx4 %0, %1, off" : "+v"(r4) : "v"((const unsigned char*)(sp0 + ((size_t)(n + 1) * 40 + 28) * 1024) + voff) : "memory");
        __builtin_amdgcn_sched_barrier(0);
        asm volatile("s_waitcnt vmcnt(47)" : "+v"(r5));
        S0_2 = mfma16(r5, vp0_1, S0_2);
        S1_2 = mfma16(r5, vp1_1, S1_2);
        asm volatile("global_load_dwordx4 %0, %1, off" : "+v"(r5) : "v"((const unsigned char*)(sp0 + ((size_t)(n + 1) * 40 + 29) * 1024) + voff) : "memory");
        __builtin_amdgcn_sched_barrier(0);
        S0_3 = S0_3 * dec;
        S1_3 = S1_3 * dec;
        asm volatile("s_waitcnt vmcnt(47)" : "+v"(r6));
        S0_3 = mfma16(r6, vp0_0, S0_3);
        S1_3 = mfma16(r6, vp1_0, S1_3);
        asm volatile("global_load_dwordx4 %0, %1, off" : "+v"(r6) : "v"((const unsigned char*)(sp0 + ((size_t)(n + 1) * 40 + 30) * 1024) + voff) : "memory");
        __builtin_amdgcn_sched_barrier(0);
        asm volatile("s_waitcnt vmcnt(47)" : "+v"(r7));
        S0_3 = mfma16(r7, vp0_1, S0_3);
        S1_3 = mfma16(r7, vp1_1, S1_3);
        asm volatile("global_load_dwordx4 %0, %1, off" : "+v"(r7) : "v"((const unsigned char*)(sp0 + ((size_t)(n + 1) * 40 + 31) * 1024) + voff) : "memory");
        __builtin_amdgcn_sched_barrier(0);
        S0_4 = S0_4 * dec;
        S1_4 = S1_4 * dec;
        asm volatile("s_waitcnt vmcnt(47)" : "+v"(r8));
        S0_4 = mfma16(r8, vp0_0, S0_4);
        S1_4 = mfma16(r8, vp1_0, S1_4);
        asm volatile("global_load_dwordx4 %0, %1, off" : "+v"(r8) : "v"((const unsigned char*)(sp0 + ((size_t)(n + 1) * 40 + 32) * 1024) + voff) : "memory");
        __builtin_amdgcn_sched_barrier(0);
        asm volatile("s_waitcnt vmcnt(47)" : "+v"(r9));
        S0_4 = mfma16(r9, vp0_1, S0_4);
        S1_4 = mfma16(r9, vp1_1, S1_4);
        asm volatile("global_load_dwordx4 %0, %1, off" : "+v"(r9) : "v"((const unsigned char*)(sp0 + ((size_t)(n + 1) * 40 + 33) * 1024) + voff) : "memory");
        __builtin_amdgcn_sched_barrier(0);
        S0_5 = S0_5 * dec;
        S1_5 = S1_5 * dec;
        asm volatile("s_waitcnt vmcnt(47)" : "+v"(r10));
        S0_5 = mfma16(r10, vp0_0, S0_5);
        S1_5 = mfma16(r10, vp1_0, S1_5);
        asm volatile("global_load_dwordx4 %0, %1, off" : "+v"(r10) : "v"((const unsigned char*)(sp0 + ((size_t)(n + 1) * 40 + 34) * 1024) + voff) : "memory");
        __builtin_amdgcn_sched_barrier(0);
        asm volatile("s_waitcnt vmcnt(47)" : "+v"(r11));
        S0_5 = mfma16(r11, vp0_1, S0_5);
        S1_5 = mfma16(r11, vp1_1, S1_5);
        asm volatile("global_load_dwordx4 %0, %1, off" : "+v"(r11) : "v"((const unsigned char*)(sp0 + ((size_t)(n + 1) * 40 + 35) * 1024) + voff) : "memory");
        __builtin_amdgcn_sched_barrier(0);
        S0_6 = S0_6 * dec;
        S1_6 = S1_6 * dec;
        asm volatile("s_waitcnt vmcnt(47)" : "+v"(r12));
        S0_6 = mfma16(r12, vp0_0, S0_6);
        S1_6 = mfma16(r12, vp1_0, S1_6);
        asm volatile("global_load_dwordx4 %0, %1, off" : "+v"(r12) : "v"((const unsigned char*)(sp0 + ((size_t)(n + 1) * 40 + 36) * 1024) + voff) : "memory");
        __builtin_amdgcn_sched_barrier(0);
        asm volatile("s_waitcnt vmcnt(47)" : "+v"(r13));
        S0_6 = mfma16(r13, vp0_1, S0_6);
        S1_6 = mfma16(r13, vp1_1, S1_6);
        asm volatile("global_load_dwordx4 %0, %1, off" : "+v"(r13) : "v"((const unsigned char*)(sp0 + ((size_t)(n + 1) * 40 + 37) * 1024) + voff) : "memory");
        __builtin_amdgcn_sched_barrier(0);
        S0_7 = S0_7 * dec;
        S1_7 = S1_7 * dec;
        asm volatile("s_waitcnt vmcnt(47)" : "+v"(r14));
        S0_7 = mfma16(r14, vp0_0, S0_7);
        S1_7 = mfma16(r14, vp1_0, S1_7);
        asm volatile("global_load_dwordx4 %0, %1, off" : "+v"(r14) : "v"((const unsigned char*)(sp0 + ((size_t)(n + 1) * 40 + 38) * 1024) + voff) : "memory");
        __builtin_amdgcn_sched_barrier(0);
        asm volatile("s_waitcnt vmcnt(47)" : "+v"(r15));
        S0_7 = mfma16(r15, vp0_1, S0_7);
        S1_7 = mfma16(r15, vp1_1, S1_7);
        asm volatile("global_load_dwordx4 %0, %1, off" : "+v"(r15) : "v"((const unsigned char*)(sp0 + ((size_t)(n + 1) * 40 + 39) * 1024) + voff) : "memory");
        __builtin_amdgcn_sched_barrier(0);
        { u32x4 w; w.x = cvt_pk_bf16(S0_0[0], S0_0[1]); w.y = cvt_pk_bf16(S0_0[2], S0_0[3]); w.z = cvt_pk_bf16(S0_1[0], S0_1[1]); w.w = cvt_pk_bf16(S0_1[2], S0_1[3]); Sp0_0 = __builtin_bit_cast(bf16x8, w); }
        { u32x4 w; w.x = cvt_pk_bf16(S0_2[0], S0_2[1]); w.y = cvt_pk_bf16(S0_2[2], S0_2[3]); w.z = cvt_pk_bf16(S0_3[0], S0_3[1]); w.w = cvt_pk_bf16(S0_3[2], S0_3[3]); Sp0_1 = __builtin_bit_cast(bf16x8, w); }
        { u32x4 w; w.x = cvt_pk_bf16(S0_4[0], S0_4[1]); w.y = cvt_pk_bf16(S0_4[2], S0_4[3]); w.z = cvt_pk_bf16(S0_5[0], S0_5[1]); w.w = cvt_pk_bf16(S0_5[2], S0_5[3]); Sp0_2 = __builtin_bit_cast(bf16x8, w); }
        { u32x4 w; w.x = cvt_pk_bf16(S0_6[0], S0_6[1]); w.y = cvt_pk_bf16(S0_6[2], S0_6[3]); w.z = cvt_pk_bf16(S0_7[0], S0_7[1]); w.w = cvt_pk_bf16(S0_7[2], S0_7[3]); Sp0_3 = __builtin_bit_cast(bf16x8, w); }
        { u32x4 w; w.x = cvt_pk_bf16(S1_0[0], S1_0[1]); w.y = cvt_pk_bf16(S1_0[2], S1_0[3]); w.z = cvt_pk_bf16(S1_1[0], S1_1[1]); w.w = cvt_pk_bf16(S1_1[2], S1_1[3]); Sp1_0 = __builtin_bit_cast(bf16x8, w); }
        { u32x4 w; w.x = cvt_pk_bf16(S1_2[0], S1_2[1]); w.y = cvt_pk_bf16(S1_2[2], S1_2[3]); w.z = cvt_pk_bf16(S1_3[0], S1_3[1]); w.w = cvt_pk_bf16(S1_3[2], S1_3[3]); Sp1_1 = __builtin_bit_cast(bf16x8, w); }
        { u32x4 w; w.x = cvt_pk_bf16(S1_4[0], S1_4[1]); w.y = cvt_pk_bf16(S1_4[2], S1_4[3]); w.z = cvt_pk_bf16(S1_5[0], S1_5[1]); w.w = cvt_pk_bf16(S1_5[2], S1_5[3]); Sp1_2 = __builtin_bit_cast(bf16x8, w); }
        { u32x4 w; w.x = cvt_pk_bf16(S1_6[0], S1_6[1]); w.y = cvt_pk_bf16(S1_6[2], S1_6[3]); w.z = cvt_pk_bf16(S1_7[0], S1_7[1]); w.w = cvt_pk_bf16(S1_7[2], S1_7[3]); Sp1_3 = __builtin_bit_cast(bf16x8, w); }
    }
    asm volatile("s_waitcnt vmcnt(0)" ::: "memory");
    } else {
    bf16x8 r0 = (bf16x8){0, 0, 0, 0, 0, 0, 0, 0};
    bf16x8 r1 = (bf16x8){0, 0, 0, 0, 0, 0, 0, 0};
    bf16x8 r2 = (bf16x8){0, 0, 0, 0, 0, 0, 0, 0};
    bf16x8 r3 = (bf16x8){0, 0, 0, 0, 0, 0, 0, 0};
    bf16x8 r4 = (bf16x8){0, 0, 0, 0, 0, 0, 0, 0};
    bf16x8 r5 = (bf16x8){0, 0, 0, 0, 0, 0, 0, 0};
    bf16x8 r6 = (bf16x8){0, 0, 0, 0, 0, 0, 0, 0};
    bf16x8 r7 = (bf16x8){0, 0, 0, 0, 0, 0, 0, 0};
    bf16x8 r8 = (bf16x8){0, 0, 0, 0, 0, 0, 0, 0};
    bf16x8 r9 = (bf16x8){0, 0, 0, 0, 0, 0, 0, 0};
    bf16x8 r10 = (bf16x8){0, 0, 0, 0, 0, 0, 0, 0};
    bf16x8 r11 = (bf16x8){0, 0, 0, 0, 0, 0, 0, 0};
    bf16x8 r12 = (bf16x8){0, 0, 0, 0, 0, 0, 0, 0};
    bf16x8 r13 = (bf16x8){0, 0, 0, 0, 0, 0, 0, 0};
    bf16x8 r14 = (bf16x8){0, 0, 0, 0, 0, 0, 0, 0};
    bf16x8 r15 = (bf16x8){0, 0, 0, 0, 0, 0, 0, 0};
    bf16x8 r16 = (bf16x8){0, 0, 0, 0, 0, 0, 0, 0};
    bf16x8 r17 = (bf16x8){0, 0, 0, 0, 0, 0, 0, 0};
    bf16x8 r18 = (bf16x8){0, 0, 0, 0, 0, 0, 0, 0};
    bf16x8 r19 = (bf16x8){0, 0, 0, 0, 0, 0, 0, 0};
    bf16x8 r20 = (bf16x8){0, 0, 0, 0, 0, 0, 0, 0};
    bf16x8 r21 = (bf16x8){0, 0, 0, 0, 0, 0, 0, 0};
    bf16x8 r22 = (bf16x8){0, 0, 0, 0, 0, 0, 0, 0};
    bf16x8 r23 = (bf16x8){0, 0, 0, 0, 0, 0, 0, 0};
    asm volatile("global_load_dwordx4 %0, %1, off" : "+v"(r0) : "v"((const unsigned char*)(sp0 + ((size_t)(0 + 0) * 40 + 0) * 1024) + voff) : "memory");
    asm volatile("global_load_dwordx4 %0, %1, off" : "+v"(r1) : "v"((const unsigned char*)(sp0 + ((size_t)(0 + 0) * 40 + 1) * 1024) + voff) : "memory");
    asm volatile("global_load_dwordx4 %0, %1, off" : "+v"(r2) : "v"((const unsigned char*)(sp0 + ((size_t)(0 + 0) * 40 + 2) * 1024) + voff) : "memory");
    asm volatile("global_load_dwordx4 %0, %1, off" : "+v"(r3) : "v"((const unsigned char*)(sp0 + ((size_t)(0 + 0) * 40 + 3) * 1024) + voff) : "memory");
    asm volatile("global_load_dwordx4 %0, %1, off" : "+v"(r4) : "v"((const unsigned char*)(sp0 + ((size_t)(0 + 0) * 40 + 4) * 1024) + voff) : "memory");
    asm volatile("global_load_dwordx4 %0, %1, off" : "+v"(r5) : "v"((const unsigned char*)(sp0 + ((size_t)(0 + 0) * 40 + 5) * 1024) + voff) : "memory");
    asm volatile("global_load_dwordx4 %0, %1, off" : "+v"(r6) : "v"((const unsigned char*)(sp0 + ((size_t)(0 + 0) * 40 + 6) * 1024) + voff) : "memory");
    asm volatile("global_load_dwordx4 %0, %1, off" : "+v"(r7) : "v"((const unsigned char*)(sp0 + ((size_t)(0 + 0) * 40 + 7) * 1024) + voff) : "memory");
    asm volatile("global_load_dwordx4 %0, %1, off" : "+v"(r8) : "v"((const unsigned char*)(sp0 + ((size_t)(0 + 0) * 40 + 8) * 1024) + voff) : "memory");
    asm volatile("global_load_dwordx4 %0, %1, off" : "+v"(r9) : "v"((const unsigned char*)(sp0 + ((size_t)(0 + 0) * 40 + 9) * 1024) + voff) : "memory");
    asm volatile("global_load_dwordx4 %0, %1, off" : "+v"(r10) : "v"((const unsigned char*)(sp0 + ((size_t)(0 + 0) * 40 + 10) * 1024) + voff) : "memory");
    asm volatile("global_load_dwordx4 %0, %1, off" : "+v"(r11) : "v"((const unsigned char*)(sp0 + ((size_t)(0 + 0) * 40 + 11) * 1024) + voff) : "memory");
    asm volatile("global_load_dwordx4 %0, %1, off" : "+v"(r12) : "v"((const unsigned char*)(sp0 + ((size_t)(0 + 0) * 40 + 12) * 1024) + voff) : "memory");
    asm volatile("global_load_dwordx4 %0, %1, off" : "+v"(r13) : "v"((const unsigned char*)(sp0 + ((size_t)(0 + 0) * 40 + 13) * 1024) + voff) : "memory");
    asm volatile("global_load_dwordx4 %0, %1, off" : "+v"(r14) : "v"((const unsigned char*)(sp0 + ((size_t)(0 + 0) * 40 + 14) * 1024) + voff) : "memory");
    asm volatile("global_load_dwordx4 %0, %1, off" : "+v"(r15) : "v"((const unsigned char*)(sp0 + ((size_t)(0 + 0) * 40 + 15) * 1024) + voff) : "memory");
    asm volatile("global_load_dwordx4 %0, %1, off" : "+v"(r16) : "v"((const unsigned char*)(sp0 + ((size_t)(0 + 0) * 40 + 16) * 1024) + voff) : "memory");
    asm volatile("global_load_dwordx4 %0, %1, off" : "+v"(r17) : "v"((const unsigned char*)(sp0 + ((size_t)(0 + 0) * 40 + 17) * 1024) + voff) : "memory");
    asm volatile("global_load_dwordx4 %0, %1, off" : "+v"(r18) : "v"((const unsigned char*)(sp0 + ((size_t)(0 + 0) * 40 + 18) * 1024) + voff) : "memory");
    asm volatile("global_load_dwordx4 %0, %1, off" : "+v"(r19) : "v"((const unsigned char*)(sp0 + ((size_t)(0 + 0) * 40 + 19) * 1024) + voff) : "memory");
    asm volatile("global_load_dwordx4 %0, %1, off" : "+v"(r20) : "v"((const unsigned char*)(sp0 + ((size_t)(0 + 0) * 40 + 20) * 1024) + voff) : "memory");
    asm volatile("global_load_dwordx4 %0, %1, off" : "+v"(r21) : "v"((const unsigned char*)(sp0 + ((size_t)(0 + 0) * 40 + 21) * 1024) + voff) : "memory");
    asm volatile("global_load_dwordx4 %0, %1, off" : "+v"(r22) : "v"((const unsigned char*)(sp0 + ((size_t)(0 + 0) * 40 + 22) * 1024) + voff) : "memory");
    asm volatile("global_load_dwordx4 %0, %1, off" : "+v"(r23) : "v"((const unsigned char*)(sp0 + ((size_t)(0 + 0) * 40 + 23) * 1024) + voff) : "memory");
    { unsigned z = 0u;
      asm volatile("global_store_short %0, %1, off" :: "v"((const unsigned char*)(obu + (size_t)(0) * orow + 0) + ooff), "v"(z) : "memory");
      asm volatile("global_store_short %0, %1, off" :: "v"((const unsigned char*)(obu + (size_t)(1) * orow + 0) + ooff), "v"(z) : "memory");
      asm volatile("global_store_short %0, %1, off" :: "v"((const unsigned char*)(obu + (size_t)(2) * orow + 0) + ooff), "v"(z) : "memory");
      asm volatile("global_store_short %0, %1, off" :: "v"((const unsigned char*)(obu + (size_t)(3) * orow + 0) + ooff), "v"(z) : "memory");
      asm volatile("global_store_short %0, %1, off" :: "v"((const unsigned char*)(obu + (size_t)(16) * orow + 0) + ooff), "v"(z) : "memory");
      asm volatile("global_store_short %0, %1, off" :: "v"((const unsigned char*)(obu + (size_t)(17) * orow + 0) + ooff), "v"(z) : "memory");
      asm volatile("global_store_short %0, %1, off" :: "v"((const unsigned char*)(obu + (size_t)(18) * orow + 0) + ooff), "v"(z) : "memory");
      asm volatile("global_store_short %0, %1, off" :: "v"((const unsigned char*)(obu + (size_t)(19) * orow + 0) + ooff), "v"(z) : "memory");
      asm volatile("global_store_short %0, %1, off" :: "v"((const unsigned char*)(obu + (size_t)(32) * orow + 0) + ooff), "v"(z) : "memory");
      asm volatile("global_store_short %0, %1, off" :: "v"((const unsigned char*)(obu + (size_t)(33) * orow + 0) + ooff), "v"(z) : "memory");
      asm volatile("global_store_short %0, %1, off" :: "v"((const unsigned char*)(obu + (size_t)(34) * orow + 0) + ooff), "v"(z) : "memory");
      asm volatile("global_store_short %0, %1, off" :: "v"((const unsigned char*)(obu + (size_t)(35) * orow + 0) + ooff), "v"(z) : "memory");
      asm volatile("global_store_short %0, %1, off" :: "v"((const unsigned char*)(obu + (size_t)(48) * orow + 0) + ooff), "v"(z) : "memory");
      asm volatile("global_store_short %0, %1, off" :: "v"((const unsigned char*)(obu + (size_t)(49) * orow + 0) + ooff), "v"(z) : "memory");
      asm volatile("global_store_short %0, %1, off" :: "v"((const unsigned char*)(obu + (size_t)(50) * orow + 0) + ooff), "v"(z) : "memory");
      asm volatile("global_store_short %0, %1, off" :: "v"((const unsigned char*)(obu + (size_t)(51) * orow + 0) + ooff), "v"(z) : "memory");
      asm volatile("global_store_short %0, %1, off" :: "v"((const unsigned char*)(obu + (size_t)(0) * orow + 32) + ooff), "v"(z) : "memory");
      asm volatile("global_store_short %0, %1, off" :: "v"((const unsigned char*)(obu + (size_t)(1) * orow + 32) + ooff), "v"(z) : "memory");
      asm volatile("global_store_short %0, %1, off" :: "v"((const unsigned char*)(obu + (size_t)(2) * orow + 32) + ooff), "v"(z) : "memory");
      asm volatile("global_store_short %0, %1, off" :: "v"((const unsigned char*)(obu + (size_t)(3) * orow + 32) + ooff), "v"(z) : "memory");
      asm volatile("global_store_short %0, %1, off" :: "v"((const unsigned char*)(obu + (size_t)(16) * orow + 32) + ooff), "v"(z) : "memory");
      asm volatile("global_store_short %0, %1, off" :: "v"((const unsigned char*)(obu + (size_t)(17) * orow + 32) + ooff), "v"(z) : "memory");
      asm volatile("global_store_short %0, %1, off" :: "v"((const unsigned char*)(obu + (size_t)(18) * orow + 32) + ooff), "v"(z) : "memory");
      asm volatile("global_store_short %0, %1, off" :: "v"((const unsigned char*)(obu + (size_t)(19) * orow + 32) + ooff), "v"(z) : "memory");
      asm volatile("global_store_short %0, %1, off" :: "v"((const unsigned char*)(obu + (size_t)(32) * orow + 32) + ooff), "v"(z) : "memory");
      asm volatile("global_store_short %0, %1, off" :: "v"((const unsigned char*)(obu + (size_t)(33) * orow + 32) + ooff), "v"(z) : "memory");
      asm volatile("global_store_short %0, %1, off" :: "v"((const unsigned char*)(obu + (size_t)(34) * orow + 32) + ooff), "v"(z) : "memory");
      asm volatile("global_store_short %0, %1, off" :: "v"((const unsigned char*)(obu + (size_t)(35) * orow + 32) + ooff), "v"(z) : "memory");
      asm volatile("global_store_short %0, %1, off" :: "v"((const unsigned char*)(obu + (size_t)(48) * orow + 32) + ooff), "v"(z) : "memory");
      asm volatile("global_store_short %0, %1, off" :: "v"((const unsigned char*)(obu + (size_t)(49) * orow + 32) + ooff), "v"(z) : "memory");
      asm volatile("global_store_short %0, %1, off" :: "v"((const unsigned char*)(obu + (size_t)(50) * orow + 32) + ooff), "v"(z) : "memory");
      asm volatile("global_store_short %0, %1, off" :: "v"((const unsigned char*)(obu + (size_t)(51) * orow + 32) + ooff), "v"(z) : "memory");
    }
#pragma unroll 1
    for (int n = 0; n < NCH; ++n) {
        { unsigned sp_ = 0; while (*(volatile LAS unsigned*)(xl + XL_CNT) <= (unsigned)n) { __builtin_amdgcn_s_sleep(1); if (++sp_ > (1u << 22)) break; } }
        bf16x8 Sp0_0, Sp0_1, Sp0_2, Sp0_3, vp0_0, vp0_1;
        bf16x8 Sp1_0, Sp1_1, Sp1_2, Sp1_3, vp1_0, vp1_1;
        { const LAS bf16x8* sl_ = (const LAS bf16x8*)(xl + (n & 3) * XL_SLOT) + lane; Sp0_0 = sl_[0]; Sp0_1 = sl_[64]; Sp0_2 = sl_[128]; Sp0_3 = sl_[192]; vp0_0 = sl_[256]; vp0_1 = sl_[320]; Sp1_0 = sl_[384]; Sp1_1 = sl_[448]; Sp1_2 = sl_[512]; Sp1_3 = sl_[576]; vp1_0 = sl_[640]; vp1_1 = sl_[704]; }
        asm volatile("s_waitcnt lgkmcnt(0)" ::: "memory");
        if (lane == 0) *(volatile LAS unsigned*)(xl + XL_CNT + 64) = (unsigned)(n + 1);
        f32x4 o0_0 = {0.f, 0.f, 0.f, 0.f}, o0_1 = o0_0, o0_2 = o0_0, o0_3 = o0_0;
        f32x4 o1_0 = {0.f, 0.f, 0.f, 0.f}, o1_1 = o1_0, o1_2 = o1_0, o1_3 = o1_0;
        asm volatile("s_waitcnt vmcnt(55)" : "+v"(r0));
        o0_0 = mfma16(r0, Sp0_0, o0_0);
        o1_0 = mfma16(r0, Sp1_0, o1_0);
        asm volatile("global_load_dwordx4 %0, %1, off" : "+v"(r0) : "v"((const unsigned char*)(sp0 + ((size_t)(n + 1) * 40 + 0) * 1024) + voff) : "memory");
        __builtin_amdgcn_sched_barrier(0);
        asm volatile("s_waitcnt vmcnt(55)" : "+v"(r1));
        o0_0 = mfma16(r1, Sp0_1, o0_0);
        o1_0 = mfma16(r1, Sp1_1, o1_0);
        asm volatile("global_load_dwordx4 %0, %1, off" : "+v"(r1) : "v"((const unsigned char*)(sp0 + ((size_t)(n + 1) * 40 + 1) * 1024) + voff) : "memory");
        __builtin_amdgcn_sched_barrier(0);
        asm volatile("s_waitcnt vmcnt(55)" : "+v"(r2));
        o0_0 = mfma16(r2, Sp0_2, o0_0);
        o1_0 = mfma16(r2, Sp1_2, o1_0);
        asm volatile("global_load_dwordx4 %0, %1, off" : "+v"(r2) : "v"((const unsigned char*)(sp0 + ((size_t)(n + 1) * 40 + 2) * 1024) + voff) : "memory");
        __builtin_amdgcn_sched_barrier(0);
        asm volatile("s_waitcnt vmcnt(55)" : "+v"(r3));
        o0_0 = mfma16(r3, Sp0_3, o0_0);
        o1_0 = mfma16(r3, Sp1_3, o1_0);
        asm volatile("global_load_dwordx4 %0, %1, off" : "+v"(r3) : "v"((const unsigned char*)(sp0 + ((size_t)(n + 1) * 40 + 3) * 1024) + voff) : "memory");
        __builtin_amdgcn_sched_barrier(0);
        asm volatile("s_waitcnt vmcnt(55)" : "+v"(r4));
        o0_1 = mfma16(r4, Sp0_0, o0_1);
        o1_1 = mfma16(r4, Sp1_0, o1_1);
        asm volatile("global_load_dwordx4 %0, %1, off" : "+v"(r4) : "v"((const unsigned char*)(sp0 + ((size_t)(n + 1) * 40 + 4) * 1024) + voff) : "memory");
        __builtin_amdgcn_sched_barrier(0);
        asm volatile("s_waitcnt vmcnt(55)" : "+v"(r5));
        o0_1 = mfma16(r5, Sp0_1, o0_1);
        o1_1 = mfma16(r5, Sp1_1, o1_1);
        asm volatile("global_load_dwordx4 %0, %1, off" : "+v"(r5) : "v"((const unsigned char*)(sp0 + ((size_t)(n + 1) * 40 + 5) * 1024) + voff) : "memory");
        __builtin_amdgcn_sched_barrier(0);
        asm volatile("s_waitcnt vmcnt(55)" : "+v"(r6));
        o0_1 = mfma16(r6, Sp0_2, o0_1);
        o1_1 = mfma16(r6, Sp1_2, o1_1);
        asm volatile("global_load_dwordx4 %0, %1, off" : "+v"(r6) : "v"((const unsigned char*)(sp0 + ((size_t)(n + 1) * 40 + 6) * 1024) + voff) : "memory");
        __builtin_amdgcn_sched_barrier(0);
        asm volatile("s_waitcnt vmcnt(55)" : "+v"(r7));
        o0_1 = mfma16(r7, Sp0_3, o0_1);
        o1_1 = mfma16(r7, Sp1_3, o1_1);
        asm volatile("global_load_dwordx4 %0, %1, off" : "+v"(r7) : "v"((const unsigned char*)(sp0 + ((size_t)(n + 1) * 40 + 7) * 1024) + voff) : "memory");
        __builtin_amdgcn_sched_barrier(0);
        asm volatile("s_waitcnt vmcnt(55)" : "+v"(r8));
        o0_2 = mfma16(r8, Sp0_0, o0_2);
        o1_2 = mfma16(r8, Sp1_0, o1_2);
        asm volatile("global_load_dwordx4 %0, %1, off" : "+v"(r8) : "v"((const unsigned char*)(sp0 + ((size_t)(n + 1) * 40 + 8) * 1024) + voff) : "memory");
        __builtin_amdgcn_sched_barrier(0);
        asm volatile("s_waitcnt vmcnt(55)" : "+v"(r9));
        o0_2 = mfma16(r9, Sp0_1, o0_2);
        o1_2 = mfma16(r9, Sp1_1, o1_2);
        asm volatile("global_load_dwordx4 %0, %1, off" : "+v"(r9) : "v"((const unsigned char*)(sp0 + ((size_t)(n + 1) * 40 + 9) * 1024) + voff) : "memory");
        __builtin_amdgcn_sched_barrier(0);
        asm volatile("s_waitcnt vmcnt(55)" : "+v"(r10));
        o0_2 = mfma16(r10, Sp0_2, o0_2);
        o1_2 = mfma16(r10, Sp1_2, o1_2);
        asm volatile("global_load_dwordx4 %0, %1, off" : "+v"(r10) : "v"((const unsigned char*)(sp0 + ((size_t)(n + 1) * 40 + 10) * 1024) + voff) : "memory");
        __builtin_amdgcn_sched_barrier(0);
        asm volatile("s_waitcnt vmcnt(55)" : "+v"(r11));
        o0_2 = mfma16(r11, Sp0_3, o0_2);
        o1_2 = mfma16(r11, Sp1_3, o1_2);
        asm volatile("global_load_dwordx4 %0, %1, off" : "+v"(r11) : "v"((const unsigned char*)(sp0 + ((size_t)(n + 1) * 40 + 11) * 1024) + voff) : "memory");
        __builtin_amdgcn_sched_barrier(0);
        asm volatile("s_waitcnt vmcnt(55)" : "+v"(r12));
        o0_3 = mfma16(r12, Sp0_0, o0_3);
        o1_3 = mfma16(r12, Sp1_0, o1_3);
        asm volatile("global_load_dwordx4 %0, %1, off" : "+v"(r12) : "v"((const unsigned char*)(sp0 + ((size_t)(n + 1) * 40 + 12) * 1024) + voff) : "memory");
        __builtin_amdgcn_sched_barrier(0);
        asm volatile("s_waitcnt vmcnt(55)" : "+v"(r13));
        o0_3 = mfma16(r13, Sp0_1, o0_3);
        o1_3 = mfma16(r13, Sp1_1, o1_3);
        asm volatile("global_load_dwordx4 %0, %1, off" : "+v"(r13) : "v"((const unsigned char*)(sp0 + ((size_t)(n + 1) * 40 + 13) * 1024) + voff) : "memory");
        __builtin_amdgcn_sched_barrier(0);
        asm volatile("s_waitcnt vmcnt(55)" : "+v"(r14));
        o0_3 = mfma16(r14, Sp0_2, o0_3);
        o1_3 = mfma16(r14, Sp1_2, o1_3);
        asm volatile("global_load_dwordx4 %0, %1, off" : "+v"(r14) : "v"((const unsigned char*)(sp0 + ((size_t)(n + 1) * 40 + 14) * 1024) + voff) : "memory");
        __builtin_amdgcn_sched_barrier(0);
        asm volatile("s_waitcnt vmcnt(55)" : "+v"(r15));
        o0_3 = mfma16(r15, Sp0_3, o0_3);
        o1_3 = mfma16(r15, Sp1_3, o1_3);
        asm volatile("global_load_dwordx4 %0, %1, off" : "+v"(r15) : "v"((const unsigned char*)(sp0 + ((size_t)(n + 1) * 40 + 15) * 1024) + voff) : "memory");
        __builtin_amdgcn_sched_barrier(0);
        asm volatile("s_waitcnt vmcnt(55)" : "+v"(r16));
        o0_0 = mfma16(r16, vp0_0, o0_0);
        o1_0 = mfma16(r16, vp1_0, o1_0);
        asm volatile("global_load_dwordx4 %0, %1, off" : "+v"(r16) : "v"((const unsigned char*)(sp0 + ((size_t)(n + 1) * 40 + 16) * 1024) + voff) : "memory");
        __builtin_amdgcn_sched_barrier(0);
        asm volatile("s_waitcnt vmcnt(55)" : "+v"(r17));
        o0_0 = mfma16(r17, vp0_1, o0_0);
        o1_0 = mfma16(r17, vp1_1, o1_0);
        asm volatile("global_load_dwordx4 %0, %1, off" : "+v"(r17) : "v"((const unsigned char*)(sp0 + ((size_t)(n + 1) * 40 + 17) * 1024) + voff) : "memory");
        __builtin_amdgcn_sched_barrier(0);
        asm volatile("s_waitcnt vmcnt(55)" : "+v"(r18));
        o0_1 = mfma16(r18, vp0_0, o0_1);
        o1_1 = mfma16(r18, vp1_0, o1_1);
        asm volatile("global_load_dwordx4 %0, %1, off" : "+v"(r18) : "v"((const unsigned char*)(sp0 + ((size_t)(n + 1) * 40 + 18) * 1024) + voff) : "memory");
        __builtin_amdgcn_sched_barrier(0);
        asm volatile("s_waitcnt vmcnt(55)" : "+v"(r19));
        o0_1 = mfma16(r19, vp0_1, o0_1);
        o1_1 = mfma16(r19, vp1_1, o1_1);
        asm volatile("global_load_dwordx4 %0, %1, off" : "+v"(r19) : "v"((const unsigned char*)(sp0 + ((size_t)(n + 1) * 40 + 19) * 1024) + voff) : "memory");
        __builtin_amdgcn_sched_barrier(0);
        asm volatile("s_waitcnt vmcnt(55)" : "+v"(r20));
        o0_2 = mfma16(r20, vp0_0, o0_2);
        o1_2 = mfma16(r20, vp1_0, o1_2);
        asm volatile("global_load_dwordx4 %0, %1, off" : "+v"(r20) : "v"((const unsigned char*)(sp0 + ((size_t)(n + 1) * 40 + 20) * 1024) + voff) : "memory");
        __builtin_amdgcn_sched_barrier(0);
        asm volatile("s_waitcnt vmcnt(55)" : "+v"(r21));
        o0_2 = mfma16(r21, vp0_1, o0_2);
        o1_2 = mfma16(r21, vp1_1, o1_2);
        asm volatile("global_load_dwordx4 %0, %1, off" : "+v"(r21) : "v"((const unsigned char*)(sp0 + ((size_t)(n + 1) * 40 + 21) * 1024) + voff) : "memory");
        __builtin_amdgcn_sched_barrier(0);
        asm volatile("s_waitcnt vmcnt(55)" : "+v"(r22));
        o0_3 = mfma16(r22, vp0_0, o0_3);
        o1_3 = mfma16(r22, vp1_0, o1_3);
        asm volatile("global_load_dwordx4 %0, %1, off" : "+v"(r22) : "v"((const unsigned char*)(sp0 + ((size_t)(n + 1) * 40 + 22) * 1024) + voff) : "memory");
        __builtin_amdgcn_sched_barrier(0);
        asm volatile("s_waitcnt vmcnt(55)" : "+v"(r23));
        o0_3 = mfma16(r23, vp0_1, o0_3);
        o1_3 = mfma16(r23, vp1_1, o1_3);
        asm volatile("global_load_dwordx4 %0, %1, off" : "+v"(r23) : "v"((const unsigned char*)(sp0 + ((size_t)(n + 1) * 40 + 23) * 1024) + voff) : "memory");
        __builtin_amdgcn_sched_barrier(0);
        { const unsigned char* obn = obu + (size_t)n * 64 * orow;
          { const unsigned v = f2bf(o0_0[0]); asm volatile("global_store_short %0, %1, off" :: "v"((const unsigned char*)(obn + (size_t)(0) * orow + 0) + ooff), "v"(v) : "memory"); }
          { const unsigned v = f2bf(o0_0[1]); asm volatile("global_store_short %0, %1, off" :: "v"((const unsigned char*)(obn + (size_t)(1) * orow + 0) + ooff), "v"(v) : "memory"); }
          { const unsigned v = f2bf(o0_0[2]); asm volatile("global_store_short %0, %1, off" :: "v"((const unsigned char*)(obn + (size_t)(2) * orow + 0) + ooff), "v"(v) : "memory"); }
          { const unsigned v = f2bf(o0_0[3]); asm volatile("global_store_short %0, %1, off" :: "v"((const unsigned char*)(obn + (size_t)(3) * orow + 0) + ooff), "v"(v) : "memory"); }
          { const unsigned v = f2bf(o0_1[0]); asm volatile("global_store_short %0, %1, off" :: "v"((const unsigned char*)(obn + (size_t)(16) * orow + 0) + ooff), "v"(v) : "memory"); }
          { const unsigned v = f2bf(o0_1[1]); asm volatile("global_store_short %0, %1, off" :: "v"((const unsigned char*)(obn + (size_t)(17) * orow + 0) + ooff), "v"(v) : "memory"); }
          { const unsigned v = f2bf(o0_1[2]); asm volatile("global_store_short %0, %1, off" :: "v"((const unsigned char*)(obn + (size_t)(18) * orow + 0) + ooff), "v"(v) : "memory"); }
          { const unsigned v = f2bf(o0_1[3]); asm volatile("global_store_short %0, %1, off" :: "v"((const unsigned char*)(obn + (size_t)(19) * orow + 0) + ooff), "v"(v) : "memory"); }
          { const unsigned v = f2bf(o0_2[0]); asm volatile("global_store_short %0, %1, off" :: "v"((const unsigned char*)(obn + (size_t)(32) * orow + 0) + ooff), "v"(v) : "memory"); }
          { const unsigned v = f2bf(o0_2[1]); asm volatile("global_store_short %0, %1, off" :: "v"((const unsigned char*)(obn + (size_t)(33) * orow + 0) + ooff), "v"(v) : "memory"); }
          { const unsigned v = f2bf(o0_2[2]); asm volatile("global_store_short %0, %1, off" :: "v"((const unsigned char*)(obn + (size_t)(34) * orow + 0) + ooff), "v"(v) : "memory"); }
          { const unsigned v = f2bf(o0_2[3]); asm volatile("global_store_short %0, %1, off" :: "v"((const unsigned char*)(obn + (size_t)(35) * orow + 0) + ooff), "v"(v) : "memory"); }
          { const unsigned v = f2bf(o0_3[0]); asm volatile("global_store_short %0, %1, off" :: "v"((const unsigned char*)(obn + (size_t)(48) * orow + 0) + ooff), "v"(v) : "memory"); }
          { const unsigned v = f2bf(o0_3[1]); asm volatile("global_store_short %0, %1, off" :: "v"((const unsigned char*)(obn + (size_t)(49) * orow + 0) + ooff), "v"(v) : "memory"); }
          { const unsigned v = f2bf(o0_3[2]); asm volatile("global_store_short %0, %1, off" :: "v"((const unsigned char*)(obn + (size_t)(50) * orow + 0) + ooff), "v"(v) : "memory"); }
          { const unsigned v = f2bf(o0_3[3]); asm volatile("global_store_short %0, %1, off" :: "v"((const unsigned char*)(obn + (size_t)(51) * orow + 0) + ooff), "v"(v) : "memory"); }
          { const unsigned v = f2bf(o1_0[0]); asm volatile("global_store_short %0, %1, off" :: "v"((const unsigned char*)(obn + (size_t)(0) * orow + 32) + ooff), "v"(v) : "memory"); }
          { const unsigned v = f2bf(o1_0[1]); asm volatile("global_store_short %0, %1, off" :: "v"((const unsigned char*)(obn + (size_t)(1) * orow + 32) + ooff), "v"(v) : "memory"); }
          { const unsigned v = f2bf(o1_0[2]); asm volatile("global_store_short %0, %1, off" :: "v"((const unsigned char*)(obn + (size_t)(2) * orow + 32) + ooff), "v"(v) : "memory"); }
          { const unsigned v = f2bf(o1_0[3]); asm volatile("global_store_short %0, %1, off" :: "v"((const unsigned char*)(obn + (size_t)(3) * orow + 32) + ooff), "v"(v) : "memory"); }
          { const unsigned v = f2bf(o1_1[0]); asm volatile("global_store_short %0, %1, off" :: "v"((const unsigned char*)(obn + (size_t)(16) * orow + 32) + ooff), "v"(v) : "memory"); }
          { const unsigned v = f2bf(o1_1[1]); asm volatile("global_store_short %0, %1, off" :: "v"((const unsigned char*)(obn + (size_t)(17) * orow + 32) + ooff), "v"(v) : "memory"); }
          { const unsigned v = f2bf(o1_1[2]); asm volatile("global_store_short %0, %1, off" :: "v"((const unsigned char*)(obn + (size_t)(18) * orow + 32) + ooff), "v"(v) : "memory"); }
          { const unsigned v = f2bf(o1_1[3]); asm volatile("global_store_short %0, %1, off" :: "v"((const unsigned char*)(obn + (size_t)(19) * orow + 32) + ooff), "v"(v) : "memory"); }
          { const unsigned v = f2bf(o1_2[0]); asm volatile("global_store_short %0, %1, off" :: "v"((const unsigned char*)(obn + (size_t)(32) * orow + 32) + ooff), "v"(v) : "memory"); }
          { const unsigned v = f2bf(o1_2[1]); asm volatile("global_store_short %0, %1, off" :: "v"((const unsigned char*)(obn + (size_t)(33) * orow + 32) + ooff), "v"(v) : "memory"); }
          { const unsigned v = f2bf(o1_2[2]); asm volatile("global_store_short %0, %1, off" :: "v"((const unsigned char*)(obn + (size_t)(34) * orow + 32) + ooff), "v"(v) : "memory"); }
          { const unsigned v = f2bf(o1_2[3]); asm volatile("global_store_short %0, %1, off" :: "v"((const unsigned char*)(obn + (size_t)(35) * orow + 32) + ooff), "v"(v) : "memory"); }
          { const unsigned v = f2bf(o1_3[0]); asm volatile("global_store_short %0, %1, off" :: "v"((const unsigned char*)(obn + (size_t)(48) * orow + 32) + ooff), "v"(v) : "memory"); }
          { const unsigned v = f2bf(o1_3[1]); asm volatile("global_store_short %0, %1, off" :: "v"((const unsigned char*)(obn + (size_t)(49) * orow + 32) + ooff), "v"(v) : "memory"); }
          { const unsigned v = f2bf(o1_3[2]); asm volatile("global_store_short %0, %1, off" :: "v"((const unsigned char*)(obn + (size_t)(50) * orow + 32) + ooff), "v"(v) : "memory"); }
          { const unsigned v = f2bf(o1_3[3]); asm volatile("global_store_short %0, %1, off" :: "v"((const unsigned char*)(obn + (size_t)(51) * orow + 32) + ooff), "v"(v) : "memory"); }
        }
        __builtin_amdgcn_sched_barrier(0);
    }
    asm volatile("s_waitcnt vmcnt(0)" ::: "memory");
    }
}

DI void p4_mixnorm(Frame& F, const float* ret_norm, const float* gdn_norm) {
    bf16_t* pj = (bf16_t*)(F.ws + WS_BIG + BIG_PJ); const bf16_t* vc = (const bf16_t*)(F.ws + AUX_VC); const bf16_t* rr = (const bf16_t*)(F.ws + AUX_QN);
    const int lane = F.lane, l32 = lane & 31, hh = lane >> 5;
    const f32x4 gr0 = *(const f32x4*)(ret_norm + 8 * l32), gr1 = *(const f32x4*)(ret_norm + 8 * l32 + 4), gg0 = *(const f32x4*)(gdn_norm + 8 * l32), gg1 = *(const f32x4*)(gdn_norm + 8 * l32 + 4);
    for (int m = F.gw; m < NTOK; m += F.NGW) {
        bf16_t* row = pj + (size_t)m * PJW;
        u32x4 ro[8], gt[8];
#pragma unroll
        for (int q = 0; q < 8; ++q) { const int hv = 2 * q + hh, hd = hv & 7; const bool gdn = hv >= 8;
            ro[q] = *(const u32x4*)((gdn ? vc : rr) + (size_t)m * 2048 + hd * 256 + 8 * l32);
            gt[q] = *(const u32x4*)(row + (gdn ? C_GZ : C_RG) + hd * 256 + 8 * l32); }
        asm volatile("" ::: "memory");
#pragma unroll
        for (int q = 0; q < 8; ++q) { const int hv = 2 * q + hh, hd = hv & 7; const bool gdn = q >= 4;
            float o[8] = {bflo(ro[q].x), bfhi(ro[q].x), bflo(ro[q].y), bfhi(ro[q].y), bflo(ro[q].z), bfhi(ro[q].z), bflo(ro[q].w), bfhi(ro[q].w)};
            float gv[8] = {bflo(gt[q].x), bfhi(gt[q].x), bflo(gt[q].y), bfhi(gt[q].y), bflo(gt[q].z), bfhi(gt[q].z), bflo(gt[q].w), bfhi(gt[q].w)};
            float ss = 0.f;
#pragma unroll
            for (int e = 0; e < 8; ++e) ss += o[e] * o[e];
            ss += __shfl_xor(ss, 1); ss += __shfl_xor(ss, 2); ss += __shfl_xor(ss, 4); ss += __shfl_xor(ss, 8); ss += __shfl_xor(ss, 16);
            const float rstd = 1.0f / sqrtf(ss * (1.0f / 256.0f) + EPS);
            const f32x4 g0 = gdn ? gg0 : gr0, g1 = gdn ? gg1 : gr1;
            u32x4 w; w.x = pk2(o[0] * rstd * g0.x * siluf(gv[0]), o[1] * rstd * g0.y * siluf(gv[1])); w.y = pk2(o[2] * rstd * g0.z * siluf(gv[2]), o[3] * rstd * g0.w * siluf(gv[3]));
            w.z = pk2(o[4] * rstd * g1.x * siluf(gv[4]), o[5] * rstd * g1.y * siluf(gv[5])); w.w = pk2(o[6] * rstd * g1.z * siluf(gv[6]), o[7] * rstd * g1.w * siluf(gv[7]));
            *(u32x4*)(row + (gdn ? C_GZ : C_RG) + hd * 256 + 8 * l32) = w; }
    }
}

DI void p11_swaprep(Frame& F, const float* qnorm, const float* knorm) {
    bf16_t* qkv = (bf16_t*)(F.ws + WS_BIG + BIG_QKV1); const f32x2* cs32 = (const f32x2*)(F.ws + AUX_CS32);
    const int lane = F.lane, l8 = lane & 7;
    const f32x4 gq0 = *(const f32x4*)(qnorm + 8 * l8), gq1 = *(const f32x4*)(qnorm + 8 * l8 + 4), gk0 = *(const f32x4*)(knorm + 8 * l8), gk1 = *(const f32x4*)(knorm + 8 * l8 + 4);
    const float sg = (l8 < 4) ? -1.f : 1.f;
    for (int m = F.gw; m < NTOK; m += F.NGW) {
        const int pos = m & (SEQ - 1);
        const f32x4* cp = (const f32x4*)(cs32 + (size_t)pos * 32 + 8 * (l8 & 3));
        const f32x4 c0 = cp[0], c1 = cp[1], c2 = cp[2], c3 = cp[3];
        bf16_t* row = qkv + (size_t)m * ODD_IN;
        u32x4 x[5];
#pragma unroll
        for (int i = 0; i < 5; ++i) { x[i] = (u32x4){0u, 0u, 0u, 0u}; if (i < 4 || lane < 32) x[i] = *(const u32x4*)(row + i * 512 + 8 * lane); }
        asm volatile("" ::: "memory");
#pragma unroll
        for (int i = 0; i < 5; ++i) {
            float v[8] = {bflo(x[i].x), bfhi(x[i].x), bflo(x[i].y), bfhi(x[i].y), bflo(x[i].z), bfhi(x[i].z), bflo(x[i].w), bfhi(x[i].w)};
            float ss = 0.f;
#pragma unroll
            for (int e = 0; e < 8; ++e) ss += v[e] * v[e];
            ss += __shfl_xor(ss, 1); ss += __shfl_xor(ss, 2); ss += __shfl_xor(ss, 4);
            const float rstd = 1.0f / sqrtf(ss * (1.0f / 64.0f) + EPS);
            const f32x4 g0 = i < 4 ? gq0 : gk0, g1 = i < 4 ? gq1 : gk1;
            v[0] *= rstd * g0.x; v[1] *= rstd * g0.y; v[2] *= rstd * g0.z; v[3] *= rstd * g0.w; v[4] *= rstd * g1.x; v[5] *= rstd * g1.y; v[6] *= rstd * g1.z; v[7] *= rstd * g1.w;
            float p[8];
#pragma unroll
            for (int e = 0; e < 8; ++e) p[e] = __shfl_xor(v[e], 4);
            u32x4 o;
            o.x = pk2(v[0] * c0.x + sg * p[0] * c0.y, v[1] * c0.z + sg * p[1] * c0.w); o.y = pk2(v[2] * c1.x + sg * p[2] * c1.y, v[3] * c1.z + sg * p[3] * c1.w);
            o.z = pk2(v[4] * c2.x + sg * p[4] * c2.y, v[5] * c2.z + sg * p[5] * c2.w); o.w = pk2(v[6] * c3.x + sg * p[6] * c3.y, v[7] * c3.z + sg * p[7] * c3.w);
            if (i < 4 || lane < 32) *(u32x4*)(row + i * 512 + 8 * lane) = o; }
    }
}
typedef float f32x16 __attribute__((ext_vector_type(16)));
DI f32x16 mfma32(bf16x8 a, bf16x8 b, f32x16 c) { return __builtin_amdgcn_mfma_f32_32x32x16_bf16(a, b, c, 0, 0, 0); }
DI void swa_phase(Frame& F, const float* sinks) {
    constexpr int KP = 144;
    bf16_t* qkv = (bf16_t*)(F.ws + WS_BIG + BIG_QKV1);
    LAS unsigned char* Ks = F.lds; LAS unsigned char* Vs = F.lds + 256 * KP;
    const unsigned vs_addr = (unsigned)(size_t)Vs;
    const int lane = F.lane, w = F.wave, h = lane >> 5, ql = lane & 31, q4 = (lane & 15) >> 2, p4 = lane & 3, blk = (lane >> 4) & 1;
    for (int unit = blockIdx.x; unit < 1024; unit += F.G) {
        const int b = unit >> 9, kvh = (unit >> 7) & 3, qb = unit & 127;
        const size_t tok0 = (size_t)b * SEQ + (size_t)qb * 128;
        __syncthreads();
#pragma unroll
        for (int i = 0; i < 4; ++i) { const int pc = F.tid + 512 * i, row = pc >> 3, c = pc & 7; const size_t tok = (qb == 0 && row < 128) ? tok0 : tok0 - 128 + row;
            const bf16_t* src = qkv + tok * ODD_IN + 2048 + kvh * 64 + c * 8;
            *(LAS u32x4*)(Ks + row * KP + c * 16) = *(const u32x4*)src; *(LAS u32x4*)(Vs + row * KP + c * 16) = *(const u32x4*)(src + 256); }
        __syncthreads();
        const int hq = kvh * 8 + w; const float sink = sinks[hq];
#pragma unroll 1
        for (int t = 0; t < 4; ++t) {
            bf16_t* qrow = qkv + (tok0 + 32 * t + ql) * ODD_IN + hq * 64;
            bf16x8 Qf[4];
#pragma unroll
            for (int s2 = 0; s2 < 4; ++s2) Qf[s2] = *(const bf16x8*)(qrow + 16 * s2 + 8 * h);
            f32x16 sc[5];
#pragma unroll
            for (int kt = 0; kt < 5; ++kt) {
#pragma unroll
                for (int r = 0; r < 16; ++r) sc[kt][r] = 0.f;
#pragma unroll
                for (int s2 = 0; s2 < 4; ++s2) { const bf16x8 a = *(const LAS bf16x8*)(Ks + (32 * (t + kt) + ql) * KP + (16 * s2 + 8 * h) * 2); sc[kt] = mfma32(a, Qf[s2], sc[kt]); } }
            float m = sink;
#pragma unroll
            for (int kt = 0; kt < 5; ++kt) { const bool tile_ok = !(qb == 0 && t + kt < 4);
#pragma unroll
                for (int r = 0; r < 16; ++r) { const int keyrow = (r & 3) + 8 * (r >> 2) + 4 * h; bool ok = tile_ok; if (kt == 0) ok = ok && (keyrow > ql); if (kt == 4) ok = ok && (keyrow <= ql);
                    const float v = ok ? sc[kt][r] * 0.125f : -1.0e30f; sc[kt][r] = v; m = fmaxf(m, v); } }
            m = fmaxf(m, __shfl_xor(m, 32));
            float l = 0.f;
#pragma unroll
            for (int kt = 0; kt < 5; ++kt)
#pragma unroll
                for (int r = 0; r < 16; ++r) { const float p = exp2f((sc[kt][r] - m) * 1.4426950408889634f); sc[kt][r] = p; l += p; }
            l += __shfl_xor(l, 32);
            l += exp2f((sink - m) * 1.4426950408889634f);
            f32x16 o0, o1;
#pragma unroll
            for (int r = 0; r < 16; ++r) { o0[r] = 0.f; o1[r] = 0.f; }
#pragma unroll
            for (int kt = 0; kt < 5; ++kt)
#pragma unroll
                for (int s2 = 0; s2 < 2; ++s2) { u32x4 pw; pw.x = pkbf(sc[kt][8 * s2], sc[kt][8 * s2 + 1]); pw.y = pkbf(sc[kt][8 * s2 + 2], sc[kt][8 * s2 + 3]); pw.z = pkbf(sc[kt][8 * s2 + 4], sc[kt][8 * s2 + 5]); pw.w = pkbf(sc[kt][8 * s2 + 6], sc[kt][8 * s2 + 7]);
                    const bf16x8 pb = __builtin_bit_cast(bf16x8, pw);
                    const unsigned ra = vs_addr + (unsigned)((32 * (t + kt) + 16 * s2 + 4 * h + q4) * KP + blk * 32 + p4 * 8);
                    s16x4 a00, a01, a10, a11; tr_read4(ra, ra + 8 * KP, ra + 64, ra + 8 * KP + 64, a00, a01, a10, a11);
                    o0 = mfma32(cat8(a00, a01), pb, o0); o1 = mfma32(cat8(a10, a11), pb, o1); }
            const float il = 1.0f / l;
            unsigned char* orow8 = F.ws + WS_H + (tok0 + 32 * t + ql) * D + hq * 64; const float il16 = il * 16.0f;
#pragma unroll
            for (int gq = 0; gq < 4; ++gq) { *(unsigned*)(orow8 + 8 * gq + 4 * h) = pk4fp8(o0[4 * gq] * il16, o0[4 * gq + 1] * il16, o0[4 * gq + 2] * il16, o0[4 * gq + 3] * il16);
                *(unsigned*)(orow8 + 32 + 8 * gq + 4 * h) = pk4fp8(o1[4 * gq] * il16, o1[4 * gq + 1] * il16, o1[4 * gq + 2] * il16, o1[4 * gq + 3] * il16); }
        }
    }
}

struct NoHandler { DI void operator()(int, float) const {} };
DI void moe_tables(Frame& F, const unsigned* cntg) {
    LAS int* cnt = (LAS int*)(F.lds + TBL_OFF); LAS int* tb = cnt + 32;
    __syncthreads();
    if (F.tid == 0) { int acc = 0; for (int e = 0; e < 32; ++e) { const int c = (int)__hip_atomic_load(cntg + e, __ATOMIC_RELAXED, __HIP_MEMORY_SCOPE_AGENT); cnt[e] = c; tb[e] = acc; acc += (c + 255) >> 8; } tb[32] = acc; }
    __syncthreads();
}

constexpr int NPH = 19;

struct Args { const float* in[20]; float* out; unsigned char* ws; int ph_lo, ph_hi; };
__global__ void __launch_bounds__(NTHR, 2) mk_fwd(Args args) {
    extern __shared__ __attribute__((aligned(16))) unsigned char lds[];
    Frame F;
    F.lds = (LAS unsigned char*)lds; F.tid = threadIdx.x; F.lane = F.tid & 63; F.wave = __builtin_amdgcn_readfirstlane(F.tid >> 6); F.G = gridDim.x;
    F.gw = blockIdx.x * NWAVES + F.wave; F.NGW = F.G * NWAVES; F.ws = args.ws; F.ctl = (unsigned*)(args.ws + WS_CTL);
    volatile LAS unsigned* MISC = (volatile LAS unsigned*)(F.lds + MISC_OFF);
    if (F.tid < 64) MISC[F.tid] = 0u;
    __syncthreads();
    XcdBarrier bar; bar.bar = F.ctl + CW_BAR; bar.x = 0; bar.st = nullptr;
    if (!MK_MULTI) bar = xcd_barrier_post(F.ctl + CW_BAR, MISC + 8);
    const int lo = args.ph_lo, hi = args.ph_hi;
#ifdef ONLY_PH
#define IN(k) ((k) == ONLY_PH && lo <= (k) && (k) < hi)
#else
#define IN(k) (lo <= (k) && (k) < hi)
#endif
#define SEAM(k) do { if (IN(k) && IN((k) + 1)) xcd_barrier(bar); } while (0)
    const float* const* in = args.in;
    float* XC = args.out;
    bf16_t* H = (bf16_t*)(F.ws + WS_H);
    bf16_t* PJ = (bf16_t*)(F.ws + WS_BIG + BIG_PJ);
    unsigned char* aux = F.ws;
    const LAS int* tbl_cnt = (const LAS int*)(F.lds + TBL_OFF); const LAS int* tbl_tb = tbl_cnt + 32;
    LAS unsigned* tokoff = (LAS unsigned*)(F.lds + TOK_OFF);

    enum { P_W = 0, P_N0, P_G0, P_PREP, P_GA, P_SCAN, P_MIX, P_O0, P_M0A, P_M0B, P_M0C, P_N1, P_G1, P_SPREP, P_SWA, P_O1, P_M1A, P_M1B, P_M1C, P_FIN };
    static_assert(P_FIN == NPH, "phase count");
    if (IN(P_W)) { p0_weights(F, in); __syncthreads(); }
    SEAM(P_W);
    if (IN(P_N0)) {
        normproj_pass<0>(F, in[0], in[1], (const bf16_t*)(aux + AUX_SW), (const bf16_t*)(aux + AUX_SW) + 112 * D, H, (float*)(aux + AUX_BG), in[6], in[7], nullptr, nullptr, nullptr, nullptr);
    }
    SEAM(P_N0);
    if (IN(P_G0)) {
        pg8::DenseOrder S; S.init(NTOK, PJW, D, D, (const bf16_t*)(F.ws + WS_WIN0), F.G, blockIdx.x);
        pg8::EpiBf16 E{PJ, PJW};
        pg8::gemm_phase(F.lds, H, D, S, E);
    }
    SEAM(P_G0);
    if (IN(P_PREP)) p2_prep(F, in[5]);
    SEAM(P_PREP);
    if (IN(P_GA)) {
        for (int u = F.gw; u < 16 * NCH; u += F.NGW) {
            ga_unit<true>(F, u, (unsigned char*)args.out, nullptr);
            ga_unit<false>(F, u, F.ws + AUX_W, nullptr);
        }
        __syncthreads();
    }
    SEAM(P_GA);
    if (IN(P_SCAN)) {
        for (int id = blockIdx.x; id < 256; id += F.G) { const int idl = id & 127, bh = (idl % 8) * 2 + (idl / 8) / 8, sl = 2 * ((idl / 8) % 8);
            __syncthreads();
            if (F.tid == 0) { *(volatile LAS unsigned*)(F.lds + XL_CNT) = 0u; *(volatile LAS unsigned*)(F.lds + XL_CNT + 64) = 0u; }
            __syncthreads();
            if (id < 128) { if (F.wave == 0) scan_wave<true, 0>(F, bh, sl, (const unsigned char*)args.out, F.lds); else if (F.wave == 1) scan_wave<true, 1>(F, bh, sl, (const unsigned char*)args.out, F.lds); }
            else { if (F.wave == 0) scan_wave<false, 0>(F, bh, sl, F.ws + AUX_W, F.lds); else if (F.wave == 1) scan_wave<false, 1>(F, bh, sl, F.ws + AUX_W, F.lds); } }
        __syncthreads();
    }
    SEAM(P_SCAN);
    if (IN(P_MIX)) p4_mixnorm(F, in[4], in[8]);
    SEAM(P_MIX);
    if (IN(P_O0)) {
        pg8::DenseOrder S; S.init(NTOK, D, 4096, PJW, (const bf16_t*)(F.ws + WS_WOUT0), F.G, blockIdx.x);
        pg8::EpiResF32 E{in[0], XC, D};
        pg8::gemm_phase(F.lds, PJ + C_RG, 4096, S, E);
    }
    SEAM(P_O0);
#define MOE_LAYER(P, L, CNTW)                                                                                                                  \
    if (IN(P)) {                                                            \
        convert_experts(F, in, L);                                                                                                             \
        __syncthreads();                                                                \
        normproj_pass<1>(F, XC, in[2] + L * D, (const bf16_t*)(aux + AUX_SW) + (16 + L * 48) * D, (const bf16_t*)(aux + AUX_SW) + (112 + 16 + L * 48) * D, H, nullptr, nullptr, nullptr, F.ctl + CNTW, (int*)(aux + AUX_LIST), (float*)(aux + AUX_GW), (unsigned*)(aux + AUX_ASG)); \
        __syncthreads();                                                                                                                       \
    }                                                                                                                                          \
    SEAM(P);                                                                                                                                   \
    if (IN(P + 1)) {                                                                                                \
        moe_tables(F, F.ctl + CNTW);                                                                                                           \
        pg8::MoeOrder<true> S; S.init(tbl_tb, tokoff, 6, D, D, F.ws + WS_BIG + BIG_EGU, (size_t)1536 * D, F.G, blockIdx.x, 1);   \
        { pg8::Unit u; const int* list = (const int*)(aux + AUX_LIST);                                                                         \
          for (int ui = 0; ui < 12 && S.next(ui, u); ++ui) if (F.tid < 256) { const int idx = (u.pm - tbl_tb[u.e]) * 256 + F.tid;               \
              const int tok = idx < tbl_cnt[u.e] ? list[u.e * 65536 + idx] : 0; tokoff[ui * 256 + F.tid] = (unsigned)tok * (unsigned)D; } } \
        __syncthreads();                                                                                                                       \
        pg8::EpiSwiglu8 E{F.ws + WS_BIG + BIG_HID};                                                                                            \
        pg8::gemm_phase<pg8::EpiSwiglu8, pg8::MoeOrder<true>, true, 0x79797979, 0x7d7d7d7d>(F.lds, H, D, S, E);         \
    }                                                                                                                                          \
    SEAM(P + 1);                                                                                                                               \
    if (IN(P + 2)) {                                                                                  \
        moe_tables(F, F.ctl + CNTW);                                                                                                           \
        pg8::MoeOrder<false> S; S.init(tbl_tb, tokoff, 8, FF, FF, F.ws + WS_BIG + BIG_EDN, (size_t)D * FF, F.G, blockIdx.x, 1);  \
        pg8::EpiDown E{(bf16_t*)(F.ws + WS_BIG + BIG_Y), (const float*)(aux + AUX_GW), tbl_tb};                                                \
        pg8::gemm_phase<pg8::EpiDown, pg8::MoeOrder<false>, true, 0x7a7a7a7a, 0x7c7c7c7c>(F.lds, F.ws + WS_BIG + BIG_HID, FF, S, E);     \
    }                                                                                                                                          \
    SEAM(P + 2);
    MOE_LAYER(P_M0A, 0, CW_CNT0)
    if (IN(P_N1)) {
        moe_tables(F, F.ctl + CW_CNT0);
        norm_pass<0, true, true, true, NoHandler, true>(F, XC, XC, (const bf16_t*)(F.ws + WS_BIG + BIG_Y), (const unsigned*)(aux + AUX_ASG), tbl_tb, in[1] + D, nullptr, H, NoHandler{});
        __syncthreads();
    }
    SEAM(P_N1);
    if (IN(P_G1)) {
        pg8::DenseOrder S; S.init(NTOK, ODD_IN, D, D, F.ws + WS_WIN1, F.G, blockIdx.x, 1);
        pg8::EpiBf16 E{(bf16_t*)(F.ws + WS_BIG + BIG_QKV1), ODD_IN};
        pg8::gemm_phase<pg8::EpiBf16, pg8::DenseOrder, true, 0x7a7a7a7a, 0x7d7d7d7d>(F.lds, H, D, S, E);
    }
    SEAM(P_G1);
    if (IN(P_SPREP)) p11_swaprep(F, in[11], in[12]);
    SEAM(P_SPREP);
    if (IN(P_SWA)) { swa_phase(F, in[13]); __syncthreads(); }
    SEAM(P_SWA);
    if (IN(P_O1)) {
        pg8::DenseOrder S; S.init(NTOK, D, D, D, F.ws + WS_WOUT1, F.G, blockIdx.x, 1);
        pg8::EpiResF32 E{XC, XC, D};
        pg8::gemm_phase<pg8::EpiResF32, pg8::DenseOrder, true, 0x7a7a7a7a, 0x7b7b7b7b>(F.lds, F.ws + WS_H, D, S, E);
    }
    SEAM(P_O1);
    MOE_LAYER(P_M1A, 1, CW_CNT1)
    if (IN(P_FIN)) {
        moe_tables(F, F.ctl + CW_CNT1);
        norm_pass<0, true, true, false>(F, XC, XC, (const bf16_t*)(F.ws + WS_BIG + BIG_Y), (const unsigned*)(aux + AUX_ASG), tbl_tb, nullptr, nullptr, nullptr, NoHandler{});
    }
#undef IN
#undef SEAM
}

extern "C" void kernel_launch(void* const* d_in, const int* in_sizes, int n_in, void* d_out, int out_size, void* d_ws, size_t ws_size, hipStream_t stream) {
    static int grid = 0;
    if (grid == 0) {
        if (n_in != 20 || in_sizes[0] != NTOK * D || out_size != NTOK * D || ws_size < WS_END) { fprintf(stderr, "kernel_launch: unexpected shapes / workspace (n_in %d, in0 %d, out %d, ws %zu, need %zu)\n", n_in, n_in > 0 ? in_sizes[0] : -1, out_size, ws_size, (size_t)WS_END); grid = -1; return; }
        int dev = 0, cus = 0, per_cu = 0;
        if (hipGetDevice(&dev) != hipSuccess || hipDeviceGetAttribute(&cus, hipDeviceAttributeMultiprocessorCount, dev) != hipSuccess) { grid = -1; return; }
        if (hipFuncSetAttribute((const void*)mk_fwd, hipFuncAttributeMaxDynamicSharedMemorySize, LDS_BYTES) != hipSuccess) { fprintf(stderr, "kernel_launch: hipFuncSetAttribute failed\n"); grid = -1; return; }
        if (hipOccupancyMaxActiveBlocksPerMultiprocessor(&per_cu, (const void*)mk_fwd, NTHR, LDS_BYTES) != hipSuccess || per_cu < 1) fprintf(stderr, "kernel_launch: occupancy query reports %d\n", per_cu);
        (void)hipGetLastError();
        if (cus < 256) { fprintf(stderr, "kernel_launch: built for 256 CUs (got %d)\n", cus); grid = -1; return; }
        grid = 256;
    }
    if (grid < 0) return;
    (void)hipMemsetAsync((char*)d_ws + WS_CTL, 0, CTL_ZERO_BYTES, stream);
    Args a{};
    for (int i = 0; i < 20; ++i) a.in[i] = (const float*)d_in[i];
    a.out = (float*)d_out; a.ws = (unsigned char*)d_ws;
#if MK_MULTI
    for (int p = 0; p <= NPH; ++p) { a.ph_lo = p; a.ph_hi = p + 1; hipLaunchKernelGGL(mk_fwd, dim3(grid), dim3(NTHR), LDS_BYTES, stream, a); }
#else
    a.ph_lo = 0; a.ph_hi = NPH + 1;
    hipLaunchKernelGGL(mk_fwd, dim3(grid), dim3(NTHR), LDS_BYTES, stream, a);
#endif
}
```

```cpp
#include <hip/hip_runtime.h>
#include <cstdio>
#include <cstdint>

#ifndef MK_MULTI
#define MK_MULTI 0
#endif

#define LAS __attribute__((address_space(3)))
typedef unsigned short bf16_t;
typedef short bf16x8 __attribute__((ext_vector_type(8)));
typedef float f32x4 __attribute__((ext_vector_type(4)));
typedef float f32x2 __attribute__((ext_vector_type(2)));
typedef unsigned u32x4 __attribute__((ext_vector_type(4)));
typedef unsigned u32x2 __attribute__((ext_vector_type(2)));
#define DI __device__ __forceinline__

constexpr int D = 2048, BATCH = 2, SEQ = 16384, NTOK = BATCH * SEQ;
constexpr int EVEN_IN = 12304, PJW = 12288;
constexpr int ODD_IN = 2560;
constexpr int NEXP = 32, FF = 768, TOPK = 2, MAXT = 288;
constexpr float EPS = 1e-6f;
constexpr double ROPE_R = 0.86596432336006535;
constexpr int C_RQ = 0, C_RK = 1024, C_RV = 2048, C_GQKV = 4096, C_RG = 8192, C_GZ = 10240;

constexpr size_t MiB = 1u << 20;
constexpr size_t WS_CTL = 0, CTL_ZERO_BYTES = 1 * MiB;
constexpr size_t WS_WIN0 = 2 * MiB;
constexpr size_t WS_WOUT0 = WS_WIN0 + 48 * MiB;
constexpr size_t WS_WIN1 = WS_WOUT0 + 16 * MiB;
constexpr size_t WS_WOUT1 = WS_WIN1 + 10 * MiB;
constexpr size_t WS_H = 84 * MiB;
constexpr size_t WS_BIG = 212 * MiB;
constexpr size_t WS_AUX = 980 * MiB;
constexpr size_t WS_END = 1492 * MiB;
constexpr size_t BIG_PJ = 0;
constexpr size_t BIG_EGU = 0;
constexpr size_t BIG_EDN = 192 * MiB;
constexpr size_t BIG_HID = 288 * MiB;
constexpr size_t BIG_Y = 400 * MiB;
constexpr size_t BIG_QKV1 = 0;
constexpr size_t AUX_QN = WS_AUX + 0;
constexpr size_t AUX_KN = WS_AUX + 64 * MiB;
constexpr size_t AUX_VC = WS_AUX + 128 * MiB;
constexpr size_t AUX_W = WS_AUX + 256 * MiB;
constexpr size_t AUX_ATT = WS_AUX + 320 * MiB;
constexpr size_t AUX_RST = WS_AUX + 352 * MiB;
constexpr size_t AUX_BG = WS_AUX + 480 * MiB;
constexpr size_t AUX_CS = WS_AUX + 482 * MiB;
constexpr size_t AUX_DEC = WS_AUX + 490 * MiB + 960 * 1024;
constexpr size_t AUX_SW = WS_AUX + 490 * MiB;
constexpr size_t AUX_LIST = WS_AUX + 491 * MiB;
constexpr size_t AUX_GW = WS_AUX + 499 * MiB;
constexpr size_t AUX_ASG = WS_AUX + 507 * MiB;
constexpr size_t AUX_CS32 = WS_AUX + 508 * MiB;
static_assert(AUX_CS32 + 4 * MiB <= WS_END, "aux map");
constexpr int CW_BAR = 4096;
constexpr int CW_CNT0 = 16384, CW_CNT1 = 16384 + 64;

constexpr int RING_BYTES = 131072;
constexpr int GA_LDS_WAVE = 17920;
constexpr int MISC_OFF = 8 * GA_LDS_WAVE;
constexpr int TBL_OFF = MISC_OFF + 256;
constexpr int TOK_OFF = MISC_OFF + 1024;
constexpr int LDS_BYTES = 163840;
static_assert(TOK_OFF + 12 * 1024 <= LDS_BYTES, "lds map");
DI float rdlane(float v, int l) { return __builtin_bit_cast(float, __builtin_amdgcn_readlane(__builtin_bit_cast(int, v), l)); }

DI unsigned f2bf(float f) { unsigned u = __builtin_bit_cast(unsigned, f); return (u + 0x7fffu + ((u >> 16) & 1u)) >> 16; }
DI unsigned pk2(float lo, float hi) { return f2bf(lo) | (f2bf(hi) << 16); }
DI float bflo(unsigned w) { return __builtin_bit_cast(float, w << 16); }
DI float bfhi(unsigned w) { return __builtin_bit_cast(float, w & 0xffff0000u); }
DI float bf2f(bf16_t b) { return __builtin_bit_cast(float, ((unsigned)b) << 16); }
DI unsigned cvt_pk_bf16(float lo, float hi) { unsigned r; asm volatile("v_cvt_pk_bf16_f32 %0, %1, %2" : "=v"(r) : "v"(lo), "v"(hi)); return r; }
DI float wave_sum(float v) {
#pragma unroll
    for (int o = 1; o < 64; o <<= 1) v += __shfl_xor(v, o);
    return v;
}
DI float siluf(float x) { return x / (1.0f + __expf(-x)); }
DI unsigned pk4fp8(float a, float b, float c, float d) { int w = __builtin_amdgcn_cvt_pk_fp8_f32(a, b, 0, false); w = __builtin_amdgcn_cvt_pk_fp8_f32(c, d, w, true); return (unsigned)w; }
typedef __bf16 bf16v2 __attribute__((ext_vector_type(2)));
DI unsigned pkbf(float a, float b) { f32x2 v = {a, b}; return __builtin_bit_cast(unsigned, __builtin_convertvector(v, bf16v2)); }
DI f32x4 mfma16(bf16x8 a, bf16x8 b, f32x4 c) { return __builtin_amdgcn_mfma_f32_16x16x32_bf16(a, b, c, 0, 0, 0); }
#define LDS_WAIT() asm volatile("s_waitcnt lgkmcnt(0)" ::: "memory")
#define VM_WAIT() asm volatile("s_waitcnt vmcnt(0)" ::: "memory")

#define XB_TMO      128
#define XB_XCNT(j)  (256  + 64 * (j))
#define XB_XSUB(j)  (1280 + 64 * (j))
#define XB_XGEN(j)  (2304 + 64 * (j))
#define XB_TOP      3328
#define XB_TOPGEN   3392
#define XCD_BAR_WORDS 3456
#define XB_SPIN_CAP (1u << 22)
DI unsigned xb_ld(unsigned* p)              { return __hip_atomic_load(p, __ATOMIC_RELAXED, __HIP_MEMORY_SCOPE_AGENT); }
DI unsigned xb_add(unsigned* p, unsigned v) { return __hip_atomic_fetch_add(p, v, __ATOMIC_RELAXED, __HIP_MEMORY_SCOPE_AGENT); }
DI unsigned xb_xcc_id() { return (unsigned)__builtin_amdgcn_s_getreg((3 << 11) | 20) & 0xFu; }
#define XB_SPIN(cond, bar) do { unsigned _sp = 0; while (cond) { __builtin_amdgcn_s_sleep(1); \
    if ((++_sp & 255u) == 0u) { if (xb_ld(&(bar)[XB_TMO])) break; if (_sp > XB_SPIN_CAP) { atomicAdd(&(bar)[XB_TMO], 1u); break; } } } } while (0)
struct XcdBarrier { unsigned* bar; unsigned x; volatile LAS unsigned* st; };
DI XcdBarrier xcd_barrier_post(unsigned* bar, volatile LAS unsigned* st) {
    XcdBarrier b; b.bar = bar; b.x = xb_xcc_id(); b.st = st;
    if (threadIdx.x == 0) (void)xb_add(&bar[XB_XCNT(b.x)], 1u);
    return b;
}
DI void xcd_barrier_complete(unsigned* bar, unsigned x, unsigned& nloc, unsigned& nx) {
    const unsigned G = gridDim.x * gridDim.y * gridDim.z;
    unsigned sum, cnt, mine, sp = 0u;
    for (;;) {
        sum = 0u; cnt = 0u; mine = 0u;
#pragma unroll
        for (unsigned j = 0; j < 16; ++j) { const unsigned c = xb_ld(&bar[XB_XCNT(j)]); sum += c; cnt += (c > 0u) ? 1u : 0u; mine = (j == x) ? c : mine; }
        if (sum == G) break;
        __builtin_amdgcn_s_sleep(1);
        if ((++sp & 255u) == 0u) { if (xb_ld(&bar[XB_TMO])) break; if (sp > XB_SPIN_CAP) { atomicAdd(&bar[XB_TMO], 1u); break; } }
    }
    nloc = mine > 0u ? mine : 1u; nx = cnt > 0u ? cnt : 1u;
}
DI void xcd_barrier(const XcdBarrier& b) {
    asm volatile("s_waitcnt vmcnt(0)" ::: "memory");
    __syncthreads();
    if (threadIdx.x == 0) {
        unsigned* bar = b.bar;
        __builtin_amdgcn_s_waitcnt(0);
        unsigned nloc = b.st[0], nx = b.st[1];
        if (nloc == 0u) { xcd_barrier_complete(bar, b.x, nloc, nx); b.st[0] = nloc; b.st[1] = nx; }
        const unsigned old = xb_add(&bar[XB_XSUB(b.x)], 1u);
        const unsigned gen = old / nloc;
        if (old + 1u == (gen + 1u) * nloc) {
            __builtin_amdgcn_fence(__ATOMIC_RELEASE, "agent");
            asm volatile("s_waitcnt vmcnt(0)" ::: "memory");
            const unsigned og = xb_add(&bar[XB_TOP], 1u);
            const unsigned tg = og / nx;
            if (og + 1u == (tg + 1u) * nx) xb_add(&bar[XB_TOPGEN], 1u);
            else XB_SPIN(xb_ld(&bar[XB_TOPGEN]) == tg, bar);
            __builtin_amdgcn_fence(__ATOMIC_ACQUIRE, "agent");
            xb_add(&bar[XB_XGEN(b.x)], 1u);
            asm volatile("s_waitcnt vmcnt(0)" ::: "memory");
        } else {
            XB_SPIN(xb_ld(&bar[XB_XGEN(b.x)]) == gen, bar);
            __builtin_amdgcn_fence(__ATOMIC_ACQUIRE, "agent");
            asm volatile("s_waitcnt vmcnt(0)" ::: "memory");
        }
    }
    __syncthreads();
}

namespace pg8 {
constexpr int BM = 256, BK = 64, HALF = 128, HTB = HALF * BK * 2, STAGE_BYTES = 8 * HTB, NXCD = 8, WGM = 8;
__host__ __device__ __forceinline__ int lds_byte(int r, int c) { const int st = (r >> 4) * 2 + (c >> 5), rr = r & 15, cc = c & 31, ob = rr * 64 + cc * 2; return st * 1024 + (ob ^ (((ob >> 9) & 1) << 5)); }
__host__ __device__ __forceinline__ void stage_rc(int b, int& R, int& C) { const int st = b / 1024, sb = b % 1024, swz = sb ^ (((sb >> 9) & 1) << 5); R = (st >> 1) * 16 + swz / 64; C = (st & 1) * 32 + (swz % 64) / 2; }
__host__ __device__ __forceinline__ int perm32(int rho) { const int n = rho >> 4, i = rho & 15; return 8 * (i >> 2) + 4 * n + (i & 3); }

struct Unit { int pm, pn, e, slot; };

DI int xcd_remap(int L, int nwg) { const int q = nwg / NXCD, r = nwg % NXCD, xcd = L % NXCD, off = L / NXCD; return (xcd < r ? xcd * (q + 1) : r * (q + 1) + (xcd - r) * q) + off; }

struct DenseOrder {
    int nM, nN, nwg, G, c; unsigned lda2; const char* Bt; size_t tstepB;
    DI void init(int M, int N, int K, int lda, const void* Bt_, int G_, int c_, int EB = 2) { nM = M / BM; nN = N / BM; nwg = nM * nN; G = G_; c = c_; lda2 = (unsigned)(lda * EB); Bt = (const char*)Bt_; tstepB = (size_t)BM * K * EB; }
    DI bool next(int i, Unit& u) const {
        const long L = (long)i * G + c; if (L >= nwg) return false;
        const int wgid = xcd_remap((int)L, nwg);
        const int nig = WGM * nN, gid = wgid / nig, fm = gid * WGM, gsz = (nM - fm) < WGM ? (nM - fm) : WGM;
        u.pm = fm + ((wgid % nig) % gsz); u.pn = (wgid % nig) / gsz; u.e = 0; u.slot = i; return true;
    }
    DI unsigned a_off(const Unit& u, int h, int R) const { return (unsigned)(u.pm * BM + h * HALF + R) * lda2; }
    DI const char* b_base(const Unit& u) const { return Bt + (size_t)u.pn * tstepB; }
};
template <bool GATHER> struct MoeOrder {
    const LAS int* tb; const LAS unsigned* tokoff; int NT, nwg, G, c; unsigned lda2; const char* Bt; size_t estepB, tstepB;
    DI void init(const LAS int* tb_, const LAS unsigned* tokoff_, int NT_, int K, int lda, const void* Bt_, size_t estep_elems, int G_, int c_, int EB = 2) {
        tb = tb_; tokoff = tokoff_; NT = NT_; nwg = tb_[32] * NT_; G = G_; c = c_; lda2 = (unsigned)(lda * EB); Bt = (const char*)Bt_; estepB = estep_elems * EB; tstepB = (size_t)BM * K * EB; }
    DI bool next(int i, Unit& u) const {
        const long L = (long)i * G + c; if (L >= nwg) return false;
        const int w = xcd_remap((int)L, nwg);
        int e = 0;
#pragma unroll 1
        for (int s = 16; s >= 1; s >>= 1) if (tb[e + s] * NT <= w) e += s;
        const int nt = tb[e + 1] - tb[e], local = w - tb[e] * NT;
        u.e = e; u.pn = local / nt; u.pm = tb[e] + local % nt; u.slot = i; return true;
    }
    DI unsigned a_off(const Unit& u, int h, int R) const { if (GATHER) return tokoff[u.slot * 256 + h * HALF + R]; return (unsigned)(u.pm * BM + h * HALF + R) * lda2; }
    DI const char* b_base(const Unit& u) const { return Bt + (size_t)u.e * estepB + (size_t)u.pn * tstepB; }
};

struct EpiBf16 {
    static constexpr bool PERM = true;
    bf16_t* O; int ldc;
    DI void operator()(const f32x4 (&acc)[2][2][4][2], const Unit& u, int wr, int wc, int fr, int fq) const {
        const int row0 = u.pm * BM + wr * 64 + fr, col0 = u.pn * BM + wc * 32 + 8 * fq;
#pragma unroll
        for (int ai = 0; ai < 2; ++ai)
#pragma unroll
            for (int m = 0; m < 4; ++m) { bf16_t* rowp = O + (size_t)(row0 + ai * HALF + m * 16) * ldc + col0;
#pragma unroll
                for (int bj = 0; bj < 2; ++bj) { const f32x4 v0 = acc[ai][bj][m][0], v1 = acc[ai][bj][m][1];
                    u32x4 w; w.x = cvt_pk_bf16(v0[0], v0[1]); w.y = cvt_pk_bf16(v0[2], v0[3]); w.z = cvt_pk_bf16(v1[0], v1[1]); w.w = cvt_pk_bf16(v1[2], v1[3]);
                    *(u32x4*)(rowp + bj * HALF) = w; } }
    }
};
struct EpiResF32 {
    static constexpr bool PERM = false;
    const float* base; float* out; int ldc;
    DI void operator()(const f32x4 (&acc)[2][2][4][2], const Unit& u, int wr, int wc, int fr, int fq) const {
        const int row0 = u.pm * BM + wr * 64 + fr, col0 = u.pn * BM + wc * 32 + 4 * fq;
#pragma unroll
        for (int ai = 0; ai < 2; ++ai)
#pragma unroll
            for (int m = 0; m < 4; ++m) { const size_t off = (size_t)(row0 + ai * HALF + m * 16) * ldc + col0;
#pragma unroll
                for (int bj = 0; bj < 2; ++bj)
#pragma unroll
                    for (int n = 0; n < 2; ++n) { const f32x4 bs = *(const f32x4*)(base + off + bj * HALF + n * 16); *(f32x4*)(out + off + bj * HALF + n * 16) = bs + acc[ai][bj][m][n]; }
                asm volatile("" ::: "memory"); }
    }
};
struct EpiSwiglu {
    static constexpr bool PERM = true;
    bf16_t* O;
    DI void operator()(const f32x4 (&acc)[2][2][4][2], const Unit& u, int wr, int wc, int fr, int fq) const {
        const int row0 = u.pm * BM + wr * 64 + fr, col0 = u.pn * HALF + wc * 32 + 8 * fq;
#pragma unroll
        for (int ai = 0; ai < 2; ++ai)
#pragma unroll
            for (int m = 0; m < 4; ++m) { bf16_t* rowp = O + (size_t)(row0 + ai * HALF + m * 16) * FF + col0;
                float h[8];
#pragma unroll
                for (int n = 0; n < 2; ++n)
#pragma unroll
                    for (int j = 0; j < 4; ++j) { const float g = acc[ai][0][m][n][j], up = acc[ai][1][m][n][j]; h[n * 4 + j] = g / (1.0f + __expf(-g)) * up; }
                u32x4 w; w.x = cvt_pk_bf16(h[0], h[1]); w.y = cvt_pk_bf16(h[2], h[3]); w.z = cvt_pk_bf16(h[4], h[5]); w.w = cvt_pk_bf16(h[6], h[7]);
                *(u32x4*)rowp = w; }
    }
};
struct EpiSwiglu8 {
    static constexpr bool PERM = true;
    unsigned char* O;
    DI void operator()(const f32x4 (&acc)[2][2][4][2], const Unit& u, int wr, int wc, int fr, int fq) const {
        const int row0 = u.pm * BM + wr * 64 + fr, col0 = u.pn * HALF + wc * 32 + 8 * fq;
#pragma unroll
        for (int ai = 0; ai < 2; ++ai)
#pragma unroll
            for (int m = 0; m < 4; ++m) { unsigned char* rowp = O + (size_t)(row0 + ai * HALF + m * 16) * FF + col0;
                float h[8];
#pragma unroll
                for (int n = 0; n < 2; ++n)
#pragma unroll
                    for (int j = 0; j < 4; ++j) { const float g = acc[ai][0][m][n][j], up = acc[ai][1][m][n][j]; h[n * 4 + j] = g / (1.0f + __expf(-g)) * up * 8.0f; }
                u32x2 w; w.x = pk4fp8(h[0], h[1], h[2], h[3]); w.y = pk4fp8(h[4], h[5], h[6], h[7]);
                *(u32x2*)rowp = w; }
    }
};
struct EpiDown {
    static constexpr bool PERM = true;
    bf16_t* O; const float* gw; const LAS int* tb;
    DI void operator()(const f32x4 (&acc)[2][2][4][2], const Unit& u, int wr, int wc, int fr, int fq) const {
        const int row0 = u.pm * BM + wr * 64 + fr, col0 = u.pn * BM + wc * 32 + 8 * fq;
        const int lrow0 = (u.pm - tb[u.e]) * BM + wr * 64 + fr;
        const float* gwe = gw + (size_t)u.e * 65536;
#pragma unroll
        for (int ai = 0; ai < 2; ++ai)
#pragma unroll
            for (int m = 0; m < 4; ++m) { unsigned char* rowp = (unsigned char*)O + (size_t)(row0 + ai * HALF + m * 16) * D + col0; const float g = gwe[lrow0 + ai * HALF + m * 16] * 16.0f;
#pragma unroll
                for (int bj = 0; bj < 2; ++bj) { const f32x4 v0 = acc[ai][bj][m][0] * g, v1 = acc[ai][bj][m][1] * g;
                    u32x2 w; w.x = pk4fp8(v0[0], v0[1], v0[2], v0[3]); w.y = pk4fp8(v1[0], v1[1], v1[2], v1[3]);
                    *(u32x2*)(rowp + bj * HALF) = w; } }
    }
};

typedef int v8i __attribute__((ext_vector_type(8)));
typedef int v4i __attribute__((ext_vector_type(4)));
template <class Epi, class Sched, bool FP8 = false, int SCW = 0x7f7f7f7f, int SCA = 0x7f7f7f7f>
DI void gemm_phase(LAS unsigned char* lds, const void* Aptr, int K, const Sched& S, const Epi& E) {
    constexpr int EB = FP8 ? 1 : 2;
    const int tid = threadIdx.x, wid = __builtin_amdgcn_readfirstlane(tid >> 6), lane = tid & 63, wr = wid >> 2, wc = wid & 3, fr = lane & 15, fq = lane >> 4;
    const int nt = K * EB / (BK * 2);
    const char* Ab = (const char*)Aptr;
    int Rr[2], Cc[2]; unsigned voffB[2];
#pragma unroll
    for (int i = 0; i < 2; ++i) { int R, C; stage_rc(tid * 16 + i * 8192, R, C); const int Rb = Epi::PERM ? ((R & ~31) + perm32(R & 31)) : R; Rr[i] = R; Cc[i] = C * 2; voffB[i] = (unsigned)(Rb * K * EB + C * 2); }
    const unsigned kstep = (unsigned)(BK * 2);
    const size_t hstepB = (size_t)HALF * K * EB;
    const unsigned ldsw = (unsigned)wid * 1024u;
    const int aoff = lds_byte(wr * 64 + fr, fq * (FP8 ? 16 : 8)), boff = lds_byte(wc * 32 + fr, fq * (FP8 ? 16 : 8));
#define PG8_SA(b, h) (((b) * 2 + (h)) * HTB)
#define PG8_SB(b, h) ((4 + (b) * 2 + (h)) * HTB)
#define PG8_STAGEB(bufoff, gbase) do { _Pragma("unroll") for (int _i = 0; _i < 2; ++_i) \
        __builtin_amdgcn_global_load_lds((const unsigned*)((const char*)(gbase) + voffB[_i]), (LAS unsigned*)(lds + (bufoff) + ldsw + _i * 8192), 16, 0, 0); } while (0)
#define PG8_STAGEA(bufoff, offs, kb) do { _Pragma("unroll") for (int _i = 0; _i < 2; ++_i) \
        __builtin_amdgcn_global_load_lds((const unsigned*)(Ab + (size_t)((offs)[_i] + (kb))), (LAS unsigned*)(lds + (bufoff) + ldsw + _i * 8192), 16, 0, 0); } while (0)
#define PG8_LDA(dst, b, h) do { _Pragma("unroll") for (int m = 0; m < 4; ++m) { if constexpr (FP8) { dst##8[m] = *(const LAS v8i*)(lds + PG8_SA(b, h) + aoff + m * 2048); } \
        else { _Pragma("unroll") for (int k = 0; k < 2; ++k) dst[m][k] = *(const LAS bf16x8*)(lds + PG8_SA(b, h) + aoff + m * 2048 + k * 1024); } } } while (0)
#define PG8_LDB(dst, b, h) do { _Pragma("unroll") for (int n = 0; n < 2; ++n) { if constexpr (FP8) { dst##8[n] = *(const LAS v8i*)(lds + PG8_SB(b, h) + boff + n * 2048); } \
        else { _Pragma("unroll") for (int k = 0; k < 2; ++k) dst[n][k] = *(const LAS bf16x8*)(lds + PG8_SB(b, h) + boff + n * 2048 + k * 1024); } } } while (0)
#define PG8_MMA(ai, bj, At, Bt) do { __builtin_amdgcn_s_setprio(1); _Pragma("unroll") for (int m = 0; m < 4; ++m) _Pragma("unroll") for (int n = 0; n < 2; ++n) { \
        if constexpr (FP8) asm volatile("v_mfma_scale_f32_16x16x128_f8f6f4 %0, %1, %2, %0, %3, %4 op_sel_hi:[0,0,0]" : "+v"(acc[ai][bj][m][n]) : "v"(Bt##8[n]), "v"(At##8[m]), "v"(scw_), "v"(sca_)); \
        else { _Pragma("unroll") for (int k = 0; k < 2; ++k) acc[ai][bj][m][n] = __builtin_amdgcn_mfma_f32_16x16x32_bf16(Bt[n][k], At[m][k], acc[ai][bj][m][n], 0, 0, 0); } } __builtin_amdgcn_s_setprio(0); } while (0)
#define PG8_WAIT_V(n) asm volatile("s_waitcnt vmcnt(" #n ")" ::: "memory")
#define PG8_WAIT_L(n) asm volatile("s_waitcnt lgkmcnt(" #n ")" ::: "memory")
#define PG8_BAR __builtin_amdgcn_s_barrier()
#define PG8_SCHED __builtin_amdgcn_sched_barrier(0)
    Unit cur, nxt; int ui = 0;
    if (!S.next(0, cur)) return;
    f32x4 acc[2][2][4][2];
#pragma unroll
    for (int a = 0; a < 2; ++a)
#pragma unroll
        for (int b = 0; b < 2; ++b)
#pragma unroll
            for (int m = 0; m < 4; ++m)
#pragma unroll
                for (int n = 0; n < 2; ++n) acc[a][b][m][n] = (f32x4){0.f, 0.f, 0.f, 0.f};
    const int scw_ = SCW, sca_ = SCA; (void)scw_; (void)sca_;
    bf16x8 At[4][2], B0[2][2], B1[2][2]; v8i At8[4], B08[2], B18[2]; (void)At; (void)B0; (void)B1; (void)At8; (void)B08; (void)B18;
    unsigned ao[2][2];
#pragma unroll
    for (int h = 0; h < 2; ++h)
#pragma unroll
        for (int i = 0; i < 2; ++i) ao[h][i] = S.a_off(cur, h, Rr[i]) + (unsigned)Cc[i];
    const char* cB = S.b_base(cur);
    PG8_STAGEB(PG8_SB(0, 0), cB); PG8_STAGEB(PG8_SB(0, 1), cB + hstepB); PG8_STAGEA(PG8_SA(0, 0), ao[0], 0u); PG8_STAGEA(PG8_SA(0, 1), ao[1], 0u);
    if (wr == 1) PG8_BAR;
    PG8_WAIT_V(2); PG8_BAR;
    PG8_STAGEB(PG8_SB(1, 0), cB + kstep); PG8_STAGEA(PG8_SA(1, 0), ao[0], kstep); PG8_STAGEB(PG8_SB(1, 1), cB + hstepB + kstep);
    PG8_WAIT_V(6); PG8_BAR;
    for (;;) {
        const bool has_next = S.next(ui + 1, nxt);
        const char* nB = has_next ? S.b_base(nxt) : cB;
#pragma unroll 1
        for (int t = 0; t < nt; t += 2) {
            const bool last = (t == nt - 2);
            const unsigned kb1 = (unsigned)(t + 1) * kstep, kb2 = (unsigned)(t + 2) * kstep;
            unsigned x2[2][2];
#pragma unroll
            for (int h = 0; h < 2; ++h)
#pragma unroll
                for (int i = 0; i < 2; ++i) x2[h][i] = last ? (has_next ? (S.a_off(nxt, h, Rr[i]) + (unsigned)Cc[i]) : ao[h][i]) : ao[h][i] + kb2;
            const char* b2 = last ? nB : cB + kb2; const char* b3 = b2 + kstep;
            PG8_LDB(B0, 0, 0); PG8_LDB(B1, 0, 1); PG8_SCHED; PG8_LDA(At, 0, 0); PG8_STAGEA(PG8_SA(1, 1), ao[1], kb1);
            PG8_WAIT_V(8); PG8_WAIT_L(0); PG8_BAR; PG8_MMA(0, 0, At, B0); PG8_MMA(0, 1, At, B1); PG8_BAR; PG8_SCHED;
            PG8_LDA(At, 0, 1); PG8_STAGEB(PG8_SB(0, 0), b2); PG8_STAGEB(PG8_SB(0, 1), b2 + hstepB); PG8_STAGEA(PG8_SA(0, 0), x2[0], 0u);
            PG8_WAIT_V(8); PG8_WAIT_L(0); PG8_BAR; PG8_MMA(1, 0, At, B0); PG8_MMA(1, 1, At, B1); PG8_BAR; PG8_SCHED;
            PG8_LDB(B0, 1, 0); PG8_LDB(B1, 1, 1); PG8_SCHED; PG8_LDA(At, 1, 0); PG8_STAGEA(PG8_SA(0, 1), x2[1], 0u);
            PG8_WAIT_V(8); PG8_WAIT_L(0); PG8_BAR; PG8_MMA(0, 0, At, B0); PG8_MMA(0, 1, At, B1); PG8_BAR; PG8_SCHED;
            PG8_LDA(At, 1, 1); PG8_STAGEB(PG8_SB(1, 0), b3); PG8_STAGEB(PG8_SB(1, 1), b3 + hstepB); PG8_STAGEA(PG8_SA(1, 0), x2[0], kstep);
            PG8_WAIT_V(8); PG8_WAIT_L(0); PG8_BAR; PG8_MMA(1, 0, At, B0); PG8_MMA(1, 1, At, B1); PG8_BAR; PG8_SCHED;
        }
        if (wr == 0) PG8_BAR;
        if constexpr (FP8) asm volatile("s_nop 15" ::: "memory");
        E(acc, cur, wr, wc, fr, fq);
        if (!has_next) break;
#pragma unroll
        for (int a = 0; a < 2; ++a)
#pragma unroll
            for (int b = 0; b < 2; ++b)
#pragma unroll
                for (int m = 0; m < 4; ++m)
#pragma unroll
                    for (int n = 0; n < 2; ++n) acc[a][b][m][n] = (f32x4){0.f, 0.f, 0.f, 0.f};
        cur = nxt; cB = nB; ++ui;
#pragma unroll
        for (int h = 0; h < 2; ++h)
#pragma unroll
            for (int i = 0; i < 2; ++i) ao[h][i] = S.a_off(cur, h, Rr[i]) + (unsigned)Cc[i];
        if (wr == 1) PG8_BAR;
    }
    PG8_WAIT_V(0);
    PG8_BAR;
#undef PG8_SA
#undef PG8_SB
#undef PG8_STAGEA
#undef PG8_STAGEB
#undef PG8_LDA
#undef PG8_LDB
#undef PG8_MMA
#undef PG8_WAIT_V
#undef PG8_WAIT_L
#undef PG8_BAR
#undef PG8_SCHED
}
}

constexpr int NWAVES = 8, NTHR = 512;
struct Frame {
    LAS unsigned char* lds;
    int tid, lane, wave, G, gw, NGW;
    unsigned* ctl;
    unsigned char* ws;
};

DI void transpose_item(const float* Wseg, int ldw, int ncols, int K, bf16_t* WT, int row_off, LAS float* scr, int item, int lane) {
    const int nblk = ncols / 32, kb = item / nblk, nb = item % nblk, k0 = 64 * kb, n0 = 32 * nb;
#pragma unroll 8
    for (int i = 0; i < 32; ++i) { const int kk = 2 * i + (lane >> 5); scr[kk * 33 + (lane & 31)] = Wseg[(size_t)(k0 + kk) * ldw + n0 + (lane & 31)]; }
    LDS_WAIT(); asm volatile("" ::: "memory");
    const int c = lane & 7;
#pragma unroll
    for (int j = 0; j < 4; ++j) { const int n = (lane >> 3) + 8 * j; const LAS float* s = scr + (8 * c) * 33 + n;
        u32x4 o; o.x = pk2(s[0 * 33], s[1 * 33]); o.y = pk2(s[2 * 33], s[3 * 33]); o.z = pk2(s[4 * 33], s[5 * 33]); o.w = pk2(s[6 * 33], s[7 * 33]);
        *(u32x4*)(WT + (size_t)(row_off + n0 + n) * K + k0 + 8 * c) = o; }
    LDS_WAIT(); asm volatile("" ::: "memory");
}

DI void transpose_item8(const float* Wseg, int ldw, int ncols, int K, unsigned char* WT, int row_off, LAS float* scr, int item, int lane, float qs) {
    const int nblk = ncols / 32, kb = item / nblk, nb = item % nblk, k0 = 64 * kb, n0 = 32 * nb;
#pragma unroll 8
    for (int i = 0; i < 32; ++i) { const int kk = 2 * i + (lane >> 5); scr[kk * 33 + (lane & 31)] = Wseg[(size_t)(k0 + kk) * ldw + n0 + (lane & 31)] * qs; }
    LDS_WAIT(); asm volatile("" ::: "memory");
    const int n = lane >> 1, hf = lane & 1; const LAS float* sp = scr + (32 * hf) * 33 + n;
    u32x4 o0, o1;
    o0.x = pk4fp8(sp[0 * 33], sp[1 * 33], sp[2 * 33], sp[3 * 33]); o0.y = pk4fp8(sp[4 * 33], sp[5 * 33], sp[6 * 33], sp[7 * 33]); o0.z = pk4fp8(sp[8 * 33], sp[9 * 33], sp[10 * 33], sp[11 * 33]); o0.w = pk4fp8(sp[12 * 33], sp[13 * 33], sp[14 * 33], sp[15 * 33]);
    o1.x = pk4fp8(sp[16 * 33], sp[17 * 33], sp[18 * 33], sp[19 * 33]); o1.y = pk4fp8(sp[20 * 33], sp[21 * 33], sp[22 * 33], sp[23 * 33]); o1.z = pk4fp8(sp[24 * 33], sp[25 * 33], sp[26 * 33], sp[27 * 33]); o1.w = pk4fp8(sp[28 * 33], sp[29 * 33], sp[30 * 33], sp[31 * 33]);
    unsigned char* dst = WT + (size_t)(row_off + n0 + n) * K + k0 + 32 * hf;
    *(u32x4*)dst = o0; *(u32x4*)(dst + 16) = o1;
    LDS_WAIT(); asm volatile("" ::: "memory");
}
DI void p0_weights(Frame& F, const float* const* in) {
    LAS float* scr = (LAS float*)(F.lds + F.wave * 16384);
    bf16_t* win0 = (bf16_t*)(F.ws + WS_WIN0); bf16_t* wout0 = (bf16_t*)(F.ws + WS_WOUT0); bf16_t* win1 = (bf16_t*)(F.ws + WS_WIN1); bf16_t* wout1 = (bf16_t*)(F.ws + WS_WOUT1);
    const float* ewin = in[3]; const float* ewout = in[9]; const float* owin = in[10]; const float* owout = in[14];
    constexpr int KB = D / 64;
    constexpr int I_A = KB * (4096 / 32), I_B = KB * (4096 / 32), I_C = KB * (2048 / 32), I_D = KB * (2048 / 32);
    constexpr int I_O0 = (4096 / 64) * (D / 32), I_I1 = KB * (ODD_IN / 32), I_O1 = KB * (D / 32);
    constexpr int NIT = I_A + I_B + I_C + I_D + I_O0 + I_I1 + I_O1;
    for (int it = F.gw; it < NIT; it += F.NGW) {
        int r = it;
        if (r < I_A) { transpose_item(ewin + 0, EVEN_IN, 4096, D, win0, 0, scr, r, F.lane); continue; } r -= I_A;
        if (r < I_B) { transpose_item(ewin + 6144, EVEN_IN, 4096, D, win0, C_GQKV, scr, r, F.lane); continue; } r -= I_B;
        if (r < I_C) { transpose_item(ewin + 4096, EVEN_IN, 2048, D, win0, C_RG, scr, r, F.lane); continue; } r -= I_C;
        if (r < I_D) { transpose_item(ewin + 10240, EVEN_IN, 2048, D, win0, C_GZ, scr, r, F.lane); continue; } r -= I_D;
        if (r < I_O0) { transpose_item(ewout, D, D, 4096, wout0, 0, scr, r, F.lane); continue; } r -= I_O0;
        if (r < I_I1) { transpose_item8(owin, ODD_IN, ODD_IN, D, (unsigned char*)win1, 0, scr, r, F.lane, 32.f); continue; } r -= I_I1;
        transpose_item8(owout, D, D, D, (unsigned char*)wout1, 0, scr, r, F.lane, 32.f);
    }
    bf16_t* swh = (bf16_t*)(F.ws + AUX_SW); bf16_t* swl = swh + 112 * D;
    const int gt = (F.gw * 64 + F.lane), NGT = F.NGW * 64;
    for (int i = gt; i < 112 * D; i += NGT) { const int c = i / D, k = i % D; float v;
        if (c < 16) v = ewin[(size_t)k * EVEN_IN + 12288 + c] * in[1][k];
        else { const int l = (c - 16) / 48, cc = (c - 16) % 48; const float gn = in[2][l * D + k]; v = cc < 4 ? in[15][(size_t)l * D * 4 + k * 4 + cc] * gn : (cc < 36 ? in[16][(size_t)l * D * 32 + k * 32 + (cc - 4)] * gn : 0.f); }
        const unsigned hb = f2bf(v); const float lo = v - __builtin_bit_cast(float, hb << 16); swh[i] = (bf16_t)hb; swl[i] = (bf16_t)f2bf(lo); }
    f32x2* cs = (f32x2*)(F.ws + AUX_CS);
    for (int i = gt; i < SEQ * 64; i += NGT) { const int pos = i >> 6, fi = i & 63; double inv = 1.0;
        for (int q = 0; q < fi; ++q) inv *= ROPE_R;
        const double x = (double)pos * inv, k = __builtin_rint(x * 0.15915494309189535), r = (x - k * 6.283185307179586) - k * 2.4492935982947064e-16;
        const float rf = (float)r; const f32x2 v = {cosf(rf), sinf(rf)}; cs[i] = v; if ((fi & 1) == 0) ((f32x2*)(F.ws + AUX_CS32))[pos * 32 + (fi >> 1)] = v; }
}
DI void convert_experts(Frame& F, const float* const* in, int l) {
    LAS float* scr = (LAS float*)(F.lds + F.wave * 16384);
    const float* wg = in[17] + (size_t)l * NEXP * D * FF; const float* wu = in[18] + (size_t)l * NEXP * D * FF; const float* wd = in[19] + (size_t)l * NEXP * FF * D;
    unsigned char* gu = F.ws + WS_BIG + BIG_EGU; unsigned char* dn = F.ws + WS_BIG + BIG_EDN;
    constexpr int I_G = (D / 64) * (128 / 32);
    constexpr int I_GU = NEXP * 6 * 2 * I_G;
    constexpr int I_DE = (FF / 64) * (D / 32);
    constexpr int NIT = I_GU + NEXP * I_DE;
    for (int it = F.gw; it < NIT; it += F.NGW) {
        if (it < I_GU) { const int seg = it / I_G, r = it % I_G, e = seg / 12, s = seg % 12, pn = s >> 1, isup = s & 1;
            const float* src = (isup ? wu : wg) + (size_t)e * D * FF + pn * 128;
            transpose_item8(src, FF, 128, D, gu + (size_t)e * 1536 * D, pn * 256 + isup * 128, scr, r, F.lane, 64.f); }
        else { const int r2 = it - I_GU, e = r2 / I_DE, r = r2 % I_DE;
            transpose_item8(wd + (size_t)e * FF * D, D, D, FF, dn + (size_t)e * D * FF, 0, scr, r, F.lane, 32.f); }
    }
}

template <int NP, bool ADDY, bool WRITEX, bool WRITEH, class Handler, bool H8 = false>
DI void norm_pass(Frame& F, const float* src, float* dst, const bf16_t* y, const unsigned* asg, const LAS int* tb, const float* gain, const float* Wt, bf16_t* H, Handler hnd) {
    for (int m = F.gw; m < NTOK; m += F.NGW) {
        const f32x4* xr = (const f32x4*)(src + (size_t)m * D) + F.lane;
        f32x4 v[8];
#pragma unroll
        for (int j = 0; j < 8; ++j) v[j] = xr[64 * j];
        if (ADDY) {
            const unsigned a0 = asg[2 * m], a1 = asg[2 * m + 1];
            const size_t r0 = (size_t)tb[a0 >> 16] * 256 + (a0 & 0xffffu), r1 = (size_t)tb[a1 >> 16] * 256 + (a1 & 0xffffu);
            const unsigned* y0 = (const unsigned*)((const unsigned char*)y + r0 * D) + F.lane; const unsigned* y1 = (const unsigned*)((const unsigned char*)y + r1 * D) + F.lane;
#pragma unroll
            for (int j = 0; j < 8; ++j) { const int p = (int)y0[64 * j], q = (int)y1[64 * j];
                v[j].x += (__builtin_amdgcn_cvt_f32_fp8(p, 0) + __builtin_amdgcn_cvt_f32_fp8(q, 0)) * 0.0625f; v[j].y += (__builtin_amdgcn_cvt_f32_fp8(p, 1) + __builtin_amdgcn_cvt_f32_fp8(q, 1)) * 0.0625f;
                v[j].z += (__builtin_amdgcn_cvt_f32_fp8(p, 2) + __builtin_amdgcn_cvt_f32_fp8(q, 2)) * 0.0625f; v[j].w += (__builtin_amdgcn_cvt_f32_fp8(p, 3) + __builtin_amdgcn_cvt_f32_fp8(q, 3)) * 0.0625f; }
        }
        if (WRITEX) { f32x4* xo = (f32x4*)(dst + (size_t)m * D) + F.lane;
#pragma unroll
            for (int j = 0; j < 8; ++j) xo[64 * j] = v[j]; }
        if (WRITEH) {
            float s = 0.f;
#pragma unroll
            for (int j = 0; j < 8; ++j) s += (v[j].x * v[j].x + v[j].y * v[j].y) + (v[j].z * v[j].z + v[j].w * v[j].w);
            const float rstd = 1.0f / sqrtf(wave_sum(s) * (1.0f / D) + EPS);
            const f32x4* gr = (const f32x4*)gain + F.lane;
#pragma unroll
            for (int j = 0; j < 8; ++j) v[j] = v[j] * rstd * gr[64 * j];
            if (H8) { unsigned* ho8 = (unsigned*)((unsigned char*)H + (size_t)m * D) + F.lane;
#pragma unroll
                for (int j = 0; j < 8; ++j) ho8[64 * j] = pk4fp8(v[j].x * 4.f, v[j].y * 4.f, v[j].z * 4.f, v[j].w * 4.f); }
            else {
            u32x2* ho = (u32x2*)(H + (size_t)m * D) + F.lane;
#pragma unroll
            for (int j = 0; j < 8; ++j) { u32x2 w; w.x = pk2(v[j].x, v[j].y); w.y = pk2(v[j].z, v[j].w); ho[64 * j] = w; } }
            if constexpr (NP > 0) {
                float res = 0.f;
#pragma unroll 1
                for (int c0 = 0; c0 < NP; c0 += 4) {
                    float a[4];
#pragma unroll
                    for (int cc = 0; cc < 4; ++cc) { const f32x4* wr = (const f32x4*)(Wt + (size_t)(c0 + cc) * D) + F.lane; a[cc] = 0.f;
#pragma unroll
                        for (int j = 0; j < 8; ++j) { const f32x4 w = wr[64 * j]; a[cc] += (v[j].x * w.x + v[j].y * w.y) + (v[j].z * w.z + v[j].w * w.w); } }
#pragma unroll
                    for (int cc = 0; cc < 4; ++cc) { const float t = wave_sum(a[cc]); res = (F.lane == c0 + cc) ? t : res; }
                }
                hnd(m, res);
            }
        }
    }
}


typedef f32x4 XTile[8][2];
template <int MODE>
DI void normproj_tile(Frame& F, const XTile& xr, int tile, int tl, int par, const float* gain, const bf16_t* Wh, const bf16_t* Wl, bf16_t* H, float* bg, const float* a_log, const float* dt_bias) {
    constexpr int NT = MODE == 0 ? 1 : 3;
    int lane_o = F.lane; asm volatile("" : "+v"(lane_o));
    const int lane = lane_o, r = lane & 15, kq = lane >> 4, w = F.wave;
    LAS float* ssp = (LAS float*)(F.lds + par * 32768);
    LAS f32x4* lp = (LAS f32x4*)(F.lds + par * 32768 + 1024);
    LAS float* lg = (LAS float*)(F.lds + par * 32768 + 1024 + 24576);
    LAS f32x4* sel = (LAS f32x4*)(F.lds + 65536);
    const size_t tok0 = (size_t)tile * 16;
    f32x4 acc[NT];
#pragma unroll
    for (int nt = 0; nt < NT; ++nt) acc[nt] = (f32x4){0.f, 0.f, 0.f, 0.f};
    float ss = 0.f;
#pragma unroll
    for (int i = 0; i < 8; ++i) { const f32x4 xa = xr[i][0], xb = xr[i][1]; asm volatile("" ::: "memory");
        ss += ((xa.x * xa.x + xa.y * xa.y) + (xa.z * xa.z + xa.w * xa.w)) + ((xb.x * xb.x + xb.y * xb.y) + (xb.z * xb.z + xb.w * xb.w));
        u32x4 hw; hw.x = pkbf(xa.x, xa.y); hw.y = pkbf(xa.z, xa.w); hw.z = pkbf(xb.x, xb.y); hw.w = pkbf(xb.z, xb.w);
        u32x4 lw; lw.x = pkbf(xa.x - bflo(hw.x), xa.y - bfhi(hw.x)); lw.y = pkbf(xa.z - bflo(hw.y), xa.w - bfhi(hw.y)); lw.z = pkbf(xb.x - bflo(hw.z), xb.y - bfhi(hw.z)); lw.w = pkbf(xb.z - bflo(hw.w), xb.w - bfhi(hw.w));
        const bf16x8 xh = __builtin_bit_cast(bf16x8, hw), xl = __builtin_bit_cast(bf16x8, lw);
#pragma unroll
        for (int nt = 0; nt < NT; ++nt) { const size_t wo = (size_t)(16 * nt + r) * D + 256 * w + 32 * i + 8 * kq; const bf16x8 wh = *(const bf16x8*)(Wh + wo), wl = *(const bf16x8*)(Wl + wo);
            acc[nt] = mfma16(xh, wh, acc[nt]); acc[nt] = mfma16(xh, wl, acc[nt]); acc[nt] = mfma16(xl, wh, acc[nt]); } }
    ss += __shfl_xor(ss, 16); ss += __shfl_xor(ss, 32);
    if (lane < 16) ssp[w * 16 + lane] = ss;
#pragma unroll
    for (int nt = 0; nt < NT; ++nt) lp[(w * NT + nt) * 64 + lane] = acc[nt];
    __syncthreads();
    float tot = 0.f;
#pragma unroll
    for (int q = 0; q < 8; ++q) tot += ssp[q * 16 + r];
    const float rstd = 1.0f / sqrtf(tot * (1.0f / D) + EPS);
    { const f32x4* gp = (const f32x4*)(gain + 256 * w + 8 * kq); bf16_t* hp = H + (tok0 + r) * D + 256 * w + 8 * kq;
#pragma unroll
      for (int i = 0; i < 8; ++i) { const f32x4 ga = gp[8 * i], gb = gp[8 * i + 1], xa = xr[i][0] * rstd, xb = xr[i][1] * rstd;
        if (MODE == 1) { u32x2 o; o.x = pk4fp8(xa.x * ga.x * 4.f, xa.y * ga.y * 4.f, xa.z * ga.z * 4.f, xa.w * ga.w * 4.f); o.y = pk4fp8(xb.x * gb.x * 4.f, xb.y * gb.y * 4.f, xb.z * gb.z * 4.f, xb.w * gb.w * 4.f);
            *(u32x2*)((unsigned char*)H + (tok0 + r) * D + 256 * w + 8 * kq + 32 * i) = o; }
        else { u32x4 o; o.x = pkbf(xa.x * ga.x, xa.y * ga.y); o.y = pkbf(xa.z * ga.z, xa.w * ga.w); o.z = pkbf(xb.x * gb.x, xb.y * gb.y); o.w = pkbf(xb.z * gb.z, xb.w * gb.w);
            *(u32x4*)(hp + 32 * i) = o; } } }
    if (w == 0) {
        float rs[4];
#pragma unroll
        for (int q = 0; q < 4; ++q) rs[q] = __shfl(rstd, 4 * kq + q);
        f32x4 tl4[NT];
#pragma unroll
        for (int nt = 0; nt < NT; ++nt) { tl4[nt] = lp[nt * 64 + lane];
#pragma unroll
            for (int q = 1; q < 8; ++q) tl4[nt] += lp[(q * NT + nt) * 64 + lane]; }
        if (MODE == 0) {
#pragma unroll
            for (int q = 0; q < 4; ++q) { const float v = tl4[0][q] * rs[q]; float o;
                if (r < 8) o = 1.0f / (1.0f + __expf(-v)); else { const float z = v + dt_bias[r - 8]; const float sp = z > 20.f ? z : log1pf(__expf(z)); o = -__expf(a_log[r - 8]) * sp; }
                bg[(tok0 + 4 * kq + q) * 16 + r] = o; }
        } else {
#pragma unroll
            for (int nt = 0; nt < NT; ++nt)
#pragma unroll
                for (int q = 0; q < 4; ++q) lg[(4 * kq + q) * 48 + 16 * nt + r] = tl4[nt][q] * rs[q];
            LDS_WAIT();
            if (lane < 16) {
                const LAS float* p = lg + lane * 48;
                int g = 0; float gm = p[0];
#pragma unroll
                for (int j = 1; j < 4; ++j) { const float v = p[j]; if (v > gm) { gm = v; g = j; } }
                float gs = 0.f;
#pragma unroll
                for (int j = 0; j < 4; ++j) gs += __expf(p[j] - gm);
                const float g_p = 1.0f / gs;
                float q8[8];
#pragma unroll
                for (int i = 0; i < 8; ++i) q8[i] = p[4 + 8 * g + i];
                int i0 = 0; float m0 = q8[0];
#pragma unroll
                for (int i = 1; i < 8; ++i) if (q8[i] > m0) { m0 = q8[i]; i0 = i; }
                int i1 = -1; float m1 = -3.0e38f;
#pragma unroll
                for (int i = 0; i < 8; ++i) if (i != i0 && q8[i] > m1) { m1 = q8[i]; i1 = i; }
                if (i1 < 0) i1 = (i0 + 1) & 7;
                const float e1 = __expf(m1 - m0), w0 = g_p / (1.0f + e1), w1 = g_p * e1 / (1.0f + e1);
                sel[tl * 16 + lane] = (f32x4){__builtin_bit_cast(float, g * 8 + i0), __builtin_bit_cast(float, g * 8 + i1), w0, w1};
            }
        }
    }
}
DI void xtile_load(Frame& F, XTile& xr, const float* x, int tile) {
    const f32x4* xp = (const f32x4*)(x + ((size_t)tile * 16 + (F.lane & 15)) * D + 256 * F.wave + 8 * (F.lane >> 4));
#pragma unroll
    for (int i = 0; i < 8; ++i) { xr[i][0] = xp[8 * i]; xr[i][1] = xp[8 * i + 1]; }
}
template <int MODE>
DI void normproj_pass(Frame& F, const float* x, const float* gain, const bf16_t* Wh, const bf16_t* Wl, bf16_t* H, float* bg, const float* a_log, const float* dt_bias, unsigned* cnt, int* list, float* gw, unsigned* asg) {
    constexpr int NTILE = NTOK / 16;
    XTile xa, xb;
    int tile = blockIdx.x, tl = 0;
    if (tile < NTILE) xtile_load(F, xa, x, tile);
    while (tile < NTILE) {
        if (tile + F.G < NTILE) xtile_load(F, xb, x, tile + F.G);
        normproj_tile<MODE>(F, xa, tile, tl, tl & 1, gain, Wh, Wl, H, bg, a_log, dt_bias);
        tile += F.G; ++tl;
        if (tile >= NTILE) break;
        if (tile + F.G < NTILE) xtile_load(F, xa, x, tile + F.G);
        normproj_tile<MODE>(F, xb, tile, tl, tl & 1, gain, Wh, Wl, H, bg, a_log, dt_bias);
        tile += F.G; ++tl;
    }
    __syncthreads();
    if (MODE == 1 && F.wave == 0) {
        LAS f32x4* sel = (LAS f32x4*)(F.lds + 65536); LAS unsigned* hist = (LAS unsigned*)(F.lds + 65536 + 4096); LAS unsigned* base = hist + 32;
        const int lane = F.lane;
        if (lane < 32) hist[lane] = 0u;
        LDS_WAIT();
        const int ntok = tl * 16;
        unsigned rk[8]; int ee[8]; float ww[8]; int mm[8];
#pragma unroll
        for (int q = 0; q < 8; ++q) { const int a = lane + 64 * q;
            ee[q] = -1; if ((a >> 1) < ntok) { const f32x4 sv = sel[a >> 1]; ee[q] = __builtin_bit_cast(int, (a & 1) ? sv.y : sv.x); ww[q] = (a & 1) ? sv.w : sv.z;
                mm[q] = (blockIdx.x + ((a >> 1) >> 4) * F.G) * 16 + ((a >> 1) & 15); rk[q] = __hip_atomic_fetch_add(hist + ee[q], 1u, __ATOMIC_RELAXED, __HIP_MEMORY_SCOPE_WORKGROUP); } }
        LDS_WAIT();
        if (lane < 32) { const unsigned c = hist[lane]; base[lane] = c ? __hip_atomic_fetch_add(cnt + lane, c, __ATOMIC_RELAXED, __HIP_MEMORY_SCOPE_AGENT) : 0u; }
        LDS_WAIT();
#pragma unroll
        for (int q = 0; q < 8; ++q) if (ee[q] >= 0) { const unsigned pos = base[ee[q]] + rk[q]; const int a = lane + 64 * q;
            list[ee[q] * 65536 + pos] = mm[q]; gw[ee[q] * 65536 + pos] = ww[q]; asg[2 * mm[q] + (a & 1)] = ((unsigned)ee[q] << 16) | pos; }
    }
    __syncthreads();
}

DI unsigned dpp_ror8(unsigned v) { return (unsigned)__builtin_amdgcn_mov_dpp((int)v, 0x128, 0xf, 0xf, true); }
DI void p2_prep(Frame& F, const float* conv_w) {
    bf16_t* pj = (bf16_t*)(F.ws + WS_BIG + BIG_PJ);
    const f32x2* cs = (const f32x2*)(F.ws + AUX_CS);
    bf16_t* qn = (bf16_t*)(F.ws + AUX_QN); bf16_t* kn = (bf16_t*)(F.ws + AUX_KN); bf16_t* vc = (bf16_t*)(F.ws + AUX_VC);
    const int lane = F.lane, l16 = lane & 15;
    for (int grp = F.gw; grp < NTOK / 16; grp += F.NGW) {
        const int m0 = grp * 16, pos0 = m0 & (SEQ - 1);
#pragma unroll 1
        for (int j = 0; j < 8; ++j) { const int ch = 512 * j + 8 * lane;
            f32x4 w[4][2];
#pragma unroll
            for (int tp = 0; tp < 4; ++tp) { w[tp][0] = *(const f32x4*)(conv_w + tp * 4096 + ch); w[tp][1] = *(const f32x4*)(conv_w + tp * 4096 + ch + 4); }
            u32x4 rr[19];
#pragma unroll
            for (int q = 0; q < 19; ++q) { const int dp = pos0 - 3 + q; rr[q] = (u32x4){0u, 0u, 0u, 0u}; if (dp >= 0) rr[q] = *(const u32x4*)(pj + (size_t)(m0 - 3 + q) * PJW + C_GQKV + ch); }
#pragma unroll
            for (int tt = 0; tt < 16; ++tt) { float a[8];
#pragma unroll
                for (int e = 0; e < 8; ++e) a[e] = 0.f;
#pragma unroll
                for (int tp = 0; tp < 4; ++tp) { const u32x4 r = rr[tt + tp];
                    a[0] += bflo(r.x) * w[tp][0].x; a[1] += bfhi(r.x) * w[tp][0].y; a[2] += bflo(r.y) * w[tp][0].z; a[3] += bfhi(r.y) * w[tp][0].w; a[4] += bflo(r.z) * w[tp][1].x; a[5] += bfhi(r.z) * w[tp][1].y; a[6] += bflo(r.w) * w[tp][1].z; a[7] += bfhi(r.w) * w[tp][1].w; }
                float ss = 0.f;
#pragma unroll
                for (int e = 0; e < 8; ++e) { a[e] = siluf(a[e]); ss += a[e] * a[e]; }
                if (j < 4) { ss += __shfl_xor(ss, 1); ss += __shfl_xor(ss, 2); ss += __shfl_xor(ss, 4); ss += __shfl_xor(ss, 8);
                    const float sc = (1.0f / sqrtf(ss + EPS)) * (j < 2 ? 0.08838834764831845f : 1.0f);
#pragma unroll
                    for (int e = 0; e < 8; ++e) a[e] *= sc; }
                u32x4 o; o.x = pk2(a[0], a[1]); o.y = pk2(a[2], a[3]); o.z = pk2(a[4], a[5]); o.w = pk2(a[6], a[7]);
                const size_t m = (size_t)(m0 + tt);
                bf16_t* dst = j < 2 ? qn + m * 1024 + ch : (j < 4 ? kn + m * 1024 + (ch - 1024) : vc + m * 2048 + (ch - 2048));
                *(u32x4*)dst = o; }
        }
    }
}

constexpr int TB = 16;
template <bool GDN>
DI void p3_recurrence(Frame& F, int u  ) {
    const int b = u >> 2, h = 2 * (u & 3) + (F.tid >> 8), e = F.tid & 255, hh = F.tid >> 8;
    bf16_t* pj = (bf16_t*)(F.ws + WS_BIG + BIG_PJ);
    const bf16_t* qsrc = GDN ? (const bf16_t*)(F.ws + AUX_QN) : pj + C_RQ; const bf16_t* ksrc = GDN ? (const bf16_t*)(F.ws + AUX_KN) : pj + C_RK;
    const int qld = GDN ? 1024 : PJW;
    bf16_t* vsrc = GDN ? (bf16_t*)(F.ws + AUX_VC) : pj + C_RV; const int vld = GDN ? 2048 : PJW;
    const float* bg = (const float*)(F.ws + AUX_BG);
    LAS float* qs = (LAS float*)F.lds;
    LAS float* ks = qs + 2 * TB * 128;
    LAS float* ab = ks + 2 * TB * 128;
    LAS float* vs = ab + 2 * TB * 2;
    float S[128];
#pragma unroll
    for (int d = 0; d < 128; ++d) S[d] = 0.f;
    const float gam = GDN ? 0.f : (1.0f - exp2f(-5.0f - (float)h));
    for (int t0 = 0; t0 < SEQ; t0 += TB) {
        const size_t r0 = (size_t)b * SEQ + t0;
        __syncthreads();
        for (int i = F.tid; i < 2 * TB * 128; i += NTHR) { const int h2 = i / (TB * 128), tt = (i / 128) % TB, d = i % 128; const int hd = 2 * (u & 3) + h2;
            qs[i] = bf2f(qsrc[(r0 + tt) * qld + hd * 128 + d]); ks[i] = bf2f(ksrc[(r0 + tt) * qld + hd * 128 + d]); }
        for (int i = F.tid; i < 2 * TB * 256; i += NTHR) { const int h2 = i / (TB * 256), tt = (i / 256) % TB, ee = i % 256; vs[i] = bf2f(vsrc[(r0 + tt) * vld + (2 * (u & 3) + h2) * 256 + ee]); }
        if (GDN && F.tid < 2 * TB) { const int h2 = F.tid / TB, tt = F.tid % TB, hd = 2 * (u & 3) + h2; ab[F.tid * 2] = __expf(bg[(r0 + tt) * 16 + 8 + hd]); ab[F.tid * 2 + 1] = bg[(r0 + tt) * 16 + hd]; }
        __syncthreads();
#pragma unroll 1
        for (int tt = 0; tt < TB; ++tt) {
            const LAS f32x4* q4 = (const LAS f32x4*)(qs + (hh * TB + tt) * 128); const LAS f32x4* k4 = (const LAS f32x4*)(ks + (hh * TB + tt) * 128);
            const float v = vs[(hh * TB + tt) * 256 + e];
            float o = 0.f;
            if (GDN) {
                const float a = ab[(hh * TB + tt) * 2], beta = ab[(hh * TB + tt) * 2 + 1];
                float ksum = 0.f;
#pragma unroll
                for (int d4 = 0; d4 < 32; ++d4) { if ((d4 & 7) == 0) asm volatile("" ::: "memory"); const f32x4 kk = k4[d4]; ksum += (kk.x * S[4 * d4] + kk.y * S[4 * d4 + 1]) + (kk.z * S[4 * d4 + 2] + kk.w * S[4 * d4 + 3]); }
                const float r = (v - a * ksum) * beta;
#pragma unroll
                for (int d4 = 0; d4 < 32; ++d4) { if ((d4 & 3) == 0) asm volatile("" ::: "memory"); const f32x4 kk = k4[d4], qq = q4[d4];
                    S[4 * d4] = a * S[4 * d4] + r * kk.x; S[4 * d4 + 1] = a * S[4 * d4 + 1] + r * kk.y; S[4 * d4 + 2] = a * S[4 * d4 + 2] + r * kk.z; S[4 * d4 + 3] = a * S[4 * d4 + 3] + r * kk.w;
                    o += (qq.x * S[4 * d4] + qq.y * S[4 * d4 + 1]) + (qq.z * S[4 * d4 + 2] + qq.w * S[4 * d4 + 3]); }
            } else {
#pragma unroll
                for (int d4 = 0; d4 < 32; ++d4) { if ((d4 & 3) == 0) asm volatile("" ::: "memory"); const f32x4 kk = k4[d4], qq = q4[d4];
                    S[4 * d4] = gam * S[4 * d4] + v * kk.x; S[4 * d4 + 1] = gam * S[4 * d4 + 1] + v * kk.y; S[4 * d4 + 2] = gam * S[4 * d4 + 2] + v * kk.z; S[4 * d4 + 3] = gam * S[4 * d4 + 3] + v * kk.w;
                    o += (qq.x * S[4 * d4] + qq.y * S[4 * d4 + 1]) + (qq.z * S[4 * d4 + 2] + qq.w * S[4 * d4 + 3]); }
            }
            vsrc[(r0 + tt) * vld + h * 256 + e] = (bf16_t)f2bf(o);
        }
    }
}


constexpr int NCH = SEQ / 64;
DI constexpr int rowoff4c(int i) { int a = 0; for (int k = 0; k < i; ++k) a += (k + 3) / 4; return a; }
typedef short s16x4 __attribute__((ext_vector_type(4)));
DI s16x4 tr_read(unsigned lds_addr) { s16x4 r; asm volatile("ds_read_b64_tr_b16 %0, %1\n\ts_waitcnt lgkmcnt(0)" : "=&v"(r) : "v"(lds_addr) : "memory"); return r; }
DI void tr_read4(unsigned a0, unsigned a1, unsigned a2, unsigned a3, s16x4& r0, s16x4& r1, s16x4& r2, s16x4& r3) {
    asm volatile("ds_read_b64_tr_b16 %0, %4\n\tds_read_b64_tr_b16 %1, %5\n\tds_read_b64_tr_b16 %2, %6\n\tds_read_b64_tr_b16 %3, %7\n\ts_waitcnt lgkmcnt(0)"
                 : "=&v"(r0), "=&v"(r1), "=&v"(r2), "=&v"(r3) : "v"(a0), "v"(a1), "v"(a2), "v"(a3) : "memory"); }
DI bf16x8 cat8(s16x4 a, s16x4 b) { return __builtin_shufflevector(a, b, 0, 1, 2, 3, 4, 5, 6, 7); }

DI void rope_pair(bf16x8& f1, bf16x8& f2, const f32x4* cp, float sc) {
    const f32x4 c0 = cp[0], c1 = cp[1], c2 = cp[2], c3 = cp[3];
    const float cs_[8] = {c0.x, c0.z, c1.x, c1.z, c2.x, c2.z, c3.x, c3.z}, sn_[8] = {c0.y, c0.w, c1.y, c1.w, c2.y, c2.w, c3.y, c3.w};
    const u32x4 a = __builtin_bit_cast(u32x4, f1), b = __builtin_bit_cast(u32x4, f2);
    const float x1[8] = {bflo(a.x), bfhi(a.x), bflo(a.y), bfhi(a.y), bflo(a.z), bfhi(a.z), bflo(a.w), bfhi(a.w)}, x2[8] = {bflo(b.x), bfhi(b.x), bflo(b.y), bfhi(b.y), bflo(b.z), bfhi(b.z), bflo(b.w), bfhi(b.w)};
    float y1[8], y2[8];
#pragma unroll
    for (int e = 0; e < 8; ++e) { y1[e] = (x1[e] * cs_[e] - x2[e] * sn_[e]) * sc; y2[e] = (x2[e] * cs_[e] + x1[e] * sn_[e]) * sc; }
    u32x4 o1, o2; o1.x = pk2(y1[0], y1[1]); o1.y = pk2(y1[2], y1[3]); o1.z = pk2(y1[4], y1[5]); o1.w = pk2(y1[6], y1[7]); o2.x = pk2(y2[0], y2[1]); o2.y = pk2(y2[2], y2[3]); o2.z = pk2(y2[4], y2[5]); o2.w = pk2(y2[6], y2[7]);
    f1 = __builtin_bit_cast(bf16x8, o1); f2 = __builtin_bit_cast(bf16x8, o2);
}
template <bool GDN>
DI void ga_unit(Frame& F, int unit, unsigned char* stream, float* out_f32_unused) {
    (void)out_f32_unused;
    constexpr int NF = GDN ? 56 : 40, OFF_W = 0, OFF_QG = GDN ? 16 : 0, OFF_ATT = OFF_QG + 16, OFF_KT = OFF_ATT + 8;
    int lane_o = F.lane; asm volatile("" : "+v"(lane_o));
    const int lane = lane_o, fr = lane & 15, g = lane >> 4;
    const int bh = unit / NCH, n = unit % NCH, b = bh >> 3, h = bh & 7;
    const size_t row0 = (size_t)b * SEQ + (size_t)n * 64;
    LAS unsigned char* L = F.lds + F.wave * GA_LDS_WAVE;
    LAS float* LAf = (LAS float*)L; LAS unsigned char* LA = L; LAS unsigned char* LT = L + 9216; LAS float* LG = (LAS float*)(L + 17408); LAS float* LB = LG + 64;
    const bf16_t* pj = (const bf16_t*)(F.ws + WS_BIG + BIG_PJ);
    const bf16_t* qsrc = GDN ? (const bf16_t*)(F.ws + AUX_QN) + h * 128 : pj + C_RQ + h * 128;
    const bf16_t* ksrc = GDN ? (const bf16_t*)(F.ws + AUX_KN) + h * 128 : pj + C_RK + h * 128;
    const size_t qld = GDN ? 1024 : PJW;
    unsigned char* st = stream + (size_t)unit * NF * 1024 + lane * 16;
    float gv, bv = 1.f;
    if (GDN) { const float* bg = (const float*)(F.ws + AUX_BG); gv = bg[(row0 + lane) * 16 + 8 + h]; bv = bg[(row0 + lane) * 16 + h];
#pragma unroll
        for (int o = 1; o < 64; o <<= 1) { const float t = __shfl_up(gv, o); if (lane >= o) gv += t; } }
    else gv = (float)(lane + 1) * log1pf(-exp2f(-5.0f - (float)h));
    const float gl = rdlane(gv, 63);
    LG[lane] = gv; LB[lane] = bv;
    LDS_WAIT();
    float gr[16], gcl[4], br[16];
#pragma unroll
    for (int t = 0; t < 4; ++t) { gcl[t] = LG[16 * t + fr];
#pragma unroll
        for (int r = 0; r < 4; ++r) { gr[t * 4 + r] = LG[16 * t + 4 * g + r]; br[t * 4 + r] = LB[16 * t + 4 * g + r]; } }
    bf16x8 Kf[4][4], Qf[4][4];
#pragma unroll
    for (int t = 0; t < 4; ++t)
#pragma unroll
        for (int s2 = 0; s2 < 4; ++s2) Kf[t][s2] = *(const bf16x8*)(ksrc + (row0 + 16 * t + fr) * qld + 32 * s2 + 8 * g);
    if (!GDN) {
        const f32x2* cs = (const f32x2*)(F.ws + AUX_CS);
#pragma unroll
        for (int t = 0; t < 4; ++t) { const f32x2* cr = cs + (size_t)((row0 + 16 * t + fr) & (SEQ - 1)) * 64 + 8 * g;
            rope_pair(Kf[t][0], Kf[t][2], (const f32x4*)cr, 0.08838834764831845f); rope_pair(Kf[t][1], Kf[t][3], (const f32x4*)(cr + 32), 0.08838834764831845f); }
    }
    if (GDN) {
#pragma unroll
        for (int it = 0; it < 4; ++it)
#pragma unroll
            for (int jt = 0; jt <= it; ++jt) { f32x4 acc = {0.f, 0.f, 0.f, 0.f};
#pragma unroll
                for (int s2 = 0; s2 < 4; ++s2) acc = mfma16(Kf[it][s2], Kf[jt][s2], acc);
#pragma unroll
                for (int r = 0; r < 4; ++r) { const int i = 16 * it + 4 * g + r, j = 16 * jt + fr; const int q = (i + 3) >> 2; const int ro = 2 * q * (q - 1) + q * (i - 4 * q + 3);
                    if (j < i) LAf[ro * 4 + j] = br[it * 4 + r] * acc[r] * __expf(gr[it * 4 + r] - gcl[jt]); } }
    }
    asm volatile("" ::: "memory");
#pragma unroll
    for (int it = 0; it < 4; ++it) {
        asm volatile("" ::: "memory");
#pragma unroll
        for (int s2 = 0; s2 < 4; ++s2) Qf[it][s2] = *(const bf16x8*)(qsrc + (row0 + 16 * it + fr) * qld + 32 * s2 + 8 * g);
        if (!GDN) { const f32x2* cr = (const f32x2*)(F.ws + AUX_CS) + (size_t)((row0 + 16 * it + fr) & (SEQ - 1)) * 64 + 8 * g;
            rope_pair(Qf[it][0], Qf[it][2], (const f32x4*)cr, 1.0f); rope_pair(Qf[it][1], Qf[it][3], (const f32x4*)(cr + 32), 1.0f);
#pragma unroll
            for (int s2 = 0; s2 < 4; ++s2) *(LAS bf16x8*)(L + (16 * it + fr) * 256 + (32 * s2 + 8 * g) * 2) = Qf[it][s2]; }
#pragma unroll
        for (int sp = 0; sp < 2; ++sp) { u32x4 w;
#pragma unroll
            for (int hf = 0; hf < 2; ++hf) { const int jt = 2 * sp + hf; float v[4] = {0.f, 0.f, 0.f, 0.f};
                if (jt <= it) { f32x4 acc = {0.f, 0.f, 0.f, 0.f};
#pragma unroll
                    for (int s2 = 0; s2 < 4; ++s2) acc = mfma16(Kf[jt][s2], Qf[it][s2], acc);
#pragma unroll
                    for (int r = 0; r < 4; ++r) { const int j = 16 * jt + 4 * g + r, i = 16 * it + fr; v[r] = (j <= i) ? acc[r] * __expf(gcl[it] - gr[jt * 4 + r]) : 0.f; } }
                if (hf == 0) { w.x = pk2(v[0], v[1]); w.y = pk2(v[2], v[3]); } else { w.z = pk2(v[0], v[1]); w.w = pk2(v[2], v[3]); } }
            *(u32x4*)(st + (OFF_ATT + it * 2 + sp) * 1024) = w; }
    }
    if (!GDN) LDS_WAIT();
    asm volatile("" ::: "memory");
#pragma unroll
    for (int it = 0; it < 4; ++it) { const float sc = __expf(gcl[it]); asm volatile("" ::: "memory");
#pragma unroll
        for (int s2 = 0; s2 < 4; ++s2) { const bf16_t* qp = qsrc + (row0 + 16 * it + fr) * qld + 32 * s2 + 4 * g; u32x2 lo, hi;
            if (GDN) { lo = *(const u32x2*)qp; hi = *(const u32x2*)(qp + 16); }
            else { const LAS unsigned char* lq = L + (16 * it + fr) * 256 + (32 * s2 + 4 * g) * 2; lo = *(const LAS u32x2*)lq; hi = *(const LAS u32x2*)(lq + 32); }
            u32x4 w; w.x = pk2(bflo(lo.x) * sc, bfhi(lo.x) * sc); w.y = pk2(bflo(lo.y) * sc, bfhi(lo.y) * sc); w.z = pk2(bflo(hi.x) * sc, bfhi(hi.x) * sc); w.w = pk2(bflo(hi.y) * sc, bfhi(hi.y) * sc);
            *(u32x4*)(st + (OFF_QG + it * 4 + s2) * 1024) = w; } }
    asm volatile("" ::: "memory");
    float t[64];
    float sw_ = 1.f, su_ = 1.f;
    if (GDN) {
        LDS_WAIT();
        const LAS f32x4* LA4 = (const LAS f32x4*)LA;
#pragma unroll
        for (int i = 0; i < 64; ++i) { float acc = (lane == i) ? 1.f : 0.f; if ((i & 1) == 0) asm volatile("" ::: "memory");
#pragma unroll
            for (int m4 = 0; m4 < (i + 3) / 4; ++m4) { const f32x4 l = LA4[rowoff4c(i) + m4];
                if (4 * m4 + 0 < i) acc -= l.x * t[4 * m4 + 0]; if (4 * m4 + 1 < i) acc -= l.y * t[4 * m4 + 1]; if (4 * m4 + 2 < i) acc -= l.z * t[4 * m4 + 2]; if (4 * m4 + 3 < i) acc -= l.w * t[4 * m4 + 3]; }
            t[i] = acc; }
        su_ = bv; sw_ = bv * __expf(gv);
        LDS_WAIT();
#pragma unroll
        for (int i = 0; i < 64; ++i) *(LAS bf16_t*)(LT + (i * 64 + lane) * 2) = (bf16_t)f2bf(t[i] * sw_);
    }
    asm volatile("" ::: "memory");
    float ksc[2][2][4];
#pragma unroll
    for (int sp = 0; sp < 2; ++sp)
#pragma unroll
        for (int tp = 0; tp < 2; ++tp)
#pragma unroll
            for (int e = 0; e < 4; ++e) ksc[sp][tp][e] = __expf(gl - LG[32 * sp + 16 * tp + 4 * g + e]);
    const unsigned la_addr = (unsigned)(size_t)LA, q4 = (unsigned)((lane & 15) >> 2), p4 = (unsigned)(lane & 3);
#pragma unroll 1
    for (int p = 0; p < 2; ++p) {
        LDS_WAIT();
#pragma unroll
        for (int k = 0; k < 8; ++k) { const int row = (lane >> 3) + 8 * k, pc = lane & 7; if (GDN) *(LAS u32x4*)(LA + row * 128 + pc * 16) = *(const u32x4*)(ksrc + (row0 + row) * qld + 64 * p + 8 * pc); }
        if (!GDN) {
#pragma unroll
            for (int t = 0; t < 4; ++t)
#pragma unroll
                for (int s2 = 0; s2 < 4; ++s2) if ((s2 >> 1) == p) *(LAS bf16x8*)(LA + (16 * t + fr) * 128 + (32 * (s2 & 1) + 8 * g) * 2) = Kf[t][s2]; }
        LDS_WAIT();
        if (GDN) {
#pragma unroll
            for (int it = 0; it < 4; ++it) { bf16x8 Tf[2];
#pragma unroll
                for (int ks = 0; ks < 2; ++ks) Tf[ks] = *(const LAS bf16x8*)(LT + ((16 * it + fr) * 64 + 32 * ks + 8 * g) * 2);
#pragma unroll
                for (int sl = 0; sl < 2; ++sl) { u32x4 w;
#pragma unroll
                    for (int hf = 0; hf < 2; ++hf) { const int dtl = 2 * sl + hf; f32x4 acc = {0.f, 0.f, 0.f, 0.f};
                        { s16x4 a0, a1, a2, a3; const unsigned ad = la_addr + (8 * g + q4) * 128 + dtl * 32 + p4 * 8; tr_read4(ad, ad + 4 * 128, ad + 32 * 128, ad + 36 * 128, a0, a1, a2, a3);
                          acc = mfma16(cat8(a0, a1), Tf[0], acc); acc = mfma16(cat8(a2, a3), Tf[1], acc); }
                        if (hf == 0) { w.x = pk2(-acc[0], -acc[1]); w.y = pk2(-acc[2], -acc[3]); } else { w.z = pk2(-acc[0], -acc[1]); w.w = pk2(-acc[2], -acc[3]); } }
                    *(u32x4*)(st + (OFF_W + it * 4 + 2 * p + sl) * 1024) = w; } }
        }
#pragma unroll
        for (int dtl = 0; dtl < 4; ++dtl) { s16x4 t0, t1, t2, t3; const unsigned ad = la_addr + (4 * g + q4) * 128 + dtl * 32 + p4 * 8; tr_read4(ad, ad + 16 * 128, ad + 32 * 128, ad + 48 * 128, t0, t1, t2, t3);
#pragma unroll
            for (int sp = 0; sp < 2; ++sp) { const s16x4 a0 = sp ? t2 : t0, a1 = sp ? t3 : t1;
                u32x4 w; w.x = pk2(bf2f((bf16_t)a0[0]) * ksc[sp][0][0], bf2f((bf16_t)a0[1]) * ksc[sp][0][1]); w.y = pk2(bf2f((bf16_t)a0[2]) * ksc[sp][0][2], bf2f((bf16_t)a0[3]) * ksc[sp][0][3]);
                w.z = pk2(bf2f((bf16_t)a1[0]) * ksc[sp][1][0], bf2f((bf16_t)a1[1]) * ksc[sp][1][1]); w.w = pk2(bf2f((bf16_t)a1[2]) * ksc[sp][1][2], bf2f((bf16_t)a1[3]) * ksc[sp][1][3]);
                *(u32x4*)(st + (OFF_KT + (4 * p + dtl) * 2 + sp) * 1024) = w; } }
    }
    if (GDN) {
        LDS_WAIT();
#pragma unroll
        for (int i = 0; i < 64; ++i) *(LAS bf16_t*)(LT + (i * 64 + lane) * 2) = (bf16_t)f2bf(t[i] * su_);
        const bf16_t* vsrc = (const bf16_t*)(F.ws + AUX_VC) + h * 256;
        unsigned char* ub = F.ws + WS_H + (size_t)unit * 32768 + lane * 32;
#pragma unroll 1
        for (int p = 0; p < 4; ++p) {
            LDS_WAIT();
#pragma unroll
            for (int k = 0; k < 8; ++k) { const int row = (lane >> 3) + 8 * k, pc = lane & 7; *(LAS u32x4*)(LA + row * 128 + pc * 16) = *(const u32x4*)(vsrc + (row0 + row) * 2048 + 64 * p + 8 * pc); }
            LDS_WAIT();
            bf16x8 Tf[4][2];
#pragma unroll
            for (int it = 0; it < 4; ++it)
#pragma unroll
                for (int ks = 0; ks < 2; ++ks) Tf[it][ks] = *(const LAS bf16x8*)(LT + ((16 * it + fr) * 64 + 32 * ks + 8 * g) * 2);
#pragma unroll
            for (int etl = 0; etl < 4; ++etl) { bf16x8 Vf[2];
                { s16x4 a0, a1, a2, a3; const unsigned ad = la_addr + (8 * g + q4) * 128 + etl * 32 + p4 * 8; tr_read4(ad, ad + 4 * 128, ad + 32 * 128, ad + 36 * 128, a0, a1, a2, a3); Vf[0] = cat8(a0, a1); Vf[1] = cat8(a2, a3); }
                u32x4 w0, w1;
#pragma unroll
                for (int it = 0; it < 4; ++it) { f32x4 acc = {0.f, 0.f, 0.f, 0.f};
#pragma unroll
                    for (int ks = 0; ks < 2; ++ks) acc = mfma16(Tf[it][ks], Vf[ks], acc);
                    const unsigned a = pk2(acc[0], acc[1]), c = pk2(acc[2], acc[3]);
                    if (it == 0) { w0.x = a; w0.y = c; } else if (it == 1) { w0.z = a; w0.w = c; } else if (it == 2) { w1.x = a; w1.y = c; } else { w1.z = a; w1.w = c; } }
                *(u32x4*)(ub + (4 * p + etl) * 2048) = w0; *(u32x4*)(ub + (4 * p + etl) * 2048 + 16) = w1; }
        }
        if (lane == 0) ((float*)(F.ws + AUX_DEC))[unit] = __expf(gl);
    }
    LDS_WAIT();
}

constexpr int XL_SLOT = 12288, XL_CNT = 4 * XL_SLOT;
template <bool GDN, int ROLE>
DI void scan_wave(Frame& F, int bh, int sl, const unsigned char* stream, LAS unsigned char* xl) {
    constexpr int NF = GDN ? 56 : 40;
    const int lane = F.lane, fr = lane & 15, g = lane >> 4, b = bh >> 3, h = bh & 7;
    const unsigned char* sp0 = stream + (size_t)bh * NCH * NF * 1024;
    const unsigned voff = (unsigned)lane * 16u;
    const size_t orow = (size_t)2048 * 2;
    const unsigned char* obu = (GDN ? F.ws + AUX_VC : F.ws + AUX_QN) + (size_t)b * SEQ * orow + (size_t)(h * 256 + 16 * sl) * 2;
    const unsigned ooff = (unsigned)((size_t)(4 * g) * orow) + (unsigned)fr * 2u;
    const size_t vrow = (size_t)PJW * 2;
    const unsigned char* vbu = F.ws + WS_BIG + BIG_PJ + (size_t)C_RV * 2 + (size_t)b * SEQ * vrow + (size_t)(h * 256 + 16 * sl) * 2;
    const unsigned voff2 = (unsigned)((size_t)(4 * g) * vrow) + (unsigned)fr * 2u;
    const float* decp = (const float*)(F.ws + AUX_DEC) + bh * NCH;
    float decr = 1.f; { const float gm = 1.0f - exp2f(-5.0f - (float)h); float d2 = gm * gm; d2 *= d2; d2 *= d2; d2 *= d2; d2 *= d2; d2 *= d2; decr = d2; }
    const unsigned char* ubp = F.ws + WS_H + (size_t)bh * NCH * 32768 + sl * 2048; const unsigned uoff = (unsigned)lane * 32u;
    const unsigned zoff = 0u; (void)decp; (void)decr; (void)ubp; (void)uoff; (void)zoff; (void)obu; (void)ooff; (void)vbu; (void)voff2; (void)vrow; (void)orow;
    if constexpr (GDN && ROLE == 0) {
    bf16x8 r0 = (bf16x8){0, 0, 0, 0, 0, 0, 0, 0};
    bf16x8 r1 = (bf16x8){0, 0, 0, 0, 0, 0, 0, 0};
    bf16x8 r2 = (bf16x8){0, 0, 0, 0, 0, 0, 0, 0};
    bf16x8 r3 = (bf16x8){0, 0, 0, 0, 0, 0, 0, 0};
    bf16x8 r4 = (bf16x8){0, 0, 0, 0, 0, 0, 0, 0};
    bf16x8 r5 = (bf16x8){0, 0, 0, 0, 0, 0, 0, 0};
    bf16x8 r6 = (bf16x8){0, 0, 0, 0, 0, 0, 0, 0};
    bf16x8 r7 = (bf16x8){0, 0, 0, 0, 0, 0, 0, 0};
    bf16x8 r8 = (bf16x8){0, 0, 0, 0, 0, 0, 0, 0};
    bf16x8 r9 = (bf16x8){0, 0, 0, 0, 0, 0, 0, 0};
    bf16x8 r10 = (bf16x8){0, 0, 0, 0, 0, 0, 0, 0};
    bf16x8 r11 = (bf16x8){0, 0, 0, 0, 0, 0, 0, 0};
    bf16x8 r12 = (bf16x8){0, 0, 0, 0, 0, 0, 0, 0};
    bf16x8 r13 = (bf16x8){0, 0, 0, 0, 0, 0, 0, 0};
    bf16x8 r14 = (bf16x8){0, 0, 0, 0, 0, 0, 0, 0};
    bf16x8 r15 = (bf16x8){0, 0, 0, 0, 0, 0, 0, 0};
    f32x4 S0_0 = {0.f, 0.f, 0.f, 0.f};
    f32x4 S0_1 = {0.f, 0.f, 0.f, 0.f};
    f32x4 S0_2 = {0.f, 0.f, 0.f, 0.f};
    f32x4 S0_3 = {0.f, 0.f, 0.f, 0.f};
    f32x4 S0_4 = {0.f, 0.f, 0.f, 0.f};
    f32x4 S0_5 = {0.f, 0.f, 0.f, 0.f};
    f32x4 S0_6 = {0.f, 0.f, 0.f, 0.f};
    f32x4 S0_7 = {0.f, 0.f, 0.f, 0.f};
    bf16x8 Sp0_0 = (bf16x8){0, 0, 0, 0, 0, 0, 0, 0};
    bf16x8 Sp0_1 = (bf16x8){0, 0, 0, 0, 0, 0, 0, 0};
    bf16x8 Sp0_2 = (bf16x8){0, 0, 0, 0, 0, 0, 0, 0};
    bf16x8 Sp0_3 = (bf16x8){0, 0, 0, 0, 0, 0, 0, 0};
    f32x4 S1_0 = {0.f, 0.f, 0.f, 0.f};
    f32x4 S1_1 = {0.f, 0.f, 0.f, 0.f};
    f32x4 S1_2 = {0.f, 0.f, 0.f, 0.f};
    f32x4 S1_3 = {0.f, 0.f, 0.f, 0.f};
    f32x4 S1_4 = {0.f, 0.f, 0.f, 0.f};
    f32x4 S1_5 = {0.f, 0.f, 0.f, 0.f};
    f32x4 S1_6 = {0.f, 0.f, 0.f, 0.f};
    f32x4 S1_7 = {0.f, 0.f, 0.f, 0.f};
    bf16x8 Sp1_0 = (bf16x8){0, 0, 0, 0, 0, 0, 0, 0};
    bf16x8 Sp1_1 = (bf16x8){0, 0, 0, 0, 0, 0, 0, 0};
    bf16x8 Sp1_2 = (bf16x8){0, 0, 0, 0, 0, 0, 0, 0};
    bf16x8 Sp1_3 = (bf16x8){0, 0, 0, 0, 0, 0, 0, 0};
    float decv = 0.f;
    u32x4 un0_0 = {0u, 0u, 0u, 0u}, un0_1 = {0u, 0u, 0u, 0u};
    u32x4 un1_0 = {0u, 0u, 0u, 0u}, un1_1 = {0u, 0u, 0u, 0u};
    { const int n = 0; (void)n;
    asm volatile("global_load_dwordx4 %0, %1, off" : "+v"(un0_0) : "v"((const unsigned char*)(ubp + 0 * 2048) + uoff) : "memory");
    asm volatile("global_load_dwordx4 %0, %1, off offset:16" : "+v"(un0_1) : "v"((const unsigned char*)(ubp + 0 * 2048) + uoff) : "memory");
    asm volatile("global_load_dwordx4 %0, %1, off" : "+v"(un1_0) : "v"((const unsigned char*)(ubp + 1 * 2048) + uoff) : "memory");
    asm volatile("global_load_dwordx4 %0, %1, off offset:16" : "+v"(un1_1) : "v"((const unsigned char*)(ubp + 1 * 2048) + uoff) : "memory");
    asm volatile("global_load_dword %0, %1, off" : "+v"(decv) : "v"((const unsigned char*)(decp) + zoff) : "memory");
    asm volatile("global_load_dwordx4 %0, %1, off" : "+v"(r0) : "v"((const unsigned char*)(sp0 + ((size_t)(n + 0) * 56 + 0) * 1024) + voff) : "memory");
    asm volatile("global_load_dwordx4 %0, %1, off" : "+v"(r1) : "v"((const unsigned char*)(sp0 + ((size_t)(n + 0) * 56 + 1) * 1024) + voff) : "memory");
    asm volatile("global_load_dwordx4 %0, %1, off" : "+v"(r2) : "v"((const unsigned char*)(sp0 + ((size_t)(n + 0) * 56 + 2) * 1024) + voff) : "memory");
    asm volatile("global_load_dwordx4 %0, %1, off" : "+v"(r3) : "v"((const unsigned char*)(sp0 + ((size_t)(n + 0) * 56 + 3) * 1024) + voff) : "memory");
    asm volatile("global_load_dwordx4 %0, %1, off" : "+v"(r4) : "v"((const unsigned char*)(sp0 + ((size_t)(n + 0) * 56 + 4) * 1024) + voff) : "memory");
    asm volatile("global_load_dwordx4 %0, %1, off" : "+v"(r5) : "v"((const unsigned char*)(sp0 + ((size_t)(n + 0) * 56 + 5) * 1024) + voff) : "memory");
    asm volatile("global_load_dwordx4 %0, %1, off" : "+v"(r6) : "v"((const unsigned char*)(sp0 + ((size_t)(n + 0) * 56 + 6) * 1024) + voff) : "memory");
    asm volatile("global_load_dwordx4 %0, %1, off" : "+v"(r7) : "v"((const unsigned char*)(sp0 + ((size_t)(n + 0) * 56 + 7) * 1024) + voff) : "memory");
    asm volatile("global_load_dwordx4 %0, %1, off" : "+v"(r8) : "v"((const unsigned char*)(sp0 + ((size_t)(n + 0) * 56 + 8) * 1024) + voff) : "memory");
    asm volatile("global_load_dwordx4 %0, %1, off" : "+v"(r9) : "v"((const unsigned char*)(sp0 + ((size_t)(n + 0) * 56 + 9) * 1024) + voff) : "memory");
    asm volatile("global_load_dwordx4 %0, %1, off" : "+v"(r10) : "v"((const unsigned char*)(sp0 + ((size_t)(n + 0) * 56 + 10) * 1024) + voff) : "memory");
    asm volatile("global_load_dwordx4 %0, %1, off" : "+v"(r11) : "v"((const unsigned char*)(sp0 + ((size_t)(n + 0) * 56 + 11) * 1024) + voff) : "memory");
    asm volatile("global_load_dwordx4 %0, %1, off" : "+v"(r12) : "v"((const unsigned char*)(sp0 + ((size_t)(n + 0) * 56 + 12) * 1024) + voff) : "memory");
    asm volatile("global_load_dwordx4 %0, %1, off" : "+v"(r13) : "v"((const unsigned char*)(sp0 + ((size_t)(n + 0) * 56 + 13) * 1024) + voff) : "memory");
    asm volatile("global_load_dwordx4 %0, %1, off" : "+v"(r14) : "v"((const unsigned char*)(sp0 + ((size_t)(n + 0) * 56 + 14) * 1024) + voff) : "memory");
    asm volatile("global_load_dwordx4 %0, %1, off" : "+v"(r15) : "v"((const unsigned char*)(sp0 + ((size_t)(n + 0) * 56 + 15) * 1024) + voff) : "memory");
    }
#pragma unroll 1
    for (int n = 0; n < NCH; ++n) {
        const int nn = n + 1 < NCH ? n + 1 : n;
        f32x4 a0_0, a0_1, a0_2, a0_3;
        f32x4 a1_0, a1_1, a1_2, a1_3;
        asm volatile("s_waitcnt vmcnt(16)" : "+v"(un0_0), "+v"(un0_1), "+v"(un1_0), "+v"(un1_1), "+v"(decv));
        a0_0 = (f32x4){bflo(un0_0.x), bfhi(un0_0.x), bflo(un0_0.y), bfhi(un0_0.y)}; a0_1 = (f32x4){bflo(un0_0.z), bfhi(un0_0.z), bflo(un0_0.w), bfhi(un0_0.w)};
        a0_2 = (f32x4){bflo(un0_1.x), bfhi(un0_1.x), bflo(un0_1.y), bfhi(un0_1.y)}; a0_3 = (f32x4){bflo(un0_1.z), bfhi(un0_1.z), bflo(un0_1.w), bfhi(un0_1.w)};
        a1_0 = (f32x4){bflo(un1_0.x), bfhi(un1_0.x), bflo(un1_0.y), bfhi(un1_0.y)}; a1_1 = (f32x4){bflo(un1_0.z), bfhi(un1_0.z), bflo(un1_0.w), bfhi(un1_0.w)};
        a1_2 = (f32x4){bflo(un1_1.x), bfhi(un1_1.x), bflo(un1_1.y), bfhi(un1_1.y)}; a1_3 = (f32x4){bflo(un1_1.z), bfhi(un1_1.z), bflo(un1_1.w), bfhi(un1_1.w)};
        const float dec = decv;
        { const unsigned char* ubn = ubp + (size_t)nn * 32768;
          asm volatile("global_load_dwordx4 %0, %1, off" : "+v"(un0_0) : "v"((const unsigned char*)(ubn + 0 * 2048) + uoff) : "memory");
          asm volatile("global_load_dwordx4 %0, %1, off offset:16" : "+v"(un0_1) : "v"((const unsigned char*)(ubn + 0 * 2048) + uoff) : "memory");
          asm volatile("global_load_dwordx4 %0, %1, off" : "+v"(un1_0) : "v"((const unsigned char*)(ubn + 1 * 2048) + uoff) : "memory");
          asm volatile("global_load_dwordx4 %0, %1, off offset:16" : "+v"(un1_1) : "v"((const unsigned char*)(ubn + 1 * 2048) + uoff) : "memory");
          asm volatile("global_load_dword %0, %1, off" : "+v"(decv) : "v"((const unsigned char*)(decp + nn) + zoff) : "memory"); }
        __builtin_amdgcn_sched_barrier(0);
        asm volatile("s_waitcnt vmcnt(20)" : "+v"(r0));
        a0_0 = mfma16(r0, Sp0_0, a0_0);
        a1_0 = mfma16(r0, Sp1_0, a1_0);
        asm volatile("global_load_dwordx4 %0, %1, off" : "+v"(r0) : "v"((const unsigned char*)(sp0 + ((size_t)(n + 0) * 56 + 40) * 1024) + voff) : "memory");
        __builtin_amdgcn_sched_barrier(0);
        asm volatile("s_waitcnt vmcnt(20)" : "+v"(r1));
        a0_0 = mfma16(r1, Sp0_1, a0_0);
        a1_0 = mfma16(r1, Sp1_1, a1_0);
        asm volatile("global_load_dwordx4 %0, %1, off" : "+v"(r1) : "v"((const unsigned char*)(sp0 + ((size_t)(n + 0) * 56 + 41) * 1024) + voff) : "memory");
        __builtin_amdgcn_sched_barrier(0);
        asm volatile("s_waitcnt vmcnt(20)" : "+v"(r2));
        a0_0 = mfma16(r2, Sp0_2, a0_0);
        a1_0 = mfma16(r2, Sp1_2, a1_0);
        asm volatile("global_load_dwordx4 %0, %1, off" : "+v"(r2) : "v"((const unsigned char*)(sp0 + ((size_t)(n + 0) * 56 + 42) * 1024) + voff) : "memory");
        __builtin_amdgcn_sched_barrier(0);
        asm volatile("s_waitcnt vmcnt(20)" : "+v"(r3));
        a0_0 = mfma16(r3, Sp0_3, a0_0);
        a1_0 = mfma16(r3, Sp1_3, a1_0);
        asm volatile("global_load_dwordx4 %0, %1, off" : "+v"(r3) : "v"((const unsigned char*)(sp0 + ((size_t)(n + 0) * 56 + 43) * 1024) + voff) : "memory");
        __builtin_amdgcn_sched_barrier(0);
        asm volatile("s_waitcnt vmcnt(20)" : "+v"(r4));
        a0_1 = mfma16(r4, Sp0_0, a0_1);
        a1_1 = mfma16(r4, Sp1_0, a1_1);
        asm volatile("global_load_dwordx4 %0, %1, off" : "+v"(r4) : "v"((const unsigned char*)(sp0 + ((size_t)(n + 0) * 56 + 44) * 1024) + voff) : "memory");
        __builtin_amdgcn_sched_barrier(0);
        asm volatile("s_waitcnt vmcnt(20)" : "+v"(r5));
        a0_1 = mfma16(r5, Sp0_1, a0_1);
        a1_1 = mfma16(r5, Sp1_1, a1_1);
        asm volatile("global_load_dwordx4 %0, %1, off" : "+v"(r5) : "v"((const unsigned char*)(sp0 + ((size_t)(n + 0) * 56 + 45) * 1024) + voff) : "memory");
        __builtin_amdgcn_sched_barrier(0);
        asm volatile("s_waitcnt vmcnt(20)" : "+v"(r6));
        a0_1 = mfma16(r6, Sp0_2, a0_1);
        a1_1 = mfma16(r6, Sp1_2, a1_1);
        asm volatile("global_load_dwordx4 %0, %1, off" : "+v"(r6) : "v"((const unsigned char*)(sp0 + ((size_t)(n + 0) * 56 + 46) * 1024) + voff) : "memory");
        __builtin_amdgcn_sched_barrier(0);
        asm volatile("s_waitcnt vmcnt(20)" : "+v"(r7));
        a0_1 = mfma16(r7, Sp0_3, a0_1);
        a1_1 = mfma16(r7, Sp1_3, a1_1);
        asm volatile("global_load_dwordx4 %0, %1, off" : "+v"(r7) : "v"((const unsigned char*)(sp0 + ((size_t)(n + 0) * 56 + 47) * 1024) + voff) : "memory");
        __builtin_amdgcn_sched_barrier(0);
        asm volatile("s_waitcnt vmcnt(20)" : "+v"(r8));
        a0_2 = mfma16(r8, Sp0_0, a0_2);
        a1_2 = mfma16(r8, Sp1_0, a1_2);
        asm volatile("global_load_dwordx4 %0, %1, off" : "+v"(r8) : "v"((const unsigned char*)(sp0 + ((size_t)(n + 0) * 56 + 48) * 1024) + voff) : "memory");
        __builtin_amdgcn_sched_barrier(0);
        asm volatile("s_waitcnt vmcnt(20)" : "+v"(r9));
        a0_2 = mfma16(r9, Sp0_1, a0_2);
        a1_2 = mfma16(r9, Sp1_1, a1_2);
        asm volatile("global_load_dwordx4 %0, %1, off" : "+v"(r9) : "v"((const unsigned char*)(sp0 + ((size_t)(n + 0) * 56 + 49) * 1024) + voff) : "memory");
        __builtin_amdgcn_sched_barrier(0);
        asm volatile("s_waitcnt vmcnt(20)" : "+v"(r10));
        a0_2 = mfma16(r10, Sp0_2, a0_2);
        a1_2 = mfma16(r10, Sp1_2, a1_2);
        asm volatile("global_load_dwordx4 %0, %1, off" : "+v"(r10) : "v"((const unsigned char*)(sp0 + ((size_t)(n + 0) * 56 + 50) * 1024) + voff) : "memory");
        __builtin_amdgcn_sched_barrier(0);
        asm volatile("s_waitcnt vmcnt(20)" : "+v"(r11));
        a0_2 = mfma16(r11, Sp0_3, a0_2);
        a1_2 = mfma16(r11, Sp1_3, a1_2);
        asm volatile("global_load_dwordx4 %0, %1, off" : "+v"(r11) : "v"((const unsigned char*)(sp0 + ((size_t)(n + 0) * 56 + 51) * 1024) + voff) : "memory");
        __builtin_amdgcn_sched_barrier(0);
        asm volatile("s_waitcnt vmcnt(20)" : "+v"(r12));
        a0_3 = mfma16(r12, Sp0_0, a0_3);
        a1_3 = mfma16(r12, Sp1_0, a1_3);
        asm volatile("global_load_dwordx4 %0, %1, off" : "+v"(r12) : "v"((const unsigned char*)(sp0 + ((size_t)(n + 0) * 56 + 52) * 1024) + voff) : "memory");
        __builtin_amdgcn_sched_barrier(0);
        asm volatile("s_waitcnt vmcnt(20)" : "+v"(r13));
        a0_3 = mfma16(r13, Sp0_1, a0_3);
        a1_3 = mfma16(r13, Sp1_1, a1_3);
        asm volatile("global_load_dwordx4 %0, %1, off" : "+v"(r13) : "v"((const unsigned char*)(sp0 + ((size_t)(n + 0) * 56 + 53) * 1024) + voff) : "memory");
        __builtin_amdgcn_sched_barrier(0);
        asm volatile("s_waitcnt vmcnt(20)" : "+v"(r14));
        a0_3 = mfma16(r14, Sp0_2, a0_3);
        a1_3 = mfma16(r14, Sp1_2, a1_3);
        asm volatile("global_load_dwordx4 %0, %1, off" : "+v"(r14) : "v"((const unsigned char*)(sp0 + ((size_t)(n + 0) * 56 + 54) * 1024) + voff) : "memory");
        __builtin_amdgcn_sched_barrier(0);
        asm volatile("s_waitcnt vmcnt(20)" : "+v"(r15));
        a0_3 = mfma16(r15, Sp0_3, a0_3);
        a1_3 = mfma16(r15, Sp1_3, a1_3);
        asm volatile("global_load_dwordx4 %0, %1, off" : "+v"(r15) : "v"((const unsigned char*)(sp0 + ((size_t)(n + 0) * 56 + 55) * 1024) + voff) : "memory");
        __builtin_amdgcn_sched_barrier(0);
        bf16x8 vp0_0, vp0_1;
        { u32x4 w; w.x = cvt_pk_bf16(a0_0[0], a0_0[1]); w.y = cvt_pk_bf16(a0_0[2], a0_0[3]); w.z = cvt_pk_bf16(a0_1[0], a0_1[1]); w.w = cvt_pk_bf16(a0_1[2], a0_1[3]); vp0_0 = __builtin_bit_cast(bf16x8, w); }
        { u32x4 w; w.x = cvt_pk_bf16(a0_2[0], a0_2[1]); w.y = cvt_pk_bf16(a0_2[2], a0_2[3]); w.z = cvt_pk_bf16(a0_3[0], a0_3[1]); w.w = cvt_pk_bf16(a0_3[2], a0_3[3]); vp0_1 = __builtin_bit_cast(bf16x8, w); }
        bf16x8 vp1_0, vp1_1;
        { u32x4 w; w.x = cvt_pk_bf16(a1_0[0], a1_0[1]); w.y = cvt_pk_bf16(a1_0[2], a1_0[3]); w.z = cvt_pk_bf16(a1_1[0], a1_1[1]); w.w = cvt_pk_bf16(a1_1[2], a1_1[3]); vp1_0 = __builtin_bit_cast(bf16x8, w); }
        { u32x4 w; w.x = cvt_pk_bf16(a1_2[0], a1_2[1]); w.y = cvt_pk_bf16(a1_2[2], a1_2[3]); w.z = cvt_pk_bf16(a1_3[0], a1_3[1]); w.w = cvt_pk_bf16(a1_3[2], a1_3[3]); vp1_1 = __builtin_bit_cast(bf16x8, w); }
        { unsigned sp_ = 0; while (*(volatile LAS unsigned*)(xl + XL_CNT + 64) + 4u <= (unsigned)n) { __builtin_amdgcn_s_sleep(1); if (++sp_ > (1u << 22)) break; } }
        { LAS bf16x8* sl_ = (LAS bf16x8*)(xl + (n & 3) * XL_SLOT) + lane; sl_[0] = Sp0_0; sl_[64] = Sp0_1; sl_[128] = Sp0_2; sl_[192] = Sp0_3; sl_[256] = vp0_0; sl_[320] = vp0_1; sl_[384] = Sp1_0; sl_[448] = Sp1_1; sl_[512] = Sp1_2; sl_[576] = Sp1_3; sl_[640] = vp1_0; sl_[704] = vp1_1; }
        asm volatile("s_waitcnt lgkmcnt(0)" ::: "memory");
        if (lane == 0) *(volatile LAS unsigned*)(xl + XL_CNT) = (unsigned)(n + 1);
        S0_0 = S0_0 * dec;
        S1_0 = S1_0 * dec;
        asm volatile("s_waitcnt vmcnt(15)" : "+v"(r0));
        S0_0 = mfma16(r0, vp0_0, S0_0);
        S1_0 = mfma16(r0, vp1_0, S1_0);
        asm volatile("global_load_dwordx4 %0, %1, off" : "+v"(r0) : "v"((const unsigned char*)(sp0 + ((size_t)(n + 1) * 56 + 0) * 1024) + voff) : "memory");
        __builtin_amdgcn_sched_barrier(0);
        asm volatile("s_waitcnt vmcnt(15)" : "+v"(r1));
        S0_0 = mfma16(r1, vp0_1, S0_0);
        S1_0 = mfma16(r1, vp1_1, S1_0);
        asm volatile("global_load_dwordx4 %0, %1, off" : "+v"(r1) : "v"((const unsigned char*)(sp0 + ((size_t)(n + 1) * 56 + 1) * 1024) + voff) : "memory");
        __builtin_amdgcn_sched_barrier(0);
        S0_1 = S0_1 * dec;
        S1_1 = S1_1 * dec;
        asm volatile("s_waitcnt vmcnt(15)" : "+v"(r2));
        S0_1 = mfma16(r2, vp0_0, S0_1);
        S1_1 = mfma16(r2, vp1_0, S1_1);
        asm volatile("global_load_dwordx4 %0, %1, off" : "+v"(r2) : "v"((const unsigned char*)(sp0 + ((size_t)(n + 1) * 56 + 2) * 1024) + voff) : "memory");
        __builtin_amdgcn_sched_barrier(0);
        asm volatile("s_waitcnt vmcnt(15)" : "+v"(r3));
        S0_1 = mfma16(r3, vp0_1, S0_1);
        S1_1 = mfma16(r3, vp1_1, S1_1);
        asm volatile("global_load_dwordx4 %0, %1, off" : "+v"(r3) : "v"((const unsigned char*)(sp0 + ((size_t)(n + 1) * 56 + 3) * 1024) + voff) : "memory");
        __builtin_amdgcn_sched_barrier(0);
        S0_2 = S0_2 * dec;
        S1_2 = S1_2 * dec;
        asm volatile("s_waitcnt vmcnt(15)" : "+v"(r4));
        S0_2 = mfma16(r4, vp0_0, S0_2);
        S1_2 = mfma16(r4, vp1_0, S1_2);
        asm volatile("global_load_dwordx4 %0, %1, off" : "+v"(r4) : "v"((const unsigned char*)(sp0 + ((size_t)(n + 1) * 56 + 4) * 1024) + voff) : "memory");
        __builtin_amdgcn_sched_barrier(0);
        asm volatile("s_waitcnt vmcnt(15)" : "+v"(r5));
        S0_2 = mfma16(r5, vp0_1, S0_2);
        S1_2 = mfma16(r5, vp1_1, S1_2);
        asm volatile("global_load_dwordx4 %0, %1, off" : "+v"(r5) : "v"((const unsigned char*)(sp0 + ((size_t)(n + 1) * 56 + 5) * 1024) + voff) : "memory");
        __builtin_amdgcn_sched_barrier(0);
        S0_3 = S0_3 * dec;
        S1_3 = S1_3 * dec;
        asm volatile("s_waitcnt vmcnt(15)" : "+v"(r6));
        S0_3 = mfma16(r6, vp0_0, S0_3);
        S1_3 = mfma16(r6, vp1_0, S1_3);
        asm volatile("global_load_dwordx4 %0, %1, off" : "+v"(r6) : "v"((const unsigned char*)(sp0 + ((size_t)(n + 1) * 56 + 6) * 1024) + voff) : "memory");
        __builtin_amdgcn_sched_barrier(0);
        asm volatile("s_waitcnt vmcnt(15)" : "+v"(r7));
        S0_3 = mfma16(r7, vp0_1, S0_3);
        S1_3 = mfma16(r7, vp1_1, S1_3);
        asm volatile("global_load_dwordx4 %0, %1, off" : "+v"(r7) : "v"((const unsigned char*)(sp0 + ((size_t)(n + 1) * 56 + 7) * 1024) + voff) : "memory");
        __builtin_amdgcn_sched_barrier(0);
        S0_4 = S0_4 * dec;
        S1_4 = S1_4 * dec;
        asm volatile("s_waitcnt vmcnt(15)" : "+v"(r8));
        S0_4 = mfma16(r8, vp0_0, S0_4);
        S1_4 = mfma16(r8, vp1_0, S1_4);
        asm volatile("global_load_dwordx4 %0, %1, off" : "+v"(r8) : "v"((const unsigned char*)(sp0 + ((size_t)(n + 1) * 56 + 8) * 1024) + voff) : "memory");
        __builtin_amdgcn_sched_barrier(0);
        asm volatile("s_waitcnt vmcnt(15)" : "+v"(r9));
        S0_4 = mfma16(r9, vp0_1, S0_4);
        S1_4 = mfma16(r9, vp1_1, S1_4);
        asm volatile("global_load_dwordx4 %0, %1, off" : "+v"(r9) : "v"((const unsigned char*)(sp0 + ((size_t)(n + 1) * 56 + 9) * 1024) + voff) : "memory");
        __builtin_amdgcn_sched_barrier(0);
        S0_5 = S0_5 * dec;
        S1_5 = S1_5 * dec;
        asm volatile("s_waitcnt vmcnt(15)" : "+v"(r10));
        S0_5 = mfma16(r10, vp0_0, S0_5);
        S1_5 = mfma16(r10, vp1_0, S1_5);
        asm volatile("global_load_dwordx4 %0, %1, off" : "+v"(r10) : "v"((const unsigned char*)(sp0 + ((size_t)(n + 1) * 56 + 10) * 1024) + voff) : "memory");
        __builtin_amdgcn_sched_barrier(0);
        asm volatile("s_waitcnt vmcnt(15)" : "+v"(r11));
        S0_5 = mfma16(r11, vp0_1, S0_5);
        S1_5 = mfma16(r11, vp1_1, S1_5);
        asm volatile("global_load_dwordx4 %0, %1, off" : "+v"(r11) : "v"((const unsigned char*)(sp0 + ((size_t)(n + 1) * 56 + 11) * 1024) + voff) : "memory");
        __builtin_amdgcn_sched_barrier(0);
        S0_6 = S0_6 * dec;
        S1_6 = S1_6 * dec;
        asm volatile("s_waitcnt vmcnt(15)" : "+v"(r12));
        S0_6 = mfma16(r12, vp0_0, S0_6);
        S1_6 = mfma16(r12, vp1_0, S1_6);
        asm volatile("global_load_dwordx4 %0, %1, off" : "+v"(r12) : "v"((const unsigned char*)(sp0 + ((size_t)(n + 1) * 56 + 12) * 1024) + voff) : "memory");
        __builtin_amdgcn_sched_barrier(0);
        asm volatile("s_waitcnt vmcnt(15)" : "+v"(r13));
        S0_6 = mfma16(r13, vp0_1, S0_6);
        S1_6 = mfma16(r13, vp1_1, S1_6);
        asm volatile("global_load_dwordx4 %0, %1, off" : "+v"(r13) : "v"((const unsigned char*)(sp0 + ((size_t)(n + 1) * 56 + 13) * 1024) + voff) : "memory");
        __builtin_amdgcn_sched_barrier(0);
        S0_7 = S0_7 * dec;
        S1_7 = S1_7 * dec;
        asm volatile("s_waitcnt vmcnt(15)" : "+v"(r14));
        S0_7 = mfma16(r14, vp0_0, S0_7);
        S1_7 = mfma16(r14, vp1_0, S1_7);
        asm volatile("global_load_dwordx4 %0, %1, off" : "+v"(r14) : "v"((const unsigned char*)(sp0 + ((size_t)(n + 1) * 56 + 14) * 1024) + voff) : "memory");
        __builtin_amdgcn_sched_barrier(0);
        asm volatile("s_waitcnt vmcnt(15)" : "+v"(r15));
        S0_7 = mfma16(r15, vp0_1, S0_7);
        S1_7 = mfma16(r15, vp1_1, S1_7);
        asm volatile("global_load_dwordx4 %0, %1, off" : "+v"(r15) : "v"((const unsigned char*)(sp0 + ((size_t)(n + 1) * 56 + 15) * 1024) + voff) : "memory");
        __builtin_amdgcn_sched_barrier(0);
        { u32x4 w; w.x = cvt_pk_bf16(S0_0[0], S0_0[1]); w.y = cvt_pk_bf16(S0_0[2], S0_0[3]); w.z = cvt_pk_bf16(S0_1[0], S0_1[1]); w.w = cvt_pk_bf16(S0_1[2], S0_1[3]); Sp0_0 = __builtin_bit_cast(bf16x8, w); }
        { u32x4 w; w.x = cvt_pk_bf16(S0_2[0], S0_2[1]); w.y = cvt_pk_bf16(S0_2[2], S0_2[3]); w.z = cvt_pk_bf16(S0_3[0], S0_3[1]); w.w = cvt_pk_bf16(S0_3[2], S0_3[3]); Sp0_1 = __builtin_bit_cast(bf16x8, w); }
        { u32x4 w; w.x = cvt_pk_bf16(S0_4[0], S0_4[1]); w.y = cvt_pk_bf16(S0_4[2], S0_4[3]); w.z = cvt_pk_bf16(S0_5[0], S0_5[1]); w.w = cvt_pk_bf16(S0_5[2], S0_5[3]); Sp0_2 = __builtin_bit_cast(bf16x8, w); }
        { u32x4 w; w.x = cvt_pk_bf16(S0_6[0], S0_6[1]); w.y = cvt_pk_bf16(S0_6[2], S0_6[3]); w.z = cvt_pk_bf16(S0_7[0], S0_7[1]); w.w = cvt_pk_bf16(S0_7[2], S0_7[3]); Sp0_3 = __builtin_bit_cast(bf16x8, w); }
        { u32x4 w; w.x = cvt_pk_bf16(S1_0[0], S1_0[1]); w.y = cvt_pk_bf16(S1_0[2], S1_0[3]); w.z = cvt_pk_bf16(S1_1[0], S1_1[1]); w.w = cvt_pk_bf16(S1_1[2], S1_1[3]); Sp1_0 = __builtin_bit_cast(bf16x8, w); }
        { u32x4 w; w.x = cvt_pk_bf16(S1_2[0], S1_2[1]); w.y = cvt_pk_bf16(S1_2[2], S1_2[3]); w.z = cvt_pk_bf16(S1_3[0], S1_3[1]); w.w = cvt_pk_bf16(S1_3[2], S1_3[3]); Sp1_1 = __builtin_bit_cast(bf16x8, w); }
        { u32x4 w; w.x = cvt_pk_bf16(S1_4[0], S1_4[1]); w.y = cvt_pk_bf16(S1_4[2], S1_4[3]); w.z = cvt_pk_bf16(S1_5[0], S1_5[1]); w.w = cvt_pk_bf16(S1_5[2], S1_5[3]); Sp1_2 = __builtin_bit_cast(bf16x8, w); }
        { u32x4 w; w.x = cvt_pk_bf16(S1_6[0], S1_6[1]); w.y = cvt_pk_bf16(S1_6[2], S1_6[3]); w.z = cvt_pk_bf16(S1_7[0], S1_7[1]); w.w = cvt_pk_bf16(S1_7[2], S1_7[3]); Sp1_3 = __builtin_bit_cast(bf16x8, w); }
    }
    asm volatile("s_waitcnt vmcnt(0)" ::: "memory");
    } else if constexpr (GDN && ROLE == 1) {
    bf16x8 r0 = (bf16x8){0, 0, 0, 0, 0, 0, 0, 0};
    bf16x8 r1 = (bf16x8){0, 0, 0, 0, 0, 0, 0, 0};
    bf16x8 r2 = (bf16x8){0, 0, 0, 0, 0, 0, 0, 0};
    bf16x8 r3 = (bf16x8){0, 0, 0, 0, 0, 0, 0, 0};
    bf16x8 r4 = (bf16x8){0, 0, 0, 0, 0, 0, 0, 0};
    bf16x8 r5 = (bf16x8){0, 0, 0, 0, 0, 0, 0, 0};
    bf16x8 r6 = (bf16x8){0, 0, 0, 0, 0, 0, 0, 0};
    bf16x8 r7 = (bf16x8){0, 0, 0, 0, 0, 0, 0, 0};
    bf16x8 r8 = (bf16x8){0, 0, 0, 0, 0, 0, 0, 0};
    bf16x8 r9 = (bf16x8){0, 0, 0, 0, 0, 0, 0, 0};
    bf16x8 r10 = (bf16x8){0, 0, 0, 0, 0, 0, 0, 0};
    bf16x8 r11 = (bf16x8){0, 0, 0, 0, 0, 0, 0, 0};
    bf16x8 r12 = (bf16x8){0, 0, 0, 0, 0, 0, 0, 0};
    bf16x8 r13 = (bf16x8){0, 0, 0, 0, 0, 0, 0, 0};
    bf16x8 r14 = (bf16x8){0, 0, 0, 0, 0, 0, 0, 0};
    bf16x8 r15 = (bf16x8){0, 0, 0, 0, 0, 0, 0, 0};
    bf16x8 r16 = (bf16x8){0, 0, 0, 0, 0, 0, 0, 0};
    bf16x8 r17 = (bf16x8){0, 0, 0, 0, 0, 0, 0, 0};
    bf16x8 r18 = (bf16x8){0, 0, 0, 0, 0, 0, 0, 0};
    bf16x8 r19 = (bf16x8){0, 0, 0, 0, 0, 0, 0, 0};
    bf16x8 r20 = (bf16x8){0, 0, 0, 0, 0, 0, 0, 0};
    bf16x8 r21 = (bf16x8){0, 0, 0, 0, 0, 0, 0, 0};
    bf16x8 r22 = (bf16x8){0, 0, 0, 0, 0, 0, 0, 0};
    bf16x8 r23 = (bf16x8){0, 0, 0, 0, 0, 0, 0, 0};
    asm volatile("global_load_dwordx4 %0, %1, off" : "+v"(r0) : "v"((const unsigned char*)(sp0 + ((size_t)(0 + 0) * 56 + 16) * 1024) + voff) : "memory");
    asm volatile("global_load_dwordx4 %0, %1, off" : "+v"(r1) : "v"((const unsigned char*)(sp0 + ((size_t)(0 + 0) * 56 + 17) * 1024) + voff) : "memory");
    asm volatile("global_load_dwordx4 %0, %1, off" : "+v"(r2) : "v"((const unsigned char*)(sp0 + ((size_t)(0 + 0) * 56 + 18) * 1024) + voff) : "memory");
    asm volatile("global_load_dwordx4 %0, %1, off" : "+v"(r3) : "v"((const unsigned char*)(sp0 + ((size_t)(0 + 0) * 56 + 19) * 1024) + voff) : "memory");
    asm volatile("global_load_dwordx4 %0, %1, off" : "+v"(r4) : "v"((const unsigned char*)(sp0 + ((size_t)(0 + 0) * 56 + 20) * 1024) + voff) : "memory");
    asm volatile("global_load_dwordx4 %0, %1, off" : "+v"(r5) : "v"((const unsigned char*)(sp0 + ((size_t)(0 + 0) * 56 + 21) * 1024) + voff) : "memory");
    asm volatile("global_load_dwordx4 %0, %1, off" : "+v"(r6) : "v"((const unsigned char*)(sp0 + ((size_t)(0 + 0) * 56 + 22) * 1024) + voff) : "memory");
    asm volatile("global_load_dwordx4 %0, %1, off" : "+v"(r7) : "v"((const unsigned char*)(sp0 + ((size_t)(0 + 0) * 56 + 23) * 1024) + voff) : "memory");
    asm volatile("global_load_dwordx4 %0, %1, off" : "+v"(r8) : "v"((const unsigned char*)(sp0 + ((size_t)(0 + 0) * 56 + 24) * 1024) + voff) : "memory");
    asm volatile("global_load_dwordx4 %0, %1, off" : "+v"(r9) : "v"((const unsigned char*)(sp0 + ((size_t)(0 + 0) * 56 + 25) * 1024) + voff) : "memory");
    asm volatile("global_load_dwordx4 %0, %1, off" : "+v"(r10) : "v"((const unsigned char*)(sp0 + ((size_t)(0 + 0) * 56 + 26) * 1024) + voff) : "memory");
    asm volatile("global_load_dwordx4 %0, %1, off" : "+v"(r11) : "v"((const unsigned char*)(sp0 + ((size_t)(0 + 0) * 56 + 27) * 1024) + voff) : "memory");
    asm volatile("global_load_dwordx4 %0, %1, off" : "+v"(r12) : "v"((const unsigned char*)(sp0 + ((size_t)(0 + 0) * 56 + 28) * 1024) + voff) : "memory");
    asm volatile("global_load_dwordx4 %0, %1, off" : "+v"(r13) : "v"((const unsigned char*)(sp0 + ((size_t)(0 + 0) * 56 + 29) * 1024) + voff) : "memory");
    asm volatile("global_load_dwordx4 %0, %1, off" : "+v"(r14) : "v"((const unsigned char*)(sp0 + ((size_t)(0 + 0) * 56 + 30) * 1024) + voff) : "memory");
    asm volatile("global_load_dwordx4 %0, %1, off" : "+v"(r15) : "v"((const unsigned char*)(sp0 + ((size_t)(0 + 0) * 56 + 31) * 1024) + voff) : "memory");
    asm volatile("global_load_dwordx4 %0, %1, off" : "+v"(r16) : "v"((const unsigned char*)(sp0 + ((size_t)(0 + 0) * 56 + 32) * 1024) + voff) : "memory");
    asm volatile("global_load_dwordx4 %0, %1, off" : "+v"(r17) : "v"((const unsigned char*)(sp0 + ((size_t)(0 + 0) * 56 + 33) * 1024) + voff) : "memory");
    asm volatile("global_load_dwordx4 %0, %1, off" : "+v"(r18) : "v"((const unsigned char*)(sp0 + ((size_t)(0 + 0) * 56 + 34) * 1024) + voff) : "memory");
    asm volatile("global_load_dwordx4 %0, %1, off" : "+v"(r19) : "v"((const unsigned char*)(sp0 + ((size_t)(0 + 0) * 56 + 35) * 1024) + voff) : "memory");
    asm volatile("global_load_dwordx4 %0, %1, off" : "+v"(r20) : "v"((const unsigned char*)(sp0 + ((size_t)(0 + 0) * 56 + 36) * 1024) + voff) : "memory");
    asm volatile("global_load_dwordx4 %0, %1, off" : "+v"(r21) : "v"((const unsigned char*)(sp0 + ((size_t)(0 + 0) * 56 + 37) * 1024) + voff) : "memory");
    asm volatile("global_load_dwordx4 %0, %1, off" : "+v"(r22) : "v"((const unsigned char*)(sp0 + ((size_t)(0 + 0) * 56 + 38) * 1024) + voff) : "memory");
    asm volatile("global_load_dwordx4 %0, %1, off" : "+v"(r23) : "v"((const unsigned char*)(sp0 + ((size_t)(0 + 0) * 56 + 39) * 1024) + voff) : "memory");
    { unsigned z = 0u;
      asm volatile("global_store_short %0, %1, off" :: "v"((const unsigned char*)(obu + (size_t)(0) * orow + 0) + ooff), "v"(z) : "memory");
      asm volatile("global_store_short %0, %1, off" :: "v"((const unsigned char*)(obu + (size_t)(1) * orow + 0) + ooff), "v"(z) : "memory");
      asm volatile("global_store_short %0, %1, off" :: "v"((const unsigned char*)(obu + (size_t)(2) * orow + 0) + ooff), "v"(z) : "memory");
      asm volatile("global_store_short %0, %1, off" :: "v"((const unsigned char*)(obu + (size_t)(3) * orow + 0) + ooff), "v"(z) : "memory");
      asm volatile("global_store_short %0, %1, off" :: "v"((const unsigned char*)(obu + (size_t)(16) * orow + 0) + ooff), "v"(z) : "memory");
      asm volatile("global_store_short %0, %1, off" :: "v"((const unsigned char*)(obu + (size_t)(17) * orow + 0) + ooff), "v"(z) : "memory");
      asm volatile("global_store_short %0, %1, off" :: "v"((const unsigned char*)(obu + (size_t)(18) * orow + 0) + ooff), "v"(z) : "memory");
      asm volatile("global_store_short %0, %1, off" :: "v"((const unsigned char*)(obu + (size_t)(19) * orow + 0) + ooff), "v"(z) : "memory");
      asm volatile("global_store_short %0, %1, off" :: "v"((const unsigned char*)(obu + (size_t)(32) * orow + 0) + ooff), "v"(z) : "memory");
      asm volatile("global_store_short %0, %1, off" :: "v"((const unsigned char*)(obu + (size_t)(33) * orow + 0) + ooff), "v"(z) : "memory");
      asm volatile("global_store_short %0, %1, off" :: "v"((const unsigned char*)(obu + (size_t)(34) * orow + 0) + ooff), "v"(z) : "memory");
      asm volatile("global_store_short %0, %1, off" :: "v"((const unsigned char*)(obu + (size_t)(35) * orow + 0) + ooff), "v"(z) : "memory");
      asm volatile("global_store_short %0, %1, off" :: "v"((const unsigned char*)(obu + (size_t)(48) * orow + 0) + ooff), "v"(z) : "memory");
      asm volatile("global_store_short %0, %1, off" :: "v"((const unsigned char*)(obu + (size_t)(49) * orow + 0) + ooff), "v"(z) : "memory");
      asm volatile("global_store_short %0, %1, off" :: "v"((const unsigned char*)(obu + (size_t)(50) * orow + 0) + ooff), "v"(z) : "memory");
      asm volatile("global_store_short %0, %1, off" :: "v"((const unsigned char*)(obu + (size_t)(51) * orow + 0) + ooff), "v"(z) : "memory");
      asm volatile("global_store_short %0, %1, off" :: "v"((const unsigned char*)(obu + (size_t)(0) * orow + 32) + ooff), "v"(z) : "memory");
      asm volatile("global_store_short %0, %1, off" :: "v"((const unsigned char*)(obu + (size_t)(1) * orow + 32) + ooff), "v"(z) : "memory");
      asm volatile("global_store_short %0, %1, off" :: "v"((const unsigned char*)(obu + (size_t)(2) * orow + 32) + ooff), "v"(z) : "memory");
      asm volatile("global_store_short %0, %1, off" :: "v"((const unsigned char*)(obu + (size_t)(3) * orow + 32) + ooff), "v"(z) : "memory");
      asm volatile("global_store_short %0, %1, off" :: "v"((const unsigned char*)(obu + (size_t)(16) * orow + 32) + ooff), "v"(z) : "memory");
      asm volatile("global_store_short %0, %1, off" :: "v"((const unsigned char*)(obu + (size_t)(17) * orow + 32) + ooff), "v"(z) : "memory");
      asm volatile("global_store_short %0, %1, off" :: "v"((const unsigned char*)(obu + (size_t)(18) * orow + 32) + ooff), "v"(z) : "memory");
      asm volatile("global_store_short %0, %1, off" :: "v"((const unsigned char*)(obu + (size_t)(19) * orow + 32) + ooff), "v"(z) : "memory");
      asm volatile("global_store_short %0, %1, off" :: "v"((const unsigned char*)(obu + (size_t)(32) * orow + 32) + ooff), "v"(z) : "memory");
      asm volatile("global_store_short %0, %1, off" :: "v"((const unsigned char*)(obu + (size_t)(33) * orow + 32) + ooff), "v"(z) : "memory");
      asm volatile("global_store_short %0, %1, off" :: "v"((const unsigned char*)(obu + (size_t)(34) * orow + 32) + ooff), "v"(z) : "memory");
      asm volatile("global_store_short %0, %1, off" :: "v"((const unsigned char*)(obu + (size_t)(35) * orow + 32) + ooff), "v"(z) : "memory");
      asm volatile("global_store_short %0, %1, off" :: "v"((const unsigned char*)(obu + (size_t)(48) * orow + 32) + ooff), "v"(z) : "memory");
      asm volatile("global_store_short %0, %1, off" :: "v"((const unsigned char*)(obu + (size_t)(49) * orow + 32) + ooff), "v"(z) : "memory");
      asm volatile("global_store_short %0, %1, off" :: "v"((const unsigned char*)(obu + (size_t)(50) * orow + 32) + ooff), "v"(z) : "memory");
      asm volatile("global_store_short %0, %1, off" :: "v"((const unsigned char*)(obu + (size_t)(51) * orow + 32) + ooff), "v"(z) : "memory");
    }
#pragma unroll 1
    for (int n = 0; n < NCH; ++n) {
        { unsigned sp_ = 0; while (*(volatile LAS unsigned*)(xl + XL_CNT) <= (unsigned)n) { __builtin_amdgcn_s_sleep(1); if (++sp_ > (1u << 22)) break; } }
        bf16x8 Sp0_0, Sp0_1, Sp0_2, Sp0_3, vp0_0, vp0_1;
        bf16x8 Sp1_0, Sp1_1, Sp1_2, Sp1_3, vp1_0, vp1_1;
        { const LAS bf16x8* sl_ = (const LAS bf16x8*)(xl + (n & 3) * XL_SLOT) + lane; Sp0_0 = sl_[0]; Sp0_1 = sl_[64]; Sp0_2 = sl_[128]; Sp0_3 = sl_[192]; vp0_0 = sl_[256]; vp0_1 = sl_[320]; Sp1_0 = sl_[384]; Sp1_1 = sl_[448]; Sp1_2 = sl_[512]; Sp1_3 = sl_[576]; vp1_0 = sl_[640]; vp1_1 = sl_[704]; }
        asm volatile("s_waitcnt lgkmcnt(0)" ::: "memory");
        if (lane == 0) *(volatile LAS unsigned*)(xl + XL_CNT + 64) = (unsigned)(n + 1);
        f32x4 o0_0 = {0.f, 0.f, 0.f, 0.f}, o0_1 = o0_0, o0_2 = o0_0, o0_3 = o0_0;
        f32x4 o1_0 = {0.f, 0.f, 0.f, 0.f}, o1_1 = o1_0, o1_2 = o1_0, o1_3 = o1_0;
        asm volatile("s_waitcnt vmcnt(55)" : "+v"(r0));
        o0_0 = mfma16(r0, Sp0_0, o0_0);
        o1_0 = mfma16(r0, Sp1_0, o1_0);
        asm volatile("global_load_dwordx4 %0, %1, off" : "+v"(r0) : "v"((const unsigned char*)(sp0 + ((size_t)(n + 1) * 56 + 16) * 1024) + voff) : "memory");
        __builtin_amdgcn_sched_barrier(0);
        asm volatile("s_waitcnt vmcnt(55)" : "+v"(r1));
        o0_0 = mfma16(r1, Sp0_1, o0_0);
        o1_0 = mfma16(r1, Sp1_1, o1_0);
        asm volatile("global_load_dwordx4 %0, %1, off" : "+v"(r1) : "v"((const unsigned char*)(sp0 + ((size_t)(n + 1) * 56 + 17) * 1024) + voff) : "memory");
        __builtin_amdgcn_sched_barrier(0);
        asm volatile("s_waitcnt vmcnt(55)" : "+v"(r2));
        o0_0 = mfma16(r2, Sp0_2, o0_0);
        o1_0 = mfma16(r2, Sp1_2, o1_0);
        asm volatile("global_load_dwordx4 %0, %1, off" : "+v"(r2) : "v"((const unsigned char*)(sp0 + ((size_t)(n + 1) * 56 + 18) * 1024) + voff) : "memory");
        __builtin_amdgcn_sched_barrier(0);
        asm volatile("s_waitcnt vmcnt(55)" : "+v"(r3));
        o0_0 = mfma16(r3, Sp0_3, o0_0);
        o1_0 = mfma16(r3, Sp1_3, o1_0);
        asm volatile("global_load_dwordx4 %0, %1, off" : "+v"(r3) : "v"((const unsigned char*)(sp0 + ((size_t)(n + 1) * 56 + 19) * 1024) + voff) : "memory");
        __builtin_amdgcn_sched_barrier(0);
        asm volatile("s_waitcnt vmcnt(55)" : "+v"(r4));
        o0_1 = mfma16(r4, Sp0_0, o0_1);
        o1_1 = mfma16(r4, Sp1_0, o1_1);
        asm volatile("global_load_dwordx4 %0, %1, off" : "+v"(r4) : "v"((const unsigned char*)(sp0 + ((size_t)(n + 1) * 56 + 20) * 1024) + voff) : "memory");
        __builtin_amdgcn_sched_barrier(0);
        asm volatile("s_waitcnt vmcnt(55)" : "+v"(r5));
        o0_1 = mfma16(r5, Sp0_1, o0_1);
        o1_1 = mfma16(r5, Sp1_1, o1_1);
        asm volatile("global_load_dwordx4 %0, %1, off" : "+v"(r5) : "v"((const unsigned char*)(sp0 + ((size_t)(n + 1) * 56 + 21) * 1024) + voff) : "memory");
        __builtin_amdgcn_sched_barrier(0);
        asm volatile("s_waitcnt vmcnt(55)" : "+v"(r6));
        o0_1 = mfma16(r6, Sp0_2, o0_1);
        o1_1 = mfma16(r6, Sp1_2, o1_1);
        asm volatile("global_load_dwordx4 %0, %1, off" : "+v"(r6) : "v"((const unsigned char*)(sp0 + ((size_t)(n + 1) * 56 + 22) * 1024) + voff) : "memory");
        __builtin_amdgcn_sched_barrier(0);
        asm volatile("s_waitcnt vmcnt(55)" : "+v"(r7));
        o0_1 = mfma16(r7, Sp0_3, o0_1);
        o1_1 = mfma16(r7, Sp1_3, o1_1);
        asm volatile("global_load_dwordx4 %0, %1, off" : "+v"(r7) : "v"((const unsigned char*)(sp0 + ((size_t)(n + 1) * 56 + 23) * 1024) + voff) : "memory");
        __builtin_amdgcn_sched_barrier(0);
        asm volatile("s_waitcnt vmcnt(55)" : "+v"(r8));
        o0_2 = mfma16(r8, Sp0_0, o0_2);
        o1_2 = mfma16(r8, Sp1_0, o1_2);
        asm volatile("global_load_dwordx4 %0, %1, off" : "+v"(r8) : "v"((const unsigned char*)(sp0 + ((size_t)(n + 1) * 56 + 24) * 1024) + voff) : "memory");
        __builtin_amdgcn_sched_barrier(0);
        asm volatile("s_waitcnt vmcnt(55)" : "+v"(r9));
        o0_2 = mfma16(r9, Sp0_1, o0_2);
        o1_2 = mfma16(r9, Sp1_1, o1_2);
        asm volatile("global_load_dwordx4 %0, %1, off" : "+v"(r9) : "v"((const unsigned char*)(sp0 + ((size_t)(n + 1) * 56 + 25) * 1024) + voff) : "memory");
        __builtin_amdgcn_sched_barrier(0);
        asm volatile("s_waitcnt vmcnt(55)" : "+v"(r10));
        o0_2 = mfma16(r10, Sp0_2, o0_2);
        o1_2 = mfma16(r10, Sp1_2, o1_2);
        asm volatile("global_load_dwordx4 %0, %1, off" : "+v"(r10) : "v"((const unsigned char*)(sp0 + ((size_t)(n + 1) * 56 + 26) * 1024) + voff) : "memory");
        __builtin_amdgcn_sched_barrier(0);
        asm volatile("s_waitcnt vmcnt(55)" : "+v"(r11));
        o0_2 = mfma16(r11, Sp0_3, o0_2);
        o1_2 = mfma16(r11, Sp1_3, o1_2);
        asm volatile("global_load_dwordx4 %0, %1, off" : "+v"(r11) : "v"((const unsigned char*)(sp0 + ((size_t)(n + 1) * 56 + 27) * 1024) + voff) : "memory");
        __builtin_amdgcn_sched_barrier(0);
        asm volatile("s_waitcnt vmcnt(55)" : "+v"(r12));
        o0_3 = mfma16(r12, Sp0_0, o0_3);
        o1_3 = mfma16(r12, Sp1_0, o1_3);
        asm volatile("global_load_dwordx4 %0, %1, off" : "+v"(r12) : "v"((const unsigned char*)(sp0 + ((size_t)(n + 1) * 56 + 28) * 1024) + voff) : "memory");
        __builtin_amdgcn_sched_barrier(0);
        asm volatile("s_waitcnt vmcnt(55)" : "+v"(r13));
        o0_3 = mfma16(r13, Sp0_1, o0_3);
        o1_3 = mfma16(r13, Sp1_1, o1_3);
        asm volatile("global_load_dwordx4 %0, %1, off" : "+v"(r13) : "v"((const unsigned char*)(sp0 + ((size_t)(n + 1) * 56 + 29) * 1024) + voff) : "memory");
        __builtin_amdgcn_sched_barrier(0);
        asm volatile("s_waitcnt vmcnt(55)" : "+v"(r14));
        o0_3 = mfma16(r14, Sp0_2, o0_3);
        o1_3 = mfma16(r14, Sp1_2, o1_3);
        asm volatile("global_load_dwordx4 %0, %1, off" : "+v"(r14) : "v"((const unsigned char*)(sp0 + ((size_t)(n + 1) * 56 + 30) * 1024) + voff) : "memory");
        __builtin_amdgcn_sched_barrier(0);
        asm volatile("s_waitcnt vmcnt(55)" : "+v"(r15));
        o0_3 = mfma16(r15, Sp0_3, o0_3);
        o1_3 = mfma16(r15, Sp1_3, o1_3);
        asm volatile("global_load_dwordx4 %0, %1, off" : "+v"(r15) : "v"((const unsigned char*)(sp0 + ((size_t)(n + 1) * 56 + 31) * 1024) + voff) : "memory");
        __builtin_amdgcn_sched_barrier(0);
        asm volatile("s_waitcnt vmcnt(55)" : "+v"(r16));
        o0_0 = mfma16(r16, vp0_0, o0_0);
        o1_0 = mfma16(r16, vp1_0, o1_0);
        asm volatile("global_load_dwordx4 %0, %1, off" : "+v"(r16) : "v"((const unsigned char*)(sp0 + ((size_t)(n + 1) * 56 + 32) * 1024) + voff) : "memory");
        __builtin_amdgcn_sched_barrier(0);
        asm volatile("s_waitcnt vmcnt(55)" : "+v"(r17));
        o0_0 = mfma16(r17, vp0_1, o0_0);
        o1_0 = mfma16(r17, vp1_1, o1_0);
        asm volatile("global_load_dwordx4 %0, %1, off" : "+v"(r17) : "v"((const unsigned char*)(sp0 + ((size_t)(n + 1) * 56 + 33) * 1024) + voff) : "memory");
        __builtin_amdgcn_sched_barrier(0);
        asm volatile("s_waitcnt vmcnt(55)" : "+v"(r18));
        o0_1 = mfma16(r18, vp0_0, o0_1);
        o1_1 = mfma16(r18, vp1_0, o1_1);
        asm volatile("global_load_dwordx4 %0, %1, off" : "+v"(r18) : "v"((const unsigned char*)(sp0 + ((size_t)(n + 1) * 56 + 34) * 1024) + voff) : "memory");
        __builtin_amdgcn_sched_barrier(0);
        asm volatile("s_waitcnt vmcnt(55)" : "+v"(r19));
        o0_1 = mfma16(r19, vp0_1, o0_1);
        o1_1 = mfma16(r19, vp1_1, o1_1);
        asm volatile("global_load_dwordx4 %0, %1, off" : "+v"(r19) : "v"((const unsigned char*)(sp0 + ((size_t)(n + 1) * 56 + 35) * 1024) + voff) : "memory");
        __builtin_amdgcn_sched_barrier(0);
        asm volatile("s_waitcnt vmcnt(55)" : "+v"(r20));
        o0_2 = mfma16(r20, vp0_0, o0_2);
        o1_2 = mfma16(r20, vp1_0, o1_2);
        asm volatile("global_load_dwordx4 %0, %1, off" : "+v"(r20) : "v"((const unsigned char*)(sp0 + ((size_t)(n + 1) * 56 + 36) * 1024) + voff) : "memory");
        __builtin_amdgcn_sched_barrier(0);
        asm volatile("s_waitcnt vmcnt(55)" : "+v"(r21));
        o0_2 = mfma16(r21, vp0_1, o0_2);
        o1_2 = mfma16(r21, vp1_1, o1_2);
        asm volatile("global_load_dwordx4 %0, %1, off" : "+v"(r21) : "v"((const unsigned char*)(sp0 + ((size_t)(n + 1) * 56 + 37) * 1024) + voff) : "memory");
        __builtin_amdgcn_sched_barrier(0);
        asm volatile("s_waitcnt vmcnt(55)" : "+v"(r22));
        o0_3 = mfma16(r22, vp0_0, o0_3);
        o1_3 = mfma16(r22, vp1_0, o1_3);
        asm volatile("global_load_dwordx4 %0, %1, off" : "+v"(r22) : "v"((const unsigned char*)(sp0 + ((size_t)(n + 1) * 56 + 38) * 1024) + voff) : "memory");
        __builtin_amdgcn_sched_barrier(0);
        asm volatile("s_waitcnt vmcnt(55)" : "+v"(r23));
        o0_3 = mfma16(r23, vp0_1, o0_3);
        o1_3 = mfma16(r23, vp1_1, o1_3);
        asm volatile("global_load_dwordx4 %0, %1, off" : "+v"(r23) : "v"((const unsigned char*)(sp0 + ((size_t)(n + 1) * 56 + 39) * 1024) + voff) : "memory");
        __builtin_amdgcn_sched_barrier(0);
        { const unsigned char* obn = obu + (size_t)n * 64 * orow;
          { const unsigned v = f2bf(o0_0[0]); asm volatile("global_store_short %0, %1, off" :: "v"((const unsigned char*)(obn + (size_t)(0) * orow + 0) + ooff), "v"(v) : "memory"); }
          { const unsigned v = f2bf(o0_0[1]); asm volatile("global_store_short %0, %1, off" :: "v"((const unsigned char*)(obn + (size_t)(1) * orow + 0) + ooff), "v"(v) : "memory"); }
          { const unsigned v = f2bf(o0_0[2]); asm volatile("global_store_short %0, %1, off" :: "v"((const unsigned char*)(obn + (size_t)(2) * orow + 0) + ooff), "v"(v) : "memory"); }
          { const unsigned v = f2bf(o0_0[3]); asm volatile("global_store_short %0, %1, off" :: "v"((const unsigned char*)(obn + (size_t)(3) * orow + 0) + ooff), "v"(v) : "memory"); }
          { const unsigned v = f2bf(o0_1[0]); asm volatile("global_store_short %0, %1, off" :: "v"((const unsigned char*)(obn + (size_t)(16) * orow + 0) + ooff), "v"(v) : "memory"); }
          { const unsigned v = f2bf(o0_1[1]); asm volatile("global_store_short %0, %1, off" :: "v"((const unsigned char*)(obn + (size_t)(17) * orow + 0) + ooff), "v"(v) : "memory"); }
          { const unsigned v = f2bf(o0_1[2]); asm volatile("global_store_short %0, %1, off" :: "v"((const unsigned char*)(obn + (size_t)(18) * orow + 0) + ooff), "v"(v) : "memory"); }
          { const unsigned v = f2bf(o0_1[3]); asm volatile("global_store_short %0, %1, off" :: "v"((const unsigned char*)(obn + (size_t)(19) * orow + 0) + ooff), "v"(v) : "memory"); }
          { const unsigned v = f2bf(o0_2[0]); asm volatile("global_store_short %0, %1, off" :: "v"((const unsigned char*)(obn + (size_t)(32) * orow + 0) + ooff), "v"(v) : "memory"); }
          { const unsigned v = f2bf(o0_2[1]); asm volatile("global_store_short %0, %1, off" :: "v"((const unsigned char*)(obn + (size_t)(33) * orow + 0) + ooff), "v"(v) : "memory"); }
          { const unsigned v = f2bf(o0_2[2]); asm volatile("global_store_short %0, %1, off" :: "v"((const unsigned char*)(obn + (size_t)(34) * orow + 0) + ooff), "v"(v) : "memory"); }
          { const unsigned v = f2bf(o0_2[3]); asm volatile("global_store_short %0, %1, off" :: "v"((const unsigned char*)(obn + (size_t)(35) * orow + 0) + ooff), "v"(v) : "memory"); }
          { const unsigned v = f2bf(o0_3[0]); asm volatile("global_store_short %0, %1, off" :: "v"((const unsigned char*)(obn + (size_t)(48) * orow + 0) + ooff), "v"(v) : "memory"); }
          { const unsigned v = f2bf(o0_3[1]); asm volatile("global_store_short %0, %1, off" :: "v"((const unsigned char*)(obn + (size_t)(49) * orow + 0) + ooff), "v"(v) : "memory"); }
          { const unsigned v = f2bf(o0_3[2]); asm volatile("global_store_short %0, %1, off" :: "v"((const unsigned char*)(obn + (size_t)(50) * orow + 0) + ooff), "v"(v) : "memory"); }
          { const unsigned v = f2bf(o0_3[3]); asm volatile("global_store_short %0, %1, off" :: "v"((const unsigned char*)(obn + (size_t)(51) * orow + 0) + ooff), "v"(v) : "memory"); }
          { const unsigned v = f2bf(o1_0[0]); asm volatile("global_store_short %0, %1, off" :: "v"((const unsigned char*)(obn + (size_t)(0) * orow + 32) + ooff), "v"(v) : "memory"); }
          { const unsigned v = f2bf(o1_0[1]); asm volatile("global_store_short %0, %1, off" :: "v"((const unsigned char*)(obn + (size_t)(1) * orow + 32) + ooff), "v"(v) : "memory"); }
          { const unsigned v = f2bf(o1_0[2]); asm volatile("global_store_short %0, %1, off" :: "v"((const unsigned char*)(obn + (size_t)(2) * orow + 32) + ooff), "v"(v) : "memory"); }
          { const unsigned v = f2bf(o1_0[3]); asm volatile("global_store_short %0, %1, off" :: "v"((const unsigned char*)(obn + (size_t)(3) * orow + 32) + ooff), "v"(v) : "memory"); }
          { const unsigned v = f2bf(o1_1[0]); asm volatile("global_store_short %0, %1, off" :: "v"((const unsigned char*)(obn + (size_t)(16) * orow + 32) + ooff), "v"(v) : "memory"); }
          { const unsigned v = f2bf(o1_1[1]); asm volatile("global_store_short %0, %1, off" :: "v"((const unsigned char*)(obn + (size_t)(17) * orow + 32) + ooff), "v"(v) : "memory"); }
          { const unsigned v = f2bf(o1_1[2]); asm volatile("global_store_short %0, %1, off" :: "v"((const unsigned char*)(obn + (size_t)(18) * orow + 32) + ooff), "v"(v) : "memory"); }
          { const unsigned v = f2bf(o1_1[3]); asm volatile("global_store_short %0, %1, off" :: "v"((const unsigned char*)(obn + (size_t)(19) * orow + 32) + ooff), "v"(v) : "memory"); }
          { const unsigned v = f2bf(o1_2[0]); asm volatile("global_store_short %0, %1, off" :: "v"((const unsigned char*)(obn + (size_t)(32) * orow + 32) + ooff), "v"(v) : "memory"); }
          { const unsigned v = f2bf(o1_2[1]); asm volatile("global_store_short %0, %1, off" :: "v"((const unsigned char*)(obn + (size_t)(33) * orow + 32) + ooff), "v"(v) : "memory"); }
          { const unsigned v = f2bf(o1_2[2]); asm volatile("global_store_short %0, %1, off" :: "v"((const unsigned char*)(obn + (size_t)(34) * orow + 32) + ooff), "v"(v) : "memory"); }
          { const unsigned v = f2bf(o1_2[3]); asm volatile("global_store_short %0, %1, off" :: "v"((const unsigned char*)(obn + (size_t)(35) * orow + 32) + ooff), "v"(v) : "memory"); }
          { const unsigned v = f2bf(o1_3[0]); asm volatile("global_store_short %0, %1, off" :: "v"((const unsigned char*)(obn + (size_t)(48) * orow + 32) + ooff), "v"(v) : "memory"); }
          { const unsigned v = f2bf(o1_3[1]); asm volatile("global_store_short %0, %1, off" :: "v"((const unsigned char*)(obn + (size_t)(49) * orow + 32) + ooff), "v"(v) : "memory"); }
          { const unsigned v = f2bf(o1_3[2]); asm volatile("global_store_short %0, %1, off" :: "v"((const unsigned char*)(obn + (size_t)(50) * orow + 32) + ooff), "v"(v) : "memory"); }
          { const unsigned v = f2bf(o1_3[3]); asm volatile("global_store_short %0, %1, off" :: "v"((const unsigned char*)(obn + (size_t)(51) * orow + 32) + ooff), "v"(v) : "memory"); }
        }
        __builtin_amdgcn_sched_barrier(0);
    }
    asm volatile("s_waitcnt vmcnt(0)" ::: "memory");
    } else if constexpr (!GDN && ROLE == 0) {
    bf16x8 r0 = (bf16x8){0, 0, 0, 0, 0, 0, 0, 0};
    bf16x8 r1 = (bf16x8){0, 0, 0, 0, 0, 0, 0, 0};
    bf16x8 r2 = (bf16x8){0, 0, 0, 0, 0, 0, 0, 0};
    bf16x8 r3 = (bf16x8){0, 0, 0, 0, 0, 0, 0, 0};
    bf16x8 r4 = (bf16x8){0, 0, 0, 0, 0, 0, 0, 0};
    bf16x8 r5 = (bf16x8){0, 0, 0, 0, 0, 0, 0, 0};
    bf16x8 r6 = (bf16x8){0, 0, 0, 0, 0, 0, 0, 0};
    bf16x8 r7 = (bf16x8){0, 0, 0, 0, 0, 0, 0, 0};
    bf16x8 r8 = (bf16x8){0, 0, 0, 0, 0, 0, 0, 0};
    bf16x8 r9 = (bf16x8){0, 0, 0, 0, 0, 0, 0, 0};
    bf16x8 r10 = (bf16x8){0, 0, 0, 0, 0, 0, 0, 0};
    bf16x8 r11 = (bf16x8){0, 0, 0, 0, 0, 0, 0, 0};
    bf16x8 r12 = (bf16x8){0, 0, 0, 0, 0, 0, 0, 0};
    bf16x8 r13 = (bf16x8){0, 0, 0, 0, 0, 0, 0, 0};
    bf16x8 r14 = (bf16x8){0, 0, 0, 0, 0, 0, 0, 0};
    bf16x8 r15 = (bf16x8){0, 0, 0, 0, 0, 0, 0, 0};
    f32x4 S0_0 = {0.f, 0.f, 0.f, 0.f};
    f32x4 S0_1 = {0.f, 0.f, 0.f, 0.f};
    f32x4 S0_2 = {0.f, 0.f, 0.f, 0.f};
    f32x4 S0_3 = {0.f, 0.f, 0.f, 0.f};
    f32x4 S0_4 = {0.f, 0.f, 0.f, 0.f};
    f32x4 S0_5 = {0.f, 0.f, 0.f, 0.f};
    f32x4 S0_6 = {0.f, 0.f, 0.f, 0.f};
    f32x4 S0_7 = {0.f, 0.f, 0.f, 0.f};
    bf16x8 Sp0_0 = (bf16x8){0, 0, 0, 0, 0, 0, 0, 0};
    bf16x8 Sp0_1 = (bf16x8){0, 0, 0, 0, 0, 0, 0, 0};
    bf16x8 Sp0_2 = (bf16x8){0, 0, 0, 0, 0, 0, 0, 0};
    bf16x8 Sp0_3 = (bf16x8){0, 0, 0, 0, 0, 0, 0, 0};
    f32x4 S1_0 = {0.f, 0.f, 0.f, 0.f};
    f32x4 S1_1 = {0.f, 0.f, 0.f, 0.f};
    f32x4 S1_2 = {0.f, 0.f, 0.f, 0.f};
    f32x4 S1_3 = {0.f, 0.f, 0.f, 0.f};
    f32x4 S1_4 = {0.f, 0.f, 0.f, 0.f};
    f32x4 S1_5 = {0.f, 0.f, 0.f, 0.f};
    f32x4 S1_6 = {0.f, 0.f, 0.f, 0.f};
    f32x4 S1_7 = {0.f, 0.f, 0.f, 0.f};
    bf16x8 Sp1_0 = (bf16x8){0, 0, 0, 0, 0, 0, 0, 0};
    bf16x8 Sp1_1 = (bf16x8){0, 0, 0, 0, 0, 0, 0, 0};
    bf16x8 Sp1_2 = (bf16x8){0, 0, 0, 0, 0, 0, 0, 0};
    bf16x8 Sp1_3 = (bf16x8){0, 0, 0, 0, 0, 0, 0, 0};
    unsigned vn0_0 = 0u, vn0_1 = 0u, vn0_2 = 0u, vn0_3 = 0u, vn0_4 = 0u, vn0_5 = 0u, vn0_6 = 0u, vn0_7 = 0u, vn0_8 = 0u, vn0_9 = 0u, vn0_10 = 0u, vn0_11 = 0u, vn0_12 = 0u, vn0_13 = 0u, vn0_14 = 0u, vn0_15 = 0u;
    unsigned vn1_0 = 0u, vn1_1 = 0u, vn1_2 = 0u, vn1_3 = 0u, vn1_4 = 0u, vn1_5 = 0u, vn1_6 = 0u, vn1_7 = 0u, vn1_8 = 0u, vn1_9 = 0u, vn1_10 = 0u, vn1_11 = 0u, vn1_12 = 0u, vn1_13 = 0u, vn1_14 = 0u, vn1_15 = 0u;
    { const int n = 0; (void)n;
    asm volatile("global_load_ushort %0, %1, off" : "+v"(vn0_0) : "v"((const unsigned char*)(vbu + (size_t)(0) * vrow + 0) + voff2) : "memory");
    asm volatile("global_load_ushort %0, %1, off" : "+v"(vn0_1) : "v"((const unsigned char*)(vbu + (size_t)(1) * vrow + 0) + voff2) : "memory");
    asm volatile("global_load_ushort %0, %1, off" : "+v"(vn0_2) : "v"((const unsigned char*)(vbu + (size_t)(2) * vrow + 0) + voff2) : "memory");
    asm volatile("global_load_ushort %0, %1, off" : "+v"(vn0_3) : "v"((const unsigned char*)(vbu + (size_t)(3) * vrow + 0) + voff2) : "memory");
    asm volatile("global_load_ushort %0, %1, off" : "+v"(vn0_4) : "v"((const unsigned char*)(vbu + (size_t)(16) * vrow + 0) + voff2) : "memory");
    asm volatile("global_load_ushort %0, %1, off" : "+v"(vn0_5) : "v"((const unsigned char*)(vbu + (size_t)(17) * vrow + 0) + voff2) : "memory");
    asm volatile("global_load_ushort %0, %1, off" : "+v"(vn0_6) : "v"((const unsigned char*)(vbu + (size_t)(18) * vrow + 0) + voff2) : "memory");
    asm volatile("global_load_ushort %0, %1, off" : "+v"(vn0_7) : "v"((const unsigned char*)(vbu + (size_t)(19) * vrow + 0) + voff2) : "memory");
    asm volatile("global_load_ushort %0, %1, off" : "+v"(vn0_8) : "v"((const unsigned char*)(vbu + (size_t)(32) * vrow + 0) + voff2) : "memory");
    asm volatile("global_load_ushort %0, %1, off" : "+v"(vn0_9) : "v"((const unsigned char*)(vbu + (size_t)(33) * vrow + 0) + voff2) : "memory");
    asm volatile("global_load_ushort %0, %1, off" : "+v"(vn0_10) : "v"((const unsigned char*)(vbu + (size_t)(34) * vrow + 0) + voff2) : "memory");
    asm volatile("global_load_ushort %0, %1, off" : "+v"(vn0_11) : "v"((const unsigned char*)(vbu + (size_t)(35) * vrow + 0) + voff2) : "memory");
    asm volatile("global_load_ushort %0, %1, off" : "+v"(vn0_12) : "v"((const unsigned char*)(vbu + (size_t)(48) * vrow + 0) + voff2) : "memory");
    asm volatile("global_load_ushort %0, %1, off" : "+v"(vn0_13) : "v"((const unsigned char*)(vbu + (size_t)(49) * vrow + 0) + voff2) : "memory");
    asm volatile("global_load_ushort %0, %1, off" : "+v"(vn0_14) : "v"((const unsigned char*)(vbu + (size_t)(50) * vrow + 0) + voff2) : "memory");
    asm volatile("global_load_ushort %0, %1, off" : "+v"(vn0_15) : "v"((const unsigned char*)(vbu + (size_t)(51) * vrow + 0) + voff2) : "memory");
    asm volatile("global_load_ushort %0, %1, off" : "+v"(vn1_0) : "v"((const unsigned char*)(vbu + (size_t)(0) * vrow + 32) + voff2) : "memory");
    asm volatile("global_load_ushort %0, %1, off" : "+v"(vn1_1) : "v"((const unsigned char*)(vbu + (size_t)(1) * vrow + 32) + voff2) : "memory");
    asm volatile("global_load_ushort %0, %1, off" : "+v"(vn1_2) : "v"((const unsigned char*)(vbu + (size_t)(2) * vrow + 32) + voff2) : "memory");
    asm volatile("global_load_ushort %0, %1, off" : "+v"(vn1_3) : "v"((const unsigned char*)(vbu + (size_t)(3) * vrow + 32) + voff2) : "memory");
    asm volatile("global_load_ushort %0, %1, off" : "+v"(vn1_4) : "v"((const unsigned char*)(vbu + (size_t)(16) * vrow + 32) + voff2) : "memory");
    asm volatile("global_load_ushort %0, %1, off" : "+v"(vn1_5) : "v"((const unsigned char*)(vbu + (size_t)(17) * vrow + 32) + voff2) : "memory");
    asm volatile("global_load_ushort %0, %1, off" : "+v"(vn1_6) : "v"((const unsigned char*)(vbu + (size_t)(18) * vrow + 32) + voff2) : "memory");
    asm volatile("global_load_ushort %0, %1, off" : "+v"(vn1_7) : "v"((const unsigned char*)(vbu + (size_t)(19) * vrow + 32) + voff2) : "memory");
    asm volatile("global_load_ushort %0, %1, off" : "+v"(vn1_8) : "v"((const unsigned char*)(vbu + (size_t)(32) * vrow + 32) + voff2) : "memory");
    asm volatile("global_load_ushort %0, %1, off" : "+v"(vn1_9) : "v"((const unsigned char*)(vbu + (size_t)(33) * vrow + 32) + voff2) : "memory");
    asm volatile("global_load_ushort %0, %1, off" : "+v"(vn1_10) : "v"((const unsigned char*)(vbu + (size_t)(34) * vrow + 32) + voff2) : "memory");
    asm volatile("global_load_ushort %0, %1, off" : "+v"(vn1_11) : "v"((const unsigned char*)(vbu + (size_t)(35) * vrow + 32) + voff2) : "memory");
    asm volatile("global_load_ushort %0, %1, off" : "+v"(vn1_12) : "v"((const unsigned char*)(vbu + (size_t)(48) * vrow + 32) + voff2) : "memory");
    asm volatile("global_load_ushort %0, %1, off" : "+v"(vn1_13) : "v"((const unsigned char*)(vbu + (size_t)(49) * vrow + 32) + voff2) : "memory");
    asm volatile("global_load_ushort %0, %1, off" : "+v"(vn1_14) : "v"((const unsigned char*)(vbu + (size_t)(50) * vrow + 32) + voff2) : "memory");
    asm volatile("global_load_ushort %0, %1, off" : "+v"(vn1_15) : "v"((const unsigned char*)(vbu + (size_t)(51) * vrow + 32) + voff2) : "memory");
    asm volatile("global_load_dwordx4 %0, %1, off" : "+v"(r0) : "v"((const unsigned char*)(sp0 + ((size_t)(n + 0) * 40 + 24) * 1024) + voff) : "memory");
    asm volatile("global_load_dwordx4 %0, %1, off" : "+v"(r1) : "v"((const unsigned char*)(sp0 + ((size_t)(n + 0) * 40 + 25) * 1024) + voff) : "memory");
    asm volatile("global_load_dwordx4 %0, %1, off" : "+v"(r2) : "v"((const unsigned char*)(sp0 + ((size_t)(n + 0) * 40 + 26) * 1024) + voff) : "memory");
    asm volatile("global_load_dwordx4 %0, %1, off" : "+v"(r3) : "v"((const unsigned char*)(sp0 + ((size_t)(n + 0) * 40 + 27) * 1024) + voff) : "memory");
    asm volatile("global_load_dwordx4 %0, %1, off" : "+v"(r4) : "v"((const unsigned char*)(sp0 + ((size_t)(n + 0) * 40 + 28) * 1024) + voff) : "memory");
    asm volatile("global_load_dwordx4 %0, %1, off" : "+v"(r5) : "v"((const unsigned char*)(sp0 + ((size_t)(n + 0) * 40 + 29) * 1024) + voff) : "memory");
    asm volatile("global_load_dwordx4 %0, %1, off" : "+v"(r6) : "v"((const unsigned char*)(sp0 + ((size_t)(n + 0) * 40 + 30) * 1024) + voff) : "memory");
    asm volatile("global_load_dwordx4 %0, %1, off" : "+v"(r7) : "v"((const unsigned char*)(sp0 + ((size_t)(n + 0) * 40 + 31) * 1024) + voff) : "memory");
    asm volatile("global_load_dwordx4 %0, %1, off" : "+v"(r8) : "v"((const unsigned char*)(sp0 + ((size_t)(n + 0) * 40 + 32) * 1024) + voff) : "memory");
    asm volatile("global_load_dwordx4 %0, %1, off" : "+v"(r9) : "v"((const unsigned char*)(sp0 + ((size_t)(n + 0) * 40 + 33) * 1024) + voff) : "memory");
    asm volatile("global_load_dwordx4 %0, %1, off" : "+v"(r10) : "v"((const unsigned char*)(sp0 + ((size_t)(n + 0) * 40 + 34) * 1024) + voff) : "memory");
    asm volatile("global_load_dwordx4 %0, %1, off" : "+v"(r11) : "v"((const unsigned char*)(sp0 + ((size_t)(n + 0) * 40 + 35) * 1024) + voff) : "memory");
    asm volatile("global_load_dwordx4 %0, %1, off" : "+v"(r12) : "v"((const unsigned char*)(sp0 + ((size_t)(n + 0) * 40 + 36) * 1024) + voff) : "memory");
    asm volatile("global_load_dwordx4 %0, %1, off" : "+v"(r13) : "v"((const unsigned char*)(sp0 + ((size_t)(n + 0) * 40 + 37) * 1024) + voff) : "memory");
    asm volatile("global_load_dwordx4 %0, %1, off" : "+v"(r14) : "v"((const unsigned char*)(sp0 + ((size_t)(n + 0) * 40 + 38) * 1024) + voff) : "memory");
    asm volatile("global_load_dwordx4 %0, %1, off" : "+v"(r15) : "v"((const unsigned char*)(sp0 + ((size_t)(n + 0) * 40 + 39) * 1024) + voff) : "memory");
    }
#pragma unroll 1
    for (int n = 0; n < NCH; ++n) {
        const int nn = n + 1 < NCH ? n + 1 : n;
        f32x4 a0_0, a0_1, a0_2, a0_3;
        f32x4 a1_0, a1_1, a1_2, a1_3;
        asm volatile("s_waitcnt vmcnt(16)" : "+v"(vn0_0), "+v"(vn0_1), "+v"(vn0_2), "+v"(vn0_3), "+v"(vn0_4), "+v"(vn0_5), "+v"(vn0_6), "+v"(vn0_7), "+v"(vn0_8), "+v"(vn0_9), "+v"(vn0_10), "+v"(vn0_11), "+v"(vn0_12), "+v"(vn0_13), "+v"(vn0_14), "+v"(vn0_15));
        asm volatile("s_waitcnt vmcnt(16)" : "+v"(vn1_0), "+v"(vn1_1), "+v"(vn1_2), "+v"(vn1_3), "+v"(vn1_4), "+v"(vn1_5), "+v"(vn1_6), "+v"(vn1_7), "+v"(vn1_8), "+v"(vn1_9), "+v"(vn1_10), "+v"(vn1_11), "+v"(vn1_12), "+v"(vn1_13), "+v"(vn1_14), "+v"(vn1_15));
        a0_0 = (f32x4){__builtin_bit_cast(float, vn0_0 << 16), __builtin_bit_cast(float, vn0_1 << 16), __builtin_bit_cast(float, vn0_2 << 16), __builtin_bit_cast(float, vn0_3 << 16)};
        a0_1 = (f32x4){__builtin_bit_cast(float, vn0_4 << 16), __builtin_bit_cast(float, vn0_5 << 16), __builtin_bit_cast(float, vn0_6 << 16), __builtin_bit_cast(float, vn0_7 << 16)};
        a0_2 = (f32x4){__builtin_bit_cast(float, vn0_8 << 16), __builtin_bit_cast(float, vn0_9 << 16), __builtin_bit_cast(float, vn0_10 << 16), __builtin_bit_cast(float, vn0_11 << 16)};
        a0_3 = (f32x4){__builtin_bit_cast(float, vn0_12 << 16), __builtin_bit_cast(float, vn0_13 << 16), __builtin_bit_cast(float, vn0_14 << 16), __builtin_bit_cast(float, vn0_15 << 16)};
        a1_0 = (f32x4){__builtin_bit_cast(float, vn1_0 << 16), __builtin_bit_cast(float, vn1_1 << 16), __builtin_bit_cast(float, vn1_2 << 16), __builtin_bit_cast(float, vn1_3 << 16)};
        a1_1 = (f32x4){__builtin_bit_cast(float, vn1_4 << 16), __builtin_bit_cast(float, vn1_5 << 16), __builtin_bit_cast(float, vn1_6 << 16), __builtin_bit_cast(float, vn1_7 << 16)};
        a1_2 = (f32x4){__builtin_bit_cast(float, vn1_8 << 16), __builtin_bit_cast(float, vn1_9 << 16), __builtin_bit_cast(float, vn1_10 << 16), __builtin_bit_cast(float, vn1_11 << 16)};
        a1_3 = (f32x4){__builtin_bit_cast(float, vn1_12 << 16), __builtin_bit_cast(float, vn1_13 << 16), __builtin_bit_cast(float, vn1_14 << 16), __builtin_bit_cast(float, vn1_15 << 16)};
        const float dec = decr;
        { const unsigned char* vbn = vbu + (size_t)nn * 64 * vrow;
          asm volatile("global_load_ushort %0, %1, off" : "+v"(vn0_0) : "v"((const unsigned char*)(vbn + (size_t)(0) * vrow + 0) + voff2) : "memory");
          asm volatile("global_load_ushort %0, %1, off" : "+v"(vn0_1) : "v"((const unsigned char*)(vbn + (size_t)(1) * vrow + 0) + voff2) : "memory");
          asm volatile("global_load_ushort %0, %1, off" : "+v"(vn0_2) : "v"((const unsigned char*)(vbn + (size_t)(2) * vrow + 0) + voff2) : "memory");
          asm volatile("global_load_ushort %0, %1, off" : "+v"(vn0_3) : "v"((const unsigned char*)(vbn + (size_t)(3) * vrow + 0) + voff2) : "memory");
          asm volatile("global_load_ushort %0, %1, off" : "+v"(vn0_4) : "v"((const unsigned char*)(vbn + (size_t)(16) * vrow + 0) + voff2) : "memory");
          asm volatile("global_load_ushort %0, %1, off" : "+v"(vn0_5) : "v"((const unsigned char*)(vbn + (size_t)(17) * vrow + 0) + voff2) : "memory");
          asm volatile("global_load_ushort %0, %1, off" : "+v"(vn0_6) : "v"((const unsigned char*)(vbn + (size_t)(18) * vrow + 0) + voff2) : "memory");
          asm volatile("global_load_ushort %0, %1, off" : "+v"(vn0_7) : "v"((const unsigned char*)(vbn + (size_t)(19) * vrow + 0) + voff2) : "memory");
          asm volatile("global_load_ushort %0, %1, off" : "+v"(vn0_8) : "v"((const unsigned char*)(vbn + (size_t)(32) * vrow + 0) + voff2) : "memory");
          asm volatile("global_load_ushort %0, %1, off" : "+v"(vn0_9) : "v"((const unsigned char*)(vbn + (size_t)(33) * vrow + 0) + voff2) : "memory");
          asm volatile("global_load_ushort %0, %1, off" : "+v"(vn0_10) : "v"((const unsigned char*)(vbn + (size_t)(34) * vrow + 0) + voff2) : "memory");
          asm volatile("global_load_ushort %0, %1, off" : "+v"(vn0_11) : "v"((const unsigned char*)(vbn + (size_t)(35) * vrow + 0) + voff2) : "memory");
          asm volatile("global_load_ushort %0, %1, off" : "+v"(vn0_12) : "v"((const unsigned char*)(vbn + (size_t)(48) * vrow + 0) + voff2) : "memory");
          asm volatile("global_load_ushort %0, %1, off" : "+v"(vn0_13) : "v"((const unsigned char*)(vbn + (size_t)(49) * vrow + 0) + voff2) : "memory");
          asm volatile("global_load_ushort %0, %1, off" : "+v"(vn0_14) : "v"((const unsigned char*)(vbn + (size_t)(50) * vrow + 0) + voff2) : "memory");
          asm volatile("global_load_ushort %0, %1, off" : "+v"(vn0_15) : "v"((const unsigned char*)(vbn + (size_t)(51) * vrow + 0) + voff2) : "memory");
          asm volatile("global_load_ushort %0, %1, off" : "+v"(vn1_0) : "v"((const unsigned char*)(vbn + (size_t)(0) * vrow + 32) + voff2) : "memory");
          asm volatile("global_load_ushort %0, %1, off" : "+v"(vn1_1) : "v"((const unsigned char*)(vbn + (size_t)(1) * vrow + 32) + voff2) : "memory");
          asm volatile("global_load_ushort %0, %1, off" : "+v"(vn1_2) : "v"((const unsigned char*)(vbn + (size_t)(2) * vrow + 32) + voff2) : "memory");
          asm volatile("global_load_ushort %0, %1, off" : "+v"(vn1_3) : "v"((const unsigned char*)(vbn + (size_t)(3) * vrow + 32) + voff2) : "memory");
          asm volatile("global_load_ushort %0, %1, off" : "+v"(vn1_4) : "v"((const unsigned char*)(vbn + (size_t)(16) * vrow + 32) + voff2) : "memory");
          asm volatile("global_load_ushort %0, %1, off" : "+v"(vn1_5) : "v"((const unsigned char*)(vbn + (size_t)(17) * vrow + 32) + voff2) : "memory");
          asm volatile("global_load_ushort %0, %1, off" : "+v"(vn1_6) : "v"((const unsigned char*)(vbn + (size_t)(18) * vrow + 32) + voff2) : "memory");
          asm volatile("global_load_ushort %0, %1, off" : "+v"(vn1_7) : "v"((const unsigned char*)(vbn + (size_t)(19) * vrow + 32) + voff2) : "memory");
          asm volatile("global_load_ushort %0, %1, off" : "+v"(vn1_8) : "v"((const unsigned char*)(vbn + (size_t)(32) * vrow + 32) + voff2) : "memory");
          asm volatile("global_load_ushort %0, %1, off" : "+v"(vn1_9) : "v"((const unsigned char*)(vbn + (size_t)(33) * vrow + 32) + voff2) : "memory");
          asm volatile("global_load_ushort %0, %1, off" : "+v"(vn1_10) : "v"((const unsigned char*)(vbn + (size_t)(34) * vrow + 32) + voff2) : "memory");
          asm volatile("global_load_ushort %0, %1, off" : "+v"(vn1_11) : "v"((const unsigned char*)(vbn + (size_t)(35) * vrow + 32) + voff2) : "memory");
          asm volatile("global_load_ushort %0, %1, off" : "+v"(vn1_12) : "v"((const unsigned char*)(vbn + (size_t)(48) * vrow + 32) + voff2) : "memory");
          asm volatile("global_load_ushort %0, %1, off" : "+v"(vn1_13) : "v"((const unsigned char*)(vbn + (size_t)(49) * vrow + 32) + voff2) : "memory");
          asm volatile("global_load_ushort %0, %1, off" : "+v"(vn1_14) : "v"((const unsigned char*)(vbn + (size_t)(50) * vrow + 32) + voff2) : "memory");
          asm volatile("global_load_ushort %0, %1, off" : "+v"(vn1_15) : "v"((const unsigned char*)(vbn + (size_t)(51) * vrow + 32) + voff2) : "memory");
        }
        __builtin_amdgcn_sched_barrier(0);
        bf16x8 vp0_0, vp0_1;
        { u32x4 w; w.x = cvt_pk_bf16(a0_0[0], a0_0[1]); w.y = cvt_pk_bf16(a0_0[2], a0_0[3]); w.z = cvt_pk_bf16(a0_1[0], a0_1[1]); w.w = cvt_pk_bf16(a0_1[2], a0_1[3]); vp0_0 = __builtin_bit_cast(bf16x8, w); }
        { u32x4 w; w.x = cvt_pk_bf16(a0_2[0], a0_2[1]); w.y = cvt_pk_bf16(a0_2[2], a0_2[3]); w.z = cvt_pk_bf16(a0_3[0], a0_3[1]); w.w = cvt_pk_bf16(a0_3[2], a0_3[3]); vp0_1 = __builtin_bit_cast(bf16x8, w); }
        bf16x8 vp1_0, vp1_1;
        { u32x4 w; w.x = cvt_pk_bf16(a1_0[0], a1_0[1]); w.y = cvt_pk_bf16(a1_0[2], a1_0[3]); w.z = cvt_pk_bf16(a1_1[0], a1_1[1]); w.w = cvt_pk_bf16(a1_1[2], a1_1[3]); vp1_0 = __builtin_bit_cast(bf16x8, w); }
        { u32x4 w; w.x = cvt_pk_bf16(a1_2[0], a1_2[1]); w.y = cvt_pk_bf16(a1_2[2], a1_2[3]); w.z = cvt_pk_bf16(a1_3[0], a1_3[1]); w.w = cvt_pk_bf16(a1_3[2], a1_3[3]); vp1_1 = __builtin_bit_cast(bf16x8, w); }
        { unsigned sp_ = 0; while (*(volatile LAS unsigned*)(xl + XL_CNT + 64) + 4u <= (unsigned)n) { __builtin_amdgcn_s_sleep(1); if (++sp_ > (1u << 22)) break; } }
        { LAS bf16x8* sl_ = (LAS bf16x8*)(xl + (n & 3) * XL_SLOT) + lane; sl_[0] = Sp0_0; sl_[64] = Sp0_1; sl_[128] = Sp0_2; sl_[192] = Sp0_3; sl_[256] = vp0_0; sl_[320] = vp0_1; sl_[384] = Sp1_0; sl_[448] = Sp1_1; sl_[512] = Sp1_2; sl_[576] = Sp1_3; sl_[640] = vp1_0; sl_[704] = vp1_1; }
        asm volatile("s_waitcnt lgkmcnt(0)" ::: "memory");
        if (lane == 0) *(volatile LAS unsigned*)(xl + XL_CNT) = (unsigned)(n + 1);
        S0_0 = S0_0 * dec;
        S1_0 = S1_0 * dec;
        asm volatile("s_waitcnt vmcnt(47)" : "+v"(r0));
        S0_0 = mfma16(r0, vp0_0, S0_0);
        S1_0 = mfma16(r0, vp1_0, S1_0);
        asm volatile("global_load_dwordx4 %0, %1, off" : "+v"(r0) : "v"((const unsigned char*)(sp0 + ((size_t)(n + 1) * 40 + 24) * 1024) + voff) : "memory");
        __builtin_amdgcn_sched_barrier(0);
        asm volatile("s_waitcnt vmcnt(47)" : "+v"(r1));
        S0_0 = mfma16(r1, vp0_1, S0_0);
        S1_0 = mfma16(r1, vp1_1, S1_0);
        asm volatile("global_load_dwordx4 %0, %1, off" : "+v"(r1) : "v"((const unsigned char*)(sp0 + ((size_t)(n + 1) * 40 + 25) * 1024) + voff) : "memory");
        __builtin_amdgcn_sched_barrier(0);
        S0_1 = S0_1 * dec;
        S1_1 = S1_1 * dec;
        asm volatile("s_waitcnt vmcnt(47)" : "+v"(r2));
        S0_1 = mfma16(r2, vp0_0, S0_1);
        S1_1 = mfma16(r2, vp1_0, S1_1);
        asm volatile("global_load_dwordx4 %0, %1, off" : "+v"(r2) : "v"((const unsigned char*)(sp0 + ((size_t)(n + 1) * 40 + 26) * 1024) + voff) : "memory");
        __builtin_amdgcn_sched_barrier(0);
        asm volatile("s_waitcnt vmcnt(47)" : "+v"(r3));
        S0_1 = mfma16(r3, vp0_1, S0_1);
        S1_1 = mfma16(r3, vp1_1, S1_1);
        asm volatile("global_load_dwordx4 %0, %1, off" : "+v"(r3) : "v"((const unsigned char*)(sp0 + ((size_t)(n + 1) * 40 + 27) * 1024) + voff) : "memory");
        __builtin_amdgcn_sched_barrier(0);
        S0_2 = S0_2 * dec;
        S1_2 = S1_2 * dec;
        asm volatile("s_waitcnt vmcnt(47)" : "+v"(r4));
        S0_2 = mfma16(r4, vp0_0, S0_2);
        S1_2 = mfma16(r4, vp1_0, S1_2);
        asm volatile("global_load_dwordx4 %0, %1, off" : "+v"(r4) : "v"((const unsigned char*)(sp0 + ((size_t)(n + 1) * 40 + 28) * 1024) + voff) : "memory");
        __builtin_amdgcn_sched_barrier(0);
        asm volatile("s_waitcnt vmcnt(47)" : "+v"(r5));
        S0_2 = mfma16(r5, vp0_1, S0_2);
        S1_2 = mfma16(r5, vp1_1, S1_2);
        asm volatile("global_load_dwordx4 %0, %1, off" : "+v"(r5) : "v"((const unsigned char*)(sp0 + ((size_t)(n + 1) * 40 + 29) * 1024) + voff) : "memory");
        __builtin_amdgcn_sched_barrier(0);
        S0_3 = S0_3 * dec;
        S1_3 = S1_3 * dec;
        asm volatile("s_waitcnt vmcnt(47)" : "+v"(r6));
        S0_3 = mfma16(r6, vp0_0, S0_3);
        S1_3 = mfma16(r6, vp1_0, S1_3);
        asm volatile("global_load_dwordx4 %0, %1, off" : "+v"(r6) : "v"((const unsigned char*)(sp0 + ((size_t)(n + 1) * 40 + 30) * 1024) + voff) : "memory");
        __builtin_amdgcn_sched_barrier(0);
        asm volatile("s_waitcnt vmcnt(47)" : "+v"(r7));
        S0_3 = mfma16(r7, vp0_1, S0_3);
        S1_3 = mfma16(r7, vp1_1, S1_3);
        asm volatile("global_load_dwordx4 %0, %1, off" : "+v"(r7) : "v"((const unsigned char*)(sp0 + ((size_t)(n + 1) * 40 + 31) * 1024) + voff) : "memory");
        __builtin_amdgcn_sched_barrier(0);
        S0_4 = S0_4 * dec;
        S1_4 = S1_4 * dec;
        asm volatile("s_waitcnt vmcnt(47)" : "+v"(r8));
        S0_4 = mfma16(r8, vp0_0, S0_4);
        S1_4 = mfma16(r8, vp1_0, S1_4);
        asm volatile("global_load_dwordx4 %0, %1, off" : "+v"(r8) : "v"((const unsigned char*)(sp0 + ((size_t)(n + 1) * 40 + 32) * 1024) + voff) : "memory");
        __builtin_amdgcn_sched_barrier(0);
        asm volatile("s_waitcnt vmcnt(47)" : "+v"(r9));
        S0_4 = mfma16(r9, vp0_1, S0_4);
        S1_4 = mfma16(r9, vp1_1, S1_4);
        asm volatile("global_load_dwordx4 %0, %1, off" : "+v"(r9) : "v"((const unsigned char*)(sp0 + ((size_t)(n + 1) * 40 + 33) * 1024) + voff) : "memory");
        __builtin_amdgcn_sched_barrier(0);
        S0_5 = S0_5 * dec;
        S1_5 = S1_5 * dec;
        asm volatile("s_waitcnt vmcnt(47)" : "+v"(r10));
        S0_5 = mfma16(r10, vp0_0, S0_5);
        S1_5 = mfma16(r10, vp1_0, S1_5);
        asm volatile("global_load_dwordx4 %0, %1, off" : "+v"(r10) : "v"((const unsigned char*)(sp0 + ((size_t)(n + 1) * 40 + 34) * 1024) + voff) : "memory");
        __builtin_amdgcn_sched_barrier(0);
        asm volatile("s_waitcnt vmcnt(47)" : "+v"(r11));
        S0_5 = mfma16(r11, vp0_1, S0_5);
        S1_5 = mfma16(r11, vp1_1, S1_5);
        asm volatile("global_load_dwordx4 %0, %1, off" : "+v"(r11) : "v"((const unsigned char*)(sp0 + ((size_t)(n + 1) * 40 + 35) * 1024) + voff) : "memory");
        __builtin_amdgcn_sched_barrier(0);
        S0_6 = S0_6 * dec;
        S1_6 = S1_6 * dec;
        asm volatile("s_waitcnt vmcnt(47)" : "+v"(r12));
        S0_6 = mfma16(r12, vp0_0, S0_6);
        S1_6 = mfma16(r12, vp1_0, S1_6);
        asm volatile("global_load_dwordx4 %0, %1, off" : "+v"(r12) : "v"((const unsigned char*)(sp0 + ((size_t)(n + 1) * 40 + 36) * 1024) + voff) : "memory");
        __builtin_amdgcn_sched_barrier(0);
        asm volatile("s_waitcnt vmcnt(47)" : "+v"(r13));
        S0_6 = mfma16(r13, vp0_1, S0_6);
        S1_6 = mfma16(r13, vp1_1, S1_6);
        asm volatile("global_load_dwordx4 %0, %1, off" : "+v"(r13) : "v"((const unsigned char*)(sp0 + ((size_t)(n + 1) * 40 + 37) * 1024) + voff) : "memory");
        __builtin_amdgcn_sched_barrier(0);
        S0_7 = S0_7 * dec;
        S1_7 = S1_7 * dec;
        asm volatile("s_waitcnt vmcnt(47)" : "+v"(r14));
        S0_7 = mfma16(r14, vp0_0, S0_7);
        S1_7 = mfma16(r14, vp1_0, S1_7);
        asm volatile("global_load_dwordx4 %0, %1, off" : "+v"(r14) : "v"((const unsigned char*)(sp0 + ((size_t)(n + 1) * 40 + 38) * 1024) + voff) : "memory");
        __builtin_amdgcn_sched_barrier(0);
        asm volatile("s_waitcnt vmcnt(47)" : "+v"(r15));
        S0_7 = mfma16(r15, vp0_1, S0_7);
        S1_7 = mfma16(r15, vp1_1, S1_7);
        asm volatile("global_load_dwordx4 %0, %1, off" : "+v"(r15) : "v"((const unsigned char*)(sp0 + ((size_t)(n + 1) * 40 + 39) * 1024) + voff) : "memory");
        __builtin_amdgcn_sched_barrier(0);
        { u32x4 w; w.x = cvt_pk_bf16(S0_0[0], S0_0[1]); w.y = cvt_pk_bf16(S0_0[2], S0_0[3]); w.z = cvt_pk_bf16(S0_1[0], S0_1[1]); w.w = cvt_pk_bf16(S0_1[2], S0_1[3]); Sp0_0 = __builtin_bit_cast(bf16x8, w); }
        { u32x4 w; w.x = cvt_pk_bf16(S0_2[0], S0_2[1]); w.y = cvt_pk_bf16(S0_2[2], S0_2[3]); w.z = cvt_pk_bf16(S0_3[0], S0_3[1]); w.w = cvt_pk_bf16(S0_3[2], S0_3[3]); Sp0_1 = __builtin_bit_cast(bf16x8, w); }
        { u32x4 w; w.x = cvt_pk_bf16(S0_4[0], S0_4[1]); w.y = cvt_pk_bf16(S0_4[2], S0_4[3]); w.z = cvt_pk_bf16(S0_5[0], S0_5[1]); w.w = cvt_pk_bf16(S0_5[2], S0_5[3]); Sp0_2 = __builtin_bit_cast(bf16x8, w); }
        { u32x4 w; w.x = cvt_pk_bf16(S0_6[0], S0_6[1]); w.y = cvt_pk_bf16(S0_6[2], S0_6[3]); w.z = cvt_pk_bf16(S0_7[0], S0_7[1]); w.w = cvt_pk_bf16(S0_7[2], S0_7[3]); Sp0_3 = __builtin_bit_cast(bf16x8, w); }
        { u32x4 w; w.x = cvt_pk_bf16(S1_0[0], S1_0[1]); w.y = cvt_pk_bf16(S1_0[2], S1_0[3]); w.z = cvt_pk_bf16(S1_1[0], S1_1[1]); w.w = cvt_pk_bf16(S1_1[2], S1_1[3]); Sp1_0 = __builtin_bit_cast(bf16x8, w); }
        { u32x4 w; w.x = cvt_pk_bf16(S1_2[0], S1_2[1]); w.y = cvt_pk_bf16(S1_2[2], S1_2[3]); w.z = cvt_pk_bf16(S1_3[0], S1_3[1]); w.w = cvt_pk_bf16(S1_3[2], S1_3[3]); Sp1_1 = __builtin_bit_cast(bf16x8, w); }
        { u32x4 w; w.x = cvt_pk_bf16(S1_4[0], S1_4[1]); w.y = cvt_pk_bf16(S1_4[2], S1_4[3]); w.z = cvt_pk_bf16(S1_5[0], S1_5[1]); w.w = cvt_pk_bf16(S1_5[2], S1_5[3]); Sp1_2 = __builtin_bit_cast(bf16x8, w); }
        { u32x4 w; w.x = cvt_pk_bf16(S1_6[0], S1_6[1]); w.y = cvt_pk_bf16(S1_6[2], S1_6[3]); w.z = cvt_pk_bf16(S1_7[0], S1_7[1]); w.w = cvt_pk_bf16(S1_7[2], S1_7[3]); Sp1_3 = __builtin_bit_cast(bf16x8, w); }
    }
    asm volatile("s_waitcnt vmcnt(0)" ::: "memory");
    } else {
    bf16x8 r0 = (bf16x8){0, 0, 0, 0, 0, 0, 0, 0};
    bf16x8 r1 = (bf16x8){0, 0, 0, 0, 0, 0, 0, 0};
    bf16x8 r2 = (bf16x8){0, 0, 0, 0, 0, 0, 0, 0};
    bf16x8 r3 = (bf16x8){0, 0, 0, 0, 0, 0, 0, 0};
    bf16x8 r4 = (bf16x8){0, 0, 0, 0, 0, 0, 0, 0};
    bf16x8 r5 = (bf16x8){0, 0, 0, 0, 0, 0, 0, 0};
    bf16x8 r6 = (bf16x8){0, 0, 0, 0, 0, 0, 0, 0};
    bf16x8 r7 = (bf16x8){0, 0, 0, 0, 0, 0, 0, 0};
    bf16x8 r8 = (bf16x8){0, 0, 0, 0, 0, 0, 0, 0};
    bf16x8 r9 = (bf16x8){0, 0, 0, 0, 0, 0, 0, 0};
    bf16x8 r10 = (bf16x8){0, 0, 0, 0, 0, 0, 0, 0};
    bf16x8 r11 = (bf16x8){0, 0, 0, 0, 0, 0, 0, 0};
    bf16x8 r12 = (bf16x8){0, 0, 0, 0, 0, 0, 0, 0};
    bf16x8 r13 = (bf16x8){0, 0, 0, 0, 0, 0, 0, 0};
    bf16x8 r14 = (bf16x8){0, 0, 0, 0, 0, 0, 0, 0};
    bf16x8 r15 = (bf16x8){0, 0, 0, 0, 0, 0, 0, 0};
    bf16x8 r16 = (bf16x8){0, 0, 0, 0, 0, 0, 0, 0};
    bf16x8 r17 = (bf16x8){0, 0, 0, 0, 0, 0, 0, 0};
    bf16x8 r18 = (bf16x8){0, 0, 0, 0, 0, 0, 0, 0};
    bf16x8 r19 = (bf16x8){0, 0, 0, 0, 0, 0, 0, 0};
    bf16x8 r20 = (bf16x8){0, 0, 0, 0, 0, 0, 0, 0};
    bf16x8 r21 = (bf16x8){0, 0, 0, 0, 0, 0, 0, 0};
    bf16x8 r22 = (bf16x8){0, 0, 0, 0, 0, 0, 0, 0};
    bf16x8 r23 = (bf16x8){0, 0, 0, 0, 0, 0, 0, 0};
    asm volatile("global_load_dwordx4 %0, %1, off" : "+v"(r0) : "v"((const unsigned char*)(sp0 + ((size_t)(0 + 0) * 40 + 0) * 1024) + voff) : "memory");
    asm volatile("global_load_dwordx4 %0, %1, off" : "+v"(r1) : "v"((const unsigned char*)(sp0 + ((size_t)(0 + 0) * 40 + 1) * 1024) + voff) : "memory");
    asm volatile("global_load_dwordx4 %0, %1, off" : "+v"(r2) : "v"((const unsigned char*)(sp0 + ((size_t)(0 + 0) * 40 + 2) * 1024) + voff) : "memory");
    asm volatile("global_load_dwordx4 %0, %1, off" : "+v"(r3) : "v"((const unsigned char*)(sp0 + ((size_t)(0 + 0) * 40 + 3) * 1024) + voff) : "memory");
    asm volatile("global_load_dwordx4 %0, %1, off" : "+v"(r4) : "v"((const unsigned char*)(sp0 + ((size_t)(0 + 0) * 40 + 4) * 1024) + voff) : "memory");
    asm volatile("global_load_dwordx4 %0, %1, off" : "+v"(r5) : "v"((const unsigned char*)(sp0 + ((size_t)(0 + 0) * 40 + 5) * 1024) + voff) : "memory");
    asm volatile("global_load_dwordx4 %0, %1, off" : "+v"(r6) : "v"((const unsigned char*)(sp0 + ((size_t)(0 + 0) * 40 + 6) * 1024) + voff) : "memory");
    asm volatile("global_load_dwordx4 %0, %1, off" : "+v"(r7) : "v"((const unsigned char*)(sp0 + ((size_t)(0 + 0) * 40 + 7) * 1024) + voff) : "memory");
    asm volatile("global_load_dwordx4 %0, %1, off" : "+v"(r8) : "v"((const unsigned char*)(sp0 + ((size_t)(0 + 0) * 40 + 8) * 1024) + voff) : "memory");
    asm volatile("global_load_dwordx4 %0, %1, off" : "+v"(r9) : "v"((const unsigned char*)(sp0 + ((size_t)(0 + 0) * 40 + 9) * 1024) + voff) : "memory");
    asm volatile("global_load_dwordx4 %0, %1, off" : "+v"(r10) : "v"((const unsigned char*)(sp0 + ((size_t)(0 + 0) * 40 + 10) * 1024) + voff) : "memory");
    asm volatile("global_load_dwordx4 %0, %1, off" : "+v"(r11) : "v"((const unsigned char*)(sp0 + ((size_t)(0 + 0) * 40 + 11) * 1024) + voff) : "memory");
    asm volatile("global_load_dwordx4 %0, %1, off" : "+v"(r12) : "v"((const unsigned char*)(sp0 + ((size_t)(0 + 0) * 40 + 12) * 1024) + voff) : "memory");
    asm volatile("global_load_dwordx4 %0, %1, off" : "+v"(r13) : "v"((const unsigned char*)(sp0 + ((size_t)(0 + 0) * 40 + 13) * 1024) + voff) : "memory");
    asm volatile("global_load_dwordx4 %0, %1, off" : "+v"(r14) : "v"((const unsigned char*)(sp0 + ((size_t)(0 + 0) * 40 + 14) * 1024) + voff) : "memory");
    asm volatile("global_load_dwordx4 %0, %1, off" : "+v"(r15) : "v"((const unsigned char*)(sp0 + ((size_t)(0 + 0) * 40 + 15) * 1024) + voff) : "memory");
    asm volatile("global_load_dwordx4 %0, %1, off" : "+v"(r16) : "v"((const unsigned char*)(sp0 + ((size_t)(0 + 0) * 40 + 16) * 1024) + voff) : "memory");
    asm volatile("global_load_dwordx4 %0, %1, off" : "+v"(r17) : "v"((const unsigned char*)(sp0 + ((size_t)(0 + 0) * 40 + 17) * 1024) + voff) : "memory");
    asm volatile("global_load_dwordx4 %0, %1, off" : "+v"(r18) : "v"((const unsigned char*)(sp0 + ((size_t)(0 + 0) * 40 + 18) * 1024) + voff) : "memory");
    asm volatile("global_load_dwordx4 %0, %1, off" : "+v"(r19) : "v"((const unsigned char*)(sp0 + ((size_t)(0 + 0) * 40 + 19) * 1024) + voff) : "memory");
    asm volatile("global_load_dwordx4 %0, %1, off" : "+v"(r20) : "v"((const unsigned char*)(sp0 + ((size_t)(0 + 0) * 40 + 20) * 1024) + voff) : "memory");
    asm volatile("global_load_dwordx4 %0, %1, off" : "+v"(r21) : "v"((const unsigned char*)(sp0 + ((size_t)(0 + 0) * 40 + 21) * 1024) + voff) : "memory");
    asm volatile("global_load_dwordx4 %0, %1, off" : "+v"(r22) : "v"((const unsigned char*)(sp0 + ((size_t)(0 + 0) * 40 + 22) * 1024) + voff) : "memory");
    asm volatile("global_load_dwordx4 %0, %1, off" : "+v"(r23) : "v"((const unsigned char*)(sp0 + ((size_t)(0 + 0) * 40 + 23) * 1024) + voff) : "memory");
    { unsigned z = 0u;
      asm volatile("global_store_short %0, %1, off" :: "v"((const unsigned char*)(obu + (size_t)(0) * orow + 0) + ooff), "v"(z) : "memory");
      asm volatile("global_store_short %0, %1, off" :: "v"((const unsigned char*)(obu + (size_t)(1) * orow + 0) + ooff), "v"(z) : "memory");
      asm volatile("global_store_short %0, %1, off" :: "v"((const unsigned char*)(obu + (size_t)(2) * orow + 0) + ooff), "v"(z) : "memory");
      asm volatile("global_store_short %0, %1, off" :: "v"((const unsigned char*)(obu + (size_t)(3) * orow + 0) + ooff), "v"(z) : "memory");
      asm volatile("global_store_short %0, %1, off" :: "v"((const unsigned char*)(obu + (size_t)(16) * orow + 0) + ooff), "v"(z) : "memory");
      asm volatile("global_store_short %0, %1, off" :: "v"((const unsigned char*)(obu + (size_t)(17) * orow + 0) + ooff), "v"(z) : "memory");
      asm volatile("global_store_short %0, %1, off" :: "v"((const unsigned char*)(obu + (size_t)(18) * orow + 0) + ooff), "v"(z) : "memory");
      asm volatile("global_store_short %0, %1, off" :: "v"((const unsigned char*)(obu + (size_t)(19) * orow + 0) + ooff), "v"(z) : "memory");
      asm volatile("global_store_short %0, %1, off" :: "v"((const unsigned char*)(obu + (size_t)(32) * orow + 0) + ooff), "v"(z) : "memory");
      asm volatile("global_store_short %0, %1, off" :: "v"((const unsigned char*)(obu + (size_t)(33) * orow + 0) + ooff), "v"(z) : "memory");
      asm volatile("global_store_short %0, %1, off" :: "v"((const unsigned char*)(obu + (size_t)(34) * orow + 0) + ooff), "v"(z) : "memory");
      asm volatile("global_store_short %0, %1, off" :: "v"((const unsigned char*)(obu + (size_t)(35) * orow + 0) + ooff), "v"(z) : "memory");
      asm volatile("global_store_short %0, %1, off" :: "v"((const unsigned char*)(obu + (size_t)(48) * orow + 0) + ooff), "v"(z) : "memory");
      asm volatile("global_store_short %0, %1, off" :: "v"((const unsigned char*)(obu + (size_t)(49) * orow + 0) + ooff), "v"(z) : "memory");
      asm volatile("global_store_short %0, %1, off" :: "v"((const unsigned char*)(obu + (size_t)(50) * orow + 0) + ooff), "v"(z) : "memory");
      asm volatile("global_store_short %0, %1, off" :: "v"((const unsigned char*)(obu + (size_t)(51) * orow + 0) + ooff), "v"(z) : "memory");
      asm volatile("global_store_short %0, %1, off" :: "v"((const unsigned char*)(obu + (size_t)(0) * orow + 32) + ooff), "v"(z) : "memory");
      asm volatile("global_store_short %0, %1, off" :: "v"((const unsigned char*)(obu + (size_t)(1) * orow + 32) + ooff), "v"(z) : "memory");
      asm volatile("global_store_short %0, %1, off" :: "v"((const unsigned char*)(obu + (size_t)(2) * orow + 32) + ooff), "v"(z) : "memory");
      asm volatile("global_store_short %0, %1, off" :: "v"((const unsigned char*)(obu + (size_t)(3) * orow + 32) + ooff), "v"(z) : "memory");
      asm volatile("global_store_short %0, %1, off" :: "v"((const unsigned char*)(obu + (size_t)(16) * orow + 32) + ooff), "v"(z) : "memory");
      asm volatile("global_store_short %0, %1, off" :: "v"((const unsigned char*)(obu + (size_t)(17) * orow + 32) + ooff), "v"(z) : "memory");
      asm volatile("global_store_short %0, %1, off" :: "v"((const unsigned char*)(obu + (size_t)(18) * orow + 32) + ooff), "v"(z) : "memory");
      asm volatile("global_store_short %0, %1, off" :: "v"((const unsigned char*)(obu + (size_t)(19) * orow + 32) + ooff), "v"(z) : "memory");
      asm volatile("global_store_short %0, %1, off" :: "v"((const unsigned char*)(obu + (size_t)(32) * orow + 32) + ooff), "v"(z) : "memory");
      asm volatile("global_store_short %0, %1, off" :: "v"((const unsigned char*)(obu + (size_t)(33) * orow + 32) + ooff), "v"(z) : "memory");
      asm volatile("global_store_short %0, %1, off" :: "v"((const unsigned char*)(obu + (size_t)(34) * orow + 32) + ooff), "v"(z) : "memory");
      asm volatile("global_store_short %0, %1, off" :: "v"((const unsigned char*)(obu + (size_t)(35) * orow + 32) + ooff), "v"(z) : "memory");
      asm volatile("global_store_short %0, %1, off" :: "v"((const unsigned char*)(obu + (size_t)(48) * orow + 32) + ooff), "v"(z) : "memory");
      asm volatile("global_store_short %0, %1, off" :: "v"((const unsigned char*)(obu + (size_t)(49) * orow + 32) + ooff), "v"(z) : "memory");
      asm volatile("global_store_short %0, %1, off" :: "v"((const unsigned char*)(obu + (size_t)(50) * orow + 32) + ooff), "v"(z) : "memory");
      asm volatile("global_store_short %0, %1, off" :: "v"((const unsigned char*)(obu + (size_t)(51) * orow + 32) + ooff), "v"(z) : "memory");
    }
#pragma unroll 1
    for (int n = 0; n < NCH; ++n) {
        { unsigned sp_ = 0; while (*(volatile LAS unsigned*)(xl + XL_CNT) <= (unsigned)n) { __builtin_amdgcn_s_sleep(1); if (++sp_ > (1u << 22)) break; } }
        bf16x8 Sp0_0, Sp0_1, Sp0_2, Sp0_3, vp0_0, vp0_1;
        bf16x8 Sp1_0, Sp1_1, Sp1_2, Sp1_3, vp1_0, vp1_1;
        { const LAS bf16x8* sl_ = (const LAS bf16x8*)(xl + (n & 3) * XL_SLOT) + lane; Sp0_0 = sl_[0]; Sp0_1 = sl_[64]; Sp0_2 = sl_[128]; Sp0_3 = sl_[192]; vp0_0 = sl_[256]; vp0_1 = sl_[320]; Sp1_0 = sl_[384]; Sp1_1 = sl_[448]; Sp1_2 = sl_[512]; Sp1_3 = sl_[576]; vp1_0 = sl_[640]; vp1_1 = sl_[704]; }
        asm volatile("s_waitcnt lgkmcnt(0)" ::: "memory");
        if (lane == 0) *(volatile LAS unsigned*)(xl + XL_CNT + 64) = (unsigned)(n + 1);
        f32x4 o0_0 = {0.f, 0.f, 0.f, 0.f}, o0_1 = o0_0, o0_2 = o0_0, o0_3 = o0_0;
        f32x4 o1_0 = {0.f, 0.f, 0.f, 0.f}, o1_1 = o1_0, o1_2 = o1_0, o1_3 = o1_0;
        asm volatile("s_waitcnt vmcnt(55)" : "+v"(r0));
        o0_0 = mfma16(r0, Sp0_0, o0_0);
        o1_0 = mfma16(r0, Sp1_0, o1_0);
        asm volatile("global_load_dwordx4 %0, %1, off" : "+v"(r0) : "v"((const unsigned char*)(sp0 + ((size_t)(n + 1) * 40 + 0) * 1024) + voff) : "memory");
        __builtin_amdgcn_sched_barrier(0);
        asm volatile("s_waitcnt vmcnt(55)" : "+v"(r1));
        o0_0 = mfma16(r1, Sp0_1, o0_0);
        o1_0 = mfma16(r1, Sp1_1, o1_0);
        asm volatile("global_load_dwordx4 %0, %1, off" : "+v"(r1) : "v"((const unsigned char*)(sp0 + ((size_t)(n + 1) * 40 + 1) * 1024) + voff) : "memory");
        __builtin_amdgcn_sched_barrier(0);
        asm volatile("s_waitcnt vmcnt(55)" : "+v"(r2));
        o0_0 = mfma16(r2, Sp0_2, o0_0);
        o1_0 = mfma16(r2, Sp1_2, o1_0);
        asm volatile("global_load_dwordx4 %0, %1, off" : "+v"(r2) : "v"((const unsigned char*)(sp0 + ((size_t)(n + 1) * 40 + 2) * 1024) + voff) : "memory");
        __builtin_amdgcn_sched_barrier(0);
        asm volatile("s_waitcnt vmcnt(55)" : "+v"(r3));
        o0_0 = mfma16(r3, Sp0_3, o0_0);
        o1_0 = mfma16(r3, Sp1_3, o1_0);
        asm volatile("global_load_dwordx4 %0, %1, off" : "+v"(r3) : "v"((const unsigned char*)(sp0 + ((size_t)(n + 1) * 40 + 3) * 1024) + voff) : "memory");
        __builtin_amdgcn_sched_barrier(0);
        asm volatile("s_waitcnt vmcnt(55)" : "+v"(r4));
        o0_1 = mfma16(r4, Sp0_0, o0_1);
        o1_1 = mfma16(r4, Sp1_0, o1_1);
        asm volatile("global_load_dwordx4 %0, %1, off" : "+v"(r4) : "v"((const unsigned char*)(sp0 + ((size_t)(n + 1) * 40 + 4) * 1024) + voff) : "memory");
        __builtin_amdgcn_sched_barrier(0);
        asm volatile("s_waitcnt vmcnt(55)" : "+v"(r5));
        o0_1 = mfma16(r5, Sp0_1, o0_1);
        o1_1 = mfma16(r5, Sp1_1, o1_1);
        asm volatile("global_load_dwordx4 %0, %1, off" : "+v"(r5) : "v"((const unsigned char*)(sp0 + ((size_t)(n + 1) * 40 + 5) * 1024) + voff) : "memory");
        __builtin_amdgcn_sched_barrier(0);
        asm volatile("s_waitcnt vmcnt(55)" : "+v"(r6));
        o0_1 = mfma16(r6, Sp0_2, o0_1);
        o1_1 = mfma16(r6, Sp1_2, o1_1);
        asm volatile("global_load_dwordx4 %0, %1, off" : "+v"(r6) : "v"((const unsigned char*)(sp0 + ((size_t)(n + 1) * 40 + 6) * 1024) + voff) : "memory");
        __builtin_amdgcn_sched_barrier(0);
        asm volatile("s_waitcnt vmcnt(55)" : "+v"(r7));
        o0_1 = mfma16(r7, Sp0_3, o0_1);
        o1_1 = mfma16(r7, Sp1_3, o1_1);
        asm volatile("global_load_dwordx4 %0, %1, off" : "+v"(r7) : "v"((const unsigned char*)(sp0 + ((size_t)(n + 1) * 40 + 7) * 1024) + voff) : "memory");
        __builtin_amdgcn_sched_barrier(0);
        asm volatile("s_waitcnt vmcnt(55)" : "+v"(r8));
        o0_2 = mfma16(r8, Sp0_0, o0_2);
        o1_2 = mfma16(r8, Sp1_0, o1_2);
        asm volatile("global_load_dwordx4 %0, %1, off" : "+v"(r8) : "v"((const unsigned char*)(sp0 + ((size_t)(n + 1) * 40 + 8) * 1024) + voff) : "memory");
        __builtin_amdgcn_sched_barrier(0);
        asm volatile("s_waitcnt vmcnt(55)" : "+v"(r9));
        o0_2 = mfma16(r9, Sp0_1, o0_2);
        o1_2 = mfma16(r9, Sp1_1, o1_2);
        asm volatile("global_load_dwordx4 %0, %1, off" : "+v"(r9) : "v"((const unsigned char*)(sp0 + ((size_t)(n + 1) * 40 + 9) * 1024) + voff) : "memory");
        __builtin_amdgcn_sched_barrier(0);
        asm volatile("s_waitcnt vmcnt(55)" : "+v"(r10));
        o0_2 = mfma16(r10, Sp0_2, o0_2);
        o1_2 = mfma16(r10, Sp1_2, o1_2);
        asm volatile("global_load_dwordx4 %0, %1, off" : "+v"(r10) : "v"((const unsigned char*)(sp0 + ((size_t)(n + 1) * 40 + 10) * 1024) + voff) : "memory");
        __builtin_amdgcn_sched_barrier(0);
        asm volatile("s_waitcnt vmcnt(55)" : "+v"(r11));
        o0_2 = mfma16(r11, Sp0_3, o0_2);
        o1_2 = mfma16(r11, Sp1_3, o1_2);
        asm volatile("global_load_dwordx4 %0, %1, off" : "+v"(r11) : "v"((const unsigned char*)(sp0 + ((size_t)(n + 1) * 40 + 11) * 1024) + voff) : "memory");
        __builtin_amdgcn_sched_barrier(0);
        asm volatile("s_waitcnt vmcnt(55)" : "+v"(r12));
        o0_3 = mfma16(r12, Sp0_0, o0_3);
        o1_3 = mfma16(r12, Sp1_0, o1_3);
        asm volatile("global_load_dwordx4 %0, %1, off" : "+v"(r12) : "v"((const unsigned char*)(sp0 + ((size_t)(n + 1) * 40 + 12) * 1024) + voff) : "memory");
        __builtin_amdgcn_sched_barrier(0);
        asm volatile("s_waitcnt vmcnt(55)" : "+v"(r13));
        o0_3 = mfma16(r13, Sp0_1, o0_3);
        o1_3 = mfma16(r13, Sp1_1, o1_3);
        asm volatile("global_load_dwordx4 %0, %1, off" : "+v"(r13) : "v"((const unsigned char*)(sp0 + ((size_t)(n + 1) * 40 + 13) * 1024) + voff) : "memory");
        __builtin_amdgcn_sched_barrier(0);
        asm volatile("s_waitcnt vmcnt(55)" : "+v"(r14));
        o0_3 = mfma16(r14, Sp0_2, o0_3);
        o1_3 = mfma16(r14, Sp1_2, o1_3);
        asm volatile("global_load_dwordx4 %0, %1, off" : "+v"(r14) : "v"((const unsigned char*)(sp0 + ((size_t)(n + 1) * 40 + 14) * 1024) + voff) : "memory");
        __builtin_amdgcn_sched_barrier(0);
        asm volatile("s_waitcnt vmcnt(55)" : "+v"(r15));
        o0_3 = mfma16(r15, Sp0_3, o0_3);
        o1_3 = mfma16(r15, Sp1_3, o1_3);
        asm volatile("global_load_dwordx4 %0, %1, off" : "+v"(r15) : "v"((const unsigned char*)(sp0 + ((size_t)(n + 1) * 40 + 15) * 1024) + voff) : "memory");
        __builtin_amdgcn_sched_barrier(0);
        asm volatile("s_waitcnt vmcnt(55)" : "+v"(r16));
        o0_0 = mfma16(r16, vp0_0, o0_0);
        o1_0 = mfma16(r16, vp1_0, o1_0);
        asm volatile("global_load_dwordx4 %0, %1, off" : "+v"(r16) : "v"((const unsigned char*)(sp0 + ((size_t)(n + 1) * 40 + 16) * 1024) + voff) : "memory");
        __builtin_amdgcn_sched_barrier(0);
        asm volatile("s_waitcnt vmcnt(55)" : "+v"(r17));
        o0_0 = mfma16(r17, vp0_1, o0_0);
        o1_0 = mfma16(r17, vp1_1, o1_0);
        asm volatile("global_load_dwordx4 %0, %1, off" : "+v"(r17) : "v"((const unsigned char*)(sp0 + ((size_t)(n + 1) * 40 + 17) * 1024) + voff) : "memory");
        __builtin_amdgcn_sched_barrier(0);
        asm volatile("s_waitcnt vmcnt(55)" : "+v"(r18));
        o0_1 = mfma16(r18, vp0_0, o0_1);
        o1_1 = mfma16(r18, vp1_0, o1_1);
        asm volatile("global_load_dwordx4 %0, %1, off" : "+v"(r18) : "v"((const unsigned char*)(sp0 + ((size_t)(n + 1) * 40 + 18) * 1024) + voff) : "memory");
        __builtin_amdgcn_sched_barrier(0);
        asm volatile("s_waitcnt vmcnt(55)" : "+v"(r19));
        o0_1 = mfma16(r19, vp0_1, o0_1);
        o1_1 = mfma16(r19, vp1_1, o1_1);
        asm volatile("global_load_dwordx4 %0, %1, off" : "+v"(r19) : "v"((const unsigned char*)(sp0 + ((size_t)(n + 1) * 40 + 19) * 1024) + voff) : "memory");
        __builtin_amdgcn_sched_barrier(0);
        asm volatile("s_waitcnt vmcnt(55)" : "+v"(r20));
        o0_2 = mfma16(r20, vp0_0, o0_2);
        o1_2 = mfma16(r20, vp1_0, o1_2);
        asm volatile("global_load_dwordx4 %0, %1, off" : "+v"(r20) : "v"((const unsigned char*)(sp0 + ((size_t)(n + 1) * 40 + 20) * 1024) + voff) : "memory");
        __builtin_amdgcn_sched_barrier(0);
        asm volatile("s_waitcnt vmcnt(55)" : "+v"(r21));
        o0_2 = mfma16(r21, vp0_1, o0_2);
        o1_2 = mfma16(r21, vp1_1, o1_2);
        asm volatile("global_load_dwordx4 %0, %1, off" : "+v"(r21) : "v"((const unsigned char*)(sp0 + ((size_t)(n + 1) * 40 + 21) * 1024) + voff) : "memory");
        __builtin_amdgcn_sched_barrier(0);
        asm volatile("s_waitcnt vmcnt(55)" : "+v"(r22));
        o0_3 = mfma16(r22, vp0_0, o0_3);
        o1_3 = mfma16(r22, vp1_0, o1_3);
        asm volatile("global_load_dwordx4 %0, %1, off" : "+v"(r22) : "v"((const unsigned char*)(sp0 + ((size_t)(n + 1) * 40 + 22) * 1024) + voff) : "memory");
        __builtin_amdgcn_sched_barrier(0);
        asm volatile("s_waitcnt vmcnt(55)" : "+v"(r23));
        o0_3 = mfma16(r23, vp0_1, o0_3);
        o1_3 = mfma16(r23, vp1_1, o1_3);
        asm volatile("global_load_dwordx4 %0, %1, off" : "+v"(r23) : "v"((const unsigned char*)(sp0 + ((size_t)(n + 1) * 40 + 23) * 1024) + voff) : "memory");
        __builtin_amdgcn_sched_barrier(0);
        { const unsigned char* obn = obu + (size_t)n * 64 * orow;
          { const unsigned v = f2bf(o0_0[0]); asm volatile("global_store_short %0, %1, off" :: "v"((const unsigned char*)(obn + (size_t)(0) * orow + 0) + ooff), "v"(v) : "memory"); }
          { const unsigned v = f2bf(o0_0[1]); asm volatile("global_store_short %0, %1, off" :: "v"((const unsigned char*)(obn + (size_t)(1) * orow + 0) + ooff), "v"(v) : "memory"); }
          { const unsigned v = f2bf(o0_0[2]); asm volatile("global_store_short %0, %1, off" :: "v"((const unsigned char*)(obn + (size_t)(2) * orow + 0) + ooff), "v"(v) : "memory"); }
          { const unsigned v = f2bf(o0_0[3]); asm volatile("global_store_short %0, %1, off" :: "v"((const unsigned char*)(obn + (size_t)(3) * orow + 0) + ooff), "v"(v) : "memory"); }
          { const unsigned v = f2bf(o0_1[0]); asm volatile("global_store_short %0, %1, off" :: "v"((const unsigned char*)(obn + (size_t)(16) * orow + 0) + ooff), "v"(v) : "memory"); }
          { const unsigned v = f2bf(o0_1[1]); asm volatile("global_store_short %0, %1, off" :: "v"((const unsigned char*)(obn + (size_t)(17) * orow + 0) + ooff), "v"(v) : "memory"); }
          { const unsigned v = f2bf(o0_1[2]); asm volatile("global_store_short %0, %1, off" :: "v"((const unsigned char*)(obn + (size_t)(18) * orow + 0) + ooff), "v"(v) : "memory"); }
          { const unsigned v = f2bf(o0_1[3]); asm volatile("global_store_short %0, %1, off" :: "v"((const unsigned char*)(obn + (size_t)(19) * orow + 0) + ooff), "v"(v) : "memory"); }
          { const unsigned v = f2bf(o0_2[0]); asm volatile("global_store_short %0, %1, off" :: "v"((const unsigned char*)(obn + (size_t)(32) * orow + 0) + ooff), "v"(v) : "memory"); }
          { const unsigned v = f2bf(o0_2[1]); asm volatile("global_store_short %0, %1, off" :: "v"((const unsigned char*)(obn + (size_t)(33) * orow + 0) + ooff), "v"(v) : "memory"); }
          { const unsigned v = f2bf(o0_2[2]); asm volatile("global_store_short %0, %1, off" :: "v"((const unsigned char*)(obn + (size_t)(34) * orow + 0) + ooff), "v"(v) : "memory"); }
          { const unsigned v = f2bf(o0_2[3]); asm volatile("global_store_short %0, %1, off" :: "v"((const unsigned char*)(obn + (size_t)(35) * orow + 0) + ooff), "v"(v) : "memory"); }
          { const unsigned v = f2bf(o0_3[0]); asm volatile("global_store_short %0, %1, off" :: "v"((const unsigned char*)(obn + (size_t)(48) * orow + 0) + ooff), "v"(v) : "memory"); }
          { const unsigned v = f2bf(o0_3[1]); asm volatile("global_store_short %0, %1, off" :: "v"((const unsigned char*)(obn + (size_t)(49) * orow + 0) + ooff), "v"(v) : "memory"); }
          { const unsigned v = f2bf(o0_3[2]); asm volatile("global_store_short %0, %1, off" :: "v"((const unsigned char*)(obn + (size_t)(50) * orow + 0) + ooff), "v"(v) : "memory"); }
          { const unsigned v = f2bf(o0_3[3]); asm volatile("global_store_short %0, %1, off" :: "v"((const unsigned char*)(obn + (size_t)(51) * orow + 0) + ooff), "v"(v) : "memory"); }
          { const unsigned v = f2bf(o1_0[0]); asm volatile("global_store_short %0, %1, off" :: "v"((const unsigned char*)(obn + (size_t)(0) * orow + 32) + ooff), "v"(v) : "memory"); }
          { const unsigned v = f2bf(o1_0[1]); asm volatile("global_store_short %0, %1, off" :: "v"((const unsigned char*)(obn + (size_t)(1) * orow + 32) + ooff), "v"(v) : "memory"); }
          { const unsigned v = f2bf(o1_0[2]); asm volatile("global_store_short %0, %1, off" :: "v"((const unsigned char*)(obn + (size_t)(2) * orow + 32) + ooff), "v"(v) : "memory"); }
          { const unsigned v = f2bf(o1_0[3]); asm volatile("global_store_short %0, %1, off" :: "v"((const unsigned char*)(obn + (size_t)(3) * orow + 32) + ooff), "v"(v) : "memory"); }
          { const unsigned v = f2bf(o1_1[0]); asm volatile("global_store_short %0, %1, off" :: "v"((const unsigned char*)(obn + (size_t)(16) * orow + 32) + ooff), "v"(v) : "memory"); }
          { const unsigned v = f2bf(o1_1[1]); asm volatile("global_store_short %0, %1, off" :: "v"((const unsigned char*)(obn + (size_t)(17) * orow + 32) + ooff), "v"(v) : "memory"); }
          { const unsigned v = f2bf(o1_1[2]); asm volatile("global_store_short %0, %1, off" :: "v"((const unsigned char*)(obn + (size_t)(18) * orow + 32) + ooff), "v"(v) : "memory"); }
          { const unsigned v = f2bf(o1_1[3]); asm volatile("global_store_short %0, %1, off" :: "v"((const unsigned char*)(obn + (size_t)(19) * orow + 32) + ooff), "v"(v) : "memory"); }
          { const unsigned v = f2bf(o1_2[0]); asm volatile("global_store_short %0, %1, off" :: "v"((const unsigned char*)(obn + (size_t)(32) * orow + 32) + ooff), "v"(v) : "memory"); }
          { const unsigned v = f2bf(o1_2[1]); asm volatile("global_store_short %0, %1, off" :: "v"((const unsigned char*)(obn + (size_t)(33) * orow + 32) + ooff), "v"(v) : "memory"); }
          { const unsigned v = f2bf(o1_2[2]); asm volatile("global_store_short %0, %1, off" :: "v"((const unsigned char*)(obn + (size_t)(34) * orow + 32) + ooff), "v"(v) : "memory"); }
          { const unsigned v = f2bf(o1_2[3]); asm volatile("global_store_short %0, %1, off" :: "v"((const unsigned char*)(obn + (size_t)(35) * orow + 32) + ooff), "v"(v) : "memory"); }
          { const unsigned v = f2bf(o1_3[0]); asm volatile("global_store_short %0, %1, off" :: "v"((const unsigned char*)(obn + (size_t)(48) * orow + 32) + ooff), "v"(v) : "memory"); }
          { const unsigned v = f2bf(o1_3[1]); asm volatile("global_store_short %0, %1, off" :: "v"((const unsigned char*)(obn + (size_t)(49) * orow + 32) + ooff), "v"(v) : "memory"); }
          { const unsigned v = f2bf(o1_3[2]); asm volatile("global_store_short %0, %1, off" :: "v"((const unsigned char*)(obn + (size_t)(50) * orow + 32) + ooff), "v"(v) : "memory"); }
          { const unsigned v = f2bf(o1_3[3]); asm volatile("global_store_short %0, %1, off" :: "v"((const unsigned char*)(obn + (size_t)(51) * orow + 32) + ooff), "v"(v) : "memory"); }
        }
        __builtin_amdgcn_sched_barrier(0);
    }
    asm volatile("s_waitcnt vmcnt(0)" ::: "memory");
    }
}

DI void p4_mixnorm(Frame& F, const float* ret_norm, const float* gdn_norm) {
    bf16_t* pj = (bf16_t*)(F.ws + WS_BIG + BIG_PJ); const bf16_t* vc = (const bf16_t*)(F.ws + AUX_VC); const bf16_t* rr = (const bf16_t*)(F.ws + AUX_QN);
    const int lane = F.lane, l32 = lane & 31, hh = lane >> 5;
    const f32x4 gr0 = *(const f32x4*)(ret_norm + 8 * l32), gr1 = *(const f32x4*)(ret_norm + 8 * l32 + 4), gg0 = *(const f32x4*)(gdn_norm + 8 * l32), gg1 = *(const f32x4*)(gdn_norm + 8 * l32 + 4);
    for (int m = F.gw; m < NTOK; m += F.NGW) {
        bf16_t* row = pj + (size_t)m * PJW;
        u32x4 ro[8], gt[8];
#pragma unroll
        for (int q = 0; q < 8; ++q) { const int hv = 2 * q + hh, hd = hv & 7; const bool gdn = hv >= 8;
            ro[q] = *(const u32x4*)((gdn ? vc : rr) + (size_t)m * 2048 + hd * 256 + 8 * l32);
            gt[q] = *(const u32x4*)(row + (gdn ? C_GZ : C_RG) + hd * 256 + 8 * l32); }
        asm volatile("" ::: "memory");
#pragma unroll
        for (int q = 0; q < 8; ++q) { const int hv = 2 * q + hh, hd = hv & 7; const bool gdn = q >= 4;
            float o[8] = {bflo(ro[q].x), bfhi(ro[q].x), bflo(ro[q].y), bfhi(ro[q].y), bflo(ro[q].z), bfhi(ro[q].z), bflo(ro[q].w), bfhi(ro[q].w)};
            float gv[8] = {bflo(gt[q].x), bfhi(gt[q].x), bflo(gt[q].y), bfhi(gt[q].y), bflo(gt[q].z), bfhi(gt[q].z), bflo(gt[q].w), bfhi(gt[q].w)};
            float ss = 0.f;
#pragma unroll
            for (int e = 0; e < 8; ++e) ss += o[e] * o[e];
            ss += __shfl_xor(ss, 1); ss += __shfl_xor(ss, 2); ss += __shfl_xor(ss, 4); ss += __shfl_xor(ss, 8); ss += __shfl_xor(ss, 16);
            const float rstd = 1.0f / sqrtf(ss * (1.0f / 256.0f) + EPS);
            const f32x4 g0 = gdn ? gg0 : gr0, g1 = gdn ? gg1 : gr1;
            u32x4 w; w.x = pk2(o[0] * rstd * g0.x * siluf(gv[0]), o[1] * rstd * g0.y * siluf(gv[1])); w.y = pk2(o[2] * rstd * g0.z * siluf(gv[2]), o[3] * rstd * g0.w * siluf(gv[3]));
            w.z = pk2(o[4] * rstd * g1.x * siluf(gv[4]), o[5] * rstd * g1.y * siluf(gv[5])); w.w = pk2(o[6] * rstd * g1.z * siluf(gv[6]), o[7] * rstd * g1.w * siluf(gv[7]));
            *(u32x4*)(row + (gdn ? C_GZ : C_RG) + hd * 256 + 8 * l32) = w; }
    }
}

DI void p11_swaprep(Frame& F, const float* qnorm, const float* knorm) {
    bf16_t* qkv = (bf16_t*)(F.ws + WS_BIG + BIG_QKV1); const f32x2* cs32 = (const f32x2*)(F.ws + AUX_CS32);
    const int lane = F.lane, l8 = lane & 7;
    const f32x4 gq0 = *(const f32x4*)(qnorm + 8 * l8), gq1 = *(const f32x4*)(qnorm + 8 * l8 + 4), gk0 = *(const f32x4*)(knorm + 8 * l8), gk1 = *(const f32x4*)(knorm + 8 * l8 + 4);
    const float sg = (l8 < 4) ? -1.f : 1.f;
    for (int m = F.gw; m < NTOK; m += F.NGW) {
        const int pos = m & (SEQ - 1);
        const f32x4* cp = (const f32x4*)(cs32 + (size_t)pos * 32 + 8 * (l8 & 3));
        const f32x4 c0 = cp[0], c1 = cp[1], c2 = cp[2], c3 = cp[3];
        bf16_t* row = qkv + (size_t)m * ODD_IN;
        u32x4 x[5];
#pragma unroll
        for (int i = 0; i < 5; ++i) { x[i] = (u32x4){0u, 0u, 0u, 0u}; if (i < 4 || lane < 32) x[i] = *(const u32x4*)(row + i * 512 + 8 * lane); }
        asm volatile("" ::: "memory");
#pragma unroll
        for (int i = 0; i < 5; ++i) {
            float v[8] = {bflo(x[i].x), bfhi(x[i].x), bflo(x[i].y), bfhi(x[i].y), bflo(x[i].z), bfhi(x[i].z), bflo(x[i].w), bfhi(x[i].w)};
            float ss = 0.f;
#pragma unroll
            for (int e = 0; e < 8; ++e) ss += v[e] * v[e];
            ss += __shfl_xor(ss, 1); ss += __shfl_xor(ss, 2); ss += __shfl_xor(ss, 4);
            const float rstd = 1.0f / sqrtf(ss * (1.0f / 64.0f) + EPS);
            const f32x4 g0 = i < 4 ? gq0 : gk0, g1 = i < 4 ? gq1 : gk1;
            v[0] *= rstd * g0.x; v[1] *= rstd * g0.y; v[2] *= rstd * g0.z; v[3] *= rstd * g0.w; v[4] *= rstd * g1.x; v[5] *= rstd * g1.y; v[6] *= rstd * g1.z; v[7] *= rstd * g1.w;
            float p[8];
#pragma unroll
            for (int e = 0; e < 8; ++e) p[e] = __shfl_xor(v[e], 4);
            u32x4 o;
            o.x = pk2(v[0] * c0.x + sg * p[0] * c0.y, v[1] * c0.z + sg * p[1] * c0.w); o.y = pk2(v[2] * c1.x + sg * p[2] * c1.y, v[3] * c1.z + sg * p[3] * c1.w);
            o.z = pk2(v[4] * c2.x + sg * p[4] * c2.y, v[5] * c2.z + sg * p[5] * c2.w); o.w = pk2(v[6] * c3.x + sg * p[6] * c3.y, v[7] * c3.z + sg * p[7] * c3.w);
            if (i < 4 || lane < 32) *(u32x4*)(row + i * 512 + 8 * lane) = o; }
    }
}
typedef float f32x16 __attribute__((ext_vector_type(16)));
DI f32x16 mfma32(bf16x8 a, bf16x8 b, f32x16 c) { return __builtin_amdgcn_mfma_f32_32x32x16_bf16(a, b, c, 0, 0, 0); }
DI void swa_phase(Frame& F, const float* sinks) {
    constexpr int KP = 144;
    bf16_t* qkv = (bf16_t*)(F.ws + WS_BIG + BIG_QKV1);
    LAS unsigned char* Ks = F.lds; LAS unsigned char* Vs = F.lds + 256 * KP;
    const unsigned vs_addr = (unsigned)(size_t)Vs;
    const int lane = F.lane, w = F.wave, h = lane >> 5, ql = lane & 31, q4 = (lane & 15) >> 2, p4 = lane & 3, blk = (lane >> 4) & 1;
    for (int unit = blockIdx.x; unit < 1024; unit += F.G) {
        const int b = unit >> 9, kvh = (unit >> 7) & 3, qb = unit & 127;
        const size_t tok0 = (size_t)b * SEQ + (size_t)qb * 128;
        __syncthreads();
#pragma unroll
        for (int i = 0; i < 4; ++i) { const int pc = F.tid + 512 * i, row = pc >> 3, c = pc & 7; const size_t tok = (qb == 0 && row < 128) ? tok0 : tok0 - 128 + row;
            const bf16_t* src = qkv + tok * ODD_IN + 2048 + kvh * 64 + c * 8;
            *(LAS u32x4*)(Ks + row * KP + c * 16) = *(const u32x4*)src; *(LAS u32x4*)(Vs + row * KP + c * 16) = *(const u32x4*)(src + 256); }
        __syncthreads();
        const int hq = kvh * 8 + w; const float sink = sinks[hq];
#pragma unroll 1
        for (int t = 0; t < 4; ++t) {
            bf16_t* qrow = qkv + (tok0 + 32 * t + ql) * ODD_IN + hq * 64;
            bf16x8 Qf[4];
#pragma unroll
            for (int s2 = 0; s2 < 4; ++s2) Qf[s2] = *(const bf16x8*)(qrow + 16 * s2 + 8 * h);
            f32x16 sc[5];
#pragma unroll
            for (int kt = 0; kt < 5; ++kt) {
#pragma unroll
                for (int r = 0; r < 16; ++r) sc[kt][r] = 0.f;
#pragma unroll
                for (int s2 = 0; s2 < 4; ++s2) { const bf16x8 a = *(const LAS bf16x8*)(Ks + (32 * (t + kt) + ql) * KP + (16 * s2 + 8 * h) * 2); sc[kt] = mfma32(a, Qf[s2], sc[kt]); } }
            float m = sink;
#pragma unroll
            for (int kt = 0; kt < 5; ++kt) { const bool tile_ok = !(qb == 0 && t + kt < 4);
#pragma unroll
                for (int r = 0; r < 16; ++r) { const int keyrow = (r & 3) + 8 * (r >> 2) + 4 * h; bool ok = tile_ok; if (kt == 0) ok = ok && (keyrow > ql); if (kt == 4) ok = ok && (keyrow <= ql);
                    const float v = ok ? sc[kt][r] * 0.125f : -1.0e30f; sc[kt][r] = v; m = fmaxf(m, v); } }
            m = fmaxf(m, __shfl_xor(m, 32));
            float l = 0.f;
#pragma unroll
            for (int kt = 0; kt < 5; ++kt)
#pragma unroll
                for (int r = 0; r < 16; ++r) { const float p = exp2f((sc[kt][r] - m) * 1.4426950408889634f); sc[kt][r] = p; l += p; }
            l += __shfl_xor(l, 32);
            l += exp2f((sink - m) * 1.4426950408889634f);
            f32x16 o0, o1;
#pragma unroll
            for (int r = 0; r < 16; ++r) { o0[r] = 0.f; o1[r] = 0.f; }
#pragma unroll
            for (int kt = 0; kt < 5; ++kt)
#pragma unroll
                for (int s2 = 0; s2 < 2; ++s2) { u32x4 pw; pw.x = pkbf(sc[kt][8 * s2], sc[kt][8 * s2 + 1]); pw.y = pkbf(sc[kt][8 * s2 + 2], sc[kt][8 * s2 + 3]); pw.z = pkbf(sc[kt][8 * s2 + 4], sc[kt][8 * s2 + 5]); pw.w = pkbf(sc[kt][8 * s2 + 6], sc[kt][8 * s2 + 7]);
                    const bf16x8 pb = __builtin_bit_cast(bf16x8, pw);
                    const unsigned ra = vs_addr + (unsigned)((32 * (t + kt) + 16 * s2 + 4 * h + q4) * KP + blk * 32 + p4 * 8);
                    s16x4 a00, a01, a10, a11; tr_read4(ra, ra + 8 * KP, ra + 64, ra + 8 * KP + 64, a00, a01, a10, a11);
                    o0 = mfma32(cat8(a00, a01), pb, o0); o1 = mfma32(cat8(a10, a11), pb, o1); }
            const float il = 1.0f / l;
            unsigned char* orow8 = F.ws + WS_H + (tok0 + 32 * t + ql) * D + hq * 64; const float il16 = il * 16.0f;
#pragma unroll
            for (int gq = 0; gq < 4; ++gq) { *(unsigned*)(orow8 + 8 * gq + 4 * h) = pk4fp8(o0[4 * gq] * il16, o0[4 * gq + 1] * il16, o0[4 * gq + 2] * il16, o0[4 * gq + 3] * il16);
                *(unsigned*)(orow8 + 32 + 8 * gq + 4 * h) = pk4fp8(o1[4 * gq] * il16, o1[4 * gq + 1] * il16, o1[4 * gq + 2] * il16, o1[4 * gq + 3] * il16); }
        }
    }
}

struct NoHandler { DI void operator()(int, float) const {} };
DI void moe_tables(Frame& F, const unsigned* cntg) {
    LAS int* cnt = (LAS int*)(F.lds + TBL_OFF); LAS int* tb = cnt + 32;
    __syncthreads();
    if (F.tid == 0) { int acc = 0; for (int e = 0; e < 32; ++e) { const int c = (int)__hip_atomic_load(cntg + e, __ATOMIC_RELAXED, __HIP_MEMORY_SCOPE_AGENT); cnt[e] = c; tb[e] = acc; acc += (c + 255) >> 8; } tb[32] = acc; }
    __syncthreads();
}

constexpr int NPH = 19;

struct Args { const float* in[20]; float* out; unsigned char* ws; int ph_lo, ph_hi; };
__global__ void __launch_bounds__(NTHR, 2) mk_fwd(Args args) {
    extern __shared__ __attribute__((aligned(16))) unsigned char lds[];
    Frame F;
    F.lds = (LAS unsigned char*)lds; F.tid = threadIdx.x; F.lane = F.tid & 63; F.wave = __builtin_amdgcn_readfirstlane(F.tid >> 6); F.G = gridDim.x;
    F.gw = blockIdx.x * NWAVES + F.wave; F.NGW = F.G * NWAVES; F.ws = args.ws; F.ctl = (unsigned*)(args.ws + WS_CTL);
    volatile LAS unsigned* MISC = (volatile LAS unsigned*)(F.lds + MISC_OFF);
    if (F.tid < 64) MISC[F.tid] = 0u;
    __syncthreads();
    XcdBarrier bar; bar.bar = F.ctl + CW_BAR; bar.x = 0; bar.st = nullptr;
    if (!MK_MULTI) bar = xcd_barrier_post(F.ctl + CW_BAR, MISC + 8);
    const int lo = args.ph_lo, hi = args.ph_hi;
#ifdef ONLY_PH
#define IN(k) ((k) == ONLY_PH && lo <= (k) && (k) < hi)
#else
#define IN(k) (lo <= (k) && (k) < hi)
#endif
#define SEAM(k) do { if (IN(k) && IN((k) + 1)) xcd_barrier(bar); } while (0)
    const float* const* in = args.in;
    float* XC = args.out;
    bf16_t* H = (bf16_t*)(F.ws + WS_H);
    bf16_t* PJ = (bf16_t*)(F.ws + WS_BIG + BIG_PJ);
    unsigned char* aux = F.ws;
    const LAS int* tbl_cnt = (const LAS int*)(F.lds + TBL_OFF); const LAS int* tbl_tb = tbl_cnt + 32;
    LAS unsigned* tokoff = (LAS unsigned*)(F.lds + TOK_OFF);

    enum { P_W = 0, P_N0, P_G0, P_PREP, P_GA, P_SCAN, P_MIX, P_O0, P_M0A, P_M0B, P_M0C, P_N1, P_G1, P_SPREP, P_SWA, P_O1, P_M1A, P_M1B, P_M1C, P_FIN };
    static_assert(P_FIN == NPH, "phase count");
    if (IN(P_W)) { p0_weights(F, in); __syncthreads(); }
    SEAM(P_W);
    if (IN(P_N0)) {
        normproj_pass<0>(F, in[0], in[1], (const bf16_t*)(aux + AUX_SW), (const bf16_t*)(aux + AUX_SW) + 112 * D, H, (float*)(aux + AUX_BG), in[6], in[7], nullptr, nullptr, nullptr, nullptr);
    }
    SEAM(P_N0);
    if (IN(P_G0)) {
        pg8::DenseOrder S; S.init(NTOK, PJW, D, D, (const bf16_t*)(F.ws + WS_WIN0), F.G, blockIdx.x);
        pg8::EpiBf16 E{PJ, PJW};
        pg8::gemm_phase(F.lds, H, D, S, E);
    }
    SEAM(P_G0);
    if (IN(P_PREP)) p2_prep(F, in[5]);
    SEAM(P_PREP);
    if (IN(P_GA)) {
        for (int u = F.gw; u < 16 * NCH; u += F.NGW) {
            ga_unit<true>(F, u, (unsigned char*)args.out, nullptr);
            ga_unit<false>(F, u, F.ws + AUX_W, nullptr);
        }
        __syncthreads();
    }
    SEAM(P_GA);
    if (IN(P_SCAN)) {
        for (int id = blockIdx.x; id < 256; id += F.G) { const int idl = id & 127, bh = (idl % 8) * 2 + (idl / 8) / 8, sl = 2 * ((idl / 8) % 8);
            __syncthreads();
            if (F.tid == 0) { *(volatile LAS unsigned*)(F.lds + XL_CNT) = 0u; *(volatile LAS unsigned*)(F.lds + XL_CNT + 64) = 0u; }
            __syncthreads();
            if (id < 128) { if (F.wave == 0) scan_wave<true, 0>(F, bh, sl, (const unsigned char*)args.out, F.lds); else if (F.wave == 1) scan_wave<true, 1>(F, bh, sl, (const unsigned char*)args.out, F.lds); }
            else { if (F.wave == 0) scan_wave<false, 0>(F, bh, sl, F.ws + AUX_W, F.lds); else if (F.wave == 1) scan_wave<false, 1>(F, bh, sl, F.ws + AUX_W, F.lds); } }
        __syncthreads();
    }
    SEAM(P_SCAN);
    if (IN(P_MIX)) p4_mixnorm(F, in[4], in[8]);
    SEAM(P_MIX);
    if (IN(P_O0)) {
        pg8::DenseOrder S; S.init(NTOK, D, 4096, PJW, (const bf16_t*)(F.ws + WS_WOUT0), F.G, blockIdx.x);
        pg8::EpiResF32 E{in[0], XC, D};
        pg8::gemm_phase(F.lds, PJ + C_RG, 4096, S, E);
    }
    SEAM(P_O0);
#define MOE_LAYER(P, L, CNTW)                                                                                                                  \
    if (IN(P)) {                                                            \
        convert_experts(F, in, L);                                                                                                             \
        __syncthreads();                                                                \
        normproj_pass<1>(F, XC, in[2] + L * D, (const bf16_t*)(aux + AUX_SW) + (16 + L * 48) * D, (const bf16_t*)(aux + AUX_SW) + (112 + 16 + L * 48) * D, H, nullptr, nullptr, nullptr, F.ctl + CNTW, (int*)(aux + AUX_LIST), (float*)(aux + AUX_GW), (unsigned*)(aux + AUX_ASG)); \
        __syncthreads();                                                                                                                       \
    }                                                                                                                                          \
    SEAM(P);                                                                                                                                   \
    if (IN(P + 1)) {                                                                                                \
        moe_tables(F, F.ctl + CNTW);                                                                                                           \
        pg8::MoeOrder<true> S; S.init(tbl_tb, tokoff, 6, D, D, F.ws + WS_BIG + BIG_EGU, (size_t)1536 * D, F.G, blockIdx.x, 1);   \
        { pg8::Unit u; const int* list = (const int*)(aux + AUX_LIST);                                                                         \
          for (int ui = 0; ui < 12 && S.next(ui, u); ++ui) if (F.tid < 256) { const int idx = (u.pm - tbl_tb[u.e]) * 256 + F.tid;               \
              const int tok = idx < tbl_cnt[u.e] ? list[u.e * 65536 + idx] : 0; tokoff[ui * 256 + F.tid] = (unsigned)tok * (unsigned)D; } } \
        __syncthreads();                                                                                                                       \
        pg8::EpiSwiglu8 E{F.ws + WS_BIG + BIG_HID};                                                                                            \
        pg8::gemm_phase<pg8::EpiSwiglu8, pg8::MoeOrder<true>, true, 0x79797979, 0x7d7d7d7d>(F.lds, H, D, S, E);         \
    }                                                                                                                                          \
    SEAM(P + 1);                                                                                                                               \
    if (IN(P + 2)) {                                                                                  \
        moe_tables(F, F.ctl + CNTW);                                                                                                           \
        pg8::MoeOrder<false> S; S.init(tbl_tb, tokoff, 8, FF, FF, F.ws + WS_BIG + BIG_EDN, (size_t)D * FF, F.G, blockIdx.x, 1);  \
        pg8::EpiDown E{(bf16_t*)(F.ws + WS_BIG + BIG_Y), (const float*)(aux + AUX_GW), tbl_tb};                                                \
        pg8::gemm_phase<pg8::EpiDown, pg8::MoeOrder<false>, true, 0x7a7a7a7a, 0x7c7c7c7c>(F.lds, F.ws + WS_BIG + BIG_HID, FF, S, E);     \
    }                                                                                                                                          \
    SEAM(P + 2);
    MOE_LAYER(P_M0A, 0, CW_CNT0)
    if (IN(P_N1)) {
        moe_tables(F, F.ctl + CW_CNT0);
        norm_pass<0, true, true, true, NoHandler, true>(F, XC, XC, (const bf16_t*)(F.ws + WS_BIG + BIG_Y), (const unsigned*)(aux + AUX_ASG), tbl_tb, in[1] + D, nullptr, H, NoHandler{});
        __syncthreads();
    }
    SEAM(P_N1);
    if (IN(P_G1)) {
        pg8::DenseOrder S; S.init(NTOK, ODD_IN, D, D, F.ws + WS_WIN1, F.G, blockIdx.x, 1);
        pg8::EpiBf16 E{(bf16_t*)(F.ws + WS_BIG + BIG_QKV1), ODD_IN};
        pg8::gemm_phase<pg8::EpiBf16, pg8::DenseOrder, true, 0x7a7a7a7a, 0x7d7d7d7d>(F.lds, H, D, S, E);
    }
    SEAM(P_G1);
    if (IN(P_SPREP)) p11_swaprep(F, in[11], in[12]);
    SEAM(P_SPREP);
    if (IN(P_SWA)) { swa_phase(F, in[13]); __syncthreads(); }
    SEAM(P_SWA);
    if (IN(P_O1)) {
        pg8::DenseOrder S; S.init(NTOK, D, D, D, F.ws + WS_WOUT1, F.G, blockIdx.x, 1);
        pg8::EpiResF32 E{XC, XC, D};
        pg8::gemm_phase<pg8::EpiResF32, pg8::DenseOrder, true, 0x7a7a7a7a, 0x7b7b7b7b>(F.lds, F.ws + WS_H, D, S, E);
    }
    SEAM(P_O1);
    MOE_LAYER(P_M1A, 1, CW_CNT1)
    if (IN(P_FIN)) {
        moe_tables(F, F.ctl + CW_CNT1);
        norm_pass<0, true, true, false>(F, XC, XC, (const bf16_t*)(F.ws + WS_BIG + BIG_Y), (const unsigned*)(aux + AUX_ASG), tbl_tb, nullptr, nullptr, nullptr, NoHandler{});
    }
#undef IN
#undef SEAM
}

extern "C" void kernel_launch(void* const* d_in, const int* in_sizes, int n_in, void* d_out, int out_size, void* d_ws, size_t ws_size, hipStream_t stream) {
    static int grid = 0;
    if (grid == 0) {
        if (n_in != 20 || in_sizes[0] != NTOK * D || out_size != NTOK * D || ws_size < WS_END) { fprintf(stderr, "kernel_launch: unexpected shapes / workspace (n_in %d, in0 %d, out %d, ws %zu, need %zu)\n", n_in, n_in > 0 ? in_sizes[0] : -1, out_size, ws_size, (size_t)WS_END); grid = -1; return; }
        int dev = 0, cus = 0, per_cu = 0;
        if (hipGetDevice(&dev) != hipSuccess || hipDeviceGetAttribute(&cus, hipDeviceAttributeMultiprocessorCount, dev) != hipSuccess) { grid = -1; return; }
        if (hipFuncSetAttribute((const void*)mk_fwd, hipFuncAttributeMaxDynamicSharedMemorySize, LDS_BYTES) != hipSuccess) { fprintf(stderr, "kernel_launch: hipFuncSetAttribute failed\n"); grid = -1; return; }
        if (hipOccupancyMaxActiveBlocksPerMultiprocessor(&per_cu, (const void*)mk_fwd, NTHR, LDS_BYTES) != hipSuccess || per_cu < 1) fprintf(stderr, "kernel_launch: occupancy query reports %d\n", per_cu);
        (void)hipGetLastError();
        if (cus < 256) { fprintf(stderr, "kernel_launch: built for 256 CUs (got %d)\n", cus); grid = -1; return; }
        grid = 256;
    }
    if (grid < 0) return;
    (void)hipMemsetAsync((char*)d_ws + WS_CTL, 0, CTL_ZERO_BYTES, stream);
    Args a{};
    for (int i = 0; i < 20; ++i) a.in[i] = (const float*)d_in[i];
    a.out = (float*)d_out; a.ws = (unsigned char*)d_ws;
#if MK_MULTI
    for (int p = 0; p <= NPH; ++p) { a.ph_lo = p; a.ph_hi = p + 1; hipLaunchKernelGGL(mk_fwd, dim3(grid), dim3(NTHR), LDS_BYTES, stream, a); }
#else
    a.ph_lo = 0; a.ph_hi = NPH + 1;
    hipLaunchKernelGGL(mk_fwd, dim3(grid), dim3(NTHR), LDS_BYTES, stream, a);
#endif
}
```

```cpp
#include <hip/hip_runtime.h>
#include <cstdio>
#include <cstdint>

#ifndef MK_MULTI
#define MK_MULTI 0
#endif

#define LAS __attribute__((address_space(3)))
typedef unsigned short bf16_t;
typedef short bf16x8 __attribute__((ext_vector_type(8)));
typedef float f32x4 __attribute__((ext_vector_type(4)));
typedef float f32x2 __attribute__((ext_vector_type(2)));
typedef unsigned u32x4 __attribute__((ext_vector_type(4)));
typedef unsigned u32x2 __attribute__((ext_vector_type(2)));
#define DI __device__ __forceinline__

constexpr int D = 2048, BATCH = 2, SEQ = 16384, NTOK = BATCH * SEQ;
constexpr int EVEN_IN = 12304, PJW = 12288;
constexpr int ODD_IN = 2560;
constexpr int NEXP = 32, FF = 768, TOPK = 2, MAXT = 288;
constexpr float EPS = 1e-6f;
constexpr double ROPE_R = 0.86596432336006535;
constexpr int C_RQ = 0, C_RK = 1024, C_RV = 2048, C_GQKV = 4096, C_RG = 8192, C_GZ = 10240;

constexpr size_t MiB = 1u << 20;
constexpr size_t WS_CTL = 0, CTL_ZERO_BYTES = 1 * MiB;
constexpr size_t WS_WIN0 = 2 * MiB;
constexpr size_t WS_WOUT0 = WS_WIN0 + 48 * MiB;
constexpr size_t WS_WIN1 = WS_WOUT0 + 16 * MiB;
constexpr size_t WS_WOUT1 = WS_WIN1 + 10 * MiB;
constexpr size_t WS_H = 84 * MiB;
constexpr size_t WS_BIG = 212 * MiB;
constexpr size_t WS_AUX = 980 * MiB;
constexpr size_t WS_MISC = 1540 * MiB;
constexpr size_t WS_EXP1 = 1396 * MiB;
constexpr size_t WS_END = 1572 * MiB;
constexpr size_t BIG_PJ = 0;
constexpr size_t BIG_EGU = 0;
constexpr size_t BIG_EDN = 192 * MiB;
constexpr size_t BIG_HID = 288 * MiB;
constexpr size_t BIG_Y = 400 * MiB;
constexpr size_t BIG_QKV1 = 0;
constexpr size_t AUX_QN = WS_AUX + 0;
constexpr size_t AUX_KN = WS_AUX + 64 * MiB;
constexpr size_t AUX_VC = WS_AUX + 128 * MiB;
constexpr size_t AUX_W = WS_AUX + 256 * MiB;
constexpr size_t AUX_ATT = WS_AUX + 320 * MiB;
constexpr size_t AUX_RST = WS_AUX + 352 * MiB;
constexpr size_t AUX_BG = WS_MISC + 0;
constexpr size_t AUX_CS = WS_MISC + 2 * MiB;
constexpr size_t AUX_DEC = WS_MISC + 10 * MiB + 960 * 1024;
constexpr size_t AUX_SW = WS_MISC + 10 * MiB;
constexpr size_t AUX_LIST = WS_MISC + 11 * MiB;
constexpr size_t AUX_GW = WS_MISC + 19 * MiB;
constexpr size_t AUX_ASG = WS_MISC + 27 * MiB;
constexpr size_t AUX_CS32 = WS_MISC + 28 * MiB;
static_assert(AUX_CS32 + 4 * MiB <= WS_END && AUX_W + 160 * MiB <= WS_EXP1 && WS_EXP1 + 144 * MiB <= WS_MISC, "aux map");
constexpr int CW_BAR = 4096;
constexpr int CSTR = 1088;
constexpr int CW_CNT0 = 16384, CW_CNT1 = 16384 + 40960;

constexpr int RING_BYTES = 131072;
constexpr int GA_LDS_WAVE = 17920;
constexpr int MISC_OFF = 8 * GA_LDS_WAVE;
constexpr int TBL_OFF = MISC_OFF + 256;
constexpr int TOK_OFF = MISC_OFF + 1024;
constexpr int LDS_BYTES = 163840;
static_assert(TOK_OFF + 12 * 1024 <= LDS_BYTES, "lds map");
DI float rdlane(float v, int l) { return __builtin_bit_cast(float, __builtin_amdgcn_readlane(__builtin_bit_cast(int, v), l)); }

DI unsigned f2bf(float f) { unsigned u = __builtin_bit_cast(unsigned, f); return (u + 0x7fffu + ((u >> 16) & 1u)) >> 16; }
DI unsigned pk2(float lo, float hi) { return f2bf(lo) | (f2bf(hi) << 16); }
DI float bflo(unsigned w) { return __builtin_bit_cast(float, w << 16); }
DI float bfhi(unsigned w) { return __builtin_bit_cast(float, w & 0xffff0000u); }
DI float bf2f(bf16_t b) { return __builtin_bit_cast(float, ((unsigned)b) << 16); }
DI unsigned cvt_pk_bf16(float lo, float hi) { unsigned r; asm volatile("v_cvt_pk_bf16_f32 %0, %1, %2" : "=v"(r) : "v"(lo), "v"(hi)); return r; }
DI float wave_sum(float v) {
#pragma unroll
    for (int o = 1; o < 64; o <<= 1) v += __shfl_xor(v, o);
    return v;
}
DI float siluf(float x) { return x / (1.0f + __expf(-x)); }
DI unsigned pk4fp8(float a, float b, float c, float d) { int w = __builtin_amdgcn_cvt_pk_fp8_f32(a, b, 0, false); w = __builtin_amdgcn_cvt_pk_fp8_f32(c, d, w, true); return (unsigned)w; }
typedef __bf16 bf16v2 __attribute__((ext_vector_type(2)));
DI unsigned pkbf(float a, float b) { f32x2 v = {a, b}; return __builtin_bit_cast(unsigned, __builtin_convertvector(v, bf16v2)); }
DI f32x4 mfma16(bf16x8 a, bf16x8 b, f32x4 c) { return __builtin_amdgcn_mfma_f32_16x16x32_bf16(a, b, c, 0, 0, 0); }
#define LDS_WAIT() asm volatile("s_waitcnt lgkmcnt(0)" ::: "memory")
#define VM_WAIT() asm volatile("s_waitcnt vmcnt(0)" ::: "memory")

#define XB_TMO      128
#define XB_XCNT(j)  (256  + 64 * (j))
#define XB_XSUB(j)  (1280 + 64 * (j))
#define XB_XGEN(j)  (2304 + 64 * (j))
#define XB_TOP      3328
#define XB_TOPGEN   3392
#define XCD_BAR_WORDS 3456
#define XB_SPIN_CAP (1u << 22)
DI unsigned xb_ld(unsigned* p)              { return __hip_atomic_load(p, __ATOMIC_RELAXED, __HIP_MEMORY_SCOPE_AGENT); }
DI unsigned xb_add(unsigned* p, unsigned v) { return __hip_atomic_fetch_add(p, v, __ATOMIC_RELAXED, __HIP_MEMORY_SCOPE_AGENT); }
DI unsigned xb_xcc_id() { return (unsigned)__builtin_amdgcn_s_getreg((3 << 11) | 20) & 0xFu; }
#define XB_SPIN(cond, bar) do { unsigned _sp = 0; while (cond) { __builtin_amdgcn_s_sleep(1); \
    if ((++_sp & 255u) == 0u) { if (xb_ld(&(bar)[XB_TMO])) break; if (_sp > XB_SPIN_CAP) { atomicAdd(&(bar)[XB_TMO], 1u); break; } } } } while (0)
struct XcdBarrier { unsigned* bar; unsigned x; volatile LAS unsigned* st; };
DI XcdBarrier xcd_barrier_post(unsigned* bar, volatile LAS unsigned* st) {
    XcdBarrier b; b.bar = bar; b.x = xb_xcc_id(); b.st = st;
    if (threadIdx.x == 0) (void)xb_add(&bar[XB_XCNT(b.x)], 1u);
    return b;
}
DI void xcd_barrier_complete(unsigned* bar, unsigned x, unsigned& nloc, unsigned& nx) {
    const unsigned G = gridDim.x * gridDim.y * gridDim.z;
    unsigned sum, cnt, mine, sp = 0u;
    for (;;) {
        sum = 0u; cnt = 0u; mine = 0u;
#pragma unroll
        for (unsigned j = 0; j < 16; ++j) { const unsigned c = xb_ld(&bar[XB_XCNT(j)]); sum += c; cnt += (c > 0u) ? 1u : 0u; mine = (j == x) ? c : mine; }
        if (sum == G) break;
        __builtin_amdgcn_s_sleep(1);
        if ((++sp & 255u) == 0u) { if (xb_ld(&bar[XB_TMO])) break; if (sp > XB_SPIN_CAP) { atomicAdd(&bar[XB_TMO], 1u); break; } }
    }
    nloc = mine > 0u ? mine : 1u; nx = cnt > 0u ? cnt : 1u;
}
DI void xcd_barrier(const XcdBarrier& b) {
    asm volatile("s_waitcnt vmcnt(0)" ::: "memory");
    __syncthreads();
    if (threadIdx.x == 0) {
        unsigned* bar = b.bar;
        __builtin_amdgcn_s_waitcnt(0);
        unsigned nloc = b.st[0], nx = b.st[1];
        if (nloc == 0u) { xcd_barrier_complete(bar, b.x, nloc, nx); b.st[0] = nloc; b.st[1] = nx; }
        const unsigned old = xb_add(&bar[XB_XSUB(b.x)], 1u);
        const unsigned gen = old / nloc;
        if (old + 1u == (gen + 1u) * nloc) {
            __builtin_amdgcn_fence(__ATOMIC_RELEASE, "agent");
            asm volatile("s_waitcnt vmcnt(0)" ::: "memory");
            const unsigned og = xb_add(&bar[XB_TOP], 1u);
            const unsigned tg = og / nx;
            if (og + 1u == (tg + 1u) * nx) xb_add(&bar[XB_TOPGEN], 1u);
            else XB_SPIN(xb_ld(&bar[XB_TOPGEN]) == tg, bar);
            __builtin_amdgcn_fence(__ATOMIC_ACQUIRE, "agent");
            xb_add(&bar[XB_XGEN(b.x)], 1u);
            asm volatile("s_waitcnt vmcnt(0)" ::: "memory");
        } else {
            XB_SPIN(xb_ld(&bar[XB_XGEN(b.x)]) == gen, bar);
            __builtin_amdgcn_fence(__ATOMIC_ACQUIRE, "agent");
            asm volatile("s_waitcnt vmcnt(0)" ::: "memory");
        }
    }
    __syncthreads();
}

namespace pg8 {
constexpr int BM = 256, BK = 64, HALF = 128, HTB = HALF * BK * 2, STAGE_BYTES = 8 * HTB, NXCD = 8, WGM = 8;
__host__ __device__ __forceinline__ int lds_byte(int r, int c) { const int st = (r >> 4) * 2 + (c >> 5), rr = r & 15, cc = c & 31, ob = rr * 64 + cc * 2; return st * 1024 + (ob ^ (((ob >> 9) & 1) << 5)); }
__host__ __device__ __forceinline__ void stage_rc(int b, int& R, int& C) { const int st = b / 1024, sb = b % 1024, swz = sb ^ (((sb >> 9) & 1) << 5); R = (st >> 1) * 16 + swz / 64; C = (st & 1) * 32 + (swz % 64) / 2; }
__host__ __device__ __forceinline__ int perm32(int rho) { const int n = rho >> 4, i = rho & 15; return 8 * (i >> 2) + 4 * n + (i & 3); }

struct Unit { int pm, pn, e, slot; };

DI int xcd_remap(int L, int nwg) { const int q = nwg / NXCD, r = nwg % NXCD, xcd = L % NXCD, off = L / NXCD; return (xcd < r ? xcd * (q + 1) : r * (q + 1) + (xcd - r) * q) + off; }

struct DenseOrder {
    int nM, nN, nwg, G, c; unsigned lda2; const char* Bt; size_t tstepB;
    DI void init(int M, int N, int K, int lda, const void* Bt_, int G_, int c_, int EB = 2) { nM = M / BM; nN = N / BM; nwg = nM * nN; G = G_; c = c_; lda2 = (unsigned)(lda * EB); Bt = (const char*)Bt_; tstepB = (size_t)BM * K * EB; }
    DI bool next(int i, Unit& u) const {
        const long L = (long)i * G + c; if (L >= nwg) return false;
        const int wgid = xcd_remap((int)L, nwg);
        const int nig = WGM * nN, gid = wgid / nig, fm = gid * WGM, gsz = (nM - fm) < WGM ? (nM - fm) : WGM;
        u.pm = fm + ((wgid % nig) % gsz); u.pn = (wgid % nig) / gsz; u.e = 0; u.slot = i; return true;
    }
    DI unsigned a_off(const Unit& u, int h, int R) const { return (unsigned)(u.pm * BM + h * HALF + R) * lda2; }
    DI const char* b_base(const Unit& u) const { return Bt + (size_t)u.pn * tstepB; }
};
template <bool GATHER> struct MoeOrder {
    const LAS int* tb; const LAS unsigned* tokoff; int NT, nwg, G, c; unsigned lda2; const char* Bt; size_t estepB, tstepB;
    DI void init(const LAS int* tb_, const LAS unsigned* tokoff_, int NT_, int K, int lda, const void* Bt_, size_t estep_elems, int G_, int c_, int EB = 2) {
        tb = tb_; tokoff = tokoff_; NT = NT_; nwg = tb_[32] * NT_; G = G_; c = c_; lda2 = (unsigned)(lda * EB); Bt = (const char*)Bt_; estepB = estep_elems * EB; tstepB = (size_t)BM * K * EB; }
    DI bool next(int i, Unit& u) const {
        const long L = (long)i * G + c; if (L >= nwg) return false;
        const int w = xcd_remap((int)L, nwg);
        int e = 0;
#pragma unroll 1
        for (int s = 16; s >= 1; s >>= 1) if (tb[e + s] * NT <= w) e += s;
        const int nt = tb[e + 1] - tb[e], local = w - tb[e] * NT;
        u.e = e; u.pn = local / nt; u.pm = tb[e] + local % nt; u.slot = i; return true;
    }
    DI unsigned a_off(const Unit& u, int h, int R) const { if (GATHER) return tokoff[u.slot * 256 + h * HALF + R]; return (unsigned)(u.pm * BM + h * HALF + R) * lda2; }
    DI const char* b_base(const Unit& u) const { return Bt + (size_t)u.e * estepB + (size_t)u.pn * tstepB; }
};

struct EpiBf16 {
    static constexpr bool PERM = true;
    bf16_t* O; int ldc;
    DI void operator()(const f32x4 (&acc)[2][2][4][2], const Unit& u, int wr, int wc, int fr, int fq) const {
        const int row0 = u.pm * BM + wr * 64 + fr, col0 = u.pn * BM + wc * 32 + 8 * fq;
#pragma unroll
        for (int ai = 0; ai < 2; ++ai)
#pragma unroll
            for (int m = 0; m < 4; ++m) { bf16_t* rowp = O + (size_t)(row0 + ai * HALF + m * 16) * ldc + col0;
#pragma unroll
                for (int bj = 0; bj < 2; ++bj) { const f32x4 v0 = acc[ai][bj][m][0], v1 = acc[ai][bj][m][1];
                    u32x4 w; w.x = cvt_pk_bf16(v0[0], v0[1]); w.y = cvt_pk_bf16(v0[2], v0[3]); w.z = cvt_pk_bf16(v1[0], v1[1]); w.w = cvt_pk_bf16(v1[2], v1[3]);
                    *(u32x4*)(rowp + bj * HALF) = w; } }
    }
};
struct EpiResF32 {
    static constexpr bool PERM = false;
    const float* base; float* out; int ldc;
    DI void operator()(const f32x4 (&acc)[2][2][4][2], const Unit& u, int wr, int wc, int fr, int fq) const {
        const int row0 = u.pm * BM + wr * 64 + fr, col0 = u.pn * BM + wc * 32 + 4 * fq;
#pragma unroll
        for (int ai = 0; ai < 2; ++ai)
#pragma unroll
            for (int m = 0; m < 4; ++m) { const size_t off = (size_t)(row0 + ai * HALF + m * 16) * ldc + col0;
#pragma unroll
                for (int bj = 0; bj < 2; ++bj)
#pragma unroll
                    for (int n = 0; n < 2; ++n) { const f32x4 bs = *(const f32x4*)(base + off + bj * HALF + n * 16); *(f32x4*)(out + off + bj * HALF + n * 16) = bs + acc[ai][bj][m][n]; }
                asm volatile("" ::: "memory"); }
    }
};
template <bool BASE16> struct EpiRes16 {
    static constexpr bool PERM = true;
    const void* base; bf16_t* out; int ldc;
    DI void operator()(const f32x4 (&acc)[2][2][4][2], const Unit& u, int wr, int wc, int fr, int fq) const {
        const int row0 = u.pm * BM + wr * 64 + fr, col0 = u.pn * BM + wc * 32 + 8 * fq;
#pragma unroll
        for (int ai = 0; ai < 2; ++ai)
#pragma unroll
            for (int m = 0; m < 4; ++m) { const size_t off = (size_t)(row0 + ai * HALF + m * 16) * ldc + col0;
#pragma unroll
                for (int bj = 0; bj < 2; ++bj) { f32x4 v0 = acc[ai][bj][m][0], v1 = acc[ai][bj][m][1];
                    if (BASE16) { const u32x4 b = *(const u32x4*)((const bf16_t*)base + off + bj * HALF); v0 += (f32x4){bflo(b.x), bfhi(b.x), bflo(b.y), bfhi(b.y)}; v1 += (f32x4){bflo(b.z), bfhi(b.z), bflo(b.w), bfhi(b.w)}; }
                    else { const float* bp = (const float*)base + off + bj * HALF; v0 += *(const f32x4*)bp; v1 += *(const f32x4*)(bp + 4); }
                    u32x4 w; w.x = cvt_pk_bf16(v0[0], v0[1]); w.y = cvt_pk_bf16(v0[2], v0[3]); w.z = cvt_pk_bf16(v1[0], v1[1]); w.w = cvt_pk_bf16(v1[2], v1[3]);
                    *(u32x4*)(out + off + bj * HALF) = w; }
                asm volatile("" ::: "memory"); }
    }
};
struct EpiSwiglu {
    static constexpr bool PERM = true;
    bf16_t* O;
    DI void operator()(const f32x4 (&acc)[2][2][4][2], const Unit& u, int wr, int wc, int fr, int fq) const {
        const int row0 = u.pm * BM + wr * 64 + fr, col0 = u.pn * HALF + wc * 32 + 8 * fq;
#pragma unroll
        for (int ai = 0; ai < 2; ++ai)
#pragma unroll
            for (int m = 0; m < 4; ++m) { bf16_t* rowp = O + (size_t)(row0 + ai * HALF + m * 16) * FF + col0;
                float h[8];
#pragma unroll
                for (int n = 0; n < 2; ++n)
#pragma unroll
                    for (int j = 0; j < 4; ++j) { const float g = acc[ai][0][m][n][j], up = acc[ai][1][m][n][j]; h[n * 4 + j] = g / (1.0f + __expf(-g)) * up; }
                u32x4 w; w.x = cvt_pk_bf16(h[0], h[1]); w.y = cvt_pk_bf16(h[2], h[3]); w.z = cvt_pk_bf16(h[4], h[5]); w.w = cvt_pk_bf16(h[6], h[7]);
                *(u32x4*)rowp = w; }
    }
};
struct EpiSwiglu8 {
    static constexpr bool PERM = true;
    unsigned char* O;
    DI void operator()(const f32x4 (&acc)[2][2][4][2], const Unit& u, int wr, int wc, int fr, int fq) const {
        const int row0 = u.pm * BM + wr * 64 + fr, col0 = u.pn * HALF + wc * 32 + 8 * fq;
#pragma unroll
        for (int ai = 0; ai < 2; ++ai)
#pragma unroll
            for (int m = 0; m < 4; ++m) { unsigned char* rowp = O + (size_t)(row0 + ai * HALF + m * 16) * FF + col0;
                float h[8];
#pragma unroll
                for (int n = 0; n < 2; ++n)
#pragma unroll
                    for (int j = 0; j < 4; ++j) { const float g = acc[ai][0][m][n][j], up = acc[ai][1][m][n][j]; h[n * 4 + j] = g / (1.0f + __expf(-g)) * up * 8.0f; }
                u32x2 w; w.x = pk4fp8(h[0], h[1], h[2], h[3]); w.y = pk4fp8(h[4], h[5], h[6], h[7]);
                *(u32x2*)rowp = w; }
    }
};
struct EpiDown {
    static constexpr bool PERM = true;
    bf16_t* O; const float* gw; const LAS int* tb;
    DI void operator()(const f32x4 (&acc)[2][2][4][2], const Unit& u, int wr, int wc, int fr, int fq) const {
        const int row0 = u.pm * BM + wr * 64 + fr, col0 = u.pn * BM + wc * 32 + 8 * fq;
        const int lrow0 = (u.pm - tb[u.e]) * BM + wr * 64 + fr;
        const float* gwe = gw + (size_t)u.e * 65536;
#pragma unroll
        for (int ai = 0; ai < 2; ++ai)
#pragma unroll
            for (int m = 0; m < 4; ++m) { unsigned char* rowp = (unsigned char*)O + (size_t)(row0 + ai * HALF + m * 16) * D + col0; const float g = gwe[lrow0 + ai * HALF + m * 16] * 16.0f;
#pragma unroll
                for (int bj = 0; bj < 2; ++bj) { const f32x4 v0 = acc[ai][bj][m][0] * g, v1 = acc[ai][bj][m][1] * g;
                    u32x2 w; w.x = pk4fp8(v0[0], v0[1], v0[2], v0[3]); w.y = pk4fp8(v1[0], v1[1], v1[2], v1[3]);
                    *(u32x2*)(rowp + bj * HALF) = w; } }
    }
};

typedef int v8i __attribute__((ext_vector_type(8)));
typedef int v4i __attribute__((ext_vector_type(4)));
template <class Epi, class Sched, bool FP8 = false, int SCW = 0x7f7f7f7f, int SCA = 0x7f7f7f7f>
DI void gemm_phase(LAS unsigned char* lds, const void* Aptr, int K, const Sched& S, const Epi& E) {
    constexpr int EB = FP8 ? 1 : 2;
    const int tid = threadIdx.x, wid = __builtin_amdgcn_readfirstlane(tid >> 6), lane = tid & 63, wr = wid >> 2, wc = wid & 3, fr = lane & 15, fq = lane >> 4;
    const int nt = K * EB / (BK * 2);
    const char* Ab = (const char*)Aptr;
    int Rr[2], Cc[2]; unsigned voffB[2];
#pragma unroll
    for (int i = 0; i < 2; ++i) { int R, C; stage_rc(tid * 16 + i * 8192, R, C); const int Rb = Epi::PERM ? ((R & ~31) + perm32(R & 31)) : R; Rr[i] = R; Cc[i] = C * 2; voffB[i] = (unsigned)(Rb * K * EB + C * 2); }
    const unsigned kstep = (unsigned)(BK * 2);
    const size_t hstepB = (size_t)HALF * K * EB;
    const unsigned ldsw = (unsigned)wid * 1024u;
    const int aoff = lds_byte(wr * 64 + fr, fq * (FP8 ? 16 : 8)), boff = lds_byte(wc * 32 + fr, fq * (FP8 ? 16 : 8));
#define PG8_SA(b, h) (((b) * 2 + (h)) * HTB)
#define PG8_SB(b, h) ((4 + (b) * 2 + (h)) * HTB)
#define PG8_STAGEB(bufoff, gbase) do { _Pragma("unroll") for (int _i = 0; _i < 2; ++_i) \
        __builtin_amdgcn_global_load_lds((const unsigned*)((const char*)(gbase) + voffB[_i]), (LAS unsigned*)(lds + (bufoff) + ldsw + _i * 8192), 16, 0, 0); } while (0)
#define PG8_STAGEA(bufoff, offs, kb) do { _Pragma("unroll") for (int _i = 0; _i < 2; ++_i) \
        __builtin_amdgcn_global_load_lds((const unsigned*)(Ab + (size_t)((offs)[_i] + (kb))), (LAS unsigned*)(lds + (bufoff) + ldsw + _i * 8192), 16, 0, 0); } while (0)
#define PG8_LDA(dst, b, h) do { _Pragma("unroll") for (int m = 0; m < 4; ++m) { if constexpr (FP8) { dst##8[m] = *(const LAS v8i*)(lds + PG8_SA(b, h) + aoff + m * 2048); } \
        else { _Pragma("unroll") for (int k = 0; k < 2; ++k) dst[m][k] = *(const LAS bf16x8*)(lds + PG8_SA(b, h) + aoff + m * 2048 + k * 1024); } } } while (0)
#define PG8_LDB(dst, b, h) do { _Pragma("unroll") for (int n = 0; n < 2; ++n) { if constexpr (FP8) { dst##8[n] = *(const LAS v8i*)(lds + PG8_SB(b, h) + boff + n * 2048); } \
        else { _Pragma("unroll") for (int k = 0; k < 2; ++k) dst[n][k] = *(const LAS bf16x8*)(lds + PG8_SB(b, h) + boff + n * 2048 + k * 1024); } } } while (0)
#define PG8_MMA(ai, bj, At, Bt) do { __builtin_amdgcn_s_setprio(1); _Pragma("unroll") for (int m = 0; m < 4; ++m) _Pragma("unroll") for (int n = 0; n < 2; ++n) { \
        if constexpr (FP8) asm volatile("v_mfma_scale_f32_16x16x128_f8f6f4 %0, %1, %2, %0, %3, %4 op_sel_hi:[0,0,0]" : "+v"(acc[ai][bj][m][n]) : "v"(Bt##8[n]), "v"(At##8[m]), "v"(scw_), "v"(sca_)); \
        else { _Pragma("unroll") for (int k = 0; k < 2; ++k) acc[ai][bj][m][n] = __builtin_amdgcn_mfma_f32_16x16x32_bf16(Bt[n][k], At[m][k], acc[ai][bj][m][n], 0, 0, 0); } } __builtin_amdgcn_s_setprio(0); } while (0)
#define PG8_WAIT_V(n) asm volatile("s_waitcnt vmcnt(" #n ")" ::: "memory")
#define PG8_WAIT_L(n) asm volatile("s_waitcnt lgkmcnt(" #n ")" ::: "memory")
#define PG8_BAR __builtin_amdgcn_s_barrier()
#define PG8_SCHED __builtin_amdgcn_sched_barrier(0)
    Unit cur, nxt; int ui = 0;
    if (!S.next(0, cur)) return;
    f32x4 acc[2][2][4][2];
#pragma unroll
    for (int a = 0; a < 2; ++a)
#pragma unroll
        for (int b = 0; b < 2; ++b)
#pragma unroll
            for (int m = 0; m < 4; ++m)
#pragma unroll
                for (int n = 0; n < 2; ++n) acc[a][b][m][n] = (f32x4){0.f, 0.f, 0.f, 0.f};
    const int scw_ = SCW, sca_ = SCA; (void)scw_; (void)sca_;
    bf16x8 At[4][2], B0[2][2], B1[2][2]; v8i At8[4], B08[2], B18[2]; (void)At; (void)B0; (void)B1; (void)At8; (void)B08; (void)B18;
    unsigned ao[2][2];
#pragma unroll
    for (int h = 0; h < 2; ++h)
#pragma unroll
        for (int i = 0; i < 2; ++i) ao[h][i] = S.a_off(cur, h, Rr[i]) + (unsigned)Cc[i];
    const char* cB = S.b_base(cur);
    PG8_STAGEB(PG8_SB(0, 0), cB); PG8_STAGEB(PG8_SB(0, 1), cB + hstepB); PG8_STAGEA(PG8_SA(0, 0), ao[0], 0u); PG8_STAGEA(PG8_SA(0, 1), ao[1], 0u);
    if (wr == 1) PG8_BAR;
    PG8_WAIT_V(2); PG8_BAR;
    PG8_STAGEB(PG8_SB(1, 0), cB + kstep); PG8_STAGEA(PG8_SA(1, 0), ao[0], kstep); PG8_STAGEB(PG8_SB(1, 1), cB + hstepB + kstep);
    PG8_WAIT_V(6); PG8_BAR;
    for (;;) {
        const bool has_next = S.next(ui + 1, nxt);
        const char* nB = has_next ? S.b_base(nxt) : cB;
#pragma unroll 1
        for (int t = 0; t < nt; t += 2) {
            const bool last = (t == nt - 2);
            const unsigned kb1 = (unsigned)(t + 1) * kstep, kb2 = (unsigned)(t + 2) * kstep;
            unsigned x2[2][2];
#pragma unroll
            for (int h = 0; h < 2; ++h)
#pragma unroll
                for (int i = 0; i < 2; ++i) x2[h][i] = last ? (has_next ? (S.a_off(nxt, h, Rr[i]) + (unsigned)Cc[i]) : ao[h][i]) : ao[h][i] + kb2;
            const char* b2 = last ? nB : cB + kb2; const char* b3 = b2 + kstep;
            PG8_LDB(B0, 0, 0); PG8_LDB(B1, 0, 1); PG8_SCHED; PG8_LDA(At, 0, 0); PG8_STAGEA(PG8_SA(1, 1), ao[1], kb1);
            PG8_WAIT_V(8); PG8_WAIT_L(0); PG8_BAR; PG8_MMA(0, 0, At, B0); PG8_MMA(0, 1, At, B1); PG8_BAR; PG8_SCHED;
            PG8_LDA(At, 0, 1); PG8_STAGEB(PG8_SB(0, 0), b2); PG8_STAGEB(PG8_SB(0, 1), b2 + hstepB); PG8_STAGEA(PG8_SA(0, 0), x2[0], 0u);
            PG8_WAIT_V(8); PG8_WAIT_L(0); PG8_BAR; PG8_MMA(1, 0, At, B0); PG8_MMA(1, 1, At, B1); PG8_BAR; PG8_SCHED;
            PG8_LDB(B0, 1, 0); PG8_LDB(B1, 1, 1); PG8_SCHED; PG8_LDA(At, 1, 0); PG8_STAGEA(PG8_SA(0, 1), x2[1], 0u);
            PG8_WAIT_V(8); PG8_WAIT_L(0); PG8_BAR; PG8_MMA(0, 0, At, B0); PG8_MMA(0, 1, At, B1); PG8_BAR; PG8_SCHED;
            PG8_LDA(At, 1, 1); PG8_STAGEB(PG8_SB(1, 0), b3); PG8_STAGEB(PG8_SB(1, 1), b3 + hstepB); PG8_STAGEA(PG8_SA(1, 0), x2[0], kstep);
            PG8_WAIT_V(8); PG8_WAIT_L(0); PG8_BAR; PG8_MMA(1, 0, At, B0); PG8_MMA(1, 1, At, B1); PG8_BAR; PG8_SCHED;
        }
        if (wr == 0) PG8_BAR;
        if constexpr (FP8) asm volatile("s_nop 15" ::: "memory");
        E(acc, cur, wr, wc, fr, fq);
        if (!has_next) break;
#pragma unroll
        for (int a = 0; a < 2; ++a)
#pragma unroll
            for (int b = 0; b < 2; ++b)
#pragma unroll
                for (int m = 0; m < 4; ++m)
#pragma unroll
                    for (int n = 0; n < 2; ++n) acc[a][b][m][n] = (f32x4){0.f, 0.f, 0.f, 0.f};
        cur = nxt; cB = nB; ++ui;
#pragma unroll
        for (int h = 0; h < 2; ++h)
#pragma unroll
            for (int i = 0; i < 2; ++i) ao[h][i] = S.a_off(cur, h, Rr[i]) + (unsigned)Cc[i];
        if (wr == 1) PG8_BAR;
    }
    PG8_WAIT_V(0);
    PG8_BAR;
#undef PG8_SA
#undef PG8_SB
#undef PG8_STAGEA
#undef PG8_STAGEB
#undef PG8_LDA
#undef PG8_LDB
#undef PG8_MMA
#undef PG8_WAIT_V
#undef PG8_WAIT_L
#undef PG8_BAR
#undef PG8_SCHED
}
}

constexpr int NWAVES = 8, NTHR = 512;
struct Frame {
    LAS unsigned char* lds;
    int tid, lane, wave, G, gw, NGW;
    unsigned* ctl;
    unsigned char* ws;
};

DI void transpose_item(const float* Wseg, int ldw, int ncols, int K, bf16_t* WT, int row_off, LAS float* scr, int item, int lane) {
    const int nblk = ncols / 32, kb = item / nblk, nb = item % nblk, k0 = 64 * kb, n0 = 32 * nb;
#pragma unroll 8
    for (int i = 0; i < 32; ++i) { const int kk = 2 * i + (lane >> 5); scr[kk * 33 + (lane & 31)] = Wseg[(size_t)(k0 + kk) * ldw + n0 + (lane & 31)]; }
    LDS_WAIT(); asm volatile("" ::: "memory");
    const int c = lane & 7;
#pragma unroll
    for (int j = 0; j < 4; ++j) { const int n = (lane >> 3) + 8 * j; const LAS float* s = scr + (8 * c) * 33 + n;
        u32x4 o; o.x = pk2(s[0 * 33], s[1 * 33]); o.y = pk2(s[2 * 33], s[3 * 33]); o.z = pk2(s[4 * 33], s[5 * 33]); o.w = pk2(s[6 * 33], s[7 * 33]);
        *(u32x4*)(WT + (size_t)(row_off + n0 + n) * K + k0 + 8 * c) = o; }
    LDS_WAIT(); asm volatile("" ::: "memory");
}

DI void transpose_item8(const float* Wseg, int ldw, int ncols, int K, unsigned char* WT, int row_off, LAS float* scr, int item, int lane, float qs) {
    const int nblk = ncols / 32, kb = item / nblk, nb = item % nblk, k0 = 128 * kb, n0 = 32 * nb;
    const float* wp = Wseg + (size_t)(k0 + (lane >> 5)) * ldw + n0 + (lane & 31);
#pragma unroll
    for (int hb = 0; hb < 2; ++hb) { float v[32];
#pragma unroll
        for (int i = 0; i < 32; ++i) v[i] = wp[(size_t)(64 * hb + 2 * i) * ldw];
#pragma unroll
        for (int i = 0; i < 32; ++i) scr[(64 * hb + 2 * i + (lane >> 5)) * 33 + (lane & 31)] = v[i] * qs; }
    LDS_WAIT(); asm volatile("" ::: "memory");
    const int n = lane >> 1, hf = lane & 1; const LAS float* sp = scr + (64 * hf) * 33 + n;
    unsigned char* dst = WT + (size_t)(row_off + n0 + n) * K + k0 + 64 * hf;
#pragma unroll
    for (int q = 0; q < 4; ++q) { u32x4 o;
        o.x = pk4fp8(sp[(16 * q + 0) * 33], sp[(16 * q + 1) * 33], sp[(16 * q + 2) * 33], sp[(16 * q + 3) * 33]); o.y = pk4fp8(sp[(16 * q + 4) * 33], sp[(16 * q + 5) * 33], sp[(16 * q + 6) * 33], sp[(16 * q + 7) * 33]);
        o.z = pk4fp8(sp[(16 * q + 8) * 33], sp[(16 * q + 9) * 33], sp[(16 * q + 10) * 33], sp[(16 * q + 11) * 33]); o.w = pk4fp8(sp[(16 * q + 12) * 33], sp[(16 * q + 13) * 33], sp[(16 * q + 14) * 33], sp[(16 * q + 15) * 33]);
        *(u32x4*)(dst + 16 * q) = o; }
    LDS_WAIT(); asm volatile("" ::: "memory");
}
DI void p0_weights(Frame& F, const float* const* in) {
    LAS float* scr = (LAS float*)(F.lds + F.wave * 16896);
    bf16_t* win0 = (bf16_t*)(F.ws + WS_WIN0); bf16_t* wout0 = (bf16_t*)(F.ws + WS_WOUT0); bf16_t* win1 = (bf16_t*)(F.ws + WS_WIN1); bf16_t* wout1 = (bf16_t*)(F.ws + WS_WOUT1);
    const float* ewin = in[3]; const float* ewout = in[9]; const float* owin = in[10]; const float* owout = in[14];
    constexpr int KB = D / 64;
    constexpr int I_A = KB * (4096 / 32), I_B = KB * (4096 / 32), I_C = KB * (2048 / 32), I_D = KB * (2048 / 32);
    constexpr int I_O0 = (4096 / 64) * (D / 32), I_I1 = (D / 128) * (ODD_IN / 32), I_O1 = (D / 128) * (D / 32);
    constexpr int NIT = I_A + I_B + I_C + I_D + I_O0 + I_I1 + I_O1;
    for (int it = F.gw; it < NIT; it += F.NGW) {
        int r = it;
        if (r < I_A) { transpose_item(ewin + 0, EVEN_IN, 4096, D, win0, 0, scr, r, F.lane); continue; } r -= I_A;
        if (r < I_B) { transpose_item(ewin + 6144, EVEN_IN, 4096, D, win0, C_GQKV, scr, r, F.lane); continue; } r -= I_B;
        if (r < I_C) { transpose_item(ewin + 4096, EVEN_IN, 2048, D, win0, C_RG, scr, r, F.lane); continue; } r -= I_C;
        if (r < I_D) { transpose_item(ewin + 10240, EVEN_IN, 2048, D, win0, C_GZ, scr, r, F.lane); continue; } r -= I_D;
        if (r < I_O0) { transpose_item(ewout, D, D, 4096, wout0, 0, scr, r, F.lane); continue; } r -= I_O0;
        if (r < I_I1) { transpose_item8(owin, ODD_IN, ODD_IN, D, (unsigned char*)win1, 0, scr, r, F.lane, 32.f); continue; } r -= I_I1;
        transpose_item8(owout, D, D, D, (unsigned char*)wout1, 0, scr, r, F.lane, 32.f);
    }
    bf16_t* swh = (bf16_t*)(F.ws + AUX_SW); bf16_t* swl = swh + 112 * D;
    const int gt = (F.gw * 64 + F.lane), NGT = F.NGW * 64;
    for (int i = gt; i < 112 * D; i += NGT) { const int c = i / D, k = i % D; float v;
        if (c < 16) v = ewin[(size_t)k * EVEN_IN + 12288 + c] * in[1][k];
        else { const int l = (c - 16) / 48, cc = (c - 16) % 48; const float gn = in[2][l * D + k]; v = cc < 4 ? in[15][(size_t)l * D * 4 + k * 4 + cc] * gn : (cc < 36 ? in[16][(size_t)l * D * 32 + k * 32 + (cc - 4)] * gn : 0.f); }
        const unsigned hb = f2bf(v); const float lo = v - __builtin_bit_cast(float, hb << 16); swh[i] = (bf16_t)hb; swl[i] = (bf16_t)f2bf(lo); }
    f32x2* cs = (f32x2*)(F.ws + AUX_CS);
    for (int i = gt; i < SEQ * 64; i += NGT) { const int pos = i >> 6, fi = i & 63; double inv = 1.0;
        for (int q = 0; q < fi; ++q) inv *= ROPE_R;
        const double x = (double)pos * inv, k = __builtin_rint(x * 0.15915494309189535), r = (x - k * 6.283185307179586) - k * 2.4492935982947064e-16;
        const float rf = (float)r; const f32x2 v = {cosf(rf), sinf(rf)}; cs[i] = v; if ((fi & 1) == 0) ((f32x2*)(F.ws + AUX_CS32))[pos * 32 + (fi >> 1)] = v; }
}
DI void convert_experts(Frame& F, const float* const* in, int l, unsigned char* gu, unsigned char* dn, int widx, int nw) {
    LAS float* scr = (LAS float*)(F.lds + F.wave * 16896);
    const float* wg = in[17] + (size_t)l * NEXP * D * FF; const float* wu = in[18] + (size_t)l * NEXP * D * FF; const float* wd = in[19] + (size_t)l * NEXP * FF * D;
    constexpr int I_G = (D / 128) * (128 / 32);
    constexpr int I_GU = NEXP * 6 * 2 * I_G;
    constexpr int I_DE = (FF / 128) * (D / 32);
    constexpr int NIT = I_GU + NEXP * I_DE;
    for (int it = widx; it < NIT; it += nw) {
        if (it < I_GU) { const int seg = it / I_G, r = it % I_G, e = seg / 12, s = seg % 12, pn = s >> 1, isup = s & 1;
            const float* src = (isup ? wu : wg) + (size_t)e * D * FF + pn * 128;
            transpose_item8(src, FF, 128, D, gu + (size_t)e * 1536 * D, pn * 256 + isup * 128, scr, r, F.lane, 64.f); }
        else { const int r2 = it - I_GU, e = r2 / I_DE, r = r2 % I_DE;
            transpose_item8(wd + (size_t)e * FF * D, D, D, FF, dn + (size_t)e * D * FF, 0, scr, r, F.lane, 32.f); }
    }
}

template <int NP, bool ADDY, bool WRITEX, bool WRITEH, class Handler, bool H8 = false, bool SRC16 = false, bool DST16 = false>
DI void norm_pass(Frame& F, const void* src, void* dst, const bf16_t* y, const unsigned* asg, const LAS int* tb, const float* gain, const float* Wt, bf16_t* H, Handler hnd) {
    for (int m = F.gw; m < NTOK; m += F.NGW) {
        f32x4 v[8];
        if (SRC16) { const u32x2* xr = (const u32x2*)((const bf16_t*)src + (size_t)m * D) + F.lane;
#pragma unroll
            for (int j = 0; j < 8; ++j) { const u32x2 b = xr[64 * j]; v[j] = (f32x4){bflo(b.x), bfhi(b.x), bflo(b.y), bfhi(b.y)}; } }
        else { const f32x4* xr = (const f32x4*)((const float*)src + (size_t)m * D) + F.lane;
#pragma unroll
            for (int j = 0; j < 8; ++j) v[j] = xr[64 * j]; }
        if (ADDY) {
            const unsigned a0 = asg[2 * m], a1 = asg[2 * m + 1];
            const size_t r0 = (size_t)tb[a0 >> 16] * 256 + (a0 & 0xffffu), r1 = (size_t)tb[a1 >> 16] * 256 + (a1 & 0xffffu);
            const unsigned* y0 = (const unsigned*)((const unsigned char*)y + r0 * D) + F.lane; const unsigned* y1 = (const unsigned*)((const unsigned char*)y + r1 * D) + F.lane;
#pragma unroll
            for (int j = 0; j < 8; ++j) { const int p = (int)y0[64 * j], q = (int)y1[64 * j];
                v[j].x += (__builtin_amdgcn_cvt_f32_fp8(p, 0) + __builtin_amdgcn_cvt_f32_fp8(q, 0)) * 0.0625f; v[j].y += (__builtin_amdgcn_cvt_f32_fp8(p, 1) + __builtin_amdgcn_cvt_f32_fp8(q, 1)) * 0.0625f;
                v[j].z += (__builtin_amdgcn_cvt_f32_fp8(p, 2) + __builtin_amdgcn_cvt_f32_fp8(q, 2)) * 0.0625f; v[j].w += (__builtin_amdgcn_cvt_f32_fp8(p, 3) + __builtin_amdgcn_cvt_f32_fp8(q, 3)) * 0.0625f; }
        }
        if (WRITEX) {
            if (DST16) { u32x2* xo = (u32x2*)((bf16_t*)dst + (size_t)m * D) + F.lane;
#pragma unroll
                for (int j = 0; j < 8; ++j) { u32x2 w; w.x = pk2(v[j].x, v[j].y); w.y = pk2(v[j].z, v[j].w); xo[64 * j] = w;
                    if (WRITEH) v[j] = (f32x4){bflo(w.x), bfhi(w.x), bflo(w.y), bfhi(w.y)}; } }
            else { f32x4* xo = (f32x4*)((float*)dst + (size_t)m * D) + F.lane;
#pragma unroll
                for (int j = 0; j < 8; ++j) xo[64 * j] = v[j]; } }
        if (WRITEH) {
            float s = 0.f;
#pragma unroll
            for (int j = 0; j < 8; ++j) s += (v[j].x * v[j].x + v[j].y * v[j].y) + (v[j].z * v[j].z + v[j].w * v[j].w);
            const float rstd = 1.0f / sqrtf(wave_sum(s) * (1.0f / D) + EPS);
            const f32x4* gr = (const f32x4*)gain + F.lane;
#pragma unroll
            for (int j = 0; j < 8; ++j) v[j] = v[j] * rstd * gr[64 * j];
            if (H8) { unsigned* ho8 = (unsigned*)((unsigned char*)H + (size_t)m * D) + F.lane;
#pragma unroll
                for (int j = 0; j < 8; ++j) ho8[64 * j] = pk4fp8(v[j].x * 4.f, v[j].y * 4.f, v[j].z * 4.f, v[j].w * 4.f); }
            else {
            u32x2* ho = (u32x2*)(H + (size_t)m * D) + F.lane;
#pragma unroll
            for (int j = 0; j < 8; ++j) { u32x2 w; w.x = pk2(v[j].x, v[j].y); w.y = pk2(v[j].z, v[j].w); ho[64 * j] = w; } }
            if constexpr (NP > 0) {
                float res = 0.f;
#pragma unroll 1
                for (int c0 = 0; c0 < NP; c0 += 4) {
                    float a[4];
#pragma unroll
                    for (int cc = 0; cc < 4; ++cc) { const f32x4* wr = (const f32x4*)(Wt + (size_t)(c0 + cc) * D) + F.lane; a[cc] = 0.f;
#pragma unroll
                        for (int j = 0; j < 8; ++j) { const f32x4 w = wr[64 * j]; a[cc] += (v[j].x * w.x + v[j].y * w.y) + (v[j].z * w.z + v[j].w * w.w); } }
#pragma unroll
                    for (int cc = 0; cc < 4; ++cc) { const float t = wave_sum(a[cc]); res = (F.lane == c0 + cc) ? t : res; }
                }
                hnd(m, res);
            }
        }
    }
}


typedef f32x4 XTile[8][2];
template <int MODE>
DI void normproj_tile(Frame& F, const XTile& xr, int tile, int tl, int par, const float* gain, const bf16_t* Wh, const bf16_t* Wl, bf16_t* H, float* bg, const float* a_log, const float* dt_bias) {
    constexpr int NT = MODE == 0 ? 1 : 3;
    int lane_o = F.lane; asm volatile("" : "+v"(lane_o));
    const int lane = lane_o, r = lane & 15, kq = lane >> 4, w = F.wave;
    LAS float* ssp = (LAS float*)(F.lds + par * 32768);
    LAS f32x4* lp = (LAS f32x4*)(F.lds + par * 32768 + 1024);
    LAS float* lg = (LAS float*)(F.lds + par * 32768 + 1024 + 24576);
    LAS f32x4* sel = (LAS f32x4*)(F.lds + 65536);
    const size_t tok0 = (size_t)tile * 16;
    f32x4 acc[NT];
#pragma unroll
    for (int nt = 0; nt < NT; ++nt) acc[nt] = (f32x4){0.f, 0.f, 0.f, 0.f};
    float ss = 0.f;
#pragma unroll
    for (int i = 0; i < 8; ++i) { const f32x4 xa = xr[i][0], xb = xr[i][1]; asm volatile("" ::: "memory");
        ss += ((xa.x * xa.x + xa.y * xa.y) + (xa.z * xa.z + xa.w * xa.w)) + ((xb.x * xb.x + xb.y * xb.y) + (xb.z * xb.z + xb.w * xb.w));
        u32x4 hw; hw.x = pkbf(xa.x, xa.y); hw.y = pkbf(xa.z, xa.w); hw.z = pkbf(xb.x, xb.y); hw.w = pkbf(xb.z, xb.w);
        u32x4 lw; lw.x = pkbf(xa.x - bflo(hw.x), xa.y - bfhi(hw.x)); lw.y = pkbf(xa.z - bflo(hw.y), xa.w - bfhi(hw.y)); lw.z = pkbf(xb.x - bflo(hw.z), xb.y - bfhi(hw.z)); lw.w = pkbf(xb.z - bflo(hw.w), xb.w - bfhi(hw.w));
        const bf16x8 xh = __builtin_bit_cast(bf16x8, hw), xl = __builtin_bit_cast(bf16x8, lw);
#pragma unroll
        for (int nt = 0; nt < NT; ++nt) { const size_t wo = (size_t)(16 * nt + r) * D + 256 * w + 32 * i + 8 * kq; const bf16x8 wh = *(const bf16x8*)(Wh + wo), wl = *(const bf16x8*)(Wl + wo);
            acc[nt] = mfma16(xh, wh, acc[nt]); acc[nt] = mfma16(xh, wl, acc[nt]); acc[nt] = mfma16(xl, wh, acc[nt]); } }
    ss += __shfl_xor(ss, 16); ss += __shfl_xor(ss, 32);
    if (lane < 16) ssp[w * 16 + lane] = ss;
#pragma unroll
    for (int nt = 0; nt < NT; ++nt) lp[(w * NT + nt) * 64 + lane] = acc[nt];
    __syncthreads();
    float tot = 0.f;
#pragma unroll
    for (int q = 0; q < 8; ++q) tot += ssp[q * 16 + r];
    const float rstd = 1.0f / sqrtf(tot * (1.0f / D) + EPS);
    { const f32x4* gp = (const f32x4*)(gain + 256 * w + 8 * kq); bf16_t* hp = H + (tok0 + r) * D + 256 * w + 8 * kq;
#pragma unroll
      for (int i = 0; i < 8; ++i) { const f32x4 ga = gp[8 * i], gb = gp[8 * i + 1], xa = xr[i][0] * rstd, xb = xr[i][1] * rstd;
        if (MODE == 1) { u32x2 o; o.x = pk4fp8(xa.x * ga.x * 4.f, xa.y * ga.y * 4.f, xa.z * ga.z * 4.f, xa.w * ga.w * 4.f); o.y = pk4fp8(xb.x * gb.x * 4.f, xb.y * gb.y * 4.f, xb.z * gb.z * 4.f, xb.w * gb.w * 4.f);
            *(u32x2*)((unsigned char*)H + (tok0 + r) * D + 256 * w + 8 * kq + 32 * i) = o; }
        else { u32x4 o; o.x = pkbf(xa.x * ga.x, xa.y * ga.y); o.y = pkbf(xa.z * ga.z, xa.w * ga.w); o.z = pkbf(xb.x * gb.x, xb.y * gb.y); o.w = pkbf(xb.z * gb.z, xb.w * gb.w);
            *(u32x4*)(hp + 32 * i) = o; } } }
    if (w == 0) {
        float rs[4];
#pragma unroll
        for (int q = 0; q < 4; ++q) rs[q] = __shfl(rstd, 4 * kq + q);
        f32x4 tl4[NT];
#pragma unroll
        for (int nt = 0; nt < NT; ++nt) { tl4[nt] = lp[nt * 64 + lane];
#pragma unroll
            for (int q = 1; q < 8; ++q) tl4[nt] += lp[(q * NT + nt) * 64 + lane]; }
        if (MODE == 0) {
#pragma unroll
            for (int q = 0; q < 4; ++q) { const float v = tl4[0][q] * rs[q]; float o;
                if (r < 8) o = 1.0f / (1.0f + __expf(-v)); else { const float z = v + dt_bias[r - 8]; const float sp = z > 20.f ? z : log1pf(__expf(z)); o = -__expf(a_log[r - 8]) * sp; }
                bg[(tok0 + 4 * kq + q) * 16 + r] = o; }
        } else {
#pragma unroll
            for (int nt = 0; nt < NT; ++nt)
#pragma unroll
                for (int q = 0; q < 4; ++q) lg[(4 * kq + q) * 48 + 16 * nt + r] = tl4[nt][q] * rs[q];
            LDS_WAIT();
            if (lane < 16) {
                const LAS float* p = lg + lane * 48;
                int g = 0; float gm = p[0];
#pragma unroll
                for (int j = 1; j < 4; ++j) { const float v = p[j]; if (v > gm) { gm = v; g = j; } }
                float gs = 0.f;
#pragma unroll
                for (int j = 0; j < 4; ++j) gs += __expf(p[j] - gm);
                const float g_p = 1.0f / gs;
                float q8[8];
#pragma unroll
                for (int i = 0; i < 8; ++i) q8[i] = p[4 + 8 * g + i];
                int i0 = 0; float m0 = q8[0];
#pragma unroll
                for (int i = 1; i < 8; ++i) if (q8[i] > m0) { m0 = q8[i]; i0 = i; }
                int i1 = -1; float m1 = -3.0e38f;
#pragma unroll
                for (int i = 0; i < 8; ++i) if (i != i0 && q8[i] > m1) { m1 = q8[i]; i1 = i; }
                if (i1 < 0) i1 = (i0 + 1) & 7;
                const float e1 = __expf(m1 - m0), w0 = g_p / (1.0f + e1), w1 = g_p * e1 / (1.0f + e1);
                sel[tl * 16 + lane] = (f32x4){__builtin_bit_cast(float, g * 8 + i0), __builtin_bit_cast(float, g * 8 + i1), w0, w1};
            }
        }
    }
}
template <bool XB>
DI void xtile_load(Frame& F, XTile& xr, const void* x, int tile) {
    const size_t eo = ((size_t)tile * 16 + (F.lane & 15)) * D + 256 * F.wave + 8 * (F.lane >> 4);
    if (XB) { const u32x4* xp = (const u32x4*)((const bf16_t*)x + eo);
#pragma unroll
        for (int i = 0; i < 8; ++i) { const u32x4 b = xp[4 * i]; xr[i][0] = (f32x4){bflo(b.x), bfhi(b.x), bflo(b.y), bfhi(b.y)}; xr[i][1] = (f32x4){bflo(b.z), bfhi(b.z), bflo(b.w), bfhi(b.w)}; } }
    else { const f32x4* xp = (const f32x4*)((const float*)x + eo);
#pragma unroll
        for (int i = 0; i < 8; ++i) { xr[i][0] = xp[8 * i]; xr[i][1] = xp[8 * i + 1]; } }
}
template <int MODE, bool XB = false>
DI void normproj_pass(Frame& F, const void* x, const float* gain, const bf16_t* Wh, const bf16_t* Wl, bf16_t* H, float* bg, const float* a_log, const float* dt_bias, unsigned* cnt, int* list, float* gw, unsigned* asg) {
    constexpr int NTILE = NTOK / 16;
    XTile xa, xb;
    int tile = blockIdx.x, tl = 0;
    if (tile < NTILE) xtile_load<XB>(F, xa, x, tile);
    while (tile < NTILE) {
        if (tile + F.G < NTILE) xtile_load<XB>(F, xb, x, tile + F.G);
        normproj_tile<MODE>(F, xa, tile, tl, tl & 1, gain, Wh, Wl, H, bg, a_log, dt_bias);
        tile += F.G; ++tl;
        if (tile >= NTILE) break;
        if (tile + F.G < NTILE) xtile_load<XB>(F, xa, x, tile + F.G);
        normproj_tile<MODE>(F, xb, tile, tl, tl & 1, gain, Wh, Wl, H, bg, a_log, dt_bias);
        tile += F.G; ++tl;
    }
    __syncthreads();
    if (MODE == 1 && F.wave == 0) {
        LAS f32x4* sel = (LAS f32x4*)(F.lds + 65536); LAS unsigned* hist = (LAS unsigned*)(F.lds + 65536 + 4096); LAS unsigned* base = hist + 32;
        const int lane = F.lane;
        if (lane < 32) hist[lane] = 0u;
        LDS_WAIT();
        const int ntok = tl * 16;
        unsigned rk[8]; int ee[8]; float ww[8]; int mm[8];
#pragma unroll
        for (int q = 0; q < 8; ++q) { const int a = lane + 64 * q;
            ee[q] = -1; if ((a >> 1) < ntok) { const f32x4 sv = sel[a >> 1]; ee[q] = __builtin_bit_cast(int, (a & 1) ? sv.y : sv.x); ww[q] = (a & 1) ? sv.w : sv.z;
                mm[q] = (blockIdx.x + ((a >> 1) >> 4) * F.G) * 16 + ((a >> 1) & 15); rk[q] = __hip_atomic_fetch_add(hist + ee[q], 1u, __ATOMIC_RELAXED, __HIP_MEMORY_SCOPE_WORKGROUP); } }
        LDS_WAIT();
        if (lane < 32) { const unsigned c = hist[lane]; base[lane] = c ? __hip_atomic_fetch_add(cnt + lane * CSTR, c, __ATOMIC_RELAXED, __HIP_MEMORY_SCOPE_AGENT) : 0u; }
        LDS_WAIT();
#pragma unroll
        for (int q = 0; q < 8; ++q) if (ee[q] >= 0) { const unsigned pos = base[ee[q]] + rk[q]; const int a = lane + 64 * q;
            list[ee[q] * 65536 + pos] = mm[q]; gw[ee[q] * 65536 + pos] = ww[q]; asg[2 * mm[q] + (a & 1)] = ((unsigned)ee[q] << 16) | pos; }
    }
    __syncthreads();
}

DI unsigned dpp_ror8(unsigned v) { return (unsigned)__builtin_amdgcn_mov_dpp((int)v, 0x128, 0xf, 0xf, true); }
DI void p2_prep(Frame& F, const float* conv_w) {
    bf16_t* pj = (bf16_t*)(F.ws + WS_BIG + BIG_PJ);
    const f32x2* cs = (const f32x2*)(F.ws + AUX_CS);
    bf16_t* qn = (bf16_t*)(F.ws + AUX_QN); bf16_t* kn = (bf16_t*)(F.ws + AUX_KN); bf16_t* vc = (bf16_t*)(F.ws + AUX_VC);
    const int lane = F.lane, l16 = lane & 15;
    for (int grp = F.gw; grp < NTOK / 16; grp += F.NGW) {
        const int m0 = grp * 16, pos0 = m0 & (SEQ - 1);
#pragma unroll 1
        for (int j = 0; j < 8; ++j) { const int ch = 512 * j + 8 * lane;
            f32x4 w[4][2];
#pragma unroll
            for (int tp = 0; tp < 4; ++tp) { w[tp][0] = *(const f32x4*)(conv_w + tp * 4096 + ch); w[tp][1] = *(const f32x4*)(conv_w + tp * 4096 + ch + 4); }
            u32x4 rr[19];
#pragma unroll
            for (int q = 0; q < 19; ++q) { const int dp = pos0 - 3 + q; rr[q] = (u32x4){0u, 0u, 0u, 0u}; if (dp >= 0) rr[q] = *(const u32x4*)(pj + (size_t)(m0 - 3 + q) * PJW + C_GQKV + ch); }
#pragma unroll
            for (int tt = 0; tt < 16; ++tt) { float a[8];
#pragma unroll
                for (int e = 0; e < 8; ++e) a[e] = 0.f;
#pragma unroll
                for (int tp = 0; tp < 4; ++tp) { const u32x4 r = rr[tt + tp];
                    a[0] += bflo(r.x) * w[tp][0].x; a[1] += bfhi(r.x) * w[tp][0].y; a[2] += bflo(r.y) * w[tp][0].z; a[3] += bfhi(r.y) * w[tp][0].w; a[4] += bflo(r.z) * w[tp][1].x; a[5] += bfhi(r.z) * w[tp][1].y; a[6] += bflo(r.w) * w[tp][1].z; a[7] += bfhi(r.w) * w[tp][1].w; }
                float ss = 0.f;
#pragma unroll
                for (int e = 0; e < 8; ++e) { a[e] = siluf(a[e]); ss += a[e] * a[e]; }
                if (j < 4) { ss += __shfl_xor(ss, 1); ss += __shfl_xor(ss, 2); ss += __shfl_xor(ss, 4); ss += __shfl_xor(ss, 8);
                    const float sc = (1.0f / sqrtf(ss + EPS)) * (j < 2 ? 0.08838834764831845f : 1.0f);
#pragma unroll
                    for (int e = 0; e < 8; ++e) a[e] *= sc; }
                u32x4 o; o.x = pk2(a[0], a[1]); o.y = pk2(a[2], a[3]); o.z = pk2(a[4], a[5]); o.w = pk2(a[6], a[7]);
                const size_t m = (size_t)(m0 + tt);
                bf16_t* dst = j < 2 ? qn + m * 1024 + ch : (j < 4 ? kn + m * 1024 + (ch - 1024) : vc + m * 2048 + (ch - 2048));
                *(u32x4*)dst = o; }
        }
    }
}

constexpr int TB = 16;
template <bool GDN>
DI void p3_recurrence(Frame& F, int u  ) {
    const int b = u >> 2, h = 2 * (u & 3) + (F.tid >> 8), e = F.tid & 255, hh = F.tid >> 8;
    bf16_t* pj = (bf16_t*)(F.ws + WS_BIG + BIG_PJ);
    const bf16_t* qsrc = GDN ? (const bf16_t*)(F.ws + AUX_QN) : pj + C_RQ; const bf16_t* ksrc = GDN ? (const bf16_t*)(F.ws + AUX_KN) : pj + C_RK;
    const int qld = GDN ? 1024 : PJW;
    bf16_t* vsrc = GDN ? (bf16_t*)(F.ws + AUX_VC) : pj + C_RV; const int vld = GDN ? 2048 : PJW;
    const float* bg = (const float*)(F.ws + AUX_BG);
    LAS float* qs = (LAS float*)F.lds;
    LAS float* ks = qs + 2 * TB * 128;
    LAS float* ab = ks + 2 * TB * 128;
    LAS float* vs = ab + 2 * TB * 2;
    float S[128];
#pragma unroll
    for (int d = 0; d < 128; ++d) S[d] = 0.f;
    const float gam = GDN ? 0.f : (1.0f - exp2f(-5.0f - (float)h));
    for (int t0 = 0; t0 < SEQ; t0 += TB) {
        const size_t r0 = (size_t)b * SEQ + t0;
        __syncthreads();
        for (int i = F.tid; i < 2 * TB * 128; i += NTHR) { const int h2 = i / (TB * 128), tt = (i / 128) % TB, d = i % 128; const int hd = 2 * (u & 3) + h2;
            qs[i] = bf2f(qsrc[(r0 + tt) * qld + hd * 128 + d]); ks[i] = bf2f(ksrc[(r0 + tt) * qld + hd * 128 + d]); }
        for (int i = F.tid; i < 2 * TB * 256; i += NTHR) { const int h2 = i / (TB * 256), tt = (i / 256) % TB, ee = i % 256; vs[i] = bf2f(vsrc[(r0 + tt) * vld + (2 * (u & 3) + h2) * 256 + ee]); }
        if (GDN && F.tid < 2 * TB) { const int h2 = F.tid / TB, tt = F.tid % TB, hd = 2 * (u & 3) + h2; ab[F.tid * 2] = __expf(bg[(r0 + tt) * 16 + 8 + hd]); ab[F.tid * 2 + 1] = bg[(r0 + tt) * 16 + hd]; }
        __syncthreads();
#pragma unroll 1
        for (int tt = 0; tt < TB; ++tt) {
            const LAS f32x4* q4 = (const LAS f32x4*)(qs + (hh * TB + tt) * 128); const LAS f32x4* k4 = (const LAS f32x4*)(ks + (hh * TB + tt) * 128);
            const float v = vs[(hh * TB + tt) * 256 + e];
            float o = 0.f;
            if (GDN) {
                const float a = ab[(hh * TB + tt) * 2], beta = ab[(hh * TB + tt) * 2 + 1];
                float ksum = 0.f;
#pragma unroll
                for (int d4 = 0; d4 < 32; ++d4) { if ((d4 & 7) == 0) asm volatile("" ::: "memory"); const f32x4 kk = k4[d4]; ksum += (kk.x * S[4 * d4] + kk.y * S[4 * d4 + 1]) + (kk.z * S[4 * d4 + 2] + kk.w * S[4 * d4 + 3]); }
                const float r = (v - a * ksum) * beta;
#pragma unroll
                for (int d4 = 0; d4 < 32; ++d4) { if ((d4 & 3) == 0) asm volatile("" ::: "memory"); const f32x4 kk = k4[d4], qq = q4[d4];
                    S[4 * d4] = a * S[4 * d4] + r * kk.x; S[4 * d4 + 1] = a * S[4 * d4 + 1] + r * kk.y; S[4 * d4 + 2] = a * S[4 * d4 + 2] + r * kk.z; S[4 * d4 + 3] = a * S[4 * d4 + 3] + r * kk.w;
                    o += (qq.x * S[4 * d4] + qq.y * S[4 * d4 + 1]) + (qq.z * S[4 * d4 + 2] + qq.w * S[4 * d4 + 3]); }
            } else {
#pragma unroll
                for (int d4 = 0; d4 < 32; ++d4) { if ((d4 & 3) == 0) asm volatile("" ::: "memory"); const f32x4 kk = k4[d4], qq = q4[d4];
                    S[4 * d4] = gam * S[4 * d4] + v * kk.x; S[4 * d4 + 1] = gam * S[4 * d4 + 1] + v * kk.y; S[4 * d4 + 2] = gam * S[4 * d4 + 2] + v * kk.z; S[4 * d4 + 3] = gam * S[4 * d4 + 3] + v * kk.w;
                    o += (qq.x * S[4 * d4] + qq.y * S[4 * d4 + 1]) + (qq.z * S[4 * d4 + 2] + qq.w * S[4 * d4 + 3]); }
            }
            vsrc[(r0 + tt) * vld + h * 256 + e] = (bf16_t)f2bf(o);
        }
    }
}


constexpr int NCH = SEQ / 64;
DI constexpr int rowoff4c(int i) { int a = 0; for (int k = 0; k < i; ++k) a += (k + 3) / 4; return a; }
typedef short s16x4 __attribute__((ext_vector_type(4)));
DI s16x4 tr_read(unsigned lds_addr) { s16x4 r; asm volatile("ds_read_b64_tr_b16 %0, %1\n\ts_waitcnt lgkmcnt(0)" : "=&v"(r) : "v"(lds_addr) : "memory"); return r; }
DI void tr_read4(unsigned a0, unsigned a1, unsigned a2, unsigned a3, s16x4& r0, s16x4& r1, s16x4& r2, s16x4& r3) {
    asm volatile("ds_read_b64_tr_b16 %0, %4\n\tds_read_b64_tr_b16 %1, %5\n\tds_read_b64_tr_b16 %2, %6\n\tds_read_b64_tr_b16 %3, %7\n\ts_waitcnt lgkmcnt(0)"
                 : "=&v"(r0), "=&v"(r1), "=&v"(r2), "=&v"(r3) : "v"(a0), "v"(a1), "v"(a2), "v"(a3) : "memory"); }
DI bf16x8 cat8(s16x4 a, s16x4 b) { return __builtin_shufflevector(a, b, 0, 1, 2, 3, 4, 5, 6, 7); }

DI void rope_pair(bf16x8& f1, bf16x8& f2, const f32x4* cp, float sc) {
    const f32x4 c0 = cp[0], c1 = cp[1], c2 = cp[2], c3 = cp[3];
    const float cs_[8] = {c0.x, c0.z, c1.x, c1.z, c2.x, c2.z, c3.x, c3.z}, sn_[8] = {c0.y, c0.w, c1.y, c1.w, c2.y, c2.w, c3.y, c3.w};
    const u32x4 a = __builtin_bit_cast(u32x4, f1), b = __builtin_bit_cast(u32x4, f2);
    const float x1[8] = {bflo(a.x), bfhi(a.x), bflo(a.y), bfhi(a.y), bflo(a.z), bfhi(a.z), bflo(a.w), bfhi(a.w)}, x2[8] = {bflo(b.x), bfhi(b.x), bflo(b.y), bfhi(b.y), bflo(b.z), bfhi(b.z), bflo(b.w), bfhi(b.w)};
    float y1[8], y2[8];
#pragma unroll
    for (int e = 0; e < 8; ++e) { y1[e] = (x1[e] * cs_[e] - x2[e] * sn_[e]) * sc; y2[e] = (x2[e] * cs_[e] + x1[e] * sn_[e]) * sc; }
    u32x4 o1, o2; o1.x = pk2(y1[0], y1[1]); o1.y = pk2(y1[2], y1[3]); o1.z = pk2(y1[4], y1[5]); o1.w = pk2(y1[6], y1[7]); o2.x = pk2(y2[0], y2[1]); o2.y = pk2(y2[2], y2[3]); o2.z = pk2(y2[4], y2[5]); o2.w = pk2(y2[6], y2[7]);
    f1 = __builtin_bit_cast(bf16x8, o1); f2 = __builtin_bit_cast(bf16x8, o2);
}
template <bool GDN>
DI void ga_unit(Frame& F, int unit, unsigned char* stream, float* out_f32_unused) {
    (void)out_f32_unused;
    constexpr int NF = GDN ? 56 : 40, OFF_W = 0, OFF_QG = GDN ? 16 : 0, OFF_ATT = OFF_QG + 16, OFF_KT = OFF_ATT + 8;
    int lane_o = F.lane; asm volatile("" : "+v"(lane_o));
    const int lane = lane_o, fr = lane & 15, g = lane >> 4;
    const int bh = unit / NCH, n = unit % NCH, b = bh >> 3, h = bh & 7;
    const size_t row0 = (size_t)b * SEQ + (size_t)n * 64;
    LAS unsigned char* L = F.lds + F.wave * GA_LDS_WAVE;
    LAS float* LAf = (LAS float*)L; LAS unsigned char* LA = L; LAS unsigned char* LT = L + 9216; LAS float* LG = (LAS float*)(L + 17408); LAS float* LB = LG + 64;
    const bf16_t* pj = (const bf16_t*)(F.ws + WS_BIG + BIG_PJ);
    const bf16_t* qsrc = GDN ? (const bf16_t*)(F.ws + AUX_QN) + h * 128 : pj + C_RQ + h * 128;
    const bf16_t* ksrc = GDN ? (const bf16_t*)(F.ws + AUX_KN) + h * 128 : pj + C_RK + h * 128;
    const size_t qld = GDN ? 1024 : PJW;
    unsigned char* st = stream + (size_t)unit * NF * 1024 + lane * 16;
    float gv, bv = 1.f;
    if (GDN) { const float* bg = (const float*)(F.ws + AUX_BG); gv = bg[(row0 + lane) * 16 + 8 + h]; bv = bg[(row0 + lane) * 16 + h];
#pragma unroll
        for (int o = 1; o < 64; o <<= 1) { const float t = __shfl_up(gv, o); if (lane >= o) gv += t; } }
    else gv = (float)(lane + 1) * log1pf(-exp2f(-5.0f - (float)h));
    const float gl = rdlane(gv, 63);
    LG[lane] = gv; LB[lane] = bv;
    LDS_WAIT();
    float gr[16], gcl[4], br[16];
#pragma unroll
    for (int t = 0; t < 4; ++t) { gcl[t] = LG[16 * t + fr];
#pragma unroll
        for (int r = 0; r < 4; ++r) { gr[t * 4 + r] = LG[16 * t + 4 * g + r]; br[t * 4 + r] = LB[16 * t + 4 * g + r]; } }
    bf16x8 Kf[4][4], Qf[4][4];
#pragma unroll
    for (int t = 0; t < 4; ++t)
#pragma unroll
        for (int s2 = 0; s2 < 4; ++s2) Kf[t][s2] = *(const bf16x8*)(ksrc + (row0 + 16 * t + fr) * qld + 32 * s2 + 8 * g);
    if (!GDN) {
        const f32x2* cs = (const f32x2*)(F.ws + AUX_CS);
#pragma unroll
        for (int t = 0; t < 4; ++t) { const f32x2* cr = cs + (size_t)((row0 + 16 * t + fr) & (SEQ - 1)) * 64 + 8 * g;
            rope_pair(Kf[t][0], Kf[t][2], (const f32x4*)cr, 0.08838834764831845f); rope_pair(Kf[t][1], Kf[t][3], (const f32x4*)(cr + 32), 0.08838834764831845f); }
    }
    if (GDN) {
#pragma unroll
        for (int it = 0; it < 4; ++it)
#pragma unroll
            for (int jt = 0; jt <= it; ++jt) { f32x4 acc = {0.f, 0.f, 0.f, 0.f};
#pragma unroll
                for (int s2 = 0; s2 < 4; ++s2) acc = mfma16(Kf[it][s2], Kf[jt][s2], acc);
#pragma unroll
                for (int r = 0; r < 4; ++r) { const int i = 16 * it + 4 * g + r, j = 16 * jt + fr; const int q = (i + 3) >> 2; const int ro = 2 * q * (q - 1) + q * (i - 4 * q + 3);
                    if (j < i) LAf[ro * 4 + j] = br[it * 4 + r] * acc[r] * __expf(gr[it * 4 + r] - gcl[jt]); } }
    }
    asm volatile("" ::: "memory");
#pragma unroll
    for (int it = 0; it < 4; ++it) {
        asm volatile("" ::: "memory");
#pragma unroll
        for (int s2 = 0; s2 < 4; ++s2) Qf[it][s2] = *(const bf16x8*)(qsrc + (row0 + 16 * it + fr) * qld + 32 * s2 + 8 * g);
        if (!GDN) { const f32x2* cr = (const f32x2*)(F.ws + AUX_CS) + (size_t)((row0 + 16 * it + fr) & (SEQ - 1)) * 64 + 8 * g;
            rope_pair(Qf[it][0], Qf[it][2], (const f32x4*)cr, 1.0f); rope_pair(Qf[it][1], Qf[it][3], (const f32x4*)(cr + 32), 1.0f);
#pragma unroll
            for (int s2 = 0; s2 < 4; ++s2) *(LAS bf16x8*)(L + (16 * it + fr) * 256 + (32 * s2 + 8 * g) * 2) = Qf[it][s2]; }
#pragma unroll
        for (int sp = 0; sp < 2; ++sp) { u32x4 w;
#pragma unroll
            for (int hf = 0; hf < 2; ++hf) { const int jt = 2 * sp + hf; float v[4] = {0.f, 0.f, 0.f, 0.f};
                if (jt <= it) { f32x4 acc = {0.f, 0.f, 0.f, 0.f};
#pragma unroll
                    for (int s2 = 0; s2 < 4; ++s2) acc = mfma16(Kf[jt][s2], Qf[it][s2], acc);
#pragma unroll
                    for (int r = 0; r < 4; ++r) { const int j = 16 * jt + 4 * g + r, i = 16 * it + fr; v[r] = (j <= i) ? acc[r] * __expf(gcl[it] - gr[jt * 4 + r]) : 0.f; } }
                if (hf == 0) { w.x = pk2(v[0], v[1]); w.y = pk2(v[2], v[3]); } else { w.z = pk2(v[0], v[1]); w.w = pk2(v[2], v[3]); } }
            *(u32x4*)(st + (OFF_ATT + it * 2 + sp) * 1024) = w; }
    }
    if (!GDN) LDS_WAIT();
    asm volatile("" ::: "memory");
#pragma unroll
    for (int it = 0; it < 4; ++it) { const float sc = __expf(gcl[it]); asm volatile("" ::: "memory");
#pragma unroll
        for (int s2 = 0; s2 < 4; ++s2) { const bf16_t* qp = qsrc + (row0 + 16 * it + fr) * qld + 32 * s2 + 4 * g; u32x2 lo, hi;
            if (GDN) { lo = *(const u32x2*)qp; hi = *(const u32x2*)(qp + 16); }
            else { const LAS unsigned char* lq = L + (16 * it + fr) * 256 + (32 * s2 + 4 * g) * 2; lo = *(const LAS u32x2*)lq; hi = *(const LAS u32x2*)(lq + 32); }
            u32x4 w; w.x = pk2(bflo(lo.x) * sc, bfhi(lo.x) * sc); w.y = pk2(bflo(lo.y) * sc, bfhi(lo.y) * sc); w.z = pk2(bflo(hi.x) * sc, bfhi(hi.x) * sc); w.w = pk2(bflo(hi.y) * sc, bfhi(hi.y) * sc);
            *(u32x4*)(st + (OFF_QG + it * 4 + s2) * 1024) = w; } }
    asm volatile("" ::: "memory");
    float t[64];
    float sw_ = 1.f, su_ = 1.f;
    if (GDN) {
        LDS_WAIT();
        const LAS f32x4* LA4 = (const LAS f32x4*)LA;
#pragma unroll
        for (int i = 0; i < 64; ++i) { float acc = (lane == i) ? 1.f : 0.f; if ((i & 1) == 0) asm volatile("" ::: "memory");
#pragma unroll
            for (int m4 = 0; m4 < (i + 3) / 4; ++m4) { const f32x4 l = LA4[rowoff4c(i) + m4];
                if (4 * m4 + 0 < i) acc -= l.x * t[4 * m4 + 0]; if (4 * m4 + 1 < i) acc -= l.y * t[4 * m4 + 1]; if (4 * m4 + 2 < i) acc -= l.z * t[4 * m4 + 2]; if (4 * m4 + 3 < i) acc -= l.w * t[4 * m4 + 3]; }
            t[i] = acc; }
        su_ = bv; sw_ = bv * __expf(gv);
        LDS_WAIT();
#pragma unroll
        for (int i = 0; i < 64; ++i) *(LAS bf16_t*)(LT + (i * 64 + lane) * 2) = (bf16_t)f2bf(t[i] * sw_);
    }
    asm volatile("" ::: "memory");
    float ksc[2][2][4];
#pragma unroll
    for (int sp = 0; sp < 2; ++sp)
#pragma unroll
        for (int tp = 0; tp < 2; ++tp)
#pragma unroll
            for (int e = 0; e < 4; ++e) ksc[sp][tp][e] = __expf(gl - LG[32 * sp + 16 * tp + 4 * g + e]);
    const unsigned la_addr = (unsigned)(size_t)LA, q4 = (unsigned)((lane & 15) >> 2), p4 = (unsigned)(lane & 3);
#pragma unroll 1
    for (int p = 0; p < 2; ++p) {
        LDS_WAIT();
#pragma unroll
        for (int k = 0; k < 8; ++k) { const int row = (lane >> 3) + 8 * k, pc = lane & 7; if (GDN) *(LAS u32x4*)(LA + row * 128 + pc * 16) = *(const u32x4*)(ksrc + (row0 + row) * qld + 64 * p + 8 * pc); }
        if (!GDN) {
#pragma unroll
            for (int t = 0; t < 4; ++t)
#pragma unroll
                for (int s2 = 0; s2 < 4; ++s2) if ((s2 >> 1) == p) *(LAS bf16x8*)(LA + (16 * t + fr) * 128 + (32 * (s2 & 1) + 8 * g) * 2) = Kf[t][s2]; }
        LDS_WAIT();
        if (GDN) {
#pragma unroll
            for (int it = 0; it < 4; ++it) { bf16x8 Tf[2];
#pragma unroll
                for (int ks = 0; ks < 2; ++ks) Tf[ks] = *(const LAS bf16x8*)(LT + ((16 * it + fr) * 64 + 32 * ks + 8 * g) * 2);
#pragma unroll
                for (int sl = 0; sl < 2; ++sl) { u32x4 w;
#pragma unroll
                    for (int hf = 0; hf < 2; ++hf) { const int dtl = 2 * sl + hf; f32x4 acc = {0.f, 0.f, 0.f, 0.f};
                        { s16x4 a0, a1, a2, a3; const unsigned ad = la_addr + (8 * g + q4) * 128 + dtl * 32 + p4 * 8; tr_read4(ad, ad + 4 * 128, ad + 32 * 128, ad + 36 * 128, a0, a1, a2, a3);
                          acc = mfma16(cat8(a0, a1), Tf[0], acc); acc = mfma16(cat8(a2, a3), Tf[1], acc); }
                        if (hf == 0) { w.x = pk2(-acc[0], -acc[1]); w.y = pk2(-acc[2], -acc[3]); } else { w.z = pk2(-acc[0], -acc[1]); w.w = pk2(-acc[2], -acc[3]); } }
                    *(u32x4*)(st + (OFF_W + it * 4 + 2 * p + sl) * 1024) = w; } }
        }
#pragma unroll
        for (int dtl = 0; dtl < 4; ++dtl) { s16x4 t0, t1, t2, t3; const unsigned ad = la_addr + (4 * g + q4) * 128 + dtl * 32 + p4 * 8; tr_read4(ad, ad + 16 * 128, ad + 32 * 128, ad + 48 * 128, t0, t1, t2, t3);
#pragma unroll
            for (int sp = 0; sp < 2; ++sp) { const s16x4 a0 = sp ? t2 : t0, a1 = sp ? t3 : t1;
                u32x4 w; w.x = pk2(bf2f((bf16_t)a0[0]) * ksc[sp][0][0], bf2f((bf16_t)a0[1]) * ksc[sp][0][1]); w.y = pk2(bf2f((bf16_t)a0[2]) * ksc[sp][0][2], bf2f((bf16_t)a0[3]) * ksc[sp][0][3]);
                w.z = pk2(bf2f((bf16_t)a1[0]) * ksc[sp][1][0], bf2f((bf16_t)a1[1]) * ksc[sp][1][1]); w.w = pk2(bf2f((bf16_t)a1[2]) * ksc[sp][1][2], bf2f((bf16_t)a1[3]) * ksc[sp][1][3]);
                *(u32x4*)(st + (OFF_KT + (4 * p + dtl) * 2 + sp) * 1024) = w; } }
    }
    if (GDN) {
        LDS_WAIT();
#pragma unroll
        for (int i = 0; i < 64; ++i) *(LAS bf16_t*)(LT + (i * 64 + lane) * 2) = (bf16_t)f2bf(t[i] * su_);
        const bf16_t* vsrc = (const bf16_t*)(F.ws + AUX_VC) + h * 256;
        unsigned char* ub = F.ws + WS_H + (size_t)unit * 32768 + lane * 32;
#pragma unroll 1
        for (int p = 0; p < 4; ++p) {
            LDS_WAIT();
#pragma unroll
            for (int k = 0; k < 8; ++k) { const int row = (lane >> 3) + 8 * k, pc = lane & 7; *(LAS u32x4*)(LA + row * 128 + pc * 16) = *(const u32x4*)(vsrc + (row0 + row) * 2048 + 64 * p + 8 * pc); }
            LDS_WAIT();
            bf16x8 Tf[4][2];
#pragma unroll
            for (int it = 0; it < 4; ++it)
#pragma unroll
                for (int ks = 0; ks < 2; ++ks) Tf[it][ks] = *(const LAS bf16x8*)(LT + ((16 * it + fr) * 64 + 32 * ks + 8 * g) * 2);
#pragma unroll
            for (int etl = 0; etl < 4; ++etl) { bf16x8 Vf[2];
                { s16x4 a0, a1, a2, a3; const unsigned ad = la_addr + (8 * g + q4) * 128 + etl * 32 + p4 * 8; tr_read4(ad, ad + 4 * 128, ad + 32 * 128, ad + 36 * 128, a0, a1, a2, a3); Vf[0] = cat8(a0, a1); Vf[1] = cat8(a2, a3); }
                u32x4 w0, w1;
#pragma unroll
                for (int it = 0; it < 4; ++it) { f32x4 acc = {0.f, 0.f, 0.f, 0.f};
#pragma unroll
                    for (int ks = 0; ks < 2; ++ks) acc = mfma16(Tf[it][ks], Vf[ks], acc);
                    const unsigned a = pk2(acc[0], acc[1]), c = pk2(acc[2], acc[3]);
                    if (it == 0) { w0.x = a; w0.y = c; } else if (it == 1) { w0.z = a; w0.w = c; } else if (it == 2) { w1.x = a; w1.y = c; } else { w1.z = a; w1.w = c; } }
                *(u32x4*)(ub + (4 * p + etl) * 2048) = w0; *(u32x4*)(ub + (4 * p + etl) * 2048 + 16) = w1; }
        }
        if (lane == 0) ((float*)(F.ws + AUX_DEC))[unit] = __expf(gl);
    }
    LDS_WAIT();
}

constexpr int XL_SLOT = 12288, XL_CNT = 2 * XL_SLOT;
template <bool GDN, int ROLE>
DI void scan_wave(Frame& F, int bh, int sl, const unsigned char* stream, LAS unsigned char* xl) {
    constexpr int NF = GDN ? 56 : 40;
    const int lane = F.lane, fr = lane & 15, g = lane >> 4, b = bh >> 3, h = bh & 7;
    const unsigned char* sp0 = stream + (size_t)bh * NCH * NF * 1024;
    const unsigned voff = (unsigned)lane * 16u;
    const size_t orow = (size_t)2048 * 2;
    const unsigned char* obu = (GDN ? F.ws + AUX_VC : F.ws + AUX_QN) + (size_t)b * SEQ * orow + (size_t)(h * 256 + 16 * sl) * 2;
    const unsigned ooff = (unsigned)((size_t)(4 * g) * orow) + (unsigned)fr * 2u;
    const size_t vrow = (size_t)PJW * 2;
    const unsigned char* vbu = F.ws + WS_BIG + BIG_PJ + (size_t)C_RV * 2 + (size_t)b * SEQ * vrow + (size_t)(h * 256 + 16 * sl) * 2;
    const unsigned voff2 = (unsigned)((size_t)(4 * g) * vrow) + (unsigned)fr * 2u;
    const float* decp = (const float*)(F.ws + AUX_DEC) + bh * NCH;
    float decr = 1.f; { const float gm = 1.0f - exp2f(-5.0f - (float)h); float d2 = gm * gm; d2 *= d2; d2 *= d2; d2 *= d2; d2 *= d2; d2 *= d2; decr = d2; }
    const unsigned char* ubp = F.ws + WS_H + (size_t)bh * NCH * 32768 + sl * 2048; const unsigned uoff = (unsigned)lane * 32u;
    const unsigned zoff = 0u; (void)decp; (void)decr; (void)ubp; (void)uoff; (void)zoff; (void)obu; (void)ooff; (void)vbu; (void)voff2; (void)vrow; (void)orow;
    if constexpr (GDN && ROLE == 0) {
    bf16x8 r0 = (bf16x8){0, 0, 0, 0, 0, 0, 0, 0};
    bf16x8 r1 = (bf16x8){0, 0, 0, 0, 0, 0, 0, 0};
    bf16x8 r2 = (bf16x8){0, 0, 0, 0, 0, 0, 0, 0};
    bf16x8 r3 = (bf16x8){0, 0, 0, 0, 0, 0, 0, 0};
    bf16x8 r4 = (bf16x8){0, 0, 0, 0, 0, 0, 0, 0};
    bf16x8 r5 = (bf16x8){0, 0, 0, 0, 0, 0, 0, 0};
    bf16x8 r6 = (bf16x8){0, 0, 0, 0, 0, 0, 0, 0};
    bf16x8 r7 = (bf16x8){0, 0, 0, 0, 0, 0, 0, 0};
    bf16x8 r8 = (bf16x8){0, 0, 0, 0, 0, 0, 0, 0};
    bf16x8 r9 = (bf16x8){0, 0, 0, 0, 0, 0, 0, 0};
    bf16x8 r10 = (bf16x8){0, 0, 0, 0, 0, 0, 0, 0};
    bf16x8 r11 = (bf16x8){0, 0, 0, 0, 0, 0, 0, 0};
    bf16x8 r12 = (bf16x8){0, 0, 0, 0, 0, 0, 0, 0};
    bf16x8 r13 = (bf16x8){0, 0, 0, 0, 0, 0, 0, 0};
    bf16x8 r14 = (bf16x8){0, 0, 0, 0, 0, 0, 0, 0};
    bf16x8 r15 = (bf16x8){0, 0, 0, 0, 0, 0, 0, 0};
    f32x4 S0_0 = {0.f, 0.f, 0.f, 0.f};
    f32x4 S0_1 = {0.f, 0.f, 0.f, 0.f};
    f32x4 S0_2 = {0.f, 0.f, 0.f, 0.f};
    f32x4 S0_3 = {0.f, 0.f, 0.f, 0.f};
    f32x4 S0_4 = {0.f, 0.f, 0.f, 0.f};
    f32x4 S0_5 = {0.f, 0.f, 0.f, 0.f};
    f32x4 S0_6 = {0.f, 0.f, 0.f, 0.f};
    f32x4 S0_7 = {0.f, 0.f, 0.f, 0.f};
    bf16x8 Sp0_0 = (bf16x8){0, 0, 0, 0, 0, 0, 0, 0};
    bf16x8 Sp0_1 = (bf16x8){0, 0, 0, 0, 0, 0, 0, 0};
    bf16x8 Sp0_2 = (bf16x8){0, 0, 0, 0, 0, 0, 0, 0};
    bf16x8 Sp0_3 = (bf16x8){0, 0, 0, 0, 0, 0, 0, 0};
    f32x4 S1_0 = {0.f, 0.f, 0.f, 0.f};
    f32x4 S1_1 = {0.f, 0.f, 0.f, 0.f};
    f32x4 S1_2 = {0.f, 0.f, 0.f, 0.f};
    f32x4 S1_3 = {0.f, 0.f, 0.f, 0.f};
    f32x4 S1_4 = {0.f, 0.f, 0.f, 0.f};
    f32x4 S1_5 = {0.f, 0.f, 0.f, 0.f};
    f32x4 S1_6 = {0.f, 0.f, 0.f, 0.f};
    f32x4 S1_7 = {0.f, 0.f, 0.f, 0.f};
    bf16x8 Sp1_0 = (bf16x8){0, 0, 0, 0, 0, 0, 0, 0};
    bf16x8 Sp1_1 = (bf16x8){0, 0, 0, 0, 0, 0, 0, 0};
    bf16x8 Sp1_2 = (bf16x8){0, 0, 0, 0, 0, 0, 0, 0};
    bf16x8 Sp1_3 = (bf16x8){0, 0, 0, 0, 0, 0, 0, 0};
    float decv = 0.f;
    u32x4 un0_0 = {0u, 0u, 0u, 0u}, un0_1 = {0u, 0u, 0u, 0u};
    u32x4 un1_0 = {0u, 0u, 0u, 0u}, un1_1 = {0u, 0u, 0u, 0u};
    { const int n = 0; (void)n;
    asm volatile("global_load_dwordx4 %0, %1, off" : "+v"(un0_0) : "v"((const unsigned char*)(ubp + 0 * 2048) + uoff) : "memory");
    asm volatile("global_load_dwordx4 %0, %1, off offset:16" : "+v"(un0_1) : "v"((const unsigned char*)(ubp + 0 * 2048) + uoff) : "memory");
    asm volatile("global_load_dwordx4 %0, %1, off" : "+v"(un1_0) : "v"((const unsigned char*)(ubp + 1 * 2048) + uoff) : "memory");
    asm volatile("global_load_dwordx4 %0, %1, off offset:16" : "+v"(un1_1) : "v"((const unsigned char*)(ubp + 1 * 2048) + uoff) : "memory");
    asm volatile("global_load_dword %0, %1, off" : "+v"(decv) : "v"((const unsigned char*)(decp) + zoff) : "memory");
    asm volatile("global_load_dwordx4 %0, %1, off" : "+v"(r0) : "v"((const unsigned char*)(sp0 + ((size_t)(n + 0) * 56 + 0) * 1024) + voff) : "memory");
    asm volatile("global_load_dwordx4 %0, %1, off" : "+v"(r1) : "v"((const unsigned char*)(sp0 + ((size_t)(n + 0) * 56 + 1) * 1024) + voff) : "memory");
    asm volatile("global_load_dwordx4 %0, %1, off" : "+v"(r2) : "v"((const unsigned char*)(sp0 + ((size_t)(n + 0) * 56 + 2) * 1024) + voff) : "memory");
    asm volatile("global_load_dwordx4 %0, %1, off" : "+v"(r3) : "v"((const unsigned char*)(sp0 + ((size_t)(n + 0) * 56 + 3) * 1024) + voff) : "memory");
    asm volatile("global_load_dwordx4 %0, %1, off" : "+v"(r4) : "v"((const unsigned char*)(sp0 + ((size_t)(n + 0) * 56 + 4) * 1024) + voff) : "memory");
    asm volatile("global_load_dwordx4 %0, %1, off" : "+v"(r5) : "v"((const unsigned char*)(sp0 + ((size_t)(n + 0) * 56 + 5) * 1024) + voff) : "memory");
    asm volatile("global_load_dwordx4 %0, %1, off" : "+v"(r6) : "v"((const unsigned char*)(sp0 + ((size_t)(n + 0) * 56 + 6) * 1024) + voff) : "memory");
    asm volatile("global_load_dwordx4 %0, %1, off" : "+v"(r7) : "v"((const unsigned char*)(sp0 + ((size_t)(n + 0) * 56 + 7) * 1024) + voff) : "memory");
    asm volatile("global_load_dwordx4 %0, %1, off" : "+v"(r8) : "v"((const unsigned char*)(sp0 + ((size_t)(n + 0) * 56 + 8) * 1024) + voff) : "memory");
    asm volatile("global_load_dwordx4 %0, %1, off" : "+v"(r9) : "v"((const unsigned char*)(sp0 + ((size_t)(n + 0) * 56 + 9) * 1024) + voff) : "memory");
    asm volatile("global_load_dwordx4 %0, %1, off" : "+v"(r10) : "v"((const unsigned char*)(sp0 + ((size_t)(n + 0) * 56 + 10) * 1024) + voff) : "memory");
    asm volatile("global_load_dwordx4 %0, %1, off" : "+v"(r11) : "v"((const unsigned char*)(sp0 + ((size_t)(n + 0) * 56 + 11) * 1024) + voff) : "memory");
    asm volatile("global_load_dwordx4 %0, %1, off" : "+v"(r12) : "v"((const unsigned char*)(sp0 + ((size_t)(n + 0) * 56 + 12) * 1024) + voff) : "memory");
    asm volatile("global_load_dwordx4 %0, %1, off" : "+v"(r13) : "v"((const unsigned char*)(sp0 + ((size_t)(n + 0) * 56 + 13) * 1024) + voff) : "memory");
    asm volatile("global_load_dwordx4 %0, %1, off" : "+v"(r14) : "v"((const unsigned char*)(sp0 + ((size_t)(n + 0) * 56 + 14) * 1024) + voff) : "memory");
    asm volatile("global_load_dwordx4 %0, %1, off" : "+v"(r15) : "v"((const unsigned char*)(sp0 + ((size_t)(n + 0) * 56 + 15) * 1024) + voff) : "memory");
    }
#pragma unroll 1
    for (int n = 0; n < NCH; ++n) {
        const int nn = n + 1 < NCH ? n + 1 : n;
        f32x4 a0_0, a0_1, a0_2, a0_3;
        f32x4 a1_0, a1_1, a1_2, a1_3;
        asm volatile("s_waitcnt vmcnt(16)" : "+v"(un0_0), "+v"(un0_1), "+v"(un1_0), "+v"(un1_1), "+v"(decv));
        a0_0 = (f32x4){bflo(un0_0.x), bfhi(un0_0.x), bflo(un0_0.y), bfhi(un0_0.y)}; a0_1 = (f32x4){bflo(un0_0.z), bfhi(un0_0.z), bflo(un0_0.w), bfhi(un0_0.w)};
        a0_2 = (f32x4){bflo(un0_1.x), bfhi(un0_1.x), bflo(un0_1.y), bfhi(un0_1.y)}; a0_3 = (f32x4){bflo(un0_1.z), bfhi(un0_1.z), bflo(un0_1.w), bfhi(un0_1.w)};
        a1_0 = (f32x4){bflo(un1_0.x), bfhi(un1_0.x), bflo(un1_0.y), bfhi(un1_0.y)}; a1_1 = (f32x4){bflo(un1_0.z), bfhi(un1_0.z), bflo(un1_0.w), bfhi(un1_0.w)};
        a1_2 = (f32x4){bflo(un1_1.x), bfhi(un1_1.x), bflo(un1_1.y), bfhi(un1_1.y)}; a1_3 = (f32x4){bflo(un1_1.z), bfhi(un1_1.z), bflo(un1_1.w), bfhi(un1_1.w)};
        const float dec = decv;
        { const unsigned char* ubn = ubp + (size_t)nn * 32768;
          asm volatile("global_load_dwordx4 %0, %1, off" : "+v"(un0_0) : "v"((const unsigned char*)(ubn + 0 * 2048) + uoff) : "memory");
          asm volatile("global_load_dwordx4 %0, %1, off offset:16" : "+v"(un0_1) : "v"((const unsigned char*)(ubn + 0 * 2048) + uoff) : "memory");
          asm volatile("global_load_dwordx4 %0, %1, off" : "+v"(un1_0) : "v"((const unsigned char*)(ubn + 1 * 2048) + uoff) : "memory");
          asm volatile("global_load_dwordx4 %0, %1, off offset:16" : "+v"(un1_1) : "v"((const unsigned char*)(ubn + 1 * 2048) + uoff) : "memory");
          asm volatile("global_load_dword %0, %1, off" : "+v"(decv) : "v"((const unsigned char*)(decp + nn) + zoff) : "memory"); }
        __builtin_amdgcn_sched_barrier(0);
        asm volatile("s_waitcnt vmcnt(20)" : "+v"(r0));
        a0_0 = mfma16(r0, Sp0_0, a0_0);
        a1_0 = mfma16(r0, Sp1_0, a1_0);
        asm volatile("global_load_dwordx4 %0, %1, off" : "+v"(r0) : "v"((const unsigned char*)(sp0 + ((size_t)(n + 0) * 56 + 40) * 1024) + voff) : "memory");
        __builtin_amdgcn_sched_barrier(0);
        asm volatile("s_waitcnt vmcnt(20)" : "+v"(r1));
        a0_0 = mfma16(r1, Sp0_1, a0_0);
        a1_0 = mfma16(r1, Sp1_1, a1_0);
        asm volatile("global_load_dwordx4 %0, %1, off" : "+v"(r1) : "v"((const unsigned char*)(sp0 + ((size_t)(n + 0) * 56 + 41) * 1024) + voff) : "memory");
        __builtin_amdgcn_sched_barrier(0);
        asm volatile("s_waitcnt vmcnt(20)" : "+v"(r2));
        a0_0 = mfma16(r2, Sp0_2, a0_0);
        a1_0 = mfma16(r2, Sp1_2, a1_0);
        asm volatile("global_load_dwordx4 %0, %1, off" : "+v"(r2) : "v"((const unsigned char*)(sp0 + ((size_t)(n + 0) * 56 + 42) * 1024) + voff) : "memory");
        __builtin_amdgcn_sched_barrier(0);
        asm volatile("s_waitcnt vmcnt(20)" : "+v"(r3));
        a0_0 = mfma16(r3, Sp0_3, a0_0);
        a1_0 = mfma16(r3, Sp1_3, a1_0);
        asm volatile("global_load_dwordx4 %0, %1, off" : "+v"(r3) : "v"((const unsigned char*)(sp0 + ((size_t)(n + 0) * 56 + 43) * 1024) + voff) : "memory");
        __builtin_amdgcn_sched_barrier(0);
        asm volatile("s_waitcnt vmcnt(20)" : "+v"(r4));
        a0_1 = mfma16(r4, Sp0_0, a0_1);
        a1_1 = mfma16(r4, Sp1_0, a1_1);
        asm volatile("global_load_dwordx4 %0, %1, off" : "+v"(r4) : "v"((const unsigned char*)(sp0 + ((size_t)(n + 0) * 56 + 44) * 1024) + voff) : "memory");
        __builtin_amdgcn_sched_barrier(0);
        asm volatile("s_waitcnt vmcnt(20)" : "+v"(r5));
        a0_1 = mfma16(r5, Sp0_1, a0_1);
        a1_1 = mfma16(r5, Sp1_1, a1_1);
        asm volatile("global_load_dwordx4 %0, %1, off" : "+v"(r5) : "v"((const unsigned char*)(sp0 + ((size_t)(n + 0) * 56 + 45) * 1024) + voff) : "memory");
        __builtin_amdgcn_sched_barrier(0);
        asm volatile("s_waitcnt vmcnt(20)" : "+v"(r6));
        a0_1 = mfma16(r6, Sp0_2, a0_1);
        a1_1 = mfma16(r6, Sp1_2, a1_1);
        asm volatile("global_load_dwordx4 %0, %1, off" : "+v"(r6) : "v"((const unsigned char*)(sp0 + ((size_t)(n + 0) * 56 + 46) * 1024) + voff) : "memory");
        __builtin_amdgcn_sched_barrier(0);
        asm volatile("s_waitcnt vmcnt(20)" : "+v"(r7));
        a0_1 = mfma16(r7, Sp0_3, a0_1);
        a1_1 = mfma16(r7, Sp1_3, a1_1);
        asm volatile("global_load_dwordx4 %0, %1, off" : "+v"(r7) : "v"((const unsigned char*)(sp0 + ((size_t)(n + 0) * 56 + 47) * 1024) + voff) : "memory");
        __builtin_amdgcn_sched_barrier(0);
        asm volatile("s_waitcnt vmcnt(20)" : "+v"(r8));
        a0_2 = mfma16(r8, Sp0_0, a0_2);
        a1_2 = mfma16(r8, Sp1_0, a1_2);
        asm volatile("global_load_dwordx4 %0, %1, off" : "+v"(r8) : "v"((const unsigned char*)(sp0 + ((size_t)(n + 0) * 56 + 48) * 1024) + voff) : "memory");
        __builtin_amdgcn_sched_barrier(0);
        asm volatile("s_waitcnt vmcnt(20)" : "+v"(r9));
        a0_2 = mfma16(r9, Sp0_1, a0_2);
        a1_2 = mfma16(r9, Sp1_1, a1_2);
        asm volatile("global_load_dwordx4 %0, %1, off" : "+v"(r9) : "v"((const unsigned char*)(sp0 + ((size_t)(n + 0) * 56 + 49) * 1024) + voff) : "memory");
        __builtin_amdgcn_sched_barrier(0);
        asm volatile("s_waitcnt vmcnt(20)" : "+v"(r10));
        a0_2 = mfma16(r10, Sp0_2, a0_2);
        a1_2 = mfma16(r10, Sp1_2, a1_2);
        asm volatile("global_load_dwordx4 %0, %1, off" : "+v"(r10) : "v"((const unsigned char*)(sp0 + ((size_t)(n + 0) * 56 + 50) * 1024) + voff) : "memory");
        __builtin_amdgcn_sched_barrier(0);
        asm volatile("s_waitcnt vmcnt(20)" : "+v"(r11));
        a0_2 = mfma16(r11, Sp0_3, a0_2);
        a1_2 = mfma16(r11, Sp1_3, a1_2);
        asm volatile("global_load_dwordx4 %0, %1, off" : "+v"(r11) : "v"((const unsigned char*)(sp0 + ((size_t)(n + 0) * 56 + 51) * 1024) + voff) : "memory");
        __builtin_amdgcn_sched_barrier(0);
        asm volatile("s_waitcnt vmcnt(20)" : "+v"(r12));
        a0_3 = mfma16(r12, Sp0_0, a0_3);
        a1_3 = mfma16(r12, Sp1_0, a1_3);
        asm volatile("global_load_dwordx4 %0, %1, off" : "+v"(r12) : "v"((const unsigned char*)(sp0 + ((size_t)(n + 0) * 56 + 52) * 1024) + voff) : "memory");
        __builtin_amdgcn_sched_barrier(0);
        asm volatile("s_waitcnt vmcnt(20)" : "+v"(r13));
        a0_3 = mfma16(r13, Sp0_1, a0_3);
        a1_3 = mfma16(r13, Sp1_1, a1_3);
        asm volatile("global_load_dwordx4 %0, %1, off" : "+v"(r13) : "v"((const unsigned char*)(sp0 + ((size_t)(n + 0) * 56 + 53) * 1024) + voff) : "memory");
        __builtin_amdgcn_sched_barrier(0);
        asm volatile("s_waitcnt vmcnt(20)" : "+v"(r14));
        a0_3 = mfma16(r14, Sp0_2, a0_3);
        a1_3 = mfma16(r14, Sp1_2, a1_3);
        asm volatile("global_load_dwordx4 %0, %1, off" : "+v"(r14) : "v"((const unsigned char*)(sp0 + ((size_t)(n + 0) * 56 + 54) * 1024) + voff) : "memory");
        __builtin_amdgcn_sched_barrier(0);
        asm volatile("s_waitcnt vmcnt(20)" : "+v"(r15));
        a0_3 = mfma16(r15, Sp0_3, a0_3);
        a1_3 = mfma16(r15, Sp1_3, a1_3);
        asm volatile("global_load_dwordx4 %0, %1, off" : "+v"(r15) : "v"((const unsigned char*)(sp0 + ((size_t)(n + 0) * 56 + 55) * 1024) + voff) : "memory");
        __builtin_amdgcn_sched_barrier(0);
        bf16x8 vp0_0, vp0_1;
        { u32x4 w; w.x = cvt_pk_bf16(a0_0[0], a0_0[1]); w.y = cvt_pk_bf16(a0_0[2], a0_0[3]); w.z = cvt_pk_bf16(a0_1[0], a0_1[1]); w.w = cvt_pk_bf16(a0_1[2], a0_1[3]); vp0_0 = __builtin_bit_cast(bf16x8, w); }
        { u32x4 w; w.x = cvt_pk_bf16(a0_2[0], a0_2[1]); w.y = cvt_pk_bf16(a0_2[2], a0_2[3]); w.z = cvt_pk_bf16(a0_3[0], a0_3[1]); w.w = cvt_pk_bf16(a0_3[2], a0_3[3]); vp0_1 = __builtin_bit_cast(bf16x8, w); }
        bf16x8 vp1_0, vp1_1;
        { u32x4 w; w.x = cvt_pk_bf16(a1_0[0], a1_0[1]); w.y = cvt_pk_bf16(a1_0[2], a1_0[3]); w.z = cvt_pk_bf16(a1_1[0], a1_1[1]); w.w = cvt_pk_bf16(a1_1[2], a1_1[3]); vp1_0 = __builtin_bit_cast(bf16x8, w); }
        { u32x4 w; w.x = cvt_pk_bf16(a1_2[0], a1_2[1]); w.y = cvt_pk_bf16(a1_2[2], a1_2[3]); w.z = cvt_pk_bf16(a1_3[0], a1_3[1]); w.w = cvt_pk_bf16(a1_3[2], a1_3[3]); vp1_1 = __builtin_bit_cast(bf16x8, w); }
        { unsigned sp_ = 0; while (*(volatile LAS unsigned*)(xl + XL_CNT + 64) + 2u <= (unsigned)n) { __builtin_amdgcn_s_sleep(1); if (++sp_ > (1u << 22)) break; } }
        { LAS bf16x8* sl_ = (LAS bf16x8*)(xl + (n & 1) * XL_SLOT) + lane; sl_[0] = Sp0_0; sl_[64] = Sp0_1; sl_[128] = Sp0_2; sl_[192] = Sp0_3; sl_[256] = vp0_0; sl_[320] = vp0_1; sl_[384] = Sp1_0; sl_[448] = Sp1_1; sl_[512] = Sp1_2; sl_[576] = Sp1_3; sl_[640] = vp1_0; sl_[704] = vp1_1; }
        asm volatile("s_waitcnt lgkmcnt(0)" ::: "memory");
        if (lane == 0) *(volatile LAS unsigned*)(xl + XL_CNT) = (unsigned)(n + 1);
        S0_0 = S0_0 * dec;
        S1_0 = S1_0 * dec;
        asm volatile("s_waitcnt vmcnt(15)" : "+v"(r0));
        S0_0 = mfma16(r0, vp0_0, S0_0);
        S1_0 = mfma16(r0, vp1_0, S1_0);
        asm volatile("global_load_dwordx4 %0, %1, off" : "+v"(r0) : "v"((const unsigned char*)(sp0 + ((size_t)(n + 1) * 56 + 0) * 1024) + voff) : "memory");
        __builtin_amdgcn_sched_barrier(0);
        asm volatile("s_waitcnt vmcnt(15)" : "+v"(r1));
        S0_0 = mfma16(r1, vp0_1, S0_0);
        S1_0 = mfma16(r1, vp1_1, S1_0);
        asm volatile("global_load_dwordx4 %0, %1, off" : "+v"(r1) : "v"((const unsigned char*)(sp0 + ((size_t)(n + 1) * 56 + 1) * 1024) + voff) : "memory");
        __builtin_amdgcn_sched_barrier(0);
        S0_1 = S0_1 * dec;
        S1_1 = S1_1 * dec;
        asm volatile("s_waitcnt vmcnt(15)" : "+v"(r2));
        S0_1 = mfma16(r2, vp0_0, S0_1);
        S1_1 = mfma16(r2, vp1_0, S1_1);
        asm volatile("global_load_dwordx4 %0, %1, off" : "+v"(r2) : "v"((const unsigned char*)(sp0 + ((size_t)(n + 1) * 56 + 2) * 1024) + voff) : "memory");
        __builtin_amdgcn_sched_barrier(0);
        asm volatile("s_waitcnt vmcnt(15)" : "+v"(r3));
        S0_1 = mfma16(r3, vp0_1, S0_1);
        S1_1 = mfma16(r3, vp1_1, S1_1);
        asm volatile("global_load_dwordx4 %0, %1, off" : "+v"(r3) : "v"((const unsigned char*)(sp0 + ((size_t)(n + 1) * 56 + 3) * 1024) + voff) : "memory");
        __builtin_amdgcn_sched_barrier(0);
        S0_2 = S0_2 * dec;
        S1_2 = S1_2 * dec;
        asm volatile("s_waitcnt vmcnt(15)" : "+v"(r4));
        S0_2 = mfma16(r4, vp0_0, S0_2);
        S1_2 = mfma16(r4, vp1_0, S1_2);
        asm volatile("global_load_dwordx4 %0, %1, off" : "+v"(r4) : "v"((const unsigned char*)(sp0 + ((size_t)(n + 1) * 56 + 4) * 1024) + voff) : "memory");
        __builtin_amdgcn_sched_barrier(0);
        asm volatile("s_waitcnt vmcnt(15)" : "+v"(r5));
        S0_2 = mfma16(r5, vp0_1, S0_2);
        S1_2 = mfma16(r5, vp1_1, S1_2);
        asm volatile("global_load_dwordx4 %0, %1, off" : "+v"(r5) : "v"((const unsigned char*)(sp0 + ((size_t)(n + 1) * 56 + 5) * 1024) + voff) : "memory");
        __builtin_amdgcn_sched_barrier(0);
        S0_3 = S0_3 * dec;
        S1_3 = S1_3 * dec;
        asm volatile("s_waitcnt vmcnt(15)" : "+v"(r6));
        S0_3 = mfma16(r6, vp0_0, S0_3);
        S1_3 = mfma16(r6, vp1_0, S1_3);
        asm volatile("global_load_dwordx4 %0, %1, off" : "+v"(r6) : "v"((const unsigned char*)(sp0 + ((size_t)(n + 1) * 56 + 6) * 1024) + voff) : "memory");
        __builtin_amdgcn_sched_barrier(0);
        asm volatile("s_waitcnt vmcnt(15)" : "+v"(r7));
        S0_3 = mfma16(r7, vp0_1, S0_3);
        S1_3 = mfma16(r7, vp1_1, S1_3);
        asm volatile("global_load_dwordx4 %0, %1, off" : "+v"(r7) : "v"((const unsigned char*)(sp0 + ((size_t)(n + 1) * 56 + 7) * 1024) + voff) : "memory");
        __builtin_amdgcn_sched_barrier(0);
        S0_4 = S0_4 * dec;
        S1_4 = S1_4 * dec;
        asm volatile("s_waitcnt vmcnt(15)" : "+v"(r8));
        S0_4 = mfma16(r8, vp0_0, S0_4);
        S1_4 = mfma16(r8, vp1_0, S1_4);
        asm volatile("global_load_dwordx4 %0, %1, off" : "+v"(r8) : "v"((const unsigned char*)(sp0 + ((size_t)(n + 1) * 56 + 8) * 1024) + voff) : "memory");
        __builtin_amdgcn_sched_barrier(0);
        asm volatile("s_waitcnt vmcnt(15)" : "+v"(r9));
        S0_4 = mfma16(r9, vp0_1, S0_4);
        S1_4 = mfma16(r9, vp1_1, S1_4);
        asm volatile("global_load_dwordx4 %0, %1, off" : "+v"(r9) : "v"((const unsigned char*)(sp0 + ((size_t)(n + 1) * 56 + 9) * 1024) + voff) : "memory");
        __builtin_amdgcn_sched_barrier(0);
        S0_5 = S0_5 * dec;
        S1_5 = S1_5 * dec;
        asm volatile("s_waitcnt vmcnt(15)" : "+v"(r10));
        S0_5 = mfma16(r10, vp0_0, S0_5);
        S1_5 = mfma16(r10, vp1_0, S1_5);
        asm volatile("global_load_dwordx4 %0, %1, off" : "+v"(r10) : "v"((const unsigned char*)(sp0 + ((size_t)(n + 1) * 56 + 10) * 1024) + voff) : "memory");
        __builtin_amdgcn_sched_barrier(0);
        asm volatile("s_waitcnt vmcnt(15)" : "+v"(r11));
        S0_5 = mfma16(r11, vp0_1, S0_5);
        S1_5 = mfma16(r11, vp1_1, S1_5);
        asm volatile("global_load_dwordx4 %0, %1, off" : "+v"(r11) : "v"((const unsigned char*)(sp0 + ((size_t)(n + 1) * 56 + 11) * 1024) + voff) : "memory");
        __builtin_amdgcn_sched_barrier(0);
        S0_6 = S0_6 * dec;
        S1_6 = S1_6 * dec;
        asm volatile("s_waitcnt vmcnt(15)" : "+v"(r12));
        S0_6 = mfma16(r12, vp0_0, S0_6);
        S1_6 = mfma16(r12, vp1_0, S1_6);
        asm volatile("global_load_dwordx4 %0, %1, off" : "+v"(r12) : "v"((const unsigned char*)(sp0 + ((size_t)(n + 1) * 56 + 12) * 1024) + voff) : "memory");
        __builtin_amdgcn_sched_barrier(0);
        asm volatile("s_waitcnt vmcnt(15)" : "+v"(r13));
        S0_6 = mfma16(r13, vp0_1, S0_6);
        S1_6 = mfma16(r13, vp1_1, S1_6);
        asm volatile("global_load_dwordx4 %0, %1, off" : "+v"(r13) : "v"((const unsigned char*)(sp0 + ((size_t)(n + 1) * 56 + 13) * 1024) + voff) : "memory");
        __builtin_amdgcn_sched_barrier(0);
        S0_7 = S0_7 * dec;
        S1_7 = S1_7 * dec;
        asm volatile("s_waitcnt vmcnt(15)" : "+v"(r14));
        S0_7 = mfma16(r14, vp0_0, S0_7);
        S1_7 = mfma16(r14, vp1_0, S1_7);
        asm volatile("global_load_dwordx4 %0, %1, off" : "+v"(r14) : "v"((const unsigned char*)(sp0 + ((size_t)(n + 1) * 56 + 14) * 1024) + voff) : "memory");
        __builtin_amdgcn_sched_barrier(0);
        asm volatile("s_waitcnt vmcnt(15)" : "+v"(r15));
        S0_7 = mfma16(r15, vp0_1, S0_7);
        S1_7 = mfma16(r15, vp1_1, S1_7);
        asm volatile("global_load_dwordx4 %0, %1, off" : "+v"(r15) : "v"((const unsigned char*)(sp0 + ((size_t)(n + 1) * 56 + 15) * 1024) + voff) : "memory");
        __builtin_amdgcn_sched_barrier(0);
        { u32x4 w; w.x = cvt_pk_bf16(S0_0[0], S0_0[1]); w.y = cvt_pk_bf16(S0_0[2], S0_0[3]); w.z = cvt_pk_bf16(S0_1[0], S0_1[1]); w.w = cvt_pk_bf16(S0_1[2], S0_1[3]); Sp0_0 = __builtin_bit_cast(bf16x8, w); }
        { u32x4 w; w.x = cvt_pk_bf16(S0_2[0], S0_2[1]); w.y = cvt_pk_bf16(S0_2[2], S0_2[3]); w.z = cvt_pk_bf16(S0_3[0], S0_3[1]); w.w = cvt_pk_bf16(S0_3[2], S0_3[3]); Sp0_1 = __builtin_bit_cast(bf16x8, w); }
        { u32x4 w; w.x = cvt_pk_bf16(S0_4[0], S0_4[1]); w.y = cvt_pk_bf16(S0_4[2], S0_4[3]); w.z = cvt_pk_bf16(S0_5[0], S0_5[1]); w.w = cvt_pk_bf16(S0_5[2], S0_5[3]); Sp0_2 = __builtin_bit_cast(bf16x8, w); }
        { u32x4 w; w.x = cvt_pk_bf16(S0_6[0], S0_6[1]); w.y = cvt_pk_bf16(S0_6[2], S0_6[3]); w.z = cvt_pk_bf16(S0_7[0], S0_7[1]); w.w = cvt_pk_bf16(S0_7[2], S0_7[3]); Sp0_3 = __builtin_bit_cast(bf16x8, w); }
        { u32x4 w; w.x = cvt_pk_bf16(S1_0[0], S1_0[1]); w.y = cvt_pk_bf16(S1_0[2], S1_0[3]); w.z = cvt_pk_bf16(S1_1[0], S1_1[1]); w.w = cvt_pk_bf16(S1_1[2], S1_1[3]); Sp1_0 = __builtin_bit_cast(bf16x8, w); }
        { u32x4 w; w.x = cvt_pk_bf16(S1_2[0], S1_2[1]); w.y = cvt_pk_bf16(S1_2[2], S1_2[3]); w.z = cvt_pk_bf16(S1_3[0], S1_3[1]); w.w = cvt_pk_bf16(S1_3[2], S1_3[3]); Sp1_1 = __builtin_bit_cast(bf16x8, w); }
        { u32x4 w; w.x = cvt_pk_bf16(S1_4[0], S1_4[1]); w.y = cvt_pk_bf16(S1_4[2], S1_4[3]); w.z = cvt_pk_bf16(S1_5[0], S1_5[1]); w.w = cvt_pk_bf16(S1_5[2], S1_5[3]); Sp1_2 = __builtin_bit_cast(bf16x8, w); }
        { u32x4 w; w.x = cvt_pk_bf16(S1_6[0], S1_6[1]); w.y = cvt_pk_bf16(S1_6[2], S1_6[3]); w.z = cvt_pk_bf16(S1_7[0], S1_7[1]); w.w = cvt_pk_bf16(S1_7[2], S1_7[3]); Sp1_3 = __builtin_bit_cast(bf16x8, w); }
    }
    asm volatile("s_waitcnt vmcnt(0)" ::: "memory");
    } else if constexpr (GDN && ROLE == 1) {
    bf16x8 r0 = (bf16x8){0, 0, 0, 0, 0, 0, 0, 0};
    bf16x8 r1 = (bf16x8){0, 0, 0, 0, 0, 0, 0, 0};
    bf16x8 r2 = (bf16x8){0, 0, 0, 0, 0, 0, 0, 0};
    bf16x8 r3 = (bf16x8){0, 0, 0, 0, 0, 0, 0, 0};
    bf16x8 r4 = (bf16x8){0, 0, 0, 0, 0, 0, 0, 0};
    bf16x8 r5 = (bf16x8){0, 0, 0, 0, 0, 0, 0, 0};
    bf16x8 r6 = (bf16x8){0, 0, 0, 0, 0, 0, 0, 0};
    bf16x8 r7 = (bf16x8){0, 0, 0, 0, 0, 0, 0, 0};
    bf16x8 r8 = (bf16x8){0, 0, 0, 0, 0, 0, 0, 0};
    bf16x8 r9 = (bf16x8){0, 0, 0, 0, 0, 0, 0, 0};
    bf16x8 r10 = (bf16x8){0, 0, 0, 0, 0, 0, 0, 0};
    bf16x8 r11 = (bf16x8){0, 0, 0, 0, 0, 0, 0, 0};
    bf16x8 r12 = (bf16x8){0, 0, 0, 0, 0, 0, 0, 0};
    bf16x8 r13 = (bf16x8){0, 0, 0, 0, 0, 0, 0, 0};
    bf16x8 r14 = (bf16x8){0, 0, 0, 0, 0, 0, 0, 0};
    bf16x8 r15 = (bf16x8){0, 0, 0, 0, 0, 0, 0, 0};
    bf16x8 r16 = (bf16x8){0, 0, 0, 0, 0, 0, 0, 0};
    bf16x8 r17 = (bf16x8){0, 0, 0, 0, 0, 0, 0, 0};
    bf16x8 r18 = (bf16x8){0, 0, 0, 0, 0, 0, 0, 0};
    bf16x8 r19 = (bf16x8){0, 0, 0, 0, 0, 0, 0, 0};
    bf16x8 r20 = (bf16x8){0, 0, 0, 0, 0, 0, 0, 0};
    bf16x8 r21 = (bf16x8){0, 0, 0, 0, 0, 0, 0, 0};
    bf16x8 r22 = (bf16x8){0, 0, 0, 0, 0, 0, 0, 0};
    bf16x8 r23 = (bf16x8){0, 0, 0, 0, 0, 0, 0, 0};
    asm volatile("global_load_dwordx4 %0, %1, off" : "+v"(r0) : "v"((const unsigned char*)(sp0 + ((size_t)(0 + 0) * 56 + 16) * 1024) + voff) : "memory");
    asm volatile("global_load_dwordx4 %0, %1, off" : "+v"(r1) : "v"((const unsigned char*)(sp0 + ((size_t)(0 + 0) * 56 + 17) * 1024) + voff) : "memory");
    asm volatile("global_load_dwordx4 %0, %1, off" : "+v"(r2) : "v"((const unsigned char*)(sp0 + ((size_t)(0 + 0) * 56 + 18) * 1024) + voff) : "memory");
    asm volatile("global_load_dwordx4 %0, %1, off" : "+v"(r3) : "v"((const unsigned char*)(sp0 + ((size_t)(0 + 0) * 56 + 19) * 1024) + voff) : "memory");
    asm volatile("global_load_dwordx4 %0, %1, off" : "+v"(r4) : "v"((const unsigned char*)(sp0 + ((size_t)(0 + 0) * 56 + 20) * 1024) + voff) : "memory");
    asm volatile("global_load_dwordx4 %0, %1, off" : "+v"(r5) : "v"((const unsigned char*)(sp0 + ((size_t)(0 + 0) * 56 + 21) * 1024) + voff) : "memory");
    asm volatile("global_load_dwordx4 %0, %1, off" : "+v"(r6) : "v"((const unsigned char*)(sp0 + ((size_t)(0 + 0) * 56 + 22) * 1024) + voff) : "memory");
    asm volatile("global_load_dwordx4 %0, %1, off" : "+v"(r7) : "v"((const unsigned char*)(sp0 + ((size_t)(0 + 0) * 56 + 23) * 1024) + voff) : "memory");
    asm volatile("global_load_dwordx4 %0, %1, off" : "+v"(r8) : "v"((const unsigned char*)(sp0 + ((size_t)(0 + 0) * 56 + 24) * 1024) + voff) : "memory");
    asm volatile("global_load_dwordx4 %0, %1, off" : "+v"(r9) : "v"((const unsigned char*)(sp0 + ((size_t)(0 + 0) * 56 + 25) * 1024) + voff) : "memory");
    asm volatile("global_load_dwordx4 %0, %1, off" : "+v"(r10) : "v"((const unsigned char*)(sp0 + ((size_t)(0 + 0) * 56 + 26) * 1024) + voff) : "memory");
    asm volatile("global_load_dwordx4 %0, %1, off" : "+v"(r11) : "v"((const unsigned char*)(sp0 + ((size_t)(0 + 0) * 56 + 27) * 1024) + voff) : "memory");
    asm volatile("global_load_dwordx4 %0, %1, off" : "+v"(r12) : "v"((const unsigned char*)(sp0 + ((size_t)(0 + 0) * 56 + 28) * 1024) + voff) : "memory");
    asm volatile("global_load_dwordx4 %0, %1, off" : "+v"(r13) : "v"((const unsigned char*)(sp0 + ((size_t)(0 + 0) * 56 + 29) * 1024) + voff) : "memory");
    asm volatile("global_load_dwordx4 %0, %1, off" : "+v"(r14) : "v"((const unsigned char*)(sp0 + ((size_t)(0 + 0) * 56 + 30) * 1024) + voff) : "memory");
    asm volatile("global_load_dwordx4 %0, %1, off" : "+v"(r15) : "v"((const unsigned char*)(sp0 + ((size_t)(0 + 0) * 56 + 31) * 1024) + voff) : "memory");
    asm volatile("global_load_dwordx4 %0, %1, off" : "+v"(r16) : "v"((const unsigned char*)(sp0 + ((size_t)(0 + 0) * 56 + 32) * 1024) + voff) : "memory");
    asm volatile("global_load_dwordx4 %0, %1, off" : "+v"(r17) : "v"((const unsigned char*)(sp0 + ((size_t)(0 + 0) * 56 + 33) * 1024) + voff) : "memory");
    asm volatile("global_load_dwordx4 %0, %1, off" : "+v"(r18) : "v"((const unsigned char*)(sp0 + ((size_t)(0 + 0) * 56 + 34) * 1024) + voff) : "memory");
    asm volatile("global_load_dwordx4 %0, %1, off" : "+v"(r19) : "v"((const unsigned char*)(sp0 + ((size_t)(0 + 0) * 56 + 35) * 1024) + voff) : "memory");
    asm volatile("global_load_dwordx4 %0, %1, off" : "+v"(r20) : "v"((const unsigned char*)(sp0 + ((size_t)(0 + 0) * 56 + 36) * 1024) + voff) : "memory");
    asm volatile("global_load_dwordx4 %0, %1, off" : "+v"(r21) : "v"((const unsigned char*)(sp0 + ((size_t)(0 + 0) * 56 + 37) * 1024) + voff) : "memory");
    asm volatile("global_load_dwordx4 %0, %1, off" : "+v"(r22) : "v"((const unsigned char*)(sp0 + ((size_t)(0 + 0) * 56 + 38) * 1024) + voff) : "memory");
    asm volatile("global_load_dwordx4 %0, %1, off" : "+v"(r23) : "v"((const unsigned char*)(sp0 + ((size_t)(0 + 0) * 56 + 39) * 1024) + voff) : "memory");
    { unsigned z = 0u;
      asm volatile("global_store_short %0, %1, off" :: "v"((const unsigned char*)(obu + (size_t)(0) * orow + 0) + ooff), "v"(z) : "memory");
      asm volatile("global_store_short %0, %1, off" :: "v"((const unsigned char*)(obu + (size_t)(1) * orow + 0) + ooff), "v"(z) : "memory");
      asm volatile("global_store_short %0, %1, off" :: "v"((const unsigned char*)(obu + (size_t)(2) * orow + 0) + ooff), "v"(z) : "memory");
      asm volatile("global_store_short %0, %1, off" :: "v"((const unsigned char*)(obu + (size_t)(3) * orow + 0) + ooff), "v"(z) : "memory");
      asm volatile("global_store_short %0, %1, off" :: "v"((const unsigned char*)(obu + (size_t)(16) * orow + 0) + ooff), "v"(z) : "memory");
      asm volatile("global_store_short %0, %1, off" :: "v"((const unsigned char*)(obu + (size_t)(17) * orow + 0) + ooff), "v"(z) : "memory");
      asm volatile("global_store_short %0, %1, off" :: "v"((const unsigned char*)(obu + (size_t)(18) * orow + 0) + ooff), "v"(z) : "memory");
      asm volatile("global_store_short %0, %1, off" :: "v"((const unsigned char*)(obu + (size_t)(19) * orow + 0) + ooff), "v"(z) : "memory");
      asm volatile("global_store_short %0, %1, off" :: "v"((const unsigned char*)(obu + (size_t)(32) * orow + 0) + ooff), "v"(z) : "memory");
      asm volatile("global_store_short %0, %1, off" :: "v"((const unsigned char*)(obu + (size_t)(33) * orow + 0) + ooff), "v"(z) : "memory");
      asm volatile("global_store_short %0, %1, off" :: "v"((const unsigned char*)(obu + (size_t)(34) * orow + 0) + ooff), "v"(z) : "memory");
      asm volatile("global_store_short %0, %1, off" :: "v"((const unsigned char*)(obu + (size_t)(35) * orow + 0) + ooff), "v"(z) : "memory");
      asm volatile("global_store_short %0, %1, off" :: "v"((const unsigned char*)(obu + (size_t)(48) * orow + 0) + ooff), "v"(z) : "memory");
      asm volatile("global_store_short %0, %1, off" :: "v"((const unsigned char*)(obu + (size_t)(49) * orow + 0) + ooff), "v"(z) : "memory");
      asm volatile("global_store_short %0, %1, off" :: "v"((const unsigned char*)(obu + (size_t)(50) * orow + 0) + ooff), "v"(z) : "memory");
      asm volatile("global_store_short %0, %1, off" :: "v"((const unsigned char*)(obu + (size_t)(51) * orow + 0) + ooff), "v"(z) : "memory");
      asm volatile("global_store_short %0, %1, off" :: "v"((const unsigned char*)(obu + (size_t)(0) * orow + 32) + ooff), "v"(z) : "memory");
      asm volatile("global_store_short %0, %1, off" :: "v"((const unsigned char*)(obu + (size_t)(1) * orow + 32) + ooff), "v"(z) : "memory");
      asm volatile("global_store_short %0, %1, off" :: "v"((const unsigned char*)(obu + (size_t)(2) * orow + 32) + ooff), "v"(z) : "memory");
      asm volatile("global_store_short %0, %1, off" :: "v"((const unsigned char*)(obu + (size_t)(3) * orow + 32) + ooff), "v"(z) : "memory");
      asm volatile("global_store_short %0, %1, off" :: "v"((const unsigned char*)(obu + (size_t)(16) * orow + 32) + ooff), "v"(z) : "memory");
      asm volatile("global_store_short %0, %1, off" :: "v"((const unsigned char*)(obu + (size_t)(17) * orow + 32) + ooff), "v"(z) : "memory");
      asm volatile("global_store_short %0, %1, off" :: "v"((const unsigned char*)(obu + (size_t)(18) * orow + 32) + ooff), "v"(z) : "memory");
      asm volatile("global_store_short %0, %1, off" :: "v"((const unsigned char*)(obu + (size_t)(19) * orow + 32) + ooff), "v"(z) : "memory");
      asm volatile("global_store_short %0, %1, off" :: "v"((const unsigned char*)(obu + (size_t)(32) * orow + 32) + ooff), "v"(z) : "memory");
      asm volatile("global_store_short %0, %1, off" :: "v"((const unsigned char*)(obu + (size_t)(33) * orow + 32) + ooff), "v"(z) : "memory");
      asm volatile("global_store_short %0, %1, off" :: "v"((const unsigned char*)(obu + (size_t)(34) * orow + 32) + ooff), "v"(z) : "memory");
      asm volatile("global_store_short %0, %1, off" :: "v"((const unsigned char*)(obu + (size_t)(35) * orow + 32) + ooff), "v"(z) : "memory");
      asm volatile("global_store_short %0, %1, off" :: "v"((const unsigned char*)(obu + (size_t)(48) * orow + 32) + ooff), "v"(z) : "memory");
      asm volatile("global_store_short %0, %1, off" :: "v"((const unsigned char*)(obu + (size_t)(49) * orow + 32) + ooff), "v"(z) : "memory");
      asm volatile("global_store_short %0, %1, off" :: "v"((const unsigned char*)(obu + (size_t)(50) * orow + 32) + ooff), "v"(z) : "memory");
      asm volatile("global_store_short %0, %1, off" :: "v"((const unsigned char*)(obu + (size_t)(51) * orow + 32) + ooff), "v"(z) : "memory");
    }
#pragma unroll 1
    for (int n = 0; n < NCH; ++n) {
        { unsigned sp_ = 0; while (*(volatile LAS unsigned*)(xl + XL_CNT) <= (unsigned)n) { __builtin_amdgcn_s_sleep(1); if (++sp_ > (1u << 22)) break; } }
        bf16x8 Sp0_0, Sp0_1, Sp0_2, Sp0_3, vp0_0, vp0_1;
        bf16x8 Sp1_0, Sp1_1, Sp1_2, Sp1_3, vp1_0, vp1_1;
        { const LAS bf16x8* sl_ = (const LAS bf16x8*)(xl + (n & 1) * XL_SLOT) + lane; Sp0_0 = sl_[0]; Sp0_1 = sl_[64]; Sp0_2 = sl_[128]; Sp0_3 = sl_[192]; vp0_0 = sl_[256]; vp0_1 = sl_[320]; Sp1_0 = sl_[384]; Sp1_1 = sl_[448]; Sp1_2 = sl_[512]; Sp1_3 = sl_[576]; vp1_0 = sl_[640]; vp1_1 = sl_[704]; }
        asm volatile("s_waitcnt lgkmcnt(0)" ::: "memory");
        if (lane == 0) *(volatile LAS unsigned*)(xl + XL_CNT + 64) = (unsigned)(n + 1);
        f32x4 o0_0 = {0.f, 0.f, 0.f, 0.f}, o0_1 = o0_0, o0_2 = o0_0, o0_3 = o0_0;
        f32x4 o1_0 = {0.f, 0.f, 0.f, 0.f}, o1_1 = o1_0, o1_2 = o1_0, o1_3 = o1_0;
        asm volatile("s_waitcnt vmcnt(55)" : "+v"(r0));
        o0_0 = mfma16(r0, Sp0_0, o0_0);
        o1_0 = mfma16(r0, Sp1_0, o1_0);
        asm volatile("global_load_dwordx4 %0, %1, off" : "+v"(r0) : "v"((const unsigned char*)(sp0 + ((size_t)(n + 1) * 56 + 16) * 1024) + voff) : "memory");
        __builtin_amdgcn_sched_barrier(0);
        asm volatile("s_waitcnt vmcnt(55)" : "+v"(r1));
        o0_0 = mfma16(r1, Sp0_1, o0_0);
        o1_0 = mfma16(r1, Sp1_1, o1_0);
        asm volatile("global_load_dwordx4 %0, %1, off" : "+v"(r1) : "v"((const unsigned char*)(sp0 + ((size_t)(n + 1) * 56 + 17) * 1024) + voff) : "memory");
        __builtin_amdgcn_sched_barrier(0);
        asm volatile("s_waitcnt vmcnt(55)" : "+v"(r2));
        o0_0 = mfma16(r2, Sp0_2, o0_0);
        o1_0 = mfma16(r2, Sp1_2, o1_0);
        asm volatile("global_load_dwordx4 %0, %1, off" : "+v"(r2) : "v"((const unsigned char*)(sp0 + ((size_t)(n + 1) * 56 + 18) * 1024) + voff) : "memory");
        __builtin_amdgcn_sched_barrier(0);
        asm volatile("s_waitcnt vmcnt(55)" : "+v"(r3));
        o0_0 = mfma16(r3, Sp0_3, o0_0);
        o1_0 = mfma16(r3, Sp1_3, o1_0);
        asm volatile("global_load_dwordx4 %0, %1, off" : "+v"(r3) : "v"((const unsigned char*)(sp0 + ((size_t)(n + 1) * 56 + 19) * 1024) + voff) : "memory");
        __builtin_amdgcn_sched_barrier(0);
        asm volatile("s_waitcnt vmcnt(55)" : "+v"(r4));
        o0_1 = mfma16(r4, Sp0_0, o0_1);
        o1_1 = mfma16(r4, Sp1_0, o1_1);
        asm volatile("global_load_dwordx4 %0, %1, off" : "+v"(r4) : "v"((const unsigned char*)(sp0 + ((size_t)(n + 1) * 56 + 20) * 1024) + voff) : "memory");
        __builtin_amdgcn_sched_barrier(0);
        asm volatile("s_waitcnt vmcnt(55)" : "+v"(r5));
        o0_1 = mfma16(r5, Sp0_1, o0_1);
        o1_1 = mfma16(r5, Sp1_1, o1_1);
        asm volatile("global_load_dwordx4 %0, %1, off" : "+v"(r5) : "v"((const unsigned char*)(sp0 + ((size_t)(n + 1) * 56 + 21) * 1024) + voff) : "memory");
        __builtin_amdgcn_sched_barrier(0);
        asm volatile("s_waitcnt vmcnt(55)" : "+v"(r6));
        o0_1 = mfma16(r6, Sp0_2, o0_1);
        o1_1 = mfma16(r6, Sp1_2, o1_1);
        asm volatile("global_load_dwordx4 %0, %1, off" : "+v"(r6) : "v"((const unsigned char*)(sp0 + ((size_t)(n + 1) * 56 + 22) * 1024) + voff) : "memory");
        __builtin_amdgcn_sched_barrier(0);
        asm volatile("s_waitcnt vmcnt(55)" : "+v"(r7));
        o0_1 = mfma16(r7, Sp0_3, o0_1);
        o1_1 = mfma16(r7, Sp1_3, o1_1);
        asm volatile("global_load_dwordx4 %0, %1, off" : "+v"(r7) : "v"((const unsigned char*)(sp0 + ((size_t)(n + 1) * 56 + 23) * 1024) + voff) : "memory");
        __builtin_amdgcn_sched_barrier(0);
        asm volatile("s_waitcnt vmcnt(55)" : "+v"(r8));
        o0_2 = mfma16(r8, Sp0_0, o0_2);
        o1_2 = mfma16(r8, Sp1_0, o1_2);
        asm volatile("global_load_dwordx4 %0, %1, off" : "+v"(r8) : "v"((const unsigned char*)(sp0 + ((size_t)(n + 1) * 56 + 24) * 1024) + voff) : "memory");
        __builtin_amdgcn_sched_barrier(0);
        asm volatile("s_waitcnt vmcnt(55)" : "+v"(r9));
        o0_2 = mfma16(r9, Sp0_1, o0_2);
        o1_2 = mfma16(r9, Sp1_1, o1_2);
        asm volatile("global_load_dwordx4 %0, %1, off" : "+v"(r9) : "v"((const unsigned char*)(sp0 + ((size_t)(n + 1) * 56 + 25) * 1024) + voff) : "memory");
        __builtin_amdgcn_sched_barrier(0);
        asm volatile("s_waitcnt vmcnt(55)" : "+v"(r10));
        o0_2 = mfma16(r10, Sp0_2, o0_2);
        o1_2 = mfma16(r10, Sp1_2, o1_2);
        asm volatile("global_load_dwordx4 %0, %1, off" : "+v"(r10) : "v"((const unsigned char*)(sp0 + ((size_t)(n + 1) * 56 + 26) * 1024) + voff) : "memory");
        __builtin_amdgcn_sched_barrier(0);
        asm volatile("s_waitcnt vmcnt(55)" : "+v"(r11));
        o0_2 = mfma16(r11, Sp0_3, o0_2);
        o1_2 = mfma16(r11, Sp1_3, o1_2);
        asm volatile("global_load_dwordx4 %0, %1, off" : "+v"(r11) : "v"((const unsigned char*)(sp0 + ((size_t)(n + 1) * 56 + 27) * 1024) + voff) : "memory");
        __builtin_amdgcn_sched_barrier(0);
        asm volatile("s_waitcnt vmcnt(55)" : "+v"(r12));
        o0_3 = mfma16(r12, Sp0_0, o0_3);
        o1_3 = mfma16(r12, Sp1_0, o1_3);
        asm volatile("global_load_dwordx4 %0, %1, off" : "+v"(r12) : "v"((const unsigned char*)(sp0 + ((size_t)(n + 1) * 56 + 28) * 1024) + voff) : "memory");
        __builtin_amdgcn_sched_barrier(0);
        asm volatile("s_waitcnt vmcnt(55)" : "+v"(r13));
        o0_3 = mfma16(r13, Sp0_1, o0_3);
        o1_3 = mfma16(r13, Sp1_1, o1_3);
        asm volatile("global_load_dwordx4 %0, %1, off" : "+v"(r13) : "v"((const unsigned char*)(sp0 + ((size_t)(n + 1) * 56 + 29) * 1024) + voff) : "memory");
        __builtin_amdgcn_sched_barrier(0);
        asm volatile("s_waitcnt vmcnt(55)" : "+v"(r14));
        o0_3 = mfma16(r14, Sp0_2, o0_3);
        o1_3 = mfma16(r14, Sp1_2, o1_3);
        asm volatile("global_load_dwordx4 %0, %1, off" : "+v"(r14) : "v"((const unsigned char*)(sp0 + ((size_t)(n + 1) * 56 + 30) * 1024) + voff) : "memory");
        __builtin_amdgcn_sched_barrier(0);
        asm volatile("s_waitcnt vmcnt(55)" : "+v"(r15));
        o0_3 = mfma16(r15, Sp0_3, o0_3);
        o1_3 = mfma16(r15, Sp1_3, o1_3);
        asm volatile("global_load_dwordx4 %0, %1, off" : "+v"(r15) : "v"((const unsigned char*)(sp0 + ((size_t)(n + 1) * 56 + 31) * 1024) + voff) : "memory");
        __builtin_amdgcn_sched_barrier(0);
        asm volatile("s_waitcnt vmcnt(55)" : "+v"(r16));
        o0_0 = mfma16(r16, vp0_0, o0_0);
        o1_0 = mfma16(r16, vp1_0, o1_0);
        asm volatile("global_load_dwordx4 %0, %1, off" : "+v"(r16) : "v"((const unsigned char*)(sp0 + ((size_t)(n + 1) * 56 + 32) * 1024) + voff) : "memory");
        __builtin_amdgcn_sched_barrier(0);
        asm volatile("s_waitcnt vmcnt(55)" : "+v"(r17));
        o0_0 = mfma16(r17, vp0_1, o0_0);
        o1_0 = mfma16(r17, vp1_1, o1_0);
        asm volatile("global_load_dwordx4 %0, %1, off" : "+v"(r17) : "v"((const unsigned char*)(sp0 + ((size_t)(n + 1) * 56 + 33) * 1024) + voff) : "memory");
        __builtin_amdgcn_sched_barrier(0);
        asm volatile("s_waitcnt vmcnt(55)" : "+v"(r18));
        o0_1 = mfma16(r18, vp0_0, o0_1);
        o1_1 = mfma16(r18, vp1_0, o1_1);
        asm volatile("global_load_dwordx4 %0, %1, off" : "+v"(r18) : "v"((const unsigned char*)(sp0 + ((size_t)(n + 1) * 56 + 34) * 1024) + voff) : "memory");
        __builtin_amdgcn_sched_barrier(0);
        asm volatile("s_waitcnt vmcnt(55)" : "+v"(r19));
        o0_1 = mfma16(r19, vp0_1, o0_1);
        o1_1 = mfma16(r19, vp1_1, o1_1);
        asm volatile("global_load_dwordx4 %0, %1, off" : "+v"(r19) : "v"((const unsigned char*)(sp0 + ((size_t)(n + 1) * 56 + 35) * 1024) + voff) : "memory");
        __builtin_amdgcn_sched_barrier(0);
        asm volatile("s_waitcnt vmcnt(55)" : "+v"(r20));
        o0_2 = mfma16(r20, vp0_0, o0_2);
        o1_2 = mfma16(r20, vp1_0, o1_2);
        asm volatile("global_load_dwordx4 %0, %1, off" : "+v"(r20) : "v"((const unsigned char*)(sp0 + ((size_t)(n + 1) * 56 + 36) * 1024) + voff) : "memory");
        __builtin_amdgcn_sched_barrier(0);
        asm volatile("s_waitcnt vmcnt(55)" : "+v"(r21));
        o0_2 = mfma16(r21, vp0_1, o0_2);
        o1_2 = mfma16(r21, vp1_1, o1_2);
        asm volatile("global_load_dwordx4 %0, %1, off" : "+v"(r21) : "v"((const unsigned char*)(sp0 + ((size_t)(n + 1) * 56 + 37) * 1024) + voff) : "memory");
        __builtin_amdgcn_sched_barrier(0);
        asm volatile("s_waitcnt vmcnt(55)" : "+v"(r22));
        o0_3 = mfma16(r22, vp0_0, o0_3);
        o1_3 = mfma16(r22, vp1_0, o1_3);
        asm volatile("global_load_dwordx4 %0, %1, off" : "+v"(r22) : "v"((const unsigned char*)(sp0 + ((size_t)(n + 1) * 56 + 38) * 1024) + voff) : "memory");
        __builtin_amdgcn_sched_barrier(0);
        asm volatile("s_waitcnt vmcnt(55)" : "+v"(r23));
        o0_3 = mfma16(r23, vp0_1, o0_3);
        o1_3 = mfma16(r23, vp1_1, o1_3);
        asm volatile("global_load_dwordx4 %0, %1, off" : "+v"(r23) : "v"((const unsigned char*)(sp0 + ((size_t)(n + 1) * 56 + 39) * 1024) + voff) : "memory");
        __builtin_amdgcn_sched_barrier(0);
        { const unsigned char* obn = obu + (size_t)n * 64 * orow;
          { const unsigned v = f2bf(o0_0[0]); asm volatile("global_store_short %0, %1, off" :: "v"((const unsigned char*)(obn + (size_t)(0) * orow + 0) + ooff), "v"(v) : "memory"); }
          { const unsigned v = f2bf(o0_0[1]); asm volatile("global_store_short %0, %1, off" :: "v"((const unsigned char*)(obn + (size_t)(1) * orow + 0) + ooff), "v"(v) : "memory"); }
          { const unsigned v = f2bf(o0_0[2]); asm volatile("global_store_short %0, %1, off" :: "v"((const unsigned char*)(obn + (size_t)(2) * orow + 0) + ooff), "v"(v) : "memory"); }
          { const unsigned v = f2bf(o0_0[3]); asm volatile("global_store_short %0, %1, off" :: "v"((const unsigned char*)(obn + (size_t)(3) * orow + 0) + ooff), "v"(v) : "memory"); }
          { const unsigned v = f2bf(o0_1[0]); asm volatile("global_store_short %0, %1, off" :: "v"((const unsigned char*)(obn + (size_t)(16) * orow + 0) + ooff), "v"(v) : "memory"); }
          { const unsigned v = f2bf(o0_1[1]); asm volatile("global_store_short %0, %1, off" :: "v"((const unsigned char*)(obn + (size_t)(17) * orow + 0) + ooff), "v"(v) : "memory"); }
          { const unsigned v = f2bf(o0_1[2]); asm volatile("global_store_short %0, %1, off" :: "v"((const unsigned char*)(obn + (size_t)(18) * orow + 0) + ooff), "v"(v) : "memory"); }
          { const unsigned v = f2bf(o0_1[3]); asm volatile("global_store_short %0, %1, off" :: "v"((const unsigned char*)(obn + (size_t)(19) * orow + 0) + ooff), "v"(v) : "memory"); }
          { const unsigned v = f2bf(o0_2[0]); asm volatile("global_store_short %0, %1, off" :: "v"((const unsigned char*)(obn + (size_t)(32) * orow + 0) + ooff), "v"(v) : "memory"); }
          { const unsigned v = f2bf(o0_2[1]); asm volatile("global_store_short %0, %1, off" :: "v"((const unsigned char*)(obn + (size_t)(33) * orow + 0) + ooff), "v"(v) : "memory"); }
          { const unsigned v = f2bf(o0_2[2]); asm volatile("global_store_short %0, %1, off" :: "v"((const unsigned char*)(obn + (size_t)(34) * orow + 0) + ooff), "v"(v) : "memory"); }
          { const unsigned v = f2bf(o0_2[3]); asm volatile("global_store_short %0, %1, off" :: "v"((const unsigned char*)(obn + (size_t)(35) * orow + 0) + ooff), "v"(v) : "memory"); }
          { const unsigned v = f2bf(o0_3[0]); asm volatile("global_store_short %0, %1, off" :: "v"((const unsigned char*)(obn + (size_t)(48) * orow + 0) + ooff), "v"(v) : "memory"); }
          { const unsigned v = f2bf(o0_3[1]); asm volatile("global_store_short %0, %1, off" :: "v"((const unsigned char*)(obn + (size_t)(49) * orow + 0) + ooff), "v"(v) : "memory"); }
          { const unsigned v = f2bf(o0_3[2]); asm volatile("global_store_short %0, %1, off" :: "v"((const unsigned char*)(obn + (size_t)(50) * orow + 0) + ooff), "v"(v) : "memory"); }
          { const unsigned v = f2bf(o0_3[3]); asm volatile("global_store_short %0, %1, off" :: "v"((const unsigned char*)(obn + (size_t)(51) * orow + 0) + ooff), "v"(v) : "memory"); }
          { const unsigned v = f2bf(o1_0[0]); asm volatile("global_store_short %0, %1, off" :: "v"((const unsigned char*)(obn + (size_t)(0) * orow + 32) + ooff), "v"(v) : "memory"); }
          { const unsigned v = f2bf(o1_0[1]); asm volatile("global_store_short %0, %1, off" :: "v"((const unsigned char*)(obn + (size_t)(1) * orow + 32) + ooff), "v"(v) : "memory"); }
          { const unsigned v = f2bf(o1_0[2]); asm volatile("global_store_short %0, %1, off" :: "v"((const unsigned char*)(obn + (size_t)(2) * orow + 32) + ooff), "v"(v) : "memory"); }
          { const unsigned v = f2bf(o1_0[3]); asm volatile("global_store_short %0, %1, off" :: "v"((const unsigned char*)(obn + (size_t)(3) * orow + 32) + ooff), "v"(v) : "memory"); }
          { const unsigned v = f2bf(o1_1[0]); asm volatile("global_store_short %0, %1, off" :: "v"((const unsigned char*)(obn + (size_t)(16) * orow + 32) + ooff), "v"(v) : "memory"); }
          { const unsigned v = f2bf(o1_1[1]); asm volatile("global_store_short %0, %1, off" :: "v"((const unsigned char*)(obn + (size_t)(17) * orow + 32) + ooff), "v"(v) : "memory"); }
          { const unsigned v = f2bf(o1_1[2]); asm volatile("global_store_short %0, %1, off" :: "v"((const unsigned char*)(obn + (size_t)(18) * orow + 32) + ooff), "v"(v) : "memory"); }
          { const unsigned v = f2bf(o1_1[3]); asm volatile("global_store_short %0, %1, off" :: "v"((const unsigned char*)(obn + (size_t)(19) * orow + 32) + ooff), "v"(v) : "memory"); }
          { const unsigned v = f2bf(o1_2[0]); asm volatile("global_store_short %0, %1, off" :: "v"((const unsigned char*)(obn + (size_t)(32) * orow + 32) + ooff), "v"(v) : "memory"); }
          { const unsigned v = f2bf(o1_2[1]); asm volatile("global_store_short %0, %1, off" :: "v"((const unsigned char*)(obn + (size_t)(33) * orow + 32) + ooff), "v"(v) : "memory"); }
          { const unsigned v = f2bf(o1_2[2]); asm volatile("global_store_short %0, %1, off" :: "v"((const unsigned char*)(obn + (size_t)(34) * orow + 32) + ooff), "v"(v) : "memory"); }
          { const unsigned v = f2bf(o1_2[3]); asm volatile("global_store_short %0, %1, off" :: "v"((const unsigned char*)(obn + (size_t)(35) * orow + 32) + ooff), "v"(v) : "memory"); }
          { const unsigned v = f2bf(o1_3[0]); asm volatile("global_store_short %0, %1, off" :: "v"((const unsigned char*)(obn + (size_t)(48) * orow + 32) + ooff), "v"(v) : "memory"); }
          { const unsigned v = f2bf(o1_3[1]); asm volatile("global_store_short %0, %1, off" :: "v"((const unsigned char*)(obn + (size_t)(49) * orow + 32) + ooff), "v"(v) : "memory"); }
          { const unsigned v = f2bf(o1_3[2]); asm volatile("global_store_short %0, %1, off" :: "v"((const unsigned char*)(obn + (size_t)(50) * orow + 32) + ooff), "v"(v) : "memory"); }
          { const unsigned v = f2bf(o1_3[3]); asm volatile("global_store_short %0, %1, off" :: "v"((const unsigned char*)(obn + (size_t)(51) * orow + 32) + ooff), "v"(v) : "memory"); }
        }
        __builtin_amdgcn_sched_barrier(0);
    }
    asm volatile("s_waitcnt vmcnt(0)" ::: "memory");
    } else if constexpr (!GDN && ROLE == 0) {
    bf16x8 r0 = (bf16x8){0, 0, 0, 0, 0, 0, 0, 0};
    bf16x8 r1 = (bf16x8){0, 0, 0, 0, 0, 0, 0, 0};
    bf16x8 r2 = (bf16x8){0, 0, 0, 0, 0, 0, 0, 0};
    bf16x8 r3 = (bf16x8){0, 0, 0, 0, 0, 0, 0, 0};
    bf16x8 r4 = (bf16x8){0, 0, 0, 0, 0, 0, 0, 0};
    bf16x8 r5 = (bf16x8){0, 0, 0, 0, 0, 0, 0, 0};
    bf16x8 r6 = (bf16x8){0, 0, 0, 0, 0, 0, 0, 0};
    bf16x8 r7 = (bf16x8){0, 0, 0, 0, 0, 0, 0, 0};
    bf16x8 r8 = (bf16x8){0, 0, 0, 0, 0, 0, 0, 0};
    bf16x8 r9 = (bf16x8){0, 0, 0, 0, 0, 0, 0, 0};
    bf16x8 r10 = (bf16x8){0, 0, 0, 0, 0, 0, 0, 0};
    bf16x8 r11 = (bf16x8){0, 0, 0, 0, 0, 0, 0, 0};
    bf16x8 r12 = (bf16x8){0, 0, 0, 0, 0, 0, 0, 0};
    bf16x8 r13 = (bf16x8){0, 0, 0, 0, 0, 0, 0, 0};
    bf16x8 r14 = (bf16x8){0, 0, 0, 0, 0, 0, 0, 0};
    bf16x8 r15 = (bf16x8){0, 0, 0, 0, 0, 0, 0, 0};
    f32x4 S0_0 = {0.f, 0.f, 0.f, 0.f};
    f32x4 S0_1 = {0.f, 0.f, 0.f, 0.f};
    f32x4 S0_2 = {0.f, 0.f, 0.f, 0.f};
    f32x4 S0_3 = {0.f, 0.f, 0.f, 0.f};
    f32x4 S0_4 = {0.f, 0.f, 0.f, 0.f};
    f32x4 S0_5 = {0.f, 0.f, 0.f, 0.f};
    f32x4 S0_6 = {0.f, 0.f, 0.f, 0.f};
    f32x4 S0_7 = {0.f, 0.f, 0.f, 0.f};
    bf16x8 Sp0_0 = (bf16x8){0, 0, 0, 0, 0, 0, 0, 0};
    bf16x8 Sp0_1 = (bf16x8){0, 0, 0, 0, 0, 0, 0, 0};
    bf16x8 Sp0_2 = (bf16x8){0, 0, 0, 0, 0, 0, 0, 0};
    bf16x8 Sp0_3 = (bf16x8){0, 0, 0, 0, 0, 0, 0, 0};
    f32x4 S1_0 = {0.f, 0.f, 0.f, 0.f};
    f32x4 S1_1 = {0.f, 0.f, 0.f, 0.f};
    f32x4 S1_2 = {0.f, 0.f, 0.f, 0.f};
    f32x4 S1_3 = {0.f, 0.f, 0.f, 0.f};
    f32x4 S1_4 = {0.f, 0.f, 0.f, 0.f};
    f32x4 S1_5 = {0.f, 0.f, 0.f, 0.f};
    f32x4 S1_6 = {0.f, 0.f, 0.f, 0.f};
    f32x4 S1_7 = {0.f, 0.f, 0.f, 0.f};
    bf16x8 Sp1_0 = (bf16x8){0, 0, 0, 0, 0, 0, 0, 0};
    bf16x8 Sp1_1 = (bf16x8){0, 0, 0, 0, 0, 0, 0, 0};
    bf16x8 Sp1_2 = (bf16x8){0, 0, 0, 0, 0, 0, 0, 0};
    bf16x8 Sp1_3 = (bf16x8){0, 0, 0, 0, 0, 0, 0, 0};
    unsigned vn0_0 = 0u, vn0_1 = 0u, vn0_2 = 0u, vn0_3 = 0u, vn0_4 = 0u, vn0_5 = 0u, vn0_6 = 0u, vn0_7 = 0u, vn0_8 = 0u, vn0_9 = 0u, vn0_10 = 0u, vn0_11 = 0u, vn0_12 = 0u, vn0_13 = 0u, vn0_14 = 0u, vn0_15 = 0u;
    unsigned vn1_0 = 0u, vn1_1 = 0u, vn1_2 = 0u, vn1_3 = 0u, vn1_4 = 0u, vn1_5 = 0u, vn1_6 = 0u, vn1_7 = 0u, vn1_8 = 0u, vn1_9 = 0u, vn1_10 = 0u, vn1_11 = 0u, vn1_12 = 0u, vn1_13 = 0u, vn1_14 = 0u, vn1_15 = 0u;
    { const int n = 0; (void)n;
    asm volatile("global_load_ushort %0, %1, off" : "+v"(vn0_0) : "v"((const unsigned char*)(vbu + (size_t)(0) * vrow + 0) + voff2) : "memory");
    asm volatile("global_load_ushort %0, %1, off" : "+v"(vn0_1) : "v"((const unsigned char*)(vbu + (size_t)(1) * vrow + 0) + voff2) : "memory");
    asm volatile("global_load_ushort %0, %1, off" : "+v"(vn0_2) : "v"((const unsigned char*)(vbu + (size_t)(2) * vrow + 0) + voff2) : "memory");
    asm volatile("global_load_ushort %0, %1, off" : "+v"(vn0_3) : "v"((const unsigned char*)(vbu + (size_t)(3) * vrow + 0) + voff2) : "memory");
    asm volatile("global_load_ushort %0, %1, off" : "+v"(vn0_4) : "v"((const unsigned char*)(vbu + (size_t)(16) * vrow + 0) + voff2) : "memory");
    asm volatile("global_load_ushort %0, %1, off" : "+v"(vn0_5) : "v"((const unsigned char*)(vbu + (size_t)(17) * vrow + 0) + voff2) : "memory");
    asm volatile("global_load_ushort %0, %1, off" : "+v"(vn0_6) : "v"((const unsigned char*)(vbu + (size_t)(18) * vrow + 0) + voff2) : "memory");
    asm volatile("global_load_ushort %0, %1, off" : "+v"(vn0_7) : "v"((const unsigned char*)(vbu + (size_t)(19) * vrow + 0) + voff2) : "memory");
    asm volatile("global_load_ushort %0, %1, off" : "+v"(vn0_8) : "v"((const unsigned char*)(vbu + (size_t)(32) * vrow + 0) + voff2) : "memory");
    asm volatile("global_load_ushort %0, %1, off" : "+v"(vn0_9) : "v"((const unsigned char*)(vbu + (size_t)(33) * vrow + 0) + voff2) : "memory");
    asm volatile("global_load_ushort %0, %1, off" : "+v"(vn0_10) : "v"((const unsigned char*)(vbu + (size_t)(34) * vrow + 0) + voff2) : "memory");
    asm volatile("global_load_ushort %0, %1, off" : "+v"(vn0_11) : "v"((const unsigned char*)(vbu + (size_t)(35) * vrow + 0) + voff2) : "memory");
    asm volatile("global_load_ushort %0, %1, off" : "+v"(vn0_12) : "v"((const unsigned char*)(vbu + (size_t)(48) * vrow + 0) + voff2) : "memory");
    asm volatile("global_load_ushort %0, %1, off" : "+v"(vn0_13) : "v"((const unsigned char*)(vbu + (size_t)(49) * vrow + 0) + voff2) : "memory");
    asm volatile("global_load_ushort %0, %1, off" : "+v"(vn0_14) : "v"((const unsigned char*)(vbu + (size_t)(50) * vrow + 0) + voff2) : "memory");
    asm volatile("global_load_ushort %0, %1, off" : "+v"(vn0_15) : "v"((const unsigned char*)(vbu + (size_t)(51) * vrow + 0) + voff2) : "memory");
    asm volatile("global_load_ushort %0, %1, off" : "+v"(vn1_0) : "v"((const unsigned char*)(vbu + (size_t)(0) * vrow + 32) + voff2) : "memory");
    asm volatile("global_load_ushort %0, %1, off" : "+v"(vn1_1) : "v"((const unsigned char*)(vbu + (size_t)(1) * vrow + 32) + voff2) : "memory");
    asm volatile("global_load_ushort %0, %1, off" : "+v"(vn1_2) : "v"((const unsigned char*)(vbu + (size_t)(2) * vrow + 32) + voff2) : "memory");
    asm volatile("global_load_ushort %0, %1, off" : "+v"(vn1_3) : "v"((const unsigned char*)(vbu + (size_t)(3) * vrow + 32) + voff2) : "memory");
    asm volatile("global_load_ushort %0, %1, off" : "+v"(vn1_4) : "v"((const unsigned char*)(vbu + (size_t)(16) * vrow + 32) + voff2) : "memory");
    asm volatile("global_load_ushort %0, %1, off" : "+v"(vn1_5) : "v"((const unsigned char*)(vbu + (size_t)(17) * vrow + 32) + voff2) : "memory");
    asm volatile("global_load_ushort %0, %1, off" : "+v"(vn1_6) : "v"((const unsigned char*)(vbu + (size_t)(18) * vrow + 32) + voff2) : "memory");
    asm volatile("global_load_ushort %0, %1, off" : "+v"(vn1_7) : "v"((const unsigned char*)(vbu + (size_t)(19) * vrow + 32) + voff2) : "memory");
    asm volatile("global_load_ushort %0, %1, off" : "+v"(vn1_8) : "v"((const unsigned char*)(vbu + (size_t)(32) * vrow + 32) + voff2) : "memory");
    asm volatile("global_load_ushort %0, %1, off" : "+v"(vn1_9) : "v"((const unsigned char*)(vbu + (size_t)(33) * vrow + 32) + voff2) : "memory");
    asm volatile("global_load_ushort %0, %1, off" : "+v"(vn1_10) : "v"((const unsigned char*)(vbu + (size_t)(34) * vrow + 32) + voff2) : "memory");
    asm volatile("global_load_ushort %0, %1, off" : "+v"(vn1_11) : "v"((const unsigned char*)(vbu + (size_t)(35) * vrow + 32) + voff2) : "memory");
    asm volatile("global_load_ushort %0, %1, off" : "+v"(vn1_12) : "v"((const unsigned char*)(vbu + (size_t)(48) * vrow + 32) + voff2) : "memory");
    asm volatile("global_load_ushort %0, %1, off" : "+v"(vn1_13) : "v"((const unsigned char*)(vbu + (size_t)(49) * vrow + 32) + voff2) : "memory");
    asm volatile("global_load_ushort %0, %1, off" : "+v"(vn1_14) : "v"((const unsigned char*)(vbu + (size_t)(50) * vrow + 32) + voff2) : "memory");
    asm volatile("global_load_ushort %0, %1, off" : "+v"(vn1_15) : "v"((const unsigned char*)(vbu + (size_t)(51) * vrow + 32) + voff2) : "memory");
    asm volatile("global_load_dwordx4 %0, %1, off" : "+v"(r0) : "v"((const unsigned char*)(sp0 + ((size_t)(n + 0) * 40 + 24) * 1024) + voff) : "memory");
    asm volatile("global_load_dwordx4 %0, %1, off" : "+v"(r1) : "v"((const unsigned char*)(sp0 + ((size_t)(n + 0) * 40 + 25) * 1024) + voff) : "memory");
    asm volatile("global_load_dwordx4 %0, %1, off" : "+v"(r2) : "v"((const unsigned char*)(sp0 + ((size_t)(n + 0) * 40 + 26) * 1024) + voff) : "memory");
    asm volatile("global_load_dwordx4 %0, %1, off" : "+v"(r3) : "v"((const unsigned char*)(sp0 + ((size_t)(n + 0) * 40 + 27) * 1024) + voff) : "memory");
    asm volatile("global_load_dwordx4 %0, %1, off" : "+v"(r4) : "v"((const unsigned char*)(sp0 + ((size_t)(n + 0) * 40 + 28) * 1024) + voff) : "memory");
    asm volatile("global_load_dwordx4 %0, %1, off" : "+v"(r5) : "v"((const unsigned char*)(sp0 + ((size_t)(n + 0) * 40 + 29) * 1024) + voff) : "memory");
    asm volatile("global_load_dwordx4 %0, %1, off" : "+v"(r6) : "v"((const unsigned char*)(sp0 + ((size_t)(n + 0) * 40 + 30) * 1024) + voff) : "memory");
    asm volatile("global_load_dwordx4 %0, %1, off" : "+v"(r7) : "v"((const unsigned char*)(sp0 + ((size_t)(n + 0) * 40 + 31) * 1024) + voff) : "memory");
    asm volatile("global_load_dwordx4 %0, %1, off" : "+v"(r8) : "v"((const unsigned char*)(sp0 + ((size_t)(n + 0) * 40 + 32) * 1024) + voff) : "memory");
    asm volatile("global_load_dwordx4 %0, %1, off" : "+v"(r9) : "v"((const unsigned char*)(sp0 + ((size_t)(n + 0) * 40 + 33) * 1024) + voff) : "memory");
    asm volatile("global_load_dwordx4 %0, %1, off" : "+v"(r10) : "v"((const unsigned char*)(sp0 + ((size_t)(n + 0) * 40 + 34) * 1024) + voff) : "memory");
    asm volatile("global_load_dwordx4 %0, %1, off" : "+v"(r11) : "v"((const unsigned char*)(sp0 + ((size_t)(n + 0) * 40 + 35) * 1024) + voff) : "memory");
    asm volatile("global_load_dwordx4 %0, %1, off" : "+v"(r12) : "v"((const unsigned char*)(sp0 + ((size_t)(n + 0) * 40 + 36) * 1024) + voff) : "memory");
    asm volatile("global_load_dwordx4 %0, %1, off" : "+v"(r13) : "v"((const unsigned char*)(sp0 + ((size_t)(n + 0) * 40 + 37) * 1024) + voff) : "memory");
    asm volatile("global_load_dwordx4 %0, %1, off" : "+v"(r14) : "v"((const unsigned char*)(sp0 + ((size_t)(n + 0) * 40 + 38) * 1024) + voff) : "memory");
    asm volatile("global_load_dwordx4 %0, %1, off" : "+v"(r15) : "v"((const unsigned char*)(sp0 + ((size_t)(n + 0) * 40 + 39) * 1024) + voff) : "memory");
    }
#pragma unroll 1
    for (int n = 0; n < NCH; ++n) {
        const int nn = n + 1 < NCH ? n + 1 : n;
        f32x4 a0_0, a0_1, a0_2, a0_3;
        f32x4 a1_0, a1_1, a1_2, a1_3;
        asm volatile("s_waitcnt vmcnt(16)" : "+v"(vn0_0), "+v"(vn0_1), "+v"(vn0_2), "+v"(vn0_3), "+v"(vn0_4), "+v"(vn0_5), "+v"(vn0_6), "+v"(vn0_7), "+v"(vn0_8), "+v"(vn0_9), "+v"(vn0_10), "+v"(vn0_11), "+v"(vn0_12), "+v"(vn0_13), "+v"(vn0_14), "+v"(vn0_15));
        asm volatile("s_waitcnt vmcnt(16)" : "+v"(vn1_0), "+v"(vn1_1), "+v"(vn1_2), "+v"(vn1_3), "+v"(vn1_4), "+v"(vn1_5), "+v"(vn1_6), "+v"(vn1_7), "+v"(vn1_8), "+v"(vn1_9), "+v"(vn1_10), "+v"(vn1_11), "+v"(vn1_12), "+v"(vn1_13), "+v"(vn1_14), "+v"(vn1_15));
        a0_0 = (f32x4){__builtin_bit_cast(float, vn0_0 << 16), __builtin_bit_cast(float, vn0_1 << 16), __builtin_bit_cast(float, vn0_2 << 16), __builtin_bit_cast(float, vn0_3 << 16)};
        a0_1 = (f32x4){__builtin_bit_cast(float, vn0_4 << 16), __builtin_bit_cast(float, vn0_5 << 16), __builtin_bit_cast(float, vn0_6 << 16), __builtin_bit_cast(float, vn0_7 << 16)};
        a0_2 = (f32x4){__builtin_bit_cast(float, vn0_8 << 16), __builtin_bit_cast(float, vn0_9 << 16), __builtin_bit_cast(float, vn0_10 << 16), __builtin_bit_cast(float, vn0_11 << 16)};
        a0_3 = (f32x4){__builtin_bit_cast(float, vn0_12 << 16), __builtin_bit_cast(float, vn0_13 << 16), __builtin_bit_cast(float, vn0_14 << 16), __builtin_bit_cast(float, vn0_15 << 16)};
        a1_0 = (f32x4){__builtin_bit_cast(float, vn1_0 << 16), __builtin_bit_cast(float, vn1_1 << 16), __builtin_bit_cast(float, vn1_2 << 16), __builtin_bit_cast(float, vn1_3 << 16)};
        a1_1 = (f32x4){__builtin_bit_cast(float, vn1_4 << 16), __builtin_bit_cast(float, vn1_5 << 16), __builtin_bit_cast(float, vn1_6 << 16), __builtin_bit_cast(float, vn1_7 << 16)};
        a1_2 = (f32x4){__builtin_bit_cast(float, vn1_8 << 16), __builtin_bit_cast(float, vn1_9 << 16), __builtin_bit_cast(float, vn1_10 << 16), __builtin_bit_cast(float, vn1_11 << 16)};
        a1_3 = (f32x4){__builtin_bit_cast(float, vn1_12 << 16), __builtin_bit_cast(float, vn1_13 << 16), __builtin_bit_cast(float, vn1_14 << 16), __builtin_bit_cast(float, vn1_15 << 16)};
        const float dec = decr;
        { const unsigned char* vbn = vbu + (size_t)nn * 64 * vrow;
          asm volatile("global_load_ushort %0, %1, off" : "+v"(vn0_0) : "v"((const unsigned char*)(vbn + (size_t)(0) * vrow + 0) + voff2) : "memory");
          asm volatile("global_load_ushort %0, %1, off" : "+v"(vn0_1) : "v"((const unsigned char*)(vbn + (size_t)(1) * vrow + 0) + voff2) : "memory");
          asm volatile("global_load_ushort %0, %1, off" : "+v"(vn0_2) : "v"((const unsigned char*)(vbn + (size_t)(2) * vrow + 0) + voff2) : "memory");
          asm volatile("global_load_ushort %0, %1, off" : "+v"(vn0_3) : "v"((const unsigned char*)(vbn + (size_t)(3) * vrow + 0) + voff2) : "memory");
          asm volatile("global_load_ushort %0, %1, off" : "+v"(vn0_4) : "v"((const unsigned char*)(vbn + (size_t)(16) * vrow + 0) + voff2) : "memory");
          asm volatile("global_load_ushort %0, %1, off" : "+v"(vn0_5) : "v"((const unsigned char*)(vbn + (size_t)(17) * vrow + 0) + voff2) : "memory");
          asm volatile("global_load_ushort %0, %1, off" : "+v"(vn0_6) : "v"((const unsigned char*)(vbn + (size_t)(18) * vrow + 0) + voff2) : "memory");
          asm volatile("global_load_ushort %0, %1, off" : "+v"(vn0_7) : "v"((const unsigned char*)(vbn + (size_t)(19) * vrow + 0) + voff2) : "memory");
          asm volatile("global_load_ushort %0, %1, off" : "+v"(vn0_8) : "v"((const unsigned char*)(vbn + (size_t)(32) * vrow + 0) + voff2) : "memory");
          asm volatile("global_load_ushort %0, %1, off" : "+v"(vn0_9) : "v"((const unsigned char*)(vbn + (size_t)(33) * vrow + 0) + voff2) : "memory");
          asm volatile("global_load_ushort %0, %1, off" : "+v"(vn0_10) : "v"((const unsigned char*)(vbn + (size_t)(34) * vrow + 0) + voff2) : "memory");
          asm volatile("global_load_ushort %0, %1, off" : "+v"(vn0_11) : "v"((const unsigned char*)(vbn + (size_t)(35) * vrow + 0) + voff2) : "memory");
          asm volatile("global_load_ushort %0, %1, off" : "+v"(vn0_12) : "v"((const unsigned char*)(vbn + (size_t)(48) * vrow + 0) + voff2) : "memory");
          asm volatile("global_load_ushort %0, %1, off" : "+v"(vn0_13) : "v"((const unsigned char*)(vbn + (size_t)(49) * vrow + 0) + voff2) : "memory");
          asm volatile("global_load_ushort %0, %1, off" : "+v"(vn0_14) : "v"((const unsigned char*)(vbn + (size_t)(50) * vrow + 0) + voff2) : "memory");
          asm volatile("global_load_ushort %0, %1, off" : "+v"(vn0_15) : "v"((const unsigned char*)(vbn + (size_t)(51) * vrow + 0) + voff2) : "memory");
          asm volatile("global_load_ushort %0, %1, off" : "+v"(vn1_0) : "v"((const unsigned char*)(vbn + (size_t)(0) * vrow + 32) + voff2) : "memory");
          asm volatile("global_load_ushort %0, %1, off" : "+v"(vn1_1) : "v"((const unsigned char*)(vbn + (size_t)(1) * vrow + 32) + voff2) : "memory");
          asm volatile("global_load_ushort %0, %1, off" : "+v"(vn1_2) : "v"((const unsigned char*)(vbn + (size_t)(2) * vrow + 32) + voff2) : "memory");
          asm volatile("global_load_ushort %0, %1, off" : "+v"(vn1_3) : "v"((const unsigned char*)(vbn + (size_t)(3) * vrow + 32) + voff2) : "memory");
          asm volatile("global_load_ushort %0, %1, off" : "+v"(vn1_4) : "v"((const unsigned char*)(vbn + (size_t)(16) * vrow + 32) + voff2) : "memory");
          asm volatile("global_load_ushort %0, %1, off" : "+v"(vn1_5) : "v"((const unsigned char*)(vbn + (size_t)(17) * vrow + 32) + voff2) : "memory");
          asm volatile("global_load_ushort %0, %1, off" : "+v"(vn1_6) : "v"((const unsigned char*)(vbn + (size_t)(18) * vrow + 32) + voff2) : "memory");
          asm volatile("global_load_ushort %0, %1, off" : "+v"(vn1_7) : "v"((const unsigned char*)(vbn + (size_t)(19) * vrow + 32) + voff2) : "memory");
          asm volatile("global_load_ushort %0, %1, off" : "+v"(vn1_8) : "v"((const unsigned char*)(vbn + (size_t)(32) * vrow + 32) + voff2) : "memory");
          asm volatile("global_load_ushort %0, %1, off" : "+v"(vn1_9) : "v"((const unsigned char*)(vbn + (size_t)(33) * vrow + 32) + voff2) : "memory");
          asm volatile("global_load_ushort %0, %1, off" : "+v"(vn1_10) : "v"((const unsigned char*)(vbn + (size_t)(34) * vrow + 32) + voff2) : "memory");
          asm volatile("global_load_ushort %0, %1, off" : "+v"(vn1_11) : "v"((const unsigned char*)(vbn + (size_t)(35) * vrow + 32) + voff2) : "memory");
          asm volatile("global_load_ushort %0, %1, off" : "+v"(vn1_12) : "v"((const unsigned char*)(vbn + (size_t)(48) * vrow + 32) + voff2) : "memory");
          asm volatile("global_load_ushort %0, %1, off" : "+v"(vn1_13) : "v"((const unsigned char*)(vbn + (size_t)(49) * vrow + 32) + voff2) : "memory");
          asm volatile("global_load_ushort %0, %1, off" : "+v"(vn1_14) : "v"((const unsigned char*)(vbn + (size_t)(50) * vrow + 32) + voff2) : "memory");
          asm volatile("global_load_ushort %0, %1, off" : "+v"(vn1_15) : "v"((const unsigned char*)(vbn + (size_t)(51) * vrow + 32) + voff2) : "memory");
        }
        __builtin_amdgcn_sched_barrier(0);
        bf16x8 vp0_0, vp0_1;
        { u32x4 w; w.x = cvt_pk_bf16(a0_0[0], a0_0[1]); w.y = cvt_pk_bf16(a0_0[2], a0_0[3]); w.z = cvt_pk_bf16(a0_1[0], a0_1[1]); w.w = cvt_pk_bf16(a0_1[2], a0_1[3]); vp0_0 = __builtin_bit_cast(bf16x8, w); }
        { u32x4 w; w.x = cvt_pk_bf16(a0_2[0], a0_2[1]); w.y = cvt_pk_bf16(a0_2[2], a0_2[3]); w.z = cvt_pk_bf16(a0_3[0], a0_3[1]); w.w = cvt_pk_bf16(a0_3[2], a0_3[3]); vp0_1 = __builtin_bit_cast(bf16x8, w); }
        bf16x8 vp1_0, vp1_1;
        { u32x4 w; w.x = cvt_pk_bf16(a1_0[0], a1_0[1]); w.y = cvt_pk_bf16(a1_0[2], a1_0[3]); w.z = cvt_pk_bf16(a1_1[0], a1_1[1]); w.w = cvt_pk_bf16(a1_1[2], a1_1[3]); vp1_0 = __builtin_bit_cast(bf16x8, w); }
        { u32x4 w; w.x = cvt_pk_bf16(a1_2[0], a1_2[1]); w.y = cvt_pk_bf16(a1_2[2], a1_2[3]); w.z = cvt_pk_bf16(a1_3[0], a1_3[1]); w.w = cvt_pk_bf16(a1_3[2], a1_3[3]); vp1_1 = __builtin_bit_cast(bf16x8, w); }
        { unsigned sp_ = 0; while (*(volatile LAS unsigned*)(xl + XL_CNT + 64) + 2u <= (unsigned)n) { __builtin_amdgcn_s_sleep(1); if (++sp_ > (1u << 22)) break; } }
        { LAS bf16x8* sl_ = (LAS bf16x8*)(xl + (n & 1) * XL_SLOT) + lane; sl_[0] = Sp0_0; sl_[64] = Sp0_1; sl_[128] = Sp0_2; sl_[192] = Sp0_3; sl_[256] = vp0_0; sl_[320] = vp0_1; sl_[384] = Sp1_0; sl_[448] = Sp1_1; sl_[512] = Sp1_2; sl_[576] = Sp1_3; sl_[640] = vp1_0; sl_[704] = vp1_1; }
        asm volatile("s_waitcnt lgkmcnt(0)" ::: "memory");
        if (lane == 0) *(volatile LAS unsigned*)(xl + XL_CNT) = (unsigned)(n + 1);
        S0_0 = S0_0 * dec;
        S1_0 = S1_0 * dec;
        asm volatile("s_waitcnt vmcnt(47)" : "+v"(r0));
        S0_0 = mfma16(r0, vp0_0, S0_0);
        S1_0 = mfma16(r0, vp1_0, S1_0);
        asm volatile("global_load_dwordx4 %0, %1, off" : "+v"(r0) : "v"((const unsigned char*)(sp0 + ((size_t)(n + 1) * 40 + 24) * 1024) + voff) : "memory");
        __builtin_amdgcn_sched_barrier(0);
        asm volatile("s_waitcnt vmcnt(47)" : "+v"(r1));
        S0_0 = mfma16(r1, vp0_1, S0_0);
        S1_0 = mfma16(r1, vp1_1, S1_0);
        asm volatile("global_load_dwordx4 %0, %1, off" : "+v"(r1) : "v"((const unsigned char*)(sp0 + ((size_t)(n + 1) * 40 + 25) * 1024) + voff) : "memory");
        __builtin_amdgcn_sched_barrier(0);
        S0_1 = S0_1 * dec;
        S1_1 = S1_1 * dec;
        asm volatile("s_waitcnt vmcnt(47)" : "+v"(r2));
        S0_1 = mfma16(r2, vp0_0, S0_1);
        S1_1 = mfma16(r2, vp1_0, S1_1);
        asm volatile("global_load_dwordx4 %0, %1, off" : "+v"(r2) : "v"((const unsigned char*)(sp0 + ((size_t)(n + 1) * 40 + 26) * 1024) + voff) : "memory");
        __builtin_amdgcn_sched_barrier(0);
        asm volatile("s_waitcnt vmcnt(47)" : "+v"(r3));
        S0_1 = mfma16(r3, vp0_1, S0_1);
        S1_1 = mfma16(r3, vp1_1, S1_1);
        asm volatile("global_load_dwordx4 %0, %1, off" : "+v"(r3) : "v"((const unsigned char*)(sp0 + ((size_t)(n + 1) * 40 + 27) * 1024) + voff) : "memory");
        __builtin_amdgcn_sched_barrier(0);
        S0_2 = S0_2 * dec;
        S1_2 = S1_2 * dec;
        asm volatile("s_waitcnt vmcnt(47)" : "+v"(r4));
        S0_2 = mfma16(r4, vp0_0, S0_2);
        S1_2 = mfma16(r4, vp1_0, S1_2);
        asm volatile("global_load_dwordx4 %0, %1, off" : "+v"(r4) : "v"((const unsigned char*)(sp0 + ((size_t)(n + 1) * 40 + 28) * 1024) + voff) : "memory");
        __builtin_amdgcn_sched_barrier(0);
        asm volatile("s_waitcnt vmcnt(47)" : "+v"(r5));
        S0_2 = mfma16(r5, vp0_1, S0_2);
        S1_2 = mfma16(r5, vp1_1, S1_2);
        asm volatile("global_load_dwordx4 %0, %1, off" : "+v"(r5) : "v"((const unsigned char*)(sp0 + ((size_t)(n + 1) * 40 + 29) * 1024) + voff) : "memory");
        __builtin_amdgcn_sched_barrier(0);
        S0_3 = S0_3 * dec;
        S1_3 = S1_3 * dec;
        asm volatile("s_waitcnt vmcnt(47)" : "+v"(r6));
        S0_3 = mfma16(r6, vp0_0, S0_3);
        S1_3 = mfma16(r6, vp1_0, S1_3);
        asm volatile("global_load_dwordx4 %0, %1, off" : "+v"(r6) : "v"((const unsigned char*)(sp0 + ((size_t)(n + 1) * 40 + 30) * 1024) + voff) : "memory");
        __builtin_amdgcn_sched_barrier(0);
        asm volatile("s_waitcnt vmcnt(47)" : "+v"(r7));
        S0_3 = mfma16(r7, vp0_1, S0_3);
        S1_3 = mfma16(r7, vp1_1, S1_3);
        asm volatile("global_load_dwordx4 %0, %1, off" : "+v"(r7) : "v"((const unsigned char*)(sp0 + ((size_t)(n + 1) * 40 + 31) * 1024) + voff) : "memory");
        __builtin_amdgcn_sched_barrier(0);
        S0_4 = S0_4 * dec;
        S1_4 = S1_4 * dec;
        asm volatile("s_waitcnt vmcnt(47)" : "+v"(r8));
        S0_4 = mfma16(r8, vp0_0, S0_4);
        S1_4 = mfma16(r8, vp1_0, S1_4);
        asm volatile("global_load_dwordx4 %0, %1, off" : "+v"(r8) : "v"((const unsigned char*)(sp0 + ((size_t)(n + 1) * 40 + 32) * 1024) + voff) : "memory");
        __builtin_amdgcn_sched_barrier(0);
        asm volatile("s_waitcnt vmcnt(47)" : "+v"(r9));
        S0_4 = mfma16(r9, vp0_1, S0_4);
        S1_4 = mfma16(r9, vp1_1, S1_4);
        asm volatile("global_load_dwordx4 %0, %1, off" : "+v"(r9) : "v"((const unsigned char*)(sp0 + ((size_t)(n + 1) * 40 + 33) * 1024) + voff) : "memory");
        __builtin_amdgcn_sched_barrier(0);
        S0_5 = S0_5 * dec;
        S1_5 = S1_5 * dec;
        asm volatile("s_waitcnt vmcnt(47)" : "+v"(r10));
        S0_5 = mfma16(r10, vp0_0, S0_5);
        S1_5 = mfma16(r10, vp1_0, S1_5);
        asm volatile("global_load_dwordx4 %0, %1, off" : "+v"(r10) : "v"((const unsigned char*)(sp0 + ((size_t)(n + 1) * 40 + 34) * 1024) + voff) : "memory");
        __builtin_amdgcn_sched_barrier(0);
        asm volatile("s_waitcnt vmcnt(47)" : "+v"(r11));
        S0_5 = mfma16(r11, vp0_1, S0_5);
        S1_5 = mfma16(r11, vp1_1, S1_5);
        asm volatile("global_load_dwordx4 %0, %1, off" : "+v"(r11) : "v"((const unsigned char*)(sp0 + ((size_t)(n + 1) * 40 + 35) * 1024) + voff) : "memory");
        __builtin_amdgcn_sched_barrier(0);
        S0_6 = S0_6 * dec;
        S1_6 = S1_6 * dec;
        asm volatile("s_waitcnt vmcnt(47)" : "+v"(r12));
        S0_6 = mfma16(r12, vp0_0, S0_6);
        S1_6 = mfma16(r12, vp1_0, S1_6);
        asm volatile("global_load_dwordx4 %0, %1, off" : "+v"(r12) : "v"((const unsigned char*)(sp0 + ((size_t)(n + 1) * 40 + 36) * 1024) + voff) : "memory");
        __builtin_amdgcn_sched_barrier(0);
        asm volatile("s_waitcnt vmcnt(47)" : "+v"(r13));
        S0_6 = mfma16(r13, vp0_1, S0_6);
        S1_6 = mfma16(r13, vp1_1, S1_6);
        asm volatile("global_load_dwordx4 %0, %1, off" : "+v"(r13) : "v"((const unsigned char*)(sp0 + ((size_t)(n + 1) * 40 + 37) * 1024) + voff) : "memory");
        __builtin_amdgcn_sched_barrier(0);
        S0_7 = S0_7 * dec;
        S1_7 = S1_7 * dec;
        asm volatile("s_waitcnt vmcnt(47)" : "+v"(r14));
        S0_7 = mfma16(r14, vp0_0, S0_7);
        S1_7 = mfma16(r14, vp1_0, S1_7);
        asm volatile("global_load_dwordx4 %0, %1, off" : "+v"(r14) : "v"((const unsigned char*)(sp0 + ((size_t)(n + 1) * 40 + 38) * 1024) + voff) : "memory");
        __builtin_amdgcn_sched_barrier(0);
        asm volatile("s_waitcnt vmcnt(47)" : "+v"(r15));
        S0_7 = mfma16(r15, vp0_1, S0_7);
        S1_7 = mfma16(r15, vp1_1, S1_7);
        asm volatile("global_load_dwordx4 %0, %1, off" : "+v"(r15) : "v"((const unsigned char*)(sp0 + ((size_t)(n + 1) * 40 + 39) * 1024) + voff) : "memory");
        __builtin_amdgcn_sched_barrier(0);
        { u32x4 w; w.x = cvt_pk_bf16(S0_0[0], S0_0[1]); w.y = cvt_pk_bf16(S0_0[2], S0_0[3]); w.z = cvt_pk_bf16(S0_1[0], S0_1[1]); w.w = cvt_pk_bf16(S0_1[2], S0_1[3]); Sp0_0 = __builtin_bit_cast(bf16x8, w); }
        { u32x4 w; w.x = cvt_pk_bf16(S0_2[0], S0_2[1]); w.y = cvt_pk_bf16(S0_2[2], S0_2[3]); w.z = cvt_pk_bf16(S0_3[0], S0_3[1]); w.w = cvt_pk_bf16(S0_3[2], S0_3[3]); Sp0_1 = __builtin_bit_cast(bf16x8, w); }
        { u32x4 w; w.x = cvt_pk_bf16(S0_4[0], S0_4[1]); w.y = cvt_pk_bf16(S0_4[2], S0_4[3]); w.z = cvt_pk_bf16(S0_5[0], S0_5[1]); w.w = cvt_pk_bf16(S0_5[2], S0_5[3]); Sp0_2 = __builtin_bit_cast(bf16x8, w); }
        { u32x4 w; w.x = cvt_pk_bf16(S0_6[0], S0_6[1]); w.y = cvt_pk_bf16(S0_6[2], S0_6[3]); w.z = cvt_pk_bf16(S0_7[0], S0_7[1]); w.w = cvt_pk_bf16(S0_7[2], S0_7[3]); Sp0_3 = __builtin_bit_cast(bf16x8, w); }
        { u32x4 w; w.x = cvt_pk_bf16(S1_0[0], S1_0[1]); w.y = cvt_pk_bf16(S1_0[2], S1_0[3]); w.z = cvt_pk_bf16(S1_1[0], S1_1[1]); w.w = cvt_pk_bf16(S1_1[2], S1_1[3]); Sp1_0 = __builtin_bit_cast(bf16x8, w); }
        { u32x4 w; w.x = cvt_pk_bf16(S1_2[0], S1_2[1]); w.y = cvt_pk_bf16(S1_2[2], S1_2[3]); w.z = cvt_pk_bf16(S1_3[0], S1_3[1]); w.w = cvt_pk_bf16(S1_3[2], S1_3[3]); Sp1_1 = __builtin_bit_cast(bf16x8, w); }
        { u32x4 w; w.x = cvt_pk_bf16(S1_4[0], S1_4[1]); w.y = cvt_pk_bf16(S1_4[2], S1_4[3]); w.z = cvt_pk_bf16(S1_5[0], S1_5[1]); w.w = cvt_pk_bf16(S1_5[2], S1_5[3]); Sp1_2 = __builtin_bit_cast(bf16x8, w); }
        { u32x4 w; w.x = cvt_pk_bf16(S1_6[0], S1_6[1]); w.y = cvt_pk_bf16(S1_6[2], S1_6[3]); w.z = cvt_pk_bf16(S1_7[0], S1_7[1]); w.w = cvt_pk_bf16(S1_7[2], S1_7[3]); Sp1_3 = __builtin_bit_cast(bf16x8, w); }
    }
    asm volatile("s_waitcnt vmcnt(0)" ::: "memory");
    } else {
    bf16x8 r0 = (bf16x8){0, 0, 0, 0, 0, 0, 0, 0};
    bf16x8 r1 = (bf16x8){0, 0, 0, 0, 0, 0, 0, 0};
    bf16x8 r2 = (bf16x8){0, 0, 0, 0, 0, 0, 0, 0};
    bf16x8 r3 = (bf16x8){0, 0, 0, 0, 0, 0, 0, 0};
    bf16x8 r4 = (bf16x8){0, 0, 0, 0, 0, 0, 0, 0};
    bf16x8 r5 = (bf16x8){0, 0, 0, 0, 0, 0, 0, 0};
    bf16x8 r6 = (bf16x8){0, 0, 0, 0, 0, 0, 0, 0};
    bf16x8 r7 = (bf16x8){0, 0, 0, 0, 0, 0, 0, 0};
    bf16x8 r8 = (bf16x8){0, 0, 0, 0, 0, 0, 0, 0};
    bf16x8 r9 = (bf16x8){0, 0, 0, 0, 0, 0, 0, 0};
    bf16x8 r10 = (bf16x8){0, 0, 0, 0, 0, 0, 0, 0};
    bf16x8 r11 = (bf16x8){0, 0, 0, 0, 0, 0, 0, 0};
    bf16x8 r12 = (bf16x8){0, 0, 0, 0, 0, 0, 0, 0};
    bf16x8 r13 = (bf16x8){0, 0, 0, 0, 0, 0, 0, 0};
    bf16x8 r14 = (bf16x8){0, 0, 0, 0, 0, 0, 0, 0};
    bf16x8 r15 = (bf16x8){0, 0, 0, 0, 0, 0, 0, 0};
    bf16x8 r16 = (bf16x8){0, 0, 0, 0, 0, 0, 0, 0};
    bf16x8 r17 = (bf16x8){0, 0, 0, 0, 0, 0, 0, 0};
    bf16x8 r18 = (bf16x8){0, 0, 0, 0, 0, 0, 0, 0};
    bf16x8 r19 = (bf16x8){0, 0, 0, 0, 0, 0, 0, 0};
    bf16x8 r20 = (bf16x8){0, 0, 0, 0, 0, 0, 0, 0};
    bf16x8 r21 = (bf16x8){0, 0, 0, 0, 0, 0, 0, 0};
    bf16x8 r22 = (bf16x8){0, 0, 0, 0, 0, 0, 0, 0};
    bf16x8 r23 = (bf16x8){0, 0, 0, 0, 0, 0, 0, 0};
    asm volatile("global_load_dwordx4 %0, %1, off" : "+v"(r0) : "v"((const unsigned char*)(sp0 + ((size_t)(0 + 0) * 40 + 0) * 1024) + voff) : "memory");
    asm volatile("global_load_dwordx4 %0, %1, off" : "+v"(r1) : "v"((const unsigned char*)(sp0 + ((size_t)(0 + 0) * 40 + 1) * 1024) + voff) : "memory");
    asm volatile("global_load_dwordx4 %0, %1, off" : "+v"(r2) : "v"((const unsigned char*)(sp0 + ((size_t)(0 + 0) * 40 + 2) * 1024) + voff) : "memory");
    asm volatile("global_load_dwordx4 %0, %1, off" : "+v"(r3) : "v"((const unsigned char*)(sp0 + ((size_t)(0 + 0) * 40 + 3) * 1024) + voff) : "memory");
    asm volatile("global_load_dwordx4 %0, %1, off" : "+v"(r4) : "v"((const unsigned char*)(sp0 + ((size_t)(0 + 0) * 40 + 4) * 1024) + voff) : "memory");
    asm volatile("global_load_dwordx4 %0, %1, off" : "+v"(r5) : "v"((const unsigned char*)(sp0 + ((size_t)(0 + 0) * 40 + 5) * 1024) + voff) : "memory");
    asm volatile("global_load_dwordx4 %0, %1, off" : "+v"(r6) : "v"((const unsigned char*)(sp0 + ((size_t)(0 + 0) * 40 + 6) * 1024) + voff) : "memory");
    asm volatile("global_load_dwordx4 %0, %1, off" : "+v"(r7) : "v"((const unsigned char*)(sp0 + ((size_t)(0 + 0) * 40 + 7) * 1024) + voff) : "memory");
    asm volatile("global_load_dwordx4 %0, %1, off" : "+v"(r8) : "v"((const unsigned char*)(sp0 + ((size_t)(0 + 0) * 40 + 8) * 1024) + voff) : "memory");
    asm volatile("global_load_dwordx4 %0, %1, off" : "+v"(r9) : "v"((const unsigned char*)(sp0 + ((size_t)(0 + 0) * 40 + 9) * 1024) + voff) : "memory");
    asm volatile("global_load_dwordx4 %0, %1, off" : "+v"(r10) : "v"((const unsigned char*)(sp0 + ((size_t)(0 + 0) * 40 + 10) * 1024) + voff) : "memory");
    asm volatile("global_load_dwordx4 %0, %1, off" : "+v"(r11) : "v"((const unsigned char*)(sp0 + ((size_t)(0 + 0) * 40 + 11) * 1024) + voff) : "memory");
    asm volatile("global_load_dwordx4 %0, %1, off" : "+v"(r12) : "v"((const unsigned char*)(sp0 + ((size_t)(0 + 0) * 40 + 12) * 1024) + voff) : "memory");
    asm volatile("global_load_dwordx4 %0, %1, off" : "+v"(r13) : "v"((const unsigned char*)(sp0 + ((size_t)(0 + 0) * 40 + 13) * 1024) + voff) : "memory");
    asm volatile("global_load_dwordx4 %0, %1, off" : "+v"(r14) : "v"((const unsigned char*)(sp0 + ((size_t)(0 + 0) * 40 + 14) * 1024) + voff) : "memory");
    asm volatile("global_load_dwordx4 %0, %1, off" : "+v"(r15) : "v"((const unsigned char*)(sp0 + ((size_t)(0 + 0) * 40 + 15) * 1024) + voff) : "memory");
    asm volatile("global_load_dwordx4 %0, %1, off" : "+v"(r16) : "v"((const unsigned char*)(sp0 + ((size_t)(0 + 0) * 40 + 16) * 1024) + voff) : "memory");
    asm volatile("global_load_dwordx4 %0, %1, off" : "+v"(r17) : "v"((const unsigned char*)(sp0 + ((size_t)(0 + 0) * 40 + 17) * 1024) + voff) : "memory");
    asm volatile("global_load_dwordx4 %0, %1, off" : "+v"(r18) : "v"((const unsigned char*)(sp0 + ((size_t)(0 + 0) * 40 + 18) * 1024) + voff) : "memory");
    asm volatile("global_load_dwordx4 %0, %1, off" : "+v"(r19) : "v"((const unsigned char*)(sp0 + ((size_t)(0 + 0) * 40 + 19) * 1024) + voff) : "memory");
    asm volatile("global_load_dwordx4 %0, %1, off" : "+v"(r20) : "v"((const unsigned char*)(sp0 + ((size_t)(0 + 0) * 40 + 20) * 1024) + voff) : "memory");
    asm volatile("global_load_dwordx4 %0, %1, off" : "+v"(r21) : "v"((const unsigned char*)(sp0 + ((size_t)(0 + 0) * 40 + 21) * 1024) + voff) : "memory");
    asm volatile("global_load_dwordx4 %0, %1, off" : "+v"(r22) : "v"((const unsigned char*)(sp0 + ((size_t)(0 + 0) * 40 + 22) * 1024) + voff) : "memory");
    asm volatile("global_load_dwordx4 %0, %1, off" : "+v"(r23) : "v"((const unsigned char*)(sp0 + ((size_t)(0 + 0) * 40 + 23) * 1024) + voff) : "memory");
    { unsigned z = 0u;
      asm volatile("global_store_short %0, %1, off" :: "v"((const unsigned char*)(obu + (size_t)(0) * orow + 0) + ooff), "v"(z) : "memory");
      asm volatile("global_store_short %0, %1, off" :: "v"((const unsigned char*)(obu + (size_t)(1) * orow + 0) + ooff), "v"(z) : "memory");
      asm volatile("global_store_short %0, %1, off" :: "v"((const unsigned char*)(obu + (size_t)(2) * orow + 0) + ooff), "v"(z) : "memory");
      asm volatile("global_store_short %0, %1, off" :: "v"((const unsigned char*)(obu + (size_t)(3) * orow + 0) + ooff), "v"(z) : "memory");
      asm volatile("global_store_short %0, %1, off" :: "v"((const unsigned char*)(obu + (size_t)(16) * orow + 0) + ooff), "v"(z) : "memory");
      asm volatile("global_store_short %0, %1, off" :: "v"((const unsigned char*)(obu + (size_t)(17) * orow + 0) + ooff), "v"(z) : "memory");
      asm volatile("global_store_short %0, %1, off" :: "v"((const unsigned char*)(obu + (size_t)(18) * orow + 0) + ooff), "v"(z) : "memory");
      asm volatile("global_store_short %0, %1, off" :: "v"((const unsigned char*)(obu + (size_t)(19) * orow + 0) + ooff), "v"(z) : "memory");
      asm volatile("global_store_short %0, %1, off" :: "v"((const unsigned char*)(obu + (size_t)(32) * orow + 0) + ooff), "v"(z) : "memory");
      asm volatile("global_store_short %0, %1, off" :: "v"((const unsigned char*)(obu + (size_t)(33) * orow + 0) + ooff), "v"(z) : "memory");
      asm volatile("global_store_short %0, %1, off" :: "v"((const unsigned char*)(obu + (size_t)(34) * orow + 0) + ooff), "v"(z) : "memory");
      asm volatile("global_store_short %0, %1, off" :: "v"((const unsigned char*)(obu + (size_t)(35) * orow + 0) + ooff), "v"(z) : "memory");
      asm volatile("global_store_short %0, %1, off" :: "v"((const unsigned char*)(obu + (size_t)(48) * orow + 0) + ooff), "v"(z) : "memory");
      asm volatile("global_store_short %0, %1, off" :: "v"((const unsigned char*)(obu + (size_t)(49) * orow + 0) + ooff), "v"(z) : "memory");
      asm volatile("global_store_short %0, %1, off" :: "v"((const unsigned char*)(obu + (size_t)(50) * orow + 0) + ooff), "v"(z) : "memory");
      asm volatile("global_store_short %0, %1, off" :: "v"((const unsigned char*)(obu + (size_t)(51) * orow + 0) + ooff), "v"(z) : "memory");
      asm volatile("global_store_short %0, %1, off" :: "v"((const unsigned char*)(obu + (size_t)(0) * orow + 32) + ooff), "v"(z) : "memory");
      asm volatile("global_store_short %0, %1, off" :: "v"((const unsigned char*)(obu + (size_t)(1) * orow + 32) + ooff), "v"(z) : "memory");
      asm volatile("global_store_short %0, %1, off" :: "v"((const unsigned char*)(obu + (size_t)(2) * orow + 32) + ooff), "v"(z) : "memory");
      asm volatile("global_store_short %0, %1, off" :: "v"((const unsigned char*)(obu + (size_t)(3) * orow + 32) + ooff), "v"(z) : "memory");
      asm volatile("global_store_short %0, %1, off" :: "v"((const unsigned char*)(obu + (size_t)(16) * orow + 32) + ooff), "v"(z) : "memory");
      asm volatile("global_store_short %0, %1, off" :: "v"((const unsigned char*)(obu + (size_t)(17) * orow + 32) + ooff), "v"(z) : "memory");
      asm volatile("global_store_short %0, %1, off" :: "v"((const unsigned char*)(obu + (size_t)(18) * orow + 32) + ooff), "v"(z) : "memory");
      asm volatile("global_store_short %0, %1, off" :: "v"((const unsigned char*)(obu + (size_t)(19) * orow + 32) + ooff), "v"(z) : "memory");
      asm volatile("global_store_short %0, %1, off" :: "v"((const unsigned char*)(obu + (size_t)(32) * orow + 32) + ooff), "v"(z) : "memory");
      asm volatile("global_store_short %0, %1, off" :: "v"((const unsigned char*)(obu + (size_t)(33) * orow + 32) + ooff), "v"(z) : "memory");
      asm volatile("global_store_short %0, %1, off" :: "v"((const unsigned char*)(obu + (size_t)(34) * orow + 32) + ooff), "v"(z) : "memory");
      asm volatile("global_store_short %0, %1, off" :: "v"((const unsigned char*)(obu + (size_t)(35) * orow + 32) + ooff), "v"(z) : "memory");
      asm volatile("global_store_short %0, %1, off" :: "v"((const unsigned char*)(obu + (size_t)(48) * orow + 32) + ooff), "v"(z) : "memory");
      asm volatile("global_store_short %0, %1, off" :: "v"((const unsigned char*)(obu + (size_t)(49) * orow + 32) + ooff), "v"(z) : "memory");
      asm volatile("global_store_short %0, %1, off" :: "v"((const unsigned char*)(obu + (size_t)(50) * orow + 32) + ooff), "v"(z) : "memory");
      asm volatile("global_store_short %0, %1, off" :: "v"((const unsigned char*)(obu + (size_t)(51) * orow + 32) + ooff), "v"(z) : "memory");
    }
#pragma unroll 1
    for (int n = 0; n < NCH; ++n) {
        { unsigned sp_ = 0; while (*(volatile LAS unsigned*)(xl + XL_CNT) <= (unsigned)n) { __builtin_amdgcn_s_sleep(1); if (++sp_ > (1u << 22)) break; } }
        bf16x8 Sp0_0, Sp0_1, Sp0_2, Sp0_3, vp0_0, vp0_1;
        bf16x8 Sp1_0, Sp1_1, Sp1_2, Sp1_3, vp1_0, vp1_1;
        { const LAS bf16x8* sl_ = (const LAS bf16x8*)(xl + (n & 1) * XL_SLOT) + lane; Sp0_0 = sl_[0]; Sp0_1 = sl_[64]; Sp0_2 = sl_[128]; Sp0_3 = sl_[192]; vp0_0 = sl_[256]; vp0_1 = sl_[320]; Sp1_0 = sl_[384]; Sp1_1 = sl_[448]; Sp1_2 = sl_[512]; Sp1_3 = sl_[576]; vp1_0 = sl_[640]; vp1_1 = sl_[704]; }
        asm volatile("s_waitcnt lgkmcnt(0)" ::: "memory");
        if (lane == 0) *(volatile LAS unsigned*)(xl + XL_CNT + 64) = (unsigned)(n + 1);
        f32x4 o0_0 = {0.f, 0.f, 0.f, 0.f}, o0_1 = o0_0, o0_2 = o0_0, o0_3 = o0_0;
        f32x4 o1_0 = {0.f, 0.f, 0.f, 0.f}, o1_1 = o1_0, o1_2 = o1_0, o1_3 = o1_0;
        asm volatile("s_waitcnt vmcnt(55)" : "+v"(r0));
        o0_0 = mfma16(r0, Sp0_0, o0_0);
        o1_0 = mfma16(r0, Sp1_0, o1_0);
        asm volatile("global_load_dwordx4 %0, %1, off" : "+v"(r0) : "v"((const unsigned char*)(sp0 + ((size_t)(n + 1) * 40 + 0) * 1024) + voff) : "memory");
        __builtin_amdgcn_sched_barrier(0);
        asm volatile("s_waitcnt vmcnt(55)" : "+v"(r1));
        o0_0 = mfma16(r1, Sp0_1, o0_0);
        o1_0 = mfma16(r1, Sp1_1, o1_0);
        asm volatile("global_load_dwordx4 %0, %1, off" : "+v"(r1) : "v"((const unsigned char*)(sp0 + ((size_t)(n + 1) * 40 + 1) * 1024) + voff) : "memory");
        __builtin_amdgcn_sched_barrier(0);
        asm volatile("s_waitcnt vmcnt(55)" : "+v"(r2));
        o0_0 = mfma16(r2, Sp0_2, o0_0);
        o1_0 = mfma16(r2, Sp1_2, o1_0);
        asm volatile("global_load_dwordx4 %0, %1, off" : "+v"(r2) : "v"((const unsigned char*)(sp0 + ((size_t)(n + 1) * 40 + 2) * 1024) + voff) : "memory");
        __builtin_amdgcn_sched_barrier(0);
        asm volatile("s_waitcnt vmcnt(55)" : "+v"(r3));
        o0_0 = mfma16(r3, Sp0_3, o0_0);
        o1_0 = mfma16(r3, Sp1_3, o1_0);
        asm volatile("global_load_dwordx4 %0, %1, off" : "+v"(r3) : "v"((const unsigned char*)(sp0 + ((size_t)(n + 1) * 40 + 3) * 1024) + voff) : "memory");
        __builtin_amdgcn_sched_barrier(0);
        asm volatile("s_waitcnt vmcnt(55)" : "+v"(r4));
        o0_1 = mfma16(r4, Sp0_0, o0_1);
        o1_1 = mfma16(r4, Sp1_0, o1_1);
        asm volatile("global_load_dwordx4 %0, %1, off" : "+v"(r4) : "v"((const unsigned char*)(sp0 + ((size_t)(n + 1) * 40 + 4) * 1024) + voff) : "memory");
        __builtin_amdgcn_sched_barrier(0);
        asm volatile("s_waitcnt vmcnt(55)" : "+v"(r5));
        o0_1 = mfma16(r5, Sp0_1, o0_1);
        o1_1 = mfma16(r5, Sp1_1, o1_1);
        asm volatile("global_load_dwordx4 %0, %1, off" : "+v"(r5) : "v"((const unsigned char*)(sp0 + ((size_t)(n + 1) * 40 + 5) * 1024) + voff) : "memory");
        __builtin_amdgcn_sched_barrier(0);
        asm volatile("s_waitcnt vmcnt(55)" : "+v"(r6));
        o0_1 = mfma16(r6, Sp0_2, o0_1);
        o1_1 = mfma16(r6, Sp1_2, o1_1);
        asm volatile("global_load_dwordx4 %0, %1, off" : "+v"(r6) : "v"((const unsigned char*)(sp0 + ((size_t)(n + 1) * 40 + 6) * 1024) + voff) : "memory");
        __builtin_amdgcn_sched_barrier(0);
        asm volatile("s_waitcnt vmcnt(55)" : "+v"(r7));
        o0_1 = mfma16(r7, Sp0_3, o0_1);
        o1_1 = mfma16(r7, Sp1_3, o1_1);
        asm volatile("global_load_dwordx4 %0, %1, off" : "+v"(r7) : "v"((const unsigned char*)(sp0 + ((size_t)(n + 1) * 40 + 7) * 1024) + voff) : "memory");
        __builtin_amdgcn_sched_barrier(0);
        asm volatile("s_waitcnt vmcnt(55)" : "+v"(r8));
        o0_2 = mfma16(r8, Sp0_0, o0_2);
        o1_2 = mfma16(r8, Sp1_0, o1_2);
        asm volatile("global_load_dwordx4 %0, %1, off" : "+v"(r8) : "v"((const unsigned char*)(sp0 + ((size_t)(n + 1) * 40 + 8) * 1024) + voff) : "memory");
        __builtin_amdgcn_sched_barrier(0);
        asm volatile("s_waitcnt vmcnt(55)" : "+v"(r9));
        o0_2 = mfma16(r9, Sp0_1, o0_2);
        o1_2 = mfma16(r9, Sp1_1, o1_2);
        asm volatile("global_load_dwordx4 %0, %1, off" : "+v"(r9) : "v"((const unsigned char*)(sp0 + ((size_t)(n + 1) * 40 + 9) * 1024) + voff) : "memory");
        __builtin_amdgcn_sched_barrier(0);
        asm volatile("s_waitcnt vmcnt(55)" : "+v"(r10));
        o0_2 = mfma16(r10, Sp0_2, o0_2);
        o1_2 = mfma16(r10, Sp1_2, o1_2);
        asm volatile("global_load_dwordx4 %0, %1, off" : "+v"(r10) : "v"((const unsigned char*)(sp0 + ((size_t)(n + 1) * 40 + 10) * 1024) + voff) : "memory");
        __builtin_amdgcn_sched_barrier(0);
        asm volatile("s_waitcnt vmcnt(55)" : "+v"(r11));
        o0_2 = mfma16(r11, Sp0_3, o0_2);
        o1_2 = mfma16(r11, Sp1_3, o1_2);
        asm volatile("global_load_dwordx4 %0, %1, off" : "+v"(r11) : "v"((const unsigned char*)(sp0 + ((size_t)(n + 1) * 40 + 11) * 1024) + voff) : "memory");
        __builtin_amdgcn_sched_barrier(0);
        asm volatile("s_waitcnt vmcnt(55)" : "+v"(r12));
        o0_3 = mfma16(r12, Sp0_0, o0_3);
        o1_3 = mfma16(r12, Sp1_0, o1_3);
        asm volatile("global_load_dwordx4 %0, %1, off" : "+v"(r12) : "v"((const unsigned char*)(sp0 + ((size_t)(n + 1) * 40 + 12) * 1024) + voff) : "memory");
        __builtin_amdgcn_sched_barrier(0);
        asm volatile("s_waitcnt vmcnt(55)" : "+v"(r13));
        o0_3 = mfma16(r13, Sp0_1, o0_3);
        o1_3 = mfma16(r13, Sp1_1, o1_3);
        asm volatile("global_load_dwordx4 %0, %1, off" : "+v"(r13) : "v"((const unsigned char*)(sp0 + ((size_t)(n + 1) * 40 + 13) * 1024) + voff) : "memory");
        __builtin_amdgcn_sched_barrier(0);
        asm volatile("s_waitcnt vmcnt(55)" : "+v"(r14));
        o0_3 = mfma16(r14, Sp0_2, o0_3);
        o1_3 = mfma16(r14, Sp1_2, o1_3);
        asm volatile("global_load_dwordx4 %0, %1, off" : "+v"(r14) : "v"((const unsigned char*)(sp0 + ((size_t)(n + 1) * 40 + 14) * 1024) + voff) : "memory");
        __builtin_amdgcn_sched_barrier(0);
        asm volatile("s_waitcnt vmcnt(55)" : "+v"(r15));
        o0_3 = mfma16(r15, Sp0_3, o0_3);
        o1_3 = mfma16(r15, Sp1_3, o1_3);
        asm volatile("global_load_dwordx4 %0, %1, off" : "+v"(r15) : "v"((const unsigned char*)(sp0 + ((size_t)(n + 1) * 40 + 15) * 1024) + voff) : "memory");
        __builtin_amdgcn_sched_barrier(0);
        asm volatile("s_waitcnt vmcnt(55)" : "+v"(r16));
        o0_0 = mfma16(r16, vp0_0, o0_0);
        o1_0 = mfma16(r16, vp1_0, o1_0);
        asm volatile("global_load_dwordx4 %0, %1, off" : "+v"(r16) : "v"((const unsigned char*)(sp0 + ((size_t)(n + 1) * 40 + 16) * 1024) + voff) : "memory");
        __builtin_amdgcn_sched_barrier(0);
        asm volatile("s_waitcnt vmcnt(55)" : "+v"(r17));
        o0_0 = mfma16(r17, vp0_1, o0_0);
        o1_0 = mfma16(r17, vp1_1, o1_0);
        asm volatile("global_load_dwordx4 %0, %1, off" : "+v"(r17) : "v"((const unsigned char*)(sp0 + ((size_t)(n + 1) * 40 + 17) * 1024) + voff) : "memory");
        __builtin_amdgcn_sched_barrier(0);
        asm volatile("s_waitcnt vmcnt(55)" : "+v"(r18));
        o0_1 = mfma16(r18, vp0_0, o0_1);
        o1_1 = mfma16(r18, vp1_0, o1_1);
        asm volatile("global_load_dwordx4 %0, %1, off" : "+v"(r18) : "v"((const unsigned char*)(sp0 + ((size_t)(n + 1) * 40 + 18) * 1024) + voff) : "memory");
        __builtin_amdgcn_sched_barrier(0);
        asm volatile("s_waitcnt vmcnt(55)" : "+v"(r19));
        o0_1 = mfma16(r19, vp0_1, o0_1);
        o1_1 = mfma16(r19, vp1_1, o1_1);
        asm volatile("global_load_dwordx4 %0, %1, off" : "+v"(r19) : "v"((const unsigned char*)(sp0 + ((size_t)(n + 1) * 40 + 19) * 1024) + voff) : "memory");
        __builtin_amdgcn_sched_barrier(0);
        asm volatile("s_waitcnt vmcnt(55)" : "+v"(r20));
        o0_2 = mfma16(r20, vp0_0, o0_2);
        o1_2 = mfma16(r20, vp1_0, o1_2);
        asm volatile("global_load_dwordx4 %0, %1, off" : "+v"(r20) : "v"((const unsigned char*)(sp0 + ((size_t)(n + 1) * 40 + 20) * 1024) + voff) : "memory");
        __builtin_amdgcn_sched_barrier(0);
        asm volatile("s_waitcnt vmcnt(55)" : "+v"(r21));
        o0_2 = mfma16(r21, vp0_1, o0_2);
        o1_2 = mfma16(r21, vp1_1, o1_2);
        asm volatile("global_load_dwordx4 %0, %1, off" : "+v"(r21) : "v"((const unsigned char*)(sp0 + ((size_t)(n + 1) * 40 + 21) * 1024) + voff) : "memory");
        __builtin_amdgcn_sched_barrier(0);
        asm volatile("s_waitcnt vmcnt(55)" : "+v"(r22));
        o0_3 = mfma16(r22, vp0_0, o0_3);
        o1_3 = mfma16(r22, vp1_0, o1_3);
        asm volatile("global_load_dwordx4 %0, %1, off" : "+v"(r22) : "v"((const unsigned char*)(sp0 + ((size_t)(n + 1) * 40 + 22) * 1024) + voff) : "memory");
        __builtin_amdgcn_sched_barrier(0);
        asm volatile("s_waitcnt vmcnt(55)" : "+v"(r23));
        o0_3 = mfma16(r23, vp0_1, o0_3);
        o1_3 = mfma16(r23, vp1_1, o1_3);
        asm volatile("global_load_dwordx4 %0, %1, off" : "+v"(r23) : "v"((const unsigned char*)(sp0 + ((size_t)(n + 1) * 40 + 23) * 1024) + voff) : "memory");
        __builtin_amdgcn_sched_barrier(0);
        { const unsigned char* obn = obu + (size_t)n * 64 * orow;
          { const unsigned v = f2bf(o0_0[0]); asm volatile("global_store_short %0, %1, off" :: "v"((const unsigned char*)(obn + (size_t)(0) * orow + 0) + ooff), "v"(v) : "memory"); }
          { const unsigned v = f2bf(o0_0[1]); asm volatile("global_store_short %0, %1, off" :: "v"((const unsigned char*)(obn + (size_t)(1) * orow + 0) + ooff), "v"(v) : "memory"); }
          { const unsigned v = f2bf(o0_0[2]); asm volatile("global_store_short %0, %1, off" :: "v"((const unsigned char*)(obn + (size_t)(2) * orow + 0) + ooff), "v"(v) : "memory"); }
          { const unsigned v = f2bf(o0_0[3]); asm volatile("global_store_short %0, %1, off" :: "v"((const unsigned char*)(obn + (size_t)(3) * orow + 0) + ooff), "v"(v) : "memory"); }
          { const unsigned v = f2bf(o0_1[0]); asm volatile("global_store_short %0, %1, off" :: "v"((const unsigned char*)(obn + (size_t)(16) * orow + 0) + ooff), "v"(v) : "memory"); }
          { const unsigned v = f2bf(o0_1[1]); asm volatile("global_store_short %0, %1, off" :: "v"((const unsigned char*)(obn + (size_t)(17) * orow + 0) + ooff), "v"(v) : "memory"); }
          { const unsigned v = f2bf(o0_1[2]); asm volatile("global_store_short %0, %1, off" :: "v"((const unsigned char*)(obn + (size_t)(18) * orow + 0) + ooff), "v"(v) : "memory"); }
          { const unsigned v = f2bf(o0_1[3]); asm volatile("global_store_short %0, %1, off" :: "v"((const unsigned char*)(obn + (size_t)(19) * orow + 0) + ooff), "v"(v) : "memory"); }
          { const unsigned v = f2bf(o0_2[0]); asm volatile("global_store_short %0, %1, off" :: "v"((const unsigned char*)(obn + (size_t)(32) * orow + 0) + ooff), "v"(v) : "memory"); }
          { const unsigned v = f2bf(o0_2[1]); asm volatile("global_store_short %0, %1, off" :: "v"((const unsigned char*)(obn + (size_t)(33) * orow + 0) + ooff), "v"(v) : "memory"); }
          { const unsigned v = f2bf(o0_2[2]); asm volatile("global_store_short %0, %1, off" :: "v"((const unsigned char*)(obn + (size_t)(34) * orow + 0) + ooff), "v"(v) : "memory"); }
          { const unsigned v = f2bf(o0_2[3]); asm volatile("global_store_short %0, %1, off" :: "v"((const unsigned char*)(obn + (size_t)(35) * orow + 0) + ooff), "v"(v) : "memory"); }
          { const unsigned v = f2bf(o0_3[0]); asm volatile("global_store_short %0, %1, off" :: "v"((const unsigned char*)(obn + (size_t)(48) * orow + 0) + ooff), "v"(v) : "memory"); }
          { const unsigned v = f2bf(o0_3[1]); asm volatile("global_store_short %0, %1, off" :: "v"((const unsigned char*)(obn + (size_t)(49) * orow + 0) + ooff), "v"(v) : "memory"); }
          { const unsigned v = f2bf(o0_3[2]); asm volatile("global_store_short %0, %1, off" :: "v"((const unsigned char*)(obn + (size_t)(50) * orow + 0) + ooff), "v"(v) : "memory"); }
          { const unsigned v = f2bf(o0_3[3]); asm volatile("global_store_short %0, %1, off" :: "v"((const unsigned char*)(obn + (size_t)(51) * orow + 0) + ooff), "v"(v) : "memory"); }
          { const unsigned v = f2bf(o1_0[0]); asm volatile("global_store_short %0, %1, off" :: "v"((const unsigned char*)(obn + (size_t)(0) * orow + 32) + ooff), "v"(v) : "memory"); }
          { const unsigned v = f2bf(o1_0[1]); asm volatile("global_store_short %0, %1, off" :: "v"((const unsigned char*)(obn + (size_t)(1) * orow + 32) + ooff), "v"(v) : "memory"); }
          { const unsigned v = f2bf(o1_0[2]); asm volatile("global_store_short %0, %1, off" :: "v"((const unsigned char*)(obn + (size_t)(2) * orow + 32) + ooff), "v"(v) : "memory"); }
          { const unsigned v = f2bf(o1_0[3]); asm volatile("global_store_short %0, %1, off" :: "v"((const unsigned char*)(obn + (size_t)(3) * orow + 32) + ooff), "v"(v) : "memory"); }
          { const unsigned v = f2bf(o1_1[0]); asm volatile("global_store_short %0, %1, off" :: "v"((const unsigned char*)(obn + (size_t)(16) * orow + 32) + ooff), "v"(v) : "memory"); }
          { const unsigned v = f2bf(o1_1[1]); asm volatile("global_store_short %0, %1, off" :: "v"((const unsigned char*)(obn + (size_t)(17) * orow + 32) + ooff), "v"(v) : "memory"); }
          { const unsigned v = f2bf(o1_1[2]); asm volatile("global_store_short %0, %1, off" :: "v"((const unsigned char*)(obn + (size_t)(18) * orow + 32) + ooff), "v"(v) : "memory"); }
          { const unsigned v = f2bf(o1_1[3]); asm volatile("global_store_short %0, %1, off" :: "v"((const unsigned char*)(obn + (size_t)(19) * orow + 32) + ooff), "v"(v) : "memory"); }
          { const unsigned v = f2bf(o1_2[0]); asm volatile("global_store_short %0, %1, off" :: "v"((const unsigned char*)(obn + (size_t)(32) * orow + 32) + ooff), "v"(v) : "memory"); }
          { const unsigned v = f2bf(o1_2[1]); asm volatile("global_store_short %0, %1, off" :: "v"((const unsigned char*)(obn + (size_t)(33) * orow + 32) + ooff), "v"(v) : "memory"); }
          { const unsigned v = f2bf(o1_2[2]); asm volatile("global_store_short %0, %1, off" :: "v"((const unsigned char*)(obn + (size_t)(34) * orow + 32) + ooff), "v"(v) : "memory"); }
          { const unsigned v = f2bf(o1_2[3]); asm volatile("global_store_short %0, %1, off" :: "v"((const unsigned char*)(obn + (size_t)(35) * orow + 32) + ooff), "v"(v) : "memory"); }
          { const unsigned v = f2bf(o1_3[0]); asm volatile("global_store_short %0, %1, off" :: "v"((const unsigned char*)(obn + (size_t)(48) * orow + 32) + ooff), "v"(v) : "memory"); }
          { const unsigned v = f2bf(o1_3[1]); asm volatile("global_store_short %0, %1, off" :: "v"((const unsigned char*)(obn + (size_t)(49) * orow + 32) + ooff), "v"(v) : "memory"); }
          { const unsigned v = f2bf(o1_3[2]); asm volatile("global_store_short %0, %1, off" :: "v"((const unsigned char*)(obn + (size_t)(50) * orow + 32) + ooff), "v"(v) : "memory"); }
          { const unsigned v = f2bf(o1_3[3]); asm volatile("global_store_short %0, %1, off" :: "v"((const unsigned char*)(obn + (size_t)(51) * orow + 32) + ooff), "v"(v) : "memory"); }
        }
        __builtin_amdgcn_sched_barrier(0);
    }
    asm volatile("s_waitcnt vmcnt(0)" ::: "memory");
    }
}

DI void p4_mixnorm(Frame& F, const float* ret_norm, const float* gdn_norm) {
    bf16_t* pj = (bf16_t*)(F.ws + WS_BIG + BIG_PJ); const bf16_t* vc = (const bf16_t*)(F.ws + AUX_VC); const bf16_t* rr = (const bf16_t*)(F.ws + AUX_QN);
    const int lane = F.lane, l32 = lane & 31, hh = lane >> 5;
    const f32x4 gr0 = *(const f32x4*)(ret_norm + 8 * l32), gr1 = *(const f32x4*)(ret_norm + 8 * l32 + 4), gg0 = *(const f32x4*)(gdn_norm + 8 * l32), gg1 = *(const f32x4*)(gdn_norm + 8 * l32 + 4);
    for (int m = F.gw; m < NTOK; m += F.NGW) {
        bf16_t* row = pj + (size_t)m * PJW;
        u32x4 ro[8], gt[8];
#pragma unroll
        for (int q = 0; q < 8; ++q) { const int hv = 2 * q + hh, hd = hv & 7; const bool gdn = hv >= 8;
            ro[q] = *(const u32x4*)((gdn ? vc : rr) + (size_t)m * 2048 + hd * 256 + 8 * l32);
            gt[q] = *(const u32x4*)(row + (gdn ? C_GZ : C_RG) + hd * 256 + 8 * l32); }
        asm volatile("" ::: "memory");
#pragma unroll
        for (int q = 0; q < 8; ++q) { const int hv = 2 * q + hh, hd = hv & 7; const bool gdn = q >= 4;
            float o[8] = {bflo(ro[q].x), bfhi(ro[q].x), bflo(ro[q].y), bfhi(ro[q].y), bflo(ro[q].z), bfhi(ro[q].z), bflo(ro[q].w), bfhi(ro[q].w)};
            float gv[8] = {bflo(gt[q].x), bfhi(gt[q].x), bflo(gt[q].y), bfhi(gt[q].y), bflo(gt[q].z), bfhi(gt[q].z), bflo(gt[q].w), bfhi(gt[q].w)};
            float ss = 0.f;
#pragma unroll
            for (int e = 0; e < 8; ++e) ss += o[e] * o[e];
            ss += __shfl_xor(ss, 1); ss += __shfl_xor(ss, 2); ss += __shfl_xor(ss, 4); ss += __shfl_xor(ss, 8); ss += __shfl_xor(ss, 16);
            const float rstd = 1.0f / sqrtf(ss * (1.0f / 256.0f) + EPS);
            const f32x4 g0 = gdn ? gg0 : gr0, g1 = gdn ? gg1 : gr1;
            u32x4 w; w.x = pk2(o[0] * rstd * g0.x * siluf(gv[0]), o[1] * rstd * g0.y * siluf(gv[1])); w.y = pk2(o[2] * rstd * g0.z * siluf(gv[2]), o[3] * rstd * g0.w * siluf(gv[3]));
            w.z = pk2(o[4] * rstd * g1.x * siluf(gv[4]), o[5] * rstd * g1.y * siluf(gv[5])); w.w = pk2(o[6] * rstd * g1.z * siluf(gv[6]), o[7] * rstd * g1.w * siluf(gv[7]));
            *(u32x4*)(row + (gdn ? C_GZ : C_RG) + hd * 256 + 8 * l32) = w; }
    }
}

DI void p11_swaprep(Frame& F, const float* qnorm, const float* knorm) {
    bf16_t* qkv = (bf16_t*)(F.ws + WS_BIG + BIG_QKV1); const f32x2* cs32 = (const f32x2*)(F.ws + AUX_CS32);
    const int lane = F.lane, l8 = lane & 7;
    const f32x4 gq0 = *(const f32x4*)(qnorm + 8 * l8), gq1 = *(const f32x4*)(qnorm + 8 * l8 + 4), gk0 = *(const f32x4*)(knorm + 8 * l8), gk1 = *(const f32x4*)(knorm + 8 * l8 + 4);
    const float sg = (l8 < 4) ? -1.f : 1.f;
    for (int m = F.gw; m < NTOK; m += F.NGW) {
        const int pos = m & (SEQ - 1);
        const f32x4* cp = (const f32x4*)(cs32 + (size_t)pos * 32 + 8 * (l8 & 3));
        const f32x4 c0 = cp[0], c1 = cp[1], c2 = cp[2], c3 = cp[3];
        bf16_t* row = qkv + (size_t)m * ODD_IN;
        u32x4 x[5];
#pragma unroll
        for (int i = 0; i < 5; ++i) { x[i] = (u32x4){0u, 0u, 0u, 0u}; if (i < 4 || lane < 32) x[i] = *(const u32x4*)(row + i * 512 + 8 * lane); }
        asm volatile("" ::: "memory");
#pragma unroll
        for (int i = 0; i < 5; ++i) {
            float v[8] = {bflo(x[i].x), bfhi(x[i].x), bflo(x[i].y), bfhi(x[i].y), bflo(x[i].z), bfhi(x[i].z), bflo(x[i].w), bfhi(x[i].w)};
            float ss = 0.f;
#pragma unroll
            for (int e = 0; e < 8; ++e) ss += v[e] * v[e];
            ss += __shfl_xor(ss, 1); ss += __shfl_xor(ss, 2); ss += __shfl_xor(ss, 4);
            const float rstd = 1.0f / sqrtf(ss * (1.0f / 64.0f) + EPS);
            const f32x4 g0 = i < 4 ? gq0 : gk0, g1 = i < 4 ? gq1 : gk1;
            v[0] *= rstd * g0.x; v[1] *= rstd * g0.y; v[2] *= rstd * g0.z; v[3] *= rstd * g0.w; v[4] *= rstd * g1.x; v[5] *= rstd * g1.y; v[6] *= rstd * g1.z; v[7] *= rstd * g1.w;
            float p[8];
#pragma unroll
            for (int e = 0; e < 8; ++e) p[e] = __shfl_xor(v[e], 4);
            u32x4 o;
            o.x = pk2(v[0] * c0.x + sg * p[0] * c0.y, v[1] * c0.z + sg * p[1] * c0.w); o.y = pk2(v[2] * c1.x + sg * p[2] * c1.y, v[3] * c1.z + sg * p[3] * c1.w);
            o.z = pk2(v[4] * c2.x + sg * p[4] * c2.y, v[5] * c2.z + sg * p[5] * c2.w); o.w = pk2(v[6] * c3.x + sg * p[6] * c3.y, v[7] * c3.z + sg * p[7] * c3.w);
            if (i < 4 || lane < 32) *(u32x4*)(row + i * 512 + 8 * lane) = o; }
    }
}
typedef float f32x16 __attribute__((ext_vector_type(16)));
DI f32x16 mfma32(bf16x8 a, bf16x8 b, f32x16 c) { return __builtin_amdgcn_mfma_f32_32x32x16_bf16(a, b, c, 0, 0, 0); }
DI void swa_phase(Frame& F, const float* sinks) {
    constexpr int KP = 144;
    bf16_t* qkv = (bf16_t*)(F.ws + WS_BIG + BIG_QKV1);
    LAS unsigned char* Ks = F.lds; LAS unsigned char* Vs = F.lds + 256 * KP;
    const unsigned vs_addr = (unsigned)(size_t)Vs;
    const int lane = F.lane, w = F.wave, h = lane >> 5, ql = lane & 31, q4 = (lane & 15) >> 2, p4 = lane & 3, blk = (lane >> 4) & 1;
    for (int unit = blockIdx.x; unit < 1024; unit += F.G) {
        const int b = unit >> 9, kvh = (unit >> 7) & 3, qb = unit & 127;
        const size_t tok0 = (size_t)b * SEQ + (size_t)qb * 128;
        __syncthreads();
#pragma unroll
        for (int i = 0; i < 4; ++i) { const int pc = F.tid + 512 * i, row = pc >> 3, c = pc & 7; const size_t tok = (qb == 0 && row < 128) ? tok0 : tok0 - 128 + row;
            const bf16_t* src = qkv + tok * ODD_IN + 2048 + kvh * 64 + c * 8;
            *(LAS u32x4*)(Ks + row * KP + c * 16) = *(const u32x4*)src; *(LAS u32x4*)(Vs + row * KP + c * 16) = *(const u32x4*)(src + 256); }
        __syncthreads();
        const int hq = kvh * 8 + w; const float sink = sinks[hq];
#pragma unroll 1
        for (int t = 0; t < 4; ++t) {
            bf16_t* qrow = qkv + (tok0 + 32 * t + ql) * ODD_IN + hq * 64;
            bf16x8 Qf[4];
#pragma unroll
            for (int s2 = 0; s2 < 4; ++s2) Qf[s2] = *(const bf16x8*)(qrow + 16 * s2 + 8 * h);
            f32x16 sc[5];
#pragma unroll
            for (int kt = 0; kt < 5; ++kt) {
#pragma unroll
                for (int r = 0; r < 16; ++r) sc[kt][r] = 0.f;
#pragma unroll
                for (int s2 = 0; s2 < 4; ++s2) { const bf16x8 a = *(const LAS bf16x8*)(Ks + (32 * (t + kt) + ql) * KP + (16 * s2 + 8 * h) * 2); sc[kt] = mfma32(a, Qf[s2], sc[kt]); } }
            float m = sink;
#pragma unroll
            for (int kt = 0; kt < 5; ++kt) { const bool tile_ok = !(qb == 0 && t + kt < 4);
#pragma unroll
                for (int r = 0; r < 16; ++r) { const int keyrow = (r & 3) + 8 * (r >> 2) + 4 * h; bool ok = tile_ok; if (kt == 0) ok = ok && (keyrow > ql); if (kt == 4) ok = ok && (keyrow <= ql);
                    const float v = ok ? sc[kt][r] * 0.125f : -1.0e30f; sc[kt][r] = v; m = fmaxf(m, v); } }
            m = fmaxf(m, __shfl_xor(m, 32));
            float l = 0.f;
#pragma unroll
            for (int kt = 0; kt < 5; ++kt)
#pragma unroll
                for (int r = 0; r < 16; ++r) { const float p = exp2f((sc[kt][r] - m) * 1.4426950408889634f); sc[kt][r] = p; l += p; }
            l += __shfl_xor(l, 32);
            l += exp2f((sink - m) * 1.4426950408889634f);
            f32x16 o0, o1;
#pragma unroll
            for (int r = 0; r < 16; ++r) { o0[r] = 0.f; o1[r] = 0.f; }
#pragma unroll
            for (int kt = 0; kt < 5; ++kt)
#pragma unroll
                for (int s2 = 0; s2 < 2; ++s2) { u32x4 pw; pw.x = pkbf(sc[kt][8 * s2], sc[kt][8 * s2 + 1]); pw.y = pkbf(sc[kt][8 * s2 + 2], sc[kt][8 * s2 + 3]); pw.z = pkbf(sc[kt][8 * s2 + 4], sc[kt][8 * s2 + 5]); pw.w = pkbf(sc[kt][8 * s2 + 6], sc[kt][8 * s2 + 7]);
                    const bf16x8 pb = __builtin_bit_cast(bf16x8, pw);
                    const unsigned ra = vs_addr + (unsigned)((32 * (t + kt) + 16 * s2 + 4 * h + q4) * KP + blk * 32 + p4 * 8);
                    s16x4 a00, a01, a10, a11; tr_read4(ra, ra + 8 * KP, ra + 64, ra + 8 * KP + 64, a00, a01, a10, a11);
                    o0 = mfma32(cat8(a00, a01), pb, o0); o1 = mfma32(cat8(a10, a11), pb, o1); }
            const float il = 1.0f / l;
            unsigned char* orow8 = F.ws + WS_H + (tok0 + 32 * t + ql) * D + hq * 64; const float il16 = il * 16.0f;
#pragma unroll
            for (int gq = 0; gq < 4; ++gq) { *(unsigned*)(orow8 + 8 * gq + 4 * h) = pk4fp8(o0[4 * gq] * il16, o0[4 * gq + 1] * il16, o0[4 * gq + 2] * il16, o0[4 * gq + 3] * il16);
                *(unsigned*)(orow8 + 32 + 8 * gq + 4 * h) = pk4fp8(o1[4 * gq] * il16, o1[4 * gq + 1] * il16, o1[4 * gq + 2] * il16, o1[4 * gq + 3] * il16); }
        }
    }
}

struct NoHandler { DI void operator()(int, float) const {} };
DI void moe_tables(Frame& F, const unsigned* cntg) {
    LAS int* cnt = (LAS int*)(F.lds + TBL_OFF); LAS int* tb = cnt + 32;
    __syncthreads();
    if (F.wave == 0) {
        const int e = F.lane & 31; const int c = (int)__hip_atomic_load(cntg + e * CSTR, __ATOMIC_RELAXED, __HIP_MEMORY_SCOPE_AGENT); const int t = (c + 255) >> 8; int inc = t;
#pragma unroll
        for (int d = 1; d < 32; d <<= 1) { const int o = __shfl_up(inc, d); if (e >= d) inc += o; }
        if (F.lane < 32) { cnt[e] = c; tb[e] = inc - t; if (e == 31) tb[32] = inc; } }
    __syncthreads();
}

constexpr int NPH = 19;

struct Args { const float* in[20]; float* out; unsigned char* ws; int ph_lo, ph_hi; };
__global__ void __launch_bounds__(NTHR, 2) mk_fwd(Args args) {
    extern __shared__ __attribute__((aligned(16))) unsigned char lds[];
    Frame F;
    F.lds = (LAS unsigned char*)lds; F.tid = threadIdx.x; F.lane = F.tid & 63; F.wave = __builtin_amdgcn_readfirstlane(F.tid >> 6); F.G = gridDim.x;
    F.gw = blockIdx.x * NWAVES + F.wave; F.NGW = F.G * NWAVES; F.ws = args.ws; F.ctl = (unsigned*)(args.ws + WS_CTL);
    volatile LAS unsigned* MISC = (volatile LAS unsigned*)(F.lds + MISC_OFF);
    if (F.tid < 64) MISC[F.tid] = 0u;
    __syncthreads();
    XcdBarrier bar; bar.bar = F.ctl + CW_BAR; bar.x = 0; bar.st = nullptr;
    if (!MK_MULTI) bar = xcd_barrier_post(F.ctl + CW_BAR, MISC + 8);
    const int lo = args.ph_lo, hi = args.ph_hi;
#ifdef ONLY_PH
#define IN(k) ((k) == ONLY_PH && lo <= (k) && (k) < hi)
#else
#define IN(k) (lo <= (k) && (k) < hi)
#endif
#define SEAM(k) do { if (IN(k) && IN((k) + 1)) xcd_barrier(bar); } while (0)
    const float* const* in = args.in;
    float* XC = args.out;
    bf16_t* XC16 = (bf16_t*)(F.ws + AUX_QN);
    bf16_t* H = (bf16_t*)(F.ws + WS_H);
    bf16_t* PJ = (bf16_t*)(F.ws + WS_BIG + BIG_PJ);
    unsigned char* aux = F.ws;
    const LAS int* tbl_cnt = (const LAS int*)(F.lds + TBL_OFF); const LAS int* tbl_tb = tbl_cnt + 32;
    LAS unsigned* tokoff = (LAS unsigned*)(F.lds + TOK_OFF);

    enum { P_W = 0, P_N0, P_G0, P_PREP, P_GA, P_SCAN, P_MIX, P_O0, P_M0A, P_M0B, P_M0C, P_N1, P_G1, P_SPREP, P_SWA, P_O1, P_M1A, P_M1B, P_M1C, P_FIN };
    static_assert(P_FIN == NPH, "phase count");
    if (IN(P_W)) { p0_weights(F, in); __syncthreads(); }
    SEAM(P_W);
    if (IN(P_N0)) {
        normproj_pass<0>(F, in[0], in[1], (const bf16_t*)(aux + AUX_SW), (const bf16_t*)(aux + AUX_SW) + 112 * D, H, (float*)(aux + AUX_BG), in[6], in[7], nullptr, nullptr, nullptr, nullptr);
    }
    SEAM(P_N0);
    if (IN(P_G0)) {
        pg8::DenseOrder S; S.init(NTOK, PJW, D, D, (const bf16_t*)(F.ws + WS_WIN0), F.G, blockIdx.x);
        pg8::EpiBf16 E{PJ, PJW};
        pg8::gemm_phase(F.lds, H, D, S, E);
    }
    SEAM(P_G0);
    if (IN(P_PREP)) p2_prep(F, in[5]);
    SEAM(P_PREP);
    if (IN(P_GA)) {
        for (int u = F.gw; u < 16 * NCH; u += F.NGW) {
            ga_unit<true>(F, u, (unsigned char*)args.out, nullptr);
            ga_unit<false>(F, u, F.ws + AUX_W, nullptr);
        }
        __syncthreads();
    }
    SEAM(P_GA);
    if (IN(P_SCAN)) {
        for (int id = blockIdx.x; id < 256; id += F.G) { const int idl = id & 127, bh = (idl % 8) * 2 + (idl / 8) / 8, sl = 2 * ((idl / 8) % 8);
            __syncthreads();
            if (F.tid == 0) { *(volatile LAS unsigned*)(F.lds + XL_CNT) = 0u; *(volatile LAS unsigned*)(F.lds + XL_CNT + 64) = 0u; }
            __syncthreads();
            if (id < 128) { if (F.wave == 0) scan_wave<true, 0>(F, bh, sl, (const unsigned char*)args.out, F.lds); else if (F.wave == 1) scan_wave<true, 1>(F, bh, sl, (const unsigned char*)args.out, F.lds); }
            else { if (F.wave == 0) scan_wave<false, 0>(F, bh, sl, F.ws + AUX_W, F.lds); else if (F.wave == 1) scan_wave<false, 1>(F, bh, sl, F.ws + AUX_W, F.lds); } }
        if (F.wave >= 2) convert_experts(F, in, 1, F.ws + WS_EXP1, F.ws + WS_EXP1 + 96 * MiB, blockIdx.x * 6 + (F.wave - 2), F.G * 6);
        __syncthreads();
    }
    SEAM(P_SCAN);
    if (IN(P_MIX)) p4_mixnorm(F, in[4], in[8]);
    SEAM(P_MIX);
    if (IN(P_O0)) {
        pg8::DenseOrder S; S.init(NTOK, D, 4096, PJW, (const bf16_t*)(F.ws + WS_WOUT0), F.G, blockIdx.x);
        pg8::EpiRes16<false> E{in[0], XC16, D};
        pg8::gemm_phase(F.lds, PJ + C_RG, 4096, S, E);
    }
    SEAM(P_O0);
#define MOE_LAYER(P, L, CNTW)                                                                                                                  \
    if (IN(P)) {                                                            \
        if (L == 0) convert_experts(F, in, 0, F.ws + WS_BIG + BIG_EGU, F.ws + WS_BIG + BIG_EDN, F.gw, F.NGW);     \
        __syncthreads();                                                                \
        normproj_pass<1, true>(F, XC16, in[2] + L * D, (const bf16_t*)(aux + AUX_SW) + (16 + L * 48) * D, (const bf16_t*)(aux + AUX_SW) + (112 + 16 + L * 48) * D, H, nullptr, nullptr, nullptr, F.ctl + CNTW, (int*)(aux + AUX_LIST), (float*)(aux + AUX_GW), (unsigned*)(aux + AUX_ASG)); \
        __syncthreads();                                                                                                                       \
    }                                                                                                                                          \
    SEAM(P);                                                                                                                                   \
    if (IN(P + 1)) {                                                                                                \
        moe_tables(F, F.ctl + CNTW);                                                                                                           \
        pg8::MoeOrder<true> S; S.init(tbl_tb, tokoff, 6, D, D, L == 0 ? F.ws + WS_BIG + BIG_EGU : F.ws + WS_EXP1, (size_t)1536 * D, F.G, blockIdx.x, 1);   \
        { pg8::Unit u; const int* list = (const int*)(aux + AUX_LIST);                                                                         \
          for (int ui = 0; ui < 12 && S.next(ui, u); ++ui) if (F.tid < 256) { const int idx = (u.pm - tbl_tb[u.e]) * 256 + F.tid;               \
              const int tok = idx < tbl_cnt[u.e] ? list[u.e * 65536 + idx] : 0; tokoff[ui * 256 + F.tid] = (unsigned)tok * (unsigned)D; } } \
        __syncthreads();                                                                                                                       \
        pg8::EpiSwiglu8 E{F.ws + WS_BIG + BIG_HID};                                                                                            \
        pg8::gemm_phase<pg8::EpiSwiglu8, pg8::MoeOrder<true>, true, 0x79797979, 0x7d7d7d7d>(F.lds, H, D, S, E);         \
    }                                                                                                                                          \
    SEAM(P + 1);                                                                                                                               \
    if (IN(P + 2)) {                                                                                  \
        moe_tables(F, F.ctl + CNTW);                                                                                                           \
        pg8::MoeOrder<false> S; S.init(tbl_tb, tokoff, 8, FF, FF, L == 0 ? F.ws + WS_BIG + BIG_EDN : F.ws + WS_EXP1 + 96 * MiB, (size_t)D * FF, F.G, blockIdx.x, 1);  \
        pg8::EpiDown E{(bf16_t*)(F.ws + WS_BIG + BIG_Y), (const float*)(aux + AUX_GW), tbl_tb};                                                \
        pg8::gemm_phase<pg8::EpiDown, pg8::MoeOrder<false>, true, 0x7a7a7a7a, 0x7c7c7c7c>(F.lds, F.ws + WS_BIG + BIG_HID, FF, S, E);     \
    }                                                                                                                                          \
    SEAM(P + 2);
    MOE_LAYER(P_M0A, 0, CW_CNT0)
    if (IN(P_N1)) {
        moe_tables(F, F.ctl + CW_CNT0);
        norm_pass<0, true, true, true, NoHandler, true, true, true>(F, XC16, XC16, (const bf16_t*)(F.ws + WS_BIG + BIG_Y), (const unsigned*)(aux + AUX_ASG), tbl_tb, in[1] + D, nullptr, H, NoHandler{});
        __syncthreads();
    }
    SEAM(P_N1);
    if (IN(P_G1)) {
        pg8::DenseOrder S; S.init(NTOK, ODD_IN, D, D, F.ws + WS_WIN1, F.G, blockIdx.x, 1);
        pg8::EpiBf16 E{(bf16_t*)(F.ws + WS_BIG + BIG_QKV1), ODD_IN};
        pg8::gemm_phase<pg8::EpiBf16, pg8::DenseOrder, true, 0x7a7a7a7a, 0x7d7d7d7d>(F.lds, H, D, S, E);
    }
    SEAM(P_G1);
    if (IN(P_SPREP)) p11_swaprep(F, in[11], in[12]);
    SEAM(P_SPREP);
    if (IN(P_SWA)) { swa_phase(F, in[13]); __syncthreads(); }
    SEAM(P_SWA);
    if (IN(P_O1)) {
        pg8::DenseOrder S; S.init(NTOK, D, D, D, F.ws + WS_WOUT1, F.G, blockIdx.x, 1);
        pg8::EpiRes16<true> E{XC16, XC16, D};
        pg8::gemm_phase<pg8::EpiRes16<true>, pg8::DenseOrder, true, 0x7a7a7a7a, 0x7b7b7b7b>(F.lds, F.ws + WS_H, D, S, E);
    }
    SEAM(P_O1);
    MOE_LAYER(P_M1A, 1, CW_CNT1)
    if (IN(P_FIN)) {
        moe_tables(F, F.ctl + CW_CNT1);
        norm_pass<0, true, true, false, NoHandler, false, true, false>(F, XC16, XC, (const bf16_t*)(F.ws + WS_BIG + BIG_Y), (const unsigned*)(aux + AUX_ASG), tbl_tb, nullptr, nullptr, nullptr, NoHandler{});
    }
#undef IN
#undef SEAM
}

extern "C" void kernel_launch(void* const* d_in, const int* in_sizes, int n_in, void* d_out, int out_size, void* d_ws, size_t ws_size, hipStream_t stream) {
    static int grid = 0;
    if (grid == 0) {
        if (n_in != 20 || in_sizes[0] != NTOK * D || out_size != NTOK * D || ws_size < WS_END) { fprintf(stderr, "kernel_launch: unexpected shapes / workspace (n_in %d, in0 %d, out %d, ws %zu, need %zu)\n", n_in, n_in > 0 ? in_sizes[0] : -1, out_size, ws_size, (size_t)WS_END); grid = -1; return; }
        int dev = 0, cus = 0, per_cu = 0;
        if (hipGetDevice(&dev) != hipSuccess || hipDeviceGetAttribute(&cus, hipDeviceAttributeMultiprocessorCount, dev) != hipSuccess) { grid = -1; return; }
        if (hipFuncSetAttribute((const void*)mk_fwd, hipFuncAttributeMaxDynamicSharedMemorySize, LDS_BYTES) != hipSuccess) { fprintf(stderr, "kernel_launch: hipFuncSetAttribute failed\n"); grid = -1; return; }
        if (hipOccupancyMaxActiveBlocksPerMultiprocessor(&per_cu, (const void*)mk_fwd, NTHR, LDS_BYTES) != hipSuccess || per_cu < 1) fprintf(stderr, "kernel_launch: occupancy query reports %d\n", per_cu);
        (void)hipGetLastError();
        if (cus < 256) { fprintf(stderr, "kernel_launch: built for 256 CUs (got %d)\n", cus); grid = -1; return; }
        grid = 256;
    }
    if (grid < 0) return;
    (void)hipMemsetAsync((char*)d_ws + WS_CTL, 0, CTL_ZERO_BYTES, stream);
    Args a{};
    for (int i = 0; i < 20; ++i) a.in[i] = (const float*)d_in[i];
    a.out = (float*)d_out; a.ws = (unsigned char*)d_ws;
#if MK_MULTI
    for (int p = 0; p <= NPH; ++p) { a.ph_lo = p; a.ph_hi = p + 1; hipLaunchKernelGGL(mk_fwd, dim3(grid), dim3(NTHR), LDS_BYTES, stream, a); }
#else
    a.ph_lo = 0; a.ph_hi = NPH + 1;
    hipLaunchKernelGGL(mk_fwd, dim3(grid), dim3(NTHR), LDS_BYTES, stream, a);
#endif
}
```

```cpp
#include <hip/hip_runtime.h>
#include <cstdio>
#include <cstdint>

#ifndef MK_MULTI
#define MK_MULTI 0
#endif

#define LAS __attribute__((address_space(3)))
typedef unsigned short bf16_t;
typedef short bf16x8 __attribute__((ext_vector_type(8)));
typedef float f32x4 __attribute__((ext_vector_type(4)));
typedef float f32x2 __attribute__((ext_vector_type(2)));
typedef unsigned u32x4 __attribute__((ext_vector_type(4)));
typedef unsigned u32x2 __attribute__((ext_vector_type(2)));
#define DI __device__ __forceinline__

constexpr int D = 2048, BATCH = 2, SEQ = 16384, NTOK = BATCH * SEQ;
constexpr int EVEN_IN = 12304, PJW = 12288;
constexpr int ODD_IN = 2560;
constexpr int NEXP = 32, FF = 768, TOPK = 2, MAXT = 288;
constexpr float EPS = 1e-6f;
constexpr double ROPE_R = 0.86596432336006535;
constexpr int C_RQ = 0, C_RK = 1024, C_RV = 2048, C_GQKV = 4096, C_RG = 8192, C_GZ = 10240;

constexpr size_t MiB = 1u << 20;
constexpr size_t WS_CTL = 0, CTL_ZERO_BYTES = 1 * MiB;
constexpr size_t WS_WIN0 = 2 * MiB;
constexpr size_t WS_WOUT0 = WS_WIN0 + 48 * MiB;
constexpr size_t WS_WIN1 = WS_WOUT0 + 16 * MiB;
constexpr size_t WS_WOUT1 = WS_WIN1 + 10 * MiB;
constexpr size_t WS_H = 84 * MiB;
constexpr size_t WS_BIG = 212 * MiB;
constexpr size_t WS_AUX = 980 * MiB;
constexpr size_t WS_MISC = 1540 * MiB;
constexpr size_t WS_EXP1 = 1396 * MiB;
constexpr size_t WS_END = 1572 * MiB;
constexpr size_t BIG_PJ = 0;
constexpr size_t BIG_EGU = 0;
constexpr size_t BIG_EDN = 192 * MiB;
constexpr size_t BIG_HID = 288 * MiB;
constexpr size_t BIG_Y = 400 * MiB;
constexpr size_t BIG_QKV1 = 0;
constexpr size_t AUX_QN = WS_AUX + 0;
constexpr size_t AUX_KN = WS_AUX + 64 * MiB;
constexpr size_t AUX_VC = WS_AUX + 128 * MiB;
constexpr size_t AUX_W = WS_AUX + 256 * MiB;
constexpr size_t AUX_ATT = WS_AUX + 320 * MiB;
constexpr size_t AUX_RST = WS_AUX + 352 * MiB;
constexpr size_t AUX_BG = WS_MISC + 0;
constexpr size_t AUX_CS = WS_MISC + 2 * MiB;
constexpr size_t AUX_DEC = WS_MISC + 10 * MiB + 960 * 1024;
constexpr size_t AUX_SW = WS_MISC + 10 * MiB;
constexpr size_t AUX_LIST = WS_MISC + 11 * MiB;
constexpr size_t AUX_GW = WS_MISC + 19 * MiB;
constexpr size_t AUX_ASG = WS_MISC + 27 * MiB;
constexpr size_t AUX_CS32 = WS_MISC + 28 * MiB;
static_assert(AUX_CS32 + 4 * MiB <= WS_END && AUX_W + 160 * MiB <= WS_EXP1 && WS_EXP1 + 144 * MiB <= WS_MISC, "aux map");
constexpr int CW_BAR = 4096;
constexpr int CSTR = 1088;
constexpr int CW_CNT0 = 16384, CW_CNT1 = 16384 + 40960;

constexpr int RING_BYTES = 131072;
constexpr int GA_LDS_WAVE = 17920;
constexpr int MISC_OFF = 8 * GA_LDS_WAVE;
constexpr int TBL_OFF = MISC_OFF + 256;
constexpr int TOK_OFF = MISC_OFF + 1024;
constexpr int LDS_BYTES = 163840;
static_assert(TOK_OFF + 12 * 1024 <= LDS_BYTES, "lds map");
DI float rdlane(float v, int l) { return __builtin_bit_cast(float, __builtin_amdgcn_readlane(__builtin_bit_cast(int, v), l)); }

typedef __bf16 bf16v2 __attribute__((ext_vector_type(2)));
DI unsigned pkbf(float a, float b) { f32x2 v = {a, b}; return __builtin_bit_cast(unsigned, __builtin_convertvector(v, bf16v2)); }
DI unsigned f2bf(float f) { return pkbf(f, 0.f) & 0xffffu; }
DI unsigned pk2(float lo, float hi) { return pkbf(lo, hi); }
DI float bflo(unsigned w) { return __builtin_bit_cast(float, w << 16); }
DI float bfhi(unsigned w) { return __builtin_bit_cast(float, w & 0xffff0000u); }
DI float bf2f(bf16_t b) { return __builtin_bit_cast(float, ((unsigned)b) << 16); }
DI unsigned cvt_pk_bf16(float lo, float hi) { unsigned r; asm volatile("v_cvt_pk_bf16_f32 %0, %1, %2" : "=v"(r) : "v"(lo), "v"(hi)); return r; }
DI float wave_sum(float v) {
#pragma unroll
    for (int o = 1; o < 64; o <<= 1) v += __shfl_xor(v, o);
    return v;
}
DI float siluf(float x) { return x / (1.0f + __expf(-x)); }
DI unsigned pk4fp8(float a, float b, float c, float d) { int w = __builtin_amdgcn_cvt_pk_fp8_f32(a, b, 0, false); w = __builtin_amdgcn_cvt_pk_fp8_f32(c, d, w, true); return (unsigned)w; }
DI f32x4 mfma16(bf16x8 a, bf16x8 b, f32x4 c) { return __builtin_amdgcn_mfma_f32_16x16x32_bf16(a, b, c, 0, 0, 0); }
#define LDS_WAIT() asm volatile("s_waitcnt lgkmcnt(0)" ::: "memory")
#define VM_WAIT() asm volatile("s_waitcnt vmcnt(0)" ::: "memory")

#define XB_TMO      128
#define XB_XCNT(j)  (256  + 64 * (j))
#define XB_XSUB(j)  (1280 + 64 * (j))
#define XB_XGEN(j)  (2304 + 64 * (j))
#define XB_TOP      3328
#define XB_TOPGEN   3392
#define XCD_BAR_WORDS 3456
#define XB_SPIN_CAP (1u << 22)
DI unsigned xb_ld(unsigned* p)              { return __hip_atomic_load(p, __ATOMIC_RELAXED, __HIP_MEMORY_SCOPE_AGENT); }
DI unsigned xb_add(unsigned* p, unsigned v) { return __hip_atomic_fetch_add(p, v, __ATOMIC_RELAXED, __HIP_MEMORY_SCOPE_AGENT); }
DI unsigned xb_xcc_id() { return (unsigned)__builtin_amdgcn_s_getreg((3 << 11) | 20) & 0xFu; }
#define XB_SPIN(cond, bar) do { unsigned _sp = 0; while (cond) { __builtin_amdgcn_s_sleep(1); \
    if ((++_sp & 255u) == 0u) { if (xb_ld(&(bar)[XB_TMO])) break; if (_sp > XB_SPIN_CAP) { atomicAdd(&(bar)[XB_TMO], 1u); break; } } } } while (0)
struct XcdBarrier { unsigned* bar; unsigned x; volatile LAS unsigned* st; };
DI XcdBarrier xcd_barrier_post(unsigned* bar, volatile LAS unsigned* st) {
    XcdBarrier b; b.bar = bar; b.x = xb_xcc_id(); b.st = st;
    if (threadIdx.x == 0) (void)xb_add(&bar[XB_XCNT(b.x)], 1u);
    return b;
}
DI void xcd_barrier_complete(unsigned* bar, unsigned x, unsigned& nloc, unsigned& nx) {
    const unsigned G = gridDim.x * gridDim.y * gridDim.z;
    unsigned sum, cnt, mine, sp = 0u;
    for (;;) {
        sum = 0u; cnt = 0u; mine = 0u;
#pragma unroll
        for (unsigned j = 0; j < 16; ++j) { const unsigned c = xb_ld(&bar[XB_XCNT(j)]); sum += c; cnt += (c > 0u) ? 1u : 0u; mine = (j == x) ? c : mine; }
        if (sum == G) break;
        __builtin_amdgcn_s_sleep(1);
        if ((++sp & 255u) == 0u) { if (xb_ld(&bar[XB_TMO])) break; if (sp > XB_SPIN_CAP) { atomicAdd(&bar[XB_TMO], 1u); break; } }
    }
    nloc = mine > 0u ? mine : 1u; nx = cnt > 0u ? cnt : 1u;
}
DI void xcd_barrier(const XcdBarrier& b) {
    asm volatile("s_waitcnt vmcnt(0)" ::: "memory");
    __syncthreads();
    if (threadIdx.x == 0) {
        unsigned* bar = b.bar;
        __builtin_amdgcn_s_waitcnt(0);
        unsigned nloc = b.st[0], nx = b.st[1];
        if (nloc == 0u) { xcd_barrier_complete(bar, b.x, nloc, nx); b.st[0] = nloc; b.st[1] = nx; }
        const unsigned old = xb_add(&bar[XB_XSUB(b.x)], 1u);
        const unsigned gen = old / nloc;
        if (old + 1u == (gen + 1u) * nloc) {
            __builtin_amdgcn_fence(__ATOMIC_RELEASE, "agent");
            asm volatile("s_waitcnt vmcnt(0)" ::: "memory");
            const unsigned og = xb_add(&bar[XB_TOP], 1u);
            const unsigned tg = og / nx;
            if (og + 1u == (tg + 1u) * nx) xb_add(&bar[XB_TOPGEN], 1u);
            else XB_SPIN(xb_ld(&bar[XB_TOPGEN]) == tg, bar);
            __builtin_amdgcn_fence(__ATOMIC_ACQUIRE, "agent");
            xb_add(&bar[XB_XGEN(b.x)], 1u);
            asm volatile("s_waitcnt vmcnt(0)" ::: "memory");
        } else {
            XB_SPIN(xb_ld(&bar[XB_XGEN(b.x)]) == gen, bar);
            __builtin_amdgcn_fence(__ATOMIC_ACQUIRE, "agent");
            asm volatile("s_waitcnt vmcnt(0)" ::: "memory");
        }
    }
    __syncthreads();
}

namespace pg8 {
constexpr int BM = 256, BK = 64, HALF = 128, HTB = HALF * BK * 2, STAGE_BYTES = 8 * HTB, NXCD = 8, WGM = 8;
__host__ __device__ __forceinline__ int lds_byte(int r, int c) { const int st = (r >> 4) * 2 + (c >> 5), rr = r & 15, cc = c & 31, ob = rr * 64 + cc * 2; return st * 1024 + (ob ^ (((ob >> 9) & 1) << 5)); }
__host__ __device__ __forceinline__ void stage_rc(int b, int& R, int& C) { const int st = b / 1024, sb = b % 1024, swz = sb ^ (((sb >> 9) & 1) << 5); R = (st >> 1) * 16 + swz / 64; C = (st & 1) * 32 + (swz % 64) / 2; }
__host__ __device__ __forceinline__ int perm32(int rho) { const int n = rho >> 4, i = rho & 15; return 8 * (i >> 2) + 4 * n + (i & 3); }

struct Unit { int pm, pn, e, slot; };

DI int xcd_remap(int L, int nwg) { const int q = nwg / NXCD, r = nwg % NXCD, xcd = L % NXCD, off = L / NXCD; return (xcd < r ? xcd * (q + 1) : r * (q + 1) + (xcd - r) * q) + off; }

struct DenseOrder {
    int nM, nN, nwg, G, c; unsigned lda2; const char* Bt; size_t tstepB;
    DI void init(int M, int N, int K, int lda, const void* Bt_, int G_, int c_, int EB = 2) { nM = M / BM; nN = N / BM; nwg = nM * nN; G = G_; c = c_; lda2 = (unsigned)(lda * EB); Bt = (const char*)Bt_; tstepB = (size_t)BM * K * EB; }
    DI bool next(int i, Unit& u) const {
        const long L = (long)i * G + c; if (L >= nwg) return false;
        const int wgid = xcd_remap((int)L, nwg);
        const int nig = WGM * nN, gid = wgid / nig, fm = gid * WGM, gsz = (nM - fm) < WGM ? (nM - fm) : WGM;
        u.pm = fm + ((wgid % nig) % gsz); u.pn = (wgid % nig) / gsz; u.e = 0; u.slot = i; return true;
    }
    DI unsigned a_off(const Unit& u, int h, int R) const { return (unsigned)(u.pm * BM + h * HALF + R) * lda2; }
    DI const char* b_base(const Unit& u) const { return Bt + (size_t)u.pn * tstepB; }
};
template <bool GATHER> struct MoeOrder {
    const LAS int* tb; const LAS unsigned* tokoff; int NT, nwg, G, c; unsigned lda2; const char* Bt; size_t estepB, tstepB;
    DI void init(const LAS int* tb_, const LAS unsigned* tokoff_, int NT_, int K, int lda, const void* Bt_, size_t estep_elems, int G_, int c_, int EB = 2) {
        tb = tb_; tokoff = tokoff_; NT = NT_; nwg = tb_[32] * NT_; G = G_; c = c_; lda2 = (unsigned)(lda * EB); Bt = (const char*)Bt_; estepB = estep_elems * EB; tstepB = (size_t)BM * K * EB; }
    DI bool next(int i, Unit& u) const {
        const long L = (long)i * G + c; if (L >= nwg) return false;
        const int w = xcd_remap((int)L, nwg);
        int e = 0;
#pragma unroll 1
        for (int s = 16; s >= 1; s >>= 1) if (tb[e + s] * NT <= w) e += s;
        const int nt = tb[e + 1] - tb[e], local = w - tb[e] * NT;
        u.e = e; u.pn = local / nt; u.pm = tb[e] + local % nt; u.slot = i; return true;
    }
    DI unsigned a_off(const Unit& u, int h, int R) const { if (GATHER) return tokoff[u.slot * 256 + h * HALF + R]; return (unsigned)(u.pm * BM + h * HALF + R) * lda2; }
    DI const char* b_base(const Unit& u) const { return Bt + (size_t)u.e * estepB + (size_t)u.pn * tstepB; }
};

struct EpiBf16 {
    static constexpr bool PERM = true;
    bf16_t* O; int ldc;
    DI void operator()(const f32x4 (&acc)[2][2][4][2], const Unit& u, int wr, int wc, int fr, int fq) const {
        const int row0 = u.pm * BM + wr * 64 + fr, col0 = u.pn * BM + wc * 32 + 8 * fq;
#pragma unroll
        for (int ai = 0; ai < 2; ++ai)
#pragma unroll
            for (int m = 0; m < 4; ++m) { bf16_t* rowp = O + (size_t)(row0 + ai * HALF + m * 16) * ldc + col0;
#pragma unroll
                for (int bj = 0; bj < 2; ++bj) { const f32x4 v0 = acc[ai][bj][m][0], v1 = acc[ai][bj][m][1];
                    u32x4 w; w.x = cvt_pk_bf16(v0[0], v0[1]); w.y = cvt_pk_bf16(v0[2], v0[3]); w.z = cvt_pk_bf16(v1[0], v1[1]); w.w = cvt_pk_bf16(v1[2], v1[3]);
                    *(u32x4*)(rowp + bj * HALF) = w; } }
    }
};
struct EpiResF32 {
    static constexpr bool PERM = false;
    const float* base; float* out; int ldc;
    DI void operator()(const f32x4 (&acc)[2][2][4][2], const Unit& u, int wr, int wc, int fr, int fq) const {
        const int row0 = u.pm * BM + wr * 64 + fr, col0 = u.pn * BM + wc * 32 + 4 * fq;
#pragma unroll
        for (int ai = 0; ai < 2; ++ai)
#pragma unroll
            for (int m = 0; m < 4; ++m) { const size_t off = (size_t)(row0 + ai * HALF + m * 16) * ldc + col0;
#pragma unroll
                for (int bj = 0; bj < 2; ++bj)
#pragma unroll
                    for (int n = 0; n < 2; ++n) { const f32x4 bs = *(const f32x4*)(base + off + bj * HALF + n * 16); *(f32x4*)(out + off + bj * HALF + n * 16) = bs + acc[ai][bj][m][n]; }
                asm volatile("" ::: "memory"); }
    }
};
template <bool BASE16> struct EpiRes16 {
    static constexpr bool PERM = true;
    const void* base; bf16_t* out; int ldc;
    DI void operator()(const f32x4 (&acc)[2][2][4][2], const Unit& u, int wr, int wc, int fr, int fq) const {
        const int row0 = u.pm * BM + wr * 64 + fr, col0 = u.pn * BM + wc * 32 + 8 * fq;
#pragma unroll
        for (int ai = 0; ai < 2; ++ai)
#pragma unroll
            for (int m = 0; m < 4; ++m) { const size_t off = (size_t)(row0 + ai * HALF + m * 16) * ldc + col0;
#pragma unroll
                for (int bj = 0; bj < 2; ++bj) { f32x4 v0 = acc[ai][bj][m][0], v1 = acc[ai][bj][m][1];
                    if (BASE16) { const u32x4 b = *(const u32x4*)((const bf16_t*)base + off + bj * HALF); v0 += (f32x4){bflo(b.x), bfhi(b.x), bflo(b.y), bfhi(b.y)}; v1 += (f32x4){bflo(b.z), bfhi(b.z), bflo(b.w), bfhi(b.w)}; }
                    else { const float* bp = (const float*)base + off + bj * HALF; v0 += *(const f32x4*)bp; v1 += *(const f32x4*)(bp + 4); }
                    u32x4 w; w.x = cvt_pk_bf16(v0[0], v0[1]); w.y = cvt_pk_bf16(v0[2], v0[3]); w.z = cvt_pk_bf16(v1[0], v1[1]); w.w = cvt_pk_bf16(v1[2], v1[3]);
                    *(u32x4*)(out + off + bj * HALF) = w; }
                asm volatile("" ::: "memory"); }
    }
};
struct EpiSwiglu {
    static constexpr bool PERM = true;
    bf16_t* O;
    DI void operator()(const f32x4 (&acc)[2][2][4][2], const Unit& u, int wr, int wc, int fr, int fq) const {
        const int row0 = u.pm * BM + wr * 64 + fr, col0 = u.pn * HALF + wc * 32 + 8 * fq;
#pragma unroll
        for (int ai = 0; ai < 2; ++ai)
#pragma unroll
            for (int m = 0; m < 4; ++m) { bf16_t* rowp = O + (size_t)(row0 + ai * HALF + m * 16) * FF + col0;
                float h[8];
#pragma unroll
                for (int n = 0; n < 2; ++n)
#pragma unroll
                    for (int j = 0; j < 4; ++j) { const float g = acc[ai][0][m][n][j], up = acc[ai][1][m][n][j]; h[n * 4 + j] = g / (1.0f + __expf(-g)) * up; }
                u32x4 w; w.x = cvt_pk_bf16(h[0], h[1]); w.y = cvt_pk_bf16(h[2], h[3]); w.z = cvt_pk_bf16(h[4], h[5]); w.w = cvt_pk_bf16(h[6], h[7]);
                *(u32x4*)rowp = w; }
    }
};
struct EpiSwiglu8 {
    static constexpr bool PERM = true;
    unsigned char* O;
    DI void operator()(const f32x4 (&acc)[2][2][4][2], const Unit& u, int wr, int wc, int fr, int fq) const {
        const int row0 = u.pm * BM + wr * 64 + fr, col0 = u.pn * HALF + wc * 32 + 8 * fq;
#pragma unroll
        for (int ai = 0; ai < 2; ++ai)
#pragma unroll
            for (int m = 0; m < 4; ++m) { unsigned char* rowp = O + (size_t)(row0 + ai * HALF + m * 16) * FF + col0;
                float h[8];
#pragma unroll
                for (int n = 0; n < 2; ++n)
#pragma unroll
                    for (int j = 0; j < 4; ++j) { const float g = acc[ai][0][m][n][j], up = acc[ai][1][m][n][j]; h[n * 4 + j] = g / (1.0f + __expf(-g)) * up * 8.0f; }
                u32x2 w; w.x = pk4fp8(h[0], h[1], h[2], h[3]); w.y = pk4fp8(h[4], h[5], h[6], h[7]);
                *(u32x2*)rowp = w; }
    }
};
struct EpiDown {
    static constexpr bool PERM = true;
    bf16_t* O; const float* gw; const LAS int* tb;
    DI void operator()(const f32x4 (&acc)[2][2][4][2], const Unit& u, int wr, int wc, int fr, int fq) const {
        const int row0 = u.pm * BM + wr * 64 + fr, col0 = u.pn * BM + wc * 32 + 8 * fq;
        const int lrow0 = (u.pm - tb[u.e]) * BM + wr * 64 + fr;
        const float* gwe = gw + (size_t)u.e * 65536;
#pragma unroll
        for (int ai = 0; ai < 2; ++ai)
#pragma unroll
            for (int m = 0; m < 4; ++m) { unsigned char* rowp = (unsigned char*)O + (size_t)(row0 + ai * HALF + m * 16) * D + col0; const float g = gwe[lrow0 + ai * HALF + m * 16] * 16.0f;
#pragma unroll
                for (int bj = 0; bj < 2; ++bj) { const f32x4 v0 = acc[ai][bj][m][0] * g, v1 = acc[ai][bj][m][1] * g;
                    u32x2 w; w.x = pk4fp8(v0[0], v0[1], v0[2], v0[3]); w.y = pk4fp8(v1[0], v1[1], v1[2], v1[3]);
                    *(u32x2*)(rowp + bj * HALF) = w; } }
    }
};

typedef int v8i __attribute__((ext_vector_type(8)));
typedef int v4i __attribute__((ext_vector_type(4)));
template <class Epi, class Sched, bool FP8 = false, int SCW = 0x7f7f7f7f, int SCA = 0x7f7f7f7f>
DI void gemm_phase(LAS unsigned char* lds, const void* Aptr, int K, const Sched& S, const Epi& E) {
    constexpr int EB = FP8 ? 1 : 2;
    const int tid = threadIdx.x, wid = __builtin_amdgcn_readfirstlane(tid >> 6), lane = tid & 63, wr = wid >> 2, wc = wid & 3, fr = lane & 15, fq = lane >> 4;
    const int nt = K * EB / (BK * 2);
    const char* Ab = (const char*)Aptr;
    int Rr[2], Cc[2]; unsigned voffB[2];
#pragma unroll
    for (int i = 0; i < 2; ++i) { int R, C; stage_rc(tid * 16 + i * 8192, R, C); const int Rb = Epi::PERM ? ((R & ~31) + perm32(R & 31)) : R; Rr[i] = R; Cc[i] = C * 2; voffB[i] = (unsigned)(Rb * K * EB + C * 2); }
    const unsigned kstep = (unsigned)(BK * 2);
    const size_t hstepB = (size_t)HALF * K * EB;
    const unsigned ldsw = (unsigned)wid * 1024u;
    const int aoff = lds_byte(wr * 64 + fr, fq * (FP8 ? 16 : 8)), boff = lds_byte(wc * 32 + fr, fq * (FP8 ? 16 : 8));
#define PG8_SA(b, h) (((b) * 2 + (h)) * HTB)
#define PG8_SB(b, h) ((4 + (b) * 2 + (h)) * HTB)
#define PG8_STAGEB(bufoff, gbase) do { _Pragma("unroll") for (int _i = 0; _i < 2; ++_i) \
        __builtin_amdgcn_global_load_lds((const unsigned*)((const char*)(gbase) + voffB[_i]), (LAS unsigned*)(lds + (bufoff) + ldsw + _i * 8192), 16, 0, 0); } while (0)
#define PG8_STAGEA(bufoff, offs, kb) do { _Pragma("unroll") for (int _i = 0; _i < 2; ++_i) \
        __builtin_amdgcn_global_load_lds((const unsigned*)(Ab + (size_t)((offs)[_i] + (kb))), (LAS unsigned*)(lds + (bufoff) + ldsw + _i * 8192), 16, 0, 0); } while (0)
#define PG8_LDA(dst, b, h) do { _Pragma("unroll") for (int m = 0; m < 4; ++m) { if constexpr (FP8) { dst##8[m] = *(const LAS v8i*)(lds + PG8_SA(b, h) + aoff + m * 2048); } \
        else { _Pragma("unroll") for (int k = 0; k < 2; ++k) dst[m][k] = *(const LAS bf16x8*)(lds + PG8_SA(b, h) + aoff + m * 2048 + k * 1024); } } } while (0)
#define PG8_LDB(dst, b, h) do { _Pragma("unroll") for (int n = 0; n < 2; ++n) { if constexpr (FP8) { dst##8[n] = *(const LAS v8i*)(lds + PG8_SB(b, h) + boff + n * 2048); } \
        else { _Pragma("unroll") for (int k = 0; k < 2; ++k) dst[n][k] = *(const LAS bf16x8*)(lds + PG8_SB(b, h) + boff + n * 2048 + k * 1024); } } } while (0)
#define PG8_MMA(ai, bj, At, Bt) do { __builtin_amdgcn_s_setprio(1); _Pragma("unroll") for (int m = 0; m < 4; ++m) _Pragma("unroll") for (int n = 0; n < 2; ++n) { \
        if constexpr (FP8) asm volatile("v_mfma_scale_f32_16x16x128_f8f6f4 %0, %1, %2, %0, %3, %4 op_sel_hi:[0,0,0]" : "+v"(acc[ai][bj][m][n]) : "v"(Bt##8[n]), "v"(At##8[m]), "v"(scw_), "v"(sca_)); \
        else { _Pragma("unroll") for (int k = 0; k < 2; ++k) acc[ai][bj][m][n] = __builtin_amdgcn_mfma_f32_16x16x32_bf16(Bt[n][k], At[m][k], acc[ai][bj][m][n], 0, 0, 0); } } __builtin_amdgcn_s_setprio(0); } while (0)
#define PG8_WAIT_V(n) asm volatile("s_waitcnt vmcnt(" #n ")" ::: "memory")
#define PG8_WAIT_L(n) asm volatile("s_waitcnt lgkmcnt(" #n ")" ::: "memory")
#define PG8_BAR __builtin_amdgcn_s_barrier()
#define PG8_SCHED __builtin_amdgcn_sched_barrier(0)
    Unit cur, nxt; int ui = 0;
    if (!S.next(0, cur)) return;
    f32x4 acc[2][2][4][2];
#pragma unroll
    for (int a = 0; a < 2; ++a)
#pragma unroll
        for (int b = 0; b < 2; ++b)
#pragma unroll
            for (int m = 0; m < 4; ++m)
#pragma unroll
                for (int n = 0; n < 2; ++n) acc[a][b][m][n] = (f32x4){0.f, 0.f, 0.f, 0.f};
    const int scw_ = SCW, sca_ = SCA; (void)scw_; (void)sca_;
    bf16x8 At[4][2], B0[2][2], B1[2][2]; v8i At8[4], B08[2], B18[2]; (void)At; (void)B0; (void)B1; (void)At8; (void)B08; (void)B18;
    unsigned ao[2][2];
#pragma unroll
    for (int h = 0; h < 2; ++h)
#pragma unroll
        for (int i = 0; i < 2; ++i) ao[h][i] = S.a_off(cur, h, Rr[i]) + (unsigned)Cc[i];
    const char* cB = S.b_base(cur);
    PG8_STAGEB(PG8_SB(0, 0), cB); PG8_STAGEB(PG8_SB(0, 1), cB + hstepB); PG8_STAGEA(PG8_SA(0, 0), ao[0], 0u); PG8_STAGEA(PG8_SA(0, 1), ao[1], 0u);
    if (wr == 1) PG8_BAR;
    PG8_WAIT_V(2); PG8_BAR;
    PG8_STAGEB(PG8_SB(1, 0), cB + kstep); PG8_STAGEA(PG8_SA(1, 0), ao[0], kstep); PG8_STAGEB(PG8_SB(1, 1), cB + hstepB + kstep);
    PG8_WAIT_V(6); PG8_BAR;
    for (;;) {
        const bool has_next = S.next(ui + 1, nxt);
        const char* nB = has_next ? S.b_base(nxt) : cB;
#pragma unroll 1
        for (int t = 0; t < nt; t += 2) {
            const bool last = (t == nt - 2);
            const unsigned kb1 = (unsigned)(t + 1) * kstep, kb2 = (unsigned)(t + 2) * kstep;
            unsigned x2[2][2];
#pragma unroll
            for (int h = 0; h < 2; ++h)
#pragma unroll
                for (int i = 0; i < 2; ++i) x2[h][i] = last ? (has_next ? (S.a_off(nxt, h, Rr[i]) + (unsigned)Cc[i]) : ao[h][i]) : ao[h][i] + kb2;
            const char* b2 = last ? nB : cB + kb2; const char* b3 = b2 + kstep;
            PG8_LDB(B0, 0, 0); PG8_LDB(B1, 0, 1); PG8_SCHED; PG8_LDA(At, 0, 0); PG8_STAGEA(PG8_SA(1, 1), ao[1], kb1);
            PG8_WAIT_V(8); PG8_WAIT_L(0); PG8_BAR; PG8_MMA(0, 0, At, B0); PG8_MMA(0, 1, At, B1); PG8_BAR; PG8_SCHED;
            PG8_LDA(At, 0, 1); PG8_STAGEB(PG8_SB(0, 0), b2); PG8_STAGEB(PG8_SB(0, 1), b2 + hstepB); PG8_STAGEA(PG8_SA(0, 0), x2[0], 0u);
            PG8_WAIT_V(8); PG8_WAIT_L(0); PG8_BAR; PG8_MMA(1, 0, At, B0); PG8_MMA(1, 1, At, B1); PG8_BAR; PG8_SCHED;
            PG8_LDB(B0, 1, 0); PG8_LDB(B1, 1, 1); PG8_SCHED; PG8_LDA(At, 1, 0); PG8_STAGEA(PG8_SA(0, 1), x2[1], 0u);
            PG8_WAIT_V(8); PG8_WAIT_L(0); PG8_BAR; PG8_MMA(0, 0, At, B0); PG8_MMA(0, 1, At, B1); PG8_BAR; PG8_SCHED;
            PG8_LDA(At, 1, 1); PG8_STAGEB(PG8_SB(1, 0), b3); PG8_STAGEB(PG8_SB(1, 1), b3 + hstepB); PG8_STAGEA(PG8_SA(1, 0), x2[0], kstep);
            PG8_WAIT_V(8); PG8_WAIT_L(0); PG8_BAR; PG8_MMA(1, 0, At, B0); PG8_MMA(1, 1, At, B1); PG8_BAR; PG8_SCHED;
        }
        if (wr == 0) PG8_BAR;
        if constexpr (FP8) asm volatile("s_nop 15" ::: "memory");
        E(acc, cur, wr, wc, fr, fq);
        if (!has_next) break;
#pragma unroll
        for (int a = 0; a < 2; ++a)
#pragma unroll
            for (int b = 0; b < 2; ++b)
#pragma unroll
                for (int m = 0; m < 4; ++m)
#pragma unroll
                    for (int n = 0; n < 2; ++n) acc[a][b][m][n] = (f32x4){0.f, 0.f, 0.f, 0.f};
        cur = nxt; cB = nB; ++ui;
#pragma unroll
        for (int h = 0; h < 2; ++h)
#pragma unroll
            for (int i = 0; i < 2; ++i) ao[h][i] = S.a_off(cur, h, Rr[i]) + (unsigned)Cc[i];
        if (wr == 1) PG8_BAR;
    }
    PG8_WAIT_V(0);
    PG8_BAR;
#undef PG8_SA
#undef PG8_SB
#undef PG8_STAGEA
#undef PG8_STAGEB
#undef PG8_LDA
#undef PG8_LDB
#undef PG8_MMA
#undef PG8_WAIT_V
#undef PG8_WAIT_L
#undef PG8_BAR
#undef PG8_SCHED
}
}

constexpr int NWAVES = 8, NTHR = 512;
struct Frame {
    LAS unsigned char* lds;
    int tid, lane, wave, G, gw, NGW;
    unsigned* ctl;
    unsigned char* ws;
};

DI void transpose_item(const float* Wseg, int ldw, int ncols, int K, bf16_t* WT, int row_off, LAS float* scr, int item, int lane) {
    const int nblk = ncols / 32, kb = item / nblk, nb = item % nblk, k0 = 64 * kb, n0 = 32 * nb;
#pragma unroll 8
    for (int i = 0; i < 32; ++i) { const int kk = 2 * i + (lane >> 5); scr[kk * 33 + (lane & 31)] = Wseg[(size_t)(k0 + kk) * ldw + n0 + (lane & 31)]; }
    LDS_WAIT(); asm volatile("" ::: "memory");
    const int c = lane & 7;
#pragma unroll
    for (int j = 0; j < 4; ++j) { const int n = (lane >> 3) + 8 * j; const LAS float* s = scr + (8 * c) * 33 + n;
        u32x4 o; o.x = pk2(s[0 * 33], s[1 * 33]); o.y = pk2(s[2 * 33], s[3 * 33]); o.z = pk2(s[4 * 33], s[5 * 33]); o.w = pk2(s[6 * 33], s[7 * 33]);
        *(u32x4*)(WT + (size_t)(row_off + n0 + n) * K + k0 + 8 * c) = o; }
    LDS_WAIT(); asm volatile("" ::: "memory");
}

DI void transpose_item8(const float* Wseg, int ldw, int ncols, int K, unsigned char* WT, int row_off, LAS float* scr, int item, int lane, float qs) {
    const int nblk = ncols / 32, kb = item / nblk, nb = item % nblk, k0 = 128 * kb, n0 = 32 * nb;
    const float* wp = Wseg + (size_t)(k0 + (lane >> 5)) * ldw + n0 + (lane & 31);
#pragma unroll
    for (int hb = 0; hb < 2; ++hb) { float v[32];
#pragma unroll
        for (int i = 0; i < 32; ++i) v[i] = wp[(size_t)(64 * hb + 2 * i) * ldw];
#pragma unroll
        for (int i = 0; i < 32; ++i) scr[(64 * hb + 2 * i + (lane >> 5)) * 33 + (lane & 31)] = v[i] * qs; }
    LDS_WAIT(); asm volatile("" ::: "memory");
    const int n = lane >> 1, hf = lane & 1; const LAS float* sp = scr + (64 * hf) * 33 + n;
    unsigned char* dst = WT + (size_t)(row_off + n0 + n) * K + k0 + 64 * hf;
#pragma unroll
    for (int q = 0; q < 4; ++q) { u32x4 o;
        o.x = pk4fp8(sp[(16 * q + 0) * 33], sp[(16 * q + 1) * 33], sp[(16 * q + 2) * 33], sp[(16 * q + 3) * 33]); o.y = pk4fp8(sp[(16 * q + 4) * 33], sp[(16 * q + 5) * 33], sp[(16 * q + 6) * 33], sp[(16 * q + 7) * 33]);
        o.z = pk4fp8(sp[(16 * q + 8) * 33], sp[(16 * q + 9) * 33], sp[(16 * q + 10) * 33], sp[(16 * q + 11) * 33]); o.w = pk4fp8(sp[(16 * q + 12) * 33], sp[(16 * q + 13) * 33], sp[(16 * q + 14) * 33], sp[(16 * q + 15) * 33]);
        *(u32x4*)(dst + 16 * q) = o; }
    LDS_WAIT(); asm volatile("" ::: "memory");
}
DI void p0_weights(Frame& F, const float* const* in) {
    LAS float* scr = (LAS float*)(F.lds + F.wave * 16896);
    bf16_t* win0 = (bf16_t*)(F.ws + WS_WIN0); bf16_t* wout0 = (bf16_t*)(F.ws + WS_WOUT0); bf16_t* win1 = (bf16_t*)(F.ws + WS_WIN1); bf16_t* wout1 = (bf16_t*)(F.ws + WS_WOUT1);
    const float* ewin = in[3]; const float* ewout = in[9]; const float* owin = in[10]; const float* owout = in[14];
    constexpr int KB = D / 64;
    constexpr int I_A = KB * (4096 / 32), I_B = KB * (4096 / 32), I_C = KB * (2048 / 32), I_D = KB * (2048 / 32);
    constexpr int I_O0 = (4096 / 64) * (D / 32), I_I1 = (D / 128) * (ODD_IN / 32), I_O1 = (D / 128) * (D / 32);
    constexpr int NIT = I_A + I_B + I_C + I_D + I_O0 + I_I1 + I_O1;
    for (int it = F.gw; it < NIT; it += F.NGW) {
        int r = it;
        if (r < I_A) { transpose_item(ewin + 0, EVEN_IN, 4096, D, win0, 0, scr, r, F.lane); continue; } r -= I_A;
        if (r < I_B) { transpose_item(ewin + 6144, EVEN_IN, 4096, D, win0, C_GQKV, scr, r, F.lane); continue; } r -= I_B;
        if (r < I_C) { transpose_item(ewin + 4096, EVEN_IN, 2048, D, win0, C_RG, scr, r, F.lane); continue; } r -= I_C;
        if (r < I_D) { transpose_item(ewin + 10240, EVEN_IN, 2048, D, win0, C_GZ, scr, r, F.lane); continue; } r -= I_D;
        if (r < I_O0) { transpose_item(ewout, D, D, 4096, wout0, 0, scr, r, F.lane); continue; } r -= I_O0;
        if (r < I_I1) { transpose_item8(owin, ODD_IN, ODD_IN, D, (unsigned char*)win1, 0, scr, r, F.lane, 32.f); continue; } r -= I_I1;
        transpose_item8(owout, D, D, D, (unsigned char*)wout1, 0, scr, r, F.lane, 32.f);
    }
    bf16_t* swh = (bf16_t*)(F.ws + AUX_SW); bf16_t* swl = swh + 112 * D;
    const int gt = (F.gw * 64 + F.lane), NGT = F.NGW * 64;
    for (int i = gt; i < 112 * D; i += NGT) { const int c = i / D, k = i % D; float v;
        if (c < 16) v = ewin[(size_t)k * EVEN_IN + 12288 + c] * in[1][k];
        else { const int l = (c - 16) / 48, cc = (c - 16) % 48; const float gn = in[2][l * D + k]; v = cc < 4 ? in[15][(size_t)l * D * 4 + k * 4 + cc] * gn : (cc < 36 ? in[16][(size_t)l * D * 32 + k * 32 + (cc - 4)] * gn : 0.f); }
        const unsigned hb = f2bf(v); const float lo = v - __builtin_bit_cast(float, hb << 16); swh[i] = (bf16_t)hb; swl[i] = (bf16_t)f2bf(lo); }
    f32x2* cs = (f32x2*)(F.ws + AUX_CS);
    for (int i = gt; i < SEQ * 64; i += NGT) { const int pos = i >> 6, fi = i & 63; double inv = 1.0;
        for (int q = 0; q < fi; ++q) inv *= ROPE_R;
        const double x = (double)pos * inv, k = __builtin_rint(x * 0.15915494309189535), r = (x - k * 6.283185307179586) - k * 2.4492935982947064e-16;
        const float rf = (float)r; const f32x2 v = {cosf(rf), sinf(rf)}; cs[i] = v; if ((fi & 1) == 0) ((f32x2*)(F.ws + AUX_CS32))[pos * 32 + (fi >> 1)] = v; }
}
DI void convert_experts(Frame& F, const float* const* in, int l, unsigned char* gu, unsigned char* dn, int widx, int nw) {
    LAS float* scr = (LAS float*)(F.lds + F.wave * 16896);
    const float* wg = in[17] + (size_t)l * NEXP * D * FF; const float* wu = in[18] + (size_t)l * NEXP * D * FF; const float* wd = in[19] + (size_t)l * NEXP * FF * D;
    constexpr int I_G = (D / 128) * (128 / 32);
    constexpr int I_GU = NEXP * 6 * 2 * I_G;
    constexpr int I_DE = (FF / 128) * (D / 32);
    constexpr int NIT = I_GU + NEXP * I_DE;
    for (int it = widx; it < NIT; it += nw) {
        if (it < I_GU) { const int seg = it / I_G, r = it % I_G, e = seg / 12, s = seg % 12, pn = s >> 1, isup = s & 1;
            const float* src = (isup ? wu : wg) + (size_t)e * D * FF + pn * 128;
            transpose_item8(src, FF, 128, D, gu + (size_t)e * 1536 * D, pn * 256 + isup * 128, scr, r, F.lane, 64.f); }
        else { const int r2 = it - I_GU, e = r2 / I_DE, r = r2 % I_DE;
            transpose_item8(wd + (size_t)e * FF * D, D, D, FF, dn + (size_t)e * D * FF, 0, scr, r, F.lane, 32.f); }
    }
}

template <int NP, bool ADDY, bool WRITEX, bool WRITEH, class Handler, bool H8 = false, bool SRC16 = false, bool DST16 = false>
DI void norm_pass(Frame& F, const void* src, void* dst, const bf16_t* y, const unsigned* asg, const LAS int* tb, const float* gain, const float* Wt, bf16_t* H, Handler hnd) {
    for (int m = F.gw; m < NTOK; m += F.NGW) {
        f32x4 v[8];
        if (SRC16) { const u32x2* xr = (const u32x2*)((const bf16_t*)src + (size_t)m * D) + F.lane;
#pragma unroll
            for (int j = 0; j < 8; ++j) { const u32x2 b = xr[64 * j]; v[j] = (f32x4){bflo(b.x), bfhi(b.x), bflo(b.y), bfhi(b.y)}; } }
        else { const f32x4* xr = (const f32x4*)((const float*)src + (size_t)m * D) + F.lane;
#pragma unroll
            for (int j = 0; j < 8; ++j) v[j] = xr[64 * j]; }
        if (ADDY) {
            const unsigned a0 = asg[2 * m], a1 = asg[2 * m + 1];
            const size_t r0 = (size_t)tb[a0 >> 16] * 256 + (a0 & 0xffffu), r1 = (size_t)tb[a1 >> 16] * 256 + (a1 & 0xffffu);
            const unsigned* y0 = (const unsigned*)((const unsigned char*)y + r0 * D) + F.lane; const unsigned* y1 = (const unsigned*)((const unsigned char*)y + r1 * D) + F.lane;
#pragma unroll
            for (int j = 0; j < 8; ++j) { const int p = (int)y0[64 * j], q = (int)y1[64 * j];
                v[j].x += (__builtin_amdgcn_cvt_f32_fp8(p, 0) + __builtin_amdgcn_cvt_f32_fp8(q, 0)) * 0.0625f; v[j].y += (__builtin_amdgcn_cvt_f32_fp8(p, 1) + __builtin_amdgcn_cvt_f32_fp8(q, 1)) * 0.0625f;
                v[j].z += (__builtin_amdgcn_cvt_f32_fp8(p, 2) + __builtin_amdgcn_cvt_f32_fp8(q, 2)) * 0.0625f; v[j].w += (__builtin_amdgcn_cvt_f32_fp8(p, 3) + __builtin_amdgcn_cvt_f32_fp8(q, 3)) * 0.0625f; }
        }
        if (WRITEX) {
            if (DST16) { u32x2* xo = (u32x2*)((bf16_t*)dst + (size_t)m * D) + F.lane;
#pragma unroll
                for (int j = 0; j < 8; ++j) { u32x2 w; w.x = pk2(v[j].x, v[j].y); w.y = pk2(v[j].z, v[j].w); xo[64 * j] = w;
                    if (WRITEH) v[j] = (f32x4){bflo(w.x), bfhi(w.x), bflo(w.y), bfhi(w.y)}; } }
            else { f32x4* xo = (f32x4*)((float*)dst + (size_t)m * D) + F.lane;
#pragma unroll
                for (int j = 0; j < 8; ++j) xo[64 * j] = v[j]; } }
        if (WRITEH) {
            float s = 0.f;
#pragma unroll
            for (int j = 0; j < 8; ++j) s += (v[j].x * v[j].x + v[j].y * v[j].y) + (v[j].z * v[j].z + v[j].w * v[j].w);
            const float rstd = 1.0f / sqrtf(wave_sum(s) * (1.0f / D) + EPS);
            const f32x4* gr = (const f32x4*)gain + F.lane;
#pragma unroll
            for (int j = 0; j < 8; ++j) v[j] = v[j] * rstd * gr[64 * j];
            if (H8) { unsigned* ho8 = (unsigned*)((unsigned char*)H + (size_t)m * D) + F.lane;
#pragma unroll
                for (int j = 0; j < 8; ++j) ho8[64 * j] = pk4fp8(v[j].x * 4.f, v[j].y * 4.f, v[j].z * 4.f, v[j].w * 4.f); }
            else {
            u32x2* ho = (u32x2*)(H + (size_t)m * D) + F.lane;
#pragma unroll
            for (int j = 0; j < 8; ++j) { u32x2 w; w.x = pk2(v[j].x, v[j].y); w.y = pk2(v[j].z, v[j].w); ho[64 * j] = w; } }
            if constexpr (NP > 0) {
                float res = 0.f;
#pragma unroll 1
                for (int c0 = 0; c0 < NP; c0 += 4) {
                    float a[4];
#pragma unroll
                    for (int cc = 0; cc < 4; ++cc) { const f32x4* wr = (const f32x4*)(Wt + (size_t)(c0 + cc) * D) + F.lane; a[cc] = 0.f;
#pragma unroll
                        for (int j = 0; j < 8; ++j) { const f32x4 w = wr[64 * j]; a[cc] += (v[j].x * w.x + v[j].y * w.y) + (v[j].z * w.z + v[j].w * w.w); } }
#pragma unroll
                    for (int cc = 0; cc < 4; ++cc) { const float t = wave_sum(a[cc]); res = (F.lane == c0 + cc) ? t : res; }
                }
                hnd(m, res);
            }
        }
    }
}


typedef f32x4 XTile[8][2];
template <bool XB>
DI void xtile_load(Frame& F, XTile& xr, const void* x, int tile) {
    const size_t eo = ((size_t)tile * 16 + (F.lane & 15)) * D + 256 * F.wave + 8 * (F.lane >> 4);
    if (XB) { const u32x4* xp = (const u32x4*)((const bf16_t*)x + eo);
#pragma unroll
        for (int i = 0; i < 8; ++i) { const u32x4 b = xp[4 * i]; xr[i][0] = (f32x4){bflo(b.x), bfhi(b.x), bflo(b.y), bfhi(b.y)}; xr[i][1] = (f32x4){bflo(b.z), bfhi(b.z), bflo(b.w), bfhi(b.w)}; } }
    else { const f32x4* xp = (const f32x4*)((const float*)x + eo);
#pragma unroll
        for (int i = 0; i < 8; ++i) { xr[i][0] = xp[8 * i]; xr[i][1] = xp[8 * i + 1]; } }
}
constexpr int NP_GAIN_OFF = 65536 + 8192;
template <int MODE, bool XB>
DI void normproj_tile(Frame& F, const XTile& xr, XTile& xn, const void* x, int ntile, int tile, int tl, int par, const bf16_t* Wh, const bf16_t* Wl, bf16_t* H, float* bg, float dtb, float nea) {
    constexpr int NT = MODE == 0 ? 1 : 3;
    int lane_o = F.lane; asm volatile("" : "+v"(lane_o));
    const int lane = lane_o, r = lane & 15, kq = lane >> 4, w = F.wave;
    LAS float* ssp = (LAS float*)(F.lds + par * 32768);
    LAS f32x4* lp = (LAS f32x4*)(F.lds + par * 32768 + 1024);
    LAS float* lg = (LAS float*)(F.lds + par * 32768 + 1024 + 24576);
    LAS f32x4* sel = (LAS f32x4*)(F.lds + 65536);
    const size_t tok0 = (size_t)tile * 16;
    f32x4 acc[NT];
#pragma unroll
    for (int nt = 0; nt < NT; ++nt) acc[nt] = (f32x4){0.f, 0.f, 0.f, 0.f};
    float ss = 0.f;
    constexpr int WD = 3;
    bf16x8 wq[WD][NT][2];
    const bf16_t* whp = Wh + (size_t)r * D + 256 * w + 8 * kq; const bf16_t* wlp = Wl + (size_t)r * D + 256 * w + 8 * kq;
#pragma unroll
    for (int i = 0; i < WD; ++i)
#pragma unroll
        for (int nt = 0; nt < NT; ++nt) { wq[i][nt][0] = *(const bf16x8*)(whp + (size_t)(16 * nt) * D + 32 * i); wq[i][nt][1] = *(const bf16x8*)(wlp + (size_t)(16 * nt) * D + 32 * i); }
    asm volatile("" ::: "memory");
#pragma unroll
    for (int i = 0; i < 8; ++i) { const f32x4 xa = xr[i][0], xb = xr[i][1];
        ss += ((xa.x * xa.x + xa.y * xa.y) + (xa.z * xa.z + xa.w * xa.w)) + ((xb.x * xb.x + xb.y * xb.y) + (xb.z * xb.z + xb.w * xb.w));
        u32x4 hw; hw.x = pkbf(xa.x, xa.y); hw.y = pkbf(xa.z, xa.w); hw.z = pkbf(xb.x, xb.y); hw.w = pkbf(xb.z, xb.w);
        u32x4 lw; lw.x = pkbf(xa.x - bflo(hw.x), xa.y - bfhi(hw.x)); lw.y = pkbf(xa.z - bflo(hw.y), xa.w - bfhi(hw.y)); lw.z = pkbf(xb.x - bflo(hw.z), xb.y - bfhi(hw.z)); lw.w = pkbf(xb.z - bflo(hw.w), xb.w - bfhi(hw.w));
        const bf16x8 xh = __builtin_bit_cast(bf16x8, hw), xl = __builtin_bit_cast(bf16x8, lw);
#pragma unroll
        for (int nt = 0; nt < NT; ++nt) { const bf16x8 wh = wq[i % WD][nt][0], wl = wq[i % WD][nt][1];
            acc[nt] = mfma16(xh, wh, acc[nt]); acc[nt] = mfma16(xh, wl, acc[nt]); acc[nt] = mfma16(xl, wh, acc[nt]); }
        asm volatile("" ::: "memory");
        if (i + WD < 8) {
#pragma unroll
            for (int nt = 0; nt < NT; ++nt) { wq[i % WD][nt][0] = *(const bf16x8*)(whp + (size_t)(16 * nt) * D + 32 * (i + WD)); wq[i % WD][nt][1] = *(const bf16x8*)(wlp + (size_t)(16 * nt) * D + 32 * (i + WD)); }
            asm volatile("" ::: "memory"); } }
    if (ntile >= 0) xtile_load<XB>(F, xn, x, ntile);
    ss += __shfl_xor(ss, 16); ss += __shfl_xor(ss, 32);
    if (lane < 16) ssp[w * 16 + lane] = ss;
#pragma unroll
    for (int nt = 0; nt < NT; ++nt) lp[(w * NT + nt) * 64 + lane] = acc[nt];
    __syncthreads();
    float tot = 0.f;
#pragma unroll
    for (int q = 0; q < 8; ++q) tot += ssp[q * 16 + r];
    const float rstd = 1.0f / sqrtf(tot * (1.0f / D) + EPS);
    { const LAS f32x4* gp = (const LAS f32x4*)(F.lds + NP_GAIN_OFF) + 64 * w + 2 * kq; bf16_t* hp = H + (tok0 + r) * D + 256 * w + 8 * kq;
#pragma unroll
      for (int i = 0; i < 8; ++i) { const f32x4 ga = gp[8 * i], gb = gp[8 * i + 1], xa = xr[i][0] * rstd, xb = xr[i][1] * rstd;
        if (MODE == 1) { u32x2 o; o.x = pk4fp8(xa.x * ga.x * 4.f, xa.y * ga.y * 4.f, xa.z * ga.z * 4.f, xa.w * ga.w * 4.f); o.y = pk4fp8(xb.x * gb.x * 4.f, xb.y * gb.y * 4.f, xb.z * gb.z * 4.f, xb.w * gb.w * 4.f);
            *(u32x2*)((unsigned char*)H + (tok0 + r) * D + 256 * w + 8 * kq + 32 * i) = o; }
        else { u32x4 o; o.x = pkbf(xa.x * ga.x, xa.y * ga.y); o.y = pkbf(xa.z * ga.z, xa.w * ga.w); o.z = pkbf(xb.x * gb.x, xb.y * gb.y); o.w = pkbf(xb.z * gb.z, xb.w * gb.w);
            *(u32x4*)(hp + 32 * i) = o; } } }
    if (w == 0) {
        float rs[4];
#pragma unroll
        for (int q = 0; q < 4; ++q) rs[q] = __shfl(rstd, 4 * kq + q);
        f32x4 tl4[NT];
#pragma unroll
        for (int nt = 0; nt < NT; ++nt) { tl4[nt] = lp[nt * 64 + lane];
#pragma unroll
            for (int q = 1; q < 8; ++q) tl4[nt] += lp[(q * NT + nt) * 64 + lane]; }
        if (MODE == 0) {
#pragma unroll
            for (int q = 0; q < 4; ++q) { const float v = tl4[0][q] * rs[q]; float o;
                if (r < 8) o = 1.0f / (1.0f + __expf(-v)); else { const float z = v + dtb; const float sp = z > 20.f ? z : log1pf(__expf(z)); o = nea * sp; }
                bg[(tok0 + 4 * kq + q) * 16 + r] = o; }
        } else {
#pragma unroll
            for (int nt = 0; nt < NT; ++nt)
#pragma unroll
                for (int q = 0; q < 4; ++q) lg[(4 * kq + q) * 48 + 16 * nt + r] = tl4[nt][q] * rs[q];
            LDS_WAIT();
            if (lane < 16) {
                const LAS float* p = lg + lane * 48;
                int g = 0; float gm = p[0];
#pragma unroll
                for (int j = 1; j < 4; ++j) { const float v = p[j]; if (v > gm) { gm = v; g = j; } }
                float gs = 0.f;
#pragma unroll
                for (int j = 0; j < 4; ++j) gs += __expf(p[j] - gm);
                const float g_p = 1.0f / gs;
                float q8[8];
#pragma unroll
                for (int i = 0; i < 8; ++i) q8[i] = p[4 + 8 * g + i];
                int i0 = 0; float m0 = q8[0];
#pragma unroll
                for (int i = 1; i < 8; ++i) if (q8[i] > m0) { m0 = q8[i]; i0 = i; }
                int i1 = -1; float m1 = -3.0e38f;
#pragma unroll
                for (int i = 0; i < 8; ++i) if (i != i0 && q8[i] > m1) { m1 = q8[i]; i1 = i; }
                if (i1 < 0) i1 = (i0 + 1) & 7;
                const float e1 = __expf(m1 - m0), w0 = g_p / (1.0f + e1), w1 = g_p * e1 / (1.0f + e1);
                sel[tl * 16 + lane] = (f32x4){__builtin_bit_cast(float, g * 8 + i0), __builtin_bit_cast(float, g * 8 + i1), w0, w1};
            }
        }
    }
}
template <int MODE, bool XB = false>
DI void normproj_pass(Frame& F, const void* x, const float* gain, const bf16_t* Wh, const bf16_t* Wl, bf16_t* H, float* bg, const float* a_log, const float* dt_bias, unsigned* cnt, int* list, float* gw, unsigned* asg) {
    constexpr int NTILE = NTOK / 16;
    XTile xa, xb;
    int tile = blockIdx.x, tl = 0;
    if (tile < NTILE) xtile_load<XB>(F, xa, x, tile);
    ((LAS f32x4*)(F.lds + NP_GAIN_OFF))[F.tid] = ((const f32x4*)gain)[F.tid];
    float dtb = 0.f, nea = 0.f;
    if (MODE == 0) { const int r8 = (F.lane & 15) - 8; if (r8 >= 0) { dtb = dt_bias[r8]; nea = -__expf(a_log[r8]); } }
    __syncthreads();
    while (tile < NTILE) {
        normproj_tile<MODE, XB>(F, xa, xb, x, tile + F.G < NTILE ? tile + F.G : -1, tile, tl, tl & 1, Wh, Wl, H, bg, dtb, nea);
        tile += F.G; ++tl;
        if (tile >= NTILE) break;
        normproj_tile<MODE, XB>(F, xb, xa, x, tile + F.G < NTILE ? tile + F.G : -1, tile, tl, tl & 1, Wh, Wl, H, bg, dtb, nea);
        tile += F.G; ++tl;
    }
    __syncthreads();
    if (MODE == 1 && F.wave == 0) {
        LAS f32x4* sel = (LAS f32x4*)(F.lds + 65536); LAS unsigned* hist = (LAS unsigned*)(F.lds + 65536 + 4096); LAS unsigned* base = hist + 32;
        const int lane = F.lane;
        if (lane < 32) hist[lane] = 0u;
        LDS_WAIT();
        const int ntok = tl * 16;
        unsigned rk[8]; int ee[8]; float ww[8]; int mm[8];
#pragma unroll
        for (int q = 0; q < 8; ++q) { const int a = lane + 64 * q;
            ee[q] = -1; if ((a >> 1) < ntok) { const f32x4 sv = sel[a >> 1]; ee[q] = __builtin_bit_cast(int, (a & 1) ? sv.y : sv.x); ww[q] = (a & 1) ? sv.w : sv.z;
                mm[q] = (blockIdx.x + ((a >> 1) >> 4) * F.G) * 16 + ((a >> 1) & 15); rk[q] = __hip_atomic_fetch_add(hist + ee[q], 1u, __ATOMIC_RELAXED, __HIP_MEMORY_SCOPE_WORKGROUP); } }
        LDS_WAIT();
        if (lane < 32) { const unsigned c = hist[lane]; base[lane] = c ? __hip_atomic_fetch_add(cnt + lane * CSTR, c, __ATOMIC_RELAXED, __HIP_MEMORY_SCOPE_AGENT) : 0u; }
        LDS_WAIT();
#pragma unroll
        for (int q = 0; q < 8; ++q) if (ee[q] >= 0) { const unsigned pos = base[ee[q]] + rk[q]; const int a = lane + 64 * q;
            list[ee[q] * 65536 + pos] = mm[q]; gw[ee[q] * 65536 + pos] = ww[q]; asg[2 * mm[q] + (a & 1)] = ((unsigned)ee[q] << 16) | pos; }
    }
    __syncthreads();
}

DI unsigned dpp_ror8(unsigned v) { return (unsigned)__builtin_amdgcn_mov_dpp((int)v, 0x128, 0xf, 0xf, true); }
DI void p2_prep(Frame& F, const float* conv_w) {
    bf16_t* pj = (bf16_t*)(F.ws + WS_BIG + BIG_PJ);
    const f32x2* cs = (const f32x2*)(F.ws + AUX_CS);
    bf16_t* qn = (bf16_t*)(F.ws + AUX_QN); bf16_t* kn = (bf16_t*)(F.ws + AUX_KN); bf16_t* vc = (bf16_t*)(F.ws + AUX_VC);
    const int lane = F.lane, l16 = lane & 15;
    for (int grp = F.gw; grp < NTOK / 16; grp += F.NGW) {
        const int m0 = grp * 16, pos0 = m0 & (SEQ - 1);
#pragma unroll 1
        for (int j = 0; j < 8; ++j) { const int ch = 512 * j + 8 * lane;
            f32x4 w[4][2];
#pragma unroll
            for (int tp = 0; tp < 4; ++tp) { w[tp][0] = *(const f32x4*)(conv_w + tp * 4096 + ch); w[tp][1] = *(const f32x4*)(conv_w + tp * 4096 + ch + 4); }
            u32x4 rr[19];
#pragma unroll
            for (int q = 0; q < 19; ++q) { const int dp = pos0 - 3 + q; rr[q] = (u32x4){0u, 0u, 0u, 0u}; if (dp >= 0) rr[q] = *(const u32x4*)(pj + (size_t)(m0 - 3 + q) * PJW + C_GQKV + ch); }
#pragma unroll
            for (int tt = 0; tt < 16; ++tt) { float a[8];
#pragma unroll
                for (int e = 0; e < 8; ++e) a[e] = 0.f;
#pragma unroll
                for (int tp = 0; tp < 4; ++tp) { const u32x4 r = rr[tt + tp];
                    a[0] += bflo(r.x) * w[tp][0].x; a[1] += bfhi(r.x) * w[tp][0].y; a[2] += bflo(r.y) * w[tp][0].z; a[3] += bfhi(r.y) * w[tp][0].w; a[4] += bflo(r.z) * w[tp][1].x; a[5] += bfhi(r.z) * w[tp][1].y; a[6] += bflo(r.w) * w[tp][1].z; a[7] += bfhi(r.w) * w[tp][1].w; }
                float ss = 0.f;
#pragma unroll
                for (int e = 0; e < 8; ++e) { a[e] = siluf(a[e]); ss += a[e] * a[e]; }
                if (j < 4) { ss += __shfl_xor(ss, 1); ss += __shfl_xor(ss, 2); ss += __shfl_xor(ss, 4); ss += __shfl_xor(ss, 8);
                    const float sc = (1.0f / sqrtf(ss + EPS)) * (j < 2 ? 0.08838834764831845f : 1.0f);
#pragma unroll
                    for (int e = 0; e < 8; ++e) a[e] *= sc; }
                u32x4 o; o.x = pk2(a[0], a[1]); o.y = pk2(a[2], a[3]); o.z = pk2(a[4], a[5]); o.w = pk2(a[6], a[7]);
                const size_t m = (size_t)(m0 + tt);
                bf16_t* dst = j < 2 ? qn + m * 1024 + ch : (j < 4 ? kn + m * 1024 + (ch - 1024) : vc + m * 2048 + (ch - 2048));
                *(u32x4*)dst = o; }
        }
    }
}

constexpr int TB = 16;
template <bool GDN>
DI void p3_recurrence(Frame& F, int u  ) {
    const int b = u >> 2, h = 2 * (u & 3) + (F.tid >> 8), e = F.tid & 255, hh = F.tid >> 8;
    bf16_t* pj = (bf16_t*)(F.ws + WS_BIG + BIG_PJ);
    const bf16_t* qsrc = GDN ? (const bf16_t*)(F.ws + AUX_QN) : pj + C_RQ; const bf16_t* ksrc = GDN ? (const bf16_t*)(F.ws + AUX_KN) : pj + C_RK;
    const int qld = GDN ? 1024 : PJW;
    bf16_t* vsrc = GDN ? (bf16_t*)(F.ws + AUX_VC) : pj + C_RV; const int vld = GDN ? 2048 : PJW;
    const float* bg = (const float*)(F.ws + AUX_BG);
    LAS float* qs = (LAS float*)F.lds;
    LAS float* ks = qs + 2 * TB * 128;
    LAS float* ab = ks + 2 * TB * 128;
    LAS float* vs = ab + 2 * TB * 2;
    float S[128];
#pragma unroll
    for (int d = 0; d < 128; ++d) S[d] = 0.f;
    const float gam = GDN ? 0.f : (1.0f - exp2f(-5.0f - (float)h));
    for (int t0 = 0; t0 < SEQ; t0 += TB) {
        const size_t r0 = (size_t)b * SEQ + t0;
        __syncthreads();
        for (int i = F.tid; i < 2 * TB * 128; i += NTHR) { const int h2 = i / (TB * 128), tt = (i / 128) % TB, d = i % 128; const int hd = 2 * (u & 3) + h2;
            qs[i] = bf2f(qsrc[(r0 + tt) * qld + hd * 128 + d]); ks[i] = bf2f(ksrc[(r0 + tt) * qld + hd * 128 + d]); }
        for (int i = F.tid; i < 2 * TB * 256; i += NTHR) { const int h2 = i / (TB * 256), tt = (i / 256) % TB, ee = i % 256; vs[i] = bf2f(vsrc[(r0 + tt) * vld + (2 * (u & 3) + h2) * 256 + ee]); }
        if (GDN && F.tid < 2 * TB) { const int h2 = F.tid / TB, tt = F.tid % TB, hd = 2 * (u & 3) + h2; ab[F.tid * 2] = __expf(bg[(r0 + tt) * 16 + 8 + hd]); ab[F.tid * 2 + 1] = bg[(r0 + tt) * 16 + hd]; }
        __syncthreads();
#pragma unroll 1
        for (int tt = 0; tt < TB; ++tt) {
            const LAS f32x4* q4 = (const LAS f32x4*)(qs + (hh * TB + tt) * 128); const LAS f32x4* k4 = (const LAS f32x4*)(ks + (hh * TB + tt) * 128);
            const float v = vs[(hh * TB + tt) * 256 + e];
            float o = 0.f;
            if (GDN) {
                const float a = ab[(hh * TB + tt) * 2], beta = ab[(hh * TB + tt) * 2 + 1];
                float ksum = 0.f;
#pragma unroll
                for (int d4 = 0; d4 < 32; ++d4) { if ((d4 & 7) == 0) asm volatile("" ::: "memory"); const f32x4 kk = k4[d4]; ksum += (kk.x * S[4 * d4] + kk.y * S[4 * d4 + 1]) + (kk.z * S[4 * d4 + 2] + kk.w * S[4 * d4 + 3]); }
                const float r = (v - a * ksum) * beta;
#pragma unroll
                for (int d4 = 0; d4 < 32; ++d4) { if ((d4 & 3) == 0) asm volatile("" ::: "memory"); const f32x4 kk = k4[d4], qq = q4[d4];
                    S[4 * d4] = a * S[4 * d4] + r * kk.x; S[4 * d4 + 1] = a * S[4 * d4 + 1] + r * kk.y; S[4 * d4 + 2] = a * S[4 * d4 + 2] + r * kk.z; S[4 * d4 + 3] = a * S[4 * d4 + 3] + r * kk.w;
                    o += (qq.x * S[4 * d4] + qq.y * S[4 * d4 + 1]) + (qq.z * S[4 * d4 + 2] + qq.w * S[4 * d4 + 3]); }
            } else {
#pragma unroll
                for (int d4 = 0; d4 < 32; ++d4) { if ((d4 & 3) == 0) asm volatile("" ::: "memory"); const f32x4 kk = k4[d4], qq = q4[d4];
                    S[4 * d4] = gam * S[4 * d4] + v * kk.x; S[4 * d4 + 1] = gam * S[4 * d4 + 1] + v * kk.y; S[4 * d4 + 2] = gam * S[4 * d4 + 2] + v * kk.z; S[4 * d4 + 3] = gam * S[4 * d4 + 3] + v * kk.w;
                    o += (qq.x * S[4 * d4] + qq.y * S[4 * d4 + 1]) + (qq.z * S[4 * d4 + 2] + qq.w * S[4 * d4 + 3]); }
            }
            vsrc[(r0 + tt) * vld + h * 256 + e] = (bf16_t)f2bf(o);
        }
    }
}


constexpr int NCH = SEQ / 64;
DI constexpr int rowoff4c(int i) { int a = 0; for (int k = 0; k < i; ++k) a += (k + 3) / 4; return a; }
typedef short s16x4 __attribute__((ext_vector_type(4)));
DI s16x4 tr_read(unsigned lds_addr) { s16x4 r; asm volatile("ds_read_b64_tr_b16 %0, %1\n\ts_waitcnt lgkmcnt(0)" : "=&v"(r) : "v"(lds_addr) : "memory"); return r; }
DI void tr_read4(unsigned a0, unsigned a1, unsigned a2, unsigned a3, s16x4& r0, s16x4& r1, s16x4& r2, s16x4& r3) {
    asm volatile("ds_read_b64_tr_b16 %0, %4\n\tds_read_b64_tr_b16 %1, %5\n\tds_read_b64_tr_b16 %2, %6\n\tds_read_b64_tr_b16 %3, %7\n\ts_waitcnt lgkmcnt(0)"
                 : "=&v"(r0), "=&v"(r1), "=&v"(r2), "=&v"(r3) : "v"(a0), "v"(a1), "v"(a2), "v"(a3) : "memory"); }
DI bf16x8 cat8(s16x4 a, s16x4 b) { return __builtin_shufflevector(a, b, 0, 1, 2, 3, 4, 5, 6, 7); }

DI void rope_pair(bf16x8& f1, bf16x8& f2, const f32x4* cp, float sc) {
    const f32x4 c0 = cp[0], c1 = cp[1], c2 = cp[2], c3 = cp[3];
    const float cs_[8] = {c0.x, c0.z, c1.x, c1.z, c2.x, c2.z, c3.x, c3.z}, sn_[8] = {c0.y, c0.w, c1.y, c1.w, c2.y, c2.w, c3.y, c3.w};
    const u32x4 a = __builtin_bit_cast(u32x4, f1), b = __builtin_bit_cast(u32x4, f2);
    const float x1[8] = {bflo(a.x), bfhi(a.x), bflo(a.y), bfhi(a.y), bflo(a.z), bfhi(a.z), bflo(a.w), bfhi(a.w)}, x2[8] = {bflo(b.x), bfhi(b.x), bflo(b.y), bfhi(b.y), bflo(b.z), bfhi(b.z), bflo(b.w), bfhi(b.w)};
    float y1[8], y2[8];
#pragma unroll
    for (int e = 0; e < 8; ++e) { y1[e] = (x1[e] * cs_[e] - x2[e] * sn_[e]) * sc; y2[e] = (x2[e] * cs_[e] + x1[e] * sn_[e]) * sc; }
    u32x4 o1, o2; o1.x = pk2(y1[0], y1[1]); o1.y = pk2(y1[2], y1[3]); o1.z = pk2(y1[4], y1[5]); o1.w = pk2(y1[6], y1[7]); o2.x = pk2(y2[0], y2[1]); o2.y = pk2(y2[2], y2[3]); o2.z = pk2(y2[4], y2[5]); o2.w = pk2(y2[6], y2[7]);
    f1 = __builtin_bit_cast(bf16x8, o1); f2 = __builtin_bit_cast(bf16x8, o2);
}
template <bool GDN>
DI void ga_unit(Frame& F, int unit, unsigned char* stream, float* out_f32_unused) {
    (void)out_f32_unused;
    constexpr int NF = GDN ? 56 : 40, OFF_W = 0, OFF_QG = GDN ? 16 : 0, OFF_ATT = OFF_QG + 16, OFF_KT = OFF_ATT + 8;
    int lane_o = F.lane; asm volatile("" : "+v"(lane_o));
    const int lane = lane_o, fr = lane & 15, g = lane >> 4;
    const int bh = unit / NCH, n = unit % NCH, b = bh >> 3, h = bh & 7;
    const size_t row0 = (size_t)b * SEQ + (size_t)n * 64;
    LAS unsigned char* L = F.lds + F.wave * GA_LDS_WAVE;
    LAS float* LAf = (LAS float*)L; LAS unsigned char* LA = L; LAS unsigned char* LT = L + 9216; LAS float* LG = (LAS float*)(L + 17408); LAS float* LB = LG + 64;
    const bf16_t* pj = (const bf16_t*)(F.ws + WS_BIG + BIG_PJ);
    const bf16_t* qsrc = GDN ? (const bf16_t*)(F.ws + AUX_QN) + h * 128 : pj + C_RQ + h * 128;
    const bf16_t* ksrc = GDN ? (const bf16_t*)(F.ws + AUX_KN) + h * 128 : pj + C_RK + h * 128;
    const size_t qld = GDN ? 1024 : PJW;
    unsigned char* st = stream + (size_t)unit * NF * 1024 + lane * 16;
    float gv, bv = 1.f;
    if (GDN) { const float* bg = (const float*)(F.ws + AUX_BG); gv = bg[(row0 + lane) * 16 + 8 + h]; bv = bg[(row0 + lane) * 16 + h];
#pragma unroll
        for (int o = 1; o < 64; o <<= 1) { const float t = __shfl_up(gv, o); if (lane >= o) gv += t; } }
    else gv = (float)(lane + 1) * log1pf(-exp2f(-5.0f - (float)h));
    const float gl = rdlane(gv, 63);
    LG[lane] = gv; LB[lane] = bv;
    LDS_WAIT();
    float gr[16], gcl[4], br[16];
#pragma unroll
    for (int t = 0; t < 4; ++t) { gcl[t] = LG[16 * t + fr];
#pragma unroll
        for (int r = 0; r < 4; ++r) { gr[t * 4 + r] = LG[16 * t + 4 * g + r]; br[t * 4 + r] = LB[16 * t + 4 * g + r]; } }
    bf16x8 Kf[4][4], Qf[4][4];
#pragma unroll
    for (int t = 0; t < 4; ++t)
#pragma unroll
        for (int s2 = 0; s2 < 4; ++s2) Kf[t][s2] = *(const bf16x8*)(ksrc + (row0 + 16 * t + fr) * qld + 32 * s2 + 8 * g);
    if (!GDN) {
        const f32x2* cs = (const f32x2*)(F.ws + AUX_CS);
#pragma unroll
        for (int t = 0; t < 4; ++t) { const f32x2* cr = cs + (size_t)((row0 + 16 * t + fr) & (SEQ - 1)) * 64 + 8 * g;
            rope_pair(Kf[t][0], Kf[t][2], (const f32x4*)cr, 0.08838834764831845f); rope_pair(Kf[t][1], Kf[t][3], (const f32x4*)(cr + 32), 0.08838834764831845f); }
    }
    if (GDN) {
#pragma unroll
        for (int it = 0; it < 4; ++it)
#pragma unroll
            for (int jt = 0; jt <= it; ++jt) { f32x4 acc = {0.f, 0.f, 0.f, 0.f};
#pragma unroll
                for (int s2 = 0; s2 < 4; ++s2) acc = mfma16(Kf[it][s2], Kf[jt][s2], acc);
#pragma unroll
                for (int r = 0; r < 4; ++r) { const int i = 16 * it + 4 * g + r, j = 16 * jt + fr; const int q = (i + 3) >> 2; const int ro = 2 * q * (q - 1) + q * (i - 4 * q + 3);
                    if (j < i) LAf[ro * 4 + j] = br[it * 4 + r] * acc[r] * __expf(gr[it * 4 + r] - gcl[jt]); } }
    }
    asm volatile("" ::: "memory");
#pragma unroll
    for (int it = 0; it < 4; ++it) {
        asm volatile("" ::: "memory");
#pragma unroll
        for (int s2 = 0; s2 < 4; ++s2) Qf[it][s2] = *(const bf16x8*)(qsrc + (row0 + 16 * it + fr) * qld + 32 * s2 + 8 * g);
        if (!GDN) { const f32x2* cr = (const f32x2*)(F.ws + AUX_CS) + (size_t)((row0 + 16 * it + fr) & (SEQ - 1)) * 64 + 8 * g;
            rope_pair(Qf[it][0], Qf[it][2], (const f32x4*)cr, 1.0f); rope_pair(Qf[it][1], Qf[it][3], (const f32x4*)(cr + 32), 1.0f);
#pragma unroll
            for (int s2 = 0; s2 < 4; ++s2) *(LAS bf16x8*)(L + (16 * it + fr) * 256 + (32 * s2 + 8 * g) * 2) = Qf[it][s2]; }
#pragma unroll
        for (int sp = 0; sp < 2; ++sp) { u32x4 w;
#pragma unroll
            for (int hf = 0; hf < 2; ++hf) { const int jt = 2 * sp + hf; float v[4] = {0.f, 0.f, 0.f, 0.f};
                if (jt <= it) { f32x4 acc = {0.f, 0.f, 0.f, 0.f};
#pragma unroll
                    for (int s2 = 0; s2 < 4; ++s2) acc = mfma16(Kf[jt][s2], Qf[it][s2], acc);
#pragma unroll
                    for (int r = 0; r < 4; ++r) { const int j = 16 * jt + 4 * g + r, i = 16 * it + fr; v[r] = (j <= i) ? acc[r] * __expf(gcl[it] - gr[jt * 4 + r]) : 0.f; } }
                if (hf == 0) { w.x = pk2(v[0], v[1]); w.y = pk2(v[2], v[3]); } else { w.z = pk2(v[0], v[1]); w.w = pk2(v[2], v[3]); } }
            *(u32x4*)(st + (OFF_ATT + it * 2 + sp) * 1024) = w; }
    }
    if (!GDN) LDS_WAIT();
    asm volatile("" ::: "memory");
#pragma unroll
    for (int it = 0; it < 4; ++it) { const float sc = __expf(gcl[it]); asm volatile("" ::: "memory");
#pragma unroll
        for (int s2 = 0; s2 < 4; ++s2) { const bf16_t* qp = qsrc + (row0 + 16 * it + fr) * qld + 32 * s2 + 4 * g; u32x2 lo, hi;
            if (GDN) { lo = *(const u32x2*)qp; hi = *(const u32x2*)(qp + 16); }
            else { const LAS unsigned char* lq = L + (16 * it + fr) * 256 + (32 * s2 + 4 * g) * 2; lo = *(const LAS u32x2*)lq; hi = *(const LAS u32x2*)(lq + 32); }
            u32x4 w; w.x = pk2(bflo(lo.x) * sc, bfhi(lo.x) * sc); w.y = pk2(bflo(lo.y) * sc, bfhi(lo.y) * sc); w.z = pk2(bflo(hi.x) * sc, bfhi(hi.x) * sc); w.w = pk2(bflo(hi.y) * sc, bfhi(hi.y) * sc);
            *(u32x4*)(st + (OFF_QG + it * 4 + s2) * 1024) = w; } }
    asm volatile("" ::: "memory");
    float t[64];
    float sw_ = 1.f, su_ = 1.f;
    if (GDN) {
        LDS_WAIT();
        const LAS f32x4* LA4 = (const LAS f32x4*)LA;
#pragma unroll
        for (int i = 0; i < 64; ++i) { float acc = (lane == i) ? 1.f : 0.f; if ((i & 1) == 0) asm volatile("" ::: "memory");
#pragma unroll
            for (int m4 = 0; m4 < (i + 3) / 4; ++m4) { const f32x4 l = LA4[rowoff4c(i) + m4];
                if (4 * m4 + 0 < i) acc -= l.x * t[4 * m4 + 0]; if (4 * m4 + 1 < i) acc -= l.y * t[4 * m4 + 1]; if (4 * m4 + 2 < i) acc -= l.z * t[4 * m4 + 2]; if (4 * m4 + 3 < i) acc -= l.w * t[4 * m4 + 3]; }
            t[i] = acc; }
        su_ = bv; sw_ = bv * __expf(gv);
        LDS_WAIT();
#pragma unroll
        for (int i = 0; i < 64; ++i) *(LAS bf16_t*)(LT + (i * 64 + lane) * 2) = (bf16_t)f2bf(t[i] * sw_);
    }
    asm volatile("" ::: "memory");
    float ksc[2][2][4];
#pragma unroll
    for (int sp = 0; sp < 2; ++sp)
#pragma unroll
        for (int tp = 0; tp < 2; ++tp)
#pragma unroll
            for (int e = 0; e < 4; ++e) ksc[sp][tp][e] = __expf(gl - LG[32 * sp + 16 * tp + 4 * g + e]);
    const unsigned la_addr = (unsigned)(size_t)LA, q4 = (unsigned)((lane & 15) >> 2), p4 = (unsigned)(lane & 3);
#pragma unroll 1
    for (int p = 0; p < 2; ++p) {
        LDS_WAIT();
#pragma unroll
        for (int k = 0; k < 8; ++k) { const int row = (lane >> 3) + 8 * k, pc = lane & 7; if (GDN) *(LAS u32x4*)(LA + row * 128 + pc * 16) = *(const u32x4*)(ksrc + (row0 + row) * qld + 64 * p + 8 * pc); }
        if (!GDN) {
#pragma unroll
            for (int t = 0; t < 4; ++t)
#pragma unroll
                for (int s2 = 0; s2 < 4; ++s2) if ((s2 >> 1) == p) *(LAS bf16x8*)(LA + (16 * t + fr) * 128 + (32 * (s2 & 1) + 8 * g) * 2) = Kf[t][s2]; }
        LDS_WAIT();
        if (GDN) {
#pragma unroll
            for (int it = 0; it < 4; ++it) { bf16x8 Tf[2];
#pragma unroll
                for (int ks = 0; ks < 2; ++ks) Tf[ks] = *(const LAS bf16x8*)(LT + ((16 * it + fr) * 64 + 32 * ks + 8 * g) * 2);
#pragma unroll
                for (int sl = 0; sl < 2; ++sl) { u32x4 w;
#pragma unroll
                    for (int hf = 0; hf < 2; ++hf) { const int dtl = 2 * sl + hf; f32x4 acc = {0.f, 0.f, 0.f, 0.f};
                        { s16x4 a0, a1, a2, a3; const unsigned ad = la_addr + (8 * g + q4) * 128 + dtl * 32 + p4 * 8; tr_read4(ad, ad + 4 * 128, ad + 32 * 128, ad + 36 * 128, a0, a1, a2, a3);
                          acc = mfma16(cat8(a0, a1), Tf[0], acc); acc = mfma16(cat8(a2, a3), Tf[1], acc); }
                        if (hf == 0) { w.x = pk2(-acc[0], -acc[1]); w.y = pk2(-acc[2], -acc[3]); } else { w.z = pk2(-acc[0], -acc[1]); w.w = pk2(-acc[2], -acc[3]); } }
                    *(u32x4*)(st + (OFF_W + it * 4 + 2 * p + sl) * 1024) = w; } }
        }
#pragma unroll
        for (int dtl = 0; dtl < 4; ++dtl) { s16x4 t0, t1, t2, t3; const unsigned ad = la_addr + (4 * g + q4) * 128 + dtl * 32 + p4 * 8; tr_read4(ad, ad + 16 * 128, ad + 32 * 128, ad + 48 * 128, t0, t1, t2, t3);
#pragma unroll
            for (int sp = 0; sp < 2; ++sp) { const s16x4 a0 = sp ? t2 : t0, a1 = sp ? t3 : t1;
                u32x4 w; w.x = pk2(bf2f((bf16_t)a0[0]) * ksc[sp][0][0], bf2f((bf16_t)a0[1]) * ksc[sp][0][1]); w.y = pk2(bf2f((bf16_t)a0[2]) * ksc[sp][0][2], bf2f((bf16_t)a0[3]) * ksc[sp][0][3]);
                w.z = pk2(bf2f((bf16_t)a1[0]) * ksc[sp][1][0], bf2f((bf16_t)a1[1]) * ksc[sp][1][1]); w.w = pk2(bf2f((bf16_t)a1[2]) * ksc[sp][1][2], bf2f((bf16_t)a1[3]) * ksc[sp][1][3]);
                *(u32x4*)(st + (OFF_KT + (4 * p + dtl) * 2 + sp) * 1024) = w; } }
    }
    if (GDN) {
        LDS_WAIT();
#pragma unroll
        for (int i = 0; i < 64; ++i) *(LAS bf16_t*)(LT + (i * 64 + lane) * 2) = (bf16_t)f2bf(t[i] * su_);
        const bf16_t* vsrc = (const bf16_t*)(F.ws + AUX_VC) + h * 256;
        unsigned char* ub = F.ws + WS_H + (size_t)unit * 32768 + lane * 32;
#pragma unroll 1
        for (int p = 0; p < 4; ++p) {
            LDS_WAIT();
#pragma unroll
            for (int k = 0; k < 8; ++k) { const int row = (lane >> 3) + 8 * k, pc = lane & 7; *(LAS u32x4*)(LA + row * 128 + pc * 16) = *(const u32x4*)(vsrc + (row0 + row) * 2048 + 64 * p + 8 * pc); }
            LDS_WAIT();
            bf16x8 Tf[4][2];
#pragma unroll
            for (int it = 0; it < 4; ++it)
#pragma unroll
                for (int ks = 0; ks < 2; ++ks) Tf[it][ks] = *(const LAS bf16x8*)(LT + ((16 * it + fr) * 64 + 32 * ks + 8 * g) * 2);
#pragma unroll
            for (int etl = 0; etl < 4; ++etl) { bf16x8 Vf[2];
                { s16x4 a0, a1, a2, a3; const unsigned ad = la_addr + (8 * g + q4) * 128 + etl * 32 + p4 * 8; tr_read4(ad, ad + 4 * 128, ad + 32 * 128, ad + 36 * 128, a0, a1, a2, a3); Vf[0] = cat8(a0, a1); Vf[1] = cat8(a2, a3); }
                u32x4 w0, w1;
#pragma unroll
                for (int it = 0; it < 4; ++it) { f32x4 acc = {0.f, 0.f, 0.f, 0.f};
#pragma unroll
                    for (int ks = 0; ks < 2; ++ks) acc = mfma16(Tf[it][ks], Vf[ks], acc);
                    const unsigned a = pk2(acc[0], acc[1]), c = pk2(acc[2], acc[3]);
                    if (it == 0) { w0.x = a; w0.y = c; } else if (it == 1) { w0.z = a; w0.w = c; } else if (it == 2) { w1.x = a; w1.y = c; } else { w1.z = a; w1.w = c; } }
                *(u32x4*)(ub + (4 * p + etl) * 2048) = w0; *(u32x4*)(ub + (4 * p + etl) * 2048 + 16) = w1; }
        }
        if (lane == 0) ((float*)(F.ws + AUX_DEC))[unit] = __expf(gl);
    }
    LDS_WAIT();
}

constexpr int XL_SLOT = 12288, XL_CNT = 2 * XL_SLOT;
template <bool GDN, int ROLE>
DI void scan_wave(Frame& F, int bh, int sl, const unsigned char* stream, LAS unsigned char* xl) {
    constexpr int NF = GDN ? 56 : 40;
    const int lane = F.lane, fr = lane & 15, g = lane >> 4, b = bh >> 3, h = bh & 7;
    const unsigned char* sp0 = stream + (size_t)bh * NCH * NF * 1024;
    const unsigned voff = (unsigned)lane * 16u;
    const size_t orow = (size_t)2048 * 2;
    const unsigned char* obu = (GDN ? F.ws + AUX_VC : F.ws + AUX_QN) + (size_t)b * SEQ * orow + (size_t)(h * 256 + 16 * sl) * 2;
    const unsigned ooff = (unsigned)((size_t)(4 * g) * orow) + (unsigned)fr * 2u;
    const size_t vrow = (size_t)PJW * 2;
    const unsigned char* vbu = F.ws + WS_BIG + BIG_PJ + (size_t)C_RV * 2 + (size_t)b * SEQ * vrow + (size_t)(h * 256 + 16 * sl) * 2;
    const unsigned voff2 = (unsigned)((size_t)(4 * g) * vrow) + (unsigned)fr * 2u;
    const float* decp = (const float*)(F.ws + AUX_DEC) + bh * NCH;
    float decr = 1.f; { const float gm = 1.0f - exp2f(-5.0f - (float)h); float d2 = gm * gm; d2 *= d2; d2 *= d2; d2 *= d2; d2 *= d2; d2 *= d2; decr = d2; }
    const unsigned char* ubp = F.ws + WS_H + (size_t)bh * NCH * 32768 + sl * 2048; const unsigned uoff = (unsigned)lane * 32u;
    const unsigned zoff = 0u; (void)decp; (void)decr; (void)ubp; (void)uoff; (void)zoff; (void)obu; (void)ooff; (void)vbu; (void)voff2; (void)vrow; (void)orow;
    if constexpr (GDN && ROLE == 0) {
    bf16x8 r0 = (bf16x8){0, 0, 0, 0, 0, 0, 0, 0};
    bf16x8 r1 = (bf16x8){0, 0, 0, 0, 0, 0, 0, 0};
    bf16x8 r2 = (bf16x8){0, 0, 0, 0, 0, 0, 0, 0};
    bf16x8 r3 = (bf16x8){0, 0, 0, 0, 0, 0, 0, 0};
    bf16x8 r4 = (bf16x8){0, 0, 0, 0, 0, 0, 0, 0};
    bf16x8 r5 = (bf16x8){0, 0, 0, 0, 0, 0, 0, 0};
    bf16x8 r6 = (bf16x8){0, 0, 0, 0, 0, 0, 0, 0};
    bf16x8 r7 = (bf16x8){0, 0, 0, 0, 0, 0, 0, 0};
    bf16x8 r8 = (bf16x8){0, 0, 0, 0, 0, 0, 0, 0};
    bf16x8 r9 = (bf16x8){0, 0, 0, 0, 0, 0, 0, 0};
    bf16x8 r10 = (bf16x8){0, 0, 0, 0, 0, 0, 0, 0};
    bf16x8 r11 = (bf16x8){0, 0, 0, 0, 0, 0, 0, 0};
    bf16x8 r12 = (bf16x8){0, 0, 0, 0, 0, 0, 0, 0};
    bf16x8 r13 = (bf16x8){0, 0, 0, 0, 0, 0, 0, 0};
    bf16x8 r14 = (bf16x8){0, 0, 0, 0, 0, 0, 0, 0};
    bf16x8 r15 = (bf16x8){0, 0, 0, 0, 0, 0, 0, 0};
    f32x4 S0_0 = {0.f, 0.f, 0.f, 0.f};
    f32x4 S0_1 = {0.f, 0.f, 0.f, 0.f};
    f32x4 S0_2 = {0.f, 0.f, 0.f, 0.f};
    f32x4 S0_3 = {0.f, 0.f, 0.f, 0.f};
    f32x4 S0_4 = {0.f, 0.f, 0.f, 0.f};
    f32x4 S0_5 = {0.f, 0.f, 0.f, 0.f};
    f32x4 S0_6 = {0.f, 0.f, 0.f, 0.f};
    f32x4 S0_7 = {0.f, 0.f, 0.f, 0.f};
    bf16x8 Sp0_0 = (bf16x8){0, 0, 0, 0, 0, 0, 0, 0};
    bf16x8 Sp0_1 = (bf16x8){0, 0, 0, 0, 0, 0, 0, 0};
    bf16x8 Sp0_2 = (bf16x8){0, 0, 0, 0, 0, 0, 0, 0};
    bf16x8 Sp0_3 = (bf16x8){0, 0, 0, 0, 0, 0, 0, 0};
    f32x4 S1_0 = {0.f, 0.f, 0.f, 0.f};
    f32x4 S1_1 = {0.f, 0.f, 0.f, 0.f};
    f32x4 S1_2 = {0.f, 0.f, 0.f, 0.f};
    f32x4 S1_3 = {0.f, 0.f, 0.f, 0.f};
    f32x4 S1_4 = {0.f, 0.f, 0.f, 0.f};
    f32x4 S1_5 = {0.f, 0.f, 0.f, 0.f};
    f32x4 S1_6 = {0.f, 0.f, 0.f, 0.f};
    f32x4 S1_7 = {0.f, 0.f, 0.f, 0.f};
    bf16x8 Sp1_0 = (bf16x8){0, 0, 0, 0, 0, 0, 0, 0};
    bf16x8 Sp1_1 = (bf16x8){0, 0, 0, 0, 0, 0, 0, 0};
    bf16x8 Sp1_2 = (bf16x8){0, 0, 0, 0, 0, 0, 0, 0};
    bf16x8 Sp1_3 = (bf16x8){0, 0, 0, 0, 0, 0, 0, 0};
    float decv = 0.f;
    u32x4 un0_0 = {0u, 0u, 0u, 0u}, un0_1 = {0u, 0u, 0u, 0u};
    u32x4 un1_0 = {0u, 0u, 0u, 0u}, un1_1 = {0u, 0u, 0u, 0u};
    { const int n = 0; (void)n;
    asm volatile("global_load_dwordx4 %0, %1, off" : "+v"(un0_0) : "v"((const unsigned char*)(ubp + 0 * 2048) + uoff) : "memory");
    asm volatile("global_load_dwordx4 %0, %1, off offset:16" : "+v"(un0_1) : "v"((const unsigned char*)(ubp + 0 * 2048) + uoff) : "memory");
    asm volatile("global_load_dwordx4 %0, %1, off" : "+v"(un1_0) : "v"((const unsigned char*)(ubp + 1 * 2048) + uoff) : "memory");
    asm volatile("global_load_dwordx4 %0, %1, off offset:16" : "+v"(un1_1) : "v"((const unsigned char*)(ubp + 1 * 2048) + uoff) : "memory");
    asm volatile("global_load_dword %0, %1, off" : "+v"(decv) : "v"((const unsigned char*)(decp) + zoff) : "memory");
    asm volatile("global_load_dwordx4 %0, %1, off" : "+v"(r0) : "v"((const unsigned char*)(sp0 + ((size_t)(n + 0) * 56 + 0) * 1024) + voff) : "memory");
    asm volatile("global_load_dwordx4 %0, %1, off" : "+v"(r1) : "v"((const unsigned char*)(sp0 + ((size_t)(n + 0) * 56 + 1) * 1024) + voff) : "memory");
    asm volatile("global_load_dwordx4 %0, %1, off" : "+v"(r2) : "v"((const unsigned char*)(sp0 + ((size_t)(n + 0) * 56 + 2) * 1024) + voff) : "memory");
    asm volatile("global_load_dwordx4 %0, %1, off" : "+v"(r3) : "v"((const unsigned char*)(sp0 + ((size_t)(n + 0) * 56 + 3) * 1024) + voff) : "memory");
    asm volatile("global_load_dwordx4 %0, %1, off" : "+v"(r4) : "v"((const unsigned char*)(sp0 + ((size_t)(n + 0) * 56 + 4) * 1024) + voff) : "memory");
    asm volatile("global_load_dwordx4 %0, %1, off" : "+v"(r5) : "v"((const unsigned char*)(sp0 + ((size_t)(n + 0) * 56 + 5) * 1024) + voff) : "memory");
    asm volatile("global_load_dwordx4 %0, %1, off" : "+v"(r6) : "v"((const unsigned char*)(sp0 + ((size_t)(n + 0) * 56 + 6) * 1024) + voff) : "memory");
    asm volatile("global_load_dwordx4 %0, %1, off" : "+v"(r7) : "v"((const unsigned char*)(sp0 + ((size_t)(n + 0) * 56 + 7) * 1024) + voff) : "memory");
    asm volatile("global_load_dwordx4 %0, %1, off" : "+v"(r8) : "v"((const unsigned char*)(sp0 + ((size_t)(n + 0) * 56 + 8) * 1024) + voff) : "memory");
    asm volatile("global_load_dwordx4 %0, %1, off" : "+v"(r9) : "v"((const unsigned char*)(sp0 + ((size_t)(n + 0) * 56 + 9) * 1024) + voff) : "memory");
    asm volatile("global_load_dwordx4 %0, %1, off" : "+v"(r10) : "v"((const unsigned char*)(sp0 + ((size_t)(n + 0) * 56 + 10) * 1024) + voff) : "memory");
    asm volatile("global_load_dwordx4 %0, %1, off" : "+v"(r11) : "v"((const unsigned char*)(sp0 + ((size_t)(n + 0) * 56 + 11) * 1024) + voff) : "memory");
    asm volatile("global_load_dwordx4 %0, %1, off" : "+v"(r12) : "v"((const unsigned char*)(sp0 + ((size_t)(n + 0) * 56 + 12) * 1024) + voff) : "memory");
    asm volatile("global_load_dwordx4 %0, %1, off" : "+v"(r13) : "v"((const unsigned char*)(sp0 + ((size_t)(n + 0) * 56 + 13) * 1024) + voff) : "memory");
    asm volatile("global_load_dwordx4 %0, %1, off" : "+v"(r14) : "v"((const unsigned char*)(sp0 + ((size_t)(n + 0) * 56 + 14) * 1024) + voff) : "memory");
    asm volatile("global_load_dwordx4 %0, %1, off" : "+v"(r15) : "v"((const unsigned char*)(sp0 + ((size_t)(n + 0) * 56 + 15) * 1024) + voff) : "memory");
    }
#pragma unroll 1
    for (int n = 0; n < NCH; ++n) {
        const int nn = n + 1 < NCH ? n + 1 : n;
        f32x4 a0_0, a0_1, a0_2, a0_3;
        f32x4 a1_0, a1_1, a1_2, a1_3;
        asm volatile("s_waitcnt vmcnt(16)" : "+v"(un0_0), "+v"(un0_1), "+v"(un1_0), "+v"(un1_1), "+v"(decv));
        a0_0 = (f32x4){bflo(un0_0.x), bfhi(un0_0.x), bflo(un0_0.y), bfhi(un0_0.y)}; a0_1 = (f32x4){bflo(un0_0.z), bfhi(un0_0.z), bflo(un0_0.w), bfhi(un0_0.w)};
        a0_2 = (f32x4){bflo(un0_1.x), bfhi(un0_1.x), bflo(un0_1.y), bfhi(un0_1.y)}; a0_3 = (f32x4){bflo(un0_1.z), bfhi(un0_1.z), bflo(un0_1.w), bfhi(un0_1.w)};
        a1_0 = (f32x4){bflo(un1_0.x), bfhi(un1_0.x), bflo(un1_0.y), bfhi(un1_0.y)}; a1_1 = (f32x4){bflo(un1_0.z), bfhi(un1_0.z), bflo(un1_0.w), bfhi(un1_0.w)};
        a1_2 = (f32x4){bflo(un1_1.x), bfhi(un1_1.x), bflo(un1_1.y), bfhi(un1_1.y)}; a1_3 = (f32x4){bflo(un1_1.z), bfhi(un1_1.z), bflo(un1_1.w), bfhi(un1_1.w)};
        const float dec = decv;
        { const unsigned char* ubn = ubp + (size_t)nn * 32768;
          asm volatile("global_load_dwordx4 %0, %1, off" : "+v"(un0_0) : "v"((const unsigned char*)(ubn + 0 * 2048) + uoff) : "memory");
          asm volatile("global_load_dwordx4 %0, %1, off offset:16" : "+v"(un0_1) : "v"((const unsigned char*)(ubn + 0 * 2048) + uoff) : "memory");
          asm volatile("global_load_dwordx4 %0, %1, off" : "+v"(un1_0) : "v"((const unsigned char*)(ubn + 1 * 2048) + uoff) : "memory");
          asm volatile("global_load_dwordx4 %0, %1, off offset:16" : "+v"(un1_1) : "v"((const unsigned char*)(ubn + 1 * 2048) + uoff) : "memory");
          asm volatile("global_load_dword %0, %1, off" : "+v"(decv) : "v"((const unsigned char*)(decp + nn) + zoff) : "memory"); }
        __builtin_amdgcn_sched_barrier(0);
        asm volatile("s_waitcnt vmcnt(20)" : "+v"(r0));
        a0_0 = mfma16(r0, Sp0_0, a0_0);
        a1_0 = mfma16(r0, Sp1_0, a1_0);
        asm volatile("global_load_dwordx4 %0, %1, off" : "+v"(r0) : "v"((const unsigned char*)(sp0 + ((size_t)(n + 0) * 56 + 40) * 1024) + voff) : "memory");
        __builtin_amdgcn_sched_barrier(0);
        asm volatile("s_waitcnt vmcnt(20)" : "+v"(r1));
        a0_0 = mfma16(r1, Sp0_1, a0_0);
        a1_0 = mfma16(r1, Sp1_1, a1_0);
        asm volatile("global_load_dwordx4 %0, %1, off" : "+v"(r1) : "v"((const unsigned char*)(sp0 + ((size_t)(n + 0) * 56 + 41) * 1024) + voff) : "memory");
        __builtin_amdgcn_sched_barrier(0);
        asm volatile("s_waitcnt vmcnt(20)" : "+v"(r2));
        a0_0 = mfma16(r2, Sp0_2, a0_0);
        a1_0 = mfma16(r2, Sp1_2, a1_0);
        asm volatile("global_load_dwordx4 %0, %1, off" : "+v"(r2) : "v"((const unsigned char*)(sp0 + ((size_t)(n + 0) * 56 + 42) * 1024) + voff) : "memory");
        __builtin_amdgcn_sched_barrier(0);
        asm volatile("s_waitcnt vmcnt(20)" : "+v"(r3));
        a0_0 = mfma16(r3, Sp0_3, a0_0);
        a1_0 = mfma16(r3, Sp1_3, a1_0);
        asm volatile("global_load_dwordx4 %0, %1, off" : "+v"(r3) : "v"((const unsigned char*)(sp0 + ((size_t)(n + 0) * 56 + 43) * 1024) + voff) : "memory");
        __builtin_amdgcn_sched_barrier(0);
        asm volatile("s_waitcnt vmcnt(20)" : "+v"(r4));
        a0_1 = mfma16(r4, Sp0_0, a0_1);
        a1_1 = mfma16(r4, Sp1_0, a1_1);
        asm volatile("global_load_dwordx4 %0, %1, off" : "+v"(r4) : "v"((const unsigned char*)(sp0 + ((size_t)(n + 0) * 56 + 44) * 1024) + voff) : "memory");
        __builtin_amdgcn_sched_barrier(0);
        asm volatile("s_waitcnt vmcnt(20)" : "+v"(r5));
        a0_1 = mfma16(r5, Sp0_1, a0_1);
        a1_1 = mfma16(r5, Sp1_1, a1_1);
        asm volatile("global_load_dwordx4 %0, %1, off" : "+v"(r5) : "v"((const unsigned char*)(sp0 + ((size_t)(n + 0) * 56 + 45) * 1024) + voff) : "memory");
        __builtin_amdgcn_sched_barrier(0);
        asm volatile("s_waitcnt vmcnt(20)" : "+v"(r6));
        a0_1 = mfma16(r6, Sp0_2, a0_1);
        a1_1 = mfma16(r6, Sp1_2, a1_1);
        asm volatile("global_load_dwordx4 %0, %1, off" : "+v"(r6) : "v"((const unsigned char*)(sp0 + ((size_t)(n + 0) * 56 + 46) * 1024) + voff) : "memory");
        __builtin_amdgcn_sched_barrier(0);
        asm volatile("s_waitcnt vmcnt(20)" : "+v"(r7));
        a0_1 = mfma16(r7, Sp0_3, a0_1);
        a1_1 = mfma16(r7, Sp1_3, a1_1);
        asm volatile("global_load_dwordx4 %0, %1, off" : "+v"(r7) : "v"((const unsigned char*)(sp0 + ((size_t)(n + 0) * 56 + 47) * 1024) + voff) : "memory");
        __builtin_amdgcn_sched_barrier(0);
        asm volatile("s_waitcnt vmcnt(20)" : "+v"(r8));
        a0_2 = mfma16(r8, Sp0_0, a0_2);
        a1_2 = mfma16(r8, Sp1_0, a1_2);
        asm volatile("global_load_dwordx4 %0, %1, off" : "+v"(r8) : "v"((const unsigned char*)(sp0 + ((size_t)(n + 0) * 56 + 48) * 1024) + voff) : "memory");
        __builtin_amdgcn_sched_barrier(0);
        asm volatile("s_waitcnt vmcnt(20)" : "+v"(r9));
        a0_2 = mfma16(r9, Sp0_1, a0_2);
        a1_2 = mfma16(r9, Sp1_1, a1_2);
        asm volatile("global_load_dwordx4 %0, %1, off" : "+v"(r9) : "v"((const unsigned char*)(sp0 + ((size_t)(n + 0) * 56 + 49) * 1024) + voff) : "memory");
        __builtin_amdgcn_sched_barrier(0);
        asm volatile("s_waitcnt vmcnt(20)" : "+v"(r10));
        a0_2 = mfma16(r10, Sp0_2, a0_2);
        a1_2 = mfma16(r10, Sp1_2, a1_2);
        asm volatile("global_load_dwordx4 %0, %1, off" : "+v"(r10) : "v"((const unsigned char*)(sp0 + ((size_t)(n + 0) * 56 + 50) * 1024) + voff) : "memory");
        __builtin_amdgcn_sched_barrier(0);
        asm volatile("s_waitcnt vmcnt(20)" : "+v"(r11));
        a0_2 = mfma16(r11, Sp0_3, a0_2);
        a1_2 = mfma16(r11, Sp1_3, a1_2);
        asm volatile("global_load_dwordx4 %0, %1, off" : "+v"(r11) : "v"((const unsigned char*)(sp0 + ((size_t)(n + 0) * 56 + 51) * 1024) + voff) : "memory");
        __builtin_amdgcn_sched_barrier(0);
        asm volatile("s_waitcnt vmcnt(20)" : "+v"(r12));
        a0_3 = mfma16(r12, Sp0_0, a0_3);
        a1_3 = mfma16(r12, Sp1_0, a1_3);
        asm volatile("global_load_dwordx4 %0, %1, off" : "+v"(r12) : "v"((const unsigned char*)(sp0 + ((size_t)(n + 0) * 56 + 52) * 1024) + voff) : "memory");
        __builtin_amdgcn_sched_barrier(0);
        asm volatile("s_waitcnt vmcnt(20)" : "+v"(r13));
        a0_3 = mfma16(r13, Sp0_1, a0_3);
        a1_3 = mfma16(r13, Sp1_1, a1_3);
        asm volatile("global_load_dwordx4 %0, %1, off" : "+v"(r13) : "v"((const unsigned char*)(sp0 + ((size_t)(n + 0) * 56 + 53) * 1024) + voff) : "memory");
        __builtin_amdgcn_sched_barrier(0);
        asm volatile("s_waitcnt vmcnt(20)" : "+v"(r14));
        a0_3 = mfma16(r14, Sp0_2, a0_3);
        a1_3 = mfma16(r14, Sp1_2, a1_3);
        asm volatile("global_load_dwordx4 %0, %1, off" : "+v"(r14) : "v"((const unsigned char*)(sp0 + ((size_t)(n + 0) * 56 + 54) * 1024) + voff) : "memory");
        __builtin_amdgcn_sched_barrier(0);
        asm volatile("s_waitcnt vmcnt(20)" : "+v"(r15));
        a0_3 = mfma16(r15, Sp0_3, a0_3);
        a1_3 = mfma16(r15, Sp1_3, a1_3);
        asm volatile("global_load_dwordx4 %0, %1, off" : "+v"(r15) : "v"((const unsigned char*)(sp0 + ((size_t)(n + 0) * 56 + 55) * 1024) + voff) : "memory");
        __builtin_amdgcn_sched_barrier(0);
        bf16x8 vp0_0, vp0_1;
        { u32x4 w; w.x = cvt_pk_bf16(a0_0[0], a0_0[1]); w.y = cvt_pk_bf16(a0_0[2], a0_0[3]); w.z = cvt_pk_bf16(a0_1[0], a0_1[1]); w.w = cvt_pk_bf16(a0_1[2], a0_1[3]); vp0_0 = __builtin_bit_cast(bf16x8, w); }
        { u32x4 w; w.x = cvt_pk_bf16(a0_2[0], a0_2[1]); w.y = cvt_pk_bf16(a0_2[2], a0_2[3]); w.z = cvt_pk_bf16(a0_3[0], a0_3[1]); w.w = cvt_pk_bf16(a0_3[2], a0_3[3]); vp0_1 = __builtin_bit_cast(bf16x8, w); }
        bf16x8 vp1_0, vp1_1;
        { u32x4 w; w.x = cvt_pk_bf16(a1_0[0], a1_0[1]); w.y = cvt_pk_bf16(a1_0[2], a1_0[3]); w.z = cvt_pk_bf16(a1_1[0], a1_1[1]); w.w = cvt_pk_bf16(a1_1[2], a1_1[3]); vp1_0 = __builtin_bit_cast(bf16x8, w); }
        { u32x4 w; w.x = cvt_pk_bf16(a1_2[0], a1_2[1]); w.y = cvt_pk_bf16(a1_2[2], a1_2[3]); w.z = cvt_pk_bf16(a1_3[0], a1_3[1]); w.w = cvt_pk_bf16(a1_3[2], a1_3[3]); vp1_1 = __builtin_bit_cast(bf16x8, w); }
        { unsigned sp_ = 0; while (*(volatile LAS unsigned*)(xl + XL_CNT + 64) + 2u <= (unsigned)n) { __builtin_amdgcn_s_sleep(1); if (++sp_ > (1u << 22)) break; } }
        { LAS bf16x8* sl_ = (LAS bf16x8*)(xl + (n & 1) * XL_SLOT) + lane; sl_[0] = Sp0_0; sl_[64] = Sp0_1; sl_[128] = Sp0_2; sl_[192] = Sp0_3; sl_[256] = vp0_0; sl_[320] = vp0_1; sl_[384] = Sp1_0; sl_[448] = Sp1_1; sl_[512] = Sp1_2; sl_[576] = Sp1_3; sl_[640] = vp1_0; sl_[704] = vp1_1; }
        asm volatile("s_waitcnt lgkmcnt(0)" ::: "memory");
        if (lane == 0) *(volatile LAS unsigned*)(xl + XL_CNT) = (unsigned)(n + 1);
        S0_0 = S0_0 * dec;
        S1_0 = S1_0 * dec;
        asm volatile("s_waitcnt vmcnt(15)" : "+v"(r0));
        S0_0 = mfma16(r0, vp0_0, S0_0);
        S1_0 = mfma16(r0, vp1_0, S1_0);
        asm volatile("global_load_dwordx4 %0, %1, off" : "+v"(r0) : "v"((const unsigned char*)(sp0 + ((size_t)(n + 1) * 56 + 0) * 1024) + voff) : "memory");
        __builtin_amdgcn_sched_barrier(0);
        asm volatile("s_waitcnt vmcnt(15)" : "+v"(r1));
        S0_0 = mfma16(r1, vp0_1, S0_0);
        S1_0 = mfma16(r1, vp1_1, S1_0);
        asm volatile("global_load_dwordx4 %0, %1, off" : "+v"(r1) : "v"((const unsigned char*)(sp0 + ((size_t)(n + 1) * 56 + 1) * 1024) + voff) : "memory");
        __builtin_amdgcn_sched_barrier(0);
        S0_1 = S0_1 * dec;
        S1_1 = S1_1 * dec;
        asm volatile("s_waitcnt vmcnt(15)" : "+v"(r2));
        S0_1 = mfma16(r2, vp0_0, S0_1);
        S1_1 = mfma16(r2, vp1_0, S1_1);
        asm volatile("global_load_dwordx4 %0, %1, off" : "+v"(r2) : "v"((const unsigned char*)(sp0 + ((size_t)(n + 1) * 56 + 2) * 1024) + voff) : "memory");
        __builtin_amdgcn_sched_barrier(0);
        asm volatile("s_waitcnt vmcnt(15)" : "+v"(r3));
        S0_1 = mfma16(r3, vp0_1, S0_1);
        S1_1 = mfma16(r3, vp1_1, S1_1);
        asm volatile("global_load_dwordx4 %0, %1, off" : "+v"(r3) : "v"((const unsigned char*)(sp0 + ((size_t)(n + 1) * 56 + 3) * 1024) + voff) : "memory");
        __builtin_amdgcn_sched_barrier(0);
        S0_2 = S0_2 * dec;
        S1_2 = S1_2 * dec;
        asm volatile("s_waitcnt vmcnt(15)" : "+v"(r4));
        S0_2 = mfma16(r4, vp0_0, S0_2);
        S1_2 = mfma16(r4, vp1_0, S1_2);
        asm volatile("global_load_dwordx4 %0, %1, off" : "+v"(r4) : "v"((const unsigned char*)(sp0 + ((size_t)(n + 1) * 56 + 4) * 1024) + voff) : "memory");
        __builtin_amdgcn_sched_barrier(0);
        asm volatile("s_waitcnt vmcnt(15)" : "+v"(r5));
        S0_2 = mfma16(r5, vp0_1, S0_2);
        S1_2 = mfma16(r5, vp1_1, S1_2);
        asm volatile("global_load_dwordx4 %0, %1, off" : "+v"(r5) : "v"((const unsigned char*)(sp0 + ((size_t)(n + 1) * 56 + 5) * 1024) + voff) : "memory");
        __builtin_amdgcn_sched_barrier(0);
        S0_3 = S0_3 * dec;
        S1_3 = S1_3 * dec;
        asm volatile("s_waitcnt vmcnt(15)" : "+v"(r6));
        S0_3 = mfma16(r6, vp0_0, S0_3);
        S1_3 = mfma16(r6, vp1_0, S1_3);
        asm volatile("global_load_dwordx4 %0, %1, off" : "+v"(r6) : "v"((const unsigned char*)(sp0 + ((size_t)(n + 1) * 56 + 6) * 1024) + voff) : "memory");
        __builtin_amdgcn_sched_barrier(0);
        asm volatile("s_waitcnt vmcnt(15)" : "+v"(r7));
        S0_3 = mfma16(r7, vp0_1, S0_3);
        S1_3 = mfma16(r7, vp1_1, S1_3);
        asm volatile("global_load_dwordx4 %0, %1, off" : "+v"(r7) : "v"((const unsigned char*)(sp0 + ((size_t)(n + 1) * 56 + 7) * 1024) + voff) : "memory");
        __builtin_amdgcn_sched_barrier(0);
        S0_4 = S0_4 * dec;
        S1_4 = S1_4 * dec;
        asm volatile("s_waitcnt vmcnt(15)" : "+v"(r8));
        S0_4 = mfma16(r8, vp0_0, S0_4);
        S1_4 = mfma16(r8, vp1_0, S1_4);
        asm volatile("global_load_dwordx4 %0, %1, off" : "+v"(r8) : "v"((const unsigned char*)(sp0 + ((size_t)(n + 1) * 56 + 8) * 1024) + voff) : "memory");
        __builtin_amdgcn_sched_barrier(0);
        asm volatile("s_waitcnt vmcnt(15)" : "+v"(r9));
        S0_4 = mfma16(r9, vp0_1, S0_4);
        S1_4 = mfma16(r9, vp1_1, S1_4);
        asm volatile("global_load_dwordx4 %0, %1, off" : "+v"(r9) : "v"((const unsigned char*)(sp0 + ((size_t)(n + 1) * 56 + 9) * 1024) + voff) : "memory");
        __builtin_amdgcn_sched_barrier(0);
        S0_5 = S0_5 * dec;
        S1_5 = S1_5 * dec;
        asm volatile("s_waitcnt vmcnt(15)" : "+v"(r10));
        S0_5 = mfma16(r10, vp0_0, S0_5);
        S1_5 = mfma16(r10, vp1_0, S1_5);
        asm volatile("global_load_dwordx4 %0, %1, off" : "+v"(r10) : "v"((const unsigned char*)(sp0 + ((size_t)(n + 1) * 56 + 10) * 1024) + voff) : "memory");
        __builtin_amdgcn_sched_barrier(0);
        asm volatile("s_waitcnt vmcnt(15)" : "+v"(r11));
        S0_5 = mfma16(r11, vp0_1, S0_5);
        S1_5 = mfma16(r11, vp1_1, S1_5);
        asm volatile("global_load_dwordx4 %0, %1, off" : "+v"(r11) : "v"((const unsigned char*)(sp0 + ((size_t)(n + 1) * 56 + 11) * 1024) + voff) : "memory");
        __builtin_amdgcn_sched_barrier(0);
        S0_6 = S0_6 * dec;
        S1_6 = S1_6 * dec;
        asm volatile("s_waitcnt vmcnt(15)" : "+v"(r12));
        S0_6 = mfma16(r12, vp0_0, S0_6);
        S1_6 = mfma16(r12, vp1_0, S1_6);
        asm volatile("global_load_dwordx4 %0, %1, off" : "+v"(r12) : "v"((const unsigned char*)(sp0 + ((size_t)(n + 1) * 56 + 12) * 1024) + voff) : "memory");
        __builtin_amdgcn_sched_barrier(0);
        asm volatile("s_waitcnt vmcnt(15)" : "+v"(r13));
        S0_6 = mfma16(r13, vp0_1, S0_6);
        S1_6 = mfma16(r13, vp1_1, S1_6);
        asm volatile("global_load_dwordx4 %0, %1, off" : "+v"(r13) : "v"((const unsigned char*)(sp0 + ((size_t)(n + 1) * 56 + 13) * 1024) + voff) : "memory");
        __builtin_amdgcn_sched_barrier(0);
        S0_7 = S0_7 * dec;
        S1_7 = S1_7 * dec;
        asm volatile("s_waitcnt vmcnt(15)" : "+v"(r14));
        S0_7 = mfma16(r14, vp0_0, S0_7);
        S1_7 = mfma16(r14, vp1_0, S1_7);
        asm volatile("global_load_dwordx4 %0, %1, off" : "+v"(r14) : "v"((const unsigned char*)(sp0 + ((size_t)(n + 1) * 56 + 14) * 1024) + voff) : "memory");
        __builtin_amdgcn_sched_barrier(0);
        asm volatile("s_waitcnt vmcnt(15)" : "+v"(r15));
        S0_7 = mfma16(r15, vp0_1, S0_7);
        S1_7 = mfma16(r15, vp1_1, S1_7);
        asm volatile("global_load_dwordx4 %0, %1, off" : "+v"(r15) : "v"((const unsigned char*)(sp0 + ((size_t)(n + 1) * 56 + 15) * 1024) + voff) : "memory");
        __builtin_amdgcn_sched_barrier(0);
        { u32x4 w; w.x = cvt_pk_bf16(S0_0[0], S0_0[1]); w.y = cvt_pk_bf16(S0_0[2], S0_0[3]); w.z = cvt_pk_bf16(S0_1[0], S0_1[1]); w.w = cvt_pk_bf16(S0_1[2], S0_1[3]); Sp0_0 = __builtin_bit_cast(bf16x8, w); }
        { u32x4 w; w.x = cvt_pk_bf16(S0_2[0], S0_2[1]); w.y = cvt_pk_bf16(S0_2[2], S0_2[3]); w.z = cvt_pk_bf16(S0_3[0], S0_3[1]); w.w = cvt_pk_bf16(S0_3[2], S0_3[3]); Sp0_1 = __builtin_bit_cast(bf16x8, w); }
        { u32x4 w; w.x = cvt_pk_bf16(S0_4[0], S0_4[1]); w.y = cvt_pk_bf16(S0_4[2], S0_4[3]); w.z = cvt_pk_bf16(S0_5[0], S0_5[1]); w.w = cvt_pk_bf16(S0_5[2], S0_5[3]); Sp0_2 = __builtin_bit_cast(bf16x8, w); }
        { u32x4 w; w.x = cvt_pk_bf16(S0_6[0], S0_6[1]); w.y = cvt_pk_bf16(S0_6[2], S0_6[3]); w.z = cvt_pk_bf16(S0_7[0], S0_7[1]); w.w = cvt_pk_bf16(S0_7[2], S0_7[3]); Sp0_3 = __builtin_bit_cast(bf16x8, w); }
        { u32x4 w; w.x = cvt_pk_bf16(S1_0[0], S1_0[1]); w.y = cvt_pk_bf16(S1_0[2], S1_0[3]); w.z = cvt_pk_bf16(S1_1[0], S1_1[1]); w.w = cvt_pk_bf16(S1_1[2], S1_1[3]); Sp1_0 = __builtin_bit_cast(bf16x8, w); }
        { u32x4 w; w.x = cvt_pk_bf16(S1_2[0], S1_2[1]); w.y = cvt_pk_bf16(S1_2[2], S1_2[3]); w.z = cvt_pk_bf16(S1_3[0], S1_3[1]); w.w = cvt_pk_bf16(S1_3[2], S1_3[3]); Sp1_1 = __builtin_bit_cast(bf16x8, w); }
        { u32x4 w; w.x = cvt_pk_bf16(S1_4[0], S1_4[1]); w.y = cvt_pk_bf16(S1_4[2], S1_4[3]); w.z = cvt_pk_bf16(S1_5[0], S1_5[1]); w.w = cvt_pk_bf16(S1_5[2], S1_5[3]); Sp1_2 = __builtin_bit_cast(bf16x8, w); }
        { u32x4 w; w.x = cvt_pk_bf16(S1_6[0], S1_6[1]); w.y = cvt_pk_bf16(S1_6[2], S1_6[3]); w.z = cvt_pk_bf16(S1_7[0], S1_7[1]); w.w = cvt_pk_bf16(S1_7[2], S1_7[3]); Sp1_3 = __builtin_bit_cast(bf16x8, w); }
    }
    asm volatile("s_waitcnt vmcnt(0)" ::: "memory");
    } else if constexpr (GDN && ROLE == 1) {
    bf16x8 r0 = (bf16x8){0, 0, 0, 0, 0, 0, 0, 0};
    bf16x8 r1 = (bf16x8){0, 0, 0, 0, 0, 0, 0, 0};
    bf16x8 r2 = (bf16x8){0, 0, 0, 0, 0, 0, 0, 0};
    bf16x8 r3 = (bf16x8){0, 0, 0, 0, 0, 0, 0, 0};
    bf16x8 r4 = (bf16x8){0, 0, 0, 0, 0, 0, 0, 0};
    bf16x8 r5 = (bf16x8){0, 0, 0, 0, 0, 0, 0, 0};
    bf16x8 r6 = (bf16x8){0, 0, 0, 0, 0, 0, 0, 0};
    bf16x8 r7 = (bf16x8){0, 0, 0, 0, 0, 0, 0, 0};
    bf16x8 r8 = (bf16x8){0, 0, 0, 0, 0, 0, 0, 0};
    bf16x8 r9 = (bf16x8){0, 0, 0, 0, 0, 0, 0, 0};
    bf16x8 r10 = (bf16x8){0, 0, 0, 0, 0, 0, 0, 0};
    bf16x8 r11 = (bf16x8){0, 0, 0, 0, 0, 0, 0, 0};
    bf16x8 r12 = (bf16x8){0, 0, 0, 0, 0, 0, 0, 0};
    bf16x8 r13 = (bf16x8){0, 0, 0, 0, 0, 0, 0, 0};
    bf16x8 r14 = (bf16x8){0, 0, 0, 0, 0, 0, 0, 0};
    bf16x8 r15 = (bf16x8){0, 0, 0, 0, 0, 0, 0, 0};
    bf16x8 r16 = (bf16x8){0, 0, 0, 0, 0, 0, 0, 0};
    bf16x8 r17 = (bf16x8){0, 0, 0, 0, 0, 0, 0, 0};
    bf16x8 r18 = (bf16x8){0, 0, 0, 0, 0, 0, 0, 0};
    bf16x8 r19 = (bf16x8){0, 0, 0, 0, 0, 0, 0, 0};
    bf16x8 r20 = (bf16x8){0, 0, 0, 0, 0, 0, 0, 0};
    bf16x8 r21 = (bf16x8){0, 0, 0, 0, 0, 0, 0, 0};
    bf16x8 r22 = (bf16x8){0, 0, 0, 0, 0, 0, 0, 0};
    bf16x8 r23 = (bf16x8){0, 0, 0, 0, 0, 0, 0, 0};
    asm volatile("global_load_dwordx4 %0, %1, off" : "+v"(r0) : "v"((const unsigned char*)(sp0 + ((size_t)(0 + 0) * 56 + 16) * 1024) + voff) : "memory");
    asm volatile("global_load_dwordx4 %0, %1, off" : "+v"(r1) : "v"((const unsigned char*)(sp0 + ((size_t)(0 + 0) * 56 + 17) * 1024) + voff) : "memory");
    asm volatile("global_load_dwordx4 %0, %1, off" : "+v"(r2) : "v"((const unsigned char*)(sp0 + ((size_t)(0 + 0) * 56 + 18) * 1024) + voff) : "memory");
    asm volatile("global_load_dwordx4 %0, %1, off" : "+v"(r3) : "v"((const unsigned char*)(sp0 + ((size_t)(0 + 0) * 56 + 19) * 1024) + voff) : "memory");
    asm volatile("global_load_dwordx4 %0, %1, off" : "+v"(r4) : "v"((const unsigned char*)(sp0 + ((size_t)(0 + 0) * 56 + 20) * 1024) + voff) : "memory");
    asm volatile("global_load_dwordx4 %0, %1, off" : "+v"(r5) : "v"((const unsigned char*)(sp0 + ((size_t)(0 + 0) * 56 + 21) * 1024) + voff) : "memory");
    asm volatile("global_load_dwordx4 %0, %1, off" : "+v"(r6) : "v"((const unsigned char*)(sp0 + ((size_t)(0 + 0) * 56 + 22) * 1024) + voff) : "memory");
    asm volatile("global_load_dwordx4 %0, %1, off" : "+v"(r7) : "v"((const unsigned char*)(sp0 + ((size_t)(0 + 0) * 56 + 23) * 1024) + voff) : "memory");
    asm volatile("global_load_dwordx4 %0, %1, off" : "+v"(r8) : "v"((const unsigned char*)(sp0 + ((size_t)(0 + 0) * 56 + 24) * 1024) + voff) : "memory");
    asm volatile("global_load_dwordx4 %0, %1, off" : "+v"(r9) : "v"((const unsigned char*)(sp0 + ((size_t)(0 + 0) * 56 + 25) * 1024) + voff) : "memory");
    asm volatile("global_load_dwordx4 %0, %1, off" : "+v"(r10) : "v"((const unsigned char*)(sp0 + ((size_t)(0 + 0) * 56 + 26) * 1024) + voff) : "memory");
    asm volatile("global_load_dwordx4 %0, %1, off" : "+v"(r11) : "v"((const unsigned char*)(sp0 + ((size_t)(0 + 0) * 56 + 27) * 1024) + voff) : "memory");
    asm volatile("global_load_dwordx4 %0, %1, off" : "+v"(r12) : "v"((const unsigned char*)(sp0 + ((size_t)(0 + 0) * 56 + 28) * 1024) + voff) : "memory");
    asm volatile("global_load_dwordx4 %0, %1, off" : "+v"(r13) : "v"((const unsigned char*)(sp0 + ((size_t)(0 + 0) * 56 + 29) * 1024) + voff) : "memory");
    asm volatile("global_load_dwordx4 %0, %1, off" : "+v"(r14) : "v"((const unsigned char*)(sp0 + ((size_t)(0 + 0) * 56 + 30) * 1024) + voff) : "memory");
    asm volatile("global_load_dwordx4 %0, %1, off" : "+v"(r15) : "v"((const unsigned char*)(sp0 + ((size_t)(0 + 0) * 56 + 31) * 1024) + voff) : "memory");
    asm volatile("global_load_dwordx4 %0, %1, off" : "+v"(r16) : "v"((const unsigned char*)(sp0 + ((size_t)(0 + 0) * 56 + 32) * 1024) + voff) : "memory");
    asm volatile("global_load_dwordx4 %0, %1, off" : "+v"(r17) : "v"((const unsigned char*)(sp0 + ((size_t)(0 + 0) * 56 + 33) * 1024) + voff) : "memory");
    asm volatile("global_load_dwordx4 %0, %1, off" : "+v"(r18) : "v"((const unsigned char*)(sp0 + ((size_t)(0 + 0) * 56 + 34) * 1024) + voff) : "memory");
    asm volatile("global_load_dwordx4 %0, %1, off" : "+v"(r19) : "v"((const unsigned char*)(sp0 + ((size_t)(0 + 0) * 56 + 35) * 1024) + voff) : "memory");
    asm volatile("global_load_dwordx4 %0, %1, off" : "+v"(r20) : "v"((const unsigned char*)(sp0 + ((size_t)(0 + 0) * 56 + 36) * 1024) + voff) : "memory");
    asm volatile("global_load_dwordx4 %0, %1, off" : "+v"(r21) : "v"((const unsigned char*)(sp0 + ((size_t)(0 + 0) * 56 + 37) * 1024) + voff) : "memory");
    asm volatile("global_load_dwordx4 %0, %1, off" : "+v"(r22) : "v"((const unsigned char*)(sp0 + ((size_t)(0 + 0) * 56 + 38) * 1024) + voff) : "memory");
    asm volatile("global_load_dwordx4 %0, %1, off" : "+v"(r23) : "v"((const unsigned char*)(sp0 + ((size_t)(0 + 0) * 56 + 39) * 1024) + voff) : "memory");
    { unsigned z = 0u;
      asm volatile("global_store_short %0, %1, off" :: "v"((const unsigned char*)(obu + (size_t)(0) * orow + 0) + ooff), "v"(z) : "memory");
      asm volatile("global_store_short %0, %1, off" :: "v"((const unsigned char*)(obu + (size_t)(1) * orow + 0) + ooff), "v"(z) : "memory");
      asm volatile("global_store_short %0, %1, off" :: "v"((const unsigned char*)(obu + (size_t)(2) * orow + 0) + ooff), "v"(z) : "memory");
      asm volatile("global_store_short %0, %1, off" :: "v"((const unsigned char*)(obu + (size_t)(3) * orow + 0) + ooff), "v"(z) : "memory");
      asm volatile("global_store_short %0, %1, off" :: "v"((const unsigned char*)(obu + (size_t)(16) * orow + 0) + ooff), "v"(z) : "memory");
      asm volatile("global_store_short %0, %1, off" :: "v"((const unsigned char*)(obu + (size_t)(17) * orow + 0) + ooff), "v"(z) : "memory");
      asm volatile("global_store_short %0, %1, off" :: "v"((const unsigned char*)(obu + (size_t)(18) * orow + 0) + ooff), "v"(z) : "memory");
      asm volatile("global_store_short %0, %1, off" :: "v"((const unsigned char*)(obu + (size_t)(19) * orow + 0) + ooff), "v"(z) : "memory");
      asm volatile("global_store_short %0, %1, off" :: "v"((const unsigned char*)(obu + (size_t)(32) * orow + 0) + ooff), "v"(z) : "memory");
      asm volatile("global_store_short %0, %1, off" :: "v"((const unsigned char*)(obu + (size_t)(33) * orow + 0) + ooff), "v"(z) : "memory");
      asm volatile("global_store_short %0, %1, off" :: "v"((const unsigned char*)(obu + (size_t)(34) * orow + 0) + ooff), "v"(z) : "memory");
      asm volatile("global_store_short %0, %1, off" :: "v"((const unsigned char*)(obu + (size_t)(35) * orow + 0) + ooff), "v"(z) : "memory");
      asm volatile("global_store_short %0, %1, off" :: "v"((const unsigned char*)(obu + (size_t)(48) * orow + 0) + ooff), "v"(z) : "memory");
      asm volatile("global_store_short %0, %1, off" :: "v"((const unsigned char*)(obu + (size_t)(49) * orow + 0) + ooff), "v"(z) : "memory");
      asm volatile("global_store_short %0, %1, off" :: "v"((const unsigned char*)(obu + (size_t)(50) * orow + 0) + ooff), "v"(z) : "memory");
      asm volatile("global_store_short %0, %1, off" :: "v"((const unsigned char*)(obu + (size_t)(51) * orow + 0) + ooff), "v"(z) : "memory");
      asm volatile("global_store_short %0, %1, off" :: "v"((const unsigned char*)(obu + (size_t)(0) * orow + 32) + ooff), "v"(z) : "memory");
      asm volatile("global_store_short %0, %1, off" :: "v"((const unsigned char*)(obu + (size_t)(1) * orow + 32) + ooff), "v"(z) : "memory");
      asm volatile("global_store_short %0, %1, off" :: "v"((const unsigned char*)(obu + (size_t)(2) * orow + 32) + ooff), "v"(z) : "memory");
      asm volatile("global_store_short %0, %1, off" :: "v"((const unsigned char*)(obu + (size_t)(3) * orow + 32) + ooff), "v"(z) : "memory");
      asm volatile("global_store_short %0, %1, off" :: "v"((const unsigned char*)(obu + (size_t)(16) * orow + 32) + ooff), "v"(z) : "memory");
      asm volatile("global_store_short %0, %1, off" :: "v"((const unsigned char*)(obu + (size_t)(17) * orow + 32) + ooff), "v"(z) : "memory");
      asm volatile("global_store_short %0, %1, off" :: "v"((const unsigned char*)(obu + (size_t)(18) * orow + 32) + ooff), "v"(z) : "memory");
      asm volatile("global_store_short %0, %1, off" :: "v"((const unsigned char*)(obu + (size_t)(19) * orow + 32) + ooff), "v"(z) : "memory");
      asm volatile("global_store_short %0, %1, off" :: "v"((const unsigned char*)(obu + (size_t)(32) * orow + 32) + ooff), "v"(z) : "memory");
      asm volatile("global_store_short %0, %1, off" :: "v"((const unsigned char*)(obu + (size_t)(33) * orow + 32) + ooff), "v"(z) : "memory");
      asm volatile("global_store_short %0, %1, off" :: "v"((const unsigned char*)(obu + (size_t)(34) * orow + 32) + ooff), "v"(z) : "memory");
      asm volatile("global_store_short %0, %1, off" :: "v"((const unsigned char*)(obu + (size_t)(35) * orow + 32) + ooff), "v"(z) : "memory");
      asm volatile("global_store_short %0, %1, off" :: "v"((const unsigned char*)(obu + (size_t)(48) * orow + 32) + ooff), "v"(z) : "memory");
      asm volatile("global_store_short %0, %1, off" :: "v"((const unsigned char*)(obu + (size_t)(49) * orow + 32) + ooff), "v"(z) : "memory");
      asm volatile("global_store_short %0, %1, off" :: "v"((const unsigned char*)(obu + (size_t)(50) * orow + 32) + ooff), "v"(z) : "memory");
      asm volatile("global_store_short %0, %1, off" :: "v"((const unsigned char*)(obu + (size_t)(51) * orow + 32) + ooff), "v"(z) : "memory");
    }
#pragma unroll 1
    for (int n = 0; n < NCH; ++n) {
        { unsigned sp_ = 0; while (*(volatile LAS unsigned*)(xl + XL_CNT) <= (unsigned)n) { __builtin_amdgcn_s_sleep(1); if (++sp_ > (1u << 22)) break; } }
        bf16x8 Sp0_0, Sp0_1, Sp0_2, Sp0_3, vp0_0, vp0_1;
        bf16x8 Sp1_0, Sp1_1, Sp1_2, Sp1_3, vp1_0, vp1_1;
        { const LAS bf16x8* sl_ = (const LAS bf16x8*)(xl + (n & 1) * XL_SLOT) + lane; Sp0_0 = sl_[0]; Sp0_1 = sl_[64]; Sp0_2 = sl_[128]; Sp0_3 = sl_[192]; vp0_0 = sl_[256]; vp0_1 = sl_[320]; Sp1_0 = sl_[384]; Sp1_1 = sl_[448]; Sp1_2 = sl_[512]; Sp1_3 = sl_[576]; vp1_0 = sl_[640]; vp1_1 = sl_[704]; }
        asm volatile("s_waitcnt lgkmcnt(0)" ::: "memory");
        if (lane == 0) *(volatile LAS unsigned*)(xl + XL_CNT + 64) = (unsigned)(n + 1);
        f32x4 o0_0 = {0.f, 0.f, 0.f, 0.f}, o0_1 = o0_0, o0_2 = o0_0, o0_3 = o0_0;
        f32x4 o1_0 = {0.f, 0.f, 0.f, 0.f}, o1_1 = o1_0, o1_2 = o1_0, o1_3 = o1_0;
        asm volatile("s_waitcnt vmcnt(55)" : "+v"(r0));
        o0_0 = mfma16(r0, Sp0_0, o0_0);
        o1_0 = mfma16(r0, Sp1_0, o1_0);
        asm volatile("global_load_dwordx4 %0, %1, off" : "+v"(r0) : "v"((const unsigned char*)(sp0 + ((size_t)(n + 1) * 56 + 16) * 1024) + voff) : "memory");
        __builtin_amdgcn_sched_barrier(0);
        asm volatile("s_waitcnt vmcnt(55)" : "+v"(r1));
        o0_0 = mfma16(r1, Sp0_1, o0_0);
        o1_0 = mfma16(r1, Sp1_1, o1_0);
        asm volatile("global_load_dwordx4 %0, %1, off" : "+v"(r1) : "v"((const unsigned char*)(sp0 + ((size_t)(n + 1) * 56 + 17) * 1024) + voff) : "memory");
        __builtin_amdgcn_sched_barrier(0);
        asm volatile("s_waitcnt vmcnt(55)" : "+v"(r2));
        o0_0 = mfma16(r2, Sp0_2, o0_0);
        o1_0 = mfma16(r2, Sp1_2, o1_0);
        asm volatile("global_load_dwordx4 %0, %1, off" : "+v"(r2) : "v"((const unsigned char*)(sp0 + ((size_t)(n + 1) * 56 + 18) * 1024) + voff) : "memory");
        __builtin_amdgcn_sched_barrier(0);
        asm volatile("s_waitcnt vmcnt(55)" : "+v"(r3));
        o0_0 = mfma16(r3, Sp0_3, o0_0);
        o1_0 = mfma16(r3, Sp1_3, o1_0);
        asm volatile("global_load_dwordx4 %0, %1, off" : "+v"(r3) : "v"((const unsigned char*)(sp0 + ((size_t)(n + 1) * 56 + 19) * 1024) + voff) : "memory");
        __builtin_amdgcn_sched_barrier(0);
        asm volatile("s_waitcnt vmcnt(55)" : "+v"(r4));
        o0_1 = mfma16(r4, Sp0_0, o0_1);
        o1_1 = mfma16(r4, Sp1_0, o1_1);
        asm volatile("global_load_dwordx4 %0, %1, off" : "+v"(r4) : "v"((const unsigned char*)(sp0 + ((size_t)(n + 1) * 56 + 20) * 1024) + voff) : "memory");
        __builtin_amdgcn_sched_barrier(0);
        asm volatile("s_waitcnt vmcnt(55)" : "+v"(r5));
        o0_1 = mfma16(r5, Sp0_1, o0_1);
        o1_1 = mfma16(r5, Sp1_1, o1_1);
        asm volatile("global_load_dwordx4 %0, %1, off" : "+v"(r5) : "v"((const unsigned char*)(sp0 + ((size_t)(n + 1) * 56 + 21) * 1024) + voff) : "memory");
        __builtin_amdgcn_sched_barrier(0);
        asm volatile("s_waitcnt vmcnt(55)" : "+v"(r6));
        o0_1 = mfma16(r6, Sp0_2, o0_1);
        o1_1 = mfma16(r6, Sp1_2, o1_1);
        asm volatile("global_load_dwordx4 %0, %1, off" : "+v"(r6) : "v"((const unsigned char*)(sp0 + ((size_t)(n + 1) * 56 + 22) * 1024) + voff) : "memory");
        __builtin_amdgcn_sched_barrier(0);
        asm volatile("s_waitcnt vmcnt(55)" : "+v"(r7));
        o0_1 = mfma16(r7, Sp0_3, o0_1);
        o1_1 = mfma16(r7, Sp1_3, o1_1);
        asm volatile("global_load_dwordx4 %0, %1, off" : "+v"(r7) : "v"((const unsigned char*)(sp0 + ((size_t)(n + 1) * 56 + 23) * 1024) + voff) : "memory");
        __builtin_amdgcn_sched_barrier(0);
        asm volatile("s_waitcnt vmcnt(55)" : "+v"(r8));
        o0_2 = mfma16(r8, Sp0_0, o0_2);
        o1_2 = mfma16(r8, Sp1_0, o1_2);
        asm volatile("global_load_dwordx4 %0, %1, off" : "+v"(r8) : "v"((const unsigned char*)(sp0 + ((size_t)(n + 1) * 56 + 24) * 1024) + voff) : "memory");
        __builtin_amdgcn_sched_barrier(0);
        asm volatile("s_waitcnt vmcnt(55)" : "+v"(r9));
        o0_2 = mfma16(r9, Sp0_1, o0_2);
        o1_2 = mfma16(r9, Sp1_1, o1_2);
        asm volatile("global_load_dwordx4 %0, %1, off" : "+v"(r9) : "v"((const unsigned char*)(sp0 + ((size_t)(n + 1) * 56 + 25) * 1024) + voff) : "memory");
        __builtin_amdgcn_sched_barrier(0);
        asm volatile("s_waitcnt vmcnt(55)" : "+v"(r10));
        o0_2 = mfma16(r10, Sp0_2, o0_2);
        o1_2 = mfma16(r10, Sp1_2, o1_2);
        asm volatile("global_load_dwordx4 %0, %1, off" : "+v"(r10) : "v"((const unsigned char*)(sp0 + ((size_t)(n + 1) * 56 + 26) * 1024) + voff) : "memory");
        __builtin_amdgcn_sched_barrier(0);
        asm volatile("s_waitcnt vmcnt(55)" : "+v"(r11));
        o0_2 = mfma16(r11, Sp0_3, o0_2);
        o1_2 = mfma16(r11, Sp1_3, o1_2);
        asm volatile("global_load_dwordx4 %0, %1, off" : "+v"(r11) : "v"((const unsigned char*)(sp0 + ((size_t)(n + 1) * 56 + 27) * 1024) + voff) : "memory");
        __builtin_amdgcn_sched_barrier(0);
        asm volatile("s_waitcnt vmcnt(55)" : "+v"(r12));
        o0_3 = mfma16(r12, Sp0_0, o0_3);
        o1_3 = mfma16(r12, Sp1_0, o1_3);
        asm volatile("global_load_dwordx4 %0, %1, off" : "+v"(r12) : "v"((const unsigned char*)(sp0 + ((size_t)(n + 1) * 56 + 28) * 1024) + voff) : "memory");
        __builtin_amdgcn_sched_barrier(0);
        asm volatile("s_waitcnt vmcnt(55)" : "+v"(r13));
        o0_3 = mfma16(r13, Sp0_1, o0_3);
        o1_3 = mfma16(r13, Sp1_1, o1_3);
        asm volatile("global_load_dwordx4 %0, %1, off" : "+v"(r13) : "v"((const unsigned char*)(sp0 + ((size_t)(n + 1) * 56 + 29) * 1024) + voff) : "memory");
        __builtin_amdgcn_sched_barrier(0);
        asm volatile("s_waitcnt vmcnt(55)" : "+v"(r14));
        o0_3 = mfma16(r14, Sp0_2, o0_3);
        o1_3 = mfma16(r14, Sp1_2, o1_3);
        asm volatile("global_load_dwordx4 %0, %1, off" : "+v"(r14) : "v"((const unsigned char*)(sp0 + ((size_t)(n + 1) * 56 + 30) * 1024) + voff) : "memory");
        __builtin_amdgcn_sched_barrier(0);
        asm volatile("s_waitcnt vmcnt(55)" : "+v"(r15));
        o0_3 = mfma16(r15, Sp0_3, o0_3);
        o1_3 = mfma16(r15, Sp1_3, o1_3);
        asm volatile("global_load_dwordx4 %0, %1, off" : "+v"(r15) : "v"((const unsigned char*)(sp0 + ((size_t)(n + 1) * 56 + 31) * 1024) + voff) : "memory");
        __builtin_amdgcn_sched_barrier(0);
        asm volatile("s_waitcnt vmcnt(55)" : "+v"(r16));
        o0_0 = mfma16(r16, vp0_0, o0_0);
        o1_0 = mfma16(r16, vp1_0, o1_0);
        asm volatile("global_load_dwordx4 %0, %1, off" : "+v"(r16) : "v"((const unsigned char*)(sp0 + ((size_t)(n + 1) * 56 + 32) * 1024) + voff) : "memory");
        __builtin_amdgcn_sched_barrier(0);
        asm volatile("s_waitcnt vmcnt(55)" : "+v"(r17));
        o0_0 = mfma16(r17, vp0_1, o0_0);
        o1_0 = mfma16(r17, vp1_1, o1_0);
        asm volatile("global_load_dwordx4 %0, %1, off" : "+v"(r17) : "v"((const unsigned char*)(sp0 + ((size_t)(n + 1) * 56 + 33) * 1024) + voff) : "memory");
        __builtin_amdgcn_sched_barrier(0);
        asm volatile("s_waitcnt vmcnt(55)" : "+v"(r18));
        o0_1 = mfma16(r18, vp0_0, o0_1);
        o1_1 = mfma16(r18, vp1_0, o1_1);
        asm volatile("global_load_dwordx4 %0, %1, off" : "+v"(r18) : "v"((const unsigned char*)(sp0 + ((size_t)(n + 1) * 56 + 34) * 1024) + voff) : "memory");
        __builtin_amdgcn_sched_barrier(0);
        asm volatile("s_waitcnt vmcnt(55)" : "+v"(r19));
        o0_1 = mfma16(r19, vp0_1, o0_1);
        o1_1 = mfma16(r19, vp1_1, o1_1);
        asm volatile("global_load_dwordx4 %0, %1, off" : "+v"(r19) : "v"((const unsigned char*)(sp0 + ((size_t)(n + 1) * 56 + 35) * 1024) + voff) : "memory");
        __builtin_amdgcn_sched_barrier(0);
        asm volatile("s_waitcnt vmcnt(55)" : "+v"(r20));
        o0_2 = mfma16(r20, vp0_0, o0_2);
        o1_2 = mfma16(r20, vp1_0, o1_2);
        asm volatile("global_load_dwordx4 %0, %1, off" : "+v"(r20) : "v"((const unsigned char*)(sp0 + ((size_t)(n + 1) * 56 + 36) * 1024) + voff) : "memory");
        __builtin_amdgcn_sched_barrier(0);
        asm volatile("s_waitcnt vmcnt(55)" : "+v"(r21));
        o0_2 = mfma16(r21, vp0_1, o0_2);
        o1_2 = mfma16(r21, vp1_1, o1_2);
        asm volatile("global_load_dwordx4 %0, %1, off" : "+v"(r21) : "v"((const unsigned char*)(sp0 + ((size_t)(n + 1) * 56 + 37) * 1024) + voff) : "memory");
        __builtin_amdgcn_sched_barrier(0);
        asm volatile("s_waitcnt vmcnt(55)" : "+v"(r22));
        o0_3 = mfma16(r22, vp0_0, o0_3);
        o1_3 = mfma16(r22, vp1_0, o1_3);
        asm volatile("global_load_dwordx4 %0, %1, off" : "+v"(r22) : "v"((const unsigned char*)(sp0 + ((size_t)(n + 1) * 56 + 38) * 1024) + voff) : "memory");
        __builtin_amdgcn_sched_barrier(0);
        asm volatile("s_waitcnt vmcnt(55)" : "+v"(r23));
        o0_3 = mfma16(r23, vp0_1, o0_3);
        o1_3 = mfma16(r23, vp1_1, o1_3);
        asm volatile("global_load_dwordx4 %0, %1, off" : "+v"(r23) : "v"((const unsigned char*)(sp0 + ((size_t)(n + 1) * 56 + 39) * 1024) + voff) : "memory");
        __builtin_amdgcn_sched_barrier(0);
        { const unsigned char* obn = obu + (size_t)n * 64 * orow;
          { const unsigned v = f2bf(o0_0[0]); asm volatile("global_store_short %0, %1, off" :: "v"((const unsigned char*)(obn + (size_t)(0) * orow + 0) + ooff), "v"(v) : "memory"); }
          { const unsigned v = f2bf(o0_0[1]); asm volatile("global_store_short %0, %1, off" :: "v"((const unsigned char*)(obn + (size_t)(1) * orow + 0) + ooff), "v"(v) : "memory"); }
          { const unsigned v = f2bf(o0_0[2]); asm volatile("global_store_short %0, %1, off" :: "v"((const unsigned char*)(obn + (size_t)(2) * orow + 0) + ooff), "v"(v) : "memory"); }
          { const unsigned v = f2bf(o0_0[3]); asm volatile("global_store_short %0, %1, off" :: "v"((const unsigned char*)(obn + (size_t)(3) * orow + 0) + ooff), "v"(v) : "memory"); }
          { const unsigned v = f2bf(o0_1[0]); asm volatile("global_store_short %0, %1, off" :: "v"((const unsigned char*)(obn + (size_t)(16) * orow + 0) + ooff), "v"(v) : "memory"); }
          { const unsigned v = f2bf(o0_1[1]); asm volatile("global_store_short %0, %1, off" :: "v"((const unsigned char*)(obn + (size_t)(17) * orow + 0) + ooff), "v"(v) : "memory"); }
          { const unsigned v = f2bf(o0_1[2]); asm volatile("global_store_short %0, %1, off" :: "v"((const unsigned char*)(obn + (size_t)(18) * orow + 0) + ooff), "v"(v) : "memory"); }
          { const unsigned v = f2bf(o0_1[3]); asm volatile("global_store_short %0, %1, off" :: "v"((const unsigned char*)(obn + (size_t)(19) * orow + 0) + ooff), "v"(v) : "memory"); }
          { const unsigned v = f2bf(o0_2[0]); asm volatile("global_store_short %0, %1, off" :: "v"((const unsigned char*)(obn + (size_t)(32) * orow + 0) + ooff), "v"(v) : "memory"); }
          { const unsigned v = f2bf(o0_2[1]); asm volatile("global_store_short %0, %1, off" :: "v"((const unsigned char*)(obn + (size_t)(33) * orow + 0) + ooff), "v"(v) : "memory"); }
          { const unsigned v = f2bf(o0_2[2]); asm volatile("global_store_short %0, %1, off" :: "v"((const unsigned char*)(obn + (size_t)(34) * orow + 0) + ooff), "v"(v) : "memory"); }
          { const unsigned v = f2bf(o0_2[3]); asm volatile("global_store_short %0, %1, off" :: "v"((const unsigned char*)(obn + (size_t)(35) * orow + 0) + ooff), "v"(v) : "memory"); }
          { const unsigned v = f2bf(o0_3[0]); asm volatile("global_store_short %0, %1, off" :: "v"((const unsigned char*)(obn + (size_t)(48) * orow + 0) + ooff), "v"(v) : "memory"); }
          { const unsigned v = f2bf(o0_3[1]); asm volatile("global_store_short %0, %1, off" :: "v"((const unsigned char*)(obn + (size_t)(49) * orow + 0) + ooff), "v"(v) : "memory"); }
          { const unsigned v = f2bf(o0_3[2]); asm volatile("global_store_short %0, %1, off" :: "v"((const unsigned char*)(obn + (size_t)(50) * orow + 0) + ooff), "v"(v) : "memory"); }
          { const unsigned v = f2bf(o0_3[3]); asm volatile("global_store_short %0, %1, off" :: "v"((const unsigned char*)(obn + (size_t)(51) * orow + 0) + ooff), "v"(v) : "memory"); }
          { const unsigned v = f2bf(o1_0[0]); asm volatile("global_store_short %0, %1, off" :: "v"((const unsigned char*)(obn + (size_t)(0) * orow + 32) + ooff), "v"(v) : "memory"); }
          { const unsigned v = f2bf(o1_0[1]); asm volatile("global_store_short %0, %1, off" :: "v"((const unsigned char*)(obn + (size_t)(1) * orow + 32) + ooff), "v"(v) : "memory"); }
          { const unsigned v = f2bf(o1_0[2]); asm volatile("global_store_short %0, %1, off" :: "v"((const unsigned char*)(obn + (size_t)(2) * orow + 32) + ooff), "v"(v) : "memory"); }
          { const unsigned v = f2bf(o1_0[3]); asm volatile("global_store_short %0, %1, off" :: "v"((const unsigned char*)(obn + (size_t)(3) * orow + 32) + ooff), "v"(v) : "memory"); }
          { const unsigned v = f2bf(o1_1[0]); asm volatile("global_store_short %0, %1, off" :: "v"((const unsigned char*)(obn + (size_t)(16) * orow + 32) + ooff), "v"(v) : "memory"); }
          { const unsigned v = f2bf(o1_1[1]); asm volatile("global_store_short %0, %1, off" :: "v"((const unsigned char*)(obn + (size_t)(17) * orow + 32) + ooff), "v"(v) : "memory"); }
          { const unsigned v = f2bf(o1_1[2]); asm volatile("global_store_short %0, %1, off" :: "v"((const unsigned char*)(obn + (size_t)(18) * orow + 32) + ooff), "v"(v) : "memory"); }
          { const unsigned v = f2bf(o1_1[3]); asm volatile("global_store_short %0, %1, off" :: "v"((const unsigned char*)(obn + (size_t)(19) * orow + 32) + ooff), "v"(v) : "memory"); }
          { const unsigned v = f2bf(o1_2[0]); asm volatile("global_store_short %0, %1, off" :: "v"((const unsigned char*)(obn + (size_t)(32) * orow + 32) + ooff), "v"(v) : "memory"); }
          { const unsigned v = f2bf(o1_2[1]); asm volatile("global_store_short %0, %1, off" :: "v"((const unsigned char*)(obn + (size_t)(33) * orow + 32) + ooff), "v"(v) : "memory"); }
          { const unsigned v = f2bf(o1_2[2]); asm volatile("global_store_short %0, %1, off" :: "v"((const unsigned char*)(obn + (size_t)(34) * orow + 32) + ooff), "v"(v) : "memory"); }
          { const unsigned v = f2bf(o1_2[3]); asm volatile("global_store_short %0, %1, off" :: "v"((const unsigned char*)(obn + (size_t)(35) * orow + 32) + ooff), "v"(v) : "memory"); }
          { const unsigned v = f2bf(o1_3[0]); asm volatile("global_store_short %0, %1, off" :: "v"((const unsigned char*)(obn + (size_t)(48) * orow + 32) + ooff), "v"(v) : "memory"); }
          { const unsigned v = f2bf(o1_3[1]); asm volatile("global_store_short %0, %1, off" :: "v"((const unsigned char*)(obn + (size_t)(49) * orow + 32) + ooff), "v"(v) : "memory"); }
          { const unsigned v = f2bf(o1_3[2]); asm volatile("global_store_short %0, %1, off" :: "v"((const unsigned char*)(obn + (size_t)(50) * orow + 32) + ooff), "v"(v) : "memory"); }
          { const unsigned v = f2bf(o1_3[3]); asm volatile("global_store_short %0, %1, off" :: "v"((const unsigned char*)(obn + (size_t)(51) * orow + 32) + ooff), "v"(v) : "memory"); }
        }
        __builtin_amdgcn_sched_barrier(0);
    }
    asm volatile("s_waitcnt vmcnt(0)" ::: "memory");
    } else if constexpr (!GDN && ROLE == 0) {
    bf16x8 r0 = (bf16x8){0, 0, 0, 0, 0, 0, 0, 0};
    bf16x8 r1 = (bf16x8){0, 0, 0, 0, 0, 0, 0, 0};
    bf16x8 r2 = (bf16x8){0, 0, 0, 0, 0, 0, 0, 0};
    bf16x8 r3 = (bf16x8){0, 0, 0, 0, 0, 0, 0, 0};
    bf16x8 r4 = (bf16x8){0, 0, 0, 0, 0, 0, 0, 0};
    bf16x8 r5 = (bf16x8){0, 0, 0, 0, 0, 0, 0, 0};
    bf16x8 r6 = (bf16x8){0, 0, 0, 0, 0, 0, 0, 0};
    bf16x8 r7 = (bf16x8){0, 0, 0, 0, 0, 0, 0, 0};
    bf16x8 r8 = (bf16x8){0, 0, 0, 0, 0, 0, 0, 0};
    bf16x8 r9 = (bf16x8){0, 0, 0, 0, 0, 0, 0, 0};
    bf16x8 r10 = (bf16x8){0, 0, 0, 0, 0, 0, 0, 0};
    bf16x8 r11 = (bf16x8){0, 0, 0, 0, 0, 0, 0, 0};
    bf16x8 r12 = (bf16x8){0, 0, 0, 0, 0, 0, 0, 0};
    bf16x8 r13 = (bf16x8){0, 0, 0, 0, 0, 0, 0, 0};
    bf16x8 r14 = (bf16x8){0, 0, 0, 0, 0, 0, 0, 0};
    bf16x8 r15 = (bf16x8){0, 0, 0, 0, 0, 0, 0, 0};
    f32x4 S0_0 = {0.f, 0.f, 0.f, 0.f};
    f32x4 S0_1 = {0.f, 0.f, 0.f, 0.f};
    f32x4 S0_2 = {0.f, 0.f, 0.f, 0.f};
    f32x4 S0_3 = {0.f, 0.f, 0.f, 0.f};
    f32x4 S0_4 = {0.f, 0.f, 0.f, 0.f};
    f32x4 S0_5 = {0.f, 0.f, 0.f, 0.f};
    f32x4 S0_6 = {0.f, 0.f, 0.f, 0.f};
    f32x4 S0_7 = {0.f, 0.f, 0.f, 0.f};
    bf16x8 Sp0_0 = (bf16x8){0, 0, 0, 0, 0, 0, 0, 0};
    bf16x8 Sp0_1 = (bf16x8){0, 0, 0, 0, 0, 0, 0, 0};
    bf16x8 Sp0_2 = (bf16x8){0, 0, 0, 0, 0, 0, 0, 0};
    bf16x8 Sp0_3 = (bf16x8){0, 0, 0, 0, 0, 0, 0, 0};
    f32x4 S1_0 = {0.f, 0.f, 0.f, 0.f};
    f32x4 S1_1 = {0.f, 0.f, 0.f, 0.f};
    f32x4 S1_2 = {0.f, 0.f, 0.f, 0.f};
    f32x4 S1_3 = {0.f, 0.f, 0.f, 0.f};
    f32x4 S1_4 = {0.f, 0.f, 0.f, 0.f};
    f32x4 S1_5 = {0.f, 0.f, 0.f, 0.f};
    f32x4 S1_6 = {0.f, 0.f, 0.f, 0.f};
    f32x4 S1_7 = {0.f, 0.f, 0.f, 0.f};
    bf16x8 Sp1_0 = (bf16x8){0, 0, 0, 0, 0, 0, 0, 0};
    bf16x8 Sp1_1 = (bf16x8){0, 0, 0, 0, 0, 0, 0, 0};
    bf16x8 Sp1_2 = (bf16x8){0, 0, 0, 0, 0, 0, 0, 0};
    bf16x8 Sp1_3 = (bf16x8){0, 0, 0, 0, 0, 0, 0, 0};
    unsigned vn0_0 = 0u, vn0_1 = 0u, vn0_2 = 0u, vn0_3 = 0u, vn0_4 = 0u, vn0_5 = 0u, vn0_6 = 0u, vn0_7 = 0u, vn0_8 = 0u, vn0_9 = 0u, vn0_10 = 0u, vn0_11 = 0u, vn0_12 = 0u, vn0_13 = 0u, vn0_14 = 0u, vn0_15 = 0u;
    unsigned vn1_0 = 0u, vn1_1 = 0u, vn1_2 = 0u, vn1_3 = 0u, vn1_4 = 0u, vn1_5 = 0u, vn1_6 = 0u, vn1_7 = 0u, vn1_8 = 0u, vn1_9 = 0u, vn1_10 = 0u, vn1_11 = 0u, vn1_12 = 0u, vn1_13 = 0u, vn1_14 = 0u, vn1_15 = 0u;
    { const int n = 0; (void)n;
    asm volatile("global_load_ushort %0, %1, off" : "+v"(vn0_0) : "v"((const unsigned char*)(vbu + (size_t)(0) * vrow + 0) + voff2) : "memory");
    asm volatile("global_load_ushort %0, %1, off" : "+v"(vn0_1) : "v"((const unsigned char*)(vbu + (size_t)(1) * vrow + 0) + voff2) : "memory");
    asm volatile("global_load_ushort %0, %1, off" : "+v"(vn0_2) : "v"((const unsigned char*)(vbu + (size_t)(2) * vrow + 0) + voff2) : "memory");
    asm volatile("global_load_ushort %0, %1, off" : "+v"(vn0_3) : "v"((const unsigned char*)(vbu + (size_t)(3) * vrow + 0) + voff2) : "memory");
    asm volatile("global_load_ushort %0, %1, off" : "+v"(vn0_4) : "v"((const unsigned char*)(vbu + (size_t)(16) * vrow + 0) + voff2) : "memory");
    asm volatile("global_load_ushort %0, %1, off" : "+v"(vn0_5) : "v"((const unsigned char*)(vbu + (size_t)(17) * vrow + 0) + voff2) : "memory");
    asm volatile("global_load_ushort %0, %1, off" : "+v"(vn0_6) : "v"((const unsigned char*)(vbu + (size_t)(18) * vrow + 0) + voff2) : "memory");
    asm volatile("global_load_ushort %0, %1, off" : "+v"(vn0_7) : "v"((const unsigned char*)(vbu + (size_t)(19) * vrow + 0) + voff2) : "memory");
    asm volatile("global_load_ushort %0, %1, off" : "+v"(vn0_8) : "v"((const unsigned char*)(vbu + (size_t)(32) * vrow + 0) + voff2) : "memory");
    asm volatile("global_load_ushort %0, %1, off" : "+v"(vn0_9) : "v"((const unsigned char*)(vbu + (size_t)(33) * vrow + 0) + voff2) : "memory");
    asm volatile("global_load_ushort %0, %1, off" : "+v"(vn0_10) : "v"((const unsigned char*)(vbu + (size_t)(34) * vrow + 0) + voff2) : "memory");
    asm volatile("global_load_ushort %0, %1, off" : "+v"(vn0_11) : "v"((const unsigned char*)(vbu + (size_t)(35) * vrow + 0) + voff2) : "memory");
    asm volatile("global_load_ushort %0, %1, off" : "+v"(vn0_12) : "v"((const unsigned char*)(vbu + (size_t)(48) * vrow + 0) + voff2) : "memory");
    asm volatile("global_load_ushort %0, %1, off" : "+v"(vn0_13) : "v"((const unsigned char*)(vbu + (size_t)(49) * vrow + 0) + voff2) : "memory");
    asm volatile("global_load_ushort %0, %1, off" : "+v"(vn0_14) : "v"((const unsigned char*)(vbu + (size_t)(50) * vrow + 0) + voff2) : "memory");
    asm volatile("global_load_ushort %0, %1, off" : "+v"(vn0_15) : "v"((const unsigned char*)(vbu + (size_t)(51) * vrow + 0) + voff2) : "memory");
    asm volatile("global_load_ushort %0, %1, off" : "+v"(vn1_0) : "v"((const unsigned char*)(vbu + (size_t)(0) * vrow + 32) + voff2) : "memory");
    asm volatile("global_load_ushort %0, %1, off" : "+v"(vn1_1) : "v"((const unsigned char*)(vbu + (size_t)(1) * vrow + 32) + voff2) : "memory");
    asm volatile("global_load_ushort %0, %1, off" : "+v"(vn1_2) : "v"((const unsigned char*)(vbu + (size_t)(2) * vrow + 32) + voff2) : "memory");
    asm volatile("global_load_ushort %0, %1, off" : "+v"(vn1_3) : "v"((const unsigned char*)(vbu + (size_t)(3) * vrow + 32) + voff2) : "memory");
    asm volatile("global_load_ushort %0, %1, off" : "+v"(vn1_4) : "v"((const unsigned char*)(vbu + (size_t)(16) * vrow + 32) + voff2) : "memory");
    asm volatile("global_load_ushort %0, %1, off" : "+v"(vn1_5) : "v"((const unsigned char*)(vbu + (size_t)(17) * vrow + 32) + voff2) : "memory");
    asm volatile("global_load_ushort %0, %1, off" : "+v"(vn1_6) : "v"((const unsigned char*)(vbu + (size_t)(18) * vrow + 32) + voff2) : "memory");
    asm volatile("global_load_ushort %0, %1, off" : "+v"(vn1_7) : "v"((const unsigned char*)(vbu + (size_t)(19) * vrow + 32) + voff2) : "memory");
    asm volatile("global_load_ushort %0, %1, off" : "+v"(vn1_8) : "v"((const unsigned char*)(vbu + (size_t)(32) * vrow + 32) + voff2) : "memory");
    asm volatile("global_load_ushort %0, %1, off" : "+v"(vn1_9) : "v"((const unsigned char*)(vbu + (size_t)(33) * vrow + 32) + voff2) : "memory");
    asm volatile("global_load_ushort %0, %1, off" : "+v"(vn1_10) : "v"((const unsigned char*)(vbu + (size_t)(34) * vrow + 32) + voff2) : "memory");
    asm volatile("global_load_ushort %0, %1, off" : "+v"(vn1_11) : "v"((const unsigned char*)(vbu + (size_t)(35) * vrow + 32) + voff2) : "memory");
    asm volatile("global_load_ushort %0, %1, off" : "+v"(vn1_12) : "v"((const unsigned char*)(vbu + (size_t)(48) * vrow + 32) + voff2) : "memory");
    asm volatile("global_load_ushort %0, %1, off" : "+v"(vn1_13) : "v"((const unsigned char*)(vbu + (size_t)(49) * vrow + 32) + voff2) : "memory");
    asm volatile("global_load_ushort %0, %1, off" : "+v"(vn1_14) : "v"((const unsigned char*)(vbu + (size_t)(50) * vrow + 32) + voff2) : "memory");
    asm volatile("global_load_ushort %0, %1, off" : "+v"(vn1_15) : "v"((const unsigned char*)(vbu + (size_t)(51) * vrow + 32) + voff2) : "memory");
    asm volatile("global_load_dwordx4 %0, %1, off" : "+v"(r0) : "v"((const unsigned char*)(sp0 + ((size_t)(n + 0) * 40 + 24) * 1024) + voff) : "memory");
    asm volatile("global_load_dwordx4 %0, %1, off" : "+v"(r1) : "v"((const unsigned char*)(sp0 + ((size_t)(n + 0) * 40 + 25) * 1024) + voff) : "memory");
    asm volatile("global_load_dwordx4 %0, %1, off" : "+v"(r2) : "v"((const unsigned char*)(sp0 + ((size_t)(n + 0) * 40 + 26) * 1024) + voff) : "memory");
    asm volatile("global_load_dwordx4 %0, %1, off" : "+v"(r3) : "v"((const unsigned char*)(sp0 + ((size_t)(n + 0) * 40 + 27) * 1024) + voff) : "memory");
    asm volatile("global_load_dwordx4 %0, %1, off" : "+v"(r4) : "v"((const unsigned char*)(sp0 + ((size_t)(n + 0) * 40 + 28) * 1024) + voff) : "memory");
    asm volatile("global_load_dwordx4 %0, %1, off" : "+v"(r5) : "v"((const unsigned char*)(sp0 + ((size_t)(n + 0) * 40 + 29) * 1024) + voff) : "memory");
    asm volatile("global_load_dwordx4 %0, %1, off" : "+v"(r6) : "v"((const unsigned char*)(sp0 + ((size_t)(n + 0) * 40 + 30) * 1024) + voff) : "memory");
    asm volatile("global_load_dwordx4 %0, %1, off" : "+v"(r7) : "v"((const unsigned char*)(sp0 + ((size_t)(n + 0) * 40 + 31) * 1024) + voff) : "memory");
    asm volatile("global_load_dwordx4 %0, %1, off" : "+v"(r8) : "v"((const unsigned char*)(sp0 + ((size_t)(n + 0) * 40 + 32) * 1024) + voff) : "memory");
    asm volatile("global_load_dwordx4 %0, %1, off" : "+v"(r9) : "v"((const unsigned char*)(sp0 + ((size_t)(n + 0) * 40 + 33) * 1024) + voff) : "memory");
    asm volatile("global_load_dwordx4 %0, %1, off" : "+v"(r10) : "v"((const unsigned char*)(sp0 + ((size_t)(n + 0) * 40 + 34) * 1024) + voff) : "memory");
    asm volatile("global_load_dwordx4 %0, %1, off" : "+v"(r11) : "v"((const unsigned char*)(sp0 + ((size_t)(n + 0) * 40 + 35) * 1024) + voff) : "memory");
    asm volatile("global_load_dwordx4 %0, %1, off" : "+v"(r12) : "v"((const unsigned char*)(sp0 + ((size_t)(n + 0) * 40 + 36) * 1024) + voff) : "memory");
    asm volatile("global_load_dwordx4 %0, %1, off" : "+v"(r13) : "v"((const unsigned char*)(sp0 + ((size_t)(n + 0) * 40 + 37) * 1024) + voff) : "memory");
    asm volatile("global_load_dwordx4 %0, %1, off" : "+v"(r14) : "v"((const unsigned char*)(sp0 + ((size_t)(n + 0) * 40 + 38) * 1024) + voff) : "memory");
    asm volatile("global_load_dwordx4 %0, %1, off" : "+v"(r15) : "v"((const unsigned char*)(sp0 + ((size_t)(n + 0) * 40 + 39) * 1024) + voff) : "memory");
    }
#pragma unroll 1
    for (int n = 0; n < NCH; ++n) {
        const int nn = n + 1 < NCH ? n + 1 : n;
        f32x4 a0_0, a0_1, a0_2, a0_3;
        f32x4 a1_0, a1_1, a1_2, a1_3;
        asm volatile("s_waitcnt vmcnt(16)" : "+v"(vn0_0), "+v"(vn0_1), "+v"(vn0_2), "+v"(vn0_3), "+v"(vn0_4), "+v"(vn0_5), "+v"(vn0_6), "+v"(vn0_7), "+v"(vn0_8), "+v"(vn0_9), "+v"(vn0_10), "+v"(vn0_11), "+v"(vn0_12), "+v"(vn0_13), "+v"(vn0_14), "+v"(vn0_15));
        asm volatile("s_waitcnt vmcnt(16)" : "+v"(vn1_0), "+v"(vn1_1), "+v"(vn1_2), "+v"(vn1_3), "+v"(vn1_4), "+v"(vn1_5), "+v"(vn1_6), "+v"(vn1_7), "+v"(vn1_8), "+v"(vn1_9), "+v"(vn1_10), "+v"(vn1_11), "+v"(vn1_12), "+v"(vn1_13), "+v"(vn1_14), "+v"(vn1_15));
        a0_0 = (f32x4){__builtin_bit_cast(float, vn0_0 << 16), __builtin_bit_cast(float, vn0_1 << 16), __builtin_bit_cast(float, vn0_2 << 16), __builtin_bit_cast(float, vn0_3 << 16)};
        a0_1 = (f32x4){__builtin_bit_cast(float, vn0_4 << 16), __builtin_bit_cast(float, vn0_5 << 16), __builtin_bit_cast(float, vn0_6 << 16), __builtin_bit_cast(float, vn0_7 << 16)};
        a0_2 = (f32x4){__builtin_bit_cast(float, vn0_8 << 16), __builtin_bit_cast(float, vn0_9 << 16), __builtin_bit_cast(float, vn0_10 << 16), __builtin_bit_cast(float, vn0_11 << 16)};
        a0_3 = (f32x4){__builtin_bit_cast(float, vn0_12 << 16), __builtin_bit_cast(float, vn0_13 << 16), __builtin_bit_cast(float, vn0_14 << 16), __builtin_bit_cast(float, vn0_15 << 16)};
        a1_0 = (f32x4){__builtin_bit_cast(float, vn1_0 << 16), __builtin_bit_cast(float, vn1_1 << 16), __builtin_bit_cast(float, vn1_2 << 16), __builtin_bit_cast(float, vn1_3 << 16)};
        a1_1 = (f32x4){__builtin_bit_cast(float, vn1_4 << 16), __builtin_bit_cast(float, vn1_5 << 16), __builtin_bit_cast(float, vn1_6 << 16), __builtin_bit_cast(float, vn1_7 << 16)};
        a1_2 = (f32x4){__builtin_bit_cast(float, vn1_8 << 16), __builtin_bit_cast(float, vn1_9 << 16), __builtin_bit_cast(float, vn1_10 << 16), __builtin_bit_cast(float, vn1_11 << 16)};
        a1_3 = (f32x4){__builtin_bit_cast(float, vn1_12 << 16), __builtin_bit_cast(float, vn1_13 << 16), __builtin_bit_cast(float, vn1_14 << 16), __builtin_bit_cast(float, vn1_15 << 16)};
        const float dec = decr;
        { const unsigned char* vbn = vbu + (size_t)nn * 64 * vrow;
          asm volatile("global_load_ushort %0, %1, off" : "+v"(vn0_0) : "v"((const unsigned char*)(vbn + (size_t)(0) * vrow + 0) + voff2) : "memory");
          asm volatile("global_load_ushort %0, %1, off" : "+v"(vn0_1) : "v"((const unsigned char*)(vbn + (size_t)(1) * vrow + 0) + voff2) : "memory");
          asm volatile("global_load_ushort %0, %1, off" : "+v"(vn0_2) : "v"((const unsigned char*)(vbn + (size_t)(2) * vrow + 0) + voff2) : "memory");
          asm volatile("global_load_ushort %0, %1, off" : "+v"(vn0_3) : "v"((const unsigned char*)(vbn + (size_t)(3) * vrow + 0) + voff2) : "memory");
          asm volatile("global_load_ushort %0, %1, off" : "+v"(vn0_4) : "v"((const unsigned char*)(vbn + (size_t)(16) * vrow + 0) + voff2) : "memory");
          asm volatile("global_load_ushort %0, %1, off" : "+v"(vn0_5) : "v"((const unsigned char*)(vbn + (size_t)(17) * vrow + 0) + voff2) : "memory");
          asm volatile("global_load_ushort %0, %1, off" : "+v"(vn0_6) : "v"((const unsigned char*)(vbn + (size_t)(18) * vrow + 0) + voff2) : "memory");
          asm volatile("global_load_ushort %0, %1, off" : "+v"(vn0_7) : "v"((const unsigned char*)(vbn + (size_t)(19) * vrow + 0) + voff2) : "memory");
          asm volatile("global_load_ushort %0, %1, off" : "+v"(vn0_8) : "v"((const unsigned char*)(vbn + (size_t)(32) * vrow + 0) + voff2) : "memory");
          asm volatile("global_load_ushort %0, %1, off" : "+v"(vn0_9) : "v"((const unsigned char*)(vbn + (size_t)(33) * vrow + 0) + voff2) : "memory");
          asm volatile("global_load_ushort %0, %1, off" : "+v"(vn0_10) : "v"((const unsigned char*)(vbn + (size_t)(34) * vrow + 0) + voff2) : "memory");
          asm volatile("global_load_ushort %0, %1, off" : "+v"(vn0_11) : "v"((const unsigned char*)(vbn + (size_t)(35) * vrow + 0) + voff2) : "memory");
          asm volatile("global_load_ushort %0, %1, off" : "+v"(vn0_12) : "v"((const unsigned char*)(vbn + (size_t)(48) * vrow + 0) + voff2) : "memory");
          asm volatile("global_load_ushort %0, %1, off" : "+v"(vn0_13) : "v"((const unsigned char*)(vbn + (size_t)(49) * vrow + 0) + voff2) : "memory");
          asm volatile("global_load_ushort %0, %1, off" : "+v"(vn0_14) : "v"((const unsigned char*)(vbn + (size_t)(50) * vrow + 0) + voff2) : "memory");
          asm volatile("global_load_ushort %0, %1, off" : "+v"(vn0_15) : "v"((const unsigned char*)(vbn + (size_t)(51) * vrow + 0) + voff2) : "memory");
          asm volatile("global_load_ushort %0, %1, off" : "+v"(vn1_0) : "v"((const unsigned char*)(vbn + (size_t)(0) * vrow + 32) + voff2) : "memory");
          asm volatile("global_load_ushort %0, %1, off" : "+v"(vn1_1) : "v"((const unsigned char*)(vbn + (size_t)(1) * vrow + 32) + voff2) : "memory");
          asm volatile("global_load_ushort %0, %1, off" : "+v"(vn1_2) : "v"((const unsigned char*)(vbn + (size_t)(2) * vrow + 32) + voff2) : "memory");
          asm volatile("global_load_ushort %0, %1, off" : "+v"(vn1_3) : "v"((const unsigned char*)(vbn + (size_t)(3) * vrow + 32) + voff2) : "memory");
          asm volatile("global_load_ushort %0, %1, off" : "+v"(vn1_4) : "v"((const unsigned char*)(vbn + (size_t)(16) * vrow + 32) + voff2) : "memory");
          asm volatile("global_load_ushort %0, %1, off" : "+v"(vn1_5) : "v"((const unsigned char*)(vbn + (size_t)(17) * vrow + 32) + voff2) : "memory");
          asm volatile("global_load_ushort %0, %1, off" : "+v"(vn1_6) : "v"((const unsigned char*)(vbn + (size_t)(18) * vrow + 32) + voff2) : "memory");
          asm volatile("global_load_ushort %0, %1, off" : "+v"(vn1_7) : "v"((const unsigned char*)(vbn + (size_t)(19) * vrow + 32) + voff2) : "memory");
          asm volatile("global_load_ushort %0, %1, off" : "+v"(vn1_8) : "v"((const unsigned char*)(vbn + (size_t)(32) * vrow + 32) + voff2) : "memory");
          asm volatile("global_load_ushort %0, %1, off" : "+v"(vn1_9) : "v"((const unsigned char*)(vbn + (size_t)(33) * vrow + 32) + voff2) : "memory");
          asm volatile("global_load_ushort %0, %1, off" : "+v"(vn1_10) : "v"((const unsigned char*)(vbn + (size_t)(34) * vrow + 32) + voff2) : "memory");
          asm volatile("global_load_ushort %0, %1, off" : "+v"(vn1_11) : "v"((const unsigned char*)(vbn + (size_t)(35) * vrow + 32) + voff2) : "memory");
          asm volatile("global_load_ushort %0, %1, off" : "+v"(vn1_12) : "v"((const unsigned char*)(vbn + (size_t)(48) * vrow + 32) + voff2) : "memory");
          asm volatile("global_load_ushort %0, %1, off" : "+v"(vn1_13) : "v"((const unsigned char*)(vbn + (size_t)(49) * vrow + 32) + voff2) : "memory");
          asm volatile("global_load_ushort %0, %1, off" : "+v"(vn1_14) : "v"((const unsigned char*)(vbn + (size_t)(50) * vrow + 32) + voff2) : "memory");
          asm volatile("global_load_ushort %0, %1, off" : "+v"(vn1_15) : "v"((const unsigned char*)(vbn + (size_t)(51) * vrow + 32) + voff2) : "memory");
        }
        __builtin_amdgcn_sched_barrier(0);
        bf16x8 vp0_0, vp0_1;
        { u32x4 w; w.x = cvt_pk_bf16(a0_0[0], a0_0[1]); w.y = cvt_pk_bf16(a0_0[2], a0_0[3]); w.z = cvt_pk_bf16(a0_1[0], a0_1[1]); w.w = cvt_pk_bf16(a0_1[2], a0_1[3]); vp0_0 = __builtin_bit_cast(bf16x8, w); }
        { u32x4 w; w.x = cvt_pk_bf16(a0_2[0], a0_2[1]); w.y = cvt_pk_bf16(a0_2[2], a0_2[3]); w.z = cvt_pk_bf16(a0_3[0], a0_3[1]); w.w = cvt_pk_bf16(a0_3[2], a0_3[3]); vp0_1 = __builtin_bit_cast(bf16x8, w); }
        bf16x8 vp1_0, vp1_1;
        { u32x4 w; w.x = cvt_pk_bf16(a1_0[0], a1_0[1]); w.y = cvt_pk_bf16(a1_0[2], a1_0[3]); w.z = cvt_pk_bf16(a1_1[0], a1_1[1]); w.w = cvt_pk_bf16(a1_1[2], a1_1[3]); vp1_0 = __builtin_bit_cast(bf16x8, w); }
        { u32x4 w; w.x = cvt_pk_bf16(a1_2[0], a1_2[1]); w.y = cvt_pk_bf16(a1_2[2], a1_2[3]); w.z = cvt_pk_bf16(a1_3[0], a1_3[1]); w.w = cvt_pk_bf16(a1_3[2], a1_3[3]); vp1_1 = __builtin_bit_cast(bf16x8, w); }
        { unsigned sp_ = 0; while (*(volatile LAS unsigned*)(xl + XL_CNT + 64) + 2u <= (unsigned)n) { __builtin_amdgcn_s_sleep(1); if (++sp_ > (1u << 22)) break; } }
        { LAS bf16x8* sl_ = (LAS bf16x8*)(xl + (n & 1) * XL_SLOT) + lane; sl_[0] = Sp0_0; sl_[64] = Sp0_1; sl_[128] = Sp0_2; sl_[192] = Sp0_3; sl_[256] = vp0_0; sl_[320] = vp0_1; sl_[384] = Sp1_0; sl_[448] = Sp1_1; sl_[512] = Sp1_2; sl_[576] = Sp1_3; sl_[640] = vp1_0; sl_[704] = vp1_1; }
        asm volatile("s_waitcnt lgkmcnt(0)" ::: "memory");
        if (lane == 0) *(volatile LAS unsigned*)(xl + XL_CNT) = (unsigned)(n + 1);
        S0_0 = S0_0 * dec;
        S1_0 = S1_0 * dec;
        asm volatile("s_waitcnt vmcnt(47)" : "+v"(r0));
        S0_0 = mfma16(r0, vp0_0, S0_0);
        S1_0 = mfma16(r0, vp1_0, S1_0);
        asm volatile("global_load_dwordx4 %0, %1, off" : "+v"(r0) : "v"((const unsigned char*)(sp0 + ((size_t)(n + 1) * 40 + 24) * 1024) + voff) : "memory");
        __builtin_amdgcn_sched_barrier(0);
        asm volatile("s_waitcnt vmcnt(47)" : "+v"(r1));
        S0_0 = mfma16(r1, vp0_1, S0_0);
        S1_0 = mfma16(r1, vp1_1, S1_0);
        asm volatile("global_load_dwordx4 %0, %1, off" : "+v"(r1) : "v"((const unsigned char*)(sp0 + ((size_t)(n + 1) * 40 + 25) * 1024) + voff) : "memory");
        __builtin_amdgcn_sched_barrier(0);
        S0_1 = S0_1 * dec;
        S1_1 = S1_1 * dec;
        asm volatile("s_waitcnt vmcnt(47)" : "+v"(r2));
        S0_1 = mfma16(r2, vp0_0, S0_1);
        S1_1 = mfma16(r2, vp1_0, S1_1);
        asm volatile("global_load_dwordx4 %0, %1, off" : "+v"(r2) : "v"((const unsigned char*)(sp0 + ((size_t)(n + 1) * 40 + 26) * 1024) + voff) : "memory");
        __builtin_amdgcn_sched_barrier(0);
        asm volatile("s_waitcnt vmcnt(47)" : "+v"(r3));
        S0_1 = mfma16(r3, vp0_1, S0_1);
        S1_1 = mfma16(r3, vp1_1, S1_1);
        asm volatile("global_load_dwordx4 %0, %1, off" : "+v"(r3) : "v"((const unsigned char*)(sp0 + ((size_t)(n + 1) * 40 + 27) * 1024) + voff) : "memory");
        __builtin_amdgcn_sched_barrier(0);
        S0_2 = S0_2 * dec;
        S1_2 = S1_2 * dec;
        asm volatile("s_waitcnt vmcnt(47)" : "+v"(r4));
        S0_2 = mfma16(r4, vp0_0, S0_2);
        S1_2 = mfma16(r4, vp1_0, S1_2);
        asm volatile("global_load_dwordx4 %0, %1, off" : "+v"(r4) : "v"((const unsigned char*)(sp0 + ((size_t)(n + 1) * 40 + 28) * 1024) + voff) : "memory");
        __builtin_amdgcn_sched_barrier(0);
        asm volatile("s_waitcnt vmcnt(47)" : "+v"(r5));
        S0_2 = mfma16(r5, vp0_1, S0_2);
        S1_2 = mfma16(r5, vp1_1, S1_2);
        asm volatile("global_load_dwordx4 %0, %1, off" : "+v"(r5) : "v"((const unsigned char*)(sp0 + ((size_t)(n + 1) * 40 + 29) * 1024) + voff) : "memory");
        __builtin_amdgcn_sched_barrier(0);
        S0_3 = S0_3 * dec;
        S1_3 = S1_3 * dec;
        asm volatile("s_waitcnt vmcnt(47)" : "+v"(r6));
        S0_3 = mfma16(r6, vp0_0, S0_3);
        S1_3 = mfma16(r6, vp1_0, S1_3);
        asm volatile("global_load_dwordx4 %0, %1, off" : "+v"(r6) : "v"((const unsigned char*)(sp0 + ((size_t)(n + 1) * 40 + 30) * 1024) + voff) : "memory");
        __builtin_amdgcn_sched_barrier(0);
        asm volatile("s_waitcnt vmcnt(47)" : "+v"(r7));
        S0_3 = mfma16(r7, vp0_1, S0_3);
        S1_3 = mfma16(r7, vp1_1, S1_3);
        asm volatile("global_load_dwordx4 %0, %1, off" : "+v"(r7) : "v"((const unsigned char*)(sp0 + ((size_t)(n + 1) * 40 + 31) * 1024) + voff) : "memory");
        __builtin_amdgcn_sched_barrier(0);
        S0_4 = S0_4 * dec;
        S1_4 = S1_4 * dec;
        asm volatile("s_waitcnt vmcnt(47)" : "+v"(r8));
        S0_4 = mfma16(r8, vp0_0, S0_4);
        S1_4 = mfma16(r8, vp1_0, S1_4);
        asm volatile("global_load_dwordx4 %0, %1, off" : "+v"(r8) : "v"((const unsigned char*)(sp0 + ((size_t)(n + 1) * 40 + 32) * 1024) + voff) : "memory");
        __builtin_amdgcn_sched_barrier(0);
        asm volatile("s_waitcnt vmcnt(47)" : "+v"(r9));
        S0_4 = mfma16(r9, vp0_1, S0_4);
        S1_4 = mfma16(r9, vp1_1, S1_4);
        asm volatile("global_load_dwordx4 %0, %1, off" : "+v"(r9) : "v"((const unsigned char*)(sp0 + ((size_t)(n + 1) * 40 + 33) * 1024) + voff) : "memory");
        __builtin_amdgcn_sched_barrier(0);
        S0_5 = S0_5 * dec;
        S1_5 = S1_5 * dec;
        asm volatile("s_waitcnt vmcnt(47)" : "+v"(r10));
        S0_5 = mfma16(r10, vp0_0, S0_5);
        S1_5 = mfma16(r10, vp1_0, S1_5);
        asm volatile("global_load_dwordx4 %0, %1, off" : "+v"(r10) : "v"((const unsigned char*)(sp0 + ((size_t)(n + 1) * 40 + 34) * 1024) + voff) : "memory");
        __builtin_amdgcn_sched_barrier(0);
        asm volatile("s_waitcnt vmcnt(47)" : "+v"(r11));
        S0_5 = mfma16(r11, vp0_1, S0_5);
        S1_5 = mfma16(r11, vp1_1, S1_5);
        asm volatile("global_load_dwordx4 %0, %1, off" : "+v"(r11) : "v"((const unsigned char*)(sp0 + ((size_t)(n + 1) * 40 + 35) * 1024) + voff) : "memory");
        __builtin_amdgcn_sched_barrier(0);
        S0_6 = S0_6 * dec;
        S1_6 = S1_6 * dec;
        asm volatile("s_waitcnt vmcnt(47)" : "+v"(r12));
        S0_6 = mfma16(r12, vp0_0, S0_6);
        S1_6 = mfma16(r12, vp1_0, S1_6);
        asm volatile("global_load_dwordx4 %0, %1, off" : "+v"(r12) : "v"((const unsigned char*)(sp0 + ((size_t)(n + 1) * 40 + 36) * 1024) + voff) : "memory");
        __builtin_amdgcn_sched_barrier(0);
        asm volatile("s_waitcnt vmcnt(47)" : "+v"(r13));
        S0_6 = mfma16(r13, vp0_1, S0_6);
        S1_6 = mfma16(r13, vp1_1, S1_6);
        asm volatile("global_load_dwordx4 %0, %1, off" : "+v"(r13) : "v"((const unsigned char*)(sp0 + ((size_t)(n + 1) * 40 + 37) * 1024) + voff) : "memory");
        __builtin_amdgcn_sched_barrier(0);
        S0_7 = S0_7 * dec;
        S1_7 = S1_7 * dec;
        asm volatile("s_waitcnt vmcnt(47)" : "+v"(r14));
        S0_7 = mfma16(r14, vp0_0, S0_7);
        S1_7 = mfma16(r14, vp1_0, S1_7);
        asm volatile("global_load_dwordx4 %0, %1, off" : "+v"(r14) : "v"((const unsigned char*)(sp0 + ((size_t)(n + 1) * 40 + 38) * 1024) + voff) : "memory");
        __builtin_amdgcn_sched_barrier(0);
        asm volatile("s_waitcnt vmcnt(47)" : "+v"(r15));
        S0_7 = mfma16(r15, vp0_1, S0_7);
        S1_7 = mfma16(r15, vp1_1, S1_7);
        asm volatile("global_load_dwordx4 %0, %1, off" : "+v"(r15) : "v"((const unsigned char*)(sp0 + ((size_t)(n + 1) * 40 + 39) * 1024) + voff) : "memory");
        __builtin_amdgcn_sched_barrier(0);
        { u32x4 w; w.x = cvt_pk_bf16(S0_0[0], S0_0[1]); w.y = cvt_pk_bf16(S0_0[2], S0_0[3]); w.z = cvt_pk_bf16(S0_1[0], S0_1[1]); w.w = cvt_pk_bf16(S0_1[2], S0_1[3]); Sp0_0 = __builtin_bit_cast(bf16x8, w); }
        { u32x4 w; w.x = cvt_pk_bf16(S0_2[0], S0_2[1]); w.y = cvt_pk_bf16(S0_2[2], S0_2[3]); w.z = cvt_pk_bf16(S0_3[0], S0_3[1]); w.w = cvt_pk_bf16(S0_3[2], S0_3[3]); Sp0_1 = __builtin_bit_cast(bf16x8, w); }
        { u32x4 w; w.x = cvt_pk_bf16(S0_4[0], S0_4[1]); w.y = cvt_pk_bf16(S0_4[2], S0_4[3]); w.z = cvt_pk_bf16(S0_5[0], S0_5[1]); w.w = cvt_pk_bf16(S0_5[2], S0_5[3]); Sp0_2 = __builtin_bit_cast(bf16x8, w); }
        { u32x4 w; w.x = cvt_pk_bf16(S0_6[0], S0_6[1]); w.y = cvt_pk_bf16(S0_6[2], S0_6[3]); w.z = cvt_pk_bf16(S0_7[0], S0_7[1]); w.w = cvt_pk_bf16(S0_7[2], S0_7[3]); Sp0_3 = __builtin_bit_cast(bf16x8, w); }
        { u32x4 w; w.x = cvt_pk_bf16(S1_0[0], S1_0[1]); w.y = cvt_pk_bf16(S1_0[2], S1_0[3]); w.z = cvt_pk_bf16(S1_1[0], S1_1[1]); w.w = cvt_pk_bf16(S1_1[2], S1_1[3]); Sp1_0 = __builtin_bit_cast(bf16x8, w); }
        { u32x4 w; w.x = cvt_pk_bf16(S1_2[0], S1_2[1]); w.y = cvt_pk_bf16(S1_2[2], S1_2[3]); w.z = cvt_pk_bf16(S1_3[0], S1_3[1]); w.w = cvt_pk_bf16(S1_3[2], S1_3[3]); Sp1_1 = __builtin_bit_cast(bf16x8, w); }
        { u32x4 w; w.x = cvt_pk_bf16(S1_4[0], S1_4[1]); w.y = cvt_pk_bf16(S1_4[2], S1_4[3]); w.z = cvt_pk_bf16(S1_5[0], S1_5[1]); w.w = cvt_pk_bf16(S1_5[2], S1_5[3]); Sp1_2 = __builtin_bit_cast(bf16x8, w); }
        { u32x4 w; w.x = cvt_pk_bf16(S1_6[0], S1_6[1]); w.y = cvt_pk_bf16(S1_6[2], S1_6[3]); w.z = cvt_pk_bf16(S1_7[0], S1_7[1]); w.w = cvt_pk_bf16(S1_7[2], S1_7[3]); Sp1_3 = __builtin_bit_cast(bf16x8, w); }
    }
    asm volatile("s_waitcnt vmcnt(0)" ::: "memory");
    } else {
    bf16x8 r0 = (bf16x8){0, 0, 0, 0, 0, 0, 0, 0};
    bf16x8 r1 = (bf16x8){0, 0, 0, 0, 0, 0, 0, 0};
    bf16x8 r2 = (bf16x8){0, 0, 0, 0, 0, 0, 0, 0};
    bf16x8 r3 = (bf16x8){0, 0, 0, 0, 0, 0, 0, 0};
    bf16x8 r4 = (bf16x8){0, 0, 0, 0, 0, 0, 0, 0};
    bf16x8 r5 = (bf16x8){0, 0, 0, 0, 0, 0, 0, 0};
    bf16x8 r6 = (bf16x8){0, 0, 0, 0, 0, 0, 0, 0};
    bf16x8 r7 = (bf16x8){0, 0, 0, 0, 0, 0, 0, 0};
    bf16x8 r8 = (bf16x8){0, 0, 0, 0, 0, 0, 0, 0};
    bf16x8 r9 = (bf16x8){0, 0, 0, 0, 0, 0, 0, 0};
    bf16x8 r10 = (bf16x8){0, 0, 0, 0, 0, 0, 0, 0};
    bf16x8 r11 = (bf16x8){0, 0, 0, 0, 0, 0, 0, 0};
    bf16x8 r12 = (bf16x8){0, 0, 0, 0, 0, 0, 0, 0};
    bf16x8 r13 = (bf16x8){0, 0, 0, 0, 0, 0, 0, 0};
    bf16x8 r14 = (bf16x8){0, 0, 0, 0, 0, 0, 0, 0};
    bf16x8 r15 = (bf16x8){0, 0, 0, 0, 0, 0, 0, 0};
    bf16x8 r16 = (bf16x8){0, 0, 0, 0, 0, 0, 0, 0};
    bf16x8 r17 = (bf16x8){0, 0, 0, 0, 0, 0, 0, 0};
    bf16x8 r18 = (bf16x8){0, 0, 0, 0, 0, 0, 0, 0};
    bf16x8 r19 = (bf16x8){0, 0, 0, 0, 0, 0, 0, 0};
    bf16x8 r20 = (bf16x8){0, 0, 0, 0, 0, 0, 0, 0};
    bf16x8 r21 = (bf16x8){0, 0, 0, 0, 0, 0, 0, 0};
    bf16x8 r22 = (bf16x8){0, 0, 0, 0, 0, 0, 0, 0};
    bf16x8 r23 = (bf16x8){0, 0, 0, 0, 0, 0, 0, 0};
    asm volatile("global_load_dwordx4 %0, %1, off" : "+v"(r0) : "v"((const unsigned char*)(sp0 + ((size_t)(0 + 0) * 40 + 0) * 1024) + voff) : "memory");
    asm volatile("global_load_dwordx4 %0, %1, off" : "+v"(r1) : "v"((const unsigned char*)(sp0 + ((size_t)(0 + 0) * 40 + 1) * 1024) + voff) : "memory");
    asm volatile("global_load_dwordx4 %0, %1, off" : "+v"(r2) : "v"((const unsigned char*)(sp0 + ((size_t)(0 + 0) * 40 + 2) * 1024) + voff) : "memory");
    asm volatile("global_load_dwordx4 %0, %1, off" : "+v"(r3) : "v"((const unsigned char*)(sp0 + ((size_t)(0 + 0) * 40 + 3) * 1024) + voff) : "memory");
    asm volatile("global_load_dwordx4 %0, %1, off" : "+v"(r4) : "v"((const unsigned char*)(sp0 + ((size_t)(0 + 0) * 40 + 4) * 1024) + voff) : "memory");
    asm volatile("global_load_dwordx4 %0, %1, off" : "+v"(r5) : "v"((const unsigned char*)(sp0 + ((size_t)(0 + 0) * 40 + 5) * 1024) + voff) : "memory");
    asm volatile("global_load_dwordx4 %0, %1, off" : "+v"(r6) : "v"((const unsigned char*)(sp0 + ((size_t)(0 + 0) * 40 + 6) * 1024) + voff) : "memory");
    asm volatile("global_load_dwordx4 %0, %1, off" : "+v"(r7) : "v"((const unsigned char*)(sp0 + ((size_t)(0 + 0) * 40 + 7) * 1024) + voff) : "memory");
    asm volatile("global_load_dwordx4 %0, %1, off" : "+v"(r8) : "v"((const unsigned char*)(sp0 + ((size_t)(0 + 0) * 40 + 8) * 1024) + voff) : "memory");
    asm volatile("global_load_dwordx4 %0, %1, off" : "+v"(r9) : "v"((const unsigned char*)(sp0 + ((size_t)(0 + 0) * 40 + 9) * 1024) + voff) : "memory");
    asm volatile("global_load_dwordx4 %0, %1, off" : "+v"(r10) : "v"((const unsigned char*)(sp0 + ((size_t)(0 + 0) * 40 + 10) * 1024) + voff) : "memory");
    asm volatile("global_load_dwordx4 %0, %1, off" : "+v"(r11) : "v"((const unsigned char*)(sp0 + ((size_t)(0 + 0) * 40 + 11) * 1024) + voff) : "memory");
    asm volatile("global_load_dwordx4 %0, %1, off" : "+v"(r12) : "v"((const unsigned char*)(sp0 + ((size_t)(0 + 0) * 40 + 12) * 1024) + voff) : "memory");
    asm volatile("global_load_dwordx4 %0, %1, off" : "+v"(r13) : "v"((const unsigned char*)(sp0 + ((size_t)(0 + 0) * 40 + 13) * 1024) + voff) : "memory");
    asm volatile("global_load_dwordx4 %0, %1, off" : "+v"(r14) : "v"((const unsigned char*)(sp0 + ((size_t)(0 + 0) * 40 + 14) * 1024) + voff) : "memory");
    asm volatile("global_load_dwordx4 %0, %1, off" : "+v"(r15) : "v"((const unsigned char*)(sp0 + ((size_t)(0 + 0) * 40 + 15) * 1024) + voff) : "memory");
    asm volatile("global_load_dwordx4 %0, %1, off" : "+v"(r16) : "v"((const unsigned char*)(sp0 + ((size_t)(0 + 0) * 40 + 16) * 1024) + voff) : "memory");
    asm volatile("global_load_dwordx4 %0, %1, off" : "+v"(r17) : "v"((const unsigned char*)(sp0 + ((size_t)(0 + 0) * 40 + 17) * 1024) + voff) : "memory");
    asm volatile("global_load_dwordx4 %0, %1, off" : "+v"(r18) : "v"((const unsigned char*)(sp0 + ((size_t)(0 + 0) * 40 + 18) * 1024) + voff) : "memory");
    asm volatile("global_load_dwordx4 %0, %1, off" : "+v"(r19) : "v"((const unsigned char*)(sp0 + ((size_t)(0 + 0) * 40 + 19) * 1024) + voff) : "memory");
    asm volatile("global_load_dwordx4 %0, %1, off" : "+v"(r20) : "v"((const unsigned char*)(sp0 + ((size_t)(0 + 0) * 40 + 20) * 1024) + voff) : "memory");
    asm volatile("global_load_dwordx4 %0, %1, off" : "+v"(r21) : "v"((const unsigned char*)(sp0 + ((size_t)(0 + 0) * 40 + 21) * 1024) + voff) : "memory");
    asm volatile("global_load_dwordx4 %0, %1, off" : "+v"(r22) : "v"((const unsigned char*)(sp0 + ((size_t)(0 + 0) * 40 + 22) * 1024) + voff) : "memory");
    asm volatile("global_load_dwordx4 %0, %1, off" : "+v"(r23) : "v"((const unsigned char*)(sp0 + ((size_t)(0 + 0) * 40 + 23) * 1024) + voff) : "memory");
    { unsigned z = 0u;
      asm volatile("global_store_short %0, %1, off" :: "v"((const unsigned char*)(obu + (size_t)(0) * orow + 0) + ooff), "v"(z) : "memory");
      asm volatile("global_store_short %0, %1, off" :: "v"((const unsigned char*)(obu + (size_t)(1) * orow + 0) + ooff), "v"(z) : "memory");
      asm volatile("global_store_short %0, %1, off" :: "v"((const unsigned char*)(obu + (size_t)(2) * orow + 0) + ooff), "v"(z) : "memory");
      asm volatile("global_store_short %0, %1, off" :: "v"((const unsigned char*)(obu + (size_t)(3) * orow + 0) + ooff), "v"(z) : "memory");
      asm volatile("global_store_short %0, %1, off" :: "v"((const unsigned char*)(obu + (size_t)(16) * orow + 0) + ooff), "v"(z) : "memory");
      asm volatile("global_store_short %0, %1, off" :: "v"((const unsigned char*)(obu + (size_t)(17) * orow + 0) + ooff), "v"(z) : "memory");
      asm volatile("global_store_short %0, %1, off" :: "v"((const unsigned char*)(obu + (size_t)(18) * orow + 0) + ooff), "v"(z) : "memory");
      asm volatile("global_store_short %0, %1, off" :: "v"((const unsigned char*)(obu + (size_t)(19) * orow + 0) + ooff), "v"(z) : "memory");
      asm volatile("global_store_short %0, %1, off" :: "v"((const unsigned char*)(obu + (size_t)(32) * orow + 0) + ooff), "v"(z) : "memory");
      asm volatile("global_store_short %0, %1, off" :: "v"((const unsigned char*)(obu + (size_t)(33) * orow + 0) + ooff), "v"(z) : "memory");
      asm volatile("global_store_short %0, %1, off" :: "v"((const unsigned char*)(obu + (size_t)(34) * orow + 0) + ooff), "v"(z) : "memory");
      asm volatile("global_store_short %0, %1, off" :: "v"((const unsigned char*)(obu + (size_t)(35) * orow + 0) + ooff), "v"(z) : "memory");
      asm volatile("global_store_short %0, %1, off" :: "v"((const unsigned char*)(obu + (size_t)(48) * orow + 0) + ooff), "v"(z) : "memory");
      asm volatile("global_store_short %0, %1, off" :: "v"((const unsigned char*)(obu + (size_t)(49) * orow + 0) + ooff), "v"(z) : "memory");
      asm volatile("global_store_short %0, %1, off" :: "v"((const unsigned char*)(obu + (size_t)(50) * orow + 0) + ooff), "v"(z) : "memory");
      asm volatile("global_store_short %0, %1, off" :: "v"((const unsigned char*)(obu + (size_t)(51) * orow + 0) + ooff), "v"(z) : "memory");
      asm volatile("global_store_short %0, %1, off" :: "v"((const unsigned char*)(obu + (size_t)(0) * orow + 32) + ooff), "v"(z) : "memory");
      asm volatile("global_store_short %0, %1, off" :: "v"((const unsigned char*)(obu + (size_t)(1) * orow + 32) + ooff), "v"(z) : "memory");
      asm volatile("global_store_short %0, %1, off" :: "v"((const unsigned char*)(obu + (size_t)(2) * orow + 32) + ooff), "v"(z) : "memory");
      asm volatile("global_store_short %0, %1, off" :: "v"((const unsigned char*)(obu + (size_t)(3) * orow + 32) + ooff), "v"(z) : "memory");
      asm volatile("global_store_short %0, %1, off" :: "v"((const unsigned char*)(obu + (size_t)(16) * orow + 32) + ooff), "v"(z) : "memory");
      asm volatile("global_store_short %0, %1, off" :: "v"((const unsigned char*)(obu + (size_t)(17) * orow + 32) + ooff), "v"(z) : "memory");
      asm volatile("global_store_short %0, %1, off" :: "v"((const unsigned char*)(obu + (size_t)(18) * orow + 32) + ooff), "v"(z) : "memory");
      asm volatile("global_store_short %0, %1, off" :: "v"((const unsigned char*)(obu + (size_t)(19) * orow + 32) + ooff), "v"(z) : "memory");
      asm volatile("global_store_short %0, %1, off" :: "v"((const unsigned char*)(obu + (size_t)(32) * orow + 32) + ooff), "v"(z) : "memory");
      asm volatile("global_store_short %0, %1, off" :: "v"((const unsigned char*)(obu + (size_t)(33) * orow + 32) + ooff), "v"(z) : "memory");
      asm volatile("global_store_short %0, %1, off" :: "v"((const unsigned char*)(obu + (size_t)(34) * orow + 32) + ooff), "v"(z) : "memory");
      asm volatile("global_store_short %0, %1, off" :: "v"((const unsigned char*)(obu + (size_t)(35) * orow + 32) + ooff), "v"(z) : "memory");
      asm volatile("global_store_short %0, %1, off" :: "v"((const unsigned char*)(obu + (size_t)(48) * orow + 32) + ooff), "v"(z) : "memory");
      asm volatile("global_store_short %0, %1, off" :: "v"((const unsigned char*)(obu + (size_t)(49) * orow + 32) + ooff), "v"(z) : "memory");
      asm volatile("global_store_short %0, %1, off" :: "v"((const unsigned char*)(obu + (size_t)(50) * orow + 32) + ooff), "v"(z) : "memory");
      asm volatile("global_store_short %0, %1, off" :: "v"((const unsigned char*)(obu + (size_t)(51) * orow + 32) + ooff), "v"(z) : "memory");
    }
#pragma unroll 1
    for (int n = 0; n < NCH; ++n) {
        { unsigned sp_ = 0; while (*(volatile LAS unsigned*)(xl + XL_CNT) <= (unsigned)n) { __builtin_amdgcn_s_sleep(1); if (++sp_ > (1u << 22)) break; } }
        bf16x8 Sp0_0, Sp0_1, Sp0_2, Sp0_3, vp0_0, vp0_1;
        bf16x8 Sp1_0, Sp1_1, Sp1_2, Sp1_3, vp1_0, vp1_1;
        { const LAS bf16x8* sl_ = (const LAS bf16x8*)(xl + (n & 1) * XL_SLOT) + lane; Sp0_0 = sl_[0]; Sp0_1 = sl_[64]; Sp0_2 = sl_[128]; Sp0_3 = sl_[192]; vp0_0 = sl_[256]; vp0_1 = sl_[320]; Sp1_0 = sl_[384]; Sp1_1 = sl_[448]; Sp1_2 = sl_[512]; Sp1_3 = sl_[576]; vp1_0 = sl_[640]; vp1_1 = sl_[704]; }
        asm volatile("s_waitcnt lgkmcnt(0)" ::: "memory");
        if (lane == 0) *(volatile LAS unsigned*)(xl + XL_CNT + 64) = (unsigned)(n + 1);
        f32x4 o0_0 = {0.f, 0.f, 0.f, 0.f}, o0_1 = o0_0, o0_2 = o0_0, o0_3 = o0_0;
        f32x4 o1_0 = {0.f, 0.f, 0.f, 0.f}, o1_1 = o1_0, o1_2 = o1_0, o1_3 = o1_0;
        asm volatile("s_waitcnt vmcnt(55)" : "+v"(r0));
        o0_0 = mfma16(r0, Sp0_0, o0_0);
        o1_0 = mfma16(r0, Sp1_0, o1_0);
        asm volatile("global_load_dwordx4 %0, %1, off" : "+v"(r0) : "v"((const unsigned char*)(sp0 + ((size_t)(n + 1) * 40 + 0) * 1024) + voff) : "memory");
        __builtin_amdgcn_sched_barrier(0);
        asm volatile("s_waitcnt vmcnt(55)" : "+v"(r1));
        o0_0 = mfma16(r1, Sp0_1, o0_0);
        o1_0 = mfma16(r1, Sp1_1, o1_0);
        asm volatile("global_load_dwordx4 %0, %1, off" : "+v"(r1) : "v"((const unsigned char*)(sp0 + ((size_t)(n + 1) * 40 + 1) * 1024) + voff) : "memory");
        __builtin_amdgcn_sched_barrier(0);
        asm volatile("s_waitcnt vmcnt(55)" : "+v"(r2));
        o0_0 = mfma16(r2, Sp0_2, o0_0);
        o1_0 = mfma16(r2, Sp1_2, o1_0);
        asm volatile("global_load_dwordx4 %0, %1, off" : "+v"(r2) : "v"((const unsigned char*)(sp0 + ((size_t)(n + 1) * 40 + 2) * 1024) + voff) : "memory");
        __builtin_amdgcn_sched_barrier(0);
        asm volatile("s_waitcnt vmcnt(55)" : "+v"(r3));
        o0_0 = mfma16(r3, Sp0_3, o0_0);
        o1_0 = mfma16(r3, Sp1_3, o1_0);
        asm volatile("global_load_dwordx4 %0, %1, off" : "+v"(r3) : "v"((const unsigned char*)(sp0 + ((size_t)(n + 1) * 40 + 3) * 1024) + voff) : "memory");
        __builtin_amdgcn_sched_barrier(0);
        asm volatile("s_waitcnt vmcnt(55)" : "+v"(r4));
        o0_1 = mfma16(r4, Sp0_0, o0_1);
        o1_1 = mfma16(r4, Sp1_0, o1_1);
        asm volatile("global_load_dwordx4 %0, %1, off" : "+v"(r4) : "v"((const unsigned char*)(sp0 + ((size_t)(n + 1) * 40 + 4) * 1024) + voff) : "memory");
        __builtin_amdgcn_sched_barrier(0);
        asm volatile("s_waitcnt vmcnt(55)" : "+v"(r5));
        o0_1 = mfma16(r5, Sp0_1, o0_1);
        o1_1 = mfma16(r5, Sp1_1, o1_1);
        asm volatile("global_load_dwordx4 %0, %1, off" : "+v"(r5) : "v"((const unsigned char*)(sp0 + ((size_t)(n + 1) * 40 + 5) * 1024) + voff) : "memory");
        __builtin_amdgcn_sched_barrier(0);
        asm volatile("s_waitcnt vmcnt(55)" : "+v"(r6));
        o0_1 = mfma16(r6, Sp0_2, o0_1);
        o1_1 = mfma16(r6, Sp1_2, o1_1);
        asm volatile("global_load_dwordx4 %0, %1, off" : "+v"(r6) : "v"((const unsigned char*)(sp0 + ((size_t)(n + 1) * 40 + 6) * 1024) + voff) : "memory");
        __builtin_amdgcn_sched_barrier(0);
        asm volatile("s_waitcnt vmcnt(55)" : "+v"(r7));
        o0_1 = mfma16(r7, Sp0_3, o0_1);
        o1_1 = mfma16(r7, Sp1_3, o1_1);
        asm volatile("global_load_dwordx4 %0, %1, off" : "+v"(r7) : "v"((const unsigned char*)(sp0 + ((size_t)(n + 1) * 40 + 7) * 1024) + voff) : "memory");
        __builtin_amdgcn_sched_barrier(0);
        asm volatile("s_waitcnt vmcnt(55)" : "+v"(r8));
        o0_2 = mfma16(r8, Sp0_0, o0_2);
        o1_2 = mfma16(r8, Sp1_0, o1_2);
        asm volatile("global_load_dwordx4 %0, %1, off" : "+v"(r8) : "v"((const unsigned char*)(sp0 + ((size_t)(n + 1) * 40 + 8) * 1024) + voff) : "memory");
        __builtin_amdgcn_sched_barrier(0);
        asm volatile("s_waitcnt vmcnt(55)" : "+v"(r9));
        o0_2 = mfma16(r9, Sp0_1, o0_2);
        o1_2 = mfma16(r9, Sp1_1, o1_2);
        asm volatile("global_load_dwordx4 %0, %1, off" : "+v"(r9) : "v"((const unsigned char*)(sp0 + ((size_t)(n + 1) * 40 + 9) * 1024) + voff) : "memory");
        __builtin_amdgcn_sched_barrier(0);
        asm volatile("s_waitcnt vmcnt(55)" : "+v"(r10));
        o0_2 = mfma16(r10, Sp0_2, o0_2);
        o1_2 = mfma16(r10, Sp1_2, o1_2);
        asm volatile("global_load_dwordx4 %0, %1, off" : "+v"(r10) : "v"((const unsigned char*)(sp0 + ((size_t)(n + 1) * 40 + 10) * 1024) + voff) : "memory");
        __builtin_amdgcn_sched_barrier(0);
        asm volatile("s_waitcnt vmcnt(55)" : "+v"(r11));
        o0_2 = mfma16(r11, Sp0_3, o0_2);
        o1_2 = mfma16(r11, Sp1_3, o1_2);
        asm volatile("global_load_dwordx4 %0, %1, off" : "+v"(r11) : "v"((const unsigned char*)(sp0 + ((size_t)(n + 1) * 40 + 11) * 1024) + voff) : "memory");
        __builtin_amdgcn_sched_barrier(0);
        asm volatile("s_waitcnt vmcnt(55)" : "+v"(r12));
        o0_3 = mfma16(r12, Sp0_0, o0_3);
        o1_3 = mfma16(r12, Sp1_0, o1_3);
        asm volatile("global_load_dwordx4 %0, %1, off" : "+v"(r12) : "v"((const unsigned char*)(sp0 + ((size_t)(n + 1) * 40 + 12) * 1024) + voff) : "memory");
        __builtin_amdgcn_sched_barrier(0);
        asm volatile("s_waitcnt vmcnt(55)" : "+v"(r13));
        o0_3 = mfma16(r13, Sp0_1, o0_3);
        o1_3 = mfma16(r13, Sp1_1, o1_3);
        asm volatile("global_load_dwordx4 %0, %1, off" : "+v"(r13) : "v"((const unsigned char*)(sp0 + ((size_t)(n + 1) * 40 + 13) * 1024) + voff) : "memory");
        __builtin_amdgcn_sched_barrier(0);
        asm volatile("s_waitcnt vmcnt(55)" : "+v"(r14));
        o0_3 = mfma16(r14, Sp0_2, o0_3);
        o1_3 = mfma16(r14, Sp1_2, o1_3);
        asm volatile("global_load_dwordx4 %0, %1, off" : "+v"(r14) : "v"((const unsigned char*)(sp0 + ((size_t)(n + 1) * 40 + 14) * 1024) + voff) : "memory");
        __builtin_amdgcn_sched_barrier(0);
        asm volatile("s_waitcnt vmcnt(55)" : "+v"(r15));
        o0_3 = mfma16(r15, Sp0_3, o0_3);
        o1_3 = mfma16(r15, Sp1_3, o1_3);
        asm volatile("global_load_dwordx4 %0, %1, off" : "+v"(r15) : "v"((const unsigned char*)(sp0 + ((size_t)(n + 1) * 40 + 15) * 1024) + voff) : "memory");
        __builtin_amdgcn_sched_barrier(0);
        asm volatile("s_waitcnt vmcnt(55)" : "+v"(r16));
        o0_0 = mfma16(r16, vp0_0, o0_0);
        o1_0 = mfma16(r16, vp1_0, o1_0);
        asm volatile("global_load_dwordx4 %0, %1, off" : "+v"(r16) : "v"((const unsigned char*)(sp0 + ((size_t)(n + 1) * 40 + 16) * 1024) + voff) : "memory");
        __builtin_amdgcn_sched_barrier(0);
        asm volatile("s_waitcnt vmcnt(55)" : "+v"(r17));
        o0_0 = mfma16(r17, vp0_1, o0_0);
        o1_0 = mfma16(r17, vp1_1, o1_0);
        asm volatile("global_load_dwordx4 %0, %1, off" : "+v"(r17) : "v"((const unsigned char*)(sp0 + ((size_t)(n + 1) * 40 + 17) * 1024) + voff) : "memory");
        __builtin_amdgcn_sched_barrier(0);
        asm volatile("s_waitcnt vmcnt(55)" : "+v"(r18));
        o0_1 = mfma16(r18, vp0_0, o0_1);
        o1_1 = mfma16(r18, vp1_0, o1_1);
        asm volatile("global_load_dwordx4 %0, %1, off" : "+v"(r18) : "v"((const unsigned char*)(sp0 + ((size_t)(n + 1) * 40 + 18) * 1024) + voff) : "memory");
        __builtin_amdgcn_sched_barrier(0);
        asm volatile("s_waitcnt vmcnt(55)" : "+v"(r19));
        o0_1 = mfma16(r19, vp0_1, o0_1);
        o1_1 = mfma16(r19, vp1_1, o1_1);
        asm volatile("global_load_dwordx4 %0, %1, off" : "+v"(r19) : "v"((const unsigned char*)(sp0 + ((size_t)(n + 1) * 40 + 19) * 1024) + voff) : "memory");
        __builtin_amdgcn_sched_barrier(0);
        asm volatile("s_waitcnt vmcnt(55)" : "+v"(r20));
        o0_2 = mfma16(r20, vp0_0, o0_2);
        o1_2 = mfma16(r20, vp1_0, o1_2);
        asm volatile("global_load_dwordx4 %0, %1, off" : "+v"(r20) : "v"((const unsigned char*)(sp0 + ((size_t)(n + 1) * 40 + 20) * 1024) + voff) : "memory");
        __builtin_amdgcn_sched_barrier(0);
        asm volatile("s_waitcnt vmcnt(55)" : "+v"(r21));
        o0_2 = mfma16(r21, vp0_1, o0_2);
        o1_2 = mfma16(r21, vp1_1, o1_2);
        asm volatile("global_load_dwordx4 %0, %1, off" : "+v"(r21) : "v"((const unsigned char*)(sp0 + ((size_t)(n + 1) * 40 + 21) * 1024) + voff) : "memory");
        __builtin_amdgcn_sched_barrier(0);
        asm volatile("s_waitcnt vmcnt(55)" : "+v"(r22));
        o0_3 = mfma16(r22, vp0_0, o0_3);
        o1_3 = mfma16(r22, vp1_0, o1_3);
        asm volatile("global_load_dwordx4 %0, %1, off" : "+v"(r22) : "v"((const unsigned char*)(sp0 + ((size_t)(n + 1) * 40 + 22) * 1024) + voff) : "memory");
        __builtin_amdgcn_sched_barrier(0);
        asm volatile("s_waitcnt vmcnt(55)" : "+v"(r23));
        o0_3 = mfma16(r23, vp0_1, o0_3);
        o1_3 = mfma16(r23, vp1_1, o1_3);
        asm volatile("global_load_dwordx4 %0, %1, off" : "+v"(r23) : "v"((const unsigned char*)(sp0 + ((size_t)(n + 1) * 40 + 23) * 1024) + voff) : "memory");
        __builtin_amdgcn_sched_barrier(0);
        { const unsigned char* obn = obu + (size_t)n * 64 * orow;
          { const unsigned v = f2bf(o0_0[0]); asm volatile("global_store_short %0, %1, off" :: "v"((const unsigned char*)(obn + (size_t)(0) * orow + 0) + ooff), "v"(v) : "memory"); }
          { const unsigned v = f2bf(o0_0[1]); asm volatile("global_store_short %0, %1, off" :: "v"((const unsigned char*)(obn + (size_t)(1) * orow + 0) + ooff), "v"(v) : "memory"); }
          { const unsigned v = f2bf(o0_0[2]); asm volatile("global_store_short %0, %1, off" :: "v"((const unsigned char*)(obn + (size_t)(2) * orow + 0) + ooff), "v"(v) : "memory"); }
          { const unsigned v = f2bf(o0_0[3]); asm volatile("global_store_short %0, %1, off" :: "v"((const unsigned char*)(obn + (size_t)(3) * orow + 0) + ooff), "v"(v) : "memory"); }
          { const unsigned v = f2bf(o0_1[0]); asm volatile("global_store_short %0, %1, off" :: "v"((const unsigned char*)(obn + (size_t)(16) * orow + 0) + ooff), "v"(v) : "memory"); }
          { const unsigned v = f2bf(o0_1[1]); asm volatile("global_store_short %0, %1, off" :: "v"((const unsigned char*)(obn + (size_t)(17) * orow + 0) + ooff), "v"(v) : "memory"); }
          { const unsigned v = f2bf(o0_1[2]); asm volatile("global_store_short %0, %1, off" :: "v"((const unsigned char*)(obn + (size_t)(18) * orow + 0) + ooff), "v"(v) : "memory"); }
          { const unsigned v = f2bf(o0_1[3]); asm volatile("global_store_short %0, %1, off" :: "v"((const unsigned char*)(obn + (size_t)(19) * orow + 0) + ooff), "v"(v) : "memory"); }
          { const unsigned v = f2bf(o0_2[0]); asm volatile("global_store_short %0, %1, off" :: "v"((const unsigned char*)(obn + (size_t)(32) * orow + 0) + ooff), "v"(v) : "memory"); }
          { const unsigned v = f2bf(o0_2[1]); asm volatile("global_store_short %0, %1, off" :: "v"((const unsigned char*)(obn + (size_t)(33) * orow + 0) + ooff), "v"(v) : "memory"); }
          { const unsigned v = f2bf(o0_2[2]); asm volatile("global_store_short %0, %1, off" :: "v"((const unsigned char*)(obn + (size_t)(34) * orow + 0) + ooff), "v"(v) : "memory"); }
          { const unsigned v = f2bf(o0_2[3]); asm volatile("global_store_short %0, %1, off" :: "v"((const unsigned char*)(obn + (size_t)(35) * orow + 0) + ooff), "v"(v) : "memory"); }
          { const unsigned v = f2bf(o0_3[0]); asm volatile("global_store_short %0, %1, off" :: "v"((const unsigned char*)(obn + (size_t)(48) * orow + 0) + ooff), "v"(v) : "memory"); }
          { const unsigned v = f2bf(o0_3[1]); asm volatile("global_store_short %0, %1, off" :: "v"((const unsigned char*)(obn + (size_t)(49) * orow + 0) + ooff), "v"(v) : "memory"); }
          { const unsigned v = f2bf(o0_3[2]); asm volatile("global_store_short %0, %1, off" :: "v"((const unsigned char*)(obn + (size_t)(50) * orow + 0) + ooff), "v"(v) : "memory"); }
          { const unsigned v = f2bf(o0_3[3]); asm volatile("global_store_short %0, %1, off" :: "v"((const unsigned char*)(obn + (size_t)(51) * orow + 0) + ooff), "v"(v) : "memory"); }
          { const unsigned v = f2bf(o1_0[0]); asm volatile("global_store_short %0, %1, off" :: "v"((const unsigned char*)(obn + (size_t)(0) * orow + 32) + ooff), "v"(v) : "memory"); }
          { const unsigned v = f2bf(o1_0[1]); asm volatile("global_store_short %0, %1, off" :: "v"((const unsigned char*)(obn + (size_t)(1) * orow + 32) + ooff), "v"(v) : "memory"); }
          { const unsigned v = f2bf(o1_0[2]); asm volatile("global_store_short %0, %1, off" :: "v"((const unsigned char*)(obn + (size_t)(2) * orow + 32) + ooff), "v"(v) : "memory"); }
          { const unsigned v = f2bf(o1_0[3]); asm volatile("global_store_short %0, %1, off" :: "v"((const unsigned char*)(obn + (size_t)(3) * orow + 32) + ooff), "v"(v) : "memory"); }
          { const unsigned v = f2bf(o1_1[0]); asm volatile("global_store_short %0, %1, off" :: "v"((const unsigned char*)(obn + (size_t)(16) * orow + 32) + ooff), "v"(v) : "memory"); }
          { const unsigned v = f2bf(o1_1[1]); asm volatile("global_store_short %0, %1, off" :: "v"((const unsigned char*)(obn + (size_t)(17) * orow + 32) + ooff), "v"(v) : "memory"); }
          { const unsigned v = f2bf(o1_1[2]); asm volatile("global_store_short %0, %1, off" :: "v"((const unsigned char*)(obn + (size_t)(18) * orow + 32) + ooff), "v"(v) : "memory"); }
          { const unsigned v = f2bf(o1_1[3]); asm volatile("global_store_short %0, %1, off" :: "v"((const unsigned char*)(obn + (size_t)(19) * orow + 32) + ooff), "v"(v) : "memory"); }
          { const unsigned v = f2bf(o1_2[0]); asm volatile("global_store_short %0, %1, off" :: "v"((const unsigned char*)(obn + (size_t)(32) * orow + 32) + ooff), "v"(v) : "memory"); }
          { const unsigned v = f2bf(o1_2[1]); asm volatile("global_store_short %0, %1, off" :: "v"((const unsigned char*)(obn + (size_t)(33) * orow + 32) + ooff), "v"(v) : "memory"); }
          { const unsigned v = f2bf(o1_2[2]); asm volatile("global_store_short %0, %1, off" :: "v"((const unsigned char*)(obn + (size_t)(34) * orow + 32) + ooff), "v"(v) : "memory"); }
          { const unsigned v = f2bf(o1_2[3]); asm volatile("global_store_short %0, %1, off" :: "v"((const unsigned char*)(obn + (size_t)(35) * orow + 32) + ooff), "v"(v) : "memory"); }
          { const unsigned v = f2bf(o1_3[0]); asm volatile("global_store_short %0, %1, off" :: "v"((const unsigned char*)(obn + (size_t)(48) * orow + 32) + ooff), "v"(v) : "memory"); }
          { const unsigned v = f2bf(o1_3[1]); asm volatile("global_store_short %0, %1, off" :: "v"((const unsigned char*)(obn + (size_t)(49) * orow + 32) + ooff), "v"(v) : "memory"); }
          { const unsigned v = f2bf(o1_3[2]); asm volatile("global_store_short %0, %1, off" :: "v"((const unsigned char*)(obn + (size_t)(50) * orow + 32) + ooff), "v"(v) : "memory"); }
          { const unsigned v = f2bf(o1_3[3]); asm volatile("global_store_short %0, %1, off" :: "v"((const unsigned char*)(obn + (size_t)(51) * orow + 32) + ooff), "v"(v) : "memory"); }
        }
        __builtin_amdgcn_sched_barrier(0);
    }
    asm volatile("s_waitcnt vmcnt(0)" ::: "memory");
    }
}

DI void p4_mixnorm(Frame& F, const float* ret_norm, const float* gdn_norm) {
    bf16_t* pj = (bf16_t*)(F.ws + WS_BIG + BIG_PJ); const bf16_t* vc = (const bf16_t*)(F.ws + AUX_VC); const bf16_t* rr = (const bf16_t*)(F.ws + AUX_QN);
    const int lane = F.lane, l32 = lane & 31, hh = lane >> 5;
    const f32x4 gr0 = *(const f32x4*)(ret_norm + 8 * l32), gr1 = *(const f32x4*)(ret_norm + 8 * l32 + 4), gg0 = *(const f32x4*)(gdn_norm + 8 * l32), gg1 = *(const f32x4*)(gdn_norm + 8 * l32 + 4);
    for (int m = F.gw; m < NTOK; m += F.NGW) {
        bf16_t* row = pj + (size_t)m * PJW;
        u32x4 ro[8], gt[8];
#pragma unroll
        for (int q = 0; q < 8; ++q) { const int hv = 2 * q + hh, hd = hv & 7; const bool gdn = hv >= 8;
            ro[q] = *(const u32x4*)((gdn ? vc : rr) + (size_t)m * 2048 + hd * 256 + 8 * l32);
            gt[q] = *(const u32x4*)(row + (gdn ? C_GZ : C_RG) + hd * 256 + 8 * l32); }
        asm volatile("" ::: "memory");
#pragma unroll
        for (int q = 0; q < 8; ++q) { const int hv = 2 * q + hh, hd = hv & 7; const bool gdn = q >= 4;
            float o[8] = {bflo(ro[q].x), bfhi(ro[q].x), bflo(ro[q].y), bfhi(ro[q].y), bflo(ro[q].z), bfhi(ro[q].z), bflo(ro[q].w), bfhi(ro[q].w)};
            float gv[8] = {bflo(gt[q].x), bfhi(gt[q].x), bflo(gt[q].y), bfhi(gt[q].y), bflo(gt[q].z), bfhi(gt[q].z), bflo(gt[q].w), bfhi(gt[q].w)};
            float ss = 0.f;
#pragma unroll
            for (int e = 0; e < 8; ++e) ss += o[e] * o[e];
            ss += __shfl_xor(ss, 1); ss += __shfl_xor(ss, 2); ss += __shfl_xor(ss, 4); ss += __shfl_xor(ss, 8); ss += __shfl_xor(ss, 16);
            const float rstd = 1.0f / sqrtf(ss * (1.0f / 256.0f) + EPS);
            const f32x4 g0 = gdn ? gg0 : gr0, g1 = gdn ? gg1 : gr1;
            u32x4 w; w.x = pk2(o[0] * rstd * g0.x * siluf(gv[0]), o[1] * rstd * g0.y * siluf(gv[1])); w.y = pk2(o[2] * rstd * g0.z * siluf(gv[2]), o[3] * rstd * g0.w * siluf(gv[3]));
            w.z = pk2(o[4] * rstd * g1.x * siluf(gv[4]), o[5] * rstd * g1.y * siluf(gv[5])); w.w = pk2(o[6] * rstd * g1.z * siluf(gv[6]), o[7] * rstd * g1.w * siluf(gv[7]));
            *(u32x4*)(row + (gdn ? C_GZ : C_RG) + hd * 256 + 8 * l32) = w; }
    }
}

DI void p11_swaprep(Frame& F, const float* qnorm, const float* knorm) {
    bf16_t* qkv = (bf16_t*)(F.ws + WS_BIG + BIG_QKV1); const f32x2* cs32 = (const f32x2*)(F.ws + AUX_CS32);
    const int lane = F.lane, l8 = lane & 7;
    const f32x4 gq0 = *(const f32x4*)(qnorm + 8 * l8), gq1 = *(const f32x4*)(qnorm + 8 * l8 + 4), gk0 = *(const f32x4*)(knorm + 8 * l8), gk1 = *(const f32x4*)(knorm + 8 * l8 + 4);
    const float sg = (l8 < 4) ? -1.f : 1.f;
    for (int m = F.gw; m < NTOK; m += F.NGW) {
        const int pos = m & (SEQ - 1);
        const f32x4* cp = (const f32x4*)(cs32 + (size_t)pos * 32 + 8 * (l8 & 3));
        const f32x4 c0 = cp[0], c1 = cp[1], c2 = cp[2], c3 = cp[3];
        bf16_t* row = qkv + (size_t)m * ODD_IN;
        u32x4 x[5];
#pragma unroll
        for (int i = 0; i < 5; ++i) { x[i] = (u32x4){0u, 0u, 0u, 0u}; if (i < 4 || lane < 32) x[i] = *(const u32x4*)(row + i * 512 + 8 * lane); }
        asm volatile("" ::: "memory");
#pragma unroll
        for (int i = 0; i < 5; ++i) {
            float v[8] = {bflo(x[i].x), bfhi(x[i].x), bflo(x[i].y), bfhi(x[i].y), bflo(x[i].z), bfhi(x[i].z), bflo(x[i].w), bfhi(x[i].w)};
            float ss = 0.f;
#pragma unroll
            for (int e = 0; e < 8; ++e) ss += v[e] * v[e];
            ss += __shfl_xor(ss, 1); ss += __shfl_xor(ss, 2); ss += __shfl_xor(ss, 4);
            const float rstd = 1.0f / sqrtf(ss * (1.0f / 64.0f) + EPS);
            const f32x4 g0 = i < 4 ? gq0 : gk0, g1 = i < 4 ? gq1 : gk1;
            v[0] *= rstd * g0.x; v[1] *= rstd * g0.y; v[2] *= rstd * g0.z; v[3] *= rstd * g0.w; v[4] *= rstd * g1.x; v[5] *= rstd * g1.y; v[6] *= rstd * g1.z; v[7] *= rstd * g1.w;
            float p[8];
#pragma unroll
            for (int e = 0; e < 8; ++e) p[e] = __shfl_xor(v[e], 4);
            u32x4 o;
            o.x = pk2(v[0] * c0.x + sg * p[0] * c0.y, v[1] * c0.z + sg * p[1] * c0.w); o.y = pk2(v[2] * c1.x + sg * p[2] * c1.y, v[3] * c1.z + sg * p[3] * c1.w);
            o.z = pk2(v[4] * c2.x + sg * p[4] * c2.y, v[5] * c2.z + sg * p[5] * c2.w); o.w = pk2(v[6] * c3.x + sg * p[6] * c3.y, v[7] * c3.z + sg * p[7] * c3.w);
            if (i < 4 || lane < 32) *(u32x4*)(row + i * 512 + 8 * lane) = o; }
    }
}
typedef float f32x16 __attribute__((ext_vector_type(16)));
DI f32x16 mfma32(bf16x8 a, bf16x8 b, f32x16 c) { return __builtin_amdgcn_mfma_f32_32x32x16_bf16(a, b, c, 0, 0, 0); }
DI void swa_phase(Frame& F, const float* sinks) {
    constexpr int KP = 144;
    bf16_t* qkv = (bf16_t*)(F.ws + WS_BIG + BIG_QKV1);
    LAS unsigned char* Ks = F.lds; LAS unsigned char* Vs = F.lds + 256 * KP;
    const unsigned vs_addr = (unsigned)(size_t)Vs;
    const int lane = F.lane, w = F.wave, h = lane >> 5, ql = lane & 31, q4 = (lane & 15) >> 2, p4 = lane & 3, blk = (lane >> 4) & 1;
    for (int unit = blockIdx.x; unit < 1024; unit += F.G) {
        const int b = unit >> 9, kvh = (unit >> 7) & 3, qb = unit & 127;
        const size_t tok0 = (size_t)b * SEQ + (size_t)qb * 128;
        __syncthreads();
#pragma unroll
        for (int i = 0; i < 4; ++i) { const int pc = F.tid + 512 * i, row = pc >> 3, c = pc & 7; const size_t tok = (qb == 0 && row < 128) ? tok0 : tok0 - 128 + row;
            const bf16_t* src = qkv + tok * ODD_IN + 2048 + kvh * 64 + c * 8;
            *(LAS u32x4*)(Ks + row * KP + c * 16) = *(const u32x4*)src; *(LAS u32x4*)(Vs + row * KP + c * 16) = *(const u32x4*)(src + 256); }
        __syncthreads();
        const int hq = kvh * 8 + w; const float sink = sinks[hq];
#pragma unroll 1
        for (int t = 0; t < 4; ++t) {
            bf16_t* qrow = qkv + (tok0 + 32 * t + ql) * ODD_IN + hq * 64;
            bf16x8 Qf[4];
#pragma unroll
            for (int s2 = 0; s2 < 4; ++s2) Qf[s2] = *(const bf16x8*)(qrow + 16 * s2 + 8 * h);
            f32x16 sc[5];
#pragma unroll
            for (int kt = 0; kt < 5; ++kt) {
#pragma unroll
                for (int r = 0; r < 16; ++r) sc[kt][r] = 0.f;
#pragma unroll
                for (int s2 = 0; s2 < 4; ++s2) { const bf16x8 a = *(const LAS bf16x8*)(Ks + (32 * (t + kt) + ql) * KP + (16 * s2 + 8 * h) * 2); sc[kt] = mfma32(a, Qf[s2], sc[kt]); } }
            float m = sink;
#pragma unroll
            for (int kt = 0; kt < 5; ++kt) { const bool tile_ok = !(qb == 0 && t + kt < 4);
#pragma unroll
                for (int r = 0; r < 16; ++r) { const int keyrow = (r & 3) + 8 * (r >> 2) + 4 * h; bool ok = tile_ok; if (kt == 0) ok = ok && (keyrow > ql); if (kt == 4) ok = ok && (keyrow <= ql);
                    const float v = ok ? sc[kt][r] * 0.125f : -1.0e30f; sc[kt][r] = v; m = fmaxf(m, v); } }
            m = fmaxf(m, __shfl_xor(m, 32));
            float l = 0.f;
#pragma unroll
            for (int kt = 0; kt < 5; ++kt)
#pragma unroll
                for (int r = 0; r < 16; ++r) { const float p = exp2f((sc[kt][r] - m) * 1.4426950408889634f); sc[kt][r] = p; l += p; }
            l += __shfl_xor(l, 32);
            l += exp2f((sink - m) * 1.4426950408889634f);
            f32x16 o0, o1;
#pragma unroll
            for (int r = 0; r < 16; ++r) { o0[r] = 0.f; o1[r] = 0.f; }
#pragma unroll
            for (int kt = 0; kt < 5; ++kt)
#pragma unroll
                for (int s2 = 0; s2 < 2; ++s2) { u32x4 pw; pw.x = pkbf(sc[kt][8 * s2], sc[kt][8 * s2 + 1]); pw.y = pkbf(sc[kt][8 * s2 + 2], sc[kt][8 * s2 + 3]); pw.z = pkbf(sc[kt][8 * s2 + 4], sc[kt][8 * s2 + 5]); pw.w = pkbf(sc[kt][8 * s2 + 6], sc[kt][8 * s2 + 7]);
                    const bf16x8 pb = __builtin_bit_cast(bf16x8, pw);
                    const unsigned ra = vs_addr + (unsigned)((32 * (t + kt) + 16 * s2 + 4 * h + q4) * KP + blk * 32 + p4 * 8);
                    s16x4 a00, a01, a10, a11; tr_read4(ra, ra + 8 * KP, ra + 64, ra + 8 * KP + 64, a00, a01, a10, a11);
                    o0 = mfma32(cat8(a00, a01), pb, o0); o1 = mfma32(cat8(a10, a11), pb, o1); }
            const float il = 1.0f / l;
            unsigned char* orow8 = F.ws + WS_H + (tok0 + 32 * t + ql) * D + hq * 64; const float il16 = il * 16.0f;
#pragma unroll
            for (int gq = 0; gq < 4; ++gq) { *(unsigned*)(orow8 + 8 * gq + 4 * h) = pk4fp8(o0[4 * gq] * il16, o0[4 * gq + 1] * il16, o0[4 * gq + 2] * il16, o0[4 * gq + 3] * il16);
                *(unsigned*)(orow8 + 32 + 8 * gq + 4 * h) = pk4fp8(o1[4 * gq] * il16, o1[4 * gq + 1] * il16, o1[4 * gq + 2] * il16, o1[4 * gq + 3] * il16); }
        }
    }
}

struct NoHandler { DI void operator()(int, float) const {} };
DI void moe_tables(Frame& F, const unsigned* cntg) {
    LAS int* cnt = (LAS int*)(F.lds + TBL_OFF); LAS int* tb = cnt + 32;
    __syncthreads();
    if (F.wave == 0) {
        const int e = F.lane & 31; const int c = (int)__hip_atomic_load(cntg + e * CSTR, __ATOMIC_RELAXED, __HIP_MEMORY_SCOPE_AGENT); const int t = (c + 255) >> 8; int inc = t;
#pragma unroll
        for (int d = 1; d < 32; d <<= 1) { const int o = __shfl_up(inc, d); if (e >= d) inc += o; }
        if (F.lane < 32) { cnt[e] = c; tb[e] = inc - t; if (e == 31) tb[32] = inc; } }
    __syncthreads();
}

constexpr int NPH = 19;

struct Args { const float* in[20]; float* out; unsigned char* ws; int ph_lo, ph_hi; };
__global__ void __launch_bounds__(NTHR, 2) mk_fwd(Args args) {
    extern __shared__ __attribute__((aligned(16))) unsigned char lds[];
    Frame F;
    F.lds = (LAS unsigned char*)lds; F.tid = threadIdx.x; F.lane = F.tid & 63; F.wave = __builtin_amdgcn_readfirstlane(F.tid >> 6); F.G = gridDim.x;
    F.gw = blockIdx.x * NWAVES + F.wave; F.NGW = F.G * NWAVES; F.ws = args.ws; F.ctl = (unsigned*)(args.ws + WS_CTL);
    volatile LAS unsigned* MISC = (volatile LAS unsigned*)(F.lds + MISC_OFF);
    if (F.tid < 64) MISC[F.tid] = 0u;
    __syncthreads();
    XcdBarrier bar; bar.bar = F.ctl + CW_BAR; bar.x = 0; bar.st = nullptr;
    if (!MK_MULTI) bar = xcd_barrier_post(F.ctl + CW_BAR, MISC + 8);
    const int lo = args.ph_lo, hi = args.ph_hi;
#ifdef ONLY_PH
#define IN(k) ((k) == ONLY_PH && lo <= (k) && (k) < hi)
#else
#define IN(k) (lo <= (k) && (k) < hi)
#endif
#define SEAM(k) do { if (IN(k) && IN((k) + 1)) xcd_barrier(bar); } while (0)
    const float* const* in = args.in;
    float* XC = args.out;
    bf16_t* XC16 = (bf16_t*)(F.ws + AUX_QN);
    bf16_t* H = (bf16_t*)(F.ws + WS_H);
    bf16_t* PJ = (bf16_t*)(F.ws + WS_BIG + BIG_PJ);
    unsigned char* aux = F.ws;
    const LAS int* tbl_cnt = (const LAS int*)(F.lds + TBL_OFF); const LAS int* tbl_tb = tbl_cnt + 32;
    LAS unsigned* tokoff = (LAS unsigned*)(F.lds + TOK_OFF);

    enum { P_W = 0, P_N0, P_G0, P_PREP, P_GA, P_SCAN, P_MIX, P_O0, P_M0A, P_M0B, P_M0C, P_N1, P_G1, P_SPREP, P_SWA, P_O1, P_M1A, P_M1B, P_M1C, P_FIN };
    static_assert(P_FIN == NPH, "phase count");
    if (IN(P_W)) { p0_weights(F, in); __syncthreads(); }
    SEAM(P_W);
    if (IN(P_N0)) {
        normproj_pass<0>(F, in[0], in[1], (const bf16_t*)(aux + AUX_SW), (const bf16_t*)(aux + AUX_SW) + 112 * D, H, (float*)(aux + AUX_BG), in[6], in[7], nullptr, nullptr, nullptr, nullptr);
    }
    SEAM(P_N0);
    if (IN(P_G0)) {
        pg8::DenseOrder S; S.init(NTOK, PJW, D, D, (const bf16_t*)(F.ws + WS_WIN0), F.G, blockIdx.x);
        pg8::EpiBf16 E{PJ, PJW};
        pg8::gemm_phase(F.lds, H, D, S, E);
    }
    SEAM(P_G0);
    if (IN(P_PREP)) p2_prep(F, in[5]);
    SEAM(P_PREP);
    if (IN(P_GA)) {
        for (int u = F.gw; u < 16 * NCH; u += F.NGW) {
            ga_unit<true>(F, u, (unsigned char*)args.out, nullptr);
            ga_unit<false>(F, u, F.ws + AUX_W, nullptr);
        }
        __syncthreads();
    }
    SEAM(P_GA);
    if (IN(P_SCAN)) {
        for (int id = blockIdx.x; id < 256; id += F.G) { const int idl = id & 127, bh = (idl % 8) * 2 + (idl / 8) / 8, sl = 2 * ((idl / 8) % 8);
            __syncthreads();
            if (F.tid == 0) { *(volatile LAS unsigned*)(F.lds + XL_CNT) = 0u; *(volatile LAS unsigned*)(F.lds + XL_CNT + 64) = 0u; }
            __syncthreads();
            if (id < 128) { if (F.wave == 0) scan_wave<true, 0>(F, bh, sl, (const unsigned char*)args.out, F.lds); else if (F.wave == 1) scan_wave<true, 1>(F, bh, sl, (const unsigned char*)args.out, F.lds); }
            else { if (F.wave == 0) scan_wave<false, 0>(F, bh, sl, F.ws + AUX_W, F.lds); else if (F.wave == 1) scan_wave<false, 1>(F, bh, sl, F.ws + AUX_W, F.lds); } }
        if (F.wave >= 2) convert_experts(F, in, 1, F.ws + WS_EXP1, F.ws + WS_EXP1 + 96 * MiB, blockIdx.x * 6 + (F.wave - 2), F.G * 6);
        __syncthreads();
    }
    SEAM(P_SCAN);
    if (IN(P_MIX)) p4_mixnorm(F, in[4], in[8]);
    SEAM(P_MIX);
    if (IN(P_O0)) {
        pg8::DenseOrder S; S.init(NTOK, D, 4096, PJW, (const bf16_t*)(F.ws + WS_WOUT0), F.G, blockIdx.x);
        pg8::EpiRes16<false> E{in[0], XC16, D};
        pg8::gemm_phase(F.lds, PJ + C_RG, 4096, S, E);
    }
    SEAM(P_O0);
#define MOE_LAYER(P, L, CNTW)                                                                                                                  \
    if (IN(P)) {                                                            \
        if (L == 0) convert_experts(F, in, 0, F.ws + WS_BIG + BIG_EGU, F.ws + WS_BIG + BIG_EDN, F.gw, F.NGW);     \
        __syncthreads();                                                                \
        normproj_pass<1, true>(F, XC16, in[2] + L * D, (const bf16_t*)(aux + AUX_SW) + (16 + L * 48) * D, (const bf16_t*)(aux + AUX_SW) + (112 + 16 + L * 48) * D, H, nullptr, nullptr, nullptr, F.ctl + CNTW, (int*)(aux + AUX_LIST), (float*)(aux + AUX_GW), (unsigned*)(aux + AUX_ASG)); \
        __syncthreads();                                                                                                                       \
    }                                                                                                                                          \
    SEAM(P);                                                                                                                                   \
    if (IN(P + 1)) {                                                                                                \
        moe_tables(F, F.ctl + CNTW);                                                                                                           \
        pg8::MoeOrder<true> S; S.init(tbl_tb, tokoff, 6, D, D, L == 0 ? F.ws + WS_BIG + BIG_EGU : F.ws + WS_EXP1, (size_t)1536 * D, F.G, blockIdx.x, 1);   \
        { pg8::Unit u; const int* list = (const int*)(aux + AUX_LIST);                                                                         \
          for (int ui = 0; ui < 12 && S.next(ui, u); ++ui) if (F.tid < 256) { const int idx = (u.pm - tbl_tb[u.e]) * 256 + F.tid;               \
              const int tok = idx < tbl_cnt[u.e] ? list[u.e * 65536 + idx] : 0; tokoff[ui * 256 + F.tid] = (unsigned)tok * (unsigned)D; } } \
        __syncthreads();                                                                                                                       \
        pg8::EpiSwiglu8 E{F.ws + WS_BIG + BIG_HID};                                                                                            \
        pg8::gemm_phase<pg8::EpiSwiglu8, pg8::MoeOrder<true>, true, 0x79797979, 0x7d7d7d7d>(F.lds, H, D, S, E);         \
    }                                                                                                                                          \
    SEAM(P + 1);                                                                                                                               \
    if (IN(P + 2)) {                                                                                  \
        moe_tables(F, F.ctl + CNTW);                                                                                                           \
        pg8::MoeOrder<false> S; S.init(tbl_tb, tokoff, 8, FF, FF, L == 0 ? F.ws + WS_BIG + BIG_EDN : F.ws + WS_EXP1 + 96 * MiB, (size_t)D * FF, F.G, blockIdx.x, 1);  \
        pg8::EpiDown E{(bf16_t*)(F.ws + WS_BIG + BIG_Y), (const float*)(aux + AUX_GW), tbl_tb};                                                \
        pg8::gemm_phase<pg8::EpiDown, pg8::MoeOrder<false>, true, 0x7a7a7a7a, 0x7c7c7c7c>(F.lds, F.ws + WS_BIG + BIG_HID, FF, S, E);     \
    }                                                                                                                                          \
    SEAM(P + 2);
    MOE_LAYER(P_M0A, 0, CW_CNT0)
    if (IN(P_N1)) {
        moe_tables(F, F.ctl + CW_CNT0);
        norm_pass<0, true, true, true, NoHandler, true, true, true>(F, XC16, XC16, (const bf16_t*)(F.ws + WS_BIG + BIG_Y), (const unsigned*)(aux + AUX_ASG), tbl_tb, in[1] + D, nullptr, H, NoHandler{});
        __syncthreads();
    }
    SEAM(P_N1);
    if (IN(P_G1)) {
        pg8::DenseOrder S; S.init(NTOK, ODD_IN, D, D, F.ws + WS_WIN1, F.G, blockIdx.x, 1);
        pg8::EpiBf16 E{(bf16_t*)(F.ws + WS_BIG + BIG_QKV1), ODD_IN};
        pg8::gemm_phase<pg8::EpiBf16, pg8::DenseOrder, true, 0x7a7a7a7a, 0x7d7d7d7d>(F.lds, H, D, S, E);
    }
    SEAM(P_G1);
    if (IN(P_SPREP)) p11_swaprep(F, in[11], in[12]);
    SEAM(P_SPREP);
    if (IN(P_SWA)) { swa_phase(F, in[13]); __syncthreads(); }
    SEAM(P_SWA);
    if (IN(P_O1)) {
        pg8::DenseOrder S; S.init(NTOK, D, D, D, F.ws + WS_WOUT1, F.G, blockIdx.x, 1);
        pg8::EpiRes16<true> E{XC16, XC16, D};
        pg8::gemm_phase<pg8::EpiRes16<true>, pg8::DenseOrder, true, 0x7a7a7a7a, 0x7b7b7b7b>(F.lds, F.ws + WS_H, D, S, E);
    }
    SEAM(P_O1);
    MOE_LAYER(P_M1A, 1, CW_CNT1)
    if (IN(P_FIN)) {
        moe_tables(F, F.ctl + CW_CNT1);
        norm_pass<0, true, true, false, NoHandler, false, true, false>(F, XC16, XC, (const bf16_t*)(F.ws + WS_BIG + BIG_Y), (const unsigned*)(aux + AUX_ASG), tbl_tb, nullptr, nullptr, nullptr, NoHandler{});
    }
#undef IN
#undef SEAM
}

extern "C" void kernel_launch(void* const* d_in, const int* in_sizes, int n_in, void* d_out, int out_size, void* d_ws, size_t ws_size, hipStream_t stream) {
    static int grid = 0;
    if (grid == 0) {
        if (n_in != 20 || in_sizes[0] != NTOK * D || out_size != NTOK * D || ws_size < WS_END) { fprintf(stderr, "kernel_launch: unexpected shapes / workspace (n_in %d, in0 %d, out %d, ws %zu, need %zu)\n", n_in, n_in > 0 ? in_sizes[0] : -1, out_size, ws_size, (size_t)WS_END); grid = -1; return; }
        int dev = 0, cus = 0, per_cu = 0;
        if (hipGetDevice(&dev) != hipSuccess || hipDeviceGetAttribute(&cus, hipDeviceAttributeMultiprocessorCount, dev) != hipSuccess) { grid = -1; return; }
        if (hipFuncSetAttribute((const void*)mk_fwd, hipFuncAttributeMaxDynamicSharedMemorySize, LDS_BYTES) != hipSuccess) { fprintf(stderr, "kernel_launch: hipFuncSetAttribute failed\n"); grid = -1; return; }
        if (hipOccupancyMaxActiveBlocksPerMultiprocessor(&per_cu, (const void*)mk_fwd, NTHR, LDS_BYTES) != hipSuccess || per_cu < 1) fprintf(stderr, "kernel_launch: occupancy query reports %d\n", per_cu);
        (void)hipGetLastError();
        if (cus < 256) { fprintf(stderr, "kernel_launch: built for 256 CUs (got %d)\n", cus); grid = -1; return; }
        grid = 256;
    }
    if (grid < 0) return;
    (void)hipMemsetAsync((char*)d_ws + WS_CTL, 0, CTL_ZERO_BYTES, stream);
    Args a{};
    for (int i = 0; i < 20; ++i) a.in[i] = (const float*)d_in[i];
    a.out = (float*)d_out; a.ws = (unsigned char*)d_ws;
#if MK_MULTI
    for (int p = 0; p <= NPH; ++p) { a.ph_lo = p; a.ph_hi = p + 1; hipLaunchKernelGGL(mk_fwd, dim3(grid), dim3(NTHR), LDS_BYTES, stream, a); }
#else
    a.ph_lo = 0; a.ph_hi = NPH + 1;
    hipLaunchKernelGGL(mk_fwd, dim3(grid), dim3(NTHR), LDS_BYTES, stream, a);
#endif
}
```

```cpp
#include <hip/hip_runtime.h>
#include <cstdio>
#include <cstdint>

#ifndef MK_MULTI
#define MK_MULTI 0
#endif

#define LAS __attribute__((address_space(3)))
typedef unsigned short bf16_t;
typedef short bf16x8 __attribute__((ext_vector_type(8)));
typedef float f32x4 __attribute__((ext_vector_type(4)));
typedef float f32x2 __attribute__((ext_vector_type(2)));
typedef unsigned u32x4 __attribute__((ext_vector_type(4)));
typedef unsigned u32x2 __attribute__((ext_vector_type(2)));
#define DI __device__ __forceinline__

constexpr int D = 2048, BATCH = 2, SEQ = 16384, NTOK = BATCH * SEQ;
constexpr int EVEN_IN = 12304, PJW = 12288;
constexpr int ODD_IN = 2560;
constexpr int NEXP = 32, FF = 768, TOPK = 2, MAXT = 288;
constexpr float EPS = 1e-6f;
constexpr double ROPE_R = 0.86596432336006535;
constexpr int C_RQ = 0, C_RK = 1024, C_RV = 2048, C_GQKV = 4096, C_RG = 8192, C_GZ = 10240;

constexpr size_t MiB = 1u << 20;
constexpr size_t WS_CTL = 0, CTL_ZERO_BYTES = 1 * MiB;
constexpr size_t WS_WIN0 = 2 * MiB;
constexpr size_t WS_WOUT0 = WS_WIN0 + 48 * MiB;
constexpr size_t WS_WIN1 = WS_WOUT0 + 16 * MiB;
constexpr size_t WS_WOUT1 = WS_WIN1 + 10 * MiB;
constexpr size_t WS_H = 84 * MiB;
constexpr size_t WS_BIG = 212 * MiB;
constexpr size_t WS_AUX = 980 * MiB;
constexpr size_t WS_MISC = 1540 * MiB;
constexpr size_t WS_EXP1 = 1396 * MiB;
constexpr size_t WS_END = 1572 * MiB;
constexpr size_t BIG_PJ = 0;
constexpr size_t BIG_EGU = 0;
constexpr size_t BIG_EDN = 192 * MiB;
constexpr size_t BIG_HID = 288 * MiB;
constexpr size_t BIG_Y = 400 * MiB;
constexpr size_t BIG_QKV1 = 0;
constexpr size_t AUX_QN = WS_AUX + 0;
constexpr size_t AUX_KN = WS_AUX + 64 * MiB;
constexpr size_t AUX_VC = WS_AUX + 128 * MiB;
constexpr size_t AUX_W = WS_AUX + 256 * MiB;
constexpr size_t AUX_ATT = WS_AUX + 320 * MiB;
constexpr size_t AUX_RST = WS_AUX + 352 * MiB;
constexpr size_t AUX_H8 = WS_AUX + 128 * MiB;
constexpr size_t AUX_WIN8 = WS_AUX + 256 * MiB;
constexpr size_t AUX_BG = WS_MISC + 0;
constexpr size_t AUX_CS = WS_MISC + 2 * MiB;
constexpr size_t AUX_DEC = WS_MISC + 10 * MiB + 960 * 1024;
constexpr size_t AUX_SW = WS_MISC + 10 * MiB;
constexpr size_t AUX_LIST = WS_MISC + 11 * MiB;
constexpr size_t AUX_GW = WS_MISC + 19 * MiB;
constexpr size_t AUX_ASG = WS_MISC + 27 * MiB;
constexpr size_t AUX_CS32 = WS_MISC + 28 * MiB;
static_assert(AUX_CS32 + 4 * MiB <= WS_END && AUX_W + 160 * MiB <= WS_EXP1 && WS_EXP1 + 144 * MiB <= WS_MISC, "aux map");
constexpr int CW_BAR = 4096;
constexpr int CSTR = 1088;
constexpr int CW_CNT0 = 16384, CW_CNT1 = 16384 + 40960;

constexpr int RING_BYTES = 131072;
constexpr int GA_LDS_WAVE = 17920;
constexpr int MISC_OFF = 8 * GA_LDS_WAVE;
constexpr int TBL_OFF = MISC_OFF + 256;
constexpr int TOK_OFF = MISC_OFF + 1024;
constexpr int LDS_BYTES = 163840;
static_assert(TOK_OFF + 12 * 1024 <= LDS_BYTES, "lds map");
DI float rdlane(float v, int l) { return __builtin_bit_cast(float, __builtin_amdgcn_readlane(__builtin_bit_cast(int, v), l)); }

typedef __bf16 bf16v2 __attribute__((ext_vector_type(2)));
DI unsigned pkbf(float a, float b) { f32x2 v = {a, b}; return __builtin_bit_cast(unsigned, __builtin_convertvector(v, bf16v2)); }
DI unsigned f2bf(float f) { return pkbf(f, 0.f) & 0xffffu; }
DI unsigned pk2(float lo, float hi) { return pkbf(lo, hi); }
DI float bflo(unsigned w) { return __builtin_bit_cast(float, w << 16); }
DI float bfhi(unsigned w) { return __builtin_bit_cast(float, w & 0xffff0000u); }
DI float bf2f(bf16_t b) { return __builtin_bit_cast(float, ((unsigned)b) << 16); }
DI unsigned cvt_pk_bf16(float lo, float hi) { unsigned r; asm volatile("v_cvt_pk_bf16_f32 %0, %1, %2" : "=v"(r) : "v"(lo), "v"(hi)); return r; }
DI float wave_sum(float v) {
#pragma unroll
    for (int o = 1; o < 64; o <<= 1) v += __shfl_xor(v, o);
    return v;
}
DI float siluf(float x) { return x / (1.0f + __expf(-x)); }
DI unsigned pk4fp8(float a, float b, float c, float d) { int w = __builtin_amdgcn_cvt_pk_fp8_f32(a, b, 0, false); w = __builtin_amdgcn_cvt_pk_fp8_f32(c, d, w, true); return (unsigned)w; }
DI f32x4 mfma16(bf16x8 a, bf16x8 b, f32x4 c) { return __builtin_amdgcn_mfma_f32_16x16x32_bf16(a, b, c, 0, 0, 0); }
#define LDS_WAIT() asm volatile("s_waitcnt lgkmcnt(0)" ::: "memory")
#define VM_WAIT() asm volatile("s_waitcnt vmcnt(0)" ::: "memory")

#define XB_TMO      128
#define XB_XCNT(j)  (256  + 64 * (j))
#define XB_XSUB(j)  (1280 + 64 * (j))
#define XB_XGEN(j)  (2304 + 64 * (j))
#define XB_TOP      3328
#define XB_TOPGEN   3392
#define XCD_BAR_WORDS 3456
#define XB_SPIN_CAP (1u << 22)
DI unsigned xb_ld(unsigned* p)              { return __hip_atomic_load(p, __ATOMIC_RELAXED, __HIP_MEMORY_SCOPE_AGENT); }
DI unsigned xb_add(unsigned* p, unsigned v) { return __hip_atomic_fetch_add(p, v, __ATOMIC_RELAXED, __HIP_MEMORY_SCOPE_AGENT); }
DI unsigned xb_xcc_id() { return (unsigned)__builtin_amdgcn_s_getreg((3 << 11) | 20) & 0xFu; }
#define XB_SPIN(cond, bar) do { unsigned _sp = 0; while (cond) { __builtin_amdgcn_s_sleep(1); \
    if ((++_sp & 255u) == 0u) { if (xb_ld(&(bar)[XB_TMO])) break; if (_sp > XB_SPIN_CAP) { atomicAdd(&(bar)[XB_TMO], 1u); break; } } } } while (0)
struct XcdBarrier { unsigned* bar; unsigned x; volatile LAS unsigned* st; };
DI XcdBarrier xcd_barrier_post(unsigned* bar, volatile LAS unsigned* st) {
    XcdBarrier b; b.bar = bar; b.x = xb_xcc_id(); b.st = st;
    if (threadIdx.x == 0) (void)xb_add(&bar[XB_XCNT(b.x)], 1u);
    return b;
}
DI void xcd_barrier_complete(unsigned* bar, unsigned x, unsigned& nloc, unsigned& nx) {
    const unsigned G = gridDim.x * gridDim.y * gridDim.z;
    unsigned sum, cnt, mine, sp = 0u;
    for (;;) {
        sum = 0u; cnt = 0u; mine = 0u;
#pragma unroll
        for (unsigned j = 0; j < 16; ++j) { const unsigned c = xb_ld(&bar[XB_XCNT(j)]); sum += c; cnt += (c > 0u) ? 1u : 0u; mine = (j == x) ? c : mine; }
        if (sum == G) break;
        __builtin_amdgcn_s_sleep(1);
        if ((++sp & 255u) == 0u) { if (xb_ld(&bar[XB_TMO])) break; if (sp > XB_SPIN_CAP) { atomicAdd(&bar[XB_TMO], 1u); break; } }
    }
    nloc = mine > 0u ? mine : 1u; nx = cnt > 0u ? cnt : 1u;
}
DI void xcd_barrier(const XcdBarrier& b) {
    asm volatile("s_waitcnt vmcnt(0)" ::: "memory");
    __syncthreads();
    if (threadIdx.x == 0) {
        unsigned* bar = b.bar;
        __builtin_amdgcn_s_waitcnt(0);
        unsigned nloc = b.st[0], nx = b.st[1];
        if (nloc == 0u) { xcd_barrier_complete(bar, b.x, nloc, nx); b.st[0] = nloc; b.st[1] = nx; }
        const unsigned old = xb_add(&bar[XB_XSUB(b.x)], 1u);
        const unsigned gen = old / nloc;
        if (old + 1u == (gen + 1u) * nloc) {
            __builtin_amdgcn_fence(__ATOMIC_RELEASE, "agent");
            asm volatile("s_waitcnt vmcnt(0)" ::: "memory");
            const unsigned og = xb_add(&bar[XB_TOP], 1u);
            const unsigned tg = og / nx;
            if (og + 1u == (tg + 1u) * nx) xb_add(&bar[XB_TOPGEN], 1u);
            else XB_SPIN(xb_ld(&bar[XB_TOPGEN]) == tg, bar);
            __builtin_amdgcn_fence(__ATOMIC_ACQUIRE, "agent");
            xb_add(&bar[XB_XGEN(b.x)], 1u);
            asm volatile("s_waitcnt vmcnt(0)" ::: "memory");
        } else {
            XB_SPIN(xb_ld(&bar[XB_XGEN(b.x)]) == gen, bar);
            __builtin_amdgcn_fence(__ATOMIC_ACQUIRE, "agent");
            asm volatile("s_waitcnt vmcnt(0)" ::: "memory");
        }
    }
    __syncthreads();
}

namespace pg8 {
constexpr int BM = 256, BK = 64, HALF = 128, HTB = HALF * BK * 2, STAGE_BYTES = 8 * HTB, NXCD = 8, WGM = 8;
__host__ __device__ __forceinline__ int lds_byte(int r, int c) { const int st = (r >> 4) * 2 + (c >> 5), rr = r & 15, cc = c & 31, ob = rr * 64 + cc * 2; return st * 1024 + (ob ^ (((ob >> 9) & 1) << 5)); }
__host__ __device__ __forceinline__ void stage_rc(int b, int& R, int& C) { const int st = b / 1024, sb = b % 1024, swz = sb ^ (((sb >> 9) & 1) << 5); R = (st >> 1) * 16 + swz / 64; C = (st & 1) * 32 + (swz % 64) / 2; }
__host__ __device__ __forceinline__ int perm32(int rho) { const int n = rho >> 4, i = rho & 15; return 8 * (i >> 2) + 4 * n + (i & 3); }

struct Unit { int pm, pn, e, slot; };

DI int xcd_remap(int L, int nwg) { const int q = nwg / NXCD, r = nwg % NXCD, xcd = L % NXCD, off = L / NXCD; return (xcd < r ? xcd * (q + 1) : r * (q + 1) + (xcd - r) * q) + off; }

template <int MAP> struct DenseOrderT {
    int nM, nN, nwg, G, c; unsigned lda2; const char* Bt; size_t tstepB;
    DI void init(int M, int N, int K, int lda, const void* Bt_, int G_, int c_, int EB = 2) { nM = M / BM; nN = N / BM; nwg = nM * nN; G = G_; c = c_; lda2 = (unsigned)(lda * EB); Bt = (const char*)Bt_; tstepB = (size_t)BM * K * EB; }
    DI bool next(int i, Unit& u) const {
        const long L = (long)i * G + c; if (L >= nwg) return false;
        const int wgid = xcd_remap((int)L, nwg);
        const int nig = WGM * nN, gid = wgid / nig, fm = gid * WGM, gsz = (nM - fm) < WGM ? (nM - fm) : WGM;
        u.pm = fm + ((wgid % nig) % gsz); const int t = (wgid % nig) / gsz; u.pn = MAP == 0 ? t : (MAP == 1 ? (t < 8 ? t : (t < 16 ? t + 8 : t + 16)) : (t < 8 ? t + 8 : t + 16)); u.e = 0; u.slot = i; return true;
    }
    DI unsigned a_off(const Unit& u, int h, int R) const { return (unsigned)(u.pm * BM + h * HALF + R) * lda2; }
    DI const char* b_base(const Unit& u) const { return Bt + (size_t)u.pn * tstepB; }
};
typedef DenseOrderT<0> DenseOrder;
template <bool GATHER> struct MoeOrder {
    const LAS int* tb; const LAS unsigned* tokoff; int NT, nwg, G, c; unsigned lda2; const char* Bt; size_t estepB, tstepB;
    DI void init(const LAS int* tb_, const LAS unsigned* tokoff_, int NT_, int K, int lda, const void* Bt_, size_t estep_elems, int G_, int c_, int EB = 2) {
        tb = tb_; tokoff = tokoff_; NT = NT_; nwg = tb_[32] * NT_; G = G_; c = c_; lda2 = (unsigned)(lda * EB); Bt = (const char*)Bt_; estepB = estep_elems * EB; tstepB = (size_t)BM * K * EB; }
    DI bool next(int i, Unit& u) const {
        const long L = (long)i * G + c; if (L >= nwg) return false;
        const int w = xcd_remap((int)L, nwg);
        int e = 0;
#pragma unroll 1
        for (int s = 16; s >= 1; s >>= 1) if (tb[e + s] * NT <= w) e += s;
        const int nt = tb[e + 1] - tb[e], local = w - tb[e] * NT;
        u.e = e; u.pn = local / nt; u.pm = tb[e] + local % nt; u.slot = i; return true;
    }
    DI unsigned a_off(const Unit& u, int h, int R) const { if (GATHER) return tokoff[u.slot * 256 + h * HALF + R]; return (unsigned)(u.pm * BM + h * HALF + R) * lda2; }
    DI const char* b_base(const Unit& u) const { return Bt + (size_t)u.e * estepB + (size_t)u.pn * tstepB; }
};

struct EpiBf16 {
    static constexpr bool PERM = true;
    bf16_t* O; int ldc;
    DI void operator()(const f32x4 (&acc)[2][2][4][2], const Unit& u, int wr, int wc, int fr, int fq) const {
        const int row0 = u.pm * BM + wr * 64 + fr, col0 = u.pn * BM + wc * 32 + 8 * fq;
#pragma unroll
        for (int ai = 0; ai < 2; ++ai)
#pragma unroll
            for (int m = 0; m < 4; ++m) { bf16_t* rowp = O + (size_t)(row0 + ai * HALF + m * 16) * ldc + col0;
#pragma unroll
                for (int bj = 0; bj < 2; ++bj) { const f32x4 v0 = acc[ai][bj][m][0], v1 = acc[ai][bj][m][1];
                    u32x4 w; w.x = cvt_pk_bf16(v0[0], v0[1]); w.y = cvt_pk_bf16(v0[2], v0[3]); w.z = cvt_pk_bf16(v1[0], v1[1]); w.w = cvt_pk_bf16(v1[2], v1[3]);
                    *(u32x4*)(rowp + bj * HALF) = w; } }
    }
};
struct EpiResF32 {
    static constexpr bool PERM = false;
    const float* base; float* out; int ldc;
    DI void operator()(const f32x4 (&acc)[2][2][4][2], const Unit& u, int wr, int wc, int fr, int fq) const {
        const int row0 = u.pm * BM + wr * 64 + fr, col0 = u.pn * BM + wc * 32 + 4 * fq;
#pragma unroll
        for (int ai = 0; ai < 2; ++ai)
#pragma unroll
            for (int m = 0; m < 4; ++m) { const size_t off = (size_t)(row0 + ai * HALF + m * 16) * ldc + col0;
#pragma unroll
                for (int bj = 0; bj < 2; ++bj)
#pragma unroll
                    for (int n = 0; n < 2; ++n) { const f32x4 bs = *(const f32x4*)(base + off + bj * HALF + n * 16); *(f32x4*)(out + off + bj * HALF + n * 16) = bs + acc[ai][bj][m][n]; }
                asm volatile("" ::: "memory"); }
    }
};
template <bool BASE16> struct EpiRes16 {
    static constexpr bool PERM = true;
    const void* base; bf16_t* out; int ldc;
    DI void operator()(const f32x4 (&acc)[2][2][4][2], const Unit& u, int wr, int wc, int fr, int fq) const {
        const int row0 = u.pm * BM + wr * 64 + fr, col0 = u.pn * BM + wc * 32 + 8 * fq;
#pragma unroll
        for (int ai = 0; ai < 2; ++ai)
#pragma unroll
            for (int m = 0; m < 4; ++m) { const size_t off = (size_t)(row0 + ai * HALF + m * 16) * ldc + col0;
#pragma unroll
                for (int bj = 0; bj < 2; ++bj) { f32x4 v0 = acc[ai][bj][m][0], v1 = acc[ai][bj][m][1];
                    if (BASE16) { const u32x4 b = *(const u32x4*)((const bf16_t*)base + off + bj * HALF); v0 += (f32x4){bflo(b.x), bfhi(b.x), bflo(b.y), bfhi(b.y)}; v1 += (f32x4){bflo(b.z), bfhi(b.z), bflo(b.w), bfhi(b.w)}; }
                    else { const float* bp = (const float*)base + off + bj * HALF; v0 += *(const f32x4*)bp; v1 += *(const f32x4*)(bp + 4); }
                    u32x4 w; w.x = cvt_pk_bf16(v0[0], v0[1]); w.y = cvt_pk_bf16(v0[2], v0[3]); w.z = cvt_pk_bf16(v1[0], v1[1]); w.w = cvt_pk_bf16(v1[2], v1[3]);
                    *(u32x4*)(out + off + bj * HALF) = w; }
                asm volatile("" ::: "memory"); }
    }
};
struct EpiSwiglu {
    static constexpr bool PERM = true;
    bf16_t* O;
    DI void operator()(const f32x4 (&acc)[2][2][4][2], const Unit& u, int wr, int wc, int fr, int fq) const {
        const int row0 = u.pm * BM + wr * 64 + fr, col0 = u.pn * HALF + wc * 32 + 8 * fq;
#pragma unroll
        for (int ai = 0; ai < 2; ++ai)
#pragma unroll
            for (int m = 0; m < 4; ++m) { bf16_t* rowp = O + (size_t)(row0 + ai * HALF + m * 16) * FF + col0;
                float h[8];
#pragma unroll
                for (int n = 0; n < 2; ++n)
#pragma unroll
                    for (int j = 0; j < 4; ++j) { const float g = acc[ai][0][m][n][j], up = acc[ai][1][m][n][j]; h[n * 4 + j] = g / (1.0f + __expf(-g)) * up; }
                u32x4 w; w.x = cvt_pk_bf16(h[0], h[1]); w.y = cvt_pk_bf16(h[2], h[3]); w.z = cvt_pk_bf16(h[4], h[5]); w.w = cvt_pk_bf16(h[6], h[7]);
                *(u32x4*)rowp = w; }
    }
};
struct EpiSwiglu8 {
    static constexpr bool PERM = true;
    unsigned char* O;
    DI void operator()(const f32x4 (&acc)[2][2][4][2], const Unit& u, int wr, int wc, int fr, int fq) const {
        const int row0 = u.pm * BM + wr * 64 + fr, col0 = u.pn * HALF + wc * 32 + 8 * fq;
#pragma unroll
        for (int ai = 0; ai < 2; ++ai)
#pragma unroll
            for (int m = 0; m < 4; ++m) { unsigned char* rowp = O + (size_t)(row0 + ai * HALF + m * 16) * FF + col0;
                float h[8];
#pragma unroll
                for (int n = 0; n < 2; ++n)
#pragma unroll
                    for (int j = 0; j < 4; ++j) { const float g = acc[ai][0][m][n][j], up = acc[ai][1][m][n][j]; h[n * 4 + j] = g / (1.0f + __expf(-g)) * up * 8.0f; }
                u32x2 w; w.x = pk4fp8(h[0], h[1], h[2], h[3]); w.y = pk4fp8(h[4], h[5], h[6], h[7]);
                *(u32x2*)rowp = w; }
    }
};
struct EpiDown {
    static constexpr bool PERM = true;
    bf16_t* O; const float* gw; const LAS int* tb;
    DI void operator()(const f32x4 (&acc)[2][2][4][2], const Unit& u, int wr, int wc, int fr, int fq) const {
        const int row0 = u.pm * BM + wr * 64 + fr, col0 = u.pn * BM + wc * 32 + 8 * fq;
        const int lrow0 = (u.pm - tb[u.e]) * BM + wr * 64 + fr;
        const float* gwe = gw + (size_t)u.e * 65536;
#pragma unroll
        for (int ai = 0; ai < 2; ++ai)
#pragma unroll
            for (int m = 0; m < 4; ++m) { unsigned char* rowp = (unsigned char*)O + (size_t)(row0 + ai * HALF + m * 16) * D + col0; const float g = gwe[lrow0 + ai * HALF + m * 16] * 16.0f;
#pragma unroll
                for (int bj = 0; bj < 2; ++bj) { const f32x4 v0 = acc[ai][bj][m][0] * g, v1 = acc[ai][bj][m][1] * g;
                    u32x2 w; w.x = pk4fp8(v0[0], v0[1], v0[2], v0[3]); w.y = pk4fp8(v1[0], v1[1], v1[2], v1[3]);
                    *(u32x2*)(rowp + bj * HALF) = w; } }
    }
};

typedef int v8i __attribute__((ext_vector_type(8)));
typedef int v4i __attribute__((ext_vector_type(4)));
template <class Epi, class Sched, bool FP8 = false, int SCW = 0x7f7f7f7f, int SCA = 0x7f7f7f7f>
DI void gemm_phase(LAS unsigned char* lds, const void* Aptr, int K, const Sched& S, const Epi& E) {
    constexpr int EB = FP8 ? 1 : 2;
    const int tid = threadIdx.x, wid = __builtin_amdgcn_readfirstlane(tid >> 6), lane = tid & 63, wr = wid >> 2, wc = wid & 3, fr = lane & 15, fq = lane >> 4;
    const int nt = K * EB / (BK * 2);
    const char* Ab = (const char*)Aptr;
    int Rr[2], Cc[2]; unsigned voffB[2];
#pragma unroll
    for (int i = 0; i < 2; ++i) { int R, C; stage_rc(tid * 16 + i * 8192, R, C); const int Rb = Epi::PERM ? ((R & ~31) + perm32(R & 31)) : R; Rr[i] = R; Cc[i] = C * 2; voffB[i] = (unsigned)(Rb * K * EB + C * 2); }
    const unsigned kstep = (unsigned)(BK * 2);
    const size_t hstepB = (size_t)HALF * K * EB;
    const unsigned ldsw = (unsigned)wid * 1024u;
    const int aoff = lds_byte(wr * 64 + fr, fq * (FP8 ? 16 : 8)), boff = lds_byte(wc * 32 + fr, fq * (FP8 ? 16 : 8));
#define PG8_SA(b, h) (((b) * 2 + (h)) * HTB)
#define PG8_SB(b, h) ((4 + (b) * 2 + (h)) * HTB)
#define PG8_STAGEB(bufoff, gbase) do { _Pragma("unroll") for (int _i = 0; _i < 2; ++_i) \
        __builtin_amdgcn_global_load_lds((const unsigned*)((const char*)(gbase) + voffB[_i]), (LAS unsigned*)(lds + (bufoff) + ldsw + _i * 8192), 16, 0, 0); } while (0)
#define PG8_STAGEA(bufoff, offs, kb) do { _Pragma("unroll") for (int _i = 0; _i < 2; ++_i) \
        __builtin_amdgcn_global_load_lds((const unsigned*)(Ab + (size_t)((offs)[_i] + (kb))), (LAS unsigned*)(lds + (bufoff) + ldsw + _i * 8192), 16, 0, 0); } while (0)
#define PG8_LDA(dst, b, h) do { _Pragma("unroll") for (int m = 0; m < 4; ++m) { if constexpr (FP8) { dst##8[m] = *(const LAS v8i*)(lds + PG8_SA(b, h) + aoff + m * 2048); } \
        else { _Pragma("unroll") for (int k = 0; k < 2; ++k) dst[m][k] = *(const LAS bf16x8*)(lds + PG8_SA(b, h) + aoff + m * 2048 + k * 1024); } } } while (0)
#define PG8_LDB(dst, b, h) do { _Pragma("unroll") for (int n = 0; n < 2; ++n) { if constexpr (FP8) { dst##8[n] = *(const LAS v8i*)(lds + PG8_SB(b, h) + boff + n * 2048); } \
        else { _Pragma("unroll") for (int k = 0; k < 2; ++k) dst[n][k] = *(const LAS bf16x8*)(lds + PG8_SB(b, h) + boff + n * 2048 + k * 1024); } } } while (0)
#define PG8_MMA(ai, bj, At, Bt) do { __builtin_amdgcn_s_setprio(1); _Pragma("unroll") for (int m = 0; m < 4; ++m) _Pragma("unroll") for (int n = 0; n < 2; ++n) { \
        if constexpr (FP8) asm volatile("v_mfma_scale_f32_16x16x128_f8f6f4 %0, %1, %2, %0, %3, %4 op_sel_hi:[0,0,0]" : "+v"(acc[ai][bj][m][n]) : "v"(Bt##8[n]), "v"(At##8[m]), "v"(scw_), "v"(sca_)); \
        else { _Pragma("unroll") for (int k = 0; k < 2; ++k) acc[ai][bj][m][n] = __builtin_amdgcn_mfma_f32_16x16x32_bf16(Bt[n][k], At[m][k], acc[ai][bj][m][n], 0, 0, 0); } } __builtin_amdgcn_s_setprio(0); } while (0)
#define PG8_WAIT_V(n) asm volatile("s_waitcnt vmcnt(" #n ")" ::: "memory")
#define PG8_WAIT_L(n) asm volatile("s_waitcnt lgkmcnt(" #n ")" ::: "memory")
#define PG8_BAR __builtin_amdgcn_s_barrier()
#define PG8_SCHED __builtin_amdgcn_sched_barrier(0)
    Unit cur, nxt; int ui = 0;
    if (!S.next(0, cur)) return;
    f32x4 acc[2][2][4][2];
#pragma unroll
    for (int a = 0; a < 2; ++a)
#pragma unroll
        for (int b = 0; b < 2; ++b)
#pragma unroll
            for (int m = 0; m < 4; ++m)
#pragma unroll
                for (int n = 0; n < 2; ++n) acc[a][b][m][n] = (f32x4){0.f, 0.f, 0.f, 0.f};
    const int scw_ = SCW, sca_ = SCA; (void)scw_; (void)sca_;
    bf16x8 At[4][2], B0[2][2], B1[2][2]; v8i At8[4], B08[2], B18[2]; (void)At; (void)B0; (void)B1; (void)At8; (void)B08; (void)B18;
    unsigned ao[2][2];
#pragma unroll
    for (int h = 0; h < 2; ++h)
#pragma unroll
        for (int i = 0; i < 2; ++i) ao[h][i] = S.a_off(cur, h, Rr[i]) + (unsigned)Cc[i];
    const char* cB = S.b_base(cur);
    PG8_STAGEB(PG8_SB(0, 0), cB); PG8_STAGEB(PG8_SB(0, 1), cB + hstepB); PG8_STAGEA(PG8_SA(0, 0), ao[0], 0u); PG8_STAGEA(PG8_SA(0, 1), ao[1], 0u);
    if (wr == 1) PG8_BAR;
    PG8_WAIT_V(2); PG8_BAR;
    PG8_STAGEB(PG8_SB(1, 0), cB + kstep); PG8_STAGEA(PG8_SA(1, 0), ao[0], kstep); PG8_STAGEB(PG8_SB(1, 1), cB + hstepB + kstep);
    PG8_WAIT_V(6); PG8_BAR;
    for (;;) {
        const bool has_next = S.next(ui + 1, nxt);
        const char* nB = has_next ? S.b_base(nxt) : cB;
#pragma unroll 1
        for (int t = 0; t < nt; t += 2) {
            const bool last = (t == nt - 2);
            const unsigned kb1 = (unsigned)(t + 1) * kstep, kb2 = (unsigned)(t + 2) * kstep;
            unsigned x2[2][2];
#pragma unroll
            for (int h = 0; h < 2; ++h)
#pragma unroll
                for (int i = 0; i < 2; ++i) x2[h][i] = last ? (has_next ? (S.a_off(nxt, h, Rr[i]) + (unsigned)Cc[i]) : ao[h][i]) : ao[h][i] + kb2;
            const char* b2 = last ? nB : cB + kb2; const char* b3 = b2 + kstep;
            PG8_LDB(B0, 0, 0); PG8_LDB(B1, 0, 1); PG8_SCHED; PG8_LDA(At, 0, 0); PG8_STAGEA(PG8_SA(1, 1), ao[1], kb1);
            PG8_WAIT_V(8); PG8_WAIT_L(0); PG8_BAR; PG8_MMA(0, 0, At, B0); PG8_MMA(0, 1, At, B1); PG8_BAR; PG8_SCHED;
            PG8_LDA(At, 0, 1); PG8_STAGEB(PG8_SB(0, 0), b2); PG8_STAGEB(PG8_SB(0, 1), b2 + hstepB); PG8_STAGEA(PG8_SA(0, 0), x2[0], 0u);
            PG8_WAIT_V(8); PG8_WAIT_L(0); PG8_BAR; PG8_MMA(1, 0, At, B0); PG8_MMA(1, 1, At, B1); PG8_BAR; PG8_SCHED;
            PG8_LDB(B0, 1, 0); PG8_LDB(B1, 1, 1); PG8_SCHED; PG8_LDA(At, 1, 0); PG8_STAGEA(PG8_SA(0, 1), x2[1], 0u);
            PG8_WAIT_V(8); PG8_WAIT_L(0); PG8_BAR; PG8_MMA(0, 0, At, B0); PG8_MMA(0, 1, At, B1); PG8_BAR; PG8_SCHED;
            PG8_LDA(At, 1, 1); PG8_STAGEB(PG8_SB(1, 0), b3); PG8_STAGEB(PG8_SB(1, 1), b3 + hstepB); PG8_STAGEA(PG8_SA(1, 0), x2[0], kstep);
            PG8_WAIT_V(8); PG8_WAIT_L(0); PG8_BAR; PG8_MMA(1, 0, At, B0); PG8_MMA(1, 1, At, B1); PG8_BAR; PG8_SCHED;
        }
        if (wr == 0) PG8_BAR;
        if constexpr (FP8) asm volatile("s_nop 15" ::: "memory");
        E(acc, cur, wr, wc, fr, fq);
        if (!has_next) break;
#pragma unroll
        for (int a = 0; a < 2; ++a)
#pragma unroll
            for (int b = 0; b < 2; ++b)
#pragma unroll
                for (int m = 0; m < 4; ++m)
#pragma unroll
                    for (int n = 0; n < 2; ++n) acc[a][b][m][n] = (f32x4){0.f, 0.f, 0.f, 0.f};
        cur = nxt; cB = nB; ++ui;
#pragma unroll
        for (int h = 0; h < 2; ++h)
#pragma unroll
            for (int i = 0; i < 2; ++i) ao[h][i] = S.a_off(cur, h, Rr[i]) + (unsigned)Cc[i];
        if (wr == 1) PG8_BAR;
    }
    PG8_WAIT_V(0);
    PG8_BAR;
#undef PG8_SA
#undef PG8_SB
#undef PG8_STAGEA
#undef PG8_STAGEB
#undef PG8_LDA
#undef PG8_LDB
#undef PG8_MMA
#undef PG8_WAIT_V
#undef PG8_WAIT_L
#undef PG8_BAR
#undef PG8_SCHED
}
}

constexpr int NWAVES = 8, NTHR = 512;
struct Frame {
    LAS unsigned char* lds;
    int tid, lane, wave, G, gw, NGW;
    unsigned* ctl;
    unsigned char* ws;
};

DI void transpose_item(const float* Wseg, int ldw, int ncols, int K, bf16_t* WT, int row_off, LAS float* scr, int item, int lane) {
    const int nblk = ncols / 32, kb = item / nblk, nb = item % nblk, k0 = 64 * kb, n0 = 32 * nb;
#pragma unroll 8
    for (int i = 0; i < 32; ++i) { const int kk = 2 * i + (lane >> 5); scr[kk * 33 + (lane & 31)] = Wseg[(size_t)(k0 + kk) * ldw + n0 + (lane & 31)]; }
    LDS_WAIT(); asm volatile("" ::: "memory");
    const int c = lane & 7;
#pragma unroll
    for (int j = 0; j < 4; ++j) { const int n = (lane >> 3) + 8 * j; const LAS float* s = scr + (8 * c) * 33 + n;
        u32x4 o; o.x = pk2(s[0 * 33], s[1 * 33]); o.y = pk2(s[2 * 33], s[3 * 33]); o.z = pk2(s[4 * 33], s[5 * 33]); o.w = pk2(s[6 * 33], s[7 * 33]);
        *(u32x4*)(WT + (size_t)(row_off + n0 + n) * K + k0 + 8 * c) = o; }
    LDS_WAIT(); asm volatile("" ::: "memory");
}

DI void transpose_item8(const float* Wseg, int ldw, int ncols, int K, unsigned char* WT, int row_off, LAS float* scr, int item, int lane, float qs) {
    const int nblk = ncols / 32, kb = item / nblk, nb = item % nblk, k0 = 128 * kb, n0 = 32 * nb;
    const float* wp = Wseg + (size_t)(k0 + (lane >> 5)) * ldw + n0 + (lane & 31);
#pragma unroll
    for (int hb = 0; hb < 2; ++hb) { float v[32];
#pragma unroll
        for (int i = 0; i < 32; ++i) v[i] = wp[(size_t)(64 * hb + 2 * i) * ldw];
#pragma unroll
        for (int i = 0; i < 32; ++i) scr[(64 * hb + 2 * i + (lane >> 5)) * 33 + (lane & 31)] = v[i] * qs; }
    LDS_WAIT(); asm volatile("" ::: "memory");
    const int n = lane >> 1, hf = lane & 1; const LAS float* sp = scr + (64 * hf) * 33 + n;
    unsigned char* dst = WT + (size_t)(row_off + n0 + n) * K + k0 + 64 * hf;
#pragma unroll
    for (int q = 0; q < 4; ++q) { u32x4 o;
        o.x = pk4fp8(sp[(16 * q + 0) * 33], sp[(16 * q + 1) * 33], sp[(16 * q + 2) * 33], sp[(16 * q + 3) * 33]); o.y = pk4fp8(sp[(16 * q + 4) * 33], sp[(16 * q + 5) * 33], sp[(16 * q + 6) * 33], sp[(16 * q + 7) * 33]);
        o.z = pk4fp8(sp[(16 * q + 8) * 33], sp[(16 * q + 9) * 33], sp[(16 * q + 10) * 33], sp[(16 * q + 11) * 33]); o.w = pk4fp8(sp[(16 * q + 12) * 33], sp[(16 * q + 13) * 33], sp[(16 * q + 14) * 33], sp[(16 * q + 15) * 33]);
        *(u32x4*)(dst + 16 * q) = o; }
    LDS_WAIT(); asm volatile("" ::: "memory");
}
DI void p0_weights(Frame& F, const float* const* in) {
    LAS float* scr = (LAS float*)(F.lds + F.wave * 16896);
    bf16_t* win0 = (bf16_t*)(F.ws + WS_WIN0); bf16_t* wout0 = (bf16_t*)(F.ws + WS_WOUT0); bf16_t* win1 = (bf16_t*)(F.ws + WS_WIN1); bf16_t* wout1 = (bf16_t*)(F.ws + WS_WOUT1);
    const float* ewin = in[3]; const float* ewout = in[9]; const float* owin = in[10]; const float* owout = in[14];
    constexpr int KB = D / 64;
    constexpr int I_A = KB * (2048 / 32), I_B = KB * (2048 / 32), I_8 = (D / 128) * (2048 / 32);
    constexpr int I_O0 = (4096 / 64) * (D / 32), I_I1 = (D / 128) * (ODD_IN / 32), I_O1 = (D / 128) * (D / 32);
    constexpr int NIT = I_A + I_B + 2 * I_8 + 2 * I_A + I_O0 + I_I1 + I_O1;
    unsigned char* win8 = F.ws + AUX_WIN8;
    for (int it = F.gw; it < NIT; it += F.NGW) {
        int r = it;
        if (r < I_A) { transpose_item(ewin + 0, EVEN_IN, 2048, D, win0, C_RQ, scr, r, F.lane); continue; } r -= I_A;
        if (r < I_B) { transpose_item(ewin + 6144, EVEN_IN, 2048, D, win0, C_GQKV, scr, r, F.lane); continue; } r -= I_B;
        if (r < I_8) { transpose_item8(ewin + 2048, EVEN_IN, 2048, D, win8, C_RV, scr, r, F.lane, 32.f); continue; } r -= I_8;
        if (r < I_8) { transpose_item8(ewin + 8192, EVEN_IN, 2048, D, win8, C_GQKV + 2048, scr, r, F.lane, 32.f); continue; } r -= I_8;
        if (r < I_A) { transpose_item(ewin + 4096, EVEN_IN, 2048, D, win0, C_RG, scr, r, F.lane); continue; } r -= I_A;
        if (r < I_A) { transpose_item(ewin + 10240, EVEN_IN, 2048, D, win0, C_GZ, scr, r, F.lane); continue; } r -= I_A;
        if (r < I_O0) { transpose_item(ewout, D, D, 4096, wout0, 0, scr, r, F.lane); continue; } r -= I_O0;
        if (r < I_I1) { transpose_item8(owin, ODD_IN, ODD_IN, D, (unsigned char*)win1, 0, scr, r, F.lane, 32.f); continue; } r -= I_I1;
        transpose_item8(owout, D, D, D, (unsigned char*)wout1, 0, scr, r, F.lane, 32.f);
    }
    bf16_t* swh = (bf16_t*)(F.ws + AUX_SW); bf16_t* swl = swh + 112 * D;
    const int gt = (F.gw * 64 + F.lane), NGT = F.NGW * 64;
    for (int i = gt; i < 112 * D; i += NGT) { const int c = i / D, k = i % D; float v;
        if (c < 16) v = ewin[(size_t)k * EVEN_IN + 12288 + c] * in[1][k];
        else { const int l = (c - 16) / 48, cc = (c - 16) % 48; const float gn = in[2][l * D + k]; v = cc < 4 ? in[15][(size_t)l * D * 4 + k * 4 + cc] * gn : (cc < 36 ? in[16][(size_t)l * D * 32 + k * 32 + (cc - 4)] * gn : 0.f); }
        const unsigned hb = f2bf(v); const float lo = v - __builtin_bit_cast(float, hb << 16); swh[i] = (bf16_t)hb; swl[i] = (bf16_t)f2bf(lo); }
    f32x2* cs = (f32x2*)(F.ws + AUX_CS);
    for (int i = gt; i < SEQ * 64; i += NGT) { const int pos = i >> 6, fi = i & 63; double inv = 1.0;
        for (int q = 0; q < fi; ++q) inv *= ROPE_R;
        const double x = (double)pos * inv, k = __builtin_rint(x * 0.15915494309189535), r = (x - k * 6.283185307179586) - k * 2.4492935982947064e-16;
        const float rf = (float)r; const f32x2 v = {cosf(rf), sinf(rf)}; cs[i] = v; if ((fi & 1) == 0) ((f32x2*)(F.ws + AUX_CS32))[pos * 32 + (fi >> 1)] = v; }
}
DI void convert_experts(Frame& F, const float* const* in, int l, unsigned char* gu, unsigned char* dn, int widx, int nw) {
    LAS float* scr = (LAS float*)(F.lds + F.wave * 16896);
    const float* wg = in[17] + (size_t)l * NEXP * D * FF; const float* wu = in[18] + (size_t)l * NEXP * D * FF; const float* wd = in[19] + (size_t)l * NEXP * FF * D;
    constexpr int I_G = (D / 128) * (128 / 32);
    constexpr int I_GU = NEXP * 6 * 2 * I_G;
    constexpr int I_DE = (FF / 128) * (D / 32);
    constexpr int NIT = I_GU + NEXP * I_DE;
    for (int it = widx; it < NIT; it += nw) {
        if (it < I_GU) { const int seg = it / I_G, r = it % I_G, e = seg / 12, s = seg % 12, pn = s >> 1, isup = s & 1;
            const float* src = (isup ? wu : wg) + (size_t)e * D * FF + pn * 128;
            transpose_item8(src, FF, 128, D, gu + (size_t)e * 1536 * D, pn * 256 + isup * 128, scr, r, F.lane, 64.f); }
        else { const int r2 = it - I_GU, e = r2 / I_DE, r = r2 % I_DE;
            transpose_item8(wd + (size_t)e * FF * D, D, D, FF, dn + (size_t)e * D * FF, 0, scr, r, F.lane, 32.f); }
    }
}

template <int NP, bool ADDY, bool WRITEX, bool WRITEH, class Handler, bool H8 = false, bool SRC16 = false, bool DST16 = false>
DI void norm_pass(Frame& F, const void* src, void* dst, const bf16_t* y, const unsigned* asg, const LAS int* tb, const float* gain, const float* Wt, bf16_t* H, Handler hnd) {
    for (int m = F.gw; m < NTOK; m += F.NGW) {
        f32x4 v[8];
        if (SRC16) { const u32x2* xr = (const u32x2*)((const bf16_t*)src + (size_t)m * D) + F.lane;
#pragma unroll
            for (int j = 0; j < 8; ++j) { const u32x2 b = xr[64 * j]; v[j] = (f32x4){bflo(b.x), bfhi(b.x), bflo(b.y), bfhi(b.y)}; } }
        else { const f32x4* xr = (const f32x4*)((const float*)src + (size_t)m * D) + F.lane;
#pragma unroll
            for (int j = 0; j < 8; ++j) v[j] = xr[64 * j]; }
        if (ADDY) {
            const unsigned a0 = asg[2 * m], a1 = asg[2 * m + 1];
            const size_t r0 = (size_t)tb[a0 >> 16] * 256 + (a0 & 0xffffu), r1 = (size_t)tb[a1 >> 16] * 256 + (a1 & 0xffffu);
            const unsigned* y0 = (const unsigned*)((const unsigned char*)y + r0 * D) + F.lane; const unsigned* y1 = (const unsigned*)((const unsigned char*)y + r1 * D) + F.lane;
#pragma unroll
            for (int j = 0; j < 8; ++j) { const int p = (int)y0[64 * j], q = (int)y1[64 * j];
                v[j].x += (__builtin_amdgcn_cvt_f32_fp8(p, 0) + __builtin_amdgcn_cvt_f32_fp8(q, 0)) * 0.0625f; v[j].y += (__builtin_amdgcn_cvt_f32_fp8(p, 1) + __builtin_amdgcn_cvt_f32_fp8(q, 1)) * 0.0625f;
                v[j].z += (__builtin_amdgcn_cvt_f32_fp8(p, 2) + __builtin_amdgcn_cvt_f32_fp8(q, 2)) * 0.0625f; v[j].w += (__builtin_amdgcn_cvt_f32_fp8(p, 3) + __builtin_amdgcn_cvt_f32_fp8(q, 3)) * 0.0625f; }
        }
        if (WRITEX) {
            if (DST16) { u32x2* xo = (u32x2*)((bf16_t*)dst + (size_t)m * D) + F.lane;
#pragma unroll
                for (int j = 0; j < 8; ++j) { u32x2 w; w.x = pk2(v[j].x, v[j].y); w.y = pk2(v[j].z, v[j].w); xo[64 * j] = w;
                    if (WRITEH) v[j] = (f32x4){bflo(w.x), bfhi(w.x), bflo(w.y), bfhi(w.y)}; } }
            else { f32x4* xo = (f32x4*)((float*)dst + (size_t)m * D) + F.lane;
#pragma unroll
                for (int j = 0; j < 8; ++j) xo[64 * j] = v[j]; } }
        if (WRITEH) {
            float s = 0.f;
#pragma unroll
            for (int j = 0; j < 8; ++j) s += (v[j].x * v[j].x + v[j].y * v[j].y) + (v[j].z * v[j].z + v[j].w * v[j].w);
            const float rstd = 1.0f / sqrtf(wave_sum(s) * (1.0f / D) + EPS);
            const f32x4* gr = (const f32x4*)gain + F.lane;
#pragma unroll
            for (int j = 0; j < 8; ++j) v[j] = v[j] * rstd * gr[64 * j];
            if (H8) { unsigned* ho8 = (unsigned*)((unsigned char*)H + (size_t)m * D) + F.lane;
#pragma unroll
                for (int j = 0; j < 8; ++j) ho8[64 * j] = pk4fp8(v[j].x * 4.f, v[j].y * 4.f, v[j].z * 4.f, v[j].w * 4.f); }
            else {
            u32x2* ho = (u32x2*)(H + (size_t)m * D) + F.lane;
#pragma unroll
            for (int j = 0; j < 8; ++j) { u32x2 w; w.x = pk2(v[j].x, v[j].y); w.y = pk2(v[j].z, v[j].w); ho[64 * j] = w; } }
            if constexpr (NP > 0) {
                float res = 0.f;
#pragma unroll 1
                for (int c0 = 0; c0 < NP; c0 += 4) {
                    float a[4];
#pragma unroll
                    for (int cc = 0; cc < 4; ++cc) { const f32x4* wr = (const f32x4*)(Wt + (size_t)(c0 + cc) * D) + F.lane; a[cc] = 0.f;
#pragma unroll
                        for (int j = 0; j < 8; ++j) { const f32x4 w = wr[64 * j]; a[cc] += (v[j].x * w.x + v[j].y * w.y) + (v[j].z * w.z + v[j].w * w.w); } }
#pragma unroll
                    for (int cc = 0; cc < 4; ++cc) { const float t = wave_sum(a[cc]); res = (F.lane == c0 + cc) ? t : res; }
                }
                hnd(m, res);
            }
        }
    }
}


struct XTileF { f32x4 f[8][2]; };
struct XTileB { u32x4 p[8]; };
template <bool XB> struct XTileSel { typedef XTileF T; };
template <> struct XTileSel<true> { typedef XTileB T; };
DI void xget(const XTileF& t, int i, f32x4& xa, f32x4& xb) { xa = t.f[i][0]; xb = t.f[i][1]; }
DI void xget(const XTileB& t, int i, f32x4& xa, f32x4& xb) { const u32x4 b = t.p[i]; xa = (f32x4){bflo(b.x), bfhi(b.x), bflo(b.y), bfhi(b.y)}; xb = (f32x4){bflo(b.z), bfhi(b.z), bflo(b.w), bfhi(b.w)}; }
DI void xtile_load(Frame& F, XTileB& xr, const void* x, int tile) {
    const u32x4* xp = (const u32x4*)((const bf16_t*)x + ((size_t)tile * 16 + (F.lane & 15)) * D + 256 * F.wave + 8 * (F.lane >> 4));
#pragma unroll
    for (int i = 0; i < 8; ++i) xr.p[i] = xp[4 * i];
}
DI void xtile_load(Frame& F, XTileF& xr, const void* x, int tile) {
    const f32x4* xp = (const f32x4*)((const float*)x + ((size_t)tile * 16 + (F.lane & 15)) * D + 256 * F.wave + 8 * (F.lane >> 4));
#pragma unroll
    for (int i = 0; i < 8; ++i) { xr.f[i][0] = xp[8 * i]; xr.f[i][1] = xp[8 * i + 1]; }
}
template <bool XB, class T> DI void xsplit(const T& t, int i, const f32x4& xa, const f32x4& xb, bf16x8& xh, bf16x8& xl) {
    if constexpr (XB) { xh = __builtin_bit_cast(bf16x8, t.p[i]); xl = xh; }
    else { u32x4 hw; hw.x = pkbf(xa.x, xa.y); hw.y = pkbf(xa.z, xa.w); hw.z = pkbf(xb.x, xb.y); hw.w = pkbf(xb.z, xb.w);
        u32x4 lw; lw.x = pkbf(xa.x - bflo(hw.x), xa.y - bfhi(hw.x)); lw.y = pkbf(xa.z - bflo(hw.y), xa.w - bfhi(hw.y)); lw.z = pkbf(xb.x - bflo(hw.z), xb.y - bfhi(hw.z)); lw.w = pkbf(xb.z - bflo(hw.w), xb.w - bfhi(hw.w));
        xh = __builtin_bit_cast(bf16x8, hw); xl = __builtin_bit_cast(bf16x8, lw); }
}
constexpr int NP_GAIN_OFF = 65536 + 8192;
template <int MODE, bool XB>
DI void normproj_tile(Frame& F, const typename XTileSel<XB>::T& xr, typename XTileSel<XB>::T& xn, const void* x, int ntile, int tile, int tl, int par, const bf16_t* Wh, const bf16_t* Wl, bf16_t* H, float* bg, float dtb, float nea) {
    constexpr int NT = MODE == 0 ? 1 : 3;
    int lane_o = F.lane; asm volatile("" : "+v"(lane_o));
    const int lane = lane_o, r = lane & 15, kq = lane >> 4, w = F.wave;
    LAS float* ssp = (LAS float*)(F.lds + par * 32768);
    LAS f32x4* lp = (LAS f32x4*)(F.lds + par * 32768 + 1024);
    LAS float* lg = (LAS float*)(F.lds + par * 32768 + 1024 + 24576);
    LAS f32x4* sel = (LAS f32x4*)(F.lds + 65536);
    const size_t tok0 = (size_t)tile * 16;
    f32x4 acc[NT];
#pragma unroll
    for (int nt = 0; nt < NT; ++nt) acc[nt] = (f32x4){0.f, 0.f, 0.f, 0.f};
    float ss = 0.f;
    if constexpr (NT == 3) {
        u32x4 q0_0_0, q0_0_1, q0_1_0, q0_1_1, q0_2_0, q0_2_1, q1_0_0, q1_0_1, q1_1_0, q1_1_1, q1_2_0, q1_2_1, q2_0_0, q2_0_1, q2_1_0, q2_1_1, q2_2_0, q2_2_1, q3_0_0, q3_0_1, q3_1_0, q3_1_1, q3_2_0, q3_2_1;
        const unsigned char* wp0_0 = (const unsigned char*)(Wh + (size_t)(0 + r) * D + 256 * w + 8 * kq); const unsigned char* wp0_1 = (const unsigned char*)(Wl + (size_t)(0 + r) * D + 256 * w + 8 * kq);
        const unsigned char* wp1_0 = (const unsigned char*)(Wh + (size_t)(16 + r) * D + 256 * w + 8 * kq); const unsigned char* wp1_1 = (const unsigned char*)(Wl + (size_t)(16 + r) * D + 256 * w + 8 * kq);
        const unsigned char* wp2_0 = (const unsigned char*)(Wh + (size_t)(32 + r) * D + 256 * w + 8 * kq); const unsigned char* wp2_1 = (const unsigned char*)(Wl + (size_t)(32 + r) * D + 256 * w + 8 * kq);
        asm volatile("global_load_dwordx4 %0, %1, off" : "=v"(q0_0_0) : "v"(wp0_0) : "memory"); asm volatile("global_load_dwordx4 %0, %1, off offset:64" : "=v"(q1_0_0) : "v"(wp0_0) : "memory"); asm volatile("global_load_dwordx4 %0, %1, off" : "=v"(q0_0_1) : "v"(wp0_1) : "memory"); asm volatile("global_load_dwordx4 %0, %1, off offset:64" : "=v"(q1_0_1) : "v"(wp0_1) : "memory"); asm volatile("global_load_dwordx4 %0, %1, off" : "=v"(q0_1_0) : "v"(wp1_0) : "memory"); asm volatile("global_load_dwordx4 %0, %1, off offset:64" : "=v"(q1_1_0) : "v"(wp1_0) : "memory"); asm volatile("global_load_dwordx4 %0, %1, off" : "=v"(q0_1_1) : "v"(wp1_1) : "memory"); asm volatile("global_load_dwordx4 %0, %1, off offset:64" : "=v"(q1_1_1) : "v"(wp1_1) : "memory"); asm volatile("global_load_dwordx4 %0, %1, off" : "=v"(q0_2_0) : "v"(wp2_0) : "memory"); asm volatile("global_load_dwordx4 %0, %1, off offset:64" : "=v"(q1_2_0) : "v"(wp2_0) : "memory"); asm volatile("global_load_dwordx4 %0, %1, off" : "=v"(q0_2_1) : "v"(wp2_1) : "memory"); asm volatile("global_load_dwordx4 %0, %1, off offset:64" : "=v"(q1_2_1) : "v"(wp2_1) : "memory");
        asm volatile("global_load_dwordx4 %0, %1, off offset:128" : "=v"(q2_0_0) : "v"(wp0_0) : "memory"); asm volatile("global_load_dwordx4 %0, %1, off offset:192" : "=v"(q3_0_0) : "v"(wp0_0) : "memory"); asm volatile("global_load_dwordx4 %0, %1, off offset:128" : "=v"(q2_0_1) : "v"(wp0_1) : "memory"); asm volatile("global_load_dwordx4 %0, %1, off offset:192" : "=v"(q3_0_1) : "v"(wp0_1) : "memory"); asm volatile("global_load_dwordx4 %0, %1, off offset:128" : "=v"(q2_1_0) : "v"(wp1_0) : "memory"); asm volatile("global_load_dwordx4 %0, %1, off offset:192" : "=v"(q3_1_0) : "v"(wp1_0) : "memory"); asm volatile("global_load_dwordx4 %0, %1, off offset:128" : "=v"(q2_1_1) : "v"(wp1_1) : "memory"); asm volatile("global_load_dwordx4 %0, %1, off offset:192" : "=v"(q3_1_1) : "v"(wp1_1) : "memory"); asm volatile("global_load_dwordx4 %0, %1, off offset:128" : "=v"(q2_2_0) : "v"(wp2_0) : "memory"); asm volatile("global_load_dwordx4 %0, %1, off offset:192" : "=v"(q3_2_0) : "v"(wp2_0) : "memory"); asm volatile("global_load_dwordx4 %0, %1, off offset:128" : "=v"(q2_2_1) : "v"(wp2_1) : "memory"); asm volatile("global_load_dwordx4 %0, %1, off offset:192" : "=v"(q3_2_1) : "v"(wp2_1) : "memory");
        asm volatile("s_waitcnt vmcnt(13)" : "+v"(q0_0_0), "+v"(q0_0_1), "+v"(q0_1_0), "+v"(q0_1_1), "+v"(q0_2_0), "+v"(q0_2_1));
        { f32x4 xa, xb; xget(xr, 0, xa, xb); constexpr int XI = 0;
          ss += ((xa.x * xa.x + xa.y * xa.y) + (xa.z * xa.z + xa.w * xa.w)) + ((xb.x * xb.x + xb.y * xb.y) + (xb.z * xb.z + xb.w * xb.w));
          bf16x8 xh, xl; xsplit<XB>(xr, XI, xa, xb, xh, xl);
          { const bf16x8 wh = __builtin_bit_cast(bf16x8, q0_0_0), wl = __builtin_bit_cast(bf16x8, q0_0_1); acc[0] = mfma16(xh, wh, acc[0]); acc[0] = mfma16(xh, wl, acc[0]); if constexpr (!XB) acc[0] = mfma16(xl, wh, acc[0]); }
          { const bf16x8 wh = __builtin_bit_cast(bf16x8, q0_1_0), wl = __builtin_bit_cast(bf16x8, q0_1_1); acc[1] = mfma16(xh, wh, acc[1]); acc[1] = mfma16(xh, wl, acc[1]); if constexpr (!XB) acc[1] = mfma16(xl, wh, acc[1]); }
          { const bf16x8 wh = __builtin_bit_cast(bf16x8, q0_2_0), wl = __builtin_bit_cast(bf16x8, q0_2_1); acc[2] = mfma16(xh, wh, acc[2]); acc[2] = mfma16(xh, wl, acc[2]); if constexpr (!XB) acc[2] = mfma16(xl, wh, acc[2]); }
        }
        asm volatile("s_waitcnt vmcnt(12)" : "+v"(q1_0_0), "+v"(q1_0_1), "+v"(q1_1_0), "+v"(q1_1_1), "+v"(q1_2_0), "+v"(q1_2_1));
        { f32x4 xa, xb; xget(xr, 1, xa, xb); constexpr int XI = 1;
          ss += ((xa.x * xa.x + xa.y * xa.y) + (xa.z * xa.z + xa.w * xa.w)) + ((xb.x * xb.x + xb.y * xb.y) + (xb.z * xb.z + xb.w * xb.w));
          bf16x8 xh, xl; xsplit<XB>(xr, XI, xa, xb, xh, xl);
          { const bf16x8 wh = __builtin_bit_cast(bf16x8, q1_0_0), wl = __builtin_bit_cast(bf16x8, q1_0_1); acc[0] = mfma16(xh, wh, acc[0]); acc[0] = mfma16(xh, wl, acc[0]); if constexpr (!XB) acc[0] = mfma16(xl, wh, acc[0]); }
          { const bf16x8 wh = __builtin_bit_cast(bf16x8, q1_1_0), wl = __builtin_bit_cast(bf16x8, q1_1_1); acc[1] = mfma16(xh, wh, acc[1]); acc[1] = mfma16(xh, wl, acc[1]); if constexpr (!XB) acc[1] = mfma16(xl, wh, acc[1]); }
          { const bf16x8 wh = __builtin_bit_cast(bf16x8, q1_2_0), wl = __builtin_bit_cast(bf16x8, q1_2_1); acc[2] = mfma16(xh, wh, acc[2]); acc[2] = mfma16(xh, wl, acc[2]); if constexpr (!XB) acc[2] = mfma16(xl, wh, acc[2]); }
        }
        asm volatile("" :: "v"(acc[0]));
        asm volatile("global_load_dwordx4 %0, %1, off offset:256" : "=v"(q0_0_0) : "v"(wp0_0) : "memory"); asm volatile("global_load_dwordx4 %0, %1, off offset:320" : "=v"(q1_0_0) : "v"(wp0_0) : "memory"); asm volatile("global_load_dwordx4 %0, %1, off offset:256" : "=v"(q0_0_1) : "v"(wp0_1) : "memory"); asm volatile("global_load_dwordx4 %0, %1, off offset:320" : "=v"(q1_0_1) : "v"(wp0_1) : "memory"); asm volatile("global_load_dwordx4 %0, %1, off offset:256" : "=v"(q0_1_0) : "v"(wp1_0) : "memory"); asm volatile("global_load_dwordx4 %0, %1, off offset:320" : "=v"(q1_1_0) : "v"(wp1_0) : "memory"); asm volatile("global_load_dwordx4 %0, %1, off offset:256" : "=v"(q0_1_1) : "v"(wp1_1) : "memory"); asm volatile("global_load_dwordx4 %0, %1, off offset:320" : "=v"(q1_1_1) : "v"(wp1_1) : "memory"); asm volatile("global_load_dwordx4 %0, %1, off offset:256" : "=v"(q0_2_0) : "v"(wp2_0) : "memory"); asm volatile("global_load_dwordx4 %0, %1, off offset:320" : "=v"(q1_2_0) : "v"(wp2_0) : "memory"); asm volatile("global_load_dwordx4 %0, %1, off offset:256" : "=v"(q0_2_1) : "v"(wp2_1) : "memory"); asm volatile("global_load_dwordx4 %0, %1, off offset:320" : "=v"(q1_2_1) : "v"(wp2_1) : "memory");
        asm volatile("s_waitcnt vmcnt(13)" : "+v"(q2_0_0), "+v"(q2_0_1), "+v"(q2_1_0), "+v"(q2_1_1), "+v"(q2_2_0), "+v"(q2_2_1));
        { f32x4 xa, xb; xget(xr, 2, xa, xb); constexpr int XI = 2;
          ss += ((xa.x * xa.x + xa.y * xa.y) + (xa.z * xa.z + xa.w * xa.w)) + ((xb.x * xb.x + xb.y * xb.y) + (xb.z * xb.z + xb.w * xb.w));
          bf16x8 xh, xl; xsplit<XB>(xr, XI, xa, xb, xh, xl);
          { const bf16x8 wh = __builtin_bit_cast(bf16x8, q2_0_0), wl = __builtin_bit_cast(bf16x8, q2_0_1); acc[0] = mfma16(xh, wh, acc[0]); acc[0] = mfma16(xh, wl, acc[0]); if constexpr (!XB) acc[0] = mfma16(xl, wh, acc[0]); }
          { const bf16x8 wh = __builtin_bit_cast(bf16x8, q2_1_0), wl = __builtin_bit_cast(bf16x8, q2_1_1); acc[1] = mfma16(xh, wh, acc[1]); acc[1] = mfma16(xh, wl, acc[1]); if constexpr (!XB) acc[1] = mfma16(xl, wh, acc[1]); }
          { const bf16x8 wh = __builtin_bit_cast(bf16x8, q2_2_0), wl = __builtin_bit_cast(bf16x8, q2_2_1); acc[2] = mfma16(xh, wh, acc[2]); acc[2] = mfma16(xh, wl, acc[2]); if constexpr (!XB) acc[2] = mfma16(xl, wh, acc[2]); }
        }
        asm volatile("s_waitcnt vmcnt(12)" : "+v"(q3_0_0), "+v"(q3_0_1), "+v"(q3_1_0), "+v"(q3_1_1), "+v"(q3_2_0), "+v"(q3_2_1));
        { f32x4 xa, xb; xget(xr, 3, xa, xb); constexpr int XI = 3;
          ss += ((xa.x * xa.x + xa.y * xa.y) + (xa.z * xa.z + xa.w * xa.w)) + ((xb.x * xb.x + xb.y * xb.y) + (xb.z * xb.z + xb.w * xb.w));
          bf16x8 xh, xl; xsplit<XB>(xr, XI, xa, xb, xh, xl);
          { const bf16x8 wh = __builtin_bit_cast(bf16x8, q3_0_0), wl = __builtin_bit_cast(bf16x8, q3_0_1); acc[0] = mfma16(xh, wh, acc[0]); acc[0] = mfma16(xh, wl, acc[0]); if constexpr (!XB) acc[0] = mfma16(xl, wh, acc[0]); }
          { const bf16x8 wh = __builtin_bit_cast(bf16x8, q3_1_0), wl = __builtin_bit_cast(bf16x8, q3_1_1); acc[1] = mfma16(xh, wh, acc[1]); acc[1] = mfma16(xh, wl, acc[1]); if constexpr (!XB) acc[1] = mfma16(xl, wh, acc[1]); }
          { const bf16x8 wh = __builtin_bit_cast(bf16x8, q3_2_0), wl = __builtin_bit_cast(bf16x8, q3_2_1); acc[2] = mfma16(xh, wh, acc[2]); acc[2] = mfma16(xh, wl, acc[2]); if constexpr (!XB) acc[2] = mfma16(xl, wh, acc[2]); }
        }
        asm volatile("" :: "v"(acc[0]));
        asm volatile("global_load_dwordx4 %0, %1, off offset:384" : "=v"(q2_0_0) : "v"(wp0_0) : "memory"); asm volatile("global_load_dwordx4 %0, %1, off offset:448" : "=v"(q3_0_0) : "v"(wp0_0) : "memory"); asm volatile("global_load_dwordx4 %0, %1, off offset:384" : "=v"(q2_0_1) : "v"(wp0_1) : "memory"); asm volatile("global_load_dwordx4 %0, %1, off offset:448" : "=v"(q3_0_1) : "v"(wp0_1) : "memory"); asm volatile("global_load_dwordx4 %0, %1, off offset:384" : "=v"(q2_1_0) : "v"(wp1_0) : "memory"); asm volatile("global_load_dwordx4 %0, %1, off offset:448" : "=v"(q3_1_0) : "v"(wp1_0) : "memory"); asm volatile("global_load_dwordx4 %0, %1, off offset:384" : "=v"(q2_1_1) : "v"(wp1_1) : "memory"); asm volatile("global_load_dwordx4 %0, %1, off offset:448" : "=v"(q3_1_1) : "v"(wp1_1) : "memory"); asm volatile("global_load_dwordx4 %0, %1, off offset:384" : "=v"(q2_2_0) : "v"(wp2_0) : "memory"); asm volatile("global_load_dwordx4 %0, %1, off offset:448" : "=v"(q3_2_0) : "v"(wp2_0) : "memory"); asm volatile("global_load_dwordx4 %0, %1, off offset:384" : "=v"(q2_2_1) : "v"(wp2_1) : "memory"); asm volatile("global_load_dwordx4 %0, %1, off offset:448" : "=v"(q3_2_1) : "v"(wp2_1) : "memory");
        asm volatile("s_waitcnt vmcnt(13)" : "+v"(q0_0_0), "+v"(q0_0_1), "+v"(q0_1_0), "+v"(q0_1_1), "+v"(q0_2_0), "+v"(q0_2_1));
        { f32x4 xa, xb; xget(xr, 4, xa, xb); constexpr int XI = 4;
          ss += ((xa.x * xa.x + xa.y * xa.y) + (xa.z * xa.z + xa.w * xa.w)) + ((xb.x * xb.x + xb.y * xb.y) + (xb.z * xb.z + xb.w * xb.w));
          bf16x8 xh, xl; xsplit<XB>(xr, XI, xa, xb, xh, xl);
          { const bf16x8 wh = __builtin_bit_cast(bf16x8, q0_0_0), wl = __builtin_bit_cast(bf16x8, q0_0_1); acc[0] = mfma16(xh, wh, acc[0]); acc[0] = mfma16(xh, wl, acc[0]); if constexpr (!XB) acc[0] = mfma16(xl, wh, acc[0]); }
          { const bf16x8 wh = __builtin_bit_cast(bf16x8, q0_1_0), wl = __builtin_bit_cast(bf16x8, q0_1_1); acc[1] = mfma16(xh, wh, acc[1]); acc[1] = mfma16(xh, wl, acc[1]); if constexpr (!XB) acc[1] = mfma16(xl, wh, acc[1]); }
          { const bf16x8 wh = __builtin_bit_cast(bf16x8, q0_2_0), wl = __builtin_bit_cast(bf16x8, q0_2_1); acc[2] = mfma16(xh, wh, acc[2]); acc[2] = mfma16(xh, wl, acc[2]); if constexpr (!XB) acc[2] = mfma16(xl, wh, acc[2]); }
        }
        asm volatile("s_waitcnt vmcnt(12)" : "+v"(q1_0_0), "+v"(q1_0_1), "+v"(q1_1_0), "+v"(q1_1_1), "+v"(q1_2_0), "+v"(q1_2_1));
        { f32x4 xa, xb; xget(xr, 5, xa, xb); constexpr int XI = 5;
          ss += ((xa.x * xa.x + xa.y * xa.y) + (xa.z * xa.z + xa.w * xa.w)) + ((xb.x * xb.x + xb.y * xb.y) + (xb.z * xb.z + xb.w * xb.w));
          bf16x8 xh, xl; xsplit<XB>(xr, XI, xa, xb, xh, xl);
          { const bf16x8 wh = __builtin_bit_cast(bf16x8, q1_0_0), wl = __builtin_bit_cast(bf16x8, q1_0_1); acc[0] = mfma16(xh, wh, acc[0]); acc[0] = mfma16(xh, wl, acc[0]); if constexpr (!XB) acc[0] = mfma16(xl, wh, acc[0]); }
          { const bf16x8 wh = __builtin_bit_cast(bf16x8, q1_1_0), wl = __builtin_bit_cast(bf16x8, q1_1_1); acc[1] = mfma16(xh, wh, acc[1]); acc[1] = mfma16(xh, wl, acc[1]); if constexpr (!XB) acc[1] = mfma16(xl, wh, acc[1]); }
          { const bf16x8 wh = __builtin_bit_cast(bf16x8, q1_2_0), wl = __builtin_bit_cast(bf16x8, q1_2_1); acc[2] = mfma16(xh, wh, acc[2]); acc[2] = mfma16(xh, wl, acc[2]); if constexpr (!XB) acc[2] = mfma16(xl, wh, acc[2]); }
        }
        asm volatile("s_waitcnt vmcnt(1)" : "+v"(q2_0_0), "+v"(q2_0_1), "+v"(q2_1_0), "+v"(q2_1_1), "+v"(q2_2_0), "+v"(q2_2_1));
        { f32x4 xa, xb; xget(xr, 6, xa, xb); constexpr int XI = 6;
          ss += ((xa.x * xa.x + xa.y * xa.y) + (xa.z * xa.z + xa.w * xa.w)) + ((xb.x * xb.x + xb.y * xb.y) + (xb.z * xb.z + xb.w * xb.w));
          bf16x8 xh, xl; xsplit<XB>(xr, XI, xa, xb, xh, xl);
          { const bf16x8 wh = __builtin_bit_cast(bf16x8, q2_0_0), wl = __builtin_bit_cast(bf16x8, q2_0_1); acc[0] = mfma16(xh, wh, acc[0]); acc[0] = mfma16(xh, wl, acc[0]); if constexpr (!XB) acc[0] = mfma16(xl, wh, acc[0]); }
          { const bf16x8 wh = __builtin_bit_cast(bf16x8, q2_1_0), wl = __builtin_bit_cast(bf16x8, q2_1_1); acc[1] = mfma16(xh, wh, acc[1]); acc[1] = mfma16(xh, wl, acc[1]); if constexpr (!XB) acc[1] = mfma16(xl, wh, acc[1]); }
          { const bf16x8 wh = __builtin_bit_cast(bf16x8, q2_2_0), wl = __builtin_bit_cast(bf16x8, q2_2_1); acc[2] = mfma16(xh, wh, acc[2]); acc[2] = mfma16(xh, wl, acc[2]); if constexpr (!XB) acc[2] = mfma16(xl, wh, acc[2]); }
        }
        asm volatile("s_waitcnt vmcnt(0)" : "+v"(q3_0_0), "+v"(q3_0_1), "+v"(q3_1_0), "+v"(q3_1_1), "+v"(q3_2_0), "+v"(q3_2_1));
        { f32x4 xa, xb; xget(xr, 7, xa, xb); constexpr int XI = 7;
          ss += ((xa.x * xa.x + xa.y * xa.y) + (xa.z * xa.z + xa.w * xa.w)) + ((xb.x * xb.x + xb.y * xb.y) + (xb.z * xb.z + xb.w * xb.w));
          bf16x8 xh, xl; xsplit<XB>(xr, XI, xa, xb, xh, xl);
          { const bf16x8 wh = __builtin_bit_cast(bf16x8, q3_0_0), wl = __builtin_bit_cast(bf16x8, q3_0_1); acc[0] = mfma16(xh, wh, acc[0]); acc[0] = mfma16(xh, wl, acc[0]); if constexpr (!XB) acc[0] = mfma16(xl, wh, acc[0]); }
          { const bf16x8 wh = __builtin_bit_cast(bf16x8, q3_1_0), wl = __builtin_bit_cast(bf16x8, q3_1_1); acc[1] = mfma16(xh, wh, acc[1]); acc[1] = mfma16(xh, wl, acc[1]); if constexpr (!XB) acc[1] = mfma16(xl, wh, acc[1]); }
          { const bf16x8 wh = __builtin_bit_cast(bf16x8, q3_2_0), wl = __builtin_bit_cast(bf16x8, q3_2_1); acc[2] = mfma16(xh, wh, acc[2]); acc[2] = mfma16(xh, wl, acc[2]); if constexpr (!XB) acc[2] = mfma16(xl, wh, acc[2]); }
        }
    } else {
        u32x4 q0_0_0, q0_0_1, q1_0_0, q1_0_1, q2_0_0, q2_0_1, q3_0_0, q3_0_1;
        const unsigned char* wp0_0 = (const unsigned char*)(Wh + (size_t)(0 + r) * D + 256 * w + 8 * kq); const unsigned char* wp0_1 = (const unsigned char*)(Wl + (size_t)(0 + r) * D + 256 * w + 8 * kq);
        asm volatile("global_load_dwordx4 %0, %1, off" : "=v"(q0_0_0) : "v"(wp0_0) : "memory"); asm volatile("global_load_dwordx4 %0, %1, off offset:64" : "=v"(q1_0_0) : "v"(wp0_0) : "memory"); asm volatile("global_load_dwordx4 %0, %1, off" : "=v"(q0_0_1) : "v"(wp0_1) : "memory"); asm volatile("global_load_dwordx4 %0, %1, off offset:64" : "=v"(q1_0_1) : "v"(wp0_1) : "memory");
        asm volatile("global_load_dwordx4 %0, %1, off offset:128" : "=v"(q2_0_0) : "v"(wp0_0) : "memory"); asm volatile("global_load_dwordx4 %0, %1, off offset:192" : "=v"(q3_0_0) : "v"(wp0_0) : "memory"); asm volatile("global_load_dwordx4 %0, %1, off offset:128" : "=v"(q2_0_1) : "v"(wp0_1) : "memory"); asm volatile("global_load_dwordx4 %0, %1, off offset:192" : "=v"(q3_0_1) : "v"(wp0_1) : "memory");
        asm volatile("s_waitcnt vmcnt(5)" : "+v"(q0_0_0), "+v"(q0_0_1));
        { f32x4 xa, xb; xget(xr, 0, xa, xb); constexpr int XI = 0;
          ss += ((xa.x * xa.x + xa.y * xa.y) + (xa.z * xa.z + xa.w * xa.w)) + ((xb.x * xb.x + xb.y * xb.y) + (xb.z * xb.z + xb.w * xb.w));
          bf16x8 xh, xl; xsplit<XB>(xr, XI, xa, xb, xh, xl);
          { const bf16x8 wh = __builtin_bit_cast(bf16x8, q0_0_0), wl = __builtin_bit_cast(bf16x8, q0_0_1); acc[0] = mfma16(xh, wh, acc[0]); acc[0] = mfma16(xh, wl, acc[0]); if constexpr (!XB) acc[0] = mfma16(xl, wh, acc[0]); }
        }
        asm volatile("s_waitcnt vmcnt(4)" : "+v"(q1_0_0), "+v"(q1_0_1));
        { f32x4 xa, xb; xget(xr, 1, xa, xb); constexpr int XI = 1;
          ss += ((xa.x * xa.x + xa.y * xa.y) + (xa.z * xa.z + xa.w * xa.w)) + ((xb.x * xb.x + xb.y * xb.y) + (xb.z * xb.z + xb.w * xb.w));
          bf16x8 xh, xl; xsplit<XB>(xr, XI, xa, xb, xh, xl);
          { const bf16x8 wh = __builtin_bit_cast(bf16x8, q1_0_0), wl = __builtin_bit_cast(bf16x8, q1_0_1); acc[0] = mfma16(xh, wh, acc[0]); acc[0] = mfma16(xh, wl, acc[0]); if constexpr (!XB) acc[0] = mfma16(xl, wh, acc[0]); }
        }
        asm volatile("" :: "v"(acc[0]));
        asm volatile("global_load_dwordx4 %0, %1, off offset:256" : "=v"(q0_0_0) : "v"(wp0_0) : "memory"); asm volatile("global_load_dwordx4 %0, %1, off offset:320" : "=v"(q1_0_0) : "v"(wp0_0) : "memory"); asm volatile("global_load_dwordx4 %0, %1, off offset:256" : "=v"(q0_0_1) : "v"(wp0_1) : "memory"); asm volatile("global_load_dwordx4 %0, %1, off offset:320" : "=v"(q1_0_1) : "v"(wp0_1) : "memory");
        asm volatile("s_waitcnt vmcnt(5)" : "+v"(q2_0_0), "+v"(q2_0_1));
        { f32x4 xa, xb; xget(xr, 2, xa, xb); constexpr int XI = 2;
          ss += ((xa.x * xa.x + xa.y * xa.y) + (xa.z * xa.z + xa.w * xa.w)) + ((xb.x * xb.x + xb.y * xb.y) + (xb.z * xb.z + xb.w * xb.w));
          bf16x8 xh, xl; xsplit<XB>(xr, XI, xa, xb, xh, xl);
          { const bf16x8 wh = __builtin_bit_cast(bf16x8, q2_0_0), wl = __builtin_bit_cast(bf16x8, q2_0_1); acc[0] = mfma16(xh, wh, acc[0]); acc[0] = mfma16(xh, wl, acc[0]); if constexpr (!XB) acc[0] = mfma16(xl, wh, acc[0]); }
        }
        asm volatile("s_waitcnt vmcnt(4)" : "+v"(q3_0_0), "+v"(q3_0_1));
        { f32x4 xa, xb; xget(xr, 3, xa, xb); constexpr int XI = 3;
          ss += ((xa.x * xa.x + xa.y * xa.y) + (xa.z * xa.z + xa.w * xa.w)) + ((xb.x * xb.x + xb.y * xb.y) + (xb.z * xb.z + xb.w * xb.w));
          bf16x8 xh, xl; xsplit<XB>(xr, XI, xa, xb, xh, xl);
          { const bf16x8 wh = __builtin_bit_cast(bf16x8, q3_0_0), wl = __builtin_bit_cast(bf16x8, q3_0_1); acc[0] = mfma16(xh, wh, acc[0]); acc[0] = mfma16(xh, wl, acc[0]); if constexpr (!XB) acc[0] = mfma16(xl, wh, acc[0]); }
        }
        asm volatile("" :: "v"(acc[0]));
        asm volatile("global_load_dwordx4 %0, %1, off offset:384" : "=v"(q2_0_0) : "v"(wp0_0) : "memory"); asm volatile("global_load_dwordx4 %0, %1, off offset:448" : "=v"(q3_0_0) : "v"(wp0_0) : "memory"); asm volatile("global_load_dwordx4 %0, %1, off offset:384" : "=v"(q2_0_1) : "v"(wp0_1) : "memory"); asm volatile("global_load_dwordx4 %0, %1, off offset:448" : "=v"(q3_0_1) : "v"(wp0_1) : "memory");
        asm volatile("s_waitcnt vmcnt(5)" : "+v"(q0_0_0), "+v"(q0_0_1));
        { f32x4 xa, xb; xget(xr, 4, xa, xb); constexpr int XI = 4;
          ss += ((xa.x * xa.x + xa.y * xa.y) + (xa.z * xa.z + xa.w * xa.w)) + ((xb.x * xb.x + xb.y * xb.y) + (xb.z * xb.z + xb.w * xb.w));
          bf16x8 xh, xl; xsplit<XB>(xr, XI, xa, xb, xh, xl);
          { const bf16x8 wh = __builtin_bit_cast(bf16x8, q0_0_0), wl = __builtin_bit_cast(bf16x8, q0_0_1); acc[0] = mfma16(xh, wh, acc[0]); acc[0] = mfma16(xh, wl, acc[0]); if constexpr (!XB) acc[0] = mfma16(xl, wh, acc[0]); }
        }
        asm volatile("s_waitcnt vmcnt(4)" : "+v"(q1_0_0), "+v"(q1_0_1));
        { f32x4 xa, xb; xget(xr, 5, xa, xb); constexpr int XI = 5;
          ss += ((xa.x * xa.x + xa.y * xa.y) + (xa.z * xa.z + xa.w * xa.w)) + ((xb.x * xb.x + xb.y * xb.y) + (xb.z * xb.z + xb.w * xb.w));
          bf16x8 xh, xl; xsplit<XB>(xr, XI, xa, xb, xh, xl);
          { const bf16x8 wh = __builtin_bit_cast(bf16x8, q1_0_0), wl = __builtin_bit_cast(bf16x8, q1_0_1); acc[0] = mfma16(xh, wh, acc[0]); acc[0] = mfma16(xh, wl, acc[0]); if constexpr (!XB) acc[0] = mfma16(xl, wh, acc[0]); }
        }
        asm volatile("s_waitcnt vmcnt(1)" : "+v"(q2_0_0), "+v"(q2_0_1));
        { f32x4 xa, xb; xget(xr, 6, xa, xb); constexpr int XI = 6;
          ss += ((xa.x * xa.x + xa.y * xa.y) + (xa.z * xa.z + xa.w * xa.w)) + ((xb.x * xb.x + xb.y * xb.y) + (xb.z * xb.z + xb.w * xb.w));
          bf16x8 xh, xl; xsplit<XB>(xr, XI, xa, xb, xh, xl);
          { const bf16x8 wh = __builtin_bit_cast(bf16x8, q2_0_0), wl = __builtin_bit_cast(bf16x8, q2_0_1); acc[0] = mfma16(xh, wh, acc[0]); acc[0] = mfma16(xh, wl, acc[0]); if constexpr (!XB) acc[0] = mfma16(xl, wh, acc[0]); }
        }
        asm volatile("s_waitcnt vmcnt(0)" : "+v"(q3_0_0), "+v"(q3_0_1));
        { f32x4 xa, xb; xget(xr, 7, xa, xb); constexpr int XI = 7;
          ss += ((xa.x * xa.x + xa.y * xa.y) + (xa.z * xa.z + xa.w * xa.w)) + ((xb.x * xb.x + xb.y * xb.y) + (xb.z * xb.z + xb.w * xb.w));
          bf16x8 xh, xl; xsplit<XB>(xr, XI, xa, xb, xh, xl);
          { const bf16x8 wh = __builtin_bit_cast(bf16x8, q3_0_0), wl = __builtin_bit_cast(bf16x8, q3_0_1); acc[0] = mfma16(xh, wh, acc[0]); acc[0] = mfma16(xh, wl, acc[0]); if constexpr (!XB) acc[0] = mfma16(xl, wh, acc[0]); }
        }
    }
    asm volatile("" ::: "memory");
    if (ntile >= 0) xtile_load(F, xn, x, ntile);
    ss += __shfl_xor(ss, 16); ss += __shfl_xor(ss, 32);
    if (lane < 16) ssp[w * 16 + lane] = ss;
#pragma unroll
    for (int nt = 0; nt < NT; ++nt) lp[(w * NT + nt) * 64 + lane] = acc[nt];
    __syncthreads();
    float tot = 0.f;
#pragma unroll
    for (int q = 0; q < 8; ++q) tot += ssp[q * 16 + r];
    const float rstd = 1.0f / sqrtf(tot * (1.0f / D) + EPS);
    { const LAS f32x4* gp = (const LAS f32x4*)(F.lds + NP_GAIN_OFF) + 64 * w + 2 * kq; bf16_t* hp = H + (tok0 + r) * D + 256 * w + 8 * kq;
#pragma unroll
      for (int i = 0; i < 8; ++i) { const f32x4 ga = gp[8 * i], gb = gp[8 * i + 1]; f32x4 xa, xb; xget(xr, i, xa, xb); xa = xa * rstd; xb = xb * rstd;
        if (MODE == 1) { u32x2 o; o.x = pk4fp8(xa.x * ga.x * 4.f, xa.y * ga.y * 4.f, xa.z * ga.z * 4.f, xa.w * ga.w * 4.f); o.y = pk4fp8(xb.x * gb.x * 4.f, xb.y * gb.y * 4.f, xb.z * gb.z * 4.f, xb.w * gb.w * 4.f);
            *(u32x2*)((unsigned char*)H + (tok0 + r) * D + 256 * w + 8 * kq + 32 * i) = o; }
        else { u32x4 o; o.x = pkbf(xa.x * ga.x, xa.y * ga.y); o.y = pkbf(xa.z * ga.z, xa.w * ga.w); o.z = pkbf(xb.x * gb.x, xb.y * gb.y); o.w = pkbf(xb.z * gb.z, xb.w * gb.w);
            *(u32x4*)(hp + 32 * i) = o;
            u32x2 o8; o8.x = pk4fp8(xa.x * ga.x * 4.f, xa.y * ga.y * 4.f, xa.z * ga.z * 4.f, xa.w * ga.w * 4.f); o8.y = pk4fp8(xb.x * gb.x * 4.f, xb.y * gb.y * 4.f, xb.z * gb.z * 4.f, xb.w * gb.w * 4.f);
            *(u32x2*)(F.ws + AUX_H8 + (tok0 + r) * D + 256 * w + 8 * kq + 32 * i) = o8; } } }
    if (w == 0) {
        float rs[4];
#pragma unroll
        for (int q = 0; q < 4; ++q) rs[q] = __shfl(rstd, 4 * kq + q);
        f32x4 tl4[NT];
#pragma unroll
        for (int nt = 0; nt < NT; ++nt) { tl4[nt] = lp[nt * 64 + lane];
#pragma unroll
            for (int q = 1; q < 8; ++q) tl4[nt] += lp[(q * NT + nt) * 64 + lane]; }
        if (MODE == 0) {
#pragma unroll
            for (int q = 0; q < 4; ++q) { const float v = tl4[0][q] * rs[q]; float o;
                if (r < 8) o = 1.0f / (1.0f + __expf(-v)); else { const float z = v + dtb; const float sp = z > 20.f ? z : log1pf(__expf(z)); o = nea * sp; }
                bg[(tok0 + 4 * kq + q) * 16 + r] = o; }
        } else {
#pragma unroll
            for (int nt = 0; nt < NT; ++nt)
#pragma unroll
                for (int q = 0; q < 4; ++q) lg[(4 * kq + q) * 48 + 16 * nt + r] = tl4[nt][q] * rs[q];
            LDS_WAIT();
            if (lane < 16) {
                const LAS float* p = lg + lane * 48;
                int g = 0; float gm = p[0];
#pragma unroll
                for (int j = 1; j < 4; ++j) { const float v = p[j]; if (v > gm) { gm = v; g = j; } }
                float gs = 0.f;
#pragma unroll
                for (int j = 0; j < 4; ++j) gs += __expf(p[j] - gm);
                const float g_p = 1.0f / gs;
                float q8[8];
#pragma unroll
                for (int i = 0; i < 8; ++i) q8[i] = p[4 + 8 * g + i];
                int i0 = 0; float m0 = q8[0];
#pragma unroll
                for (int i = 1; i < 8; ++i) if (q8[i] > m0) { m0 = q8[i]; i0 = i; }
                int i1 = -1; float m1 = -3.0e38f;
#pragma unroll
                for (int i = 0; i < 8; ++i) if (i != i0 && q8[i] > m1) { m1 = q8[i]; i1 = i; }
                if (i1 < 0) i1 = (i0 + 1) & 7;
                const float e1 = __expf(m1 - m0), w0 = g_p / (1.0f + e1), w1 = g_p * e1 / (1.0f + e1);
                sel[tl * 16 + lane] = (f32x4){__builtin_bit_cast(float, g * 8 + i0), __builtin_bit_cast(float, g * 8 + i1), w0, w1};
            }
        }
    }
}
template <int MODE, bool XB = false>
DI void normproj_pass(Frame& F, const void* x, const float* gain, const bf16_t* Wh, const bf16_t* Wl, bf16_t* H, float* bg, const float* a_log, const float* dt_bias, unsigned* cnt, int* list, float* gw, unsigned* asg) {
    constexpr int NTILE = NTOK / 16;
    typename XTileSel<XB>::T xa, xb;
    int tile = blockIdx.x, tl = 0;
    if (tile < NTILE) xtile_load(F, xa, x, tile);
    ((LAS f32x4*)(F.lds + NP_GAIN_OFF))[F.tid] = ((const f32x4*)gain)[F.tid];
    float dtb = 0.f, nea = 0.f;
    if (MODE == 0) { const int r8 = (F.lane & 15) - 8; if (r8 >= 0) { dtb = dt_bias[r8]; nea = -__expf(a_log[r8]); } }
    __syncthreads();
    while (tile < NTILE) {
        normproj_tile<MODE, XB>(F, xa, xb, x, tile + F.G < NTILE ? tile + F.G : -1, tile, tl, tl & 1, Wh, Wl, H, bg, dtb, nea);
        tile += F.G; ++tl;
        if (tile >= NTILE) break;
        normproj_tile<MODE, XB>(F, xb, xa, x, tile + F.G < NTILE ? tile + F.G : -1, tile, tl, tl & 1, Wh, Wl, H, bg, dtb, nea);
        tile += F.G; ++tl;
    }
    __syncthreads();
    if (MODE == 1 && F.wave == 0) {
        LAS f32x4* sel = (LAS f32x4*)(F.lds + 65536); LAS unsigned* hist = (LAS unsigned*)(F.lds + 65536 + 4096); LAS unsigned* base = hist + 32;
        const int lane = F.lane;
        if (lane < 32) hist[lane] = 0u;
        LDS_WAIT();
        const int ntok = tl * 16;
        unsigned rk[8]; int ee[8]; float ww[8]; int mm[8];
#pragma unroll
        for (int q = 0; q < 8; ++q) { const int a = lane + 64 * q;
            ee[q] = -1; if ((a >> 1) < ntok) { const f32x4 sv = sel[a >> 1]; ee[q] = __builtin_bit_cast(int, (a & 1) ? sv.y : sv.x); ww[q] = (a & 1) ? sv.w : sv.z;
                mm[q] = (blockIdx.x + ((a >> 1) >> 4) * F.G) * 16 + ((a >> 1) & 15); rk[q] = __hip_atomic_fetch_add(hist + ee[q], 1u, __ATOMIC_RELAXED, __HIP_MEMORY_SCOPE_WORKGROUP); } }
        LDS_WAIT();
        if (lane < 32) { const unsigned c = hist[lane]; base[lane] = c ? __hip_atomic_fetch_add(cnt + lane * CSTR, c, __ATOMIC_RELAXED, __HIP_MEMORY_SCOPE_AGENT) : 0u; }
        LDS_WAIT();
#pragma unroll
        for (int q = 0; q < 8; ++q) if (ee[q] >= 0) { const unsigned pos = base[ee[q]] + rk[q]; const int a = lane + 64 * q;
            list[ee[q] * 65536 + pos] = mm[q]; gw[ee[q] * 65536 + pos] = ww[q]; asg[2 * mm[q] + (a & 1)] = ((unsigned)ee[q] << 16) | pos; }
    }
    __syncthreads();
}

DI unsigned dpp_ror8(unsigned v) { return (unsigned)__builtin_amdgcn_mov_dpp((int)v, 0x128, 0xf, 0xf, true); }
DI void p2_prep(Frame& F, const float* conv_w) {
    bf16_t* pj = (bf16_t*)(F.ws + WS_BIG + BIG_PJ);
    const f32x2* cs = (const f32x2*)(F.ws + AUX_CS);
    bf16_t* qn = (bf16_t*)(F.ws + AUX_QN); bf16_t* kn = (bf16_t*)(F.ws + AUX_KN); bf16_t* vc = (bf16_t*)(F.ws + AUX_VC);
    const int lane = F.lane, l16 = lane & 15;
    for (int grp = F.gw; grp < NTOK / 16; grp += F.NGW) {
        const int m0 = grp * 16, pos0 = m0 & (SEQ - 1);
#pragma unroll 1
        for (int j = 0; j < 8; ++j) { const int ch = 512 * j + 8 * lane;
            f32x4 w[4][2];
#pragma unroll
            for (int tp = 0; tp < 4; ++tp) { w[tp][0] = *(const f32x4*)(conv_w + tp * 4096 + ch); w[tp][1] = *(const f32x4*)(conv_w + tp * 4096 + ch + 4); }
            u32x4 rr[19];
#pragma unroll
            for (int q = 0; q < 19; ++q) { const int dp = pos0 - 3 + q; rr[q] = (u32x4){0u, 0u, 0u, 0u}; if (dp >= 0) rr[q] = *(const u32x4*)(pj + (size_t)(m0 - 3 + q) * PJW + C_GQKV + ch); }
#pragma unroll
            for (int tt = 0; tt < 16; ++tt) { float a[8];
#pragma unroll
                for (int e = 0; e < 8; ++e) a[e] = 0.f;
#pragma unroll
                for (int tp = 0; tp < 4; ++tp) { const u32x4 r = rr[tt + tp];
                    a[0] += bflo(r.x) * w[tp][0].x; a[1] += bfhi(r.x) * w[tp][0].y; a[2] += bflo(r.y) * w[tp][0].z; a[3] += bfhi(r.y) * w[tp][0].w; a[4] += bflo(r.z) * w[tp][1].x; a[5] += bfhi(r.z) * w[tp][1].y; a[6] += bflo(r.w) * w[tp][1].z; a[7] += bfhi(r.w) * w[tp][1].w; }
                float ss = 0.f;
#pragma unroll
                for (int e = 0; e < 8; ++e) { a[e] = siluf(a[e]); ss += a[e] * a[e]; }
                if (j < 4) { ss += __shfl_xor(ss, 1); ss += __shfl_xor(ss, 2); ss += __shfl_xor(ss, 4); ss += __shfl_xor(ss, 8);
                    const float sc = (1.0f / sqrtf(ss + EPS)) * (j < 2 ? 0.08838834764831845f : 1.0f);
#pragma unroll
                    for (int e = 0; e < 8; ++e) a[e] *= sc; }
                u32x4 o; o.x = pk2(a[0], a[1]); o.y = pk2(a[2], a[3]); o.z = pk2(a[4], a[5]); o.w = pk2(a[6], a[7]);
                const size_t m = (size_t)(m0 + tt);
                bf16_t* dst = j < 2 ? qn + m * 1024 + ch : (j < 4 ? kn + m * 1024 + (ch - 1024) : vc + m * 2048 + (ch - 2048));
                *(u32x4*)dst = o; }
        }
    }
}

constexpr int TB = 16;
template <bool GDN>
DI void p3_recurrence(Frame& F, int u  ) {
    const int b = u >> 2, h = 2 * (u & 3) + (F.tid >> 8), e = F.tid & 255, hh = F.tid >> 8;
    bf16_t* pj = (bf16_t*)(F.ws + WS_BIG + BIG_PJ);
    const bf16_t* qsrc = GDN ? (const bf16_t*)(F.ws + AUX_QN) : pj + C_RQ; const bf16_t* ksrc = GDN ? (const bf16_t*)(F.ws + AUX_KN) : pj + C_RK;
    const int qld = GDN ? 1024 : PJW;
    bf16_t* vsrc = GDN ? (bf16_t*)(F.ws + AUX_VC) : pj + C_RV; const int vld = GDN ? 2048 : PJW;
    const float* bg = (const float*)(F.ws + AUX_BG);
    LAS float* qs = (LAS float*)F.lds;
    LAS float* ks = qs + 2 * TB * 128;
    LAS float* ab = ks + 2 * TB * 128;
    LAS float* vs = ab + 2 * TB * 2;
    float S[128];
#pragma unroll
    for (int d = 0; d < 128; ++d) S[d] = 0.f;
    const float gam = GDN ? 0.f : (1.0f - exp2f(-5.0f - (float)h));
    for (int t0 = 0; t0 < SEQ; t0 += TB) {
        const size_t r0 = (size_t)b * SEQ + t0;
        __syncthreads();
        for (int i = F.tid; i < 2 * TB * 128; i += NTHR) { const int h2 = i / (TB * 128), tt = (i / 128) % TB, d = i % 128; const int hd = 2 * (u & 3) + h2;
            qs[i] = bf2f(qsrc[(r0 + tt) * qld + hd * 128 + d]); ks[i] = bf2f(ksrc[(r0 + tt) * qld + hd * 128 + d]); }
        for (int i = F.tid; i < 2 * TB * 256; i += NTHR) { const int h2 = i / (TB * 256), tt = (i / 256) % TB, ee = i % 256; vs[i] = bf2f(vsrc[(r0 + tt) * vld + (2 * (u & 3) + h2) * 256 + ee]); }
        if (GDN && F.tid < 2 * TB) { const int h2 = F.tid / TB, tt = F.tid % TB, hd = 2 * (u & 3) + h2; ab[F.tid * 2] = __expf(bg[(r0 + tt) * 16 + 8 + hd]); ab[F.tid * 2 + 1] = bg[(r0 + tt) * 16 + hd]; }
        __syncthreads();
#pragma unroll 1
        for (int tt = 0; tt < TB; ++tt) {
            const LAS f32x4* q4 = (const LAS f32x4*)(qs + (hh * TB + tt) * 128); const LAS f32x4* k4 = (const LAS f32x4*)(ks + (hh * TB + tt) * 128);
            const float v = vs[(hh * TB + tt) * 256 + e];
            float o = 0.f;
            if (GDN) {
                const float a = ab[(hh * TB + tt) * 2], beta = ab[(hh * TB + tt) * 2 + 1];
                float ksum = 0.f;
#pragma unroll
                for (int d4 = 0; d4 < 32; ++d4) { if ((d4 & 7) == 0) asm volatile("" ::: "memory"); const f32x4 kk = k4[d4]; ksum += (kk.x * S[4 * d4] + kk.y * S[4 * d4 + 1]) + (kk.z * S[4 * d4 + 2] + kk.w * S[4 * d4 + 3]); }
                const float r = (v - a * ksum) * beta;
#pragma unroll
                for (int d4 = 0; d4 < 32; ++d4) { if ((d4 & 3) == 0) asm volatile("" ::: "memory"); const f32x4 kk = k4[d4], qq = q4[d4];
                    S[4 * d4] = a * S[4 * d4] + r * kk.x; S[4 * d4 + 1] = a * S[4 * d4 + 1] + r * kk.y; S[4 * d4 + 2] = a * S[4 * d4 + 2] + r * kk.z; S[4 * d4 + 3] = a * S[4 * d4 + 3] + r * kk.w;
                    o += (qq.x * S[4 * d4] + qq.y * S[4 * d4 + 1]) + (qq.z * S[4 * d4 + 2] + qq.w * S[4 * d4 + 3]); }
            } else {
#pragma unroll
                for (int d4 = 0; d4 < 32; ++d4) { if ((d4 & 3) == 0) asm volatile("" ::: "memory"); const f32x4 kk = k4[d4], qq = q4[d4];
                    S[4 * d4] = gam * S[4 * d4] + v * kk.x; S[4 * d4 + 1] = gam * S[4 * d4 + 1] + v * kk.y; S[4 * d4 + 2] = gam * S[4 * d4 + 2] + v * kk.z; S[4 * d4 + 3] = gam * S[4 * d4 + 3] + v * kk.w;
                    o += (qq.x * S[4 * d4] + qq.y * S[4 * d4 + 1]) + (qq.z * S[4 * d4 + 2] + qq.w * S[4 * d4 + 3]); }
            }
            vsrc[(r0 + tt) * vld + h * 256 + e] = (bf16_t)f2bf(o);
        }
    }
}


constexpr int NCH = SEQ / 64;
DI constexpr int rowoff4c(int i) { int a = 0; for (int k = 0; k < i; ++k) a += (k + 3) / 4; return a; }
typedef short s16x4 __attribute__((ext_vector_type(4)));
DI s16x4 tr_read(unsigned lds_addr) { s16x4 r; asm volatile("ds_read_b64_tr_b16 %0, %1\n\ts_waitcnt lgkmcnt(0)" : "=&v"(r) : "v"(lds_addr) : "memory"); return r; }
DI void tr_read4(unsigned a0, unsigned a1, unsigned a2, unsigned a3, s16x4& r0, s16x4& r1, s16x4& r2, s16x4& r3) {
    asm volatile("ds_read_b64_tr_b16 %0, %4\n\tds_read_b64_tr_b16 %1, %5\n\tds_read_b64_tr_b16 %2, %6\n\tds_read_b64_tr_b16 %3, %7\n\ts_waitcnt lgkmcnt(0)"
                 : "=&v"(r0), "=&v"(r1), "=&v"(r2), "=&v"(r3) : "v"(a0), "v"(a1), "v"(a2), "v"(a3) : "memory"); }
DI bf16x8 cat8(s16x4 a, s16x4 b) { return __builtin_shufflevector(a, b, 0, 1, 2, 3, 4, 5, 6, 7); }

DI void rope_pair(bf16x8& f1, bf16x8& f2, const f32x4* cp, float sc) {
    const f32x4 c0 = cp[0], c1 = cp[1], c2 = cp[2], c3 = cp[3];
    const float cs_[8] = {c0.x, c0.z, c1.x, c1.z, c2.x, c2.z, c3.x, c3.z}, sn_[8] = {c0.y, c0.w, c1.y, c1.w, c2.y, c2.w, c3.y, c3.w};
    const u32x4 a = __builtin_bit_cast(u32x4, f1), b = __builtin_bit_cast(u32x4, f2);
    const float x1[8] = {bflo(a.x), bfhi(a.x), bflo(a.y), bfhi(a.y), bflo(a.z), bfhi(a.z), bflo(a.w), bfhi(a.w)}, x2[8] = {bflo(b.x), bfhi(b.x), bflo(b.y), bfhi(b.y), bflo(b.z), bfhi(b.z), bflo(b.w), bfhi(b.w)};
    float y1[8], y2[8];
#pragma unroll
    for (int e = 0; e < 8; ++e) { y1[e] = (x1[e] * cs_[e] - x2[e] * sn_[e]) * sc; y2[e] = (x2[e] * cs_[e] + x1[e] * sn_[e]) * sc; }
    u32x4 o1, o2; o1.x = pk2(y1[0], y1[1]); o1.y = pk2(y1[2], y1[3]); o1.z = pk2(y1[4], y1[5]); o1.w = pk2(y1[6], y1[7]); o2.x = pk2(y2[0], y2[1]); o2.y = pk2(y2[2], y2[3]); o2.z = pk2(y2[4], y2[5]); o2.w = pk2(y2[6], y2[7]);
    f1 = __builtin_bit_cast(bf16x8, o1); f2 = __builtin_bit_cast(bf16x8, o2);
}
template <bool GDN>
DI void ga_unit(Frame& F, int unit, unsigned char* stream, float* out_f32_unused) {
    (void)out_f32_unused;
    constexpr int NF = GDN ? 56 : 40, OFF_W = 0, OFF_QG = GDN ? 16 : 0, OFF_ATT = OFF_QG + 16, OFF_KT = OFF_ATT + 8;
    int lane_o = F.lane; asm volatile("" : "+v"(lane_o));
    const int lane = lane_o, fr = lane & 15, g = lane >> 4;
    const int bh = unit / NCH, n = unit % NCH, b = bh >> 3, h = bh & 7;
    const size_t row0 = (size_t)b * SEQ + (size_t)n * 64;
    LAS unsigned char* L = F.lds + F.wave * GA_LDS_WAVE;
    LAS float* LAf = (LAS float*)L; LAS unsigned char* LA = L; LAS unsigned char* LT = L + 9216; LAS float* LG = (LAS float*)(L + 17408); LAS float* LB = LG + 64;
    const bf16_t* pj = (const bf16_t*)(F.ws + WS_BIG + BIG_PJ);
    const bf16_t* qsrc = GDN ? (const bf16_t*)(F.ws + AUX_QN) + h * 128 : pj + C_RQ + h * 128;
    const bf16_t* ksrc = GDN ? (const bf16_t*)(F.ws + AUX_KN) + h * 128 : pj + C_RK + h * 128;
    const size_t qld = GDN ? 1024 : PJW;
    unsigned char* st = stream + (size_t)unit * NF * 1024 + lane * 16;
    float gv, bv = 1.f;
    if (GDN) { const float* bg = (const float*)(F.ws + AUX_BG); gv = bg[(row0 + lane) * 16 + 8 + h]; bv = bg[(row0 + lane) * 16 + h];
#pragma unroll
        for (int o = 1; o < 64; o <<= 1) { const float t = __shfl_up(gv, o); if (lane >= o) gv += t; } }
    else gv = (float)(lane + 1) * log1pf(-exp2f(-5.0f - (float)h));
    const float gl = rdlane(gv, 63);
    LG[lane] = gv; LB[lane] = bv;
    LDS_WAIT();
    float gr[16], gcl[4], br[16];
#pragma unroll
    for (int t = 0; t < 4; ++t) { gcl[t] = LG[16 * t + fr];
#pragma unroll
        for (int r = 0; r < 4; ++r) { gr[t * 4 + r] = LG[16 * t + 4 * g + r]; br[t * 4 + r] = LB[16 * t + 4 * g + r]; } }
    bf16x8 Kf[4][4], Qf[4][4];
#pragma unroll
    for (int t = 0; t < 4; ++t)
#pragma unroll
        for (int s2 = 0; s2 < 4; ++s2) Kf[t][s2] = *(const bf16x8*)(ksrc + (row0 + 16 * t + fr) * qld + 32 * s2 + 8 * g);
    if (!GDN) {
        const f32x2* cs = (const f32x2*)(F.ws + AUX_CS);
#pragma unroll
        for (int t = 0; t < 4; ++t) { const f32x2* cr = cs + (size_t)((row0 + 16 * t + fr) & (SEQ - 1)) * 64 + 8 * g;
            rope_pair(Kf[t][0], Kf[t][2], (const f32x4*)cr, 0.08838834764831845f); rope_pair(Kf[t][1], Kf[t][3], (const f32x4*)(cr + 32), 0.08838834764831845f); }
    }
    if (GDN) {
#pragma unroll
        for (int it = 0; it < 4; ++it)
#pragma unroll
            for (int jt = 0; jt <= it; ++jt) { f32x4 acc = {0.f, 0.f, 0.f, 0.f};
#pragma unroll
                for (int s2 = 0; s2 < 4; ++s2) acc = mfma16(Kf[it][s2], Kf[jt][s2], acc);
#pragma unroll
                for (int r = 0; r < 4; ++r) { const int i = 16 * it + 4 * g + r, j = 16 * jt + fr; const int q = (i + 3) >> 2; const int ro = 2 * q * (q - 1) + q * (i - 4 * q + 3);
                    if (j < i) LAf[ro * 4 + j] = br[it * 4 + r] * acc[r] * __expf(gr[it * 4 + r] - gcl[jt]); } }
    }
    asm volatile("" ::: "memory");
#pragma unroll
    for (int it = 0; it < 4; ++it) {
        asm volatile("" ::: "memory");
#pragma unroll
        for (int s2 = 0; s2 < 4; ++s2) Qf[it][s2] = *(const bf16x8*)(qsrc + (row0 + 16 * it + fr) * qld + 32 * s2 + 8 * g);
        if (!GDN) { const f32x2* cr = (const f32x2*)(F.ws + AUX_CS) + (size_t)((row0 + 16 * it + fr) & (SEQ - 1)) * 64 + 8 * g;
            rope_pair(Qf[it][0], Qf[it][2], (const f32x4*)cr, 1.0f); rope_pair(Qf[it][1], Qf[it][3], (const f32x4*)(cr + 32), 1.0f);
#pragma unroll
            for (int s2 = 0; s2 < 4; ++s2) *(LAS bf16x8*)(L + (16 * it + fr) * 256 + (32 * s2 + 8 * g) * 2) = Qf[it][s2]; }
#pragma unroll
        for (int sp = 0; sp < 2; ++sp) { u32x4 w;
#pragma unroll
            for (int hf = 0; hf < 2; ++hf) { const int jt = 2 * sp + hf; float v[4] = {0.f, 0.f, 0.f, 0.f};
                if (jt <= it) { f32x4 acc = {0.f, 0.f, 0.f, 0.f};
#pragma unroll
                    for (int s2 = 0; s2 < 4; ++s2) acc = mfma16(Kf[jt][s2], Qf[it][s2], acc);
#pragma unroll
                    for (int r = 0; r < 4; ++r) { const int j = 16 * jt + 4 * g + r, i = 16 * it + fr; v[r] = (j <= i) ? acc[r] * __expf(gcl[it] - gr[jt * 4 + r]) : 0.f; } }
                if (hf == 0) { w.x = pk2(v[0], v[1]); w.y = pk2(v[2], v[3]); } else { w.z = pk2(v[0], v[1]); w.w = pk2(v[2], v[3]); } }
            *(u32x4*)(st + (OFF_ATT + it * 2 + sp) * 1024) = w; }
    }
    if (!GDN) LDS_WAIT();
    asm volatile("" ::: "memory");
#pragma unroll
    for (int it = 0; it < 4; ++it) { const float sc = __expf(gcl[it]); asm volatile("" ::: "memory");
#pragma unroll
        for (int s2 = 0; s2 < 4; ++s2) { const bf16_t* qp = qsrc + (row0 + 16 * it + fr) * qld + 32 * s2 + 4 * g; u32x2 lo, hi;
            if (GDN) { lo = *(const u32x2*)qp; hi = *(const u32x2*)(qp + 16); }
            else { const LAS unsigned char* lq = L + (16 * it + fr) * 256 + (32 * s2 + 4 * g) * 2; lo = *(const LAS u32x2*)lq; hi = *(const LAS u32x2*)(lq + 32); }
            u32x4 w; w.x = pk2(bflo(lo.x) * sc, bfhi(lo.x) * sc); w.y = pk2(bflo(lo.y) * sc, bfhi(lo.y) * sc); w.z = pk2(bflo(hi.x) * sc, bfhi(hi.x) * sc); w.w = pk2(bflo(hi.y) * sc, bfhi(hi.y) * sc);
            *(u32x4*)(st + (OFF_QG + it * 4 + s2) * 1024) = w; } }
    asm volatile("" ::: "memory");
    float t[64];
    float sw_ = 1.f, su_ = 1.f;
    if (GDN) {
        LDS_WAIT();
        const LAS f32x4* LA4 = (const LAS f32x4*)LA;
#pragma unroll
        for (int i = 0; i < 64; ++i) { float acc = (lane == i) ? 1.f : 0.f; if ((i & 1) == 0) asm volatile("" ::: "memory");
#pragma unroll
            for (int m4 = 0; m4 < (i + 3) / 4; ++m4) { const f32x4 l = LA4[rowoff4c(i) + m4];
                if (4 * m4 + 0 < i) acc -= l.x * t[4 * m4 + 0]; if (4 * m4 + 1 < i) acc -= l.y * t[4 * m4 + 1]; if (4 * m4 + 2 < i) acc -= l.z * t[4 * m4 + 2]; if (4 * m4 + 3 < i) acc -= l.w * t[4 * m4 + 3]; }
            t[i] = acc; }
        su_ = bv; sw_ = bv * __expf(gv);
        LDS_WAIT();
#pragma unroll
        for (int i = 0; i < 64; ++i) *(LAS bf16_t*)(LT + (i * 64 + lane) * 2) = (bf16_t)f2bf(t[i] * sw_);
    }
    asm volatile("" ::: "memory");
    float ksc[2][2][4];
#pragma unroll
    for (int sp = 0; sp < 2; ++sp)
#pragma unroll
        for (int tp = 0; tp < 2; ++tp)
#pragma unroll
            for (int e = 0; e < 4; ++e) ksc[sp][tp][e] = __expf(gl - LG[32 * sp + 16 * tp + 4 * g + e]);
    const unsigned la_addr = (unsigned)(size_t)LA, q4 = (unsigned)((lane & 15) >> 2), p4 = (unsigned)(lane & 3);
#pragma unroll 1
    for (int p = 0; p < 2; ++p) {
        LDS_WAIT();
#pragma unroll
        for (int k = 0; k < 8; ++k) { const int row = (lane >> 3) + 8 * k, pc = lane & 7; if (GDN) *(LAS u32x4*)(LA + row * 128 + pc * 16) = *(const u32x4*)(ksrc + (row0 + row) * qld + 64 * p + 8 * pc); }
        if (!GDN) {
#pragma unroll
            for (int t = 0; t < 4; ++t)
#pragma unroll
                for (int s2 = 0; s2 < 4; ++s2) if ((s2 >> 1) == p) *(LAS bf16x8*)(LA + (16 * t + fr) * 128 + (32 * (s2 & 1) + 8 * g) * 2) = Kf[t][s2]; }
        LDS_WAIT();
        if (GDN) {
#pragma unroll
            for (int it = 0; it < 4; ++it) { bf16x8 Tf[2];
#pragma unroll
                for (int ks = 0; ks < 2; ++ks) Tf[ks] = *(const LAS bf16x8*)(LT + ((16 * it + fr) * 64 + 32 * ks + 8 * g) * 2);
#pragma unroll
                for (int sl = 0; sl < 2; ++sl) { u32x4 w;
#pragma unroll
                    for (int hf = 0; hf < 2; ++hf) { const int dtl = 2 * sl + hf; f32x4 acc = {0.f, 0.f, 0.f, 0.f};
                        { s16x4 a0, a1, a2, a3; const unsigned ad = la_addr + (8 * g + q4) * 128 + dtl * 32 + p4 * 8; tr_read4(ad, ad + 4 * 128, ad + 32 * 128, ad + 36 * 128, a0, a1, a2, a3);
                          acc = mfma16(cat8(a0, a1), Tf[0], acc); acc = mfma16(cat8(a2, a3), Tf[1], acc); }
                        if (hf == 0) { w.x = pk2(-acc[0], -acc[1]); w.y = pk2(-acc[2], -acc[3]); } else { w.z = pk2(-acc[0], -acc[1]); w.w = pk2(-acc[2], -acc[3]); } }
                    *(u32x4*)(st + (OFF_W + it * 4 + 2 * p + sl) * 1024) = w; } }
        }
#pragma unroll
        for (int dtl = 0; dtl < 4; ++dtl) { s16x4 t0, t1, t2, t3; const unsigned ad = la_addr + (4 * g + q4) * 128 + dtl * 32 + p4 * 8; tr_read4(ad, ad + 16 * 128, ad + 32 * 128, ad + 48 * 128, t0, t1, t2, t3);
#pragma unroll
            for (int sp = 0; sp < 2; ++sp) { const s16x4 a0 = sp ? t2 : t0, a1 = sp ? t3 : t1;
                u32x4 w; w.x = pk2(bf2f((bf16_t)a0[0]) * ksc[sp][0][0], bf2f((bf16_t)a0[1]) * ksc[sp][0][1]); w.y = pk2(bf2f((bf16_t)a0[2]) * ksc[sp][0][2], bf2f((bf16_t)a0[3]) * ksc[sp][0][3]);
                w.z = pk2(bf2f((bf16_t)a1[0]) * ksc[sp][1][0], bf2f((bf16_t)a1[1]) * ksc[sp][1][1]); w.w = pk2(bf2f((bf16_t)a1[2]) * ksc[sp][1][2], bf2f((bf16_t)a1[3]) * ksc[sp][1][3]);
                *(u32x4*)(st + (OFF_KT + (4 * p + dtl) * 2 + sp) * 1024) = w; } }
    }
    if (GDN) {
        LDS_WAIT();
#pragma unroll
        for (int i = 0; i < 64; ++i) *(LAS bf16_t*)(LT + (i * 64 + lane) * 2) = (bf16_t)f2bf(t[i] * su_);
        const bf16_t* vsrc = (const bf16_t*)(F.ws + AUX_VC) + h * 256;
        unsigned char* ub = F.ws + WS_H + (size_t)unit * 32768 + lane * 32;
#pragma unroll 1
        for (int p = 0; p < 4; ++p) {
            LDS_WAIT();
#pragma unroll
            for (int k = 0; k < 8; ++k) { const int row = (lane >> 3) + 8 * k, pc = lane & 7; *(LAS u32x4*)(LA + row * 128 + pc * 16) = *(const u32x4*)(vsrc + (row0 + row) * 2048 + 64 * p + 8 * pc); }
            LDS_WAIT();
            bf16x8 Tf[4][2];
#pragma unroll
            for (int it = 0; it < 4; ++it)
#pragma unroll
                for (int ks = 0; ks < 2; ++ks) Tf[it][ks] = *(const LAS bf16x8*)(LT + ((16 * it + fr) * 64 + 32 * ks + 8 * g) * 2);
#pragma unroll
            for (int etl = 0; etl < 4; ++etl) { bf16x8 Vf[2];
                { s16x4 a0, a1, a2, a3; const unsigned ad = la_addr + (8 * g + q4) * 128 + etl * 32 + p4 * 8; tr_read4(ad, ad + 4 * 128, ad + 32 * 128, ad + 36 * 128, a0, a1, a2, a3); Vf[0] = cat8(a0, a1); Vf[1] = cat8(a2, a3); }
                u32x4 w0, w1;
#pragma unroll
                for (int it = 0; it < 4; ++it) { f32x4 acc = {0.f, 0.f, 0.f, 0.f};
#pragma unroll
                    for (int ks = 0; ks < 2; ++ks) acc = mfma16(Tf[it][ks], Vf[ks], acc);
                    const unsigned a = pk2(acc[0], acc[1]), c = pk2(acc[2], acc[3]);
                    if (it == 0) { w0.x = a; w0.y = c; } else if (it == 1) { w0.z = a; w0.w = c; } else if (it == 2) { w1.x = a; w1.y = c; } else { w1.z = a; w1.w = c; } }
                *(u32x4*)(ub + (4 * p + etl) * 2048) = w0; *(u32x4*)(ub + (4 * p + etl) * 2048 + 16) = w1; }
        }
        if (lane == 0) ((float*)(F.ws + AUX_DEC))[unit] = __expf(gl);
    }
    LDS_WAIT();
}

constexpr int XL_SLOT = 12288, XL_CNT = 2 * XL_SLOT;
template <bool GDN, int ROLE>
DI void scan_wave(Frame& F, int bh, int sl, const unsigned char* stream, LAS unsigned char* xl) {
    constexpr int NF = GDN ? 56 : 40;
    const int lane = F.lane, fr = lane & 15, g = lane >> 4, b = bh >> 3, h = bh & 7;
    const unsigned char* sp0 = stream + (size_t)bh * NCH * NF * 1024;
    const unsigned voff = (unsigned)lane * 16u;
    const size_t orow = (size_t)2048 * 2;
    const unsigned char* obu = (GDN ? F.ws + AUX_VC : F.ws + AUX_QN) + (size_t)b * SEQ * orow + (size_t)(h * 256 + 16 * sl) * 2;
    const unsigned ooff = (unsigned)((size_t)(4 * g) * orow) + (unsigned)fr * 2u;
    const size_t vrow = (size_t)PJW * 2;
    const unsigned char* vbu = F.ws + WS_BIG + BIG_PJ + (size_t)C_RV * 2 + (size_t)b * SEQ * vrow + (size_t)(h * 256 + 16 * sl) * 2;
    const unsigned voff2 = (unsigned)((size_t)(4 * g) * vrow) + (unsigned)fr * 2u;
    const float* decp = (const float*)(F.ws + AUX_DEC) + bh * NCH;
    float decr = 1.f; { const float gm = 1.0f - exp2f(-5.0f - (float)h); float d2 = gm * gm; d2 *= d2; d2 *= d2; d2 *= d2; d2 *= d2; d2 *= d2; decr = d2; }
    const unsigned char* ubp = F.ws + WS_H + (size_t)bh * NCH * 32768 + sl * 2048; const unsigned uoff = (unsigned)lane * 32u;
    const unsigned zoff = 0u; (void)decp; (void)decr; (void)ubp; (void)uoff; (void)zoff; (void)obu; (void)ooff; (void)vbu; (void)voff2; (void)vrow; (void)orow;
    if constexpr (GDN && ROLE == 0) {
    bf16x8 r0 = (bf16x8){0, 0, 0, 0, 0, 0, 0, 0};
    bf16x8 r1 = (bf16x8){0, 0, 0, 0, 0, 0, 0, 0};
    bf16x8 r2 = (bf16x8){0, 0, 0, 0, 0, 0, 0, 0};
    bf16x8 r3 = (bf16x8){0, 0, 0, 0, 0, 0, 0, 0};
    bf16x8 r4 = (bf16x8){0, 0, 0, 0, 0, 0, 0, 0};
    bf16x8 r5 = (bf16x8){0, 0, 0, 0, 0, 0, 0, 0};
    bf16x8 r6 = (bf16x8){0, 0, 0, 0, 0, 0, 0, 0};
    bf16x8 r7 = (bf16x8){0, 0, 0, 0, 0, 0, 0, 0};
    bf16x8 r8 = (bf16x8){0, 0, 0, 0, 0, 0, 0, 0};
    bf16x8 r9 = (bf16x8){0, 0, 0, 0, 0, 0, 0, 0};
    bf16x8 r10 = (bf16x8){0, 0, 0, 0, 0, 0, 0, 0};
    bf16x8 r11 = (bf16x8){0, 0, 0, 0, 0, 0, 0, 0};
    bf16x8 r12 = (bf16x8){0, 0, 0, 0, 0, 0, 0, 0};
    bf16x8 r13 = (bf16x8){0, 0, 0, 0, 0, 0, 0, 0};
    bf16x8 r14 = (bf16x8){0, 0, 0, 0, 0, 0, 0, 0};
    bf16x8 r15 = (bf16x8){0, 0, 0, 0, 0, 0, 0, 0};
    f32x4 S0_0 = {0.f, 0.f, 0.f, 0.f};
    f32x4 S0_1 = {0.f, 0.f, 0.f, 0.f};
    f32x4 S0_2 = {0.f, 0.f, 0.f, 0.f};
    f32x4 S0_3 = {0.f, 0.f, 0.f, 0.f};
    f32x4 S0_4 = {0.f, 0.f, 0.f, 0.f};
    f32x4 S0_5 = {0.f, 0.f, 0.f, 0.f};
    f32x4 S0_6 = {0.f, 0.f, 0.f, 0.f};
    f32x4 S0_7 = {0.f, 0.f, 0.f, 0.f};
    bf16x8 Sp0_0 = (bf16x8){0, 0, 0, 0, 0, 0, 0, 0};
    bf16x8 Sp0_1 = (bf16x8){0, 0, 0, 0, 0, 0, 0, 0};
    bf16x8 Sp0_2 = (bf16x8){0, 0, 0, 0, 0, 0, 0, 0};
    bf16x8 Sp0_3 = (bf16x8){0, 0, 0, 0, 0, 0, 0, 0};
    f32x4 S1_0 = {0.f, 0.f, 0.f, 0.f};
    f32x4 S1_1 = {0.f, 0.f, 0.f, 0.f};
    f32x4 S1_2 = {0.f, 0.f, 0.f, 0.f};
    f32x4 S1_3 = {0.f, 0.f, 0.f, 0.f};
    f32x4 S1_4 = {0.f, 0.f, 0.f, 0.f};
    f32x4 S1_5 = {0.f, 0.f, 0.f, 0.f};
    f32x4 S1_6 = {0.f, 0.f, 0.f, 0.f};
    f32x4 S1_7 = {0.f, 0.f, 0.f, 0.f};
    bf16x8 Sp1_0 = (bf16x8){0, 0, 0, 0, 0, 0, 0, 0};
    bf16x8 Sp1_1 = (bf16x8){0, 0, 0, 0, 0, 0, 0, 0};
    bf16x8 Sp1_2 = (bf16x8){0, 0, 0, 0, 0, 0, 0, 0};
    bf16x8 Sp1_3 = (bf16x8){0, 0, 0, 0, 0, 0, 0, 0};
    float decv = 0.f;
    u32x4 un0_0 = {0u, 0u, 0u, 0u}, un0_1 = {0u, 0u, 0u, 0u};
    u32x4 un1_0 = {0u, 0u, 0u, 0u}, un1_1 = {0u, 0u, 0u, 0u};
    { const int n = 0; (void)n;
    asm volatile("global_load_dwordx4 %0, %1, off" : "+v"(un0_0) : "v"((const unsigned char*)(ubp + 0 * 2048) + uoff) : "memory");
    asm volatile("global_load_dwordx4 %0, %1, off offset:16" : "+v"(un0_1) : "v"((const unsigned char*)(ubp + 0 * 2048) + uoff) : "memory");
    asm volatile("global_load_dwordx4 %0, %1, off" : "+v"(un1_0) : "v"((const unsigned char*)(ubp + 1 * 2048) + uoff) : "memory");
    asm volatile("global_load_dwordx4 %0, %1, off offset:16" : "+v"(un1_1) : "v"((const unsigned char*)(ubp + 1 * 2048) + uoff) : "memory");
    asm volatile("global_load_dword %0, %1, off" : "+v"(decv) : "v"((const unsigned char*)(decp) + zoff) : "memory");
    asm volatile("global_load_dwordx4 %0, %1, off" : "+v"(r0) : "v"((const unsigned char*)(sp0 + ((size_t)(n + 0) * 56 + 0) * 1024) + voff) : "memory");
    asm volatile("global_load_dwordx4 %0, %1, off" : "+v"(r1) : "v"((const unsigned char*)(sp0 + ((size_t)(n + 0) * 56 + 1) * 1024) + voff) : "memory");
    asm volatile("global_load_dwordx4 %0, %1, off" : "+v"(r2) : "v"((const unsigned char*)(sp0 + ((size_t)(n + 0) * 56 + 2) * 1024) + voff) : "memory");
    asm volatile("global_load_dwordx4 %0, %1, off" : "+v"(r3) : "v"((const unsigned char*)(sp0 + ((size_t)(n + 0) * 56 + 3) * 1024) + voff) : "memory");
    asm volatile("global_load_dwordx4 %0, %1, off" : "+v"(r4) : "v"((const unsigned char*)(sp0 + ((size_t)(n + 0) * 56 + 4) * 1024) + voff) : "memory");
    asm volatile("global_load_dwordx4 %0, %1, off" : "+v"(r5) : "v"((const unsigned char*)(sp0 + ((size_t)(n + 0) * 56 + 5) * 1024) + voff) : "memory");
    asm volatile("global_load_dwordx4 %0, %1, off" : "+v"(r6) : "v"((const unsigned char*)(sp0 + ((size_t)(n + 0) * 56 + 6) * 1024) + voff) : "memory");
    asm volatile("global_load_dwordx4 %0, %1, off" : "+v"(r7) : "v"((const unsigned char*)(sp0 + ((size_t)(n + 0) * 56 + 7) * 1024) + voff) : "memory");
    asm volatile("global_load_dwordx4 %0, %1, off" : "+v"(r8) : "v"((const unsigned char*)(sp0 + ((size_t)(n + 0) * 56 + 8) * 1024) + voff) : "memory");
    asm volatile("global_load_dwordx4 %0, %1, off" : "+v"(r9) : "v"((const unsigned char*)(sp0 + ((size_t)(n + 0) * 56 + 9) * 1024) + voff) : "memory");
    asm volatile("global_load_dwordx4 %0, %1, off" : "+v"(r10) : "v"((const unsigned char*)(sp0 + ((size_t)(n + 0) * 56 + 10) * 1024) + voff) : "memory");
    asm volatile("global_load_dwordx4 %0, %1, off" : "+v"(r11) : "v"((const unsigned char*)(sp0 + ((size_t)(n + 0) * 56 + 11) * 1024) + voff) : "memory");
    asm volatile("global_load_dwordx4 %0, %1, off" : "+v"(r12) : "v"((const unsigned char*)(sp0 + ((size_t)(n + 0) * 56 + 12) * 1024) + voff) : "memory");
    asm volatile("global_load_dwordx4 %0, %1, off" : "+v"(r13) : "v"((const unsigned char*)(sp0 + ((size_t)(n + 0) * 56 + 13) * 1024) + voff) : "memory");
    asm volatile("global_load_dwordx4 %0, %1, off" : "+v"(r14) : "v"((const unsigned char*)(sp0 + ((size_t)(n + 0) * 56 + 14) * 1024) + voff) : "memory");
    asm volatile("global_load_dwordx4 %0, %1, off" : "+v"(r15) : "v"((const unsigned char*)(sp0 + ((size_t)(n + 0) * 56 + 15) * 1024) + voff) : "memory");
    }
#pragma unroll 1
    for (int n = 0; n < NCH; ++n) {
        const int nn = n + 1 < NCH ? n + 1 : n;
        f32x4 a0_0, a0_1, a0_2, a0_3;
        f32x4 a1_0, a1_1, a1_2, a1_3;
        asm volatile("s_waitcnt vmcnt(16)" : "+v"(un0_0), "+v"(un0_1), "+v"(un1_0), "+v"(un1_1), "+v"(decv));
        a0_0 = (f32x4){bflo(un0_0.x), bfhi(un0_0.x), bflo(un0_0.y), bfhi(un0_0.y)}; a0_1 = (f32x4){bflo(un0_0.z), bfhi(un0_0.z), bflo(un0_0.w), bfhi(un0_0.w)};
        a0_2 = (f32x4){bflo(un0_1.x), bfhi(un0_1.x), bflo(un0_1.y), bfhi(un0_1.y)}; a0_3 = (f32x4){bflo(un0_1.z), bfhi(un0_1.z), bflo(un0_1.w), bfhi(un0_1.w)};
        a1_0 = (f32x4){bflo(un1_0.x), bfhi(un1_0.x), bflo(un1_0.y), bfhi(un1_0.y)}; a1_1 = (f32x4){bflo(un1_0.z), bfhi(un1_0.z), bflo(un1_0.w), bfhi(un1_0.w)};
        a1_2 = (f32x4){bflo(un1_1.x), bfhi(un1_1.x), bflo(un1_1.y), bfhi(un1_1.y)}; a1_3 = (f32x4){bflo(un1_1.z), bfhi(un1_1.z), bflo(un1_1.w), bfhi(un1_1.w)};
        const float dec = decv;
        { const unsigned char* ubn = ubp + (size_t)nn * 32768;
          asm volatile("global_load_dwordx4 %0, %1, off" : "+v"(un0_0) : "v"((const unsigned char*)(ubn + 0 * 2048) + uoff) : "memory");
          asm volatile("global_load_dwordx4 %0, %1, off offset:16" : "+v"(un0_1) : "v"((const unsigned char*)(ubn + 0 * 2048) + uoff) : "memory");
          asm volatile("global_load_dwordx4 %0, %1, off" : "+v"(un1_0) : "v"((const unsigned char*)(ubn + 1 * 2048) + uoff) : "memory");
          asm volatile("global_load_dwordx4 %0, %1, off offset:16" : "+v"(un1_1) : "v"((const unsigned char*)(ubn + 1 * 2048) + uoff) : "memory");
          asm volatile("global_load_dword %0, %1, off" : "+v"(decv) : "v"((const unsigned char*)(decp + nn) + zoff) : "memory"); }
        __builtin_amdgcn_sched_barrier(0);
        asm volatile("s_waitcnt vmcnt(20)" : "+v"(r0));
        a0_0 = mfma16(r0, Sp0_0, a0_0);
        a1_0 = mfma16(r0, Sp1_0, a1_0);
        asm volatile("global_load_dwordx4 %0, %1, off" : "+v"(r0) : "v"((const unsigned char*)(sp0 + ((size_t)(n + 0) * 56 + 40) * 1024) + voff) : "memory");
        __builtin_amdgcn_sched_barrier(0);
        asm volatile("s_waitcnt vmcnt(20)" : "+v"(r1));
        a0_0 = mfma16(r1, Sp0_1, a0_0);
        a1_0 = mfma16(r1, Sp1_1, a1_0);
        asm volatile("global_load_dwordx4 %0, %1, off" : "+v"(r1) : "v"((const unsigned char*)(sp0 + ((size_t)(n + 0) * 56 + 41) * 1024) + voff) : "memory");
        __builtin_amdgcn_sched_barrier(0);
        asm volatile("s_waitcnt vmcnt(20)" : "+v"(r2));
        a0_0 = mfma16(r2, Sp0_2, a0_0);
        a1_0 = mfma16(r2, Sp1_2, a1_0);
        asm volatile("global_load_dwordx4 %0, %1, off" : "+v"(r2) : "v"((const unsigned char*)(sp0 + ((size_t)(n + 0) * 56 + 42) * 1024) + voff) : "memory");
        __builtin_amdgcn_sched_barrier(0);
        asm volatile("s_waitcnt vmcnt(20)" : "+v"(r3));
        a0_0 = mfma16(r3, Sp0_3, a0_0);
        a1_0 = mfma16(r3, Sp1_3, a1_0);
        asm volatile("global_load_dwordx4 %0, %1, off" : "+v"(r3) : "v"((const unsigned char*)(sp0 + ((size_t)(n + 0) * 56 + 43) * 1024) + voff) : "memory");
        __builtin_amdgcn_sched_barrier(0);
        asm volatile("s_waitcnt vmcnt(20)" : "+v"(r4));
        a0_1 = mfma16(r4, Sp0_0, a0_1);
        a1_1 = mfma16(r4, Sp1_0, a1_1);
        asm volatile("global_load_dwordx4 %0, %1, off" : "+v"(r4) : "v"((const unsigned char*)(sp0 + ((size_t)(n + 0) * 56 + 44) * 1024) + voff) : "memory");
        __builtin_amdgcn_sched_barrier(0);
        asm volatile("s_waitcnt vmcnt(20)" : "+v"(r5));
        a0_1 = mfma16(r5, Sp0_1, a0_1);
        a1_1 = mfma16(r5, Sp1_1, a1_1);
        asm volatile("global_load_dwordx4 %0, %1, off" : "+v"(r5) : "v"((const unsigned char*)(sp0 + ((size_t)(n + 0) * 56 + 45) * 1024) + voff) : "memory");
        __builtin_amdgcn_sched_barrier(0);
        asm volatile("s_waitcnt vmcnt(20)" : "+v"(r6));
        a0_1 = mfma16(r6, Sp0_2, a0_1);
        a1_1 = mfma16(r6, Sp1_2, a1_1);
        asm volatile("global_load_dwordx4 %0, %1, off" : "+v"(r6) : "v"((const unsigned char*)(sp0 + ((size_t)(n + 0) * 56 + 46) * 1024) + voff) : "memory");
        __builtin_amdgcn_sched_barrier(0);
        asm volatile("s_waitcnt vmcnt(20)" : "+v"(r7));
        a0_1 = mfma16(r7, Sp0_3, a0_1);
        a1_1 = mfma16(r7, Sp1_3, a1_1);
        asm volatile("global_load_dwordx4 %0, %1, off" : "+v"(r7) : "v"((const unsigned char*)(sp0 + ((size_t)(n + 0) * 56 + 47) * 1024) + voff) : "memory");
        __builtin_amdgcn_sched_barrier(0);
        asm volatile("s_waitcnt vmcnt(20)" : "+v"(r8));
        a0_2 = mfma16(r8, Sp0_0, a0_2);
        a1_2 = mfma16(r8, Sp1_0, a1_2);
        asm volatile("global_load_dwordx4 %0, %1, off" : "+v"(r8) : "v"((const unsigned char*)(sp0 + ((size_t)(n + 0) * 56 + 48) * 1024) + voff) : "memory");
        __builtin_amdgcn_sched_barrier(0);
        asm volatile("s_waitcnt vmcnt(20)" : "+v"(r9));
        a0_2 = mfma16(r9, Sp0_1, a0_2);
        a1_2 = mfma16(r9, Sp1_1, a1_2);
        asm volatile("global_load_dwordx4 %0, %1, off" : "+v"(r9) : "v"((const unsigned char*)(sp0 + ((size_t)(n + 0) * 56 + 49) * 1024) + voff) : "memory");
        __builtin_amdgcn_sched_barrier(0);
        asm volatile("s_waitcnt vmcnt(20)" : "+v"(r10));
        a0_2 = mfma16(r10, Sp0_2, a0_2);
        a1_2 = mfma16(r10, Sp1_2, a1_2);
        asm volatile("global_load_dwordx4 %0, %1, off" : "+v"(r10) : "v"((const unsigned char*)(sp0 + ((size_t)(n + 0) * 56 + 50) * 1024) + voff) : "memory");
        __builtin_amdgcn_sched_barrier(0);
        asm volatile("s_waitcnt vmcnt(20)" : "+v"(r11));
        a0_2 = mfma16(r11, Sp0_3, a0_2);
        a1_2 = mfma16(r11, Sp1_3, a1_2);
        asm volatile("global_load_dwordx4 %0, %1, off" : "+v"(r11) : "v"((const unsigned char*)(sp0 + ((size_t)(n + 0) * 56 + 51) * 1024) + voff) : "memory");
        __builtin_amdgcn_sched_barrier(0);
        asm volatile("s_waitcnt vmcnt(20)" : "+v"(r12));
        a0_3 = mfma16(r12, Sp0_0, a0_3);
        a1_3 = mfma16(r12, Sp1_0, a1_3);
        asm volatile("global_load_dwordx4 %0, %1, off" : "+v"(r12) : "v"((const unsigned char*)(sp0 + ((size_t)(n + 0) * 56 + 52) * 1024) + voff) : "memory");
        __builtin_amdgcn_sched_barrier(0);
        asm volatile("s_waitcnt vmcnt(20)" : "+v"(r13));
        a0_3 = mfma16(r13, Sp0_1, a0_3);
        a1_3 = mfma16(r13, Sp1_1, a1_3);
        asm volatile("global_load_dwordx4 %0, %1, off" : "+v"(r13) : "v"((const unsigned char*)(sp0 + ((size_t)(n + 0) * 56 + 53) * 1024) + voff) : "memory");
        __builtin_amdgcn_sched_barrier(0);
        asm volatile("s_waitcnt vmcnt(20)" : "+v"(r14));
        a0_3 = mfma16(r14, Sp0_2, a0_3);
        a1_3 = mfma16(r14, Sp1_2, a1_3);
        asm volatile("global_load_dwordx4 %0, %1, off" : "+v"(r14) : "v"((const unsigned char*)(sp0 + ((size_t)(n + 0) * 56 + 54) * 1024) + voff) : "memory");
        __builtin_amdgcn_sched_barrier(0);
        asm volatile("s_waitcnt vmcnt(20)" : "+v"(r15));
        a0_3 = mfma16(r15, Sp0_3, a0_3);
        a1_3 = mfma16(r15, Sp1_3, a1_3);
        asm volatile("global_load_dwordx4 %0, %1, off" : "+v"(r15) : "v"((const unsigned char*)(sp0 + ((size_t)(n + 0) * 56 + 55) * 1024) + voff) : "memory");
        __builtin_amdgcn_sched_barrier(0);
        bf16x8 vp0_0, vp0_1;
        { u32x4 w; w.x = cvt_pk_bf16(a0_0[0], a0_0[1]); w.y = cvt_pk_bf16(a0_0[2], a0_0[3]); w.z = cvt_pk_bf16(a0_1[0], a0_1[1]); w.w = cvt_pk_bf16(a0_1[2], a0_1[3]); vp0_0 = __builtin_bit_cast(bf16x8, w); }
        { u32x4 w; w.x = cvt_pk_bf16(a0_2[0], a0_2[1]); w.y = cvt_pk_bf16(a0_2[2], a0_2[3]); w.z = cvt_pk_bf16(a0_3[0], a0_3[1]); w.w = cvt_pk_bf16(a0_3[2], a0_3[3]); vp0_1 = __builtin_bit_cast(bf16x8, w); }
        bf16x8 vp1_0, vp1_1;
        { u32x4 w; w.x = cvt_pk_bf16(a1_0[0], a1_0[1]); w.y = cvt_pk_bf16(a1_0[2], a1_0[3]); w.z = cvt_pk_bf16(a1_1[0], a1_1[1]); w.w = cvt_pk_bf16(a1_1[2], a1_1[3]); vp1_0 = __builtin_bit_cast(bf16x8, w); }
        { u32x4 w; w.x = cvt_pk_bf16(a1_2[0], a1_2[1]); w.y = cvt_pk_bf16(a1_2[2], a1_2[3]); w.z = cvt_pk_bf16(a1_3[0], a1_3[1]); w.w = cvt_pk_bf16(a1_3[2], a1_3[3]); vp1_1 = __builtin_bit_cast(bf16x8, w); }
        { unsigned sp_ = 0; while (*(volatile LAS unsigned*)(xl + XL_CNT + 64) + 2u <= (unsigned)n) { __builtin_amdgcn_s_sleep(1); if (++sp_ > (1u << 22)) break; } }
        { LAS bf16x8* sl_ = (LAS bf16x8*)(xl + (n & 1) * XL_SLOT) + lane; sl_[0] = Sp0_0; sl_[64] = Sp0_1; sl_[128] = Sp0_2; sl_[192] = Sp0_3; sl_[256] = vp0_0; sl_[320] = vp0_1; sl_[384] = Sp1_0; sl_[448] = Sp1_1; sl_[512] = Sp1_2; sl_[576] = Sp1_3; sl_[640] = vp1_0; sl_[704] = vp1_1; }
        asm volatile("s_waitcnt lgkmcnt(0)" ::: "memory");
        if (lane == 0) *(volatile LAS unsigned*)(xl + XL_CNT) = (unsigned)(n + 1);
        S0_0 = S0_0 * dec;
        S1_0 = S1_0 * dec;
        asm volatile("s_waitcnt vmcnt(15)" : "+v"(r0));
        S0_0 = mfma16(r0, vp0_0, S0_0);
        S1_0 = mfma16(r0, vp1_0, S1_0);
        asm volatile("global_load_dwordx4 %0, %1, off" : "+v"(r0) : "v"((const unsigned char*)(sp0 + ((size_t)(n + 1) * 56 + 0) * 1024) + voff) : "memory");
        __builtin_amdgcn_sched_barrier(0);
        asm volatile("s_waitcnt vmcnt(15)" : "+v"(r1));
        S0_0 = mfma16(r1, vp0_1, S0_0);
        S1_0 = mfma16(r1, vp1_1, S1_0);
        asm volatile("global_load_dwordx4 %0, %1, off" : "+v"(r1) : "v"((const unsigned char*)(sp0 + ((size_t)(n + 1) * 56 + 1) * 1024) + voff) : "memory");
        __builtin_amdgcn_sched_barrier(0);
        S0_1 = S0_1 * dec;
        S1_1 = S1_1 * dec;
        asm volatile("s_waitcnt vmcnt(15)" : "+v"(r2));
        S0_1 = mfma16(r2, vp0_0, S0_1);
        S1_1 = mfma16(r2, vp1_0, S1_1);
        asm volatile("global_load_dwordx4 %0, %1, off" : "+v"(r2) : "v"((const unsigned char*)(sp0 + ((size_t)(n + 1) * 56 + 2) * 1024) + voff) : "memory");
        __builtin_amdgcn_sched_barrier(0);
        asm volatile("s_waitcnt vmcnt(15)" : "+v"(r3));
        S0_1 = mfma16(r3, vp0_1, S0_1);
        S1_1 = mfma16(r3, vp1_1, S1_1);
        asm volatile("global_load_dwordx4 %0, %1, off" : "+v"(r3) : "v"((const unsigned char*)(sp0 + ((size_t)(n + 1) * 56 + 3) * 1024) + voff) : "memory");
        __builtin_amdgcn_sched_barrier(0);
        S0_2 = S0_2 * dec;
        S1_2 = S1_2 * dec;
        asm volatile("s_waitcnt vmcnt(15)" : "+v"(r4));
        S0_2 = mfma16(r4, vp0_0, S0_2);
        S1_2 = mfma16(r4, vp1_0, S1_2);
        asm volatile("global_load_dwordx4 %0, %1, off" : "+v"(r4) : "v"((const unsigned char*)(sp0 + ((size_t)(n + 1) * 56 + 4) * 1024) + voff) : "memory");
        __builtin_amdgcn_sched_barrier(0);
        asm volatile("s_waitcnt vmcnt(15)" : "+v"(r5));
        S0_2 = mfma16(r5, vp0_1, S0_2);
        S1_2 = mfma16(r5, vp1_1, S1_2);
        asm volatile("global_load_dwordx4 %0, %1, off" : "+v"(r5) : "v"((const unsigned char*)(sp0 + ((size_t)(n + 1) * 56 + 5) * 1024) + voff) : "memory");
        __builtin_amdgcn_sched_barrier(0);
        S0_3 = S0_3 * dec;
        S1_3 = S1_3 * dec;
        asm volatile("s_waitcnt vmcnt(15)" : "+v"(r6));
        S0_3 = mfma16(r6, vp0_0, S0_3);
        S1_3 = mfma16(r6, vp1_0, S1_3);
        asm volatile("global_load_dwordx4 %0, %1, off" : "+v"(r6) : "v"((const unsigned char*)(sp0 + ((size_t)(n + 1) * 56 + 6) * 1024) + voff) : "memory");
        __builtin_amdgcn_sched_barrier(0);
        asm volatile("s_waitcnt vmcnt(15)" : "+v"(r7));
        S0_3 = mfma16(r7, vp0_1, S0_3);
        S1_3 = mfma16(r7, vp1_1, S1_3);
        asm volatile("global_load_dwordx4 %0, %1, off" : "+v"(r7) : "v"((const unsigned char*)(sp0 + ((size_t)(n + 1) * 56 + 7) * 1024) + voff) : "memory");
        __builtin_amdgcn_sched_barrier(0);
        S0_4 = S0_4 * dec;
        S1_4 = S1_4 * dec;
        asm volatile("s_waitcnt vmcnt(15)" : "+v"(r8));
        S0_4 = mfma16(r8, vp0_0, S0_4);
        S1_4 = mfma16(r8, vp1_0, S1_4);
        asm volatile("global_load_dwordx4 %0, %1, off" : "+v"(r8) : "v"((const unsigned char*)(sp0 + ((size_t)(n + 1) * 56 + 8) * 1024) + voff) : "memory");
        __builtin_amdgcn_sched_barrier(0);
        asm volatile("s_waitcnt vmcnt(15)" : "+v"(r9));
        S0_4 = mfma16(r9, vp0_1, S0_4);
        S1_4 = mfma16(r9, vp1_1, S1_4);
        asm volatile("global_load_dwordx4 %0, %1, off" : "+v"(r9) : "v"((const unsigned char*)(sp0 + ((size_t)(n + 1) * 56 + 9) * 1024) + voff) : "memory");
        __builtin_amdgcn_sched_barrier(0);
        S0_5 = S0_5 * dec;
        S1_5 = S1_5 * dec;
        asm volatile("s_waitcnt vmcnt(15)" : "+v"(r10));
        S0_5 = mfma16(r10, vp0_0, S0_5);
        S1_5 = mfma16(r10, vp1_0, S1_5);
        asm volatile("global_load_dwordx4 %0, %1, off" : "+v"(r10) : "v"((const unsigned char*)(sp0 + ((size_t)(n + 1) * 56 + 10) * 1024) + voff) : "memory");
        __builtin_amdgcn_sched_barrier(0);
        asm volatile("s_waitcnt vmcnt(15)" : "+v"(r11));
        S0_5 = mfma16(r11, vp0_1, S0_5);
        S1_5 = mfma16(r11, vp1_1, S1_5);
        asm volatile("global_load_dwordx4 %0, %1, off" : "+v"(r11) : "v"((const unsigned char*)(sp0 + ((size_t)(n + 1) * 56 + 11) * 1024) + voff) : "memory");
        __builtin_amdgcn_sched_barrier(0);
        S0_6 = S0_6 * dec;
        S1_6 = S1_6 * dec;
        asm volatile("s_waitcnt vmcnt(15)" : "+v"(r12));
        S0_6 = mfma16(r12, vp0_0, S0_6);
        S1_6 = mfma16(r12, vp1_0, S1_6);
        asm volatile("global_load_dwordx4 %0, %1, off" : "+v"(r12) : "v"((const unsigned char*)(sp0 + ((size_t)(n + 1) * 56 + 12) * 1024) + voff) : "memory");
        __builtin_amdgcn_sched_barrier(0);
        asm volatile("s_waitcnt vmcnt(15)" : "+v"(r13));
        S0_6 = mfma16(r13, vp0_1, S0_6);
        S1_6 = mfma16(r13, vp1_1, S1_6);
        asm volatile("global_load_dwordx4 %0, %1, off" : "+v"(r13) : "v"((const unsigned char*)(sp0 + ((size_t)(n + 1) * 56 + 13) * 1024) + voff) : "memory");
        __builtin_amdgcn_sched_barrier(0);
        S0_7 = S0_7 * dec;
        S1_7 = S1_7 * dec;
        asm volatile("s_waitcnt vmcnt(15)" : "+v"(r14));
        S0_7 = mfma16(r14, vp0_0, S0_7);
        S1_7 = mfma16(r14, vp1_0, S1_7);
        asm volatile("global_load_dwordx4 %0, %1, off" : "+v"(r14) : "v"((const unsigned char*)(sp0 + ((size_t)(n + 1) * 56 + 14) * 1024) + voff) : "memory");
        __builtin_amdgcn_sched_barrier(0);
        asm volatile("s_waitcnt vmcnt(15)" : "+v"(r15));
        S0_7 = mfma16(r15, vp0_1, S0_7);
        S1_7 = mfma16(r15, vp1_1, S1_7);
        asm volatile("global_load_dwordx4 %0, %1, off" : "+v"(r15) : "v"((const unsigned char*)(sp0 + ((size_t)(n + 1) * 56 + 15) * 1024) + voff) : "memory");
        __builtin_amdgcn_sched_barrier(0);
        { u32x4 w; w.x = cvt_pk_bf16(S0_0[0], S0_0[1]); w.y = cvt_pk_bf16(S0_0[2], S0_0[3]); w.z = cvt_pk_bf16(S0_1[0], S0_1[1]); w.w = cvt_pk_bf16(S0_1[2], S0_1[3]); Sp0_0 = __builtin_bit_cast(bf16x8, w); }
        { u32x4 w; w.x = cvt_pk_bf16(S0_2[0], S0_2[1]); w.y = cvt_pk_bf16(S0_2[2], S0_2[3]); w.z = cvt_pk_bf16(S0_3[0], S0_3[1]); w.w = cvt_pk_bf16(S0_3[2], S0_3[3]); Sp0_1 = __builtin_bit_cast(bf16x8, w); }
        { u32x4 w; w.x = cvt_pk_bf16(S0_4[0], S0_4[1]); w.y = cvt_pk_bf16(S0_4[2], S0_4[3]); w.z = cvt_pk_bf16(S0_5[0], S0_5[1]); w.w = cvt_pk_bf16(S0_5[2], S0_5[3]); Sp0_2 = __builtin_bit_cast(bf16x8, w); }
        { u32x4 w; w.x = cvt_pk_bf16(S0_6[0], S0_6[1]); w.y = cvt_pk_bf16(S0_6[2], S0_6[3]); w.z = cvt_pk_bf16(S0_7[0], S0_7[1]); w.w = cvt_pk_bf16(S0_7[2], S0_7[3]); Sp0_3 = __builtin_bit_cast(bf16x8, w); }
        { u32x4 w; w.x = cvt_pk_bf16(S1_0[0], S1_0[1]); w.y = cvt_pk_bf16(S1_0[2], S1_0[3]); w.z = cvt_pk_bf16(S1_1[0], S1_1[1]); w.w = cvt_pk_bf16(S1_1[2], S1_1[3]); Sp1_0 = __builtin_bit_cast(bf16x8, w); }
        { u32x4 w; w.x = cvt_pk_bf16(S1_2[0], S1_2[1]); w.y = cvt_pk_bf16(S1_2[2], S1_2[3]); w.z = cvt_pk_bf16(S1_3[0], S1_3[1]); w.w = cvt_pk_bf16(S1_3[2], S1_3[3]); Sp1_1 = __builtin_bit_cast(bf16x8, w); }
        { u32x4 w; w.x = cvt_pk_bf16(S1_4[0], S1_4[1]); w.y = cvt_pk_bf16(S1_4[2], S1_4[3]); w.z = cvt_pk_bf16(S1_5[0], S1_5[1]); w.w = cvt_pk_bf16(S1_5[2], S1_5[3]); Sp1_2 = __builtin_bit_cast(bf16x8, w); }
        { u32x4 w; w.x = cvt_pk_bf16(S1_6[0], S1_6[1]); w.y = cvt_pk_bf16(S1_6[2], S1_6[3]); w.z = cvt_pk_bf16(S1_7[0], S1_7[1]); w.w = cvt_pk_bf16(S1_7[2], S1_7[3]); Sp1_3 = __builtin_bit_cast(bf16x8, w); }
    }
    asm volatile("s_waitcnt vmcnt(0)" ::: "memory");
    } else if constexpr (GDN && ROLE == 1) {
    bf16x8 r0 = (bf16x8){0, 0, 0, 0, 0, 0, 0, 0};
    bf16x8 r1 = (bf16x8){0, 0, 0, 0, 0, 0, 0, 0};
    bf16x8 r2 = (bf16x8){0, 0, 0, 0, 0, 0, 0, 0};
    bf16x8 r3 = (bf16x8){0, 0, 0, 0, 0, 0, 0, 0};
    bf16x8 r4 = (bf16x8){0, 0, 0, 0, 0, 0, 0, 0};
    bf16x8 r5 = (bf16x8){0, 0, 0, 0, 0, 0, 0, 0};
    bf16x8 r6 = (bf16x8){0, 0, 0, 0, 0, 0, 0, 0};
    bf16x8 r7 = (bf16x8){0, 0, 0, 0, 0, 0, 0, 0};
    bf16x8 r8 = (bf16x8){0, 0, 0, 0, 0, 0, 0, 0};
    bf16x8 r9 = (bf16x8){0, 0, 0, 0, 0, 0, 0, 0};
    bf16x8 r10 = (bf16x8){0, 0, 0, 0, 0, 0, 0, 0};
    bf16x8 r11 = (bf16x8){0, 0, 0, 0, 0, 0, 0, 0};
    bf16x8 r12 = (bf16x8){0, 0, 0, 0, 0, 0, 0, 0};
    bf16x8 r13 = (bf16x8){0, 0, 0, 0, 0, 0, 0, 0};
    bf16x8 r14 = (bf16x8){0, 0, 0, 0, 0, 0, 0, 0};
    bf16x8 r15 = (bf16x8){0, 0, 0, 0, 0, 0, 0, 0};
    bf16x8 r16 = (bf16x8){0, 0, 0, 0, 0, 0, 0, 0};
    bf16x8 r17 = (bf16x8){0, 0, 0, 0, 0, 0, 0, 0};
    bf16x8 r18 = (bf16x8){0, 0, 0, 0, 0, 0, 0, 0};
    bf16x8 r19 = (bf16x8){0, 0, 0, 0, 0, 0, 0, 0};
    bf16x8 r20 = (bf16x8){0, 0, 0, 0, 0, 0, 0, 0};
    bf16x8 r21 = (bf16x8){0, 0, 0, 0, 0, 0, 0, 0};
    bf16x8 r22 = (bf16x8){0, 0, 0, 0, 0, 0, 0, 0};
    bf16x8 r23 = (bf16x8){0, 0, 0, 0, 0, 0, 0, 0};
    asm volatile("global_load_dwordx4 %0, %1, off" : "+v"(r0) : "v"((const unsigned char*)(sp0 + ((size_t)(0 + 0) * 56 + 16) * 1024) + voff) : "memory");
    asm volatile("global_load_dwordx4 %0, %1, off" : "+v"(r1) : "v"((const unsigned char*)(sp0 + ((size_t)(0 + 0) * 56 + 17) * 1024) + voff) : "memory");
    asm volatile("global_load_dwordx4 %0, %1, off" : "+v"(r2) : "v"((const unsigned char*)(sp0 + ((size_t)(0 + 0) * 56 + 18) * 1024) + voff) : "memory");
    asm volatile("global_load_dwordx4 %0, %1, off" : "+v"(r3) : "v"((const unsigned char*)(sp0 + ((size_t)(0 + 0) * 56 + 19) * 1024) + voff) : "memory");
    asm volatile("global_load_dwordx4 %0, %1, off" : "+v"(r4) : "v"((const unsigned char*)(sp0 + ((size_t)(0 + 0) * 56 + 20) * 1024) + voff) : "memory");
    asm volatile("global_load_dwordx4 %0, %1, off" : "+v"(r5) : "v"((const unsigned char*)(sp0 + ((size_t)(0 + 0) * 56 + 21) * 1024) + voff) : "memory");
    asm volatile("global_load_dwordx4 %0, %1, off" : "+v"(r6) : "v"((const unsigned char*)(sp0 + ((size_t)(0 + 0) * 56 + 22) * 1024) + voff) : "memory");
    asm volatile("global_load_dwordx4 %0, %1, off" : "+v"(r7) : "v"((const unsigned char*)(sp0 + ((size_t)(0 + 0) * 56 + 23) * 1024) + voff) : "memory");
    asm volatile("global_load_dwordx4 %0, %1, off" : "+v"(r8) : "v"((const unsigned char*)(sp0 + ((size_t)(0 + 0) * 56 + 24) * 1024) + voff) : "memory");
    asm volatile("global_load_dwordx4 %0, %1, off" : "+v"(r9) : "v"((const unsigned char*)(sp0 + ((size_t)(0 + 0) * 56 + 25) * 1024) + voff) : "memory");
    asm volatile("global_load_dwordx4 %0, %1, off" : "+v"(r10) : "v"((const unsigned char*)(sp0 + ((size_t)(0 + 0) * 56 + 26) * 1024) + voff) : "memory");
    asm volatile("global_load_dwordx4 %0, %1, off" : "+v"(r11) : "v"((const unsigned char*)(sp0 + ((size_t)(0 + 0) * 56 + 27) * 1024) + voff) : "memory");
    asm volatile("global_load_dwordx4 %0, %1, off" : "+v"(r12) : "v"((const unsigned char*)(sp0 + ((size_t)(0 + 0) * 56 + 28) * 1024) + voff) : "memory");
    asm volatile("global_load_dwordx4 %0, %1, off" : "+v"(r13) : "v"((const unsigned char*)(sp0 + ((size_t)(0 + 0) * 56 + 29) * 1024) + voff) : "memory");
    asm volatile("global_load_dwordx4 %0, %1, off" : "+v"(r14) : "v"((const unsigned char*)(sp0 + ((size_t)(0 + 0) * 56 + 30) * 1024) + voff) : "memory");
    asm volatile("global_load_dwordx4 %0, %1, off" : "+v"(r15) : "v"((const unsigned char*)(sp0 + ((size_t)(0 + 0) * 56 + 31) * 1024) + voff) : "memory");
    asm volatile("global_load_dwordx4 %0, %1, off" : "+v"(r16) : "v"((const unsigned char*)(sp0 + ((size_t)(0 + 0) * 56 + 32) * 1024) + voff) : "memory");
    asm volatile("global_load_dwordx4 %0, %1, off" : "+v"(r17) : "v"((const unsigned char*)(sp0 + ((size_t)(0 + 0) * 56 + 33) * 1024) + voff) : "memory");
    asm volatile("global_load_dwordx4 %0, %1, off" : "+v"(r18) : "v"((const unsigned char*)(sp0 + ((size_t)(0 + 0) * 56 + 34) * 1024) + voff) : "memory");
    asm volatile("global_load_dwordx4 %0, %1, off" : "+v"(r19) : "v"((const unsigned char*)(sp0 + ((size_t)(0 + 0) * 56 + 35) * 1024) + voff) : "memory");
    asm volatile("global_load_dwordx4 %0, %1, off" : "+v"(r20) : "v"((const unsigned char*)(sp0 + ((size_t)(0 + 0) * 56 + 36) * 1024) + voff) : "memory");
    asm volatile("global_load_dwordx4 %0, %1, off" : "+v"(r21) : "v"((const unsigned char*)(sp0 + ((size_t)(0 + 0) * 56 + 37) * 1024) + voff) : "memory");
    asm volatile("global_load_dwordx4 %0, %1, off" : "+v"(r22) : "v"((const unsigned char*)(sp0 + ((size_t)(0 + 0) * 56 + 38) * 1024) + voff) : "memory");
    asm volatile("global_load_dwordx4 %0, %1, off" : "+v"(r23) : "v"((const unsigned char*)(sp0 + ((size_t)(0 + 0) * 56 + 39) * 1024) + voff) : "memory");
    { unsigned z = 0u;
      asm volatile("global_store_short %0, %1, off" :: "v"((const unsigned char*)(obu + (size_t)(0) * orow + 0) + ooff), "v"(z) : "memory");
      asm volatile("global_store_short %0, %1, off" :: "v"((const unsigned char*)(obu + (size_t)(1) * orow + 0) + ooff), "v"(z) : "memory");
      asm volatile("global_store_short %0, %1, off" :: "v"((const unsigned char*)(obu + (size_t)(2) * orow + 0) + ooff), "v"(z) : "memory");
      asm volatile("global_store_short %0, %1, off" :: "v"((const unsigned char*)(obu + (size_t)(3) * orow + 0) + ooff), "v"(z) : "memory");
      asm volatile("global_store_short %0, %1, off" :: "v"((const unsigned char*)(obu + (size_t)(16) * orow + 0) + ooff), "v"(z) : "memory");
      asm volatile("global_store_short %0, %1, off" :: "v"((const unsigned char*)(obu + (size_t)(17) * orow + 0) + ooff), "v"(z) : "memory");
      asm volatile("global_store_short %0, %1, off" :: "v"((const unsigned char*)(obu + (size_t)(18) * orow + 0) + ooff), "v"(z) : "memory");
      asm volatile("global_store_short %0, %1, off" :: "v"((const unsigned char*)(obu + (size_t)(19) * orow + 0) + ooff), "v"(z) : "memory");
      asm volatile("global_store_short %0, %1, off" :: "v"((const unsigned char*)(obu + (size_t)(32) * orow + 0) + ooff), "v"(z) : "memory");
      asm volatile("global_store_short %0, %1, off" :: "v"((const unsigned char*)(obu + (size_t)(33) * orow + 0) + ooff), "v"(z) : "memory");
      asm volatile("global_store_short %0, %1, off" :: "v"((const unsigned char*)(obu + (size_t)(34) * orow + 0) + ooff), "v"(z) : "memory");
      asm volatile("global_store_short %0, %1, off" :: "v"((const unsigned char*)(obu + (size_t)(35) * orow + 0) + ooff), "v"(z) : "memory");
      asm volatile("global_store_short %0, %1, off" :: "v"((const unsigned char*)(obu + (size_t)(48) * orow + 0) + ooff), "v"(z) : "memory");
      asm volatile("global_store_short %0, %1, off" :: "v"((const unsigned char*)(obu + (size_t)(49) * orow + 0) + ooff), "v"(z) : "memory");
      asm volatile("global_store_short %0, %1, off" :: "v"((const unsigned char*)(obu + (size_t)(50) * orow + 0) + ooff), "v"(z) : "memory");
      asm volatile("global_store_short %0, %1, off" :: "v"((const unsigned char*)(obu + (size_t)(51) * orow + 0) + ooff), "v"(z) : "memory");
      asm volatile("global_store_short %0, %1, off" :: "v"((const unsigned char*)(obu + (size_t)(0) * orow + 32) + ooff), "v"(z) : "memory");
      asm volatile("global_store_short %0, %1, off" :: "v"((const unsigned char*)(obu + (size_t)(1) * orow + 32) + ooff), "v"(z) : "memory");
      asm volatile("global_store_short %0, %1, off" :: "v"((const unsigned char*)(obu + (size_t)(2) * orow + 32) + ooff), "v"(z) : "memory");
      asm volatile("global_store_short %0, %1, off" :: "v"((const unsigned char*)(obu + (size_t)(3) * orow + 32) + ooff), "v"(z) : "memory");
      asm volatile("global_store_short %0, %1, off" :: "v"((const unsigned char*)(obu + (size_t)(16) * orow + 32) + ooff), "v"(z) : "memory");
      asm volatile("global_store_short %0, %1, off" :: "v"((const unsigned char*)(obu + (size_t)(17) * orow + 32) + ooff), "v"(z) : "memory");
      asm volatile("global_store_short %0, %1, off" :: "v"((const unsigned char*)(obu + (size_t)(18) * orow + 32) + ooff), "v"(z) : "memory");
      asm volatile("global_store_short %0, %1, off" :: "v"((const unsigned char*)(obu + (size_t)(19) * orow + 32) + ooff), "v"(z) : "memory");
      asm volatile("global_store_short %0, %1, off" :: "v"((const unsigned char*)(obu + (size_t)(32) * orow + 32) + ooff), "v"(z) : "memory");
      asm volatile("global_store_short %0, %1, off" :: "v"((const unsigned char*)(obu + (size_t)(33) * orow + 32) + ooff), "v"(z) : "memory");
      asm volatile("global_store_short %0, %1, off" :: "v"((const unsigned char*)(obu + (size_t)(34) * orow + 32) + ooff), "v"(z) : "memory");
      asm volatile("global_store_short %0, %1, off" :: "v"((const unsigned char*)(obu + (size_t)(35) * orow + 32) + ooff), "v"(z) : "memory");
      asm volatile("global_store_short %0, %1, off" :: "v"((const unsigned char*)(obu + (size_t)(48) * orow + 32) + ooff), "v"(z) : "memory");
      asm volatile("global_store_short %0, %1, off" :: "v"((const unsigned char*)(obu + (size_t)(49) * orow + 32) + ooff), "v"(z) : "memory");
      asm volatile("global_store_short %0, %1, off" :: "v"((const unsigned char*)(obu + (size_t)(50) * orow + 32) + ooff), "v"(z) : "memory");
      asm volatile("global_store_short %0, %1, off" :: "v"((const unsigned char*)(obu + (size_t)(51) * orow + 32) + ooff), "v"(z) : "memory");
    }
#pragma unroll 1
    for (int n = 0; n < NCH; ++n) {
        { unsigned sp_ = 0; while (*(volatile LAS unsigned*)(xl + XL_CNT) <= (unsigned)n) { __builtin_amdgcn_s_sleep(1); if (++sp_ > (1u << 22)) break; } }
        bf16x8 Sp0_0, Sp0_1, Sp0_2, Sp0_3, vp0_0, vp0_1;
        bf16x8 Sp1_0, Sp1_1, Sp1_2, Sp1_3, vp1_0, vp1_1;
        { const LAS bf16x8* sl_ = (const LAS bf16x8*)(xl + (n & 1) * XL_SLOT) + lane; Sp0_0 = sl_[0]; Sp0_1 = sl_[64]; Sp0_2 = sl_[128]; Sp0_3 = sl_[192]; vp0_0 = sl_[256]; vp0_1 = sl_[320]; Sp1_0 = sl_[384]; Sp1_1 = sl_[448]; Sp1_2 = sl_[512]; Sp1_3 = sl_[576]; vp1_0 = sl_[640]; vp1_1 = sl_[704]; }
        asm volatile("s_waitcnt lgkmcnt(0)" ::: "memory");
        if (lane == 0) *(volatile LAS unsigned*)(xl + XL_CNT + 64) = (unsigned)(n + 1);
        f32x4 o0_0 = {0.f, 0.f, 0.f, 0.f}, o0_1 = o0_0, o0_2 = o0_0, o0_3 = o0_0;
        f32x4 o1_0 = {0.f, 0.f, 0.f, 0.f}, o1_1 = o1_0, o1_2 = o1_0, o1_3 = o1_0;
        asm volatile("s_waitcnt vmcnt(55)" : "+v"(r0));
        o0_0 = mfma16(r0, Sp0_0, o0_0);
        o1_0 = mfma16(r0, Sp1_0, o1_0);
        asm volatile("global_load_dwordx4 %0, %1, off" : "+v"(r0) : "v"((const unsigned char*)(sp0 + ((size_t)(n + 1) * 56 + 16) * 1024) + voff) : "memory");
        __builtin_amdgcn_sched_barrier(0);
        asm volatile("s_waitcnt vmcnt(55)" : "+v"(r1));
        o0_0 = mfma16(r1, Sp0_1, o0_0);
        o1_0 = mfma16(r1, Sp1_1, o1_0);
        asm volatile("global_load_dwordx4 %0, %1, off" : "+v"(r1) : "v"((const unsigned char*)(sp0 + ((size_t)(n + 1) * 56 + 17) * 1024) + voff) : "memory");
        __builtin_amdgcn_sched_barrier(0);
        asm volatile("s_waitcnt vmcnt(55)" : "+v"(r2));
        o0_0 = mfma16(r2, Sp0_2, o0_0);
        o1_0 = mfma16(r2, Sp1_2, o1_0);
        asm volatile("global_load_dwordx4 %0, %1, off" : "+v"(r2) : "v"((const unsigned char*)(sp0 + ((size_t)(n + 1) * 56 + 18) * 1024) + voff) : "memory");
        __builtin_amdgcn_sched_barrier(0);
        asm volatile("s_waitcnt vmcnt(55)" : "+v"(r3));
        o0_0 = mfma16(r3, Sp0_3, o0_0);
        o1_0 = mfma16(r3, Sp1_3, o1_0);
        asm volatile("global_load_dwordx4 %0, %1, off" : "+v"(r3) : "v"((const unsigned char*)(sp0 + ((size_t)(n + 1) * 56 + 19) * 1024) + voff) : "memory");
        __builtin_amdgcn_sched_barrier(0);
        asm volatile("s_waitcnt vmcnt(55)" : "+v"(r4));
        o0_1 = mfma16(r4, Sp0_0, o0_1);
        o1_1 = mfma16(r4, Sp1_0, o1_1);
        asm volatile("global_load_dwordx4 %0, %1, off" : "+v"(r4) : "v"((const unsigned char*)(sp0 + ((size_t)(n + 1) * 56 + 20) * 1024) + voff) : "memory");
        __builtin_amdgcn_sched_barrier(0);
        asm volatile("s_waitcnt vmcnt(55)" : "+v"(r5));
        o0_1 = mfma16(r5, Sp0_1, o0_1);
        o1_1 = mfma16(r5, Sp1_1, o1_1);
        asm volatile("global_load_dwordx4 %0, %1, off" : "+v"(r5) : "v"((const unsigned char*)(sp0 + ((size_t)(n + 1) * 56 + 21) * 1024) + voff) : "memory");
        __builtin_amdgcn_sched_barrier(0);
        asm volatile("s_waitcnt vmcnt(55)" : "+v"(r6));
        o0_1 = mfma16(r6, Sp0_2, o0_1);
        o1_1 = mfma16(r6, Sp1_2, o1_1);
        asm volatile("global_load_dwordx4 %0, %1, off" : "+v"(r6) : "v"((const unsigned char*)(sp0 + ((size_t)(n + 1) * 56 + 22) * 1024) + voff) : "memory");
        __builtin_amdgcn_sched_barrier(0);
        asm volatile("s_waitcnt vmcnt(55)" : "+v"(r7));
        o0_1 = mfma16(r7, Sp0_3, o0_1);
        o1_1 = mfma16(r7, Sp1_3, o1_1);
        asm volatile("global_load_dwordx4 %0, %1, off" : "+v"(r7) : "v"((const unsigned char*)(sp0 + ((size_t)(n + 1) * 56 + 23) * 1024) + voff) : "memory");
        __builtin_amdgcn_sched_barrier(0);
        asm volatile("s_waitcnt vmcnt(55)" : "+v"(r8));
        o0_2 = mfma16(r8, Sp0_0, o0_2);
        o1_2 = mfma16(r8, Sp1_0, o1_2);
        asm volatile("global_load_dwordx4 %0, %1, off" : "+v"(r8) : "v"((const unsigned char*)(sp0 + ((size_t)(n + 1) * 56 + 24) * 1024) + voff) : "memory");
        __builtin_amdgcn_sched_barrier(0);
        asm volatile("s_waitcnt vmcnt(55)" : "+v"(r9));
        o0_2 = mfma16(r9, Sp0_1, o0_2);
        o1_2 = mfma16(r9, Sp1_1, o1_2);
        asm volatile("global_load_dwordx4 %0, %1, off" : "+v"(r9) : "v"((const unsigned char*)(sp0 + ((size_t)(n + 1) * 56 + 25) * 1024) + voff) : "memory");
        __builtin_amdgcn_sched_barrier(0);
        asm volatile("s_waitcnt vmcnt(55)" : "+v"(r10));
        o0_2 = mfma16(r10, Sp0_2, o0_2);
        o1_2 = mfma16(r10, Sp1_2, o1_2);
        asm volatile("global_load_dwordx4 %0, %1, off" : "+v"(r10) : "v"((const unsigned char*)(sp0 + ((size_t)(n + 1) * 56 + 26) * 1024) + voff) : "memory");
        __builtin_amdgcn_sched_barrier(0);
        asm volatile("s_waitcnt vmcnt(55)" : "+v"(r11));
        o0_2 = mfma16(r11, Sp0_3, o0_2);
        o1_2 = mfma16(r11, Sp1_3, o1_2);
        asm volatile("global_load_dwordx4 %0, %1, off" : "+v"(r11) : "v"((const unsigned char*)(sp0 + ((size_t)(n + 1) * 56 + 27) * 1024) + voff) : "memory");
        __builtin_amdgcn_sched_barrier(0);
        asm volatile("s_waitcnt vmcnt(55)" : "+v"(r12));
        o0_3 = mfma16(r12, Sp0_0, o0_3);
        o1_3 = mfma16(r12, Sp1_0, o1_3);
        asm volatile("global_load_dwordx4 %0, %1, off" : "+v"(r12) : "v"((const unsigned char*)(sp0 + ((size_t)(n + 1) * 56 + 28) * 1024) + voff) : "memory");
        __builtin_amdgcn_sched_barrier(0);
        asm volatile("s_waitcnt vmcnt(55)" : "+v"(r13));
        o0_3 = mfma16(r13, Sp0_1, o0_3);
        o1_3 = mfma16(r13, Sp1_1, o1_3);
        asm volatile("global_load_dwordx4 %0, %1, off" : "+v"(r13) : "v"((const unsigned char*)(sp0 + ((size_t)(n + 1) * 56 + 29) * 1024) + voff) : "memory");
        __builtin_amdgcn_sched_barrier(0);
        asm volatile("s_waitcnt vmcnt(55)" : "+v"(r14));
        o0_3 = mfma16(r14, Sp0_2, o0_3);
        o1_3 = mfma16(r14, Sp1_2, o1_3);
        asm volatile("global_load_dwordx4 %0, %1, off" : "+v"(r14) : "v"((const unsigned char*)(sp0 + ((size_t)(n + 1) * 56 + 30) * 1024) + voff) : "memory");
        __builtin_amdgcn_sched_barrier(0);
        asm volatile("s_waitcnt vmcnt(55)" : "+v"(r15));
        o0_3 = mfma16(r15, Sp0_3, o0_3);
        o1_3 = mfma16(r15, Sp1_3, o1_3);
        asm volatile("global_load_dwordx4 %0, %1, off" : "+v"(r15) : "v"((const unsigned char*)(sp0 + ((size_t)(n + 1) * 56 + 31) * 1024) + voff) : "memory");
        __builtin_amdgcn_sched_barrier(0);
        asm volatile("s_waitcnt vmcnt(55)" : "+v"(r16));
        o0_0 = mfma16(r16, vp0_0, o0_0);
        o1_0 = mfma16(r16, vp1_0, o1_0);
        asm volatile("global_load_dwordx4 %0, %1, off" : "+v"(r16) : "v"((const unsigned char*)(sp0 + ((size_t)(n + 1) * 56 + 32) * 1024) + voff) : "memory");
        __builtin_amdgcn_sched_barrier(0);
        asm volatile("s_waitcnt vmcnt(55)" : "+v"(r17));
        o0_0 = mfma16(r17, vp0_1, o0_0);
        o1_0 = mfma16(r17, vp1_1, o1_0);
        asm volatile("global_load_dwordx4 %0, %1, off" : "+v"(r17) : "v"((const unsigned char*)(sp0 + ((size_t)(n + 1) * 56 + 33) * 1024) + voff) : "memory");
        __builtin_amdgcn_sched_barrier(0);
        asm volatile("s_waitcnt vmcnt(55)" : "+v"(r18));
        o0_1 = mfma16(r18, vp0_0, o0_1);
        o1_1 = mfma16(r18, vp1_0, o1_1);
        asm volatile("global_load_dwordx4 %0, %1, off" : "+v"(r18) : "v"((const unsigned char*)(sp0 + ((size_t)(n + 1) * 56 + 34) * 1024) + voff) : "memory");
        __builtin_amdgcn_sched_barrier(0);
        asm volatile("s_waitcnt vmcnt(55)" : "+v"(r19));
        o0_1 = mfma16(r19, vp0_1, o0_1);
        o1_1 = mfma16(r19, vp1_1, o1_1);
        asm volatile("global_load_dwordx4 %0, %1, off" : "+v"(r19) : "v"((const unsigned char*)(sp0 + ((size_t)(n + 1) * 56 + 35) * 1024) + voff) : "memory");
        __builtin_amdgcn_sched_barrier(0);
        asm volatile("s_waitcnt vmcnt(55)" : "+v"(r20));
        o0_2 = mfma16(r20, vp0_0, o0_2);
        o1_2 = mfma16(r20, vp1_0, o1_2);
        asm volatile("global_load_dwordx4 %0, %1, off" : "+v"(r20) : "v"((const unsigned char*)(sp0 + ((size_t)(n + 1) * 56 + 36) * 1024) + voff) : "memory");
        __builtin_amdgcn_sched_barrier(0);
        asm volatile("s_waitcnt vmcnt(55)" : "+v"(r21));
        o0_2 = mfma16(r21, vp0_1, o0_2);
        o1_2 = mfma16(r21, vp1_1, o1_2);
        asm volatile("global_load_dwordx4 %0, %1, off" : "+v"(r21) : "v"((const unsigned char*)(sp0 + ((size_t)(n + 1) * 56 + 37) * 1024) + voff) : "memory");
        __builtin_amdgcn_sched_barrier(0);
        asm volatile("s_waitcnt vmcnt(55)" : "+v"(r22));
        o0_3 = mfma16(r22, vp0_0, o0_3);
        o1_3 = mfma16(r22, vp1_0, o1_3);
        asm volatile("global_load_dwordx4 %0, %1, off" : "+v"(r22) : "v"((const unsigned char*)(sp0 + ((size_t)(n + 1) * 56 + 38) * 1024) + voff) : "memory");
        __builtin_amdgcn_sched_barrier(0);
        asm volatile("s_waitcnt vmcnt(55)" : "+v"(r23));
        o0_3 = mfma16(r23, vp0_1, o0_3);
        o1_3 = mfma16(r23, vp1_1, o1_3);
        asm volatile("global_load_dwordx4 %0, %1, off" : "+v"(r23) : "v"((const unsigned char*)(sp0 + ((size_t)(n + 1) * 56 + 39) * 1024) + voff) : "memory");
        __builtin_amdgcn_sched_barrier(0);
        { const unsigned char* obn = obu + (size_t)n * 64 * orow;
          { const unsigned v = f2bf(o0_0[0]); asm volatile("global_store_short %0, %1, off" :: "v"((const unsigned char*)(obn + (size_t)(0) * orow + 0) + ooff), "v"(v) : "memory"); }
          { const unsigned v = f2bf(o0_0[1]); asm volatile("global_store_short %0, %1, off" :: "v"((const unsigned char*)(obn + (size_t)(1) * orow + 0) + ooff), "v"(v) : "memory"); }
          { const unsigned v = f2bf(o0_0[2]); asm volatile("global_store_short %0, %1, off" :: "v"((const unsigned char*)(obn + (size_t)(2) * orow + 0) + ooff), "v"(v) : "memory"); }
          { const unsigned v = f2bf(o0_0[3]); asm volatile("global_store_short %0, %1, off" :: "v"((const unsigned char*)(obn + (size_t)(3) * orow + 0) + ooff), "v"(v) : "memory"); }
          { const unsigned v = f2bf(o0_1[0]); asm volatile("global_store_short %0, %1, off" :: "v"((const unsigned char*)(obn + (size_t)(16) * orow + 0) + ooff), "v"(v) : "memory"); }
          { const unsigned v = f2bf(o0_1[1]); asm volatile("global_store_short %0, %1, off" :: "v"((const unsigned char*)(obn + (size_t)(17) * orow + 0) + ooff), "v"(v) : "memory"); }
          { const unsigned v = f2bf(o0_1[2]); asm volatile("global_store_short %0, %1, off" :: "v"((const unsigned char*)(obn + (size_t)(18) * orow + 0) + ooff), "v"(v) : "memory"); }
          { const unsigned v = f2bf(o0_1[3]); asm volatile("global_store_short %0, %1, off" :: "v"((const unsigned char*)(obn + (size_t)(19) * orow + 0) + ooff), "v"(v) : "memory"); }
          { const unsigned v = f2bf(o0_2[0]); asm volatile("global_store_short %0, %1, off" :: "v"((const unsigned char*)(obn + (size_t)(32) * orow + 0) + ooff), "v"(v) : "memory"); }
          { const unsigned v = f2bf(o0_2[1]); asm volatile("global_store_short %0, %1, off" :: "v"((const unsigned char*)(obn + (size_t)(33) * orow + 0) + ooff), "v"(v) : "memory"); }
          { const unsigned v = f2bf(o0_2[2]); asm volatile("global_store_short %0, %1, off" :: "v"((const unsigned char*)(obn + (size_t)(34) * orow + 0) + ooff), "v"(v) : "memory"); }
          { const unsigned v = f2bf(o0_2[3]); asm volatile("global_store_short %0, %1, off" :: "v"((const unsigned char*)(obn + (size_t)(35) * orow + 0) + ooff), "v"(v) : "memory"); }
          { const unsigned v = f2bf(o0_3[0]); asm volatile("global_store_short %0, %1, off" :: "v"((const unsigned char*)(obn + (size_t)(48) * orow + 0) + ooff), "v"(v) : "memory"); }
          { const unsigned v = f2bf(o0_3[1]); asm volatile("global_store_short %0, %1, off" :: "v"((const unsigned char*)(obn + (size_t)(49) * orow + 0) + ooff), "v"(v) : "memory"); }
          { const unsigned v = f2bf(o0_3[2]); asm volatile("global_store_short %0, %1, off" :: "v"((const unsigned char*)(obn + (size_t)(50) * orow + 0) + ooff), "v"(v) : "memory"); }
          { const unsigned v = f2bf(o0_3[3]); asm volatile("global_store_short %0, %1, off" :: "v"((const unsigned char*)(obn + (size_t)(51) * orow + 0) + ooff), "v"(v) : "memory"); }
          { const unsigned v = f2bf(o1_0[0]); asm volatile("global_store_short %0, %1, off" :: "v"((const unsigned char*)(obn + (size_t)(0) * orow + 32) + ooff), "v"(v) : "memory"); }
          { const unsigned v = f2bf(o1_0[1]); asm volatile("global_store_short %0, %1, off" :: "v"((const unsigned char*)(obn + (size_t)(1) * orow + 32) + ooff), "v"(v) : "memory"); }
          { const unsigned v = f2bf(o1_0[2]); asm volatile("global_store_short %0, %1, off" :: "v"((const unsigned char*)(obn + (size_t)(2) * orow + 32) + ooff), "v"(v) : "memory"); }
          { const unsigned v = f2bf(o1_0[3]); asm volatile("global_store_short %0, %1, off" :: "v"((const unsigned char*)(obn + (size_t)(3) * orow + 32) + ooff), "v"(v) : "memory"); }
          { const unsigned v = f2bf(o1_1[0]); asm volatile("global_store_short %0, %1, off" :: "v"((const unsigned char*)(obn + (size_t)(16) * orow + 32) + ooff), "v"(v) : "memory"); }
          { const unsigned v = f2bf(o1_1[1]); asm volatile("global_store_short %0, %1, off" :: "v"((const unsigned char*)(obn + (size_t)(17) * orow + 32) + ooff), "v"(v) : "memory"); }
          { const unsigned v = f2bf(o1_1[2]); asm volatile("global_store_short %0, %1, off" :: "v"((const unsigned char*)(obn + (size_t)(18) * orow + 32) + ooff), "v"(v) : "memory"); }
          { const unsigned v = f2bf(o1_1[3]); asm volatile("global_store_short %0, %1, off" :: "v"((const unsigned char*)(obn + (size_t)(19) * orow + 32) + ooff), "v"(v) : "memory"); }
          { const unsigned v = f2bf(o1_2[0]); asm volatile("global_store_short %0, %1, off" :: "v"((const unsigned char*)(obn + (size_t)(32) * orow + 32) + ooff), "v"(v) : "memory"); }
          { const unsigned v = f2bf(o1_2[1]); asm volatile("global_store_short %0, %1, off" :: "v"((const unsigned char*)(obn + (size_t)(33) * orow + 32) + ooff), "v"(v) : "memory"); }
          { const unsigned v = f2bf(o1_2[2]); asm volatile("global_store_short %0, %1, off" :: "v"((const unsigned char*)(obn + (size_t)(34) * orow + 32) + ooff), "v"(v) : "memory"); }
          { const unsigned v = f2bf(o1_2[3]); asm volatile("global_store_short %0, %1, off" :: "v"((const unsigned char*)(obn + (size_t)(35) * orow + 32) + ooff), "v"(v) : "memory"); }
          { const unsigned v = f2bf(o1_3[0]); asm volatile("global_store_short %0, %1, off" :: "v"((const unsigned char*)(obn + (size_t)(48) * orow + 32) + ooff), "v"(v) : "memory"); }
          { const unsigned v = f2bf(o1_3[1]); asm volatile("global_store_short %0, %1, off" :: "v"((const unsigned char*)(obn + (size_t)(49) * orow + 32) + ooff), "v"(v) : "memory"); }
          { const unsigned v = f2bf(o1_3[2]); asm volatile("global_store_short %0, %1, off" :: "v"((const unsigned char*)(obn + (size_t)(50) * orow + 32) + ooff), "v"(v) : "memory"); }
          { const unsigned v = f2bf(o1_3[3]); asm volatile("global_store_short %0, %1, off" :: "v"((const unsigned char*)(obn + (size_t)(51) * orow + 32) + ooff), "v"(v) : "memory"); }
        }
        __builtin_amdgcn_sched_barrier(0);
    }
    asm volatile("s_waitcnt vmcnt(0)" ::: "memory");
    } else if constexpr (!GDN && ROLE == 0) {
    bf16x8 r0 = (bf16x8){0, 0, 0, 0, 0, 0, 0, 0};
    bf16x8 r1 = (bf16x8){0, 0, 0, 0, 0, 0, 0, 0};
    bf16x8 r2 = (bf16x8){0, 0, 0, 0, 0, 0, 0, 0};
    bf16x8 r3 = (bf16x8){0, 0, 0, 0, 0, 0, 0, 0};
    bf16x8 r4 = (bf16x8){0, 0, 0, 0, 0, 0, 0, 0};
    bf16x8 r5 = (bf16x8){0, 0, 0, 0, 0, 0, 0, 0};
    bf16x8 r6 = (bf16x8){0, 0, 0, 0, 0, 0, 0, 0};
    bf16x8 r7 = (bf16x8){0, 0, 0, 0, 0, 0, 0, 0};
    bf16x8 r8 = (bf16x8){0, 0, 0, 0, 0, 0, 0, 0};
    bf16x8 r9 = (bf16x8){0, 0, 0, 0, 0, 0, 0, 0};
    bf16x8 r10 = (bf16x8){0, 0, 0, 0, 0, 0, 0, 0};
    bf16x8 r11 = (bf16x8){0, 0, 0, 0, 0, 0, 0, 0};
    bf16x8 r12 = (bf16x8){0, 0, 0, 0, 0, 0, 0, 0};
    bf16x8 r13 = (bf16x8){0, 0, 0, 0, 0, 0, 0, 0};
    bf16x8 r14 = (bf16x8){0, 0, 0, 0, 0, 0, 0, 0};
    bf16x8 r15 = (bf16x8){0, 0, 0, 0, 0, 0, 0, 0};
    f32x4 S0_0 = {0.f, 0.f, 0.f, 0.f};
    f32x4 S0_1 = {0.f, 0.f, 0.f, 0.f};
    f32x4 S0_2 = {0.f, 0.f, 0.f, 0.f};
    f32x4 S0_3 = {0.f, 0.f, 0.f, 0.f};
    f32x4 S0_4 = {0.f, 0.f, 0.f, 0.f};
    f32x4 S0_5 = {0.f, 0.f, 0.f, 0.f};
    f32x4 S0_6 = {0.f, 0.f, 0.f, 0.f};
    f32x4 S0_7 = {0.f, 0.f, 0.f, 0.f};
    bf16x8 Sp0_0 = (bf16x8){0, 0, 0, 0, 0, 0, 0, 0};
    bf16x8 Sp0_1 = (bf16x8){0, 0, 0, 0, 0, 0, 0, 0};
    bf16x8 Sp0_2 = (bf16x8){0, 0, 0, 0, 0, 0, 0, 0};
    bf16x8 Sp0_3 = (bf16x8){0, 0, 0, 0, 0, 0, 0, 0};
    f32x4 S1_0 = {0.f, 0.f, 0.f, 0.f};
    f32x4 S1_1 = {0.f, 0.f, 0.f, 0.f};
    f32x4 S1_2 = {0.f, 0.f, 0.f, 0.f};
    f32x4 S1_3 = {0.f, 0.f, 0.f, 0.f};
    f32x4 S1_4 = {0.f, 0.f, 0.f, 0.f};
    f32x4 S1_5 = {0.f, 0.f, 0.f, 0.f};
    f32x4 S1_6 = {0.f, 0.f, 0.f, 0.f};
    f32x4 S1_7 = {0.f, 0.f, 0.f, 0.f};
    bf16x8 Sp1_0 = (bf16x8){0, 0, 0, 0, 0, 0, 0, 0};
    bf16x8 Sp1_1 = (bf16x8){0, 0, 0, 0, 0, 0, 0, 0};
    bf16x8 Sp1_2 = (bf16x8){0, 0, 0, 0, 0, 0, 0, 0};
    bf16x8 Sp1_3 = (bf16x8){0, 0, 0, 0, 0, 0, 0, 0};
    unsigned vn0_0 = 0u, vn0_1 = 0u, vn0_2 = 0u, vn0_3 = 0u, vn0_4 = 0u, vn0_5 = 0u, vn0_6 = 0u, vn0_7 = 0u, vn0_8 = 0u, vn0_9 = 0u, vn0_10 = 0u, vn0_11 = 0u, vn0_12 = 0u, vn0_13 = 0u, vn0_14 = 0u, vn0_15 = 0u;
    unsigned vn1_0 = 0u, vn1_1 = 0u, vn1_2 = 0u, vn1_3 = 0u, vn1_4 = 0u, vn1_5 = 0u, vn1_6 = 0u, vn1_7 = 0u, vn1_8 = 0u, vn1_9 = 0u, vn1_10 = 0u, vn1_11 = 0u, vn1_12 = 0u, vn1_13 = 0u, vn1_14 = 0u, vn1_15 = 0u;
    { const int n = 0; (void)n;
    asm volatile("global_load_ushort %0, %1, off" : "+v"(vn0_0) : "v"((const unsigned char*)(vbu + (size_t)(0) * vrow + 0) + voff2) : "memory");
    asm volatile("global_load_ushort %0, %1, off" : "+v"(vn0_1) : "v"((const unsigned char*)(vbu + (size_t)(1) * vrow + 0) + voff2) : "memory");
    asm volatile("global_load_ushort %0, %1, off" : "+v"(vn0_2) : "v"((const unsigned char*)(vbu + (size_t)(2) * vrow + 0) + voff2) : "memory");
    asm volatile("global_load_ushort %0, %1, off" : "+v"(vn0_3) : "v"((const unsigned char*)(vbu + (size_t)(3) * vrow + 0) + voff2) : "memory");
    asm volatile("global_load_ushort %0, %1, off" : "+v"(vn0_4) : "v"((const unsigned char*)(vbu + (size_t)(16) * vrow + 0) + voff2) : "memory");
    asm volatile("global_load_ushort %0, %1, off" : "+v"(vn0_5) : "v"((const unsigned char*)(vbu + (size_t)(17) * vrow + 0) + voff2) : "memory");
    asm volatile("global_load_ushort %0, %1, off" : "+v"(vn0_6) : "v"((const unsigned char*)(vbu + (size_t)(18) * vrow + 0) + voff2) : "memory");
    asm volatile("global_load_ushort %0, %1, off" : "+v"(vn0_7) : "v"((const unsigned char*)(vbu + (size_t)(19) * vrow + 0) + voff2) : "memory");
    asm volatile("global_load_ushort %0, %1, off" : "+v"(vn0_8) : "v"((const unsigned char*)(vbu + (size_t)(32) * vrow + 0) + voff2) : "memory");
    asm volatile("global_load_ushort %0, %1, off" : "+v"(vn0_9) : "v"((const unsigned char*)(vbu + (size_t)(33) * vrow + 0) + voff2) : "memory");
    asm volatile("global_load_ushort %0, %1, off" : "+v"(vn0_10) : "v"((const unsigned char*)(vbu + (size_t)(34) * vrow + 0) + voff2) : "memory");
    asm volatile("global_load_ushort %0, %1, off" : "+v"(vn0_11) : "v"((const unsigned char*)(vbu + (size_t)(35) * vrow + 0) + voff2) : "memory");
    asm volatile("global_load_ushort %0, %1, off" : "+v"(vn0_12) : "v"((const unsigned char*)(vbu + (size_t)(48) * vrow + 0) + voff2) : "memory");
    asm volatile("global_load_ushort %0, %1, off" : "+v"(vn0_13) : "v"((const unsigned char*)(vbu + (size_t)(49) * vrow + 0) + voff2) : "memory");
    asm volatile("global_load_ushort %0, %1, off" : "+v"(vn0_14) : "v"((const unsigned char*)(vbu + (size_t)(50) * vrow + 0) + voff2) : "memory");
    asm volatile("global_load_ushort %0, %1, off" : "+v"(vn0_15) : "v"((const unsigned char*)(vbu + (size_t)(51) * vrow + 0) + voff2) : "memory");
    asm volatile("global_load_ushort %0, %1, off" : "+v"(vn1_0) : "v"((const unsigned char*)(vbu + (size_t)(0) * vrow + 32) + voff2) : "memory");
    asm volatile("global_load_ushort %0, %1, off" : "+v"(vn1_1) : "v"((const unsigned char*)(vbu + (size_t)(1) * vrow + 32) + voff2) : "memory");
    asm volatile("global_load_ushort %0, %1, off" : "+v"(vn1_2) : "v"((const unsigned char*)(vbu + (size_t)(2) * vrow + 32) + voff2) : "memory");
    asm volatile("global_load_ushort %0, %1, off" : "+v"(vn1_3) : "v"((const unsigned char*)(vbu + (size_t)(3) * vrow + 32) + voff2) : "memory");
    asm volatile("global_load_ushort %0, %1, off" : "+v"(vn1_4) : "v"((const unsigned char*)(vbu + (size_t)(16) * vrow + 32) + voff2) : "memory");
    asm volatile("global_load_ushort %0, %1, off" : "+v"(vn1_5) : "v"((const unsigned char*)(vbu + (size_t)(17) * vrow + 32) + voff2) : "memory");
    asm volatile("global_load_ushort %0, %1, off" : "+v"(vn1_6) : "v"((const unsigned char*)(vbu + (size_t)(18) * vrow + 32) + voff2) : "memory");
    asm volatile("global_load_ushort %0, %1, off" : "+v"(vn1_7) : "v"((const unsigned char*)(vbu + (size_t)(19) * vrow + 32) + voff2) : "memory");
    asm volatile("global_load_ushort %0, %1, off" : "+v"(vn1_8) : "v"((const unsigned char*)(vbu + (size_t)(32) * vrow + 32) + voff2) : "memory");
    asm volatile("global_load_ushort %0, %1, off" : "+v"(vn1_9) : "v"((const unsigned char*)(vbu + (size_t)(33) * vrow + 32) + voff2) : "memory");
    asm volatile("global_load_ushort %0, %1, off" : "+v"(vn1_10) : "v"((const unsigned char*)(vbu + (size_t)(34) * vrow + 32) + voff2) : "memory");
    asm volatile("global_load_ushort %0, %1, off" : "+v"(vn1_11) : "v"((const unsigned char*)(vbu + (size_t)(35) * vrow + 32) + voff2) : "memory");
    asm volatile("global_load_ushort %0, %1, off" : "+v"(vn1_12) : "v"((const unsigned char*)(vbu + (size_t)(48) * vrow + 32) + voff2) : "memory");
    asm volatile("global_load_ushort %0, %1, off" : "+v"(vn1_13) : "v"((const unsigned char*)(vbu + (size_t)(49) * vrow + 32) + voff2) : "memory");
    asm volatile("global_load_ushort %0, %1, off" : "+v"(vn1_14) : "v"((const unsigned char*)(vbu + (size_t)(50) * vrow + 32) + voff2) : "memory");
    asm volatile("global_load_ushort %0, %1, off" : "+v"(vn1_15) : "v"((const unsigned char*)(vbu + (size_t)(51) * vrow + 32) + voff2) : "memory");
    asm volatile("global_load_dwordx4 %0, %1, off" : "+v"(r0) : "v"((const unsigned char*)(sp0 + ((size_t)(n + 0) * 40 + 24) * 1024) + voff) : "memory");
    asm volatile("global_load_dwordx4 %0, %1, off" : "+v"(r1) : "v"((const unsigned char*)(sp0 + ((size_t)(n + 0) * 40 + 25) * 1024) + voff) : "memory");
    asm volatile("global_load_dwordx4 %0, %1, off" : "+v"(r2) : "v"((const unsigned char*)(sp0 + ((size_t)(n + 0) * 40 + 26) * 1024) + voff) : "memory");
    asm volatile("global_load_dwordx4 %0, %1, off" : "+v"(r3) : "v"((const unsigned char*)(sp0 + ((size_t)(n + 0) * 40 + 27) * 1024) + voff) : "memory");
    asm volatile("global_load_dwordx4 %0, %1, off" : "+v"(r4) : "v"((const unsigned char*)(sp0 + ((size_t)(n + 0) * 40 + 28) * 1024) + voff) : "memory");
    asm volatile("global_load_dwordx4 %0, %1, off" : "+v"(r5) : "v"((const unsigned char*)(sp0 + ((size_t)(n + 0) * 40 + 29) * 1024) + voff) : "memory");
    asm volatile("global_load_dwordx4 %0, %1, off" : "+v"(r6) : "v"((const unsigned char*)(sp0 + ((size_t)(n + 0) * 40 + 30) * 1024) + voff) : "memory");
    asm volatile("global_load_dwordx4 %0, %1, off" : "+v"(r7) : "v"((const unsigned char*)(sp0 + ((size_t)(n + 0) * 40 + 31) * 1024) + voff) : "memory");
    asm volatile("global_load_dwordx4 %0, %1, off" : "+v"(r8) : "v"((const unsigned char*)(sp0 + ((size_t)(n + 0) * 40 + 32) * 1024) + voff) : "memory");
    asm volatile("global_load_dwordx4 %0, %1, off" : "+v"(r9) : "v"((const unsigned char*)(sp0 + ((size_t)(n + 0) * 40 + 33) * 1024) + voff) : "memory");
    asm volatile("global_load_dwordx4 %0, %1, off" : "+v"(r10) : "v"((const unsigned char*)(sp0 + ((size_t)(n + 0) * 40 + 34) * 1024) + voff) : "memory");
    asm volatile("global_load_dwordx4 %0, %1, off" : "+v"(r11) : "v"((const unsigned char*)(sp0 + ((size_t)(n + 0) * 40 + 35) * 1024) + voff) : "memory");
    asm volatile("global_load_dwordx4 %0, %1, off" : "+v"(r12) : "v"((const unsigned char*)(sp0 + ((size_t)(n + 0) * 40 + 36) * 1024) + voff) : "memory");
    asm volatile("global_load_dwordx4 %0, %1, off" : "+v"(r13) : "v"((const unsigned char*)(sp0 + ((size_t)(n + 0) * 40 + 37) * 1024) + voff) : "memory");
    asm volatile("global_load_dwordx4 %0, %1, off" : "+v"(r14) : "v"((const unsigned char*)(sp0 + ((size_t)(n + 0) * 40 + 38) * 1024) + voff) : "memory");
    asm volatile("global_load_dwordx4 %0, %1, off" : "+v"(r15) : "v"((const unsigned char*)(sp0 + ((size_t)(n + 0) * 40 + 39) * 1024) + voff) : "memory");
    }
#pragma unroll 1
    for (int n = 0; n < NCH; ++n) {
        const int nn = n + 1 < NCH ? n + 1 : n;
        f32x4 a0_0, a0_1, a0_2, a0_3;
        f32x4 a1_0, a1_1, a1_2, a1_3;
        asm volatile("s_waitcnt vmcnt(16)" : "+v"(vn0_0), "+v"(vn0_1), "+v"(vn0_2), "+v"(vn0_3), "+v"(vn0_4), "+v"(vn0_5), "+v"(vn0_6), "+v"(vn0_7), "+v"(vn0_8), "+v"(vn0_9), "+v"(vn0_10), "+v"(vn0_11), "+v"(vn0_12), "+v"(vn0_13), "+v"(vn0_14), "+v"(vn0_15));
        asm volatile("s_waitcnt vmcnt(16)" : "+v"(vn1_0), "+v"(vn1_1), "+v"(vn1_2), "+v"(vn1_3), "+v"(vn1_4), "+v"(vn1_5), "+v"(vn1_6), "+v"(vn1_7), "+v"(vn1_8), "+v"(vn1_9), "+v"(vn1_10), "+v"(vn1_11), "+v"(vn1_12), "+v"(vn1_13), "+v"(vn1_14), "+v"(vn1_15));
        a0_0 = (f32x4){__builtin_bit_cast(float, vn0_0 << 16), __builtin_bit_cast(float, vn0_1 << 16), __builtin_bit_cast(float, vn0_2 << 16), __builtin_bit_cast(float, vn0_3 << 16)};
        a0_1 = (f32x4){__builtin_bit_cast(float, vn0_4 << 16), __builtin_bit_cast(float, vn0_5 << 16), __builtin_bit_cast(float, vn0_6 << 16), __builtin_bit_cast(float, vn0_7 << 16)};
        a0_2 = (f32x4){__builtin_bit_cast(float, vn0_8 << 16), __builtin_bit_cast(float, vn0_9 << 16), __builtin_bit_cast(float, vn0_10 << 16), __builtin_bit_cast(float, vn0_11 << 16)};
        a0_3 = (f32x4){__builtin_bit_cast(float, vn0_12 << 16), __builtin_bit_cast(float, vn0_13 << 16), __builtin_bit_cast(float, vn0_14 << 16), __builtin_bit_cast(float, vn0_15 << 16)};
        a1_0 = (f32x4){__builtin_bit_cast(float, vn1_0 << 16), __builtin_bit_cast(float, vn1_1 << 16), __builtin_bit_cast(float, vn1_2 << 16), __builtin_bit_cast(float, vn1_3 << 16)};
        a1_1 = (f32x4){__builtin_bit_cast(float, vn1_4 << 16), __builtin_bit_cast(float, vn1_5 << 16), __builtin_bit_cast(float, vn1_6 << 16), __builtin_bit_cast(float, vn1_7 << 16)};
        a1_2 = (f32x4){__builtin_bit_cast(float, vn1_8 << 16), __builtin_bit_cast(float, vn1_9 << 16), __builtin_bit_cast(float, vn1_10 << 16), __builtin_bit_cast(float, vn1_11 << 16)};
        a1_3 = (f32x4){__builtin_bit_cast(float, vn1_12 << 16), __builtin_bit_cast(float, vn1_13 << 16), __builtin_bit_cast(float, vn1_14 << 16), __builtin_bit_cast(float, vn1_15 << 16)};
        const float dec = decr;
        { const unsigned char* vbn = vbu + (size_t)nn * 64 * vrow;
          asm volatile("global_load_ushort %0, %1, off" : "+v"(vn0_0) : "v"((const unsigned char*)(vbn + (size_t)(0) * vrow + 0) + voff2) : "memory");
          asm volatile("global_load_ushort %0, %1, off" : "+v"(vn0_1) : "v"((const unsigned char*)(vbn + (size_t)(1) * vrow + 0) + voff2) : "memory");
          asm volatile("global_load_ushort %0, %1, off" : "+v"(vn0_2) : "v"((const unsigned char*)(vbn + (size_t)(2) * vrow + 0) + voff2) : "memory");
          asm volatile("global_load_ushort %0, %1, off" : "+v"(vn0_3) : "v"((const unsigned char*)(vbn + (size_t)(3) * vrow + 0) + voff2) : "memory");
          asm volatile("global_load_ushort %0, %1, off" : "+v"(vn0_4) : "v"((const unsigned char*)(vbn + (size_t)(16) * vrow + 0) + voff2) : "memory");
          asm volatile("global_load_ushort %0, %1, off" : "+v"(vn0_5) : "v"((const unsigned char*)(vbn + (size_t)(17) * vrow + 0) + voff2) : "memory");
          asm volatile("global_load_ushort %0, %1, off" : "+v"(vn0_6) : "v"((const unsigned char*)(vbn + (size_t)(18) * vrow + 0) + voff2) : "memory");
          asm volatile("global_load_ushort %0, %1, off" : "+v"(vn0_7) : "v"((const unsigned char*)(vbn + (size_t)(19) * vrow + 0) + voff2) : "memory");
          asm volatile("global_load_ushort %0, %1, off" : "+v"(vn0_8) : "v"((const unsigned char*)(vbn + (size_t)(32) * vrow + 0) + voff2) : "memory");
          asm volatile("global_load_ushort %0, %1, off" : "+v"(vn0_9) : "v"((const unsigned char*)(vbn + (size_t)(33) * vrow + 0) + voff2) : "memory");
          asm volatile("global_load_ushort %0, %1, off" : "+v"(vn0_10) : "v"((const unsigned char*)(vbn + (size_t)(34) * vrow + 0) + voff2) : "memory");
          asm volatile("global_load_ushort %0, %1, off" : "+v"(vn0_11) : "v"((const unsigned char*)(vbn + (size_t)(35) * vrow + 0) + voff2) : "memory");
          asm volatile("global_load_ushort %0, %1, off" : "+v"(vn0_12) : "v"((const unsigned char*)(vbn + (size_t)(48) * vrow + 0) + voff2) : "memory");
          asm volatile("global_load_ushort %0, %1, off" : "+v"(vn0_13) : "v"((const unsigned char*)(vbn + (size_t)(49) * vrow + 0) + voff2) : "memory");
          asm volatile("global_load_ushort %0, %1, off" : "+v"(vn0_14) : "v"((const unsigned char*)(vbn + (size_t)(50) * vrow + 0) + voff2) : "memory");
          asm volatile("global_load_ushort %0, %1, off" : "+v"(vn0_15) : "v"((const unsigned char*)(vbn + (size_t)(51) * vrow + 0) + voff2) : "memory");
          asm volatile("global_load_ushort %0, %1, off" : "+v"(vn1_0) : "v"((const unsigned char*)(vbn + (size_t)(0) * vrow + 32) + voff2) : "memory");
          asm volatile("global_load_ushort %0, %1, off" : "+v"(vn1_1) : "v"((const unsigned char*)(vbn + (size_t)(1) * vrow + 32) + voff2) : "memory");
          asm volatile("global_load_ushort %0, %1, off" : "+v"(vn1_2) : "v"((const unsigned char*)(vbn + (size_t)(2) * vrow + 32) + voff2) : "memory");
          asm volatile("global_load_ushort %0, %1, off" : "+v"(vn1_3) : "v"((const unsigned char*)(vbn + (size_t)(3) * vrow + 32) + voff2) : "memory");
          asm volatile("global_load_ushort %0, %1, off" : "+v"(vn1_4) : "v"((const unsigned char*)(vbn + (size_t)(16) * vrow + 32) + voff2) : "memory");
          asm volatile("global_load_ushort %0, %1, off" : "+v"(vn1_5) : "v"((const unsigned char*)(vbn + (size_t)(17) * vrow + 32) + voff2) : "memory");
          asm volatile("global_load_ushort %0, %1, off" : "+v"(vn1_6) : "v"((const unsigned char*)(vbn + (size_t)(18) * vrow + 32) + voff2) : "memory");
          asm volatile("global_load_ushort %0, %1, off" : "+v"(vn1_7) : "v"((const unsigned char*)(vbn + (size_t)(19) * vrow + 32) + voff2) : "memory");
          asm volatile("global_load_ushort %0, %1, off" : "+v"(vn1_8) : "v"((const unsigned char*)(vbn + (size_t)(32) * vrow + 32) + voff2) : "memory");
          asm volatile("global_load_ushort %0, %1, off" : "+v"(vn1_9) : "v"((const unsigned char*)(vbn + (size_t)(33) * vrow + 32) + voff2) : "memory");
          asm volatile("global_load_ushort %0, %1, off" : "+v"(vn1_10) : "v"((const unsigned char*)(vbn + (size_t)(34) * vrow + 32) + voff2) : "memory");
          asm volatile("global_load_ushort %0, %1, off" : "+v"(vn1_11) : "v"((const unsigned char*)(vbn + (size_t)(35) * vrow + 32) + voff2) : "memory");
          asm volatile("global_load_ushort %0, %1, off" : "+v"(vn1_12) : "v"((const unsigned char*)(vbn + (size_t)(48) * vrow + 32) + voff2) : "memory");
          asm volatile("global_load_ushort %0, %1, off" : "+v"(vn1_13) : "v"((const unsigned char*)(vbn + (size_t)(49) * vrow + 32) + voff2) : "memory");
          asm volatile("global_load_ushort %0, %1, off" : "+v"(vn1_14) : "v"((const unsigned char*)(vbn + (size_t)(50) * vrow + 32) + voff2) : "memory");
          asm volatile("global_load_ushort %0, %1, off" : "+v"(vn1_15) : "v"((const unsigned char*)(vbn + (size_t)(51) * vrow + 32) + voff2) : "memory");
        }
        __builtin_amdgcn_sched_barrier(0);
        bf16x8 vp0_0, vp0_1;
        { u32x4 w; w.x = cvt_pk_bf16(a0_0[0], a0_0[1]); w.y = cvt_pk_bf16(a0_0[2], a0_0[3]); w.z = cvt_pk_bf16(a0_1[0], a0_1[1]); w.w = cvt_pk_bf16(a0_1[2], a0_1[3]); vp0_0 = __builtin_bit_cast(bf16x8, w); }
        { u32x4 w; w.x = cvt_pk_bf16(a0_2[0], a0_2[1]); w.y = cvt_pk_bf16(a0_2[2], a0_2[3]); w.z = cvt_pk_bf16(a0_3[0], a0_3[1]); w.w = cvt_pk_bf16(a0_3[2], a0_3[3]); vp0_1 = __builtin_bit_cast(bf16x8, w); }
        bf16x8 vp1_0, vp1_1;
        { u32x4 w; w.x = cvt_pk_bf16(a1_0[0], a1_0[1]); w.y = cvt_pk_bf16(a1_0[2], a1_0[3]); w.z = cvt_pk_bf16(a1_1[0], a1_1[1]); w.w = cvt_pk_bf16(a1_1[2], a1_1[3]); vp1_0 = __builtin_bit_cast(bf16x8, w); }
        { u32x4 w; w.x = cvt_pk_bf16(a1_2[0], a1_2[1]); w.y = cvt_pk_bf16(a1_2[2], a1_2[3]); w.z = cvt_pk_bf16(a1_3[0], a1_3[1]); w.w = cvt_pk_bf16(a1_3[2], a1_3[3]); vp1_1 = __builtin_bit_cast(bf16x8, w); }
        { unsigned sp_ = 0; while (*(volatile LAS unsigned*)(xl + XL_CNT + 64) + 2u <= (unsigned)n) { __builtin_amdgcn_s_sleep(1); if (++sp_ > (1u << 22)) break; } }
        { LAS bf16x8* sl_ = (LAS bf16x8*)(xl + (n & 1) * XL_SLOT) + lane; sl_[0] = Sp0_0; sl_[64] = Sp0_1; sl_[128] = Sp0_2; sl_[192] = Sp0_3; sl_[256] = vp0_0; sl_[320] = vp0_1; sl_[384] = Sp1_0; sl_[448] = Sp1_1; sl_[512] = Sp1_2; sl_[576] = Sp1_3; sl_[640] = vp1_0; sl_[704] = vp1_1; }
        asm volatile("s_waitcnt lgkmcnt(0)" ::: "memory");
        if (lane == 0) *(volatile LAS unsigned*)(xl + XL_CNT) = (unsigned)(n + 1);
        S0_0 = S0_0 * dec;
        S1_0 = S1_0 * dec;
        asm volatile("s_waitcnt vmcnt(47)" : "+v"(r0));
        S0_0 = mfma16(r0, vp0_0, S0_0);
        S1_0 = mfma16(r0, vp1_0, S1_0);
        asm volatile("global_load_dwordx4 %0, %1, off" : "+v"(r0) : "v"((const unsigned char*)(sp0 + ((size_t)(n + 1) * 40 + 24) * 1024) + voff) : "memory");
        __builtin_amdgcn_sched_barrier(0);
        asm volatile("s_waitcnt vmcnt(47)" : "+v"(r1));
        S0_0 = mfma16(r1, vp0_1, S0_0);
        S1_0 = mfma16(r1, vp1_1, S1_0);
        asm volatile("global_load_dwordx4 %0, %1, off" : "+v"(r1) : "v"((const unsigned char*)(sp0 + ((size_t)(n + 1) * 40 + 25) * 1024) + voff) : "memory");
        __builtin_amdgcn_sched_barrier(0);
        S0_1 = S0_1 * dec;
        S1_1 = S1_1 * dec;
        asm volatile("s_waitcnt vmcnt(47)" : "+v"(r2));
        S0_1 = mfma16(r2, vp0_0, S0_1);
        S1_1 = mfma16(r2, vp1_0, S1_1);
        asm volatile("global_load_dwordx4 %0, %1, off" : "+v"(r2) : "v"((const unsigned char*)(sp0 + ((size_t)(n + 1) * 40 + 26) * 1024) + voff) : "memory");
        __builtin_amdgcn_sched_barrier(0);
        asm volatile("s_waitcnt vmcnt(47)" : "+v"(r3));
        S0_1 = mfma16(r3, vp0_1, S0_1);
        S1_1 = mfma16(r3, vp1_1, S1_1);
        asm volatile("global_load_dwordx4 %0, %1, off" : "+v"(r3) : "v"((const unsigned char*)(sp0 + ((size_t)(n + 1) * 40 + 27) * 1024) + voff) : "memory");
        __builtin_amdgcn_sched_barrier(0);
        S0_2 = S0_2 * dec;
        S1_2 = S1_2 * dec;
        asm volatile("s_waitcnt vmcnt(47)" : "+v"(r4));
        S0_2 = mfma16(r4, vp0_0, S0_2);
        S1_2 = mfma16(r4, vp1_0, S1_2);
        asm volatile("global_load_dwordx4 %0, %1, off" : "+v"(r4) : "v"((const unsigned char*)(sp0 + ((size_t)(n + 1) * 40 + 28) * 1024) + voff) : "memory");
        __builtin_amdgcn_sched_barrier(0);
        asm volatile("s_waitcnt vmcnt(47)" : "+v"(r5));
        S0_2 = mfma16(r5, vp0_1, S0_2);
        S1_2 = mfma16(r5, vp1_1, S1_2);
        asm volatile("global_load_dwordx4 %0, %1, off" : "+v"(r5) : "v"((const unsigned char*)(sp0 + ((size_t)(n + 1) * 40 + 29) * 1024) + voff) : "memory");
        __builtin_amdgcn_sched_barrier(0);
        S0_3 = S0_3 * dec;
        S1_3 = S1_3 * dec;
        asm volatile("s_waitcnt vmcnt(47)" : "+v"(r6));
        S0_3 = mfma16(r6, vp0_0, S0_3);
        S1_3 = mfma16(r6, vp1_0, S1_3);
        asm volatile("global_load_dwordx4 %0, %1, off" : "+v"(r6) : "v"((const unsigned char*)(sp0 + ((size_t)(n + 1) * 40 + 30) * 1024) + voff) : "memory");
        __builtin_amdgcn_sched_barrier(0);
        asm volatile("s_waitcnt vmcnt(47)" : "+v"(r7));
        S0_3 = mfma16(r7, vp0_1, S0_3);
        S1_3 = mfma16(r7, vp1_1, S1_3);
        asm volatile("global_load_dwordx4 %0, %1, off" : "+v"(r7) : "v"((const unsigned char*)(sp0 + ((size_t)(n + 1) * 40 + 31) * 1024) + voff) : "memory");
        __builtin_amdgcn_sched_barrier(0);
        S0_4 = S0_4 * dec;
        S1_4 = S1_4 * dec;
        asm volatile("s_waitcnt vmcnt(47)" : "+v"(r8));
        S0_4 = mfma16(r8, vp0_0, S0_4);
        S1_4 = mfma16(r8, vp1_0, S1_4);
        asm volatile("global_load_dwordx4 %0, %1, off" : "+v"(r8) : "v"((const unsigned char*)(sp0 + ((size_t)(n + 1) * 40 + 32) * 1024) + voff) : "memory");
        __builtin_amdgcn_sched_barrier(0);
        asm volatile("s_waitcnt vmcnt(47)" : "+v"(r9));
        S0_4 = mfma16(r9, vp0_1, S0_4);
        S1_4 = mfma16(r9, vp1_1, S1_4);
        asm volatile("global_load_dwordx4 %0, %1, off" : "+v"(r9) : "v"((const unsigned char*)(sp0 + ((size_t)(n + 1) * 40 + 33) * 1024) + voff) : "memory");
        __builtin_amdgcn_sched_barrier(0);
        S0_5 = S0_5 * dec;
        S1_5 = S1_5 * dec;
        asm volatile("s_waitcnt vmcnt(47)" : "+v"(r10));
        S0_5 = mfma16(r10, vp0_0, S0_5);
        S1_5 = mfma16(r10, vp1_0, S1_5);
        asm volatile("global_load_dwordx4 %0, %1, off" : "+v"(r10) : "v"((const unsigned char*)(sp0 + ((size_t)(n + 1) * 40 + 34) * 1024) + voff) : "memory");
        __builtin_amdgcn_sched_barrier(0);
        asm volatile("s_waitcnt vmcnt(47)" : "+v"(r11));
        S0_5 = mfma16(r11, vp0_1, S0_5);
        S1_5 = mfma16(r11, vp1_1, S1_5);
        asm volatile("global_load_dwordx4 %0, %1, off" : "+v"(r11) : "v"((const unsigned char*)(sp0 + ((size_t)(n + 1) * 40 + 35) * 1024) + voff) : "memory");
        __builtin_amdgcn_sched_barrier(0);
        S0_6 = S0_6 * dec;
        S1_6 = S1_6 * dec;
        asm volatile("s_waitcnt vmcnt(47)" : "+v"(r12));
        S0_6 = mfma16(r12, vp0_0, S0_6);
        S1_6 = mfma16(r12, vp1_0, S1_6);
        asm volatile("global_load_dwordx4 %0, %1, off" : "+v"(r12) : "v"((const unsigned char*)(sp0 + ((size_t)(n + 1) * 40 + 36) * 1024) + voff) : "memory");
        __builtin_amdgcn_sched_barrier(0);
        asm volatile("s_waitcnt vmcnt(47)" : "+v"(r13));
        S0_6 = mfma16(r13, vp0_1, S0_6);
        S1_6 = mfma16(r13, vp1_1, S1_6);
        asm volatile("global_load_dwordx4 %0, %1, off" : "+v"(r13) : "v"((const unsigned char*)(sp0 + ((size_t)(n + 1) * 40 + 37) * 1024) + voff) : "memory");
        __builtin_amdgcn_sched_barrier(0);
        S0_7 = S0_7 * dec;
        S1_7 = S1_7 * dec;
        asm volatile("s_waitcnt vmcnt(47)" : "+v"(r14));
        S0_7 = mfma16(r14, vp0_0, S0_7);
        S1_7 = mfma16(r14, vp1_0, S1_7);
        asm volatile("global_load_dwordx4 %0, %1, off" : "+v"(r14) : "v"((const unsigned char*)(sp0 + ((size_t)(n + 1) * 40 + 38) * 1024) + voff) : "memory");
        __builtin_amdgcn_sched_barrier(0);
        asm volatile("s_waitcnt vmcnt(47)" : "+v"(r15));
        S0_7 = mfma16(r15, vp0_1, S0_7);
        S1_7 = mfma16(r15, vp1_1, S1_7);
        asm volatile("global_load_dwordx4 %0, %1, off" : "+v"(r15) : "v"((const unsigned char*)(sp0 + ((size_t)(n + 1) * 40 + 39) * 1024) + voff) : "memory");
        __builtin_amdgcn_sched_barrier(0);
        { u32x4 w; w.x = cvt_pk_bf16(S0_0[0], S0_0[1]); w.y = cvt_pk_bf16(S0_0[2], S0_0[3]); w.z = cvt_pk_bf16(S0_1[0], S0_1[1]); w.w = cvt_pk_bf16(S0_1[2], S0_1[3]); Sp0_0 = __builtin_bit_cast(bf16x8, w); }
        { u32x4 w; w.x = cvt_pk_bf16(S0_2[0], S0_2[1]); w.y = cvt_pk_bf16(S0_2[2], S0_2[3]); w.z = cvt_pk_bf16(S0_3[0], S0_3[1]); w.w = cvt_pk_bf16(S0_3[2], S0_3[3]); Sp0_1 = __builtin_bit_cast(bf16x8, w); }
        { u32x4 w; w.x = cvt_pk_bf16(S0_4[0], S0_4[1]); w.y = cvt_pk_bf16(S0_4[2], S0_4[3]); w.z = cvt_pk_bf16(S0_5[0], S0_5[1]); w.w = cvt_pk_bf16(S0_5[2], S0_5[3]); Sp0_2 = __builtin_bit_cast(bf16x8, w); }
        { u32x4 w; w.x = cvt_pk_bf16(S0_6[0], S0_6[1]); w.y = cvt_pk_bf16(S0_6[2], S0_6[3]); w.z = cvt_pk_bf16(S0_7[0], S0_7[1]); w.w = cvt_pk_bf16(S0_7[2], S0_7[3]); Sp0_3 = __builtin_bit_cast(bf16x8, w); }
        { u32x4 w; w.x = cvt_pk_bf16(S1_0[0], S1_0[1]); w.y = cvt_pk_bf16(S1_0[2], S1_0[3]); w.z = cvt_pk_bf16(S1_1[0], S1_1[1]); w.w = cvt_pk_bf16(S1_1[2], S1_1[3]); Sp1_0 = __builtin_bit_cast(bf16x8, w); }
        { u32x4 w; w.x = cvt_pk_bf16(S1_2[0], S1_2[1]); w.y = cvt_pk_bf16(S1_2[2], S1_2[3]); w.z = cvt_pk_bf16(S1_3[0], S1_3[1]); w.w = cvt_pk_bf16(S1_3[2], S1_3[3]); Sp1_1 = __builtin_bit_cast(bf16x8, w); }
        { u32x4 w; w.x = cvt_pk_bf16(S1_4[0], S1_4[1]); w.y = cvt_pk_bf16(S1_4[2], S1_4[3]); w.z = cvt_pk_bf16(S1_5[0], S1_5[1]); w.w = cvt_pk_bf16(S1_5[2], S1_5[3]); Sp1_2 = __builtin_bit_cast(bf16x8, w); }
        { u32x4 w; w.x = cvt_pk_bf16(S1_6[0], S1_6[1]); w.y = cvt_pk_bf16(S1_6[2], S1_6[3]); w.z = cvt_pk_bf16(S1_7[0], S1_7[1]); w.w = cvt_pk_bf16(S1_7[2], S1_7[3]); Sp1_3 = __builtin_bit_cast(bf16x8, w); }
    }
    asm volatile("s_waitcnt vmcnt(0)" ::: "memory");
    } else {
    bf16x8 r0 = (bf16x8){0, 0, 0, 0, 0, 0, 0, 0};
    bf16x8 r1 = (bf16x8){0, 0, 0, 0, 0, 0, 0, 0};
    bf16x8 r2 = (bf16x8){0, 0, 0, 0, 0, 0, 0, 0};
    bf16x8 r3 = (bf16x8){0, 0, 0, 0, 0, 0, 0, 0};
    bf16x8 r4 = (bf16x8){0, 0, 0, 0, 0, 0, 0, 0};
    bf16x8 r5 = (bf16x8){0, 0, 0, 0, 0, 0, 0, 0};
    bf16x8 r6 = (bf16x8){0, 0, 0, 0, 0, 0, 0, 0};
    bf16x8 r7 = (bf16x8){0, 0, 0, 0, 0, 0, 0, 0};
    bf16x8 r8 = (bf16x8){0, 0, 0, 0, 0, 0, 0, 0};
    bf16x8 r9 = (bf16x8){0, 0, 0, 0, 0, 0, 0, 0};
    bf16x8 r10 = (bf16x8){0, 0, 0, 0, 0, 0, 0, 0};
    bf16x8 r11 = (bf16x8){0, 0, 0, 0, 0, 0, 0, 0};
    bf16x8 r12 = (bf16x8){0, 0, 0, 0, 0, 0, 0, 0};
    bf16x8 r13 = (bf16x8){0, 0, 0, 0, 0, 0, 0, 0};
    bf16x8 r14 = (bf16x8){0, 0, 0, 0, 0, 0, 0, 0};
    bf16x8 r15 = (bf16x8){0, 0, 0, 0, 0, 0, 0, 0};
    bf16x8 r16 = (bf16x8){0, 0, 0, 0, 0, 0, 0, 0};
    bf16x8 r17 = (bf16x8){0, 0, 0, 0, 0, 0, 0, 0};
    bf16x8 r18 = (bf16x8){0, 0, 0, 0, 0, 0, 0, 0};
    bf16x8 r19 = (bf16x8){0, 0, 0, 0, 0, 0, 0, 0};
    bf16x8 r20 = (bf16x8){0, 0, 0, 0, 0, 0, 0, 0};
    bf16x8 r21 = (bf16x8){0, 0, 0, 0, 0, 0, 0, 0};
    bf16x8 r22 = (bf16x8){0, 0, 0, 0, 0, 0, 0, 0};
    bf16x8 r23 = (bf16x8){0, 0, 0, 0, 0, 0, 0, 0};
    asm volatile("global_load_dwordx4 %0, %1, off" : "+v"(r0) : "v"((const unsigned char*)(sp0 + ((size_t)(0 + 0) * 40 + 0) * 1024) + voff) : "memory");
    asm volatile("global_load_dwordx4 %0, %1, off" : "+v"(r1) : "v"((const unsigned char*)(sp0 + ((size_t)(0 + 0) * 40 + 1) * 1024) + voff) : "memory");
    asm volatile("global_load_dwordx4 %0, %1, off" : "+v"(r2) : "v"((const unsigned char*)(sp0 + ((size_t)(0 + 0) * 40 + 2) * 1024) + voff) : "memory");
    asm volatile("global_load_dwordx4 %0, %1, off" : "+v"(r3) : "v"((const unsigned char*)(sp0 + ((size_t)(0 + 0) * 40 + 3) * 1024) + voff) : "memory");
    asm volatile("global_load_dwordx4 %0, %1, off" : "+v"(r4) : "v"((const unsigned char*)(sp0 + ((size_t)(0 + 0) * 40 + 4) * 1024) + voff) : "memory");
    asm volatile("global_load_dwordx4 %0, %1, off" : "+v"(r5) : "v"((const unsigned char*)(sp0 + ((size_t)(0 + 0) * 40 + 5) * 1024) + voff) : "memory");
    asm volatile("global_load_dwordx4 %0, %1, off" : "+v"(r6) : "v"((const unsigned char*)(sp0 + ((size_t)(0 + 0) * 40 + 6) * 1024) + voff) : "memory");
    asm volatile("global_load_dwordx4 %0, %1, off" : "+v"(r7) : "v"((const unsigned char*)(sp0 + ((size_t)(0 + 0) * 40 + 7) * 1024) + voff) : "memory");
    asm volatile("global_load_dwordx4 %0, %1, off" : "+v"(r8) : "v"((const unsigned char*)(sp0 + ((size_t)(0 + 0) * 40 + 8) * 1024) + voff) : "memory");
    asm volatile("global_load_dwordx4 %0, %1, off" : "+v"(r9) : "v"((const unsigned char*)(sp0 + ((size_t)(0 + 0) * 40 + 9) * 1024) + voff) : "memory");
    asm volatile("global_load_dwordx4 %0, %1, off" : "+v"(r10) : "v"((const unsigned char*)(sp0 + ((size_t)(0 + 0) * 40 + 10) * 1024) + voff) : "memory");
    asm volatile("global_load_dwordx4 %0, %1, off" : "+v"(r11) : "v"((const unsigned char*)(sp0 + ((size_t)(0 + 0) * 40 + 11) * 1024) + voff) : "memory");
    asm volatile("global_load_dwordx4 %0, %1, off" : "+v"(r12) : "v"((const unsigned char*)(sp0 + ((size_t)(0 + 0) * 40 + 12) * 1024) + voff) : "memory");
    asm volatile("global_load_dwordx4 %0, %1, off" : "+v"(r13) : "v"((const unsigned char*)(sp0 + ((size_t)(0 + 0) * 40 + 13) * 1024) + voff) : "memory");
    asm volatile("global_load_dwordx4 %0, %1, off" : "+v"(r14) : "v"((const unsigned char*)(sp0 + ((size_t)(0 + 0) * 40 + 14) * 1024) + voff) : "memory");
    asm volatile("global_load_dwordx4 %0, %1, off" : "+v"(r15) : "v"((const unsigned char*)(sp0 + ((size_t)(0 + 0) * 40 + 15) * 1024) + voff) : "memory");
    asm volatile("global_load_dwordx4 %0, %1, off" : "+v"(r16) : "v"((const unsigned char*)(sp0 + ((size_t)(0 + 0) * 40 + 16) * 1024) + voff) : "memory");
    asm volatile("global_load_dwordx4 %0, %1, off" : "+v"(r17) : "v"((const unsigned char*)(sp0 + ((size_t)(0 + 0) * 40 + 17) * 1024) + voff) : "memory");
    asm volatile("global_load_dwordx4 %0, %1, off" : "+v"(r18) : "v"((const unsigned char*)(sp0 + ((size_t)(0 + 0) * 40 + 18) * 1024) + voff) : "memory");
    asm volatile("global_load_dwordx4 %0, %1, off" : "+v"(r19) : "v"((const unsigned char*)(sp0 + ((size_t)(0 + 0) * 40 + 19) * 1024) + voff) : "memory");
    asm volatile("global_load_dwordx4 %0, %1, off" : "+v"(r20) : "v"((const unsigned char*)(sp0 + ((size_t)(0 + 0) * 40 + 20) * 1024) + voff) : "memory");
    asm volatile("global_load_dwordx4 %0, %1, off" : "+v"(r21) : "v"((const unsigned char*)(sp0 + ((size_t)(0 + 0) * 40 + 21) * 1024) + voff) : "memory");
    asm volatile("global_load_dwordx4 %0, %1, off" : "+v"(r22) : "v"((const unsigned char*)(sp0 + ((size_t)(0 + 0) * 40 + 22) * 1024) + voff) : "memory");
    asm volatile("global_load_dwordx4 %0, %1, off" : "+v"(r23) : "v"((const unsigned char*)(sp0 + ((size_t)(0 + 0) * 40 + 23) * 1024) + voff) : "memory");
    { unsigned z = 0u;
      asm volatile("global_store_short %0, %1, off" :: "v"((const unsigned char*)(obu + (size_t)(0) * orow + 0) + ooff), "v"(z) : "memory");
      asm volatile("global_store_short %0, %1, off" :: "v"((const unsigned char*)(obu + (size_t)(1) * orow + 0) + ooff), "v"(z) : "memory");
      asm volatile("global_store_short %0, %1, off" :: "v"((const unsigned char*)(obu + (size_t)(2) * orow + 0) + ooff), "v"(z) : "memory");
      asm volatile("global_store_short %0, %1, off" :: "v"((const unsigned char*)(obu + (size_t)(3) * orow + 0) + ooff), "v"(z) : "memory");
      asm volatile("global_store_short %0, %1, off" :: "v"((const unsigned char*)(obu + (size_t)(16) * orow + 0) + ooff), "v"(z) : "memory");
      asm volatile("global_store_short %0, %1, off" :: "v"((const unsigned char*)(obu + (size_t)(17) * orow + 0) + ooff), "v"(z) : "memory");
      asm volatile("global_store_short %0, %1, off" :: "v"((const unsigned char*)(obu + (size_t)(18) * orow + 0) + ooff), "v"(z) : "memory");
      asm volatile("global_store_short %0, %1, off" :: "v"((const unsigned char*)(obu + (size_t)(19) * orow + 0) + ooff), "v"(z) : "memory");
      asm volatile("global_store_short %0, %1, off" :: "v"((const unsigned char*)(obu + (size_t)(32) * orow + 0) + ooff), "v"(z) : "memory");
      asm volatile("global_store_short %0, %1, off" :: "v"((const unsigned char*)(obu + (size_t)(33) * orow + 0) + ooff), "v"(z) : "memory");
      asm volatile("global_store_short %0, %1, off" :: "v"((const unsigned char*)(obu + (size_t)(34) * orow + 0) + ooff), "v"(z) : "memory");
      asm volatile("global_store_short %0, %1, off" :: "v"((const unsigned char*)(obu + (size_t)(35) * orow + 0) + ooff), "v"(z) : "memory");
      asm volatile("global_store_short %0, %1, off" :: "v"((const unsigned char*)(obu + (size_t)(48) * orow + 0) + ooff), "v"(z) : "memory");
      asm volatile("global_store_short %0, %1, off" :: "v"((const unsigned char*)(obu + (size_t)(49) * orow + 0) + ooff), "v"(z) : "memory");
      asm volatile("global_store_short %0, %1, off" :: "v"((const unsigned char*)(obu + (size_t)(50) * orow + 0) + ooff), "v"(z) : "memory");
      asm volatile("global_store_short %0, %1, off" :: "v"((const unsigned char*)(obu + (size_t)(51) * orow + 0) + ooff), "v"(z) : "memory");
      asm volatile("global_store_short %0, %1, off" :: "v"((const unsigned char*)(obu + (size_t)(0) * orow + 32) + ooff), "v"(z) : "memory");
      asm volatile("global_store_short %0, %1, off" :: "v"((const unsigned char*)(obu + (size_t)(1) * orow + 32) + ooff), "v"(z) : "memory");
      asm volatile("global_store_short %0, %1, off" :: "v"((const unsigned char*)(obu + (size_t)(2) * orow + 32) + ooff), "v"(z) : "memory");
      asm volatile("global_store_short %0, %1, off" :: "v"((const unsigned char*)(obu + (size_t)(3) * orow + 32) + ooff), "v"(z) : "memory");
      asm volatile("global_store_short %0, %1, off" :: "v"((const unsigned char*)(obu + (size_t)(16) * orow + 32) + ooff), "v"(z) : "memory");
      asm volatile("global_store_short %0, %1, off" :: "v"((const unsigned char*)(obu + (size_t)(17) * orow + 32) + ooff), "v"(z) : "memory");
      asm volatile("global_store_short %0, %1, off" :: "v"((const unsigned char*)(obu + (size_t)(18) * orow + 32) + ooff), "v"(z) : "memory");
      asm volatile("global_store_short %0, %1, off" :: "v"((const unsigned char*)(obu + (size_t)(19) * orow + 32) + ooff), "v"(z) : "memory");
      asm volatile("global_store_short %0, %1, off" :: "v"((const unsigned char*)(obu + (size_t)(32) * orow + 32) + ooff), "v"(z) : "memory");
      asm volatile("global_store_short %0, %1, off" :: "v"((const unsigned char*)(obu + (size_t)(33) * orow + 32) + ooff), "v"(z) : "memory");
      asm volatile("global_store_short %0, %1, off" :: "v"((const unsigned char*)(obu + (size_t)(34) * orow + 32) + ooff), "v"(z) : "memory");
      asm volatile("global_store_short %0, %1, off" :: "v"((const unsigned char*)(obu + (size_t)(35) * orow + 32) + ooff), "v"(z) : "memory");
      asm volatile("global_store_short %0, %1, off" :: "v"((const unsigned char*)(obu + (size_t)(48) * orow + 32) + ooff), "v"(z) : "memory");
      asm volatile("global_store_short %0, %1, off" :: "v"((const unsigned char*)(obu + (size_t)(49) * orow + 32) + ooff), "v"(z) : "memory");
      asm volatile("global_store_short %0, %1, off" :: "v"((const unsigned char*)(obu + (size_t)(50) * orow + 32) + ooff), "v"(z) : "memory");
      asm volatile("global_store_short %0, %1, off" :: "v"((const unsigned char*)(obu + (size_t)(51) * orow + 32) + ooff), "v"(z) : "memory");
    }
#pragma unroll 1
    for (int n = 0; n < NCH; ++n) {
        { unsigned sp_ = 0; while (*(volatile LAS unsigned*)(xl + XL_CNT) <= (unsigned)n) { __builtin_amdgcn_s_sleep(1); if (++sp_ > (1u << 22)) break; } }
        bf16x8 Sp0_0, Sp0_1, Sp0_2, Sp0_3, vp0_0, vp0_1;
        bf16x8 Sp1_0, Sp1_1, Sp1_2, Sp1_3, vp1_0, vp1_1;
        { const LAS bf16x8* sl_ = (const LAS bf16x8*)(xl + (n & 1) * XL_SLOT) + lane; Sp0_0 = sl_[0]; Sp0_1 = sl_[64]; Sp0_2 = sl_[128]; Sp0_3 = sl_[192]; vp0_0 = sl_[256]; vp0_1 = sl_[320]; Sp1_0 = sl_[384]; Sp1_1 = sl_[448]; Sp1_2 = sl_[512]; Sp1_3 = sl_[576]; vp1_0 = sl_[640]; vp1_1 = sl_[704]; }
        asm volatile("s_waitcnt lgkmcnt(0)" ::: "memory");
        if (lane == 0) *(volatile LAS unsigned*)(xl + XL_CNT + 64) = (unsigned)(n + 1);
        f32x4 o0_0 = {0.f, 0.f, 0.f, 0.f}, o0_1 = o0_0, o0_2 = o0_0, o0_3 = o0_0;
        f32x4 o1_0 = {0.f, 0.f, 0.f, 0.f}, o1_1 = o1_0, o1_2 = o1_0, o1_3 = o1_0;
        asm volatile("s_waitcnt vmcnt(55)" : "+v"(r0));
        o0_0 = mfma16(r0, Sp0_0, o0_0);
        o1_0 = mfma16(r0, Sp1_0, o1_0);
        asm volatile("global_load_dwordx4 %0, %1, off" : "+v"(r0) : "v"((const unsigned char*)(sp0 + ((size_t)(n + 1) * 40 + 0) * 1024) + voff) : "memory");
        __builtin_amdgcn_sched_barrier(0);
        asm volatile("s_waitcnt vmcnt(55)" : "+v"(r1));
        o0_0 = mfma16(r1, Sp0_1, o0_0);
        o1_0 = mfma16(r1, Sp1_1, o1_0);
        asm volatile("global_load_dwordx4 %0, %1, off" : "+v"(r1) : "v"((const unsigned char*)(sp0 + ((size_t)(n + 1) * 40 + 1) * 1024) + voff) : "memory");
        __builtin_amdgcn_sched_barrier(0);
        asm volatile("s_waitcnt vmcnt(55)" : "+v"(r2));
        o0_0 = mfma16(r2, Sp0_2, o0_0);
        o1_0 = mfma16(r2, Sp1_2, o1_0);
        asm volatile("global_load_dwordx4 %0, %1, off" : "+v"(r2) : "v"((const unsigned char*)(sp0 + ((size_t)(n + 1) * 40 + 2) * 1024) + voff) : "memory");
        __builtin_amdgcn_sched_barrier(0);
        asm volatile("s_waitcnt vmcnt(55)" : "+v"(r3));
        o0_0 = mfma16(r3, Sp0_3, o0_0);
        o1_0 = mfma16(r3, Sp1_3, o1_0);
        asm volatile("global_load_dwordx4 %0, %1, off" : "+v"(r3) : "v"((const unsigned char*)(sp0 + ((size_t)(n + 1) * 40 + 3) * 1024) + voff) : "memory");
        __builtin_amdgcn_sched_barrier(0);
        asm volatile("s_waitcnt vmcnt(55)" : "+v"(r4));
        o0_1 = mfma16(r4, Sp0_0, o0_1);
        o1_1 = mfma16(r4, Sp1_0, o1_1);
        asm volatile("global_load_dwordx4 %0, %1, off" : "+v"(r4) : "v"((const unsigned char*)(sp0 + ((size_t)(n + 1) * 40 + 4) * 1024) + voff) : "memory");
        __builtin_amdgcn_sched_barrier(0);
        asm volatile("s_waitcnt vmcnt(55)" : "+v"(r5));
        o0_1 = mfma16(r5, Sp0_1, o0_1);
        o1_1 = mfma16(r5, Sp1_1, o1_1);
        asm volatile("global_load_dwordx4 %0, %1, off" : "+v"(r5) : "v"((const unsigned char*)(sp0 + ((size_t)(n + 1) * 40 + 5) * 1024) + voff) : "memory");
        __builtin_amdgcn_sched_barrier(0);
        asm volatile("s_waitcnt vmcnt(55)" : "+v"(r6));
        o0_1 = mfma16(r6, Sp0_2, o0_1);
        o1_1 = mfma16(r6, Sp1_2, o1_1);
        asm volatile("global_load_dwordx4 %0, %1, off" : "+v"(r6) : "v"((const unsigned char*)(sp0 + ((size_t)(n + 1) * 40 + 6) * 1024) + voff) : "memory");
        __builtin_amdgcn_sched_barrier(0);
        asm volatile("s_waitcnt vmcnt(55)" : "+v"(r7));
        o0_1 = mfma16(r7, Sp0_3, o0_1);
        o1_1 = mfma16(r7, Sp1_3, o1_1);
        asm volatile("global_load_dwordx4 %0, %1, off" : "+v"(r7) : "v"((const unsigned char*)(sp0 + ((size_t)(n + 1) * 40 + 7) * 1024) + voff) : "memory");
        __builtin_amdgcn_sched_barrier(0);
        asm volatile("s_waitcnt vmcnt(55)" : "+v"(r8));
        o0_2 = mfma16(r8, Sp0_0, o0_2);
        o1_2 = mfma16(r8, Sp1_0, o1_2);
        asm volatile("global_load_dwordx4 %0, %1, off" : "+v"(r8) : "v"((const unsigned char*)(sp0 + ((size_t)(n + 1) * 40 + 8) * 1024) + voff) : "memory");
        __builtin_amdgcn_sched_barrier(0);
        asm volatile("s_waitcnt vmcnt(55)" : "+v"(r9));
        o0_2 = mfma16(r9, Sp0_1, o0_2);
        o1_2 = mfma16(r9, Sp1_1, o1_2);
        asm volatile("global_load_dwordx4 %0, %1, off" : "+v"(r9) : "v"((const unsigned char*)(sp0 + ((size_t)(n + 1) * 40 + 9) * 1024) + voff) : "memory");
        __builtin_amdgcn_sched_barrier(0);
        asm volatile("s_waitcnt vmcnt(55)" : "+v"(r10));
        o0_2 = mfma16(r10, Sp0_2, o0_2);
        o1_2 = mfma16(r10, Sp1_2, o1_2);
        asm volatile("global_load_dwordx4 %0, %1, off" : "+v"(r10) : "v"((const unsigned char*)(sp0 + ((size_t)(n + 1) * 40 + 10) * 1024) + voff) : "memory");
        __builtin_amdgcn_sched_barrier(0);
        asm volatile("s_waitcnt vmcnt(55)" : "+v"(r11));
        o0_2 = mfma16(r11, Sp0_3, o0_2);
        o1_2 = mfma16(r11, Sp1_3, o1_2);
        asm volatile("global_load_dwordx4 %0, %1, off" : "+v"(r11) : "v"((const unsigned char*)(sp0 + ((size_t)(n + 1) * 40 + 11) * 1024) + voff) : "memory");
        __builtin_amdgcn_sched_barrier(0);
        asm volatile("s_waitcnt vmcnt(55)" : "+v"(r12));
        o0_3 = mfma16(r12, Sp0_0, o0_3);
        o1_3 = mfma16(r12, Sp1_0, o1_3);
        asm volatile("global_load_dwordx4 %0, %1, off" : "+v"(r12) : "v"((const unsigned char*)(sp0 + ((size_t)(n + 1) * 40 + 12) * 1024) + voff) : "memory");
        __builtin_amdgcn_sched_barrier(0);
        asm volatile("s_waitcnt vmcnt(55)" : "+v"(r13));
        o0_3 = mfma16(r13, Sp0_1, o0_3);
        o1_3 = mfma16(r13, Sp1_1, o1_3);
        asm volatile("global_load_dwordx4 %0, %1, off" : "+v"(r13) : "v"((const unsigned char*)(sp0 + ((size_t)(n + 1) * 40 + 13) * 1024) + voff) : "memory");
        __builtin_amdgcn_sched_barrier(0);
        asm volatile("s_waitcnt vmcnt(55)" : "+v"(r14));
        o0_3 = mfma16(r14, Sp0_2, o0_3);
        o1_3 = mfma16(r14, Sp1_2, o1_3);
        asm volatile("global_load_dwordx4 %0, %1, off" : "+v"(r14) : "v"((const unsigned char*)(sp0 + ((size_t)(n + 1) * 40 + 14) * 1024) + voff) : "memory");
        __builtin_amdgcn_sched_barrier(0);
        asm volatile("s_waitcnt vmcnt(55)" : "+v"(r15));
        o0_3 = mfma16(r15, Sp0_3, o0_3);
        o1_3 = mfma16(r15, Sp1_3, o1_3);
        asm volatile("global_load_dwordx4 %0, %1, off" : "+v"(r15) : "v"((const unsigned char*)(sp0 + ((size_t)(n + 1) * 40 + 15) * 1024) + voff) : "memory");
        __builtin_amdgcn_sched_barrier(0);
        asm volatile("s_waitcnt vmcnt(55)" : "+v"(r16));
        o0_0 = mfma16(r16, vp0_0, o0_0);
        o1_0 = mfma16(r16, vp1_0, o1_0);
        asm volatile("global_load_dwordx4 %0, %1, off" : "+v"(r16) : "v"((const unsigned char*)(sp0 + ((size_t)(n + 1) * 40 + 16) * 1024) + voff) : "memory");
        __builtin_amdgcn_sched_barrier(0);
        asm volatile("s_waitcnt vmcnt(55)" : "+v"(r17));
        o0_0 = mfma16(r17, vp0_1, o0_0);
        o1_0 = mfma16(r17, vp1_1, o1_0);
        asm volatile("global_load_dwordx4 %0, %1, off" : "+v"(r17) : "v"((const unsigned char*)(sp0 + ((size_t)(n + 1) * 40 + 17) * 1024) + voff) : "memory");
        __builtin_amdgcn_sched_barrier(0);
        asm volatile("s_waitcnt vmcnt(55)" : "+v"(r18));
        o0_1 = mfma16(r18, vp0_0, o0_1);
        o1_1 = mfma16(r18, vp1_0, o1_1);
        asm volatile("global_load_dwordx4 %0, %1, off" : "+v"(r18) : "v"((const unsigned char*)(sp0 + ((size_t)(n + 1) * 40 + 18) * 1024) + voff) : "memory");
        __builtin_amdgcn_sched_barrier(0);
        asm volatile("s_waitcnt vmcnt(55)" : "+v"(r19));
        o0_1 = mfma16(r19, vp0_1, o0_1);
        o1_1 = mfma16(r19, vp1_1, o1_1);
        asm volatile("global_load_dwordx4 %0, %1, off" : "+v"(r19) : "v"((const unsigned char*)(sp0 + ((size_t)(n + 1) * 40 + 19) * 1024) + voff) : "memory");
        __builtin_amdgcn_sched_barrier(0);
        asm volatile("s_waitcnt vmcnt(55)" : "+v"(r20));
        o0_2 = mfma16(r20, vp0_0, o0_2);
        o1_2 = mfma16(r20, vp1_0, o1_2);
        asm volatile("global_load_dwordx4 %0, %1, off" : "+v"(r20) : "v"((const unsigned char*)(sp0 + ((size_t)(n + 1) * 40 + 20) * 1024) + voff) : "memory");
        __builtin_amdgcn_sched_barrier(0);
        asm volatile("s_waitcnt vmcnt(55)" : "+v"(r21));
        o0_2 = mfma16(r21, vp0_1, o0_2);
        o1_2 = mfma16(r21, vp1_1, o1_2);
        asm volatile("global_load_dwordx4 %0, %1, off" : "+v"(r21) : "v"((const unsigned char*)(sp0 + ((size_t)(n + 1) * 40 + 21) * 1024) + voff) : "memory");
        __builtin_amdgcn_sched_barrier(0);
        asm volatile("s_waitcnt vmcnt(55)" : "+v"(r22));
        o0_3 = mfma16(r22, vp0_0, o0_3);
        o1_3 = mfma16(r22, vp1_0, o1_3);
        asm volatile("global_load_dwordx4 %0, %1, off" : "+v"(r22) : "v"((const unsigned char*)(sp0 + ((size_t)(n + 1) * 40 + 22) * 1024) + voff) : "memory");
        __builtin_amdgcn_sched_barrier(0);
        asm volatile("s_waitcnt vmcnt(55)" : "+v"(r23));
        o0_3 = mfma16(r23, vp0_1, o0_3);
        o1_3 = mfma16(r23, vp1_1, o1_3);
        asm volatile("global_load_dwordx4 %0, %1, off" : "+v"(r23) : "v"((const unsigned char*)(sp0 + ((size_t)(n + 1) * 40 + 23) * 1024) + voff) : "memory");
        __builtin_amdgcn_sched_barrier(0);
        { const unsigned char* obn = obu + (size_t)n * 64 * orow;
          { const unsigned v = f2bf(o0_0[0]); asm volatile("global_store_short %0, %1, off" :: "v"((const unsigned char*)(obn + (size_t)(0) * orow + 0) + ooff), "v"(v) : "memory"); }
          { const unsigned v = f2bf(o0_0[1]); asm volatile("global_store_short %0, %1, off" :: "v"((const unsigned char*)(obn + (size_t)(1) * orow + 0) + ooff), "v"(v) : "memory"); }
          { const unsigned v = f2bf(o0_0[2]); asm volatile("global_store_short %0, %1, off" :: "v"((const unsigned char*)(obn + (size_t)(2) * orow + 0) + ooff), "v"(v) : "memory"); }
          { const unsigned v = f2bf(o0_0[3]); asm volatile("global_store_short %0, %1, off" :: "v"((const unsigned char*)(obn + (size_t)(3) * orow + 0) + ooff), "v"(v) : "memory"); }
          { const unsigned v = f2bf(o0_1[0]); asm volatile("global_store_short %0, %1, off" :: "v"((const unsigned char*)(obn + (size_t)(16) * orow + 0) + ooff), "v"(v) : "memory"); }
          { const unsigned v = f2bf(o0_1[1]); asm volatile("global_store_short %0, %1, off" :: "v"((const unsigned char*)(obn + (size_t)(17) * orow + 0) + ooff), "v"(v) : "memory"); }
          { const unsigned v = f2bf(o0_1[2]); asm volatile("global_store_short %0, %1, off" :: "v"((const unsigned char*)(obn + (size_t)(18) * orow + 0) + ooff), "v"(v) : "memory"); }
          { const unsigned v = f2bf(o0_1[3]); asm volatile("global_store_short %0, %1, off" :: "v"((const unsigned char*)(obn + (size_t)(19) * orow + 0) + ooff), "v"(v) : "memory"); }
          { const unsigned v = f2bf(o0_2[0]); asm volatile("global_store_short %0, %1, off" :: "v"((const unsigned char*)(obn + (size_t)(32) * orow + 0) + ooff), "v"(v) : "memory"); }
          { const unsigned v = f2bf(o0_2[1]); asm volatile("global_store_short %0, %1, off" :: "v"((const unsigned char*)(obn + (size_t)(33) * orow + 0) + ooff), "v"(v) : "memory"); }
          { const unsigned v = f2bf(o0_2[2]); asm volatile("global_store_short %0, %1, off" :: "v"((const unsigned char*)(obn + (size_t)(34) * orow + 0) + ooff), "v"(v) : "memory"); }
          { const unsigned v = f2bf(o0_2[3]); asm volatile("global_store_short %0, %1, off" :: "v"((const unsigned char*)(obn + (size_t)(35) * orow + 0) + ooff), "v"(v) : "memory"); }
          { const unsigned v = f2bf(o0_3[0]); asm volatile("global_store_short %0, %1, off" :: "v"((const unsigned char*)(obn + (size_t)(48) * orow + 0) + ooff), "v"(v) : "memory"); }
          { const unsigned v = f2bf(o0_3[1]); asm volatile("global_store_short %0, %1, off" :: "v"((const unsigned char*)(obn + (size_t)(49) * orow + 0) + ooff), "v"(v) : "memory"); }
          { const unsigned v = f2bf(o0_3[2]); asm volatile("global_store_short %0, %1, off" :: "v"((const unsigned char*)(obn + (size_t)(50) * orow + 0) + ooff), "v"(v) : "memory"); }
          { const unsigned v = f2bf(o0_3[3]); asm volatile("global_store_short %0, %1, off" :: "v"((const unsigned char*)(obn + (size_t)(51) * orow + 0) + ooff), "v"(v) : "memory"); }
          { const unsigned v = f2bf(o1_0[0]); asm volatile("global_store_short %0, %1, off" :: "v"((const unsigned char*)(obn + (size_t)(0) * orow + 32) + ooff), "v"(v) : "memory"); }
          { const unsigned v = f2bf(o1_0[1]); asm volatile("global_store_short %0, %1, off" :: "v"((const unsigned char*)(obn + (size_t)(1) * orow + 32) + ooff), "v"(v) : "memory"); }
          { const unsigned v = f2bf(o1_0[2]); asm volatile("global_store_short %0, %1, off" :: "v"((const unsigned char*)(obn + (size_t)(2) * orow + 32) + ooff), "v"(v) : "memory"); }
          { const unsigned v = f2bf(o1_0[3]); asm volatile("global_store_short %0, %1, off" :: "v"((const unsigned char*)(obn + (size_t)(3) * orow + 32) + ooff), "v"(v) : "memory"); }
          { const unsigned v = f2bf(o1_1[0]); asm volatile("global_store_short %0, %1, off" :: "v"((const unsigned char*)(obn + (size_t)(16) * orow + 32) + ooff), "v"(v) : "memory"); }
          { const unsigned v = f2bf(o1_1[1]); asm volatile("global_store_short %0, %1, off" :: "v"((const unsigned char*)(obn + (size_t)(17) * orow + 32) + ooff), "v"(v) : "memory"); }
          { const unsigned v = f2bf(o1_1[2]); asm volatile("global_store_short %0, %1, off" :: "v"((const unsigned char*)(obn + (size_t)(18) * orow + 32) + ooff), "v"(v) : "memory"); }
          { const unsigned v = f2bf(o1_1[3]); asm volatile("global_store_short %0, %1, off" :: "v"((const unsigned char*)(obn + (size_t)(19) * orow + 32) + ooff), "v"(v) : "memory"); }
          { const unsigned v = f2bf(o1_2[0]); asm volatile("global_store_short %0, %1, off" :: "v"((const unsigned char*)(obn + (size_t)(32) * orow + 32) + ooff), "v"(v) : "memory"); }
          { const unsigned v = f2bf(o1_2[1]); asm volatile("global_store_short %0, %1, off" :: "v"((const unsigned char*)(obn + (size_t)(33) * orow + 32) + ooff), "v"(v) : "memory"); }
          { const unsigned v = f2bf(o1_2[2]); asm volatile("global_store_short %0, %1, off" :: "v"((const unsigned char*)(obn + (size_t)(34) * orow + 32) + ooff), "v"(v) : "memory"); }
          { const unsigned v = f2bf(o1_2[3]); asm volatile("global_store_short %0, %1, off" :: "v"((const unsigned char*)(obn + (size_t)(35) * orow + 32) + ooff), "v"(v) : "memory"); }
          { const unsigned v = f2bf(o1_3[0]); asm volatile("global_store_short %0, %1, off" :: "v"((const unsigned char*)(obn + (size_t)(48) * orow + 32) + ooff), "v"(v) : "memory"); }
          { const unsigned v = f2bf(o1_3[1]); asm volatile("global_store_short %0, %1, off" :: "v"((const unsigned char*)(obn + (size_t)(49) * orow + 32) + ooff), "v"(v) : "memory"); }
          { const unsigned v = f2bf(o1_3[2]); asm volatile("global_store_short %0, %1, off" :: "v"((const unsigned char*)(obn + (size_t)(50) * orow + 32) + ooff), "v"(v) : "memory"); }
          { const unsigned v = f2bf(o1_3[3]); asm volatile("global_store_short %0, %1, off" :: "v"((const unsigned char*)(obn + (size_t)(51) * orow + 32) + ooff), "v"(v) : "memory"); }
        }
        __builtin_amdgcn_sched_barrier(0);
    }
    asm volatile("s_waitcnt vmcnt(0)" ::: "memory");
    }
}

DI void p4_mixnorm(Frame& F, const float* ret_norm, const float* gdn_norm) {
    bf16_t* pj = (bf16_t*)(F.ws + WS_BIG + BIG_PJ); const bf16_t* vc = (const bf16_t*)(F.ws + AUX_VC); const bf16_t* rr = (const bf16_t*)(F.ws + AUX_QN);
    const int lane = F.lane, l32 = lane & 31, hh = lane >> 5;
    const f32x4 gr0 = *(const f32x4*)(ret_norm + 8 * l32), gr1 = *(const f32x4*)(ret_norm + 8 * l32 + 4), gg0 = *(const f32x4*)(gdn_norm + 8 * l32), gg1 = *(const f32x4*)(gdn_norm + 8 * l32 + 4);
    for (int m = F.gw; m < NTOK; m += F.NGW) {
        bf16_t* row = pj + (size_t)m * PJW;
        u32x4 ro[8], gt[8];
#pragma unroll
        for (int q = 0; q < 8; ++q) { const int hv = 2 * q + hh, hd = hv & 7; const bool gdn = hv >= 8;
            ro[q] = *(const u32x4*)((gdn ? vc : rr) + (size_t)m * 2048 + hd * 256 + 8 * l32);
            gt[q] = *(const u32x4*)(row + (gdn ? C_GZ : C_RG) + hd * 256 + 8 * l32); }
        asm volatile("" ::: "memory");
#pragma unroll
        for (int q = 0; q < 8; ++q) { const int hv = 2 * q + hh, hd = hv & 7; const bool gdn = q >= 4;
            float o[8] = {bflo(ro[q].x), bfhi(ro[q].x), bflo(ro[q].y), bfhi(ro[q].y), bflo(ro[q].z), bfhi(ro[q].z), bflo(ro[q].w), bfhi(ro[q].w)};
            float gv[8] = {bflo(gt[q].x), bfhi(gt[q].x), bflo(gt[q].y), bfhi(gt[q].y), bflo(gt[q].z), bfhi(gt[q].z), bflo(gt[q].w), bfhi(gt[q].w)};
            float ss = 0.f;
#pragma unroll
            for (int e = 0; e < 8; ++e) ss += o[e] * o[e];
            ss += __shfl_xor(ss, 1); ss += __shfl_xor(ss, 2); ss += __shfl_xor(ss, 4); ss += __shfl_xor(ss, 8); ss += __shfl_xor(ss, 16);
            const float rstd = 1.0f / sqrtf(ss * (1.0f / 256.0f) + EPS);
            const f32x4 g0 = gdn ? gg0 : gr0, g1 = gdn ? gg1 : gr1;
            u32x4 w; w.x = pk2(o[0] * rstd * g0.x * siluf(gv[0]), o[1] * rstd * g0.y * siluf(gv[1])); w.y = pk2(o[2] * rstd * g0.z * siluf(gv[2]), o[3] * rstd * g0.w * siluf(gv[3]));
            w.z = pk2(o[4] * rstd * g1.x * siluf(gv[4]), o[5] * rstd * g1.y * siluf(gv[5])); w.w = pk2(o[6] * rstd * g1.z * siluf(gv[6]), o[7] * rstd * g1.w * siluf(gv[7]));
            *(u32x4*)(row + (gdn ? C_GZ : C_RG) + hd * 256 + 8 * l32) = w; }
    }
}

DI void p11_swaprep(Frame& F, const float* qnorm, const float* knorm) {
    bf16_t* qkv = (bf16_t*)(F.ws + WS_BIG + BIG_QKV1); const f32x2* cs32 = (const f32x2*)(F.ws + AUX_CS32);
    const int lane = F.lane, l8 = lane & 7;
    const f32x4 gq0 = *(const f32x4*)(qnorm + 8 * l8), gq1 = *(const f32x4*)(qnorm + 8 * l8 + 4), gk0 = *(const f32x4*)(knorm + 8 * l8), gk1 = *(const f32x4*)(knorm + 8 * l8 + 4);
    const float sg = (l8 < 4) ? -1.f : 1.f;
    for (int m = F.gw; m < NTOK; m += F.NGW) {
        const int pos = m & (SEQ - 1);
        const f32x4* cp = (const f32x4*)(cs32 + (size_t)pos * 32 + 8 * (l8 & 3));
        const f32x4 c0 = cp[0], c1 = cp[1], c2 = cp[2], c3 = cp[3];
        bf16_t* row = qkv + (size_t)m * ODD_IN;
        u32x4 x[5];
#pragma unroll
        for (int i = 0; i < 5; ++i) { x[i] = (u32x4){0u, 0u, 0u, 0u}; if (i < 4 || lane < 32) x[i] = *(const u32x4*)(row + i * 512 + 8 * lane); }
        asm volatile("" ::: "memory");
#pragma unroll
        for (int i = 0; i < 5; ++i) {
            float v[8] = {bflo(x[i].x), bfhi(x[i].x), bflo(x[i].y), bfhi(x[i].y), bflo(x[i].z), bfhi(x[i].z), bflo(x[i].w), bfhi(x[i].w)};
            float ss = 0.f;
#pragma unroll
            for (int e = 0; e < 8; ++e) ss += v[e] * v[e];
            ss += __shfl_xor(ss, 1); ss += __shfl_xor(ss, 2); ss += __shfl_xor(ss, 4);
            const float rstd = 1.0f / sqrtf(ss * (1.0f / 64.0f) + EPS);
            const f32x4 g0 = i < 4 ? gq0 : gk0, g1 = i < 4 ? gq1 : gk1;
            v[0] *= rstd * g0.x; v[1] *= rstd * g0.y; v[2] *= rstd * g0.z; v[3] *= rstd * g0.w; v[4] *= rstd * g1.x; v[5] *= rstd * g1.y; v[6] *= rstd * g1.z; v[7] *= rstd * g1.w;
            float p[8];
#pragma unroll
            for (int e = 0; e < 8; ++e) p[e] = __shfl_xor(v[e], 4);
            u32x4 o;
            o.x = pk2(v[0] * c0.x + sg * p[0] * c0.y, v[1] * c0.z + sg * p[1] * c0.w); o.y = pk2(v[2] * c1.x + sg * p[2] * c1.y, v[3] * c1.z + sg * p[3] * c1.w);
            o.z = pk2(v[4] * c2.x + sg * p[4] * c2.y, v[5] * c2.z + sg * p[5] * c2.w); o.w = pk2(v[6] * c3.x + sg * p[6] * c3.y, v[7] * c3.z + sg * p[7] * c3.w);
            if (i < 4 || lane < 32) *(u32x4*)(row + i * 512 + 8 * lane) = o; }
    }
}
typedef float f32x16 __attribute__((ext_vector_type(16)));
DI f32x16 mfma32(bf16x8 a, bf16x8 b, f32x16 c) { return __builtin_amdgcn_mfma_f32_32x32x16_bf16(a, b, c, 0, 0, 0); }
DI void swa_phase(Frame& F, const float* sinks) {
    constexpr int KP = 144;
    bf16_t* qkv = (bf16_t*)(F.ws + WS_BIG + BIG_QKV1);
    LAS unsigned char* Ks = F.lds; LAS unsigned char* Vs = F.lds + 256 * KP;
    const unsigned vs_addr = (unsigned)(size_t)Vs;
    const int lane = F.lane, w = F.wave, h = lane >> 5, ql = lane & 31, q4 = (lane & 15) >> 2, p4 = lane & 3, blk = (lane >> 4) & 1;
    for (int unit = blockIdx.x; unit < 1024; unit += F.G) {
        const int b = unit >> 9, kvh = (unit >> 7) & 3, qb = unit & 127;
        const size_t tok0 = (size_t)b * SEQ + (size_t)qb * 128;
        __syncthreads();
#pragma unroll
        for (int i = 0; i < 4; ++i) { const int pc = F.tid + 512 * i, row = pc >> 3, c = pc & 7; const size_t tok = (qb == 0 && row < 128) ? tok0 : tok0 - 128 + row;
            const bf16_t* src = qkv + tok * ODD_IN + 2048 + kvh * 64 + c * 8;
            *(LAS u32x4*)(Ks + row * KP + c * 16) = *(const u32x4*)src; *(LAS u32x4*)(Vs + row * KP + c * 16) = *(const u32x4*)(src + 256); }
        __syncthreads();
        const int hq = kvh * 8 + w; const float sink = sinks[hq];
#pragma unroll 1
        for (int t = 0; t < 4; ++t) {
            bf16_t* qrow = qkv + (tok0 + 32 * t + ql) * ODD_IN + hq * 64;
            bf16x8 Qf[4];
#pragma unroll
            for (int s2 = 0; s2 < 4; ++s2) Qf[s2] = *(const bf16x8*)(qrow + 16 * s2 + 8 * h);
            f32x16 sc[5];
#pragma unroll
            for (int kt = 0; kt < 5; ++kt) {
#pragma unroll
                for (int r = 0; r < 16; ++r) sc[kt][r] = 0.f;
#pragma unroll
                for (int s2 = 0; s2 < 4; ++s2) { const bf16x8 a = *(const LAS bf16x8*)(Ks + (32 * (t + kt) + ql) * KP + (16 * s2 + 8 * h) * 2); sc[kt] = mfma32(a, Qf[s2], sc[kt]); } }
            float m = sink;
#pragma unroll
            for (int kt = 0; kt < 5; ++kt) { const bool tile_ok = !(qb == 0 && t + kt < 4);
#pragma unroll
                for (int r = 0; r < 16; ++r) { const int keyrow = (r & 3) + 8 * (r >> 2) + 4 * h; bool ok = tile_ok; if (kt == 0) ok = ok && (keyrow > ql); if (kt == 4) ok = ok && (keyrow <= ql);
                    const float v = ok ? sc[kt][r] * 0.125f : -1.0e30f; sc[kt][r] = v; m = fmaxf(m, v); } }
            m = fmaxf(m, __shfl_xor(m, 32));
            float l = 0.f;
#pragma unroll
            for (int kt = 0; kt < 5; ++kt)
#pragma unroll
                for (int r = 0; r < 16; ++r) { const float p = exp2f((sc[kt][r] - m) * 1.4426950408889634f); sc[kt][r] = p; l += p; }
            l += __shfl_xor(l, 32);
            l += exp2f((sink - m) * 1.4426950408889634f);
            f32x16 o0, o1;
#pragma unroll
            for (int r = 0; r < 16; ++r) { o0[r] = 0.f; o1[r] = 0.f; }
#pragma unroll
            for (int kt = 0; kt < 5; ++kt)
#pragma unroll
                for (int s2 = 0; s2 < 2; ++s2) { u32x4 pw; pw.x = pkbf(sc[kt][8 * s2], sc[kt][8 * s2 + 1]); pw.y = pkbf(sc[kt][8 * s2 + 2], sc[kt][8 * s2 + 3]); pw.z = pkbf(sc[kt][8 * s2 + 4], sc[kt][8 * s2 + 5]); pw.w = pkbf(sc[kt][8 * s2 + 6], sc[kt][8 * s2 + 7]);
                    const bf16x8 pb = __builtin_bit_cast(bf16x8, pw);
                    const unsigned ra = vs_addr + (unsigned)((32 * (t + kt) + 16 * s2 + 4 * h + q4) * KP + blk * 32 + p4 * 8);
                    s16x4 a00, a01, a10, a11; tr_read4(ra, ra + 8 * KP, ra + 64, ra + 8 * KP + 64, a00, a01, a10, a11);
                    o0 = mfma32(cat8(a00, a01), pb, o0); o1 = mfma32(cat8(a10, a11), pb, o1); }
            const float il = 1.0f / l;
            unsigned char* orow8 = F.ws + WS_H + (tok0 + 32 * t + ql) * D + hq * 64; const float il16 = il * 16.0f;
#pragma unroll
            for (int gq = 0; gq < 4; ++gq) { *(unsigned*)(orow8 + 8 * gq + 4 * h) = pk4fp8(o0[4 * gq] * il16, o0[4 * gq + 1] * il16, o0[4 * gq + 2] * il16, o0[4 * gq + 3] * il16);
                *(unsigned*)(orow8 + 32 + 8 * gq + 4 * h) = pk4fp8(o1[4 * gq] * il16, o1[4 * gq + 1] * il16, o1[4 * gq + 2] * il16, o1[4 * gq + 3] * il16); }
        }
    }
}

struct NoHandler { DI void operator()(int, float) const {} };
DI void moe_tables(Frame& F, const unsigned* cntg) {
    LAS int* cnt = (LAS int*)(F.lds + TBL_OFF); LAS int* tb = cnt + 32;
    __syncthreads();
    if (F.wave == 0) {
        const int e = F.lane & 31; const int c = (int)__hip_atomic_load(cntg + e * CSTR, __ATOMIC_RELAXED, __HIP_MEMORY_SCOPE_AGENT); const int t = (c + 255) >> 8; int inc = t;
#pragma unroll
        for (int d = 1; d < 32; d <<= 1) { const int o = __shfl_up(inc, d); if (e >= d) inc += o; }
        if (F.lane < 32) { cnt[e] = c; tb[e] = inc - t; if (e == 31) tb[32] = inc; } }
    __syncthreads();
}

constexpr int NPH = 19;

struct Args { const float* in[20]; float* out; unsigned char* ws; int ph_lo, ph_hi; };
__global__ void __launch_bounds__(NTHR, 2) mk_fwd(Args args) {
    extern __shared__ __attribute__((aligned(16))) unsigned char lds[];
    Frame F;
    F.lds = (LAS unsigned char*)lds; F.tid = threadIdx.x; F.lane = F.tid & 63; F.wave = __builtin_amdgcn_readfirstlane(F.tid >> 6); F.G = gridDim.x;
    F.gw = blockIdx.x * NWAVES + F.wave; F.NGW = F.G * NWAVES; F.ws = args.ws; F.ctl = (unsigned*)(args.ws + WS_CTL);
    volatile LAS unsigned* MISC = (volatile LAS unsigned*)(F.lds + MISC_OFF);
    if (F.tid < 64) MISC[F.tid] = 0u;
    __syncthreads();
    XcdBarrier bar; bar.bar = F.ctl + CW_BAR; bar.x = 0; bar.st = nullptr;
    if (!MK_MULTI) bar = xcd_barrier_post(F.ctl + CW_BAR, MISC + 8);
    const int lo = args.ph_lo, hi = args.ph_hi;
#ifdef ONLY_PH
#define IN(k) ((k) == ONLY_PH && lo <= (k) && (k) < hi)
#else
#define IN(k) (lo <= (k) && (k) < hi)
#endif
#define SEAM(k) do { if (IN(k) && IN((k) + 1)) xcd_barrier(bar); } while (0)
    const float* const* in = args.in;
    float* XC = args.out;
    bf16_t* XC16 = (bf16_t*)(F.ws + AUX_QN);
    bf16_t* H = (bf16_t*)(F.ws + WS_H);
    bf16_t* PJ = (bf16_t*)(F.ws + WS_BIG + BIG_PJ);
    unsigned char* aux = F.ws;
    const LAS int* tbl_cnt = (const LAS int*)(F.lds + TBL_OFF); const LAS int* tbl_tb = tbl_cnt + 32;
    LAS unsigned* tokoff = (LAS unsigned*)(F.lds + TOK_OFF);

    enum { P_W = 0, P_N0, P_G0, P_PREP, P_GA, P_SCAN, P_MIX, P_O0, P_M0A, P_M0B, P_M0C, P_N1, P_G1, P_SPREP, P_SWA, P_O1, P_M1A, P_M1B, P_M1C, P_FIN };
    static_assert(P_FIN == NPH, "phase count");
    if (IN(P_W)) { p0_weights(F, in); __syncthreads(); }
    SEAM(P_W);
    if (IN(P_N0)) {
        normproj_pass<0>(F, in[0], in[1], (const bf16_t*)(aux + AUX_SW), (const bf16_t*)(aux + AUX_SW) + 112 * D, H, (float*)(aux + AUX_BG), in[6], in[7], nullptr, nullptr, nullptr, nullptr);
    }
    SEAM(P_N0);
    if (IN(P_G0)) {
        pg8::EpiBf16 E{PJ, PJW};
        { pg8::DenseOrderT<1> S; S.init(NTOK, 8192, D, D, (const bf16_t*)(F.ws + WS_WIN0), F.G, blockIdx.x);
          pg8::gemm_phase(F.lds, H, D, S, E); }
        __syncthreads();
        { pg8::DenseOrderT<2> S; S.init(NTOK, 4096, D, D, F.ws + AUX_WIN8, F.G, blockIdx.x, 1);
          pg8::gemm_phase<pg8::EpiBf16, pg8::DenseOrderT<2>, true, 0x7a7a7a7a, 0x7d7d7d7d>(F.lds, F.ws + AUX_H8, D, S, E); }
    }
    SEAM(P_G0);
    if (IN(P_PREP)) p2_prep(F, in[5]);
    SEAM(P_PREP);
    if (IN(P_GA)) {
        for (int u = F.gw; u < 16 * NCH; u += F.NGW) {
            ga_unit<true>(F, u, (unsigned char*)args.out, nullptr);
            ga_unit<false>(F, u, F.ws + AUX_W, nullptr);
        }
        __syncthreads();
    }
    SEAM(P_GA);
    if (IN(P_SCAN)) {
        for (int id = blockIdx.x; id < 256; id += F.G) { const int idl = id & 127, bh = (idl % 8) * 2 + (idl / 8) / 8, sl = 2 * ((idl / 8) % 8);
            __syncthreads();
            if (F.tid == 0) { *(volatile LAS unsigned*)(F.lds + XL_CNT) = 0u; *(volatile LAS unsigned*)(F.lds + XL_CNT + 64) = 0u; }
            __syncthreads();
            if (id < 128) { if (F.wave == 0) scan_wave<true, 0>(F, bh, sl, (const unsigned char*)args.out, F.lds); else if (F.wave == 1) scan_wave<true, 1>(F, bh, sl, (const unsigned char*)args.out, F.lds); }
            else { if (F.wave == 0) scan_wave<false, 0>(F, bh, sl, F.ws + AUX_W, F.lds); else if (F.wave == 1) scan_wave<false, 1>(F, bh, sl, F.ws + AUX_W, F.lds); } }
        if (F.wave >= 2) convert_experts(F, in, 1, F.ws + WS_EXP1, F.ws + WS_EXP1 + 96 * MiB, blockIdx.x * 6 + (F.wave - 2), F.G * 6);
        __syncthreads();
    }
    SEAM(P_SCAN);
    if (IN(P_MIX)) p4_mixnorm(F, in[4], in[8]);
    SEAM(P_MIX);
    if (IN(P_O0)) {
        pg8::DenseOrder S; S.init(NTOK, D, 4096, PJW, (const bf16_t*)(F.ws + WS_WOUT0), F.G, blockIdx.x);
        pg8::EpiRes16<false> E{in[0], XC16, D};
        pg8::gemm_phase(F.lds, PJ + C_RG, 4096, S, E);
    }
    SEAM(P_O0);
#define MOE_LAYER(P, L, CNTW)                                                                                                                  \
    if (IN(P)) {                                                            \
        if (L == 0) convert_experts(F, in, 0, F.ws + WS_BIG + BIG_EGU, F.ws + WS_BIG + BIG_EDN, F.gw, F.NGW);     \
        __syncthreads();                                                                \
        normproj_pass<1, true>(F, XC16, in[2] + L * D, (const bf16_t*)(aux + AUX_SW) + (16 + L * 48) * D, (const bf16_t*)(aux + AUX_SW) + (112 + 16 + L * 48) * D, H, nullptr, nullptr, nullptr, F.ctl + CNTW, (int*)(aux + AUX_LIST), (float*)(aux + AUX_GW), (unsigned*)(aux + AUX_ASG)); \
        __syncthreads();                                                                                                                       \
    }                                                                                                                                          \
    SEAM(P);                                                                                                                                   \
    if (IN(P + 1)) {                                                                                                \
        moe_tables(F, F.ctl + CNTW);                                                                                                           \
        pg8::MoeOrder<true> S; S.init(tbl_tb, tokoff, 6, D, D, L == 0 ? F.ws + WS_BIG + BIG_EGU : F.ws + WS_EXP1, (size_t)1536 * D, F.G, blockIdx.x, 1);   \
        { pg8::Unit u; const int* list = (const int*)(aux + AUX_LIST);                                                                         \
          for (int ui = 0; ui < 12 && S.next(ui, u); ++ui) if (F.tid < 256) { const int idx = (u.pm - tbl_tb[u.e]) * 256 + F.tid;               \
              const int tok = idx < tbl_cnt[u.e] ? list[u.e * 65536 + idx] : 0; tokoff[ui * 256 + F.tid] = (unsigned)tok * (unsigned)D; } } \
        __syncthreads();                                                                                                                       \
        pg8::EpiSwiglu8 E{F.ws + WS_BIG + BIG_HID};                                                                                            \
        pg8::gemm_phase<pg8::EpiSwiglu8, pg8::MoeOrder<true>, true, 0x79797979, 0x7d7d7d7d>(F.lds, H, D, S, E);         \
    }                                                                                                                                          \
    SEAM(P + 1);                                                                                                                               \
    if (IN(P + 2)) {                                                                                  \
        moe_tables(F, F.ctl + CNTW);                                                                                                           \
        pg8::MoeOrder<false> S; S.init(tbl_tb, tokoff, 8, FF, FF, L == 0 ? F.ws + WS_BIG + BIG_EDN : F.ws + WS_EXP1 + 96 * MiB, (size_t)D * FF, F.G, blockIdx.x, 1);  \
        pg8::EpiDown E{(bf16_t*)(F.ws + WS_BIG + BIG_Y), (const float*)(aux + AUX_GW), tbl_tb};                                                \
        pg8::gemm_phase<pg8::EpiDown, pg8::MoeOrder<false>, true, 0x7a7a7a7a, 0x7c7c7c7c>(F.lds, F.ws + WS_BIG + BIG_HID, FF, S, E);     \
    }                                                                                                                                          \
    SEAM(P + 2);
    MOE_LAYER(P_M0A, 0, CW_CNT0)
    if (IN(P_N1)) {
        moe_tables(F, F.ctl + CW_CNT0);
        norm_pass<0, true, true, true, NoHandler, true, true, true>(F, XC16, XC16, (const bf16_t*)(F.ws + WS_BIG + BIG_Y), (const unsigned*)(aux + AUX_ASG), tbl_tb, in[1] + D, nullptr, H, NoHandler{});
        __syncthreads();
    }
    SEAM(P_N1);
    if (IN(P_G1)) {
        pg8::DenseOrder S; S.init(NTOK, ODD_IN, D, D, F.ws + WS_WIN1, F.G, blockIdx.x, 1);
        pg8::EpiBf16 E{(bf16_t*)(F.ws + WS_BIG + BIG_QKV1), ODD_IN};
        pg8::gemm_phase<pg8::EpiBf16, pg8::DenseOrder, true, 0x7a7a7a7a, 0x7d7d7d7d>(F.lds, H, D, S, E);
    }
    SEAM(P_G1);
    if (IN(P_SPREP)) p11_swaprep(F, in[11], in[12]);
    SEAM(P_SPREP);
    if (IN(P_SWA)) { swa_phase(F, in[13]); __syncthreads(); }
    SEAM(P_SWA);
    if (IN(P_O1)) {
        pg8::DenseOrder S; S.init(NTOK, D, D, D, F.ws + WS_WOUT1, F.G, blockIdx.x, 1);
        pg8::EpiRes16<true> E{XC16, XC16, D};
        pg8::gemm_phase<pg8::EpiRes16<true>, pg8::DenseOrder, true, 0x7a7a7a7a, 0x7b7b7b7b>(F.lds, F.ws + WS_H, D, S, E);
    }
    SEAM(P_O1);
    MOE_LAYER(P_M1A, 1, CW_CNT1)
    if (IN(P_FIN)) {
        moe_tables(F, F.ctl + CW_CNT1);
        norm_pass<0, true, true, false, NoHandler, false, true, false>(F, XC16, XC, (const bf16_t*)(F.ws + WS_BIG + BIG_Y), (const unsigned*)(aux + AUX_ASG), tbl_tb, nullptr, nullptr, nullptr, NoHandler{});
    }
#undef IN
#undef SEAM
}

extern "C" void kernel_launch(void* const* d_in, const int* in_sizes, int n_in, void* d_out, int out_size, void* d_ws, size_t ws_size, hipStream_t stream) {
    static int grid = 0;
    if (grid == 0) {
        if (n_in != 20 || in_sizes[0] != NTOK * D || out_size != NTOK * D || ws_size < WS_END) { fprintf(stderr, "kernel_launch: unexpected shapes / workspace (n_in %d, in0 %d, out %d, ws %zu, need %zu)\n", n_in, n_in > 0 ? in_sizes[0] : -1, out_size, ws_size, (size_t)WS_END); grid = -1; return; }
        int dev = 0, cus = 0, per_cu = 0;
        if (hipGetDevice(&dev) != hipSuccess || hipDeviceGetAttribute(&cus, hipDeviceAttributeMultiprocessorCount, dev) != hipSuccess) { grid = -1; return; }
        if (hipFuncSetAttribute((const void*)mk_fwd, hipFuncAttributeMaxDynamicSharedMemorySize, LDS_BYTES) != hipSuccess) { fprintf(stderr, "kernel_launch: hipFuncSetAttribute failed\n"); grid = -1; return; }
        if (hipOccupancyMaxActiveBlocksPerMultiprocessor(&per_cu, (const void*)mk_fwd, NTHR, LDS_BYTES) != hipSuccess || per_cu < 1) fprintf(stderr, "kernel_launch: occupancy query reports %d\n", per_cu);
        (void)hipGetLastError();
        if (cus < 256) { fprintf(stderr, "kernel_launch: built for 256 CUs (got %d)\n", cus); grid = -1; return; }
        grid = 256;
    }
    if (grid < 0) return;
    (void)hipMemsetAsync((char*)d_ws + WS_CTL, 0, CTL_ZERO_BYTES, stream);
    Args a{};
    for (int i = 0; i < 20; ++i) a.in[i] = (const float*)d_in[i];
    a.out = (float*)d_out; a.ws = (unsigned char*)d_ws;
#if MK_MULTI
    for (int p = 0; p <= NPH; ++p) { a.ph_lo = p; a.ph_hi = p + 1; hipLaunchKernelGGL(mk_fwd, dim3(grid), dim3(NTHR), LDS_BYTES, stream, a); }
#else
    a.ph_lo = 0; a.ph_hi = NPH + 1;
    hipLaunchKernelGGL(mk_fwd, dim3(grid), dim3(NTHR), LDS_BYTES, stream, a);
#endif
}
```

```cpp
#include <hip/hip_runtime.h>
#include <cstdio>
#include <cstdint>

#ifndef MK_MULTI
#define MK_MULTI 0
#endif

#define LAS __attribute__((address_space(3)))
typedef unsigned short bf16_t;
typedef short bf16x8 __attribute__((ext_vector_type(8)));
typedef float f32x4 __attribute__((ext_vector_type(4)));
typedef float f32x2 __attribute__((ext_vector_type(2)));
typedef unsigned u32x4 __attribute__((ext_vector_type(4)));
typedef unsigned u32x2 __attribute__((ext_vector_type(2)));
#define DI __device__ __forceinline__

constexpr int D = 2048, BATCH = 2, SEQ = 16384, NTOK = BATCH * SEQ;
constexpr int EVEN_IN = 12304, PJW = 12288;
constexpr int ODD_IN = 2560;
constexpr int NEXP = 32, FF = 768, TOPK = 2, MAXT = 288;
constexpr float EPS = 1e-6f;
constexpr double ROPE_R = 0.86596432336006535;
constexpr int C_RQ = 0, C_RK = 1024, C_RV = 2048, C_GQKV = 4096, C_RG = 8192, C_GZ = 10240;

constexpr size_t MiB = 1u << 20;
constexpr size_t WS_CTL = 0, CTL_ZERO_BYTES = 1 * MiB;
constexpr size_t WS_WIN0 = 2 * MiB;
constexpr size_t WS_WOUT0 = WS_WIN0 + 48 * MiB;
constexpr size_t WS_WIN1 = WS_WOUT0 + 16 * MiB;
constexpr size_t WS_WOUT1 = WS_WIN1 + 10 * MiB;
constexpr size_t WS_H = 84 * MiB;
constexpr size_t WS_BIG = 212 * MiB;
constexpr size_t WS_AUX = 980 * MiB;
constexpr size_t WS_MISC = 1540 * MiB;
constexpr size_t WS_EXP1 = 1396 * MiB;
constexpr size_t WS_END = 1572 * MiB;
constexpr size_t BIG_PJ = 0;
constexpr size_t BIG_EGU = 0;
constexpr size_t BIG_EDN = 192 * MiB;
constexpr size_t BIG_HID = 288 * MiB;
constexpr size_t BIG_Y = 400 * MiB;
constexpr size_t BIG_QKV1 = 0;
constexpr size_t AUX_QN = WS_AUX + 0;
constexpr size_t AUX_KN = WS_AUX + 64 * MiB;
constexpr size_t AUX_VC = WS_AUX + 128 * MiB;
constexpr size_t AUX_W = WS_AUX + 256 * MiB;
constexpr size_t AUX_ATT = WS_AUX + 320 * MiB;
constexpr size_t AUX_RST = WS_AUX + 352 * MiB;
constexpr size_t AUX_H8 = WS_AUX + 128 * MiB;
constexpr size_t AUX_WIN8 = WS_AUX + 256 * MiB;
constexpr size_t AUX_BG = WS_MISC + 0;
constexpr size_t AUX_CS = WS_MISC + 2 * MiB;
constexpr size_t AUX_DEC = WS_MISC + 10 * MiB + 960 * 1024;
constexpr size_t AUX_SW = WS_MISC + 10 * MiB;
constexpr size_t AUX_LIST = WS_MISC + 11 * MiB;
constexpr size_t AUX_GW = WS_MISC + 19 * MiB;
constexpr size_t AUX_ASG = WS_MISC + 27 * MiB;
constexpr size_t AUX_CS32 = WS_MISC + 28 * MiB;
static_assert(AUX_CS32 + 4 * MiB <= WS_END && AUX_W + 160 * MiB <= WS_EXP1 && WS_EXP1 + 144 * MiB <= WS_MISC, "aux map");
constexpr int CW_BAR = 4096;
constexpr int CSTR = 1088;
constexpr int CW_CNT0 = 16384, CW_CNT1 = 16384 + 40960;

constexpr int RING_BYTES = 131072;
constexpr int GA_LDS_WAVE = 17920;
constexpr int MISC_OFF = 8 * GA_LDS_WAVE;
constexpr int TBL_OFF = MISC_OFF + 256;
constexpr int TOK_OFF = MISC_OFF + 1024;
constexpr int LDS_BYTES = 163840;
static_assert(TOK_OFF + 12 * 1024 <= LDS_BYTES, "lds map");
DI float rdlane(float v, int l) { return __builtin_bit_cast(float, __builtin_amdgcn_readlane(__builtin_bit_cast(int, v), l)); }

typedef __bf16 bf16v2 __attribute__((ext_vector_type(2)));
DI unsigned pkbf(float a, float b) { f32x2 v = {a, b}; return __builtin_bit_cast(unsigned, __builtin_convertvector(v, bf16v2)); }
DI unsigned f2bf(float f) { return pkbf(f, 0.f) & 0xffffu; }
DI unsigned pk2(float lo, float hi) { return pkbf(lo, hi); }
DI float bflo(unsigned w) { return __builtin_bit_cast(float, w << 16); }
DI float bfhi(unsigned w) { return __builtin_bit_cast(float, w & 0xffff0000u); }
DI float bf2f(bf16_t b) { return __builtin_bit_cast(float, ((unsigned)b) << 16); }
DI unsigned cvt_pk_bf16(float lo, float hi) { unsigned r; asm volatile("v_cvt_pk_bf16_f32 %0, %1, %2" : "=v"(r) : "v"(lo), "v"(hi)); return r; }
DI float wave_sum(float v) {
#pragma unroll
    for (int o = 1; o < 64; o <<= 1) v += __shfl_xor(v, o);
    return v;
}
DI float siluf(float x) { return x / (1.0f + __expf(-x)); }
DI unsigned pk4fp8(float a, float b, float c, float d) { int w = __builtin_amdgcn_cvt_pk_fp8_f32(a, b, 0, false); w = __builtin_amdgcn_cvt_pk_fp8_f32(c, d, w, true); return (unsigned)w; }
DI f32x4 mfma16(bf16x8 a, bf16x8 b, f32x4 c) { return __builtin_amdgcn_mfma_f32_16x16x32_bf16(a, b, c, 0, 0, 0); }
#define LDS_WAIT() asm volatile("s_waitcnt lgkmcnt(0)" ::: "memory")
#define VM_WAIT() asm volatile("s_waitcnt vmcnt(0)" ::: "memory")

#define XB_TMO      128
#define XB_XCNT(j)  (256  + 64 * (j))
#define XB_XSUB(j)  (1280 + 64 * (j))
#define XB_XGEN(j)  (2304 + 64 * (j))
#define XB_TOP      3328
#define XB_TOPGEN   3392
#define XCD_BAR_WORDS 3456
#define XB_SPIN_CAP (1u << 22)
DI unsigned xb_ld(unsigned* p)              { return __hip_atomic_load(p, __ATOMIC_RELAXED, __HIP_MEMORY_SCOPE_AGENT); }
DI unsigned xb_add(unsigned* p, unsigned v) { return __hip_atomic_fetch_add(p, v, __ATOMIC_RELAXED, __HIP_MEMORY_SCOPE_AGENT); }
DI unsigned xb_xcc_id() { return (unsigned)__builtin_amdgcn_s_getreg((3 << 11) | 20) & 0xFu; }
#define XB_SPIN(cond, bar) do { unsigned _sp = 0; while (cond) { __builtin_amdgcn_s_sleep(1); \
    if ((++_sp & 255u) == 0u) { if (xb_ld(&(bar)[XB_TMO])) break; if (_sp > XB_SPIN_CAP) { atomicAdd(&(bar)[XB_TMO], 1u); break; } } } } while (0)
struct XcdBarrier { unsigned* bar; unsigned x; volatile LAS unsigned* st; };
DI XcdBarrier xcd_barrier_post(unsigned* bar, volatile LAS unsigned* st) {
    XcdBarrier b; b.bar = bar; b.x = xb_xcc_id(); b.st = st;
    if (threadIdx.x == 0) (void)xb_add(&bar[XB_XCNT(b.x)], 1u);
    return b;
}
DI void xcd_barrier_complete(unsigned* bar, unsigned x, unsigned& nloc, unsigned& nx) {
    const unsigned G = gridDim.x * gridDim.y * gridDim.z;
    unsigned sum, cnt, mine, sp = 0u;
    for (;;) {
        sum = 0u; cnt = 0u; mine = 0u;
#pragma unroll
        for (unsigned j = 0; j < 16; ++j) { const unsigned c = xb_ld(&bar[XB_XCNT(j)]); sum += c; cnt += (c > 0u) ? 1u : 0u; mine = (j == x) ? c : mine; }
        if (sum == G) break;
        __builtin_amdgcn_s_sleep(1);
        if ((++sp & 255u) == 0u) { if (xb_ld(&bar[XB_TMO])) break; if (sp > XB_SPIN_CAP) { atomicAdd(&bar[XB_TMO], 1u); break; } }
    }
    nloc = mine > 0u ? mine : 1u; nx = cnt > 0u ? cnt : 1u;
}
DI void xcd_barrier(const XcdBarrier& b) {
    asm volatile("s_waitcnt vmcnt(0)" ::: "memory");
    __syncthreads();
    if (threadIdx.x == 0) {
        unsigned* bar = b.bar;
        __builtin_amdgcn_s_waitcnt(0);
        unsigned nloc = b.st[0], nx = b.st[1];
        if (nloc == 0u) { xcd_barrier_complete(bar, b.x, nloc, nx); b.st[0] = nloc; b.st[1] = nx; }
        const unsigned old = xb_add(&bar[XB_XSUB(b.x)], 1u);
        const unsigned gen = old / nloc;
        if (old + 1u == (gen + 1u) * nloc) {
            __builtin_amdgcn_fence(__ATOMIC_RELEASE, "agent");
            asm volatile("s_waitcnt vmcnt(0)" ::: "memory");
            const unsigned og = xb_add(&bar[XB_TOP], 1u);
            const unsigned tg = og / nx;
            if (og + 1u == (tg + 1u) * nx) xb_add(&bar[XB_TOPGEN], 1u);
            else XB_SPIN(xb_ld(&bar[XB_TOPGEN]) == tg, bar);
            __builtin_amdgcn_fence(__ATOMIC_ACQUIRE, "agent");
            xb_add(&bar[XB_XGEN(b.x)], 1u);
            asm volatile("s_waitcnt vmcnt(0)" ::: "memory");
        } else {
            XB_SPIN(xb_ld(&bar[XB_XGEN(b.x)]) == gen, bar);
            __builtin_amdgcn_fence(__ATOMIC_ACQUIRE, "agent");
            asm volatile("s_waitcnt vmcnt(0)" ::: "memory");
        }
    }
    __syncthreads();
}

namespace pg8 {
constexpr int BM = 256, BK = 64, HALF = 128, HTB = HALF * BK * 2, STAGE_BYTES = 8 * HTB, NXCD = 8, WGM = 8;
__host__ __device__ __forceinline__ int lds_byte(int r, int c) { const int st = (r >> 4) * 2 + (c >> 5), rr = r & 15, cc = c & 31, ob = rr * 64 + cc * 2; return st * 1024 + (ob ^ (((ob >> 9) & 1) << 5)); }
__host__ __device__ __forceinline__ void stage_rc(int b, int& R, int& C) { const int st = b / 1024, sb = b % 1024, swz = sb ^ (((sb >> 9) & 1) << 5); R = (st >> 1) * 16 + swz / 64; C = (st & 1) * 32 + (swz % 64) / 2; }
__host__ __device__ __forceinline__ int perm32(int rho) { const int n = rho >> 4, i = rho & 15; return 8 * (i >> 2) + 4 * n + (i & 3); }

struct Unit { int pm, pn, e, slot; };

DI int xcd_remap(int L, int nwg) { const int q = nwg / NXCD, r = nwg % NXCD, xcd = L % NXCD, off = L / NXCD; return (xcd < r ? xcd * (q + 1) : r * (q + 1) + (xcd - r) * q) + off; }

template <int MAP> struct DenseOrderT {
    int nM, nN, nwg, G, c; unsigned lda2; const char* Bt; size_t tstepB;
    DI void init(int M, int N, int K, int lda, const void* Bt_, int G_, int c_, int EB = 2) { nM = M / BM; nN = N / BM; nwg = nM * nN; G = G_; c = c_; lda2 = (unsigned)(lda * EB); Bt = (const char*)Bt_; tstepB = (size_t)BM * K * EB; }
    DI bool next(int i, Unit& u) const {
        const long L = (long)i * G + c; if (L >= nwg) return false;
        const int wgid = xcd_remap((int)L, nwg);
        const int nig = WGM * nN, gid = wgid / nig, fm = gid * WGM, gsz = (nM - fm) < WGM ? (nM - fm) : WGM;
        u.pm = fm + ((wgid % nig) % gsz); const int t = (wgid % nig) / gsz; u.pn = MAP == 0 ? t : (MAP == 1 ? (t < 8 ? t : (t < 16 ? t + 8 : t + 16)) : (t < 8 ? t + 8 : t + 16)); u.e = 0; u.slot = i; return true;
    }
    DI unsigned a_off(const Unit& u, int h, int R) const { return (unsigned)(u.pm * BM + h * HALF + R) * lda2; }
    DI const char* b_base(const Unit& u) const { return Bt + (size_t)u.pn * tstepB; }
};
typedef DenseOrderT<0> DenseOrder;
template <bool GATHER> struct MoeOrder {
    const LAS int* tb; const LAS unsigned* tokoff; int NT, nwg, G, c; unsigned lda2; const char* Bt; size_t estepB, tstepB;
    DI void init(const LAS int* tb_, const LAS unsigned* tokoff_, int NT_, int K, int lda, const void* Bt_, size_t estep_elems, int G_, int c_, int EB = 2) {
        tb = tb_; tokoff = tokoff_; NT = NT_; nwg = tb_[32] * NT_; G = G_; c = c_; lda2 = (unsigned)(lda * EB); Bt = (const char*)Bt_; estepB = estep_elems * EB; tstepB = (size_t)BM * K * EB; }
    DI bool next(int i, Unit& u) const {
        const long L = (long)i * G + c; if (L >= nwg) return false;
        const int w = xcd_remap((int)L, nwg);
        int e = 0;
#pragma unroll 1
        for (int s = 16; s >= 1; s >>= 1) if (tb[e + s] * NT <= w) e += s;
        const int nt = tb[e + 1] - tb[e], local = w - tb[e] * NT;
        u.e = e; u.pn = local / nt; u.pm = tb[e] + local % nt; u.slot = i; return true;
    }
    DI unsigned a_off(const Unit& u, int h, int R) const { if (GATHER) return tokoff[u.slot * 256 + h * HALF + R]; return (unsigned)(u.pm * BM + h * HALF + R) * lda2; }
    DI const char* b_base(const Unit& u) const { return Bt + (size_t)u.e * estepB + (size_t)u.pn * tstepB; }
};

struct EpiBf16 {
    static constexpr bool PERM = true;
    bf16_t* O; int ldc;
    DI void operator()(const f32x4 (&acc)[2][2][4][2], const Unit& u, int wr, int wc, int fr, int fq) const {
        const int row0 = u.pm * BM + wr * 64 + fr, col0 = u.pn * BM + wc * 32 + 8 * fq;
#pragma unroll
        for (int ai = 0; ai < 2; ++ai)
#pragma unroll
            for (int m = 0; m < 4; ++m) { bf16_t* rowp = O + (size_t)(row0 + ai * HALF + m * 16) * ldc + col0;
#pragma unroll
                for (int bj = 0; bj < 2; ++bj) { const f32x4 v0 = acc[ai][bj][m][0], v1 = acc[ai][bj][m][1];
                    u32x4 w; w.x = cvt_pk_bf16(v0[0], v0[1]); w.y = cvt_pk_bf16(v0[2], v0[3]); w.z = cvt_pk_bf16(v1[0], v1[1]); w.w = cvt_pk_bf16(v1[2], v1[3]);
                    *(u32x4*)(rowp + bj * HALF) = w; } }
    }
};
struct EpiResF32 {
    static constexpr bool PERM = false;
    const float* base; float* out; int ldc;
    DI void operator()(const f32x4 (&acc)[2][2][4][2], const Unit& u, int wr, int wc, int fr, int fq) const {
        const int row0 = u.pm * BM + wr * 64 + fr, col0 = u.pn * BM + wc * 32 + 4 * fq;
#pragma unroll
        for (int ai = 0; ai < 2; ++ai)
#pragma unroll
            for (int m = 0; m < 4; ++m) { const size_t off = (size_t)(row0 + ai * HALF + m * 16) * ldc + col0;
#pragma unroll
                for (int bj = 0; bj < 2; ++bj)
#pragma unroll
                    for (int n = 0; n < 2; ++n) { const f32x4 bs = *(const f32x4*)(base + off + bj * HALF + n * 16); *(f32x4*)(out + off + bj * HALF + n * 16) = bs + acc[ai][bj][m][n]; }
                asm volatile("" ::: "memory"); }
    }
};
template <bool BASE16> struct EpiRes16 {
    static constexpr bool PERM = true;
    const void* base; bf16_t* out; int ldc;
    DI void operator()(const f32x4 (&acc)[2][2][4][2], const Unit& u, int wr, int wc, int fr, int fq) const {
        const int row0 = u.pm * BM + wr * 64 + fr, col0 = u.pn * BM + wc * 32 + 8 * fq;
#pragma unroll
        for (int ai = 0; ai < 2; ++ai)
#pragma unroll
            for (int m = 0; m < 4; ++m) { const size_t off = (size_t)(row0 + ai * HALF + m * 16) * ldc + col0;
#pragma unroll
                for (int bj = 0; bj < 2; ++bj) { f32x4 v0 = acc[ai][bj][m][0], v1 = acc[ai][bj][m][1];
                    if (BASE16) { const u32x4 b = *(const u32x4*)((const bf16_t*)base + off + bj * HALF); v0 += (f32x4){bflo(b.x), bfhi(b.x), bflo(b.y), bfhi(b.y)}; v1 += (f32x4){bflo(b.z), bfhi(b.z), bflo(b.w), bfhi(b.w)}; }
                    else { const float* bp = (const float*)base + off + bj * HALF; v0 += *(const f32x4*)bp; v1 += *(const f32x4*)(bp + 4); }
                    u32x4 w; w.x = cvt_pk_bf16(v0[0], v0[1]); w.y = cvt_pk_bf16(v0[2], v0[3]); w.z = cvt_pk_bf16(v1[0], v1[1]); w.w = cvt_pk_bf16(v1[2], v1[3]);
                    *(u32x4*)(out + off + bj * HALF) = w; }
                asm volatile("" ::: "memory"); }
    }
};
struct EpiSwiglu {
    static constexpr bool PERM = true;
    bf16_t* O;
    DI void operator()(const f32x4 (&acc)[2][2][4][2], const Unit& u, int wr, int wc, int fr, int fq) const {
        const int row0 = u.pm * BM + wr * 64 + fr, col0 = u.pn * HALF + wc * 32 + 8 * fq;
#pragma unroll
        for (int ai = 0; ai < 2; ++ai)
#pragma unroll
            for (int m = 0; m < 4; ++m) { bf16_t* rowp = O + (size_t)(row0 + ai * HALF + m * 16) * FF + col0;
                float h[8];
#pragma unroll
                for (int n = 0; n < 2; ++n)
#pragma unroll
                    for (int j = 0; j < 4; ++j) { const float g = acc[ai][0][m][n][j], up = acc[ai][1][m][n][j]; h[n * 4 + j] = g / (1.0f + __expf(-g)) * up; }
                u32x4 w; w.x = cvt_pk_bf16(h[0], h[1]); w.y = cvt_pk_bf16(h[2], h[3]); w.z = cvt_pk_bf16(h[4], h[5]); w.w = cvt_pk_bf16(h[6], h[7]);
                *(u32x4*)rowp = w; }
    }
};
struct EpiSwiglu8 {
    static constexpr bool PERM = true;
    unsigned char* O;
    DI void operator()(const f32x4 (&acc)[2][2][4][2], const Unit& u, int wr, int wc, int fr, int fq) const {
        const int row0 = u.pm * BM + wr * 64 + fr, col0 = u.pn * HALF + wc * 32 + 8 * fq;
#pragma unroll
        for (int ai = 0; ai < 2; ++ai)
#pragma unroll
            for (int m = 0; m < 4; ++m) { unsigned char* rowp = O + (size_t)(row0 + ai * HALF + m * 16) * FF + col0;
                float h[8];
#pragma unroll
                for (int n = 0; n < 2; ++n)
#pragma unroll
                    for (int j = 0; j < 4; ++j) { const float g = acc[ai][0][m][n][j], up = acc[ai][1][m][n][j]; h[n * 4 + j] = g / (1.0f + __expf(-g)) * up * 8.0f; }
                u32x2 w; w.x = pk4fp8(h[0], h[1], h[2], h[3]); w.y = pk4fp8(h[4], h[5], h[6], h[7]);
                *(u32x2*)rowp = w; }
    }
};
struct EpiDown {
    static constexpr bool PERM = true;
    bf16_t* O; const float* gw; const LAS int* tb;
    DI void operator()(const f32x4 (&acc)[2][2][4][2], const Unit& u, int wr, int wc, int fr, int fq) const {
        const int row0 = u.pm * BM + wr * 64 + fr, col0 = u.pn * BM + wc * 32 + 8 * fq;
        const int lrow0 = (u.pm - tb[u.e]) * BM + wr * 64 + fr;
        const float* gwe = gw + (size_t)u.e * 65536;
#pragma unroll
        for (int ai = 0; ai < 2; ++ai)
#pragma unroll
            for (int m = 0; m < 4; ++m) { unsigned char* rowp = (unsigned char*)O + (size_t)(row0 + ai * HALF + m * 16) * D + col0; const float g = gwe[lrow0 + ai * HALF + m * 16] * 16.0f;
#pragma unroll
                for (int bj = 0; bj < 2; ++bj) { const f32x4 v0 = acc[ai][bj][m][0] * g, v1 = acc[ai][bj][m][1] * g;
                    u32x2 w; w.x = pk4fp8(v0[0], v0[1], v0[2], v0[3]); w.y = pk4fp8(v1[0], v1[1], v1[2], v1[3]);
                    *(u32x2*)(rowp + bj * HALF) = w; } }
    }
};

typedef int v8i __attribute__((ext_vector_type(8)));
typedef int v4i __attribute__((ext_vector_type(4)));
template <class Epi, class Sched, bool FP8 = false, int SCW = 0x7f7f7f7f, int SCA = 0x7f7f7f7f>
DI void gemm_phase(LAS unsigned char* lds, const void* Aptr, int K, const Sched& S, const Epi& E) {
    constexpr int EB = FP8 ? 1 : 2;
    const int tid = threadIdx.x, wid = __builtin_amdgcn_readfirstlane(tid >> 6), lane = tid & 63, wr = wid >> 2, wc = wid & 3, fr = lane & 15, fq = lane >> 4;
    const int nt = K * EB / (BK * 2);
    const char* Ab = (const char*)Aptr;
    int Rr[2], Cc[2]; unsigned voffB[2];
#pragma unroll
    for (int i = 0; i < 2; ++i) { int R, C; stage_rc(tid * 16 + i * 8192, R, C); const int Rb = Epi::PERM ? ((R & ~31) + perm32(R & 31)) : R; Rr[i] = R; Cc[i] = C * 2; voffB[i] = (unsigned)(Rb * K * EB + C * 2); }
    const unsigned kstep = (unsigned)(BK * 2);
    const size_t hstepB = (size_t)HALF * K * EB;
    const unsigned ldsw = (unsigned)wid * 1024u;
    const int aoff = lds_byte(wr * 64 + fr, fq * (FP8 ? 16 : 8)), boff = lds_byte(wc * 32 + fr, fq * (FP8 ? 16 : 8));
#define PG8_SA(b, h) (((b) * 2 + (h)) * HTB)
#define PG8_SB(b, h) ((4 + (b) * 2 + (h)) * HTB)
#define PG8_STAGEB(bufoff, gbase) do { _Pragma("unroll") for (int _i = 0; _i < 2; ++_i) \
        __builtin_amdgcn_global_load_lds((const unsigned*)((const char*)(gbase) + voffB[_i]), (LAS unsigned*)(lds + (bufoff) + ldsw + _i * 8192), 16, 0, 0); } while (0)
#define PG8_STAGEA(bufoff, offs, kb) do { _Pragma("unroll") for (int _i = 0; _i < 2; ++_i) \
        __builtin_amdgcn_global_load_lds((const unsigned*)(Ab + (size_t)((offs)[_i] + (kb))), (LAS unsigned*)(lds + (bufoff) + ldsw + _i * 8192), 16, 0, 0); } while (0)
#define PG8_LDA(dst, b, h) do { _Pragma("unroll") for (int m = 0; m < 4; ++m) { if constexpr (FP8) { dst##8[m] = *(const LAS v8i*)(lds + PG8_SA(b, h) + aoff + m * 2048); } \
        else { _Pragma("unroll") for (int k = 0; k < 2; ++k) dst[m][k] = *(const LAS bf16x8*)(lds + PG8_SA(b, h) + aoff + m * 2048 + k * 1024); } } } while (0)
#define PG8_LDB(dst, b, h) do { _Pragma("unroll") for (int n = 0; n < 2; ++n) { if constexpr (FP8) { dst##8[n] = *(const LAS v8i*)(lds + PG8_SB(b, h) + boff + n * 2048); } \
        else { _Pragma("unroll") for (int k = 0; k < 2; ++k) dst[n][k] = *(const LAS bf16x8*)(lds + PG8_SB(b, h) + boff + n * 2048 + k * 1024); } } } while (0)
#define PG8_MMA(ai, bj, At, Bt) do { __builtin_amdgcn_s_setprio(1); _Pragma("unroll") for (int m = 0; m < 4; ++m) _Pragma("unroll") for (int n = 0; n < 2; ++n) { \
        if constexpr (FP8) asm volatile("v_mfma_scale_f32_16x16x128_f8f6f4 %0, %1, %2, %0, %3, %4 op_sel_hi:[0,0,0]" : "+v"(acc[ai][bj][m][n]) : "v"(Bt##8[n]), "v"(At##8[m]), "v"(scw_), "v"(sca_)); \
        else { _Pragma("unroll") for (int k = 0; k < 2; ++k) acc[ai][bj][m][n] = __builtin_amdgcn_mfma_f32_16x16x32_bf16(Bt[n][k], At[m][k], acc[ai][bj][m][n], 0, 0, 0); } } __builtin_amdgcn_s_setprio(0); } while (0)
#define PG8_WAIT_V(n) asm volatile("s_waitcnt vmcnt(" #n ")" ::: "memory")
#define PG8_WAIT_L(n) asm volatile("s_waitcnt lgkmcnt(" #n ")" ::: "memory")
#define PG8_BAR __builtin_amdgcn_s_barrier()
#define PG8_SCHED __builtin_amdgcn_sched_barrier(0)
    Unit cur, nxt; int ui = 0;
    if (!S.next(0, cur)) return;
    f32x4 acc[2][2][4][2];
#pragma unroll
    for (int a = 0; a < 2; ++a)
#pragma unroll
        for (int b = 0; b < 2; ++b)
#pragma unroll
            for (int m = 0; m < 4; ++m)
#pragma unroll
                for (int n = 0; n < 2; ++n) acc[a][b][m][n] = (f32x4){0.f, 0.f, 0.f, 0.f};
    const int scw_ = SCW, sca_ = SCA; (void)scw_; (void)sca_;
    bf16x8 At[4][2], B0[2][2], B1[2][2]; v8i At8[4], B08[2], B18[2]; (void)At; (void)B0; (void)B1; (void)At8; (void)B08; (void)B18;
    unsigned ao[2][2];
#pragma unroll
    for (int h = 0; h < 2; ++h)
#pragma unroll
        for (int i = 0; i < 2; ++i) ao[h][i] = S.a_off(cur, h, Rr[i]) + (unsigned)Cc[i];
    const char* cB = S.b_base(cur);
    PG8_STAGEB(PG8_SB(0, 0), cB); PG8_STAGEB(PG8_SB(0, 1), cB + hstepB); PG8_STAGEA(PG8_SA(0, 0), ao[0], 0u); PG8_STAGEA(PG8_SA(0, 1), ao[1], 0u);
    if (wr == 1) PG8_BAR;
    PG8_WAIT_V(2); PG8_BAR;
    PG8_STAGEB(PG8_SB(1, 0), cB + kstep); PG8_STAGEA(PG8_SA(1, 0), ao[0], kstep); PG8_STAGEB(PG8_SB(1, 1), cB + hstepB + kstep);
    PG8_WAIT_V(6); PG8_BAR;
    for (;;) {
        const bool has_next = S.next(ui + 1, nxt);
        const char* nB = has_next ? S.b_base(nxt) : cB;
#pragma unroll 1
        for (int t = 0; t < nt; t += 2) {
            const bool last = (t == nt - 2);
            const unsigned kb1 = (unsigned)(t + 1) * kstep, kb2 = (unsigned)(t + 2) * kstep;
            unsigned x2[2][2];
#pragma unroll
            for (int h = 0; h < 2; ++h)
#pragma unroll
                for (int i = 0; i < 2; ++i) x2[h][i] = last ? (has_next ? (S.a_off(nxt, h, Rr[i]) + (unsigned)Cc[i]) : ao[h][i]) : ao[h][i] + kb2;
            const char* b2 = last ? nB : cB + kb2; const char* b3 = b2 + kstep;
            PG8_LDB(B0, 0, 0); PG8_LDB(B1, 0, 1); PG8_SCHED; PG8_LDA(At, 0, 0); PG8_STAGEA(PG8_SA(1, 1), ao[1], kb1);
            PG8_WAIT_V(8); PG8_WAIT_L(0); PG8_BAR; PG8_MMA(0, 0, At, B0); PG8_MMA(0, 1, At, B1); PG8_BAR; PG8_SCHED;
            PG8_LDA(At, 0, 1); PG8_STAGEB(PG8_SB(0, 0), b2); PG8_STAGEB(PG8_SB(0, 1), b2 + hstepB); PG8_STAGEA(PG8_SA(0, 0), x2[0], 0u);
            PG8_WAIT_V(8); PG8_WAIT_L(0); PG8_BAR; PG8_MMA(1, 0, At, B0); PG8_MMA(1, 1, At, B1); PG8_BAR; PG8_SCHED;
            PG8_LDB(B0, 1, 0); PG8_LDB(B1, 1, 1); PG8_SCHED; PG8_LDA(At, 1, 0); PG8_STAGEA(PG8_SA(0, 1), x2[1], 0u);
            PG8_WAIT_V(8); PG8_WAIT_L(0); PG8_BAR; PG8_MMA(0, 0, At, B0); PG8_MMA(0, 1, At, B1); PG8_BAR; PG8_SCHED;
            PG8_LDA(At, 1, 1); PG8_STAGEB(PG8_SB(1, 0), b3); PG8_STAGEB(PG8_SB(1, 1), b3 + hstepB); PG8_STAGEA(PG8_SA(1, 0), x2[0], kstep);
            PG8_WAIT_V(8); PG8_WAIT_L(0); PG8_BAR; PG8_MMA(1, 0, At, B0); PG8_MMA(1, 1, At, B1); PG8_BAR; PG8_SCHED;
        }
        if (wr == 0) PG8_BAR;
        if constexpr (FP8) asm volatile("s_nop 15" ::: "memory");
        E(acc, cur, wr, wc, fr, fq);
        if (!has_next) break;
#pragma unroll
        for (int a = 0; a < 2; ++a)
#pragma unroll
            for (int b = 0; b < 2; ++b)
#pragma unroll
                for (int m = 0; m < 4; ++m)
#pragma unroll
                    for (int n = 0; n < 2; ++n) acc[a][b][m][n] = (f32x4){0.f, 0.f, 0.f, 0.f};
        cur = nxt; cB = nB; ++ui;
#pragma unroll
        for (int h = 0; h < 2; ++h)
#pragma unroll
            for (int i = 0; i < 2; ++i) ao[h][i] = S.a_off(cur, h, Rr[i]) + (unsigned)Cc[i];
        if (wr == 1) PG8_BAR;
    }
    PG8_WAIT_V(0);
    PG8_BAR;
#undef PG8_SA
#undef PG8_SB
#undef PG8_STAGEA
#undef PG8_STAGEB
#undef PG8_LDA
#undef PG8_LDB
#undef PG8_MMA
#undef PG8_WAIT_V
#undef PG8_WAIT_L
#undef PG8_BAR
#undef PG8_SCHED
}
}

constexpr int NWAVES = 8, NTHR = 512;
struct Frame {
    LAS unsigned char* lds;
    int tid, lane, wave, G, gw, NGW;
    unsigned* ctl;
    unsigned char* ws;
};

DI void transpose_item(const float* Wseg, int ldw, int ncols, int K, bf16_t* WT, int row_off, LAS float* scr, int item, int lane) {
    const int nblk = ncols / 32, kb = item / nblk, nb = item % nblk, k0 = 64 * kb, n0 = 32 * nb;
#pragma unroll 8
    for (int i = 0; i < 32; ++i) { const int kk = 2 * i + (lane >> 5); scr[kk * 33 + (lane & 31)] = Wseg[(size_t)(k0 + kk) * ldw + n0 + (lane & 31)]; }
    LDS_WAIT(); asm volatile("" ::: "memory");
    const int c = lane & 7;
#pragma unroll
    for (int j = 0; j < 4; ++j) { const int n = (lane >> 3) + 8 * j; const LAS float* s = scr + (8 * c) * 33 + n;
        u32x4 o; o.x = pk2(s[0 * 33], s[1 * 33]); o.y = pk2(s[2 * 33], s[3 * 33]); o.z = pk2(s[4 * 33], s[5 * 33]); o.w = pk2(s[6 * 33], s[7 * 33]);
        *(u32x4*)(WT + (size_t)(row_off + n0 + n) * K + k0 + 8 * c) = o; }
    LDS_WAIT(); asm volatile("" ::: "memory");
}

DI void transpose_item8(const float* Wseg, int ldw, int ncols, int K, unsigned char* WT, int row_off, LAS float* scr, int item, int lane, float qs) {
    const int nblk = ncols / 32, kb = item / nblk, nb = item % nblk, k0 = 128 * kb, n0 = 32 * nb;
    const float* wp = Wseg + (size_t)(k0 + (lane >> 5)) * ldw + n0 + (lane & 31);
#pragma unroll
    for (int hb = 0; hb < 2; ++hb) { float v[32];
#pragma unroll
        for (int i = 0; i < 32; ++i) v[i] = wp[(size_t)(64 * hb + 2 * i) * ldw];
#pragma unroll
        for (int i = 0; i < 32; ++i) scr[(64 * hb + 2 * i + (lane >> 5)) * 33 + (lane & 31)] = v[i] * qs; }
    LDS_WAIT(); asm volatile("" ::: "memory");
    const int n = lane >> 1, hf = lane & 1; const LAS float* sp = scr + (64 * hf) * 33 + n;
    unsigned char* dst = WT + (size_t)(row_off + n0 + n) * K + k0 + 64 * hf;
#pragma unroll
    for (int q = 0; q < 4; ++q) { u32x4 o;
        o.x = pk4fp8(sp[(16 * q + 0) * 33], sp[(16 * q + 1) * 33], sp[(16 * q + 2) * 33], sp[(16 * q + 3) * 33]); o.y = pk4fp8(sp[(16 * q + 4) * 33], sp[(16 * q + 5) * 33], sp[(16 * q + 6) * 33], sp[(16 * q + 7) * 33]);
        o.z = pk4fp8(sp[(16 * q + 8) * 33], sp[(16 * q + 9) * 33], sp[(16 * q + 10) * 33], sp[(16 * q + 11) * 33]); o.w = pk4fp8(sp[(16 * q + 12) * 33], sp[(16 * q + 13) * 33], sp[(16 * q + 14) * 33], sp[(16 * q + 15) * 33]);
        *(u32x4*)(dst + 16 * q) = o; }
    LDS_WAIT(); asm volatile("" ::: "memory");
}
DI void p0_weights(Frame& F, const float* const* in) {
    LAS float* scr = (LAS float*)(F.lds + F.wave * 16896);
    bf16_t* win0 = (bf16_t*)(F.ws + WS_WIN0); bf16_t* wout0 = (bf16_t*)(F.ws + WS_WOUT0); bf16_t* win1 = (bf16_t*)(F.ws + WS_WIN1); bf16_t* wout1 = (bf16_t*)(F.ws + WS_WOUT1);
    const float* ewin = in[3]; const float* ewout = in[9]; const float* owin = in[10]; const float* owout = in[14];
    constexpr int KB = D / 64;
    constexpr int I_A = KB * (2048 / 32), I_B = KB * (2048 / 32), I_8 = (D / 128) * (2048 / 32);
    constexpr int I_O0 = (4096 / 64) * (D / 32), I_I1 = (D / 128) * (ODD_IN / 32), I_O1 = (D / 128) * (D / 32);
    constexpr int NIT = I_A + I_B + 2 * I_8 + 2 * I_A;
    unsigned char* win8 = F.ws + AUX_WIN8; (void)wout0; (void)win1; (void)wout1; (void)ewout; (void)owin; (void)owout; (void)I_O0; (void)I_I1; (void)I_O1;
    for (int it = F.gw; it < NIT; it += F.NGW) {
        int r = it;
        if (r < I_A) { transpose_item(ewin + 0, EVEN_IN, 2048, D, win0, C_RQ, scr, r, F.lane); continue; } r -= I_A;
        if (r < I_B) { transpose_item(ewin + 6144, EVEN_IN, 2048, D, win0, C_GQKV, scr, r, F.lane); continue; } r -= I_B;
        if (r < I_8) { transpose_item8(ewin + 2048, EVEN_IN, 2048, D, win8, C_RV, scr, r, F.lane, 32.f); continue; } r -= I_8;
        if (r < I_8) { transpose_item8(ewin + 8192, EVEN_IN, 2048, D, win8, C_GQKV + 2048, scr, r, F.lane, 32.f); continue; } r -= I_8;
        if (r < I_A) { transpose_item(ewin + 4096, EVEN_IN, 2048, D, win0, C_RG, scr, r, F.lane); continue; } r -= I_A;
        transpose_item(ewin + 10240, EVEN_IN, 2048, D, win0, C_GZ, scr, r, F.lane);
    }
    bf16_t* swh = (bf16_t*)(F.ws + AUX_SW); bf16_t* swl = swh + 112 * D;
    const int gt = (F.gw * 64 + F.lane), NGT = F.NGW * 64;
    for (int i = gt; i < 112 * D; i += NGT) { const int c = i / D, k = i % D; float v;
        if (c < 16) v = ewin[(size_t)k * EVEN_IN + 12288 + c] * in[1][k];
        else { const int l = (c - 16) / 48, cc = (c - 16) % 48; const float gn = in[2][l * D + k]; v = cc < 4 ? in[15][(size_t)l * D * 4 + k * 4 + cc] * gn : (cc < 36 ? in[16][(size_t)l * D * 32 + k * 32 + (cc - 4)] * gn : 0.f); }
        const unsigned hb = f2bf(v); const float lo = v - __builtin_bit_cast(float, hb << 16); swh[i] = (bf16_t)hb; swl[i] = (bf16_t)f2bf(lo); }
    f32x2* cs = (f32x2*)(F.ws + AUX_CS);
    for (int i = gt; i < SEQ * 64; i += NGT) { const int pos = i >> 6, fi = i & 63; double inv = 1.0;
        for (int q = 0; q < fi; ++q) inv *= ROPE_R;
        const double x = (double)pos * inv, k = __builtin_rint(x * 0.15915494309189535), r = (x - k * 6.283185307179586) - k * 2.4492935982947064e-16;
        const float rf = (float)r; const f32x2 v = {cosf(rf), sinf(rf)}; cs[i] = v; if ((fi & 1) == 0) ((f32x2*)(F.ws + AUX_CS32))[pos * 32 + (fi >> 1)] = v; }
}
DI void p0_late(Frame& F, const float* const* in, int widx, int nw) {
    LAS float* scr = (LAS float*)(F.lds + F.wave * 16896);
    constexpr int I_O0 = (4096 / 64) * (D / 32), I_I1 = (D / 128) * (ODD_IN / 32), I_O1 = (D / 128) * (D / 32);
    for (int it = widx; it < I_O0 + I_I1 + I_O1; it += nw) {
        int r = it;
        if (r < I_O0) { transpose_item(in[9], D, D, 4096, (bf16_t*)(F.ws + WS_WOUT0), 0, scr, r, F.lane); continue; } r -= I_O0;
        if (r < I_I1) { transpose_item8(in[10], ODD_IN, ODD_IN, D, F.ws + WS_WIN1, 0, scr, r, F.lane, 32.f); continue; } r -= I_I1;
        transpose_item8(in[14], D, D, D, F.ws + WS_WOUT1, 0, scr, r, F.lane, 32.f);
    }
}
struct T8Item { const float* wp; size_t ldw; unsigned char* dst; float qs; };
DI T8Item t8_item(const float* Wseg, int ldw, int ncols, int K, unsigned char* WT, int row_off, int item, int lane, float qs) {
    const int nblk = ncols / 32, kb = item / nblk, nb = item % nblk, k0 = 128 * kb, n0 = 32 * nb;
    T8Item t; t.wp = Wseg + (size_t)(k0 + (lane >> 5)) * ldw + n0 + (lane & 31); t.ldw = (size_t)ldw; t.dst = WT + (size_t)(row_off + n0 + (lane >> 1)) * K + k0 + 64 * (lane & 1); t.qs = qs; return t;
}
DI void t8_issue(float (&v)[64], const T8Item& t) {
#pragma unroll
    for (int i = 0; i < 64; ++i) v[i] = t.wp[(size_t)(2 * i) * t.ldw];
}
DI void t8_to_lds(const float (&v)[64], const T8Item& t, LAS float* scr, int lane) {
#pragma unroll
    for (int i = 0; i < 64; ++i) scr[(2 * i + (lane >> 5)) * 33 + (lane & 31)] = v[i] * t.qs;
}
DI void t8_finish(const T8Item& t, LAS float* scr, int lane) {
    const LAS float* sp = scr + (64 * (lane & 1)) * 33 + (lane >> 1);
#pragma unroll
    for (int q = 0; q < 4; ++q) { u32x4 o;
        o.x = pk4fp8(sp[(16 * q + 0) * 33], sp[(16 * q + 1) * 33], sp[(16 * q + 2) * 33], sp[(16 * q + 3) * 33]); o.y = pk4fp8(sp[(16 * q + 4) * 33], sp[(16 * q + 5) * 33], sp[(16 * q + 6) * 33], sp[(16 * q + 7) * 33]);
        o.z = pk4fp8(sp[(16 * q + 8) * 33], sp[(16 * q + 9) * 33], sp[(16 * q + 10) * 33], sp[(16 * q + 11) * 33]); o.w = pk4fp8(sp[(16 * q + 12) * 33], sp[(16 * q + 13) * 33], sp[(16 * q + 14) * 33], sp[(16 * q + 15) * 33]);
        *(u32x4*)(t.dst + 16 * q) = o; }
}
DI void convert_experts(Frame& F, const float* const* in, int l, unsigned char* gu, unsigned char* dn, int widx, int nw, bool do_gu = true, bool do_dn = true) {
    LAS float* scr = (LAS float*)(F.lds + F.wave * 16896);
    const float* wg = in[17] + (size_t)l * NEXP * D * FF; const float* wu = in[18] + (size_t)l * NEXP * D * FF; const float* wd = in[19] + (size_t)l * NEXP * FF * D;
    constexpr int I_G = (D / 128) * (128 / 32);
    constexpr int I_GU = NEXP * 6 * 2 * I_G;
    constexpr int I_DE = (FF / 128) * (D / 32);
    constexpr int NIT = I_GU + NEXP * I_DE;
    const int lane = F.lane;
    const int hi = do_dn ? NIT : I_GU;
    int it = (do_gu ? 0 : I_GU) + widx;
    float v[64];
    T8Item cur, nxt;
#define EXPERT_ITEM(T, IT) do { const int it_ = (IT); const bool g_ = it_ < I_GU; const int seg_ = it_ / I_G, r2_ = it_ - I_GU; const int e_ = g_ ? seg_ / 12 : r2_ / I_DE, sg_ = seg_ % 12, pn_ = sg_ >> 1, up_ = sg_ & 1;  \
        const float* src_ = g_ ? (up_ ? wu : wg) + (size_t)e_ * D * FF + pn_ * 128 : wd + (size_t)e_ * FF * D;                                                                                          \
        unsigned char* wt_ = g_ ? gu + (size_t)e_ * 1536 * D : dn + (size_t)e_ * D * FF;                                                                                                                 \
        T = t8_item(src_, g_ ? FF : D, g_ ? 128 : D, g_ ? D : FF, wt_, g_ ? pn_ * 256 + up_ * 128 : 0, g_ ? it_ % I_G : r2_ % I_DE, lane, g_ ? 64.f : 32.f); } while (0)
    if (it < hi) {
        EXPERT_ITEM(cur, it);
        t8_issue(v, cur);
        bool more = true;
        while (more) {
            asm volatile("" ::: "memory");
            t8_to_lds(v, cur, scr, lane);
            asm volatile("" ::: "memory");
            const int nx = it + nw; more = nx < hi;
            EXPERT_ITEM(nxt, more ? nx : it);
            if (more) t8_issue(v, nxt);
            LDS_WAIT(); asm volatile("" ::: "memory");
            t8_finish(cur, scr, lane);
            LDS_WAIT(); asm volatile("" ::: "memory");
            cur = nxt; it = nx;
        }
    }
#undef EXPERT_ITEM
}

template <int NP, bool ADDY, bool WRITEX, bool WRITEH, class Handler, bool H8 = false, bool SRC16 = false, bool DST16 = false>
DI void norm_pass(Frame& F, const void* src, void* dst, const bf16_t* y, const unsigned* asg, const LAS int* tb, const float* gain, const float* Wt, bf16_t* H, Handler hnd) {
    for (int m = F.gw; m < NTOK; m += F.NGW) {
        f32x4 v[8];
        if (SRC16) { const u32x2* xr = (const u32x2*)((const bf16_t*)src + (size_t)m * D) + F.lane;
#pragma unroll
            for (int j = 0; j < 8; ++j) { const u32x2 b = xr[64 * j]; v[j] = (f32x4){bflo(b.x), bfhi(b.x), bflo(b.y), bfhi(b.y)}; } }
        else { const f32x4* xr = (const f32x4*)((const float*)src + (size_t)m * D) + F.lane;
#pragma unroll
            for (int j = 0; j < 8; ++j) v[j] = xr[64 * j]; }
        if (ADDY) {
            const unsigned a0 = asg[2 * m], a1 = asg[2 * m + 1];
            const size_t r0 = (size_t)tb[a0 >> 16] * 256 + (a0 & 0xffffu), r1 = (size_t)tb[a1 >> 16] * 256 + (a1 & 0xffffu);
            const unsigned* y0 = (const unsigned*)((const unsigned char*)y + r0 * D) + F.lane; const unsigned* y1 = (const unsigned*)((const unsigned char*)y + r1 * D) + F.lane;
#pragma unroll
            for (int j = 0; j < 8; ++j) { const int p = (int)y0[64 * j], q = (int)y1[64 * j];
                v[j].x += (__builtin_amdgcn_cvt_f32_fp8(p, 0) + __builtin_amdgcn_cvt_f32_fp8(q, 0)) * 0.0625f; v[j].y += (__builtin_amdgcn_cvt_f32_fp8(p, 1) + __builtin_amdgcn_cvt_f32_fp8(q, 1)) * 0.0625f;
                v[j].z += (__builtin_amdgcn_cvt_f32_fp8(p, 2) + __builtin_amdgcn_cvt_f32_fp8(q, 2)) * 0.0625f; v[j].w += (__builtin_amdgcn_cvt_f32_fp8(p, 3) + __builtin_amdgcn_cvt_f32_fp8(q, 3)) * 0.0625f; }
        }
        if (WRITEX) {
            if (DST16) { u32x2* xo = (u32x2*)((bf16_t*)dst + (size_t)m * D) + F.lane;
#pragma unroll
                for (int j = 0; j < 8; ++j) { u32x2 w; w.x = pk2(v[j].x, v[j].y); w.y = pk2(v[j].z, v[j].w); xo[64 * j] = w;
                    if (WRITEH) v[j] = (f32x4){bflo(w.x), bfhi(w.x), bflo(w.y), bfhi(w.y)}; } }
            else { f32x4* xo = (f32x4*)((float*)dst + (size_t)m * D) + F.lane;
#pragma unroll
                for (int j = 0; j < 8; ++j) xo[64 * j] = v[j]; } }
        if (WRITEH) {
            float s = 0.f;
#pragma unroll
            for (int j = 0; j < 8; ++j) s += (v[j].x * v[j].x + v[j].y * v[j].y) + (v[j].z * v[j].z + v[j].w * v[j].w);
            const float rstd = 1.0f / sqrtf(wave_sum(s) * (1.0f / D) + EPS);
            const f32x4* gr = (const f32x4*)gain + F.lane;
#pragma unroll
            for (int j = 0; j < 8; ++j) v[j] = v[j] * rstd * gr[64 * j];
            if (H8) { unsigned* ho8 = (unsigned*)((unsigned char*)H + (size_t)m * D) + F.lane;
#pragma unroll
                for (int j = 0; j < 8; ++j) ho8[64 * j] = pk4fp8(v[j].x * 4.f, v[j].y * 4.f, v[j].z * 4.f, v[j].w * 4.f); }
            else {
            u32x2* ho = (u32x2*)(H + (size_t)m * D) + F.lane;
#pragma unroll
            for (int j = 0; j < 8; ++j) { u32x2 w; w.x = pk2(v[j].x, v[j].y); w.y = pk2(v[j].z, v[j].w); ho[64 * j] = w; } }
            if constexpr (NP > 0) {
                float res = 0.f;
#pragma unroll 1
                for (int c0 = 0; c0 < NP; c0 += 4) {
                    float a[4];
#pragma unroll
                    for (int cc = 0; cc < 4; ++cc) { const f32x4* wr = (const f32x4*)(Wt + (size_t)(c0 + cc) * D) + F.lane; a[cc] = 0.f;
#pragma unroll
                        for (int j = 0; j < 8; ++j) { const f32x4 w = wr[64 * j]; a[cc] += (v[j].x * w.x + v[j].y * w.y) + (v[j].z * w.z + v[j].w * w.w); } }
#pragma unroll
                    for (int cc = 0; cc < 4; ++cc) { const float t = wave_sum(a[cc]); res = (F.lane == c0 + cc) ? t : res; }
                }
                hnd(m, res);
            }
        }
    }
}


struct XTileF { f32x4 f[8][2]; };
struct XTileB { u32x4 p[8]; };
template <bool XB> struct XTileSel { typedef XTileF T; };
template <> struct XTileSel<true> { typedef XTileB T; };
DI void xget(const XTileF& t, int i, f32x4& xa, f32x4& xb) { xa = t.f[i][0]; xb = t.f[i][1]; }
DI void xget(const XTileB& t, int i, f32x4& xa, f32x4& xb) { const u32x4 b = t.p[i]; xa = (f32x4){bflo(b.x), bfhi(b.x), bflo(b.y), bfhi(b.y)}; xb = (f32x4){bflo(b.z), bfhi(b.z), bflo(b.w), bfhi(b.w)}; }
DI void xtile_load(Frame& F, XTileB& xr, const void* x, int tile) {
    const u32x4* xp = (const u32x4*)((const bf16_t*)x + ((size_t)tile * 16 + (F.lane & 15)) * D + 256 * F.wave + 8 * (F.lane >> 4));
#pragma unroll
    for (int i = 0; i < 8; ++i) xr.p[i] = xp[4 * i];
}
DI void xtile_load(Frame& F, XTileF& xr, const void* x, int tile) {
    const f32x4* xp = (const f32x4*)((const float*)x + ((size_t)tile * 16 + (F.lane & 15)) * D + 256 * F.wave + 8 * (F.lane >> 4));
#pragma unroll
    for (int i = 0; i < 8; ++i) { xr.f[i][0] = xp[8 * i]; xr.f[i][1] = xp[8 * i + 1]; }
}
template <bool XB, class T> DI void xsplit(const T& t, int i, const f32x4& xa, const f32x4& xb, bf16x8& xh, bf16x8& xl) {
    if constexpr (XB) { xh = __builtin_bit_cast(bf16x8, t.p[i]); xl = xh; }
    else { u32x4 hw; hw.x = pkbf(xa.x, xa.y); hw.y = pkbf(xa.z, xa.w); hw.z = pkbf(xb.x, xb.y); hw.w = pkbf(xb.z, xb.w);
        u32x4 lw; lw.x = pkbf(xa.x - bflo(hw.x), xa.y - bfhi(hw.x)); lw.y = pkbf(xa.z - bflo(hw.y), xa.w - bfhi(hw.y)); lw.z = pkbf(xb.x - bflo(hw.z), xb.y - bfhi(hw.z)); lw.w = pkbf(xb.z - bflo(hw.w), xb.w - bfhi(hw.w));
        xh = __builtin_bit_cast(bf16x8, hw); xl = __builtin_bit_cast(bf16x8, lw); }
}
constexpr int NP_GAIN_OFF = 65536 + 8192;
template <int MODE, bool XB>
DI void normproj_tile(Frame& F, const typename XTileSel<XB>::T& xr, typename XTileSel<XB>::T& xn, const void* x, int ntile, int tile, int tl, int par, const bf16_t* Wh, const bf16_t* Wl, bf16_t* H, float* bg, float dtb, float nea) {
    constexpr int NT = MODE == 0 ? 1 : 3;
    int lane_o = F.lane; asm volatile("" : "+v"(lane_o));
    const int lane = lane_o, r = lane & 15, kq = lane >> 4, w = F.wave;
    LAS float* ssp = (LAS float*)(F.lds + par * 32768);
    LAS f32x4* lp = (LAS f32x4*)(F.lds + par * 32768 + 1024);
    LAS float* lg = (LAS float*)(F.lds + par * 32768 + 1024 + 24576);
    LAS f32x4* sel = (LAS f32x4*)(F.lds + 65536);
    const size_t tok0 = (size_t)tile * 16;
    f32x4 acc[NT];
#pragma unroll
    for (int nt = 0; nt < NT; ++nt) acc[nt] = (f32x4){0.f, 0.f, 0.f, 0.f};
    float ss = 0.f;
    if constexpr (NT == 3) {
        u32x4 q0_0_0, q0_0_1, q0_1_0, q0_1_1, q0_2_0, q0_2_1, q1_0_0, q1_0_1, q1_1_0, q1_1_1, q1_2_0, q1_2_1, q2_0_0, q2_0_1, q2_1_0, q2_1_1, q2_2_0, q2_2_1, q3_0_0, q3_0_1, q3_1_0, q3_1_1, q3_2_0, q3_2_1;
        const unsigned char* wp0_0 = (const unsigned char*)(Wh + (size_t)(0 + r) * D + 256 * w + 8 * kq); const unsigned char* wp0_1 = (const unsigned char*)(Wl + (size_t)(0 + r) * D + 256 * w + 8 * kq);
        const unsigned char* wp1_0 = (const unsigned char*)(Wh + (size_t)(16 + r) * D + 256 * w + 8 * kq); const unsigned char* wp1_1 = (const unsigned char*)(Wl + (size_t)(16 + r) * D + 256 * w + 8 * kq);
        const unsigned char* wp2_0 = (const unsigned char*)(Wh + (size_t)(32 + r) * D + 256 * w + 8 * kq); const unsigned char* wp2_1 = (const unsigned char*)(Wl + (size_t)(32 + r) * D + 256 * w + 8 * kq);
        asm volatile("global_load_dwordx4 %0, %1, off" : "=v"(q0_0_0) : "v"(wp0_0) : "memory"); asm volatile("global_load_dwordx4 %0, %1, off offset:64" : "=v"(q1_0_0) : "v"(wp0_0) : "memory"); asm volatile("global_load_dwordx4 %0, %1, off" : "=v"(q0_0_1) : "v"(wp0_1) : "memory"); asm volatile("global_load_dwordx4 %0, %1, off offset:64" : "=v"(q1_0_1) : "v"(wp0_1) : "memory"); asm volatile("global_load_dwordx4 %0, %1, off" : "=v"(q0_1_0) : "v"(wp1_0) : "memory"); asm volatile("global_load_dwordx4 %0, %1, off offset:64" : "=v"(q1_1_0) : "v"(wp1_0) : "memory"); asm volatile("global_load_dwordx4 %0, %1, off" : "=v"(q0_1_1) : "v"(wp1_1) : "memory"); asm volatile("global_load_dwordx4 %0, %1, off offset:64" : "=v"(q1_1_1) : "v"(wp1_1) : "memory"); asm volatile("global_load_dwordx4 %0, %1, off" : "=v"(q0_2_0) : "v"(wp2_0) : "memory"); asm volatile("global_load_dwordx4 %0, %1, off offset:64" : "=v"(q1_2_0) : "v"(wp2_0) : "memory"); asm volatile("global_load_dwordx4 %0, %1, off" : "=v"(q0_2_1) : "v"(wp2_1) : "memory"); asm volatile("global_load_dwordx4 %0, %1, off offset:64" : "=v"(q1_2_1) : "v"(wp2_1) : "memory");
        asm volatile("global_load_dwordx4 %0, %1, off offset:128" : "=v"(q2_0_0) : "v"(wp0_0) : "memory"); asm volatile("global_load_dwordx4 %0, %1, off offset:192" : "=v"(q3_0_0) : "v"(wp0_0) : "memory"); asm volatile("global_load_dwordx4 %0, %1, off offset:128" : "=v"(q2_0_1) : "v"(wp0_1) : "memory"); asm volatile("global_load_dwordx4 %0, %1, off offset:192" : "=v"(q3_0_1) : "v"(wp0_1) : "memory"); asm volatile("global_load_dwordx4 %0, %1, off offset:128" : "=v"(q2_1_0) : "v"(wp1_0) : "memory"); asm volatile("global_load_dwordx4 %0, %1, off offset:192" : "=v"(q3_1_0) : "v"(wp1_0) : "memory"); asm volatile("global_load_dwordx4 %0, %1, off offset:128" : "=v"(q2_1_1) : "v"(wp1_1) : "memory"); asm volatile("global_load_dwordx4 %0, %1, off offset:192" : "=v"(q3_1_1) : "v"(wp1_1) : "memory"); asm volatile("global_load_dwordx4 %0, %1, off offset:128" : "=v"(q2_2_0) : "v"(wp2_0) : "memory"); asm volatile("global_load_dwordx4 %0, %1, off offset:192" : "=v"(q3_2_0) : "v"(wp2_0) : "memory"); asm volatile("global_load_dwordx4 %0, %1, off offset:128" : "=v"(q2_2_1) : "v"(wp2_1) : "memory"); asm volatile("global_load_dwordx4 %0, %1, off offset:192" : "=v"(q3_2_1) : "v"(wp2_1) : "memory");
        asm volatile("s_waitcnt vmcnt(13)" : "+v"(q0_0_0), "+v"(q0_0_1), "+v"(q0_1_0), "+v"(q0_1_1), "+v"(q0_2_0), "+v"(q0_2_1));
        { f32x4 xa, xb; xget(xr, 0, xa, xb); constexpr int XI = 0;
          ss += ((xa.x * xa.x + xa.y * xa.y) + (xa.z * xa.z + xa.w * xa.w)) + ((xb.x * xb.x + xb.y * xb.y) + (xb.z * xb.z + xb.w * xb.w));
          bf16x8 xh, xl; xsplit<XB>(xr, XI, xa, xb, xh, xl);
          { const bf16x8 wh = __builtin_bit_cast(bf16x8, q0_0_0), wl = __builtin_bit_cast(bf16x8, q0_0_1); acc[0] = mfma16(xh, wh, acc[0]); acc[0] = mfma16(xh, wl, acc[0]); if constexpr (!XB) acc[0] = mfma16(xl, wh, acc[0]); }
          { const bf16x8 wh = __builtin_bit_cast(bf16x8, q0_1_0), wl = __builtin_bit_cast(bf16x8, q0_1_1); acc[1] = mfma16(xh, wh, acc[1]); acc[1] = mfma16(xh, wl, acc[1]); if constexpr (!XB) acc[1] = mfma16(xl, wh, acc[1]); }
          { const bf16x8 wh = __builtin_bit_cast(bf16x8, q0_2_0), wl = __builtin_bit_cast(bf16x8, q0_2_1); acc[2] = mfma16(xh, wh, acc[2]); acc[2] = mfma16(xh, wl, acc[2]); if constexpr (!XB) acc[2] = mfma16(xl, wh, acc[2]); }
        }
        asm volatile("s_waitcnt vmcnt(12)" : "+v"(q1_0_0), "+v"(q1_0_1), "+v"(q1_1_0), "+v"(q1_1_1), "+v"(q1_2_0), "+v"(q1_2_1));
        { f32x4 xa, xb; xget(xr, 1, xa, xb); constexpr int XI = 1;
          ss += ((xa.x * xa.x + xa.y * xa.y) + (xa.z * xa.z + xa.w * xa.w)) + ((xb.x * xb.x + xb.y * xb.y) + (xb.z * xb.z + xb.w * xb.w));
          bf16x8 xh, xl; xsplit<XB>(xr, XI, xa, xb, xh, xl);
          { const bf16x8 wh = __builtin_bit_cast(bf16x8, q1_0_0), wl = __builtin_bit_cast(bf16x8, q1_0_1); acc[0] = mfma16(xh, wh, acc[0]); acc[0] = mfma16(xh, wl, acc[0]); if constexpr (!XB) acc[0] = mfma16(xl, wh, acc[0]); }
          { const bf16x8 wh = __builtin_bit_cast(bf16x8, q1_1_0), wl = __builtin_bit_cast(bf16x8, q1_1_1); acc[1] = mfma16(xh, wh, acc[1]); acc[1] = mfma16(xh, wl, acc[1]); if constexpr (!XB) acc[1] = mfma16(xl, wh, acc[1]); }
          { const bf16x8 wh = __builtin_bit_cast(bf16x8, q1_2_0), wl = __builtin_bit_cast(bf16x8, q1_2_1); acc[2] = mfma16(xh, wh, acc[2]); acc[2] = mfma16(xh, wl, acc[2]); if constexpr (!XB) acc[2] = mfma16(xl, wh, acc[2]); }
        }
        asm volatile("" :: "v"(acc[0]));
        asm volatile("global_load_dwordx4 %0, %1, off offset:256" : "=v"(q0_0_0) : "v"(wp0_0) : "memory"); asm volatile("global_load_dwordx4 %0, %1, off offset:320" : "=v"(q1_0_0) : "v"(wp0_0) : "memory"); asm volatile("global_load_dwordx4 %0, %1, off offset:256" : "=v"(q0_0_1) : "v"(wp0_1) : "memory"); asm volatile("global_load_dwordx4 %0, %1, off offset:320" : "=v"(q1_0_1) : "v"(wp0_1) : "memory"); asm volatile("global_load_dwordx4 %0, %1, off offset:256" : "=v"(q0_1_0) : "v"(wp1_0) : "memory"); asm volatile("global_load_dwordx4 %0, %1, off offset:320" : "=v"(q1_1_0) : "v"(wp1_0) : "memory"); asm volatile("global_load_dwordx4 %0, %1, off offset:256" : "=v"(q0_1_1) : "v"(wp1_1) : "memory"); asm volatile("global_load_dwordx4 %0, %1, off offset:320" : "=v"(q1_1_1) : "v"(wp1_1) : "memory"); asm volatile("global_load_dwordx4 %0, %1, off offset:256" : "=v"(q0_2_0) : "v"(wp2_0) : "memory"); asm volatile("global_load_dwordx4 %0, %1, off offset:320" : "=v"(q1_2_0) : "v"(wp2_0) : "memory"); asm volatile("global_load_dwordx4 %0, %1, off offset:256" : "=v"(q0_2_1) : "v"(wp2_1) : "memory"); asm volatile("global_load_dwordx4 %0, %1, off offset:320" : "=v"(q1_2_1) : "v"(wp2_1) : "memory");
        asm volatile("s_waitcnt vmcnt(13)" : "+v"(q2_0_0), "+v"(q2_0_1), "+v"(q2_1_0), "+v"(q2_1_1), "+v"(q2_2_0), "+v"(q2_2_1));
        { f32x4 xa, xb; xget(xr, 2, xa, xb); constexpr int XI = 2;
          ss += ((xa.x * xa.x + xa.y * xa.y) + (xa.z * xa.z + xa.w * xa.w)) + ((xb.x * xb.x + xb.y * xb.y) + (xb.z * xb.z + xb.w * xb.w));
          bf16x8 xh, xl; xsplit<XB>(xr, XI, xa, xb, xh, xl);
          { const bf16x8 wh = __builtin_bit_cast(bf16x8, q2_0_0), wl = __builtin_bit_cast(bf16x8, q2_0_1); acc[0] = mfma16(xh, wh, acc[0]); acc[0] = mfma16(xh, wl, acc[0]); if constexpr (!XB) acc[0] = mfma16(xl, wh, acc[0]); }
          { const bf16x8 wh = __builtin_bit_cast(bf16x8, q2_1_0), wl = __builtin_bit_cast(bf16x8, q2_1_1); acc[1] = mfma16(xh, wh, acc[1]); acc[1] = mfma16(xh, wl, acc[1]); if constexpr (!XB) acc[1] = mfma16(xl, wh, acc[1]); }
          { const bf16x8 wh = __builtin_bit_cast(bf16x8, q2_2_0), wl = __builtin_bit_cast(bf16x8, q2_2_1); acc[2] = mfma16(xh, wh, acc[2]); acc[2] = mfma16(xh, wl, acc[2]); if constexpr (!XB) acc[2] = mfma16(xl, wh, acc[2]); }
        }
        asm volatile("s_waitcnt vmcnt(12)" : "+v"(q3_0_0), "+v"(q3_0_1), "+v"(q3_1_0), "+v"(q3_1_1), "+v"(q3_2_0), "+v"(q3_2_1));
        { f32x4 xa, xb; xget(xr, 3, xa, xb); constexpr int XI = 3;
          ss += ((xa.x * xa.x + xa.y * xa.y) + (xa.z * xa.z + xa.w * xa.w)) + ((xb.x * xb.x + xb.y * xb.y) + (xb.z * xb.z + xb.w * xb.w));
          bf16x8 xh, xl; xsplit<XB>(xr, XI, xa, xb, xh, xl);
          { const bf16x8 wh = __builtin_bit_cast(bf16x8, q3_0_0), wl = __builtin_bit_cast(bf16x8, q3_0_1); acc[0] = mfma16(xh, wh, acc[0]); acc[0] = mfma16(xh, wl, acc[0]); if constexpr (!XB) acc[0] = mfma16(xl, wh, acc[0]); }
          { const bf16x8 wh = __builtin_bit_cast(bf16x8, q3_1_0), wl = __builtin_bit_cast(bf16x8, q3_1_1); acc[1] = mfma16(xh, wh, acc[1]); acc[1] = mfma16(xh, wl, acc[1]); if constexpr (!XB) acc[1] = mfma16(xl, wh, acc[1]); }
          { const bf16x8 wh = __builtin_bit_cast(bf16x8, q3_2_0), wl = __builtin_bit_cast(bf16x8, q3_2_1); acc[2] = mfma16(xh, wh, acc[2]); acc[2] = mfma16(xh, wl, acc[2]); if constexpr (!XB) acc[2] = mfma16(xl, wh, acc[2]); }
        }
        asm volatile("" :: "v"(acc[0]));
        asm volatile("global_load_dwordx4 %0, %1, off offset:384" : "=v"(q2_0_0) : "v"(wp0_0) : "memory"); asm volatile("global_load_dwordx4 %0, %1, off offset:448" : "=v"(q3_0_0) : "v"(wp0_0) : "memory"); asm volatile("global_load_dwordx4 %0, %1, off offset:384" : "=v"(q2_0_1) : "v"(wp0_1) : "memory"); asm volatile("global_load_dwordx4 %0, %1, off offset:448" : "=v"(q3_0_1) : "v"(wp0_1) : "memory"); asm volatile("global_load_dwordx4 %0, %1, off offset:384" : "=v"(q2_1_0) : "v"(wp1_0) : "memory"); asm volatile("global_load_dwordx4 %0, %1, off offset:448" : "=v"(q3_1_0) : "v"(wp1_0) : "memory"); asm volatile("global_load_dwordx4 %0, %1, off offset:384" : "=v"(q2_1_1) : "v"(wp1_1) : "memory"); asm volatile("global_load_dwordx4 %0, %1, off offset:448" : "=v"(q3_1_1) : "v"(wp1_1) : "memory"); asm volatile("global_load_dwordx4 %0, %1, off offset:384" : "=v"(q2_2_0) : "v"(wp2_0) : "memory"); asm volatile("global_load_dwordx4 %0, %1, off offset:448" : "=v"(q3_2_0) : "v"(wp2_0) : "memory"); asm volatile("global_load_dwordx4 %0, %1, off offset:384" : "=v"(q2_2_1) : "v"(wp2_1) : "memory"); asm volatile("global_load_dwordx4 %0, %1, off offset:448" : "=v"(q3_2_1) : "v"(wp2_1) : "memory");
        asm volatile("s_waitcnt vmcnt(13)" : "+v"(q0_0_0), "+v"(q0_0_1), "+v"(q0_1_0), "+v"(q0_1_1), "+v"(q0_2_0), "+v"(q0_2_1));
        { f32x4 xa, xb; xget(xr, 4, xa, xb); constexpr int XI = 4;
          ss += ((xa.x * xa.x + xa.y * xa.y) + (xa.z * xa.z + xa.w * xa.w)) + ((xb.x * xb.x + xb.y * xb.y) + (xb.z * xb.z + xb.w * xb.w));
          bf16x8 xh, xl; xsplit<XB>(xr, XI, xa, xb, xh, xl);
          { const bf16x8 wh = __builtin_bit_cast(bf16x8, q0_0_0), wl = __builtin_bit_cast(bf16x8, q0_0_1); acc[0] = mfma16(xh, wh, acc[0]); acc[0] = mfma16(xh, wl, acc[0]); if constexpr (!XB) acc[0] = mfma16(xl, wh, acc[0]); }
          { const bf16x8 wh = __builtin_bit_cast(bf16x8, q0_1_0), wl = __builtin_bit_cast(bf16x8, q0_1_1); acc[1] = mfma16(xh, wh, acc[1]); acc[1] = mfma16(xh, wl, acc[1]); if constexpr (!XB) acc[1] = mfma16(xl, wh, acc[1]); }
          { const bf16x8 wh = __builtin_bit_cast(bf16x8, q0_2_0), wl = __builtin_bit_cast(bf16x8, q0_2_1); acc[2] = mfma16(xh, wh, acc[2]); acc[2] = mfma16(xh, wl, acc[2]); if constexpr (!XB) acc[2] = mfma16(xl, wh, acc[2]); }
        }
        asm volatile("s_waitcnt vmcnt(12)" : "+v"(q1_0_0), "+v"(q1_0_1), "+v"(q1_1_0), "+v"(q1_1_1), "+v"(q1_2_0), "+v"(q1_2_1));
        { f32x4 xa, xb; xget(xr, 5, xa, xb); constexpr int XI = 5;
          ss += ((xa.x * xa.x + xa.y * xa.y) + (xa.z * xa.z + xa.w * xa.w)) + ((xb.x * xb.x + xb.y * xb.y) + (xb.z * xb.z + xb.w * xb.w));
          bf16x8 xh, xl; xsplit<XB>(xr, XI, xa, xb, xh, xl);
          { const bf16x8 wh = __builtin_bit_cast(bf16x8, q1_0_0), wl = __builtin_bit_cast(bf16x8, q1_0_1); acc[0] = mfma16(xh, wh, acc[0]); acc[0] = mfma16(xh, wl, acc[0]); if constexpr (!XB) acc[0] = mfma16(xl, wh, acc[0]); }
          { const bf16x8 wh = __builtin_bit_cast(bf16x8, q1_1_0), wl = __builtin_bit_cast(bf16x8, q1_1_1); acc[1] = mfma16(xh, wh, acc[1]); acc[1] = mfma16(xh, wl, acc[1]); if constexpr (!XB) acc[1] = mfma16(xl, wh, acc[1]); }
          { const bf16x8 wh = __builtin_bit_cast(bf16x8, q1_2_0), wl = __builtin_bit_cast(bf16x8, q1_2_1); acc[2] = mfma16(xh, wh, acc[2]); acc[2] = mfma16(xh, wl, acc[2]); if constexpr (!XB) acc[2] = mfma16(xl, wh, acc[2]); }
        }
        asm volatile("s_waitcnt vmcnt(1)" : "+v"(q2_0_0), "+v"(q2_0_1), "+v"(q2_1_0), "+v"(q2_1_1), "+v"(q2_2_0), "+v"(q2_2_1));
        { f32x4 xa, xb; xget(xr, 6, xa, xb); constexpr int XI = 6;
          ss += ((xa.x * xa.x + xa.y * xa.y) + (xa.z * xa.z + xa.w * xa.w)) + ((xb.x * xb.x + xb.y * xb.y) + (xb.z * xb.z + xb.w * xb.w));
          bf16x8 xh, xl; xsplit<XB>(xr, XI, xa, xb, xh, xl);
          { const bf16x8 wh = __builtin_bit_cast(bf16x8, q2_0_0), wl = __builtin_bit_cast(bf16x8, q2_0_1); acc[0] = mfma16(xh, wh, acc[0]); acc[0] = mfma16(xh, wl, acc[0]); if constexpr (!XB) acc[0] = mfma16(xl, wh, acc[0]); }
          { const bf16x8 wh = __builtin_bit_cast(bf16x8, q2_1_0), wl = __builtin_bit_cast(bf16x8, q2_1_1); acc[1] = mfma16(xh, wh, acc[1]); acc[1] = mfma16(xh, wl, acc[1]); if constexpr (!XB) acc[1] = mfma16(xl, wh, acc[1]); }
          { const bf16x8 wh = __builtin_bit_cast(bf16x8, q2_2_0), wl = __builtin_bit_cast(bf16x8, q2_2_1); acc[2] = mfma16(xh, wh, acc[2]); acc[2] = mfma16(xh, wl, acc[2]); if constexpr (!XB) acc[2] = mfma16(xl, wh, acc[2]); }
        }
        asm volatile("s_waitcnt vmcnt(0)" : "+v"(q3_0_0), "+v"(q3_0_1), "+v"(q3_1_0), "+v"(q3_1_1), "+v"(q3_2_0), "+v"(q3_2_1));
        { f32x4 xa, xb; xget(xr, 7, xa, xb); constexpr int XI = 7;
          ss += ((xa.x * xa.x + xa.y * xa.y) + (xa.z * xa.z + xa.w * xa.w)) + ((xb.x * xb.x + xb.y * xb.y) + (xb.z * xb.z + xb.w * xb.w));
          bf16x8 xh, xl; xsplit<XB>(xr, XI, xa, xb, xh, xl);
          { const bf16x8 wh = __builtin_bit_cast(bf16x8, q3_0_0), wl = __builtin_bit_cast(bf16x8, q3_0_1); acc[0] = mfma16(xh, wh, acc[0]); acc[0] = mfma16(xh, wl, acc[0]); if constexpr (!XB) acc[0] = mfma16(xl, wh, acc[0]); }
          { const bf16x8 wh = __builtin_bit_cast(bf16x8, q3_1_0), wl = __builtin_bit_cast(bf16x8, q3_1_1); acc[1] = mfma16(xh, wh, acc[1]); acc[1] = mfma16(xh, wl, acc[1]); if constexpr (!XB) acc[1] = mfma16(xl, wh, acc[1]); }
          { const bf16x8 wh = __builtin_bit_cast(bf16x8, q3_2_0), wl = __builtin_bit_cast(bf16x8, q3_2_1); acc[2] = mfma16(xh, wh, acc[2]); acc[2] = mfma16(xh, wl, acc[2]); if constexpr (!XB) acc[2] = mfma16(xl, wh, acc[2]); }
        }
    } else {
        u32x4 q0_0_0, q0_0_1, q1_0_0, q1_0_1, q2_0_0, q2_0_1, q3_0_0, q3_0_1;
        const unsigned char* wp0_0 = (const unsigned char*)(Wh + (size_t)(0 + r) * D + 256 * w + 8 * kq); const unsigned char* wp0_1 = (const unsigned char*)(Wl + (size_t)(0 + r) * D + 256 * w + 8 * kq);
        asm volatile("global_load_dwordx4 %0, %1, off" : "=v"(q0_0_0) : "v"(wp0_0) : "memory"); asm volatile("global_load_dwordx4 %0, %1, off offset:64" : "=v"(q1_0_0) : "v"(wp0_0) : "memory"); asm volatile("global_load_dwordx4 %0, %1, off" : "=v"(q0_0_1) : "v"(wp0_1) : "memory"); asm volatile("global_load_dwordx4 %0, %1, off offset:64" : "=v"(q1_0_1) : "v"(wp0_1) : "memory");
        asm volatile("global_load_dwordx4 %0, %1, off offset:128" : "=v"(q2_0_0) : "v"(wp0_0) : "memory"); asm volatile("global_load_dwordx4 %0, %1, off offset:192" : "=v"(q3_0_0) : "v"(wp0_0) : "memory"); asm volatile("global_load_dwordx4 %0, %1, off offset:128" : "=v"(q2_0_1) : "v"(wp0_1) : "memory"); asm volatile("global_load_dwordx4 %0, %1, off offset:192" : "=v"(q3_0_1) : "v"(wp0_1) : "memory");
        asm volatile("s_waitcnt vmcnt(5)" : "+v"(q0_0_0), "+v"(q0_0_1));
        { f32x4 xa, xb; xget(xr, 0, xa, xb); constexpr int XI = 0;
          ss += ((xa.x * xa.x + xa.y * xa.y) + (xa.z * xa.z + xa.w * xa.w)) + ((xb.x * xb.x + xb.y * xb.y) + (xb.z * xb.z + xb.w * xb.w));
          bf16x8 xh, xl; xsplit<XB>(xr, XI, xa, xb, xh, xl);
          { const bf16x8 wh = __builtin_bit_cast(bf16x8, q0_0_0), wl = __builtin_bit_cast(bf16x8, q0_0_1); acc[0] = mfma16(xh, wh, acc[0]); acc[0] = mfma16(xh, wl, acc[0]); if constexpr (!XB) acc[0] = mfma16(xl, wh, acc[0]); }
        }
        asm volatile("s_waitcnt vmcnt(4)" : "+v"(q1_0_0), "+v"(q1_0_1));
        { f32x4 xa, xb; xget(xr, 1, xa, xb); constexpr int XI = 1;
          ss += ((xa.x * xa.x + xa.y * xa.y) + (xa.z * xa.z + xa.w * xa.w)) + ((xb.x * xb.x + xb.y * xb.y) + (xb.z * xb.z + xb.w * xb.w));
          bf16x8 xh, xl; xsplit<XB>(xr, XI, xa, xb, xh, xl);
          { const bf16x8 wh = __builtin_bit_cast(bf16x8, q1_0_0), wl = __builtin_bit_cast(bf16x8, q1_0_1); acc[0] = mfma16(xh, wh, acc[0]); acc[0] = mfma16(xh, wl, acc[0]); if constexpr (!XB) acc[0] = mfma16(xl, wh, acc[0]); }
        }
        asm volatile("" :: "v"(acc[0]));
        asm volatile("global_load_dwordx4 %0, %1, off offset:256" : "=v"(q0_0_0) : "v"(wp0_0) : "memory"); asm volatile("global_load_dwordx4 %0, %1, off offset:320" : "=v"(q1_0_0) : "v"(wp0_0) : "memory"); asm volatile("global_load_dwordx4 %0, %1, off offset:256" : "=v"(q0_0_1) : "v"(wp0_1) : "memory"); asm volatile("global_load_dwordx4 %0, %1, off offset:320" : "=v"(q1_0_1) : "v"(wp0_1) : "memory");
        asm volatile("s_waitcnt vmcnt(5)" : "+v"(q2_0_0), "+v"(q2_0_1));
        { f32x4 xa, xb; xget(xr, 2, xa, xb); constexpr int XI = 2;
          ss += ((xa.x * xa.x + xa.y * xa.y) + (xa.z * xa.z + xa.w * xa.w)) + ((xb.x * xb.x + xb.y * xb.y) + (xb.z * xb.z + xb.w * xb.w));
          bf16x8 xh, xl; xsplit<XB>(xr, XI, xa, xb, xh, xl);
          { const bf16x8 wh = __builtin_bit_cast(bf16x8, q2_0_0), wl = __builtin_bit_cast(bf16x8, q2_0_1); acc[0] = mfma16(xh, wh, acc[0]); acc[0] = mfma16(xh, wl, acc[0]); if constexpr (!XB) acc[0] = mfma16(xl, wh, acc[0]); }
        }
        asm volatile("s_waitcnt vmcnt(4)" : "+v"(q3_0_0), "+v"(q3_0_1));
        { f32x4 xa, xb; xget(xr, 3, xa, xb); constexpr int XI = 3;
          ss += ((xa.x * xa.x + xa.y * xa.y) + (xa.z * xa.z + xa.w * xa.w)) + ((xb.x * xb.x + xb.y * xb.y) + (xb.z * xb.z + xb.w * xb.w));
          bf16x8 xh, xl; xsplit<XB>(xr, XI, xa, xb, xh, xl);
          { const bf16x8 wh = __builtin_bit_cast(bf16x8, q3_0_0), wl = __builtin_bit_cast(bf16x8, q3_0_1); acc[0] = mfma16(xh, wh, acc[0]); acc[0] = mfma16(xh, wl, acc[0]); if constexpr (!XB) acc[0] = mfma16(xl, wh, acc[0]); }
        }
        asm volatile("" :: "v"(acc[0]));
        asm volatile("global_load_dwordx4 %0, %1, off offset:384" : "=v"(q2_0_0) : "v"(wp0_0) : "memory"); asm volatile("global_load_dwordx4 %0, %1, off offset:448" : "=v"(q3_0_0) : "v"(wp0_0) : "memory"); asm volatile("global_load_dwordx4 %0, %1, off offset:384" : "=v"(q2_0_1) : "v"(wp0_1) : "memory"); asm volatile("global_load_dwordx4 %0, %1, off offset:448" : "=v"(q3_0_1) : "v"(wp0_1) : "memory");
        asm volatile("s_waitcnt vmcnt(5)" : "+v"(q0_0_0), "+v"(q0_0_1));
        { f32x4 xa, xb; xget(xr, 4, xa, xb); constexpr int XI = 4;
          ss += ((xa.x * xa.x + xa.y * xa.y) + (xa.z * xa.z + xa.w * xa.w)) + ((xb.x * xb.x + xb.y * xb.y) + (xb.z * xb.z + xb.w * xb.w));
          bf16x8 xh, xl; xsplit<XB>(xr, XI, xa, xb, xh, xl);
          { const bf16x8 wh = __builtin_bit_cast(bf16x8, q0_0_0), wl = __builtin_bit_cast(bf16x8, q0_0_1); acc[0] = mfma16(xh, wh, acc[0]); acc[0] = mfma16(xh, wl, acc[0]); if constexpr (!XB) acc[0] = mfma16(xl, wh, acc[0]); }
        }
        asm volatile("s_waitcnt vmcnt(4)" : "+v"(q1_0_0), "+v"(q1_0_1));
        { f32x4 xa, xb; xget(xr, 5, xa, xb); constexpr int XI = 5;
          ss += ((xa.x * xa.x + xa.y * xa.y) + (xa.z * xa.z + xa.w * xa.w)) + ((xb.x * xb.x + xb.y * xb.y) + (xb.z * xb.z + xb.w * xb.w));
          bf16x8 xh, xl; xsplit<XB>(xr, XI, xa, xb, xh, xl);
          { const bf16x8 wh = __builtin_bit_cast(bf16x8, q1_0_0), wl = __builtin_bit_cast(bf16x8, q1_0_1); acc[0] = mfma16(xh, wh, acc[0]); acc[0] = mfma16(xh, wl, acc[0]); if constexpr (!XB) acc[0] = mfma16(xl, wh, acc[0]); }
        }
        asm volatile("s_waitcnt vmcnt(1)" : "+v"(q2_0_0), "+v"(q2_0_1));
        { f32x4 xa, xb; xget(xr, 6, xa, xb); constexpr int XI = 6;
          ss += ((xa.x * xa.x + xa.y * xa.y) + (xa.z * xa.z + xa.w * xa.w)) + ((xb.x * xb.x + xb.y * xb.y) + (xb.z * xb.z + xb.w * xb.w));
          bf16x8 xh, xl; xsplit<XB>(xr, XI, xa, xb, xh, xl);
          { const bf16x8 wh = __builtin_bit_cast(bf16x8, q2_0_0), wl = __builtin_bit_cast(bf16x8, q2_0_1); acc[0] = mfma16(xh, wh, acc[0]); acc[0] = mfma16(xh, wl, acc[0]); if constexpr (!XB) acc[0] = mfma16(xl, wh, acc[0]); }
        }
        asm volatile("s_waitcnt vmcnt(0)" : "+v"(q3_0_0), "+v"(q3_0_1));
        { f32x4 xa, xb; xget(xr, 7, xa, xb); constexpr int XI = 7;
          ss += ((xa.x * xa.x + xa.y * xa.y) + (xa.z * xa.z + xa.w * xa.w)) + ((xb.x * xb.x + xb.y * xb.y) + (xb.z * xb.z + xb.w * xb.w));
          bf16x8 xh, xl; xsplit<XB>(xr, XI, xa, xb, xh, xl);
          { const bf16x8 wh = __builtin_bit_cast(bf16x8, q3_0_0), wl = __builtin_bit_cast(bf16x8, q3_0_1); acc[0] = mfma16(xh, wh, acc[0]); acc[0] = mfma16(xh, wl, acc[0]); if constexpr (!XB) acc[0] = mfma16(xl, wh, acc[0]); }
        }
    }
    asm volatile("" ::: "memory");
    if (ntile >= 0) xtile_load(F, xn, x, ntile);
    ss += __shfl_xor(ss, 16); ss += __shfl_xor(ss, 32);
    if (lane < 16) ssp[w * 16 + lane] = ss;
#pragma unroll
    for (int nt = 0; nt < NT; ++nt) lp[(w * NT + nt) * 64 + lane] = acc[nt];
    __syncthreads();
    float tot = 0.f;
#pragma unroll
    for (int q = 0; q < 8; ++q) tot += ssp[q * 16 + r];
    const float rstd = 1.0f / sqrtf(tot * (1.0f / D) + EPS);
    { const LAS f32x4* gp = (const LAS f32x4*)(F.lds + NP_GAIN_OFF) + 64 * w + 2 * kq; bf16_t* hp = H + (tok0 + r) * D + 256 * w + 8 * kq;
#pragma unroll
      for (int i = 0; i < 8; ++i) { const f32x4 ga = gp[8 * i], gb = gp[8 * i + 1]; f32x4 xa, xb; xget(xr, i, xa, xb); xa = xa * rstd; xb = xb * rstd;
        if (MODE == 1) { u32x2 o; o.x = pk4fp8(xa.x * ga.x * 4.f, xa.y * ga.y * 4.f, xa.z * ga.z * 4.f, xa.w * ga.w * 4.f); o.y = pk4fp8(xb.x * gb.x * 4.f, xb.y * gb.y * 4.f, xb.z * gb.z * 4.f, xb.w * gb.w * 4.f);
            *(u32x2*)((unsigned char*)H + (tok0 + r) * D + 256 * w + 8 * kq + 32 * i) = o; }
        else { u32x4 o; o.x = pkbf(xa.x * ga.x, xa.y * ga.y); o.y = pkbf(xa.z * ga.z, xa.w * ga.w); o.z = pkbf(xb.x * gb.x, xb.y * gb.y); o.w = pkbf(xb.z * gb.z, xb.w * gb.w);
            *(u32x4*)(hp + 32 * i) = o;
            u32x2 o8; o8.x = pk4fp8(xa.x * ga.x * 4.f, xa.y * ga.y * 4.f, xa.z * ga.z * 4.f, xa.w * ga.w * 4.f); o8.y = pk4fp8(xb.x * gb.x * 4.f, xb.y * gb.y * 4.f, xb.z * gb.z * 4.f, xb.w * gb.w * 4.f);
            *(u32x2*)(F.ws + AUX_H8 + (tok0 + r) * D + 256 * w + 8 * kq + 32 * i) = o8; } } }
    if (w == 0) {
        float rs[4];
#pragma unroll
        for (int q = 0; q < 4; ++q) rs[q] = __shfl(rstd, 4 * kq + q);
        f32x4 tl4[NT];
#pragma unroll
        for (int nt = 0; nt < NT; ++nt) { tl4[nt] = lp[nt * 64 + lane];
#pragma unroll
            for (int q = 1; q < 8; ++q) tl4[nt] += lp[(q * NT + nt) * 64 + lane]; }
        if (MODE == 0) {
#pragma unroll
            for (int q = 0; q < 4; ++q) { const float v = tl4[0][q] * rs[q]; float o;
                if (r < 8) o = 1.0f / (1.0f + __expf(-v)); else { const float z = v + dtb; const float sp = z > 20.f ? z : log1pf(__expf(z)); o = nea * sp; }
                bg[(tok0 + 4 * kq + q) * 16 + r] = o; }
        } else {
#pragma unroll
            for (int nt = 0; nt < NT; ++nt)
#pragma unroll
                for (int q = 0; q < 4; ++q) lg[(4 * kq + q) * 48 + 16 * nt + r] = tl4[nt][q] * rs[q];
            LDS_WAIT();
            if (lane < 16) {
                const LAS float* p = lg + lane * 48;
                int g = 0; float gm = p[0];
#pragma unroll
                for (int j = 1; j < 4; ++j) { const float v = p[j]; if (v > gm) { gm = v; g = j; } }
                float gs = 0.f;
#pragma unroll
                for (int j = 0; j < 4; ++j) gs += __expf(p[j] - gm);
                const float g_p = 1.0f / gs;
                float q8[8];
#pragma unroll
                for (int i = 0; i < 8; ++i) q8[i] = p[4 + 8 * g + i];
                int i0 = 0; float m0 = q8[0];
#pragma unroll
                for (int i = 1; i < 8; ++i) if (q8[i] > m0) { m0 = q8[i]; i0 = i; }
                int i1 = -1; float m1 = -3.0e38f;
#pragma unroll
                for (int i = 0; i < 8; ++i) if (i != i0 && q8[i] > m1) { m1 = q8[i]; i1 = i; }
                if (i1 < 0) i1 = (i0 + 1) & 7;
                const float e1 = __expf(m1 - m0), w0 = g_p / (1.0f + e1), w1 = g_p * e1 / (1.0f + e1);
                sel[tl * 16 + lane] = (f32x4){__builtin_bit_cast(float, g * 8 + i0), __builtin_bit_cast(float, g * 8 + i1), w0, w1};
            }
        }
    }
}
template <int MODE, bool XB = false>
DI void normproj_pass(Frame& F, const void* x, const float* gain, const bf16_t* Wh, const bf16_t* Wl, bf16_t* H, float* bg, const float* a_log, const float* dt_bias, unsigned* cnt, int* list, float* gw, unsigned* asg) {
    constexpr int NTILE = NTOK / 16;
    typename XTileSel<XB>::T xa, xb;
    int tile = blockIdx.x, tl = 0;
    if (tile < NTILE) xtile_load(F, xa, x, tile);
    ((LAS f32x4*)(F.lds + NP_GAIN_OFF))[F.tid] = ((const f32x4*)gain)[F.tid];
    float dtb = 0.f, nea = 0.f;
    if (MODE == 0) { const int r8 = (F.lane & 15) - 8; if (r8 >= 0) { dtb = dt_bias[r8]; nea = -__expf(a_log[r8]); } }
    __syncthreads();
    while (tile < NTILE) {
        normproj_tile<MODE, XB>(F, xa, xb, x, tile + F.G < NTILE ? tile + F.G : -1, tile, tl, tl & 1, Wh, Wl, H, bg, dtb, nea);
        tile += F.G; ++tl;
        if (tile >= NTILE) break;
        normproj_tile<MODE, XB>(F, xb, xa, x, tile + F.G < NTILE ? tile + F.G : -1, tile, tl, tl & 1, Wh, Wl, H, bg, dtb, nea);
        tile += F.G; ++tl;
    }
    __syncthreads();
    if (MODE == 1 && F.wave == 0) {
        LAS f32x4* sel = (LAS f32x4*)(F.lds + 65536); LAS unsigned* hist = (LAS unsigned*)(F.lds + 65536 + 4096); LAS unsigned* base = hist + 32;
        const int lane = F.lane;
        if (lane < 32) hist[lane] = 0u;
        LDS_WAIT();
        const int ntok = tl * 16;
        unsigned rk[8]; int ee[8]; float ww[8]; int mm[8];
#pragma unroll
        for (int q = 0; q < 8; ++q) { const int a = lane + 64 * q;
            ee[q] = -1; if ((a >> 1) < ntok) { const f32x4 sv = sel[a >> 1]; ee[q] = __builtin_bit_cast(int, (a & 1) ? sv.y : sv.x); ww[q] = (a & 1) ? sv.w : sv.z;
                mm[q] = (blockIdx.x + ((a >> 1) >> 4) * F.G) * 16 + ((a >> 1) & 15); rk[q] = __hip_atomic_fetch_add(hist + ee[q], 1u, __ATOMIC_RELAXED, __HIP_MEMORY_SCOPE_WORKGROUP); } }
        LDS_WAIT();
        if (lane < 32) { const unsigned c = hist[lane]; base[lane] = c ? __hip_atomic_fetch_add(cnt + lane * CSTR, c, __ATOMIC_RELAXED, __HIP_MEMORY_SCOPE_AGENT) : 0u; }
        LDS_WAIT();
#pragma unroll
        for (int q = 0; q < 8; ++q) if (ee[q] >= 0) { const unsigned pos = base[ee[q]] + rk[q]; const int a = lane + 64 * q;
            list[ee[q] * 65536 + pos] = mm[q]; gw[ee[q] * 65536 + pos] = ww[q]; asg[2 * mm[q] + (a & 1)] = ((unsigned)ee[q] << 16) | pos; }
    }
    __syncthreads();
}

constexpr int NP1_PAR = 57344, NP1_SEL = 114688, NP1_GAIN = 122880;
DI void normproj_tile1(Frame& F, XTileB (&xr)[2], const void* x, int ntile, int tile, int tl, int par, const bf16_t* Wh, const bf16_t* Wl, bf16_t* H) {
    constexpr int NT = 3;
    int lane_o = F.lane; asm volatile("" : "+v"(lane_o));
    const int lane = lane_o, r = lane & 15, kq = lane >> 4, w = F.wave;
    LAS float* ssp = (LAS float*)(F.lds + par * NP1_PAR);
    LAS f32x4* lp = (LAS f32x4*)(F.lds + par * NP1_PAR + 1024);
    LAS float* lg = (LAS float*)(F.lds + par * NP1_PAR + 50176);
    LAS f32x4* sel = (LAS f32x4*)(F.lds + NP1_SEL);
    const size_t tok0 = (size_t)tile * 32;
    f32x4 acc[2][NT];
#pragma unroll
    for (int sb = 0; sb < 2; ++sb)
#pragma unroll
        for (int nt = 0; nt < NT; ++nt) acc[sb][nt] = (f32x4){0.f, 0.f, 0.f, 0.f};
    float ss[2] = {0.f, 0.f};
    u32x4 q0_0_0, q0_0_1, q0_1_0, q0_1_1, q0_2_0, q0_2_1, q1_0_0, q1_0_1, q1_1_0, q1_1_1, q1_2_0, q1_2_1, q2_0_0, q2_0_1, q2_1_0, q2_1_1, q2_2_0, q2_2_1;
    const unsigned char* wp0_0 = (const unsigned char*)(Wh + (size_t)(0 + r) * D + 256 * w + 8 * kq); const unsigned char* wp0_1 = (const unsigned char*)(Wl + (size_t)(0 + r) * D + 256 * w + 8 * kq);
    const unsigned char* wp1_0 = (const unsigned char*)(Wh + (size_t)(16 + r) * D + 256 * w + 8 * kq); const unsigned char* wp1_1 = (const unsigned char*)(Wl + (size_t)(16 + r) * D + 256 * w + 8 * kq);
    const unsigned char* wp2_0 = (const unsigned char*)(Wh + (size_t)(32 + r) * D + 256 * w + 8 * kq); const unsigned char* wp2_1 = (const unsigned char*)(Wl + (size_t)(32 + r) * D + 256 * w + 8 * kq);
    asm volatile("global_load_dwordx4 %0, %1, off" : "=v"(q0_0_0) : "v"(wp0_0) : "memory"); asm volatile("global_load_dwordx4 %0, %1, off" : "=v"(q0_0_1) : "v"(wp0_1) : "memory"); asm volatile("global_load_dwordx4 %0, %1, off" : "=v"(q0_1_0) : "v"(wp1_0) : "memory"); asm volatile("global_load_dwordx4 %0, %1, off" : "=v"(q0_1_1) : "v"(wp1_1) : "memory"); asm volatile("global_load_dwordx4 %0, %1, off" : "=v"(q0_2_0) : "v"(wp2_0) : "memory"); asm volatile("global_load_dwordx4 %0, %1, off" : "=v"(q0_2_1) : "v"(wp2_1) : "memory");
    asm volatile("global_load_dwordx4 %0, %1, off offset:64" : "=v"(q1_0_0) : "v"(wp0_0) : "memory"); asm volatile("global_load_dwordx4 %0, %1, off offset:64" : "=v"(q1_0_1) : "v"(wp0_1) : "memory"); asm volatile("global_load_dwordx4 %0, %1, off offset:64" : "=v"(q1_1_0) : "v"(wp1_0) : "memory"); asm volatile("global_load_dwordx4 %0, %1, off offset:64" : "=v"(q1_1_1) : "v"(wp1_1) : "memory"); asm volatile("global_load_dwordx4 %0, %1, off offset:64" : "=v"(q1_2_0) : "v"(wp2_0) : "memory"); asm volatile("global_load_dwordx4 %0, %1, off offset:64" : "=v"(q1_2_1) : "v"(wp2_1) : "memory");
    asm volatile("global_load_dwordx4 %0, %1, off offset:128" : "=v"(q2_0_0) : "v"(wp0_0) : "memory"); asm volatile("global_load_dwordx4 %0, %1, off offset:128" : "=v"(q2_0_1) : "v"(wp0_1) : "memory"); asm volatile("global_load_dwordx4 %0, %1, off offset:128" : "=v"(q2_1_0) : "v"(wp1_0) : "memory"); asm volatile("global_load_dwordx4 %0, %1, off offset:128" : "=v"(q2_1_1) : "v"(wp1_1) : "memory"); asm volatile("global_load_dwordx4 %0, %1, off offset:128" : "=v"(q2_2_0) : "v"(wp2_0) : "memory"); asm volatile("global_load_dwordx4 %0, %1, off offset:128" : "=v"(q2_2_1) : "v"(wp2_1) : "memory");
    asm volatile("s_waitcnt vmcnt(12)" : "+v"(q0_0_0), "+v"(q0_0_1), "+v"(q0_1_0), "+v"(q0_1_1), "+v"(q0_2_0), "+v"(q0_2_1));
#pragma unroll
    for (int sb = 0; sb < 2; ++sb) { f32x4 xa, xb; xget(xr[sb], 0, xa, xb);
        ss[sb] += ((xa.x * xa.x + xa.y * xa.y) + (xa.z * xa.z + xa.w * xa.w)) + ((xb.x * xb.x + xb.y * xb.y) + (xb.z * xb.z + xb.w * xb.w));
        const bf16x8 xh = __builtin_bit_cast(bf16x8, xr[sb].p[0]);
        acc[sb][0] = mfma16(xh, __builtin_bit_cast(bf16x8, q0_0_0), acc[sb][0]); acc[sb][0] = mfma16(xh, __builtin_bit_cast(bf16x8, q0_0_1), acc[sb][0]);
        acc[sb][1] = mfma16(xh, __builtin_bit_cast(bf16x8, q0_1_0), acc[sb][1]); acc[sb][1] = mfma16(xh, __builtin_bit_cast(bf16x8, q0_1_1), acc[sb][1]);
        acc[sb][2] = mfma16(xh, __builtin_bit_cast(bf16x8, q0_2_0), acc[sb][2]); acc[sb][2] = mfma16(xh, __builtin_bit_cast(bf16x8, q0_2_1), acc[sb][2]);
    }
    asm volatile("" :: "v"(acc[0][0]), "v"(acc[1][0]), "v"(acc[0][1]), "v"(acc[1][1]), "v"(acc[0][2]), "v"(acc[1][2]));
    asm volatile("global_load_dwordx4 %0, %1, off offset:192" : "=v"(q0_0_0) : "v"(wp0_0) : "memory"); asm volatile("global_load_dwordx4 %0, %1, off offset:192" : "=v"(q0_0_1) : "v"(wp0_1) : "memory"); asm volatile("global_load_dwordx4 %0, %1, off offset:192" : "=v"(q0_1_0) : "v"(wp1_0) : "memory"); asm volatile("global_load_dwordx4 %0, %1, off offset:192" : "=v"(q0_1_1) : "v"(wp1_1) : "memory"); asm volatile("global_load_dwordx4 %0, %1, off offset:192" : "=v"(q0_2_0) : "v"(wp2_0) : "memory"); asm volatile("global_load_dwordx4 %0, %1, off offset:192" : "=v"(q0_2_1) : "v"(wp2_1) : "memory");
    asm volatile("s_waitcnt vmcnt(12)" : "+v"(q1_0_0), "+v"(q1_0_1), "+v"(q1_1_0), "+v"(q1_1_1), "+v"(q1_2_0), "+v"(q1_2_1));
#pragma unroll
    for (int sb = 0; sb < 2; ++sb) { f32x4 xa, xb; xget(xr[sb], 1, xa, xb);
        ss[sb] += ((xa.x * xa.x + xa.y * xa.y) + (xa.z * xa.z + xa.w * xa.w)) + ((xb.x * xb.x + xb.y * xb.y) + (xb.z * xb.z + xb.w * xb.w));
        const bf16x8 xh = __builtin_bit_cast(bf16x8, xr[sb].p[1]);
        acc[sb][0] = mfma16(xh, __builtin_bit_cast(bf16x8, q1_0_0), acc[sb][0]); acc[sb][0] = mfma16(xh, __builtin_bit_cast(bf16x8, q1_0_1), acc[sb][0]);
        acc[sb][1] = mfma16(xh, __builtin_bit_cast(bf16x8, q1_1_0), acc[sb][1]); acc[sb][1] = mfma16(xh, __builtin_bit_cast(bf16x8, q1_1_1), acc[sb][1]);
        acc[sb][2] = mfma16(xh, __builtin_bit_cast(bf16x8, q1_2_0), acc[sb][2]); acc[sb][2] = mfma16(xh, __builtin_bit_cast(bf16x8, q1_2_1), acc[sb][2]);
    }
    asm volatile("" :: "v"(acc[0][0]), "v"(acc[1][0]), "v"(acc[0][1]), "v"(acc[1][1]), "v"(acc[0][2]), "v"(acc[1][2]));
    asm volatile("global_load_dwordx4 %0, %1, off offset:256" : "=v"(q1_0_0) : "v"(wp0_0) : "memory"); asm volatile("global_load_dwordx4 %0, %1, off offset:256" : "=v"(q1_0_1) : "v"(wp0_1) : "memory"); asm volatile("global_load_dwordx4 %0, %1, off offset:256" : "=v"(q1_1_0) : "v"(wp1_0) : "memory"); asm volatile("global_load_dwordx4 %0, %1, off offset:256" : "=v"(q1_1_1) : "v"(wp1_1) : "memory"); asm volatile("global_load_dwordx4 %0, %1, off offset:256" : "=v"(q1_2_0) : "v"(wp2_0) : "memory"); asm volatile("global_load_dwordx4 %0, %1, off offset:256" : "=v"(q1_2_1) : "v"(wp2_1) : "memory");
    asm volatile("s_waitcnt vmcnt(12)" : "+v"(q2_0_0), "+v"(q2_0_1), "+v"(q2_1_0), "+v"(q2_1_1), "+v"(q2_2_0), "+v"(q2_2_1));
#pragma unroll
    for (int sb = 0; sb < 2; ++sb) { f32x4 xa, xb; xget(xr[sb], 2, xa, xb);
        ss[sb] += ((xa.x * xa.x + xa.y * xa.y) + (xa.z * xa.z + xa.w * xa.w)) + ((xb.x * xb.x + xb.y * xb.y) + (xb.z * xb.z + xb.w * xb.w));
        const bf16x8 xh = __builtin_bit_cast(bf16x8, xr[sb].p[2]);
        acc[sb][0] = mfma16(xh, __builtin_bit_cast(bf16x8, q2_0_0), acc[sb][0]); acc[sb][0] = mfma16(xh, __builtin_bit_cast(bf16x8, q2_0_1), acc[sb][0]);
        acc[sb][1] = mfma16(xh, __builtin_bit_cast(bf16x8, q2_1_0), acc[sb][1]); acc[sb][1] = mfma16(xh, __builtin_bit_cast(bf16x8, q2_1_1), acc[sb][1]);
        acc[sb][2] = mfma16(xh, __builtin_bit_cast(bf16x8, q2_2_0), acc[sb][2]); acc[sb][2] = mfma16(xh, __builtin_bit_cast(bf16x8, q2_2_1), acc[sb][2]);
    }
    asm volatile("" :: "v"(acc[0][0]), "v"(acc[1][0]), "v"(acc[0][1]), "v"(acc[1][1]), "v"(acc[0][2]), "v"(acc[1][2]));
    asm volatile("global_load_dwordx4 %0, %1, off offset:320" : "=v"(q2_0_0) : "v"(wp0_0) : "memory"); asm volatile("global_load_dwordx4 %0, %1, off offset:320" : "=v"(q2_0_1) : "v"(wp0_1) : "memory"); asm volatile("global_load_dwordx4 %0, %1, off offset:320" : "=v"(q2_1_0) : "v"(wp1_0) : "memory"); asm volatile("global_load_dwordx4 %0, %1, off offset:320" : "=v"(q2_1_1) : "v"(wp1_1) : "memory"); asm volatile("global_load_dwordx4 %0, %1, off offset:320" : "=v"(q2_2_0) : "v"(wp2_0) : "memory"); asm volatile("global_load_dwordx4 %0, %1, off offset:320" : "=v"(q2_2_1) : "v"(wp2_1) : "memory");
    asm volatile("s_waitcnt vmcnt(12)" : "+v"(q0_0_0), "+v"(q0_0_1), "+v"(q0_1_0), "+v"(q0_1_1), "+v"(q0_2_0), "+v"(q0_2_1));
#pragma unroll
    for (int sb = 0; sb < 2; ++sb) { f32x4 xa, xb; xget(xr[sb], 3, xa, xb);
        ss[sb] += ((xa.x * xa.x + xa.y * xa.y) + (xa.z * xa.z + xa.w * xa.w)) + ((xb.x * xb.x + xb.y * xb.y) + (xb.z * xb.z + xb.w * xb.w));
        const bf16x8 xh = __builtin_bit_cast(bf16x8, xr[sb].p[3]);
        acc[sb][0] = mfma16(xh, __builtin_bit_cast(bf16x8, q0_0_0), acc[sb][0]); acc[sb][0] = mfma16(xh, __builtin_bit_cast(bf16x8, q0_0_1), acc[sb][0]);
        acc[sb][1] = mfma16(xh, __builtin_bit_cast(bf16x8, q0_1_0), acc[sb][1]); acc[sb][1] = mfma16(xh, __builtin_bit_cast(bf16x8, q0_1_1), acc[sb][1]);
        acc[sb][2] = mfma16(xh, __builtin_bit_cast(bf16x8, q0_2_0), acc[sb][2]); acc[sb][2] = mfma16(xh, __builtin_bit_cast(bf16x8, q0_2_1), acc[sb][2]);
    }
    asm volatile("" :: "v"(acc[0][0]), "v"(acc[1][0]), "v"(acc[0][1]), "v"(acc[1][1]), "v"(acc[0][2]), "v"(acc[1][2]));
    asm volatile("global_load_dwordx4 %0, %1, off offset:384" : "=v"(q0_0_0) : "v"(wp0_0) : "memory"); asm volatile("global_load_dwordx4 %0, %1, off offset:384" : "=v"(q0_0_1) : "v"(wp0_1) : "memory"); asm volatile("global_load_dwordx4 %0, %1, off offset:384" : "=v"(q0_1_0) : "v"(wp1_0) : "memory"); asm volatile("global_load_dwordx4 %0, %1, off offset:384" : "=v"(q0_1_1) : "v"(wp1_1) : "memory"); asm volatile("global_load_dwordx4 %0, %1, off offset:384" : "=v"(q0_2_0) : "v"(wp2_0) : "memory"); asm volatile("global_load_dwordx4 %0, %1, off offset:384" : "=v"(q0_2_1) : "v"(wp2_1) : "memory");
    asm volatile("s_waitcnt vmcnt(12)" : "+v"(q1_0_0), "+v"(q1_0_1), "+v"(q1_1_0), "+v"(q1_1_1), "+v"(q1_2_0), "+v"(q1_2_1));
#pragma unroll
    for (int sb = 0; sb < 2; ++sb) { f32x4 xa, xb; xget(xr[sb], 4, xa, xb);
        ss[sb] += ((xa.x * xa.x + xa.y * xa.y) + (xa.z * xa.z + xa.w * xa.w)) + ((xb.x * xb.x + xb.y * xb.y) + (xb.z * xb.z + xb.w * xb.w));
        const bf16x8 xh = __builtin_bit_cast(bf16x8, xr[sb].p[4]);
        acc[sb][0] = mfma16(xh, __builtin_bit_cast(bf16x8, q1_0_0), acc[sb][0]); acc[sb][0] = mfma16(xh, __builtin_bit_cast(bf16x8, q1_0_1), acc[sb][0]);
        acc[sb][1] = mfma16(xh, __builtin_bit_cast(bf16x8, q1_1_0), acc[sb][1]); acc[sb][1] = mfma16(xh, __builtin_bit_cast(bf16x8, q1_1_1), acc[sb][1]);
        acc[sb][2] = mfma16(xh, __builtin_bit_cast(bf16x8, q1_2_0), acc[sb][2]); acc[sb][2] = mfma16(xh, __builtin_bit_cast(bf16x8, q1_2_1), acc[sb][2]);
    }
    asm volatile("" :: "v"(acc[0][0]), "v"(acc[1][0]), "v"(acc[0][1]), "v"(acc[1][1]), "v"(acc[0][2]), "v"(acc[1][2]));
    asm volatile("global_load_dwordx4 %0, %1, off offset:448" : "=v"(q1_0_0) : "v"(wp0_0) : "memory"); asm volatile("global_load_dwordx4 %0, %1, off offset:448" : "=v"(q1_0_1) : "v"(wp0_1) : "memory"); asm volatile("global_load_dwordx4 %0, %1, off offset:448" : "=v"(q1_1_0) : "v"(wp1_0) : "memory"); asm volatile("global_load_dwordx4 %0, %1, off offset:448" : "=v"(q1_1_1) : "v"(wp1_1) : "memory"); asm volatile("global_load_dwordx4 %0, %1, off offset:448" : "=v"(q1_2_0) : "v"(wp2_0) : "memory"); asm volatile("global_load_dwordx4 %0, %1, off offset:448" : "=v"(q1_2_1) : "v"(wp2_1) : "memory");
    asm volatile("s_waitcnt vmcnt(12)" : "+v"(q2_0_0), "+v"(q2_0_1), "+v"(q2_1_0), "+v"(q2_1_1), "+v"(q2_2_0), "+v"(q2_2_1));
#pragma unroll
    for (int sb = 0; sb < 2; ++sb) { f32x4 xa, xb; xget(xr[sb], 5, xa, xb);
        ss[sb] += ((xa.x * xa.x + xa.y * xa.y) + (xa.z * xa.z + xa.w * xa.w)) + ((xb.x * xb.x + xb.y * xb.y) + (xb.z * xb.z + xb.w * xb.w));
        const bf16x8 xh = __builtin_bit_cast(bf16x8, xr[sb].p[5]);
        acc[sb][0] = mfma16(xh, __builtin_bit_cast(bf16x8, q2_0_0), acc[sb][0]); acc[sb][0] = mfma16(xh, __builtin_bit_cast(bf16x8, q2_0_1), acc[sb][0]);
        acc[sb][1] = mfma16(xh, __builtin_bit_cast(bf16x8, q2_1_0), acc[sb][1]); acc[sb][1] = mfma16(xh, __builtin_bit_cast(bf16x8, q2_1_1), acc[sb][1]);
        acc[sb][2] = mfma16(xh, __builtin_bit_cast(bf16x8, q2_2_0), acc[sb][2]); acc[sb][2] = mfma16(xh, __builtin_bit_cast(bf16x8, q2_2_1), acc[sb][2]);
    }
    asm volatile("s_waitcnt vmcnt(6)" : "+v"(q0_0_0), "+v"(q0_0_1), "+v"(q0_1_0), "+v"(q0_1_1), "+v"(q0_2_0), "+v"(q0_2_1));
#pragma unroll
    for (int sb = 0; sb < 2; ++sb) { f32x4 xa, xb; xget(xr[sb], 6, xa, xb);
        ss[sb] += ((xa.x * xa.x + xa.y * xa.y) + (xa.z * xa.z + xa.w * xa.w)) + ((xb.x * xb.x + xb.y * xb.y) + (xb.z * xb.z + xb.w * xb.w));
        const bf16x8 xh = __builtin_bit_cast(bf16x8, xr[sb].p[6]);
        acc[sb][0] = mfma16(xh, __builtin_bit_cast(bf16x8, q0_0_0), acc[sb][0]); acc[sb][0] = mfma16(xh, __builtin_bit_cast(bf16x8, q0_0_1), acc[sb][0]);
        acc[sb][1] = mfma16(xh, __builtin_bit_cast(bf16x8, q0_1_0), acc[sb][1]); acc[sb][1] = mfma16(xh, __builtin_bit_cast(bf16x8, q0_1_1), acc[sb][1]);
        acc[sb][2] = mfma16(xh, __builtin_bit_cast(bf16x8, q0_2_0), acc[sb][2]); acc[sb][2] = mfma16(xh, __builtin_bit_cast(bf16x8, q0_2_1), acc[sb][2]);
    }
    asm volatile("s_waitcnt vmcnt(0)" : "+v"(q1_0_0), "+v"(q1_0_1), "+v"(q1_1_0), "+v"(q1_1_1), "+v"(q1_2_0), "+v"(q1_2_1));
#pragma unroll
    for (int sb = 0; sb < 2; ++sb) { f32x4 xa, xb; xget(xr[sb], 7, xa, xb);
        ss[sb] += ((xa.x * xa.x + xa.y * xa.y) + (xa.z * xa.z + xa.w * xa.w)) + ((xb.x * xb.x + xb.y * xb.y) + (xb.z * xb.z + xb.w * xb.w));
        const bf16x8 xh = __builtin_bit_cast(bf16x8, xr[sb].p[7]);
        acc[sb][0] = mfma16(xh, __builtin_bit_cast(bf16x8, q1_0_0), acc[sb][0]); acc[sb][0] = mfma16(xh, __builtin_bit_cast(bf16x8, q1_0_1), acc[sb][0]);
        acc[sb][1] = mfma16(xh, __builtin_bit_cast(bf16x8, q1_1_0), acc[sb][1]); acc[sb][1] = mfma16(xh, __builtin_bit_cast(bf16x8, q1_1_1), acc[sb][1]);
        acc[sb][2] = mfma16(xh, __builtin_bit_cast(bf16x8, q1_2_0), acc[sb][2]); acc[sb][2] = mfma16(xh, __builtin_bit_cast(bf16x8, q1_2_1), acc[sb][2]);
    }
    asm volatile("" ::: "memory");
#pragma unroll
    for (int sb = 0; sb < 2; ++sb) { ss[sb] += __shfl_xor(ss[sb], 16); ss[sb] += __shfl_xor(ss[sb], 32); if (lane < 16) ssp[w * 32 + 16 * sb + lane] = ss[sb];
#pragma unroll
        for (int nt = 0; nt < NT; ++nt) lp[((w * 2 + sb) * NT + nt) * 64 + lane] = acc[sb][nt]; }
    __syncthreads();
    float rstd[2];
#pragma unroll
    for (int sb = 0; sb < 2; ++sb) { float tot = 0.f;
#pragma unroll
        for (int q = 0; q < 8; ++q) tot += ssp[q * 32 + 16 * sb + r];
        rstd[sb] = 1.0f / sqrtf(tot * (1.0f / D) + EPS); }
    { const LAS f32x4* gp = (const LAS f32x4*)(F.lds + NP1_GAIN) + 64 * w + 2 * kq;
#pragma unroll
      for (int sb = 0; sb < 2; ++sb)
#pragma unroll
        for (int i = 0; i < 8; ++i) { const f32x4 ga = gp[8 * i], gb = gp[8 * i + 1]; f32x4 xa, xb; xget(xr[sb], i, xa, xb); xa = xa * rstd[sb]; xb = xb * rstd[sb];
            u32x2 o; o.x = pk4fp8(xa.x * ga.x * 4.f, xa.y * ga.y * 4.f, xa.z * ga.z * 4.f, xa.w * ga.w * 4.f); o.y = pk4fp8(xb.x * gb.x * 4.f, xb.y * gb.y * 4.f, xb.z * gb.z * 4.f, xb.w * gb.w * 4.f);
            *(u32x2*)((unsigned char*)H + (tok0 + 16 * sb + r) * D + 256 * w + 8 * kq + 32 * i) = o; } }
    asm volatile("" ::: "memory");
    if (ntile >= 0) { xtile_load(F, xr[0], x, 2 * ntile); xtile_load(F, xr[1], x, 2 * ntile + 1); }
    if (w == 0) {
#pragma unroll
        for (int sb = 0; sb < 2; ++sb) { float rs[4];
#pragma unroll
            for (int q = 0; q < 4; ++q) rs[q] = __shfl(rstd[sb], 4 * kq + q);
#pragma unroll
            for (int nt = 0; nt < NT; ++nt) { f32x4 t4 = lp[(sb * NT + nt) * 64 + lane];
#pragma unroll
                for (int q = 1; q < 8; ++q) t4 += lp[((q * 2 + sb) * NT + nt) * 64 + lane];
#pragma unroll
                for (int q = 0; q < 4; ++q) lg[(16 * sb + 4 * kq + q) * 48 + 16 * nt + r] = t4[q] * rs[q]; } }
        LDS_WAIT();
        if (lane < 32) {
            const LAS float* p = lg + lane * 48;
            int g = 0; float gm = p[0];
#pragma unroll
            for (int j = 1; j < 4; ++j) { const float v = p[j]; if (v > gm) { gm = v; g = j; } }
            float gs = 0.f;
#pragma unroll
            for (int j = 0; j < 4; ++j) gs += __expf(p[j] - gm);
            const float g_p = 1.0f / gs;
            float q8[8];
#pragma unroll
            for (int i = 0; i < 8; ++i) q8[i] = p[4 + 8 * g + i];
            int i0 = 0; float m0 = q8[0];
#pragma unroll
            for (int i = 1; i < 8; ++i) if (q8[i] > m0) { m0 = q8[i]; i0 = i; }
            int i1 = -1; float m1 = -3.0e38f;
#pragma unroll
            for (int i = 0; i < 8; ++i) if (i != i0 && q8[i] > m1) { m1 = q8[i]; i1 = i; }
            if (i1 < 0) i1 = (i0 + 1) & 7;
            const float e1 = __expf(m1 - m0), w0 = g_p / (1.0f + e1), w1 = g_p * e1 / (1.0f + e1);
            sel[tl * 32 + lane] = (f32x4){__builtin_bit_cast(float, g * 8 + i0), __builtin_bit_cast(float, g * 8 + i1), w0, w1};
        }
    }
}
DI void normproj_pass1(Frame& F, const void* x, const float* gain, const bf16_t* Wh, const bf16_t* Wl, bf16_t* H, unsigned* cnt, int* list, float* gw, unsigned* asg) {
    constexpr int NTILE = NTOK / 32;
    XTileB xr[2];
    int tile = blockIdx.x, tl = 0;
    if (tile < NTILE) { xtile_load(F, xr[0], x, 2 * tile); xtile_load(F, xr[1], x, 2 * tile + 1); }
    ((LAS f32x4*)(F.lds + NP1_GAIN))[F.tid] = ((const f32x4*)gain)[F.tid];
    __syncthreads();
    while (tile < NTILE) {
        normproj_tile1(F, xr, x, tile + F.G < NTILE ? tile + F.G : -1, tile, tl, tl & 1, Wh, Wl, H);
        tile += F.G; ++tl;
    }
    __syncthreads();
    if (F.wave == 0) {
        LAS f32x4* sel = (LAS f32x4*)(F.lds + NP1_SEL); LAS unsigned* hist = (LAS unsigned*)(F.lds + NP1_SEL + 4096); LAS unsigned* base = hist + 32;
        const int lane = F.lane;
        if (lane < 32) hist[lane] = 0u;
        LDS_WAIT();
        const int ntok = tl * 32;
        unsigned rk[4]; int ee[4]; float ww[4]; int mm[4];
#pragma unroll
        for (int q = 0; q < 4; ++q) { const int a = lane + 64 * q;
            ee[q] = -1; if ((a >> 1) < ntok) { const f32x4 sv = sel[a >> 1]; ee[q] = __builtin_bit_cast(int, (a & 1) ? sv.y : sv.x); ww[q] = (a & 1) ? sv.w : sv.z;
                mm[q] = (blockIdx.x + ((a >> 1) >> 5) * F.G) * 32 + ((a >> 1) & 31); rk[q] = __hip_atomic_fetch_add(hist + ee[q], 1u, __ATOMIC_RELAXED, __HIP_MEMORY_SCOPE_WORKGROUP); } }
        LDS_WAIT();
        if (lane < 32) { const unsigned c = hist[lane]; base[lane] = c ? __hip_atomic_fetch_add(cnt + lane * CSTR, c, __ATOMIC_RELAXED, __HIP_MEMORY_SCOPE_AGENT) : 0u; }
        LDS_WAIT();
#pragma unroll
        for (int q = 0; q < 4; ++q) if (ee[q] >= 0) { const unsigned pos = base[ee[q]] + rk[q]; const int a = lane + 64 * q;
            list[ee[q] * 65536 + pos] = mm[q]; gw[ee[q] * 65536 + pos] = ww[q]; asg[2 * mm[q] + (a & 1)] = ((unsigned)ee[q] << 16) | pos; }
    }
    __syncthreads();
}

DI unsigned dpp_ror8(unsigned v) { return (unsigned)__builtin_amdgcn_mov_dpp((int)v, 0x128, 0xf, 0xf, true); }
DI void p2_prep(Frame& F, const float* conv_w) {
    bf16_t* pj = (bf16_t*)(F.ws + WS_BIG + BIG_PJ);
    const f32x2* cs = (const f32x2*)(F.ws + AUX_CS);
    bf16_t* qn = (bf16_t*)(F.ws + AUX_QN); bf16_t* kn = (bf16_t*)(F.ws + AUX_KN); bf16_t* vc = (bf16_t*)(F.ws + AUX_VC);
    const int lane = F.lane, l16 = lane & 15;
    for (int grp = F.gw; grp < NTOK / 16; grp += F.NGW) {
        const int m0 = grp * 16, pos0 = m0 & (SEQ - 1);
#pragma unroll 1
        for (int j = 0; j < 8; ++j) { const int ch = 512 * j + 8 * lane;
            f32x4 w[4][2];
#pragma unroll
            for (int tp = 0; tp < 4; ++tp) { w[tp][0] = *(const f32x4*)(conv_w + tp * 4096 + ch); w[tp][1] = *(const f32x4*)(conv_w + tp * 4096 + ch + 4); }
            u32x4 rr[19];
#pragma unroll
            for (int q = 0; q < 19; ++q) { const int dp = pos0 - 3 + q; rr[q] = (u32x4){0u, 0u, 0u, 0u}; if (dp >= 0) rr[q] = *(const u32x4*)(pj + (size_t)(m0 - 3 + q) * PJW + C_GQKV + ch); }
#pragma unroll
            for (int tt = 0; tt < 16; ++tt) { float a[8];
#pragma unroll
                for (int e = 0; e < 8; ++e) a[e] = 0.f;
#pragma unroll
                for (int tp = 0; tp < 4; ++tp) { const u32x4 r = rr[tt + tp];
                    a[0] += bflo(r.x) * w[tp][0].x; a[1] += bfhi(r.x) * w[tp][0].y; a[2] += bflo(r.y) * w[tp][0].z; a[3] += bfhi(r.y) * w[tp][0].w; a[4] += bflo(r.z) * w[tp][1].x; a[5] += bfhi(r.z) * w[tp][1].y; a[6] += bflo(r.w) * w[tp][1].z; a[7] += bfhi(r.w) * w[tp][1].w; }
                float ss = 0.f;
#pragma unroll
                for (int e = 0; e < 8; ++e) { a[e] = siluf(a[e]); ss += a[e] * a[e]; }
                if (j < 4) { ss += __shfl_xor(ss, 1); ss += __shfl_xor(ss, 2); ss += __shfl_xor(ss, 4); ss += __shfl_xor(ss, 8);
                    const float sc = (1.0f / sqrtf(ss + EPS)) * (j < 2 ? 0.08838834764831845f : 1.0f);
#pragma unroll
                    for (int e = 0; e < 8; ++e) a[e] *= sc; }
                u32x4 o; o.x = pk2(a[0], a[1]); o.y = pk2(a[2], a[3]); o.z = pk2(a[4], a[5]); o.w = pk2(a[6], a[7]);
                const size_t m = (size_t)(m0 + tt);
                bf16_t* dst = j < 2 ? qn + m * 1024 + ch : (j < 4 ? kn + m * 1024 + (ch - 1024) : vc + m * 2048 + (ch - 2048));
                *(u32x4*)dst = o; }
        }
    }
}

constexpr int TB = 16;
template <bool GDN>
DI void p3_recurrence(Frame& F, int u  ) {
    const int b = u >> 2, h = 2 * (u & 3) + (F.tid >> 8), e = F.tid & 255, hh = F.tid >> 8;
    bf16_t* pj = (bf16_t*)(F.ws + WS_BIG + BIG_PJ);
    const bf16_t* qsrc = GDN ? (const bf16_t*)(F.ws + AUX_QN) : pj + C_RQ; const bf16_t* ksrc = GDN ? (const bf16_t*)(F.ws + AUX_KN) : pj + C_RK;
    const int qld = GDN ? 1024 : PJW;
    bf16_t* vsrc = GDN ? (bf16_t*)(F.ws + AUX_VC) : pj + C_RV; const int vld = GDN ? 2048 : PJW;
    const float* bg = (const float*)(F.ws + AUX_BG);
    LAS float* qs = (LAS float*)F.lds;
    LAS float* ks = qs + 2 * TB * 128;
    LAS float* ab = ks + 2 * TB * 128;
    LAS float* vs = ab + 2 * TB * 2;
    float S[128];
#pragma unroll
    for (int d = 0; d < 128; ++d) S[d] = 0.f;
    const float gam = GDN ? 0.f : (1.0f - exp2f(-5.0f - (float)h));
    for (int t0 = 0; t0 < SEQ; t0 += TB) {
        const size_t r0 = (size_t)b * SEQ + t0;
        __syncthreads();
        for (int i = F.tid; i < 2 * TB * 128; i += NTHR) { const int h2 = i / (TB * 128), tt = (i / 128) % TB, d = i % 128; const int hd = 2 * (u & 3) + h2;
            qs[i] = bf2f(qsrc[(r0 + tt) * qld + hd * 128 + d]); ks[i] = bf2f(ksrc[(r0 + tt) * qld + hd * 128 + d]); }
        for (int i = F.tid; i < 2 * TB * 256; i += NTHR) { const int h2 = i / (TB * 256), tt = (i / 256) % TB, ee = i % 256; vs[i] = bf2f(vsrc[(r0 + tt) * vld + (2 * (u & 3) + h2) * 256 + ee]); }
        if (GDN && F.tid < 2 * TB) { const int h2 = F.tid / TB, tt = F.tid % TB, hd = 2 * (u & 3) + h2; ab[F.tid * 2] = __expf(bg[(r0 + tt) * 16 + 8 + hd]); ab[F.tid * 2 + 1] = bg[(r0 + tt) * 16 + hd]; }
        __syncthreads();
#pragma unroll 1
        for (int tt = 0; tt < TB; ++tt) {
            const LAS f32x4* q4 = (const LAS f32x4*)(qs + (hh * TB + tt) * 128); const LAS f32x4* k4 = (const LAS f32x4*)(ks + (hh * TB + tt) * 128);
            const float v = vs[(hh * TB + tt) * 256 + e];
            float o = 0.f;
            if (GDN) {
                const float a = ab[(hh * TB + tt) * 2], beta = ab[(hh * TB + tt) * 2 + 1];
                float ksum = 0.f;
#pragma unroll
                for (int d4 = 0; d4 < 32; ++d4) { if ((d4 & 7) == 0) asm volatile("" ::: "memory"); const f32x4 kk = k4[d4]; ksum += (kk.x * S[4 * d4] + kk.y * S[4 * d4 + 1]) + (kk.z * S[4 * d4 + 2] + kk.w * S[4 * d4 + 3]); }
                const float r = (v - a * ksum) * beta;
#pragma unroll
                for (int d4 = 0; d4 < 32; ++d4) { if ((d4 & 3) == 0) asm volatile("" ::: "memory"); const f32x4 kk = k4[d4], qq = q4[d4];
                    S[4 * d4] = a * S[4 * d4] + r * kk.x; S[4 * d4 + 1] = a * S[4 * d4 + 1] + r * kk.y; S[4 * d4 + 2] = a * S[4 * d4 + 2] + r * kk.z; S[4 * d4 + 3] = a * S[4 * d4 + 3] + r * kk.w;
                    o += (qq.x * S[4 * d4] + qq.y * S[4 * d4 + 1]) + (qq.z * S[4 * d4 + 2] + qq.w * S[4 * d4 + 3]); }
            } else {
#pragma unroll
                for (int d4 = 0; d4 < 32; ++d4) { if ((d4 & 3) == 0) asm volatile("" ::: "memory"); const f32x4 kk = k4[d4], qq = q4[d4];
                    S[4 * d4] = gam * S[4 * d4] + v * kk.x; S[4 * d4 + 1] = gam * S[4 * d4 + 1] + v * kk.y; S[4 * d4 + 2] = gam * S[4 * d4 + 2] + v * kk.z; S[4 * d4 + 3] = gam * S[4 * d4 + 3] + v * kk.w;
                    o += (qq.x * S[4 * d4] + qq.y * S[4 * d4 + 1]) + (qq.z * S[4 * d4 + 2] + qq.w * S[4 * d4 + 3]); }
            }
            vsrc[(r0 + tt) * vld + h * 256 + e] = (bf16_t)f2bf(o);
        }
    }
}


constexpr int NCH = SEQ / 64;
DI constexpr int rowoff4c(int i) { int a = 0; for (int k = 0; k < i; ++k) a += (k + 3) / 4; return a; }
typedef short s16x4 __attribute__((ext_vector_type(4)));
DI s16x4 tr_read(unsigned lds_addr) { s16x4 r; asm volatile("ds_read_b64_tr_b16 %0, %1\n\ts_waitcnt lgkmcnt(0)" : "=&v"(r) : "v"(lds_addr) : "memory"); return r; }
DI void tr_read4(unsigned a0, unsigned a1, unsigned a2, unsigned a3, s16x4& r0, s16x4& r1, s16x4& r2, s16x4& r3) {
    asm volatile("ds_read_b64_tr_b16 %0, %4\n\tds_read_b64_tr_b16 %1, %5\n\tds_read_b64_tr_b16 %2, %6\n\tds_read_b64_tr_b16 %3, %7\n\ts_waitcnt lgkmcnt(0)"
                 : "=&v"(r0), "=&v"(r1), "=&v"(r2), "=&v"(r3) : "v"(a0), "v"(a1), "v"(a2), "v"(a3) : "memory"); }
DI bf16x8 cat8(s16x4 a, s16x4 b) { return __builtin_shufflevector(a, b, 0, 1, 2, 3, 4, 5, 6, 7); }

DI void rope_pair(bf16x8& f1, bf16x8& f2, const f32x4* cp, float sc) {
    const f32x4 c0 = cp[0], c1 = cp[1], c2 = cp[2], c3 = cp[3];
    const float cs_[8] = {c0.x, c0.z, c1.x, c1.z, c2.x, c2.z, c3.x, c3.z}, sn_[8] = {c0.y, c0.w, c1.y, c1.w, c2.y, c2.w, c3.y, c3.w};
    const u32x4 a = __builtin_bit_cast(u32x4, f1), b = __builtin_bit_cast(u32x4, f2);
    const float x1[8] = {bflo(a.x), bfhi(a.x), bflo(a.y), bfhi(a.y), bflo(a.z), bfhi(a.z), bflo(a.w), bfhi(a.w)}, x2[8] = {bflo(b.x), bfhi(b.x), bflo(b.y), bfhi(b.y), bflo(b.z), bfhi(b.z), bflo(b.w), bfhi(b.w)};
    float y1[8], y2[8];
#pragma unroll
    for (int e = 0; e < 8; ++e) { y1[e] = (x1[e] * cs_[e] - x2[e] * sn_[e]) * sc; y2[e] = (x2[e] * cs_[e] + x1[e] * sn_[e]) * sc; }
    u32x4 o1, o2; o1.x = pk2(y1[0], y1[1]); o1.y = pk2(y1[2], y1[3]); o1.z = pk2(y1[4], y1[5]); o1.w = pk2(y1[6], y1[7]); o2.x = pk2(y2[0], y2[1]); o2.y = pk2(y2[2], y2[3]); o2.z = pk2(y2[4], y2[5]); o2.w = pk2(y2[6], y2[7]);
    f1 = __builtin_bit_cast(bf16x8, o1); f2 = __builtin_bit_cast(bf16x8, o2);
}
template <bool GDN>
DI void ga_unit(Frame& F, int unit, unsigned char* stream, float* out_f32_unused) {
    (void)out_f32_unused;
    constexpr int NF = GDN ? 56 : 40, OFF_W = 0, OFF_QG = GDN ? 16 : 0, OFF_ATT = OFF_QG + 16, OFF_KT = OFF_ATT + 8;
    int lane_o = F.lane; asm volatile("" : "+v"(lane_o));
    const int lane = lane_o, fr = lane & 15, g = lane >> 4;
    const int bh = unit / NCH, n = unit % NCH, b = bh >> 3, h = bh & 7;
    const size_t row0 = (size_t)b * SEQ + (size_t)n * 64;
    LAS unsigned char* L = F.lds + F.wave * GA_LDS_WAVE;
    LAS float* LAf = (LAS float*)L; LAS unsigned char* LA = L; LAS unsigned char* LT = L + 9216; LAS float* LG = (LAS float*)(L + 17408); LAS float* LB = LG + 64;
    const bf16_t* pj = (const bf16_t*)(F.ws + WS_BIG + BIG_PJ);
    const bf16_t* qsrc = GDN ? (const bf16_t*)(F.ws + AUX_QN) + h * 128 : pj + C_RQ + h * 128;
    const bf16_t* ksrc = GDN ? (const bf16_t*)(F.ws + AUX_KN) + h * 128 : pj + C_RK + h * 128;
    const size_t qld = GDN ? 1024 : PJW;
    unsigned char* st = stream + (size_t)unit * NF * 1024 + lane * 16;
    float gv, bv = 1.f;
    if (GDN) { const float* bg = (const float*)(F.ws + AUX_BG); gv = bg[(row0 + lane) * 16 + 8 + h]; bv = bg[(row0 + lane) * 16 + h];
#pragma unroll
        for (int o = 1; o < 64; o <<= 1) { const float t = __shfl_up(gv, o); if (lane >= o) gv += t; } }
    else gv = (float)(lane + 1) * log1pf(-exp2f(-5.0f - (float)h));
    const float gl = rdlane(gv, 63);
    LG[lane] = gv; LB[lane] = bv;
    LDS_WAIT();
    float gr[16], gcl[4], br[16];
#pragma unroll
    for (int t = 0; t < 4; ++t) { gcl[t] = LG[16 * t + fr];
#pragma unroll
        for (int r = 0; r < 4; ++r) { gr[t * 4 + r] = LG[16 * t + 4 * g + r]; br[t * 4 + r] = LB[16 * t + 4 * g + r]; } }
    bf16x8 Kf[4][4], Qf[4][4];
#pragma unroll
    for (int t = 0; t < 4; ++t)
#pragma unroll
        for (int s2 = 0; s2 < 4; ++s2) Kf[t][s2] = *(const bf16x8*)(ksrc + (row0 + 16 * t + fr) * qld + 32 * s2 + 8 * g);
    if (!GDN) {
        const f32x2* cs = (const f32x2*)(F.ws + AUX_CS);
#pragma unroll
        for (int t = 0; t < 4; ++t) { const f32x2* cr = cs + (size_t)((row0 + 16 * t + fr) & (SEQ - 1)) * 64 + 8 * g;
            rope_pair(Kf[t][0], Kf[t][2], (const f32x4*)cr, 0.08838834764831845f); rope_pair(Kf[t][1], Kf[t][3], (const f32x4*)(cr + 32), 0.08838834764831845f); }
    }
    if (GDN) {
#pragma unroll
        for (int it = 0; it < 4; ++it)
#pragma unroll
            for (int jt = 0; jt <= it; ++jt) { f32x4 acc = {0.f, 0.f, 0.f, 0.f};
#pragma unroll
                for (int s2 = 0; s2 < 4; ++s2) acc = mfma16(Kf[it][s2], Kf[jt][s2], acc);
#pragma unroll
                for (int r = 0; r < 4; ++r) { const int i = 16 * it + 4 * g + r, j = 16 * jt + fr; const int q = (i + 3) >> 2; const int ro = 2 * q * (q - 1) + q * (i - 4 * q + 3);
                    if (j < i) LAf[ro * 4 + j] = br[it * 4 + r] * acc[r] * __expf(gr[it * 4 + r] - gcl[jt]); } }
    }
    asm volatile("" ::: "memory");
#pragma unroll
    for (int it = 0; it < 4; ++it) {
        asm volatile("" ::: "memory");
#pragma unroll
        for (int s2 = 0; s2 < 4; ++s2) Qf[it][s2] = *(const bf16x8*)(qsrc + (row0 + 16 * it + fr) * qld + 32 * s2 + 8 * g);
        if (!GDN) { const f32x2* cr = (const f32x2*)(F.ws + AUX_CS) + (size_t)((row0 + 16 * it + fr) & (SEQ - 1)) * 64 + 8 * g;
            rope_pair(Qf[it][0], Qf[it][2], (const f32x4*)cr, 1.0f); rope_pair(Qf[it][1], Qf[it][3], (const f32x4*)(cr + 32), 1.0f);
#pragma unroll
            for (int s2 = 0; s2 < 4; ++s2) *(LAS bf16x8*)(L + (16 * it + fr) * 256 + (32 * s2 + 8 * g) * 2) = Qf[it][s2]; }
#pragma unroll
        for (int sp = 0; sp < 2; ++sp) { u32x4 w;
#pragma unroll
            for (int hf = 0; hf < 2; ++hf) { const int jt = 2 * sp + hf; float v[4] = {0.f, 0.f, 0.f, 0.f};
                if (jt <= it) { f32x4 acc = {0.f, 0.f, 0.f, 0.f};
#pragma unroll
                    for (int s2 = 0; s2 < 4; ++s2) acc = mfma16(Kf[jt][s2], Qf[it][s2], acc);
#pragma unroll
                    for (int r = 0; r < 4; ++r) { const int j = 16 * jt + 4 * g + r, i = 16 * it + fr; v[r] = (j <= i) ? acc[r] * __expf(gcl[it] - gr[jt * 4 + r]) : 0.f; } }
                if (hf == 0) { w.x = pk2(v[0], v[1]); w.y = pk2(v[2], v[3]); } else { w.z = pk2(v[0], v[1]); w.w = pk2(v[2], v[3]); } }
            *(u32x4*)(st + (OFF_ATT + it * 2 + sp) * 1024) = w; }
    }
    if (!GDN) LDS_WAIT();
    asm volatile("" ::: "memory");
#pragma unroll
    for (int it = 0; it < 4; ++it) { const float sc = __expf(gcl[it]); asm volatile("" ::: "memory");
#pragma unroll
        for (int s2 = 0; s2 < 4; ++s2) { const bf16_t* qp = qsrc + (row0 + 16 * it + fr) * qld + 32 * s2 + 4 * g; u32x2 lo, hi;
            if (GDN) { lo = *(const u32x2*)qp; hi = *(const u32x2*)(qp + 16); }
            else { const LAS unsigned char* lq = L + (16 * it + fr) * 256 + (32 * s2 + 4 * g) * 2; lo = *(const LAS u32x2*)lq; hi = *(const LAS u32x2*)(lq + 32); }
            u32x4 w; w.x = pk2(bflo(lo.x) * sc, bfhi(lo.x) * sc); w.y = pk2(bflo(lo.y) * sc, bfhi(lo.y) * sc); w.z = pk2(bflo(hi.x) * sc, bfhi(hi.x) * sc); w.w = pk2(bflo(hi.y) * sc, bfhi(hi.y) * sc);
            *(u32x4*)(st + (OFF_QG + it * 4 + s2) * 1024) = w; } }
    asm volatile("" ::: "memory");
    float t[64];
    float sw_ = 1.f, su_ = 1.f;
    if (GDN) {
        LDS_WAIT();
        const LAS f32x4* LA4 = (const LAS f32x4*)LA;
#pragma unroll
        for (int i = 0; i < 64; ++i) { float acc = (lane == i) ? 1.f : 0.f; if ((i & 1) == 0) asm volatile("" ::: "memory");
#pragma unroll
            for (int m4 = 0; m4 < (i + 3) / 4; ++m4) { const f32x4 l = LA4[rowoff4c(i) + m4];
                if (4 * m4 + 0 < i) acc -= l.x * t[4 * m4 + 0]; if (4 * m4 + 1 < i) acc -= l.y * t[4 * m4 + 1]; if (4 * m4 + 2 < i) acc -= l.z * t[4 * m4 + 2]; if (4 * m4 + 3 < i) acc -= l.w * t[4 * m4 + 3]; }
            t[i] = acc; }
        su_ = bv; sw_ = bv * __expf(gv);
        LDS_WAIT();
#pragma unroll
        for (int i = 0; i < 64; ++i) *(LAS bf16_t*)(LT + (i * 64 + lane) * 2) = (bf16_t)f2bf(t[i] * sw_);
    }
    asm volatile("" ::: "memory");
    float ksc[2][2][4];
#pragma unroll
    for (int sp = 0; sp < 2; ++sp)
#pragma unroll
        for (int tp = 0; tp < 2; ++tp)
#pragma unroll
            for (int e = 0; e < 4; ++e) ksc[sp][tp][e] = __expf(gl - LG[32 * sp + 16 * tp + 4 * g + e]);
    const unsigned la_addr = (unsigned)(size_t)LA, q4 = (unsigned)((lane & 15) >> 2), p4 = (unsigned)(lane & 3);
#pragma unroll 1
    for (int p = 0; p < 2; ++p) {
        LDS_WAIT();
#pragma unroll
        for (int k = 0; k < 8; ++k) { const int row = (lane >> 3) + 8 * k, pc = lane & 7; if (GDN) *(LAS u32x4*)(LA + row * 128 + pc * 16) = *(const u32x4*)(ksrc + (row0 + row) * qld + 64 * p + 8 * pc); }
        if (!GDN) {
#pragma unroll
            for (int t = 0; t < 4; ++t)
#pragma unroll
                for (int s2 = 0; s2 < 4; ++s2) if ((s2 >> 1) == p) *(LAS bf16x8*)(LA + (16 * t + fr) * 128 + (32 * (s2 & 1) + 8 * g) * 2) = Kf[t][s2]; }
        LDS_WAIT();
        if (GDN) {
#pragma unroll
            for (int it = 0; it < 4; ++it) { bf16x8 Tf[2];
#pragma unroll
                for (int ks = 0; ks < 2; ++ks) Tf[ks] = *(const LAS bf16x8*)(LT + ((16 * it + fr) * 64 + 32 * ks + 8 * g) * 2);
#pragma unroll
                for (int sl = 0; sl < 2; ++sl) { u32x4 w;
#pragma unroll
                    for (int hf = 0; hf < 2; ++hf) { const int dtl = 2 * sl + hf; f32x4 acc = {0.f, 0.f, 0.f, 0.f};
                        { s16x4 a0, a1, a2, a3; const unsigned ad = la_addr + (8 * g + q4) * 128 + dtl * 32 + p4 * 8; tr_read4(ad, ad + 4 * 128, ad + 32 * 128, ad + 36 * 128, a0, a1, a2, a3);
                          acc = mfma16(cat8(a0, a1), Tf[0], acc); acc = mfma16(cat8(a2, a3), Tf[1], acc); }
                        if (hf == 0) { w.x = pk2(-acc[0], -acc[1]); w.y = pk2(-acc[2], -acc[3]); } else { w.z = pk2(-acc[0], -acc[1]); w.w = pk2(-acc[2], -acc[3]); } }
                    *(u32x4*)(st + (OFF_W + it * 4 + 2 * p + sl) * 1024) = w; } }
        }
#pragma unroll
        for (int dtl = 0; dtl < 4; ++dtl) { s16x4 t0, t1, t2, t3; const unsigned ad = la_addr + (4 * g + q4) * 128 + dtl * 32 + p4 * 8; tr_read4(ad, ad + 16 * 128, ad + 32 * 128, ad + 48 * 128, t0, t1, t2, t3);
#pragma unroll
            for (int sp = 0; sp < 2; ++sp) { const s16x4 a0 = sp ? t2 : t0, a1 = sp ? t3 : t1;
                u32x4 w; w.x = pk2(bf2f((bf16_t)a0[0]) * ksc[sp][0][0], bf2f((bf16_t)a0[1]) * ksc[sp][0][1]); w.y = pk2(bf2f((bf16_t)a0[2]) * ksc[sp][0][2], bf2f((bf16_t)a0[3]) * ksc[sp][0][3]);
                w.z = pk2(bf2f((bf16_t)a1[0]) * ksc[sp][1][0], bf2f((bf16_t)a1[1]) * ksc[sp][1][1]); w.w = pk2(bf2f((bf16_t)a1[2]) * ksc[sp][1][2], bf2f((bf16_t)a1[3]) * ksc[sp][1][3]);
                *(u32x4*)(st + (OFF_KT + (4 * p + dtl) * 2 + sp) * 1024) = w; } }
    }
    if (GDN) {
        LDS_WAIT();
#pragma unroll
        for (int i = 0; i < 64; ++i) *(LAS bf16_t*)(LT + (i * 64 + lane) * 2) = (bf16_t)f2bf(t[i] * su_);
        const bf16_t* vsrc = (const bf16_t*)(F.ws + AUX_VC) + h * 256;
        unsigned char* ub = F.ws + WS_H + (size_t)unit * 32768 + lane * 32;
#pragma unroll 1
        for (int p = 0; p < 4; ++p) {
            LDS_WAIT();
#pragma unroll
            for (int k = 0; k < 8; ++k) { const int row = (lane >> 3) + 8 * k, pc = lane & 7; *(LAS u32x4*)(LA + row * 128 + pc * 16) = *(const u32x4*)(vsrc + (row0 + row) * 2048 + 64 * p + 8 * pc); }
            LDS_WAIT();
            bf16x8 Tf[4][2];
#pragma unroll
            for (int it = 0; it < 4; ++it)
#pragma unroll
                for (int ks = 0; ks < 2; ++ks) Tf[it][ks] = *(const LAS bf16x8*)(LT + ((16 * it + fr) * 64 + 32 * ks + 8 * g) * 2);
#pragma unroll
            for (int etl = 0; etl < 4; ++etl) { bf16x8 Vf[2];
                { s16x4 a0, a1, a2, a3; const unsigned ad = la_addr + (8 * g + q4) * 128 + etl * 32 + p4 * 8; tr_read4(ad, ad + 4 * 128, ad + 32 * 128, ad + 36 * 128, a0, a1, a2, a3); Vf[0] = cat8(a0, a1); Vf[1] = cat8(a2, a3); }
                u32x4 w0, w1;
#pragma unroll
                for (int it = 0; it < 4; ++it) { f32x4 acc = {0.f, 0.f, 0.f, 0.f};
#pragma unroll
                    for (int ks = 0; ks < 2; ++ks) acc = mfma16(Tf[it][ks], Vf[ks], acc);
                    const unsigned a = pk2(acc[0], acc[1]), c = pk2(acc[2], acc[3]);
                    if (it == 0) { w0.x = a; w0.y = c; } else if (it == 1) { w0.z = a; w0.w = c; } else if (it == 2) { w1.x = a; w1.y = c; } else { w1.z = a; w1.w = c; } }
                *(u32x4*)(ub + (4 * p + etl) * 2048) = w0; *(u32x4*)(ub + (4 * p + etl) * 2048 + 16) = w1; }
        }
        if (lane == 0) ((float*)(F.ws + AUX_DEC))[unit] = __expf(gl);
    }
    LDS_WAIT();
}

constexpr int XL_SLOT = 12288, XL_CNT = 2 * XL_SLOT;
template <bool GDN, int ROLE>
DI void scan_wave(Frame& F, int bh, int sl, const unsigned char* stream, LAS unsigned char* xl) {
    constexpr int NF = GDN ? 56 : 40;
    const int lane = F.lane, fr = lane & 15, g = lane >> 4, b = bh >> 3, h = bh & 7;
    const unsigned char* sp0 = stream + (size_t)bh * NCH * NF * 1024;
    const unsigned voff = (unsigned)lane * 16u;
    const size_t orow = (size_t)2048 * 2;
    const unsigned char* obu = (GDN ? F.ws + AUX_VC : F.ws + AUX_QN) + (size_t)b * SEQ * orow + (size_t)(h * 256 + 16 * sl) * 2;
    const unsigned ooff = (unsigned)((size_t)(4 * g) * orow) + (unsigned)fr * 2u;
    const size_t vrow = (size_t)PJW * 2;
    const unsigned char* vbu = F.ws + WS_BIG + BIG_PJ + (size_t)C_RV * 2 + (size_t)b * SEQ * vrow + (size_t)(h * 256 + 16 * sl) * 2;
    const unsigned voff2 = (unsigned)((size_t)(4 * g) * vrow) + (unsigned)fr * 2u;
    const float* decp = (const float*)(F.ws + AUX_DEC) + bh * NCH;
    float decr = 1.f; { const float gm = 1.0f - exp2f(-5.0f - (float)h); float d2 = gm * gm; d2 *= d2; d2 *= d2; d2 *= d2; d2 *= d2; d2 *= d2; decr = d2; }
    const unsigned char* ubp = F.ws + WS_H + (size_t)bh * NCH * 32768 + sl * 2048; const unsigned uoff = (unsigned)lane * 32u;
    const unsigned zoff = 0u; (void)decp; (void)decr; (void)ubp; (void)uoff; (void)zoff; (void)obu; (void)ooff; (void)vbu; (void)voff2; (void)vrow; (void)orow;
    if constexpr (GDN && ROLE == 0) {
    bf16x8 r0 = (bf16x8){0, 0, 0, 0, 0, 0, 0, 0};
    bf16x8 r1 = (bf16x8){0, 0, 0, 0, 0, 0, 0, 0};
    bf16x8 r2 = (bf16x8){0, 0, 0, 0, 0, 0, 0, 0};
    bf16x8 r3 = (bf16x8){0, 0, 0, 0, 0, 0, 0, 0};
    bf16x8 r4 = (bf16x8){0, 0, 0, 0, 0, 0, 0, 0};
    bf16x8 r5 = (bf16x8){0, 0, 0, 0, 0, 0, 0, 0};
    bf16x8 r6 = (bf16x8){0, 0, 0, 0, 0, 0, 0, 0};
    bf16x8 r7 = (bf16x8){0, 0, 0, 0, 0, 0, 0, 0};
    bf16x8 r8 = (bf16x8){0, 0, 0, 0, 0, 0, 0, 0};
    bf16x8 r9 = (bf16x8){0, 0, 0, 0, 0, 0, 0, 0};
    bf16x8 r10 = (bf16x8){0, 0, 0, 0, 0, 0, 0, 0};
    bf16x8 r11 = (bf16x8){0, 0, 0, 0, 0, 0, 0, 0};
    bf16x8 r12 = (bf16x8){0, 0, 0, 0, 0, 0, 0, 0};
    bf16x8 r13 = (bf16x8){0, 0, 0, 0, 0, 0, 0, 0};
    bf16x8 r14 = (bf16x8){0, 0, 0, 0, 0, 0, 0, 0};
    bf16x8 r15 = (bf16x8){0, 0, 0, 0, 0, 0, 0, 0};
    f32x4 S0_0 = {0.f, 0.f, 0.f, 0.f};
    f32x4 S0_1 = {0.f, 0.f, 0.f, 0.f};
    f32x4 S0_2 = {0.f, 0.f, 0.f, 0.f};
    f32x4 S0_3 = {0.f, 0.f, 0.f, 0.f};
    f32x4 S0_4 = {0.f, 0.f, 0.f, 0.f};
    f32x4 S0_5 = {0.f, 0.f, 0.f, 0.f};
    f32x4 S0_6 = {0.f, 0.f, 0.f, 0.f};
    f32x4 S0_7 = {0.f, 0.f, 0.f, 0.f};
    bf16x8 Sp0_0 = (bf16x8){0, 0, 0, 0, 0, 0, 0, 0};
    bf16x8 Sp0_1 = (bf16x8){0, 0, 0, 0, 0, 0, 0, 0};
    bf16x8 Sp0_2 = (bf16x8){0, 0, 0, 0, 0, 0, 0, 0};
    bf16x8 Sp0_3 = (bf16x8){0, 0, 0, 0, 0, 0, 0, 0};
    f32x4 S1_0 = {0.f, 0.f, 0.f, 0.f};
    f32x4 S1_1 = {0.f, 0.f, 0.f, 0.f};
    f32x4 S1_2 = {0.f, 0.f, 0.f, 0.f};
    f32x4 S1_3 = {0.f, 0.f, 0.f, 0.f};
    f32x4 S1_4 = {0.f, 0.f, 0.f, 0.f};
    f32x4 S1_5 = {0.f, 0.f, 0.f, 0.f};
    f32x4 S1_6 = {0.f, 0.f, 0.f, 0.f};
    f32x4 S1_7 = {0.f, 0.f, 0.f, 0.f};
    bf16x8 Sp1_0 = (bf16x8){0, 0, 0, 0, 0, 0, 0, 0};
    bf16x8 Sp1_1 = (bf16x8){0, 0, 0, 0, 0, 0, 0, 0};
    bf16x8 Sp1_2 = (bf16x8){0, 0, 0, 0, 0, 0, 0, 0};
    bf16x8 Sp1_3 = (bf16x8){0, 0, 0, 0, 0, 0, 0, 0};
    float decv = 0.f;
    u32x4 un0_0 = {0u, 0u, 0u, 0u}, un0_1 = {0u, 0u, 0u, 0u};
    u32x4 un1_0 = {0u, 0u, 0u, 0u}, un1_1 = {0u, 0u, 0u, 0u};
    { const int n = 0; (void)n;
    asm volatile("global_load_dwordx4 %0, %1, off" : "+v"(un0_0) : "v"((const unsigned char*)(ubp + 0 * 2048) + uoff) : "memory");
    asm volatile("global_load_dwordx4 %0, %1, off offset:16" : "+v"(un0_1) : "v"((const unsigned char*)(ubp + 0 * 2048) + uoff) : "memory");
    asm volatile("global_load_dwordx4 %0, %1, off" : "+v"(un1_0) : "v"((const unsigned char*)(ubp + 1 * 2048) + uoff) : "memory");
    asm volatile("global_load_dwordx4 %0, %1, off offset:16" : "+v"(un1_1) : "v"((const unsigned char*)(ubp + 1 * 2048) + uoff) : "memory");
    asm volatile("global_load_dword %0, %1, off" : "+v"(decv) : "v"((const unsigned char*)(decp) + zoff) : "memory");
    asm volatile("global_load_dwordx4 %0, %1, off" : "+v"(r0) : "v"((const unsigned char*)(sp0 + ((size_t)(n + 0) * 56 + 0) * 1024) + voff) : "memory");
    asm volatile("global_load_dwordx4 %0, %1, off" : "+v"(r1) : "v"((const unsigned char*)(sp0 + ((size_t)(n + 0) * 56 + 1) * 1024) + voff) : "memory");
    asm volatile("global_load_dwordx4 %0, %1, off" : "+v"(r2) : "v"((const unsigned char*)(sp0 + ((size_t)(n + 0) * 56 + 2) * 1024) + voff) : "memory");
    asm volatile("global_load_dwordx4 %0, %1, off" : "+v"(r3) : "v"((const unsigned char*)(sp0 + ((size_t)(n + 0) * 56 + 3) * 1024) + voff) : "memory");
    asm volatile("global_load_dwordx4 %0, %1, off" : "+v"(r4) : "v"((const unsigned char*)(sp0 + ((size_t)(n + 0) * 56 + 4) * 1024) + voff) : "memory");
    asm volatile("global_load_dwordx4 %0, %1, off" : "+v"(r5) : "v"((const unsigned char*)(sp0 + ((size_t)(n + 0) * 56 + 5) * 1024) + voff) : "memory");
    asm volatile("global_load_dwordx4 %0, %1, off" : "+v"(r6) : "v"((const unsigned char*)(sp0 + ((size_t)(n + 0) * 56 + 6) * 1024) + voff) : "memory");
    asm volatile("global_load_dwordx4 %0, %1, off" : "+v"(r7) : "v"((const unsigned char*)(sp0 + ((size_t)(n + 0) * 56 + 7) * 1024) + voff) : "memory");
    asm volatile("global_load_dwordx4 %0, %1, off" : "+v"(r8) : "v"((const unsigned char*)(sp0 + ((size_t)(n + 0) * 56 + 8) * 1024) + voff) : "memory");
    asm volatile("global_load_dwordx4 %0, %1, off" : "+v"(r9) : "v"((const unsigned char*)(sp0 + ((size_t)(n + 0) * 56 + 9) * 1024) + voff) : "memory");
    asm volatile("global_load_dwordx4 %0, %1, off" : "+v"(r10) : "v"((const unsigned char*)(sp0 + ((size_t)(n + 0) * 56 + 10) * 1024) + voff) : "memory");
    asm volatile("global_load_dwordx4 %0, %1, off" : "+v"(r11) : "v"((const unsigned char*)(sp0 + ((size_t)(n + 0) * 56 + 11) * 1024) + voff) : "memory");
    asm volatile("global_load_dwordx4 %0, %1, off" : "+v"(r12) : "v"((const unsigned char*)(sp0 + ((size_t)(n + 0) * 56 + 12) * 1024) + voff) : "memory");
    asm volatile("global_load_dwordx4 %0, %1, off" : "+v"(r13) : "v"((const unsigned char*)(sp0 + ((size_t)(n + 0) * 56 + 13) * 1024) + voff) : "memory");
    asm volatile("global_load_dwordx4 %0, %1, off" : "+v"(r14) : "v"((const unsigned char*)(sp0 + ((size_t)(n + 0) * 56 + 14) * 1024) + voff) : "memory");
    asm volatile("global_load_dwordx4 %0, %1, off" : "+v"(r15) : "v"((const unsigned char*)(sp0 + ((size_t)(n + 0) * 56 + 15) * 1024) + voff) : "memory");
    }
#pragma unroll 1
    for (int n = 0; n < NCH; ++n) {
        const int nn = n + 1 < NCH ? n + 1 : n;
        f32x4 a0_0, a0_1, a0_2, a0_3;
        f32x4 a1_0, a1_1, a1_2, a1_3;
        asm volatile("s_waitcnt vmcnt(16)" : "+v"(un0_0), "+v"(un0_1), "+v"(un1_0), "+v"(un1_1), "+v"(decv));
        a0_0 = (f32x4){bflo(un0_0.x), bfhi(un0_0.x), bflo(un0_0.y), bfhi(un0_0.y)}; a0_1 = (f32x4){bflo(un0_0.z), bfhi(un0_0.z), bflo(un0_0.w), bfhi(un0_0.w)};
        a0_2 = (f32x4){bflo(un0_1.x), bfhi(un0_1.x), bflo(un0_1.y), bfhi(un0_1.y)}; a0_3 = (f32x4){bflo(un0_1.z), bfhi(un0_1.z), bflo(un0_1.w), bfhi(un0_1.w)};
        a1_0 = (f32x4){bflo(un1_0.x), bfhi(un1_0.x), bflo(un1_0.y), bfhi(un1_0.y)}; a1_1 = (f32x4){bflo(un1_0.z), bfhi(un1_0.z), bflo(un1_0.w), bfhi(un1_0.w)};
        a1_2 = (f32x4){bflo(un1_1.x), bfhi(un1_1.x), bflo(un1_1.y), bfhi(un1_1.y)}; a1_3 = (f32x4){bflo(un1_1.z), bfhi(un1_1.z), bflo(un1_1.w), bfhi(un1_1.w)};
        const float dec = decv;
        { const unsigned char* ubn = ubp + (size_t)nn * 32768;
          asm volatile("global_load_dwordx4 %0, %1, off" : "+v"(un0_0) : "v"((const unsigned char*)(ubn + 0 * 2048) + uoff) : "memory");
          asm volatile("global_load_dwordx4 %0, %1, off offset:16" : "+v"(un0_1) : "v"((const unsigned char*)(ubn + 0 * 2048) + uoff) : "memory");
          asm volatile("global_load_dwordx4 %0, %1, off" : "+v"(un1_0) : "v"((const unsigned char*)(ubn + 1 * 2048) + uoff) : "memory");
          asm volatile("global_load_dwordx4 %0, %1, off offset:16" : "+v"(un1_1) : "v"((const unsigned char*)(ubn + 1 * 2048) + uoff) : "memory");
          asm volatile("global_load_dword %0, %1, off" : "+v"(decv) : "v"((const unsigned char*)(decp + nn) + zoff) : "memory"); }
        __builtin_amdgcn_sched_barrier(0);
        asm volatile("s_waitcnt vmcnt(20)" : "+v"(r0));
        a0_0 = mfma16(r0, Sp0_0, a0_0);
        a1_0 = mfma16(r0, Sp1_0, a1_0);
        asm volatile("global_load_dwordx4 %0, %1, off" : "+v"(r0) : "v"((const unsigned char*)(sp0 + ((size_t)(n + 0) * 56 + 40) * 1024) + voff) : "memory");
        __builtin_amdgcn_sched_barrier(0);
        asm volatile("s_waitcnt vmcnt(20)" : "+v"(r1));
        a0_0 = mfma16(r1, Sp0_1, a0_0);
        a1_0 = mfma16(r1, Sp1_1, a1_0);
        asm volatile("global_load_dwordx4 %0, %1, off" : "+v"(r1) : "v"((const unsigned char*)(sp0 + ((size_t)(n + 0) * 56 + 41) * 1024) + voff) : "memory");
        __builtin_amdgcn_sched_barrier(0);
        asm volatile("s_waitcnt vmcnt(20)" : "+v"(r2));
        a0_0 = mfma16(r2, Sp0_2, a0_0);
        a1_0 = mfma16(r2, Sp1_2, a1_0);
        asm volatile("global_load_dwordx4 %0, %1, off" : "+v"(r2) : "v"((const unsigned char*)(sp0 + ((size_t)(n + 0) * 56 + 42) * 1024) + voff) : "memory");
        __builtin_amdgcn_sched_barrier(0);
        asm volatile("s_waitcnt vmcnt(20)" : "+v"(r3));
        a0_0 = mfma16(r3, Sp0_3, a0_0);
        a1_0 = mfma16(r3, Sp1_3, a1_0);
        asm volatile("global_load_dwordx4 %0, %1, off" : "+v"(r3) : "v"((const unsigned char*)(sp0 + ((size_t)(n + 0) * 56 + 43) * 1024) + voff) : "memory");
        __builtin_amdgcn_sched_barrier(0);
        asm volatile("s_waitcnt vmcnt(20)" : "+v"(r4));
        a0_1 = mfma16(r4, Sp0_0, a0_1);
        a1_1 = mfma16(r4, Sp1_0, a1_1);
        asm volatile("global_load_dwordx4 %0, %1, off" : "+v"(r4) : "v"((const unsigned char*)(sp0 + ((size_t)(n + 0) * 56 + 44) * 1024) + voff) : "memory");
        __builtin_amdgcn_sched_barrier(0);
        asm volatile("s_waitcnt vmcnt(20)" : "+v"(r5));
        a0_1 = mfma16(r5, Sp0_1, a0_1);
        a1_1 = mfma16(r5, Sp1_1, a1_1);
        asm volatile("global_load_dwordx4 %0, %1, off" : "+v"(r5) : "v"((const unsigned char*)(sp0 + ((size_t)(n + 0) * 56 + 45) * 1024) + voff) : "memory");
        __builtin_amdgcn_sched_barrier(0);
        asm volatile("s_waitcnt vmcnt(20)" : "+v"(r6));
        a0_1 = mfma16(r6, Sp0_2, a0_1);
        a1_1 = mfma16(r6, Sp1_2, a1_1);
        asm volatile("global_load_dwordx4 %0, %1, off" : "+v"(r6) : "v"((const unsigned char*)(sp0 + ((size_t)(n + 0) * 56 + 46) * 1024) + voff) : "memory");
        __builtin_amdgcn_sched_barrier(0);
        asm volatile("s_waitcnt vmcnt(20)" : "+v"(r7));
        a0_1 = mfma16(r7, Sp0_3, a0_1);
        a1_1 = mfma16(r7, Sp1_3, a1_1);
        asm volatile("global_load_dwordx4 %0, %1, off" : "+v"(r7) : "v"((const unsigned char*)(sp0 + ((size_t)(n + 0) * 56 + 47) * 1024) + voff) : "memory");
        __builtin_amdgcn_sched_barrier(0);
        asm volatile("s_waitcnt vmcnt(20)" : "+v"(r8));
        a0_2 = mfma16(r8, Sp0_0, a0_2);
        a1_2 = mfma16(r8, Sp1_0, a1_2);
        asm volatile("global_load_dwordx4 %0, %1, off" : "+v"(r8) : "v"((const unsigned char*)(sp0 + ((size_t)(n + 0) * 56 + 48) * 1024) + voff) : "memory");
        __builtin_amdgcn_sched_barrier(0);
        asm volatile("s_waitcnt vmcnt(20)" : "+v"(r9));
        a0_2 = mfma16(r9, Sp0_1, a0_2);
        a1_2 = mfma16(r9, Sp1_1, a1_2);
        asm volatile("global_load_dwordx4 %0, %1, off" : "+v"(r9) : "v"((const unsigned char*)(sp0 + ((size_t)(n + 0) * 56 + 49) * 1024) + voff) : "memory");
        __builtin_amdgcn_sched_barrier(0);
        asm volatile("s_waitcnt vmcnt(20)" : "+v"(r10));
        a0_2 = mfma16(r10, Sp0_2, a0_2);
        a1_2 = mfma16(r10, Sp1_2, a1_2);
        asm volatile("global_load_dwordx4 %0, %1, off" : "+v"(r10) : "v"((const unsigned char*)(sp0 + ((size_t)(n + 0) * 56 + 50) * 1024) + voff) : "memory");
        __builtin_amdgcn_sched_barrier(0);
        asm volatile("s_waitcnt vmcnt(20)" : "+v"(r11));
        a0_2 = mfma16(r11, Sp0_3, a0_2);
        a1_2 = mfma16(r11, Sp1_3, a1_2);
        asm volatile("global_load_dwordx4 %0, %1, off" : "+v"(r11) : "v"((const unsigned char*)(sp0 + ((size_t)(n + 0) * 56 + 51) * 1024) + voff) : "memory");
        __builtin_amdgcn_sched_barrier(0);
        asm volatile("s_waitcnt vmcnt(20)" : "+v"(r12));
        a0_3 = mfma16(r12, Sp0_0, a0_3);
        a1_3 = mfma16(r12, Sp1_0, a1_3);
        asm volatile("global_load_dwordx4 %0, %1, off" : "+v"(r12) : "v"((const unsigned char*)(sp0 + ((size_t)(n + 0) * 56 + 52) * 1024) + voff) : "memory");
        __builtin_amdgcn_sched_barrier(0);
        asm volatile("s_waitcnt vmcnt(20)" : "+v"(r13));
        a0_3 = mfma16(r13, Sp0_1, a0_3);
        a1_3 = mfma16(r13, Sp1_1, a1_3);
        asm volatile("global_load_dwordx4 %0, %1, off" : "+v"(r13) : "v"((const unsigned char*)(sp0 + ((size_t)(n + 0) * 56 + 53) * 1024) + voff) : "memory");
        __builtin_amdgcn_sched_barrier(0);
        asm volatile("s_waitcnt vmcnt(20)" : "+v"(r14));
        a0_3 = mfma16(r14, Sp0_2, a0_3);
        a1_3 = mfma16(r14, Sp1_2, a1_3);
        asm volatile("global_load_dwordx4 %0, %1, off" : "+v"(r14) : "v"((const unsigned char*)(sp0 + ((size_t)(n + 0) * 56 + 54) * 1024) + voff) : "memory");
        __builtin_amdgcn_sched_barrier(0);
        asm volatile("s_waitcnt vmcnt(20)" : "+v"(r15));
        a0_3 = mfma16(r15, Sp0_3, a0_3);
        a1_3 = mfma16(r15, Sp1_3, a1_3);
        asm volatile("global_load_dwordx4 %0, %1, off" : "+v"(r15) : "v"((const unsigned char*)(sp0 + ((size_t)(n + 0) * 56 + 55) * 1024) + voff) : "memory");
        __builtin_amdgcn_sched_barrier(0);
        bf16x8 vp0_0, vp0_1;
        { u32x4 w; w.x = cvt_pk_bf16(a0_0[0], a0_0[1]); w.y = cvt_pk_bf16(a0_0[2], a0_0[3]); w.z = cvt_pk_bf16(a0_1[0], a0_1[1]); w.w = cvt_pk_bf16(a0_1[2], a0_1[3]); vp0_0 = __builtin_bit_cast(bf16x8, w); }
        { u32x4 w; w.x = cvt_pk_bf16(a0_2[0], a0_2[1]); w.y = cvt_pk_bf16(a0_2[2], a0_2[3]); w.z = cvt_pk_bf16(a0_3[0], a0_3[1]); w.w = cvt_pk_bf16(a0_3[2], a0_3[3]); vp0_1 = __builtin_bit_cast(bf16x8, w); }
        bf16x8 vp1_0, vp1_1;
        { u32x4 w; w.x = cvt_pk_bf16(a1_0[0], a1_0[1]); w.y = cvt_pk_bf16(a1_0[2], a1_0[3]); w.z = cvt_pk_bf16(a1_1[0], a1_1[1]); w.w = cvt_pk_bf16(a1_1[2], a1_1[3]); vp1_0 = __builtin_bit_cast(bf16x8, w); }
        { u32x4 w; w.x = cvt_pk_bf16(a1_2[0], a1_2[1]); w.y = cvt_pk_bf16(a1_2[2], a1_2[3]); w.z = cvt_pk_bf16(a1_3[0], a1_3[1]); w.w = cvt_pk_bf16(a1_3[2], a1_3[3]); vp1_1 = __builtin_bit_cast(bf16x8, w); }
        { unsigned sp_ = 0; while (*(volatile LAS unsigned*)(xl + XL_CNT + 64) + 2u <= (unsigned)n) { __builtin_amdgcn_s_sleep(1); if (++sp_ > (1u << 22)) break; } }
        { LAS bf16x8* sl_ = (LAS bf16x8*)(xl + (n & 1) * XL_SLOT) + lane; sl_[0] = Sp0_0; sl_[64] = Sp0_1; sl_[128] = Sp0_2; sl_[192] = Sp0_3; sl_[256] = vp0_0; sl_[320] = vp0_1; sl_[384] = Sp1_0; sl_[448] = Sp1_1; sl_[512] = Sp1_2; sl_[576] = Sp1_3; sl_[640] = vp1_0; sl_[704] = vp1_1; }
        asm volatile("s_waitcnt lgkmcnt(0)" ::: "memory");
        if (lane == 0) *(volatile LAS unsigned*)(xl + XL_CNT) = (unsigned)(n + 1);
        S0_0 = S0_0 * dec;
        S1_0 = S1_0 * dec;
        asm volatile("s_waitcnt vmcnt(15)" : "+v"(r0));
        S0_0 = mfma16(r0, vp0_0, S0_0);
        S1_0 = mfma16(r0, vp1_0, S1_0);
        asm volatile("global_load_dwordx4 %0, %1, off" : "+v"(r0) : "v"((const unsigned char*)(sp0 + ((size_t)(n + 1) * 56 + 0) * 1024) + voff) : "memory");
        __builtin_amdgcn_sched_barrier(0);
        asm volatile("s_waitcnt vmcnt(15)" : "+v"(r1));
        S0_0 = mfma16(r1, vp0_1, S0_0);
        S1_0 = mfma16(r1, vp1_1, S1_0);
        asm volatile("global_load_dwordx4 %0, %1, off" : "+v"(r1) : "v"((const unsigned char*)(sp0 + ((size_t)(n + 1) * 56 + 1) * 1024) + voff) : "memory");
        __builtin_amdgcn_sched_barrier(0);
        S0_1 = S0_1 * dec;
        S1_1 = S1_1 * dec;
        asm volatile("s_waitcnt vmcnt(15)" : "+v"(r2));
        S0_1 = mfma16(r2, vp0_0, S0_1);
        S1_1 = mfma16(r2, vp1_0, S1_1);
        asm volatile("global_load_dwordx4 %0, %1, off" : "+v"(r2) : "v"((const unsigned char*)(sp0 + ((size_t)(n + 1) * 56 + 2) * 1024) + voff) : "memory");
        __builtin_amdgcn_sched_barrier(0);
        asm volatile("s_waitcnt vmcnt(15)" : "+v"(r3));
        S0_1 = mfma16(r3, vp0_1, S0_1);
        S1_1 = mfma16(r3, vp1_1, S1_1);
        asm volatile("global_load_dwordx4 %0, %1, off" : "+v"(r3) : "v"((const unsigned char*)(sp0 + ((size_t)(n + 1) * 56 + 3) * 1024) + voff) : "memory");
        __builtin_amdgcn_sched_barrier(0);
        S0_2 = S0_2 * dec;
        S1_2 = S1_2 * dec;
        asm volatile("s_waitcnt vmcnt(15)" : "+v"(r4));
        S0_2 = mfma16(r4, vp0_0, S0_2);
        S1_2 = mfma16(r4, vp1_0, S1_2);
        asm volatile("global_load_dwordx4 %0, %1, off" : "+v"(r4) : "v"((const unsigned char*)(sp0 + ((size_t)(n + 1) * 56 + 4) * 1024) + voff) : "memory");
        __builtin_amdgcn_sched_barrier(0);
        asm volatile("s_waitcnt vmcnt(15)" : "+v"(r5));
        S0_2 = mfma16(r5, vp0_1, S0_2);
        S1_2 = mfma16(r5, vp1_1, S1_2);
        asm volatile("global_load_dwordx4 %0, %1, off" : "+v"(r5) : "v"((const unsigned char*)(sp0 + ((size_t)(n + 1) * 56 + 5) * 1024) + voff) : "memory");
        __builtin_amdgcn_sched_barrier(0);
        S0_3 = S0_3 * dec;
        S1_3 = S1_3 * dec;
        asm volatile("s_waitcnt vmcnt(15)" : "+v"(r6));
        S0_3 = mfma16(r6, vp0_0, S0_3);
        S1_3 = mfma16(r6, vp1_0, S1_3);
        asm volatile("global_load_dwordx4 %0, %1, off" : "+v"(r6) : "v"((const unsigned char*)(sp0 + ((size_t)(n + 1) * 56 + 6) * 1024) + voff) : "memory");
        __builtin_amdgcn_sched_barrier(0);
        asm volatile("s_waitcnt vmcnt(15)" : "+v"(r7));
        S0_3 = mfma16(r7, vp0_1, S0_3);
        S1_3 = mfma16(r7, vp1_1, S1_3);
        asm volatile("global_load_dwordx4 %0, %1, off" : "+v"(r7) : "v"((const unsigned char*)(sp0 + ((size_t)(n + 1) * 56 + 7) * 1024) + voff) : "memory");
        __builtin_amdgcn_sched_barrier(0);
        S0_4 = S0_4 * dec;
        S1_4 = S1_4 * dec;
        asm volatile("s_waitcnt vmcnt(15)" : "+v"(r8));
        S0_4 = mfma16(r8, vp0_0, S0_4);
        S1_4 = mfma16(r8, vp1_0, S1_4);
        asm volatile("global_load_dwordx4 %0, %1, off" : "+v"(r8) : "v"((const unsigned char*)(sp0 + ((size_t)(n + 1) * 56 + 8) * 1024) + voff) : "memory");
        __builtin_amdgcn_sched_barrier(0);
        asm volatile("s_waitcnt vmcnt(15)" : "+v"(r9));
        S0_4 = mfma16(r9, vp0_1, S0_4);
        S1_4 = mfma16(r9, vp1_1, S1_4);
        asm volatile("global_load_dwordx4 %0, %1, off" : "+v"(r9) : "v"((const unsigned char*)(sp0 + ((size_t)(n + 1) * 56 + 9) * 1024) + voff) : "memory");
        __builtin_amdgcn_sched_barrier(0);
        S0_5 = S0_5 * dec;
        S1_5 = S1_5 * dec;
        asm volatile("s_waitcnt vmcnt(15)" : "+v"(r10));
        S0_5 = mfma16(r10, vp0_0, S0_5);
        S1_5 = mfma16(r10, vp1_0, S1_5);
        asm volatile("global_load_dwordx4 %0, %1, off" : "+v"(r10) : "v"((const unsigned char*)(sp0 + ((size_t)(n + 1) * 56 + 10) * 1024) + voff) : "memory");
        __builtin_amdgcn_sched_barrier(0);
        asm volatile("s_waitcnt vmcnt(15)" : "+v"(r11));
        S0_5 = mfma16(r11, vp0_1, S0_5);
        S1_5 = mfma16(r11, vp1_1, S1_5);
        asm volatile("global_load_dwordx4 %0, %1, off" : "+v"(r11) : "v"((const unsigned char*)(sp0 + ((size_t)(n + 1) * 56 + 11) * 1024) + voff) : "memory");
        __builtin_amdgcn_sched_barrier(0);
        S0_6 = S0_6 * dec;
        S1_6 = S1_6 * dec;
        asm volatile("s_waitcnt vmcnt(15)" : "+v"(r12));
        S0_6 = mfma16(r12, vp0_0, S0_6);
        S1_6 = mfma16(r12, vp1_0, S1_6);
        asm volatile("global_load_dwordx4 %0, %1, off" : "+v"(r12) : "v"((const unsigned char*)(sp0 + ((size_t)(n + 1) * 56 + 12) * 1024) + voff) : "memory");
        __builtin_amdgcn_sched_barrier(0);
        asm volatile("s_waitcnt vmcnt(15)" : "+v"(r13));
        S0_6 = mfma16(r13, vp0_1, S0_6);
        S1_6 = mfma16(r13, vp1_1, S1_6);
        asm volatile("global_load_dwordx4 %0, %1, off" : "+v"(r13) : "v"((const unsigned char*)(sp0 + ((size_t)(n + 1) * 56 + 13) * 1024) + voff) : "memory");
        __builtin_amdgcn_sched_barrier(0);
        S0_7 = S0_7 * dec;
        S1_7 = S1_7 * dec;
        asm volatile("s_waitcnt vmcnt(15)" : "+v"(r14));
        S0_7 = mfma16(r14, vp0_0, S0_7);
        S1_7 = mfma16(r14, vp1_0, S1_7);
        asm volatile("global_load_dwordx4 %0, %1, off" : "+v"(r14) : "v"((const unsigned char*)(sp0 + ((size_t)(n + 1) * 56 + 14) * 1024) + voff) : "memory");
        __builtin_amdgcn_sched_barrier(0);
        asm volatile("s_waitcnt vmcnt(15)" : "+v"(r15));
        S0_7 = mfma16(r15, vp0_1, S0_7);
        S1_7 = mfma16(r15, vp1_1, S1_7);
        asm volatile("global_load_dwordx4 %0, %1, off" : "+v"(r15) : "v"((const unsigned char*)(sp0 + ((size_t)(n + 1) * 56 + 15) * 1024) + voff) : "memory");
        __builtin_amdgcn_sched_barrier(0);
        { u32x4 w; w.x = cvt_pk_bf16(S0_0[0], S0_0[1]); w.y = cvt_pk_bf16(S0_0[2], S0_0[3]); w.z = cvt_pk_bf16(S0_1[0], S0_1[1]); w.w = cvt_pk_bf16(S0_1[2], S0_1[3]); Sp0_0 = __builtin_bit_cast(bf16x8, w); }
        { u32x4 w; w.x = cvt_pk_bf16(S0_2[0], S0_2[1]); w.y = cvt_pk_bf16(S0_2[2], S0_2[3]); w.z = cvt_pk_bf16(S0_3[0], S0_3[1]); w.w = cvt_pk_bf16(S0_3[2], S0_3[3]); Sp0_1 = __builtin_bit_cast(bf16x8, w); }
        { u32x4 w; w.x = cvt_pk_bf16(S0_4[0], S0_4[1]); w.y = cvt_pk_bf16(S0_4[2], S0_4[3]); w.z = cvt_pk_bf16(S0_5[0], S0_5[1]); w.w = cvt_pk_bf16(S0_5[2], S0_5[3]); Sp0_2 = __builtin_bit_cast(bf16x8, w); }
        { u32x4 w; w.x = cvt_pk_bf16(S0_6[0], S0_6[1]); w.y = cvt_pk_bf16(S0_6[2], S0_6[3]); w.z = cvt_pk_bf16(S0_7[0], S0_7[1]); w.w = cvt_pk_bf16(S0_7[2], S0_7[3]); Sp0_3 = __builtin_bit_cast(bf16x8, w); }
        { u32x4 w; w.x = cvt_pk_bf16(S1_0[0], S1_0[1]); w.y = cvt_pk_bf16(S1_0[2], S1_0[3]); w.z = cvt_pk_bf16(S1_1[0], S1_1[1]); w.w = cvt_pk_bf16(S1_1[2], S1_1[3]); Sp1_0 = __builtin_bit_cast(bf16x8, w); }
        { u32x4 w; w.x = cvt_pk_bf16(S1_2[0], S1_2[1]); w.y = cvt_pk_bf16(S1_2[2], S1_2[3]); w.z = cvt_pk_bf16(S1_3[0], S1_3[1]); w.w = cvt_pk_bf16(S1_3[2], S1_3[3]); Sp1_1 = __builtin_bit_cast(bf16x8, w); }
        { u32x4 w; w.x = cvt_pk_bf16(S1_4[0], S1_4[1]); w.y = cvt_pk_bf16(S1_4[2], S1_4[3]); w.z = cvt_pk_bf16(S1_5[0], S1_5[1]); w.w = cvt_pk_bf16(S1_5[2], S1_5[3]); Sp1_2 = __builtin_bit_cast(bf16x8, w); }
        { u32x4 w; w.x = cvt_pk_bf16(S1_6[0], S1_6[1]); w.y = cvt_pk_bf16(S1_6[2], S1_6[3]); w.z = cvt_pk_bf16(S1_7[0], S1_7[1]); w.w = cvt_pk_bf16(S1_7[2], S1_7[3]); Sp1_3 = __builtin_bit_cast(bf16x8, w); }
    }
    asm volatile("s_waitcnt vmcnt(0)" ::: "memory");
    } else if constexpr (GDN && ROLE == 1) {
    bf16x8 r0 = (bf16x8){0, 0, 0, 0, 0, 0, 0, 0};
    bf16x8 r1 = (bf16x8){0, 0, 0, 0, 0, 0, 0, 0};
    bf16x8 r2 = (bf16x8){0, 0, 0, 0, 0, 0, 0, 0};
    bf16x8 r3 = (bf16x8){0, 0, 0, 0, 0, 0, 0, 0};
    bf16x8 r4 = (bf16x8){0, 0, 0, 0, 0, 0, 0, 0};
    bf16x8 r5 = (bf16x8){0, 0, 0, 0, 0, 0, 0, 0};
    bf16x8 r6 = (bf16x8){0, 0, 0, 0, 0, 0, 0, 0};
    bf16x8 r7 = (bf16x8){0, 0, 0, 0, 0, 0, 0, 0};
    bf16x8 r8 = (bf16x8){0, 0, 0, 0, 0, 0, 0, 0};
    bf16x8 r9 = (bf16x8){0, 0, 0, 0, 0, 0, 0, 0};
    bf16x8 r10 = (bf16x8){0, 0, 0, 0, 0, 0, 0, 0};
    bf16x8 r11 = (bf16x8){0, 0, 0, 0, 0, 0, 0, 0};
    bf16x8 r12 = (bf16x8){0, 0, 0, 0, 0, 0, 0, 0};
    bf16x8 r13 = (bf16x8){0, 0, 0, 0, 0, 0, 0, 0};
    bf16x8 r14 = (bf16x8){0, 0, 0, 0, 0, 0, 0, 0};
    bf16x8 r15 = (bf16x8){0, 0, 0, 0, 0, 0, 0, 0};
    bf16x8 r16 = (bf16x8){0, 0, 0, 0, 0, 0, 0, 0};
    bf16x8 r17 = (bf16x8){0, 0, 0, 0, 0, 0, 0, 0};
    bf16x8 r18 = (bf16x8){0, 0, 0, 0, 0, 0, 0, 0};
    bf16x8 r19 = (bf16x8){0, 0, 0, 0, 0, 0, 0, 0};
    bf16x8 r20 = (bf16x8){0, 0, 0, 0, 0, 0, 0, 0};
    bf16x8 r21 = (bf16x8){0, 0, 0, 0, 0, 0, 0, 0};
    bf16x8 r22 = (bf16x8){0, 0, 0, 0, 0, 0, 0, 0};
    bf16x8 r23 = (bf16x8){0, 0, 0, 0, 0, 0, 0, 0};
    asm volatile("global_load_dwordx4 %0, %1, off" : "+v"(r0) : "v"((const unsigned char*)(sp0 + ((size_t)(0 + 0) * 56 + 16) * 1024) + voff) : "memory");
    asm volatile("global_load_dwordx4 %0, %1, off" : "+v"(r1) : "v"((const unsigned char*)(sp0 + ((size_t)(0 + 0) * 56 + 17) * 1024) + voff) : "memory");
    asm volatile("global_load_dwordx4 %0, %1, off" : "+v"(r2) : "v"((const unsigned char*)(sp0 + ((size_t)(0 + 0) * 56 + 18) * 1024) + voff) : "memory");
    asm volatile("global_load_dwordx4 %0, %1, off" : "+v"(r3) : "v"((const unsigned char*)(sp0 + ((size_t)(0 + 0) * 56 + 19) * 1024) + voff) : "memory");
    asm volatile("global_load_dwordx4 %0, %1, off" : "+v"(r4) : "v"((const unsigned char*)(sp0 + ((size_t)(0 + 0) * 56 + 20) * 1024) + voff) : "memory");
    asm volatile("global_load_dwordx4 %0, %1, off" : "+v"(r5) : "v"((const unsigned char*)(sp0 + ((size_t)(0 + 0) * 56 + 21) * 1024) + voff) : "memory");
    asm volatile("global_load_dwordx4 %0, %1, off" : "+v"(r6) : "v"((const unsigned char*)(sp0 + ((size_t)(0 + 0) * 56 + 22) * 1024) + voff) : "memory");
    asm volatile("global_load_dwordx4 %0, %1, off" : "+v"(r7) : "v"((const unsigned char*)(sp0 + ((size_t)(0 + 0) * 56 + 23) * 1024) + voff) : "memory");
    asm volatile("global_load_dwordx4 %0, %1, off" : "+v"(r8) : "v"((const unsigned char*)(sp0 + ((size_t)(0 + 0) * 56 + 24) * 1024) + voff) : "memory");
    asm volatile("global_load_dwordx4 %0, %1, off" : "+v"(r9) : "v"((const unsigned char*)(sp0 + ((size_t)(0 + 0) * 56 + 25) * 1024) + voff) : "memory");
    asm volatile("global_load_dwordx4 %0, %1, off" : "+v"(r10) : "v"((const unsigned char*)(sp0 + ((size_t)(0 + 0) * 56 + 26) * 1024) + voff) : "memory");
    asm volatile("global_load_dwordx4 %0, %1, off" : "+v"(r11) : "v"((const unsigned char*)(sp0 + ((size_t)(0 + 0) * 56 + 27) * 1024) + voff) : "memory");
    asm volatile("global_load_dwordx4 %0, %1, off" : "+v"(r12) : "v"((const unsigned char*)(sp0 + ((size_t)(0 + 0) * 56 + 28) * 1024) + voff) : "memory");
    asm volatile("global_load_dwordx4 %0, %1, off" : "+v"(r13) : "v"((const unsigned char*)(sp0 + ((size_t)(0 + 0) * 56 + 29) * 1024) + voff) : "memory");
    asm volatile("global_load_dwordx4 %0, %1, off" : "+v"(r14) : "v"((const unsigned char*)(sp0 + ((size_t)(0 + 0) * 56 + 30) * 1024) + voff) : "memory");
    asm volatile("global_load_dwordx4 %0, %1, off" : "+v"(r15) : "v"((const unsigned char*)(sp0 + ((size_t)(0 + 0) * 56 + 31) * 1024) + voff) : "memory");
    asm volatile("global_load_dwordx4 %0, %1, off" : "+v"(r16) : "v"((const unsigned char*)(sp0 + ((size_t)(0 + 0) * 56 + 32) * 1024) + voff) : "memory");
    asm volatile("global_load_dwordx4 %0, %1, off" : "+v"(r17) : "v"((const unsigned char*)(sp0 + ((size_t)(0 + 0) * 56 + 33) * 1024) + voff) : "memory");
    asm volatile("global_load_dwordx4 %0, %1, off" : "+v"(r18) : "v"((const unsigned char*)(sp0 + ((size_t)(0 + 0) * 56 + 34) * 1024) + voff) : "memory");
    asm volatile("global_load_dwordx4 %0, %1, off" : "+v"(r19) : "v"((const unsigned char*)(sp0 + ((size_t)(0 + 0) * 56 + 35) * 1024) + voff) : "memory");
    asm volatile("global_load_dwordx4 %0, %1, off" : "+v"(r20) : "v"((const unsigned char*)(sp0 + ((size_t)(0 + 0) * 56 + 36) * 1024) + voff) : "memory");
    asm volatile("global_load_dwordx4 %0, %1, off" : "+v"(r21) : "v"((const unsigned char*)(sp0 + ((size_t)(0 + 0) * 56 + 37) * 1024) + voff) : "memory");
    asm volatile("global_load_dwordx4 %0, %1, off" : "+v"(r22) : "v"((const unsigned char*)(sp0 + ((size_t)(0 + 0) * 56 + 38) * 1024) + voff) : "memory");
    asm volatile("global_load_dwordx4 %0, %1, off" : "+v"(r23) : "v"((const unsigned char*)(sp0 + ((size_t)(0 + 0) * 56 + 39) * 1024) + voff) : "memory");
    { unsigned z = 0u;
      asm volatile("global_store_short %0, %1, off" :: "v"((const unsigned char*)(obu + (size_t)(0) * orow + 0) + ooff), "v"(z) : "memory");
      asm volatile("global_store_short %0, %1, off" :: "v"((const unsigned char*)(obu + (size_t)(1) * orow + 0) + ooff), "v"(z) : "memory");
      asm volatile("global_store_short %0, %1, off" :: "v"((const unsigned char*)(obu + (size_t)(2) * orow + 0) + ooff), "v"(z) : "memory");
      asm volatile("global_store_short %0, %1, off" :: "v"((const unsigned char*)(obu + (size_t)(3) * orow + 0) + ooff), "v"(z) : "memory");
      asm volatile("global_store_short %0, %1, off" :: "v"((const unsigned char*)(obu + (size_t)(16) * orow + 0) + ooff), "v"(z) : "memory");
      asm volatile("global_store_short %0, %1, off" :: "v"((const unsigned char*)(obu + (size_t)(17) * orow + 0) + ooff), "v"(z) : "memory");
      asm volatile("global_store_short %0, %1, off" :: "v"((const unsigned char*)(obu + (size_t)(18) * orow + 0) + ooff), "v"(z) : "memory");
      asm volatile("global_store_short %0, %1, off" :: "v"((const unsigned char*)(obu + (size_t)(19) * orow + 0) + ooff), "v"(z) : "memory");
      asm volatile("global_store_short %0, %1, off" :: "v"((const unsigned char*)(obu + (size_t)(32) * orow + 0) + ooff), "v"(z) : "memory");
      asm volatile("global_store_short %0, %1, off" :: "v"((const unsigned char*)(obu + (size_t)(33) * orow + 0) + ooff), "v"(z) : "memory");
      asm volatile("global_store_short %0, %1, off" :: "v"((const unsigned char*)(obu + (size_t)(34) * orow + 0) + ooff), "v"(z) : "memory");
      asm volatile("global_store_short %0, %1, off" :: "v"((const unsigned char*)(obu + (size_t)(35) * orow + 0) + ooff), "v"(z) : "memory");
      asm volatile("global_store_short %0, %1, off" :: "v"((const unsigned char*)(obu + (size_t)(48) * orow + 0) + ooff), "v"(z) : "memory");
      asm volatile("global_store_short %0, %1, off" :: "v"((const unsigned char*)(obu + (size_t)(49) * orow + 0) + ooff), "v"(z) : "memory");
      asm volatile("global_store_short %0, %1, off" :: "v"((const unsigned char*)(obu + (size_t)(50) * orow + 0) + ooff), "v"(z) : "memory");
      asm volatile("global_store_short %0, %1, off" :: "v"((const unsigned char*)(obu + (size_t)(51) * orow + 0) + ooff), "v"(z) : "memory");
      asm volatile("global_store_short %0, %1, off" :: "v"((const unsigned char*)(obu + (size_t)(0) * orow + 32) + ooff), "v"(z) : "memory");
      asm volatile("global_store_short %0, %1, off" :: "v"((const unsigned char*)(obu + (size_t)(1) * orow + 32) + ooff), "v"(z) : "memory");
      asm volatile("global_store_short %0, %1, off" :: "v"((const unsigned char*)(obu + (size_t)(2) * orow + 32) + ooff), "v"(z) : "memory");
      asm volatile("global_store_short %0, %1, off" :: "v"((const unsigned char*)(obu + (size_t)(3) * orow + 32) + ooff), "v"(z) : "memory");
      asm volatile("global_store_short %0, %1, off" :: "v"((const unsigned char*)(obu + (size_t)(16) * orow + 32) + ooff), "v"(z) : "memory");
      asm volatile("global_store_short %0, %1, off" :: "v"((const unsigned char*)(obu + (size_t)(17) * orow + 32) + ooff), "v"(z) : "memory");
      asm volatile("global_store_short %0, %1, off" :: "v"((const unsigned char*)(obu + (size_t)(18) * orow + 32) + ooff), "v"(z) : "memory");
      asm volatile("global_store_short %0, %1, off" :: "v"((const unsigned char*)(obu + (size_t)(19) * orow + 32) + ooff), "v"(z) : "memory");
      asm volatile("global_store_short %0, %1, off" :: "v"((const unsigned char*)(obu + (size_t)(32) * orow + 32) + ooff), "v"(z) : "memory");
      asm volatile("global_store_short %0, %1, off" :: "v"((const unsigned char*)(obu + (size_t)(33) * orow + 32) + ooff), "v"(z) : "memory");
      asm volatile("global_store_short %0, %1, off" :: "v"((const unsigned char*)(obu + (size_t)(34) * orow + 32) + ooff), "v"(z) : "memory");
      asm volatile("global_store_short %0, %1, off" :: "v"((const unsigned char*)(obu + (size_t)(35) * orow + 32) + ooff), "v"(z) : "memory");
      asm volatile("global_store_short %0, %1, off" :: "v"((const unsigned char*)(obu + (size_t)(48) * orow + 32) + ooff), "v"(z) : "memory");
      asm volatile("global_store_short %0, %1, off" :: "v"((const unsigned char*)(obu + (size_t)(49) * orow + 32) + ooff), "v"(z) : "memory");
      asm volatile("global_store_short %0, %1, off" :: "v"((const unsigned char*)(obu + (size_t)(50) * orow + 32) + ooff), "v"(z) : "memory");
      asm volatile("global_store_short %0, %1, off" :: "v"((const unsigned char*)(obu + (size_t)(51) * orow + 32) + ooff), "v"(z) : "memory");
    }
#pragma unroll 1
    for (int n = 0; n < NCH; ++n) {
        { unsigned sp_ = 0; while (*(volatile LAS unsigned*)(xl + XL_CNT) <= (unsigned)n) { __builtin_amdgcn_s_sleep(1); if (++sp_ > (1u << 22)) break; } }
        bf16x8 Sp0_0, Sp0_1, Sp0_2, Sp0_3, vp0_0, vp0_1;
        bf16x8 Sp1_0, Sp1_1, Sp1_2, Sp1_3, vp1_0, vp1_1;
        { const LAS bf16x8* sl_ = (const LAS bf16x8*)(xl + (n & 1) * XL_SLOT) + lane; Sp0_0 = sl_[0]; Sp0_1 = sl_[64]; Sp0_2 = sl_[128]; Sp0_3 = sl_[192]; vp0_0 = sl_[256]; vp0_1 = sl_[320]; Sp1_0 = sl_[384]; Sp1_1 = sl_[448]; Sp1_2 = sl_[512]; Sp1_3 = sl_[576]; vp1_0 = sl_[640]; vp1_1 = sl_[704]; }
        asm volatile("s_waitcnt lgkmcnt(0)" ::: "memory");
        if (lane == 0) *(volatile LAS unsigned*)(xl + XL_CNT + 64) = (unsigned)(n + 1);
        f32x4 o0_0 = {0.f, 0.f, 0.f, 0.f}, o0_1 = o0_0, o0_2 = o0_0, o0_3 = o0_0;
        f32x4 o1_0 = {0.f, 0.f, 0.f, 0.f}, o1_1 = o1_0, o1_2 = o1_0, o1_3 = o1_0;
        asm volatile("s_waitcnt vmcnt(55)" : "+v"(r0));
        o0_0 = mfma16(r0, Sp0_0, o0_0);
        o1_0 = mfma16(r0, Sp1_0, o1_0);
        asm volatile("global_load_dwordx4 %0, %1, off" : "+v"(r0) : "v"((const unsigned char*)(sp0 + ((size_t)(n + 1) * 56 + 16) * 1024) + voff) : "memory");
        __builtin_amdgcn_sched_barrier(0);
        asm volatile("s_waitcnt vmcnt(55)" : "+v"(r1));
        o0_0 = mfma16(r1, Sp0_1, o0_0);
        o1_0 = mfma16(r1, Sp1_1, o1_0);
        asm volatile("global_load_dwordx4 %0, %1, off" : "+v"(r1) : "v"((const unsigned char*)(sp0 + ((size_t)(n + 1) * 56 + 17) * 1024) + voff) : "memory");
        __builtin_amdgcn_sched_barrier(0);
        asm volatile("s_waitcnt vmcnt(55)" : "+v"(r2));
        o0_0 = mfma16(r2, Sp0_2, o0_0);
        o1_0 = mfma16(r2, Sp1_2, o1_0);
        asm volatile("global_load_dwordx4 %0, %1, off" : "+v"(r2) : "v"((const unsigned char*)(sp0 + ((size_t)(n + 1) * 56 + 18) * 1024) + voff) : "memory");
        __builtin_amdgcn_sched_barrier(0);
        asm volatile("s_waitcnt vmcnt(55)" : "+v"(r3));
        o0_0 = mfma16(r3, Sp0_3, o0_0);
        o1_0 = mfma16(r3, Sp1_3, o1_0);
        asm volatile("global_load_dwordx4 %0, %1, off" : "+v"(r3) : "v"((const unsigned char*)(sp0 + ((size_t)(n + 1) * 56 + 19) * 1024) + voff) : "memory");
        __builtin_amdgcn_sched_barrier(0);
        asm volatile("s_waitcnt vmcnt(55)" : "+v"(r4));
        o0_1 = mfma16(r4, Sp0_0, o0_1);
        o1_1 = mfma16(r4, Sp1_0, o1_1);
        asm volatile("global_load_dwordx4 %0, %1, off" : "+v"(r4) : "v"((const unsigned char*)(sp0 + ((size_t)(n + 1) * 56 + 20) * 1024) + voff) : "memory");
        __builtin_amdgcn_sched_barrier(0);
        asm volatile("s_waitcnt vmcnt(55)" : "+v"(r5));
        o0_1 = mfma16(r5, Sp0_1, o0_1);
        o1_1 = mfma16(r5, Sp1_1, o1_1);
        asm volatile("global_load_dwordx4 %0, %1, off" : "+v"(r5) : "v"((const unsigned char*)(sp0 + ((size_t)(n + 1) * 56 + 21) * 1024) + voff) : "memory");
        __builtin_amdgcn_sched_barrier(0);
        asm volatile("s_waitcnt vmcnt(55)" : "+v"(r6));
        o0_1 = mfma16(r6, Sp0_2, o0_1);
        o1_1 = mfma16(r6, Sp1_2, o1_1);
        asm volatile("global_load_dwordx4 %0, %1, off" : "+v"(r6) : "v"((const unsigned char*)(sp0 + ((size_t)(n + 1) * 56 + 22) * 1024) + voff) : "memory");
        __builtin_amdgcn_sched_barrier(0);
        asm volatile("s_waitcnt vmcnt(55)" : "+v"(r7));
        o0_1 = mfma16(r7, Sp0_3, o0_1);
        o1_1 = mfma16(r7, Sp1_3, o1_1);
        asm volatile("global_load_dwordx4 %0, %1, off" : "+v"(r7) : "v"((const unsigned char*)(sp0 + ((size_t)(n + 1) * 56 + 23) * 1024) + voff) : "memory");
        __builtin_amdgcn_sched_barrier(0);
        asm volatile("s_waitcnt vmcnt(55)" : "+v"(r8));
        o0_2 = mfma16(r8, Sp0_0, o0_2);
        o1_2 = mfma16(r8, Sp1_0, o1_2);
        asm volatile("global_load_dwordx4 %0, %1, off" : "+v"(r8) : "v"((const unsigned char*)(sp0 + ((size_t)(n + 1) * 56 + 24) * 1024) + voff) : "memory");
        __builtin_amdgcn_sched_barrier(0);
        asm volatile("s_waitcnt vmcnt(55)" : "+v"(r9));
        o0_2 = mfma16(r9, Sp0_1, o0_2);
        o1_2 = mfma16(r9, Sp1_1, o1_2);
        asm volatile("global_load_dwordx4 %0, %1, off" : "+v"(r9) : "v"((const unsigned char*)(sp0 + ((size_t)(n + 1) * 56 + 25) * 1024) + voff) : "memory");
        __builtin_amdgcn_sched_barrier(0);
        asm volatile("s_waitcnt vmcnt(55)" : "+v"(r10));
        o0_2 = mfma16(r10, Sp0_2, o0_2);
        o1_2 = mfma16(r10, Sp1_2, o1_2);
        asm volatile("global_load_dwordx4 %0, %1, off" : "+v"(r10) : "v"((const unsigned char*)(sp0 + ((size_t)(n + 1) * 56 + 26) * 1024) + voff) : "memory");
        __builtin_amdgcn_sched_barrier(0);
        asm volatile("s_waitcnt vmcnt(55)" : "+v"(r11));
        o0_2 = mfma16(r11, Sp0_3, o0_2);
        o1_2 = mfma16(r11, Sp1_3, o1_2);
        asm volatile("global_load_dwordx4 %0, %1, off" : "+v"(r11) : "v"((const unsigned char*)(sp0 + ((size_t)(n + 1) * 56 + 27) * 1024) + voff) : "memory");
        __builtin_amdgcn_sched_barrier(0);
        asm volatile("s_waitcnt vmcnt(55)" : "+v"(r12));
        o0_3 = mfma16(r12, Sp0_0, o0_3);
        o1_3 = mfma16(r12, Sp1_0, o1_3);
        asm volatile("global_load_dwordx4 %0, %1, off" : "+v"(r12) : "v"((const unsigned char*)(sp0 + ((size_t)(n + 1) * 56 + 28) * 1024) + voff) : "memory");
        __builtin_amdgcn_sched_barrier(0);
        asm volatile("s_waitcnt vmcnt(55)" : "+v"(r13));
        o0_3 = mfma16(r13, Sp0_1, o0_3);
        o1_3 = mfma16(r13, Sp1_1, o1_3);
        asm volatile("global_load_dwordx4 %0, %1, off" : "+v"(r13) : "v"((const unsigned char*)(sp0 + ((size_t)(n + 1) * 56 + 29) * 1024) + voff) : "memory");
        __builtin_amdgcn_sched_barrier(0);
        asm volatile("s_waitcnt vmcnt(55)" : "+v"(r14));
        o0_3 = mfma16(r14, Sp0_2, o0_3);
        o1_3 = mfma16(r14, Sp1_2, o1_3);
        asm volatile("global_load_dwordx4 %0, %1, off" : "+v"(r14) : "v"((const unsigned char*)(sp0 + ((size_t)(n + 1) * 56 + 30) * 1024) + voff) : "memory");
        __builtin_amdgcn_sched_barrier(0);
        asm volatile("s_waitcnt vmcnt(55)" : "+v"(r15));
        o0_3 = mfma16(r15, Sp0_3, o0_3);
        o1_3 = mfma16(r15, Sp1_3, o1_3);
        asm volatile("global_load_dwordx4 %0, %1, off" : "+v"(r15) : "v"((const unsigned char*)(sp0 + ((size_t)(n + 1) * 56 + 31) * 1024) + voff) : "memory");
        __builtin_amdgcn_sched_barrier(0);
        asm volatile("s_waitcnt vmcnt(55)" : "+v"(r16));
        o0_0 = mfma16(r16, vp0_0, o0_0);
        o1_0 = mfma16(r16, vp1_0, o1_0);
        asm volatile("global_load_dwordx4 %0, %1, off" : "+v"(r16) : "v"((const unsigned char*)(sp0 + ((size_t)(n + 1) * 56 + 32) * 1024) + voff) : "memory");
        __builtin_amdgcn_sched_barrier(0);
        asm volatile("s_waitcnt vmcnt(55)" : "+v"(r17));
        o0_0 = mfma16(r17, vp0_1, o0_0);
        o1_0 = mfma16(r17, vp1_1, o1_0);
        asm volatile("global_load_dwordx4 %0, %1, off" : "+v"(r17) : "v"((const unsigned char*)(sp0 + ((size_t)(n + 1) * 56 + 33) * 1024) + voff) : "memory");
        __builtin_amdgcn_sched_barrier(0);
        asm volatile("s_waitcnt vmcnt(55)" : "+v"(r18));
        o0_1 = mfma16(r18, vp0_0, o0_1);
        o1_1 = mfma16(r18, vp1_0, o1_1);
        asm volatile("global_load_dwordx4 %0, %1, off" : "+v"(r18) : "v"((const unsigned char*)(sp0 + ((size_t)(n + 1) * 56 + 34) * 1024) + voff) : "memory");
        __builtin_amdgcn_sched_barrier(0);
        asm volatile("s_waitcnt vmcnt(55)" : "+v"(r19));
        o0_1 = mfma16(r19, vp0_1, o0_1);
        o1_1 = mfma16(r19, vp1_1, o1_1);
        asm volatile("global_load_dwordx4 %0, %1, off" : "+v"(r19) : "v"((const unsigned char*)(sp0 + ((size_t)(n + 1) * 56 + 35) * 1024) + voff) : "memory");
        __builtin_amdgcn_sched_barrier(0);
        asm volatile("s_waitcnt vmcnt(55)" : "+v"(r20));
        o0_2 = mfma16(r20, vp0_0, o0_2);
        o1_2 = mfma16(r20, vp1_0, o1_2);
        asm volatile("global_load_dwordx4 %0, %1, off" : "+v"(r20) : "v"((const unsigned char*)(sp0 + ((size_t)(n + 1) * 56 + 36) * 1024) + voff) : "memory");
        __builtin_amdgcn_sched_barrier(0);
        asm volatile("s_waitcnt vmcnt(55)" : "+v"(r21));
        o0_2 = mfma16(r21, vp0_1, o0_2);
        o1_2 = mfma16(r21, vp1_1, o1_2);
        asm volatile("global_load_dwordx4 %0, %1, off" : "+v"(r21) : "v"((const unsigned char*)(sp0 + ((size_t)(n + 1) * 56 + 37) * 1024) + voff) : "memory");
        __builtin_amdgcn_sched_barrier(0);
        asm volatile("s_waitcnt vmcnt(55)" : "+v"(r22));
        o0_3 = mfma16(r22, vp0_0, o0_3);
        o1_3 = mfma16(r22, vp1_0, o1_3);
        asm volatile("global_load_dwordx4 %0, %1, off" : "+v"(r22) : "v"((const unsigned char*)(sp0 + ((size_t)(n + 1) * 56 + 38) * 1024) + voff) : "memory");
        __builtin_amdgcn_sched_barrier(0);
        asm volatile("s_waitcnt vmcnt(55)" : "+v"(r23));
        o0_3 = mfma16(r23, vp0_1, o0_3);
        o1_3 = mfma16(r23, vp1_1, o1_3);
        asm volatile("global_load_dwordx4 %0, %1, off" : "+v"(r23) : "v"((const unsigned char*)(sp0 + ((size_t)(n + 1) * 56 + 39) * 1024) + voff) : "memory");
        __builtin_amdgcn_sched_barrier(0);
        { const unsigned char* obn = obu + (size_t)n * 64 * orow;
          { const unsigned v = f2bf(o0_0[0]); asm volatile("global_store_short %0, %1, off" :: "v"((const unsigned char*)(obn + (size_t)(0) * orow + 0) + ooff), "v"(v) : "memory"); }
          { const unsigned v = f2bf(o0_0[1]); asm volatile("global_store_short %0, %1, off" :: "v"((const unsigned char*)(obn + (size_t)(1) * orow + 0) + ooff), "v"(v) : "memory"); }
          { const unsigned v = f2bf(o0_0[2]); asm volatile("global_store_short %0, %1, off" :: "v"((const unsigned char*)(obn + (size_t)(2) * orow + 0) + ooff), "v"(v) : "memory"); }
          { const unsigned v = f2bf(o0_0[3]); asm volatile("global_store_short %0, %1, off" :: "v"((const unsigned char*)(obn + (size_t)(3) * orow + 0) + ooff), "v"(v) : "memory"); }
          { const unsigned v = f2bf(o0_1[0]); asm volatile("global_store_short %0, %1, off" :: "v"((const unsigned char*)(obn + (size_t)(16) * orow + 0) + ooff), "v"(v) : "memory"); }
          { const unsigned v = f2bf(o0_1[1]); asm volatile("global_store_short %0, %1, off" :: "v"((const unsigned char*)(obn + (size_t)(17) * orow + 0) + ooff), "v"(v) : "memory"); }
          { const unsigned v = f2bf(o0_1[2]); asm volatile("global_store_short %0, %1, off" :: "v"((const unsigned char*)(obn + (size_t)(18) * orow + 0) + ooff), "v"(v) : "memory"); }
          { const unsigned v = f2bf(o0_1[3]); asm volatile("global_store_short %0, %1, off" :: "v"((const unsigned char*)(obn + (size_t)(19) * orow + 0) + ooff), "v"(v) : "memory"); }
          { const unsigned v = f2bf(o0_2[0]); asm volatile("global_store_short %0, %1, off" :: "v"((const unsigned char*)(obn + (size_t)(32) * orow + 0) + ooff), "v"(v) : "memory"); }
          { const unsigned v = f2bf(o0_2[1]); asm volatile("global_store_short %0, %1, off" :: "v"((const unsigned char*)(obn + (size_t)(33) * orow + 0) + ooff), "v"(v) : "memory"); }
          { const unsigned v = f2bf(o0_2[2]); asm volatile("global_store_short %0, %1, off" :: "v"((const unsigned char*)(obn + (size_t)(34) * orow + 0) + ooff), "v"(v) : "memory"); }
          { const unsigned v = f2bf(o0_2[3]); asm volatile("global_store_short %0, %1, off" :: "v"((const unsigned char*)(obn + (size_t)(35) * orow + 0) + ooff), "v"(v) : "memory"); }
          { const unsigned v = f2bf(o0_3[0]); asm volatile("global_store_short %0, %1, off" :: "v"((const unsigned char*)(obn + (size_t)(48) * orow + 0) + ooff), "v"(v) : "memory"); }
          { const unsigned v = f2bf(o0_3[1]); asm volatile("global_store_short %0, %1, off" :: "v"((const unsigned char*)(obn + (size_t)(49) * orow + 0) + ooff), "v"(v) : "memory"); }
          { const unsigned v = f2bf(o0_3[2]); asm volatile("global_store_short %0, %1, off" :: "v"((const unsigned char*)(obn + (size_t)(50) * orow + 0) + ooff), "v"(v) : "memory"); }
          { const unsigned v = f2bf(o0_3[3]); asm volatile("global_store_short %0, %1, off" :: "v"((const unsigned char*)(obn + (size_t)(51) * orow + 0) + ooff), "v"(v) : "memory"); }
          { const unsigned v = f2bf(o1_0[0]); asm volatile("global_store_short %0, %1, off" :: "v"((const unsigned char*)(obn + (size_t)(0) * orow + 32) + ooff), "v"(v) : "memory"); }
          { const unsigned v = f2bf(o1_0[1]); asm volatile("global_store_short %0, %1, off" :: "v"((const unsigned char*)(obn + (size_t)(1) * orow + 32) + ooff), "v"(v) : "memory"); }
          { const unsigned v = f2bf(o1_0[2]); asm volatile("global_store_short %0, %1, off" :: "v"((const unsigned char*)(obn + (size_t)(2) * orow + 32) + ooff), "v"(v) : "memory"); }
          { const unsigned v = f2bf(o1_0[3]); asm volatile("global_store_short %0, %1, off" :: "v"((const unsigned char*)(obn + (size_t)(3) * orow + 32) + ooff), "v"(v) : "memory"); }
          { const unsigned v = f2bf(o1_1[0]); asm volatile("global_store_short %0, %1, off" :: "v"((const unsigned char*)(obn + (size_t)(16) * orow + 32) + ooff), "v"(v) : "memory"); }
          { const unsigned v = f2bf(o1_1[1]); asm volatile("global_store_short %0, %1, off" :: "v"((const unsigned char*)(obn + (size_t)(17) * orow + 32) + ooff), "v"(v) : "memory"); }
          { const unsigned v = f2bf(o1_1[2]); asm volatile("global_store_short %0, %1, off" :: "v"((const unsigned char*)(obn + (size_t)(18) * orow + 32) + ooff), "v"(v) : "memory"); }
          { const unsigned v = f2bf(o1_1[3]); asm volatile("global_store_short %0, %1, off" :: "v"((const unsigned char*)(obn + (size_t)(19) * orow + 32) + ooff), "v"(v) : "memory"); }
          { const unsigned v = f2bf(o1_2[0]); asm volatile("global_store_short %0, %1, off" :: "v"((const unsigned char*)(obn + (size_t)(32) * orow + 32) + ooff), "v"(v) : "memory"); }
          { const unsigned v = f2bf(o1_2[1]); asm volatile("global_store_short %0, %1, off" :: "v"((const unsigned char*)(obn + (size_t)(33) * orow + 32) + ooff), "v"(v) : "memory"); }
          { const unsigned v = f2bf(o1_2[2]); asm volatile("global_store_short %0, %1, off" :: "v"((const unsigned char*)(obn + (size_t)(34) * orow + 32) + ooff), "v"(v) : "memory"); }
          { const unsigned v = f2bf(o1_2[3]); asm volatile("global_store_short %0, %1, off" :: "v"((const unsigned char*)(obn + (size_t)(35) * orow + 32) + ooff), "v"(v) : "memory"); }
          { const unsigned v = f2bf(o1_3[0]); asm volatile("global_store_short %0, %1, off" :: "v"((const unsigned char*)(obn + (size_t)(48) * orow + 32) + ooff), "v"(v) : "memory"); }
          { const unsigned v = f2bf(o1_3[1]); asm volatile("global_store_short %0, %1, off" :: "v"((const unsigned char*)(obn + (size_t)(49) * orow + 32) + ooff), "v"(v) : "memory"); }
          { const unsigned v = f2bf(o1_3[2]); asm volatile("global_store_short %0, %1, off" :: "v"((const unsigned char*)(obn + (size_t)(50) * orow + 32) + ooff), "v"(v) : "memory"); }
          { const unsigned v = f2bf(o1_3[3]); asm volatile("global_store_short %0, %1, off" :: "v"((const unsigned char*)(obn + (size_t)(51) * orow + 32) + ooff), "v"(v) : "memory"); }
        }
        __builtin_amdgcn_sched_barrier(0);
    }
    asm volatile("s_waitcnt vmcnt(0)" ::: "memory");
    } else if constexpr (!GDN && ROLE == 0) {
    bf16x8 r0 = (bf16x8){0, 0, 0, 0, 0, 0, 0, 0};
    bf16x8 r1 = (bf16x8){0, 0, 0, 0, 0, 0, 0, 0};
    bf16x8 r2 = (bf16x8){0, 0, 0, 0, 0, 0, 0, 0};
    bf16x8 r3 = (bf16x8){0, 0, 0, 0, 0, 0, 0, 0};
    bf16x8 r4 = (bf16x8){0, 0, 0, 0, 0, 0, 0, 0};
    bf16x8 r5 = (bf16x8){0, 0, 0, 0, 0, 0, 0, 0};
    bf16x8 r6 = (bf16x8){0, 0, 0, 0, 0, 0, 0, 0};
    bf16x8 r7 = (bf16x8){0, 0, 0, 0, 0, 0, 0, 0};
    bf16x8 r8 = (bf16x8){0, 0, 0, 0, 0, 0, 0, 0};
    bf16x8 r9 = (bf16x8){0, 0, 0, 0, 0, 0, 0, 0};
    bf16x8 r10 = (bf16x8){0, 0, 0, 0, 0, 0, 0, 0};
    bf16x8 r11 = (bf16x8){0, 0, 0, 0, 0, 0, 0, 0};
    bf16x8 r12 = (bf16x8){0, 0, 0, 0, 0, 0, 0, 0};
    bf16x8 r13 = (bf16x8){0, 0, 0, 0, 0, 0, 0, 0};
    bf16x8 r14 = (bf16x8){0, 0, 0, 0, 0, 0, 0, 0};
    bf16x8 r15 = (bf16x8){0, 0, 0, 0, 0, 0, 0, 0};
    f32x4 S0_0 = {0.f, 0.f, 0.f, 0.f};
    f32x4 S0_1 = {0.f, 0.f, 0.f, 0.f};
    f32x4 S0_2 = {0.f, 0.f, 0.f, 0.f};
    f32x4 S0_3 = {0.f, 0.f, 0.f, 0.f};
    f32x4 S0_4 = {0.f, 0.f, 0.f, 0.f};
    f32x4 S0_5 = {0.f, 0.f, 0.f, 0.f};
    f32x4 S0_6 = {0.f, 0.f, 0.f, 0.f};
    f32x4 S0_7 = {0.f, 0.f, 0.f, 0.f};
    bf16x8 Sp0_0 = (bf16x8){0, 0, 0, 0, 0, 0, 0, 0};
    bf16x8 Sp0_1 = (bf16x8){0, 0, 0, 0, 0, 0, 0, 0};
    bf16x8 Sp0_2 = (bf16x8){0, 0, 0, 0, 0, 0, 0, 0};
    bf16x8 Sp0_3 = (bf16x8){0, 0, 0, 0, 0, 0, 0, 0};
    f32x4 S1_0 = {0.f, 0.f, 0.f, 0.f};
    f32x4 S1_1 = {0.f, 0.f, 0.f, 0.f};
    f32x4 S1_2 = {0.f, 0.f, 0.f, 0.f};
    f32x4 S1_3 = {0.f, 0.f, 0.f, 0.f};
    f32x4 S1_4 = {0.f, 0.f, 0.f, 0.f};
    f32x4 S1_5 = {0.f, 0.f, 0.f, 0.f};
    f32x4 S1_6 = {0.f, 0.f, 0.f, 0.f};
    f32x4 S1_7 = {0.f, 0.f, 0.f, 0.f};
    bf16x8 Sp1_0 = (bf16x8){0, 0, 0, 0, 0, 0, 0, 0};
    bf16x8 Sp1_1 = (bf16x8){0, 0, 0, 0, 0, 0, 0, 0};
    bf16x8 Sp1_2 = (bf16x8){0, 0, 0, 0, 0, 0, 0, 0};
    bf16x8 Sp1_3 = (bf16x8){0, 0, 0, 0, 0, 0, 0, 0};
    unsigned vn0_0 = 0u, vn0_1 = 0u, vn0_2 = 0u, vn0_3 = 0u, vn0_4 = 0u, vn0_5 = 0u, vn0_6 = 0u, vn0_7 = 0u, vn0_8 = 0u, vn0_9 = 0u, vn0_10 = 0u, vn0_11 = 0u, vn0_12 = 0u, vn0_13 = 0u, vn0_14 = 0u, vn0_15 = 0u;
    unsigned vn1_0 = 0u, vn1_1 = 0u, vn1_2 = 0u, vn1_3 = 0u, vn1_4 = 0u, vn1_5 = 0u, vn1_6 = 0u, vn1_7 = 0u, vn1_8 = 0u, vn1_9 = 0u, vn1_10 = 0u, vn1_11 = 0u, vn1_12 = 0u, vn1_13 = 0u, vn1_14 = 0u, vn1_15 = 0u;
    { const int n = 0; (void)n;
    asm volatile("global_load_ushort %0, %1, off" : "+v"(vn0_0) : "v"((const unsigned char*)(vbu + (size_t)(0) * vrow + 0) + voff2) : "memory");
    asm volatile("global_load_ushort %0, %1, off" : "+v"(vn0_1) : "v"((const unsigned char*)(vbu + (size_t)(1) * vrow + 0) + voff2) : "memory");
    asm volatile("global_load_ushort %0, %1, off" : "+v"(vn0_2) : "v"((const unsigned char*)(vbu + (size_t)(2) * vrow + 0) + voff2) : "memory");
    asm volatile("global_load_ushort %0, %1, off" : "+v"(vn0_3) : "v"((const unsigned char*)(vbu + (size_t)(3) * vrow + 0) + voff2) : "memory");
    asm volatile("global_load_ushort %0, %1, off" : "+v"(vn0_4) : "v"((const unsigned char*)(vbu + (size_t)(16) * vrow + 0) + voff2) : "memory");
    asm volatile("global_load_ushort %0, %1, off" : "+v"(vn0_5) : "v"((const unsigned char*)(vbu + (size_t)(17) * vrow + 0) + voff2) : "memory");
    asm volatile("global_load_ushort %0, %1, off" : "+v"(vn0_6) : "v"((const unsigned char*)(vbu + (size_t)(18) * vrow + 0) + voff2) : "memory");
    asm volatile("global_load_ushort %0, %1, off" : "+v"(vn0_7) : "v"((const unsigned char*)(vbu + (size_t)(19) * vrow + 0) + voff2) : "memory");
    asm volatile("global_load_ushort %0, %1, off" : "+v"(vn0_8) : "v"((const unsigned char*)(vbu + (size_t)(32) * vrow + 0) + voff2) : "memory");
    asm volatile("global_load_ushort %0, %1, off" : "+v"(vn0_9) : "v"((const unsigned char*)(vbu + (size_t)(33) * vrow + 0) + voff2) : "memory");
    asm volatile("global_load_ushort %0, %1, off" : "+v"(vn0_10) : "v"((const unsigned char*)(vbu + (size_t)(34) * vrow + 0) + voff2) : "memory");
    asm volatile("global_load_ushort %0, %1, off" : "+v"(vn0_11) : "v"((const unsigned char*)(vbu + (size_t)(35) * vrow + 0) + voff2) : "memory");
    asm volatile("global_load_ushort %0, %1, off" : "+v"(vn0_12) : "v"((const unsigned char*)(vbu + (size_t)(48) * vrow + 0) + voff2) : "memory");
    asm volatile("global_load_ushort %0, %1, off" : "+v"(vn0_13) : "v"((const unsigned char*)(vbu + (size_t)(49) * vrow + 0) + voff2) : "memory");
    asm volatile("global_load_ushort %0, %1, off" : "+v"(vn0_14) : "v"((const unsigned char*)(vbu + (size_t)(50) * vrow + 0) + voff2) : "memory");
    asm volatile("global_load_ushort %0, %1, off" : "+v"(vn0_15) : "v"((const unsigned char*)(vbu + (size_t)(51) * vrow + 0) + voff2) : "memory");
    asm volatile("global_load_ushort %0, %1, off" : "+v"(vn1_0) : "v"((const unsigned char*)(vbu + (size_t)(0) * vrow + 32) + voff2) : "memory");
    asm volatile("global_load_ushort %0, %1, off" : "+v"(vn1_1) : "v"((const unsigned char*)(vbu + (size_t)(1) * vrow + 32) + voff2) : "memory");
    asm volatile("global_load_ushort %0, %1, off" : "+v"(vn1_2) : "v"((const unsigned char*)(vbu + (size_t)(2) * vrow + 32) + voff2) : "memory");
    asm volatile("global_load_ushort %0, %1, off" : "+v"(vn1_3) : "v"((const unsigned char*)(vbu + (size_t)(3) * vrow + 32) + voff2) : "memory");
    asm volatile("global_load_ushort %0, %1, off" : "+v"(vn1_4) : "v"((const unsigned char*)(vbu + (size_t)(16) * vrow + 32) + voff2) : "memory");
    asm volatile("global_load_ushort %0, %1, off" : "+v"(vn1_5) : "v"((const unsigned char*)(vbu + (size_t)(17) * vrow + 32) + voff2) : "memory");
    asm volatile("global_load_ushort %0, %1, off" : "+v"(vn1_6) : "v"((const unsigned char*)(vbu + (size_t)(18) * vrow + 32) + voff2) : "memory");
    asm volatile("global_load_ushort %0, %1, off" : "+v"(vn1_7) : "v"((const unsigned char*)(vbu + (size_t)(19) * vrow + 32) + voff2) : "memory");
    asm volatile("global_load_ushort %0, %1, off" : "+v"(vn1_8) : "v"((const unsigned char*)(vbu + (size_t)(32) * vrow + 32) + voff2) : "memory");
    asm volatile("global_load_ushort %0, %1, off" : "+v"(vn1_9) : "v"((const unsigned char*)(vbu + (size_t)(33) * vrow + 32) + voff2) : "memory");
    asm volatile("global_load_ushort %0, %1, off" : "+v"(vn1_10) : "v"((const unsigned char*)(vbu + (size_t)(34) * vrow + 32) + voff2) : "memory");
    asm volatile("global_load_ushort %0, %1, off" : "+v"(vn1_11) : "v"((const unsigned char*)(vbu + (size_t)(35) * vrow + 32) + voff2) : "memory");
    asm volatile("global_load_ushort %0, %1, off" : "+v"(vn1_12) : "v"((const unsigned char*)(vbu + (size_t)(48) * vrow + 32) + voff2) : "memory");
    asm volatile("global_load_ushort %0, %1, off" : "+v"(vn1_13) : "v"((const unsigned char*)(vbu + (size_t)(49) * vrow + 32) + voff2) : "memory");
    asm volatile("global_load_ushort %0, %1, off" : "+v"(vn1_14) : "v"((const unsigned char*)(vbu + (size_t)(50) * vrow + 32) + voff2) : "memory");
    asm volatile("global_load_ushort %0, %1, off" : "+v"(vn1_15) : "v"((const unsigned char*)(vbu + (size_t)(51) * vrow + 32) + voff2) : "memory");
    asm volatile("global_load_dwordx4 %0, %1, off" : "+v"(r0) : "v"((const unsigned char*)(sp0 + ((size_t)(n + 0) * 40 + 24) * 1024) + voff) : "memory");
    asm volatile("global_load_dwordx4 %0, %1, off" : "+v"(r1) : "v"((const unsigned char*)(sp0 + ((size_t)(n + 0) * 40 + 25) * 1024) + voff) : "memory");
    asm volatile("global_load_dwordx4 %0, %1, off" : "+v"(r2) : "v"((const unsigned char*)(sp0 + ((size_t)(n + 0) * 40 + 26) * 1024) + voff) : "memory");
    asm volatile("global_load_dwordx4 %0, %1, off" : "+v"(r3) : "v"((const unsigned char*)(sp0 + ((size_t)(n + 0) * 40 + 27) * 1024) + voff) : "memory");
    asm volatile("global_load_dwordx4 %0, %1, off" : "+v"(r4) : "v"((const unsigned char*)(sp0 + ((size_t)(n + 0) * 40 + 28) * 1024) + voff) : "memory");
    asm volatile("global_load_dwordx4 %0, %1, off" : "+v"(r5) : "v"((const unsigned char*)(sp0 + ((size_t)(n + 0) * 40 + 29) * 1024) + voff) : "memory");
    asm volatile("global_load_dwordx4 %0, %1, off" : "+v"(r6) : "v"((const unsigned char*)(sp0 + ((size_t)(n + 0) * 40 + 30) * 1024) + voff) : "memory");
    asm volatile("global_load_dwordx4 %0, %1, off" : "+v"(r7) : "v"((const unsigned char*)(sp0 + ((size_t)(n + 0) * 40 + 31) * 1024) + voff) : "memory");
    asm volatile("global_load_dwordx4 %0, %1, off" : "+v"(r8) : "v"((const unsigned char*)(sp0 + ((size_t)(n + 0) * 40 + 32) * 1024) + voff) : "memory");
    asm volatile("global_load_dwordx4 %0, %1, off" : "+v"(r9) : "v"((const unsigned char*)(sp0 + ((size_t)(n + 0) * 40 + 33) * 1024) + voff) : "memory");
    asm volatile("global_load_dwordx4 %0, %1, off" : "+v"(r10) : "v"((const unsigned char*)(sp0 + ((size_t)(n + 0) * 40 + 34) * 1024) + voff) : "memory");
    asm volatile("global_load_dwordx4 %0, %1, off" : "+v"(r11) : "v"((const unsigned char*)(sp0 + ((size_t)(n + 0) * 40 + 35) * 1024) + voff) : "memory");
    asm volatile("global_load_dwordx4 %0, %1, off" : "+v"(r12) : "v"((const unsigned char*)(sp0 + ((size_t)(n + 0) * 40 + 36) * 1024) + voff) : "memory");
    asm volatile("global_load_dwordx4 %0, %1, off" : "+v"(r13) : "v"((const unsigned char*)(sp0 + ((size_t)(n + 0) * 40 + 37) * 1024) + voff) : "memory");
    asm volatile("global_load_dwordx4 %0, %1, off" : "+v"(r14) : "v"((const unsigned char*)(sp0 + ((size_t)(n + 0) * 40 + 38) * 1024) + voff) : "memory");
    asm volatile("global_load_dwordx4 %0, %1, off" : "+v"(r15) : "v"((const unsigned char*)(sp0 + ((size_t)(n + 0) * 40 + 39) * 1024) + voff) : "memory");
    }
#pragma unroll 1
    for (int n = 0; n < NCH; ++n) {
        const int nn = n + 1 < NCH ? n + 1 : n;
        f32x4 a0_0, a0_1, a0_2, a0_3;
        f32x4 a1_0, a1_1, a1_2, a1_3;
        asm volatile("s_waitcnt vmcnt(16)" : "+v"(vn0_0), "+v"(vn0_1), "+v"(vn0_2), "+v"(vn0_3), "+v"(vn0_4), "+v"(vn0_5), "+v"(vn0_6), "+v"(vn0_7), "+v"(vn0_8), "+v"(vn0_9), "+v"(vn0_10), "+v"(vn0_11), "+v"(vn0_12), "+v"(vn0_13), "+v"(vn0_14), "+v"(vn0_15));
        asm volatile("s_waitcnt vmcnt(16)" : "+v"(vn1_0), "+v"(vn1_1), "+v"(vn1_2), "+v"(vn1_3), "+v"(vn1_4), "+v"(vn1_5), "+v"(vn1_6), "+v"(vn1_7), "+v"(vn1_8), "+v"(vn1_9), "+v"(vn1_10), "+v"(vn1_11), "+v"(vn1_12), "+v"(vn1_13), "+v"(vn1_14), "+v"(vn1_15));
        a0_0 = (f32x4){__builtin_bit_cast(float, vn0_0 << 16), __builtin_bit_cast(float, vn0_1 << 16), __builtin_bit_cast(float, vn0_2 << 16), __builtin_bit_cast(float, vn0_3 << 16)};
        a0_1 = (f32x4){__builtin_bit_cast(float, vn0_4 << 16), __builtin_bit_cast(float, vn0_5 << 16), __builtin_bit_cast(float, vn0_6 << 16), __builtin_bit_cast(float, vn0_7 << 16)};
        a0_2 = (f32x4){__builtin_bit_cast(float, vn0_8 << 16), __builtin_bit_cast(float, vn0_9 << 16), __builtin_bit_cast(float, vn0_10 << 16), __builtin_bit_cast(float, vn0_11 << 16)};
        a0_3 = (f32x4){__builtin_bit_cast(float, vn0_12 << 16), __builtin_bit_cast(float, vn0_13 << 16), __builtin_bit_cast(float, vn0_14 << 16), __builtin_bit_cast(float, vn0_15 << 16)};
        a1_0 = (f32x4){__builtin_bit_cast(float, vn1_0 << 16), __builtin_bit_cast(float, vn1_1 << 16), __builtin_bit_cast(float, vn1_2 << 16), __builtin_bit_cast(float, vn1_3 << 16)};
        a1_1 = (f32x4){__builtin_bit_cast(float, vn1_4 << 16), __builtin_bit_cast(float, vn1_5 << 16), __builtin_bit_cast(float, vn1_6 << 16), __builtin_bit_cast(float, vn1_7 << 16)};
        a1_2 = (f32x4){__builtin_bit_cast(float, vn1_8 << 16), __builtin_bit_cast(float, vn1_9 << 16), __builtin_bit_cast(float, vn1_10 << 16), __builtin_bit_cast(float, vn1_11 << 16)};
        a1_3 = (f32x4){__builtin_bit_cast(float, vn1_12 << 16), __builtin_bit_cast(float, vn1_13 << 16), __builtin_bit_cast(float, vn1_14 << 16), __builtin_bit_cast(float, vn1_15 << 16)};
        const float dec = decr;
        { const unsigned char* vbn = vbu + (size_t)nn * 64 * vrow;
          asm volatile("global_load_ushort %0, %1, off" : "+v"(vn0_0) : "v"((const unsigned char*)(vbn + (size_t)(0) * vrow + 0) + voff2) : "memory");
          asm volatile("global_load_ushort %0, %1, off" : "+v"(vn0_1) : "v"((const unsigned char*)(vbn + (size_t)(1) * vrow + 0) + voff2) : "memory");
          asm volatile("global_load_ushort %0, %1, off" : "+v"(vn0_2) : "v"((const unsigned char*)(vbn + (size_t)(2) * vrow + 0) + voff2) : "memory");
          asm volatile("global_load_ushort %0, %1, off" : "+v"(vn0_3) : "v"((const unsigned char*)(vbn + (size_t)(3) * vrow + 0) + voff2) : "memory");
          asm volatile("global_load_ushort %0, %1, off" : "+v"(vn0_4) : "v"((const unsigned char*)(vbn + (size_t)(16) * vrow + 0) + voff2) : "memory");
          asm volatile("global_load_ushort %0, %1, off" : "+v"(vn0_5) : "v"((const unsigned char*)(vbn + (size_t)(17) * vrow + 0) + voff2) : "memory");
          asm volatile("global_load_ushort %0, %1, off" : "+v"(vn0_6) : "v"((const unsigned char*)(vbn + (size_t)(18) * vrow + 0) + voff2) : "memory");
          asm volatile("global_load_ushort %0, %1, off" : "+v"(vn0_7) : "v"((const unsigned char*)(vbn + (size_t)(19) * vrow + 0) + voff2) : "memory");
          asm volatile("global_load_ushort %0, %1, off" : "+v"(vn0_8) : "v"((const unsigned char*)(vbn + (size_t)(32) * vrow + 0) + voff2) : "memory");
          asm volatile("global_load_ushort %0, %1, off" : "+v"(vn0_9) : "v"((const unsigned char*)(vbn + (size_t)(33) * vrow + 0) + voff2) : "memory");
          asm volatile("global_load_ushort %0, %1, off" : "+v"(vn0_10) : "v"((const unsigned char*)(vbn + (size_t)(34) * vrow + 0) + voff2) : "memory");
          asm volatile("global_load_ushort %0, %1, off" : "+v"(vn0_11) : "v"((const unsigned char*)(vbn + (size_t)(35) * vrow + 0) + voff2) : "memory");
          asm volatile("global_load_ushort %0, %1, off" : "+v"(vn0_12) : "v"((const unsigned char*)(vbn + (size_t)(48) * vrow + 0) + voff2) : "memory");
          asm volatile("global_load_ushort %0, %1, off" : "+v"(vn0_13) : "v"((const unsigned char*)(vbn + (size_t)(49) * vrow + 0) + voff2) : "memory");
          asm volatile("global_load_ushort %0, %1, off" : "+v"(vn0_14) : "v"((const unsigned char*)(vbn + (size_t)(50) * vrow + 0) + voff2) : "memory");
          asm volatile("global_load_ushort %0, %1, off" : "+v"(vn0_15) : "v"((const unsigned char*)(vbn + (size_t)(51) * vrow + 0) + voff2) : "memory");
          asm volatile("global_load_ushort %0, %1, off" : "+v"(vn1_0) : "v"((const unsigned char*)(vbn + (size_t)(0) * vrow + 32) + voff2) : "memory");
          asm volatile("global_load_ushort %0, %1, off" : "+v"(vn1_1) : "v"((const unsigned char*)(vbn + (size_t)(1) * vrow + 32) + voff2) : "memory");
          asm volatile("global_load_ushort %0, %1, off" : "+v"(vn1_2) : "v"((const unsigned char*)(vbn + (size_t)(2) * vrow + 32) + voff2) : "memory");
          asm volatile("global_load_ushort %0, %1, off" : "+v"(vn1_3) : "v"((const unsigned char*)(vbn + (size_t)(3) * vrow + 32) + voff2) : "memory");
          asm volatile("global_load_ushort %0, %1, off" : "+v"(vn1_4) : "v"((const unsigned char*)(vbn + (size_t)(16) * vrow + 32) + voff2) : "memory");
          asm volatile("global_load_ushort %0, %1, off" : "+v"(vn1_5) : "v"((const unsigned char*)(vbn + (size_t)(17) * vrow + 32) + voff2) : "memory");
          asm volatile("global_load_ushort %0, %1, off" : "+v"(vn1_6) : "v"((const unsigned char*)(vbn + (size_t)(18) * vrow + 32) + voff2) : "memory");
          asm volatile("global_load_ushort %0, %1, off" : "+v"(vn1_7) : "v"((const unsigned char*)(vbn + (size_t)(19) * vrow + 32) + voff2) : "memory");
          asm volatile("global_load_ushort %0, %1, off" : "+v"(vn1_8) : "v"((const unsigned char*)(vbn + (size_t)(32) * vrow + 32) + voff2) : "memory");
          asm volatile("global_load_ushort %0, %1, off" : "+v"(vn1_9) : "v"((const unsigned char*)(vbn + (size_t)(33) * vrow + 32) + voff2) : "memory");
          asm volatile("global_load_ushort %0, %1, off" : "+v"(vn1_10) : "v"((const unsigned char*)(vbn + (size_t)(34) * vrow + 32) + voff2) : "memory");
          asm volatile("global_load_ushort %0, %1, off" : "+v"(vn1_11) : "v"((const unsigned char*)(vbn + (size_t)(35) * vrow + 32) + voff2) : "memory");
          asm volatile("global_load_ushort %0, %1, off" : "+v"(vn1_12) : "v"((const unsigned char*)(vbn + (size_t)(48) * vrow + 32) + voff2) : "memory");
          asm volatile("global_load_ushort %0, %1, off" : "+v"(vn1_13) : "v"((const unsigned char*)(vbn + (size_t)(49) * vrow + 32) + voff2) : "memory");
          asm volatile("global_load_ushort %0, %1, off" : "+v"(vn1_14) : "v"((const unsigned char*)(vbn + (size_t)(50) * vrow + 32) + voff2) : "memory");
          asm volatile("global_load_ushort %0, %1, off" : "+v"(vn1_15) : "v"((const unsigned char*)(vbn + (size_t)(51) * vrow + 32) + voff2) : "memory");
        }
        __builtin_amdgcn_sched_barrier(0);
        bf16x8 vp0_0, vp0_1;
        { u32x4 w; w.x = cvt_pk_bf16(a0_0[0], a0_0[1]); w.y = cvt_pk_bf16(a0_0[2], a0_0[3]); w.z = cvt_pk_bf16(a0_1[0], a0_1[1]); w.w = cvt_pk_bf16(a0_1[2], a0_1[3]); vp0_0 = __builtin_bit_cast(bf16x8, w); }
        { u32x4 w; w.x = cvt_pk_bf16(a0_2[0], a0_2[1]); w.y = cvt_pk_bf16(a0_2[2], a0_2[3]); w.z = cvt_pk_bf16(a0_3[0], a0_3[1]); w.w = cvt_pk_bf16(a0_3[2], a0_3[3]); vp0_1 = __builtin_bit_cast(bf16x8, w); }
        bf16x8 vp1_0, vp1_1;
        { u32x4 w; w.x = cvt_pk_bf16(a1_0[0], a1_0[1]); w.y = cvt_pk_bf16(a1_0[2], a1_0[3]); w.z = cvt_pk_bf16(a1_1[0], a1_1[1]); w.w = cvt_pk_bf16(a1_1[2], a1_1[3]); vp1_0 = __builtin_bit_cast(bf16x8, w); }
        { u32x4 w; w.x = cvt_pk_bf16(a1_2[0], a1_2[1]); w.y = cvt_pk_bf16(a1_2[2], a1_2[3]); w.z = cvt_pk_bf16(a1_3[0], a1_3[1]); w.w = cvt_pk_bf16(a1_3[2], a1_3[3]); vp1_1 = __builtin_bit_cast(bf16x8, w); }
        { unsigned sp_ = 0; while (*(volatile LAS unsigned*)(xl + XL_CNT + 64) + 2u <= (unsigned)n) { __builtin_amdgcn_s_sleep(1); if (++sp_ > (1u << 22)) break; } }
        { LAS bf16x8* sl_ = (LAS bf16x8*)(xl + (n & 1) * XL_SLOT) + lane; sl_[0] = Sp0_0; sl_[64] = Sp0_1; sl_[128] = Sp0_2; sl_[192] = Sp0_3; sl_[256] = vp0_0; sl_[320] = vp0_1; sl_[384] = Sp1_0; sl_[448] = Sp1_1; sl_[512] = Sp1_2; sl_[576] = Sp1_3; sl_[640] = vp1_0; sl_[704] = vp1_1; }
        asm volatile("s_waitcnt lgkmcnt(0)" ::: "memory");
        if (lane == 0) *(volatile LAS unsigned*)(xl + XL_CNT) = (unsigned)(n + 1);
        S0_0 = S0_0 * dec;
        S1_0 = S1_0 * dec;
        asm volatile("s_waitcnt vmcnt(47)" : "+v"(r0));
        S0_0 = mfma16(r0, vp0_0, S0_0);
        S1_0 = mfma16(r0, vp1_0, S1_0);
        asm volatile("global_load_dwordx4 %0, %1, off" : "+v"(r0) : "v"((const unsigned char*)(sp0 + ((size_t)(n + 1) * 40 + 24) * 1024) + voff) : "memory");
        __builtin_amdgcn_sched_barrier(0);
        asm volatile("s_waitcnt vmcnt(47)" : "+v"(r1));
        S0_0 = mfma16(r1, vp0_1, S0_0);
        S1_0 = mfma16(r1, vp1_1, S1_0);
        asm volatile("global_load_dwordx4 %0, %1, off" : "+v"(r1) : "v"((const unsigned char*)(sp0 + ((size_t)(n + 1) * 40 + 25) * 1024) + voff) : "memory");
        __builtin_amdgcn_sched_barrier(0);
        S0_1 = S0_1 * dec;
        S1_1 = S1_1 * dec;
        asm volatile("s_waitcnt vmcnt(47)" : "+v"(r2));
        S0_1 = mfma16(r2, vp0_0, S0_1);
        S1_1 = mfma16(r2, vp1_0, S1_1);
        asm volatile("global_load_dwordx4 %0, %1, off" : "+v"(r2) : "v"((const unsigned char*)(sp0 + ((size_t)(n + 1) * 40 + 26) * 1024) + voff) : "memory");
        __builtin_amdgcn_sched_barrier(0);
        asm volatile("s_waitcnt vmcnt(47)" : "+v"(r3));
        S0_1 = mfma16(r3, vp0_1, S0_1);
        S1_1 = mfma16(r3, vp1_1, S1_1);
        asm volatile("global_load_dwordx4 %0, %1, off" : "+v"(r3) : "v"((const unsigned char*)(sp0 + ((size_t)(n + 1) * 40 + 27) * 1024) + voff) : "memory");
        __builtin_amdgcn_sched_barrier(0);
        S0_2 = S0_2 * dec;
        S1_2 = S1_2 * dec;
        asm volatile("s_waitcnt vmcnt(47)" : "+v"(r4));
        S0_2 = mfma16(r4, vp0_0, S0_2);
        S1_2 = mfma16(r4, vp1_0, S1_2);
        asm volatile("global_load_dwordx4 %0, %1, off" : "+v"(r4) : "v"((const unsigned char*)(sp0 + ((size_t)(n + 1) * 40 + 28) * 1024) + voff) : "memory");
        __builtin_amdgcn_sched_barrier(0);
        asm volatile("s_waitcnt vmcnt(47)" : "+v"(r5));
        S0_2 = mfma16(r5, vp0_1, S0_2);
        S1_2 = mfma16(r5, vp1_1, S1_2);
        asm volatile("global_load_dwordx4 %0, %1, off" : "+v"(r5) : "v"((const unsigned char*)(sp0 + ((size_t)(n + 1) * 40 + 29) * 1024) + voff) : "memory");
        __builtin_amdgcn_sched_barrier(0);
        S0_3 = S0_3 * dec;
        S1_3 = S1_3 * dec;
        asm volatile("s_waitcnt vmcnt(47)" : "+v"(r6));
        S0_3 = mfma16(r6, vp0_0, S0_3);
        S1_3 = mfma16(r6, vp1_0, S1_3);
        asm volatile("global_load_dwordx4 %0, %1, off" : "+v"(r6) : "v"((const unsigned char*)(sp0 + ((size_t)(n + 1) * 40 + 30) * 1024) + voff) : "memory");
        __builtin_amdgcn_sched_barrier(0);
        asm volatile("s_waitcnt vmcnt(47)" : "+v"(r7));
        S0_3 = mfma16(r7, vp0_1, S0_3);
        S1_3 = mfma16(r7, vp1_1, S1_3);
        asm volatile("global_load_dwordx4 %0, %1, off" : "+v"(r7) : "v"((const unsigned char*)(sp0 + ((size_t)(n + 1) * 40 + 31) * 1024) + voff) : "memory");
        __builtin_amdgcn_sched_barrier(0);
        S0_4 = S0_4 * dec;
        S1_4 = S1_4 * dec;
        asm volatile("s_waitcnt vmcnt(47)" : "+v"(r8));
        S0_4 = mfma16(r8, vp0_0, S0_4);
        S1_4 = mfma16(r8, vp1_0, S1_4);
        asm volatile("global_load_dwordx4 %0, %1, off" : "+v"(r8) : "v"((const unsigned char*)(sp0 + ((size_t)(n + 1) * 40 + 32) * 1024) + voff) : "memory");
        __builtin_amdgcn_sched_barrier(0);
        asm volatile("s_waitcnt vmcnt(47)" : "+v"(r9));
        S0_4 = mfma16(r9, vp0_1, S0_4);
        S1_4 = mfma16(r9, vp1_1, S1_4);
        asm volatile("global_load_dwordx4 %0, %1, off" : "+v"(r9) : "v"((const unsigned char*)(sp0 + ((size_t)(n + 1) * 40 + 33) * 1024) + voff) : "memory");
        __builtin_amdgcn_sched_barrier(0);
        S0_5 = S0_5 * dec;
        S1_5 = S1_5 * dec;
        asm volatile("s_waitcnt vmcnt(47)" : "+v"(r10));
        S0_5 = mfma16(r10, vp0_0, S0_5);
        S1_5 = mfma16(r10, vp1_0, S1_5);
        asm volatile("global_load_dwordx4 %0, %1, off" : "+v"(r10) : "v"((const unsigned char*)(sp0 + ((size_t)(n + 1) * 40 + 34) * 1024) + voff) : "memory");
        __builtin_amdgcn_sched_barrier(0);
        asm volatile("s_waitcnt vmcnt(47)" : "+v"(r11));
        S0_5 = mfma16(r11, vp0_1, S0_5);
        S1_5 = mfma16(r11, vp1_1, S1_5);
        asm volatile("global_load_dwordx4 %0, %1, off" : "+v"(r11) : "v"((const unsigned char*)(sp0 + ((size_t)(n + 1) * 40 + 35) * 1024) + voff) : "memory");
        __builtin_amdgcn_sched_barrier(0);
        S0_6 = S0_6 * dec;
        S1_6 = S1_6 * dec;
        asm volatile("s_waitcnt vmcnt(47)" : "+v"(r12));
        S0_6 = mfma16(r12, vp0_0, S0_6);
        S1_6 = mfma16(r12, vp1_0, S1_6);
        asm volatile("global_load_dwordx4 %0, %1, off" : "+v"(r12) : "v"((const unsigned char*)(sp0 + ((size_t)(n + 1) * 40 + 36) * 1024) + voff) : "memory");
        __builtin_amdgcn_sched_barrier(0);
        asm volatile("s_waitcnt vmcnt(47)" : "+v"(r13));
        S0_6 = mfma16(r13, vp0_1, S0_6);
        S1_6 = mfma16(r13, vp1_1, S1_6);
        asm volatile("global_load_dwordx4 %0, %1, off" : "+v"(r13) : "v"((const unsigned char*)(sp0 + ((size_t)(n + 1) * 40 + 37) * 1024) + voff) : "memory");
        __builtin_amdgcn_sched_barrier(0);
        S0_7 = S0_7 * dec;
        S1_7 = S1_7 * dec;
        asm volatile("s_waitcnt vmcnt(47)" : "+v"(r14));
        S0_7 = mfma16(r14, vp0_0, S0_7);
        S1_7 = mfma16(r14, vp1_0, S1_7);
        asm volatile("global_load_dwordx4 %0, %1, off" : "+v"(r14) : "v"((const unsigned char*)(sp0 + ((size_t)(n + 1) * 40 + 38) * 1024) + voff) : "memory");
        __builtin_amdgcn_sched_barrier(0);
        asm volatile("s_waitcnt vmcnt(47)" : "+v"(r15));
        S0_7 = mfma16(r15, vp0_1, S0_7);
        S1_7 = mfma16(r15, vp1_1, S1_7);
        asm volatile("global_load_dwordx4 %0, %1, off" : "+v"(r15) : "v"((const unsigned char*)(sp0 + ((size_t)(n + 1) * 40 + 39) * 1024) + voff) : "memory");
        __builtin_amdgcn_sched_barrier(0);
        { u32x4 w; w.x = cvt_pk_bf16(S0_0[0], S0_0[1]); w.y = cvt_pk_bf16(S0_0[2], S0_0[3]); w.z = cvt_pk_bf16(S0_1[0], S0_1[1]); w.w = cvt_pk_bf16(S0_1[2], S0_1[3]); Sp0_0 = __builtin_bit_cast(bf16x8, w); }
        { u32x4 w; w.x = cvt_pk_bf16(S0_2[0], S0_2[1]); w.y = cvt_pk_bf16(S0_2[2], S0_2[3]); w.z = cvt_pk_bf16(S0_3[0], S0_3[1]); w.w = cvt_pk_bf16(S0_3[2], S0_3[3]); Sp0_1 = __builtin_bit_cast(bf16x8, w); }
        { u32x4 w; w.x = cvt_pk_bf16(S0_4[0], S0_4[1]); w.y = cvt_pk_bf16(S0_4[2], S0_4[3]); w.z = cvt_pk_bf16(S0_5[0], S0_5[1]); w.w = cvt_pk_bf16(S0_5[2], S0_5[3]); Sp0_2 = __builtin_bit_cast(bf16x8, w); }
        { u32x4 w; w.x = cvt_pk_bf16(S0_6[0], S0_6[1]); w.y = cvt_pk_bf16(S0_6[2], S0_6[3]); w.z = cvt_pk_bf16(S0_7[0], S0_7[1]); w.w = cvt_pk_bf16(S0_7[2], S0_7[3]); Sp0_3 = __builtin_bit_cast(bf16x8, w); }
        { u32x4 w; w.x = cvt_pk_bf16(S1_0[0], S1_0[1]); w.y = cvt_pk_bf16(S1_0[2], S1_0[3]); w.z = cvt_pk_bf16(S1_1[0], S1_1[1]); w.w = cvt_pk_bf16(S1_1[2], S1_1[3]); Sp1_0 = __builtin_bit_cast(bf16x8, w); }
        { u32x4 w; w.x = cvt_pk_bf16(S1_2[0], S1_2[1]); w.y = cvt_pk_bf16(S1_2[2], S1_2[3]); w.z = cvt_pk_bf16(S1_3[0], S1_3[1]); w.w = cvt_pk_bf16(S1_3[2], S1_3[3]); Sp1_1 = __builtin_bit_cast(bf16x8, w); }
        { u32x4 w; w.x = cvt_pk_bf16(S1_4[0], S1_4[1]); w.y = cvt_pk_bf16(S1_4[2], S1_4[3]); w.z = cvt_pk_bf16(S1_5[0], S1_5[1]); w.w = cvt_pk_bf16(S1_5[2], S1_5[3]); Sp1_2 = __builtin_bit_cast(bf16x8, w); }
        { u32x4 w; w.x = cvt_pk_bf16(S1_6[0], S1_6[1]); w.y = cvt_pk_bf16(S1_6[2], S1_6[3]); w.z = cvt_pk_bf16(S1_7[0], S1_7[1]); w.w = cvt_pk_bf16(S1_7[2], S1_7[3]); Sp1_3 = __builtin_bit_cast(bf16x8, w); }
    }
    asm volatile("s_waitcnt vmcnt(0)" ::: "memory");
    } else {
    bf16x8 r0 = (bf16x8){0, 0, 0, 0, 0, 0, 0, 0};
    bf16x8 r1 = (bf16x8){0, 0, 0, 0, 0, 0, 0, 0};
    bf16x8 r2 = (bf16x8){0, 0, 0, 0, 0, 0, 0, 0};
    bf16x8 r3 = (bf16x8){0, 0, 0, 0, 0, 0, 0, 0};
    bf16x8 r4 = (bf16x8){0, 0, 0, 0, 0, 0, 0, 0};
    bf16x8 r5 = (bf16x8){0, 0, 0, 0, 0, 0, 0, 0};
    bf16x8 r6 = (bf16x8){0, 0, 0, 0, 0, 0, 0, 0};
    bf16x8 r7 = (bf16x8){0, 0, 0, 0, 0, 0, 0, 0};
    bf16x8 r8 = (bf16x8){0, 0, 0, 0, 0, 0, 0, 0};
    bf16x8 r9 = (bf16x8){0, 0, 0, 0, 0, 0, 0, 0};
    bf16x8 r10 = (bf16x8){0, 0, 0, 0, 0, 0, 0, 0};
    bf16x8 r11 = (bf16x8){0, 0, 0, 0, 0, 0, 0, 0};
    bf16x8 r12 = (bf16x8){0, 0, 0, 0, 0, 0, 0, 0};
    bf16x8 r13 = (bf16x8){0, 0, 0, 0, 0, 0, 0, 0};
    bf16x8 r14 = (bf16x8){0, 0, 0, 0, 0, 0, 0, 0};
    bf16x8 r15 = (bf16x8){0, 0, 0, 0, 0, 0, 0, 0};
    bf16x8 r16 = (bf16x8){0, 0, 0, 0, 0, 0, 0, 0};
    bf16x8 r17 = (bf16x8){0, 0, 0, 0, 0, 0, 0, 0};
    bf16x8 r18 = (bf16x8){0, 0, 0, 0, 0, 0, 0, 0};
    bf16x8 r19 = (bf16x8){0, 0, 0, 0, 0, 0, 0, 0};
    bf16x8 r20 = (bf16x8){0, 0, 0, 0, 0, 0, 0, 0};
    bf16x8 r21 = (bf16x8){0, 0, 0, 0, 0, 0, 0, 0};
    bf16x8 r22 = (bf16x8){0, 0, 0, 0, 0, 0, 0, 0};
    bf16x8 r23 = (bf16x8){0, 0, 0, 0, 0, 0, 0, 0};
    asm volatile("global_load_dwordx4 %0, %1, off" : "+v"(r0) : "v"((const unsigned char*)(sp0 + ((size_t)(0 + 0) * 40 + 0) * 1024) + voff) : "memory");
    asm volatile("global_load_dwordx4 %0, %1, off" : "+v"(r1) : "v"((const unsigned char*)(sp0 + ((size_t)(0 + 0) * 40 + 1) * 1024) + voff) : "memory");
    asm volatile("global_load_dwordx4 %0, %1, off" : "+v"(r2) : "v"((const unsigned char*)(sp0 + ((size_t)(0 + 0) * 40 + 2) * 1024) + voff) : "memory");
    asm volatile("global_load_dwordx4 %0, %1, off" : "+v"(r3) : "v"((const unsigned char*)(sp0 + ((size_t)(0 + 0) * 40 + 3) * 1024) + voff) : "memory");
    asm volatile("global_load_dwordx4 %0, %1, off" : "+v"(r4) : "v"((const unsigned char*)(sp0 + ((size_t)(0 + 0) * 40 + 4) * 1024) + voff) : "memory");
    asm volatile("global_load_dwordx4 %0, %1, off" : "+v"(r5) : "v"((const unsigned char*)(sp0 + ((size_t)(0 + 0) * 40 + 5) * 1024) + voff) : "memory");
    asm volatile("global_load_dwordx4 %0, %1, off" : "+v"(r6) : "v"((const unsigned char*)(sp0 + ((size_t)(0 + 0) * 40 + 6) * 1024) + voff) : "memory");
    asm volatile("global_load_dwordx4 %0, %1, off" : "+v"(r7) : "v"((const unsigned char*)(sp0 + ((size_t)(0 + 0) * 40 + 7) * 1024) + voff) : "memory");
    asm volatile("global_load_dwordx4 %0, %1, off" : "+v"(r8) : "v"((const unsigned char*)(sp0 + ((size_t)(0 + 0) * 40 + 8) * 1024) + voff) : "memory");
    asm volatile("global_load_dwordx4 %0, %1, off" : "+v"(r9) : "v"((const unsigned char*)(sp0 + ((size_t)(0 + 0) * 40 + 9) * 1024) + voff) : "memory");
    asm volatile("global_load_dwordx4 %0, %1, off" : "+v"(r10) : "v"((const unsigned char*)(sp0 + ((size_t)(0 + 0) * 40 + 10) * 1024) + voff) : "memory");
    asm volatile("global_load_dwordx4 %0, %1, off" : "+v"(r11) : "v"((const unsigned char*)(sp0 + ((size_t)(0 + 0) * 40 + 11) * 1024) + voff) : "memory");
    asm volatile("global_load_dwordx4 %0, %1, off" : "+v"(r12) : "v"((const unsigned char*)(sp0 + ((size_t)(0 + 0) * 40 + 12) * 1024) + voff) : "memory");
    asm volatile("global_load_dwordx4 %0, %1, off" : "+v"(r13) : "v"((const unsigned char*)(sp0 + ((size_t)(0 + 0) * 40 + 13) * 1024) + voff) : "memory");
    asm volatile("global_load_dwordx4 %0, %1, off" : "+v"(r14) : "v"((const unsigned char*)(sp0 + ((size_t)(0 + 0) * 40 + 14) * 1024) + voff) : "memory");
    asm volatile("global_load_dwordx4 %0, %1, off" : "+v"(r15) : "v"((const unsigned char*)(sp0 + ((size_t)(0 + 0) * 40 + 15) * 1024) + voff) : "memory");
    asm volatile("global_load_dwordx4 %0, %1, off" : "+v"(r16) : "v"((const unsigned char*)(sp0 + ((size_t)(0 + 0) * 40 + 16) * 1024) + voff) : "memory");
    asm volatile("global_load_dwordx4 %0, %1, off" : "+v"(r17) : "v"((const unsigned char*)(sp0 + ((size_t)(0 + 0) * 40 + 17) * 1024) + voff) : "memory");
    asm volatile("global_load_dwordx4 %0, %1, off" : "+v"(r18) : "v"((const unsigned char*)(sp0 + ((size_t)(0 + 0) * 40 + 18) * 1024) + voff) : "memory");
    asm volatile("global_load_dwordx4 %0, %1, off" : "+v"(r19) : "v"((const unsigned char*)(sp0 + ((size_t)(0 + 0) * 40 + 19) * 1024) + voff) : "memory");
    asm volatile("global_load_dwordx4 %0, %1, off" : "+v"(r20) : "v"((const unsigned char*)(sp0 + ((size_t)(0 + 0) * 40 + 20) * 1024) + voff) : "memory");
    asm volatile("global_load_dwordx4 %0, %1, off" : "+v"(r21) : "v"((const unsigned char*)(sp0 + ((size_t)(0 + 0) * 40 + 21) * 1024) + voff) : "memory");
    asm volatile("global_load_dwordx4 %0, %1, off" : "+v"(r22) : "v"((const unsigned char*)(sp0 + ((size_t)(0 + 0) * 40 + 22) * 1024) + voff) : "memory");
    asm volatile("global_load_dwordx4 %0, %1, off" : "+v"(r23) : "v"((const unsigned char*)(sp0 + ((size_t)(0 + 0) * 40 + 23) * 1024) + voff) : "memory");
    { unsigned z = 0u;
      asm volatile("global_store_short %0, %1, off" :: "v"((const unsigned char*)(obu + (size_t)(0) * orow + 0) + ooff), "v"(z) : "memory");
      asm volatile("global_store_short %0, %1, off" :: "v"((const unsigned char*)(obu + (size_t)(1) * orow + 0) + ooff), "v"(z) : "memory");
      asm volatile("global_store_short %0, %1, off" :: "v"((const unsigned char*)(obu + (size_t)(2) * orow + 0) + ooff), "v"(z) : "memory");
      asm volatile("global_store_short %0, %1, off" :: "v"((const unsigned char*)(obu + (size_t)(3) * orow + 0) + ooff), "v"(z) : "memory");
      asm volatile("global_store_short %0, %1, off" :: "v"((const unsigned char*)(obu + (size_t)(16) * orow + 0) + ooff), "v"(z) : "memory");
      asm volatile("global_store_short %0, %1, off" :: "v"((const unsigned char*)(obu + (size_t)(17) * orow + 0) + ooff), "v"(z) : "memory");
      asm volatile("global_store_short %0, %1, off" :: "v"((const unsigned char*)(obu + (size_t)(18) * orow + 0) + ooff), "v"(z) : "memory");
      asm volatile("global_store_short %0, %1, off" :: "v"((const unsigned char*)(obu + (size_t)(19) * orow + 0) + ooff), "v"(z) : "memory");
      asm volatile("global_store_short %0, %1, off" :: "v"((const unsigned char*)(obu + (size_t)(32) * orow + 0) + ooff), "v"(z) : "memory");
      asm volatile("global_store_short %0, %1, off" :: "v"((const unsigned char*)(obu + (size_t)(33) * orow + 0) + ooff), "v"(z) : "memory");
      asm volatile("global_store_short %0, %1, off" :: "v"((const unsigned char*)(obu + (size_t)(34) * orow + 0) + ooff), "v"(z) : "memory");
      asm volatile("global_store_short %0, %1, off" :: "v"((const unsigned char*)(obu + (size_t)(35) * orow + 0) + ooff), "v"(z) : "memory");
      asm volatile("global_store_short %0, %1, off" :: "v"((const unsigned char*)(obu + (size_t)(48) * orow + 0) + ooff), "v"(z) : "memory");
      asm volatile("global_store_short %0, %1, off" :: "v"((const unsigned char*)(obu + (size_t)(49) * orow + 0) + ooff), "v"(z) : "memory");
      asm volatile("global_store_short %0, %1, off" :: "v"((const unsigned char*)(obu + (size_t)(50) * orow + 0) + ooff), "v"(z) : "memory");
      asm volatile("global_store_short %0, %1, off" :: "v"((const unsigned char*)(obu + (size_t)(51) * orow + 0) + ooff), "v"(z) : "memory");
      asm volatile("global_store_short %0, %1, off" :: "v"((const unsigned char*)(obu + (size_t)(0) * orow + 32) + ooff), "v"(z) : "memory");
      asm volatile("global_store_short %0, %1, off" :: "v"((const unsigned char*)(obu + (size_t)(1) * orow + 32) + ooff), "v"(z) : "memory");
      asm volatile("global_store_short %0, %1, off" :: "v"((const unsigned char*)(obu + (size_t)(2) * orow + 32) + ooff), "v"(z) : "memory");
      asm volatile("global_store_short %0, %1, off" :: "v"((const unsigned char*)(obu + (size_t)(3) * orow + 32) + ooff), "v"(z) : "memory");
      asm volatile("global_store_short %0, %1, off" :: "v"((const unsigned char*)(obu + (size_t)(16) * orow + 32) + ooff), "v"(z) : "memory");
      asm volatile("global_store_short %0, %1, off" :: "v"((const unsigned char*)(obu + (size_t)(17) * orow + 32) + ooff), "v"(z) : "memory");
      asm volatile("global_store_short %0, %1, off" :: "v"((const unsigned char*)(obu + (size_t)(18) * orow + 32) + ooff), "v"(z) : "memory");
      asm volatile("global_store_short %0, %1, off" :: "v"((const unsigned char*)(obu + (size_t)(19) * orow + 32) + ooff), "v"(z) : "memory");
      asm volatile("global_store_short %0, %1, off" :: "v"((const unsigned char*)(obu + (size_t)(32) * orow + 32) + ooff), "v"(z) : "memory");
      asm volatile("global_store_short %0, %1, off" :: "v"((const unsigned char*)(obu + (size_t)(33) * orow + 32) + ooff), "v"(z) : "memory");
      asm volatile("global_store_short %0, %1, off" :: "v"((const unsigned char*)(obu + (size_t)(34) * orow + 32) + ooff), "v"(z) : "memory");
      asm volatile("global_store_short %0, %1, off" :: "v"((const unsigned char*)(obu + (size_t)(35) * orow + 32) + ooff), "v"(z) : "memory");
      asm volatile("global_store_short %0, %1, off" :: "v"((const unsigned char*)(obu + (size_t)(48) * orow + 32) + ooff), "v"(z) : "memory");
      asm volatile("global_store_short %0, %1, off" :: "v"((const unsigned char*)(obu + (size_t)(49) * orow + 32) + ooff), "v"(z) : "memory");
      asm volatile("global_store_short %0, %1, off" :: "v"((const unsigned char*)(obu + (size_t)(50) * orow + 32) + ooff), "v"(z) : "memory");
      asm volatile("global_store_short %0, %1, off" :: "v"((const unsigned char*)(obu + (size_t)(51) * orow + 32) + ooff), "v"(z) : "memory");
    }
#pragma unroll 1
    for (int n = 0; n < NCH; ++n) {
        { unsigned sp_ = 0; while (*(volatile LAS unsigned*)(xl + XL_CNT) <= (unsigned)n) { __builtin_amdgcn_s_sleep(1); if (++sp_ > (1u << 22)) break; } }
        bf16x8 Sp0_0, Sp0_1, Sp0_2, Sp0_3, vp0_0, vp0_1;
        bf16x8 Sp1_0, Sp1_1, Sp1_2, Sp1_3, vp1_0, vp1_1;
        { const LAS bf16x8* sl_ = (const LAS bf16x8*)(xl + (n & 1) * XL_SLOT) + lane; Sp0_0 = sl_[0]; Sp0_1 = sl_[64]; Sp0_2 = sl_[128]; Sp0_3 = sl_[192]; vp0_0 = sl_[256]; vp0_1 = sl_[320]; Sp1_0 = sl_[384]; Sp1_1 = sl_[448]; Sp1_2 = sl_[512]; Sp1_3 = sl_[576]; vp1_0 = sl_[640]; vp1_1 = sl_[704]; }
        asm volatile("s_waitcnt lgkmcnt(0)" ::: "memory");
        if (lane == 0) *(volatile LAS unsigned*)(xl + XL_CNT + 64) = (unsigned)(n + 1);
        f32x4 o0_0 = {0.f, 0.f, 0.f, 0.f}, o0_1 = o0_0, o0_2 = o0_0, o0_3 = o0_0;
        f32x4 o1_0 = {0.f, 0.f, 0.f, 0.f}, o1_1 = o1_0, o1_2 = o1_0, o1_3 = o1_0;
        asm volatile("s_waitcnt vmcnt(55)" : "+v"(r0));
        o0_0 = mfma16(r0, Sp0_0, o0_0);
        o1_0 = mfma16(r0, Sp1_0, o1_0);
        asm volatile("global_load_dwordx4 %0, %1, off" : "+v"(r0) : "v"((const unsigned char*)(sp0 + ((size_t)(n + 1) * 40 + 0) * 1024) + voff) : "memory");
        __builtin_amdgcn_sched_barrier(0);
        asm volatile("s_waitcnt vmcnt(55)" : "+v"(r1));
        o0_0 = mfma16(r1, Sp0_1, o0_0);
        o1_0 = mfma16(r1, Sp1_1, o1_0);
        asm volatile("global_load_dwordx4 %0, %1, off" : "+v"(r1) : "v"((const unsigned char*)(sp0 + ((size_t)(n + 1) * 40 + 1) * 1024) + voff) : "memory");
        __builtin_amdgcn_sched_barrier(0);
        asm volatile("s_waitcnt vmcnt(55)" : "+v"(r2));
        o0_0 = mfma16(r2, Sp0_2, o0_0);
        o1_0 = mfma16(r2, Sp1_2, o1_0);
        asm volatile("global_load_dwordx4 %0, %1, off" : "+v"(r2) : "v"((const unsigned char*)(sp0 + ((size_t)(n + 1) * 40 + 2) * 1024) + voff) : "memory");
        __builtin_amdgcn_sched_barrier(0);
        asm volatile("s_waitcnt vmcnt(55)" : "+v"(r3));
        o0_0 = mfma16(r3, Sp0_3, o0_0);
        o1_0 = mfma16(r3, Sp1_3, o1_0);
        asm volatile("global_load_dwordx4 %0, %1, off" : "+v"(r3) : "v"((const unsigned char*)(sp0 + ((size_t)(n + 1) * 40 + 3) * 1024) + voff) : "memory");
        __builtin_amdgcn_sched_barrier(0);
        asm volatile("s_waitcnt vmcnt(55)" : "+v"(r4));
        o0_1 = mfma16(r4, Sp0_0, o0_1);
        o1_1 = mfma16(r4, Sp1_0, o1_1);
        asm volatile("global_load_dwordx4 %0, %1, off" : "+v"(r4) : "v"((const unsigned char*)(sp0 + ((size_t)(n + 1) * 40 + 4) * 1024) + voff) : "memory");
        __builtin_amdgcn_sched_barrier(0);
        asm volatile("s_waitcnt vmcnt(55)" : "+v"(r5));
        o0_1 = mfma16(r5, Sp0_1, o0_1);
        o1_1 = mfma16(r5, Sp1_1, o1_1);
        asm volatile("global_load_dwordx4 %0, %1, off" : "+v"(r5) : "v"((const unsigned char*)(sp0 + ((size_t)(n + 1) * 40 + 5) * 1024) + voff) : "memory");
        __builtin_amdgcn_sched_barrier(0);
        asm volatile("s_waitcnt vmcnt(55)" : "+v"(r6));
        o0_1 = mfma16(r6, Sp0_2, o0_1);
        o1_1 = mfma16(r6, Sp1_2, o1_1);
        asm volatile("global_load_dwordx4 %0, %1, off" : "+v"(r6) : "v"((const unsigned char*)(sp0 + ((size_t)(n + 1) * 40 + 6) * 1024) + voff) : "memory");
        __builtin_amdgcn_sched_barrier(0);
        asm volatile("s_waitcnt vmcnt(55)" : "+v"(r7));
        o0_1 = mfma16(r7, Sp0_3, o0_1);
        o1_1 = mfma16(r7, Sp1_3, o1_1);
        asm volatile("global_load_dwordx4 %0, %1, off" : "+v"(r7) : "v"((const unsigned char*)(sp0 + ((size_t)(n + 1) * 40 + 7) * 1024) + voff) : "memory");
        __builtin_amdgcn_sched_barrier(0);
        asm volatile("s_waitcnt vmcnt(55)" : "+v"(r8));
        o0_2 = mfma16(r8, Sp0_0, o0_2);
        o1_2 = mfma16(r8, Sp1_0, o1_2);
        asm volatile("global_load_dwordx4 %0, %1, off" : "+v"(r8) : "v"((const unsigned char*)(sp0 + ((size_t)(n + 1) * 40 + 8) * 1024) + voff) : "memory");
        __builtin_amdgcn_sched_barrier(0);
        asm volatile("s_waitcnt vmcnt(55)" : "+v"(r9));
        o0_2 = mfma16(r9, Sp0_1, o0_2);
        o1_2 = mfma16(r9, Sp1_1, o1_2);
        asm volatile("global_load_dwordx4 %0, %1, off" : "+v"(r9) : "v"((const unsigned char*)(sp0 + ((size_t)(n + 1) * 40 + 9) * 1024) + voff) : "memory");
        __builtin_amdgcn_sched_barrier(0);
        asm volatile("s_waitcnt vmcnt(55)" : "+v"(r10));
        o0_2 = mfma16(r10, Sp0_2, o0_2);
        o1_2 = mfma16(r10, Sp1_2, o1_2);
        asm volatile("global_load_dwordx4 %0, %1, off" : "+v"(r10) : "v"((const unsigned char*)(sp0 + ((size_t)(n + 1) * 40 + 10) * 1024) + voff) : "memory");
        __builtin_amdgcn_sched_barrier(0);
        asm volatile("s_waitcnt vmcnt(55)" : "+v"(r11));
        o0_2 = mfma16(r11, Sp0_3, o0_2);
        o1_2 = mfma16(r11, Sp1_3, o1_2);
        asm volatile("global_load_dwordx4 %0, %1, off" : "+v"(r11) : "v"((const unsigned char*)(sp0 + ((size_t)(n + 1) * 40 + 11) * 1024) + voff) : "memory");
        __builtin_amdgcn_sched_barrier(0);
        asm volatile("s_waitcnt vmcnt(55)" : "+v"(r12));
        o0_3 = mfma16(r12, Sp0_0, o0_3);
        o1_3 = mfma16(r12, Sp1_0, o1_3);
        asm volatile("global_load_dwordx4 %0, %1, off" : "+v"(r12) : "v"((const unsigned char*)(sp0 + ((size_t)(n + 1) * 40 + 12) * 1024) + voff) : "memory");
        __builtin_amdgcn_sched_barrier(0);
        asm volatile("s_waitcnt vmcnt(55)" : "+v"(r13));
        o0_3 = mfma16(r13, Sp0_1, o0_3);
        o1_3 = mfma16(r13, Sp1_1, o1_3);
        asm volatile("global_load_dwordx4 %0, %1, off" : "+v"(r13) : "v"((const unsigned char*)(sp0 + ((size_t)(n + 1) * 40 + 13) * 1024) + voff) : "memory");
        __builtin_amdgcn_sched_barrier(0);
        asm volatile("s_waitcnt vmcnt(55)" : "+v"(r14));
        o0_3 = mfma16(r14, Sp0_2, o0_3);
        o1_3 = mfma16(r14, Sp1_2, o1_3);
        asm volatile("global_load_dwordx4 %0, %1, off" : "+v"(r14) : "v"((const unsigned char*)(sp0 + ((size_t)(n + 1) * 40 + 14) * 1024) + voff) : "memory");
        __builtin_amdgcn_sched_barrier(0);
        asm volatile("s_waitcnt vmcnt(55)" : "+v"(r15));
        o0_3 = mfma16(r15, Sp0_3, o0_3);
        o1_3 = mfma16(r15, Sp1_3, o1_3);
        asm volatile("global_load_dwordx4 %0, %1, off" : "+v"(r15) : "v"((const unsigned char*)(sp0 + ((size_t)(n + 1) * 40 + 15) * 1024) + voff) : "memory");
        __builtin_amdgcn_sched_barrier(0);
        asm volatile("s_waitcnt vmcnt(55)" : "+v"(r16));
        o0_0 = mfma16(r16, vp0_0, o0_0);
        o1_0 = mfma16(r16, vp1_0, o1_0);
        asm volatile("global_load_dwordx4 %0, %1, off" : "+v"(r16) : "v"((const unsigned char*)(sp0 + ((size_t)(n + 1) * 40 + 16) * 1024) + voff) : "memory");
        __builtin_amdgcn_sched_barrier(0);
        asm volatile("s_waitcnt vmcnt(55)" : "+v"(r17));
        o0_0 = mfma16(r17, vp0_1, o0_0);
        o1_0 = mfma16(r17, vp1_1, o1_0);
        asm volatile("global_load_dwordx4 %0, %1, off" : "+v"(r17) : "v"((const unsigned char*)(sp0 + ((size_t)(n + 1) * 40 + 17) * 1024) + voff) : "memory");
        __builtin_amdgcn_sched_barrier(0);
        asm volatile("s_waitcnt vmcnt(55)" : "+v"(r18));
        o0_1 = mfma16(r18, vp0_0, o0_1);
        o1_1 = mfma16(r18, vp1_0, o1_1);
        asm volatile("global_load_dwordx4 %0, %1, off" : "+v"(r18) : "v"((const unsigned char*)(sp0 + ((size_t)(n + 1) * 40 + 18) * 1024) + voff) : "memory");
        __builtin_amdgcn_sched_barrier(0);
        asm volatile("s_waitcnt vmcnt(55)" : "+v"(r19));
        o0_1 = mfma16(r19, vp0_1, o0_1);
        o1_1 = mfma16(r19, vp1_1, o1_1);
        asm volatile("global_load_dwordx4 %0, %1, off" : "+v"(r19) : "v"((const unsigned char*)(sp0 + ((size_t)(n + 1) * 40 + 19) * 1024) + voff) : "memory");
        __builtin_amdgcn_sched_barrier(0);
        asm volatile("s_waitcnt vmcnt(55)" : "+v"(r20));
        o0_2 = mfma16(r20, vp0_0, o0_2);
        o1_2 = mfma16(r20, vp1_0, o1_2);
        asm volatile("global_load_dwordx4 %0, %1, off" : "+v"(r20) : "v"((const unsigned char*)(sp0 + ((size_t)(n + 1) * 40 + 20) * 1024) + voff) : "memory");
        __builtin_amdgcn_sched_barrier(0);
        asm volatile("s_waitcnt vmcnt(55)" : "+v"(r21));
        o0_2 = mfma16(r21, vp0_1, o0_2);
        o1_2 = mfma16(r21, vp1_1, o1_2);
        asm volatile("global_load_dwordx4 %0, %1, off" : "+v"(r21) : "v"((const unsigned char*)(sp0 + ((size_t)(n + 1) * 40 + 21) * 1024) + voff) : "memory");
        __builtin_amdgcn_sched_barrier(0);
        asm volatile("s_waitcnt vmcnt(55)" : "+v"(r22));
        o0_3 = mfma16(r22, vp0_0, o0_3);
        o1_3 = mfma16(r22, vp1_0, o1_3);
        asm volatile("global_load_dwordx4 %0, %1, off" : "+v"(r22) : "v"((const unsigned char*)(sp0 + ((size_t)(n + 1) * 40 + 22) * 1024) + voff) : "memory");
        __builtin_amdgcn_sched_barrier(0);
        asm volatile("s_waitcnt vmcnt(55)" : "+v"(r23));
        o0_3 = mfma16(r23, vp0_1, o0_3);
        o1_3 = mfma16(r23, vp1_1, o1_3);
        asm volatile("global_load_dwordx4 %0, %1, off" : "+v"(r23) : "v"((const unsigned char*)(sp0 + ((size_t)(n + 1) * 40 + 23) * 1024) + voff) : "memory");
        __builtin_amdgcn_sched_barrier(0);
        { const unsigned char* obn = obu + (size_t)n * 64 * orow;
          { const unsigned v = f2bf(o0_0[0]); asm volatile("global_store_short %0, %1, off" :: "v"((const unsigned char*)(obn + (size_t)(0) * orow + 0) + ooff), "v"(v) : "memory"); }
          { const unsigned v = f2bf(o0_0[1]); asm volatile("global_store_short %0, %1, off" :: "v"((const unsigned char*)(obn + (size_t)(1) * orow + 0) + ooff), "v"(v) : "memory"); }
          { const unsigned v = f2bf(o0_0[2]); asm volatile("global_store_short %0, %1, off" :: "v"((const unsigned char*)(obn + (size_t)(2) * orow + 0) + ooff), "v"(v) : "memory"); }
          { const unsigned v = f2bf(o0_0[3]); asm volatile("global_store_short %0, %1, off" :: "v"((const unsigned char*)(obn + (size_t)(3) * orow + 0) + ooff), "v"(v) : "memory"); }
          { const unsigned v = f2bf(o0_1[0]); asm volatile("global_store_short %0, %1, off" :: "v"((const unsigned char*)(obn + (size_t)(16) * orow + 0) + ooff), "v"(v) : "memory"); }
          { const unsigned v = f2bf(o0_1[1]); asm volatile("global_store_short %0, %1, off" :: "v"((const unsigned char*)(obn + (size_t)(17) * orow + 0) + ooff), "v"(v) : "memory"); }
          { const unsigned v = f2bf(o0_1[2]); asm volatile("global_store_short %0, %1, off" :: "v"((const unsigned char*)(obn + (size_t)(18) * orow + 0) + ooff), "v"(v) : "memory"); }
          { const unsigned v = f2bf(o0_1[3]); asm volatile("global_store_short %0, %1, off" :: "v"((const unsigned char*)(obn + (size_t)(19) * orow + 0) + ooff), "v"(v) : "memory"); }
          { const unsigned v = f2bf(o0_2[0]); asm volatile("global_store_short %0, %1, off" :: "v"((const unsigned char*)(obn + (size_t)(32) * orow + 0) + ooff), "v"(v) : "memory"); }
          { const unsigned v = f2bf(o0_2[1]); asm volatile("global_store_short %0, %1, off" :: "v"((const unsigned char*)(obn + (size_t)(33) * orow + 0) + ooff), "v"(v) : "memory"); }
          { const unsigned v = f2bf(o0_2[2]); asm volatile("global_store_short %0, %1, off" :: "v"((const unsigned char*)(obn + (size_t)(34) * orow + 0) + ooff), "v"(v) : "memory"); }
          { const unsigned v = f2bf(o0_2[3]); asm volatile("global_store_short %0, %1, off" :: "v"((const unsigned char*)(obn + (size_t)(35) * orow + 0) + ooff), "v"(v) : "memory"); }
          { const unsigned v = f2bf(o0_3[0]); asm volatile("global_store_short %0, %1, off" :: "v"((const unsigned char*)(obn + (size_t)(48) * orow + 0) + ooff), "v"(v) : "memory"); }
          { const unsigned v = f2bf(o0_3[1]); asm volatile("global_store_short %0, %1, off" :: "v"((const unsigned char*)(obn + (size_t)(49) * orow + 0) + ooff), "v"(v) : "memory"); }
          { const unsigned v = f2bf(o0_3[2]); asm volatile("global_store_short %0, %1, off" :: "v"((const unsigned char*)(obn + (size_t)(50) * orow + 0) + ooff), "v"(v) : "memory"); }
          { const unsigned v = f2bf(o0_3[3]); asm volatile("global_store_short %0, %1, off" :: "v"((const unsigned char*)(obn + (size_t)(51) * orow + 0) + ooff), "v"(v) : "memory"); }
          { const unsigned v = f2bf(o1_0[0]); asm volatile("global_store_short %0, %1, off" :: "v"((const unsigned char*)(obn + (size_t)(0) * orow + 32) + ooff), "v"(v) : "memory"); }
          { const unsigned v = f2bf(o1_0[1]); asm volatile("global_store_short %0, %1, off" :: "v"((const unsigned char*)(obn + (size_t)(1) * orow + 32) + ooff), "v"(v) : "memory"); }
          { const unsigned v = f2bf(o1_0[2]); asm volatile("global_store_short %0, %1, off" :: "v"((const unsigned char*)(obn + (size_t)(2) * orow + 32) + ooff), "v"(v) : "memory"); }
          { const unsigned v = f2bf(o1_0[3]); asm volatile("global_store_short %0, %1, off" :: "v"((const unsigned char*)(obn + (size_t)(3) * orow + 32) + ooff), "v"(v) : "memory"); }
          { const unsigned v = f2bf(o1_1[0]); asm volatile("global_store_short %0, %1, off" :: "v"((const unsigned char*)(obn + (size_t)(16) * orow + 32) + ooff), "v"(v) : "memory"); }
          { const unsigned v = f2bf(o1_1[1]); asm volatile("global_store_short %0, %1, off" :: "v"((const unsigned char*)(obn + (size_t)(17) * orow + 32) + ooff), "v"(v) : "memory"); }
          { const unsigned v = f2bf(o1_1[2]); asm volatile("global_store_short %0, %1, off" :: "v"((const unsigned char*)(obn + (size_t)(18) * orow + 32) + ooff), "v"(v) : "memory"); }
          { const unsigned v = f2bf(o1_1[3]); asm volatile("global_store_short %0, %1, off" :: "v"((const unsigned char*)(obn + (size_t)(19) * orow + 32) + ooff), "v"(v) : "memory"); }
          { const unsigned v = f2bf(o1_2[0]); asm volatile("global_store_short %0, %1, off" :: "v"((const unsigned char*)(obn + (size_t)(32) * orow + 32) + ooff), "v"(v) : "memory"); }
          { const unsigned v = f2bf(o1_2[1]); asm volatile("global_store_short %0, %1, off" :: "v"((const unsigned char*)(obn + (size_t)(33) * orow + 32) + ooff), "v"(v) : "memory"); }
          { const unsigned v = f2bf(o1_2[2]); asm volatile("global_store_short %0, %1, off" :: "v"((const unsigned char*)(obn + (size_t)(34) * orow + 32) + ooff), "v"(v) : "memory"); }
          { const unsigned v = f2bf(o1_2[3]); asm volatile("global_store_short %0, %1, off" :: "v"((const unsigned char*)(obn + (size_t)(35) * orow + 32) + ooff), "v"(v) : "memory"); }
          { const unsigned v = f2bf(o1_3[0]); asm volatile("global_store_short %0, %1, off" :: "v"((const unsigned char*)(obn + (size_t)(48) * orow + 32) + ooff), "v"(v) : "memory"); }
          { const unsigned v = f2bf(o1_3[1]); asm volatile("global_store_short %0, %1, off" :: "v"((const unsigned char*)(obn + (size_t)(49) * orow + 32) + ooff), "v"(v) : "memory"); }
          { const unsigned v = f2bf(o1_3[2]); asm volatile("global_store_short %0, %1, off" :: "v"((const unsigned char*)(obn + (size_t)(50) * orow + 32) + ooff), "v"(v) : "memory"); }
          { const unsigned v = f2bf(o1_3[3]); asm volatile("global_store_short %0, %1, off" :: "v"((const unsigned char*)(obn + (size_t)(51) * orow + 32) + ooff), "v"(v) : "memory"); }
        }
        __builtin_amdgcn_sched_barrier(0);
    }
    asm volatile("s_waitcnt vmcnt(0)" ::: "memory");
    }
}

DI void p4_mixnorm(Frame& F, const float* ret_norm, const float* gdn_norm) {
    bf16_t* pj = (bf16_t*)(F.ws + WS_BIG + BIG_PJ); const bf16_t* vc = (const bf16_t*)(F.ws + AUX_VC); const bf16_t* rr = (const bf16_t*)(F.ws + AUX_QN);
    const int lane = F.lane, l32 = lane & 31, hh = lane >> 5;
    const f32x4 gr0 = *(const f32x4*)(ret_norm + 8 * l32), gr1 = *(const f32x4*)(ret_norm + 8 * l32 + 4), gg0 = *(const f32x4*)(gdn_norm + 8 * l32), gg1 = *(const f32x4*)(gdn_norm + 8 * l32 + 4);
    for (int m = F.gw; m < NTOK; m += F.NGW) {
        bf16_t* row = pj + (size_t)m * PJW;
        u32x4 ro[8], gt[8];
#pragma unroll
        for (int q = 0; q < 8; ++q) { const int hv = 2 * q + hh, hd = hv & 7; const bool gdn = hv >= 8;
            ro[q] = *(const u32x4*)((gdn ? vc : rr) + (size_t)m * 2048 + hd * 256 + 8 * l32);
            gt[q] = *(const u32x4*)(row + (gdn ? C_GZ : C_RG) + hd * 256 + 8 * l32); }
        asm volatile("" ::: "memory");
#pragma unroll
        for (int q = 0; q < 8; ++q) { const int hv = 2 * q + hh, hd = hv & 7; const bool gdn = q >= 4;
            float o[8] = {bflo(ro[q].x), bfhi(ro[q].x), bflo(ro[q].y), bfhi(ro[q].y), bflo(ro[q].z), bfhi(ro[q].z), bflo(ro[q].w), bfhi(ro[q].w)};
            float gv[8] = {bflo(gt[q].x), bfhi(gt[q].x), bflo(gt[q].y), bfhi(gt[q].y), bflo(gt[q].z), bfhi(gt[q].z), bflo(gt[q].w), bfhi(gt[q].w)};
            float ss = 0.f;
#pragma unroll
            for (int e = 0; e < 8; ++e) ss += o[e] * o[e];
            ss += __shfl_xor(ss, 1); ss += __shfl_xor(ss, 2); ss += __shfl_xor(ss, 4); ss += __shfl_xor(ss, 8); ss += __shfl_xor(ss, 16);
            const float rstd = 1.0f / sqrtf(ss * (1.0f / 256.0f) + EPS);
            const f32x4 g0 = gdn ? gg0 : gr0, g1 = gdn ? gg1 : gr1;
            u32x4 w; w.x = pk2(o[0] * rstd * g0.x * siluf(gv[0]), o[1] * rstd * g0.y * siluf(gv[1])); w.y = pk2(o[2] * rstd * g0.z * siluf(gv[2]), o[3] * rstd * g0.w * siluf(gv[3]));
            w.z = pk2(o[4] * rstd * g1.x * siluf(gv[4]), o[5] * rstd * g1.y * siluf(gv[5])); w.w = pk2(o[6] * rstd * g1.z * siluf(gv[6]), o[7] * rstd * g1.w * siluf(gv[7]));
            *(u32x4*)(row + (gdn ? C_GZ : C_RG) + hd * 256 + 8 * l32) = w; }
    }
}

DI void p11_swaprep(Frame& F, const float* qnorm, const float* knorm) {
    bf16_t* qkv = (bf16_t*)(F.ws + WS_BIG + BIG_QKV1); const f32x2* cs32 = (const f32x2*)(F.ws + AUX_CS32);
    const int lane = F.lane, l8 = lane & 7;
    const f32x4 gq0 = *(const f32x4*)(qnorm + 8 * l8), gq1 = *(const f32x4*)(qnorm + 8 * l8 + 4), gk0 = *(const f32x4*)(knorm + 8 * l8), gk1 = *(const f32x4*)(knorm + 8 * l8 + 4);
    const float sg = (l8 < 4) ? -1.f : 1.f;
    for (int m = F.gw; m < NTOK; m += F.NGW) {
        const int pos = m & (SEQ - 1);
        const f32x4* cp = (const f32x4*)(cs32 + (size_t)pos * 32 + 8 * (l8 & 3));
        const f32x4 c0 = cp[0], c1 = cp[1], c2 = cp[2], c3 = cp[3];
        bf16_t* row = qkv + (size_t)m * ODD_IN;
        u32x4 x[5];
#pragma unroll
        for (int i = 0; i < 5; ++i) { x[i] = (u32x4){0u, 0u, 0u, 0u}; if (i < 4 || lane < 32) x[i] = *(const u32x4*)(row + i * 512 + 8 * lane); }
        asm volatile("" ::: "memory");
#pragma unroll
        for (int i = 0; i < 5; ++i) {
            float v[8] = {bflo(x[i].x), bfhi(x[i].x), bflo(x[i].y), bfhi(x[i].y), bflo(x[i].z), bfhi(x[i].z), bflo(x[i].w), bfhi(x[i].w)};
            float ss = 0.f;
#pragma unroll
            for (int e = 0; e < 8; ++e) ss += v[e] * v[e];
            ss += __shfl_xor(ss, 1); ss += __shfl_xor(ss, 2); ss += __shfl_xor(ss, 4);
            const float rstd = 1.0f / sqrtf(ss * (1.0f / 64.0f) + EPS);
            const f32x4 g0 = i < 4 ? gq0 : gk0, g1 = i < 4 ? gq1 : gk1;
            v[0] *= rstd * g0.x; v[1] *= rstd * g0.y; v[2] *= rstd * g0.z; v[3] *= rstd * g0.w; v[4] *= rstd * g1.x; v[5] *= rstd * g1.y; v[6] *= rstd * g1.z; v[7] *= rstd * g1.w;
            float p[8];
#pragma unroll
            for (int e = 0; e < 8; ++e) p[e] = __shfl_xor(v[e], 4);
            u32x4 o;
            o.x = pk2(v[0] * c0.x + sg * p[0] * c0.y, v[1] * c0.z + sg * p[1] * c0.w); o.y = pk2(v[2] * c1.x + sg * p[2] * c1.y, v[3] * c1.z + sg * p[3] * c1.w);
            o.z = pk2(v[4] * c2.x + sg * p[4] * c2.y, v[5] * c2.z + sg * p[5] * c2.w); o.w = pk2(v[6] * c3.x + sg * p[6] * c3.y, v[7] * c3.z + sg * p[7] * c3.w);
            if (i < 4 || lane < 32) *(u32x4*)(row + i * 512 + 8 * lane) = o; }
    }
}
typedef float f32x16 __attribute__((ext_vector_type(16)));
DI f32x16 mfma32(bf16x8 a, bf16x8 b, f32x16 c) { return __builtin_amdgcn_mfma_f32_32x32x16_bf16(a, b, c, 0, 0, 0); }
DI void swa_phase(Frame& F, const float* sinks) {
    constexpr int KP = 144;
    bf16_t* qkv = (bf16_t*)(F.ws + WS_BIG + BIG_QKV1);
    LAS unsigned char* Ks = F.lds; LAS unsigned char* Vs = F.lds + 256 * KP;
    const unsigned vs_addr = (unsigned)(size_t)Vs;
    const int lane = F.lane, w = F.wave, h = lane >> 5, ql = lane & 31, q4 = (lane & 15) >> 2, p4 = lane & 3, blk = (lane >> 4) & 1;
    for (int unit = blockIdx.x; unit < 1024; unit += F.G) {
        const int b = unit >> 9, kvh = (unit >> 7) & 3, qb = unit & 127;
        const size_t tok0 = (size_t)b * SEQ + (size_t)qb * 128;
        __syncthreads();
#pragma unroll
        for (int i = 0; i < 4; ++i) { const int pc = F.tid + 512 * i, row = pc >> 3, c = pc & 7; const size_t tok = (qb == 0 && row < 128) ? tok0 : tok0 - 128 + row;
            const bf16_t* src = qkv + tok * ODD_IN + 2048 + kvh * 64 + c * 8;
            *(LAS u32x4*)(Ks + row * KP + c * 16) = *(const u32x4*)src; *(LAS u32x4*)(Vs + row * KP + c * 16) = *(const u32x4*)(src + 256); }
        __syncthreads();
        const int hq = kvh * 8 + w; const float sink = sinks[hq];
#pragma unroll 1
        for (int t = 0; t < 4; ++t) {
            bf16_t* qrow = qkv + (tok0 + 32 * t + ql) * ODD_IN + hq * 64;
            bf16x8 Qf[4];
#pragma unroll
            for (int s2 = 0; s2 < 4; ++s2) Qf[s2] = *(const bf16x8*)(qrow + 16 * s2 + 8 * h);
            f32x16 sc[5];
#pragma unroll
            for (int kt = 0; kt < 5; ++kt) {
#pragma unroll
                for (int r = 0; r < 16; ++r) sc[kt][r] = 0.f;
#pragma unroll
                for (int s2 = 0; s2 < 4; ++s2) { const bf16x8 a = *(const LAS bf16x8*)(Ks + (32 * (t + kt) + ql) * KP + (16 * s2 + 8 * h) * 2); sc[kt] = mfma32(a, Qf[s2], sc[kt]); } }
            float m = sink;
#pragma unroll
            for (int kt = 0; kt < 5; ++kt) { const bool tile_ok = !(qb == 0 && t + kt < 4);
#pragma unroll
                for (int r = 0; r < 16; ++r) { const int keyrow = (r & 3) + 8 * (r >> 2) + 4 * h; bool ok = tile_ok; if (kt == 0) ok = ok && (keyrow > ql); if (kt == 4) ok = ok && (keyrow <= ql);
                    const float v = ok ? sc[kt][r] * 0.125f : -1.0e30f; sc[kt][r] = v; m = fmaxf(m, v); } }
            m = fmaxf(m, __shfl_xor(m, 32));
            float l = 0.f;
#pragma unroll
            for (int kt = 0; kt < 5; ++kt)
#pragma unroll
                for (int r = 0; r < 16; ++r) { const float p = exp2f((sc[kt][r] - m) * 1.4426950408889634f); sc[kt][r] = p; l += p; }
            l += __shfl_xor(l, 32);
            l += exp2f((sink - m) * 1.4426950408889634f);
            f32x16 o0, o1;
#pragma unroll
            for (int r = 0; r < 16; ++r) { o0[r] = 0.f; o1[r] = 0.f; }
#pragma unroll
            for (int kt = 0; kt < 5; ++kt)
#pragma unroll
                for (int s2 = 0; s2 < 2; ++s2) { u32x4 pw; pw.x = pkbf(sc[kt][8 * s2], sc[kt][8 * s2 + 1]); pw.y = pkbf(sc[kt][8 * s2 + 2], sc[kt][8 * s2 + 3]); pw.z = pkbf(sc[kt][8 * s2 + 4], sc[kt][8 * s2 + 5]); pw.w = pkbf(sc[kt][8 * s2 + 6], sc[kt][8 * s2 + 7]);
                    const bf16x8 pb = __builtin_bit_cast(bf16x8, pw);
                    const unsigned ra = vs_addr + (unsigned)((32 * (t + kt) + 16 * s2 + 4 * h + q4) * KP + blk * 32 + p4 * 8);
                    s16x4 a00, a01, a10, a11; tr_read4(ra, ra + 8 * KP, ra + 64, ra + 8 * KP + 64, a00, a01, a10, a11);
                    o0 = mfma32(cat8(a00, a01), pb, o0); o1 = mfma32(cat8(a10, a11), pb, o1); }
            const float il = 1.0f / l;
            unsigned char* orow8 = F.ws + WS_H + (tok0 + 32 * t + ql) * D + hq * 64; const float il16 = il * 16.0f;
#pragma unroll
            for (int gq = 0; gq < 4; ++gq) { *(unsigned*)(orow8 + 8 * gq + 4 * h) = pk4fp8(o0[4 * gq] * il16, o0[4 * gq + 1] * il16, o0[4 * gq + 2] * il16, o0[4 * gq + 3] * il16);
                *(unsigned*)(orow8 + 32 + 8 * gq + 4 * h) = pk4fp8(o1[4 * gq] * il16, o1[4 * gq + 1] * il16, o1[4 * gq + 2] * il16, o1[4 * gq + 3] * il16); }
        }
    }
}

struct NoHandler { DI void operator()(int, float) const {} };
DI void moe_tables(Frame& F, const unsigned* cntg) {
    LAS int* cnt = (LAS int*)(F.lds + TBL_OFF); LAS int* tb = cnt + 32;
    __syncthreads();
    if (F.wave == 0) {
        const int e = F.lane & 31; const int c = (int)__hip_atomic_load(cntg + e * CSTR, __ATOMIC_RELAXED, __HIP_MEMORY_SCOPE_AGENT); const int t = (c + 255) >> 8; int inc = t;
#pragma unroll
        for (int d = 1; d < 32; d <<= 1) { const int o = __shfl_up(inc, d); if (e >= d) inc += o; }
        if (F.lane < 32) { cnt[e] = c; tb[e] = inc - t; if (e == 31) tb[32] = inc; } }
    __syncthreads();
}

constexpr int NPH = 19;

struct Args { const float* in[20]; float* out; unsigned char* ws; int ph_lo, ph_hi; };
__global__ void __launch_bounds__(NTHR, 2) mk_fwd(Args args) {
    extern __shared__ __attribute__((aligned(16))) unsigned char lds[];
    Frame F;
    F.lds = (LAS unsigned char*)lds; F.tid = threadIdx.x; F.lane = F.tid & 63; F.wave = __builtin_amdgcn_readfirstlane(F.tid >> 6); F.G = gridDim.x;
    F.gw = blockIdx.x * NWAVES + F.wave; F.NGW = F.G * NWAVES; F.ws = args.ws; F.ctl = (unsigned*)(args.ws + WS_CTL);
    volatile LAS unsigned* MISC = (volatile LAS unsigned*)(F.lds + MISC_OFF);
    if (F.tid < 64) MISC[F.tid] = 0u;
    __syncthreads();
    XcdBarrier bar; bar.bar = F.ctl + CW_BAR; bar.x = 0; bar.st = nullptr;
    if (!MK_MULTI) bar = xcd_barrier_post(F.ctl + CW_BAR, MISC + 8);
    const int lo = args.ph_lo, hi = args.ph_hi;
#ifdef ONLY_PH
#define IN(k) ((k) == ONLY_PH && lo <= (k) && (k) < hi)
#else
#define IN(k) (lo <= (k) && (k) < hi)
#endif
#define SEAM(k) do { if (IN(k) && IN((k) + 1)) xcd_barrier(bar); } while (0)
    const float* const* in = args.in;
    float* XC = args.out;
    bf16_t* XC16 = (bf16_t*)(F.ws + AUX_QN);
    bf16_t* H = (bf16_t*)(F.ws + WS_H);
    bf16_t* PJ = (bf16_t*)(F.ws + WS_BIG + BIG_PJ);
    unsigned char* aux = F.ws;
    const LAS int* tbl_cnt = (const LAS int*)(F.lds + TBL_OFF); const LAS int* tbl_tb = tbl_cnt + 32;
    LAS unsigned* tokoff = (LAS unsigned*)(F.lds + TOK_OFF);

    enum { P_W = 0, P_N0, P_G0, P_PREP, P_GA, P_SCAN, P_MIX, P_O0, P_M0A, P_M0B, P_M0C, P_N1, P_G1, P_SPREP, P_SWA, P_O1, P_M1A, P_M1B, P_M1C, P_FIN };
    static_assert(P_FIN == NPH, "phase count");
    if (IN(P_W)) { p0_weights(F, in); __syncthreads(); }
    SEAM(P_W);
    if (IN(P_N0)) {
        normproj_pass<0>(F, in[0], in[1], (const bf16_t*)(aux + AUX_SW), (const bf16_t*)(aux + AUX_SW) + 112 * D, H, (float*)(aux + AUX_BG), in[6], in[7], nullptr, nullptr, nullptr, nullptr);
    }
    SEAM(P_N0);
    if (IN(P_G0)) {
        pg8::EpiBf16 E{PJ, PJW};
        { pg8::DenseOrderT<1> S; S.init(NTOK, 8192, D, D, (const bf16_t*)(F.ws + WS_WIN0), F.G, blockIdx.x);
          pg8::gemm_phase(F.lds, H, D, S, E); }
        __syncthreads();
        { pg8::DenseOrderT<2> S; S.init(NTOK, 4096, D, D, F.ws + AUX_WIN8, F.G, blockIdx.x, 1);
          pg8::gemm_phase<pg8::EpiBf16, pg8::DenseOrderT<2>, true, 0x7a7a7a7a, 0x7d7d7d7d>(F.lds, F.ws + AUX_H8, D, S, E); }
    }
    SEAM(P_G0);
    if (IN(P_PREP)) p2_prep(F, in[5]);
    SEAM(P_PREP);
    if (IN(P_GA)) {
        for (int u = F.gw; u < 16 * NCH; u += F.NGW) {
            ga_unit<true>(F, u, (unsigned char*)args.out, nullptr);
            ga_unit<false>(F, u, F.ws + AUX_W, nullptr);
        }
        __syncthreads();
    }
    SEAM(P_GA);
    if (IN(P_SCAN)) {
        for (int id = blockIdx.x; id < 256; id += F.G) { const int idl = id & 127, bh = (idl % 8) * 2 + (idl / 8) / 8, sl = 2 * ((idl / 8) % 8);
            __syncthreads();
            if (F.tid == 0) { *(volatile LAS unsigned*)(F.lds + XL_CNT) = 0u; *(volatile LAS unsigned*)(F.lds + XL_CNT + 64) = 0u; }
            __syncthreads();
            if (id < 128) { if (F.wave == 0) scan_wave<true, 0>(F, bh, sl, (const unsigned char*)args.out, F.lds); else if (F.wave == 1) scan_wave<true, 1>(F, bh, sl, (const unsigned char*)args.out, F.lds); }
            else { if (F.wave == 0) scan_wave<false, 0>(F, bh, sl, F.ws + AUX_W, F.lds); else if (F.wave == 1) scan_wave<false, 1>(F, bh, sl, F.ws + AUX_W, F.lds); } }
        if (F.wave >= 2) { const int widx = blockIdx.x * 6 + (F.wave - 2), nw = F.G * 6;
            p0_late(F, in, widx, nw);
            convert_experts(F, in, 0, nullptr, F.ws + WS_WIN0, widx, nw, false, true);
            convert_experts(F, in, 1, F.ws + WS_EXP1, F.ws + WS_EXP1 + 96 * MiB, widx, nw); }
        __syncthreads();
    }
    SEAM(P_SCAN);
    if (IN(P_MIX)) p4_mixnorm(F, in[4], in[8]);
    SEAM(P_MIX);
    if (IN(P_O0)) {
        pg8::DenseOrder S; S.init(NTOK, D, 4096, PJW, (const bf16_t*)(F.ws + WS_WOUT0), F.G, blockIdx.x);
        pg8::EpiRes16<false> E{in[0], XC16, D};
        pg8::gemm_phase(F.lds, PJ + C_RG, 4096, S, E);
    }
    SEAM(P_O0);
#define MOE_LAYER(P, L, CNTW)                                                                                                                  \
    if (IN(P)) {                                                            \
        if (L == 0) convert_experts(F, in, 0, F.ws + WS_BIG + BIG_EGU, nullptr, F.gw, F.NGW, true, false);     \
        __syncthreads();                                                                \
        normproj_pass1(F, XC16, in[2] + L * D, (const bf16_t*)(aux + AUX_SW) + (16 + L * 48) * D, (const bf16_t*)(aux + AUX_SW) + (112 + 16 + L * 48) * D, H, F.ctl + CNTW, (int*)(aux + AUX_LIST), (float*)(aux + AUX_GW), (unsigned*)(aux + AUX_ASG)); \
        __syncthreads();                                                                                                                       \
    }                                                                                                                                          \
    SEAM(P);                                                                                                                                   \
    if (IN(P + 1)) {                                                                                                \
        moe_tables(F, F.ctl + CNTW);                                                                                                           \
        pg8::MoeOrder<true> S; S.init(tbl_tb, tokoff, 6, D, D, L == 0 ? F.ws + WS_BIG + BIG_EGU : F.ws + WS_EXP1, (size_t)1536 * D, F.G, blockIdx.x, 1);   \
        { pg8::Unit u; const int* list = (const int*)(aux + AUX_LIST);                                                                         \
          for (int ui = 0; ui < 12 && S.next(ui, u); ++ui) if (F.tid < 256) { const int idx = (u.pm - tbl_tb[u.e]) * 256 + F.tid;               \
              const int tok = idx < tbl_cnt[u.e] ? list[u.e * 65536 + idx] : 0; tokoff[ui * 256 + F.tid] = (unsigned)tok * (unsigned)D; } } \
        __syncthreads();                                                                                                                       \
        pg8::EpiSwiglu8 E{F.ws + WS_BIG + BIG_HID};                                                                                            \
        pg8::gemm_phase<pg8::EpiSwiglu8, pg8::MoeOrder<true>, true, 0x79797979, 0x7d7d7d7d>(F.lds, H, D, S, E);         \
    }                                                                                                                                          \
    SEAM(P + 1);                                                                                                                               \
    if (IN(P + 2)) {                                                                                  \
        moe_tables(F, F.ctl + CNTW);                                                                                                           \
        pg8::MoeOrder<false> S; S.init(tbl_tb, tokoff, 8, FF, FF, L == 0 ? F.ws + WS_WIN0 : F.ws + WS_EXP1 + 96 * MiB, (size_t)D * FF, F.G, blockIdx.x, 1);  \
        pg8::EpiDown E{(bf16_t*)(F.ws + WS_BIG + BIG_Y), (const float*)(aux + AUX_GW), tbl_tb};                                                \
        pg8::gemm_phase<pg8::EpiDown, pg8::MoeOrder<false>, true, 0x7a7a7a7a, 0x7c7c7c7c>(F.lds, F.ws + WS_BIG + BIG_HID, FF, S, E);     \
    }                                                                                                                                          \
    SEAM(P + 2);
    MOE_LAYER(P_M0A, 0, CW_CNT0)
    if (IN(P_N1)) {
        moe_tables(F, F.ctl + CW_CNT0);
        norm_pass<0, true, true, true, NoHandler, true, true, true>(F, XC16, XC16, (const bf16_t*)(F.ws + WS_BIG + BIG_Y), (const unsigned*)(aux + AUX_ASG), tbl_tb, in[1] + D, nullptr, H, NoHandler{});
        __syncthreads();
    }
    SEAM(P_N1);
    if (IN(P_G1)) {
        pg8::DenseOrder S; S.init(NTOK, ODD_IN, D, D, F.ws + WS_WIN1, F.G, blockIdx.x, 1);
        pg8::EpiBf16 E{(bf16_t*)(F.ws + WS_BIG + BIG_QKV1), ODD_IN};
        pg8::gemm_phase<pg8::EpiBf16, pg8::DenseOrder, true, 0x7a7a7a7a, 0x7d7d7d7d>(F.lds, H, D, S, E);
    }
    SEAM(P_G1);
    if (IN(P_SPREP)) p11_swaprep(F, in[11], in[12]);
    SEAM(P_SPREP);
    if (IN(P_SWA)) { swa_phase(F, in[13]); __syncthreads(); }
    SEAM(P_SWA);
    if (IN(P_O1)) {
        pg8::DenseOrder S; S.init(NTOK, D, D, D, F.ws + WS_WOUT1, F.G, blockIdx.x, 1);
        pg8::EpiRes16<true> E{XC16, XC16, D};
        pg8::gemm_phase<pg8::EpiRes16<true>, pg8::DenseOrder, true, 0x7a7a7a7a, 0x7b7b7b7b>(F.lds, F.ws + WS_H, D, S, E);
    }
    SEAM(P_O1);
    MOE_LAYER(P_M1A, 1, CW_CNT1)
    if (IN(P_FIN)) {
        moe_tables(F, F.ctl + CW_CNT1);
        norm_pass<0, true, true, false, NoHandler, false, true, false>(F, XC16, XC, (const bf16_t*)(F.ws + WS_BIG + BIG_Y), (const unsigned*)(aux + AUX_ASG), tbl_tb, nullptr, nullptr, nullptr, NoHandler{});
    }
#undef IN
#undef SEAM
}

extern "C" void kernel_launch(void* const* d_in, const int* in_sizes, int n_in, void* d_out, int out_size, void* d_ws, size_t ws_size, hipStream_t stream) {
    static int grid = 0;
    if (grid == 0) {
        if (n_in != 20 || in_sizes[0] != NTOK * D || out_size != NTOK * D || ws_size < WS_END) { fprintf(stderr, "kernel_launch: unexpected shapes / workspace (n_in %d, in0 %d, out %d, ws %zu, need %zu)\n", n_in, n_in > 0 ? in_sizes[0] : -1, out_size, ws_size, (size_t)WS_END); grid = -1; return; }
        int dev = 0, cus = 0, per_cu = 0;
        if (hipGetDevice(&dev) != hipSuccess || hipDeviceGetAttribute(&cus, hipDeviceAttributeMultiprocessorCount, dev) != hipSuccess) { grid = -1; return; }
        if (hipFuncSetAttribute((const void*)mk_fwd, hipFuncAttributeMaxDynamicSharedMemorySize, LDS_BYTES) != hipSuccess) { fprintf(stderr, "kernel_launch: hipFuncSetAttribute failed\n"); grid = -1; return; }
        if (hipOccupancyMaxActiveBlocksPerMultiprocessor(&per_cu, (const void*)mk_fwd, NTHR, LDS_BYTES) != hipSuccess || per_cu < 1) fprintf(stderr, "kernel_launch: occupancy query reports %d\n", per_cu);
        (void)hipGetLastError();
        if (cus < 256) { fprintf(stderr, "kernel_launch: built for 256 CUs (got %d)\n", cus); grid = -1; return; }
        grid = 256;
    }
    if (grid < 0) return;
    (void)hipMemsetAsync((char*)d_ws + WS_CTL, 0, CTL_ZERO_BYTES, stream);
    Args a{};
    for (int i = 0; i < 20; ++i) a.in[i] = (const float*)d_in[i];
    a.out = (float*)d_out; a.ws = (unsigned char*)d_ws;
#if MK_MULTI
    for (int p = 0; p <= NPH; ++p) { a.ph_lo = p; a.ph_hi = p + 1; hipLaunchKernelGGL(mk_fwd, dim3(grid), dim3(NTHR), LDS_BYTES, stream, a); }
#else
    a.ph_lo = 0; a.ph_hi = NPH + 1;
    hipLaunchKernelGGL(mk_fwd, dim3(grid), dim3(NTHR), LDS_BYTES, stream, a);
#endif
}
```

```cpp
#include <hip/hip_runtime.h>
#include <cstdio>
#include <cstdint>

#ifndef MK_MULTI
#define MK_MULTI 0
#endif

#define LAS __attribute__((address_space(3)))
typedef unsigned short bf16_t;
typedef short bf16x8 __attribute__((ext_vector_type(8)));
typedef float f32x4 __attribute__((ext_vector_type(4)));
typedef float f32x2 __attribute__((ext_vector_type(2)));
typedef unsigned u32x4 __attribute__((ext_vector_type(4)));
typedef unsigned u32x2 __attribute__((ext_vector_type(2)));
#define DI __device__ __forceinline__

constexpr int D = 2048, BATCH = 2, SEQ = 16384, NTOK = BATCH * SEQ;
constexpr int EVEN_IN = 12304, PJW = 12288;
constexpr int ODD_IN = 2560;
constexpr int NEXP = 32, FF = 768, TOPK = 2, MAXT = 288;
constexpr float EPS = 1e-6f;
constexpr double ROPE_R = 0.86596432336006535;
constexpr int C_RQ = 0, C_RK = 1024, C_RV = 2048, C_GQKV = 4096, C_RG = 8192, C_GZ = 10240;

constexpr size_t MiB = 1u << 20;
constexpr size_t WS_CTL = 0, CTL_ZERO_BYTES = 1 * MiB;
constexpr size_t WS_WIN0 = 2 * MiB;
constexpr size_t WS_WOUT0 = WS_WIN0 + 48 * MiB;
constexpr size_t WS_WIN1 = WS_WOUT0 + 16 * MiB;
constexpr size_t WS_WOUT1 = WS_WIN1 + 10 * MiB;
constexpr size_t WS_H = 84 * MiB;
constexpr size_t WS_BIG = 212 * MiB;
constexpr size_t WS_AUX = 980 * MiB;
constexpr size_t WS_MISC = 1540 * MiB;
constexpr size_t WS_EXP1 = 1396 * MiB;
constexpr size_t WS_END = 1572 * MiB;
constexpr size_t BIG_PJ = 0;
constexpr size_t BIG_EGU = 0;
constexpr size_t BIG_EDN = 192 * MiB;
constexpr size_t BIG_HID = 288 * MiB;
constexpr size_t BIG_Y = 400 * MiB;
constexpr size_t BIG_QKV1 = 0;
constexpr size_t AUX_QN = WS_AUX + 0;
constexpr size_t AUX_KN = WS_AUX + 64 * MiB;
constexpr size_t AUX_VC = WS_AUX + 128 * MiB;
constexpr size_t AUX_W = WS_AUX + 256 * MiB;
constexpr size_t AUX_ATT = WS_AUX + 320 * MiB;
constexpr size_t AUX_RST = WS_AUX + 352 * MiB;
constexpr size_t AUX_H8 = WS_AUX + 128 * MiB;
constexpr size_t AUX_WIN8 = WS_AUX + 256 * MiB;
constexpr size_t AUX_BG = WS_MISC + 0;
constexpr size_t AUX_CS = WS_MISC + 2 * MiB;
constexpr size_t AUX_DEC = WS_MISC + 10 * MiB + 960 * 1024;
constexpr size_t AUX_SW = WS_MISC + 10 * MiB;
constexpr size_t AUX_LIST = WS_MISC + 11 * MiB;
constexpr size_t AUX_GW = WS_MISC + 19 * MiB;
constexpr size_t AUX_ASG = WS_MISC + 27 * MiB;
constexpr size_t AUX_CS32 = WS_MISC + 28 * MiB;
static_assert(AUX_CS32 + 4 * MiB <= WS_END && AUX_W + 160 * MiB <= WS_EXP1 && WS_EXP1 + 144 * MiB <= WS_MISC, "aux map");
constexpr int CW_BAR = 4096;
constexpr int CSTR = 1088;
constexpr int CW_CNT0 = 16384, CW_CNT1 = 16384 + 40960;

constexpr int RING_BYTES = 131072;
constexpr int GA_LDS_WAVE = 17920;
constexpr int MISC_OFF = 8 * GA_LDS_WAVE;
constexpr int TBL_OFF = MISC_OFF + 256;
constexpr int TOK_OFF = MISC_OFF + 1024;
constexpr int LDS_BYTES = 163840;
static_assert(TOK_OFF + 12 * 1024 <= LDS_BYTES, "lds map");
DI float rdlane(float v, int l) { return __builtin_bit_cast(float, __builtin_amdgcn_readlane(__builtin_bit_cast(int, v), l)); }

typedef __bf16 bf16v2 __attribute__((ext_vector_type(2)));
DI unsigned pkbf(float a, float b) { f32x2 v = {a, b}; return __builtin_bit_cast(unsigned, __builtin_convertvector(v, bf16v2)); }
DI unsigned f2bf(float f) { return pkbf(f, 0.f) & 0xffffu; }
DI unsigned pk2(float lo, float hi) { return pkbf(lo, hi); }
DI float bflo(unsigned w) { return __builtin_bit_cast(float, w << 16); }
DI float bfhi(unsigned w) { return __builtin_bit_cast(float, w & 0xffff0000u); }
DI float bf2f(bf16_t b) { return __builtin_bit_cast(float, ((unsigned)b) << 16); }
DI unsigned cvt_pk_bf16(float lo, float hi) { unsigned r; asm volatile("v_cvt_pk_bf16_f32 %0, %1, %2" : "=v"(r) : "v"(lo), "v"(hi)); return r; }
DI float wave_sum(float v) {
#pragma unroll
    for (int o = 1; o < 64; o <<= 1) v += __shfl_xor(v, o);
    return v;
}
DI float dpp_x1(float v) { return __builtin_bit_cast(float, __builtin_amdgcn_mov_dpp(__builtin_bit_cast(int, v), 0xB1, 0xf, 0xf, true)); }
DI float dpp_x2(float v) { return __builtin_bit_cast(float, __builtin_amdgcn_mov_dpp(__builtin_bit_cast(int, v), 0x4E, 0xf, 0xf, true)); }
DI float dpp_r4(float v) { return __builtin_bit_cast(float, __builtin_amdgcn_mov_dpp(__builtin_bit_cast(int, v), 0x124, 0xf, 0xf, true)); }
DI float dpp_r8(float v) { return __builtin_bit_cast(float, __builtin_amdgcn_mov_dpp(__builtin_bit_cast(int, v), 0x128, 0xf, 0xf, true)); }
DI float dpp_hm(float v) { return __builtin_bit_cast(float, __builtin_amdgcn_mov_dpp(__builtin_bit_cast(int, v), 0x141, 0xf, 0xf, true)); }
DI float sum16_dpp(float v) { v += dpp_x1(v); v += dpp_x2(v); v += dpp_r4(v); v += dpp_r8(v); return v; }
DI float sum8_dpp(float v) { v += dpp_x1(v); v += dpp_x2(v); v += dpp_hm(v); return v; }
DI float siluf(float x) { return x / (1.0f + __expf(-x)); }
DI float siluf_r(float x) { return x * __builtin_amdgcn_rcpf(1.0f + __expf(-x)); }
DI unsigned pk4fp8(float a, float b, float c, float d) { int w = __builtin_amdgcn_cvt_pk_fp8_f32(a, b, 0, false); w = __builtin_amdgcn_cvt_pk_fp8_f32(c, d, w, true); return (unsigned)w; }
DI f32x4 mfma16(bf16x8 a, bf16x8 b, f32x4 c) { return __builtin_amdgcn_mfma_f32_16x16x32_bf16(a, b, c, 0, 0, 0); }
#define LDS_WAIT() asm volatile("s_waitcnt lgkmcnt(0)" ::: "memory")
#define VM_WAIT() asm volatile("s_waitcnt vmcnt(0)" ::: "memory")

#define XB_TMO      128
#define XB_XCNT(j)  (256  + 64 * (j))
#define XB_XSUB(j)  (1280 + 64 * (j))
#define XB_XGEN(j)  (2304 + 64 * (j))
#define XB_TOP      3328
#define XB_TOPGEN   3392
#define XCD_BAR_WORDS 3456
#define XB_SPIN_CAP (1u << 22)
DI unsigned xb_ld(unsigned* p)              { return __hip_atomic_load(p, __ATOMIC_RELAXED, __HIP_MEMORY_SCOPE_AGENT); }
DI unsigned xb_add(unsigned* p, unsigned v) { return __hip_atomic_fetch_add(p, v, __ATOMIC_RELAXED, __HIP_MEMORY_SCOPE_AGENT); }
DI unsigned xb_xcc_id() { return (unsigned)__builtin_amdgcn_s_getreg((3 << 11) | 20) & 0xFu; }
#define XB_SPIN(cond, bar) do { unsigned _sp = 0; while (cond) { __builtin_amdgcn_s_sleep(1); \
    if ((++_sp & 255u) == 0u) { if (xb_ld(&(bar)[XB_TMO])) break; if (_sp > XB_SPIN_CAP) { atomicAdd(&(bar)[XB_TMO], 1u); break; } } } } while (0)
struct XcdBarrier { unsigned* bar; unsigned x; volatile LAS unsigned* st; };
DI XcdBarrier xcd_barrier_post(unsigned* bar, volatile LAS unsigned* st) {
    XcdBarrier b; b.bar = bar; b.x = xb_xcc_id(); b.st = st;
    if (threadIdx.x == 0) (void)xb_add(&bar[XB_XCNT(b.x)], 1u);
    return b;
}
DI void xcd_barrier_complete(unsigned* bar, unsigned x, unsigned& nloc, unsigned& nx) {
    const unsigned G = gridDim.x * gridDim.y * gridDim.z;
    unsigned sum, cnt, mine, sp = 0u;
    for (;;) {
        sum = 0u; cnt = 0u; mine = 0u;
#pragma unroll
        for (unsigned j = 0; j < 16; ++j) { const unsigned c = xb_ld(&bar[XB_XCNT(j)]); sum += c; cnt += (c > 0u) ? 1u : 0u; mine = (j == x) ? c : mine; }
        if (sum == G) break;
        __builtin_amdgcn_s_sleep(1);
        if ((++sp & 255u) == 0u) { if (xb_ld(&bar[XB_TMO])) break; if (sp > XB_SPIN_CAP) { atomicAdd(&bar[XB_TMO], 1u); break; } }
    }
    nloc = mine > 0u ? mine : 1u; nx = cnt > 0u ? cnt : 1u;
}
DI void xcd_barrier(const XcdBarrier& b) {
    asm volatile("s_waitcnt vmcnt(0)" ::: "memory");
    __syncthreads();
    if (threadIdx.x == 0) {
        unsigned* bar = b.bar;
        __builtin_amdgcn_s_waitcnt(0);
        unsigned nloc = b.st[0], nx = b.st[1];
        if (nloc == 0u) { xcd_barrier_complete(bar, b.x, nloc, nx); b.st[0] = nloc; b.st[1] = nx; }
        const unsigned old = xb_add(&bar[XB_XSUB(b.x)], 1u);
        const unsigned gen = old / nloc;
        if (old + 1u == (gen + 1u) * nloc) {
            __builtin_amdgcn_fence(__ATOMIC_RELEASE, "agent");
            asm volatile("s_waitcnt vmcnt(0)" ::: "memory");
            const unsigned og = xb_add(&bar[XB_TOP], 1u);
            const unsigned tg = og / nx;
            if (og + 1u == (tg + 1u) * nx) xb_add(&bar[XB_TOPGEN], 1u);
            else XB_SPIN(xb_ld(&bar[XB_TOPGEN]) == tg, bar);
            __builtin_amdgcn_fence(__ATOMIC_ACQUIRE, "agent");
            xb_add(&bar[XB_XGEN(b.x)], 1u);
            asm volatile("s_waitcnt vmcnt(0)" ::: "memory");
        } else {
            XB_SPIN(xb_ld(&bar[XB_XGEN(b.x)]) == gen, bar);
            __builtin_amdgcn_fence(__ATOMIC_ACQUIRE, "agent");
            asm volatile("s_waitcnt vmcnt(0)" ::: "memory");
        }
    }
    __syncthreads();
}

namespace pg8 {
constexpr int BM = 256, BK = 64, HALF = 128, HTB = HALF * BK * 2, STAGE_BYTES = 8 * HTB, NXCD = 8, WGM = 8;
__host__ __device__ __forceinline__ int lds_byte(int r, int c) { const int st = (r >> 4) * 2 + (c >> 5), rr = r & 15, cc = c & 31, ob = rr * 64 + cc * 2; return st * 1024 + (ob ^ (((ob >> 9) & 1) << 5)); }
__host__ __device__ __forceinline__ void stage_rc(int b, int& R, int& C) { const int st = b / 1024, sb = b % 1024, swz = sb ^ (((sb >> 9) & 1) << 5); R = (st >> 1) * 16 + swz / 64; C = (st & 1) * 32 + (swz % 64) / 2; }
__host__ __device__ __forceinline__ int perm32(int rho) { const int n = rho >> 4, i = rho & 15; return 8 * (i >> 2) + 4 * n + (i & 3); }

struct Unit { int pm, pn, e, slot; };

DI int xcd_remap(int L, int nwg) { const int q = nwg / NXCD, r = nwg % NXCD, xcd = L % NXCD, off = L / NXCD; return (xcd < r ? xcd * (q + 1) : r * (q + 1) + (xcd - r) * q) + off; }

template <int MAP> struct DenseOrderT {
    int nM, nN, nwg, G, c; unsigned lda2; const char* Bt; size_t tstepB;
    DI void init(int M, int N, int K, int lda, const void* Bt_, int G_, int c_, int EB = 2) { nM = M / BM; nN = N / BM; nwg = nM * nN; G = G_; c = c_; lda2 = (unsigned)(lda * EB); Bt = (const char*)Bt_; tstepB = (size_t)BM * K * EB; }
    DI bool next(int i, Unit& u) const {
        const long L = (long)i * G + c; if (L >= nwg) return false;
        const int wgid = xcd_remap((int)L, nwg);
        const int nig = WGM * nN, gid = wgid / nig, fm = gid * WGM, gsz = (nM - fm) < WGM ? (nM - fm) : WGM;
        u.pm = fm + ((wgid % nig) % gsz); const int t = (wgid % nig) / gsz; u.pn = MAP == 0 ? t : (MAP == 1 ? (t < 8 ? t : (t < 16 ? t + 8 : t + 16)) : (t < 8 ? t + 8 : t + 16)); u.e = 0; u.slot = i; return true;
    }
    DI unsigned a_off(const Unit& u, int h, int R) const { return (unsigned)(u.pm * BM + h * HALF + R) * lda2; }
    DI const char* b_base(const Unit& u) const { return Bt + (size_t)u.pn * tstepB; }
};
typedef DenseOrderT<0> DenseOrder;
template <bool GATHER> struct MoeOrder {
    const LAS int* tb; const LAS unsigned* tokoff; int NT, nwg, G, c; unsigned lda2; const char* Bt; size_t estepB, tstepB;
    DI void init(const LAS int* tb_, const LAS unsigned* tokoff_, int NT_, int K, int lda, const void* Bt_, size_t estep_elems, int G_, int c_, int EB = 2) {
        tb = tb_; tokoff = tokoff_; NT = NT_; nwg = tb_[32] * NT_; G = G_; c = c_; lda2 = (unsigned)(lda * EB); Bt = (const char*)Bt_; estepB = estep_elems * EB; tstepB = (size_t)BM * K * EB; }
    DI bool next(int i, Unit& u) const {
        const long L = (long)i * G + c; if (L >= nwg) return false;
        const int w = xcd_remap((int)L, nwg);
        int e = 0;
#pragma unroll 1
        for (int s = 16; s >= 1; s >>= 1) if (tb[e + s] * NT <= w) e += s;
        const int nt = tb[e + 1] - tb[e], local = w - tb[e] * NT;
        u.e = e; u.pn = local / nt; u.pm = tb[e] + local % nt; u.slot = i; return true;
    }
    DI unsigned a_off(const Unit& u, int h, int R) const { if (GATHER) return tokoff[u.slot * 256 + h * HALF + R]; return (unsigned)(u.pm * BM + h * HALF + R) * lda2; }
    DI const char* b_base(const Unit& u) const { return Bt + (size_t)u.e * estepB + (size_t)u.pn * tstepB; }
};

struct EpiBf16 {
    static constexpr bool PERM = true; static constexpr int NVM = 16;
    bf16_t* O; int ldc;
    DI void operator()(const f32x4 (&acc)[2][2][4][2], const Unit& u, int wr, int wc, int fr, int fq) const {
        const int row0 = u.pm * BM + wr * 64 + fr, col0 = u.pn * BM + wc * 32 + 8 * fq;
#pragma unroll
        for (int ai = 0; ai < 2; ++ai)
#pragma unroll
            for (int m = 0; m < 4; ++m) { bf16_t* rowp = O + (size_t)(row0 + ai * HALF + m * 16) * ldc + col0;
#pragma unroll
                for (int bj = 0; bj < 2; ++bj) { const f32x4 v0 = acc[ai][bj][m][0], v1 = acc[ai][bj][m][1];
                    u32x4 w; w.x = cvt_pk_bf16(v0[0], v0[1]); w.y = cvt_pk_bf16(v0[2], v0[3]); w.z = cvt_pk_bf16(v1[0], v1[1]); w.w = cvt_pk_bf16(v1[2], v1[3]);
                    *(u32x4*)(rowp + bj * HALF) = w; } }
    }
};
struct EpiResF32 {
    static constexpr bool PERM = false; static constexpr int NVM = 0;
    const float* base; float* out; int ldc;
    DI void operator()(const f32x4 (&acc)[2][2][4][2], const Unit& u, int wr, int wc, int fr, int fq) const {
        const int row0 = u.pm * BM + wr * 64 + fr, col0 = u.pn * BM + wc * 32 + 4 * fq;
#pragma unroll
        for (int ai = 0; ai < 2; ++ai)
#pragma unroll
            for (int m = 0; m < 4; ++m) { const size_t off = (size_t)(row0 + ai * HALF + m * 16) * ldc + col0;
#pragma unroll
                for (int bj = 0; bj < 2; ++bj)
#pragma unroll
                    for (int n = 0; n < 2; ++n) { const f32x4 bs = *(const f32x4*)(base + off + bj * HALF + n * 16); *(f32x4*)(out + off + bj * HALF + n * 16) = bs + acc[ai][bj][m][n]; }
                asm volatile("" ::: "memory"); }
    }
};
template <bool BASE16> struct EpiRes16 {
    static constexpr bool PERM = true; static constexpr int NVM = 32;
    const void* base; bf16_t* out; int ldc;
    DI void operator()(const f32x4 (&acc)[2][2][4][2], const Unit& u, int wr, int wc, int fr, int fq) const {
        const int row0 = u.pm * BM + wr * 64 + fr, col0 = u.pn * BM + wc * 32 + 8 * fq;
#pragma unroll
        for (int ai = 0; ai < 2; ++ai)
#pragma unroll
            for (int m = 0; m < 4; ++m) { const size_t off = (size_t)(row0 + ai * HALF + m * 16) * ldc + col0;
#pragma unroll
                for (int bj = 0; bj < 2; ++bj) { f32x4 v0 = acc[ai][bj][m][0], v1 = acc[ai][bj][m][1];
                    if (BASE16) { const u32x4 b = *(const u32x4*)((const bf16_t*)base + off + bj * HALF); v0 += (f32x4){bflo(b.x), bfhi(b.x), bflo(b.y), bfhi(b.y)}; v1 += (f32x4){bflo(b.z), bfhi(b.z), bflo(b.w), bfhi(b.w)}; }
                    else { const float* bp = (const float*)base + off + bj * HALF; v0 += *(const f32x4*)bp; v1 += *(const f32x4*)(bp + 4); }
                    u32x4 w; w.x = cvt_pk_bf16(v0[0], v0[1]); w.y = cvt_pk_bf16(v0[2], v0[3]); w.z = cvt_pk_bf16(v1[0], v1[1]); w.w = cvt_pk_bf16(v1[2], v1[3]);
                    *(u32x4*)(out + off + bj * HALF) = w; }
                asm volatile("" ::: "memory"); }
    }
};
struct EpiSwiglu {
    static constexpr bool PERM = true; static constexpr int NVM = 8;
    bf16_t* O;
    DI void operator()(const f32x4 (&acc)[2][2][4][2], const Unit& u, int wr, int wc, int fr, int fq) const {
        const int row0 = u.pm * BM + wr * 64 + fr, col0 = u.pn * HALF + wc * 32 + 8 * fq;
#pragma unroll
        for (int ai = 0; ai < 2; ++ai)
#pragma unroll
            for (int m = 0; m < 4; ++m) { bf16_t* rowp = O + (size_t)(row0 + ai * HALF + m * 16) * FF + col0;
                float h[8];
#pragma unroll
                for (int n = 0; n < 2; ++n)
#pragma unroll
                    for (int j = 0; j < 4; ++j) { const float g = acc[ai][0][m][n][j], up = acc[ai][1][m][n][j]; h[n * 4 + j] = g * __builtin_amdgcn_rcpf(1.0f + __expf(-g)) * up; }
                u32x4 w; w.x = cvt_pk_bf16(h[0], h[1]); w.y = cvt_pk_bf16(h[2], h[3]); w.z = cvt_pk_bf16(h[4], h[5]); w.w = cvt_pk_bf16(h[6], h[7]);
                *(u32x4*)rowp = w; }
    }
};
struct EpiSwiglu8 {
    static constexpr bool PERM = true; static constexpr int NVM = 8;
    unsigned char* O;
    DI void operator()(const f32x4 (&acc)[2][2][4][2], const Unit& u, int wr, int wc, int fr, int fq) const {
        const int row0 = u.pm * BM + wr * 64 + fr, col0 = u.pn * HALF + wc * 32 + 8 * fq;
#pragma unroll
        for (int ai = 0; ai < 2; ++ai)
#pragma unroll
            for (int m = 0; m < 4; ++m) { unsigned char* rowp = O + (size_t)(row0 + ai * HALF + m * 16) * FF + col0;
                float h[8];
#pragma unroll
                for (int n = 0; n < 2; ++n)
#pragma unroll
                    for (int j = 0; j < 4; ++j) { const float g = acc[ai][0][m][n][j], up = acc[ai][1][m][n][j]; h[n * 4 + j] = g * __builtin_amdgcn_rcpf(1.0f + __expf(-g)) * (up * 8.0f); }
                u32x2 w; w.x = pk4fp8(h[0], h[1], h[2], h[3]); w.y = pk4fp8(h[4], h[5], h[6], h[7]);
                *(u32x2*)rowp = w; }
    }
};
struct EpiDown {
    static constexpr bool PERM = true; static constexpr int NVM = 16;
    bf16_t* O;
    DI void operator()(const f32x4 (&acc)[2][2][4][2], const Unit& u, int wr, int wc, int fr, int fq) const {
        const int row0 = u.pm * BM + wr * 64 + fr, col0 = u.pn * BM + wc * 32 + 8 * fq;
#pragma unroll
        for (int ai = 0; ai < 2; ++ai)
#pragma unroll
            for (int m = 0; m < 4; ++m) { unsigned char* rowp = (unsigned char*)O + (size_t)(row0 + ai * HALF + m * 16) * D + col0; const float g = 16.0f;
#pragma unroll
                for (int bj = 0; bj < 2; ++bj) { const f32x4 v0 = acc[ai][bj][m][0] * g, v1 = acc[ai][bj][m][1] * g;
                    u32x2 w; w.x = pk4fp8(v0[0], v0[1], v0[2], v0[3]); w.y = pk4fp8(v1[0], v1[1], v1[2], v1[3]);
                    *(u32x2*)(rowp + bj * HALF) = w; } }
    }
};

typedef int v8i __attribute__((ext_vector_type(8)));
typedef int v4i __attribute__((ext_vector_type(4)));
template <class Epi, class Sched, bool FP8 = false, int SCW = 0x7f7f7f7f, int SCA = 0x7f7f7f7f>
DI void gemm_phase(LAS unsigned char* lds, const void* Aptr, int K, const Sched& S, const Epi& E) {
    constexpr int EB = FP8 ? 1 : 2;
    const int tid = threadIdx.x, wid = __builtin_amdgcn_readfirstlane(tid >> 6), lane = tid & 63, wr = wid >> 2, wc = wid & 3, fr = lane & 15, fq = lane >> 4;
    const int nt = K * EB / (BK * 2);
    const char* Ab = (const char*)Aptr;
    int Rr[2], Cc[2]; unsigned voffB[2];
#pragma unroll
    for (int i = 0; i < 2; ++i) { int R, C; stage_rc(tid * 16 + i * 8192, R, C); const int Rb = Epi::PERM ? ((R & ~31) + perm32(R & 31)) : R; Rr[i] = R; Cc[i] = C * 2; voffB[i] = (unsigned)(Rb * K * EB + C * 2); }
    const unsigned kstep = (unsigned)(BK * 2);
    const size_t hstepB = (size_t)HALF * K * EB;
    const unsigned ldsw = (unsigned)wid * 1024u;
    const int aoff = lds_byte(wr * 64 + fr, fq * (FP8 ? 16 : 8)), boff = lds_byte(wc * 32 + fr, fq * (FP8 ? 16 : 8));
#define PG8_SA(b, h) (((b) * 2 + (h)) * HTB)
#define PG8_SB(b, h) ((4 + (b) * 2 + (h)) * HTB)
#define PG8_STAGEB(bufoff, gbase) do { _Pragma("unroll") for (int _i = 0; _i < 2; ++_i) \
        __builtin_amdgcn_global_load_lds((const unsigned*)((const char*)(gbase) + voffB[_i]), (LAS unsigned*)(lds + (bufoff) + ldsw + _i * 8192), 16, 0, 0); } while (0)
#define PG8_STAGEA(bufoff, offs, kb) do { _Pragma("unroll") for (int _i = 0; _i < 2; ++_i) \
        __builtin_amdgcn_global_load_lds((const unsigned*)(Ab + (size_t)((offs)[_i] + (kb))), (LAS unsigned*)(lds + (bufoff) + ldsw + _i * 8192), 16, 0, 0); } while (0)
#define PG8_LDA(dst, b, h) do { _Pragma("unroll") for (int m = 0; m < 4; ++m) { if constexpr (FP8) { dst##8[m] = *(const LAS v8i*)(lds + PG8_SA(b, h) + aoff + m * 2048); } \
        else { _Pragma("unroll") for (int k = 0; k < 2; ++k) dst[m][k] = *(const LAS bf16x8*)(lds + PG8_SA(b, h) + aoff + m * 2048 + k * 1024); } } } while (0)
#define PG8_LDB(dst, b, h) do { _Pragma("unroll") for (int n = 0; n < 2; ++n) { if constexpr (FP8) { dst##8[n] = *(const LAS v8i*)(lds + PG8_SB(b, h) + boff + n * 2048); } \
        else { _Pragma("unroll") for (int k = 0; k < 2; ++k) dst[n][k] = *(const LAS bf16x8*)(lds + PG8_SB(b, h) + boff + n * 2048 + k * 1024); } } } while (0)
#define PG8_MMA(ai, bj, At, Bt) do { __builtin_amdgcn_s_setprio(1); _Pragma("unroll") for (int m = 0; m < 4; ++m) _Pragma("unroll") for (int n = 0; n < 2; ++n) { \
        if constexpr (FP8) asm volatile("v_mfma_scale_f32_16x16x128_f8f6f4 %0, %1, %2, %0, %3, %4 op_sel_hi:[0,0,0]" : "+v"(acc[ai][bj][m][n]) : "v"(Bt##8[n]), "v"(At##8[m]), "v"(scw_), "v"(sca_)); \
        else { _Pragma("unroll") for (int k = 0; k < 2; ++k) acc[ai][bj][m][n] = __builtin_amdgcn_mfma_f32_16x16x32_bf16(Bt[n][k], At[m][k], acc[ai][bj][m][n], 0, 0, 0); } } __builtin_amdgcn_s_setprio(0); } while (0)
#define PG8_WAIT_V(n) asm volatile("s_waitcnt vmcnt(" #n ")" ::: "memory")
#define PG8_WAIT_L(n) asm volatile("s_waitcnt lgkmcnt(" #n ")" ::: "memory")
#define PG8_BAR __builtin_amdgcn_s_barrier()
#define PG8_SCHED __builtin_amdgcn_sched_barrier(0)
    Unit cur, nxt; int ui = 0;
    if (!S.next(0, cur)) return;
    f32x4 acc[2][2][4][2];
#pragma unroll
    for (int a = 0; a < 2; ++a)
#pragma unroll
        for (int b = 0; b < 2; ++b)
#pragma unroll
            for (int m = 0; m < 4; ++m)
#pragma unroll
                for (int n = 0; n < 2; ++n) acc[a][b][m][n] = (f32x4){0.f, 0.f, 0.f, 0.f};
    const int scw_ = SCW, sca_ = SCA; (void)scw_; (void)sca_;
    bf16x8 At[4][2], B0[2][2], B1[2][2]; v8i At8[4], B08[2], B18[2]; (void)At; (void)B0; (void)B1; (void)At8; (void)B08; (void)B18;
    unsigned ao[2][2];
#pragma unroll
    for (int h = 0; h < 2; ++h)
#pragma unroll
        for (int i = 0; i < 2; ++i) ao[h][i] = S.a_off(cur, h, Rr[i]) + (unsigned)Cc[i];
    const char* cB = S.b_base(cur);
    PG8_STAGEB(PG8_SB(0, 0), cB); PG8_STAGEB(PG8_SB(0, 1), cB + hstepB); PG8_STAGEA(PG8_SA(0, 0), ao[0], 0u); PG8_STAGEA(PG8_SA(0, 1), ao[1], 0u);
    if (wr == 1) PG8_BAR;
    PG8_WAIT_V(2); PG8_BAR;
    PG8_STAGEB(PG8_SB(1, 0), cB + kstep); PG8_STAGEA(PG8_SA(1, 0), ao[0], kstep); PG8_STAGEB(PG8_SB(1, 1), cB + hstepB + kstep);
    PG8_WAIT_V(6); PG8_BAR;
    for (;;) {
        const bool has_next = S.next(ui + 1, nxt);
        const char* nB = has_next ? S.b_base(nxt) : cB;
#pragma unroll 1
        for (int t = 0; t < nt; t += 2) {
            const bool last = (t == nt - 2);
            const unsigned kb1 = (unsigned)(t + 1) * kstep, kb2 = (unsigned)(t + 2) * kstep;
            unsigned x2[2][2];
#pragma unroll
            for (int h = 0; h < 2; ++h)
#pragma unroll
                for (int i = 0; i < 2; ++i) x2[h][i] = last ? (has_next ? (S.a_off(nxt, h, Rr[i]) + (unsigned)Cc[i]) : ao[h][i]) : ao[h][i] + kb2;
            const char* b2 = last ? nB : cB + kb2; const char* b3 = b2 + kstep;
            const bool relax = (t == 0) && (ui > 0);
            PG8_LDB(B0, 0, 0); PG8_LDB(B1, 0, 1); PG8_SCHED; PG8_LDA(At, 0, 0); PG8_STAGEA(PG8_SA(1, 1), ao[1], kb1);
            if (relax) asm volatile("s_waitcnt vmcnt(%0)" :: "n"(8 + Epi::NVM) : "memory"); else PG8_WAIT_V(8);
            PG8_WAIT_L(0); PG8_BAR; PG8_MMA(0, 0, At, B0); PG8_MMA(0, 1, At, B1); PG8_BAR; PG8_SCHED;
            PG8_LDA(At, 0, 1); PG8_STAGEB(PG8_SB(0, 0), b2); PG8_STAGEB(PG8_SB(0, 1), b2 + hstepB); PG8_STAGEA(PG8_SA(0, 0), x2[0], 0u);
            if (relax) asm volatile("s_waitcnt vmcnt(%0)" :: "n"(8 + Epi::NVM) : "memory"); else PG8_WAIT_V(8);
            PG8_WAIT_L(0); PG8_BAR; PG8_MMA(1, 0, At, B0); PG8_MMA(1, 1, At, B1); PG8_BAR; PG8_SCHED;
            PG8_LDB(B0, 1, 0); PG8_LDB(B1, 1, 1); PG8_SCHED; PG8_LDA(At, 1, 0); PG8_STAGEA(PG8_SA(0, 1), x2[1], 0u);
            PG8_WAIT_V(8); PG8_WAIT_L(0); PG8_BAR; PG8_MMA(0, 0, At, B0); PG8_MMA(0, 1, At, B1); PG8_BAR; PG8_SCHED;
            PG8_LDA(At, 1, 1); PG8_STAGEB(PG8_SB(1, 0), b3); PG8_STAGEB(PG8_SB(1, 1), b3 + hstepB); PG8_STAGEA(PG8_SA(1, 0), x2[0], kstep);
            PG8_WAIT_V(8); PG8_WAIT_L(0); PG8_BAR; PG8_MMA(1, 0, At, B0); PG8_MMA(1, 1, At, B1); PG8_BAR; PG8_SCHED;
        }
        if (wr == 0) PG8_BAR;
        if constexpr (FP8) asm volatile("s_nop 15" ::: "memory");
        E(acc, cur, wr, wc, fr, fq);
        if (!has_next) break;
#pragma unroll
        for (int a = 0; a < 2; ++a)
#pragma unroll
            for (int b = 0; b < 2; ++b)
#pragma unroll
                for (int m = 0; m < 4; ++m)
#pragma unroll
                    for (int n = 0; n < 2; ++n) acc[a][b][m][n] = (f32x4){0.f, 0.f, 0.f, 0.f};
        cur = nxt; cB = nB; ++ui;
#pragma unroll
        for (int h = 0; h < 2; ++h)
#pragma unroll
            for (int i = 0; i < 2; ++i) ao[h][i] = S.a_off(cur, h, Rr[i]) + (unsigned)Cc[i];
        if (wr == 1) PG8_BAR;
    }
    PG8_WAIT_V(0);
    PG8_BAR;
#undef PG8_SA
#undef PG8_SB
#undef PG8_STAGEA
#undef PG8_STAGEB
#undef PG8_LDA
#undef PG8_LDB
#undef PG8_MMA
#undef PG8_WAIT_V
#undef PG8_WAIT_L
#undef PG8_BAR
#undef PG8_SCHED
}
}

constexpr int NWAVES = 8, NTHR = 512;
struct Frame {
    LAS unsigned char* lds;
    int tid, lane, wave, G, gw, NGW;
    unsigned* ctl;
    unsigned char* ws;
};

DI void transpose_item(const float* Wseg, int ldw, int ncols, int K, bf16_t* WT, int row_off, LAS float* scr, int item, int lane) {
    const int nblk = ncols / 32, kb = item / nblk, nb = item % nblk, k0 = 64 * kb, n0 = 32 * nb;
#pragma unroll 8
    for (int i = 0; i < 32; ++i) { const int kk = 2 * i + (lane >> 5); scr[kk * 33 + (lane & 31)] = Wseg[(size_t)(k0 + kk) * ldw + n0 + (lane & 31)]; }
    LDS_WAIT(); asm volatile("" ::: "memory");
    const int c = lane & 7;
#pragma unroll
    for (int j = 0; j < 4; ++j) { const int n = (lane >> 3) + 8 * j; const LAS float* s = scr + (8 * c) * 33 + n;
        u32x4 o; o.x = pk2(s[0 * 33], s[1 * 33]); o.y = pk2(s[2 * 33], s[3 * 33]); o.z = pk2(s[4 * 33], s[5 * 33]); o.w = pk2(s[6 * 33], s[7 * 33]);
        *(u32x4*)(WT + (size_t)(row_off + n0 + n) * K + k0 + 8 * c) = o; }
    LDS_WAIT(); asm volatile("" ::: "memory");
}

DI void transpose_item8(const float* Wseg, int ldw, int ncols, int K, unsigned char* WT, int row_off, LAS float* scr, int item, int lane, float qs) {
    const int nblk = ncols / 32, kb = item / nblk, nb = item % nblk, k0 = 128 * kb, n0 = 32 * nb;
    const float* wp = Wseg + (size_t)(k0 + (lane >> 5)) * ldw + n0 + (lane & 31);
#pragma unroll
    for (int hb = 0; hb < 2; ++hb) { float v[32];
#pragma unroll
        for (int i = 0; i < 32; ++i) v[i] = wp[(size_t)(64 * hb + 2 * i) * ldw];
#pragma unroll
        for (int i = 0; i < 32; ++i) scr[(64 * hb + 2 * i + (lane >> 5)) * 33 + (lane & 31)] = v[i] * qs; }
    LDS_WAIT(); asm volatile("" ::: "memory");
    const int n = lane >> 1, hf = lane & 1; const LAS float* sp = scr + (64 * hf) * 33 + n;
    unsigned char* dst = WT + (size_t)(row_off + n0 + n) * K + k0 + 64 * hf;
#pragma unroll
    for (int q = 0; q < 4; ++q) { u32x4 o;
        o.x = pk4fp8(sp[(16 * q + 0) * 33], sp[(16 * q + 1) * 33], sp[(16 * q + 2) * 33], sp[(16 * q + 3) * 33]); o.y = pk4fp8(sp[(16 * q + 4) * 33], sp[(16 * q + 5) * 33], sp[(16 * q + 6) * 33], sp[(16 * q + 7) * 33]);
        o.z = pk4fp8(sp[(16 * q + 8) * 33], sp[(16 * q + 9) * 33], sp[(16 * q + 10) * 33], sp[(16 * q + 11) * 33]); o.w = pk4fp8(sp[(16 * q + 12) * 33], sp[(16 * q + 13) * 33], sp[(16 * q + 14) * 33], sp[(16 * q + 15) * 33]);
        *(u32x4*)(dst + 16 * q) = o; }
    LDS_WAIT(); asm volatile("" ::: "memory");
}
DI void p0_weights(Frame& F, const float* const* in) {
    LAS float* scr = (LAS float*)(F.lds + F.wave * 16896);
    bf16_t* win0 = (bf16_t*)(F.ws + WS_WIN0); bf16_t* wout0 = (bf16_t*)(F.ws + WS_WOUT0); bf16_t* win1 = (bf16_t*)(F.ws + WS_WIN1); bf16_t* wout1 = (bf16_t*)(F.ws + WS_WOUT1);
    const float* ewin = in[3]; const float* ewout = in[9]; const float* owin = in[10]; const float* owout = in[14];
    constexpr int KB = D / 64;
    constexpr int I_A = KB * (2048 / 32), I_B = KB * (2048 / 32), I_8 = (D / 128) * (2048 / 32);
    constexpr int I_O0 = (4096 / 64) * (D / 32), I_I1 = (D / 128) * (ODD_IN / 32), I_O1 = (D / 128) * (D / 32);
    constexpr int NIT = I_A + I_B + 2 * I_8 + 2 * I_A;
    unsigned char* win8 = F.ws + AUX_WIN8; (void)wout0; (void)win1; (void)wout1; (void)ewout; (void)owin; (void)owout; (void)I_O0; (void)I_I1; (void)I_O1;
    (void)NIT;
    { const int lane = F.lane; constexpr int NB16 = 4 * I_A;
      float v[32]; const float* wp = nullptr; bf16_t* dp = nullptr; const float* wpn = nullptr; bf16_t* dpn = nullptr;
#define TB_ITEM(WP, DP, IT) do { const int it_ = (IT), sg_ = it_ / I_A, r_ = it_ % I_A, kb_ = r_ / 64, nb_ = r_ % 64; const int src_ = sg_ == 0 ? 0 : (sg_ == 1 ? 6144 : (sg_ == 2 ? 4096 : 10240)), ro_ = sg_ == 0 ? C_RQ : (sg_ == 1 ? C_GQKV : (sg_ == 2 ? C_RG : C_GZ)); \
        WP = ewin + src_ + (size_t)(64 * kb_ + (lane >> 5)) * EVEN_IN + 32 * nb_ + (lane & 31); DP = win0 + (size_t)(ro_ + 32 * nb_ + (lane >> 3)) * D + 64 * kb_ + 8 * (lane & 7); } while (0)
      int it = F.gw;
      if (it < NB16) { TB_ITEM(wp, dp, it);
#pragma unroll
          for (int i = 0; i < 32; ++i) v[i] = wp[(size_t)(2 * i) * EVEN_IN]; }
      while (it < NB16) {
          asm volatile("" ::: "memory");
#pragma unroll
          for (int i = 0; i < 32; ++i) scr[(2 * i + (lane >> 5)) * 33 + (lane & 31)] = v[i];
          asm volatile("" ::: "memory");
          const int nx = it + F.NGW;
          if (nx < NB16) { TB_ITEM(wpn, dpn, nx);
#pragma unroll
              for (int i = 0; i < 32; ++i) v[i] = wpn[(size_t)(2 * i) * EVEN_IN]; }
          LDS_WAIT(); asm volatile("" ::: "memory");
          { const int c = lane & 7;
#pragma unroll
            for (int j = 0; j < 4; ++j) { const int n = (lane >> 3) + 8 * j; const LAS float* sp = scr + (8 * c) * 33 + n;
                u32x4 o; o.x = pk2(sp[0 * 33], sp[1 * 33]); o.y = pk2(sp[2 * 33], sp[3 * 33]); o.z = pk2(sp[4 * 33], sp[5 * 33]); o.w = pk2(sp[6 * 33], sp[7 * 33]);
                *(u32x4*)(dp + (size_t)(8 * j) * D) = o; } }
          LDS_WAIT(); asm volatile("" ::: "memory");
          wp = wpn; dp = dpn; it = nx;
      }
#undef TB_ITEM
    }
    for (int it = F.gw; it < 2 * I_8; it += F.NGW) {
        if (it < I_8) transpose_item8(ewin + 2048, EVEN_IN, 2048, D, win8, C_RV, scr, it, F.lane, 32.f);
        else transpose_item8(ewin + 8192, EVEN_IN, 2048, D, win8, C_GQKV + 2048, scr, it - I_8, F.lane, 32.f);
    }
    bf16_t* swh = (bf16_t*)(F.ws + AUX_SW); bf16_t* swl = swh + 112 * D;
    const int gt = (F.gw * 64 + F.lane), NGT = F.NGW * 64;
    for (int i = gt; i < 112 * D; i += NGT) { const int c = i / D, k = i % D; float v;
        if (c < 16) v = ewin[(size_t)k * EVEN_IN + 12288 + c] * in[1][k];
        else { const int l = (c - 16) / 48, cc = (c - 16) % 48; const float gn = in[2][l * D + k]; v = cc < 4 ? in[15][(size_t)l * D * 4 + k * 4 + cc] * gn : (cc < 36 ? in[16][(size_t)l * D * 32 + k * 32 + (cc - 4)] * gn : 0.f); }
        const unsigned hb = f2bf(v); const float lo = v - __builtin_bit_cast(float, hb << 16); swh[i] = (bf16_t)hb; swl[i] = (bf16_t)f2bf(lo); }
    f32x2* cs = (f32x2*)(F.ws + AUX_CS);
    for (int i = gt; i < SEQ * 64; i += NGT) { const int pos = i >> 6, fi = i & 63; double inv = 1.0;
        for (int q = 0; q < fi; ++q) inv *= ROPE_R;
        const double x = (double)pos * inv, k = __builtin_rint(x * 0.15915494309189535), r = (x - k * 6.283185307179586) - k * 2.4492935982947064e-16;
        const float rf = (float)r; const f32x2 v = {cosf(rf), sinf(rf)}; cs[i] = v; if ((fi & 1) == 0) ((f32x2*)(F.ws + AUX_CS32))[pos * 32 + (fi >> 1)] = v; }
}
DI void p0_late(Frame& F, const float* const* in, int widx, int nw) {
    LAS float* scr = (LAS float*)(F.lds + F.wave * 16896);
    constexpr int I_O0 = (4096 / 64) * (D / 32), I_I1 = (D / 128) * (ODD_IN / 32), I_O1 = (D / 128) * (D / 32);
    for (int it = widx; it < I_O0 + I_I1 + I_O1; it += nw) {
        int r = it;
        if (r < I_O0) { transpose_item(in[9], D, D, 4096, (bf16_t*)(F.ws + WS_WOUT0), 0, scr, r, F.lane); continue; } r -= I_O0;
        if (r < I_I1) { transpose_item8(in[10], ODD_IN, ODD_IN, D, F.ws + WS_WIN1, 0, scr, r, F.lane, 32.f); continue; } r -= I_I1;
        transpose_item8(in[14], D, D, D, F.ws + WS_WOUT1, 0, scr, r, F.lane, 32.f);
    }
}
struct T8Item { const float* wp; size_t ldw; unsigned char* dst; float qs; };
DI T8Item t8_item(const float* Wseg, int ldw, int ncols, int K, unsigned char* WT, int row_off, int item, int lane, float qs) {
    const int nblk = ncols / 32, kb = item / nblk, nb = item % nblk, k0 = 128 * kb, n0 = 32 * nb;
    T8Item t; t.wp = Wseg + (size_t)(k0 + (lane >> 5)) * ldw + n0 + (lane & 31); t.ldw = (size_t)ldw; t.dst = WT + (size_t)(row_off + n0 + (lane >> 1)) * K + k0 + 64 * (lane & 1); t.qs = qs; return t;
}
DI void t8_issue(float (&v)[64], const T8Item& t) {
#pragma unroll
    for (int i = 0; i < 64; ++i) v[i] = t.wp[(size_t)(2 * i) * t.ldw];
}
DI void t8_to_lds(const float (&v)[64], const T8Item& t, LAS float* scr, int lane) {
#pragma unroll
    for (int i = 0; i < 64; ++i) scr[(2 * i + (lane >> 5)) * 33 + (lane & 31)] = v[i] * t.qs;
}
DI void t8_finish(const T8Item& t, LAS float* scr, int lane) {
    const LAS float* sp = scr + (64 * (lane & 1)) * 33 + (lane >> 1);
#pragma unroll
    for (int q = 0; q < 4; ++q) { u32x4 o;
        o.x = pk4fp8(sp[(16 * q + 0) * 33], sp[(16 * q + 1) * 33], sp[(16 * q + 2) * 33], sp[(16 * q + 3) * 33]); o.y = pk4fp8(sp[(16 * q + 4) * 33], sp[(16 * q + 5) * 33], sp[(16 * q + 6) * 33], sp[(16 * q + 7) * 33]);
        o.z = pk4fp8(sp[(16 * q + 8) * 33], sp[(16 * q + 9) * 33], sp[(16 * q + 10) * 33], sp[(16 * q + 11) * 33]); o.w = pk4fp8(sp[(16 * q + 12) * 33], sp[(16 * q + 13) * 33], sp[(16 * q + 14) * 33], sp[(16 * q + 15) * 33]);
        *(u32x4*)(t.dst + 16 * q) = o; }
}
DI void convert_experts(Frame& F, const float* const* in, int l, unsigned char* gu, unsigned char* dn, int widx, int nw, bool do_gu = true, bool do_dn = true) {
    LAS float* scr = (LAS float*)(F.lds + F.wave * 16896);
    const float* wg = in[17] + (size_t)l * NEXP * D * FF; const float* wu = in[18] + (size_t)l * NEXP * D * FF; const float* wd = in[19] + (size_t)l * NEXP * FF * D;
    constexpr int I_G = (D / 128) * (128 / 32);
    constexpr int I_GU = NEXP * 6 * 2 * I_G;
    constexpr int I_DE = (FF / 128) * (D / 32);
    constexpr int NIT = I_GU + NEXP * I_DE;
    const int lane = F.lane;
    const int hi = do_dn ? NIT : I_GU;
    int it = (do_gu ? 0 : I_GU) + widx;
    float v[64];
    T8Item cur, nxt;
#define EXPERT_ITEM(T, IT) do { const int it_ = (IT); const bool g_ = it_ < I_GU; const int seg_ = it_ / I_G, r2_ = it_ - I_GU; const int e_ = g_ ? seg_ / 12 : r2_ / I_DE, sg_ = seg_ % 12, pn_ = sg_ >> 1, up_ = sg_ & 1;  \
        const float* src_ = g_ ? (up_ ? wu : wg) + (size_t)e_ * D * FF + pn_ * 128 : wd + (size_t)e_ * FF * D;                                                                                          \
        unsigned char* wt_ = g_ ? gu + (size_t)e_ * 1536 * D : dn + (size_t)e_ * D * FF;                                                                                                                 \
        T = t8_item(src_, g_ ? FF : D, g_ ? 128 : D, g_ ? D : FF, wt_, g_ ? pn_ * 256 + up_ * 128 : 0, g_ ? it_ % I_G : r2_ % I_DE, lane, g_ ? 64.f : 32.f); } while (0)
    if (it < hi) {
        EXPERT_ITEM(cur, it);
        t8_issue(v, cur);
        bool more = true;
        while (more) {
            asm volatile("" ::: "memory");
            t8_to_lds(v, cur, scr, lane);
            asm volatile("" ::: "memory");
            const int nx = it + nw; more = nx < hi;
            EXPERT_ITEM(nxt, more ? nx : it);
            if (more) t8_issue(v, nxt);
            LDS_WAIT(); asm volatile("" ::: "memory");
            t8_finish(cur, scr, lane);
            LDS_WAIT(); asm volatile("" ::: "memory");
            cur = nxt; it = nx;
        }
    }
#undef EXPERT_ITEM
}

template <int NP, bool ADDY, bool WRITEX, bool WRITEH, class Handler, bool H8 = false, bool SRC16 = false, bool DST16 = false>
DI void norm_pass(Frame& F, const void* src, void* dst, const bf16_t* y, const unsigned* asg, const LAS int* tb, const float* gain, const float* Wt, bf16_t* H, Handler hnd) {
    for (int m = F.gw; m < NTOK; m += F.NGW) {
        f32x4 v[8];
        if (SRC16) { const u32x2* xr = (const u32x2*)((const bf16_t*)src + (size_t)m * D) + F.lane;
#pragma unroll
            for (int j = 0; j < 8; ++j) { const u32x2 b = xr[64 * j]; v[j] = (f32x4){bflo(b.x), bfhi(b.x), bflo(b.y), bfhi(b.y)}; } }
        else { const f32x4* xr = (const f32x4*)((const float*)src + (size_t)m * D) + F.lane;
#pragma unroll
            for (int j = 0; j < 8; ++j) v[j] = xr[64 * j]; }
        if (ADDY) {
            const unsigned a0 = asg[2 * m], a1 = asg[2 * m + 1];
            const float* gwp = (const float*)(F.ws + AUX_GW); const float g0 = gwp[a0] * 0.0625f, g1 = gwp[a1] * 0.0625f;
            const size_t r0 = (size_t)tb[a0 >> 16] * 256 + (a0 & 0xffffu), r1 = (size_t)tb[a1 >> 16] * 256 + (a1 & 0xffffu);
            const unsigned* y0 = (const unsigned*)((const unsigned char*)y + r0 * D) + F.lane; const unsigned* y1 = (const unsigned*)((const unsigned char*)y + r1 * D) + F.lane;
#pragma unroll
            for (int j = 0; j < 8; ++j) { const int p = (int)y0[64 * j], q = (int)y1[64 * j];
                v[j].x += __builtin_amdgcn_cvt_f32_fp8(p, 0) * g0 + __builtin_amdgcn_cvt_f32_fp8(q, 0) * g1; v[j].y += __builtin_amdgcn_cvt_f32_fp8(p, 1) * g0 + __builtin_amdgcn_cvt_f32_fp8(q, 1) * g1;
                v[j].z += __builtin_amdgcn_cvt_f32_fp8(p, 2) * g0 + __builtin_amdgcn_cvt_f32_fp8(q, 2) * g1; v[j].w += __builtin_amdgcn_cvt_f32_fp8(p, 3) * g0 + __builtin_amdgcn_cvt_f32_fp8(q, 3) * g1; }
        }
        if (WRITEX) {
            if (DST16) { u32x2* xo = (u32x2*)((bf16_t*)dst + (size_t)m * D) + F.lane;
#pragma unroll
                for (int j = 0; j < 8; ++j) { u32x2 w; w.x = pk2(v[j].x, v[j].y); w.y = pk2(v[j].z, v[j].w); xo[64 * j] = w;
                    if (WRITEH) v[j] = (f32x4){bflo(w.x), bfhi(w.x), bflo(w.y), bfhi(w.y)}; } }
            else { f32x4* xo = (f32x4*)((float*)dst + (size_t)m * D) + F.lane;
#pragma unroll
                for (int j = 0; j < 8; ++j) xo[64 * j] = v[j]; } }
        if (WRITEH) {
            float s = 0.f;
#pragma unroll
            for (int j = 0; j < 8; ++j) s += (v[j].x * v[j].x + v[j].y * v[j].y) + (v[j].z * v[j].z + v[j].w * v[j].w);
            const float rstd = 1.0f / sqrtf(wave_sum(s) * (1.0f / D) + EPS);
            const f32x4* gr = (const f32x4*)gain + F.lane;
#pragma unroll
            for (int j = 0; j < 8; ++j) v[j] = v[j] * rstd * gr[64 * j];
            if (H8) { unsigned* ho8 = (unsigned*)((unsigned char*)H + (size_t)m * D) + F.lane;
#pragma unroll
                for (int j = 0; j < 8; ++j) ho8[64 * j] = pk4fp8(v[j].x * 4.f, v[j].y * 4.f, v[j].z * 4.f, v[j].w * 4.f); }
            else {
            u32x2* ho = (u32x2*)(H + (size_t)m * D) + F.lane;
#pragma unroll
            for (int j = 0; j < 8; ++j) { u32x2 w; w.x = pk2(v[j].x, v[j].y); w.y = pk2(v[j].z, v[j].w); ho[64 * j] = w; } }
            if constexpr (NP > 0) {
                float res = 0.f;
#pragma unroll 1
                for (int c0 = 0; c0 < NP; c0 += 4) {
                    float a[4];
#pragma unroll
                    for (int cc = 0; cc < 4; ++cc) { const f32x4* wr = (const f32x4*)(Wt + (size_t)(c0 + cc) * D) + F.lane; a[cc] = 0.f;
#pragma unroll
                        for (int j = 0; j < 8; ++j) { const f32x4 w = wr[64 * j]; a[cc] += (v[j].x * w.x + v[j].y * w.y) + (v[j].z * w.z + v[j].w * w.w); } }
#pragma unroll
                    for (int cc = 0; cc < 4; ++cc) { const float t = wave_sum(a[cc]); res = (F.lane == c0 + cc) ? t : res; }
                }
                hnd(m, res);
            }
        }
    }
}


struct XTileF { f32x4 f[8][2]; };
struct XTileB { u32x4 p[8]; };
template <bool XB> struct XTileSel { typedef XTileF T; };
template <> struct XTileSel<true> { typedef XTileB T; };
DI void xget(const XTileF& t, int i, f32x4& xa, f32x4& xb) { xa = t.f[i][0]; xb = t.f[i][1]; }
DI void xget(const XTileB& t, int i, f32x4& xa, f32x4& xb) { const u32x4 b = t.p[i]; xa = (f32x4){bflo(b.x), bfhi(b.x), bflo(b.y), bfhi(b.y)}; xb = (f32x4){bflo(b.z), bfhi(b.z), bflo(b.w), bfhi(b.w)}; }
DI void xtile_load(Frame& F, XTileB& xr, const void* x, int tile) {
    const u32x4* xp = (const u32x4*)((const bf16_t*)x + ((size_t)tile * 16 + (F.lane & 15)) * D + 256 * F.wave + 8 * (F.lane >> 4));
#pragma unroll
    for (int i = 0; i < 8; ++i) xr.p[i] = xp[4 * i];
}
DI void xtile_load(Frame& F, XTileF& xr, const void* x, int tile) {
    const f32x4* xp = (const f32x4*)((const float*)x + ((size_t)tile * 16 + (F.lane & 15)) * D + 256 * F.wave + 8 * (F.lane >> 4));
#pragma unroll
    for (int i = 0; i < 8; ++i) { xr.f[i][0] = xp[8 * i]; xr.f[i][1] = xp[8 * i + 1]; }
}
template <bool XB, class T> DI void xsplit(const T& t, int i, const f32x4& xa, const f32x4& xb, bf16x8& xh, bf16x8& xl) {
    if constexpr (XB) { xh = __builtin_bit_cast(bf16x8, t.p[i]); xl = xh; }
    else { u32x4 hw; hw.x = pkbf(xa.x, xa.y); hw.y = pkbf(xa.z, xa.w); hw.z = pkbf(xb.x, xb.y); hw.w = pkbf(xb.z, xb.w);
        u32x4 lw; lw.x = pkbf(xa.x - bflo(hw.x), xa.y - bfhi(hw.x)); lw.y = pkbf(xa.z - bflo(hw.y), xa.w - bfhi(hw.y)); lw.z = pkbf(xb.x - bflo(hw.z), xb.y - bfhi(hw.z)); lw.w = pkbf(xb.z - bflo(hw.w), xb.w - bfhi(hw.w));
        xh = __builtin_bit_cast(bf16x8, hw); xl = __builtin_bit_cast(bf16x8, lw); }
}
constexpr int NP_GAIN_OFF = 65536 + 8192;
template <int MODE, bool XB>
DI void normproj_tile(Frame& F, const typename XTileSel<XB>::T& xr, typename XTileSel<XB>::T& xn, const void* x, int ntile, int tile, int tl, int par, const bf16_t* Wh, const bf16_t* Wl, bf16_t* H, float* bg, float dtb, float nea) {
    constexpr int NT = MODE == 0 ? 1 : 3;
    int lane_o = F.lane; asm volatile("" : "+v"(lane_o));
    const int lane = lane_o, r = lane & 15, kq = lane >> 4, w = F.wave;
    LAS float* ssp = (LAS float*)(F.lds + par * 32768);
    LAS f32x4* lp = (LAS f32x4*)(F.lds + par * 32768 + 1024);
    LAS float* lg = (LAS float*)(F.lds + par * 32768 + 1024 + 24576);
    LAS f32x4* sel = (LAS f32x4*)(F.lds + 65536);
    const size_t tok0 = (size_t)tile * 16;
    f32x4 acc[NT];
#pragma unroll
    for (int nt = 0; nt < NT; ++nt) acc[nt] = (f32x4){0.f, 0.f, 0.f, 0.f};
    float ss = 0.f;
    if constexpr (NT == 3) {
        u32x4 q0_0_0, q0_0_1, q0_1_0, q0_1_1, q0_2_0, q0_2_1, q1_0_0, q1_0_1, q1_1_0, q1_1_1, q1_2_0, q1_2_1, q2_0_0, q2_0_1, q2_1_0, q2_1_1, q2_2_0, q2_2_1, q3_0_0, q3_0_1, q3_1_0, q3_1_1, q3_2_0, q3_2_1;
        const unsigned char* wp0_0 = (const unsigned char*)(Wh + (size_t)(0 + r) * D + 256 * w + 8 * kq); const unsigned char* wp0_1 = (const unsigned char*)(Wl + (size_t)(0 + r) * D + 256 * w + 8 * kq);
        const unsigned char* wp1_0 = (const unsigned char*)(Wh + (size_t)(16 + r) * D + 256 * w + 8 * kq); const unsigned char* wp1_1 = (const unsigned char*)(Wl + (size_t)(16 + r) * D + 256 * w + 8 * kq);
        const unsigned char* wp2_0 = (const unsigned char*)(Wh + (size_t)(32 + r) * D + 256 * w + 8 * kq); const unsigned char* wp2_1 = (const unsigned char*)(Wl + (size_t)(32 + r) * D + 256 * w + 8 * kq);
        asm volatile("global_load_dwordx4 %0, %1, off" : "=v"(q0_0_0) : "v"(wp0_0) : "memory"); asm volatile("global_load_dwordx4 %0, %1, off offset:64" : "=v"(q1_0_0) : "v"(wp0_0) : "memory"); asm volatile("global_load_dwordx4 %0, %1, off" : "=v"(q0_0_1) : "v"(wp0_1) : "memory"); asm volatile("global_load_dwordx4 %0, %1, off offset:64" : "=v"(q1_0_1) : "v"(wp0_1) : "memory"); asm volatile("global_load_dwordx4 %0, %1, off" : "=v"(q0_1_0) : "v"(wp1_0) : "memory"); asm volatile("global_load_dwordx4 %0, %1, off offset:64" : "=v"(q1_1_0) : "v"(wp1_0) : "memory"); asm volatile("global_load_dwordx4 %0, %1, off" : "=v"(q0_1_1) : "v"(wp1_1) : "memory"); asm volatile("global_load_dwordx4 %0, %1, off offset:64" : "=v"(q1_1_1) : "v"(wp1_1) : "memory"); asm volatile("global_load_dwordx4 %0, %1, off" : "=v"(q0_2_0) : "v"(wp2_0) : "memory"); asm volatile("global_load_dwordx4 %0, %1, off offset:64" : "=v"(q1_2_0) : "v"(wp2_0) : "memory"); asm volatile("global_load_dwordx4 %0, %1, off" : "=v"(q0_2_1) : "v"(wp2_1) : "memory"); asm volatile("global_load_dwordx4 %0, %1, off offset:64" : "=v"(q1_2_1) : "v"(wp2_1) : "memory");
        asm volatile("global_load_dwordx4 %0, %1, off offset:128" : "=v"(q2_0_0) : "v"(wp0_0) : "memory"); asm volatile("global_load_dwordx4 %0, %1, off offset:192" : "=v"(q3_0_0) : "v"(wp0_0) : "memory"); asm volatile("global_load_dwordx4 %0, %1, off offset:128" : "=v"(q2_0_1) : "v"(wp0_1) : "memory"); asm volatile("global_load_dwordx4 %0, %1, off offset:192" : "=v"(q3_0_1) : "v"(wp0_1) : "memory"); asm volatile("global_load_dwordx4 %0, %1, off offset:128" : "=v"(q2_1_0) : "v"(wp1_0) : "memory"); asm volatile("global_load_dwordx4 %0, %1, off offset:192" : "=v"(q3_1_0) : "v"(wp1_0) : "memory"); asm volatile("global_load_dwordx4 %0, %1, off offset:128" : "=v"(q2_1_1) : "v"(wp1_1) : "memory"); asm volatile("global_load_dwordx4 %0, %1, off offset:192" : "=v"(q3_1_1) : "v"(wp1_1) : "memory"); asm volatile("global_load_dwordx4 %0, %1, off offset:128" : "=v"(q2_2_0) : "v"(wp2_0) : "memory"); asm volatile("global_load_dwordx4 %0, %1, off offset:192" : "=v"(q3_2_0) : "v"(wp2_0) : "memory"); asm volatile("global_load_dwordx4 %0, %1, off offset:128" : "=v"(q2_2_1) : "v"(wp2_1) : "memory"); asm volatile("global_load_dwordx4 %0, %1, off offset:192" : "=v"(q3_2_1) : "v"(wp2_1) : "memory");
        asm volatile("s_waitcnt vmcnt(13)" : "+v"(q0_0_0), "+v"(q0_0_1), "+v"(q0_1_0), "+v"(q0_1_1), "+v"(q0_2_0), "+v"(q0_2_1));
        { f32x4 xa, xb; xget(xr, 0, xa, xb); constexpr int XI = 0;
          ss += ((xa.x * xa.x + xa.y * xa.y) + (xa.z * xa.z + xa.w * xa.w)) + ((xb.x * xb.x + xb.y * xb.y) + (xb.z * xb.z + xb.w * xb.w));
          bf16x8 xh, xl; xsplit<XB>(xr, XI, xa, xb, xh, xl);
          { const bf16x8 wh = __builtin_bit_cast(bf16x8, q0_0_0), wl = __builtin_bit_cast(bf16x8, q0_0_1); acc[0] = mfma16(xh, wh, acc[0]); acc[0] = mfma16(xh, wl, acc[0]); if constexpr (!XB) acc[0] = mfma16(xl, wh, acc[0]); }
          { const bf16x8 wh = __builtin_bit_cast(bf16x8, q0_1_0), wl = __builtin_bit_cast(bf16x8, q0_1_1); acc[1] = mfma16(xh, wh, acc[1]); acc[1] = mfma16(xh, wl, acc[1]); if constexpr (!XB) acc[1] = mfma16(xl, wh, acc[1]); }
          { const bf16x8 wh = __builtin_bit_cast(bf16x8, q0_2_0), wl = __builtin_bit_cast(bf16x8, q0_2_1); acc[2] = mfma16(xh, wh, acc[2]); acc[2] = mfma16(xh, wl, acc[2]); if constexpr (!XB) acc[2] = mfma16(xl, wh, acc[2]); }
        }
        asm volatile("s_waitcnt vmcnt(12)" : "+v"(q1_0_0), "+v"(q1_0_1), "+v"(q1_1_0), "+v"(q1_1_1), "+v"(q1_2_0), "+v"(q1_2_1));
        { f32x4 xa, xb; xget(xr, 1, xa, xb); constexpr int XI = 1;
          ss += ((xa.x * xa.x + xa.y * xa.y) + (xa.z * xa.z + xa.w * xa.w)) + ((xb.x * xb.x + xb.y * xb.y) + (xb.z * xb.z + xb.w * xb.w));
          bf16x8 xh, xl; xsplit<XB>(xr, XI, xa, xb, xh, xl);
          { const bf16x8 wh = __builtin_bit_cast(bf16x8, q1_0_0), wl = __builtin_bit_cast(bf16x8, q1_0_1); acc[0] = mfma16(xh, wh, acc[0]); acc[0] = mfma16(xh, wl, acc[0]); if constexpr (!XB) acc[0] = mfma16(xl, wh, acc[0]); }
          { const bf16x8 wh = __builtin_bit_cast(bf16x8, q1_1_0), wl = __builtin_bit_cast(bf16x8, q1_1_1); acc[1] = mfma16(xh, wh, acc[1]); acc[1] = mfma16(xh, wl, acc[1]); if constexpr (!XB) acc[1] = mfma16(xl, wh, acc[1]); }
          { const bf16x8 wh = __builtin_bit_cast(bf16x8, q1_2_0), wl = __builtin_bit_cast(bf16x8, q1_2_1); acc[2] = mfma16(xh, wh, acc[2]); acc[2] = mfma16(xh, wl, acc[2]); if constexpr (!XB) acc[2] = mfma16(xl, wh, acc[2]); }
        }
        asm volatile("" :: "v"(acc[0]));
        asm volatile("global_load_dwordx4 %0, %1, off offset:256" : "=v"(q0_0_0) : "v"(wp0_0) : "memory"); asm volatile("global_load_dwordx4 %0, %1, off offset:320" : "=v"(q1_0_0) : "v"(wp0_0) : "memory"); asm volatile("global_load_dwordx4 %0, %1, off offset:256" : "=v"(q0_0_1) : "v"(wp0_1) : "memory"); asm volatile("global_load_dwordx4 %0, %1, off offset:320" : "=v"(q1_0_1) : "v"(wp0_1) : "memory"); asm volatile("global_load_dwordx4 %0, %1, off offset:256" : "=v"(q0_1_0) : "v"(wp1_0) : "memory"); asm volatile("global_load_dwordx4 %0, %1, off offset:320" : "=v"(q1_1_0) : "v"(wp1_0) : "memory"); asm volatile("global_load_dwordx4 %0, %1, off offset:256" : "=v"(q0_1_1) : "v"(wp1_1) : "memory"); asm volatile("global_load_dwordx4 %0, %1, off offset:320" : "=v"(q1_1_1) : "v"(wp1_1) : "memory"); asm volatile("global_load_dwordx4 %0, %1, off offset:256" : "=v"(q0_2_0) : "v"(wp2_0) : "memory"); asm volatile("global_load_dwordx4 %0, %1, off offset:320" : "=v"(q1_2_0) : "v"(wp2_0) : "memory"); asm volatile("global_load_dwordx4 %0, %1, off offset:256" : "=v"(q0_2_1) : "v"(wp2_1) : "memory"); asm volatile("global_load_dwordx4 %0, %1, off offset:320" : "=v"(q1_2_1) : "v"(wp2_1) : "memory");
        asm volatile("s_waitcnt vmcnt(13)" : "+v"(q2_0_0), "+v"(q2_0_1), "+v"(q2_1_0), "+v"(q2_1_1), "+v"(q2_2_0), "+v"(q2_2_1));
        { f32x4 xa, xb; xget(xr, 2, xa, xb); constexpr int XI = 2;
          ss += ((xa.x * xa.x + xa.y * xa.y) + (xa.z * xa.z + xa.w * xa.w)) + ((xb.x * xb.x + xb.y * xb.y) + (xb.z * xb.z + xb.w * xb.w));
          bf16x8 xh, xl; xsplit<XB>(xr, XI, xa, xb, xh, xl);
          { const bf16x8 wh = __builtin_bit_cast(bf16x8, q2_0_0), wl = __builtin_bit_cast(bf16x8, q2_0_1); acc[0] = mfma16(xh, wh, acc[0]); acc[0] = mfma16(xh, wl, acc[0]); if constexpr (!XB) acc[0] = mfma16(xl, wh, acc[0]); }
          { const bf16x8 wh = __builtin_bit_cast(bf16x8, q2_1_0), wl = __builtin_bit_cast(bf16x8, q2_1_1); acc[1] = mfma16(xh, wh, acc[1]); acc[1] = mfma16(xh, wl, acc[1]); if constexpr (!XB) acc[1] = mfma16(xl, wh, acc[1]); }
          { const bf16x8 wh = __builtin_bit_cast(bf16x8, q2_2_0), wl = __builtin_bit_cast(bf16x8, q2_2_1); acc[2] = mfma16(xh, wh, acc[2]); acc[2] = mfma16(xh, wl, acc[2]); if constexpr (!XB) acc[2] = mfma16(xl, wh, acc[2]); }
        }
        asm volatile("s_waitcnt vmcnt(12)" : "+v"(q3_0_0), "+v"(q3_0_1), "+v"(q3_1_0), "+v"(q3_1_1), "+v"(q3_2_0), "+v"(q3_2_1));
        { f32x4 xa, xb; xget(xr, 3, xa, xb); constexpr int XI = 3;
          ss += ((xa.x * xa.x + xa.y * xa.y) + (xa.z * xa.z + xa.w * xa.w)) + ((xb.x * xb.x + xb.y * xb.y) + (xb.z * xb.z + xb.w * xb.w));
          bf16x8 xh, xl; xsplit<XB>(xr, XI, xa, xb, xh, xl);
          { const bf16x8 wh = __builtin_bit_cast(bf16x8, q3_0_0), wl = __builtin_bit_cast(bf16x8, q3_0_1); acc[0] = mfma16(xh, wh, acc[0]); acc[0] = mfma16(xh, wl, acc[0]); if constexpr (!XB) acc[0] = mfma16(xl, wh, acc[0]); }
          { const bf16x8 wh = __builtin_bit_cast(bf16x8, q3_1_0), wl = __builtin_bit_cast(bf16x8, q3_1_1); acc[1] = mfma16(xh, wh, acc[1]); acc[1] = mfma16(xh, wl, acc[1]); if constexpr (!XB) acc[1] = mfma16(xl, wh, acc[1]); }
          { const bf16x8 wh = __builtin_bit_cast(bf16x8, q3_2_0), wl = __builtin_bit_cast(bf16x8, q3_2_1); acc[2] = mfma16(xh, wh, acc[2]); acc[2] = mfma16(xh, wl, acc[2]); if constexpr (!XB) acc[2] = mfma16(xl, wh, acc[2]); }
        }
        asm volatile("" :: "v"(acc[0]));
        asm volatile("global_load_dwordx4 %0, %1, off offset:384" : "=v"(q2_0_0) : "v"(wp0_0) : "memory"); asm volatile("global_load_dwordx4 %0, %1, off offset:448" : "=v"(q3_0_0) : "v"(wp0_0) : "memory"); asm volatile("global_load_dwordx4 %0, %1, off offset:384" : "=v"(q2_0_1) : "v"(wp0_1) : "memory"); asm volatile("global_load_dwordx4 %0, %1, off offset:448" : "=v"(q3_0_1) : "v"(wp0_1) : "memory"); asm volatile("global_load_dwordx4 %0, %1, off offset:384" : "=v"(q2_1_0) : "v"(wp1_0) : "memory"); asm volatile("global_load_dwordx4 %0, %1, off offset:448" : "=v"(q3_1_0) : "v"(wp1_0) : "memory"); asm volatile("global_load_dwordx4 %0, %1, off offset:384" : "=v"(q2_1_1) : "v"(wp1_1) : "memory"); asm volatile("global_load_dwordx4 %0, %1, off offset:448" : "=v"(q3_1_1) : "v"(wp1_1) : "memory"); asm volatile("global_load_dwordx4 %0, %1, off offset:384" : "=v"(q2_2_0) : "v"(wp2_0) : "memory"); asm volatile("global_load_dwordx4 %0, %1, off offset:448" : "=v"(q3_2_0) : "v"(wp2_0) : "memory"); asm volatile("global_load_dwordx4 %0, %1, off offset:384" : "=v"(q2_2_1) : "v"(wp2_1) : "memory"); asm volatile("global_load_dwordx4 %0, %1, off offset:448" : "=v"(q3_2_1) : "v"(wp2_1) : "memory");
        asm volatile("s_waitcnt vmcnt(13)" : "+v"(q0_0_0), "+v"(q0_0_1), "+v"(q0_1_0), "+v"(q0_1_1), "+v"(q0_2_0), "+v"(q0_2_1));
        { f32x4 xa, xb; xget(xr, 4, xa, xb); constexpr int XI = 4;
          ss += ((xa.x * xa.x + xa.y * xa.y) + (xa.z * xa.z + xa.w * xa.w)) + ((xb.x * xb.x + xb.y * xb.y) + (xb.z * xb.z + xb.w * xb.w));
          bf16x8 xh, xl; xsplit<XB>(xr, XI, xa, xb, xh, xl);
          { const bf16x8 wh = __builtin_bit_cast(bf16x8, q0_0_0), wl = __builtin_bit_cast(bf16x8, q0_0_1); acc[0] = mfma16(xh, wh, acc[0]); acc[0] = mfma16(xh, wl, acc[0]); if constexpr (!XB) acc[0] = mfma16(xl, wh, acc[0]); }
          { const bf16x8 wh = __builtin_bit_cast(bf16x8, q0_1_0), wl = __builtin_bit_cast(bf16x8, q0_1_1); acc[1] = mfma16(xh, wh, acc[1]); acc[1] = mfma16(xh, wl, acc[1]); if constexpr (!XB) acc[1] = mfma16(xl, wh, acc[1]); }
          { const bf16x8 wh = __builtin_bit_cast(bf16x8, q0_2_0), wl = __builtin_bit_cast(bf16x8, q0_2_1); acc[2] = mfma16(xh, wh, acc[2]); acc[2] = mfma16(xh, wl, acc[2]); if constexpr (!XB) acc[2] = mfma16(xl, wh, acc[2]); }
        }
        asm volatile("s_waitcnt vmcnt(12)" : "+v"(q1_0_0), "+v"(q1_0_1), "+v"(q1_1_0), "+v"(q1_1_1), "+v"(q1_2_0), "+v"(q1_2_1));
        { f32x4 xa, xb; xget(xr, 5, xa, xb); constexpr int XI = 5;
          ss += ((xa.x * xa.x + xa.y * xa.y) + (xa.z * xa.z + xa.w * xa.w)) + ((xb.x * xb.x + xb.y * xb.y) + (xb.z * xb.z + xb.w * xb.w));
          bf16x8 xh, xl; xsplit<XB>(xr, XI, xa, xb, xh, xl);
          { const bf16x8 wh = __builtin_bit_cast(bf16x8, q1_0_0), wl = __builtin_bit_cast(bf16x8, q1_0_1); acc[0] = mfma16(xh, wh, acc[0]); acc[0] = mfma16(xh, wl, acc[0]); if constexpr (!XB) acc[0] = mfma16(xl, wh, acc[0]); }
          { const bf16x8 wh = __builtin_bit_cast(bf16x8, q1_1_0), wl = __builtin_bit_cast(bf16x8, q1_1_1); acc[1] = mfma16(xh, wh, acc[1]); acc[1] = mfma16(xh, wl, acc[1]); if constexpr (!XB) acc[1] = mfma16(xl, wh, acc[1]); }
          { const bf16x8 wh = __builtin_bit_cast(bf16x8, q1_2_0), wl = __builtin_bit_cast(bf16x8, q1_2_1); acc[2] = mfma16(xh, wh, acc[2]); acc[2] = mfma16(xh, wl, acc[2]); if constexpr (!XB) acc[2] = mfma16(xl, wh, acc[2]); }
        }
        asm volatile("s_waitcnt vmcnt(1)" : "+v"(q2_0_0), "+v"(q2_0_1), "+v"(q2_1_0), "+v"(q2_1_1), "+v"(q2_2_0), "+v"(q2_2_1));
        { f32x4 xa, xb; xget(xr, 6, xa, xb); constexpr int XI = 6;
          ss += ((xa.x * xa.x + xa.y * xa.y) + (xa.z * xa.z + xa.w * xa.w)) + ((xb.x * xb.x + xb.y * xb.y) + (xb.z * xb.z + xb.w * xb.w));
          bf16x8 xh, xl; xsplit<XB>(xr, XI, xa, xb, xh, xl);
          { const bf16x8 wh = __builtin_bit_cast(bf16x8, q2_0_0), wl = __builtin_bit_cast(bf16x8, q2_0_1); acc[0] = mfma16(xh, wh, acc[0]); acc[0] = mfma16(xh, wl, acc[0]); if constexpr (!XB) acc[0] = mfma16(xl, wh, acc[0]); }
          { const bf16x8 wh = __builtin_bit_cast(bf16x8, q2_1_0), wl = __builtin_bit_cast(bf16x8, q2_1_1); acc[1] = mfma16(xh, wh, acc[1]); acc[1] = mfma16(xh, wl, acc[1]); if constexpr (!XB) acc[1] = mfma16(xl, wh, acc[1]); }
          { const bf16x8 wh = __builtin_bit_cast(bf16x8, q2_2_0), wl = __builtin_bit_cast(bf16x8, q2_2_1); acc[2] = mfma16(xh, wh, acc[2]); acc[2] = mfma16(xh, wl, acc[2]); if constexpr (!XB) acc[2] = mfma16(xl, wh, acc[2]); }
        }
        asm volatile("s_waitcnt vmcnt(0)" : "+v"(q3_0_0), "+v"(q3_0_1), "+v"(q3_1_0), "+v"(q3_1_1), "+v"(q3_2_0), "+v"(q3_2_1));
        { f32x4 xa, xb; xget(xr, 7, xa, xb); constexpr int XI = 7;
          ss += ((xa.x * xa.x + xa.y * xa.y) + (xa.z * xa.z + xa.w * xa.w)) + ((xb.x * xb.x + xb.y * xb.y) + (xb.z * xb.z + xb.w * xb.w));
          bf16x8 xh, xl; xsplit<XB>(xr, XI, xa, xb, xh, xl);
          { const bf16x8 wh = __builtin_bit_cast(bf16x8, q3_0_0), wl = __builtin_bit_cast(bf16x8, q3_0_1); acc[0] = mfma16(xh, wh, acc[0]); acc[0] = mfma16(xh, wl, acc[0]); if constexpr (!XB) acc[0] = mfma16(xl, wh, acc[0]); }
          { const bf16x8 wh = __builtin_bit_cast(bf16x8, q3_1_0), wl = __builtin_bit_cast(bf16x8, q3_1_1); acc[1] = mfma16(xh, wh, acc[1]); acc[1] = mfma16(xh, wl, acc[1]); if constexpr (!XB) acc[1] = mfma16(xl, wh, acc[1]); }
          { const bf16x8 wh = __builtin_bit_cast(bf16x8, q3_2_0), wl = __builtin_bit_cast(bf16x8, q3_2_1); acc[2] = mfma16(xh, wh, acc[2]); acc[2] = mfma16(xh, wl, acc[2]); if constexpr (!XB) acc[2] = mfma16(xl, wh, acc[2]); }
        }
    } else {
        u32x4 q0_0_0, q0_0_1, q1_0_0, q1_0_1, q2_0_0, q2_0_1, q3_0_0, q3_0_1;
        const unsigned char* wp0_0 = (const unsigned char*)(Wh + (size_t)(0 + r) * D + 256 * w + 8 * kq); const unsigned char* wp0_1 = (const unsigned char*)(Wl + (size_t)(0 + r) * D + 256 * w + 8 * kq);
        asm volatile("global_load_dwordx4 %0, %1, off" : "=v"(q0_0_0) : "v"(wp0_0) : "memory"); asm volatile("global_load_dwordx4 %0, %1, off offset:64" : "=v"(q1_0_0) : "v"(wp0_0) : "memory"); asm volatile("global_load_dwordx4 %0, %1, off" : "=v"(q0_0_1) : "v"(wp0_1) : "memory"); asm volatile("global_load_dwordx4 %0, %1, off offset:64" : "=v"(q1_0_1) : "v"(wp0_1) : "memory");
        asm volatile("global_load_dwordx4 %0, %1, off offset:128" : "=v"(q2_0_0) : "v"(wp0_0) : "memory"); asm volatile("global_load_dwordx4 %0, %1, off offset:192" : "=v"(q3_0_0) : "v"(wp0_0) : "memory"); asm volatile("global_load_dwordx4 %0, %1, off offset:128" : "=v"(q2_0_1) : "v"(wp0_1) : "memory"); asm volatile("global_load_dwordx4 %0, %1, off offset:192" : "=v"(q3_0_1) : "v"(wp0_1) : "memory");
        asm volatile("s_waitcnt vmcnt(5)" : "+v"(q0_0_0), "+v"(q0_0_1));
        { f32x4 xa, xb; xget(xr, 0, xa, xb); constexpr int XI = 0;
          ss += ((xa.x * xa.x + xa.y * xa.y) + (xa.z * xa.z + xa.w * xa.w)) + ((xb.x * xb.x + xb.y * xb.y) + (xb.z * xb.z + xb.w * xb.w));
          bf16x8 xh, xl; xsplit<XB>(xr, XI, xa, xb, xh, xl);
          { const bf16x8 wh = __builtin_bit_cast(bf16x8, q0_0_0), wl = __builtin_bit_cast(bf16x8, q0_0_1); acc[0] = mfma16(xh, wh, acc[0]); acc[0] = mfma16(xh, wl, acc[0]); if constexpr (!XB) acc[0] = mfma16(xl, wh, acc[0]); }
        }
        asm volatile("s_waitcnt vmcnt(4)" : "+v"(q1_0_0), "+v"(q1_0_1));
        { f32x4 xa, xb; xget(xr, 1, xa, xb); constexpr int XI = 1;
          ss += ((xa.x * xa.x + xa.y * xa.y) + (xa.z * xa.z + xa.w * xa.w)) + ((xb.x * xb.x + xb.y * xb.y) + (xb.z * xb.z + xb.w * xb.w));
          bf16x8 xh, xl; xsplit<XB>(xr, XI, xa, xb, xh, xl);
          { const bf16x8 wh = __builtin_bit_cast(bf16x8, q1_0_0), wl = __builtin_bit_cast(bf16x8, q1_0_1); acc[0] = mfma16(xh, wh, acc[0]); acc[0] = mfma16(xh, wl, acc[0]); if constexpr (!XB) acc[0] = mfma16(xl, wh, acc[0]); }
        }
        asm volatile("" :: "v"(acc[0]));
        asm volatile("global_load_dwordx4 %0, %1, off offset:256" : "=v"(q0_0_0) : "v"(wp0_0) : "memory"); asm volatile("global_load_dwordx4 %0, %1, off offset:320" : "=v"(q1_0_0) : "v"(wp0_0) : "memory"); asm volatile("global_load_dwordx4 %0, %1, off offset:256" : "=v"(q0_0_1) : "v"(wp0_1) : "memory"); asm volatile("global_load_dwordx4 %0, %1, off offset:320" : "=v"(q1_0_1) : "v"(wp0_1) : "memory");
        asm volatile("s_waitcnt vmcnt(5)" : "+v"(q2_0_0), "+v"(q2_0_1));
        { f32x4 xa, xb; xget(xr, 2, xa, xb); constexpr int XI = 2;
          ss += ((xa.x * xa.x + xa.y * xa.y) + (xa.z * xa.z + xa.w * xa.w)) + ((xb.x * xb.x + xb.y * xb.y) + (xb.z * xb.z + xb.w * xb.w));
          bf16x8 xh, xl; xsplit<XB>(xr, XI, xa, xb, xh, xl);
          { const bf16x8 wh = __builtin_bit_cast(bf16x8, q2_0_0), wl = __builtin_bit_cast(bf16x8, q2_0_1); acc[0] = mfma16(xh, wh, acc[0]); acc[0] = mfma16(xh, wl, acc[0]); if constexpr (!XB) acc[0] = mfma16(xl, wh, acc[0]); }
        }
        asm volatile("s_waitcnt vmcnt(4)" : "+v"(q3_0_0), "+v"(q3_0_1));
        { f32x4 xa, xb; xget(xr, 3, xa, xb); constexpr int XI = 3;
          ss += ((xa.x * xa.x + xa.y * xa.y) + (xa.z * xa.z + xa.w * xa.w)) + ((xb.x * xb.x + xb.y * xb.y) + (xb.z * xb.z + xb.w * xb.w));
          bf16x8 xh, xl; xsplit<XB>(xr, XI, xa, xb, xh, xl);
          { const bf16x8 wh = __builtin_bit_cast(bf16x8, q3_0_0), wl = __builtin_bit_cast(bf16x8, q3_0_1); acc[0] = mfma16(xh, wh, acc[0]); acc[0] = mfma16(xh, wl, acc[0]); if constexpr (!XB) acc[0] = mfma16(xl, wh, acc[0]); }
        }
        asm volatile("" :: "v"(acc[0]));
        asm volatile("global_load_dwordx4 %0, %1, off offset:384" : "=v"(q2_0_0) : "v"(wp0_0) : "memory"); asm volatile("global_load_dwordx4 %0, %1, off offset:448" : "=v"(q3_0_0) : "v"(wp0_0) : "memory"); asm volatile("global_load_dwordx4 %0, %1, off offset:384" : "=v"(q2_0_1) : "v"(wp0_1) : "memory"); asm volatile("global_load_dwordx4 %0, %1, off offset:448" : "=v"(q3_0_1) : "v"(wp0_1) : "memory");
        asm volatile("s_waitcnt vmcnt(5)" : "+v"(q0_0_0), "+v"(q0_0_1));
        { f32x4 xa, xb; xget(xr, 4, xa, xb); constexpr int XI = 4;
          ss += ((xa.x * xa.x + xa.y * xa.y) + (xa.z * xa.z + xa.w * xa.w)) + ((xb.x * xb.x + xb.y * xb.y) + (xb.z * xb.z + xb.w * xb.w));
          bf16x8 xh, xl; xsplit<XB>(xr, XI, xa, xb, xh, xl);
          { const bf16x8 wh = __builtin_bit_cast(bf16x8, q0_0_0), wl = __builtin_bit_cast(bf16x8, q0_0_1); acc[0] = mfma16(xh, wh, acc[0]); acc[0] = mfma16(xh, wl, acc[0]); if constexpr (!XB) acc[0] = mfma16(xl, wh, acc[0]); }
        }
        asm volatile("s_waitcnt vmcnt(4)" : "+v"(q1_0_0), "+v"(q1_0_1));
        { f32x4 xa, xb; xget(xr, 5, xa, xb); constexpr int XI = 5;
          ss += ((xa.x * xa.x + xa.y * xa.y) + (xa.z * xa.z + xa.w * xa.w)) + ((xb.x * xb.x + xb.y * xb.y) + (xb.z * xb.z + xb.w * xb.w));
          bf16x8 xh, xl; xsplit<XB>(xr, XI, xa, xb, xh, xl);
          { const bf16x8 wh = __builtin_bit_cast(bf16x8, q1_0_0), wl = __builtin_bit_cast(bf16x8, q1_0_1); acc[0] = mfma16(xh, wh, acc[0]); acc[0] = mfma16(xh, wl, acc[0]); if constexpr (!XB) acc[0] = mfma16(xl, wh, acc[0]); }
        }
        asm volatile("s_waitcnt vmcnt(1)" : "+v"(q2_0_0), "+v"(q2_0_1));
        { f32x4 xa, xb; xget(xr, 6, xa, xb); constexpr int XI = 6;
          ss += ((xa.x * xa.x + xa.y * xa.y) + (xa.z * xa.z + xa.w * xa.w)) + ((xb.x * xb.x + xb.y * xb.y) + (xb.z * xb.z + xb.w * xb.w));
          bf16x8 xh, xl; xsplit<XB>(xr, XI, xa, xb, xh, xl);
          { const bf16x8 wh = __builtin_bit_cast(bf16x8, q2_0_0), wl = __builtin_bit_cast(bf16x8, q2_0_1); acc[0] = mfma16(xh, wh, acc[0]); acc[0] = mfma16(xh, wl, acc[0]); if constexpr (!XB) acc[0] = mfma16(xl, wh, acc[0]); }
        }
        asm volatile("s_waitcnt vmcnt(0)" : "+v"(q3_0_0), "+v"(q3_0_1));
        { f32x4 xa, xb; xget(xr, 7, xa, xb); constexpr int XI = 7;
          ss += ((xa.x * xa.x + xa.y * xa.y) + (xa.z * xa.z + xa.w * xa.w)) + ((xb.x * xb.x + xb.y * xb.y) + (xb.z * xb.z + xb.w * xb.w));
          bf16x8 xh, xl; xsplit<XB>(xr, XI, xa, xb, xh, xl);
          { const bf16x8 wh = __builtin_bit_cast(bf16x8, q3_0_0), wl = __builtin_bit_cast(bf16x8, q3_0_1); acc[0] = mfma16(xh, wh, acc[0]); acc[0] = mfma16(xh, wl, acc[0]); if constexpr (!XB) acc[0] = mfma16(xl, wh, acc[0]); }
        }
    }
    asm volatile("" ::: "memory");
    if (ntile >= 0) xtile_load(F, xn, x, ntile);
    ss += __shfl_xor(ss, 16); ss += __shfl_xor(ss, 32);
    if (lane < 16) ssp[w * 16 + lane] = ss;
#pragma unroll
    for (int nt = 0; nt < NT; ++nt) lp[(w * NT + nt) * 64 + lane] = acc[nt];
    __syncthreads();
    float tot = 0.f;
#pragma unroll
    for (int q = 0; q < 8; ++q) tot += ssp[q * 16 + r];
    const float rstd = 1.0f / sqrtf(tot * (1.0f / D) + EPS);
    { const LAS f32x4* gp = (const LAS f32x4*)(F.lds + NP_GAIN_OFF) + 64 * w + 2 * kq; bf16_t* hp = H + (tok0 + r) * D + 256 * w + 8 * kq;
#pragma unroll
      for (int i = 0; i < 8; ++i) { const f32x4 ga = gp[8 * i], gb = gp[8 * i + 1]; f32x4 xa, xb; xget(xr, i, xa, xb); xa = xa * rstd; xb = xb * rstd;
        if (MODE == 1) { u32x2 o; o.x = pk4fp8(xa.x * ga.x * 4.f, xa.y * ga.y * 4.f, xa.z * ga.z * 4.f, xa.w * ga.w * 4.f); o.y = pk4fp8(xb.x * gb.x * 4.f, xb.y * gb.y * 4.f, xb.z * gb.z * 4.f, xb.w * gb.w * 4.f);
            *(u32x2*)((unsigned char*)H + (tok0 + r) * D + 256 * w + 8 * kq + 32 * i) = o; }
        else { u32x4 o; o.x = pkbf(xa.x * ga.x, xa.y * ga.y); o.y = pkbf(xa.z * ga.z, xa.w * ga.w); o.z = pkbf(xb.x * gb.x, xb.y * gb.y); o.w = pkbf(xb.z * gb.z, xb.w * gb.w);
            *(u32x4*)(hp + 32 * i) = o;
            u32x2 o8; o8.x = pk4fp8(xa.x * ga.x * 4.f, xa.y * ga.y * 4.f, xa.z * ga.z * 4.f, xa.w * ga.w * 4.f); o8.y = pk4fp8(xb.x * gb.x * 4.f, xb.y * gb.y * 4.f, xb.z * gb.z * 4.f, xb.w * gb.w * 4.f);
            *(u32x2*)(F.ws + AUX_H8 + (tok0 + r) * D + 256 * w + 8 * kq + 32 * i) = o8; } } }
    if (w == 0) {
        float rs[4];
#pragma unroll
        for (int q = 0; q < 4; ++q) rs[q] = __shfl(rstd, 4 * kq + q);
        f32x4 tl4[NT];
#pragma unroll
        for (int nt = 0; nt < NT; ++nt) { tl4[nt] = lp[nt * 64 + lane];
#pragma unroll
            for (int q = 1; q < 8; ++q) tl4[nt] += lp[(q * NT + nt) * 64 + lane]; }
        if (MODE == 0) {
#pragma unroll
            for (int q = 0; q < 4; ++q) { const float v = tl4[0][q] * rs[q]; float o;
                if (r < 8) o = 1.0f / (1.0f + __expf(-v)); else { const float z = v + dtb; const float sp = z > 20.f ? z : log1pf(__expf(z)); o = nea * sp; }
                bg[(tok0 + 4 * kq + q) * 16 + r] = o; }
        } else {
#pragma unroll
            for (int nt = 0; nt < NT; ++nt)
#pragma unroll
                for (int q = 0; q < 4; ++q) lg[(4 * kq + q) * 48 + 16 * nt + r] = tl4[nt][q] * rs[q];
            LDS_WAIT();
            if (lane < 16) {
                const LAS float* p = lg + lane * 48;
                int g = 0; float gm = p[0];
#pragma unroll
                for (int j = 1; j < 4; ++j) { const float v = p[j]; if (v > gm) { gm = v; g = j; } }
                float gs = 0.f;
#pragma unroll
                for (int j = 0; j < 4; ++j) gs += __expf(p[j] - gm);
                const float g_p = 1.0f / gs;
                float q8[8];
#pragma unroll
                for (int i = 0; i < 8; ++i) q8[i] = p[4 + 8 * g + i];
                int i0 = 0; float m0 = q8[0];
#pragma unroll
                for (int i = 1; i < 8; ++i) if (q8[i] > m0) { m0 = q8[i]; i0 = i; }
                int i1 = -1; float m1 = -3.0e38f;
#pragma unroll
                for (int i = 0; i < 8; ++i) if (i != i0 && q8[i] > m1) { m1 = q8[i]; i1 = i; }
                if (i1 < 0) i1 = (i0 + 1) & 7;
                const float e1 = __expf(m1 - m0), w0 = g_p / (1.0f + e1), w1 = g_p * e1 / (1.0f + e1);
                sel[tl * 16 + lane] = (f32x4){__builtin_bit_cast(float, g * 8 + i0), __builtin_bit_cast(float, g * 8 + i1), w0, w1};
            }
        }
    }
}
template <int MODE, bool XB = false>
DI void normproj_pass(Frame& F, const void* x, const float* gain, const bf16_t* Wh, const bf16_t* Wl, bf16_t* H, float* bg, const float* a_log, const float* dt_bias, unsigned* cnt, int* list, float* gw, unsigned* asg) {
    constexpr int NTILE = NTOK / 16;
    typename XTileSel<XB>::T xa, xb;
    int tile = blockIdx.x, tl = 0;
    if (tile < NTILE) xtile_load(F, xa, x, tile);
    ((LAS f32x4*)(F.lds + NP_GAIN_OFF))[F.tid] = ((const f32x4*)gain)[F.tid];
    float dtb = 0.f, nea = 0.f;
    if (MODE == 0) { const int r8 = (F.lane & 15) - 8; if (r8 >= 0) { dtb = dt_bias[r8]; nea = -__expf(a_log[r8]); } }
    __syncthreads();
    while (tile < NTILE) {
        normproj_tile<MODE, XB>(F, xa, xb, x, tile + F.G < NTILE ? tile + F.G : -1, tile, tl, tl & 1, Wh, Wl, H, bg, dtb, nea);
        tile += F.G; ++tl;
        if (tile >= NTILE) break;
        normproj_tile<MODE, XB>(F, xb, xa, x, tile + F.G < NTILE ? tile + F.G : -1, tile, tl, tl & 1, Wh, Wl, H, bg, dtb, nea);
        tile += F.G; ++tl;
    }
    __syncthreads();
    if (MODE == 1 && F.wave == 0) {
        LAS f32x4* sel = (LAS f32x4*)(F.lds + 65536); LAS unsigned* hist = (LAS unsigned*)(F.lds + 65536 + 4096); LAS unsigned* base = hist + 32;
        const int lane = F.lane;
        if (lane < 32) hist[lane] = 0u;
        LDS_WAIT();
        const int ntok = tl * 16;
        unsigned rk[8]; int ee[8]; float ww[8]; int mm[8];
#pragma unroll
        for (int q = 0; q < 8; ++q) { const int a = lane + 64 * q;
            ee[q] = -1; if ((a >> 1) < ntok) { const f32x4 sv = sel[a >> 1]; ee[q] = __builtin_bit_cast(int, (a & 1) ? sv.y : sv.x); ww[q] = (a & 1) ? sv.w : sv.z;
                mm[q] = (blockIdx.x + ((a >> 1) >> 4) * F.G) * 16 + ((a >> 1) & 15); rk[q] = __hip_atomic_fetch_add(hist + ee[q], 1u, __ATOMIC_RELAXED, __HIP_MEMORY_SCOPE_WORKGROUP); } }
        LDS_WAIT();
        if (lane < 32) { const unsigned c = hist[lane]; base[lane] = c ? __hip_atomic_fetch_add(cnt + lane * CSTR, c, __ATOMIC_RELAXED, __HIP_MEMORY_SCOPE_AGENT) : 0u; }
        LDS_WAIT();
#pragma unroll
        for (int q = 0; q < 8; ++q) if (ee[q] >= 0) { const unsigned pos = base[ee[q]] + rk[q]; const int a = lane + 64 * q;
            list[ee[q] * 65536 + pos] = mm[q]; gw[ee[q] * 65536 + pos] = ww[q]; asg[2 * mm[q] + (a & 1)] = ((unsigned)ee[q] << 16) | pos; }
    }
    __syncthreads();
}

constexpr int NP1_PAR = 57344, NP1_SEL = 114688, NP1_GAIN = 122880;
DI void normproj_tile1(Frame& F, XTileB (&xr)[2], const void* x, int ntile, int tile, int tl, int par, const bf16_t* Wh, const bf16_t* Wl, bf16_t* H) {
    constexpr int NT = 3;
    int lane_o = F.lane; asm volatile("" : "+v"(lane_o));
    const int lane = lane_o, r = lane & 15, kq = lane >> 4, w = F.wave;
    LAS float* ssp = (LAS float*)(F.lds + par * NP1_PAR);
    LAS f32x4* lp = (LAS f32x4*)(F.lds + par * NP1_PAR + 1024);
    LAS float* lg = (LAS float*)(F.lds + par * NP1_PAR + 50176);
    LAS f32x4* sel = (LAS f32x4*)(F.lds + NP1_SEL);
    const size_t tok0 = (size_t)tile * 32;
    f32x4 acc[2][NT];
#pragma unroll
    for (int sb = 0; sb < 2; ++sb)
#pragma unroll
        for (int nt = 0; nt < NT; ++nt) acc[sb][nt] = (f32x4){0.f, 0.f, 0.f, 0.f};
    float ss[2] = {0.f, 0.f};
    u32x4 q0_0_0, q0_0_1, q0_1_0, q0_1_1, q0_2_0, q0_2_1, q1_0_0, q1_0_1, q1_1_0, q1_1_1, q1_2_0, q1_2_1, q2_0_0, q2_0_1, q2_1_0, q2_1_1, q2_2_0, q2_2_1;
    const unsigned char* wp0_0 = (const unsigned char*)(Wh + (size_t)(0 + r) * D + 256 * w + 8 * kq); const unsigned char* wp0_1 = (const unsigned char*)(Wl + (size_t)(0 + r) * D + 256 * w + 8 * kq);
    const unsigned char* wp1_0 = (const unsigned char*)(Wh + (size_t)(16 + r) * D + 256 * w + 8 * kq); const unsigned char* wp1_1 = (const unsigned char*)(Wl + (size_t)(16 + r) * D + 256 * w + 8 * kq);
    const unsigned char* wp2_0 = (const unsigned char*)(Wh + (size_t)(32 + r) * D + 256 * w + 8 * kq); const unsigned char* wp2_1 = (const unsigned char*)(Wl + (size_t)(32 + r) * D + 256 * w + 8 * kq);
    asm volatile("global_load_dwordx4 %0, %1, off" : "=v"(q0_0_0) : "v"(wp0_0) : "memory"); asm volatile("global_load_dwordx4 %0, %1, off" : "=v"(q0_0_1) : "v"(wp0_1) : "memory"); asm volatile("global_load_dwordx4 %0, %1, off" : "=v"(q0_1_0) : "v"(wp1_0) : "memory"); asm volatile("global_load_dwordx4 %0, %1, off" : "=v"(q0_1_1) : "v"(wp1_1) : "memory"); asm volatile("global_load_dwordx4 %0, %1, off" : "=v"(q0_2_0) : "v"(wp2_0) : "memory"); asm volatile("global_load_dwordx4 %0, %1, off" : "=v"(q0_2_1) : "v"(wp2_1) : "memory");
    asm volatile("global_load_dwordx4 %0, %1, off offset:64" : "=v"(q1_0_0) : "v"(wp0_0) : "memory"); asm volatile("global_load_dwordx4 %0, %1, off offset:64" : "=v"(q1_0_1) : "v"(wp0_1) : "memory"); asm volatile("global_load_dwordx4 %0, %1, off offset:64" : "=v"(q1_1_0) : "v"(wp1_0) : "memory"); asm volatile("global_load_dwordx4 %0, %1, off offset:64" : "=v"(q1_1_1) : "v"(wp1_1) : "memory"); asm volatile("global_load_dwordx4 %0, %1, off offset:64" : "=v"(q1_2_0) : "v"(wp2_0) : "memory"); asm volatile("global_load_dwordx4 %0, %1, off offset:64" : "=v"(q1_2_1) : "v"(wp2_1) : "memory");
    asm volatile("global_load_dwordx4 %0, %1, off offset:128" : "=v"(q2_0_0) : "v"(wp0_0) : "memory"); asm volatile("global_load_dwordx4 %0, %1, off offset:128" : "=v"(q2_0_1) : "v"(wp0_1) : "memory"); asm volatile("global_load_dwordx4 %0, %1, off offset:128" : "=v"(q2_1_0) : "v"(wp1_0) : "memory"); asm volatile("global_load_dwordx4 %0, %1, off offset:128" : "=v"(q2_1_1) : "v"(wp1_1) : "memory"); asm volatile("global_load_dwordx4 %0, %1, off offset:128" : "=v"(q2_2_0) : "v"(wp2_0) : "memory"); asm volatile("global_load_dwordx4 %0, %1, off offset:128" : "=v"(q2_2_1) : "v"(wp2_1) : "memory");
    asm volatile("s_waitcnt vmcnt(12)" : "+v"(q0_0_0), "+v"(q0_0_1), "+v"(q0_1_0), "+v"(q0_1_1), "+v"(q0_2_0), "+v"(q0_2_1));
#pragma unroll
    for (int sb = 0; sb < 2; ++sb) { f32x4 xa, xb; xget(xr[sb], 0, xa, xb);
        ss[sb] += ((xa.x * xa.x + xa.y * xa.y) + (xa.z * xa.z + xa.w * xa.w)) + ((xb.x * xb.x + xb.y * xb.y) + (xb.z * xb.z + xb.w * xb.w));
        const bf16x8 xh = __builtin_bit_cast(bf16x8, xr[sb].p[0]);
        acc[sb][0] = mfma16(xh, __builtin_bit_cast(bf16x8, q0_0_0), acc[sb][0]); acc[sb][0] = mfma16(xh, __builtin_bit_cast(bf16x8, q0_0_1), acc[sb][0]);
        acc[sb][1] = mfma16(xh, __builtin_bit_cast(bf16x8, q0_1_0), acc[sb][1]); acc[sb][1] = mfma16(xh, __builtin_bit_cast(bf16x8, q0_1_1), acc[sb][1]);
        acc[sb][2] = mfma16(xh, __builtin_bit_cast(bf16x8, q0_2_0), acc[sb][2]); acc[sb][2] = mfma16(xh, __builtin_bit_cast(bf16x8, q0_2_1), acc[sb][2]);
    }
    asm volatile("" :: "v"(acc[0][0]), "v"(acc[1][0]), "v"(acc[0][1]), "v"(acc[1][1]), "v"(acc[0][2]), "v"(acc[1][2]));
    asm volatile("global_load_dwordx4 %0, %1, off offset:192" : "=v"(q0_0_0) : "v"(wp0_0) : "memory"); asm volatile("global_load_dwordx4 %0, %1, off offset:192" : "=v"(q0_0_1) : "v"(wp0_1) : "memory"); asm volatile("global_load_dwordx4 %0, %1, off offset:192" : "=v"(q0_1_0) : "v"(wp1_0) : "memory"); asm volatile("global_load_dwordx4 %0, %1, off offset:192" : "=v"(q0_1_1) : "v"(wp1_1) : "memory"); asm volatile("global_load_dwordx4 %0, %1, off offset:192" : "=v"(q0_2_0) : "v"(wp2_0) : "memory"); asm volatile("global_load_dwordx4 %0, %1, off offset:192" : "=v"(q0_2_1) : "v"(wp2_1) : "memory");
    asm volatile("s_waitcnt vmcnt(12)" : "+v"(q1_0_0), "+v"(q1_0_1), "+v"(q1_1_0), "+v"(q1_1_1), "+v"(q1_2_0), "+v"(q1_2_1));
#pragma unroll
    for (int sb = 0; sb < 2; ++sb) { f32x4 xa, xb; xget(xr[sb], 1, xa, xb);
        ss[sb] += ((xa.x * xa.x + xa.y * xa.y) + (xa.z * xa.z + xa.w * xa.w)) + ((xb.x * xb.x + xb.y * xb.y) + (xb.z * xb.z + xb.w * xb.w));
        const bf16x8 xh = __builtin_bit_cast(bf16x8, xr[sb].p[1]);
        acc[sb][0] = mfma16(xh, __builtin_bit_cast(bf16x8, q1_0_0), acc[sb][0]); acc[sb][0] = mfma16(xh, __builtin_bit_cast(bf16x8, q1_0_1), acc[sb][0]);
        acc[sb][1] = mfma16(xh, __builtin_bit_cast(bf16x8, q1_1_0), acc[sb][1]); acc[sb][1] = mfma16(xh, __builtin_bit_cast(bf16x8, q1_1_1), acc[sb][1]);
        acc[sb][2] = mfma16(xh, __builtin_bit_cast(bf16x8, q1_2_0), acc[sb][2]); acc[sb][2] = mfma16(xh, __builtin_bit_cast(bf16x8, q1_2_1), acc[sb][2]);
    }
    asm volatile("" :: "v"(acc[0][0]), "v"(acc[1][0]), "v"(acc[0][1]), "v"(acc[1][1]), "v"(acc[0][2]), "v"(acc[1][2]));
    asm volatile("global_load_dwordx4 %0, %1, off offset:256" : "=v"(q1_0_0) : "v"(wp0_0) : "memory"); asm volatile("global_load_dwordx4 %0, %1, off offset:256" : "=v"(q1_0_1) : "v"(wp0_1) : "memory"); asm volatile("global_load_dwordx4 %0, %1, off offset:256" : "=v"(q1_1_0) : "v"(wp1_0) : "memory"); asm volatile("global_load_dwordx4 %0, %1, off offset:256" : "=v"(q1_1_1) : "v"(wp1_1) : "memory"); asm volatile("global_load_dwordx4 %0, %1, off offset:256" : "=v"(q1_2_0) : "v"(wp2_0) : "memory"); asm volatile("global_load_dwordx4 %0, %1, off offset:256" : "=v"(q1_2_1) : "v"(wp2_1) : "memory");
    asm volatile("s_waitcnt vmcnt(12)" : "+v"(q2_0_0), "+v"(q2_0_1), "+v"(q2_1_0), "+v"(q2_1_1), "+v"(q2_2_0), "+v"(q2_2_1));
#pragma unroll
    for (int sb = 0; sb < 2; ++sb) { f32x4 xa, xb; xget(xr[sb], 2, xa, xb);
        ss[sb] += ((xa.x * xa.x + xa.y * xa.y) + (xa.z * xa.z + xa.w * xa.w)) + ((xb.x * xb.x + xb.y * xb.y) + (xb.z * xb.z + xb.w * xb.w));
        const bf16x8 xh = __builtin_bit_cast(bf16x8, xr[sb].p[2]);
        acc[sb][0] = mfma16(xh, __builtin_bit_cast(bf16x8, q2_0_0), acc[sb][0]); acc[sb][0] = mfma16(xh, __builtin_bit_cast(bf16x8, q2_0_1), acc[sb][0]);
        acc[sb][1] = mfma16(xh, __builtin_bit_cast(bf16x8, q2_1_0), acc[sb][1]); acc[sb][1] = mfma16(xh, __builtin_bit_cast(bf16x8, q2_1_1), acc[sb][1]);
        acc[sb][2] = mfma16(xh, __builtin_bit_cast(bf16x8, q2_2_0), acc[sb][2]); acc[sb][2] = mfma16(xh, __builtin_bit_cast(bf16x8, q2_2_1), acc[sb][2]);
    }
    asm volatile("" :: "v"(acc[0][0]), "v"(acc[1][0]), "v"(acc[0][1]), "v"(acc[1][1]), "v"(acc[0][2]), "v"(acc[1][2]));
    asm volatile("global_load_dwordx4 %0, %1, off offset:320" : "=v"(q2_0_0) : "v"(wp0_0) : "memory"); asm volatile("global_load_dwordx4 %0, %1, off offset:320" : "=v"(q2_0_1) : "v"(wp0_1) : "memory"); asm volatile("global_load_dwordx4 %0, %1, off offset:320" : "=v"(q2_1_0) : "v"(wp1_0) : "memory"); asm volatile("global_load_dwordx4 %0, %1, off offset:320" : "=v"(q2_1_1) : "v"(wp1_1) : "memory"); asm volatile("global_load_dwordx4 %0, %1, off offset:320" : "=v"(q2_2_0) : "v"(wp2_0) : "memory"); asm volatile("global_load_dwordx4 %0, %1, off offset:320" : "=v"(q2_2_1) : "v"(wp2_1) : "memory");
    asm volatile("s_waitcnt vmcnt(12)" : "+v"(q0_0_0), "+v"(q0_0_1), "+v"(q0_1_0), "+v"(q0_1_1), "+v"(q0_2_0), "+v"(q0_2_1));
#pragma unroll
    for (int sb = 0; sb < 2; ++sb) { f32x4 xa, xb; xget(xr[sb], 3, xa, xb);
        ss[sb] += ((xa.x * xa.x + xa.y * xa.y) + (xa.z * xa.z + xa.w * xa.w)) + ((xb.x * xb.x + xb.y * xb.y) + (xb.z * xb.z + xb.w * xb.w));
        const bf16x8 xh = __builtin_bit_cast(bf16x8, xr[sb].p[3]);
        acc[sb][0] = mfma16(xh, __builtin_bit_cast(bf16x8, q0_0_0), acc[sb][0]); acc[sb][0] = mfma16(xh, __builtin_bit_cast(bf16x8, q0_0_1), acc[sb][0]);
        acc[sb][1] = mfma16(xh, __builtin_bit_cast(bf16x8, q0_1_0), acc[sb][1]); acc[sb][1] = mfma16(xh, __builtin_bit_cast(bf16x8, q0_1_1), acc[sb][1]);
        acc[sb][2] = mfma16(xh, __builtin_bit_cast(bf16x8, q0_2_0), acc[sb][2]); acc[sb][2] = mfma16(xh, __builtin_bit_cast(bf16x8, q0_2_1), acc[sb][2]);
    }
    asm volatile("" :: "v"(acc[0][0]), "v"(acc[1][0]), "v"(acc[0][1]), "v"(acc[1][1]), "v"(acc[0][2]), "v"(acc[1][2]));
    asm volatile("global_load_dwordx4 %0, %1, off offset:384" : "=v"(q0_0_0) : "v"(wp0_0) : "memory"); asm volatile("global_load_dwordx4 %0, %1, off offset:384" : "=v"(q0_0_1) : "v"(wp0_1) : "memory"); asm volatile("global_load_dwordx4 %0, %1, off offset:384" : "=v"(q0_1_0) : "v"(wp1_0) : "memory"); asm volatile("global_load_dwordx4 %0, %1, off offset:384" : "=v"(q0_1_1) : "v"(wp1_1) : "memory"); asm volatile("global_load_dwordx4 %0, %1, off offset:384" : "=v"(q0_2_0) : "v"(wp2_0) : "memory"); asm volatile("global_load_dwordx4 %0, %1, off offset:384" : "=v"(q0_2_1) : "v"(wp2_1) : "memory");
    asm volatile("s_waitcnt vmcnt(12)" : "+v"(q1_0_0), "+v"(q1_0_1), "+v"(q1_1_0), "+v"(q1_1_1), "+v"(q1_2_0), "+v"(q1_2_1));
#pragma unroll
    for (int sb = 0; sb < 2; ++sb) { f32x4 xa, xb; xget(xr[sb], 4, xa, xb);
        ss[sb] += ((xa.x * xa.x + xa.y * xa.y) + (xa.z * xa.z + xa.w * xa.w)) + ((xb.x * xb.x + xb.y * xb.y) + (xb.z * xb.z + xb.w * xb.w));
        const bf16x8 xh = __builtin_bit_cast(bf16x8, xr[sb].p[4]);
        acc[sb][0] = mfma16(xh, __builtin_bit_cast(bf16x8, q1_0_0), acc[sb][0]); acc[sb][0] = mfma16(xh, __builtin_bit_cast(bf16x8, q1_0_1), acc[sb][0]);
        acc[sb][1] = mfma16(xh, __builtin_bit_cast(bf16x8, q1_1_0), acc[sb][1]); acc[sb][1] = mfma16(xh, __builtin_bit_cast(bf16x8, q1_1_1), acc[sb][1]);
        acc[sb][2] = mfma16(xh, __builtin_bit_cast(bf16x8, q1_2_0), acc[sb][2]); acc[sb][2] = mfma16(xh, __builtin_bit_cast(bf16x8, q1_2_1), acc[sb][2]);
    }
    asm volatile("" :: "v"(acc[0][0]), "v"(acc[1][0]), "v"(acc[0][1]), "v"(acc[1][1]), "v"(acc[0][2]), "v"(acc[1][2]));
    asm volatile("global_load_dwordx4 %0, %1, off offset:448" : "=v"(q1_0_0) : "v"(wp0_0) : "memory"); asm volatile("global_load_dwordx4 %0, %1, off offset:448" : "=v"(q1_0_1) : "v"(wp0_1) : "memory"); asm volatile("global_load_dwordx4 %0, %1, off offset:448" : "=v"(q1_1_0) : "v"(wp1_0) : "memory"); asm volatile("global_load_dwordx4 %0, %1, off offset:448" : "=v"(q1_1_1) : "v"(wp1_1) : "memory"); asm volatile("global_load_dwordx4 %0, %1, off offset:448" : "=v"(q1_2_0) : "v"(wp2_0) : "memory"); asm volatile("global_load_dwordx4 %0, %1, off offset:448" : "=v"(q1_2_1) : "v"(wp2_1) : "memory");
    asm volatile("s_waitcnt vmcnt(12)" : "+v"(q2_0_0), "+v"(q2_0_1), "+v"(q2_1_0), "+v"(q2_1_1), "+v"(q2_2_0), "+v"(q2_2_1));
#pragma unroll
    for (int sb = 0; sb < 2; ++sb) { f32x4 xa, xb; xget(xr[sb], 5, xa, xb);
        ss[sb] += ((xa.x * xa.x + xa.y * xa.y) + (xa.z * xa.z + xa.w * xa.w)) + ((xb.x * xb.x + xb.y * xb.y) + (xb.z * xb.z + xb.w * xb.w));
        const bf16x8 xh = __builtin_bit_cast(bf16x8, xr[sb].p[5]);
        acc[sb][0] = mfma16(xh, __builtin_bit_cast(bf16x8, q2_0_0), acc[sb][0]); acc[sb][0] = mfma16(xh, __builtin_bit_cast(bf16x8, q2_0_1), acc[sb][0]);
        acc[sb][1] = mfma16(xh, __builtin_bit_cast(bf16x8, q2_1_0), acc[sb][1]); acc[sb][1] = mfma16(xh, __builtin_bit_cast(bf16x8, q2_1_1), acc[sb][1]);
        acc[sb][2] = mfma16(xh, __builtin_bit_cast(bf16x8, q2_2_0), acc[sb][2]); acc[sb][2] = mfma16(xh, __builtin_bit_cast(bf16x8, q2_2_1), acc[sb][2]);
    }
    asm volatile("s_waitcnt vmcnt(6)" : "+v"(q0_0_0), "+v"(q0_0_1), "+v"(q0_1_0), "+v"(q0_1_1), "+v"(q0_2_0), "+v"(q0_2_1));
#pragma unroll
    for (int sb = 0; sb < 2; ++sb) { f32x4 xa, xb; xget(xr[sb], 6, xa, xb);
        ss[sb] += ((xa.x * xa.x + xa.y * xa.y) + (xa.z * xa.z + xa.w * xa.w)) + ((xb.x * xb.x + xb.y * xb.y) + (xb.z * xb.z + xb.w * xb.w));
        const bf16x8 xh = __builtin_bit_cast(bf16x8, xr[sb].p[6]);
        acc[sb][0] = mfma16(xh, __builtin_bit_cast(bf16x8, q0_0_0), acc[sb][0]); acc[sb][0] = mfma16(xh, __builtin_bit_cast(bf16x8, q0_0_1), acc[sb][0]);
        acc[sb][1] = mfma16(xh, __builtin_bit_cast(bf16x8, q0_1_0), acc[sb][1]); acc[sb][1] = mfma16(xh, __builtin_bit_cast(bf16x8, q0_1_1), acc[sb][1]);
        acc[sb][2] = mfma16(xh, __builtin_bit_cast(bf16x8, q0_2_0), acc[sb][2]); acc[sb][2] = mfma16(xh, __builtin_bit_cast(bf16x8, q0_2_1), acc[sb][2]);
    }
    asm volatile("s_waitcnt vmcnt(0)" : "+v"(q1_0_0), "+v"(q1_0_1), "+v"(q1_1_0), "+v"(q1_1_1), "+v"(q1_2_0), "+v"(q1_2_1));
#pragma unroll
    for (int sb = 0; sb < 2; ++sb) { f32x4 xa, xb; xget(xr[sb], 7, xa, xb);
        ss[sb] += ((xa.x * xa.x + xa.y * xa.y) + (xa.z * xa.z + xa.w * xa.w)) + ((xb.x * xb.x + xb.y * xb.y) + (xb.z * xb.z + xb.w * xb.w));
        const bf16x8 xh = __builtin_bit_cast(bf16x8, xr[sb].p[7]);
        acc[sb][0] = mfma16(xh, __builtin_bit_cast(bf16x8, q1_0_0), acc[sb][0]); acc[sb][0] = mfma16(xh, __builtin_bit_cast(bf16x8, q1_0_1), acc[sb][0]);
        acc[sb][1] = mfma16(xh, __builtin_bit_cast(bf16x8, q1_1_0), acc[sb][1]); acc[sb][1] = mfma16(xh, __builtin_bit_cast(bf16x8, q1_1_1), acc[sb][1]);
        acc[sb][2] = mfma16(xh, __builtin_bit_cast(bf16x8, q1_2_0), acc[sb][2]); acc[sb][2] = mfma16(xh, __builtin_bit_cast(bf16x8, q1_2_1), acc[sb][2]);
    }
    asm volatile("" ::: "memory");
#pragma unroll
    for (int sb = 0; sb < 2; ++sb) { ss[sb] += __shfl_xor(ss[sb], 16); ss[sb] += __shfl_xor(ss[sb], 32); if (lane < 16) ssp[w * 32 + 16 * sb + lane] = ss[sb];
#pragma unroll
        for (int nt = 0; nt < NT; ++nt) lp[((w * 2 + sb) * NT + nt) * 64 + lane] = acc[sb][nt]; }
    __syncthreads();
    float rstd[2];
#pragma unroll
    for (int sb = 0; sb < 2; ++sb) { float tot = 0.f;
#pragma unroll
        for (int q = 0; q < 8; ++q) tot += ssp[q * 32 + 16 * sb + r];
        rstd[sb] = 1.0f / sqrtf(tot * (1.0f / D) + EPS); }
    { const LAS f32x4* gp = (const LAS f32x4*)(F.lds + NP1_GAIN) + 64 * w + 2 * kq;
#pragma unroll
      for (int sb = 0; sb < 2; ++sb)
#pragma unroll
        for (int i = 0; i < 8; ++i) { const f32x4 ga = gp[8 * i], gb = gp[8 * i + 1]; f32x4 xa, xb; xget(xr[sb], i, xa, xb); xa = xa * rstd[sb]; xb = xb * rstd[sb];
            u32x2 o; o.x = pk4fp8(xa.x * ga.x * 4.f, xa.y * ga.y * 4.f, xa.z * ga.z * 4.f, xa.w * ga.w * 4.f); o.y = pk4fp8(xb.x * gb.x * 4.f, xb.y * gb.y * 4.f, xb.z * gb.z * 4.f, xb.w * gb.w * 4.f);
            *(u32x2*)((unsigned char*)H + (tok0 + 16 * sb + r) * D + 256 * w + 8 * kq + 32 * i) = o; } }
    asm volatile("" ::: "memory");
    if (ntile >= 0) { xtile_load(F, xr[0], x, 2 * ntile); xtile_load(F, xr[1], x, 2 * ntile + 1); }
    if (w == 0) {
#pragma unroll
        for (int sb = 0; sb < 2; ++sb) { float rs[4];
#pragma unroll
            for (int q = 0; q < 4; ++q) rs[q] = __shfl(rstd[sb], 4 * kq + q);
#pragma unroll
            for (int nt = 0; nt < NT; ++nt) { f32x4 t4 = lp[(sb * NT + nt) * 64 + lane];
#pragma unroll
                for (int q = 1; q < 8; ++q) t4 += lp[((q * 2 + sb) * NT + nt) * 64 + lane];
#pragma unroll
                for (int q = 0; q < 4; ++q) lg[(16 * sb + 4 * kq + q) * 48 + 16 * nt + r] = t4[q] * rs[q]; } }
        LDS_WAIT();
        if (lane < 32) {
            const LAS float* p = lg + lane * 48;
            int g = 0; float gm = p[0];
#pragma unroll
            for (int j = 1; j < 4; ++j) { const float v = p[j]; if (v > gm) { gm = v; g = j; } }
            float gs = 0.f;
#pragma unroll
            for (int j = 0; j < 4; ++j) gs += __expf(p[j] - gm);
            const float g_p = 1.0f / gs;
            float q8[8];
#pragma unroll
            for (int i = 0; i < 8; ++i) q8[i] = p[4 + 8 * g + i];
            int i0 = 0; float m0 = q8[0];
#pragma unroll
            for (int i = 1; i < 8; ++i) if (q8[i] > m0) { m0 = q8[i]; i0 = i; }
            int i1 = -1; float m1 = -3.0e38f;
#pragma unroll
            for (int i = 0; i < 8; ++i) if (i != i0 && q8[i] > m1) { m1 = q8[i]; i1 = i; }
            if (i1 < 0) i1 = (i0 + 1) & 7;
            const float e1 = __expf(m1 - m0), w0 = g_p / (1.0f + e1), w1 = g_p * e1 / (1.0f + e1);
            sel[tl * 32 + lane] = (f32x4){__builtin_bit_cast(float, g * 8 + i0), __builtin_bit_cast(float, g * 8 + i1), w0, w1};
        }
    }
}
DI void normproj_pass1(Frame& F, const void* x, const float* gain, const bf16_t* Wh, const bf16_t* Wl, bf16_t* H, unsigned* cnt, int* list, float* gw, unsigned* asg) {
    constexpr int NTILE = NTOK / 32;
    XTileB xr[2];
    int tile = blockIdx.x, tl = 0;
    if (tile < NTILE) { xtile_load(F, xr[0], x, 2 * tile); xtile_load(F, xr[1], x, 2 * tile + 1); }
    ((LAS f32x4*)(F.lds + NP1_GAIN))[F.tid] = ((const f32x4*)gain)[F.tid];
    __syncthreads();
    while (tile < NTILE) {
        normproj_tile1(F, xr, x, tile + F.G < NTILE ? tile + F.G : -1, tile, tl, tl & 1, Wh, Wl, H);
        tile += F.G; ++tl;
    }
    __syncthreads();
    if (F.wave == 0) {
        LAS f32x4* sel = (LAS f32x4*)(F.lds + NP1_SEL); LAS unsigned* hist = (LAS unsigned*)(F.lds + NP1_SEL + 4096); LAS unsigned* base = hist + 32;
        const int lane = F.lane;
        if (lane < 32) hist[lane] = 0u;
        LDS_WAIT();
        const int ntok = tl * 32;
        unsigned rk[4]; int ee[4]; float ww[4]; int mm[4];
#pragma unroll
        for (int q = 0; q < 4; ++q) { const int a = lane + 64 * q;
            ee[q] = -1; if ((a >> 1) < ntok) { const f32x4 sv = sel[a >> 1]; ee[q] = __builtin_bit_cast(int, (a & 1) ? sv.y : sv.x); ww[q] = (a & 1) ? sv.w : sv.z;
                mm[q] = (blockIdx.x + ((a >> 1) >> 5) * F.G) * 32 + ((a >> 1) & 31); rk[q] = __hip_atomic_fetch_add(hist + ee[q], 1u, __ATOMIC_RELAXED, __HIP_MEMORY_SCOPE_WORKGROUP); } }
        LDS_WAIT();
        if (lane < 32) { const unsigned c = hist[lane]; base[lane] = c ? __hip_atomic_fetch_add(cnt + lane * CSTR, c, __ATOMIC_RELAXED, __HIP_MEMORY_SCOPE_AGENT) : 0u; }
        LDS_WAIT();
#pragma unroll
        for (int q = 0; q < 4; ++q) if (ee[q] >= 0) { const unsigned pos = base[ee[q]] + rk[q]; const int a = lane + 64 * q;
            list[ee[q] * 65536 + pos] = mm[q]; gw[ee[q] * 65536 + pos] = ww[q]; asg[2 * mm[q] + (a & 1)] = ((unsigned)ee[q] << 16) | pos; }
    }
    __syncthreads();
}

DI unsigned dpp_ror8(unsigned v) { return (unsigned)__builtin_amdgcn_mov_dpp((int)v, 0x128, 0xf, 0xf, true); }
constexpr int PT = 8;
DI void prep_load(u32x4 (&rr)[PT + 3], f32x4 (&w)[4][2], const bf16_t* pj, const float* conv_w, int m0, int pos0, int j, int lane) {
    const int ch = 512 * j + 8 * lane;
#pragma unroll
    for (int tp = 0; tp < 4; ++tp) { w[tp][0] = *(const f32x4*)(conv_w + tp * 4096 + ch); w[tp][1] = *(const f32x4*)(conv_w + tp * 4096 + ch + 4); }
#pragma unroll
    for (int q = 0; q < PT + 3; ++q) { const int dp = pos0 - 3 + q; rr[q] = (u32x4){0u, 0u, 0u, 0u}; if (dp >= 0) rr[q] = *(const u32x4*)(pj + (size_t)(m0 - 3 + q) * PJW + C_GQKV + ch); }
}
DI void prep_compute(const u32x4 (&rr)[PT + 3], const f32x4 (&w)[4][2], bf16_t* qn, bf16_t* kn, bf16_t* vc, int m0, int j, int lane) {
    const int ch = 512 * j + 8 * lane;
#pragma unroll
    for (int tt = 0; tt < PT; ++tt) { float a[8];
#pragma unroll
        for (int e = 0; e < 8; ++e) a[e] = 0.f;
#pragma unroll
        for (int tp = 0; tp < 4; ++tp) { const u32x4 r = rr[tt + tp];
            a[0] += bflo(r.x) * w[tp][0].x; a[1] += bfhi(r.x) * w[tp][0].y; a[2] += bflo(r.y) * w[tp][0].z; a[3] += bfhi(r.y) * w[tp][0].w; a[4] += bflo(r.z) * w[tp][1].x; a[5] += bfhi(r.z) * w[tp][1].y; a[6] += bflo(r.w) * w[tp][1].z; a[7] += bfhi(r.w) * w[tp][1].w; }
        float ss = 0.f;
#pragma unroll
        for (int e = 0; e < 8; ++e) { a[e] = siluf_r(a[e]); ss += a[e] * a[e]; }
        if (j < 4) { ss = sum16_dpp(ss);
            const float sc = __builtin_amdgcn_rsqf(ss + EPS) * (j < 2 ? 0.08838834764831845f : 1.0f);
#pragma unroll
            for (int e = 0; e < 8; ++e) a[e] *= sc; }
        u32x4 o; o.x = pk2(a[0], a[1]); o.y = pk2(a[2], a[3]); o.z = pk2(a[4], a[5]); o.w = pk2(a[6], a[7]);
        const size_t m = (size_t)(m0 + tt);
        bf16_t* dst = j < 2 ? qn + m * 1024 + ch : (j < 4 ? kn + m * 1024 + (ch - 1024) : vc + m * 2048 + (ch - 2048));
        *(u32x4*)dst = o; }
}
DI void p2_prep(Frame& F, const float* conv_w) {
    const bf16_t* pj = (const bf16_t*)(F.ws + WS_BIG + BIG_PJ);
    bf16_t* qn = (bf16_t*)(F.ws + AUX_QN); bf16_t* kn = (bf16_t*)(F.ws + AUX_KN); bf16_t* vc = (bf16_t*)(F.ws + AUX_VC);
    const int lane = F.lane;
    u32x4 ra[PT + 3], rb[PT + 3]; f32x4 wa[4][2], wb[4][2];
    int grp = F.gw;
    if (grp < NTOK / PT) prep_load(ra, wa, pj, conv_w, grp * PT, (grp * PT) & (SEQ - 1), 0, lane);
    for (; grp < NTOK / PT; grp += F.NGW) {
        const int m0 = grp * PT, pos0 = m0 & (SEQ - 1);
#pragma unroll 1
        for (int j2 = 0; j2 < 4; ++j2) {
            int lane_o = F.lane; asm volatile("" : "+v"(lane_o)); const int lane = lane_o;
            prep_load(rb, wb, pj, conv_w, m0, pos0, 2 * j2 + 1, lane);
            asm volatile("" ::: "memory");
            prep_compute(ra, wa, qn, kn, vc, m0, 2 * j2, lane);
            asm volatile("" ::: "memory");
            if (j2 < 3) prep_load(ra, wa, pj, conv_w, m0, pos0, 2 * j2 + 2, lane);
            else if (grp + F.NGW < NTOK / PT) { const int mn = (grp + F.NGW) * PT; prep_load(ra, wa, pj, conv_w, mn, mn & (SEQ - 1), 0, lane); }
            asm volatile("" ::: "memory");
            prep_compute(rb, wb, qn, kn, vc, m0, 2 * j2 + 1, lane);
            asm volatile("" ::: "memory");
        }
    }
}

constexpr int TB = 16;
template <bool GDN>
DI void p3_recurrence(Frame& F, int u  ) {
    const int b = u >> 2, h = 2 * (u & 3) + (F.tid >> 8), e = F.tid & 255, hh = F.tid >> 8;
    bf16_t* pj = (bf16_t*)(F.ws + WS_BIG + BIG_PJ);
    const bf16_t* qsrc = GDN ? (const bf16_t*)(F.ws + AUX_QN) : pj + C_RQ; const bf16_t* ksrc = GDN ? (const bf16_t*)(F.ws + AUX_KN) : pj + C_RK;
    const int qld = GDN ? 1024 : PJW;
    bf16_t* vsrc = GDN ? (bf16_t*)(F.ws + AUX_VC) : pj + C_RV; const int vld = GDN ? 2048 : PJW;
    const float* bg = (const float*)(F.ws + AUX_BG);
    LAS float* qs = (LAS float*)F.lds;
    LAS float* ks = qs + 2 * TB * 128;
    LAS float* ab = ks + 2 * TB * 128;
    LAS float* vs = ab + 2 * TB * 2;
    float S[128];
#pragma unroll
    for (int d = 0; d < 128; ++d) S[d] = 0.f;
    const float gam = GDN ? 0.f : (1.0f - exp2f(-5.0f - (float)h));
    for (int t0 = 0; t0 < SEQ; t0 += TB) {
        const size_t r0 = (size_t)b * SEQ + t0;
        __syncthreads();
        for (int i = F.tid; i < 2 * TB * 128; i += NTHR) { const int h2 = i / (TB * 128), tt = (i / 128) % TB, d = i % 128; const int hd = 2 * (u & 3) + h2;
            qs[i] = bf2f(qsrc[(r0 + tt) * qld + hd * 128 + d]); ks[i] = bf2f(ksrc[(r0 + tt) * qld + hd * 128 + d]); }
        for (int i = F.tid; i < 2 * TB * 256; i += NTHR) { const int h2 = i / (TB * 256), tt = (i / 256) % TB, ee = i % 256; vs[i] = bf2f(vsrc[(r0 + tt) * vld + (2 * (u & 3) + h2) * 256 + ee]); }
        if (GDN && F.tid < 2 * TB) { const int h2 = F.tid / TB, tt = F.tid % TB, hd = 2 * (u & 3) + h2; ab[F.tid * 2] = __expf(bg[(r0 + tt) * 16 + 8 + hd]); ab[F.tid * 2 + 1] = bg[(r0 + tt) * 16 + hd]; }
        __syncthreads();
#pragma unroll 1
        for (int tt = 0; tt < TB; ++tt) {
            const LAS f32x4* q4 = (const LAS f32x4*)(qs + (hh * TB + tt) * 128); const LAS f32x4* k4 = (const LAS f32x4*)(ks + (hh * TB + tt) * 128);
            const float v = vs[(hh * TB + tt) * 256 + e];
            float o = 0.f;
            if (GDN) {
                const float a = ab[(hh * TB + tt) * 2], beta = ab[(hh * TB + tt) * 2 + 1];
                float ksum = 0.f;
#pragma unroll
                for (int d4 = 0; d4 < 32; ++d4) { if ((d4 & 7) == 0) asm volatile("" ::: "memory"); const f32x4 kk = k4[d4]; ksum += (kk.x * S[4 * d4] + kk.y * S[4 * d4 + 1]) + (kk.z * S[4 * d4 + 2] + kk.w * S[4 * d4 + 3]); }
                const float r = (v - a * ksum) * beta;
#pragma unroll
                for (int d4 = 0; d4 < 32; ++d4) { if ((d4 & 3) == 0) asm volatile("" ::: "memory"); const f32x4 kk = k4[d4], qq = q4[d4];
                    S[4 * d4] = a * S[4 * d4] + r * kk.x; S[4 * d4 + 1] = a * S[4 * d4 + 1] + r * kk.y; S[4 * d4 + 2] = a * S[4 * d4 + 2] + r * kk.z; S[4 * d4 + 3] = a * S[4 * d4 + 3] + r * kk.w;
                    o += (qq.x * S[4 * d4] + qq.y * S[4 * d4 + 1]) + (qq.z * S[4 * d4 + 2] + qq.w * S[4 * d4 + 3]); }
            } else {
#pragma unroll
                for (int d4 = 0; d4 < 32; ++d4) { if ((d4 & 3) == 0) asm volatile("" ::: "memory"); const f32x4 kk = k4[d4], qq = q4[d4];
                    S[4 * d4] = gam * S[4 * d4] + v * kk.x; S[4 * d4 + 1] = gam * S[4 * d4 + 1] + v * kk.y; S[4 * d4 + 2] = gam * S[4 * d4 + 2] + v * kk.z; S[4 * d4 + 3] = gam * S[4 * d4 + 3] + v * kk.w;
                    o += (qq.x * S[4 * d4] + qq.y * S[4 * d4 + 1]) + (qq.z * S[4 * d4 + 2] + qq.w * S[4 * d4 + 3]); }
            }
            vsrc[(r0 + tt) * vld + h * 256 + e] = (bf16_t)f2bf(o);
        }
    }
}


constexpr int NCH = SEQ / 64;
DI constexpr int rowoff4c(int i) { int a = 0; for (int k = 0; k < i; ++k) a += (k + 3) / 4; return a; }
typedef short s16x4 __attribute__((ext_vector_type(4)));
DI s16x4 tr_read(unsigned lds_addr) { s16x4 r; asm volatile("ds_read_b64_tr_b16 %0, %1\n\ts_waitcnt lgkmcnt(0)" : "=&v"(r) : "v"(lds_addr) : "memory"); return r; }
DI void tr_read4(unsigned a0, unsigned a1, unsigned a2, unsigned a3, s16x4& r0, s16x4& r1, s16x4& r2, s16x4& r3) {
    asm volatile("ds_read_b64_tr_b16 %0, %4\n\tds_read_b64_tr_b16 %1, %5\n\tds_read_b64_tr_b16 %2, %6\n\tds_read_b64_tr_b16 %3, %7\n\ts_waitcnt lgkmcnt(0)"
                 : "=&v"(r0), "=&v"(r1), "=&v"(r2), "=&v"(r3) : "v"(a0), "v"(a1), "v"(a2), "v"(a3) : "memory"); }
DI bf16x8 cat8(s16x4 a, s16x4 b) { return __builtin_shufflevector(a, b, 0, 1, 2, 3, 4, 5, 6, 7); }

DI void rope_pair_c(bf16x8& f1, bf16x8& f2, const f32x4 c0, const f32x4 c1, const f32x4 c2, const f32x4 c3, float sc) {
    const float cs_[8] = {c0.x, c0.z, c1.x, c1.z, c2.x, c2.z, c3.x, c3.z}, sn_[8] = {c0.y, c0.w, c1.y, c1.w, c2.y, c2.w, c3.y, c3.w};
    const u32x4 a = __builtin_bit_cast(u32x4, f1), b = __builtin_bit_cast(u32x4, f2);
    const float x1[8] = {bflo(a.x), bfhi(a.x), bflo(a.y), bfhi(a.y), bflo(a.z), bfhi(a.z), bflo(a.w), bfhi(a.w)}, x2[8] = {bflo(b.x), bfhi(b.x), bflo(b.y), bfhi(b.y), bflo(b.z), bfhi(b.z), bflo(b.w), bfhi(b.w)};
    float y1[8], y2[8];
#pragma unroll
    for (int e = 0; e < 8; ++e) { y1[e] = (x1[e] * cs_[e] - x2[e] * sn_[e]) * sc; y2[e] = (x2[e] * cs_[e] + x1[e] * sn_[e]) * sc; }
    u32x4 o1, o2; o1.x = pk2(y1[0], y1[1]); o1.y = pk2(y1[2], y1[3]); o1.z = pk2(y1[4], y1[5]); o1.w = pk2(y1[6], y1[7]); o2.x = pk2(y2[0], y2[1]); o2.y = pk2(y2[2], y2[3]); o2.z = pk2(y2[4], y2[5]); o2.w = pk2(y2[6], y2[7]);
    f1 = __builtin_bit_cast(bf16x8, o1); f2 = __builtin_bit_cast(bf16x8, o2);
}
DI void rope_pair(bf16x8& f1, bf16x8& f2, const f32x4* cp, float sc) { rope_pair_c(f1, f2, cp[0], cp[1], cp[2], cp[3], sc); }
template <bool GDN>
DI void ga_unit(Frame& F, int unit, unsigned char* stream, float* out_f32_unused) {
    (void)out_f32_unused;
    constexpr int NF = GDN ? 56 : 40, OFF_W = 0, OFF_QG = GDN ? 16 : 0, OFF_ATT = OFF_QG + 16, OFF_KT = OFF_ATT + 8;
    int lane_o = F.lane; asm volatile("" : "+v"(lane_o));
    const int lane = lane_o, fr = lane & 15, g = lane >> 4;
    const int bh = unit / NCH, n = unit % NCH, b = bh >> 3, h = bh & 7;
    const size_t row0 = (size_t)b * SEQ + (size_t)n * 64;
    LAS unsigned char* L = F.lds + F.wave * GA_LDS_WAVE;
    LAS float* LAf = (LAS float*)L; LAS unsigned char* LA = L; LAS unsigned char* LT = L + 9216; LAS float* LG = (LAS float*)(L + 17408); LAS float* LB = LG + 64;
    const bf16_t* pj = (const bf16_t*)(F.ws + WS_BIG + BIG_PJ);
    const bf16_t* qsrc = GDN ? (const bf16_t*)(F.ws + AUX_QN) + h * 128 : pj + C_RQ + h * 128;
    const bf16_t* ksrc = GDN ? (const bf16_t*)(F.ws + AUX_KN) + h * 128 : pj + C_RK + h * 128;
    const size_t qld = GDN ? 1024 : PJW;
    unsigned char* st = stream + (size_t)unit * NF * 1024 + lane * 16;
    bf16x8 Kf[4][4], Qf[4][4];
#pragma unroll
    for (int t = 0; t < 4; ++t)
#pragma unroll
        for (int s2 = 0; s2 < 4; ++s2) { Kf[t][s2] = *(const bf16x8*)(ksrc + (row0 + 16 * t + fr) * qld + 32 * s2 + 8 * g); Qf[t][s2] = *(const bf16x8*)(qsrc + (row0 + 16 * t + fr) * qld + 32 * s2 + 8 * g); }
    float gv, bv = 1.f;
    if (GDN) { const float* bg = (const float*)(F.ws + AUX_BG); gv = bg[(row0 + lane) * 16 + 8 + h]; bv = bg[(row0 + lane) * 16 + h];
#pragma unroll
        for (int o = 1; o < 64; o <<= 1) { const float t = __shfl_up(gv, o); if (lane >= o) gv += t; } }
    else gv = (float)(lane + 1) * log1pf(-exp2f(-5.0f - (float)h));
    const float gl = rdlane(gv, 63);
    LG[lane] = gv; LB[lane] = bv;
    LDS_WAIT();
    float gr[16], gcl[4], br[16];
#pragma unroll
    for (int t = 0; t < 4; ++t) { gcl[t] = LG[16 * t + fr];
#pragma unroll
        for (int r = 0; r < 4; ++r) { gr[t * 4 + r] = LG[16 * t + 4 * g + r]; br[t * 4 + r] = LB[16 * t + 4 * g + r]; } }
    if (!GDN) {
        const f32x2* cs = (const f32x2*)(F.ws + AUX_CS);
#pragma unroll
        for (int t = 0; t < 4; ++t) { const f32x4* cr = (const f32x4*)(cs + (size_t)((row0 + 16 * t + fr) & (SEQ - 1)) * 64 + 8 * g);
            { const f32x4 c0 = cr[0], c1 = cr[1], c2 = cr[2], c3 = cr[3]; rope_pair_c(Kf[t][0], Kf[t][2], c0, c1, c2, c3, 0.08838834764831845f); rope_pair_c(Qf[t][0], Qf[t][2], c0, c1, c2, c3, 1.0f); }
            { const f32x4 c0 = cr[16], c1 = cr[17], c2 = cr[18], c3 = cr[19]; rope_pair_c(Kf[t][1], Kf[t][3], c0, c1, c2, c3, 0.08838834764831845f); rope_pair_c(Qf[t][1], Qf[t][3], c0, c1, c2, c3, 1.0f); }
#pragma unroll
            for (int s2 = 0; s2 < 4; ++s2) *(LAS bf16x8*)(L + (16 * t + fr) * 256 + (32 * s2 + 8 * g) * 2) = Qf[t][s2]; }
    }
    if (GDN) {
#pragma unroll
        for (int it = 0; it < 4; ++it)
#pragma unroll
            for (int jt = 0; jt <= it; ++jt) { f32x4 acc = {0.f, 0.f, 0.f, 0.f};
#pragma unroll
                for (int s2 = 0; s2 < 4; ++s2) acc = mfma16(Kf[it][s2], Kf[jt][s2], acc);
#pragma unroll
                for (int r = 0; r < 4; ++r) { const int i = 16 * it + 4 * g + r, j = 16 * jt + fr; const int q = (i + 3) >> 2; const int ro = 2 * q * (q - 1) + q * (i - 4 * q + 3);
                    if (j < i) LAf[ro * 4 + j] = br[it * 4 + r] * acc[r] * __expf(gr[it * 4 + r] - gcl[jt]); } }
    }
    asm volatile("" ::: "memory");
#pragma unroll
    for (int it = 0; it < 4; ++it) {
        asm volatile("" ::: "memory");
#pragma unroll
        for (int sp = 0; sp < 2; ++sp) { u32x4 w;
#pragma unroll
            for (int hf = 0; hf < 2; ++hf) { const int jt = 2 * sp + hf; float v[4] = {0.f, 0.f, 0.f, 0.f};
                if (jt <= it) { f32x4 acc = {0.f, 0.f, 0.f, 0.f};
#pragma unroll
                    for (int s2 = 0; s2 < 4; ++s2) acc = mfma16(Kf[jt][s2], Qf[it][s2], acc);
#pragma unroll
                    for (int r = 0; r < 4; ++r) { const int j = 16 * jt + 4 * g + r, i = 16 * it + fr; v[r] = (j <= i) ? acc[r] * __expf(gcl[it] - gr[jt * 4 + r]) : 0.f; } }
                if (hf == 0) { w.x = pk2(v[0], v[1]); w.y = pk2(v[2], v[3]); } else { w.z = pk2(v[0], v[1]); w.w = pk2(v[2], v[3]); } }
            *(u32x4*)(st + (OFF_ATT + it * 2 + sp) * 1024) = w; }
    }
    if (!GDN) LDS_WAIT();
    asm volatile("" ::: "memory");
#pragma unroll
    for (int it = 0; it < 4; ++it) { const float sc = __expf(gcl[it]); if (!GDN) asm volatile("" ::: "memory");
#pragma unroll
        for (int s2 = 0; s2 < 4; ++s2) { const bf16_t* qp = qsrc + (row0 + 16 * it + fr) * qld + 32 * s2 + 4 * g; u32x2 lo, hi;
            if (GDN) { lo = *(const u32x2*)qp; hi = *(const u32x2*)(qp + 16); }
            else { const LAS unsigned char* lq = L + (16 * it + fr) * 256 + (32 * s2 + 4 * g) * 2; lo = *(const LAS u32x2*)lq; hi = *(const LAS u32x2*)(lq + 32); }
            u32x4 w; w.x = pk2(bflo(lo.x) * sc, bfhi(lo.x) * sc); w.y = pk2(bflo(lo.y) * sc, bfhi(lo.y) * sc); w.z = pk2(bflo(hi.x) * sc, bfhi(hi.x) * sc); w.w = pk2(bflo(hi.y) * sc, bfhi(hi.y) * sc);
            *(u32x4*)(st + (OFF_QG + it * 4 + s2) * 1024) = w; } }
    asm volatile("" ::: "memory");
    u32x4 kr[8];
    if (GDN) {
#pragma unroll
        for (int k = 0; k < 8; ++k) kr[k] = *(const u32x4*)(ksrc + (row0 + (lane >> 3) + 8 * k) * qld + 8 * (lane & 7)); }
    float t[64];
    float sw_ = 1.f, su_ = 1.f;
    if (GDN) {
        LDS_WAIT();
        const LAS f32x4* LA4 = (const LAS f32x4*)LA;
#pragma unroll
        for (int i = 0; i < 64; ++i) { float acc = (lane == i) ? 1.f : 0.f; if ((i & 1) == 0) asm volatile("" ::: "memory");
#pragma unroll
            for (int m4 = 0; m4 < (i + 3) / 4; ++m4) { const f32x4 l = LA4[rowoff4c(i) + m4];
                if (4 * m4 + 0 < i) acc -= l.x * t[4 * m4 + 0]; if (4 * m4 + 1 < i) acc -= l.y * t[4 * m4 + 1]; if (4 * m4 + 2 < i) acc -= l.z * t[4 * m4 + 2]; if (4 * m4 + 3 < i) acc -= l.w * t[4 * m4 + 3]; }
            t[i] = acc; }
        su_ = bv; sw_ = bv * __expf(gv);
        LDS_WAIT();
#pragma unroll
        for (int i = 0; i < 64; ++i) *(LAS bf16_t*)(LT + (i * 64 + lane) * 2) = (bf16_t)f2bf(t[i] * sw_);
    }
    asm volatile("" ::: "memory");
    float ksc[2][2][4];
#pragma unroll
    for (int sp = 0; sp < 2; ++sp)
#pragma unroll
        for (int tp = 0; tp < 2; ++tp)
#pragma unroll
            for (int e = 0; e < 4; ++e) ksc[sp][tp][e] = __expf(gl - LG[32 * sp + 16 * tp + 4 * g + e]);
    const unsigned la_addr = (unsigned)(size_t)LA, q4 = (unsigned)((lane & 15) >> 2), p4 = (unsigned)(lane & 3);
#pragma unroll 1
    for (int p = 0; p < 2; ++p) {
        LDS_WAIT();
#pragma unroll
        for (int k = 0; k < 8; ++k) { const int row = (lane >> 3) + 8 * k, pc = lane & 7; if (GDN) *(LAS u32x4*)(LA + row * 128 + pc * 16) = kr[k]; }
        if (GDN && p == 0) { asm volatile("" ::: "memory");
#pragma unroll
            for (int k = 0; k < 8; ++k) kr[k] = *(const u32x4*)(ksrc + (row0 + (lane >> 3) + 8 * k) * qld + 64 + 8 * (lane & 7)); }
        if (!GDN) {
#pragma unroll
            for (int t = 0; t < 4; ++t)
#pragma unroll
                for (int s2 = 0; s2 < 4; ++s2) if ((s2 >> 1) == p) *(LAS bf16x8*)(LA + (16 * t + fr) * 128 + (32 * (s2 & 1) + 8 * g) * 2) = Kf[t][s2]; }
        LDS_WAIT();
        if (GDN) {
#pragma unroll
            for (int it = 0; it < 4; ++it) { bf16x8 Tf[2];
#pragma unroll
                for (int ks = 0; ks < 2; ++ks) Tf[ks] = *(const LAS bf16x8*)(LT + ((16 * it + fr) * 64 + 32 * ks + 8 * g) * 2);
#pragma unroll
                for (int sl = 0; sl < 2; ++sl) { u32x4 w;
#pragma unroll
                    for (int hf = 0; hf < 2; ++hf) { const int dtl = 2 * sl + hf; f32x4 acc = {0.f, 0.f, 0.f, 0.f};
                        { s16x4 a0, a1, a2, a3; const unsigned ad = la_addr + (8 * g + q4) * 128 + dtl * 32 + p4 * 8; tr_read4(ad, ad + 4 * 128, ad + 32 * 128, ad + 36 * 128, a0, a1, a2, a3);
                          acc = mfma16(cat8(a0, a1), Tf[0], acc); acc = mfma16(cat8(a2, a3), Tf[1], acc); }
                        if (hf == 0) { w.x = pk2(-acc[0], -acc[1]); w.y = pk2(-acc[2], -acc[3]); } else { w.z = pk2(-acc[0], -acc[1]); w.w = pk2(-acc[2], -acc[3]); } }
                    *(u32x4*)(st + (OFF_W + it * 4 + 2 * p + sl) * 1024) = w; } }
        }
#pragma unroll
        for (int dtl = 0; dtl < 4; ++dtl) { s16x4 t0, t1, t2, t3; const unsigned ad = la_addr + (4 * g + q4) * 128 + dtl * 32 + p4 * 8; tr_read4(ad, ad + 16 * 128, ad + 32 * 128, ad + 48 * 128, t0, t1, t2, t3);
#pragma unroll
            for (int sp = 0; sp < 2; ++sp) { const s16x4 a0 = sp ? t2 : t0, a1 = sp ? t3 : t1;
                u32x4 w; w.x = pk2(bf2f((bf16_t)a0[0]) * ksc[sp][0][0], bf2f((bf16_t)a0[1]) * ksc[sp][0][1]); w.y = pk2(bf2f((bf16_t)a0[2]) * ksc[sp][0][2], bf2f((bf16_t)a0[3]) * ksc[sp][0][3]);
                w.z = pk2(bf2f((bf16_t)a1[0]) * ksc[sp][1][0], bf2f((bf16_t)a1[1]) * ksc[sp][1][1]); w.w = pk2(bf2f((bf16_t)a1[2]) * ksc[sp][1][2], bf2f((bf16_t)a1[3]) * ksc[sp][1][3]);
                *(u32x4*)(st + (OFF_KT + (4 * p + dtl) * 2 + sp) * 1024) = w; } }
    }
    if (GDN) {
        LDS_WAIT();
#pragma unroll
        for (int i = 0; i < 64; ++i) *(LAS bf16_t*)(LT + (i * 64 + lane) * 2) = (bf16_t)f2bf(t[i] * su_);
        const bf16_t* vsrc = (const bf16_t*)(F.ws + AUX_VC) + h * 256;
        unsigned char* ub = F.ws + WS_H + (size_t)unit * 32768 + lane * 32;
        u32x4 vr[8];
#pragma unroll
        for (int k = 0; k < 8; ++k) vr[k] = *(const u32x4*)(vsrc + (row0 + (lane >> 3) + 8 * k) * 2048 + 8 * (lane & 7));
#pragma unroll 1
        for (int p = 0; p < 4; ++p) {
            LDS_WAIT();
#pragma unroll
            for (int k = 0; k < 8; ++k) { const int row = (lane >> 3) + 8 * k, pc = lane & 7; *(LAS u32x4*)(LA + row * 128 + pc * 16) = vr[k]; }
            asm volatile("" ::: "memory");
            if (p < 3) {
#pragma unroll
                for (int k = 0; k < 8; ++k) vr[k] = *(const u32x4*)(vsrc + (row0 + (lane >> 3) + 8 * k) * 2048 + 64 * (p + 1) + 8 * (lane & 7)); }
            LDS_WAIT();
            bf16x8 Tf[4][2];
#pragma unroll
            for (int it = 0; it < 4; ++it)
#pragma unroll
                for (int ks = 0; ks < 2; ++ks) Tf[it][ks] = *(const LAS bf16x8*)(LT + ((16 * it + fr) * 64 + 32 * ks + 8 * g) * 2);
#pragma unroll
            for (int etl = 0; etl < 4; ++etl) { bf16x8 Vf[2];
                { s16x4 a0, a1, a2, a3; const unsigned ad = la_addr + (8 * g + q4) * 128 + etl * 32 + p4 * 8; tr_read4(ad, ad + 4 * 128, ad + 32 * 128, ad + 36 * 128, a0, a1, a2, a3); Vf[0] = cat8(a0, a1); Vf[1] = cat8(a2, a3); }
                u32x4 w0, w1;
#pragma unroll
                for (int it = 0; it < 4; ++it) { f32x4 acc = {0.f, 0.f, 0.f, 0.f};
#pragma unroll
                    for (int ks = 0; ks < 2; ++ks) acc = mfma16(Tf[it][ks], Vf[ks], acc);
                    const unsigned a = pk2(acc[0], acc[1]), c = pk2(acc[2], acc[3]);
                    if (it == 0) { w0.x = a; w0.y = c; } else if (it == 1) { w0.z = a; w0.w = c; } else if (it == 2) { w1.x = a; w1.y = c; } else { w1.z = a; w1.w = c; } }
                *(u32x4*)(ub + (4 * p + etl) * 2048) = w0; *(u32x4*)(ub + (4 * p + etl) * 2048 + 16) = w1; }
        }
        if (lane == 0) ((float*)(F.ws + AUX_DEC))[unit] = __expf(gl);
    }
    LDS_WAIT();
}

constexpr int XL_SLOT = 12288, XL_CNT = 2 * XL_SLOT;
template <bool GDN, int ROLE>
DI void scan_wave(Frame& F, int bh, int sl, const unsigned char* stream, LAS unsigned char* xl) {
    constexpr int NF = GDN ? 56 : 40;
    const int lane = F.lane, fr = lane & 15, g = lane >> 4, b = bh >> 3, h = bh & 7;
    const unsigned char* sp0 = stream + (size_t)bh * NCH * NF * 1024;
    const unsigned voff = (unsigned)lane * 16u;
    const size_t orow = (size_t)2048 * 2;
    const unsigned char* obu = (GDN ? F.ws + AUX_VC : F.ws + AUX_QN) + (size_t)b * SEQ * orow + (size_t)(h * 256 + 16 * sl) * 2;
    const unsigned ooff = (unsigned)((size_t)(4 * g) * orow) + (unsigned)fr * 2u;
    const size_t vrow = (size_t)PJW * 2;
    const unsigned char* vbu = F.ws + WS_BIG + BIG_PJ + (size_t)C_RV * 2 + (size_t)b * SEQ * vrow + (size_t)(h * 256 + 16 * sl) * 2;
    const unsigned voff2 = (unsigned)((size_t)(4 * g) * vrow) + (unsigned)fr * 2u;
    const float* decp = (const float*)(F.ws + AUX_DEC) + bh * NCH;
    float decr = 1.f; { const float gm = 1.0f - exp2f(-5.0f - (float)h); float d2 = gm * gm; d2 *= d2; d2 *= d2; d2 *= d2; d2 *= d2; d2 *= d2; decr = d2; }
    const unsigned char* ubp = F.ws + WS_H + (size_t)bh * NCH * 32768 + sl * 2048; const unsigned uoff = (unsigned)lane * 32u;
    const unsigned zoff = 0u; (void)decp; (void)decr; (void)ubp; (void)uoff; (void)zoff; (void)obu; (void)ooff; (void)vbu; (void)voff2; (void)vrow; (void)orow;
    if constexpr (GDN && ROLE == 0) {
    bf16x8 r0 = (bf16x8){0, 0, 0, 0, 0, 0, 0, 0};
    bf16x8 r1 = (bf16x8){0, 0, 0, 0, 0, 0, 0, 0};
    bf16x8 r2 = (bf16x8){0, 0, 0, 0, 0, 0, 0, 0};
    bf16x8 r3 = (bf16x8){0, 0, 0, 0, 0, 0, 0, 0};
    bf16x8 r4 = (bf16x8){0, 0, 0, 0, 0, 0, 0, 0};
    bf16x8 r5 = (bf16x8){0, 0, 0, 0, 0, 0, 0, 0};
    bf16x8 r6 = (bf16x8){0, 0, 0, 0, 0, 0, 0, 0};
    bf16x8 r7 = (bf16x8){0, 0, 0, 0, 0, 0, 0, 0};
    bf16x8 r8 = (bf16x8){0, 0, 0, 0, 0, 0, 0, 0};
    bf16x8 r9 = (bf16x8){0, 0, 0, 0, 0, 0, 0, 0};
    bf16x8 r10 = (bf16x8){0, 0, 0, 0, 0, 0, 0, 0};
    bf16x8 r11 = (bf16x8){0, 0, 0, 0, 0, 0, 0, 0};
    bf16x8 r12 = (bf16x8){0, 0, 0, 0, 0, 0, 0, 0};
    bf16x8 r13 = (bf16x8){0, 0, 0, 0, 0, 0, 0, 0};
    bf16x8 r14 = (bf16x8){0, 0, 0, 0, 0, 0, 0, 0};
    bf16x8 r15 = (bf16x8){0, 0, 0, 0, 0, 0, 0, 0};
    f32x4 S0_0 = {0.f, 0.f, 0.f, 0.f};
    f32x4 S0_1 = {0.f, 0.f, 0.f, 0.f};
    f32x4 S0_2 = {0.f, 0.f, 0.f, 0.f};
    f32x4 S0_3 = {0.f, 0.f, 0.f, 0.f};
    f32x4 S0_4 = {0.f, 0.f, 0.f, 0.f};
    f32x4 S0_5 = {0.f, 0.f, 0.f, 0.f};
    f32x4 S0_6 = {0.f, 0.f, 0.f, 0.f};
    f32x4 S0_7 = {0.f, 0.f, 0.f, 0.f};
    bf16x8 Sp0_0 = (bf16x8){0, 0, 0, 0, 0, 0, 0, 0};
    bf16x8 Sp0_1 = (bf16x8){0, 0, 0, 0, 0, 0, 0, 0};
    bf16x8 Sp0_2 = (bf16x8){0, 0, 0, 0, 0, 0, 0, 0};
    bf16x8 Sp0_3 = (bf16x8){0, 0, 0, 0, 0, 0, 0, 0};
    f32x4 S1_0 = {0.f, 0.f, 0.f, 0.f};
    f32x4 S1_1 = {0.f, 0.f, 0.f, 0.f};
    f32x4 S1_2 = {0.f, 0.f, 0.f, 0.f};
    f32x4 S1_3 = {0.f, 0.f, 0.f, 0.f};
    f32x4 S1_4 = {0.f, 0.f, 0.f, 0.f};
    f32x4 S1_5 = {0.f, 0.f, 0.f, 0.f};
    f32x4 S1_6 = {0.f, 0.f, 0.f, 0.f};
    f32x4 S1_7 = {0.f, 0.f, 0.f, 0.f};
    bf16x8 Sp1_0 = (bf16x8){0, 0, 0, 0, 0, 0, 0, 0};
    bf16x8 Sp1_1 = (bf16x8){0, 0, 0, 0, 0, 0, 0, 0};
    bf16x8 Sp1_2 = (bf16x8){0, 0, 0, 0, 0, 0, 0, 0};
    bf16x8 Sp1_3 = (bf16x8){0, 0, 0, 0, 0, 0, 0, 0};
    float decv = 0.f;
    u32x4 un0_0 = {0u, 0u, 0u, 0u}, un0_1 = {0u, 0u, 0u, 0u};
    u32x4 un1_0 = {0u, 0u, 0u, 0u}, un1_1 = {0u, 0u, 0u, 0u};
    { const int n = 0; (void)n;
    asm volatile("global_load_dwordx4 %0, %1, off" : "+v"(un0_0) : "v"((const unsigned char*)(ubp + 0 * 2048) + uoff) : "memory");
    asm volatile("global_load_dwordx4 %0, %1, off offset:16" : "+v"(un0_1) : "v"((const unsigned char*)(ubp + 0 * 2048) + uoff) : "memory");
    asm volatile("global_load_dwordx4 %0, %1, off" : "+v"(un1_0) : "v"((const unsigned char*)(ubp + 1 * 2048) + uoff) : "memory");
    asm volatile("global_load_dwordx4 %0, %1, off offset:16" : "+v"(un1_1) : "v"((const unsigned char*)(ubp + 1 * 2048) + uoff) : "memory");
    asm volatile("global_load_dword %0, %1, off" : "+v"(decv) : "v"((const unsigned char*)(decp) + zoff) : "memory");
    asm volatile("global_load_dwordx4 %0, %1, off" : "+v"(r0) : "v"((const unsigned char*)(sp0 + ((size_t)(n + 0) * 56 + 0) * 1024) + voff) : "memory");
    asm volatile("global_load_dwordx4 %0, %1, off" : "+v"(r1) : "v"((const unsigned char*)(sp0 + ((size_t)(n + 0) * 56 + 1) * 1024) + voff) : "memory");
    asm volatile("global_load_dwordx4 %0, %1, off" : "+v"(r2) : "v"((const unsigned char*)(sp0 + ((size_t)(n + 0) * 56 + 2) * 1024) + voff) : "memory");
    asm volatile("global_load_dwordx4 %0, %1, off" : "+v"(r3) : "v"((const unsigned char*)(sp0 + ((size_t)(n + 0) * 56 + 3) * 1024) + voff) : "memory");
    asm volatile("global_load_dwordx4 %0, %1, off" : "+v"(r4) : "v"((const unsigned char*)(sp0 + ((size_t)(n + 0) * 56 + 4) * 1024) + voff) : "memory");
    asm volatile("global_load_dwordx4 %0, %1, off" : "+v"(r5) : "v"((const unsigned char*)(sp0 + ((size_t)(n + 0) * 56 + 5) * 1024) + voff) : "memory");
    asm volatile("global_load_dwordx4 %0, %1, off" : "+v"(r6) : "v"((const unsigned char*)(sp0 + ((size_t)(n + 0) * 56 + 6) * 1024) + voff) : "memory");
    asm volatile("global_load_dwordx4 %0, %1, off" : "+v"(r7) : "v"((const unsigned char*)(sp0 + ((size_t)(n + 0) * 56 + 7) * 1024) + voff) : "memory");
    asm volatile("global_load_dwordx4 %0, %1, off" : "+v"(r8) : "v"((const unsigned char*)(sp0 + ((size_t)(n + 0) * 56 + 8) * 1024) + voff) : "memory");
    asm volatile("global_load_dwordx4 %0, %1, off" : "+v"(r9) : "v"((const unsigned char*)(sp0 + ((size_t)(n + 0) * 56 + 9) * 1024) + voff) : "memory");
    asm volatile("global_load_dwordx4 %0, %1, off" : "+v"(r10) : "v"((const unsigned char*)(sp0 + ((size_t)(n + 0) * 56 + 10) * 1024) + voff) : "memory");
    asm volatile("global_load_dwordx4 %0, %1, off" : "+v"(r11) : "v"((const unsigned char*)(sp0 + ((size_t)(n + 0) * 56 + 11) * 1024) + voff) : "memory");
    asm volatile("global_load_dwordx4 %0, %1, off" : "+v"(r12) : "v"((const unsigned char*)(sp0 + ((size_t)(n + 0) * 56 + 12) * 1024) + voff) : "memory");
    asm volatile("global_load_dwordx4 %0, %1, off" : "+v"(r13) : "v"((const unsigned char*)(sp0 + ((size_t)(n + 0) * 56 + 13) * 1024) + voff) : "memory");
    asm volatile("global_load_dwordx4 %0, %1, off" : "+v"(r14) : "v"((const unsigned char*)(sp0 + ((size_t)(n + 0) * 56 + 14) * 1024) + voff) : "memory");
    asm volatile("global_load_dwordx4 %0, %1, off" : "+v"(r15) : "v"((const unsigned char*)(sp0 + ((size_t)(n + 0) * 56 + 15) * 1024) + voff) : "memory");
    }
#pragma unroll 1
    for (int n = 0; n < NCH; ++n) {
        const int nn = n + 1 < NCH ? n + 1 : n;
        f32x4 a0_0, a0_1, a0_2, a0_3;
        f32x4 a1_0, a1_1, a1_2, a1_3;
        asm volatile("s_waitcnt vmcnt(16)" : "+v"(un0_0), "+v"(un0_1), "+v"(un1_0), "+v"(un1_1), "+v"(decv));
        a0_0 = (f32x4){bflo(un0_0.x), bfhi(un0_0.x), bflo(un0_0.y), bfhi(un0_0.y)}; a0_1 = (f32x4){bflo(un0_0.z), bfhi(un0_0.z), bflo(un0_0.w), bfhi(un0_0.w)};
        a0_2 = (f32x4){bflo(un0_1.x), bfhi(un0_1.x), bflo(un0_1.y), bfhi(un0_1.y)}; a0_3 = (f32x4){bflo(un0_1.z), bfhi(un0_1.z), bflo(un0_1.w), bfhi(un0_1.w)};
        a1_0 = (f32x4){bflo(un1_0.x), bfhi(un1_0.x), bflo(un1_0.y), bfhi(un1_0.y)}; a1_1 = (f32x4){bflo(un1_0.z), bfhi(un1_0.z), bflo(un1_0.w), bfhi(un1_0.w)};
        a1_2 = (f32x4){bflo(un1_1.x), bfhi(un1_1.x), bflo(un1_1.y), bfhi(un1_1.y)}; a1_3 = (f32x4){bflo(un1_1.z), bfhi(un1_1.z), bflo(un1_1.w), bfhi(un1_1.w)};
        const float dec = decv;
        { const unsigned char* ubn = ubp + (size_t)nn * 32768;
          asm volatile("global_load_dwordx4 %0, %1, off" : "+v"(un0_0) : "v"((const unsigned char*)(ubn + 0 * 2048) + uoff) : "memory");
          asm volatile("global_load_dwordx4 %0, %1, off offset:16" : "+v"(un0_1) : "v"((const unsigned char*)(ubn + 0 * 2048) + uoff) : "memory");
          asm volatile("global_load_dwordx4 %0, %1, off" : "+v"(un1_0) : "v"((const unsigned char*)(ubn + 1 * 2048) + uoff) : "memory");
          asm volatile("global_load_dwordx4 %0, %1, off offset:16" : "+v"(un1_1) : "v"((const unsigned char*)(ubn + 1 * 2048) + uoff) : "memory");
          asm volatile("global_load_dword %0, %1, off" : "+v"(decv) : "v"((const unsigned char*)(decp + nn) + zoff) : "memory"); }
        __builtin_amdgcn_sched_barrier(0);
        asm volatile("s_waitcnt vmcnt(20)" : "+v"(r0));
        a0_0 = mfma16(r0, Sp0_0, a0_0);
        a1_0 = mfma16(r0, Sp1_0, a1_0);
        asm volatile("global_load_dwordx4 %0, %1, off" : "+v"(r0) : "v"((const unsigned char*)(sp0 + ((size_t)(n + 0) * 56 + 40) * 1024) + voff) : "memory");
        __builtin_amdgcn_sched_barrier(0);
        asm volatile("s_waitcnt vmcnt(20)" : "+v"(r1));
        a0_0 = mfma16(r1, Sp0_1, a0_0);
        a1_0 = mfma16(r1, Sp1_1, a1_0);
        asm volatile("global_load_dwordx4 %0, %1, off" : "+v"(r1) : "v"((const unsigned char*)(sp0 + ((size_t)(n + 0) * 56 + 41) * 1024) + voff) : "memory");
        __builtin_amdgcn_sched_barrier(0);
        asm volatile("s_waitcnt vmcnt(20)" : "+v"(r2));
        a0_0 = mfma16(r2, Sp0_2, a0_0);
        a1_0 = mfma16(r2, Sp1_2, a1_0);
        asm volatile("global_load_dwordx4 %0, %1, off" : "+v"(r2) : "v"((const unsigned char*)(sp0 + ((size_t)(n + 0) * 56 + 42) * 1024) + voff) : "memory");
        __builtin_amdgcn_sched_barrier(0);
        asm volatile("s_waitcnt vmcnt(20)" : "+v"(r3));
        a0_0 = mfma16(r3, Sp0_3, a0_0);
        a1_0 = mfma16(r3, Sp1_3, a1_0);
        asm volatile("global_load_dwordx4 %0, %1, off" : "+v"(r3) : "v"((const unsigned char*)(sp0 + ((size_t)(n + 0) * 56 + 43) * 1024) + voff) : "memory");
        __builtin_amdgcn_sched_barrier(0);
        asm volatile("s_waitcnt vmcnt(20)" : "+v"(r4));
        a0_1 = mfma16(r4, Sp0_0, a0_1);
        a1_1 = mfma16(r4, Sp1_0, a1_1);
        asm volatile("global_load_dwordx4 %0, %1, off" : "+v"(r4) : "v"((const unsigned char*)(sp0 + ((size_t)(n + 0) * 56 + 44) * 1024) + voff) : "memory");
        __builtin_amdgcn_sched_barrier(0);
        asm volatile("s_waitcnt vmcnt(20)" : "+v"(r5));
        a0_1 = mfma16(r5, Sp0_1, a0_1);
        a1_1 = mfma16(r5, Sp1_1, a1_1);
        asm volatile("global_load_dwordx4 %0, %1, off" : "+v"(r5) : "v"((const unsigned char*)(sp0 + ((size_t)(n + 0) * 56 + 45) * 1024) + voff) : "memory");
        __builtin_amdgcn_sched_barrier(0);
        asm volatile("s_waitcnt vmcnt(20)" : "+v"(r6));
        a0_1 = mfma16(r6, Sp0_2, a0_1);
        a1_1 = mfma16(r6, Sp1_2, a1_1);
        asm volatile("global_load_dwordx4 %0, %1, off" : "+v"(r6) : "v"((const unsigned char*)(sp0 + ((size_t)(n + 0) * 56 + 46) * 1024) + voff) : "memory");
        __builtin_amdgcn_sched_barrier(0);
        asm volatile("s_waitcnt vmcnt(20)" : "+v"(r7));
        a0_1 = mfma16(r7, Sp0_3, a0_1);
        a1_1 = mfma16(r7, Sp1_3, a1_1);
        asm volatile("global_load_dwordx4 %0, %1, off" : "+v"(r7) : "v"((const unsigned char*)(sp0 + ((size_t)(n + 0) * 56 + 47) * 1024) + voff) : "memory");
        __builtin_amdgcn_sched_barrier(0);
        asm volatile("s_waitcnt vmcnt(20)" : "+v"(r8));
        a0_2 = mfma16(r8, Sp0_0, a0_2);
        a1_2 = mfma16(r8, Sp1_0, a1_2);
        asm volatile("global_load_dwordx4 %0, %1, off" : "+v"(r8) : "v"((const unsigned char*)(sp0 + ((size_t)(n + 0) * 56 + 48) * 1024) + voff) : "memory");
        __builtin_amdgcn_sched_barrier(0);
        asm volatile("s_waitcnt vmcnt(20)" : "+v"(r9));
        a0_2 = mfma16(r9, Sp0_1, a0_2);
        a1_2 = mfma16(r9, Sp1_1, a1_2);
        asm volatile("global_load_dwordx4 %0, %1, off" : "+v"(r9) : "v"((const unsigned char*)(sp0 + ((size_t)(n + 0) * 56 + 49) * 1024) + voff) : "memory");
        __builtin_amdgcn_sched_barrier(0);
        asm volatile("s_waitcnt vmcnt(20)" : "+v"(r10));
        a0_2 = mfma16(r10, Sp0_2, a0_2);
        a1_2 = mfma16(r10, Sp1_2, a1_2);
        asm volatile("global_load_dwordx4 %0, %1, off" : "+v"(r10) : "v"((const unsigned char*)(sp0 + ((size_t)(n + 0) * 56 + 50) * 1024) + voff) : "memory");
        __builtin_amdgcn_sched_barrier(0);
        asm volatile("s_waitcnt vmcnt(20)" : "+v"(r11));
        a0_2 = mfma16(r11, Sp0_3, a0_2);
        a1_2 = mfma16(r11, Sp1_3, a1_2);
        asm volatile("global_load_dwordx4 %0, %1, off" : "+v"(r11) : "v"((const unsigned char*)(sp0 + ((size_t)(n + 0) * 56 + 51) * 1024) + voff) : "memory");
        __builtin_amdgcn_sched_barrier(0);
        asm volatile("s_waitcnt vmcnt(20)" : "+v"(r12));
        a0_3 = mfma16(r12, Sp0_0, a0_3);
        a1_3 = mfma16(r12, Sp1_0, a1_3);
        asm volatile("global_load_dwordx4 %0, %1, off" : "+v"(r12) : "v"((const unsigned char*)(sp0 + ((size_t)(n + 0) * 56 + 52) * 1024) + voff) : "memory");
        __builtin_amdgcn_sched_barrier(0);
        asm volatile("s_waitcnt vmcnt(20)" : "+v"(r13));
        a0_3 = mfma16(r13, Sp0_1, a0_3);
        a1_3 = mfma16(r13, Sp1_1, a1_3);
        asm volatile("global_load_dwordx4 %0, %1, off" : "+v"(r13) : "v"((const unsigned char*)(sp0 + ((size_t)(n + 0) * 56 + 53) * 1024) + voff) : "memory");
        __builtin_amdgcn_sched_barrier(0);
        asm volatile("s_waitcnt vmcnt(20)" : "+v"(r14));
        a0_3 = mfma16(r14, Sp0_2, a0_3);
        a1_3 = mfma16(r14, Sp1_2, a1_3);
        asm volatile("global_load_dwordx4 %0, %1, off" : "+v"(r14) : "v"((const unsigned char*)(sp0 + ((size_t)(n + 0) * 56 + 54) * 1024) + voff) : "memory");
        __builtin_amdgcn_sched_barrier(0);
        asm volatile("s_waitcnt vmcnt(20)" : "+v"(r15));
        a0_3 = mfma16(r15, Sp0_3, a0_3);
        a1_3 = mfma16(r15, Sp1_3, a1_3);
        asm volatile("global_load_dwordx4 %0, %1, off" : "+v"(r15) : "v"((const unsigned char*)(sp0 + ((size_t)(n + 0) * 56 + 55) * 1024) + voff) : "memory");
        __builtin_amdgcn_sched_barrier(0);
        bf16x8 vp0_0, vp0_1;
        { u32x4 w; w.x = cvt_pk_bf16(a0_0[0], a0_0[1]); w.y = cvt_pk_bf16(a0_0[2], a0_0[3]); w.z = cvt_pk_bf16(a0_1[0], a0_1[1]); w.w = cvt_pk_bf16(a0_1[2], a0_1[3]); vp0_0 = __builtin_bit_cast(bf16x8, w); }
        { u32x4 w; w.x = cvt_pk_bf16(a0_2[0], a0_2[1]); w.y = cvt_pk_bf16(a0_2[2], a0_2[3]); w.z = cvt_pk_bf16(a0_3[0], a0_3[1]); w.w = cvt_pk_bf16(a0_3[2], a0_3[3]); vp0_1 = __builtin_bit_cast(bf16x8, w); }
        bf16x8 vp1_0, vp1_1;
        { u32x4 w; w.x = cvt_pk_bf16(a1_0[0], a1_0[1]); w.y = cvt_pk_bf16(a1_0[2], a1_0[3]); w.z = cvt_pk_bf16(a1_1[0], a1_1[1]); w.w = cvt_pk_bf16(a1_1[2], a1_1[3]); vp1_0 = __builtin_bit_cast(bf16x8, w); }
        { u32x4 w; w.x = cvt_pk_bf16(a1_2[0], a1_2[1]); w.y = cvt_pk_bf16(a1_2[2], a1_2[3]); w.z = cvt_pk_bf16(a1_3[0], a1_3[1]); w.w = cvt_pk_bf16(a1_3[2], a1_3[3]); vp1_1 = __builtin_bit_cast(bf16x8, w); }
        { unsigned sp_ = 0; while (*(volatile LAS unsigned*)(xl + XL_CNT + 64) + 2u <= (unsigned)n) { __builtin_amdgcn_s_sleep(1); if (++sp_ > (1u << 22)) break; } }
        { LAS bf16x8* sl_ = (LAS bf16x8*)(xl + (n & 1) * XL_SLOT) + lane; sl_[0] = Sp0_0; sl_[64] = Sp0_1; sl_[128] = Sp0_2; sl_[192] = Sp0_3; sl_[256] = vp0_0; sl_[320] = vp0_1; sl_[384] = Sp1_0; sl_[448] = Sp1_1; sl_[512] = Sp1_2; sl_[576] = Sp1_3; sl_[640] = vp1_0; sl_[704] = vp1_1; }
        asm volatile("s_waitcnt lgkmcnt(0)" ::: "memory");
        if (lane == 0) *(volatile LAS unsigned*)(xl + XL_CNT) = (unsigned)(n + 1);
        S0_0 = S0_0 * dec;
        S1_0 = S1_0 * dec;
        asm volatile("s_waitcnt vmcnt(15)" : "+v"(r0));
        S0_0 = mfma16(r0, vp0_0, S0_0);
        S1_0 = mfma16(r0, vp1_0, S1_0);
        asm volatile("global_load_dwordx4 %0, %1, off" : "+v"(r0) : "v"((const unsigned char*)(sp0 + ((size_t)(n + 1) * 56 + 0) * 1024) + voff) : "memory");
        __builtin_amdgcn_sched_barrier(0);
        asm volatile("s_waitcnt vmcnt(15)" : "+v"(r1));
        S0_0 = mfma16(r1, vp0_1, S0_0);
        S1_0 = mfma16(r1, vp1_1, S1_0);
        asm volatile("global_load_dwordx4 %0, %1, off" : "+v"(r1) : "v"((const unsigned char*)(sp0 + ((size_t)(n + 1) * 56 + 1) * 1024) + voff) : "memory");
        __builtin_amdgcn_sched_barrier(0);
        S0_1 = S0_1 * dec;
        S1_1 = S1_1 * dec;
        asm volatile("s_waitcnt vmcnt(15)" : "+v"(r2));
        S0_1 = mfma16(r2, vp0_0, S0_1);
        S1_1 = mfma16(r2, vp1_0, S1_1);
        asm volatile("global_load_dwordx4 %0, %1, off" : "+v"(r2) : "v"((const unsigned char*)(sp0 + ((size_t)(n + 1) * 56 + 2) * 1024) + voff) : "memory");
        __builtin_amdgcn_sched_barrier(0);
        asm volatile("s_waitcnt vmcnt(15)" : "+v"(r3));
        S0_1 = mfma16(r3, vp0_1, S0_1);
        S1_1 = mfma16(r3, vp1_1, S1_1);
        asm volatile("global_load_dwordx4 %0, %1, off" : "+v"(r3) : "v"((const unsigned char*)(sp0 + ((size_t)(n + 1) * 56 + 3) * 1024) + voff) : "memory");
        __builtin_amdgcn_sched_barrier(0);
        S0_2 = S0_2 * dec;
        S1_2 = S1_2 * dec;
        asm volatile("s_waitcnt vmcnt(15)" : "+v"(r4));
        S0_2 = mfma16(r4, vp0_0, S0_2);
        S1_2 = mfma16(r4, vp1_0, S1_2);
        asm volatile("global_load_dwordx4 %0, %1, off" : "+v"(r4) : "v"((const unsigned char*)(sp0 + ((size_t)(n + 1) * 56 + 4) * 1024) + voff) : "memory");
        __builtin_amdgcn_sched_barrier(0);
        asm volatile("s_waitcnt vmcnt(15)" : "+v"(r5));
        S0_2 = mfma16(r5, vp0_1, S0_2);
        S1_2 = mfma16(r5, vp1_1, S1_2);
        asm volatile("global_load_dwordx4 %0, %1, off" : "+v"(r5) : "v"((const unsigned char*)(sp0 + ((size_t)(n + 1) * 56 + 5) * 1024) + voff) : "memory");
        __builtin_amdgcn_sched_barrier(0);
        S0_3 = S0_3 * dec;
        S1_3 = S1_3 * dec;
        asm volatile("s_waitcnt vmcnt(15)" : "+v"(r6));
        S0_3 = mfma16(r6, vp0_0, S0_3);
        S1_3 = mfma16(r6, vp1_0, S1_3);
        asm volatile("global_load_dwordx4 %0, %1, off" : "+v"(r6) : "v"((const unsigned char*)(sp0 + ((size_t)(n + 1) * 56 + 6) * 1024) + voff) : "memory");
        __builtin_amdgcn_sched_barrier(0);
        asm volatile("s_waitcnt vmcnt(15)" : "+v"(r7));
        S0_3 = mfma16(r7, vp0_1, S0_3);
        S1_3 = mfma16(r7, vp1_1, S1_3);
        asm volatile("global_load_dwordx4 %0, %1, off" : "+v"(r7) : "v"((const unsigned char*)(sp0 + ((size_t)(n + 1) * 56 + 7) * 1024) + voff) : "memory");
        __builtin_amdgcn_sched_barrier(0);
        S0_4 = S0_4 * dec;
        S1_4 = S1_4 * dec;
        asm volatile("s_waitcnt vmcnt(15)" : "+v"(r8));
        S0_4 = mfma16(r8, vp0_0, S0_4);
        S1_4 = mfma16(r8, vp1_0, S1_4);
        asm volatile("global_load_dwordx4 %0, %1, off" : "+v"(r8) : "v"((const unsigned char*)(sp0 + ((size_t)(n + 1) * 56 + 8) * 1024) + voff) : "memory");
        __builtin_amdgcn_sched_barrier(0);
        asm volatile("s_waitcnt vmcnt(15)" : "+v"(r9));
        S0_4 = mfma16(r9, vp0_1, S0_4);
        S1_4 = mfma16(r9, vp1_1, S1_4);
        asm volatile("global_load_dwordx4 %0, %1, off" : "+v"(r9) : "v"((const unsigned char*)(sp0 + ((size_t)(n + 1) * 56 + 9) * 1024) + voff) : "memory");
        __builtin_amdgcn_sched_barrier(0);
        S0_5 = S0_5 * dec;
        S1_5 = S1_5 * dec;
        asm volatile("s_waitcnt vmcnt(15)" : "+v"(r10));
        S0_5 = mfma16(r10, vp0_0, S0_5);
        S1_5 = mfma16(r10, vp1_0, S1_5);
        asm volatile("global_load_dwordx4 %0, %1, off" : "+v"(r10) : "v"((const unsigned char*)(sp0 + ((size_t)(n + 1) * 56 + 10) * 1024) + voff) : "memory");
        __builtin_amdgcn_sched_barrier(0);
        asm volatile("s_waitcnt vmcnt(15)" : "+v"(r11));
        S0_5 = mfma16(r11, vp0_1, S0_5);
        S1_5 = mfma16(r11, vp1_1, S1_5);
        asm volatile("global_load_dwordx4 %0, %1, off" : "+v"(r11) : "v"((const unsigned char*)(sp0 + ((size_t)(n + 1) * 56 + 11) * 1024) + voff) : "memory");
        __builtin_amdgcn_sched_barrier(0);
        S0_6 = S0_6 * dec;
        S1_6 = S1_6 * dec;
        asm volatile("s_waitcnt vmcnt(15)" : "+v"(r12));
        S0_6 = mfma16(r12, vp0_0, S0_6);
        S1_6 = mfma16(r12, vp1_0, S1_6);
        asm volatile("global_load_dwordx4 %0, %1, off" : "+v"(r12) : "v"((const unsigned char*)(sp0 + ((size_t)(n + 1) * 56 + 12) * 1024) + voff) : "memory");
        __builtin_amdgcn_sched_barrier(0);
        asm volatile("s_waitcnt vmcnt(15)" : "+v"(r13));
        S0_6 = mfma16(r13, vp0_1, S0_6);
        S1_6 = mfma16(r13, vp1_1, S1_6);
        asm volatile("global_load_dwordx4 %0, %1, off" : "+v"(r13) : "v"((const unsigned char*)(sp0 + ((size_t)(n + 1) * 56 + 13) * 1024) + voff) : "memory");
        __builtin_amdgcn_sched_barrier(0);
        S0_7 = S0_7 * dec;
        S1_7 = S1_7 * dec;
        asm volatile("s_waitcnt vmcnt(15)" : "+v"(r14));
        S0_7 = mfma16(r14, vp0_0, S0_7);
        S1_7 = mfma16(r14, vp1_0, S1_7);
        asm volatile("global_load_dwordx4 %0, %1, off" : "+v"(r14) : "v"((const unsigned char*)(sp0 + ((size_t)(n + 1) * 56 + 14) * 1024) + voff) : "memory");
        __builtin_amdgcn_sched_barrier(0);
        asm volatile("s_waitcnt vmcnt(15)" : "+v"(r15));
        S0_7 = mfma16(r15, vp0_1, S0_7);
        S1_7 = mfma16(r15, vp1_1, S1_7);
        asm volatile("global_load_dwordx4 %0, %1, off" : "+v"(r15) : "v"((const unsigned char*)(sp0 + ((size_t)(n + 1) * 56 + 15) * 1024) + voff) : "memory");
        __builtin_amdgcn_sched_barrier(0);
        { u32x4 w; w.x = cvt_pk_bf16(S0_0[0], S0_0[1]); w.y = cvt_pk_bf16(S0_0[2], S0_0[3]); w.z = cvt_pk_bf16(S0_1[0], S0_1[1]); w.w = cvt_pk_bf16(S0_1[2], S0_1[3]); Sp0_0 = __builtin_bit_cast(bf16x8, w); }
        { u32x4 w; w.x = cvt_pk_bf16(S0_2[0], S0_2[1]); w.y = cvt_pk_bf16(S0_2[2], S0_2[3]); w.z = cvt_pk_bf16(S0_3[0], S0_3[1]); w.w = cvt_pk_bf16(S0_3[2], S0_3[3]); Sp0_1 = __builtin_bit_cast(bf16x8, w); }
        { u32x4 w; w.x = cvt_pk_bf16(S0_4[0], S0_4[1]); w.y = cvt_pk_bf16(S0_4[2], S0_4[3]); w.z = cvt_pk_bf16(S0_5[0], S0_5[1]); w.w = cvt_pk_bf16(S0_5[2], S0_5[3]); Sp0_2 = __builtin_bit_cast(bf16x8, w); }
        { u32x4 w; w.x = cvt_pk_bf16(S0_6[0], S0_6[1]); w.y = cvt_pk_bf16(S0_6[2], S0_6[3]); w.z = cvt_pk_bf16(S0_7[0], S0_7[1]); w.w = cvt_pk_bf16(S0_7[2], S0_7[3]); Sp0_3 = __builtin_bit_cast(bf16x8, w); }
        { u32x4 w; w.x = cvt_pk_bf16(S1_0[0], S1_0[1]); w.y = cvt_pk_bf16(S1_0[2], S1_0[3]); w.z = cvt_pk_bf16(S1_1[0], S1_1[1]); w.w = cvt_pk_bf16(S1_1[2], S1_1[3]); Sp1_0 = __builtin_bit_cast(bf16x8, w); }
        { u32x4 w; w.x = cvt_pk_bf16(S1_2[0], S1_2[1]); w.y = cvt_pk_bf16(S1_2[2], S1_2[3]); w.z = cvt_pk_bf16(S1_3[0], S1_3[1]); w.w = cvt_pk_bf16(S1_3[2], S1_3[3]); Sp1_1 = __builtin_bit_cast(bf16x8, w); }
        { u32x4 w; w.x = cvt_pk_bf16(S1_4[0], S1_4[1]); w.y = cvt_pk_bf16(S1_4[2], S1_4[3]); w.z = cvt_pk_bf16(S1_5[0], S1_5[1]); w.w = cvt_pk_bf16(S1_5[2], S1_5[3]); Sp1_2 = __builtin_bit_cast(bf16x8, w); }
        { u32x4 w; w.x = cvt_pk_bf16(S1_6[0], S1_6[1]); w.y = cvt_pk_bf16(S1_6[2], S1_6[3]); w.z = cvt_pk_bf16(S1_7[0], S1_7[1]); w.w = cvt_pk_bf16(S1_7[2], S1_7[3]); Sp1_3 = __builtin_bit_cast(bf16x8, w); }
    }
    asm volatile("s_waitcnt vmcnt(0)" ::: "memory");
    } else if constexpr (GDN && ROLE == 1) {
    bf16x8 r0 = (bf16x8){0, 0, 0, 0, 0, 0, 0, 0};
    bf16x8 r1 = (bf16x8){0, 0, 0, 0, 0, 0, 0, 0};
    bf16x8 r2 = (bf16x8){0, 0, 0, 0, 0, 0, 0, 0};
    bf16x8 r3 = (bf16x8){0, 0, 0, 0, 0, 0, 0, 0};
    bf16x8 r4 = (bf16x8){0, 0, 0, 0, 0, 0, 0, 0};
    bf16x8 r5 = (bf16x8){0, 0, 0, 0, 0, 0, 0, 0};
    bf16x8 r6 = (bf16x8){0, 0, 0, 0, 0, 0, 0, 0};
    bf16x8 r7 = (bf16x8){0, 0, 0, 0, 0, 0, 0, 0};
    bf16x8 r8 = (bf16x8){0, 0, 0, 0, 0, 0, 0, 0};
    bf16x8 r9 = (bf16x8){0, 0, 0, 0, 0, 0, 0, 0};
    bf16x8 r10 = (bf16x8){0, 0, 0, 0, 0, 0, 0, 0};
    bf16x8 r11 = (bf16x8){0, 0, 0, 0, 0, 0, 0, 0};
    bf16x8 r12 = (bf16x8){0, 0, 0, 0, 0, 0, 0, 0};
    bf16x8 r13 = (bf16x8){0, 0, 0, 0, 0, 0, 0, 0};
    bf16x8 r14 = (bf16x8){0, 0, 0, 0, 0, 0, 0, 0};
    bf16x8 r15 = (bf16x8){0, 0, 0, 0, 0, 0, 0, 0};
    bf16x8 r16 = (bf16x8){0, 0, 0, 0, 0, 0, 0, 0};
    bf16x8 r17 = (bf16x8){0, 0, 0, 0, 0, 0, 0, 0};
    bf16x8 r18 = (bf16x8){0, 0, 0, 0, 0, 0, 0, 0};
    bf16x8 r19 = (bf16x8){0, 0, 0, 0, 0, 0, 0, 0};
    bf16x8 r20 = (bf16x8){0, 0, 0, 0, 0, 0, 0, 0};
    bf16x8 r21 = (bf16x8){0, 0, 0, 0, 0, 0, 0, 0};
    bf16x8 r22 = (bf16x8){0, 0, 0, 0, 0, 0, 0, 0};
    bf16x8 r23 = (bf16x8){0, 0, 0, 0, 0, 0, 0, 0};
    asm volatile("global_load_dwordx4 %0, %1, off" : "+v"(r0) : "v"((const unsigned char*)(sp0 + ((size_t)(0 + 0) * 56 + 16) * 1024) + voff) : "memory");
    asm volatile("global_load_dwordx4 %0, %1, off" : "+v"(r1) : "v"((const unsigned char*)(sp0 + ((size_t)(0 + 0) * 56 + 17) * 1024) + voff) : "memory");
    asm volatile("global_load_dwordx4 %0, %1, off" : "+v"(r2) : "v"((const unsigned char*)(sp0 + ((size_t)(0 + 0) * 56 + 18) * 1024) + voff) : "memory");
    asm volatile("global_load_dwordx4 %0, %1, off" : "+v"(r3) : "v"((const unsigned char*)(sp0 + ((size_t)(0 + 0) * 56 + 19) * 1024) + voff) : "memory");
    asm volatile("global_load_dwordx4 %0, %1, off" : "+v"(r4) : "v"((const unsigned char*)(sp0 + ((size_t)(0 + 0) * 56 + 20) * 1024) + voff) : "memory");
    asm volatile("global_load_dwordx4 %0, %1, off" : "+v"(r5) : "v"((const unsigned char*)(sp0 + ((size_t)(0 + 0) * 56 + 21) * 1024) + voff) : "memory");
    asm volatile("global_load_dwordx4 %0, %1, off" : "+v"(r6) : "v"((const unsigned char*)(sp0 + ((size_t)(0 + 0) * 56 + 22) * 1024) + voff) : "memory");
    asm volatile("global_load_dwordx4 %0, %1, off" : "+v"(r7) : "v"((const unsigned char*)(sp0 + ((size_t)(0 + 0) * 56 + 23) * 1024) + voff) : "memory");
    asm volatile("global_load_dwordx4 %0, %1, off" : "+v"(r8) : "v"((const unsigned char*)(sp0 + ((size_t)(0 + 0) * 56 + 24) * 1024) + voff) : "memory");
    asm volatile("global_load_dwordx4 %0, %1, off" : "+v"(r9) : "v"((const unsigned char*)(sp0 + ((size_t)(0 + 0) * 56 + 25) * 1024) + voff) : "memory");
    asm volatile("global_load_dwordx4 %0, %1, off" : "+v"(r10) : "v"((const unsigned char*)(sp0 + ((size_t)(0 + 0) * 56 + 26) * 1024) + voff) : "memory");
    asm volatile("global_load_dwordx4 %0, %1, off" : "+v"(r11) : "v"((const unsigned char*)(sp0 + ((size_t)(0 + 0) * 56 + 27) * 1024) + voff) : "memory");
    asm volatile("global_load_dwordx4 %0, %1, off" : "+v"(r12) : "v"((const unsigned char*)(sp0 + ((size_t)(0 + 0) * 56 + 28) * 1024) + voff) : "memory");
    asm volatile("global_load_dwordx4 %0, %1, off" : "+v"(r13) : "v"((const unsigned char*)(sp0 + ((size_t)(0 + 0) * 56 + 29) * 1024) + voff) : "memory");
    asm volatile("global_load_dwordx4 %0, %1, off" : "+v"(r14) : "v"((const unsigned char*)(sp0 + ((size_t)(0 + 0) * 56 + 30) * 1024) + voff) : "memory");
    asm volatile("global_load_dwordx4 %0, %1, off" : "+v"(r15) : "v"((const unsigned char*)(sp0 + ((size_t)(0 + 0) * 56 + 31) * 1024) + voff) : "memory");
    asm volatile("global_load_dwordx4 %0, %1, off" : "+v"(r16) : "v"((const unsigned char*)(sp0 + ((size_t)(0 + 0) * 56 + 32) * 1024) + voff) : "memory");
    asm volatile("global_load_dwordx4 %0, %1, off" : "+v"(r17) : "v"((const unsigned char*)(sp0 + ((size_t)(0 + 0) * 56 + 33) * 1024) + voff) : "memory");
    asm volatile("global_load_dwordx4 %0, %1, off" : "+v"(r18) : "v"((const unsigned char*)(sp0 + ((size_t)(0 + 0) * 56 + 34) * 1024) + voff) : "memory");
    asm volatile("global_load_dwordx4 %0, %1, off" : "+v"(r19) : "v"((const unsigned char*)(sp0 + ((size_t)(0 + 0) * 56 + 35) * 1024) + voff) : "memory");
    asm volatile("global_load_dwordx4 %0, %1, off" : "+v"(r20) : "v"((const unsigned char*)(sp0 + ((size_t)(0 + 0) * 56 + 36) * 1024) + voff) : "memory");
    asm volatile("global_load_dwordx4 %0, %1, off" : "+v"(r21) : "v"((const unsigned char*)(sp0 + ((size_t)(0 + 0) * 56 + 37) * 1024) + voff) : "memory");
    asm volatile("global_load_dwordx4 %0, %1, off" : "+v"(r22) : "v"((const unsigned char*)(sp0 + ((size_t)(0 + 0) * 56 + 38) * 1024) + voff) : "memory");
    asm volatile("global_load_dwordx4 %0, %1, off" : "+v"(r23) : "v"((const unsigned char*)(sp0 + ((size_t)(0 + 0) * 56 + 39) * 1024) + voff) : "memory");
    { unsigned z = 0u;
      asm volatile("global_store_short %0, %1, off" :: "v"((const unsigned char*)(obu + (size_t)(0) * orow + 0) + ooff), "v"(z) : "memory");
      asm volatile("global_store_short %0, %1, off" :: "v"((const unsigned char*)(obu + (size_t)(1) * orow + 0) + ooff), "v"(z) : "memory");
      asm volatile("global_store_short %0, %1, off" :: "v"((const unsigned char*)(obu + (size_t)(2) * orow + 0) + ooff), "v"(z) : "memory");
      asm volatile("global_store_short %0, %1, off" :: "v"((const unsigned char*)(obu + (size_t)(3) * orow + 0) + ooff), "v"(z) : "memory");
      asm volatile("global_store_short %0, %1, off" :: "v"((const unsigned char*)(obu + (size_t)(16) * orow + 0) + ooff), "v"(z) : "memory");
      asm volatile("global_store_short %0, %1, off" :: "v"((const unsigned char*)(obu + (size_t)(17) * orow + 0) + ooff), "v"(z) : "memory");
      asm volatile("global_store_short %0, %1, off" :: "v"((const unsigned char*)(obu + (size_t)(18) * orow + 0) + ooff), "v"(z) : "memory");
      asm volatile("global_store_short %0, %1, off" :: "v"((const unsigned char*)(obu + (size_t)(19) * orow + 0) + ooff), "v"(z) : "memory");
      asm volatile("global_store_short %0, %1, off" :: "v"((const unsigned char*)(obu + (size_t)(32) * orow + 0) + ooff), "v"(z) : "memory");
      asm volatile("global_store_short %0, %1, off" :: "v"((const unsigned char*)(obu + (size_t)(33) * orow + 0) + ooff), "v"(z) : "memory");
      asm volatile("global_store_short %0, %1, off" :: "v"((const unsigned char*)(obu + (size_t)(34) * orow + 0) + ooff), "v"(z) : "memory");
      asm volatile("global_store_short %0, %1, off" :: "v"((const unsigned char*)(obu + (size_t)(35) * orow + 0) + ooff), "v"(z) : "memory");
      asm volatile("global_store_short %0, %1, off" :: "v"((const unsigned char*)(obu + (size_t)(48) * orow + 0) + ooff), "v"(z) : "memory");
      asm volatile("global_store_short %0, %1, off" :: "v"((const unsigned char*)(obu + (size_t)(49) * orow + 0) + ooff), "v"(z) : "memory");
      asm volatile("global_store_short %0, %1, off" :: "v"((const unsigned char*)(obu + (size_t)(50) * orow + 0) + ooff), "v"(z) : "memory");
      asm volatile("global_store_short %0, %1, off" :: "v"((const unsigned char*)(obu + (size_t)(51) * orow + 0) + ooff), "v"(z) : "memory");
      asm volatile("global_store_short %0, %1, off" :: "v"((const unsigned char*)(obu + (size_t)(0) * orow + 32) + ooff), "v"(z) : "memory");
      asm volatile("global_store_short %0, %1, off" :: "v"((const unsigned char*)(obu + (size_t)(1) * orow + 32) + ooff), "v"(z) : "memory");
      asm volatile("global_store_short %0, %1, off" :: "v"((const unsigned char*)(obu + (size_t)(2) * orow + 32) + ooff), "v"(z) : "memory");
      asm volatile("global_store_short %0, %1, off" :: "v"((const unsigned char*)(obu + (size_t)(3) * orow + 32) + ooff), "v"(z) : "memory");
      asm volatile("global_store_short %0, %1, off" :: "v"((const unsigned char*)(obu + (size_t)(16) * orow + 32) + ooff), "v"(z) : "memory");
      asm volatile("global_store_short %0, %1, off" :: "v"((const unsigned char*)(obu + (size_t)(17) * orow + 32) + ooff), "v"(z) : "memory");
      asm volatile("global_store_short %0, %1, off" :: "v"((const unsigned char*)(obu + (size_t)(18) * orow + 32) + ooff), "v"(z) : "memory");
      asm volatile("global_store_short %0, %1, off" :: "v"((const unsigned char*)(obu + (size_t)(19) * orow + 32) + ooff), "v"(z) : "memory");
      asm volatile("global_store_short %0, %1, off" :: "v"((const unsigned char*)(obu + (size_t)(32) * orow + 32) + ooff), "v"(z) : "memory");
      asm volatile("global_store_short %0, %1, off" :: "v"((const unsigned char*)(obu + (size_t)(33) * orow + 32) + ooff), "v"(z) : "memory");
      asm volatile("global_store_short %0, %1, off" :: "v"((const unsigned char*)(obu + (size_t)(34) * orow + 32) + ooff), "v"(z) : "memory");
      asm volatile("global_store_short %0, %1, off" :: "v"((const unsigned char*)(obu + (size_t)(35) * orow + 32) + ooff), "v"(z) : "memory");
      asm volatile("global_store_short %0, %1, off" :: "v"((const unsigned char*)(obu + (size_t)(48) * orow + 32) + ooff), "v"(z) : "memory");
      asm volatile("global_store_short %0, %1, off" :: "v"((const unsigned char*)(obu + (size_t)(49) * orow + 32) + ooff), "v"(z) : "memory");
      asm volatile("global_store_short %0, %1, off" :: "v"((const unsigned char*)(obu + (size_t)(50) * orow + 32) + ooff), "v"(z) : "memory");
      asm volatile("global_store_short %0, %1, off" :: "v"((const unsigned char*)(obu + (size_t)(51) * orow + 32) + ooff), "v"(z) : "memory");
    }
#pragma unroll 1
    for (int n = 0; n < NCH; ++n) {
        { unsigned sp_ = 0; while (*(volatile LAS unsigned*)(xl + XL_CNT) <= (unsigned)n) { __builtin_amdgcn_s_sleep(1); if (++sp_ > (1u << 22)) break; } }
        bf16x8 Sp0_0, Sp0_1, Sp0_2, Sp0_3, vp0_0, vp0_1;
        bf16x8 Sp1_0, Sp1_1, Sp1_2, Sp1_3, vp1_0, vp1_1;
        { const LAS bf16x8* sl_ = (const LAS bf16x8*)(xl + (n & 1) * XL_SLOT) + lane; Sp0_0 = sl_[0]; Sp0_1 = sl_[64]; Sp0_2 = sl_[128]; Sp0_3 = sl_[192]; vp0_0 = sl_[256]; vp0_1 = sl_[320]; Sp1_0 = sl_[384]; Sp1_1 = sl_[448]; Sp1_2 = sl_[512]; Sp1_3 = sl_[576]; vp1_0 = sl_[640]; vp1_1 = sl_[704]; }
        asm volatile("s_waitcnt lgkmcnt(0)" ::: "memory");
        if (lane == 0) *(volatile LAS unsigned*)(xl + XL_CNT + 64) = (unsigned)(n + 1);
        f32x4 o0_0 = {0.f, 0.f, 0.f, 0.f}, o0_1 = o0_0, o0_2 = o0_0, o0_3 = o0_0;
        f32x4 o1_0 = {0.f, 0.f, 0.f, 0.f}, o1_1 = o1_0, o1_2 = o1_0, o1_3 = o1_0;
        asm volatile("s_waitcnt vmcnt(55)" : "+v"(r0));
        o0_0 = mfma16(r0, Sp0_0, o0_0);
        o1_0 = mfma16(r0, Sp1_0, o1_0);
        asm volatile("global_load_dwordx4 %0, %1, off" : "+v"(r0) : "v"((const unsigned char*)(sp0 + ((size_t)(n + 1) * 56 + 16) * 1024) + voff) : "memory");
        __builtin_amdgcn_sched_barrier(0);
        asm volatile("s_waitcnt vmcnt(55)" : "+v"(r1));
        o0_0 = mfma16(r1, Sp0_1, o0_0);
        o1_0 = mfma16(r1, Sp1_1, o1_0);
        asm volatile("global_load_dwordx4 %0, %1, off" : "+v"(r1) : "v"((const unsigned char*)(sp0 + ((size_t)(n + 1) * 56 + 17) * 1024) + voff) : "memory");
        __builtin_amdgcn_sched_barrier(0);
        asm volatile("s_waitcnt vmcnt(55)" : "+v"(r2));
        o0_0 = mfma16(r2, Sp0_2, o0_0);
        o1_0 = mfma16(r2, Sp1_2, o1_0);
        asm volatile("global_load_dwordx4 %0, %1, off" : "+v"(r2) : "v"((const unsigned char*)(sp0 + ((size_t)(n + 1) * 56 + 18) * 1024) + voff) : "memory");
        __builtin_amdgcn_sched_barrier(0);
        asm volatile("s_waitcnt vmcnt(55)" : "+v"(r3));
        o0_0 = mfma16(r3, Sp0_3, o0_0);
        o1_0 = mfma16(r3, Sp1_3, o1_0);
        asm volatile("global_load_dwordx4 %0, %1, off" : "+v"(r3) : "v"((const unsigned char*)(sp0 + ((size_t)(n + 1) * 56 + 19) * 1024) + voff) : "memory");
        __builtin_amdgcn_sched_barrier(0);
        asm volatile("s_waitcnt vmcnt(55)" : "+v"(r4));
        o0_1 = mfma16(r4, Sp0_0, o0_1);
        o1_1 = mfma16(r4, Sp1_0, o1_1);
        asm volatile("global_load_dwordx4 %0, %1, off" : "+v"(r4) : "v"((const unsigned char*)(sp0 + ((size_t)(n + 1) * 56 + 20) * 1024) + voff) : "memory");
        __builtin_amdgcn_sched_barrier(0);
        asm volatile("s_waitcnt vmcnt(55)" : "+v"(r5));
        o0_1 = mfma16(r5, Sp0_1, o0_1);
        o1_1 = mfma16(r5, Sp1_1, o1_1);
        asm volatile("global_load_dwordx4 %0, %1, off" : "+v"(r5) : "v"((const unsigned char*)(sp0 + ((size_t)(n + 1) * 56 + 21) * 1024) + voff) : "memory");
        __builtin_amdgcn_sched_barrier(0);
        asm volatile("s_waitcnt vmcnt(55)" : "+v"(r6));
        o0_1 = mfma16(r6, Sp0_2, o0_1);
        o1_1 = mfma16(r6, Sp1_2, o1_1);
        asm volatile("global_load_dwordx4 %0, %1, off" : "+v"(r6) : "v"((const unsigned char*)(sp0 + ((size_t)(n + 1) * 56 + 22) * 1024) + voff) : "memory");
        __builtin_amdgcn_sched_barrier(0);
        asm volatile("s_waitcnt vmcnt(55)" : "+v"(r7));
        o0_1 = mfma16(r7, Sp0_3, o0_1);
        o1_1 = mfma16(r7, Sp1_3, o1_1);
        asm volatile("global_load_dwordx4 %0, %1, off" : "+v"(r7) : "v"((const unsigned char*)(sp0 + ((size_t)(n + 1) * 56 + 23) * 1024) + voff) : "memory");
        __builtin_amdgcn_sched_barrier(0);
        asm volatile("s_waitcnt vmcnt(55)" : "+v"(r8));
        o0_2 = mfma16(r8, Sp0_0, o0_2);
        o1_2 = mfma16(r8, Sp1_0, o1_2);
        asm volatile("global_load_dwordx4 %0, %1, off" : "+v"(r8) : "v"((const unsigned char*)(sp0 + ((size_t)(n + 1) * 56 + 24) * 1024) + voff) : "memory");
        __builtin_amdgcn_sched_barrier(0);
        asm volatile("s_waitcnt vmcnt(55)" : "+v"(r9));
        o0_2 = mfma16(r9, Sp0_1, o0_2);
        o1_2 = mfma16(r9, Sp1_1, o1_2);
        asm volatile("global_load_dwordx4 %0, %1, off" : "+v"(r9) : "v"((const unsigned char*)(sp0 + ((size_t)(n + 1) * 56 + 25) * 1024) + voff) : "memory");
        __builtin_amdgcn_sched_barrier(0);
        asm volatile("s_waitcnt vmcnt(55)" : "+v"(r10));
        o0_2 = mfma16(r10, Sp0_2, o0_2);
        o1_2 = mfma16(r10, Sp1_2, o1_2);
        asm volatile("global_load_dwordx4 %0, %1, off" : "+v"(r10) : "v"((const unsigned char*)(sp0 + ((size_t)(n + 1) * 56 + 26) * 1024) + voff) : "memory");
        __builtin_amdgcn_sched_barrier(0);
        asm volatile("s_waitcnt vmcnt(55)" : "+v"(r11));
        o0_2 = mfma16(r11, Sp0_3, o0_2);
        o1_2 = mfma16(r11, Sp1_3, o1_2);
        asm volatile("global_load_dwordx4 %0, %1, off" : "+v"(r11) : "v"((const unsigned char*)(sp0 + ((size_t)(n + 1) * 56 + 27) * 1024) + voff) : "memory");
        __builtin_amdgcn_sched_barrier(0);
        asm volatile("s_waitcnt vmcnt(55)" : "+v"(r12));
        o0_3 = mfma16(r12, Sp0_0, o0_3);
        o1_3 = mfma16(r12, Sp1_0, o1_3);
        asm volatile("global_load_dwordx4 %0, %1, off" : "+v"(r12) : "v"((const unsigned char*)(sp0 + ((size_t)(n + 1) * 56 + 28) * 1024) + voff) : "memory");
        __builtin_amdgcn_sched_barrier(0);
        asm volatile("s_waitcnt vmcnt(55)" : "+v"(r13));
        o0_3 = mfma16(r13, Sp0_1, o0_3);
        o1_3 = mfma16(r13, Sp1_1, o1_3);
        asm volatile("global_load_dwordx4 %0, %1, off" : "+v"(r13) : "v"((const unsigned char*)(sp0 + ((size_t)(n + 1) * 56 + 29) * 1024) + voff) : "memory");
        __builtin_amdgcn_sched_barrier(0);
        asm volatile("s_waitcnt vmcnt(55)" : "+v"(r14));
        o0_3 = mfma16(r14, Sp0_2, o0_3);
        o1_3 = mfma16(r14, Sp1_2, o1_3);
        asm volatile("global_load_dwordx4 %0, %1, off" : "+v"(r14) : "v"((const unsigned char*)(sp0 + ((size_t)(n + 1) * 56 + 30) * 1024) + voff) : "memory");
        __builtin_amdgcn_sched_barrier(0);
        asm volatile("s_waitcnt vmcnt(55)" : "+v"(r15));
        o0_3 = mfma16(r15, Sp0_3, o0_3);
        o1_3 = mfma16(r15, Sp1_3, o1_3);
        asm volatile("global_load_dwordx4 %0, %1, off" : "+v"(r15) : "v"((const unsigned char*)(sp0 + ((size_t)(n + 1) * 56 + 31) * 1024) + voff) : "memory");
        __builtin_amdgcn_sched_barrier(0);
        asm volatile("s_waitcnt vmcnt(55)" : "+v"(r16));
        o0_0 = mfma16(r16, vp0_0, o0_0);
        o1_0 = mfma16(r16, vp1_0, o1_0);
        asm volatile("global_load_dwordx4 %0, %1, off" : "+v"(r16) : "v"((const unsigned char*)(sp0 + ((size_t)(n + 1) * 56 + 32) * 1024) + voff) : "memory");
        __builtin_amdgcn_sched_barrier(0);
        asm volatile("s_waitcnt vmcnt(55)" : "+v"(r17));
        o0_0 = mfma16(r17, vp0_1, o0_0);
        o1_0 = mfma16(r17, vp1_1, o1_0);
        asm volatile("global_load_dwordx4 %0, %1, off" : "+v"(r17) : "v"((const unsigned char*)(sp0 + ((size_t)(n + 1) * 56 + 33) * 1024) + voff) : "memory");
        __builtin_amdgcn_sched_barrier(0);
        asm volatile("s_waitcnt vmcnt(55)" : "+v"(r18));
        o0_1 = mfma16(r18, vp0_0, o0_1);
        o1_1 = mfma16(r18, vp1_0, o1_1);
        asm volatile("global_load_dwordx4 %0, %1, off" : "+v"(r18) : "v"((const unsigned char*)(sp0 + ((size_t)(n + 1) * 56 + 34) * 1024) + voff) : "memory");
        __builtin_amdgcn_sched_barrier(0);
        asm volatile("s_waitcnt vmcnt(55)" : "+v"(r19));
        o0_1 = mfma16(r19, vp0_1, o0_1);
        o1_1 = mfma16(r19, vp1_1, o1_1);
        asm volatile("global_load_dwordx4 %0, %1, off" : "+v"(r19) : "v"((const unsigned char*)(sp0 + ((size_t)(n + 1) * 56 + 35) * 1024) + voff) : "memory");
        __builtin_amdgcn_sched_barrier(0);
        asm volatile("s_waitcnt vmcnt(55)" : "+v"(r20));
        o0_2 = mfma16(r20, vp0_0, o0_2);
        o1_2 = mfma16(r20, vp1_0, o1_2);
        asm volatile("global_load_dwordx4 %0, %1, off" : "+v"(r20) : "v"((const unsigned char*)(sp0 + ((size_t)(n + 1) * 56 + 36) * 1024) + voff) : "memory");
        __builtin_amdgcn_sched_barrier(0);
        asm volatile("s_waitcnt vmcnt(55)" : "+v"(r21));
        o0_2 = mfma16(r21, vp0_1, o0_2);
        o1_2 = mfma16(r21, vp1_1, o1_2);
        asm volatile("global_load_dwordx4 %0, %1, off" : "+v"(r21) : "v"((const unsigned char*)(sp0 + ((size_t)(n + 1) * 56 + 37) * 1024) + voff) : "memory");
        __builtin_amdgcn_sched_barrier(0);
        asm volatile("s_waitcnt vmcnt(55)" : "+v"(r22));
        o0_3 = mfma16(r22, vp0_0, o0_3);
        o1_3 = mfma16(r22, vp1_0, o1_3);
        asm volatile("global_load_dwordx4 %0, %1, off" : "+v"(r22) : "v"((const unsigned char*)(sp0 + ((size_t)(n + 1) * 56 + 38) * 1024) + voff) : "memory");
        __builtin_amdgcn_sched_barrier(0);
        asm volatile("s_waitcnt vmcnt(55)" : "+v"(r23));
        o0_3 = mfma16(r23, vp0_1, o0_3);
        o1_3 = mfma16(r23, vp1_1, o1_3);
        asm volatile("global_load_dwordx4 %0, %1, off" : "+v"(r23) : "v"((const unsigned char*)(sp0 + ((size_t)(n + 1) * 56 + 39) * 1024) + voff) : "memory");
        __builtin_amdgcn_sched_barrier(0);
        { const unsigned char* obn = obu + (size_t)n * 64 * orow;
          { const unsigned v = f2bf(o0_0[0]); asm volatile("global_store_short %0, %1, off" :: "v"((const unsigned char*)(obn + (size_t)(0) * orow + 0) + ooff), "v"(v) : "memory"); }
          { const unsigned v = f2bf(o0_0[1]); asm volatile("global_store_short %0, %1, off" :: "v"((const unsigned char*)(obn + (size_t)(1) * orow + 0) + ooff), "v"(v) : "memory"); }
          { const unsigned v = f2bf(o0_0[2]); asm volatile("global_store_short %0, %1, off" :: "v"((const unsigned char*)(obn + (size_t)(2) * orow + 0) + ooff), "v"(v) : "memory"); }
          { const unsigned v = f2bf(o0_0[3]); asm volatile("global_store_short %0, %1, off" :: "v"((const unsigned char*)(obn + (size_t)(3) * orow + 0) + ooff), "v"(v) : "memory"); }
          { const unsigned v = f2bf(o0_1[0]); asm volatile("global_store_short %0, %1, off" :: "v"((const unsigned char*)(obn + (size_t)(16) * orow + 0) + ooff), "v"(v) : "memory"); }
          { const unsigned v = f2bf(o0_1[1]); asm volatile("global_store_short %0, %1, off" :: "v"((const unsigned char*)(obn + (size_t)(17) * orow + 0) + ooff), "v"(v) : "memory"); }
          { const unsigned v = f2bf(o0_1[2]); asm volatile("global_store_short %0, %1, off" :: "v"((const unsigned char*)(obn + (size_t)(18) * orow + 0) + ooff), "v"(v) : "memory"); }
          { const unsigned v = f2bf(o0_1[3]); asm volatile("global_store_short %0, %1, off" :: "v"((const unsigned char*)(obn + (size_t)(19) * orow + 0) + ooff), "v"(v) : "memory"); }
          { const unsigned v = f2bf(o0_2[0]); asm volatile("global_store_short %0, %1, off" :: "v"((const unsigned char*)(obn + (size_t)(32) * orow + 0) + ooff), "v"(v) : "memory"); }
          { const unsigned v = f2bf(o0_2[1]); asm volatile("global_store_short %0, %1, off" :: "v"((const unsigned char*)(obn + (size_t)(33) * orow + 0) + ooff), "v"(v) : "memory"); }
          { const unsigned v = f2bf(o0_2[2]); asm volatile("global_store_short %0, %1, off" :: "v"((const unsigned char*)(obn + (size_t)(34) * orow + 0) + ooff), "v"(v) : "memory"); }
          { const unsigned v = f2bf(o0_2[3]); asm volatile("global_store_short %0, %1, off" :: "v"((const unsigned char*)(obn + (size_t)(35) * orow + 0) + ooff), "v"(v) : "memory"); }
          { const unsigned v = f2bf(o0_3[0]); asm volatile("global_store_short %0, %1, off" :: "v"((const unsigned char*)(obn + (size_t)(48) * orow + 0) + ooff), "v"(v) : "memory"); }
          { const unsigned v = f2bf(o0_3[1]); asm volatile("global_store_short %0, %1, off" :: "v"((const unsigned char*)(obn + (size_t)(49) * orow + 0) + ooff), "v"(v) : "memory"); }
          { const unsigned v = f2bf(o0_3[2]); asm volatile("global_store_short %0, %1, off" :: "v"((const unsigned char*)(obn + (size_t)(50) * orow + 0) + ooff), "v"(v) : "memory"); }
          { const unsigned v = f2bf(o0_3[3]); asm volatile("global_store_short %0, %1, off" :: "v"((const unsigned char*)(obn + (size_t)(51) * orow + 0) + ooff), "v"(v) : "memory"); }
          { const unsigned v = f2bf(o1_0[0]); asm volatile("global_store_short %0, %1, off" :: "v"((const unsigned char*)(obn + (size_t)(0) * orow + 32) + ooff), "v"(v) : "memory"); }
          { const unsigned v = f2bf(o1_0[1]); asm volatile("global_store_short %0, %1, off" :: "v"((const unsigned char*)(obn + (size_t)(1) * orow + 32) + ooff), "v"(v) : "memory"); }
          { const unsigned v = f2bf(o1_0[2]); asm volatile("global_store_short %0, %1, off" :: "v"((const unsigned char*)(obn + (size_t)(2) * orow + 32) + ooff), "v"(v) : "memory"); }
          { const unsigned v = f2bf(o1_0[3]); asm volatile("global_store_short %0, %1, off" :: "v"((const unsigned char*)(obn + (size_t)(3) * orow + 32) + ooff), "v"(v) : "memory"); }
          { const unsigned v = f2bf(o1_1[0]); asm volatile("global_store_short %0, %1, off" :: "v"((const unsigned char*)(obn + (size_t)(16) * orow + 32) + ooff), "v"(v) : "memory"); }
          { const unsigned v = f2bf(o1_1[1]); asm volatile("global_store_short %0, %1, off" :: "v"((const unsigned char*)(obn + (size_t)(17) * orow + 32) + ooff), "v"(v) : "memory"); }
          { const unsigned v = f2bf(o1_1[2]); asm volatile("global_store_short %0, %1, off" :: "v"((const unsigned char*)(obn + (size_t)(18) * orow + 32) + ooff), "v"(v) : "memory"); }
          { const unsigned v = f2bf(o1_1[3]); asm volatile("global_store_short %0, %1, off" :: "v"((const unsigned char*)(obn + (size_t)(19) * orow + 32) + ooff), "v"(v) : "memory"); }
          { const unsigned v = f2bf(o1_2[0]); asm volatile("global_store_short %0, %1, off" :: "v"((const unsigned char*)(obn + (size_t)(32) * orow + 32) + ooff), "v"(v) : "memory"); }
          { const unsigned v = f2bf(o1_2[1]); asm volatile("global_store_short %0, %1, off" :: "v"((const unsigned char*)(obn + (size_t)(33) * orow + 32) + ooff), "v"(v) : "memory"); }
          { const unsigned v = f2bf(o1_2[2]); asm volatile("global_store_short %0, %1, off" :: "v"((const unsigned char*)(obn + (size_t)(34) * orow + 32) + ooff), "v"(v) : "memory"); }
          { const unsigned v = f2bf(o1_2[3]); asm volatile("global_store_short %0, %1, off" :: "v"((const unsigned char*)(obn + (size_t)(35) * orow + 32) + ooff), "v"(v) : "memory"); }
          { const unsigned v = f2bf(o1_3[0]); asm volatile("global_store_short %0, %1, off" :: "v"((const unsigned char*)(obn + (size_t)(48) * orow + 32) + ooff), "v"(v) : "memory"); }
          { const unsigned v = f2bf(o1_3[1]); asm volatile("global_store_short %0, %1, off" :: "v"((const unsigned char*)(obn + (size_t)(49) * orow + 32) + ooff), "v"(v) : "memory"); }
          { const unsigned v = f2bf(o1_3[2]); asm volatile("global_store_short %0, %1, off" :: "v"((const unsigned char*)(obn + (size_t)(50) * orow + 32) + ooff), "v"(v) : "memory"); }
          { const unsigned v = f2bf(o1_3[3]); asm volatile("global_store_short %0, %1, off" :: "v"((const unsigned char*)(obn + (size_t)(51) * orow + 32) + ooff), "v"(v) : "memory"); }
        }
        __builtin_amdgcn_sched_barrier(0);
    }
    asm volatile("s_waitcnt vmcnt(0)" ::: "memory");
    } else if constexpr (!GDN && ROLE == 0) {
    bf16x8 r0 = (bf16x8){0, 0, 0, 0, 0, 0, 0, 0};
    bf16x8 r1 = (bf16x8){0, 0, 0, 0, 0, 0, 0, 0};
    bf16x8 r2 = (bf16x8){0, 0, 0, 0, 0, 0, 0, 0};
    bf16x8 r3 = (bf16x8){0, 0, 0, 0, 0, 0, 0, 0};
    bf16x8 r4 = (bf16x8){0, 0, 0, 0, 0, 0, 0, 0};
    bf16x8 r5 = (bf16x8){0, 0, 0, 0, 0, 0, 0, 0};
    bf16x8 r6 = (bf16x8){0, 0, 0, 0, 0, 0, 0, 0};
    bf16x8 r7 = (bf16x8){0, 0, 0, 0, 0, 0, 0, 0};
    bf16x8 r8 = (bf16x8){0, 0, 0, 0, 0, 0, 0, 0};
    bf16x8 r9 = (bf16x8){0, 0, 0, 0, 0, 0, 0, 0};
    bf16x8 r10 = (bf16x8){0, 0, 0, 0, 0, 0, 0, 0};
    bf16x8 r11 = (bf16x8){0, 0, 0, 0, 0, 0, 0, 0};
    bf16x8 r12 = (bf16x8){0, 0, 0, 0, 0, 0, 0, 0};
    bf16x8 r13 = (bf16x8){0, 0, 0, 0, 0, 0, 0, 0};
    bf16x8 r14 = (bf16x8){0, 0, 0, 0, 0, 0, 0, 0};
    bf16x8 r15 = (bf16x8){0, 0, 0, 0, 0, 0, 0, 0};
    f32x4 S0_0 = {0.f, 0.f, 0.f, 0.f};
    f32x4 S0_1 = {0.f, 0.f, 0.f, 0.f};
    f32x4 S0_2 = {0.f, 0.f, 0.f, 0.f};
    f32x4 S0_3 = {0.f, 0.f, 0.f, 0.f};
    f32x4 S0_4 = {0.f, 0.f, 0.f, 0.f};
    f32x4 S0_5 = {0.f, 0.f, 0.f, 0.f};
    f32x4 S0_6 = {0.f, 0.f, 0.f, 0.f};
    f32x4 S0_7 = {0.f, 0.f, 0.f, 0.f};
    bf16x8 Sp0_0 = (bf16x8){0, 0, 0, 0, 0, 0, 0, 0};
    bf16x8 Sp0_1 = (bf16x8){0, 0, 0, 0, 0, 0, 0, 0};
    bf16x8 Sp0_2 = (bf16x8){0, 0, 0, 0, 0, 0, 0, 0};
    bf16x8 Sp0_3 = (bf16x8){0, 0, 0, 0, 0, 0, 0, 0};
    f32x4 S1_0 = {0.f, 0.f, 0.f, 0.f};
    f32x4 S1_1 = {0.f, 0.f, 0.f, 0.f};
    f32x4 S1_2 = {0.f, 0.f, 0.f, 0.f};
    f32x4 S1_3 = {0.f, 0.f, 0.f, 0.f};
    f32x4 S1_4 = {0.f, 0.f, 0.f, 0.f};
    f32x4 S1_5 = {0.f, 0.f, 0.f, 0.f};
    f32x4 S1_6 = {0.f, 0.f, 0.f, 0.f};
    f32x4 S1_7 = {0.f, 0.f, 0.f, 0.f};
    bf16x8 Sp1_0 = (bf16x8){0, 0, 0, 0, 0, 0, 0, 0};
    bf16x8 Sp1_1 = (bf16x8){0, 0, 0, 0, 0, 0, 0, 0};
    bf16x8 Sp1_2 = (bf16x8){0, 0, 0, 0, 0, 0, 0, 0};
    bf16x8 Sp1_3 = (bf16x8){0, 0, 0, 0, 0, 0, 0, 0};
    unsigned vn0_0 = 0u, vn0_1 = 0u, vn0_2 = 0u, vn0_3 = 0u, vn0_4 = 0u, vn0_5 = 0u, vn0_6 = 0u, vn0_7 = 0u, vn0_8 = 0u, vn0_9 = 0u, vn0_10 = 0u, vn0_11 = 0u, vn0_12 = 0u, vn0_13 = 0u, vn0_14 = 0u, vn0_15 = 0u;
    unsigned vn1_0 = 0u, vn1_1 = 0u, vn1_2 = 0u, vn1_3 = 0u, vn1_4 = 0u, vn1_5 = 0u, vn1_6 = 0u, vn1_7 = 0u, vn1_8 = 0u, vn1_9 = 0u, vn1_10 = 0u, vn1_11 = 0u, vn1_12 = 0u, vn1_13 = 0u, vn1_14 = 0u, vn1_15 = 0u;
    { const int n = 0; (void)n;
    asm volatile("global_load_ushort %0, %1, off" : "+v"(vn0_0) : "v"((const unsigned char*)(vbu + (size_t)(0) * vrow + 0) + voff2) : "memory");
    asm volatile("global_load_ushort %0, %1, off" : "+v"(vn0_1) : "v"((const unsigned char*)(vbu + (size_t)(1) * vrow + 0) + voff2) : "memory");
    asm volatile("global_load_ushort %0, %1, off" : "+v"(vn0_2) : "v"((const unsigned char*)(vbu + (size_t)(2) * vrow + 0) + voff2) : "memory");
    asm volatile("global_load_ushort %0, %1, off" : "+v"(vn0_3) : "v"((const unsigned char*)(vbu + (size_t)(3) * vrow + 0) + voff2) : "memory");
    asm volatile("global_load_ushort %0, %1, off" : "+v"(vn0_4) : "v"((const unsigned char*)(vbu + (size_t)(16) * vrow + 0) + voff2) : "memory");
    asm volatile("global_load_ushort %0, %1, off" : "+v"(vn0_5) : "v"((const unsigned char*)(vbu + (size_t)(17) * vrow + 0) + voff2) : "memory");
    asm volatile("global_load_ushort %0, %1, off" : "+v"(vn0_6) : "v"((const unsigned char*)(vbu + (size_t)(18) * vrow + 0) + voff2) : "memory");
    asm volatile("global_load_ushort %0, %1, off" : "+v"(vn0_7) : "v"((const unsigned char*)(vbu + (size_t)(19) * vrow + 0) + voff2) : "memory");
    asm volatile("global_load_ushort %0, %1, off" : "+v"(vn0_8) : "v"((const unsigned char*)(vbu + (size_t)(32) * vrow + 0) + voff2) : "memory");
    asm volatile("global_load_ushort %0, %1, off" : "+v"(vn0_9) : "v"((const unsigned char*)(vbu + (size_t)(33) * vrow + 0) + voff2) : "memory");
    asm volatile("global_load_ushort %0, %1, off" : "+v"(vn0_10) : "v"((const unsigned char*)(vbu + (size_t)(34) * vrow + 0) + voff2) : "memory");
    asm volatile("global_load_ushort %0, %1, off" : "+v"(vn0_11) : "v"((const unsigned char*)(vbu + (size_t)(35) * vrow + 0) + voff2) : "memory");
    asm volatile("global_load_ushort %0, %1, off" : "+v"(vn0_12) : "v"((const unsigned char*)(vbu + (size_t)(48) * vrow + 0) + voff2) : "memory");
    asm volatile("global_load_ushort %0, %1, off" : "+v"(vn0_13) : "v"((const unsigned char*)(vbu + (size_t)(49) * vrow + 0) + voff2) : "memory");
    asm volatile("global_load_ushort %0, %1, off" : "+v"(vn0_14) : "v"((const unsigned char*)(vbu + (size_t)(50) * vrow + 0) + voff2) : "memory");
    asm volatile("global_load_ushort %0, %1, off" : "+v"(vn0_15) : "v"((const unsigned char*)(vbu + (size_t)(51) * vrow + 0) + voff2) : "memory");
    asm volatile("global_load_ushort %0, %1, off" : "+v"(vn1_0) : "v"((const unsigned char*)(vbu + (size_t)(0) * vrow + 32) + voff2) : "memory");
    asm volatile("global_load_ushort %0, %1, off" : "+v"(vn1_1) : "v"((const unsigned char*)(vbu + (size_t)(1) * vrow + 32) + voff2) : "memory");
    asm volatile("global_load_ushort %0, %1, off" : "+v"(vn1_2) : "v"((const unsigned char*)(vbu + (size_t)(2) * vrow + 32) + voff2) : "memory");
    asm volatile("global_load_ushort %0, %1, off" : "+v"(vn1_3) : "v"((const unsigned char*)(vbu + (size_t)(3) * vrow + 32) + voff2) : "memory");
    asm volatile("global_load_ushort %0, %1, off" : "+v"(vn1_4) : "v"((const unsigned char*)(vbu + (size_t)(16) * vrow + 32) + voff2) : "memory");
    asm volatile("global_load_ushort %0, %1, off" : "+v"(vn1_5) : "v"((const unsigned char*)(vbu + (size_t)(17) * vrow + 32) + voff2) : "memory");
    asm volatile("global_load_ushort %0, %1, off" : "+v"(vn1_6) : "v"((const unsigned char*)(vbu + (size_t)(18) * vrow + 32) + voff2) : "memory");
    asm volatile("global_load_ushort %0, %1, off" : "+v"(vn1_7) : "v"((const unsigned char*)(vbu + (size_t)(19) * vrow + 32) + voff2) : "memory");
    asm volatile("global_load_ushort %0, %1, off" : "+v"(vn1_8) : "v"((const unsigned char*)(vbu + (size_t)(32) * vrow + 32) + voff2) : "memory");
    asm volatile("global_load_ushort %0, %1, off" : "+v"(vn1_9) : "v"((const unsigned char*)(vbu + (size_t)(33) * vrow + 32) + voff2) : "memory");
    asm volatile("global_load_ushort %0, %1, off" : "+v"(vn1_10) : "v"((const unsigned char*)(vbu + (size_t)(34) * vrow + 32) + voff2) : "memory");
    asm volatile("global_load_ushort %0, %1, off" : "+v"(vn1_11) : "v"((const unsigned char*)(vbu + (size_t)(35) * vrow + 32) + voff2) : "memory");
    asm volatile("global_load_ushort %0, %1, off" : "+v"(vn1_12) : "v"((const unsigned char*)(vbu + (size_t)(48) * vrow + 32) + voff2) : "memory");
    asm volatile("global_load_ushort %0, %1, off" : "+v"(vn1_13) : "v"((const unsigned char*)(vbu + (size_t)(49) * vrow + 32) + voff2) : "memory");
    asm volatile("global_load_ushort %0, %1, off" : "+v"(vn1_14) : "v"((const unsigned char*)(vbu + (size_t)(50) * vrow + 32) + voff2) : "memory");
    asm volatile("global_load_ushort %0, %1, off" : "+v"(vn1_15) : "v"((const unsigned char*)(vbu + (size_t)(51) * vrow + 32) + voff2) : "memory");
    asm volatile("global_load_dwordx4 %0, %1, off" : "+v"(r0) : "v"((const unsigned char*)(sp0 + ((size_t)(n + 0) * 40 + 24) * 1024) + voff) : "memory");
    asm volatile("global_load_dwordx4 %0, %1, off" : "+v"(r1) : "v"((const unsigned char*)(sp0 + ((size_t)(n + 0) * 40 + 25) * 1024) + voff) : "memory");
    asm volatile("global_load_dwordx4 %0, %1, off" : "+v"(r2) : "v"((const unsigned char*)(sp0 + ((size_t)(n + 0) * 40 + 26) * 1024) + voff) : "memory");
    asm volatile("global_load_dwordx4 %0, %1, off" : "+v"(r3) : "v"((const unsigned char*)(sp0 + ((size_t)(n + 0) * 40 + 27) * 1024) + voff) : "memory");
    asm volatile("global_load_dwordx4 %0, %1, off" : "+v"(r4) : "v"((const unsigned char*)(sp0 + ((size_t)(n + 0) * 40 + 28) * 1024) + voff) : "memory");
    asm volatile("global_load_dwordx4 %0, %1, off" : "+v"(r5) : "v"((const unsigned char*)(sp0 + ((size_t)(n + 0) * 40 + 29) * 1024) + voff) : "memory");
    asm volatile("global_load_dwordx4 %0, %1, off" : "+v"(r6) : "v"((const unsigned char*)(sp0 + ((size_t)(n + 0) * 40 + 30) * 1024) + voff) : "memory");
    asm volatile("global_load_dwordx4 %0, %1, off" : "+v"(r7) : "v"((const unsigned char*)(sp0 + ((size_t)(n + 0) * 40 + 31) * 1024) + voff) : "memory");
    asm volatile("global_load_dwordx4 %0, %1, off" : "+v"(r8) : "v"((const unsigned char*)(sp0 + ((size_t)(n + 0) * 40 + 32) * 1024) + voff) : "memory");
    asm volatile("global_load_dwordx4 %0, %1, off" : "+v"(r9) : "v"((const unsigned char*)(sp0 + ((size_t)(n + 0) * 40 + 33) * 1024) + voff) : "memory");
    asm volatile("global_load_dwordx4 %0, %1, off" : "+v"(r10) : "v"((const unsigned char*)(sp0 + ((size_t)(n + 0) * 40 + 34) * 1024) + voff) : "memory");
    asm volatile("global_load_dwordx4 %0, %1, off" : "+v"(r11) : "v"((const unsigned char*)(sp0 + ((size_t)(n + 0) * 40 + 35) * 1024) + voff) : "memory");
    asm volatile("global_load_dwordx4 %0, %1, off" : "+v"(r12) : "v"((const unsigned char*)(sp0 + ((size_t)(n + 0) * 40 + 36) * 1024) + voff) : "memory");
    asm volatile("global_load_dwordx4 %0, %1, off" : "+v"(r13) : "v"((const unsigned char*)(sp0 + ((size_t)(n + 0) * 40 + 37) * 1024) + voff) : "memory");
    asm volatile("global_load_dwordx4 %0, %1, off" : "+v"(r14) : "v"((const unsigned char*)(sp0 + ((size_t)(n + 0) * 40 + 38) * 1024) + voff) : "memory");
    asm volatile("global_load_dwordx4 %0, %1, off" : "+v"(r15) : "v"((const unsigned char*)(sp0 + ((size_t)(n + 0) * 40 + 39) * 1024) + voff) : "memory");
    }
#pragma unroll 1
    for (int n = 0; n < NCH; ++n) {
        const int nn = n + 1 < NCH ? n + 1 : n;
        f32x4 a0_0, a0_1, a0_2, a0_3;
        f32x4 a1_0, a1_1, a1_2, a1_3;
        asm volatile("s_waitcnt vmcnt(16)" : "+v"(vn0_0), "+v"(vn0_1), "+v"(vn0_2), "+v"(vn0_3), "+v"(vn0_4), "+v"(vn0_5), "+v"(vn0_6), "+v"(vn0_7), "+v"(vn0_8), "+v"(vn0_9), "+v"(vn0_10), "+v"(vn0_11), "+v"(vn0_12), "+v"(vn0_13), "+v"(vn0_14), "+v"(vn0_15));
        asm volatile("s_waitcnt vmcnt(16)" : "+v"(vn1_0), "+v"(vn1_1), "+v"(vn1_2), "+v"(vn1_3), "+v"(vn1_4), "+v"(vn1_5), "+v"(vn1_6), "+v"(vn1_7), "+v"(vn1_8), "+v"(vn1_9), "+v"(vn1_10), "+v"(vn1_11), "+v"(vn1_12), "+v"(vn1_13), "+v"(vn1_14), "+v"(vn1_15));
        a0_0 = (f32x4){__builtin_bit_cast(float, vn0_0 << 16), __builtin_bit_cast(float, vn0_1 << 16), __builtin_bit_cast(float, vn0_2 << 16), __builtin_bit_cast(float, vn0_3 << 16)};
        a0_1 = (f32x4){__builtin_bit_cast(float, vn0_4 << 16), __builtin_bit_cast(float, vn0_5 << 16), __builtin_bit_cast(float, vn0_6 << 16), __builtin_bit_cast(float, vn0_7 << 16)};
        a0_2 = (f32x4){__builtin_bit_cast(float, vn0_8 << 16), __builtin_bit_cast(float, vn0_9 << 16), __builtin_bit_cast(float, vn0_10 << 16), __builtin_bit_cast(float, vn0_11 << 16)};
        a0_3 = (f32x4){__builtin_bit_cast(float, vn0_12 << 16), __builtin_bit_cast(float, vn0_13 << 16), __builtin_bit_cast(float, vn0_14 << 16), __builtin_bit_cast(float, vn0_15 << 16)};
        a1_0 = (f32x4){__builtin_bit_cast(float, vn1_0 << 16), __builtin_bit_cast(float, vn1_1 << 16), __builtin_bit_cast(float, vn1_2 << 16), __builtin_bit_cast(float, vn1_3 << 16)};
        a1_1 = (f32x4){__builtin_bit_cast(float, vn1_4 << 16), __builtin_bit_cast(float, vn1_5 << 16), __builtin_bit_cast(float, vn1_6 << 16), __builtin_bit_cast(float, vn1_7 << 16)};
        a1_2 = (f32x4){__builtin_bit_cast(float, vn1_8 << 16), __builtin_bit_cast(float, vn1_9 << 16), __builtin_bit_cast(float, vn1_10 << 16), __builtin_bit_cast(float, vn1_11 << 16)};
        a1_3 = (f32x4){__builtin_bit_cast(float, vn1_12 << 16), __builtin_bit_cast(float, vn1_13 << 16), __builtin_bit_cast(float, vn1_14 << 16), __builtin_bit_cast(float, vn1_15 << 16)};
        const float dec = decr;
        { const unsigned char* vbn = vbu + (size_t)nn * 64 * vrow;
          asm volatile("global_load_ushort %0, %1, off" : "+v"(vn0_0) : "v"((const unsigned char*)(vbn + (size_t)(0) * vrow + 0) + voff2) : "memory");
          asm volatile("global_load_ushort %0, %1, off" : "+v"(vn0_1) : "v"((const unsigned char*)(vbn + (size_t)(1) * vrow + 0) + voff2) : "memory");
          asm volatile("global_load_ushort %0, %1, off" : "+v"(vn0_2) : "v"((const unsigned char*)(vbn + (size_t)(2) * vrow + 0) + voff2) : "memory");
          asm volatile("global_load_ushort %0, %1, off" : "+v"(vn0_3) : "v"((const unsigned char*)(vbn + (size_t)(3) * vrow + 0) + voff2) : "memory");
          asm volatile("global_load_ushort %0, %1, off" : "+v"(vn0_4) : "v"((const unsigned char*)(vbn + (size_t)(16) * vrow + 0) + voff2) : "memory");
          asm volatile("global_load_ushort %0, %1, off" : "+v"(vn0_5) : "v"((const unsigned char*)(vbn + (size_t)(17) * vrow + 0) + voff2) : "memory");
          asm volatile("global_load_ushort %0, %1, off" : "+v"(vn0_6) : "v"((const unsigned char*)(vbn + (size_t)(18) * vrow + 0) + voff2) : "memory");
          asm volatile("global_load_ushort %0, %1, off" : "+v"(vn0_7) : "v"((const unsigned char*)(vbn + (size_t)(19) * vrow + 0) + voff2) : "memory");
          asm volatile("global_load_ushort %0, %1, off" : "+v"(vn0_8) : "v"((const unsigned char*)(vbn + (size_t)(32) * vrow + 0) + voff2) : "memory");
          asm volatile("global_load_ushort %0, %1, off" : "+v"(vn0_9) : "v"((const unsigned char*)(vbn + (size_t)(33) * vrow + 0) + voff2) : "memory");
          asm volatile("global_load_ushort %0, %1, off" : "+v"(vn0_10) : "v"((const unsigned char*)(vbn + (size_t)(34) * vrow + 0) + voff2) : "memory");
          asm volatile("global_load_ushort %0, %1, off" : "+v"(vn0_11) : "v"((const unsigned char*)(vbn + (size_t)(35) * vrow + 0) + voff2) : "memory");
          asm volatile("global_load_ushort %0, %1, off" : "+v"(vn0_12) : "v"((const unsigned char*)(vbn + (size_t)(48) * vrow + 0) + voff2) : "memory");
          asm volatile("global_load_ushort %0, %1, off" : "+v"(vn0_13) : "v"((const unsigned char*)(vbn + (size_t)(49) * vrow + 0) + voff2) : "memory");
          asm volatile("global_load_ushort %0, %1, off" : "+v"(vn0_14) : "v"((const unsigned char*)(vbn + (size_t)(50) * vrow + 0) + voff2) : "memory");
          asm volatile("global_load_ushort %0, %1, off" : "+v"(vn0_15) : "v"((const unsigned char*)(vbn + (size_t)(51) * vrow + 0) + voff2) : "memory");
          asm volatile("global_load_ushort %0, %1, off" : "+v"(vn1_0) : "v"((const unsigned char*)(vbn + (size_t)(0) * vrow + 32) + voff2) : "memory");
          asm volatile("global_load_ushort %0, %1, off" : "+v"(vn1_1) : "v"((const unsigned char*)(vbn + (size_t)(1) * vrow + 32) + voff2) : "memory");
          asm volatile("global_load_ushort %0, %1, off" : "+v"(vn1_2) : "v"((const unsigned char*)(vbn + (size_t)(2) * vrow + 32) + voff2) : "memory");
          asm volatile("global_load_ushort %0, %1, off" : "+v"(vn1_3) : "v"((const unsigned char*)(vbn + (size_t)(3) * vrow + 32) + voff2) : "memory");
          asm volatile("global_load_ushort %0, %1, off" : "+v"(vn1_4) : "v"((const unsigned char*)(vbn + (size_t)(16) * vrow + 32) + voff2) : "memory");
          asm volatile("global_load_ushort %0, %1, off" : "+v"(vn1_5) : "v"((const unsigned char*)(vbn + (size_t)(17) * vrow + 32) + voff2) : "memory");
          asm volatile("global_load_ushort %0, %1, off" : "+v"(vn1_6) : "v"((const unsigned char*)(vbn + (size_t)(18) * vrow + 32) + voff2) : "memory");
          asm volatile("global_load_ushort %0, %1, off" : "+v"(vn1_7) : "v"((const unsigned char*)(vbn + (size_t)(19) * vrow + 32) + voff2) : "memory");
          asm volatile("global_load_ushort %0, %1, off" : "+v"(vn1_8) : "v"((const unsigned char*)(vbn + (size_t)(32) * vrow + 32) + voff2) : "memory");
          asm volatile("global_load_ushort %0, %1, off" : "+v"(vn1_9) : "v"((const unsigned char*)(vbn + (size_t)(33) * vrow + 32) + voff2) : "memory");
          asm volatile("global_load_ushort %0, %1, off" : "+v"(vn1_10) : "v"((const unsigned char*)(vbn + (size_t)(34) * vrow + 32) + voff2) : "memory");
          asm volatile("global_load_ushort %0, %1, off" : "+v"(vn1_11) : "v"((const unsigned char*)(vbn + (size_t)(35) * vrow + 32) + voff2) : "memory");
          asm volatile("global_load_ushort %0, %1, off" : "+v"(vn1_12) : "v"((const unsigned char*)(vbn + (size_t)(48) * vrow + 32) + voff2) : "memory");
          asm volatile("global_load_ushort %0, %1, off" : "+v"(vn1_13) : "v"((const unsigned char*)(vbn + (size_t)(49) * vrow + 32) + voff2) : "memory");
          asm volatile("global_load_ushort %0, %1, off" : "+v"(vn1_14) : "v"((const unsigned char*)(vbn + (size_t)(50) * vrow + 32) + voff2) : "memory");
          asm volatile("global_load_ushort %0, %1, off" : "+v"(vn1_15) : "v"((const unsigned char*)(vbn + (size_t)(51) * vrow + 32) + voff2) : "memory");
        }
        __builtin_amdgcn_sched_barrier(0);
        bf16x8 vp0_0, vp0_1;
        { u32x4 w; w.x = cvt_pk_bf16(a0_0[0], a0_0[1]); w.y = cvt_pk_bf16(a0_0[2], a0_0[3]); w.z = cvt_pk_bf16(a0_1[0], a0_1[1]); w.w = cvt_pk_bf16(a0_1[2], a0_1[3]); vp0_0 = __builtin_bit_cast(bf16x8, w); }
        { u32x4 w; w.x = cvt_pk_bf16(a0_2[0], a0_2[1]); w.y = cvt_pk_bf16(a0_2[2], a0_2[3]); w.z = cvt_pk_bf16(a0_3[0], a0_3[1]); w.w = cvt_pk_bf16(a0_3[2], a0_3[3]); vp0_1 = __builtin_bit_cast(bf16x8, w); }
        bf16x8 vp1_0, vp1_1;
        { u32x4 w; w.x = cvt_pk_bf16(a1_0[0], a1_0[1]); w.y = cvt_pk_bf16(a1_0[2], a1_0[3]); w.z = cvt_pk_bf16(a1_1[0], a1_1[1]); w.w = cvt_pk_bf16(a1_1[2], a1_1[3]); vp1_0 = __builtin_bit_cast(bf16x8, w); }
        { u32x4 w; w.x = cvt_pk_bf16(a1_2[0], a1_2[1]); w.y = cvt_pk_bf16(a1_2[2], a1_2[3]); w.z = cvt_pk_bf16(a1_3[0], a1_3[1]); w.w = cvt_pk_bf16(a1_3[2], a1_3[3]); vp1_1 = __builtin_bit_cast(bf16x8, w); }
        { unsigned sp_ = 0; while (*(volatile LAS unsigned*)(xl + XL_CNT + 64) + 2u <= (unsigned)n) { __builtin_amdgcn_s_sleep(1); if (++sp_ > (1u << 22)) break; } }
        { LAS bf16x8* sl_ = (LAS bf16x8*)(xl + (n & 1) * XL_SLOT) + lane; sl_[0] = Sp0_0; sl_[64] = Sp0_1; sl_[128] = Sp0_2; sl_[192] = Sp0_3; sl_[256] = vp0_0; sl_[320] = vp0_1; sl_[384] = Sp1_0; sl_[448] = Sp1_1; sl_[512] = Sp1_2; sl_[576] = Sp1_3; sl_[640] = vp1_0; sl_[704] = vp1_1; }
        asm volatile("s_waitcnt lgkmcnt(0)" ::: "memory");
        if (lane == 0) *(volatile LAS unsigned*)(xl + XL_CNT) = (unsigned)(n + 1);
        S0_0 = S0_0 * dec;
        S1_0 = S1_0 * dec;
        asm volatile("s_waitcnt vmcnt(47)" : "+v"(r0));
        S0_0 = mfma16(r0, vp0_0, S0_0);
        S1_0 = mfma16(r0, vp1_0, S1_0);
        asm volatile("global_load_dwordx4 %0, %1, off" : "+v"(r0) : "v"((const unsigned char*)(sp0 + ((size_t)(n + 1) * 40 + 24) * 1024) + voff) : "memory");
        __builtin_amdgcn_sched_barrier(0);
        asm volatile("s_waitcnt vmcnt(47)" : "+v"(r1));
        S0_0 = mfma16(r1, vp0_1, S0_0);
        S1_0 = mfma16(r1, vp1_1, S1_0);
        asm volatile("global_load_dwordx4 %0, %1, off" : "+v"(r1) : "v"((const unsigned char*)(sp0 + ((size_t)(n + 1) * 40 + 25) * 1024) + voff) : "memory");
        __builtin_amdgcn_sched_barrier(0);
        S0_1 = S0_1 * dec;
        S1_1 = S1_1 * dec;
        asm volatile("s_waitcnt vmcnt(47)" : "+v"(r2));
        S0_1 = mfma16(r2, vp0_0, S0_1);
        S1_1 = mfma16(r2, vp1_0, S1_1);
        asm volatile("global_load_dwordx4 %0, %1, off" : "+v"(r2) : "v"((const unsigned char*)(sp0 + ((size_t)(n + 1) * 40 + 26) * 1024) + voff) : "memory");
        __builtin_amdgcn_sched_barrier(0);
        asm volatile("s_waitcnt vmcnt(47)" : "+v"(r3));
        S0_1 = mfma16(r3, vp0_1, S0_1);
        S1_1 = mfma16(r3, vp1_1, S1_1);
        asm volatile("global_load_dwordx4 %0, %1, off" : "+v"(r3) : "v"((const unsigned char*)(sp0 + ((size_t)(n + 1) * 40 + 27) * 1024) + voff) : "memory");
        __builtin_amdgcn_sched_barrier(0);
        S0_2 = S0_2 * dec;
        S1_2 = S1_2 * dec;
        asm volatile("s_waitcnt vmcnt(47)" : "+v"(r4));
        S0_2 = mfma16(r4, vp0_0, S0_2);
        S1_2 = mfma16(r4, vp1_0, S1_2);
        asm volatile("global_load_dwordx4 %0, %1, off" : "+v"(r4) : "v"((const unsigned char*)(sp0 + ((size_t)(n + 1) * 40 + 28) * 1024) + voff) : "memory");
        __builtin_amdgcn_sched_barrier(0);
        asm volatile("s_waitcnt vmcnt(47)" : "+v"(r5));
        S0_2 = mfma16(r5, vp0_1, S0_2);
        S1_2 = mfma16(r5, vp1_1, S1_2);
        asm volatile("global_load_dwordx4 %0, %1, off" : "+v"(r5) : "v"((const unsigned char*)(sp0 + ((size_t)(n + 1) * 40 + 29) * 1024) + voff) : "memory");
        __builtin_amdgcn_sched_barrier(0);
        S0_3 = S0_3 * dec;
        S1_3 = S1_3 * dec;
        asm volatile("s_waitcnt vmcnt(47)" : "+v"(r6));
        S0_3 = mfma16(r6, vp0_0, S0_3);
        S1_3 = mfma16(r6, vp1_0, S1_3);
        asm volatile("global_load_dwordx4 %0, %1, off" : "+v"(r6) : "v"((const unsigned char*)(sp0 + ((size_t)(n + 1) * 40 + 30) * 1024) + voff) : "memory");
        __builtin_amdgcn_sched_barrier(0);
        asm volatile("s_waitcnt vmcnt(47)" : "+v"(r7));
        S0_3 = mfma16(r7, vp0_1, S0_3);
        S1_3 = mfma16(r7, vp1_1, S1_3);
        asm volatile("global_load_dwordx4 %0, %1, off" : "+v"(r7) : "v"((const unsigned char*)(sp0 + ((size_t)(n + 1) * 40 + 31) * 1024) + voff) : "memory");
        __builtin_amdgcn_sched_barrier(0);
        S0_4 = S0_4 * dec;
        S1_4 = S1_4 * dec;
        asm volatile("s_waitcnt vmcnt(47)" : "+v"(r8));
        S0_4 = mfma16(r8, vp0_0, S0_4);
        S1_4 = mfma16(r8, vp1_0, S1_4);
        asm volatile("global_load_dwordx4 %0, %1, off" : "+v"(r8) : "v"((const unsigned char*)(sp0 + ((size_t)(n + 1) * 40 + 32) * 1024) + voff) : "memory");
        __builtin_amdgcn_sched_barrier(0);
        asm volatile("s_waitcnt vmcnt(47)" : "+v"(r9));
        S0_4 = mfma16(r9, vp0_1, S0_4);
        S1_4 = mfma16(r9, vp1_1, S1_4);
        asm volatile("global_load_dwordx4 %0, %1, off" : "+v"(r9) : "v"((const unsigned char*)(sp0 + ((size_t)(n + 1) * 40 + 33) * 1024) + voff) : "memory");
        __builtin_amdgcn_sched_barrier(0);
        S0_5 = S0_5 * dec;
        S1_5 = S1_5 * dec;
        asm volatile("s_waitcnt vmcnt(47)" : "+v"(r10));
        S0_5 = mfma16(r10, vp0_0, S0_5);
        S1_5 = mfma16(r10, vp1_0, S1_5);
        asm volatile("global_load_dwordx4 %0, %1, off" : "+v"(r10) : "v"((const unsigned char*)(sp0 + ((size_t)(n + 1) * 40 + 34) * 1024) + voff) : "memory");
        __builtin_amdgcn_sched_barrier(0);
        asm volatile("s_waitcnt vmcnt(47)" : "+v"(r11));
        S0_5 = mfma16(r11, vp0_1, S0_5);
        S1_5 = mfma16(r11, vp1_1, S1_5);
        asm volatile("global_load_dwordx4 %0, %1, off" : "+v"(r11) : "v"((const unsigned char*)(sp0 + ((size_t)(n + 1) * 40 + 35) * 1024) + voff) : "memory");
        __builtin_amdgcn_sched_barrier(0);
        S0_6 = S0_6 * dec;
        S1_6 = S1_6 * dec;
        asm volatile("s_waitcnt vmcnt(47)" : "+v"(r12));
        S0_6 = mfma16(r12, vp0_0, S0_6);
        S1_6 = mfma16(r12, vp1_0, S1_6);
        asm volatile("global_load_dwordx4 %0, %1, off" : "+v"(r12) : "v"((const unsigned char*)(sp0 + ((size_t)(n + 1) * 40 + 36) * 1024) + voff) : "memory");
        __builtin_amdgcn_sched_barrier(0);
        asm volatile("s_waitcnt vmcnt(47)" : "+v"(r13));
        S0_6 = mfma16(r13, vp0_1, S0_6);
        S1_6 = mfma16(r13, vp1_1, S1_6);
        asm volatile("global_load_dwordx4 %0, %1, off" : "+v"(r13) : "v"((const unsigned char*)(sp0 + ((size_t)(n + 1) * 40 + 37) * 1024) + voff) : "memory");
        __builtin_amdgcn_sched_barrier(0);
        S0_7 = S0_7 * dec;
        S1_7 = S1_7 * dec;
        asm volatile("s_waitcnt vmcnt(47)" : "+v"(r14));
        S0_7 = mfma16(r14, vp0_0, S0_7);
        S1_7 = mfma16(r14, vp1_0, S1_7);
        asm volatile("global_load_dwordx4 %0, %1, off" : "+v"(r14) : "v"((const unsigned char*)(sp0 + ((size_t)(n + 1) * 40 + 38) * 1024) + voff) : "memory");
        __builtin_amdgcn_sched_barrier(0);
        asm volatile("s_waitcnt vmcnt(47)" : "+v"(r15));
        S0_7 = mfma16(r15, vp0_1, S0_7);
        S1_7 = mfma16(r15, vp1_1, S1_7);
        asm volatile("global_load_dwordx4 %0, %1, off" : "+v"(r15) : "v"((const unsigned char*)(sp0 + ((size_t)(n + 1) * 40 + 39) * 1024) + voff) : "memory");
        __builtin_amdgcn_sched_barrier(0);
        { u32x4 w; w.x = cvt_pk_bf16(S0_0[0], S0_0[1]); w.y = cvt_pk_bf16(S0_0[2], S0_0[3]); w.z = cvt_pk_bf16(S0_1[0], S0_1[1]); w.w = cvt_pk_bf16(S0_1[2], S0_1[3]); Sp0_0 = __builtin_bit_cast(bf16x8, w); }
        { u32x4 w; w.x = cvt_pk_bf16(S0_2[0], S0_2[1]); w.y = cvt_pk_bf16(S0_2[2], S0_2[3]); w.z = cvt_pk_bf16(S0_3[0], S0_3[1]); w.w = cvt_pk_bf16(S0_3[2], S0_3[3]); Sp0_1 = __builtin_bit_cast(bf16x8, w); }
        { u32x4 w; w.x = cvt_pk_bf16(S0_4[0], S0_4[1]); w.y = cvt_pk_bf16(S0_4[2], S0_4[3]); w.z = cvt_pk_bf16(S0_5[0], S0_5[1]); w.w = cvt_pk_bf16(S0_5[2], S0_5[3]); Sp0_2 = __builtin_bit_cast(bf16x8, w); }
        { u32x4 w; w.x = cvt_pk_bf16(S0_6[0], S0_6[1]); w.y = cvt_pk_bf16(S0_6[2], S0_6[3]); w.z = cvt_pk_bf16(S0_7[0], S0_7[1]); w.w = cvt_pk_bf16(S0_7[2], S0_7[3]); Sp0_3 = __builtin_bit_cast(bf16x8, w); }
        { u32x4 w; w.x = cvt_pk_bf16(S1_0[0], S1_0[1]); w.y = cvt_pk_bf16(S1_0[2], S1_0[3]); w.z = cvt_pk_bf16(S1_1[0], S1_1[1]); w.w = cvt_pk_bf16(S1_1[2], S1_1[3]); Sp1_0 = __builtin_bit_cast(bf16x8, w); }
        { u32x4 w; w.x = cvt_pk_bf16(S1_2[0], S1_2[1]); w.y = cvt_pk_bf16(S1_2[2], S1_2[3]); w.z = cvt_pk_bf16(S1_3[0], S1_3[1]); w.w = cvt_pk_bf16(S1_3[2], S1_3[3]); Sp1_1 = __builtin_bit_cast(bf16x8, w); }
        { u32x4 w; w.x = cvt_pk_bf16(S1_4[0], S1_4[1]); w.y = cvt_pk_bf16(S1_4[2], S1_4[3]); w.z = cvt_pk_bf16(S1_5[0], S1_5[1]); w.w = cvt_pk_bf16(S1_5[2], S1_5[3]); Sp1_2 = __builtin_bit_cast(bf16x8, w); }
        { u32x4 w; w.x = cvt_pk_bf16(S1_6[0], S1_6[1]); w.y = cvt_pk_bf16(S1_6[2], S1_6[3]); w.z = cvt_pk_bf16(S1_7[0], S1_7[1]); w.w = cvt_pk_bf16(S1_7[2], S1_7[3]); Sp1_3 = __builtin_bit_cast(bf16x8, w); }
    }
    asm volatile("s_waitcnt vmcnt(0)" ::: "memory");
    } else {
    bf16x8 r0 = (bf16x8){0, 0, 0, 0, 0, 0, 0, 0};
    bf16x8 r1 = (bf16x8){0, 0, 0, 0, 0, 0, 0, 0};
    bf16x8 r2 = (bf16x8){0, 0, 0, 0, 0, 0, 0, 0};
    bf16x8 r3 = (bf16x8){0, 0, 0, 0, 0, 0, 0, 0};
    bf16x8 r4 = (bf16x8){0, 0, 0, 0, 0, 0, 0, 0};
    bf16x8 r5 = (bf16x8){0, 0, 0, 0, 0, 0, 0, 0};
    bf16x8 r6 = (bf16x8){0, 0, 0, 0, 0, 0, 0, 0};
    bf16x8 r7 = (bf16x8){0, 0, 0, 0, 0, 0, 0, 0};
    bf16x8 r8 = (bf16x8){0, 0, 0, 0, 0, 0, 0, 0};
    bf16x8 r9 = (bf16x8){0, 0, 0, 0, 0, 0, 0, 0};
    bf16x8 r10 = (bf16x8){0, 0, 0, 0, 0, 0, 0, 0};
    bf16x8 r11 = (bf16x8){0, 0, 0, 0, 0, 0, 0, 0};
    bf16x8 r12 = (bf16x8){0, 0, 0, 0, 0, 0, 0, 0};
    bf16x8 r13 = (bf16x8){0, 0, 0, 0, 0, 0, 0, 0};
    bf16x8 r14 = (bf16x8){0, 0, 0, 0, 0, 0, 0, 0};
    bf16x8 r15 = (bf16x8){0, 0, 0, 0, 0, 0, 0, 0};
    bf16x8 r16 = (bf16x8){0, 0, 0, 0, 0, 0, 0, 0};
    bf16x8 r17 = (bf16x8){0, 0, 0, 0, 0, 0, 0, 0};
    bf16x8 r18 = (bf16x8){0, 0, 0, 0, 0, 0, 0, 0};
    bf16x8 r19 = (bf16x8){0, 0, 0, 0, 0, 0, 0, 0};
    bf16x8 r20 = (bf16x8){0, 0, 0, 0, 0, 0, 0, 0};
    bf16x8 r21 = (bf16x8){0, 0, 0, 0, 0, 0, 0, 0};
    bf16x8 r22 = (bf16x8){0, 0, 0, 0, 0, 0, 0, 0};
    bf16x8 r23 = (bf16x8){0, 0, 0, 0, 0, 0, 0, 0};
    asm volatile("global_load_dwordx4 %0, %1, off" : "+v"(r0) : "v"((const unsigned char*)(sp0 + ((size_t)(0 + 0) * 40 + 0) * 1024) + voff) : "memory");
    asm volatile("global_load_dwordx4 %0, %1, off" : "+v"(r1) : "v"((const unsigned char*)(sp0 + ((size_t)(0 + 0) * 40 + 1) * 1024) + voff) : "memory");
    asm volatile("global_load_dwordx4 %0, %1, off" : "+v"(r2) : "v"((const unsigned char*)(sp0 + ((size_t)(0 + 0) * 40 + 2) * 1024) + voff) : "memory");
    asm volatile("global_load_dwordx4 %0, %1, off" : "+v"(r3) : "v"((const unsigned char*)(sp0 + ((size_t)(0 + 0) * 40 + 3) * 1024) + voff) : "memory");
    asm volatile("global_load_dwordx4 %0, %1, off" : "+v"(r4) : "v"((const unsigned char*)(sp0 + ((size_t)(0 + 0) * 40 + 4) * 1024) + voff) : "memory");
    asm volatile("global_load_dwordx4 %0, %1, off" : "+v"(r5) : "v"((const unsigned char*)(sp0 + ((size_t)(0 + 0) * 40 + 5) * 1024) + voff) : "memory");
    asm volatile("global_load_dwordx4 %0, %1, off" : "+v"(r6) : "v"((const unsigned char*)(sp0 + ((size_t)(0 + 0) * 40 + 6) * 1024) + voff) : "memory");
    asm volatile("global_load_dwordx4 %0, %1, off" : "+v"(r7) : "v"((const unsigned char*)(sp0 + ((size_t)(0 + 0) * 40 + 7) * 1024) + voff) : "memory");
    asm volatile("global_load_dwordx4 %0, %1, off" : "+v"(r8) : "v"((const unsigned char*)(sp0 + ((size_t)(0 + 0) * 40 + 8) * 1024) + voff) : "memory");
    asm volatile("global_load_dwordx4 %0, %1, off" : "+v"(r9) : "v"((const unsigned char*)(sp0 + ((size_t)(0 + 0) * 40 + 9) * 1024) + voff) : "memory");
    asm volatile("global_load_dwordx4 %0, %1, off" : "+v"(r10) : "v"((const unsigned char*)(sp0 + ((size_t)(0 + 0) * 40 + 10) * 1024) + voff) : "memory");
    asm volatile("global_load_dwordx4 %0, %1, off" : "+v"(r11) : "v"((const unsigned char*)(sp0 + ((size_t)(0 + 0) * 40 + 11) * 1024) + voff) : "memory");
    asm volatile("global_load_dwordx4 %0, %1, off" : "+v"(r12) : "v"((const unsigned char*)(sp0 + ((size_t)(0 + 0) * 40 + 12) * 1024) + voff) : "memory");
    asm volatile("global_load_dwordx4 %0, %1, off" : "+v"(r13) : "v"((const unsigned char*)(sp0 + ((size_t)(0 + 0) * 40 + 13) * 1024) + voff) : "memory");
    asm volatile("global_load_dwordx4 %0, %1, off" : "+v"(r14) : "v"((const unsigned char*)(sp0 + ((size_t)(0 + 0) * 40 + 14) * 1024) + voff) : "memory");
    asm volatile("global_load_dwordx4 %0, %1, off" : "+v"(r15) : "v"((const unsigned char*)(sp0 + ((size_t)(0 + 0) * 40 + 15) * 1024) + voff) : "memory");
    asm volatile("global_load_dwordx4 %0, %1, off" : "+v"(r16) : "v"((const unsigned char*)(sp0 + ((size_t)(0 + 0) * 40 + 16) * 1024) + voff) : "memory");
    asm volatile("global_load_dwordx4 %0, %1, off" : "+v"(r17) : "v"((const unsigned char*)(sp0 + ((size_t)(0 + 0) * 40 + 17) * 1024) + voff) : "memory");
    asm volatile("global_load_dwordx4 %0, %1, off" : "+v"(r18) : "v"((const unsigned char*)(sp0 + ((size_t)(0 + 0) * 40 + 18) * 1024) + voff) : "memory");
    asm volatile("global_load_dwordx4 %0, %1, off" : "+v"(r19) : "v"((const unsigned char*)(sp0 + ((size_t)(0 + 0) * 40 + 19) * 1024) + voff) : "memory");
    asm volatile("global_load_dwordx4 %0, %1, off" : "+v"(r20) : "v"((const unsigned char*)(sp0 + ((size_t)(0 + 0) * 40 + 20) * 1024) + voff) : "memory");
    asm volatile("global_load_dwordx4 %0, %1, off" : "+v"(r21) : "v"((const unsigned char*)(sp0 + ((size_t)(0 + 0) * 40 + 21) * 1024) + voff) : "memory");
    asm volatile("global_load_dwordx4 %0, %1, off" : "+v"(r22) : "v"((const unsigned char*)(sp0 + ((size_t)(0 + 0) * 40 + 22) * 1024) + voff) : "memory");
    asm volatile("global_load_dwordx4 %0, %1, off" : "+v"(r23) : "v"((const unsigned char*)(sp0 + ((size_t)(0 + 0) * 40 + 23) * 1024) + voff) : "memory");
    { unsigned z = 0u;
      asm volatile("global_store_short %0, %1, off" :: "v"((const unsigned char*)(obu + (size_t)(0) * orow + 0) + ooff), "v"(z) : "memory");
      asm volatile("global_store_short %0, %1, off" :: "v"((const unsigned char*)(obu + (size_t)(1) * orow + 0) + ooff), "v"(z) : "memory");
      asm volatile("global_store_short %0, %1, off" :: "v"((const unsigned char*)(obu + (size_t)(2) * orow + 0) + ooff), "v"(z) : "memory");
      asm volatile("global_store_short %0, %1, off" :: "v"((const unsigned char*)(obu + (size_t)(3) * orow + 0) + ooff), "v"(z) : "memory");
      asm volatile("global_store_short %0, %1, off" :: "v"((const unsigned char*)(obu + (size_t)(16) * orow + 0) + ooff), "v"(z) : "memory");
      asm volatile("global_store_short %0, %1, off" :: "v"((const unsigned char*)(obu + (size_t)(17) * orow + 0) + ooff), "v"(z) : "memory");
      asm volatile("global_store_short %0, %1, off" :: "v"((const unsigned char*)(obu + (size_t)(18) * orow + 0) + ooff), "v"(z) : "memory");
      asm volatile("global_store_short %0, %1, off" :: "v"((const unsigned char*)(obu + (size_t)(19) * orow + 0) + ooff), "v"(z) : "memory");
      asm volatile("global_store_short %0, %1, off" :: "v"((const unsigned char*)(obu + (size_t)(32) * orow + 0) + ooff), "v"(z) : "memory");
      asm volatile("global_store_short %0, %1, off" :: "v"((const unsigned char*)(obu + (size_t)(33) * orow + 0) + ooff), "v"(z) : "memory");
      asm volatile("global_store_short %0, %1, off" :: "v"((const unsigned char*)(obu + (size_t)(34) * orow + 0) + ooff), "v"(z) : "memory");
      asm volatile("global_store_short %0, %1, off" :: "v"((const unsigned char*)(obu + (size_t)(35) * orow + 0) + ooff), "v"(z) : "memory");
      asm volatile("global_store_short %0, %1, off" :: "v"((const unsigned char*)(obu + (size_t)(48) * orow + 0) + ooff), "v"(z) : "memory");
      asm volatile("global_store_short %0, %1, off" :: "v"((const unsigned char*)(obu + (size_t)(49) * orow + 0) + ooff), "v"(z) : "memory");
      asm volatile("global_store_short %0, %1, off" :: "v"((const unsigned char*)(obu + (size_t)(50) * orow + 0) + ooff), "v"(z) : "memory");
      asm volatile("global_store_short %0, %1, off" :: "v"((const unsigned char*)(obu + (size_t)(51) * orow + 0) + ooff), "v"(z) : "memory");
      asm volatile("global_store_short %0, %1, off" :: "v"((const unsigned char*)(obu + (size_t)(0) * orow + 32) + ooff), "v"(z) : "memory");
      asm volatile("global_store_short %0, %1, off" :: "v"((const unsigned char*)(obu + (size_t)(1) * orow + 32) + ooff), "v"(z) : "memory");
      asm volatile("global_store_short %0, %1, off" :: "v"((const unsigned char*)(obu + (size_t)(2) * orow + 32) + ooff), "v"(z) : "memory");
      asm volatile("global_store_short %0, %1, off" :: "v"((const unsigned char*)(obu + (size_t)(3) * orow + 32) + ooff), "v"(z) : "memory");
      asm volatile("global_store_short %0, %1, off" :: "v"((const unsigned char*)(obu + (size_t)(16) * orow + 32) + ooff), "v"(z) : "memory");
      asm volatile("global_store_short %0, %1, off" :: "v"((const unsigned char*)(obu + (size_t)(17) * orow + 32) + ooff), "v"(z) : "memory");
      asm volatile("global_store_short %0, %1, off" :: "v"((const unsigned char*)(obu + (size_t)(18) * orow + 32) + ooff), "v"(z) : "memory");
      asm volatile("global_store_short %0, %1, off" :: "v"((const unsigned char*)(obu + (size_t)(19) * orow + 32) + ooff), "v"(z) : "memory");
      asm volatile("global_store_short %0, %1, off" :: "v"((const unsigned char*)(obu + (size_t)(32) * orow + 32) + ooff), "v"(z) : "memory");
      asm volatile("global_store_short %0, %1, off" :: "v"((const unsigned char*)(obu + (size_t)(33) * orow + 32) + ooff), "v"(z) : "memory");
      asm volatile("global_store_short %0, %1, off" :: "v"((const unsigned char*)(obu + (size_t)(34) * orow + 32) + ooff), "v"(z) : "memory");
      asm volatile("global_store_short %0, %1, off" :: "v"((const unsigned char*)(obu + (size_t)(35) * orow + 32) + ooff), "v"(z) : "memory");
      asm volatile("global_store_short %0, %1, off" :: "v"((const unsigned char*)(obu + (size_t)(48) * orow + 32) + ooff), "v"(z) : "memory");
      asm volatile("global_store_short %0, %1, off" :: "v"((const unsigned char*)(obu + (size_t)(49) * orow + 32) + ooff), "v"(z) : "memory");
      asm volatile("global_store_short %0, %1, off" :: "v"((const unsigned char*)(obu + (size_t)(50) * orow + 32) + ooff), "v"(z) : "memory");
      asm volatile("global_store_short %0, %1, off" :: "v"((const unsigned char*)(obu + (size_t)(51) * orow + 32) + ooff), "v"(z) : "memory");
    }
#pragma unroll 1
    for (int n = 0; n < NCH; ++n) {
        { unsigned sp_ = 0; while (*(volatile LAS unsigned*)(xl + XL_CNT) <= (unsigned)n) { __builtin_amdgcn_s_sleep(1); if (++sp_ > (1u << 22)) break; } }
        bf16x8 Sp0_0, Sp0_1, Sp0_2, Sp0_3, vp0_0, vp0_1;
        bf16x8 Sp1_0, Sp1_1, Sp1_2, Sp1_3, vp1_0, vp1_1;
        { const LAS bf16x8* sl_ = (const LAS bf16x8*)(xl + (n & 1) * XL_SLOT) + lane; Sp0_0 = sl_[0]; Sp0_1 = sl_[64]; Sp0_2 = sl_[128]; Sp0_3 = sl_[192]; vp0_0 = sl_[256]; vp0_1 = sl_[320]; Sp1_0 = sl_[384]; Sp1_1 = sl_[448]; Sp1_2 = sl_[512]; Sp1_3 = sl_[576]; vp1_0 = sl_[640]; vp1_1 = sl_[704]; }
        asm volatile("s_waitcnt lgkmcnt(0)" ::: "memory");
        if (lane == 0) *(volatile LAS unsigned*)(xl + XL_CNT + 64) = (unsigned)(n + 1);
        f32x4 o0_0 = {0.f, 0.f, 0.f, 0.f}, o0_1 = o0_0, o0_2 = o0_0, o0_3 = o0_0;
        f32x4 o1_0 = {0.f, 0.f, 0.f, 0.f}, o1_1 = o1_0, o1_2 = o1_0, o1_3 = o1_0;
        asm volatile("s_waitcnt vmcnt(55)" : "+v"(r0));
        o0_0 = mfma16(r0, Sp0_0, o0_0);
        o1_0 = mfma16(r0, Sp1_0, o1_0);
        asm volatile("global_load_dwordx4 %0, %1, off" : "+v"(r0) : "v"((const unsigned char*)(sp0 + ((size_t)(n + 1) * 40 + 0) * 1024) + voff) : "memory");
        __builtin_amdgcn_sched_barrier(0);
        asm volatile("s_waitcnt vmcnt(55)" : "+v"(r1));
        o0_0 = mfma16(r1, Sp0_1, o0_0);
        o1_0 = mfma16(r1, Sp1_1, o1_0);
        asm volatile("global_load_dwordx4 %0, %1, off" : "+v"(r1) : "v"((const unsigned char*)(sp0 + ((size_t)(n + 1) * 40 + 1) * 1024) + voff) : "memory");
        __builtin_amdgcn_sched_barrier(0);
        asm volatile("s_waitcnt vmcnt(55)" : "+v"(r2));
        o0_0 = mfma16(r2, Sp0_2, o0_0);
        o1_0 = mfma16(r2, Sp1_2, o1_0);
        asm volatile("global_load_dwordx4 %0, %1, off" : "+v"(r2) : "v"((const unsigned char*)(sp0 + ((size_t)(n + 1) * 40 + 2) * 1024) + voff) : "memory");
        __builtin_amdgcn_sched_barrier(0);
        asm volatile("s_waitcnt vmcnt(55)" : "+v"(r3));
        o0_0 = mfma16(r3, Sp0_3, o0_0);
        o1_0 = mfma16(r3, Sp1_3, o1_0);
        asm volatile("global_load_dwordx4 %0, %1, off" : "+v"(r3) : "v"((const unsigned char*)(sp0 + ((size_t)(n + 1) * 40 + 3) * 1024) + voff) : "memory");
        __builtin_amdgcn_sched_barrier(0);
        asm volatile("s_waitcnt vmcnt(55)" : "+v"(r4));
        o0_1 = mfma16(r4, Sp0_0, o0_1);
        o1_1 = mfma16(r4, Sp1_0, o1_1);
        asm volatile("global_load_dwordx4 %0, %1, off" : "+v"(r4) : "v"((const unsigned char*)(sp0 + ((size_t)(n + 1) * 40 + 4) * 1024) + voff) : "memory");
        __builtin_amdgcn_sched_barrier(0);
        asm volatile("s_waitcnt vmcnt(55)" : "+v"(r5));
        o0_1 = mfma16(r5, Sp0_1, o0_1);
        o1_1 = mfma16(r5, Sp1_1, o1_1);
        asm volatile("global_load_dwordx4 %0, %1, off" : "+v"(r5) : "v"((const unsigned char*)(sp0 + ((size_t)(n + 1) * 40 + 5) * 1024) + voff) : "memory");
        __builtin_amdgcn_sched_barrier(0);
        asm volatile("s_waitcnt vmcnt(55)" : "+v"(r6));
        o0_1 = mfma16(r6, Sp0_2, o0_1);
        o1_1 = mfma16(r6, Sp1_2, o1_1);
        asm volatile("global_load_dwordx4 %0, %1, off" : "+v"(r6) : "v"((const unsigned char*)(sp0 + ((size_t)(n + 1) * 40 + 6) * 1024) + voff) : "memory");
        __builtin_amdgcn_sched_barrier(0);
        asm volatile("s_waitcnt vmcnt(55)" : "+v"(r7));
        o0_1 = mfma16(r7, Sp0_3, o0_1);
        o1_1 = mfma16(r7, Sp1_3, o1_1);
        asm volatile("global_load_dwordx4 %0, %1, off" : "+v"(r7) : "v"((const unsigned char*)(sp0 + ((size_t)(n + 1) * 40 + 7) * 1024) + voff) : "memory");
        __builtin_amdgcn_sched_barrier(0);
        asm volatile("s_waitcnt vmcnt(55)" : "+v"(r8));
        o0_2 = mfma16(r8, Sp0_0, o0_2);
        o1_2 = mfma16(r8, Sp1_0, o1_2);
        asm volatile("global_load_dwordx4 %0, %1, off" : "+v"(r8) : "v"((const unsigned char*)(sp0 + ((size_t)(n + 1) * 40 + 8) * 1024) + voff) : "memory");
        __builtin_amdgcn_sched_barrier(0);
        asm volatile("s_waitcnt vmcnt(55)" : "+v"(r9));
        o0_2 = mfma16(r9, Sp0_1, o0_2);
        o1_2 = mfma16(r9, Sp1_1, o1_2);
        asm volatile("global_load_dwordx4 %0, %1, off" : "+v"(r9) : "v"((const unsigned char*)(sp0 + ((size_t)(n + 1) * 40 + 9) * 1024) + voff) : "memory");
        __builtin_amdgcn_sched_barrier(0);
        asm volatile("s_waitcnt vmcnt(55)" : "+v"(r10));
        o0_2 = mfma16(r10, Sp0_2, o0_2);
        o1_2 = mfma16(r10, Sp1_2, o1_2);
        asm volatile("global_load_dwordx4 %0, %1, off" : "+v"(r10) : "v"((const unsigned char*)(sp0 + ((size_t)(n + 1) * 40 + 10) * 1024) + voff) : "memory");
        __builtin_amdgcn_sched_barrier(0);
        asm volatile("s_waitcnt vmcnt(55)" : "+v"(r11));
        o0_2 = mfma16(r11, Sp0_3, o0_2);
        o1_2 = mfma16(r11, Sp1_3, o1_2);
        asm volatile("global_load_dwordx4 %0, %1, off" : "+v"(r11) : "v"((const unsigned char*)(sp0 + ((size_t)(n + 1) * 40 + 11) * 1024) + voff) : "memory");
        __builtin_amdgcn_sched_barrier(0);
        asm volatile("s_waitcnt vmcnt(55)" : "+v"(r12));
        o0_3 = mfma16(r12, Sp0_0, o0_3);
        o1_3 = mfma16(r12, Sp1_0, o1_3);
        asm volatile("global_load_dwordx4 %0, %1, off" : "+v"(r12) : "v"((const unsigned char*)(sp0 + ((size_t)(n + 1) * 40 + 12) * 1024) + voff) : "memory");
        __builtin_amdgcn_sched_barrier(0);
        asm volatile("s_waitcnt vmcnt(55)" : "+v"(r13));
        o0_3 = mfma16(r13, Sp0_1, o0_3);
        o1_3 = mfma16(r13, Sp1_1, o1_3);
        asm volatile("global_load_dwordx4 %0, %1, off" : "+v"(r13) : "v"((const unsigned char*)(sp0 + ((size_t)(n + 1) * 40 + 13) * 1024) + voff) : "memory");
        __builtin_amdgcn_sched_barrier(0);
        asm volatile("s_waitcnt vmcnt(55)" : "+v"(r14));
        o0_3 = mfma16(r14, Sp0_2, o0_3);
        o1_3 = mfma16(r14, Sp1_2, o1_3);
        asm volatile("global_load_dwordx4 %0, %1, off" : "+v"(r14) : "v"((const unsigned char*)(sp0 + ((size_t)(n + 1) * 40 + 14) * 1024) + voff) : "memory");
        __builtin_amdgcn_sched_barrier(0);
        asm volatile("s_waitcnt vmcnt(55)" : "+v"(r15));
        o0_3 = mfma16(r15, Sp0_3, o0_3);
        o1_3 = mfma16(r15, Sp1_3, o1_3);
        asm volatile("global_load_dwordx4 %0, %1, off" : "+v"(r15) : "v"((const unsigned char*)(sp0 + ((size_t)(n + 1) * 40 + 15) * 1024) + voff) : "memory");
        __builtin_amdgcn_sched_barrier(0);
        asm volatile("s_waitcnt vmcnt(55)" : "+v"(r16));
        o0_0 = mfma16(r16, vp0_0, o0_0);
        o1_0 = mfma16(r16, vp1_0, o1_0);
        asm volatile("global_load_dwordx4 %0, %1, off" : "+v"(r16) : "v"((const unsigned char*)(sp0 + ((size_t)(n + 1) * 40 + 16) * 1024) + voff) : "memory");
        __builtin_amdgcn_sched_barrier(0);
        asm volatile("s_waitcnt vmcnt(55)" : "+v"(r17));
        o0_0 = mfma16(r17, vp0_1, o0_0);
        o1_0 = mfma16(r17, vp1_1, o1_0);
        asm volatile("global_load_dwordx4 %0, %1, off" : "+v"(r17) : "v"((const unsigned char*)(sp0 + ((size_t)(n + 1) * 40 + 17) * 1024) + voff) : "memory");
        __builtin_amdgcn_sched_barrier(0);
        asm volatile("s_waitcnt vmcnt(55)" : "+v"(r18));
        o0_1 = mfma16(r18, vp0_0, o0_1);
        o1_1 = mfma16(r18, vp1_0, o1_1);
        asm volatile("global_load_dwordx4 %0, %1, off" : "+v"(r18) : "v"((const unsigned char*)(sp0 + ((size_t)(n + 1) * 40 + 18) * 1024) + voff) : "memory");
        __builtin_amdgcn_sched_barrier(0);
        asm volatile("s_waitcnt vmcnt(55)" : "+v"(r19));
        o0_1 = mfma16(r19, vp0_1, o0_1);
        o1_1 = mfma16(r19, vp1_1, o1_1);
        asm volatile("global_load_dwordx4 %0, %1, off" : "+v"(r19) : "v"((const unsigned char*)(sp0 + ((size_t)(n + 1) * 40 + 19) * 1024) + voff) : "memory");
        __builtin_amdgcn_sched_barrier(0);
        asm volatile("s_waitcnt vmcnt(55)" : "+v"(r20));
        o0_2 = mfma16(r20, vp0_0, o0_2);
        o1_2 = mfma16(r20, vp1_0, o1_2);
        asm volatile("global_load_dwordx4 %0, %1, off" : "+v"(r20) : "v"((const unsigned char*)(sp0 + ((size_t)(n + 1) * 40 + 20) * 1024) + voff) : "memory");
        __builtin_amdgcn_sched_barrier(0);
        asm volatile("s_waitcnt vmcnt(55)" : "+v"(r21));
        o0_2 = mfma16(r21, vp0_1, o0_2);
        o1_2 = mfma16(r21, vp1_1, o1_2);
        asm volatile("global_load_dwordx4 %0, %1, off" : "+v"(r21) : "v"((const unsigned char*)(sp0 + ((size_t)(n + 1) * 40 + 21) * 1024) + voff) : "memory");
        __builtin_amdgcn_sched_barrier(0);
        asm volatile("s_waitcnt vmcnt(55)" : "+v"(r22));
        o0_3 = mfma16(r22, vp0_0, o0_3);
        o1_3 = mfma16(r22, vp1_0, o1_3);
        asm volatile("global_load_dwordx4 %0, %1, off" : "+v"(r22) : "v"((const unsigned char*)(sp0 + ((size_t)(n + 1) * 40 + 22) * 1024) + voff) : "memory");
        __builtin_amdgcn_sched_barrier(0);
        asm volatile("s_waitcnt vmcnt(55)" : "+v"(r23));
        o0_3 = mfma16(r23, vp0_1, o0_3);
        o1_3 = mfma16(r23, vp1_1, o1_3);
        asm volatile("global_load_dwordx4 %0, %1, off" : "+v"(r23) : "v"((const unsigned char*)(sp0 + ((size_t)(n + 1) * 40 + 23) * 1024) + voff) : "memory");
        __builtin_amdgcn_sched_barrier(0);
        { const unsigned char* obn = obu + (size_t)n * 64 * orow;
          { const unsigned v = f2bf(o0_0[0]); asm volatile("global_store_short %0, %1, off" :: "v"((const unsigned char*)(obn + (size_t)(0) * orow + 0) + ooff), "v"(v) : "memory"); }
          { const unsigned v = f2bf(o0_0[1]); asm volatile("global_store_short %0, %1, off" :: "v"((const unsigned char*)(obn + (size_t)(1) * orow + 0) + ooff), "v"(v) : "memory"); }
          { const unsigned v = f2bf(o0_0[2]); asm volatile("global_store_short %0, %1, off" :: "v"((const unsigned char*)(obn + (size_t)(2) * orow + 0) + ooff), "v"(v) : "memory"); }
          { const unsigned v = f2bf(o0_0[3]); asm volatile("global_store_short %0, %1, off" :: "v"((const unsigned char*)(obn + (size_t)(3) * orow + 0) + ooff), "v"(v) : "memory"); }
          { const unsigned v = f2bf(o0_1[0]); asm volatile("global_store_short %0, %1, off" :: "v"((const unsigned char*)(obn + (size_t)(16) * orow + 0) + ooff), "v"(v) : "memory"); }
          { const unsigned v = f2bf(o0_1[1]); asm volatile("global_store_short %0, %1, off" :: "v"((const unsigned char*)(obn + (size_t)(17) * orow + 0) + ooff), "v"(v) : "memory"); }
          { const unsigned v = f2bf(o0_1[2]); asm volatile("global_store_short %0, %1, off" :: "v"((const unsigned char*)(obn + (size_t)(18) * orow + 0) + ooff), "v"(v) : "memory"); }
          { const unsigned v = f2bf(o0_1[3]); asm volatile("global_store_short %0, %1, off" :: "v"((const unsigned char*)(obn + (size_t)(19) * orow + 0) + ooff), "v"(v) : "memory"); }
          { const unsigned v = f2bf(o0_2[0]); asm volatile("global_store_short %0, %1, off" :: "v"((const unsigned char*)(obn + (size_t)(32) * orow + 0) + ooff), "v"(v) : "memory"); }
          { const unsigned v = f2bf(o0_2[1]); asm volatile("global_store_short %0, %1, off" :: "v"((const unsigned char*)(obn + (size_t)(33) * orow + 0) + ooff), "v"(v) : "memory"); }
          { const unsigned v = f2bf(o0_2[2]); asm volatile("global_store_short %0, %1, off" :: "v"((const unsigned char*)(obn + (size_t)(34) * orow + 0) + ooff), "v"(v) : "memory"); }
          { const unsigned v = f2bf(o0_2[3]); asm volatile("global_store_short %0, %1, off" :: "v"((const unsigned char*)(obn + (size_t)(35) * orow + 0) + ooff), "v"(v) : "memory"); }
          { const unsigned v = f2bf(o0_3[0]); asm volatile("global_store_short %0, %1, off" :: "v"((const unsigned char*)(obn + (size_t)(48) * orow + 0) + ooff), "v"(v) : "memory"); }
          { const unsigned v = f2bf(o0_3[1]); asm volatile("global_store_short %0, %1, off" :: "v"((const unsigned char*)(obn + (size_t)(49) * orow + 0) + ooff), "v"(v) : "memory"); }
          { const unsigned v = f2bf(o0_3[2]); asm volatile("global_store_short %0, %1, off" :: "v"((const unsigned char*)(obn + (size_t)(50) * orow + 0) + ooff), "v"(v) : "memory"); }
          { const unsigned v = f2bf(o0_3[3]); asm volatile("global_store_short %0, %1, off" :: "v"((const unsigned char*)(obn + (size_t)(51) * orow + 0) + ooff), "v"(v) : "memory"); }
          { const unsigned v = f2bf(o1_0[0]); asm volatile("global_store_short %0, %1, off" :: "v"((const unsigned char*)(obn + (size_t)(0) * orow + 32) + ooff), "v"(v) : "memory"); }
          { const unsigned v = f2bf(o1_0[1]); asm volatile("global_store_short %0, %1, off" :: "v"((const unsigned char*)(obn + (size_t)(1) * orow + 32) + ooff), "v"(v) : "memory"); }
          { const unsigned v = f2bf(o1_0[2]); asm volatile("global_store_short %0, %1, off" :: "v"((const unsigned char*)(obn + (size_t)(2) * orow + 32) + ooff), "v"(v) : "memory"); }
          { const unsigned v = f2bf(o1_0[3]); asm volatile("global_store_short %0, %1, off" :: "v"((const unsigned char*)(obn + (size_t)(3) * orow + 32) + ooff), "v"(v) : "memory"); }
          { const unsigned v = f2bf(o1_1[0]); asm volatile("global_store_short %0, %1, off" :: "v"((const unsigned char*)(obn + (size_t)(16) * orow + 32) + ooff), "v"(v) : "memory"); }
          { const unsigned v = f2bf(o1_1[1]); asm volatile("global_store_short %0, %1, off" :: "v"((const unsigned char*)(obn + (size_t)(17) * orow + 32) + ooff), "v"(v) : "memory"); }
          { const unsigned v = f2bf(o1_1[2]); asm volatile("global_store_short %0, %1, off" :: "v"((const unsigned char*)(obn + (size_t)(18) * orow + 32) + ooff), "v"(v) : "memory"); }
          { const unsigned v = f2bf(o1_1[3]); asm volatile("global_store_short %0, %1, off" :: "v"((const unsigned char*)(obn + (size_t)(19) * orow + 32) + ooff), "v"(v) : "memory"); }
          { const unsigned v = f2bf(o1_2[0]); asm volatile("global_store_short %0, %1, off" :: "v"((const unsigned char*)(obn + (size_t)(32) * orow + 32) + ooff), "v"(v) : "memory"); }
          { const unsigned v = f2bf(o1_2[1]); asm volatile("global_store_short %0, %1, off" :: "v"((const unsigned char*)(obn + (size_t)(33) * orow + 32) + ooff), "v"(v) : "memory"); }
          { const unsigned v = f2bf(o1_2[2]); asm volatile("global_store_short %0, %1, off" :: "v"((const unsigned char*)(obn + (size_t)(34) * orow + 32) + ooff), "v"(v) : "memory"); }
          { const unsigned v = f2bf(o1_2[3]); asm volatile("global_store_short %0, %1, off" :: "v"((const unsigned char*)(obn + (size_t)(35) * orow + 32) + ooff), "v"(v) : "memory"); }
          { const unsigned v = f2bf(o1_3[0]); asm volatile("global_store_short %0, %1, off" :: "v"((const unsigned char*)(obn + (size_t)(48) * orow + 32) + ooff), "v"(v) : "memory"); }
          { const unsigned v = f2bf(o1_3[1]); asm volatile("global_store_short %0, %1, off" :: "v"((const unsigned char*)(obn + (size_t)(49) * orow + 32) + ooff), "v"(v) : "memory"); }
          { const unsigned v = f2bf(o1_3[2]); asm volatile("global_store_short %0, %1, off" :: "v"((const unsigned char*)(obn + (size_t)(50) * orow + 32) + ooff), "v"(v) : "memory"); }
          { const unsigned v = f2bf(o1_3[3]); asm volatile("global_store_short %0, %1, off" :: "v"((const unsigned char*)(obn + (size_t)(51) * orow + 32) + ooff), "v"(v) : "memory"); }
        }
        __builtin_amdgcn_sched_barrier(0);
    }
    asm volatile("s_waitcnt vmcnt(0)" ::: "memory");
    }
}

DI void mix_load(u32x4 (&ro)[8], u32x4 (&gt)[8], const bf16_t* pj, const bf16_t* vc, const bf16_t* rr, int m, int l32, int hh) {
    const bf16_t* row = pj + (size_t)m * PJW;
#pragma unroll
    for (int q = 0; q < 8; ++q) { const int hv = 2 * q + hh, hd = hv & 7; const bool gdn = hv >= 8;
        ro[q] = *(const u32x4*)((gdn ? vc : rr) + (size_t)m * 2048 + hd * 256 + 8 * l32);
        gt[q] = *(const u32x4*)(row + (gdn ? C_GZ : C_RG) + hd * 256 + 8 * l32); }
}
DI void mix_compute(const u32x4 (&ro)[8], const u32x4 (&gt)[8], bf16_t* pj, int m, int l32, int hh, const f32x4& gr0, const f32x4& gr1, const f32x4& gg0, const f32x4& gg1) {
    bf16_t* row = pj + (size_t)m * PJW;
#pragma unroll
    for (int q = 0; q < 8; ++q) { const int hv = 2 * q + hh, hd = hv & 7; const bool gdn = q >= 4;
        float o[8] = {bflo(ro[q].x), bfhi(ro[q].x), bflo(ro[q].y), bfhi(ro[q].y), bflo(ro[q].z), bfhi(ro[q].z), bflo(ro[q].w), bfhi(ro[q].w)};
        float gv[8] = {bflo(gt[q].x), bfhi(gt[q].x), bflo(gt[q].y), bfhi(gt[q].y), bflo(gt[q].z), bfhi(gt[q].z), bflo(gt[q].w), bfhi(gt[q].w)};
        float ss = 0.f;
#pragma unroll
        for (int e = 0; e < 8; ++e) ss += o[e] * o[e];
        ss = sum16_dpp(ss); ss += __shfl_xor(ss, 16);
        const float rstd = __builtin_amdgcn_rsqf(ss * (1.0f / 256.0f) + EPS);
        const f32x4 g0 = gdn ? gg0 : gr0, g1 = gdn ? gg1 : gr1;
        u32x4 w; w.x = pk2(o[0] * rstd * g0.x * siluf_r(gv[0]), o[1] * rstd * g0.y * siluf_r(gv[1])); w.y = pk2(o[2] * rstd * g0.z * siluf_r(gv[2]), o[3] * rstd * g0.w * siluf_r(gv[3]));
        w.z = pk2(o[4] * rstd * g1.x * siluf_r(gv[4]), o[5] * rstd * g1.y * siluf_r(gv[5])); w.w = pk2(o[6] * rstd * g1.z * siluf_r(gv[6]), o[7] * rstd * g1.w * siluf_r(gv[7]));
        *(u32x4*)(row + (gdn ? C_GZ : C_RG) + hd * 256 + 8 * l32) = w; __builtin_amdgcn_sched_barrier(0); }
}
DI void p4_mixnorm(Frame& F, const float* ret_norm, const float* gdn_norm) {
    bf16_t* pj = (bf16_t*)(F.ws + WS_BIG + BIG_PJ); const bf16_t* vc = (const bf16_t*)(F.ws + AUX_VC); const bf16_t* rr = (const bf16_t*)(F.ws + AUX_QN);
    const int lane = F.lane, l32 = lane & 31, hh = lane >> 5;
    const f32x4 gr0 = *(const f32x4*)(ret_norm + 8 * l32), gr1 = *(const f32x4*)(ret_norm + 8 * l32 + 4), gg0 = *(const f32x4*)(gdn_norm + 8 * l32), gg1 = *(const f32x4*)(gdn_norm + 8 * l32 + 4);
    u32x4 roa[8], gta[8], rob[8], gtb[8];
    int m = F.gw;
    if (m < NTOK) mix_load(roa, gta, pj, vc, rr, m, l32, hh);
    for (; m < NTOK; m += 2 * F.NGW) {
        const int m1 = m + F.NGW, m2 = m + 2 * F.NGW;
        if (m1 < NTOK) mix_load(rob, gtb, pj, vc, rr, m1, l32, hh);
        asm volatile("" ::: "memory");
        mix_compute(roa, gta, pj, m, l32, hh, gr0, gr1, gg0, gg1);
        asm volatile("" ::: "memory");
        if (m2 < NTOK) mix_load(roa, gta, pj, vc, rr, m2, l32, hh);
        asm volatile("" ::: "memory");
        if (m1 < NTOK) mix_compute(rob, gtb, pj, m1, l32, hh, gr0, gr1, gg0, gg1);
        asm volatile("" ::: "memory");
    }
}
DI void swp_load(u32x4 (&x)[5], f32x4 (&c)[4], const bf16_t* qkv, const f32x2* cs32, int m, int lane) {
    const f32x4* cp = (const f32x4*)(cs32 + (size_t)(m & (SEQ - 1)) * 32 + 8 * (lane & 3));
    c[0] = cp[0]; c[1] = cp[1]; c[2] = cp[2]; c[3] = cp[3];
    const bf16_t* row = qkv + (size_t)m * ODD_IN;
#pragma unroll
    for (int i = 0; i < 5; ++i) { x[i] = (u32x4){0u, 0u, 0u, 0u}; if (i < 4 || lane < 32) x[i] = *(const u32x4*)(row + i * 512 + 8 * lane); }
}
DI void swp_compute(const u32x4 (&x)[5], const f32x4 (&c)[4], bf16_t* qkv, int m, int lane, const f32x4& gq0, const f32x4& gq1, const f32x4& gk0, const f32x4& gk1, float sg) {
    bf16_t* row = qkv + (size_t)m * ODD_IN;
    const f32x4 c0 = c[0], c1 = c[1], c2 = c[2], c3 = c[3];
#pragma unroll
    for (int i = 0; i < 5; ++i) {
        float v[8] = {bflo(x[i].x), bfhi(x[i].x), bflo(x[i].y), bfhi(x[i].y), bflo(x[i].z), bfhi(x[i].z), bflo(x[i].w), bfhi(x[i].w)};
        float ss = 0.f;
#pragma unroll
        for (int e = 0; e < 8; ++e) ss += v[e] * v[e];
        ss = sum8_dpp(ss);
        const float rstd = __builtin_amdgcn_rsqf(ss * (1.0f / 64.0f) + EPS);
        const f32x4 g0 = i < 4 ? gq0 : gk0, g1 = i < 4 ? gq1 : gk1;
        v[0] *= rstd * g0.x; v[1] *= rstd * g0.y; v[2] *= rstd * g0.z; v[3] *= rstd * g0.w; v[4] *= rstd * g1.x; v[5] *= rstd * g1.y; v[6] *= rstd * g1.z; v[7] *= rstd * g1.w;
        float p[8];
#pragma unroll
        for (int e = 0; e < 8; ++e) p[e] = __shfl_xor(v[e], 4);
        u32x4 o;
        o.x = pk2(v[0] * c0.x + sg * p[0] * c0.y, v[1] * c0.z + sg * p[1] * c0.w); o.y = pk2(v[2] * c1.x + sg * p[2] * c1.y, v[3] * c1.z + sg * p[3] * c1.w);
        o.z = pk2(v[4] * c2.x + sg * p[4] * c2.y, v[5] * c2.z + sg * p[5] * c2.w); o.w = pk2(v[6] * c3.x + sg * p[6] * c3.y, v[7] * c3.z + sg * p[7] * c3.w);
        if (i < 4 || lane < 32) *(u32x4*)(row + i * 512 + 8 * lane) = o; }
}
DI void p11_swaprep(Frame& F, const float* qnorm, const float* knorm) {
    bf16_t* qkv = (bf16_t*)(F.ws + WS_BIG + BIG_QKV1); const f32x2* cs32 = (const f32x2*)(F.ws + AUX_CS32);
    const int lane = F.lane, l8 = lane & 7;
    const f32x4 gq0 = *(const f32x4*)(qnorm + 8 * l8), gq1 = *(const f32x4*)(qnorm + 8 * l8 + 4), gk0 = *(const f32x4*)(knorm + 8 * l8), gk1 = *(const f32x4*)(knorm + 8 * l8 + 4);
    const float sg = (l8 < 4) ? -1.f : 1.f;
    u32x4 xa[5], xb[5]; f32x4 ca[4], cb[4];
    int m = F.gw;
    if (m < NTOK) swp_load(xa, ca, qkv, cs32, m, lane);
    for (; m < NTOK; m += 2 * F.NGW) {
        const int m1 = m + F.NGW, m2 = m + 2 * F.NGW;
        if (m1 < NTOK) swp_load(xb, cb, qkv, cs32, m1, lane);
        asm volatile("" ::: "memory");
        swp_compute(xa, ca, qkv, m, lane, gq0, gq1, gk0, gk1, sg);
        asm volatile("" ::: "memory");
        if (m2 < NTOK) swp_load(xa, ca, qkv, cs32, m2, lane);
        asm volatile("" ::: "memory");
        if (m1 < NTOK) swp_compute(xb, cb, qkv, m1, lane, gq0, gq1, gk0, gk1, sg);
        asm volatile("" ::: "memory");
    }
}
typedef float f32x16 __attribute__((ext_vector_type(16)));
DI f32x16 mfma32(bf16x8 a, bf16x8 b, f32x16 c) { return __builtin_amdgcn_mfma_f32_32x32x16_bf16(a, b, c, 0, 0, 0); }
DI void swa_phase(Frame& F, const float* sinks) {
    constexpr int KP = 144;
    bf16_t* qkv = (bf16_t*)(F.ws + WS_BIG + BIG_QKV1);
    LAS unsigned char* Ks = F.lds; LAS unsigned char* Vs = F.lds + 256 * KP;
    const unsigned vs_addr = (unsigned)(size_t)Vs;
    const int lane = F.lane, w = F.wave, h = lane >> 5, ql = lane & 31, q4 = (lane & 15) >> 2, p4 = lane & 3, blk = (lane >> 4) & 1;
    bf16x8 Qn[4];
    if (blockIdx.x < 1024) { const int u0 = blockIdx.x; const size_t t0 = (size_t)(u0 >> 9) * SEQ + (size_t)(u0 & 127) * 128; const bf16_t* q0 = qkv + (t0 + ql) * ODD_IN + (((u0 >> 7) & 3) * 8 + w) * 64;
#pragma unroll
        for (int s2 = 0; s2 < 4; ++s2) Qn[s2] = *(const bf16x8*)(q0 + 16 * s2 + 8 * h); }
    u32x4 kr[4], vr[4];
#define SWA_KV_LOAD(U) do { const int u_ = (U), qb_ = u_ & 127; const size_t t0_ = (size_t)(u_ >> 9) * SEQ + (size_t)qb_ * 128; _Pragma("unroll") for (int i = 0; i < 4; ++i) { const int pc = F.tid + 512 * i, row = pc >> 3, c = pc & 7; \
        const size_t tok = (qb_ == 0 && row < 128) ? t0_ : t0_ - 128 + row; const bf16_t* src = qkv + tok * ODD_IN + 2048 + ((u_ >> 7) & 3) * 64 + c * 8; kr[i] = *(const u32x4*)src; vr[i] = *(const u32x4*)(src + 256); } } while (0)
    if (blockIdx.x < 1024) SWA_KV_LOAD(blockIdx.x);
    for (int unit = blockIdx.x; unit < 1024; unit += F.G) {
        const int b = unit >> 9, kvh = (unit >> 7) & 3, qb = unit & 127;
        const size_t tok0 = (size_t)b * SEQ + (size_t)qb * 128;
        __syncthreads();
#pragma unroll
        for (int i = 0; i < 4; ++i) { const int pc = F.tid + 512 * i, row = pc >> 3, c = pc & 7; *(LAS u32x4*)(Ks + row * KP + c * 16) = kr[i]; *(LAS u32x4*)(Vs + row * KP + c * 16) = vr[i]; }
        __syncthreads();
        if (unit + F.G < 1024) SWA_KV_LOAD(unit + F.G);
        const int hq = kvh * 8 + w; const float sink = sinks[hq];
#pragma unroll 1
        for (int t = 0; t < 4; ++t) {
            bf16x8 Qf[4];
#pragma unroll
            for (int s2 = 0; s2 < 4; ++s2) Qf[s2] = Qn[s2];
            { const int un = unit + F.G; const bool nu = (t == 3);
              if (!nu || un < 1024) { const size_t tn = nu ? (size_t)(un >> 9) * SEQ + (size_t)(un & 127) * 128 : tok0 + 32 * (t + 1); const int hn = nu ? ((un >> 7) & 3) * 8 + w : hq;
                const bf16_t* qn = qkv + (tn + ql) * ODD_IN + hn * 64;
#pragma unroll
                for (int s2 = 0; s2 < 4; ++s2) Qn[s2] = *(const bf16x8*)(qn + 16 * s2 + 8 * h); } }
            f32x16 sc[5];
#pragma unroll
            for (int kt = 0; kt < 5; ++kt) {
#pragma unroll
                for (int r = 0; r < 16; ++r) sc[kt][r] = 0.f;
#pragma unroll
                for (int s2 = 0; s2 < 4; ++s2) { const bf16x8 a = *(const LAS bf16x8*)(Ks + (32 * (t + kt) + ql) * KP + (16 * s2 + 8 * h) * 2); sc[kt] = mfma32(a, Qf[s2], sc[kt]); } }
            constexpr float SC2 = 0.125f * 1.4426950408889634f;
            const float sink2 = sink * 1.4426950408889634f;
            float mr = -3.0e38f;
#pragma unroll
            for (int kt = 0; kt < 5; ++kt) { const bool tile_ok = !(qb == 0 && t + kt < 4);
                if (kt == 0 || kt == 4 || !tile_ok) {
#pragma unroll
                    for (int r = 0; r < 16; ++r) { const int keyrow = (r & 3) + 8 * (r >> 2) + 4 * h; bool ok = tile_ok; if (kt == 0) ok = ok && (keyrow > ql); if (kt == 4) ok = ok && (keyrow <= ql);
                        sc[kt][r] = ok ? sc[kt][r] : -1.0e30f; } }
#pragma unroll
                for (int r = 0; r < 16; ++r) mr = fmaxf(mr, sc[kt][r]); }
            float m = fmaxf(sink2, mr * SC2);
            m = fmaxf(m, __shfl_xor(m, 32));
            float l = 0.f;
#pragma unroll
            for (int kt = 0; kt < 5; ++kt)
#pragma unroll
                for (int r = 0; r < 16; ++r) { const float p = __builtin_amdgcn_exp2f(__builtin_fmaf(sc[kt][r], SC2, -m)); sc[kt][r] = p; l += p; }
            l += __shfl_xor(l, 32);
            l += __builtin_amdgcn_exp2f(sink2 - m);
            f32x16 o0, o1;
#pragma unroll
            for (int r = 0; r < 16; ++r) { o0[r] = 0.f; o1[r] = 0.f; }
#pragma unroll
            for (int kt = 0; kt < 5; ++kt)
#pragma unroll
                for (int s2 = 0; s2 < 2; ++s2) { u32x4 pw; pw.x = pkbf(sc[kt][8 * s2], sc[kt][8 * s2 + 1]); pw.y = pkbf(sc[kt][8 * s2 + 2], sc[kt][8 * s2 + 3]); pw.z = pkbf(sc[kt][8 * s2 + 4], sc[kt][8 * s2 + 5]); pw.w = pkbf(sc[kt][8 * s2 + 6], sc[kt][8 * s2 + 7]);
                    const bf16x8 pb = __builtin_bit_cast(bf16x8, pw);
                    const unsigned ra = vs_addr + (unsigned)((32 * (t + kt) + 16 * s2 + 4 * h + q4) * KP + blk * 32 + p4 * 8);
                    s16x4 a00, a01, a10, a11; tr_read4(ra, ra + 8 * KP, ra + 64, ra + 8 * KP + 64, a00, a01, a10, a11);
                    o0 = mfma32(cat8(a00, a01), pb, o0); o1 = mfma32(cat8(a10, a11), pb, o1); }
            const float il = 1.0f / l;
            unsigned char* orow8 = F.ws + WS_H + (tok0 + 32 * t + ql) * D + hq * 64; const float il16 = il * 16.0f;
#pragma unroll
            for (int gq = 0; gq < 4; ++gq) { *(unsigned*)(orow8 + 8 * gq + 4 * h) = pk4fp8(o0[4 * gq] * il16, o0[4 * gq + 1] * il16, o0[4 * gq + 2] * il16, o0[4 * gq + 3] * il16);
                *(unsigned*)(orow8 + 32 + 8 * gq + 4 * h) = pk4fp8(o1[4 * gq] * il16, o1[4 * gq + 1] * il16, o1[4 * gq + 2] * il16, o1[4 * gq + 3] * il16); }
        }
    }
}
#undef SWA_KV_LOAD

struct NoHandler { DI void operator()(int, float) const {} };
DI void moe_tables(Frame& F, const unsigned* cntg) {
    LAS int* cnt = (LAS int*)(F.lds + TBL_OFF); LAS int* tb = cnt + 32;
    __syncthreads();
    if (F.wave == 0) {
        const int e = F.lane & 31; const int c = (int)__hip_atomic_load(cntg + e * CSTR, __ATOMIC_RELAXED, __HIP_MEMORY_SCOPE_AGENT); const int t = (c + 255) >> 8; int inc = t;
#pragma unroll
        for (int d = 1; d < 32; d <<= 1) { const int o = __shfl_up(inc, d); if (e >= d) inc += o; }
        if (F.lane < 32) { cnt[e] = c; tb[e] = inc - t; if (e == 31) tb[32] = inc; } }
    __syncthreads();
}

constexpr int NPH = 19;

struct Args { const float* in[20]; float* out; unsigned char* ws; int ph_lo, ph_hi; };
__global__ void __launch_bounds__(NTHR, 2) mk_fwd(Args args) {
    extern __shared__ __attribute__((aligned(16))) unsigned char lds[];
    Frame F;
    F.lds = (LAS unsigned char*)lds; F.tid = threadIdx.x; F.lane = F.tid & 63; F.wave = __builtin_amdgcn_readfirstlane(F.tid >> 6); F.G = gridDim.x;
    F.gw = blockIdx.x * NWAVES + F.wave; F.NGW = F.G * NWAVES; F.ws = args.ws; F.ctl = (unsigned*)(args.ws + WS_CTL);
    volatile LAS unsigned* MISC = (volatile LAS unsigned*)(F.lds + MISC_OFF);
    if (F.tid < 64) MISC[F.tid] = 0u;
    __syncthreads();
    XcdBarrier bar; bar.bar = F.ctl + CW_BAR; bar.x = 0; bar.st = nullptr;
    if (!MK_MULTI) bar = xcd_barrier_post(F.ctl + CW_BAR, MISC + 8);
    const int lo = args.ph_lo, hi = args.ph_hi;
#ifdef ONLY_PH
#define IN(k) ((k) == ONLY_PH && lo <= (k) && (k) < hi)
#else
#define IN(k) (lo <= (k) && (k) < hi)
#endif
#define SEAM(k) do { if (IN(k) && IN((k) + 1)) xcd_barrier(bar); } while (0)
    const float* const* in = args.in;
    float* XC = args.out;
    bf16_t* XC16 = (bf16_t*)(F.ws + AUX_QN);
    bf16_t* H = (bf16_t*)(F.ws + WS_H);
    bf16_t* PJ = (bf16_t*)(F.ws + WS_BIG + BIG_PJ);
    unsigned char* aux = F.ws;
    const LAS int* tbl_cnt = (const LAS int*)(F.lds + TBL_OFF); const LAS int* tbl_tb = tbl_cnt + 32;
    LAS unsigned* tokoff = (LAS unsigned*)(F.lds + TOK_OFF);

    enum { P_W = 0, P_N0, P_G0, P_PREP, P_GA, P_SCAN, P_MIX, P_O0, P_M0A, P_M0B, P_M0C, P_N1, P_G1, P_SPREP, P_SWA, P_O1, P_M1A, P_M1B, P_M1C, P_FIN };
    static_assert(P_FIN == NPH, "phase count");
    if (IN(P_W)) { p0_weights(F, in); __syncthreads(); }
    SEAM(P_W);
    if (IN(P_N0)) {
        normproj_pass<0>(F, in[0], in[1], (const bf16_t*)(aux + AUX_SW), (const bf16_t*)(aux + AUX_SW) + 112 * D, H, (float*)(aux + AUX_BG), in[6], in[7], nullptr, nullptr, nullptr, nullptr);
    }
    SEAM(P_N0);
    if (IN(P_G0)) {
        pg8::EpiBf16 E{PJ, PJW};
        { pg8::DenseOrderT<1> S; S.init(NTOK, 8192, D, D, (const bf16_t*)(F.ws + WS_WIN0), F.G, blockIdx.x);
          pg8::gemm_phase(F.lds, H, D, S, E); }
        __syncthreads();
        { pg8::DenseOrderT<2> S; S.init(NTOK, 4096, D, D, F.ws + AUX_WIN8, F.G, blockIdx.x, 1);
          pg8::gemm_phase<pg8::EpiBf16, pg8::DenseOrderT<2>, true, 0x7a7a7a7a, 0x7d7d7d7d>(F.lds, F.ws + AUX_H8, D, S, E); }
    }
    SEAM(P_G0);
    if (IN(P_PREP)) p2_prep(F, in[5]);
    SEAM(P_PREP);
    if (IN(P_GA)) {
        for (int u = F.gw; u < 16 * NCH; u += F.NGW) {
            ga_unit<true>(F, u, (unsigned char*)args.out, nullptr);
            ga_unit<false>(F, u, F.ws + AUX_W, nullptr);
        }
        __syncthreads();
    }
    SEAM(P_GA);
    if (IN(P_SCAN)) {
        for (int id = blockIdx.x; id < 256; id += F.G) { const int idl = id & 127, bh = (idl % 8) * 2 + (idl / 8) / 8, sl = 2 * ((idl / 8) % 8);
            __syncthreads();
            if (F.tid == 0) { *(volatile LAS unsigned*)(F.lds + XL_CNT) = 0u; *(volatile LAS unsigned*)(F.lds + XL_CNT + 64) = 0u; }
            __syncthreads();
            if (id < 128) { if (F.wave == 0) scan_wave<true, 0>(F, bh, sl, (const unsigned char*)args.out, F.lds); else if (F.wave == 1) scan_wave<true, 1>(F, bh, sl, (const unsigned char*)args.out, F.lds); }
            else { if (F.wave == 0) scan_wave<false, 0>(F, bh, sl, F.ws + AUX_W, F.lds); else if (F.wave == 1) scan_wave<false, 1>(F, bh, sl, F.ws + AUX_W, F.lds); } }
        if (F.wave >= 2) { const int widx = blockIdx.x * 6 + (F.wave - 2), nw = F.G * 6;
            p0_late(F, in, widx, nw);
            convert_experts(F, in, 0, nullptr, F.ws + WS_WIN0, widx, nw, false, true);
            convert_experts(F, in, 1, F.ws + WS_EXP1, F.ws + WS_EXP1 + 96 * MiB, widx, nw); }
        __syncthreads();
    }
    SEAM(P_SCAN);
    if (IN(P_MIX)) p4_mixnorm(F, in[4], in[8]);
    SEAM(P_MIX);
    if (IN(P_O0)) {
        pg8::DenseOrder S; S.init(NTOK, D, 4096, PJW, (const bf16_t*)(F.ws + WS_WOUT0), F.G, blockIdx.x);
        pg8::EpiRes16<false> E{in[0], XC16, D};
        pg8::gemm_phase(F.lds, PJ + C_RG, 4096, S, E);
    }
    SEAM(P_O0);
#define MOE_LAYER(P, L, CNTW)                                                                                                                  \
    if (IN(P)) {                                                            \
        if (L == 0) convert_experts(F, in, 0, F.ws + WS_BIG + BIG_EGU, nullptr, F.gw, F.NGW, true, false);     \
        __syncthreads();                                                                \
        normproj_pass1(F, XC16, in[2] + L * D, (const bf16_t*)(aux + AUX_SW) + (16 + L * 48) * D, (const bf16_t*)(aux + AUX_SW) + (112 + 16 + L * 48) * D, H, F.ctl + CNTW, (int*)(aux + AUX_LIST), (float*)(aux + AUX_GW), (unsigned*)(aux + AUX_ASG)); \
        __syncthreads();                                                                                                                       \
    }                                                                                                                                          \
    SEAM(P);                                                                                                                                   \
    if (IN(P + 1)) {                                                                                                \
        moe_tables(F, F.ctl + CNTW);                                                                                                           \
        pg8::MoeOrder<true> S; S.init(tbl_tb, tokoff, 6, D, D, L == 0 ? F.ws + WS_BIG + BIG_EGU : F.ws + WS_EXP1, (size_t)1536 * D, F.G, blockIdx.x, 1);   \
        { pg8::Unit u; const int* list = (const int*)(aux + AUX_LIST);                                                                         \
          int tk[6]; _Pragma("unroll") for (int k = 0; k < 6; ++k) { const int ui = 2 * k + (F.tid >> 8); tk[k] = -1;                           \
              if (S.next(ui, u)) { const int idx = (u.pm - tbl_tb[u.e]) * 256 + (F.tid & 255); tk[k] = idx < tbl_cnt[u.e] ? list[u.e * 65536 + idx] : 0; } }     \
          _Pragma("unroll") for (int k = 0; k < 6; ++k) if (tk[k] >= 0) tokoff[(2 * k + (F.tid >> 8)) * 256 + (F.tid & 255)] = (unsigned)tk[k] * (unsigned)D; } \
        __syncthreads();                                                                                                                       \
        pg8::EpiSwiglu8 E{F.ws + WS_BIG + BIG_HID};                                                                                            \
        pg8::gemm_phase<pg8::EpiSwiglu8, pg8::MoeOrder<true>, true, 0x79797979, 0x7d7d7d7d>(F.lds, H, D, S, E);         \
    }                                                                                                                                          \
    SEAM(P + 1);                                                                                                                               \
    if (IN(P + 2)) {                                                                                  \
        moe_tables(F, F.ctl + CNTW);                                                                                                           \
        pg8::MoeOrder<false> S; S.init(tbl_tb, tokoff, 8, FF, FF, L == 0 ? F.ws + WS_WIN0 : F.ws + WS_EXP1 + 96 * MiB, (size_t)D * FF, F.G, blockIdx.x, 1);  \
        pg8::EpiDown E{(bf16_t*)(F.ws + WS_BIG + BIG_Y)};                                                \
        pg8::gemm_phase<pg8::EpiDown, pg8::MoeOrder<false>, true, 0x7a7a7a7a, 0x7c7c7c7c>(F.lds, F.ws + WS_BIG + BIG_HID, FF, S, E);     \
    }                                                                                                                                          \
    SEAM(P + 2);
    MOE_LAYER(P_M0A, 0, CW_CNT0)
    if (IN(P_N1)) {
        moe_tables(F, F.ctl + CW_CNT0);
        norm_pass<0, true, true, true, NoHandler, true, true, true>(F, XC16, XC16, (const bf16_t*)(F.ws + WS_BIG + BIG_Y), (const unsigned*)(aux + AUX_ASG), tbl_tb, in[1] + D, nullptr, H, NoHandler{});
        __syncthreads();
    }
    SEAM(P_N1);
    if (IN(P_G1)) {
        pg8::DenseOrder S; S.init(NTOK, ODD_IN, D, D, F.ws + WS_WIN1, F.G, blockIdx.x, 1);
        pg8::EpiBf16 E{(bf16_t*)(F.ws + WS_BIG + BIG_QKV1), ODD_IN};
        pg8::gemm_phase<pg8::EpiBf16, pg8::DenseOrder, true, 0x7a7a7a7a, 0x7d7d7d7d>(F.lds, H, D, S, E);
    }
    SEAM(P_G1);
    if (IN(P_SPREP)) p11_swaprep(F, in[11], in[12]);
    SEAM(P_SPREP);
    if (IN(P_SWA)) { swa_phase(F, in[13]); __syncthreads(); }
    SEAM(P_SWA);
    if (IN(P_O1)) {
        pg8::DenseOrder S; S.init(NTOK, D, D, D, F.ws + WS_WOUT1, F.G, blockIdx.x, 1);
        pg8::EpiRes16<true> E{XC16, XC16, D};
        pg8::gemm_phase<pg8::EpiRes16<true>, pg8::DenseOrder, true, 0x7a7a7a7a, 0x7b7b7b7b>(F.lds, F.ws + WS_H, D, S, E);
    }
    SEAM(P_O1);
    MOE_LAYER(P_M1A, 1, CW_CNT1)
    if (IN(P_FIN)) {
        moe_tables(F, F.ctl + CW_CNT1);
        norm_pass<0, true, true, false, NoHandler, false, true, false>(F, XC16, XC, (const bf16_t*)(F.ws + WS_BIG + BIG_Y), (const unsigned*)(aux + AUX_ASG), tbl_tb, nullptr, nullptr, nullptr, NoHandler{});
    }
#undef IN
#undef SEAM
}

extern "C" void kernel_launch(void* const* d_in, const int* in_sizes, int n_in, void* d_out, int out_size, void* d_ws, size_t ws_size, hipStream_t stream) {
    static int grid = 0;
    if (grid == 0) {
        if (n_in != 20 || in_sizes[0] != NTOK * D || out_size != NTOK * D || ws_size < WS_END) { fprintf(stderr, "kernel_launch: unexpected shapes / workspace (n_in %d, in0 %d, out %d, ws %zu, need %zu)\n", n_in, n_in > 0 ? in_sizes[0] : -1, out_size, ws_size, (size_t)WS_END); grid = -1; return; }
        int dev = 0, cus = 0, per_cu = 0;
        if (hipGetDevice(&dev) != hipSuccess || hipDeviceGetAttribute(&cus, hipDeviceAttributeMultiprocessorCount, dev) != hipSuccess) { grid = -1; return; }
        if (hipFuncSetAttribute((const void*)mk_fwd, hipFuncAttributeMaxDynamicSharedMemorySize, LDS_BYTES) != hipSuccess) { fprintf(stderr, "kernel_launch: hipFuncSetAttribute failed\n"); grid = -1; return; }
        if (hipOccupancyMaxActiveBlocksPerMultiprocessor(&per_cu, (const void*)mk_fwd, NTHR, LDS_BYTES) != hipSuccess || per_cu < 1) fprintf(stderr, "kernel_launch: occupancy query reports %d\n", per_cu);
        (void)hipGetLastError();
        if (cus < 256) { fprintf(stderr, "kernel_launch: built for 256 CUs (got %d)\n", cus); grid = -1; return; }
        grid = 256;
    }
    if (grid < 0) return;
    (void)hipMemsetAsync((char*)d_ws + WS_CTL, 0, CTL_ZERO_BYTES, stream);
    Args a{};
    for (int i = 0; i < 20; ++i) a.in[i] = (const float*)d_in[i];
    a.out = (float*)d_out; a.ws = (unsigned char*)d_ws;
#if MK_MULTI
    for (int p = 0; p <= NPH; ++p) { a.ph_lo = p; a.ph_hi = p + 1; hipLaunchKernelGGL(mk_fwd, dim3(grid), dim3(NTHR), LDS_BYTES, stream, a); }
#else
    a.ph_lo = 0; a.ph_hi = NPH + 1;
    hipLaunchKernelGGL(mk_fwd, dim3(grid), dim3(NTHR), LDS_BYTES, stream, a);
#endif
}
```
